# Optimizing an MI355X kernel written in HIP

```python
import math
import jax, jax.numpy as jnp
from jax import lax
import numpy as np

D_MODEL = 1024
BATCH = 8
SEQ = 8192
DEPTH = 2

MIX_W = D_MODEL
GROUP_W = MIX_W // 4
HEAD_DIM = 64
EPS = 1e-6
NEG_INF = -1e30
ATTN_Q_HEADS = GROUP_W // HEAD_DIM
ATTN_KV_HEADS = 2
WINDOW = 128
SSM_GROUP = 16
SSM_GROUPS = GROUP_W // SSM_GROUP
SSM_STATE = 64
SSM_DT_MIN = 1e-3
SSM_DT_MAX = 1e-1
MLSTM_HEADS = GROUP_W // HEAD_DIM
MLSTM_CHUNK = 128
MLSTM_CONV = 4
SGU_GROUPS = 4
SGU_GROUP_W = GROUP_W // SGU_GROUPS
SGU_CHUNK = 128
IN_SPLITS = (GROUP_W, ATTN_KV_HEADS * HEAD_DIM, ATTN_KV_HEADS * HEAD_DIM,
             GROUP_W,
             GROUP_W, GROUP_W, GROUP_W, MLSTM_HEADS, MLSTM_HEADS, GROUP_W,
             GROUP_W, GROUP_W)
IN_W = 2312
N_EXPERT_GROUPS = 4
EXPERTS_PER_GROUP = 8
N_EXPERTS = N_EXPERT_GROUPS * EXPERTS_PER_GROUP
TOP_K = 2
D_EXPERT = D_MODEL // 2
MOE_BLOCK = 128

kernel_name = 'hymba_style_hybrid_hier_moe'


def rmsnorm(x, g):
    xf = x.astype(jnp.float32)
    y = xf * lax.rsqrt(jnp.mean(xf * xf, axis=-1, keepdims=True) + EPS)
    return (y * g.astype(jnp.float32)).astype(x.dtype)


def layernorm(x, g, b):
    xf = x.astype(jnp.float32)
    mu = jnp.mean(xf, axis=-1, keepdims=True)
    var = jnp.mean(jnp.square(xf - mu), axis=-1, keepdims=True)
    y = (xf - mu) * lax.rsqrt(var + EPS)
    return (y * g.astype(jnp.float32) + b.astype(jnp.float32)).astype(x.dtype)


def causal_depthwise_conv(x, w):
    k = w.shape[0]
    return lax.conv_general_dilated(x, w.astype(x.dtype)[:, None, :], window_strides=(1,),
                                    padding=[(k - 1, 0)], dimension_numbers=('NWC', 'WIO', 'NWC'),
                                    feature_group_count=x.shape[-1])


def sliding_window_sink_attention(q, k, v, sinks):
    bsz, seq, hq, dh = q.shape
    hkv = k.shape[2]
    rep = hq // hkv
    nb = seq // WINDOW
    qb = q.reshape(bsz, nb, WINDOW, hkv, rep, dh)

    def with_prev(t):
        t = t.reshape(bsz, nb, WINDOW, hkv, dh)
        prev = jnp.pad(t[:, :-1], ((0, 0), (1, 0), (0, 0), (0, 0), (0, 0)))
        return jnp.concatenate([prev, t], axis=2)

    kk = with_prev(k)
    vv = with_prev(v)
    scores = jnp.einsum('bnqgrd,bnkgd->bngrqk', qb, kk).astype(jnp.float32) * (dh ** -0.5)
    qi = jnp.arange(WINDOW)[:, None] + WINDOW
    kj = jnp.arange(2 * WINDOW)[None, :]
    band = (kj <= qi) & (kj > qi - WINDOW)
    valid = band[None] & ((jnp.arange(nb)[:, None, None] > 0) | (kj >= WINDOW)[None])
    scores = jnp.where(valid[None, :, None, None], scores, NEG_INF)
    sink = jnp.broadcast_to(sinks.astype(jnp.float32).reshape(hkv, rep)[None, None, :, :, None, None],
                            scores.shape[:-1] + (1,))
    p = jax.nn.softmax(jnp.concatenate([scores, sink], axis=-1), axis=-1)[..., :-1]
    o = jnp.einsum('bngrqk,bnkgd->bnqgrd', p.astype(v.dtype), vv)
    return o.reshape(bsz, seq, hq * dh)


def _ssm_combine(e1, e2):
    a1, b1 = e1
    a2, b2 = e2
    return a2 * a1, a2 * b1 + b2


def s5_mixer(u, a_re, a_im, b_re, b_im, c_re, c_im, d_skip, log_dt, glu_w, glu_b):
    bsz, seq, _ = u.shape
    f32 = jnp.float32
    uf = u.astype(f32).reshape(bsz, seq, SSM_GROUPS, SSM_GROUP)
    a = lax.complex(a_re.astype(f32), a_im.astype(f32))
    dt = jnp.exp(log_dt.astype(f32))[:, None]
    a_bar = jnp.exp(a * dt)
    b_mat = lax.complex(b_re.astype(f32), b_im.astype(f32))
    b_bar = ((a_bar - 1.0) / a)[..., None] * b_mat
    bu = jnp.einsum('bsgh,gph->bsgp', uf.astype(jnp.complex64), b_bar)
    a_seq = jnp.broadcast_to(a_bar, bu.shape)
    _, states = lax.associative_scan(_ssm_combine, (a_seq, bu), axis=1)
    c_mat = lax.complex(c_re.astype(f32), c_im.astype(f32))
    y = jnp.einsum('bsgp,ghp->bsgh', states, c_mat).real + d_skip.astype(f32).reshape(SSM_GROUPS, SSM_GROUP) * uf
    y = jax.nn.gelu(y.reshape(bsz, seq, GROUP_W))
    y = y * jax.nn.sigmoid(y @ glu_w.astype(f32) + glu_b.astype(f32))
    return y.astype(u.dtype)


def mlstm_chunkwise(q, k, v, i_pre, f_pre):
    bsz, seq, nh, dh = q.shape
    L = MLSTM_CHUNK
    nc = seq // L
    f32 = jnp.float32
    q = q.astype(f32)
    k = k.astype(f32) * (dh ** -0.5)
    v = v.astype(f32)
    log_f = jax.nn.log_sigmoid(f_pre.astype(f32))
    log_i = i_pre.astype(f32)

    def to_chunks(t):
        return jnp.moveaxis(t.reshape((bsz, nc, L) + t.shape[2:]), 1, 0)

    causal = jnp.tril(jnp.ones((L, L), dtype=bool))

    def step(carry, inp):
        c_st, n_st, m_st = carry
        qc, kc, vc, ic, fc = inp
        b = jnp.cumsum(fc, axis=1).transpose(0, 2, 1)
        ih = ic.transpose(0, 2, 1)
        log_d = jnp.where(causal, b[..., :, None] - b[..., None, :] + ih[..., None, :], -jnp.inf)
        log_inter = b + m_st[..., None]
        m_t = jnp.maximum(log_inter, jnp.max(log_d, axis=-1))
        w_intra = jnp.exp(log_d - m_t[..., None]) * jnp.einsum('blhd,bshd->bhls', qc, kc)
        w_inter = jnp.exp(log_inter - m_t)
        num = (jnp.einsum('bhls,bshd->blhd', w_intra, vc)
               + jnp.einsum('bhl,bhvk,blhk->blhv', w_inter, c_st, qc))
        den = jnp.sum(w_intra, axis=-1) + w_inter * jnp.einsum('bhk,blhk->bhl', n_st, qc)
        h = num / jnp.maximum(jnp.abs(den), jnp.exp(-m_t)).transpose(0, 2, 1)[..., None]
        m_new = m_t[..., -1]
        w_s = jnp.exp(b[..., -1:] - b + ih - m_new[..., None])
        decay = jnp.exp(b[..., -1] + m_st - m_new)
        c_new = decay[..., None, None] * c_st + jnp.einsum('bhs,bshv,bshk->bhvk', w_s, vc, kc)
        n_new = decay[..., None] * n_st + jnp.einsum('bhs,bshk->bhk', w_s, kc)
        return (c_new, n_new, m_new), h

    init = (jnp.zeros((bsz, nh, dh, dh), f32), jnp.zeros((bsz, nh, dh), f32), jnp.zeros((bsz, nh), f32))
    xs = (to_chunks(q), to_chunks(k), to_chunks(v), to_chunks(log_i), to_chunks(log_f))
    _, hs = lax.scan(step, init, xs)
    return jnp.moveaxis(hs, 0, 1).reshape(bsz, seq, nh, dh)


def mlstm_mixer(cq, ck, cv, ci, cf, co, conv_w, gate_b, norm_g):
    bsz, seq, _ = cq.shape
    qk = jax.nn.silu(causal_depthwise_conv(jnp.concatenate([cq, ck], axis=-1), conv_w))
    q, k = jnp.split(qk, 2, axis=-1)
    shp = (bsz, seq, MLSTM_HEADS, HEAD_DIM)
    gb = gate_b.astype(jnp.float32)
    h = mlstm_chunkwise(q.reshape(shp), k.reshape(shp), cv.reshape(shp),
                        ci.astype(jnp.float32) + gb[:MLSTM_HEADS], cf.astype(jnp.float32) + gb[MLSTM_HEADS:])
    h = h * lax.rsqrt(jnp.mean(h * h, axis=-1, keepdims=True) + EPS)
    h = h * norm_g.astype(jnp.float32).reshape(MLSTM_HEADS, HEAD_DIM)
    out = jax.nn.sigmoid(co.astype(jnp.float32)) * h.reshape(bsz, seq, GROUP_W)
    return out.astype(cq.dtype)


def sgu_mixer(gu, gv, ln_g, ln_b, w_s, b_s):
    bsz, seq, _ = gu.shape
    nc = seq // SGU_CHUNK
    u = jax.nn.gelu(gu)
    v = layernorm(jax.nn.gelu(gv), ln_g, ln_b)
    vb = v.reshape(bsz, nc, SGU_CHUNK, SGU_GROUPS, SGU_GROUP_W)
    w = w_s.astype(v.dtype) * jnp.tril(jnp.ones((SGU_CHUNK, SGU_CHUNK), v.dtype))
    mixed = jnp.einsum('gts,bnsgc->bntgc', w, vb) + b_s.astype(v.dtype).T[None, None, :, :, None]
    return u * mixed.reshape(bsz, seq, GROUP_W)


def hier_moe(h, wg, bg, we, be, w_gate, w_up, w_down):
    bsz, seq, d = h.shape
    n = bsz * seq
    xf = h.reshape(n, d)
    g_logits = (xf @ wg + bg).astype(jnp.float32)
    g_prob = jax.nn.softmax(g_logits, axis=-1)
    g_sel = jnp.argmax(g_logits, axis=-1)
    p_g = jnp.take_along_axis(g_prob, g_sel[:, None], axis=1)[:, 0]
    e_logits = (xf @ we + be).astype(jnp.float32).reshape(n, N_EXPERT_GROUPS, EXPERTS_PER_GROUP)
    e_in = jnp.take_along_axis(e_logits, g_sel[:, None, None], axis=1)[:, 0]
    top_v, top_i = lax.top_k(e_in, TOP_K)
    w_pair = jax.nn.softmax(top_v, axis=-1) * p_g[:, None]
    expert_id = (g_sel[:, None] * EXPERTS_PER_GROUP + top_i).reshape(-1).astype(jnp.int32)
    tok = jnp.repeat(jnp.arange(n, dtype=jnp.int32), TOP_K)
    wts = w_pair.reshape(-1)
    m = n * TOP_K
    order = jnp.argsort(expert_id)
    se, st, sw = expert_id[order], tok[order], wts[order]
    counts = jnp.bincount(expert_id, length=N_EXPERTS)
    padded = ((counts + MOE_BLOCK - 1) // MOE_BLOCK) * MOE_BLOCK
    pad_end = jnp.cumsum(padded)
    pad_start = pad_end - padded
    start = jnp.cumsum(counts) - counts
    dest = pad_start[se] + jnp.arange(m, dtype=jnp.int32) - start[se]
    p_tot = ((m + MOE_BLOCK - 1) // MOE_BLOCK) * MOE_BLOCK + N_EXPERTS * MOE_BLOCK
    nblk = p_tot // MOE_BLOCK
    pad_tok = jnp.full((p_tot,), n, jnp.int32).at[dest].set(st)
    pad_w = jnp.zeros((p_tot,), jnp.float32).at[dest].set(sw)
    blk_e = jnp.minimum(jnp.searchsorted(pad_end, jnp.arange(nblk, dtype=jnp.int32) * MOE_BLOCK, side='right'),
                        N_EXPERTS - 1)
    x_ext = jnp.concatenate([xf, jnp.zeros((1, d), xf.dtype)], axis=0)

    def run_block(args):
        tb, wb, e = args
        xb = x_ext[tb]
        y = (jax.nn.silu(xb @ w_gate[e]) * (xb @ w_up[e])) @ w_down[e]
        return y * wb[:, None].astype(y.dtype)

    yb = lax.map(run_block, (pad_tok.reshape(nblk, MOE_BLOCK), pad_w.reshape(nblk, MOE_BLOCK), blk_e))
    out = jnp.zeros((n + 1, d), yb.dtype).at[pad_tok].add(yb.reshape(p_tot, d))[:n]
    return out.reshape(bsz, seq, d).astype(h.dtype)


def setup_inputs(seed: int = 0) -> dict:
    key = jax.random.key(seed)
    ks = jax.random.split(key, 40)
    f32 = jnp.float32

    def nrm(k, shape, scale):
        return jax.random.normal(k, shape, f32) * scale

    P, G, H = SSM_STATE, SSM_GROUPS, SSM_GROUP
    return {
        'x': nrm(ks[0], (BATCH, SEQ, D_MODEL), 1.0),
        'norm_mix_g': 1.0 + nrm(ks[1], (DEPTH, D_MODEL), 0.02),
        'w_in': nrm(ks[2], (DEPTH, D_MODEL, IN_W), D_MODEL ** -0.5),
        'attn_sinks': nrm(ks[3], (DEPTH, ATTN_Q_HEADS), 0.5),
        'ssm_a_re': -0.5 + nrm(ks[4], (DEPTH, G, P), 0.01),
        'ssm_a_im': math.pi * jnp.arange(P, dtype=f32) + nrm(ks[5], (DEPTH, G, P), 0.01),
        'ssm_b_re': nrm(ks[6], (DEPTH, G, P, H), (2 * H) ** -0.5),
        'ssm_b_im': nrm(ks[7], (DEPTH, G, P, H), (2 * H) ** -0.5),
        'ssm_c_re': nrm(ks[8], (DEPTH, G, H, P), P ** -0.5),
        'ssm_c_im': nrm(ks[9], (DEPTH, G, H, P), P ** -0.5),
        'ssm_d': nrm(ks[10], (DEPTH, GROUP_W), 1.0),
        'ssm_log_dt': jax.random.uniform(ks[11], (DEPTH, G), f32, math.log(SSM_DT_MIN), math.log(SSM_DT_MAX)),
        'ssm_glu_w': nrm(ks[12], (DEPTH, GROUP_W, GROUP_W), GROUP_W ** -0.5),
        'ssm_glu_b': nrm(ks[13], (DEPTH, GROUP_W), 0.01),
        'mlstm_conv_w': nrm(ks[14], (DEPTH, MLSTM_CONV, 2 * GROUP_W), MLSTM_CONV ** -0.5),
        'mlstm_gate_b': jnp.concatenate([nrm(ks[15], (DEPTH, MLSTM_HEADS), 0.1),
                                         jnp.linspace(3.0, 6.0, MLSTM_HEADS, dtype=f32)[None, :]
                                         + nrm(ks[16], (DEPTH, MLSTM_HEADS), 0.1)], axis=-1),
        'mlstm_norm_g': 1.0 + nrm(ks[17], (DEPTH, GROUP_W), 0.02),
        'sgu_ln_g': 1.0 + nrm(ks[18], (DEPTH, GROUP_W), 0.02),
        'sgu_ln_b': nrm(ks[19], (DEPTH, GROUP_W), 0.02),
        'sgu_w': nrm(ks[20], (DEPTH, SGU_GROUPS, SGU_CHUNK, SGU_CHUNK), SGU_CHUNK ** -0.5),
        'sgu_b': 1.0 + nrm(ks[21], (DEPTH, SGU_GROUPS, SGU_CHUNK), 0.02),
        'w_out': nrm(ks[22], (DEPTH, MIX_W, D_MODEL), MIX_W ** -0.5),
        'norm_ffn_g': 1.0 + nrm(ks[23], (DEPTH, D_MODEL), 0.02),
        'router_group_w': nrm(ks[24], (DEPTH, D_MODEL, N_EXPERT_GROUPS), D_MODEL ** -0.5),
        'router_group_b': nrm(ks[25], (DEPTH, N_EXPERT_GROUPS), 0.01),
        'router_expert_w': nrm(ks[26], (DEPTH, D_MODEL, N_EXPERTS), D_MODEL ** -0.5),
        'router_expert_b': nrm(ks[27], (DEPTH, N_EXPERTS), 0.01),
        'expert_w_gate': nrm(ks[28], (DEPTH, N_EXPERTS, D_MODEL, D_EXPERT), D_MODEL ** -0.5),
        'expert_w_up': nrm(ks[29], (DEPTH, N_EXPERTS, D_MODEL, D_EXPERT), D_MODEL ** -0.5),
        'expert_w_down': nrm(ks[30], (DEPTH, N_EXPERTS, D_EXPERT, D_MODEL), D_EXPERT ** -0.5),
        'norm_final_g': 1.0 + nrm(ks[31], (D_MODEL,), 0.02),
    }


def reference(x, norm_mix_g, w_in, attn_sinks, ssm_a_re, ssm_a_im, ssm_b_re, ssm_b_im, ssm_c_re, ssm_c_im,
              ssm_d, ssm_log_dt, ssm_glu_w, ssm_glu_b, mlstm_conv_w, mlstm_gate_b, mlstm_norm_g,
              sgu_ln_g, sgu_ln_b, sgu_w, sgu_b, w_out, norm_ffn_g, router_group_w, router_group_b,
              router_expert_w, router_expert_b, expert_w_gate, expert_w_up, expert_w_down, norm_final_g):
    bsz, seq, _ = x.shape
    split_idx = np.cumsum(IN_SPLITS)[:-1].tolist()
    for l in range(DEPTH):
        h = rmsnorm(x, norm_mix_g[l])
        z = h @ w_in[l]
        aq, ak, av, su, cq, ck, cv, ci, cf, co, gu, gv = jnp.split(z, split_idx, axis=-1)
        y_a = sliding_window_sink_attention(aq.reshape(bsz, seq, ATTN_Q_HEADS, HEAD_DIM),
                                            ak.reshape(bsz, seq, ATTN_KV_HEADS, HEAD_DIM),
                                            av.reshape(bsz, seq, ATTN_KV_HEADS, HEAD_DIM), attn_sinks[l])
        y_b = s5_mixer(su, ssm_a_re[l], ssm_a_im[l], ssm_b_re[l], ssm_b_im[l], ssm_c_re[l], ssm_c_im[l],
                       ssm_d[l], ssm_log_dt[l], ssm_glu_w[l], ssm_glu_b[l])
        y_c = mlstm_mixer(cq, ck, cv, ci, cf, co, mlstm_conv_w[l], mlstm_gate_b[l], mlstm_norm_g[l])
        y_d = sgu_mixer(gu, gv, sgu_ln_g[l], sgu_ln_b[l], sgu_w[l], sgu_b[l])
        mix = jnp.concatenate([y_a.astype(x.dtype), y_b.astype(x.dtype), y_c.astype(x.dtype), y_d.astype(x.dtype)], axis=-1)
        x = x + mix @ w_out[l]
        h = rmsnorm(x, norm_ffn_g[l])
        x = x + hier_moe(h, router_group_w[l], router_group_b[l], router_expert_w[l], router_expert_b[l],
                         expert_w_gate[l], expert_w_up[l], expert_w_down[l])
    return rmsnorm(x, norm_final_g)
```

```cpp
#include <hip/hip_runtime.h>
#include <stdint.h>
#include <stdio.h>

#define LAS __attribute__((address_space(3)))

constexpr int D = 1024, NB = 8, S = 8192, NTOK = NB * S, INW = 2312, NLAYER = 2;
constexpr int NEXP = 32, DE = 512;
constexpr float EPS = 1e-6f;
constexpr int ZQ = 0, ZK = 256, ZV = 384, ZSU = 512, ZCQ = 768, ZCK = 1024, ZCV = 1280, ZCI = 1536, ZCF = 1540, ZCO = 1544, ZGU = 1800, ZGV = 2056;
constexpr int NTHREADS = 512;
constexpr int LDS_BYTES = 144 * 1024;
constexpr int PH_PER_LAYER = 8, N_PHASES = NLAYER * PH_PER_LAYER + 1;

constexpr size_t MiB = 1u << 20;
constexpr size_t WS_CTL = 0, CTL_BYTES = 1 * MiB;
constexpr size_t WS_Z = WS_CTL + CTL_BYTES;
constexpr size_t Z_BYTES = (size_t)NTOK * INW * 4;
constexpr size_t WS_H = WS_Z;
constexpr size_t WS_ACT = WS_Z + (size_t)NTOK * D * 4;
constexpr int PMAX = 2 * NTOK + NEXP * 128;
static_assert((size_t)NTOK * D * 4 + (size_t)PMAX * DE * 4 <= Z_BYTES, "alias fits");
constexpr size_t WS_MIX = WS_Z + Z_BYTES;
constexpr size_t WS_LIST = WS_MIX + (size_t)NTOK * D * 4;
constexpr size_t WS_END = WS_LIST + (size_t)NEXP * NTOK * 8;
constexpr int CW_CNT = 8192;

#define XB_TMO      128
#define XB_XCNT(j)  (256  + 64 * (j))
#define XB_XSUB(j)  (1280 + 64 * (j))
#define XB_XGEN(j)  (2304 + 64 * (j))
#define XB_TOP      3328
#define XB_TOPGEN   3392
#define XCD_BAR_WORDS 3456
#define XB_SPIN_CAP (1u << 22)
__device__ __forceinline__ unsigned xb_ld(unsigned* p)              { return __hip_atomic_load(p, __ATOMIC_RELAXED, __HIP_MEMORY_SCOPE_AGENT); }
__device__ __forceinline__ unsigned xb_add(unsigned* p, unsigned v) { return __hip_atomic_fetch_add(p, v, __ATOMIC_RELAXED, __HIP_MEMORY_SCOPE_AGENT); }
__device__ __forceinline__ unsigned xb_xcc_id() { return (unsigned)__builtin_amdgcn_s_getreg((3 << 11) | 20) & 0xFu; }
#define XB_SPIN(cond, bar) do { unsigned _sp = 0; while (cond) { __builtin_amdgcn_s_sleep(1); \
    if ((++_sp & 255u) == 0u) { if (xb_ld(&(bar)[XB_TMO])) break; if (_sp > XB_SPIN_CAP) { atomicAdd(&(bar)[XB_TMO], 1u); break; } } } } while (0)
struct XcdBarrier { unsigned* bar; unsigned x; volatile LAS unsigned* st; };
__device__ __forceinline__ XcdBarrier xcd_barrier_post(unsigned* bar, volatile LAS unsigned* st) {
    XcdBarrier b; b.bar = bar; b.x = xb_xcc_id(); b.st = st;
    if (threadIdx.x == 0) (void)xb_add(&bar[XB_XCNT(b.x)], 1u);
    return b;
}
__device__ __forceinline__ void xcd_barrier_complete(unsigned* bar, unsigned x, unsigned& nloc, unsigned& nx) {
    const unsigned G = gridDim.x * gridDim.y * gridDim.z;
    unsigned sum, cnt, mine, sp = 0u;
    for (;;) {
        sum = 0u; cnt = 0u; mine = 0u;
#pragma unroll
        for (unsigned j = 0; j < 16; ++j) { const unsigned c = xb_ld(&bar[XB_XCNT(j)]); sum += c; cnt += (c > 0u) ? 1u : 0u; mine = (j == x) ? c : mine; }
        if (sum == G) break;
        __builtin_amdgcn_s_sleep(1);
        if ((++sp & 255u) == 0u) { if (xb_ld(&bar[XB_TMO])) break; if (sp > XB_SPIN_CAP) { atomicAdd(&bar[XB_TMO], 1u); break; } }
    }
    nloc = mine > 0u ? mine : 1u; nx = cnt > 0u ? cnt : 1u;
}
__device__ __forceinline__ void xcd_barrier(const XcdBarrier& b) {
    asm volatile("s_waitcnt vmcnt(0)" ::: "memory");
    __syncthreads();
    if (threadIdx.x == 0) {
        unsigned* bar = b.bar;
        __builtin_amdgcn_s_waitcnt(0);
        unsigned nloc = b.st[0], nx = b.st[1];
        if (nloc == 0u) { xcd_barrier_complete(bar, b.x, nloc, nx); b.st[0] = nloc; b.st[1] = nx; }
        const unsigned old = xb_add(&bar[XB_XSUB(b.x)], 1u);
        const unsigned gen = old / nloc;
        if (old + 1u == (gen + 1u) * nloc) {
            __builtin_amdgcn_fence(__ATOMIC_RELEASE, "agent");
            asm volatile("s_waitcnt vmcnt(0)" ::: "memory");
            const unsigned og = xb_add(&bar[XB_TOP], 1u);
            const unsigned tg = og / nx;
            if (og + 1u == (tg + 1u) * nx) xb_add(&bar[XB_TOPGEN], 1u);
            else XB_SPIN(xb_ld(&bar[XB_TOPGEN]) == tg, bar);
            __builtin_amdgcn_fence(__ATOMIC_ACQUIRE, "agent");
            xb_add(&bar[XB_XGEN(b.x)], 1u);
            asm volatile("s_waitcnt vmcnt(0)" ::: "memory");
        } else {
            XB_SPIN(xb_ld(&bar[XB_XGEN(b.x)]) == gen, bar);
            __builtin_amdgcn_fence(__ATOMIC_ACQUIRE, "agent");
            asm volatile("s_waitcnt vmcnt(0)" ::: "memory");
        }
    }
    __syncthreads();
}

__device__ __forceinline__ float wave_sum(float v) {
#pragma unroll
    for (int o = 32; o > 0; o >>= 1) v += __shfl_xor(v, o);
    return v;
}
__device__ __forceinline__ float gelu_tanh(float x) {
    const float u = 0.7978845608028654f * (x + 0.044715f * x * x * x);
    return 0.5f * x * (1.f + tanhf(u));
}
__device__ __forceinline__ float sigm(float x) { return 1.f / (1.f + expf(-x)); }
__device__ __forceinline__ void wave_lds_fence() {
    __builtin_amdgcn_fence(__ATOMIC_RELEASE, "wavefront"); __builtin_amdgcn_wave_barrier(); __builtin_amdgcn_fence(__ATOMIC_ACQUIRE, "wavefront");
}

struct Params {
    const float* in[31];
    float* out;
    unsigned char* ws;
    int ph_lo, ph_hi;
};
enum { I_X = 0, I_NMG, I_WIN, I_SINK, I_ARE, I_AIM, I_BRE, I_BIM, I_CRE, I_CIM, I_SD, I_LDT, I_GLUW, I_GLUB, I_CONVW, I_GATEB, I_MNG,
       I_LNG, I_LNB, I_SGUW, I_SGUB, I_WOUT, I_NFG, I_RGW, I_RGB, I_REW, I_REB, I_EWG, I_EWU, I_EWD, I_NFIN };

__device__ __forceinline__ void ph_rmsnorm(const float* src, const float* g, float* dst) {
    const int wave = threadIdx.x >> 6, lane = threadIdx.x & 63;
    const float4* g4 = (const float4*)g;
    for (int r = blockIdx.x * 8 + wave; r < NTOK; r += gridDim.x * 8) {
        const float4* p = (const float4*)(src + (size_t)r * D);
        float4 v[4]; float ss = 0.f;
#pragma unroll
        for (int i = 0; i < 4; ++i) { v[i] = p[lane + 64 * i]; ss += v[i].x * v[i].x + v[i].y * v[i].y + v[i].z * v[i].z + v[i].w * v[i].w; }
        ss = wave_sum(ss);
        const float rs = rsqrtf(ss * (1.f / D) + EPS);
        float4* q = (float4*)(dst + (size_t)r * D);
#pragma unroll
        for (int i = 0; i < 4; ++i) { const float4 gg = g4[lane + 64 * i]; float4 o; o.x = v[i].x * rs * gg.x; o.y = v[i].y * rs * gg.y; o.z = v[i].z * rs * gg.z; o.w = v[i].w * rs * gg.w; q[lane + 64 * i] = o; }
    }
}

template <bool DUAL, class AF, class EF>
__device__ __forceinline__ void gemm_tile(float* lds, AF arow, int K, const float* B0, const float* B1, int ldb, int n0, int N, EF epi) {
    float* As = lds;
    float* Bs0 = lds + 32 * 132;
    float* Bs1 = Bs0 + 32 * 128;
    const int tid = threadIdx.x, ty = tid >> 4, tx = tid & 15;
    float acc0[4][8], acc1[4][8];
#pragma unroll
    for (int i = 0; i < 4; ++i)
#pragma unroll
        for (int j = 0; j < 8; ++j) { acc0[i][j] = 0.f; acc1[i][j] = 0.f; }
    const float* ap0 = arow((tid >> 3));
    const float* ap1 = arow((tid >> 3) + 64);
    const int akk = (tid & 7) * 4;
    const int bn = n0 + (tid & 31) * 4; const bool bok = bn < N;
    for (int k0 = 0; k0 < K; k0 += 32) {
        const float4 av0 = ap0 ? *(const float4*)(ap0 + k0 + akk) : make_float4(0.f, 0.f, 0.f, 0.f);
        const float4 av1 = ap1 ? *(const float4*)(ap1 + k0 + akk) : make_float4(0.f, 0.f, 0.f, 0.f);
        const int kb0 = k0 + (tid >> 5), kb1 = kb0 + 16;
        const float4 bv00 = bok ? *(const float4*)(B0 + (size_t)kb0 * ldb + bn) : make_float4(0.f, 0.f, 0.f, 0.f);
        const float4 bv01 = bok ? *(const float4*)(B0 + (size_t)kb1 * ldb + bn) : make_float4(0.f, 0.f, 0.f, 0.f);
        const float4 bv10 = (DUAL && bok) ? *(const float4*)(B1 + (size_t)kb0 * ldb + bn) : bv00;
        const float4 bv11 = (DUAL && bok) ? *(const float4*)(B1 + (size_t)kb1 * ldb + bn) : bv01;
        __syncthreads();
        { const int r = (tid >> 3);
          As[(akk + 0) * 132 + r] = av0.x; As[(akk + 1) * 132 + r] = av0.y; As[(akk + 2) * 132 + r] = av0.z; As[(akk + 3) * 132 + r] = av0.w;
          As[(akk + 0) * 132 + r + 64] = av1.x; As[(akk + 1) * 132 + r + 64] = av1.y; As[(akk + 2) * 132 + r + 64] = av1.z; As[(akk + 3) * 132 + r + 64] = av1.w; }
        { const int k = (tid >> 5);
          *(float4*)&Bs0[k * 128 + (tid & 31) * 4] = bv00; *(float4*)&Bs0[(k + 16) * 128 + (tid & 31) * 4] = bv01;
          if (DUAL) { *(float4*)&Bs1[k * 128 + (tid & 31) * 4] = bv10; *(float4*)&Bs1[(k + 16) * 128 + (tid & 31) * 4] = bv11; } }
        __syncthreads();
#pragma unroll 4
        for (int k = 0; k < 32; ++k) {
            const float4 a = *(const float4*)&As[k * 132 + ty * 4];
            const float4 b0 = *(const float4*)&Bs0[k * 128 + tx * 4], b1 = *(const float4*)&Bs0[k * 128 + 64 + tx * 4];
            const float aa[4] = {a.x, a.y, a.z, a.w};
            const float bb[8] = {b0.x, b0.y, b0.z, b0.w, b1.x, b1.y, b1.z, b1.w};
#pragma unroll
            for (int i = 0; i < 4; ++i)
#pragma unroll
                for (int j = 0; j < 8; ++j) acc0[i][j] = fmaf(aa[i], bb[j], acc0[i][j]);
            if (DUAL) {
                const float4 c0 = *(const float4*)&Bs1[k * 128 + tx * 4], c1 = *(const float4*)&Bs1[k * 128 + 64 + tx * 4];
                const float cc[8] = {c0.x, c0.y, c0.z, c0.w, c1.x, c1.y, c1.z, c1.w};
#pragma unroll
                for (int i = 0; i < 4; ++i)
#pragma unroll
                    for (int j = 0; j < 8; ++j) acc1[i][j] = fmaf(aa[i], cc[j], acc1[i][j]);
            }
        }
    }
#pragma unroll
    for (int i = 0; i < 4; ++i)
#pragma unroll
        for (int j = 0; j < 8; ++j) {
            const int r = ty * 4 + i, c = n0 + (j < 4 ? tx * 4 + j : 64 + tx * 4 + (j - 4));
            if (c < N) epi(r, c, acc0[i][j], acc1[i][j]);
        }
    __syncthreads();
}

__device__ __forceinline__ void ph_inproj(float* lds, const float* xn, const float* w, float* z) {
    constexpr int NCT = (INW + 127) / 128, NRT = NTOK / 128;
    for (int u = blockIdx.x; u < NRT * NCT; u += gridDim.x) {
        const int rt = u / NCT, ct = u % NCT; const int m0 = rt * 128, n0 = ct * 128;
        gemm_tile<false>(lds, [&](int r) { return xn + (size_t)(m0 + r) * D; }, D, w, w, INW, n0, INW,
                         [&](int r, int c, float v, float) { z[(size_t)(m0 + r) * INW + c] = v; });
    }
}

__device__ __forceinline__ void attn_wave(const float* z, const float* sinks, float* mix, int u, int lane) {
    const int b = u >> 10, hq = (u >> 8) & 3, t0 = (u & 255) * 32, t = t0 + (lane >> 1), g = hq >> 1, dh = (lane & 1) * 32;
    float q[32];
    { const float4* qp = (const float4*)(z + (size_t)(b * S + t) * INW + ZQ + hq * 64 + dh);
#pragma unroll
      for (int i = 0; i < 8; ++i) { const float4 v = qp[i]; q[4 * i] = v.x * 0.125f; q[4 * i + 1] = v.y * 0.125f; q[4 * i + 2] = v.z * 0.125f; q[4 * i + 3] = v.w * 0.125f; } }
    float m = sinks[hq], l = 1.f; float o[32];
#pragma unroll
    for (int d = 0; d < 32; ++d) o[d] = 0.f;
    const int jlo = (t0 - 127) > 0 ? (t0 - 127) : 0, jhi = t0 + 31;
    for (int j = jlo; j <= jhi; ++j) {
        const float4* kp = (const float4*)(z + (size_t)(b * S + j) * INW + ZK + g * 64 + dh);
        const float4* vp = (const float4*)(z + (size_t)(b * S + j) * INW + ZV + g * 64 + dh);
        float s = 0.f;
#pragma unroll
        for (int i = 0; i < 8; ++i) { const float4 kv = kp[i]; s += q[4 * i] * kv.x + q[4 * i + 1] * kv.y + q[4 * i + 2] * kv.z + q[4 * i + 3] * kv.w; }
        s += __shfl_xor(s, 1);
        const bool valid = (j <= t) && (j > t - 128);
        const float mn = valid ? fmaxf(m, s) : m;
        const float corr = expf(m - mn), p = valid ? expf(s - mn) : 0.f;
        l = l * corr + p; m = mn;
#pragma unroll
        for (int i = 0; i < 8; ++i) { const float4 vv = vp[i];
            o[4 * i] = o[4 * i] * corr + p * vv.x; o[4 * i + 1] = o[4 * i + 1] * corr + p * vv.y; o[4 * i + 2] = o[4 * i + 2] * corr + p * vv.z; o[4 * i + 3] = o[4 * i + 3] * corr + p * vv.w; }
    }
    const float inv = 1.f / l;
    float4* op = (float4*)(mix + (size_t)(b * S + t) * D + hq * 64 + dh);
#pragma unroll
    for (int i = 0; i < 8; ++i) op[i] = make_float4(o[4 * i] * inv, o[4 * i + 1] * inv, o[4 * i + 2] * inv, o[4 * i + 3] * inv);
}

__device__ __forceinline__ void s5_wave(float* wl  , float* z, const Params& P, int l, int u, int lane) {
    const int b = u >> 4, g = u & 15, p = lane;
    float* XS = wl;
    float* CT = wl + 16 * 130;
    const int gp = (l * 16 + g) * 64 + p;
    const float ar = P.in[I_ARE][gp], ai = P.in[I_AIM][gp], dt = expf(P.in[I_LDT][l * 16 + g]);
    const float er = expf(ar * dt); const float abr = er * cosf(ai * dt), abi = er * sinf(ai * dt);
    const float xr_ = abr - 1.f, xi_ = abi, den = ar * ar + ai * ai;
    const float cr = (xr_ * ar + xi_ * ai) / den, ci = (xi_ * ar - xr_ * ai) / den;
    float bbr[16], bbi[16];
#pragma unroll
    for (int h = 0; h < 16; ++h) { const float br = P.in[I_BRE][(size_t)gp * 16 + h], bi = P.in[I_BIM][(size_t)gp * 16 + h]; bbr[h] = cr * br - ci * bi; bbi[h] = cr * bi + ci * br; }
#pragma unroll
    for (int h = 0; h < 16; ++h) { const int ci_ = ((l * 16 + g) * 16 + h) * 64 + p; CT[h * 130 + 2 * p] = P.in[I_CRE][ci_]; CT[h * 130 + 2 * p + 1] = P.in[I_CIM][ci_]; }
    const int tt_o = lane >> 2, hq = lane & 3;
    float dsk[4];
#pragma unroll
    for (int k = 0; k < 4; ++k) dsk[k] = P.in[I_SD][l * 256 + g * 16 + hq * 4 + k];
    float sr = 0.f, si = 0.f;
    wave_lds_fence();
    for (int t0 = 0; t0 < S; t0 += 16) {
#pragma unroll 4
        for (int tt = 0; tt < 16; ++tt) {
            const float4* up = (const float4*)(z + (size_t)(b * S + t0 + tt) * INW + ZSU + g * 16);
            float bur = 0.f, bui = 0.f;
#pragma unroll
            for (int i = 0; i < 4; ++i) { const float4 uu = up[i];
                bur += bbr[4 * i] * uu.x + bbr[4 * i + 1] * uu.y + bbr[4 * i + 2] * uu.z + bbr[4 * i + 3] * uu.w;
                bui += bbi[4 * i] * uu.x + bbi[4 * i + 1] * uu.y + bbi[4 * i + 2] * uu.z + bbi[4 * i + 3] * uu.w; }
            const float nr = abr * sr - abi * si + bur, ni = abr * si + abi * sr + bui; sr = nr; si = ni;
            XS[tt * 130 + 2 * p] = sr; XS[tt * 130 + 2 * p + 1] = si;
        }
        wave_lds_fence();
        float y[4] = {0.f, 0.f, 0.f, 0.f};
        for (int p2 = 0; p2 < 64; ++p2) {
            const float xr = XS[tt_o * 130 + 2 * p2], xi = XS[tt_o * 130 + 2 * p2 + 1];
#pragma unroll
            for (int k = 0; k < 4; ++k) y[k] += CT[(hq * 4 + k) * 130 + 2 * p2] * xr - CT[(hq * 4 + k) * 130 + 2 * p2 + 1] * xi;
        }
        float4* up = (float4*)(z + (size_t)(b * S + t0 + tt_o) * INW + ZSU + g * 16 + hq * 4);
        const float4 uu = *up;
        float4 o; o.x = gelu_tanh(y[0] + dsk[0] * uu.x); o.y = gelu_tanh(y[1] + dsk[1] * uu.y); o.z = gelu_tanh(y[2] + dsk[2] * uu.z); o.w = gelu_tanh(y[3] + dsk[3] * uu.w);
        *up = o;
        wave_lds_fence();
    }
}

__device__ __forceinline__ void mlstm_block(float* lds, const float* z, float* mix, const Params& P, int l, int u) {
    const int b = u >> 2, head = u & 3, tid = threadIdx.x;
    float* RAW = lds;
    float* QK = RAW + 19 * 128;
    float* V = QK + 16 * 128;
    float* GT = V + 16 * 64;
    const int i = tid >> 3, jg = tid & 7;
    float C[8], n[8];
#pragma unroll
    for (int j = 0; j < 8; ++j) { C[j] = 0.f; n[j] = 0.f; }
    float mstate = 0.f;
    const float* cw = P.in[I_CONVW] + (size_t)l * 4 * 512;
    const float gbi = P.in[I_GATEB][l * 8 + head], gbf = P.in[I_GATEB][l * 8 + 4 + head];
    for (int t0 = 0; t0 < S; t0 += 16) {
        __syncthreads();
        for (int idx = tid; idx < 19 * 128; idx += NTHREADS) { const int tt = idx >> 7, c = idx & 127, tg = t0 - 3 + tt;
            const int col = (c < 64) ? (ZCQ + head * 64 + c) : (ZCK + head * 64 + (c - 64));
            RAW[idx] = (tg >= 0) ? z[(size_t)(b * S + tg) * INW + col] : 0.f; }
        for (int idx = tid; idx < 16 * 64; idx += NTHREADS) { const int tt = idx >> 6, c = idx & 63; V[idx] = z[(size_t)(b * S + t0 + tt) * INW + ZCV + head * 64 + c]; }
        if (tid == 0) {
            float m = mstate;
            for (int tt = 0; tt < 16; ++tt) {
                const float* zr = z + (size_t)(b * S + t0 + tt) * INW;
                const float ipre = zr[ZCI + head] + gbi, fpre = zr[ZCF + head] + gbf;
                const float logf = fminf(fpre, 0.f) - log1pf(expf(-fabsf(fpre)));
                const float mn = fmaxf(logf + m, ipre);
                GT[tt * 4 + 0] = expf(logf + m - mn); GT[tt * 4 + 1] = expf(ipre - mn); GT[tt * 4 + 2] = expf(-mn); m = mn;
            }
            mstate = m;
        }
        __syncthreads();
        for (int idx = tid; idx < 16 * 128; idx += NTHREADS) { const int tt = idx >> 7, c = idx & 127;
            const int cc = (c < 64) ? (head * 64 + c) : (256 + head * 64 + (c - 64));
            float x = 0.f;
#pragma unroll
            for (int j = 0; j < 4; ++j) x += cw[j * 512 + cc] * RAW[(tt + j) * 128 + c];
            float y = x * sigm(x); if (c >= 64) y *= 0.125f;
            QK[idx] = y; }
        __syncthreads();
        for (int tt = 0; tt < 16; ++tt) {
            const float4 q0 = *(const float4*)&QK[tt * 128 + jg * 8], q1 = *(const float4*)&QK[tt * 128 + jg * 8 + 4];
            const float4 k0 = *(const float4*)&QK[tt * 128 + 64 + jg * 8], k1 = *(const float4*)&QK[tt * 128 + 64 + jg * 8 + 4];
            const float v = V[tt * 64 + i], a = GT[tt * 4], bb = GT[tt * 4 + 1], en = GT[tt * 4 + 2];
            const float qq[8] = {q0.x, q0.y, q0.z, q0.w, q1.x, q1.y, q1.z, q1.w}, kk[8] = {k0.x, k0.y, k0.z, k0.w, k1.x, k1.y, k1.z, k1.w};
            float pn = 0.f, pd = 0.f; const float bv = bb * v;
#pragma unroll
            for (int j = 0; j < 8; ++j) { C[j] = a * C[j] + bv * kk[j]; n[j] = a * n[j] + bb * kk[j]; pn += C[j] * qq[j]; pd += n[j] * qq[j]; }
            pn += __shfl_xor(pn, 1); pd += __shfl_xor(pd, 1); pn += __shfl_xor(pn, 2); pd += __shfl_xor(pd, 2); pn += __shfl_xor(pn, 4); pd += __shfl_xor(pd, 4);
            if (jg == 0) mix[(size_t)(b * S + t0 + tt) * D + 512 + head * 64 + i] = pn / fmaxf(fabsf(pd), en);
        }
    }
    __syncthreads();
}

__device__ __forceinline__ void sgu_ln_wave(float* z, const float* lng, const float* lnb, int tok, int lane) {
    float4* p = (float4*)(z + (size_t)tok * INW + ZGV) + lane;
    float4 v = *p; v.x = gelu_tanh(v.x); v.y = gelu_tanh(v.y); v.z = gelu_tanh(v.z); v.w = gelu_tanh(v.w);
    const float mu = wave_sum(v.x + v.y + v.z + v.w) * (1.f / 256.f);
    const float dx = v.x - mu, dy = v.y - mu, dz = v.z - mu, dw = v.w - mu;
    const float var = wave_sum(dx * dx + dy * dy + dz * dz + dw * dw) * (1.f / 256.f);
    const float rs = rsqrtf(var + EPS);
    const float4 g = ((const float4*)lng)[lane], bb = ((const float4*)lnb)[lane];
    *p = make_float4(dx * rs * g.x + bb.x, dy * rs * g.y + bb.y, dz * rs * g.z + bb.z, dw * rs * g.w + bb.w);
}

__device__ __forceinline__ void ph_mix1(float* lds, const Params& P, int l, float* z, float* mix) {
    const int G = gridDim.x, bid = blockIdx.x, wave = threadIdx.x >> 6, lane = threadIdx.x & 63;
    for (int u = bid; u < 32; u += G) mlstm_block(lds, z, mix, P, l, u);
    {
        const int rb = G - 1 - bid;
        for (int u = rb * 8 + wave; u < 128; u += G * 8) s5_wave(lds + wave * (2 * 16 * 130), z, P, l, u, lane);
    }
    const bool split = (G >= 96);
    const int nlight = split ? G - 48 : G, lid = split ? bid - 32 : bid;
    if (lid >= 0 && lid < nlight) {
        const float* sinks = P.in[I_SINK] + l * 4;
        for (int u = lid * 8 + wave; u < 8192; u += nlight * 8) attn_wave(z, sinks, mix, u, lane);
        for (int tok = lid * 8 + wave; tok < NTOK; tok += nlight * 8) sgu_ln_wave(z, P.in[I_LNG] + l * 256, P.in[I_LNB] + l * 256, tok, lane);
    }
}

__device__ __forceinline__ void ph_mix2(float* lds, const Params& P, int l, const float* z, float* mix) {
    const int wave = threadIdx.x >> 6, lane = threadIdx.x & 63, tid = threadIdx.x;
    const float* gw = P.in[I_GLUW] + (size_t)l * 256 * 256; const float* gb = P.in[I_GLUB] + l * 256;
    for (int u = blockIdx.x; u < (NTOK / 128) * 2; u += gridDim.x) {
        const int m0 = (u >> 1) * 128, n0 = (u & 1) * 128;
        gemm_tile<false>(lds, [&](int r) { return z + (size_t)(m0 + r) * INW + ZSU; }, 256, gw, gw, 256, n0, 256,
                         [&](int r, int c, float v, float) { const float y = z[(size_t)(m0 + r) * INW + ZSU + c]; mix[(size_t)(m0 + r) * D + 256 + c] = y * sigm(v + gb[c]); });
    }
    const float* ng = P.in[I_MNG] + l * 256;
    for (int tok = blockIdx.x * 8 + wave; tok < NTOK; tok += gridDim.x * 8) {
        float4* hp = (float4*)(mix + (size_t)tok * D + 512) + lane;
        const float4 h = *hp;
        float ss = h.x * h.x + h.y * h.y + h.z * h.z + h.w * h.w;
        ss += __shfl_xor(ss, 1); ss += __shfl_xor(ss, 2); ss += __shfl_xor(ss, 4); ss += __shfl_xor(ss, 8);
        const float rs = rsqrtf(ss * (1.f / 64.f) + EPS);
        const float4 g = ((const float4*)ng)[lane];
        const float4 co = *((const float4*)(z + (size_t)tok * INW + ZCO) + lane);
        *hp = make_float4(h.x * rs * g.x * sigm(co.x), h.y * rs * g.y * sigm(co.y), h.z * rs * g.z * sigm(co.z), h.w * rs * g.w * sigm(co.w));
    }
    const float* sw = P.in[I_SGUW] + (size_t)l * 4 * 128 * 128; const float* sb = P.in[I_SGUB] + l * 4 * 128;
    for (int u = blockIdx.x; u < NTOK / 128; u += gridDim.x) {
        const int tok0 = u * 128;
        __syncthreads();
        for (int idx = tid; idx < 128 * 64; idx += NTHREADS) { const int s = idx >> 6, c4 = idx & 63;
            *(float4*)&lds[s * 256 + c4 * 4] = *((const float4*)(z + (size_t)(tok0 + s) * INW + ZGV) + c4); }
        __syncthreads();
        const int c = tid & 255, half = tid >> 8, g = c >> 6;
        for (int tt = 0; tt < 64; ++tt) {
            const int t = half * 64 + tt;
            const float* wr = sw + ((size_t)g * 128 + t) * 128;
            float acc = 0.f;
            for (int s = 0; s <= t; ++s) acc += wr[s] * lds[s * 256 + c];
            const float gu = z[(size_t)(tok0 + t) * INW + ZGU + c];
            mix[(size_t)(tok0 + t) * D + 768 + c] = gelu_tanh(gu) * (acc + sb[g * 128 + t]);
        }
    }
    __syncthreads();
}

__device__ __forceinline__ void ph_outproj(float* lds, const float* mix, const float* w, const float* xsrc, float* xout) {
    for (int u = blockIdx.x; u < (NTOK / 128) * 8; u += gridDim.x) {
        const int m0 = (u >> 3) * 128, n0 = (u & 7) * 128;
        gemm_tile<false>(lds, [&](int r) { return mix + (size_t)(m0 + r) * D; }, D, w, w, D, n0, D,
                         [&](int r, int c, float v, float) { const size_t o = (size_t)(m0 + r) * D + c; xout[o] = xsrc[o] + v; });
    }
}

__device__ __forceinline__ void ph_norm_router(const Params& P, int l, const float* x, float* H, unsigned* cnt, int2* lists) {
    const int wave = threadIdx.x >> 6, lane = threadIdx.x & 63;
    const float* gn = P.in[I_NFG] + l * D;
    const float* wg = P.in[I_RGW] + (size_t)l * D * 4; const float* we = P.in[I_REW] + (size_t)l * D * 32;
    const float* bg = P.in[I_RGB] + l * 4; const float* be = P.in[I_REB] + l * 32;
    for (int r = blockIdx.x * 8 + wave; r < NTOK; r += gridDim.x * 8) {
        const float* xr = x + (size_t)r * D; float* hr = H + (size_t)r * D;
        float ss = 0.f;
        { const float4* p = (const float4*)xr;
#pragma unroll
          for (int i = 0; i < 4; ++i) { const float4 v = p[lane + 64 * i]; ss += v.x * v.x + v.y * v.y + v.z * v.z + v.w * v.w; } }
        ss = wave_sum(ss);
        const float rs = rsqrtf(ss * (1.f / D) + EPS);
        float lg[36];
#pragma unroll
        for (int c = 0; c < 36; ++c) lg[c] = 0.f;
#pragma unroll 1
        for (int kk = 0; kk < 16; ++kk) {
            const int k = kk * 64 + lane;
            const float hv = xr[k] * rs * gn[k];
            hr[k] = hv;
            const float4 w4 = *(const float4*)(wg + (size_t)k * 4);
            lg[0] += hv * w4.x; lg[1] += hv * w4.y; lg[2] += hv * w4.z; lg[3] += hv * w4.w;
#pragma unroll
            for (int e4 = 0; e4 < 8; ++e4) { const float4 w = *(const float4*)(we + (size_t)k * 32 + e4 * 4);
                lg[4 + e4 * 4] += hv * w.x; lg[5 + e4 * 4] += hv * w.y; lg[6 + e4 * 4] += hv * w.z; lg[7 + e4 * 4] += hv * w.w; }
        }
#pragma unroll
        for (int c = 0; c < 36; ++c) lg[c] = wave_sum(lg[c]);
        if (lane == 0) {
            float gl[4];
#pragma unroll
            for (int j = 0; j < 4; ++j) gl[j] = lg[j] + bg[j];
            int sel = 0; float gm = gl[0];
#pragma unroll
            for (int j = 1; j < 4; ++j) if (gl[j] > gm) { gm = gl[j]; sel = j; }
            float gs = 0.f;
#pragma unroll
            for (int j = 0; j < 4; ++j) gs += expf(gl[j] - gm);
            const float pg = 1.f / gs;
            float ein[8];
#pragma unroll
            for (int j = 0; j < 8; ++j) { const float a0 = lg[4 + j] + be[j], a1 = lg[12 + j] + be[8 + j], a2 = lg[20 + j] + be[16 + j], a3 = lg[28 + j] + be[24 + j];
                ein[j] = sel == 0 ? a0 : (sel == 1 ? a1 : (sel == 2 ? a2 : a3)); }
            int i1 = 0; float v1 = ein[0];
#pragma unroll
            for (int j = 1; j < 8; ++j) if (ein[j] > v1) { v1 = ein[j]; i1 = j; }
            int i2 = -1; float v2 = -3.0e38f;
#pragma unroll
            for (int j = 0; j < 8; ++j) if (j != i1 && ein[j] > v2) { v2 = ein[j]; i2 = j; }
            const float e2 = expf(v2 - v1), den = 1.f / (1.f + e2);
            const float w1 = den * pg, w2 = e2 * den * pg;
            const int ex1 = sel * 8 + i1, ex2 = sel * 8 + i2;
            const unsigned p1 = atomicAdd(&cnt[ex1], 1u), p2 = atomicAdd(&cnt[ex2], 1u);
            lists[(size_t)ex1 * NTOK + p1] = make_int2(r, __float_as_int(w1));
            lists[(size_t)ex2 * NTOK + p2] = make_int2(r, __float_as_int(w2));
        }
    }
}

struct ExpTile { int e, pos0, T; };
__device__ __forceinline__ bool find_tile(const unsigned* cnt, int T, ExpTile& et) {
    int base = 0;
    for (int e = 0; e < NEXP; ++e) { const int c = (int)cnt[e], nt = (c + 127) >> 7;
        if (T < base + nt) { et.e = e; et.pos0 = (T - base) * 128; et.T = T; return true; }
        base += nt; }
    return false;
}
__device__ __forceinline__ int total_tiles(const unsigned* cnt) { int base = 0; for (int e = 0; e < NEXP; ++e) base += ((int)cnt[e] + 127) >> 7; return base; }

__device__ __forceinline__ void ph_moe1(float* lds, const Params& P, int l, const float* H, const unsigned* cnt, const int2* lists, float* act) {
    const int ntile = total_tiles(cnt);
    for (int u = blockIdx.x; u < ntile * 4; u += gridDim.x) {
        ExpTile et; if (!find_tile(cnt, u >> 2, et)) break;
        const int n0 = (u & 3) * 128; const int c_e = (int)cnt[et.e];
        const int2* lst = lists + (size_t)et.e * NTOK + et.pos0;
        const float* wgt = P.in[I_EWG] + ((size_t)l * NEXP + et.e) * D * DE; const float* wup = P.in[I_EWU] + ((size_t)l * NEXP + et.e) * D * DE;
        gemm_tile<true>(lds, [&](int r) -> const float* { return (et.pos0 + r < c_e) ? H + (size_t)lst[r].x * D : nullptr; }, D, wgt, wup, DE, n0, DE,
                        [&](int r, int c, float g, float uu) { act[(size_t)(et.T * 128 + r) * DE + c] = g * sigm(g) * uu; });
    }
}
__device__ __forceinline__ void ph_moe2(float* lds, const Params& P, int l, const float* act, const unsigned* cnt, const int2* lists, float* x) {
    const int ntile = total_tiles(cnt);
    for (int u = blockIdx.x; u < ntile * 8; u += gridDim.x) {
        ExpTile et; if (!find_tile(cnt, u >> 3, et)) break;
        const int n0 = (u & 7) * 128; const int c_e = (int)cnt[et.e];
        const int2* lst = lists + (size_t)et.e * NTOK + et.pos0;
        const float* wd = P.in[I_EWD] + ((size_t)l * NEXP + et.e) * DE * D;
        gemm_tile<false>(lds, [&](int r) -> const float* { return (et.pos0 + r < c_e) ? act + (size_t)(et.T * 128 + r) * DE : nullptr; }, DE, wd, wd, D, n0, D,
                         [&](int r, int c, float v, float) { if (et.pos0 + r < c_e) { const int2 tw = lst[r]; atomicAdd(&x[(size_t)tw.x * D + c], __int_as_float(tw.y) * v); } });
    }
}

__global__ void __launch_bounds__(NTHREADS, 2) fwd_kernel(Params P) {
    extern __shared__ __attribute__((aligned(16))) unsigned char lds_raw[];
    float* lds = (float*)lds_raw;
    volatile LAS unsigned* xbw = (volatile LAS unsigned*)(lds_raw + LDS_BYTES - 16);
    if (threadIdx.x == 0) { xbw[0] = 0u; xbw[1] = 0u; }
    __syncthreads();
    unsigned* ctl = (unsigned*)(P.ws + WS_CTL);
    const bool multi = (P.ph_hi - P.ph_lo) > 1;
    XcdBarrier bar; bar.bar = ctl; bar.x = 0; bar.st = xbw;
    if (multi) bar = xcd_barrier_post(ctl, xbw);
    float* z = (float*)(P.ws + WS_Z); float* mix = (float*)(P.ws + WS_MIX);
    float* H = (float*)(P.ws + WS_H); float* act = (float*)(P.ws + WS_ACT);
    int2* lists = (int2*)(P.ws + WS_LIST);
    const int lo = P.ph_lo, hi = P.ph_hi;
#define IN(k) (lo <= (k) && (k) < hi)
#define SEAM(k) do { if (IN(k) && IN((k) + 1)) xcd_barrier(bar); } while (0)
    for (int l = 0; l < NLAYER; ++l) {
        const int pb = l * PH_PER_LAYER;
        const float* xsrc = (l == 0) ? P.in[I_X] : P.out;
        unsigned* cnt = ctl + CW_CNT + l * 64;
        if (IN(pb + 0)) { ph_rmsnorm(xsrc, P.in[I_NMG] + l * D, mix); } SEAM(pb + 0);
        if (IN(pb + 1)) { ph_inproj(lds, mix, P.in[I_WIN] + (size_t)l * D * INW, z); } SEAM(pb + 1);
        if (IN(pb + 2)) { ph_mix1(lds, P, l, z, mix); } SEAM(pb + 2);
        if (IN(pb + 3)) { ph_mix2(lds, P, l, z, mix); } SEAM(pb + 3);
        if (IN(pb + 4)) { ph_outproj(lds, mix, P.in[I_WOUT] + (size_t)l * D * D, xsrc, P.out); } SEAM(pb + 4);
        if (IN(pb + 5)) { ph_norm_router(P, l, P.out, H, cnt, lists); } SEAM(pb + 5);
        if (IN(pb + 6)) { ph_moe1(lds, P, l, H, cnt, lists, act); } SEAM(pb + 6);
        if (IN(pb + 7)) { ph_moe2(lds, P, l, act, cnt, lists, P.out); } SEAM(pb + 7);
    }
    if (IN(NLAYER * PH_PER_LAYER)) ph_rmsnorm(P.out, P.in[I_NFIN], P.out);
#undef IN
#undef SEAM
}

#ifndef N_LAUNCH_MODE
#define N_LAUNCH_MODE 0
#endif
extern "C" void kernel_launch(void* const* d_in, const int* in_sizes, int n_in, void* d_out, int out_size, void* d_ws, size_t ws_size, hipStream_t stream) {
    static int grid = 0;
    if (grid == 0) {
        if (n_in != 31 || out_size != NTOK * D || ws_size < WS_END) { fprintf(stderr, "kernel_launch: unexpected shapes n_in %d out %d ws %zu (need %zu)\n", n_in, out_size, ws_size, (size_t)WS_END); grid = -1; return; }
        int dev = 0, cus = 0, per_cu = 0;
        if (hipGetDevice(&dev) != hipSuccess || hipDeviceGetAttribute(&cus, hipDeviceAttributeMultiprocessorCount, dev) != hipSuccess) { grid = -1; return; }
        if (hipFuncSetAttribute((const void*)fwd_kernel, hipFuncAttributeMaxDynamicSharedMemorySize, LDS_BYTES) != hipSuccess) { fprintf(stderr, "kernel_launch: hipFuncSetAttribute failed\n"); grid = -1; return; }
        if (hipOccupancyMaxActiveBlocksPerMultiprocessor(&per_cu, (const void*)fwd_kernel, NTHREADS, LDS_BYTES) != hipSuccess || per_cu < 1) { fprintf(stderr, "kernel_launch: occupancy query says %d\n", per_cu); }
        (void)hipGetLastError();
        grid = cus;
    }
    if (grid < 0) return;
    (void)hipMemsetAsync((char*)d_ws + WS_CTL, 0, CTL_BYTES, stream);
    Params p{};
    for (int i = 0; i < 31; ++i) p.in[i] = (const float*)d_in[i];
    p.out = (float*)d_out; p.ws = (unsigned char*)d_ws;
#if N_LAUNCH_MODE == 1
    p.ph_lo = 0; p.ph_hi = N_PHASES;
    hipLaunchKernelGGL(fwd_kernel, dim3(grid), dim3(NTHREADS), LDS_BYTES, stream, p);
#else
    for (int ph = 0; ph < N_PHASES; ++ph) { p.ph_lo = ph; p.ph_hi = ph + 1; hipLaunchKernelGGL(fwd_kernel, dim3(grid), dim3(NTHREADS), LDS_BYTES, stream, p); }
#endif
}
```

```cpp
#include <hip/hip_runtime.h>
#include <stdint.h>
#include <stdio.h>

#define LAS __attribute__((address_space(3)))

constexpr int D = 1024, NB = 8, S = 8192, NTOK = NB * S, INW = 2312, NLAYER = 2;
constexpr int NEXP = 32, DE = 512;
constexpr float EPS = 1e-6f;
constexpr int ZQ = 0, ZK = 256, ZV = 384, ZSU = 512, ZCQ = 768, ZCK = 1024, ZCV = 1280, ZCI = 1536, ZCF = 1540, ZCO = 1544, ZGU = 1800, ZGV = 2056;
constexpr int NTHREADS = 512;
constexpr int LDS_BYTES = 144 * 1024;
constexpr int PH_PER_LAYER = 8, N_PHASES = NLAYER * PH_PER_LAYER + 1;

constexpr size_t MiB = 1u << 20;
constexpr size_t WS_CTL = 0, CTL_BYTES = 1 * MiB;
constexpr size_t WS_Z = WS_CTL + CTL_BYTES;
constexpr size_t Z_BYTES = (size_t)NTOK * INW * 4;
constexpr size_t WS_H = WS_Z;
constexpr size_t WS_ACT = WS_Z + (size_t)NTOK * D * 4;
constexpr int PMAX = 2 * NTOK + NEXP * 128;
static_assert((size_t)NTOK * D * 4 + (size_t)PMAX * DE * 4 <= Z_BYTES, "alias fits");
constexpr size_t WS_MIX = WS_Z + Z_BYTES;
constexpr size_t WS_LIST = WS_MIX + (size_t)NTOK * D * 4;
constexpr size_t WS_END = WS_LIST + (size_t)NEXP * NTOK * 8;
constexpr int CW_CNT = 8192;

#define XB_TMO      128
#define XB_XCNT(j)  (256  + 64 * (j))
#define XB_XSUB(j)  (1280 + 64 * (j))
#define XB_XGEN(j)  (2304 + 64 * (j))
#define XB_TOP      3328
#define XB_TOPGEN   3392
#define XCD_BAR_WORDS 3456
#define XB_SPIN_CAP (1u << 22)
__device__ __forceinline__ unsigned xb_ld(unsigned* p)              { return __hip_atomic_load(p, __ATOMIC_RELAXED, __HIP_MEMORY_SCOPE_AGENT); }
__device__ __forceinline__ unsigned xb_add(unsigned* p, unsigned v) { return __hip_atomic_fetch_add(p, v, __ATOMIC_RELAXED, __HIP_MEMORY_SCOPE_AGENT); }
__device__ __forceinline__ unsigned xb_xcc_id() { return (unsigned)__builtin_amdgcn_s_getreg((3 << 11) | 20) & 0xFu; }
#define XB_SPIN(cond, bar) do { unsigned _sp = 0; while (cond) { __builtin_amdgcn_s_sleep(1); \
    if ((++_sp & 255u) == 0u) { if (xb_ld(&(bar)[XB_TMO])) break; if (_sp > XB_SPIN_CAP) { atomicAdd(&(bar)[XB_TMO], 1u); break; } } } } while (0)
struct XcdBarrier { unsigned* bar; unsigned x; volatile LAS unsigned* st; };
__device__ __forceinline__ XcdBarrier xcd_barrier_post(unsigned* bar, volatile LAS unsigned* st) {
    XcdBarrier b; b.bar = bar; b.x = xb_xcc_id(); b.st = st;
    if (threadIdx.x == 0) (void)xb_add(&bar[XB_XCNT(b.x)], 1u);
    return b;
}
__device__ __forceinline__ void xcd_barrier_complete(unsigned* bar, unsigned x, unsigned& nloc, unsigned& nx) {
    const unsigned G = gridDim.x * gridDim.y * gridDim.z;
    unsigned sum, cnt, mine, sp = 0u;
    for (;;) {
        sum = 0u; cnt = 0u; mine = 0u;
#pragma unroll
        for (unsigned j = 0; j < 16; ++j) { const unsigned c = xb_ld(&bar[XB_XCNT(j)]); sum += c; cnt += (c > 0u) ? 1u : 0u; mine = (j == x) ? c : mine; }
        if (sum == G) break;
        __builtin_amdgcn_s_sleep(1);
        if ((++sp & 255u) == 0u) { if (xb_ld(&bar[XB_TMO])) break; if (sp > XB_SPIN_CAP) { atomicAdd(&bar[XB_TMO], 1u); break; } }
    }
    nloc = mine > 0u ? mine : 1u; nx = cnt > 0u ? cnt : 1u;
}
__device__ __forceinline__ void xcd_barrier(const XcdBarrier& b) {
    asm volatile("s_waitcnt vmcnt(0)" ::: "memory");
    __syncthreads();
    if (threadIdx.x == 0) {
        unsigned* bar = b.bar;
        __builtin_amdgcn_s_waitcnt(0);
        unsigned nloc = b.st[0], nx = b.st[1];
        if (nloc == 0u) { xcd_barrier_complete(bar, b.x, nloc, nx); b.st[0] = nloc; b.st[1] = nx; }
        const unsigned old = xb_add(&bar[XB_XSUB(b.x)], 1u);
        const unsigned gen = old / nloc;
        if (old + 1u == (gen + 1u) * nloc) {
            __builtin_amdgcn_fence(__ATOMIC_RELEASE, "agent");
            asm volatile("s_waitcnt vmcnt(0)" ::: "memory");
            const unsigned og = xb_add(&bar[XB_TOP], 1u);
            const unsigned tg = og / nx;
            if (og + 1u == (tg + 1u) * nx) xb_add(&bar[XB_TOPGEN], 1u);
            else XB_SPIN(xb_ld(&bar[XB_TOPGEN]) == tg, bar);
            __builtin_amdgcn_fence(__ATOMIC_ACQUIRE, "agent");
            xb_add(&bar[XB_XGEN(b.x)], 1u);
            asm volatile("s_waitcnt vmcnt(0)" ::: "memory");
        } else {
            XB_SPIN(xb_ld(&bar[XB_XGEN(b.x)]) == gen, bar);
            __builtin_amdgcn_fence(__ATOMIC_ACQUIRE, "agent");
            asm volatile("s_waitcnt vmcnt(0)" ::: "memory");
        }
    }
    __syncthreads();
}

__device__ __forceinline__ float wave_sum(float v) {
#pragma unroll
    for (int o = 32; o > 0; o >>= 1) v += __shfl_xor(v, o);
    return v;
}
__device__ __forceinline__ float gelu_tanh(float x) {
    const float u = 0.7978845608028654f * (x + 0.044715f * x * x * x);
    return 0.5f * x * (1.f + tanhf(u));
}
__device__ __forceinline__ float sigm(float x) { return 1.f / (1.f + expf(-x)); }
__device__ __forceinline__ void wave_lds_fence() {
    __builtin_amdgcn_fence(__ATOMIC_RELEASE, "wavefront"); __builtin_amdgcn_wave_barrier(); __builtin_amdgcn_fence(__ATOMIC_ACQUIRE, "wavefront");
}

struct Params {
    const float* in[31];
    float* out;
    unsigned char* ws;
    int ph_lo, ph_hi;
};
enum { I_X = 0, I_NMG, I_WIN, I_SINK, I_ARE, I_AIM, I_BRE, I_BIM, I_CRE, I_CIM, I_SD, I_LDT, I_GLUW, I_GLUB, I_CONVW, I_GATEB, I_MNG,
       I_LNG, I_LNB, I_SGUW, I_SGUB, I_WOUT, I_NFG, I_RGW, I_RGB, I_REW, I_REB, I_EWG, I_EWU, I_EWD, I_NFIN };

__device__ __forceinline__ void ph_rmsnorm(const float* src, const float* g, float* dst) {
    const int wave = threadIdx.x >> 6, lane = threadIdx.x & 63;
    const float4* g4 = (const float4*)g;
    for (int r = blockIdx.x * 8 + wave; r < NTOK; r += gridDim.x * 8) {
        const float4* p = (const float4*)(src + (size_t)r * D);
        float4 v[4]; float ss = 0.f;
#pragma unroll
        for (int i = 0; i < 4; ++i) { v[i] = p[lane + 64 * i]; ss += v[i].x * v[i].x + v[i].y * v[i].y + v[i].z * v[i].z + v[i].w * v[i].w; }
        ss = wave_sum(ss);
        const float rs = rsqrtf(ss * (1.f / D) + EPS);
        float4* q = (float4*)(dst + (size_t)r * D);
#pragma unroll
        for (int i = 0; i < 4; ++i) { const float4 gg = g4[lane + 64 * i]; float4 o; o.x = v[i].x * rs * gg.x; o.y = v[i].y * rs * gg.y; o.z = v[i].z * rs * gg.z; o.w = v[i].w * rs * gg.w; q[lane + 64 * i] = o; }
    }
}

template <bool DUAL, class AF, class EF>
__device__ __forceinline__ void gemm_tile(float* lds, AF arow, int K, const float* B0, const float* B1, int ldb, int n0, int N, EF epi) {
    float* As = lds;
    float* Bs0 = lds + 32 * 132;
    float* Bs1 = Bs0 + 32 * 128;
    const int tid = threadIdx.x, ty = tid >> 4, tx = tid & 15;
    float acc0[4][8], acc1[4][8];
#pragma unroll
    for (int i = 0; i < 4; ++i)
#pragma unroll
        for (int j = 0; j < 8; ++j) { acc0[i][j] = 0.f; acc1[i][j] = 0.f; }
    const float* ap0 = arow((tid >> 3));
    const float* ap1 = arow((tid >> 3) + 64);
    const int akk = (tid & 7) * 4;
    const int bn = n0 + (tid & 31) * 4; const bool bok = bn < N;
    for (int k0 = 0; k0 < K; k0 += 32) {
        const float4 av0 = ap0 ? *(const float4*)(ap0 + k0 + akk) : make_float4(0.f, 0.f, 0.f, 0.f);
        const float4 av1 = ap1 ? *(const float4*)(ap1 + k0 + akk) : make_float4(0.f, 0.f, 0.f, 0.f);
        const int kb0 = k0 + (tid >> 5), kb1 = kb0 + 16;
        const float4 bv00 = bok ? *(const float4*)(B0 + (size_t)kb0 * ldb + bn) : make_float4(0.f, 0.f, 0.f, 0.f);
        const float4 bv01 = bok ? *(const float4*)(B0 + (size_t)kb1 * ldb + bn) : make_float4(0.f, 0.f, 0.f, 0.f);
        const float4 bv10 = (DUAL && bok) ? *(const float4*)(B1 + (size_t)kb0 * ldb + bn) : bv00;
        const float4 bv11 = (DUAL && bok) ? *(const float4*)(B1 + (size_t)kb1 * ldb + bn) : bv01;
        __syncthreads();
        { const int r = (tid >> 3);
          As[(akk + 0) * 132 + r] = av0.x; As[(akk + 1) * 132 + r] = av0.y; As[(akk + 2) * 132 + r] = av0.z; As[(akk + 3) * 132 + r] = av0.w;
          As[(akk + 0) * 132 + r + 64] = av1.x; As[(akk + 1) * 132 + r + 64] = av1.y; As[(akk + 2) * 132 + r + 64] = av1.z; As[(akk + 3) * 132 + r + 64] = av1.w; }
        { const int k = (tid >> 5);
          *(float4*)&Bs0[k * 128 + (tid & 31) * 4] = bv00; *(float4*)&Bs0[(k + 16) * 128 + (tid & 31) * 4] = bv01;
          if (DUAL) { *(float4*)&Bs1[k * 128 + (tid & 31) * 4] = bv10; *(float4*)&Bs1[(k + 16) * 128 + (tid & 31) * 4] = bv11; } }
        __syncthreads();
#pragma unroll 4
        for (int k = 0; k < 32; ++k) {
            const float4 a = *(const float4*)&As[k * 132 + ty * 4];
            const float4 b0 = *(const float4*)&Bs0[k * 128 + tx * 4], b1 = *(const float4*)&Bs0[k * 128 + 64 + tx * 4];
            const float aa[4] = {a.x, a.y, a.z, a.w};
            const float bb[8] = {b0.x, b0.y, b0.z, b0.w, b1.x, b1.y, b1.z, b1.w};
#pragma unroll
            for (int i = 0; i < 4; ++i)
#pragma unroll
                for (int j = 0; j < 8; ++j) acc0[i][j] = fmaf(aa[i], bb[j], acc0[i][j]);
            if (DUAL) {
                const float4 c0 = *(const float4*)&Bs1[k * 128 + tx * 4], c1 = *(const float4*)&Bs1[k * 128 + 64 + tx * 4];
                const float cc[8] = {c0.x, c0.y, c0.z, c0.w, c1.x, c1.y, c1.z, c1.w};
#pragma unroll
                for (int i = 0; i < 4; ++i)
#pragma unroll
                    for (int j = 0; j < 8; ++j) acc1[i][j] = fmaf(aa[i], cc[j], acc1[i][j]);
            }
        }
    }
#pragma unroll
    for (int i = 0; i < 4; ++i)
#pragma unroll
        for (int j = 0; j < 8; ++j) {
            const int r = ty * 4 + i, c = n0 + (j < 4 ? tx * 4 + j : 64 + tx * 4 + (j - 4));
            if (c < N) epi(r, c, acc0[i][j], acc1[i][j]);
        }
    __syncthreads();
}

__device__ __forceinline__ void ph_inproj(float* lds, const float* xn, const float* w, float* z) {
    constexpr int NCT = (INW + 127) / 128, NRT = NTOK / 128;
    for (int u = blockIdx.x; u < NRT * NCT; u += gridDim.x) {
        const int rt = u / NCT, ct = u % NCT; const int m0 = rt * 128, n0 = ct * 128;
        gemm_tile<false>(lds, [&](int r) { return xn + (size_t)(m0 + r) * D; }, D, w, w, INW, n0, INW,
                         [&](int r, int c, float v, float) { z[(size_t)(m0 + r) * INW + c] = v; });
    }
}

__device__ __forceinline__ void attn_wave(const float* z, const float* sinks, float* mix, int u, int lane) {
    const int b = u >> 10, hq = (u >> 8) & 3, t0 = (u & 255) * 32, t = t0 + (lane >> 1), g = hq >> 1, dh = (lane & 1) * 32;
    float q[32];
    { const float4* qp = (const float4*)(z + (size_t)(b * S + t) * INW + ZQ + hq * 64 + dh);
#pragma unroll
      for (int i = 0; i < 8; ++i) { const float4 v = qp[i]; q[4 * i] = v.x * 0.125f; q[4 * i + 1] = v.y * 0.125f; q[4 * i + 2] = v.z * 0.125f; q[4 * i + 3] = v.w * 0.125f; } }
    float m = sinks[hq], l = 1.f; float o[32];
#pragma unroll
    for (int d = 0; d < 32; ++d) o[d] = 0.f;
    const int jlo = (t0 - 127) > 0 ? (t0 - 127) : 0, jhi = t0 + 31;
    for (int j = jlo; j <= jhi; ++j) {
        const float4* kp = (const float4*)(z + (size_t)(b * S + j) * INW + ZK + g * 64 + dh);
        const float4* vp = (const float4*)(z + (size_t)(b * S + j) * INW + ZV + g * 64 + dh);
        float s = 0.f;
#pragma unroll
        for (int i = 0; i < 8; ++i) { const float4 kv = kp[i]; s += q[4 * i] * kv.x + q[4 * i + 1] * kv.y + q[4 * i + 2] * kv.z + q[4 * i + 3] * kv.w; }
        s += __shfl_xor(s, 1);
        const bool valid = (j <= t) && (j > t - 128);
        const float mn = valid ? fmaxf(m, s) : m;
        const float corr = expf(m - mn), p = valid ? expf(s - mn) : 0.f;
        l = l * corr + p; m = mn;
#pragma unroll
        for (int i = 0; i < 8; ++i) { const float4 vv = vp[i];
            o[4 * i] = o[4 * i] * corr + p * vv.x; o[4 * i + 1] = o[4 * i + 1] * corr + p * vv.y; o[4 * i + 2] = o[4 * i + 2] * corr + p * vv.z; o[4 * i + 3] = o[4 * i + 3] * corr + p * vv.w; }
    }
    const float inv = 1.f / l;
    float4* op = (float4*)(mix + (size_t)(b * S + t) * D + hq * 64 + dh);
#pragma unroll
    for (int i = 0; i < 8; ++i) op[i] = make_float4(o[4 * i] * inv, o[4 * i + 1] * inv, o[4 * i + 2] * inv, o[4 * i + 3] * inv);
}

__device__ __forceinline__ void s5_wave(float* wl  , float* z, const Params& P, int l, int u, int lane) {
    const int b = u >> 4, g = u & 15, p = lane;
    float* XS = wl;
    float* CT = wl + 16 * 130;
    const int gp = (l * 16 + g) * 64 + p;
    const float ar = P.in[I_ARE][gp], ai = P.in[I_AIM][gp], dt = expf(P.in[I_LDT][l * 16 + g]);
    const float er = expf(ar * dt); const float abr = er * cosf(ai * dt), abi = er * sinf(ai * dt);
    const float xr_ = abr - 1.f, xi_ = abi, den = ar * ar + ai * ai;
    const float cr = (xr_ * ar + xi_ * ai) / den, ci = (xi_ * ar - xr_ * ai) / den;
    float bbr[16], bbi[16];
#pragma unroll
    for (int h = 0; h < 16; ++h) { const float br = P.in[I_BRE][(size_t)gp * 16 + h], bi = P.in[I_BIM][(size_t)gp * 16 + h]; bbr[h] = cr * br - ci * bi; bbi[h] = cr * bi + ci * br; }
#pragma unroll
    for (int h = 0; h < 16; ++h) { const int ci_ = ((l * 16 + g) * 16 + h) * 64 + p; CT[h * 130 + 2 * p] = P.in[I_CRE][ci_]; CT[h * 130 + 2 * p + 1] = P.in[I_CIM][ci_]; }
    const int tt_o = lane >> 2, hq = lane & 3;
    float dsk[4];
#pragma unroll
    for (int k = 0; k < 4; ++k) dsk[k] = P.in[I_SD][l * 256 + g * 16 + hq * 4 + k];
    float sr = 0.f, si = 0.f;
    wave_lds_fence();
    for (int t0 = 0; t0 < S; t0 += 16) {
#pragma unroll 4
        for (int tt = 0; tt < 16; ++tt) {
            const float4* up = (const float4*)(z + (size_t)(b * S + t0 + tt) * INW + ZSU + g * 16);
            float bur = 0.f, bui = 0.f;
#pragma unroll
            for (int i = 0; i < 4; ++i) { const float4 uu = up[i];
                bur += bbr[4 * i] * uu.x + bbr[4 * i + 1] * uu.y + bbr[4 * i + 2] * uu.z + bbr[4 * i + 3] * uu.w;
                bui += bbi[4 * i] * uu.x + bbi[4 * i + 1] * uu.y + bbi[4 * i + 2] * uu.z + bbi[4 * i + 3] * uu.w; }
            const float nr = abr * sr - abi * si + bur, ni = abr * si + abi * sr + bui; sr = nr; si = ni;
            XS[tt * 130 + 2 * p] = sr; XS[tt * 130 + 2 * p + 1] = si;
        }
        wave_lds_fence();
        float y[4] = {0.f, 0.f, 0.f, 0.f};
        for (int p2 = 0; p2 < 64; ++p2) {
            const float xr = XS[tt_o * 130 + 2 * p2], xi = XS[tt_o * 130 + 2 * p2 + 1];
#pragma unroll
            for (int k = 0; k < 4; ++k) y[k] += CT[(hq * 4 + k) * 130 + 2 * p2] * xr - CT[(hq * 4 + k) * 130 + 2 * p2 + 1] * xi;
        }
        float4* up = (float4*)(z + (size_t)(b * S + t0 + tt_o) * INW + ZSU + g * 16 + hq * 4);
        const float4 uu = *up;
        float4 o; o.x = gelu_tanh(y[0] + dsk[0] * uu.x); o.y = gelu_tanh(y[1] + dsk[1] * uu.y); o.z = gelu_tanh(y[2] + dsk[2] * uu.z); o.w = gelu_tanh(y[3] + dsk[3] * uu.w);
        *up = o;
        wave_lds_fence();
    }
}

__device__ __forceinline__ void mlstm_block(float* lds, const float* z, float* mix, const Params& P, int l, int u) {
    const int b = u >> 2, head = u & 3, tid = threadIdx.x;
    float* RAW = lds;
    float* QK = RAW + 19 * 128;
    float* V = QK + 16 * 128;
    float* GT = V + 16 * 64;
    const int i = tid >> 3, jg = tid & 7;
    float C[8], n[8];
#pragma unroll
    for (int j = 0; j < 8; ++j) { C[j] = 0.f; n[j] = 0.f; }
    float mstate = 0.f;
    const float* cw = P.in[I_CONVW] + (size_t)l * 4 * 512;
    const float gbi = P.in[I_GATEB][l * 8 + head], gbf = P.in[I_GATEB][l * 8 + 4 + head];
    for (int t0 = 0; t0 < S; t0 += 16) {
        __syncthreads();
        for (int idx = tid; idx < 19 * 128; idx += NTHREADS) { const int tt = idx >> 7, c = idx & 127, tg = t0 - 3 + tt;
            const int col = (c < 64) ? (ZCQ + head * 64 + c) : (ZCK + head * 64 + (c - 64));
            RAW[idx] = (tg >= 0) ? z[(size_t)(b * S + tg) * INW + col] : 0.f; }
        for (int idx = tid; idx < 16 * 64; idx += NTHREADS) { const int tt = idx >> 6, c = idx & 63; V[idx] = z[(size_t)(b * S + t0 + tt) * INW + ZCV + head * 64 + c]; }
        if (tid == 0) {
            float m = mstate;
            for (int tt = 0; tt < 16; ++tt) {
                const float* zr = z + (size_t)(b * S + t0 + tt) * INW;
                const float ipre = zr[ZCI + head] + gbi, fpre = zr[ZCF + head] + gbf;
                const float logf = fminf(fpre, 0.f) - log1pf(expf(-fabsf(fpre)));
                const float mn = fmaxf(logf + m, ipre);
                GT[tt * 4 + 0] = expf(logf + m - mn); GT[tt * 4 + 1] = expf(ipre - mn); GT[tt * 4 + 2] = expf(-mn); m = mn;
            }
            mstate = m;
        }
        __syncthreads();
        for (int idx = tid; idx < 16 * 128; idx += NTHREADS) { const int tt = idx >> 7, c = idx & 127;
            const int cc = (c < 64) ? (head * 64 + c) : (256 + head * 64 + (c - 64));
            float x = 0.f;
#pragma unroll
            for (int j = 0; j < 4; ++j) x += cw[j * 512 + cc] * RAW[(tt + j) * 128 + c];
            float y = x * sigm(x); if (c >= 64) y *= 0.125f;
            QK[idx] = y; }
        __syncthreads();
        for (int tt = 0; tt < 16; ++tt) {
            const float4 q0 = *(const float4*)&QK[tt * 128 + jg * 8], q1 = *(const float4*)&QK[tt * 128 + jg * 8 + 4];
            const float4 k0 = *(const float4*)&QK[tt * 128 + 64 + jg * 8], k1 = *(const float4*)&QK[tt * 128 + 64 + jg * 8 + 4];
            const float v = V[tt * 64 + i], a = GT[tt * 4], bb = GT[tt * 4 + 1], en = GT[tt * 4 + 2];
            const float qq[8] = {q0.x, q0.y, q0.z, q0.w, q1.x, q1.y, q1.z, q1.w}, kk[8] = {k0.x, k0.y, k0.z, k0.w, k1.x, k1.y, k1.z, k1.w};
            float pn = 0.f, pd = 0.f; const float bv = bb * v;
#pragma unroll
            for (int j = 0; j < 8; ++j) { C[j] = a * C[j] + bv * kk[j]; n[j] = a * n[j] + bb * kk[j]; pn += C[j] * qq[j]; pd += n[j] * qq[j]; }
            pn += __shfl_xor(pn, 1); pd += __shfl_xor(pd, 1); pn += __shfl_xor(pn, 2); pd += __shfl_xor(pd, 2); pn += __shfl_xor(pn, 4); pd += __shfl_xor(pd, 4);
            if (jg == 0) mix[(size_t)(b * S + t0 + tt) * D + 512 + head * 64 + i] = pn / fmaxf(fabsf(pd), en);
        }
    }
    __syncthreads();
}

__device__ __forceinline__ void sgu_ln_wave(float* z, const float* lng, const float* lnb, int tok, int lane) {
    float4* p = (float4*)(z + (size_t)tok * INW + ZGV) + lane;
    float4 v = *p; v.x = gelu_tanh(v.x); v.y = gelu_tanh(v.y); v.z = gelu_tanh(v.z); v.w = gelu_tanh(v.w);
    const float mu = wave_sum(v.x + v.y + v.z + v.w) * (1.f / 256.f);
    const float dx = v.x - mu, dy = v.y - mu, dz = v.z - mu, dw = v.w - mu;
    const float var = wave_sum(dx * dx + dy * dy + dz * dz + dw * dw) * (1.f / 256.f);
    const float rs = rsqrtf(var + EPS);
    const float4 g = ((const float4*)lng)[lane], bb = ((const float4*)lnb)[lane];
    *p = make_float4(dx * rs * g.x + bb.x, dy * rs * g.y + bb.y, dz * rs * g.z + bb.z, dw * rs * g.w + bb.w);
}

__device__ __forceinline__ void ph_mix1(float* lds, const Params& P, int l, float* z, float* mix) {
    const int G = gridDim.x, bid = blockIdx.x, wave = threadIdx.x >> 6, lane = threadIdx.x & 63;
    for (int u = bid; u < 32; u += G) mlstm_block(lds, z, mix, P, l, u);
    {
        const int rb = G - 1 - bid;
        for (int u = rb * 8 + wave; u < 128; u += G * 8) s5_wave(lds + wave * (2 * 16 * 130), z, P, l, u, lane);
    }
    const bool split = (G >= 96);
    const int nlight = split ? G - 48 : G, lid = split ? bid - 32 : bid;
    if (lid >= 0 && lid < nlight) {
        const float* sinks = P.in[I_SINK] + l * 4;
        for (int u = lid * 8 + wave; u < 8192; u += nlight * 8) attn_wave(z, sinks, mix, u, lane);
        for (int tok = lid * 8 + wave; tok < NTOK; tok += nlight * 8) sgu_ln_wave(z, P.in[I_LNG] + l * 256, P.in[I_LNB] + l * 256, tok, lane);
    }
}

__device__ __forceinline__ void ph_mix2(float* lds, const Params& P, int l, const float* z, float* mix) {
    const int wave = threadIdx.x >> 6, lane = threadIdx.x & 63, tid = threadIdx.x;
    const float* gw = P.in[I_GLUW] + (size_t)l * 256 * 256; const float* gb = P.in[I_GLUB] + l * 256;
    for (int u = blockIdx.x; u < (NTOK / 128) * 2; u += gridDim.x) {
        const int m0 = (u >> 1) * 128, n0 = (u & 1) * 128;
        gemm_tile<false>(lds, [&](int r) { return z + (size_t)(m0 + r) * INW + ZSU; }, 256, gw, gw, 256, n0, 256,
                         [&](int r, int c, float v, float) { const float y = z[(size_t)(m0 + r) * INW + ZSU + c]; mix[(size_t)(m0 + r) * D + 256 + c] = y * sigm(v + gb[c]); });
    }
    const float* ng = P.in[I_MNG] + l * 256;
    for (int tok = blockIdx.x * 8 + wave; tok < NTOK; tok += gridDim.x * 8) {
        float4* hp = (float4*)(mix + (size_t)tok * D + 512) + lane;
        const float4 h = *hp;
        float ss = h.x * h.x + h.y * h.y + h.z * h.z + h.w * h.w;
        ss += __shfl_xor(ss, 1); ss += __shfl_xor(ss, 2); ss += __shfl_xor(ss, 4); ss += __shfl_xor(ss, 8);
        const float rs = rsqrtf(ss * (1.f / 64.f) + EPS);
        const float4 g = ((const float4*)ng)[lane];
        const float4 co = *((const float4*)(z + (size_t)tok * INW + ZCO) + lane);
        *hp = make_float4(h.x * rs * g.x * sigm(co.x), h.y * rs * g.y * sigm(co.y), h.z * rs * g.z * sigm(co.z), h.w * rs * g.w * sigm(co.w));
    }
    const float* sw = P.in[I_SGUW] + (size_t)l * 4 * 128 * 128; const float* sb = P.in[I_SGUB] + l * 4 * 128;
    for (int u = blockIdx.x; u < NTOK / 128; u += gridDim.x) {
        const int tok0 = u * 128;
        __syncthreads();
        for (int idx = tid; idx < 128 * 64; idx += NTHREADS) { const int s = idx >> 6, c4 = idx & 63;
            *(float4*)&lds[s * 256 + c4 * 4] = *((const float4*)(z + (size_t)(tok0 + s) * INW + ZGV) + c4); }
        __syncthreads();
        const int c = tid & 255, half = tid >> 8, g = c >> 6;
        for (int tt = 0; tt < 64; ++tt) {
            const int t = half * 64 + tt;
            const float* wr = sw + ((size_t)g * 128 + t) * 128;
            float acc = 0.f;
            for (int s = 0; s <= t; ++s) acc += wr[s] * lds[s * 256 + c];
            const float gu = z[(size_t)(tok0 + t) * INW + ZGU + c];
            mix[(size_t)(tok0 + t) * D + 768 + c] = gelu_tanh(gu) * (acc + sb[g * 128 + t]);
        }
    }
    __syncthreads();
}

__device__ __forceinline__ void ph_outproj(float* lds, const float* mix, const float* w, const float* xsrc, float* xout) {
    for (int u = blockIdx.x; u < (NTOK / 128) * 8; u += gridDim.x) {
        const int m0 = (u >> 3) * 128, n0 = (u & 7) * 128;
        gemm_tile<false>(lds, [&](int r) { return mix + (size_t)(m0 + r) * D; }, D, w, w, D, n0, D,
                         [&](int r, int c, float v, float) { const size_t o = (size_t)(m0 + r) * D + c; xout[o] = xsrc[o] + v; });
    }
}

__device__ __forceinline__ void ph_norm_router(const Params& P, int l, const float* x, float* H, unsigned* cnt, int2* lists) {
    const int wave = threadIdx.x >> 6, lane = threadIdx.x & 63;
    const float* gn = P.in[I_NFG] + l * D;
    const float* wg = P.in[I_RGW] + (size_t)l * D * 4; const float* we = P.in[I_REW] + (size_t)l * D * 32;
    const float* bg = P.in[I_RGB] + l * 4; const float* be = P.in[I_REB] + l * 32;
    for (int r = blockIdx.x * 8 + wave; r < NTOK; r += gridDim.x * 8) {
        const float* xr = x + (size_t)r * D; float* hr = H + (size_t)r * D;
        float ss = 0.f;
        { const float4* p = (const float4*)xr;
#pragma unroll
          for (int i = 0; i < 4; ++i) { const float4 v = p[lane + 64 * i]; ss += v.x * v.x + v.y * v.y + v.z * v.z + v.w * v.w; } }
        ss = wave_sum(ss);
        const float rs = rsqrtf(ss * (1.f / D) + EPS);
        float lg[36];
#pragma unroll
        for (int c = 0; c < 36; ++c) lg[c] = 0.f;
#pragma unroll 1
        for (int kk = 0; kk < 16; ++kk) {
            const int k = kk * 64 + lane;
            const float hv = xr[k] * rs * gn[k];
            hr[k] = hv;
            const float4 w4 = *(const float4*)(wg + (size_t)k * 4);
            lg[0] += hv * w4.x; lg[1] += hv * w4.y; lg[2] += hv * w4.z; lg[3] += hv * w4.w;
#pragma unroll
            for (int e4 = 0; e4 < 8; ++e4) { const float4 w = *(const float4*)(we + (size_t)k * 32 + e4 * 4);
                lg[4 + e4 * 4] += hv * w.x; lg[5 + e4 * 4] += hv * w.y; lg[6 + e4 * 4] += hv * w.z; lg[7 + e4 * 4] += hv * w.w; }
        }
#pragma unroll
        for (int c = 0; c < 36; ++c) lg[c] = wave_sum(lg[c]);
        if (lane == 0) {
            float gl[4];
#pragma unroll
            for (int j = 0; j < 4; ++j) gl[j] = lg[j] + bg[j];
            int sel = 0; float gm = gl[0];
#pragma unroll
            for (int j = 1; j < 4; ++j) if (gl[j] > gm) { gm = gl[j]; sel = j; }
            float gs = 0.f;
#pragma unroll
            for (int j = 0; j < 4; ++j) gs += expf(gl[j] - gm);
            const float pg = 1.f / gs;
            float ein[8];
#pragma unroll
            for (int j = 0; j < 8; ++j) { const float a0 = lg[4 + j] + be[j], a1 = lg[12 + j] + be[8 + j], a2 = lg[20 + j] + be[16 + j], a3 = lg[28 + j] + be[24 + j];
                ein[j] = sel == 0 ? a0 : (sel == 1 ? a1 : (sel == 2 ? a2 : a3)); }
            int i1 = 0; float v1 = ein[0];
#pragma unroll
            for (int j = 1; j < 8; ++j) if (ein[j] > v1) { v1 = ein[j]; i1 = j; }
            int i2 = -1; float v2 = -3.0e38f;
#pragma unroll
            for (int j = 0; j < 8; ++j) if (j != i1 && ein[j] > v2) { v2 = ein[j]; i2 = j; }
            const float e2 = expf(v2 - v1), den = 1.f / (1.f + e2);
            const float w1 = den * pg, w2 = e2 * den * pg;
            const int ex1 = sel * 8 + i1, ex2 = sel * 8 + i2;
            const unsigned p1 = atomicAdd(&cnt[ex1], 1u), p2 = atomicAdd(&cnt[ex2], 1u);
            lists[(size_t)ex1 * NTOK + p1] = make_int2(r, __float_as_int(w1));
            lists[(size_t)ex2 * NTOK + p2] = make_int2(r, __float_as_int(w2));
        }
    }
}

struct ExpTile { int e, pos0, T; };
__device__ __forceinline__ bool find_tile(const unsigned* cnt, int T, ExpTile& et) {
    int base = 0;
    for (int e = 0; e < NEXP; ++e) { const int c = (int)cnt[e], nt = (c + 127) >> 7;
        if (T < base + nt) { et.e = e; et.pos0 = (T - base) * 128; et.T = T; return true; }
        base += nt; }
    return false;
}
__device__ __forceinline__ int total_tiles(const unsigned* cnt) { int base = 0; for (int e = 0; e < NEXP; ++e) base += ((int)cnt[e] + 127) >> 7; return base; }

__device__ __forceinline__ void ph_moe1(float* lds, const Params& P, int l, const float* H, const unsigned* cnt, const int2* lists, float* act) {
    const int ntile = total_tiles(cnt);
    for (int u = blockIdx.x; u < ntile * 4; u += gridDim.x) {
        ExpTile et; if (!find_tile(cnt, u >> 2, et)) break;
        const int n0 = (u & 3) * 128; const int c_e = (int)cnt[et.e];
        const int2* lst = lists + (size_t)et.e * NTOK + et.pos0;
        const float* wgt = P.in[I_EWG] + ((size_t)l * NEXP + et.e) * D * DE; const float* wup = P.in[I_EWU] + ((size_t)l * NEXP + et.e) * D * DE;
        gemm_tile<true>(lds, [&](int r) -> const float* { return (et.pos0 + r < c_e) ? H + (size_t)lst[r].x * D : nullptr; }, D, wgt, wup, DE, n0, DE,
                        [&](int r, int c, float g, float uu) { act[(size_t)(et.T * 128 + r) * DE + c] = g * sigm(g) * uu; });
    }
}
__device__ __forceinline__ void ph_moe2(float* lds, const Params& P, int l, const float* act, const unsigned* cnt, const int2* lists, float* x) {
    const int ntile = total_tiles(cnt);
    for (int u = blockIdx.x; u < ntile * 8; u += gridDim.x) {
        ExpTile et; if (!find_tile(cnt, u >> 3, et)) break;
        const int n0 = (u & 7) * 128; const int c_e = (int)cnt[et.e];
        const int2* lst = lists + (size_t)et.e * NTOK + et.pos0;
        const float* wd = P.in[I_EWD] + ((size_t)l * NEXP + et.e) * DE * D;
        gemm_tile<false>(lds, [&](int r) -> const float* { return (et.pos0 + r < c_e) ? act + (size_t)(et.T * 128 + r) * DE : nullptr; }, DE, wd, wd, D, n0, D,
                         [&](int r, int c, float v, float) { if (et.pos0 + r < c_e) { const int2 tw = lst[r]; atomicAdd(&x[(size_t)tw.x * D + c], __int_as_float(tw.y) * v); } });
    }
}

__global__ void __launch_bounds__(NTHREADS, 2) fwd_kernel(Params P) {
    extern __shared__ __attribute__((aligned(16))) unsigned char lds_raw[];
    float* lds = (float*)lds_raw;
    volatile LAS unsigned* xbw = (volatile LAS unsigned*)(lds_raw + LDS_BYTES - 16);
    if (threadIdx.x == 0) { xbw[0] = 0u; xbw[1] = 0u; }
    __syncthreads();
    unsigned* ctl = (unsigned*)(P.ws + WS_CTL);
    const bool multi = (P.ph_hi - P.ph_lo) > 1;
    XcdBarrier bar; bar.bar = ctl; bar.x = 0; bar.st = xbw;
    if (multi) bar = xcd_barrier_post(ctl, xbw);
    float* z = (float*)(P.ws + WS_Z); float* mix = (float*)(P.ws + WS_MIX);
    float* H = (float*)(P.ws + WS_H); float* act = (float*)(P.ws + WS_ACT);
    int2* lists = (int2*)(P.ws + WS_LIST);
    const int lo = P.ph_lo, hi = P.ph_hi;
#define IN(k) (lo <= (k) && (k) < hi)
#define SEAM(k) do { if (IN(k) && IN((k) + 1)) xcd_barrier(bar); } while (0)
    for (int l = 0; l < NLAYER; ++l) {
        const int pb = l * PH_PER_LAYER;
        const float* xsrc = (l == 0) ? P.in[I_X] : P.out;
        unsigned* cnt = ctl + CW_CNT + l * 64;
        if (IN(pb + 0)) { ph_rmsnorm(xsrc, P.in[I_NMG] + l * D, mix); } SEAM(pb + 0);
        if (IN(pb + 1)) { ph_inproj(lds, mix, P.in[I_WIN] + (size_t)l * D * INW, z); } SEAM(pb + 1);
        if (IN(pb + 2)) { ph_mix1(lds, P, l, z, mix); } SEAM(pb + 2);
        if (IN(pb + 3)) { ph_mix2(lds, P, l, z, mix); } SEAM(pb + 3);
        if (IN(pb + 4)) { ph_outproj(lds, mix, P.in[I_WOUT] + (size_t)l * D * D, xsrc, P.out); } SEAM(pb + 4);
        if (IN(pb + 5)) { ph_norm_router(P, l, P.out, H, cnt, lists); } SEAM(pb + 5);
        if (IN(pb + 6)) { ph_moe1(lds, P, l, H, cnt, lists, act); } SEAM(pb + 6);
        if (IN(pb + 7)) { ph_moe2(lds, P, l, act, cnt, lists, P.out); } SEAM(pb + 7);
    }
    if (IN(NLAYER * PH_PER_LAYER)) ph_rmsnorm(P.out, P.in[I_NFIN], P.out);
#undef IN
#undef SEAM
}

#ifndef N_LAUNCH_MODE
#define N_LAUNCH_MODE 1
#endif
extern "C" void kernel_launch(void* const* d_in, const int* in_sizes, int n_in, void* d_out, int out_size, void* d_ws, size_t ws_size, hipStream_t stream) {
    static int grid = 0;
    if (grid == 0) {
        if (n_in != 31 || out_size != NTOK * D || ws_size < WS_END) { fprintf(stderr, "kernel_launch: unexpected shapes n_in %d out %d ws %zu (need %zu)\n", n_in, out_size, ws_size, (size_t)WS_END); grid = -1; return; }
        int dev = 0, cus = 0, per_cu = 0;
        if (hipGetDevice(&dev) != hipSuccess || hipDeviceGetAttribute(&cus, hipDeviceAttributeMultiprocessorCount, dev) != hipSuccess) { grid = -1; return; }
        if (hipFuncSetAttribute((const void*)fwd_kernel, hipFuncAttributeMaxDynamicSharedMemorySize, LDS_BYTES) != hipSuccess) { fprintf(stderr, "kernel_launch: hipFuncSetAttribute failed\n"); grid = -1; return; }
        if (hipOccupancyMaxActiveBlocksPerMultiprocessor(&per_cu, (const void*)fwd_kernel, NTHREADS, LDS_BYTES) != hipSuccess || per_cu < 1) { fprintf(stderr, "kernel_launch: occupancy query says %d\n", per_cu); }
        (void)hipGetLastError();
        grid = cus;
    }
    if (grid < 0) return;
    (void)hipMemsetAsync((char*)d_ws + WS_CTL, 0, CTL_BYTES, stream);
    Params p{};
    for (int i = 0; i < 31; ++i) p.in[i] = (const float*)d_in[i];
    p.out = (float*)d_out; p.ws = (unsigned char*)d_ws;
#if N_LAUNCH_MODE == 1
    p.ph_lo = 0; p.ph_hi = N_PHASES;
    hipLaunchKernelGGL(fwd_kernel, dim3(grid), dim3(NTHREADS), LDS_BYTES, stream, p);
#else
    for (int ph = 0; ph < N_PHASES; ++ph) { p.ph_lo = ph; p.ph_hi = ph + 1; hipLaunchKernelGGL(fwd_kernel, dim3(grid), dim3(NTHREADS), LDS_BYTES, stream, p); }
#endif
}
```

```cpp
#include <hip/hip_runtime.h>
#include <stdint.h>
#include <stdio.h>

#define LAS __attribute__((address_space(3)))

constexpr int D = 1024, NB = 8, S = 8192, NTOK = NB * S, INW = 2312, NLAYER = 2;
constexpr int NEXP = 32, DE = 512;
constexpr float EPS = 1e-6f;
constexpr int ZQ = 0, ZK = 256, ZV = 384, ZSU = 512, ZCQ = 768, ZCK = 1024, ZCV = 1280, ZCI = 1536, ZCF = 1540, ZCO = 1544, ZGU = 1800, ZGV = 2056;
constexpr int NTHREADS = 512;
constexpr int LDS_BYTES = 144 * 1024;
constexpr int TAB_OFF = 128 * 1024;
constexpr int PH_PER_LAYER = 8, N_PHASES = 1 + NLAYER * PH_PER_LAYER + 1;
constexpr int NMAIN = 2304;
typedef unsigned short bf16_t;

constexpr size_t MiB = 1u << 20;
constexpr size_t WS_CTL = 0, CTL_BYTES = 1 * MiB;
constexpr size_t WS_Z = WS_CTL + CTL_BYTES;
constexpr size_t Z_BYTES = (size_t)NTOK * INW * 4;
constexpr size_t WS_H = WS_Z;
constexpr size_t WS_ACT = WS_Z + (size_t)NTOK * D * 2;
constexpr int PMAX = 2 * NTOK + NEXP * 256;
static_assert((size_t)NTOK * D * 2 + (size_t)PMAX * DE * 2 <= Z_BYTES, "alias fits");
constexpr size_t WS_MIX = WS_Z + Z_BYTES;
constexpr size_t WS_HRAW = WS_MIX + (size_t)NTOK * D * 2;
constexpr size_t WS_LIST = WS_HRAW + (size_t)NTOK * 256 * 4;
constexpr size_t WS_WIN = WS_LIST + (size_t)NEXP * NTOK * 8;
constexpr size_t WS_WOUT = WS_WIN + (size_t)NLAYER * NMAIN * D * 2;
constexpr size_t WS_WGU = WS_WOUT + (size_t)NLAYER * D * D * 2;
constexpr size_t WS_WD = WS_WGU + (size_t)NLAYER * NEXP * 1024 * D * 2;
constexpr size_t WS_END = WS_WD + (size_t)NLAYER * NEXP * D * DE * 2;
constexpr int CW_CNT = 8192;

#define XB_TMO      128
#define XB_XCNT(j)  (256  + 64 * (j))
#define XB_XSUB(j)  (1280 + 64 * (j))
#define XB_XGEN(j)  (2304 + 64 * (j))
#define XB_TOP      3328
#define XB_TOPGEN   3392
#define XCD_BAR_WORDS 3456
#define XB_SPIN_CAP (1u << 22)
__device__ __forceinline__ unsigned xb_ld(unsigned* p)              { return __hip_atomic_load(p, __ATOMIC_RELAXED, __HIP_MEMORY_SCOPE_AGENT); }
__device__ __forceinline__ unsigned xb_add(unsigned* p, unsigned v) { return __hip_atomic_fetch_add(p, v, __ATOMIC_RELAXED, __HIP_MEMORY_SCOPE_AGENT); }
__device__ __forceinline__ unsigned xb_xcc_id() { return (unsigned)__builtin_amdgcn_s_getreg((3 << 11) | 20) & 0xFu; }
#define XB_SPIN(cond, bar) do { unsigned _sp = 0; while (cond) { __builtin_amdgcn_s_sleep(1); \
    if ((++_sp & 255u) == 0u) { if (xb_ld(&(bar)[XB_TMO])) break; if (_sp > XB_SPIN_CAP) { atomicAdd(&(bar)[XB_TMO], 1u); break; } } } } while (0)
struct XcdBarrier { unsigned* bar; unsigned x; volatile LAS unsigned* st; };
__device__ __forceinline__ XcdBarrier xcd_barrier_post(unsigned* bar, volatile LAS unsigned* st) {
    XcdBarrier b; b.bar = bar; b.x = xb_xcc_id(); b.st = st;
    if (threadIdx.x == 0) (void)xb_add(&bar[XB_XCNT(b.x)], 1u);
    return b;
}
__device__ __forceinline__ void xcd_barrier_complete(unsigned* bar, unsigned x, unsigned& nloc, unsigned& nx) {
    const unsigned G = gridDim.x * gridDim.y * gridDim.z;
    unsigned sum, cnt, mine, sp = 0u;
    for (;;) {
        sum = 0u; cnt = 0u; mine = 0u;
#pragma unroll
        for (unsigned j = 0; j < 16; ++j) { const unsigned c = xb_ld(&bar[XB_XCNT(j)]); sum += c; cnt += (c > 0u) ? 1u : 0u; mine = (j == x) ? c : mine; }
        if (sum == G) break;
        __builtin_amdgcn_s_sleep(1);
        if ((++sp & 255u) == 0u) { if (xb_ld(&bar[XB_TMO])) break; if (sp > XB_SPIN_CAP) { atomicAdd(&bar[XB_TMO], 1u); break; } }
    }
    nloc = mine > 0u ? mine : 1u; nx = cnt > 0u ? cnt : 1u;
}
__device__ __forceinline__ void xcd_barrier(const XcdBarrier& b) {
    asm volatile("s_waitcnt vmcnt(0)" ::: "memory");
    __syncthreads();
    if (threadIdx.x == 0) {
        unsigned* bar = b.bar;
        __builtin_amdgcn_s_waitcnt(0);
        unsigned nloc = b.st[0], nx = b.st[1];
        if (nloc == 0u) { xcd_barrier_complete(bar, b.x, nloc, nx); b.st[0] = nloc; b.st[1] = nx; }
        const unsigned old = xb_add(&bar[XB_XSUB(b.x)], 1u);
        const unsigned gen = old / nloc;
        if (old + 1u == (gen + 1u) * nloc) {
            __builtin_amdgcn_fence(__ATOMIC_RELEASE, "agent");
            asm volatile("s_waitcnt vmcnt(0)" ::: "memory");
            const unsigned og = xb_add(&bar[XB_TOP], 1u);
            const unsigned tg = og / nx;
            if (og + 1u == (tg + 1u) * nx) xb_add(&bar[XB_TOPGEN], 1u);
            else XB_SPIN(xb_ld(&bar[XB_TOPGEN]) == tg, bar);
            __builtin_amdgcn_fence(__ATOMIC_ACQUIRE, "agent");
            xb_add(&bar[XB_XGEN(b.x)], 1u);
            asm volatile("s_waitcnt vmcnt(0)" ::: "memory");
        } else {
            XB_SPIN(xb_ld(&bar[XB_XGEN(b.x)]) == gen, bar);
            __builtin_amdgcn_fence(__ATOMIC_ACQUIRE, "agent");
            asm volatile("s_waitcnt vmcnt(0)" ::: "memory");
        }
    }
    __syncthreads();
}

__device__ __forceinline__ int tid_opaque() { int t = threadIdx.x; asm volatile("" : "+v"(t)); return t; }
__device__ __forceinline__ float wave_sum(float v) {
#pragma unroll
    for (int o = 32; o > 0; o >>= 1) v += __shfl_xor(v, o);
    return v;
}
__device__ __forceinline__ float gelu_tanh(float x) {
    const float u = 0.7978845608028654f * (x + 0.044715f * x * x * x);
    return 0.5f * x * (1.f + tanhf(u));
}
__device__ __forceinline__ float sigm(float x) { return 1.f / (1.f + expf(-x)); }
__device__ __forceinline__ void wave_lds_fence() {
    __builtin_amdgcn_fence(__ATOMIC_RELEASE, "wavefront"); __builtin_amdgcn_wave_barrier(); __builtin_amdgcn_fence(__ATOMIC_ACQUIRE, "wavefront");
}

struct Params {
    const float* in[31];
    float* out;
    unsigned char* ws;
    int ph_lo, ph_hi;
};
enum { I_X = 0, I_NMG, I_WIN, I_SINK, I_ARE, I_AIM, I_BRE, I_BIM, I_CRE, I_CIM, I_SD, I_LDT, I_GLUW, I_GLUB, I_CONVW, I_GATEB, I_MNG,
       I_LNG, I_LNB, I_SGUW, I_SGUB, I_WOUT, I_NFG, I_RGW, I_RGB, I_REW, I_REB, I_EWG, I_EWU, I_EWD, I_NFIN };

namespace pg8 {
#define PG8_LAS __attribute__((address_space(3)))
typedef short bf16x8 __attribute__((ext_vector_type(8)));
typedef float f32x4 __attribute__((ext_vector_type(4)));
typedef unsigned u32x4 __attribute__((ext_vector_type(4)));
typedef unsigned u32x2 __attribute__((ext_vector_type(2)));
typedef int i32x4 __attribute__((ext_vector_type(4)));
constexpr int BM = 256, BK = 64, HALF = 128, HTB = HALF * BK * 2, STAGE_BYTES = 8 * HTB, NXCD = 8, WGM = 8;
__host__ __device__ __forceinline__ int lds_byte(int r, int c) { const int st = (r >> 4) * 2 + (c >> 5), rr = r & 15, cc = c & 31, ob = rr * 64 + cc * 2; return st * 1024 + (ob ^ (((ob >> 9) & 1) << 5)); }
__host__ __device__ __forceinline__ void stage_rc(int b, int& R, int& C) { const int st = b / 1024, sb = b % 1024, swz = sb ^ (((sb >> 9) & 1) << 5); R = (st >> 1) * 16 + swz / 64; C = (st & 1) * 32 + (swz % 64) / 2; }
__host__ __device__ __forceinline__ int perm32(int rho) { const int n = rho >> 4, i = rho & 15; return 8 * (i >> 2) + 4 * n + (i & 3); }
__device__ __forceinline__ unsigned cvt_pk_bf16(float lo, float hi) { unsigned r; asm volatile("v_cvt_pk_bf16_f32 %0, %1, %2" : "=v"(r) : "v"(lo), "v"(hi)); return r; }

struct Unit { int pm, pn; const char* A; const char* B; int e, pos0, cnt; };

struct StaticOrder {
    int nM, nN, nwg, G, c; const char* A; const char* Bt; size_t atile, btile;
    __device__ void init(int M, int N, int K, int lda, int G_, int c_, const void* A_, const void* Bt_) { nM = M / BM; nN = N / BM; nwg = nM * nN; G = G_; c = c_; A = (const char*)A_; Bt = (const char*)Bt_; atile = (size_t)BM * lda * 2; btile = (size_t)BM * K * 2; }
    __device__ __forceinline__ bool next(int i, Unit& u) const {
        const long L = (long)i * G + c; if (L >= nwg) return false;
        int wgid = (int)L; { const int q = nwg / NXCD, r = nwg % NXCD, xcd = wgid % NXCD, off = wgid / NXCD; wgid = (xcd < r ? xcd * (q + 1) : r * (q + 1) + (xcd - r) * q) + off; }
        const int nig = WGM * nN, gid = wgid / nig, fm = gid * WGM, gsz = (nM - fm) < WGM ? (nM - fm) : WGM;
        u.pm = fm + ((wgid % nig) % gsz); u.pn = (wgid % nig) / gsz; u.A = A + (size_t)u.pm * atile; u.B = Bt + (size_t)u.pn * btile; u.e = 0; u.pos0 = 0; u.cnt = 0; return true;
    }
    __device__ __forceinline__ void aoff(const Unit&, unsigned (&)[2], unsigned (&)[2], const int (&)[2], const int (&)[2]) const {}
};

template <class Epi, class Sched, bool GATHER>
__device__ __forceinline__ void gemm_phase(PG8_LAS unsigned char* lds, const int K, const int lda, const Sched& S, const Epi& E) {
    const int tid = tid_opaque(), wid = __builtin_amdgcn_readfirstlane(tid >> 6), lane = tid & 63, wr = wid >> 2, wc = wid & 3, fr = lane & 15, fq = lane >> 4;
    const int nt = K / BK;
    unsigned vA0[2], vA1[2], vB[2], nA0[2], nA1[2]; int Rs[2], Cs[2];
#pragma unroll
    for (int i = 0; i < 2; ++i) { int R, C; stage_rc(tid * 16 + i * 8192, R, C); const int Rb = Epi::PERM ? ((R & ~31) + perm32(R & 31)) : R;
        Rs[i] = R; Cs[i] = C; vA0[i] = (unsigned)(R * lda + C) * 2u; vA1[i] = vA0[i] + (unsigned)(HALF * lda) * 2u; vB[i] = (unsigned)(Rb * K + C) * 2u; nA0[i] = vA0[i]; nA1[i] = vA1[i]; }
    const size_t kstep = (size_t)(BK * 2);
    const size_t hstep = (size_t)HALF * K * 2;
    const unsigned ldsw = (unsigned)wid * 1024u;
    const int aoff = lds_byte(wr * 64 + fr, fq * 8), boff = lds_byte(wc * 32 + fr, fq * 8);
#define PG8_SA(b, h) (((b) * 2 + (h)) * HTB)
#define PG8_SB(b, h) ((4 + (b) * 2 + (h)) * HTB)
#define PG8_STAGE(bufoff, gbase, voff) do { _Pragma("unroll") for (int _i = 0; _i < 2; ++_i) \
        __builtin_amdgcn_global_load_lds((const unsigned*)((const char*)(gbase) + (voff)[_i]), (PG8_LAS unsigned*)(lds + (bufoff) + ldsw + _i * 8192), 16, 0, 0); } while (0)
#define PG8_LDA(dst, b, h) do { _Pragma("unroll") for (int m = 0; m < 4; ++m) _Pragma("unroll") for (int k = 0; k < 2; ++k) dst[m][k] = *(const PG8_LAS bf16x8*)(lds + PG8_SA(b, h) + aoff + m * 2048 + k * 1024); } while (0)
#define PG8_LDB(dst, b, h) do { _Pragma("unroll") for (int n = 0; n < 2; ++n) _Pragma("unroll") for (int k = 0; k < 2; ++k) dst[n][k] = *(const PG8_LAS bf16x8*)(lds + PG8_SB(b, h) + boff + n * 2048 + k * 1024); } while (0)
#define PG8_MMA(ai, bj, At, Bt) do { __builtin_amdgcn_s_setprio(1); _Pragma("unroll") for (int m = 0; m < 4; ++m) _Pragma("unroll") for (int n = 0; n < 2; ++n) _Pragma("unroll") for (int k = 0; k < 2; ++k) \
        acc[ai][bj][m][n] = __builtin_amdgcn_mfma_f32_16x16x32_bf16(Bt[n][k], At[m][k], acc[ai][bj][m][n], 0, 0, 0); __builtin_amdgcn_s_setprio(0); } while (0)
#define PG8_WAIT_V(n) asm volatile("s_waitcnt vmcnt(" #n ")" ::: "memory")
#define PG8_WAIT_L(n) asm volatile("s_waitcnt lgkmcnt(" #n ")" ::: "memory")
#define PG8_BAR __builtin_amdgcn_s_barrier()
#define PG8_SCHED __builtin_amdgcn_sched_barrier(0)
    Unit cur, nxt; int ui = 0;
    if (!S.next(0, cur)) return;
    if constexpr (GATHER) { S.aoff(cur, vA0, vA1, Rs, Cs); PG8_WAIT_V(0); }
    f32x4 acc[2][2][4][2];
#pragma unroll
    for (int a = 0; a < 2; ++a)
#pragma unroll
        for (int b = 0; b < 2; ++b)
#pragma unroll
            for (int m = 0; m < 4; ++m)
#pragma unroll
                for (int n = 0; n < 2; ++n) acc[a][b][m][n] = (f32x4){0.f, 0.f, 0.f, 0.f};
    bf16x8 At[4][2], B0[2][2], B1[2][2];
    const char* cA = cur.A; const char* cB = cur.B;
    PG8_STAGE(PG8_SB(0, 0), cB, vB); PG8_STAGE(PG8_SB(0, 1), cB + hstep, vB); PG8_STAGE(PG8_SA(0, 0), cA, vA0); PG8_STAGE(PG8_SA(0, 1), cA, vA1);
    if (wr == 1) PG8_BAR;
    PG8_WAIT_V(2); PG8_BAR;
    PG8_STAGE(PG8_SB(1, 0), cB + kstep, vB); PG8_STAGE(PG8_SA(1, 0), cA + kstep, vA0); PG8_STAGE(PG8_SB(1, 1), cB + hstep + kstep, vB);
    PG8_WAIT_V(6); PG8_BAR;
    for (;;) {
        const bool has_next = S.next(ui + 1, nxt);
        const char* nA = has_next ? nxt.A : cA; const char* nB = has_next ? nxt.B : cB;
        if constexpr (GATHER) {
            if (has_next) { S.aoff(nxt, nA0, nA1, Rs, Cs); }
            else {
#pragma unroll
                for (int i = 0; i < 2; ++i) { nA0[i] = vA0[i]; nA1[i] = vA1[i]; } }
        }
        for (int t = 0; t < nt; t += 2) {
            const bool last = (t == nt - 2);
            const char* a1 = cA + (size_t)(t + 1) * kstep;
            const char* a2 = last ? nA : cA + (size_t)(t + 2) * kstep; const char* b2 = last ? nB : cB + (size_t)(t + 2) * kstep;
            const char* a3 = a2 + kstep; const char* b3 = b2 + kstep;
            unsigned x0[2], x1[2];
#pragma unroll
            for (int i = 0; i < 2; ++i) { x0[i] = (GATHER && last) ? nA0[i] : vA0[i]; x1[i] = (GATHER && last) ? nA1[i] : vA1[i]; }
            PG8_LDB(B0, 0, 0); PG8_LDB(B1, 0, 1); PG8_SCHED; PG8_LDA(At, 0, 0); PG8_STAGE(PG8_SA(1, 1), a1, vA1);
            PG8_WAIT_V(8); PG8_WAIT_L(0); PG8_BAR; PG8_MMA(0, 0, At, B0); PG8_MMA(0, 1, At, B1); PG8_BAR; PG8_SCHED;
            PG8_LDA(At, 0, 1); PG8_STAGE(PG8_SB(0, 0), b2, vB); PG8_STAGE(PG8_SB(0, 1), b2 + hstep, vB); PG8_STAGE(PG8_SA(0, 0), a2, x0);
            PG8_WAIT_V(8); PG8_WAIT_L(0); PG8_BAR; PG8_MMA(1, 0, At, B0); PG8_MMA(1, 1, At, B1); PG8_BAR; PG8_SCHED;
            PG8_LDB(B0, 1, 0); PG8_LDB(B1, 1, 1); PG8_SCHED; PG8_LDA(At, 1, 0); PG8_STAGE(PG8_SA(0, 1), a2, x1);
            PG8_WAIT_V(8); PG8_WAIT_L(0); PG8_BAR; PG8_MMA(0, 0, At, B0); PG8_MMA(0, 1, At, B1); PG8_BAR; PG8_SCHED;
            PG8_LDA(At, 1, 1); PG8_STAGE(PG8_SB(1, 0), b3, vB); PG8_STAGE(PG8_SB(1, 1), b3 + hstep, vB); PG8_STAGE(PG8_SA(1, 0), a3, x0);
            PG8_WAIT_V(8); PG8_WAIT_L(0); PG8_BAR; PG8_MMA(1, 0, At, B0); PG8_MMA(1, 1, At, B1); PG8_BAR; PG8_SCHED;
        }
        if (wr == 0) PG8_BAR;
        E(acc, cur, wr, wc, fr, fq);
        if (!has_next) break;
#pragma unroll
        for (int a = 0; a < 2; ++a)
#pragma unroll
            for (int b = 0; b < 2; ++b)
#pragma unroll
                for (int m = 0; m < 4; ++m)
#pragma unroll
                    for (int n = 0; n < 2; ++n) acc[a][b][m][n] = (f32x4){0.f, 0.f, 0.f, 0.f};
        cur = nxt; cA = nA; cB = nB; ++ui;
        if constexpr (GATHER) {
#pragma unroll
            for (int i = 0; i < 2; ++i) { vA0[i] = nA0[i]; vA1[i] = nA1[i]; } }
        if (wr == 1) PG8_BAR;
    }
    PG8_WAIT_V(0);
    PG8_BAR;
#undef PG8_SA
#undef PG8_SB
#undef PG8_STAGE
#undef PG8_LDA
#undef PG8_LDB
#undef PG8_MMA
#undef PG8_WAIT_V
#undef PG8_WAIT_L
#undef PG8_BAR
#undef PG8_SCHED
}

struct EpiZ {
    static constexpr bool PERM = false;
    float* Z;
    __device__ __forceinline__ void operator()(const f32x4 (&acc)[2][2][4][2], const Unit& u, int wr, int wc, int fr, int fq) const {
        const int row0 = u.pm * BM + wr * 64 + fr, col0 = u.pn * BM + (u.pn >= 6 ? 8 : 0) + wc * 32 + 4 * fq;
#pragma unroll
        for (int ai = 0; ai < 2; ++ai)
#pragma unroll
            for (int m = 0; m < 4; ++m) { float* rowp = Z + (size_t)(row0 + ai * HALF + m * 16) * INW + col0;
#pragma unroll
                for (int bj = 0; bj < 2; ++bj)
#pragma unroll
                    for (int n = 0; n < 2; ++n) *(f32x4*)(rowp + bj * HALF + n * 16) = acc[ai][bj][m][n]; }
    }
};
struct EpiRes {
    static constexpr bool PERM = false;
    const float* X; float* O;
    __device__ __forceinline__ void operator()(const f32x4 (&acc)[2][2][4][2], const Unit& u, int wr, int wc, int fr, int fq) const {
        const int row0 = u.pm * BM + wr * 64 + fr, col0 = u.pn * BM + wc * 32 + 4 * fq;
#pragma unroll
        for (int ai = 0; ai < 2; ++ai)
#pragma unroll
            for (int m = 0; m < 4; ++m) { const size_t off = (size_t)(row0 + ai * HALF + m * 16) * D + col0;
#pragma unroll
                for (int bj = 0; bj < 2; ++bj)
#pragma unroll
                    for (int n = 0; n < 2; ++n) { const f32x4 xs = *(const f32x4*)(X + off + bj * HALF + n * 16); *(f32x4*)(O + off + bj * HALF + n * 16) = xs + acc[ai][bj][m][n]; }
                asm volatile("" ::: "memory"); }
    }
};
struct EpiAct {
    static constexpr bool PERM = true;
    bf16_t* ACT;
    __device__ __forceinline__ void operator()(const f32x4 (&acc)[2][2][4][2], const Unit& u, int wr, int wc, int fr, int fq) const {
        const int row0 = u.pm * BM + wr * 64 + fr, col0 = u.pn * HALF + wc * 32 + 8 * fq;
#pragma unroll
        for (int ai = 0; ai < 2; ++ai)
#pragma unroll
            for (int m = 0; m < 4; ++m) { bf16_t* rowp = ACT + (size_t)(row0 + ai * HALF + m * 16) * DE + col0;
                float o[8];
#pragma unroll
                for (int n = 0; n < 2; ++n)
#pragma unroll
                    for (int j = 0; j < 4; ++j) { const float g = acc[ai][0][m][n][j], up = acc[ai][1][m][n][j]; o[n * 4 + j] = g * up * __builtin_amdgcn_rcpf(1.f + __expf(-g)); }
                u32x4 w; w.x = cvt_pk_bf16(o[0], o[1]); w.y = cvt_pk_bf16(o[2], o[3]); w.z = cvt_pk_bf16(o[4], o[5]); w.w = cvt_pk_bf16(o[6], o[7]);
                *(u32x4*)rowp = w; }
    }
};
struct EpiDown {
    static constexpr bool PERM = false;
    float* X; const int2* lists;
    __device__ __forceinline__ void operator()(const f32x4 (&acc)[2][2][4][2], const Unit& u, int wr, int wc, int fr, int fq) const {
        const int col0 = u.pn * BM + wc * 32 + 4 * fq; const int2* lst = lists + (size_t)u.e * NTOK + u.pos0;
#pragma unroll
        for (int ai = 0; ai < 2; ++ai)
#pragma unroll
            for (int m = 0; m < 4; ++m) { const int r = ai * HALF + wr * 64 + m * 16 + fr;
                if (u.pos0 + r < u.cnt) { const int2 tw = lst[r]; const float w = __int_as_float(tw.y); float* rowp = X + (size_t)tw.x * D + col0;
#pragma unroll
                    for (int bj = 0; bj < 2; ++bj)
#pragma unroll
                        for (int n = 0; n < 2; ++n)
#pragma unroll
                            for (int j = 0; j < 4; ++j) unsafeAtomicAdd(rowp + bj * HALF + n * 16 + j, w * acc[ai][bj][m][n][j]); } }
    }
};
struct MoeOrder {
    const PG8_LAS i32x4* tab; int ntiles, npn, G, c; const char* A; size_t atile; const char* Bt; size_t bexp, btile; const int2* lists;
    __device__ __forceinline__ bool next(int i, Unit& u) const {
        const int L = i * G + c; const int T = L / npn; if (T >= ntiles) return false;
        const i32x4 te = tab[T]; u.pm = T; u.pn = L - T * npn; u.e = __builtin_amdgcn_readfirstlane(te.x); u.pos0 = __builtin_amdgcn_readfirstlane(te.y); u.cnt = __builtin_amdgcn_readfirstlane(te.z);
        u.A = A + (size_t)T * atile; u.B = Bt + (size_t)u.e * bexp + (size_t)u.pn * btile; return true;
    }
    __device__ __forceinline__ void aoff(const Unit& u, unsigned (&o0)[2], unsigned (&o1)[2], const int (&Rs)[2], const int (&Cs)[2]) const {
        const int2* lst = lists + (size_t)u.e * NTOK;
#pragma unroll
        for (int i = 0; i < 2; ++i) { const int p0 = u.pos0 + Rs[i], p1 = p0 + HALF;
            const int t0 = (p0 < u.cnt) ? lst[p0].x : 0, t1 = (p1 < u.cnt) ? lst[p1].x : 0;
            o0[i] = (unsigned)t0 * (unsigned)(D * 2) + (unsigned)Cs[i] * 2u; o1[i] = (unsigned)t1 * (unsigned)(D * 2) + (unsigned)Cs[i] * 2u; }
    }
};
}

__device__ __forceinline__ void ph_rmsnorm(const float* src, const float* g, float* dst) {
    const int wave = tid_opaque() >> 6, lane = tid_opaque() & 63;
    const float4* g4 = (const float4*)g;
    for (int r = blockIdx.x * 8 + wave; r < NTOK; r += gridDim.x * 8) {
        const float4* p = (const float4*)(src + (size_t)r * D);
        float4 v[4]; float ss = 0.f;
#pragma unroll
        for (int i = 0; i < 4; ++i) { v[i] = p[lane + 64 * i]; ss += v[i].x * v[i].x + v[i].y * v[i].y + v[i].z * v[i].z + v[i].w * v[i].w; }
        ss = wave_sum(ss);
        const float rs = rsqrtf(ss * (1.f / D) + EPS);
        float4* q = (float4*)(dst + (size_t)r * D);
#pragma unroll
        for (int i = 0; i < 4; ++i) { const float4 gg = g4[lane + 64 * i]; float4 o; o.x = v[i].x * rs * gg.x; o.y = v[i].y * rs * gg.y; o.z = v[i].z * rs * gg.z; o.w = v[i].w * rs * gg.w; q[lane + 64 * i] = o; }
    }
}
__device__ __forceinline__ void ph_norm1(const float* src, const float* g, const float* win, bf16_t* xn, float* z) {
    const int wave = tid_opaque() >> 6, lane = tid_opaque() & 63;
    const float4* g4 = (const float4*)g;
    for (int r = blockIdx.x * 8 + wave; r < NTOK; r += gridDim.x * 8) {
        const float4* p = (const float4*)(src + (size_t)r * D);
        float4 v[4]; float ss = 0.f;
#pragma unroll
        for (int i = 0; i < 4; ++i) { v[i] = p[lane + 64 * i]; ss += v[i].x * v[i].x + v[i].y * v[i].y + v[i].z * v[i].z + v[i].w * v[i].w; }
        ss = wave_sum(ss);
        const float rs = rsqrtf(ss * (1.f / D) + EPS);
        float gt[8];
#pragma unroll
        for (int c = 0; c < 8; ++c) gt[c] = 0.f;
        pg8::u32x2* q = (pg8::u32x2*)(xn + (size_t)r * D);
#pragma unroll
        for (int i = 0; i < 4; ++i) { const float4 gg = g4[lane + 64 * i]; const float o[4] = {v[i].x * rs * gg.x, v[i].y * rs * gg.y, v[i].z * rs * gg.z, v[i].w * rs * gg.w};
            pg8::u32x2 w; w.x = pg8::cvt_pk_bf16(o[0], o[1]); w.y = pg8::cvt_pk_bf16(o[2], o[3]); q[lane + 64 * i] = w;
#pragma unroll
            for (int j = 0; j < 4; ++j) { const float* wr = win + (size_t)((lane + 64 * i) * 4 + j) * INW + ZCI; const float4 w0 = *(const float4*)wr, w1 = *(const float4*)(wr + 4);
                gt[0] += o[j] * w0.x; gt[1] += o[j] * w0.y; gt[2] += o[j] * w0.z; gt[3] += o[j] * w0.w; gt[4] += o[j] * w1.x; gt[5] += o[j] * w1.y; gt[6] += o[j] * w1.z; gt[7] += o[j] * w1.w; } }
#pragma unroll
        for (int c = 0; c < 8; ++c) gt[c] = wave_sum(gt[c]);
        if (lane == 0) { float4* zp = (float4*)(z + (size_t)r * INW + ZCI); zp[0] = make_float4(gt[0], gt[1], gt[2], gt[3]); zp[1] = make_float4(gt[4], gt[5], gt[6], gt[7]); }
    }
}
__device__ __forceinline__ void tc_tile(float* T  , const float* src, int src_ld, int c0, int k0, bf16_t* dst, int K, int n0) {
    const int tid = tid_opaque();
    __syncthreads();
#pragma unroll
    for (int i = 0; i < 2; ++i) { const int kk = (tid >> 4) + 32 * i, c4 = (tid & 15) * 4;
        const float4 v = *(const float4*)(src + (size_t)(k0 + kk) * src_ld + c0 + c4);
        T[kk * 65 + c4] = v.x; T[kk * 65 + c4 + 1] = v.y; T[kk * 65 + c4 + 2] = v.z; T[kk * 65 + c4 + 3] = v.w; }
    __syncthreads();
    const int nl = tid >> 3, kc = (tid & 7) * 8;
    pg8::u32x4 w;
    w.x = pg8::cvt_pk_bf16(T[(kc + 0) * 65 + nl], T[(kc + 1) * 65 + nl]); w.y = pg8::cvt_pk_bf16(T[(kc + 2) * 65 + nl], T[(kc + 3) * 65 + nl]);
    w.z = pg8::cvt_pk_bf16(T[(kc + 4) * 65 + nl], T[(kc + 5) * 65 + nl]); w.w = pg8::cvt_pk_bf16(T[(kc + 6) * 65 + nl], T[(kc + 7) * 65 + nl]);
    *(pg8::u32x4*)(dst + (size_t)(n0 + nl) * K + k0 + kc) = w;
}
__device__ __forceinline__ void ph_prologue(float* lds, const Params& P) {
    constexpr int NJ_EXP = NLAYER * NEXP * 384, NJ_IN = NLAYER * 576, NJ_OUT = NLAYER * 256;
    bf16_t* WIN = (bf16_t*)(P.ws + WS_WIN); bf16_t* WOUT = (bf16_t*)(P.ws + WS_WOUT); bf16_t* WGU = (bf16_t*)(P.ws + WS_WGU); bf16_t* WD = (bf16_t*)(P.ws + WS_WD);
    for (int j = blockIdx.x; j < NJ_EXP + NJ_IN + NJ_OUT; j += gridDim.x) {
        if (j < NJ_EXP) {
            const int le = j / 384, r = j % 384;
            if (r < 256) { const int n0 = (r >> 4) * 64, k0 = (r & 15) * 64, pn = n0 >> 8, within = n0 & 255;
                const float* s = (within < 128 ? P.in[I_EWG] : P.in[I_EWU]) + (size_t)le * D * DE;
                tc_tile(lds, s, DE, pn * 128 + (within & 127), k0, WGU + (size_t)le * 1024 * D, D, n0);
            } else { const int r2 = r - 256, n0 = (r2 >> 3) * 64, k0 = (r2 & 7) * 64;
                tc_tile(lds, P.in[I_EWD] + (size_t)le * DE * D, D, n0, k0, WD + (size_t)le * D * DE, DE, n0); }
        } else if (j < NJ_EXP + NJ_IN) {
            const int j2 = j - NJ_EXP, l = j2 / 576, r = j2 % 576, n0 = (r >> 4) * 64, k0 = (r & 15) * 64;
            tc_tile(lds, P.in[I_WIN] + (size_t)l * D * INW, INW, n0 < ZCI ? n0 : n0 + 8, k0, WIN + (size_t)l * NMAIN * D, D, n0);
        } else {
            const int j3 = j - NJ_EXP - NJ_IN, l = j3 / 256, r = j3 % 256, n0 = (r >> 4) * 64, k0 = (r & 15) * 64;
            tc_tile(lds, P.in[I_WOUT] + (size_t)l * D * D, D, n0, k0, WOUT + (size_t)l * D * D, D, n0);
        }
    }
    __syncthreads();
}

template <bool DUAL, class AF, class EF>
__device__ __forceinline__ void gemm_tile(float* lds, AF arow, int K, const float* B0, const float* B1, int ldb, int n0, int N, EF epi) {
    float* As = lds;
    float* Bs0 = lds + 32 * 132;
    float* Bs1 = Bs0 + 32 * 128;
    const int tid = tid_opaque(), ty = tid >> 4, tx = tid & 15;
    float acc0[4][8], acc1[4][8];
#pragma unroll
    for (int i = 0; i < 4; ++i)
#pragma unroll
        for (int j = 0; j < 8; ++j) { acc0[i][j] = 0.f; acc1[i][j] = 0.f; }
    const float* ap0 = arow((tid >> 3));
    const float* ap1 = arow((tid >> 3) + 64);
    const int akk = (tid & 7) * 4;
    const int bn = n0 + (tid & 31) * 4; const bool bok = bn < N;
    for (int k0 = 0; k0 < K; k0 += 32) {
        const float4 av0 = ap0 ? *(const float4*)(ap0 + k0 + akk) : make_float4(0.f, 0.f, 0.f, 0.f);
        const float4 av1 = ap1 ? *(const float4*)(ap1 + k0 + akk) : make_float4(0.f, 0.f, 0.f, 0.f);
        const int kb0 = k0 + (tid >> 5), kb1 = kb0 + 16;
        const float4 bv00 = bok ? *(const float4*)(B0 + (size_t)kb0 * ldb + bn) : make_float4(0.f, 0.f, 0.f, 0.f);
        const float4 bv01 = bok ? *(const float4*)(B0 + (size_t)kb1 * ldb + bn) : make_float4(0.f, 0.f, 0.f, 0.f);
        const float4 bv10 = (DUAL && bok) ? *(const float4*)(B1 + (size_t)kb0 * ldb + bn) : bv00;
        const float4 bv11 = (DUAL && bok) ? *(const float4*)(B1 + (size_t)kb1 * ldb + bn) : bv01;
        __syncthreads();
        { const int r = (tid >> 3);
          As[(akk + 0) * 132 + r] = av0.x; As[(akk + 1) * 132 + r] = av0.y; As[(akk + 2) * 132 + r] = av0.z; As[(akk + 3) * 132 + r] = av0.w;
          As[(akk + 0) * 132 + r + 64] = av1.x; As[(akk + 1) * 132 + r + 64] = av1.y; As[(akk + 2) * 132 + r + 64] = av1.z; As[(akk + 3) * 132 + r + 64] = av1.w; }
        { const int k = (tid >> 5);
          *(float4*)&Bs0[k * 128 + (tid & 31) * 4] = bv00; *(float4*)&Bs0[(k + 16) * 128 + (tid & 31) * 4] = bv01;
          if (DUAL) { *(float4*)&Bs1[k * 128 + (tid & 31) * 4] = bv10; *(float4*)&Bs1[(k + 16) * 128 + (tid & 31) * 4] = bv11; } }
        __syncthreads();
#pragma unroll 4
        for (int k = 0; k < 32; ++k) {
            const float4 a = *(const float4*)&As[k * 132 + ty * 4];
            const float4 b0 = *(const float4*)&Bs0[k * 128 + tx * 4], b1 = *(const float4*)&Bs0[k * 128 + 64 + tx * 4];
            const float aa[4] = {a.x, a.y, a.z, a.w};
            const float bb[8] = {b0.x, b0.y, b0.z, b0.w, b1.x, b1.y, b1.z, b1.w};
#pragma unroll
            for (int i = 0; i < 4; ++i)
#pragma unroll
                for (int j = 0; j < 8; ++j) acc0[i][j] = fmaf(aa[i], bb[j], acc0[i][j]);
            if (DUAL) {
                const float4 c0 = *(const float4*)&Bs1[k * 128 + tx * 4], c1 = *(const float4*)&Bs1[k * 128 + 64 + tx * 4];
                const float cc[8] = {c0.x, c0.y, c0.z, c0.w, c1.x, c1.y, c1.z, c1.w};
#pragma unroll
                for (int i = 0; i < 4; ++i)
#pragma unroll
                    for (int j = 0; j < 8; ++j) acc1[i][j] = fmaf(aa[i], cc[j], acc1[i][j]);
            }
        }
    }
#pragma unroll
    for (int i = 0; i < 4; ++i)
#pragma unroll
        for (int j = 0; j < 8; ++j) {
            const int r = ty * 4 + i, c = n0 + (j < 4 ? tx * 4 + j : 64 + tx * 4 + (j - 4));
            if (c < N) epi(r, c, acc0[i][j], acc1[i][j]);
        }
    __syncthreads();
}

__device__ __forceinline__ void ph_inproj(LAS unsigned char* ldsb, const bf16_t* xn, const bf16_t* wt, float* z) {
    pg8::StaticOrder S; S.init(NTOK, NMAIN, D, D, gridDim.x, blockIdx.x, xn, wt);
    pg8::EpiZ E{z};
    pg8::gemm_phase<pg8::EpiZ, pg8::StaticOrder, false>(ldsb, D, D, S, E);
}

__device__ __forceinline__ void attn_wave(const float* z, const float* sinks, bf16_t* mix, int u, int lane) {
    const int b = u >> 10, hq = (u >> 8) & 3, t0 = (u & 255) * 32, t = t0 + (lane >> 1), g = hq >> 1, dh = (lane & 1) * 32;
    float q[32];
    { const float4* qp = (const float4*)(z + (size_t)(b * S + t) * INW + ZQ + hq * 64 + dh);
#pragma unroll
      for (int i = 0; i < 8; ++i) { const float4 v = qp[i]; q[4 * i] = v.x * 0.125f; q[4 * i + 1] = v.y * 0.125f; q[4 * i + 2] = v.z * 0.125f; q[4 * i + 3] = v.w * 0.125f; } }
    float m = sinks[hq], l = 1.f; float o[32];
#pragma unroll
    for (int d = 0; d < 32; ++d) o[d] = 0.f;
    const int jlo = (t0 - 127) > 0 ? (t0 - 127) : 0, jhi = t0 + 31;
    for (int j = jlo; j <= jhi; ++j) {
        const float4* kp = (const float4*)(z + (size_t)(b * S + j) * INW + ZK + g * 64 + dh);
        const float4* vp = (const float4*)(z + (size_t)(b * S + j) * INW + ZV + g * 64 + dh);
        float s = 0.f;
#pragma unroll
        for (int i = 0; i < 8; ++i) { const float4 kv = kp[i]; s += q[4 * i] * kv.x + q[4 * i + 1] * kv.y + q[4 * i + 2] * kv.z + q[4 * i + 3] * kv.w; }
        s += __shfl_xor(s, 1);
        const bool valid = (j <= t) && (j > t - 128);
        const float mn = valid ? fmaxf(m, s) : m;
        const float corr = expf(m - mn), p = valid ? expf(s - mn) : 0.f;
        l = l * corr + p; m = mn;
#pragma unroll
        for (int i = 0; i < 8; ++i) { const float4 vv = vp[i];
            o[4 * i] = o[4 * i] * corr + p * vv.x; o[4 * i + 1] = o[4 * i + 1] * corr + p * vv.y; o[4 * i + 2] = o[4 * i + 2] * corr + p * vv.z; o[4 * i + 3] = o[4 * i + 3] * corr + p * vv.w; }
    }
    const float inv = 1.f / l;
    pg8::u32x4* op = (pg8::u32x4*)(mix + (size_t)(b * S + t) * D + hq * 64 + dh);
#pragma unroll
    for (int i = 0; i < 4; ++i) { pg8::u32x4 w; w.x = pg8::cvt_pk_bf16(o[8 * i] * inv, o[8 * i + 1] * inv); w.y = pg8::cvt_pk_bf16(o[8 * i + 2] * inv, o[8 * i + 3] * inv);
        w.z = pg8::cvt_pk_bf16(o[8 * i + 4] * inv, o[8 * i + 5] * inv); w.w = pg8::cvt_pk_bf16(o[8 * i + 6] * inv, o[8 * i + 7] * inv); op[i] = w; }
}

__device__ __forceinline__ void s5_wave(float* wl  , float* z, const Params& P, int l, int u, int lane) {
    const int b = u >> 4, g = u & 15, p = lane;
    float* XS = wl;
    float* CT = wl + 16 * 130;
    const int gp = (l * 16 + g) * 64 + p;
    const float ar = P.in[I_ARE][gp], ai = P.in[I_AIM][gp], dt = expf(P.in[I_LDT][l * 16 + g]);
    const float er = expf(ar * dt); const float abr = er * cosf(ai * dt), abi = er * sinf(ai * dt);
    const float xr_ = abr - 1.f, xi_ = abi, den = ar * ar + ai * ai;
    const float cr = (xr_ * ar + xi_ * ai) / den, ci = (xi_ * ar - xr_ * ai) / den;
    float bbr[16], bbi[16];
#pragma unroll
    for (int h = 0; h < 16; ++h) { const float br = P.in[I_BRE][(size_t)gp * 16 + h], bi = P.in[I_BIM][(size_t)gp * 16 + h]; bbr[h] = cr * br - ci * bi; bbi[h] = cr * bi + ci * br; }
#pragma unroll
    for (int h = 0; h < 16; ++h) { const int ci_ = ((l * 16 + g) * 16 + h) * 64 + p; CT[h * 130 + 2 * p] = P.in[I_CRE][ci_]; CT[h * 130 + 2 * p + 1] = P.in[I_CIM][ci_]; }
    const int tt_o = lane >> 2, hq = lane & 3;
    float dsk[4];
#pragma unroll
    for (int k = 0; k < 4; ++k) dsk[k] = P.in[I_SD][l * 256 + g * 16 + hq * 4 + k];
    float sr = 0.f, si = 0.f;
    wave_lds_fence();
    for (int t0 = 0; t0 < S; t0 += 16) {
#pragma unroll 4
        for (int tt = 0; tt < 16; ++tt) {
            const float4* up = (const float4*)(z + (size_t)(b * S + t0 + tt) * INW + ZSU + g * 16);
            float bur = 0.f, bui = 0.f;
#pragma unroll
            for (int i = 0; i < 4; ++i) { const float4 uu = up[i];
                bur += bbr[4 * i] * uu.x + bbr[4 * i + 1] * uu.y + bbr[4 * i + 2] * uu.z + bbr[4 * i + 3] * uu.w;
                bui += bbi[4 * i] * uu.x + bbi[4 * i + 1] * uu.y + bbi[4 * i + 2] * uu.z + bbi[4 * i + 3] * uu.w; }
            const float nr = abr * sr - abi * si + bur, ni = abr * si + abi * sr + bui; sr = nr; si = ni;
            XS[tt * 130 + 2 * p] = sr; XS[tt * 130 + 2 * p + 1] = si;
        }
        wave_lds_fence();
        float y[4] = {0.f, 0.f, 0.f, 0.f};
        for (int p2 = 0; p2 < 64; ++p2) {
            const float xr = XS[tt_o * 130 + 2 * p2], xi = XS[tt_o * 130 + 2 * p2 + 1];
#pragma unroll
            for (int k = 0; k < 4; ++k) y[k] += CT[(hq * 4 + k) * 130 + 2 * p2] * xr - CT[(hq * 4 + k) * 130 + 2 * p2 + 1] * xi;
        }
        float4* up = (float4*)(z + (size_t)(b * S + t0 + tt_o) * INW + ZSU + g * 16 + hq * 4);
        const float4 uu = *up;
        float4 o; o.x = gelu_tanh(y[0] + dsk[0] * uu.x); o.y = gelu_tanh(y[1] + dsk[1] * uu.y); o.z = gelu_tanh(y[2] + dsk[2] * uu.z); o.w = gelu_tanh(y[3] + dsk[3] * uu.w);
        *up = o;
        wave_lds_fence();
    }
}

__device__ __forceinline__ void mlstm_block(float* lds, const float* z, float* hraw, const Params& P, int l, int u) {
    const int b = u >> 2, head = u & 3, tid = tid_opaque();
    float* RAW = lds;
    float* QK = RAW + 19 * 128;
    float* V = QK + 16 * 128;
    float* GT = V + 16 * 64;
    const int i = tid >> 3, jg = tid & 7;
    float C[8], n[8];
#pragma unroll
    for (int j = 0; j < 8; ++j) { C[j] = 0.f; n[j] = 0.f; }
    float mstate = 0.f;
    const float* cw = P.in[I_CONVW] + (size_t)l * 4 * 512;
    const float gbi = P.in[I_GATEB][l * 8 + head], gbf = P.in[I_GATEB][l * 8 + 4 + head];
    for (int t0 = 0; t0 < S; t0 += 16) {
        __syncthreads();
        for (int idx = tid; idx < 19 * 128; idx += NTHREADS) { const int tt = idx >> 7, c = idx & 127, tg = t0 - 3 + tt;
            const int col = (c < 64) ? (ZCQ + head * 64 + c) : (ZCK + head * 64 + (c - 64));
            RAW[idx] = (tg >= 0) ? z[(size_t)(b * S + tg) * INW + col] : 0.f; }
        for (int idx = tid; idx < 16 * 64; idx += NTHREADS) { const int tt = idx >> 6, c = idx & 63; V[idx] = z[(size_t)(b * S + t0 + tt) * INW + ZCV + head * 64 + c]; }
        if (tid == 0) {
            float m = mstate;
            for (int tt = 0; tt < 16; ++tt) {
                const float* zr = z + (size_t)(b * S + t0 + tt) * INW;
                const float ipre = zr[ZCI + head] + gbi, fpre = zr[ZCF + head] + gbf;
                const float logf = fminf(fpre, 0.f) - log1pf(expf(-fabsf(fpre)));
                const float mn = fmaxf(logf + m, ipre);
                GT[tt * 4 + 0] = expf(logf + m - mn); GT[tt * 4 + 1] = expf(ipre - mn); GT[tt * 4 + 2] = expf(-mn); m = mn;
            }
            mstate = m;
        }
        __syncthreads();
        for (int idx = tid; idx < 16 * 128; idx += NTHREADS) { const int tt = idx >> 7, c = idx & 127;
            const int cc = (c < 64) ? (head * 64 + c) : (256 + head * 64 + (c - 64));
            float x = 0.f;
#pragma unroll
            for (int j = 0; j < 4; ++j) x += cw[j * 512 + cc] * RAW[(tt + j) * 128 + c];
            float y = x * sigm(x); if (c >= 64) y *= 0.125f;
            QK[idx] = y; }
        __syncthreads();
        for (int tt = 0; tt < 16; ++tt) {
            const float4 q0 = *(const float4*)&QK[tt * 128 + jg * 8], q1 = *(const float4*)&QK[tt * 128 + jg * 8 + 4];
            const float4 k0 = *(const float4*)&QK[tt * 128 + 64 + jg * 8], k1 = *(const float4*)&QK[tt * 128 + 64 + jg * 8 + 4];
            const float v = V[tt * 64 + i], a = GT[tt * 4], bb = GT[tt * 4 + 1], en = GT[tt * 4 + 2];
            const float qq[8] = {q0.x, q0.y, q0.z, q0.w, q1.x, q1.y, q1.z, q1.w}, kk[8] = {k0.x, k0.y, k0.z, k0.w, k1.x, k1.y, k1.z, k1.w};
            float pn = 0.f, pd = 0.f; const float bv = bb * v;
#pragma unroll
            for (int j = 0; j < 8; ++j) { C[j] = a * C[j] + bv * kk[j]; n[j] = a * n[j] + bb * kk[j]; pn += C[j] * qq[j]; pd += n[j] * qq[j]; }
            pn += __shfl_xor(pn, 1); pd += __shfl_xor(pd, 1); pn += __shfl_xor(pn, 2); pd += __shfl_xor(pd, 2); pn += __shfl_xor(pn, 4); pd += __shfl_xor(pd, 4);
            if (jg == 0) hraw[(size_t)(b * S + t0 + tt) * 256 + head * 64 + i] = pn / fmaxf(fabsf(pd), en);
        }
    }
    __syncthreads();
}

__device__ __forceinline__ void sgu_ln_wave(float* z, const float* lng, const float* lnb, int tok, int lane) {
    float4* p = (float4*)(z + (size_t)tok * INW + ZGV) + lane;
    float4 v = *p; v.x = gelu_tanh(v.x); v.y = gelu_tanh(v.y); v.z = gelu_tanh(v.z); v.w = gelu_tanh(v.w);
    const float mu = wave_sum(v.x + v.y + v.z + v.w) * (1.f / 256.f);
    const float dx = v.x - mu, dy = v.y - mu, dz = v.z - mu, dw = v.w - mu;
    const float var = wave_sum(dx * dx + dy * dy + dz * dz + dw * dw) * (1.f / 256.f);
    const float rs = rsqrtf(var + EPS);
    const float4 g = ((const float4*)lng)[lane], bb = ((const float4*)lnb)[lane];
    *p = make_float4(dx * rs * g.x + bb.x, dy * rs * g.y + bb.y, dz * rs * g.z + bb.z, dw * rs * g.w + bb.w);
}

__device__ __forceinline__ void ph_mix1(float* lds, const Params& P, int l, float* z, bf16_t* mix, float* hraw) {
    const int G = gridDim.x, bid = blockIdx.x, wave = tid_opaque() >> 6, lane = tid_opaque() & 63;
    for (int u = bid; u < 32; u += G) mlstm_block(lds, z, hraw, P, l, u);
    {
        const int rb = G - 1 - bid;
        for (int u = rb * 8 + wave; u < 128; u += G * 8) s5_wave(lds + wave * (2 * 16 * 130), z, P, l, u, lane);
    }
    const bool split = (G >= 96);
    const int nlight = split ? G - 48 : G, lid = split ? bid - 32 : bid;
    if (lid >= 0 && lid < nlight) {
        const float* sinks = P.in[I_SINK] + l * 4;
        for (int u = lid * 8 + wave; u < 8192; u += nlight * 8) attn_wave(z, sinks, mix, u, lane);
        for (int tok = lid * 8 + wave; tok < NTOK; tok += nlight * 8) sgu_ln_wave(z, P.in[I_LNG] + l * 256, P.in[I_LNB] + l * 256, tok, lane);
    }
}

__device__ __forceinline__ void ph_mix2(float* lds, const Params& P, int l, const float* z, bf16_t* mix, const float* hraw) {
    const int wave = tid_opaque() >> 6, lane = tid_opaque() & 63, tid = tid_opaque();
    const float* gw = P.in[I_GLUW] + (size_t)l * 256 * 256; const float* gb = P.in[I_GLUB] + l * 256;
    for (int u = blockIdx.x; u < (NTOK / 128) * 2; u += gridDim.x) {
        const int m0 = (u >> 1) * 128, n0 = (u & 1) * 128;
        gemm_tile<false>(lds, [&](int r) { return z + (size_t)(m0 + r) * INW + ZSU; }, 256, gw, gw, 256, n0, 256,
                         [&](int r, int c, float v, float) { const float y = z[(size_t)(m0 + r) * INW + ZSU + c]; mix[(size_t)(m0 + r) * D + 256 + c] = (bf16_t)(pg8::cvt_pk_bf16(y * sigm(v + gb[c]), 0.f) & 0xffffu); });
    }
    const float* ng = P.in[I_MNG] + l * 256;
    for (int tok = blockIdx.x * 8 + wave; tok < NTOK; tok += gridDim.x * 8) {
        const float4 h = *((const float4*)(hraw + (size_t)tok * 256) + lane);
        float ss = h.x * h.x + h.y * h.y + h.z * h.z + h.w * h.w;
        ss += __shfl_xor(ss, 1); ss += __shfl_xor(ss, 2); ss += __shfl_xor(ss, 4); ss += __shfl_xor(ss, 8);
        const float rs = rsqrtf(ss * (1.f / 64.f) + EPS);
        const float4 g = ((const float4*)ng)[lane];
        const float4 co = *((const float4*)(z + (size_t)tok * INW + ZCO) + lane);
        pg8::u32x2 w; w.x = pg8::cvt_pk_bf16(h.x * rs * g.x * sigm(co.x), h.y * rs * g.y * sigm(co.y)); w.y = pg8::cvt_pk_bf16(h.z * rs * g.z * sigm(co.z), h.w * rs * g.w * sigm(co.w));
        *((pg8::u32x2*)(mix + (size_t)tok * D + 512) + lane) = w;
    }
    const float* sw = P.in[I_SGUW] + (size_t)l * 4 * 128 * 128; const float* sb = P.in[I_SGUB] + l * 4 * 128;
    for (int u = blockIdx.x; u < NTOK / 128; u += gridDim.x) {
        const int tok0 = u * 128;
        __syncthreads();
        for (int idx = tid; idx < 128 * 64; idx += NTHREADS) { const int s = idx >> 6, c4 = idx & 63;
            *(float4*)&lds[s * 256 + c4 * 4] = *((const float4*)(z + (size_t)(tok0 + s) * INW + ZGV) + c4); }
        __syncthreads();
        const int c = tid & 255, half = tid >> 8, g = c >> 6;
        for (int tt = 0; tt < 64; ++tt) {
            const int t = half * 64 + tt;
            const float* wr = sw + ((size_t)g * 128 + t) * 128;
            float acc = 0.f;
            for (int s = 0; s <= t; ++s) acc += wr[s] * lds[s * 256 + c];
            const float gu = z[(size_t)(tok0 + t) * INW + ZGU + c];
            mix[(size_t)(tok0 + t) * D + 768 + c] = (bf16_t)(pg8::cvt_pk_bf16(gelu_tanh(gu) * (acc + sb[g * 128 + t]), 0.f) & 0xffffu);
        }
    }
    __syncthreads();
}

__device__ __forceinline__ void ph_outproj(LAS unsigned char* ldsb, const bf16_t* mix, const bf16_t* wt, const float* xsrc, float* xout) {
    pg8::StaticOrder S; S.init(NTOK, D, D, D, gridDim.x, blockIdx.x, mix, wt);
    pg8::EpiRes E{xsrc, xout};
    pg8::gemm_phase<pg8::EpiRes, pg8::StaticOrder, false>(ldsb, D, D, S, E);
}

__device__ __forceinline__ void ph_norm_router(const Params& P, int l, const float* x, bf16_t* H, unsigned* cnt, int2* lists) {
    const int wave = tid_opaque() >> 6, lane = tid_opaque() & 63;
    const float* gn = P.in[I_NFG] + l * D;
    const float* wg = P.in[I_RGW] + (size_t)l * D * 4; const float* we = P.in[I_REW] + (size_t)l * D * 32;
    const float* bg = P.in[I_RGB] + l * 4; const float* be = P.in[I_REB] + l * 32;
    for (int r = blockIdx.x * 8 + wave; r < NTOK; r += gridDim.x * 8) {
        const float* xr = x + (size_t)r * D; bf16_t* hr = H + (size_t)r * D;
        float ss = 0.f;
        { const float4* p = (const float4*)xr;
#pragma unroll
          for (int i = 0; i < 4; ++i) { const float4 v = p[lane + 64 * i]; ss += v.x * v.x + v.y * v.y + v.z * v.z + v.w * v.w; } }
        ss = wave_sum(ss);
        const float rs = rsqrtf(ss * (1.f / D) + EPS);
        float lg[36];
#pragma unroll
        for (int c = 0; c < 36; ++c) lg[c] = 0.f;
#pragma unroll 1
        for (int kk = 0; kk < 16; ++kk) {
            const int k = kk * 64 + lane;
            const float hv = xr[k] * rs * gn[k];
            hr[k] = (bf16_t)(pg8::cvt_pk_bf16(hv, 0.f) & 0xffffu);
            const float4 w4 = *(const float4*)(wg + (size_t)k * 4);
            lg[0] += hv * w4.x; lg[1] += hv * w4.y; lg[2] += hv * w4.z; lg[3] += hv * w4.w;
#pragma unroll
            for (int e4 = 0; e4 < 8; ++e4) { const float4 w = *(const float4*)(we + (size_t)k * 32 + e4 * 4);
                lg[4 + e4 * 4] += hv * w.x; lg[5 + e4 * 4] += hv * w.y; lg[6 + e4 * 4] += hv * w.z; lg[7 + e4 * 4] += hv * w.w; }
        }
#pragma unroll
        for (int c = 0; c < 36; ++c) lg[c] = wave_sum(lg[c]);
        if (lane == 0) {
            float gl[4];
#pragma unroll
            for (int j = 0; j < 4; ++j) gl[j] = lg[j] + bg[j];
            int sel = 0; float gm = gl[0];
#pragma unroll
            for (int j = 1; j < 4; ++j) if (gl[j] > gm) { gm = gl[j]; sel = j; }
            float gs = 0.f;
#pragma unroll
            for (int j = 0; j < 4; ++j) gs += expf(gl[j] - gm);
            const float pg = 1.f / gs;
            float ein[8];
#pragma unroll
            for (int j = 0; j < 8; ++j) { const float a0 = lg[4 + j] + be[j], a1 = lg[12 + j] + be[8 + j], a2 = lg[20 + j] + be[16 + j], a3 = lg[28 + j] + be[24 + j];
                ein[j] = sel == 0 ? a0 : (sel == 1 ? a1 : (sel == 2 ? a2 : a3)); }
            int i1 = 0; float v1 = ein[0];
#pragma unroll
            for (int j = 1; j < 8; ++j) if (ein[j] > v1) { v1 = ein[j]; i1 = j; }
            int i2 = -1; float v2 = -3.0e38f;
#pragma unroll
            for (int j = 0; j < 8; ++j) if (j != i1 && ein[j] > v2) { v2 = ein[j]; i2 = j; }
            const float e2 = expf(v2 - v1), den = 1.f / (1.f + e2);
            const float w1 = den * pg, w2 = e2 * den * pg;
            const int ex1 = sel * 8 + i1, ex2 = sel * 8 + i2;
            const unsigned p1 = atomicAdd(&cnt[ex1], 1u), p2 = atomicAdd(&cnt[ex2], 1u);
            lists[(size_t)ex1 * NTOK + p1] = make_int2(r, __float_as_int(w1));
            lists[(size_t)ex2 * NTOK + p2] = make_int2(r, __float_as_int(w2));
        }
    }
}

__device__ __forceinline__ int moe_build_tab(LAS unsigned char* ldsb, const unsigned* cnt) {
    LAS pg8::i32x4* tab = (LAS pg8::i32x4*)(ldsb + TAB_OFF);
    __syncthreads();
    int base = 0;
#pragma unroll 1
    for (int e = 0; e < NEXP; ++e) { const int c = __builtin_amdgcn_readfirstlane((int)cnt[e]), nt = (c + 255) >> 8;
        if ((int)tid_opaque() < nt) tab[base + tid_opaque()] = (pg8::i32x4){e, (int)tid_opaque() * 256, c, 0};
        base += nt; }
    __syncthreads();
    return base;
}
__device__ __forceinline__ void ph_moe1(LAS unsigned char* ldsb, const Params& P, int l, const bf16_t* H, const unsigned* cnt, const int2* lists, bf16_t* act) {
    const int ntiles = moe_build_tab(ldsb, cnt);
    pg8::MoeOrder S; S.tab = (const LAS pg8::i32x4*)(ldsb + TAB_OFF); S.ntiles = ntiles; S.npn = 4; S.G = gridDim.x; S.c = blockIdx.x;
    S.A = (const char*)H; S.atile = 0; S.Bt = (const char*)(P.ws + WS_WGU) + (size_t)l * NEXP * 1024 * D * 2; S.bexp = (size_t)1024 * D * 2; S.btile = (size_t)256 * D * 2; S.lists = lists;
    pg8::EpiAct E{act};
    pg8::gemm_phase<pg8::EpiAct, pg8::MoeOrder, true>(ldsb, D, D, S, E);
}
__device__ __forceinline__ void ph_moe2(LAS unsigned char* ldsb, const Params& P, int l, const bf16_t* act, const unsigned* cnt, const int2* lists, float* x) {
    const int ntiles = moe_build_tab(ldsb, cnt);
    pg8::MoeOrder S; S.tab = (const LAS pg8::i32x4*)(ldsb + TAB_OFF); S.ntiles = ntiles; S.npn = 4; S.G = gridDim.x; S.c = blockIdx.x;
    S.A = (const char*)act; S.atile = (size_t)256 * DE * 2; S.Bt = (const char*)(P.ws + WS_WD) + (size_t)l * NEXP * D * DE * 2; S.bexp = (size_t)D * DE * 2; S.btile = (size_t)256 * DE * 2; S.lists = lists;
    pg8::EpiDown E{x, lists};
    pg8::gemm_phase<pg8::EpiDown, pg8::MoeOrder, false>(ldsb, DE, DE, S, E);
}

__global__ void __launch_bounds__(NTHREADS, 2) fwd_kernel(Params P) {
    extern __shared__ __attribute__((aligned(16))) unsigned char lds_raw[];
    float* lds = (float*)lds_raw;
    volatile LAS unsigned* xbw = (volatile LAS unsigned*)(lds_raw + LDS_BYTES - 16);
    if (threadIdx.x == 0) { xbw[0] = 0u; xbw[1] = 0u; }
    __syncthreads();
    unsigned* ctl = (unsigned*)(P.ws + WS_CTL);
    const bool multi = (P.ph_hi - P.ph_lo) > 1;
    XcdBarrier bar; bar.bar = ctl; bar.x = 0; bar.st = xbw;
    if (multi) bar = xcd_barrier_post(ctl, xbw);
    float* z = (float*)(P.ws + WS_Z); bf16_t* mix = (bf16_t*)(P.ws + WS_MIX); float* hraw = (float*)(P.ws + WS_HRAW);
    bf16_t* H = (bf16_t*)(P.ws + WS_H); bf16_t* act = (bf16_t*)(P.ws + WS_ACT);
    int2* lists = (int2*)(P.ws + WS_LIST);
    LAS unsigned char* ldsb = (LAS unsigned char*)lds_raw;
    const int lo = P.ph_lo, hi = P.ph_hi;
#define IN(k) (lo <= (k) && (k) < hi)
#define SEAM(k) do { if (IN(k) && IN((k) + 1)) xcd_barrier(bar); } while (0)
    if (IN(0)) { ph_prologue(lds, P); } SEAM(0);
    for (int l = 0; l < NLAYER; ++l) {
        const int pb = 1 + l * PH_PER_LAYER;
        const float* xsrc = (l == 0) ? P.in[I_X] : P.out;
        unsigned* cnt = ctl + CW_CNT + l * 64;
        if (IN(pb + 0)) { ph_norm1(xsrc, P.in[I_NMG] + l * D, P.in[I_WIN] + (size_t)l * D * INW, mix, z); } SEAM(pb + 0);
        if (IN(pb + 1)) { ph_inproj(ldsb, mix, (const bf16_t*)(P.ws + WS_WIN) + (size_t)l * NMAIN * D, z); } SEAM(pb + 1);
        if (IN(pb + 2)) { ph_mix1(lds, P, l, z, mix, hraw); } SEAM(pb + 2);
        if (IN(pb + 3)) { ph_mix2(lds, P, l, z, mix, hraw); } SEAM(pb + 3);
        if (IN(pb + 4)) { ph_outproj(ldsb, mix, (const bf16_t*)(P.ws + WS_WOUT) + (size_t)l * D * D, xsrc, P.out); } SEAM(pb + 4);
        if (IN(pb + 5)) { ph_norm_router(P, l, P.out, H, cnt, lists); } SEAM(pb + 5);
        if (IN(pb + 6)) { ph_moe1(ldsb, P, l, H, cnt, lists, act); } SEAM(pb + 6);
        if (IN(pb + 7)) { ph_moe2(ldsb, P, l, act, cnt, lists, P.out); } SEAM(pb + 7);
    }
    if (IN(1 + NLAYER * PH_PER_LAYER)) ph_rmsnorm(P.out, P.in[I_NFIN], P.out);
#undef IN
#undef SEAM
}

#ifndef N_LAUNCH_MODE
#define N_LAUNCH_MODE 1
#endif
extern "C" void kernel_launch(void* const* d_in, const int* in_sizes, int n_in, void* d_out, int out_size, void* d_ws, size_t ws_size, hipStream_t stream) {
    static int grid = 0;
    if (grid == 0) {
        if (n_in != 31 || out_size != NTOK * D || ws_size < WS_END) { fprintf(stderr, "kernel_launch: unexpected shapes n_in %d out %d ws %zu (need %zu)\n", n_in, out_size, ws_size, (size_t)WS_END); grid = -1; return; }
        int dev = 0, cus = 0, per_cu = 0;
        if (hipGetDevice(&dev) != hipSuccess || hipDeviceGetAttribute(&cus, hipDeviceAttributeMultiprocessorCount, dev) != hipSuccess) { grid = -1; return; }
        if (hipFuncSetAttribute((const void*)fwd_kernel, hipFuncAttributeMaxDynamicSharedMemorySize, LDS_BYTES) != hipSuccess) { fprintf(stderr, "kernel_launch: hipFuncSetAttribute failed\n"); grid = -1; return; }
        if (hipOccupancyMaxActiveBlocksPerMultiprocessor(&per_cu, (const void*)fwd_kernel, NTHREADS, LDS_BYTES) != hipSuccess || per_cu < 1) { fprintf(stderr, "kernel_launch: occupancy query says %d\n", per_cu); }
        (void)hipGetLastError();
        grid = cus;
    }
    if (grid < 0) return;
    (void)hipMemsetAsync((char*)d_ws + WS_CTL, 0, CTL_BYTES, stream);
    Params p{};
    for (int i = 0; i < 31; ++i) p.in[i] = (const float*)d_in[i];
    p.out = (float*)d_out; p.ws = (unsigned char*)d_ws;
#if N_LAUNCH_MODE == 1
    p.ph_lo = 0; p.ph_hi = N_PHASES;
    hipLaunchKernelGGL(fwd_kernel, dim3(grid), dim3(NTHREADS), LDS_BYTES, stream, p);
#else
    for (int ph = 0; ph < N_PHASES; ++ph) { p.ph_lo = ph; p.ph_hi = ph + 1; hipLaunchKernelGGL(fwd_kernel, dim3(grid), dim3(NTHREADS), LDS_BYTES, stream, p); }
#endif
}
```

```cpp
#include <hip/hip_runtime.h>
#include <stdint.h>
#include <stdio.h>

#define LAS __attribute__((address_space(3)))

constexpr int D = 1024, NB = 8, S = 8192, NTOK = NB * S, INW = 2312, NLAYER = 2;
constexpr int NEXP = 32, DE = 512;
constexpr float EPS = 1e-6f;
constexpr int ZQ = 0, ZK = 256, ZV = 384, ZSU = 512, ZCQ = 768, ZCK = 1024, ZCV = 1280, ZCI = 1536, ZCF = 1540, ZCO = 1544, ZGU = 1800, ZGV = 2056;
constexpr int NTHREADS = 512;
constexpr int LDS_BYTES = 144 * 1024;
constexpr int TAB_OFF = 128 * 1024;
constexpr int PH_PER_LAYER = 9, N_PHASES = 1 + NLAYER * PH_PER_LAYER + 1;
constexpr int NMAIN = 2304;
typedef unsigned short bf16_t;

constexpr size_t MiB = 1u << 20;
constexpr size_t WS_CTL = 0, CTL_BYTES = 1 * MiB;
constexpr size_t WS_Z = WS_CTL + CTL_BYTES;
constexpr size_t Z_BYTES = (size_t)NTOK * INW * 4;
constexpr size_t WS_H = WS_Z;
constexpr size_t WS_ACT = WS_Z + (size_t)NTOK * D * 2;
constexpr int PMAX = 2 * NTOK + NEXP * 256;
static_assert((size_t)NTOK * D * 2 + (size_t)PMAX * DE * 2 <= Z_BYTES, "alias fits");
constexpr size_t WS_MIX = WS_Z + Z_BYTES;
constexpr size_t WS_HRAW = WS_MIX + (size_t)NTOK * D * 2;
constexpr size_t WS_LIST = WS_HRAW + (size_t)NTOK * 256 * 4;
constexpr size_t WS_WIN = WS_LIST + (size_t)NEXP * NTOK * 8;
constexpr size_t WS_WOUT = WS_WIN + (size_t)NLAYER * NMAIN * D * 2;
constexpr size_t WS_WGU = WS_WOUT + (size_t)NLAYER * D * D * 2;
constexpr size_t WS_WD = WS_WGU + (size_t)NLAYER * NEXP * 1024 * D * 2;
constexpr size_t WS_END = WS_WD + (size_t)NLAYER * NEXP * D * DE * 2;
constexpr int CW_CNT = 8192;

#define XB_TMO      128
#define XB_XCNT(j)  (256  + 64 * (j))
#define XB_XSUB(j)  (1280 + 64 * (j))
#define XB_XGEN(j)  (2304 + 64 * (j))
#define XB_TOP      3328
#define XB_TOPGEN   3392
#define XCD_BAR_WORDS 3456
#define XB_SPIN_CAP (1u << 22)
__device__ __forceinline__ unsigned xb_ld(unsigned* p)              { return __hip_atomic_load(p, __ATOMIC_RELAXED, __HIP_MEMORY_SCOPE_AGENT); }
__device__ __forceinline__ unsigned xb_add(unsigned* p, unsigned v) { return __hip_atomic_fetch_add(p, v, __ATOMIC_RELAXED, __HIP_MEMORY_SCOPE_AGENT); }
__device__ __forceinline__ unsigned xb_xcc_id() { return (unsigned)__builtin_amdgcn_s_getreg((3 << 11) | 20) & 0xFu; }
#define XB_SPIN(cond, bar) do { unsigned _sp = 0; while (cond) { __builtin_amdgcn_s_sleep(1); \
    if ((++_sp & 255u) == 0u) { if (xb_ld(&(bar)[XB_TMO])) break; if (_sp > XB_SPIN_CAP) { atomicAdd(&(bar)[XB_TMO], 1u); break; } } } } while (0)
struct XcdBarrier { unsigned* bar; unsigned x; volatile LAS unsigned* st; };
__device__ __forceinline__ XcdBarrier xcd_barrier_post(unsigned* bar, volatile LAS unsigned* st) {
    XcdBarrier b; b.bar = bar; b.x = xb_xcc_id(); b.st = st;
    if (threadIdx.x == 0) (void)xb_add(&bar[XB_XCNT(b.x)], 1u);
    return b;
}
__device__ __forceinline__ void xcd_barrier_complete(unsigned* bar, unsigned x, unsigned& nloc, unsigned& nx) {
    const unsigned G = gridDim.x * gridDim.y * gridDim.z;
    unsigned sum, cnt, mine, sp = 0u;
    for (;;) {
        sum = 0u; cnt = 0u; mine = 0u;
#pragma unroll
        for (unsigned j = 0; j < 16; ++j) { const unsigned c = xb_ld(&bar[XB_XCNT(j)]); sum += c; cnt += (c > 0u) ? 1u : 0u; mine = (j == x) ? c : mine; }
        if (sum == G) break;
        __builtin_amdgcn_s_sleep(1);
        if ((++sp & 255u) == 0u) { if (xb_ld(&bar[XB_TMO])) break; if (sp > XB_SPIN_CAP) { atomicAdd(&bar[XB_TMO], 1u); break; } }
    }
    nloc = mine > 0u ? mine : 1u; nx = cnt > 0u ? cnt : 1u;
}
__device__ __forceinline__ void xcd_barrier(const XcdBarrier& b) {
    asm volatile("s_waitcnt vmcnt(0)" ::: "memory");
    __syncthreads();
    if (threadIdx.x == 0) {
        unsigned* bar = b.bar;
        __builtin_amdgcn_s_waitcnt(0);
        unsigned nloc = b.st[0], nx = b.st[1];
        if (nloc == 0u) { xcd_barrier_complete(bar, b.x, nloc, nx); b.st[0] = nloc; b.st[1] = nx; }
        const unsigned old = xb_add(&bar[XB_XSUB(b.x)], 1u);
        const unsigned gen = old / nloc;
        if (old + 1u == (gen + 1u) * nloc) {
            __builtin_amdgcn_fence(__ATOMIC_RELEASE, "agent");
            asm volatile("s_waitcnt vmcnt(0)" ::: "memory");
            const unsigned og = xb_add(&bar[XB_TOP], 1u);
            const unsigned tg = og / nx;
            if (og + 1u == (tg + 1u) * nx) xb_add(&bar[XB_TOPGEN], 1u);
            else XB_SPIN(xb_ld(&bar[XB_TOPGEN]) == tg, bar);
            __builtin_amdgcn_fence(__ATOMIC_ACQUIRE, "agent");
            xb_add(&bar[XB_XGEN(b.x)], 1u);
            asm volatile("s_waitcnt vmcnt(0)" ::: "memory");
        } else {
            XB_SPIN(xb_ld(&bar[XB_XGEN(b.x)]) == gen, bar);
            __builtin_amdgcn_fence(__ATOMIC_ACQUIRE, "agent");
            asm volatile("s_waitcnt vmcnt(0)" ::: "memory");
        }
    }
    __syncthreads();
}

__device__ __forceinline__ int tid_opaque() { int t = threadIdx.x; asm volatile("" : "+v"(t)); return t; }
__device__ __forceinline__ float wave_sum(float v) {
#pragma unroll
    for (int o = 32; o > 0; o >>= 1) v += __shfl_xor(v, o);
    return v;
}
__device__ __forceinline__ float gelu_tanh(float x) {
    const float u = 0.7978845608028654f * (x + 0.044715f * x * x * x);
    return 0.5f * x * (1.f + tanhf(u));
}
__device__ __forceinline__ float sigm(float x) { return 1.f / (1.f + expf(-x)); }
__device__ __forceinline__ void wave_lds_fence() {
    __builtin_amdgcn_fence(__ATOMIC_RELEASE, "wavefront"); __builtin_amdgcn_wave_barrier(); __builtin_amdgcn_fence(__ATOMIC_ACQUIRE, "wavefront");
}

struct Params {
    const float* in[31];
    float* out;
    unsigned char* ws;
    int ph_lo, ph_hi;
};
enum { I_X = 0, I_NMG, I_WIN, I_SINK, I_ARE, I_AIM, I_BRE, I_BIM, I_CRE, I_CIM, I_SD, I_LDT, I_GLUW, I_GLUB, I_CONVW, I_GATEB, I_MNG,
       I_LNG, I_LNB, I_SGUW, I_SGUB, I_WOUT, I_NFG, I_RGW, I_RGB, I_REW, I_REB, I_EWG, I_EWU, I_EWD, I_NFIN };

namespace pg8 {
#define PG8_LAS __attribute__((address_space(3)))
typedef short bf16x8 __attribute__((ext_vector_type(8)));
typedef float f32x4 __attribute__((ext_vector_type(4)));
typedef unsigned u32x4 __attribute__((ext_vector_type(4)));
typedef unsigned u32x2 __attribute__((ext_vector_type(2)));
typedef int i32x4 __attribute__((ext_vector_type(4)));
constexpr int BM = 256, BK = 64, HALF = 128, HTB = HALF * BK * 2, STAGE_BYTES = 8 * HTB, NXCD = 8, WGM = 8;
__host__ __device__ __forceinline__ int lds_byte(int r, int c) { const int st = (r >> 4) * 2 + (c >> 5), rr = r & 15, cc = c & 31, ob = rr * 64 + cc * 2; return st * 1024 + (ob ^ (((ob >> 9) & 1) << 5)); }
__host__ __device__ __forceinline__ void stage_rc(int b, int& R, int& C) { const int st = b / 1024, sb = b % 1024, swz = sb ^ (((sb >> 9) & 1) << 5); R = (st >> 1) * 16 + swz / 64; C = (st & 1) * 32 + (swz % 64) / 2; }
__host__ __device__ __forceinline__ int perm32(int rho) { const int n = rho >> 4, i = rho & 15; return 8 * (i >> 2) + 4 * n + (i & 3); }
__device__ __forceinline__ unsigned cvt_pk_bf16(float lo, float hi) { unsigned r; asm volatile("v_cvt_pk_bf16_f32 %0, %1, %2" : "=v"(r) : "v"(lo), "v"(hi)); return r; }

struct Unit { int pm, pn; const char* A; const char* B; int e, pos0, cnt; };

struct StaticOrder {
    int nM, nN, nwg, G, c; const char* A; const char* Bt; size_t atile, btile;
    __device__ void init(int M, int N, int K, int lda, int G_, int c_, const void* A_, const void* Bt_) { nM = M / BM; nN = N / BM; nwg = nM * nN; G = G_; c = c_; A = (const char*)A_; Bt = (const char*)Bt_; atile = (size_t)BM * lda * 2; btile = (size_t)BM * K * 2; }
    __device__ __forceinline__ bool next(int i, Unit& u) const {
        const long L = (long)i * G + c; if (L >= nwg) return false;
        int wgid = (int)L; { const int q = nwg / NXCD, r = nwg % NXCD, xcd = wgid % NXCD, off = wgid / NXCD; wgid = (xcd < r ? xcd * (q + 1) : r * (q + 1) + (xcd - r) * q) + off; }
        const int nig = WGM * nN, gid = wgid / nig, fm = gid * WGM, gsz = (nM - fm) < WGM ? (nM - fm) : WGM;
        u.pm = fm + ((wgid % nig) % gsz); u.pn = (wgid % nig) / gsz; u.A = A + (size_t)u.pm * atile; u.B = Bt + (size_t)u.pn * btile; u.e = 0; u.pos0 = 0; u.cnt = 0; return true;
    }
    __device__ __forceinline__ void aoff(const Unit&, unsigned (&)[2], unsigned (&)[2], const int (&)[2], const int (&)[2]) const {}
};

template <class Epi, class Sched, bool GATHER>
__device__ __forceinline__ void gemm_phase(PG8_LAS unsigned char* lds, const int K, const int lda, const Sched& S, const Epi& E) {
    const int tid = tid_opaque(), wid = __builtin_amdgcn_readfirstlane(tid >> 6), lane = tid & 63, wr = wid >> 2, wc = wid & 3, fr = lane & 15, fq = lane >> 4;
    const int nt = K / BK;
    unsigned vA0[2], vA1[2], vB[2], nA0[2], nA1[2]; int Rs[2], Cs[2];
#pragma unroll
    for (int i = 0; i < 2; ++i) { int R, C; stage_rc(tid * 16 + i * 8192, R, C); const int Rb = Epi::PERM ? ((R & ~31) + perm32(R & 31)) : R;
        Rs[i] = R; Cs[i] = C; vA0[i] = (unsigned)(R * lda + C) * 2u; vA1[i] = vA0[i] + (unsigned)(HALF * lda) * 2u; vB[i] = (unsigned)(Rb * K + C) * 2u; nA0[i] = vA0[i]; nA1[i] = vA1[i]; }
    const size_t kstep = (size_t)(BK * 2);
    const size_t hstep = (size_t)HALF * K * 2;
    const unsigned ldsw = (unsigned)wid * 1024u;
    const int aoff = lds_byte(wr * 64 + fr, fq * 8), boff = lds_byte(wc * 32 + fr, fq * 8);
#define PG8_SA(b, h) (((b) * 2 + (h)) * HTB)
#define PG8_SB(b, h) ((4 + (b) * 2 + (h)) * HTB)
#define PG8_STAGE(bufoff, gbase, voff) do { _Pragma("unroll") for (int _i = 0; _i < 2; ++_i) \
        __builtin_amdgcn_global_load_lds((const unsigned*)((const char*)(gbase) + (voff)[_i]), (PG8_LAS unsigned*)(lds + (bufoff) + ldsw + _i * 8192), 16, 0, 0); } while (0)
#define PG8_LDA(dst, b, h) do { _Pragma("unroll") for (int m = 0; m < 4; ++m) _Pragma("unroll") for (int k = 0; k < 2; ++k) dst[m][k] = *(const PG8_LAS bf16x8*)(lds + PG8_SA(b, h) + aoff + m * 2048 + k * 1024); } while (0)
#define PG8_LDB(dst, b, h) do { _Pragma("unroll") for (int n = 0; n < 2; ++n) _Pragma("unroll") for (int k = 0; k < 2; ++k) dst[n][k] = *(const PG8_LAS bf16x8*)(lds + PG8_SB(b, h) + boff + n * 2048 + k * 1024); } while (0)
#define PG8_MMA(ai, bj, At, Bt) do { __builtin_amdgcn_s_setprio(1); _Pragma("unroll") for (int m = 0; m < 4; ++m) _Pragma("unroll") for (int n = 0; n < 2; ++n) _Pragma("unroll") for (int k = 0; k < 2; ++k) \
        acc[ai][bj][m][n] = __builtin_amdgcn_mfma_f32_16x16x32_bf16(Bt[n][k], At[m][k], acc[ai][bj][m][n], 0, 0, 0); __builtin_amdgcn_s_setprio(0); } while (0)
#define PG8_WAIT_V(n) asm volatile("s_waitcnt vmcnt(" #n ")" ::: "memory")
#define PG8_WAIT_L(n) asm volatile("s_waitcnt lgkmcnt(" #n ")" ::: "memory")
#define PG8_BAR __builtin_amdgcn_s_barrier()
#define PG8_SCHED __builtin_amdgcn_sched_barrier(0)
    Unit cur, nxt; int ui = 0;
    if (!S.next(0, cur)) return;
    if constexpr (GATHER) { S.aoff(cur, vA0, vA1, Rs, Cs); PG8_WAIT_V(0); }
    f32x4 acc[2][2][4][2];
#pragma unroll
    for (int a = 0; a < 2; ++a)
#pragma unroll
        for (int b = 0; b < 2; ++b)
#pragma unroll
            for (int m = 0; m < 4; ++m)
#pragma unroll
                for (int n = 0; n < 2; ++n) acc[a][b][m][n] = (f32x4){0.f, 0.f, 0.f, 0.f};
    bf16x8 At[4][2], B0[2][2], B1[2][2];
    const char* cA = cur.A; const char* cB = cur.B;
    PG8_STAGE(PG8_SB(0, 0), cB, vB); PG8_STAGE(PG8_SB(0, 1), cB + hstep, vB); PG8_STAGE(PG8_SA(0, 0), cA, vA0); PG8_STAGE(PG8_SA(0, 1), cA, vA1);
    if (wr == 1) PG8_BAR;
    PG8_WAIT_V(2); PG8_BAR;
    PG8_STAGE(PG8_SB(1, 0), cB + kstep, vB); PG8_STAGE(PG8_SA(1, 0), cA + kstep, vA0); PG8_STAGE(PG8_SB(1, 1), cB + hstep + kstep, vB);
    PG8_WAIT_V(6); PG8_BAR;
    for (;;) {
        const bool has_next = S.next(ui + 1, nxt);
        const char* nA = has_next ? nxt.A : cA; const char* nB = has_next ? nxt.B : cB;
        if constexpr (GATHER) {
            if (has_next) { S.aoff(nxt, nA0, nA1, Rs, Cs); }
            else {
#pragma unroll
                for (int i = 0; i < 2; ++i) { nA0[i] = vA0[i]; nA1[i] = vA1[i]; } }
        }
        for (int t = 0; t < nt; t += 2) {
            const bool last = (t == nt - 2);
            const char* a1 = cA + (size_t)(t + 1) * kstep;
            const char* a2 = last ? nA : cA + (size_t)(t + 2) * kstep; const char* b2 = last ? nB : cB + (size_t)(t + 2) * kstep;
            const char* a3 = a2 + kstep; const char* b3 = b2 + kstep;
            unsigned x0[2], x1[2];
#pragma unroll
            for (int i = 0; i < 2; ++i) { x0[i] = (GATHER && last) ? nA0[i] : vA0[i]; x1[i] = (GATHER && last) ? nA1[i] : vA1[i]; }
            PG8_LDB(B0, 0, 0); PG8_LDB(B1, 0, 1); PG8_SCHED; PG8_LDA(At, 0, 0); PG8_STAGE(PG8_SA(1, 1), a1, vA1);
            PG8_WAIT_V(8); PG8_WAIT_L(0); PG8_BAR; PG8_MMA(0, 0, At, B0); PG8_MMA(0, 1, At, B1); PG8_BAR; PG8_SCHED;
            PG8_LDA(At, 0, 1); PG8_STAGE(PG8_SB(0, 0), b2, vB); PG8_STAGE(PG8_SB(0, 1), b2 + hstep, vB); PG8_STAGE(PG8_SA(0, 0), a2, x0);
            PG8_WAIT_V(8); PG8_WAIT_L(0); PG8_BAR; PG8_MMA(1, 0, At, B0); PG8_MMA(1, 1, At, B1); PG8_BAR; PG8_SCHED;
            PG8_LDB(B0, 1, 0); PG8_LDB(B1, 1, 1); PG8_SCHED; PG8_LDA(At, 1, 0); PG8_STAGE(PG8_SA(0, 1), a2, x1);
            PG8_WAIT_V(8); PG8_WAIT_L(0); PG8_BAR; PG8_MMA(0, 0, At, B0); PG8_MMA(0, 1, At, B1); PG8_BAR; PG8_SCHED;
            PG8_LDA(At, 1, 1); PG8_STAGE(PG8_SB(1, 0), b3, vB); PG8_STAGE(PG8_SB(1, 1), b3 + hstep, vB); PG8_STAGE(PG8_SA(1, 0), a3, x0);
            PG8_WAIT_V(8); PG8_WAIT_L(0); PG8_BAR; PG8_MMA(1, 0, At, B0); PG8_MMA(1, 1, At, B1); PG8_BAR; PG8_SCHED;
        }
        if (wr == 0) PG8_BAR;
        E(acc, cur, wr, wc, fr, fq);
        if (!has_next) break;
#pragma unroll
        for (int a = 0; a < 2; ++a)
#pragma unroll
            for (int b = 0; b < 2; ++b)
#pragma unroll
                for (int m = 0; m < 4; ++m)
#pragma unroll
                    for (int n = 0; n < 2; ++n) acc[a][b][m][n] = (f32x4){0.f, 0.f, 0.f, 0.f};
        cur = nxt; cA = nA; cB = nB; ++ui;
        if constexpr (GATHER) {
#pragma unroll
            for (int i = 0; i < 2; ++i) { vA0[i] = nA0[i]; vA1[i] = nA1[i]; } }
        if (wr == 1) PG8_BAR;
    }
    PG8_WAIT_V(0);
    PG8_BAR;
#undef PG8_SA
#undef PG8_SB
#undef PG8_STAGE
#undef PG8_LDA
#undef PG8_LDB
#undef PG8_MMA
#undef PG8_WAIT_V
#undef PG8_WAIT_L
#undef PG8_BAR
#undef PG8_SCHED
}

struct EpiZ {
    static constexpr bool PERM = false;
    float* Z;
    __device__ __forceinline__ void operator()(const f32x4 (&acc)[2][2][4][2], const Unit& u, int wr, int wc, int fr, int fq) const {
        const int row0 = u.pm * BM + wr * 64 + fr, col0 = u.pn * BM + (u.pn >= 6 ? 8 : 0) + wc * 32 + 4 * fq;
#pragma unroll
        for (int ai = 0; ai < 2; ++ai)
#pragma unroll
            for (int m = 0; m < 4; ++m) { float* rowp = Z + (size_t)(row0 + ai * HALF + m * 16) * INW + col0;
#pragma unroll
                for (int bj = 0; bj < 2; ++bj)
#pragma unroll
                    for (int n = 0; n < 2; ++n) *(f32x4*)(rowp + bj * HALF + n * 16) = acc[ai][bj][m][n]; }
    }
};
struct EpiRes {
    static constexpr bool PERM = false;
    const float* X; float* O;
    __device__ __forceinline__ void operator()(const f32x4 (&acc)[2][2][4][2], const Unit& u, int wr, int wc, int fr, int fq) const {
        const int row0 = u.pm * BM + wr * 64 + fr, col0 = u.pn * BM + wc * 32 + 4 * fq;
#pragma unroll
        for (int ai = 0; ai < 2; ++ai)
#pragma unroll
            for (int m = 0; m < 4; ++m) { const size_t off = (size_t)(row0 + ai * HALF + m * 16) * D + col0;
#pragma unroll
                for (int bj = 0; bj < 2; ++bj)
#pragma unroll
                    for (int n = 0; n < 2; ++n) { const f32x4 xs = *(const f32x4*)(X + off + bj * HALF + n * 16); *(f32x4*)(O + off + bj * HALF + n * 16) = xs + acc[ai][bj][m][n]; }
                asm volatile("" ::: "memory"); }
    }
};
struct EpiAct {
    static constexpr bool PERM = true;
    bf16_t* ACT;
    __device__ __forceinline__ void operator()(const f32x4 (&acc)[2][2][4][2], const Unit& u, int wr, int wc, int fr, int fq) const {
        const int row0 = u.pm * BM + wr * 64 + fr, col0 = u.pn * HALF + wc * 32 + 8 * fq;
#pragma unroll
        for (int ai = 0; ai < 2; ++ai)
#pragma unroll
            for (int m = 0; m < 4; ++m) { bf16_t* rowp = ACT + (size_t)(row0 + ai * HALF + m * 16) * DE + col0;
                float o[8];
#pragma unroll
                for (int n = 0; n < 2; ++n)
#pragma unroll
                    for (int j = 0; j < 4; ++j) { const float g = acc[ai][0][m][n][j], up = acc[ai][1][m][n][j]; o[n * 4 + j] = g * up * __builtin_amdgcn_rcpf(1.f + __expf(-g)); }
                u32x4 w; w.x = cvt_pk_bf16(o[0], o[1]); w.y = cvt_pk_bf16(o[2], o[3]); w.z = cvt_pk_bf16(o[4], o[5]); w.w = cvt_pk_bf16(o[6], o[7]);
                *(u32x4*)rowp = w; }
    }
};
struct EpiDown {
    static constexpr bool PERM = false;
    float* X; const int2* lists;
    __device__ __forceinline__ void operator()(const f32x4 (&acc)[2][2][4][2], const Unit& u, int wr, int wc, int fr, int fq) const {
        const int col0 = u.pn * BM + wc * 32 + 4 * fq; const int2* lst = lists + (size_t)u.e * NTOK + u.pos0;
#pragma unroll
        for (int ai = 0; ai < 2; ++ai)
#pragma unroll
            for (int m = 0; m < 4; ++m) { const int r = ai * HALF + wr * 64 + m * 16 + fr;
                if (u.pos0 + r < u.cnt) { const int2 tw = lst[r]; const float w = __int_as_float(tw.y); float* rowp = X + (size_t)tw.x * D + col0;
#pragma unroll
                    for (int bj = 0; bj < 2; ++bj)
#pragma unroll
                        for (int n = 0; n < 2; ++n)
#pragma unroll
                            for (int j = 0; j < 4; ++j) unsafeAtomicAdd(rowp + bj * HALF + n * 16 + j, w * acc[ai][bj][m][n][j]); } }
    }
};
struct MoeOrder {
    const PG8_LAS i32x4* tab; int ntiles, npn, G, c; const char* A; size_t atile; const char* Bt; size_t bexp, btile; const int2* lists;
    __device__ __forceinline__ bool next(int i, Unit& u) const {
        const int L = i * G + c; const int T = L / npn; if (T >= ntiles) return false;
        const i32x4 te = tab[T]; u.pm = T; u.pn = L - T * npn; u.e = __builtin_amdgcn_readfirstlane(te.x); u.pos0 = __builtin_amdgcn_readfirstlane(te.y); u.cnt = __builtin_amdgcn_readfirstlane(te.z);
        u.A = A + (size_t)T * atile; u.B = Bt + (size_t)u.e * bexp + (size_t)u.pn * btile; return true;
    }
    __device__ __forceinline__ void aoff(const Unit& u, unsigned (&o0)[2], unsigned (&o1)[2], const int (&Rs)[2], const int (&Cs)[2]) const {
        const int2* lst = lists + (size_t)u.e * NTOK;
#pragma unroll
        for (int i = 0; i < 2; ++i) { const int p0 = u.pos0 + Rs[i], p1 = p0 + HALF;
            const int t0 = (p0 < u.cnt) ? lst[p0].x : 0, t1 = (p1 < u.cnt) ? lst[p1].x : 0;
            o0[i] = (unsigned)t0 * (unsigned)(D * 2) + (unsigned)Cs[i] * 2u; o1[i] = (unsigned)t1 * (unsigned)(D * 2) + (unsigned)Cs[i] * 2u; }
    }
};
}

__device__ __forceinline__ void ph_rmsnorm(const float* src, const float* g, float* dst) {
    const int wave = tid_opaque() >> 6, lane = tid_opaque() & 63;
    const float4* g4 = (const float4*)g;
    for (int r = blockIdx.x * 8 + wave; r < NTOK; r += gridDim.x * 8) {
        const float4* p = (const float4*)(src + (size_t)r * D);
        float4 v[4]; float ss = 0.f;
#pragma unroll
        for (int i = 0; i < 4; ++i) { v[i] = p[lane + 64 * i]; ss += v[i].x * v[i].x + v[i].y * v[i].y + v[i].z * v[i].z + v[i].w * v[i].w; }
        ss = wave_sum(ss);
        const float rs = rsqrtf(ss * (1.f / D) + EPS);
        float4* q = (float4*)(dst + (size_t)r * D);
#pragma unroll
        for (int i = 0; i < 4; ++i) { const float4 gg = g4[lane + 64 * i]; float4 o; o.x = v[i].x * rs * gg.x; o.y = v[i].y * rs * gg.y; o.z = v[i].z * rs * gg.z; o.w = v[i].w * rs * gg.w; q[lane + 64 * i] = o; }
    }
}
__device__ __forceinline__ void ph_norm1(const float* src, const float* g, const float* win, bf16_t* xn, float* z) {
    const int wave = tid_opaque() >> 6, lane = tid_opaque() & 63;
    const float4* g4 = (const float4*)g;
    for (int r = blockIdx.x * 8 + wave; r < NTOK; r += gridDim.x * 8) {
        const float4* p = (const float4*)(src + (size_t)r * D);
        float4 v[4]; float ss = 0.f;
#pragma unroll
        for (int i = 0; i < 4; ++i) { v[i] = p[lane + 64 * i]; ss += v[i].x * v[i].x + v[i].y * v[i].y + v[i].z * v[i].z + v[i].w * v[i].w; }
        ss = wave_sum(ss);
        const float rs = rsqrtf(ss * (1.f / D) + EPS);
        float gt[8];
#pragma unroll
        for (int c = 0; c < 8; ++c) gt[c] = 0.f;
        pg8::u32x2* q = (pg8::u32x2*)(xn + (size_t)r * D);
#pragma unroll
        for (int i = 0; i < 4; ++i) { const float4 gg = g4[lane + 64 * i]; const float o[4] = {v[i].x * rs * gg.x, v[i].y * rs * gg.y, v[i].z * rs * gg.z, v[i].w * rs * gg.w};
            pg8::u32x2 w; w.x = pg8::cvt_pk_bf16(o[0], o[1]); w.y = pg8::cvt_pk_bf16(o[2], o[3]); q[lane + 64 * i] = w;
#pragma unroll
            for (int j = 0; j < 4; ++j) { const float* wr = win + (size_t)((lane + 64 * i) * 4 + j) * INW + ZCI; const float4 w0 = *(const float4*)wr, w1 = *(const float4*)(wr + 4);
                gt[0] += o[j] * w0.x; gt[1] += o[j] * w0.y; gt[2] += o[j] * w0.z; gt[3] += o[j] * w0.w; gt[4] += o[j] * w1.x; gt[5] += o[j] * w1.y; gt[6] += o[j] * w1.z; gt[7] += o[j] * w1.w; } }
#pragma unroll
        for (int c = 0; c < 8; ++c) gt[c] = wave_sum(gt[c]);
        if (lane == 0) { float4* zp = (float4*)(z + (size_t)r * INW + ZCI); zp[0] = make_float4(gt[0], gt[1], gt[2], gt[3]); zp[1] = make_float4(gt[4], gt[5], gt[6], gt[7]); }
    }
}
__device__ __forceinline__ void tc_tile(float* T  , const float* src, int src_ld, int c0, int k0, bf16_t* dst, int K, int n0) {
    const int tid = tid_opaque();
    __syncthreads();
#pragma unroll
    for (int i = 0; i < 2; ++i) { const int kk = (tid >> 4) + 32 * i, c4 = (tid & 15) * 4;
        const float4 v = *(const float4*)(src + (size_t)(k0 + kk) * src_ld + c0 + c4);
        T[kk * 65 + c4] = v.x; T[kk * 65 + c4 + 1] = v.y; T[kk * 65 + c4 + 2] = v.z; T[kk * 65 + c4 + 3] = v.w; }
    __syncthreads();
    const int nl = tid >> 3, kc = (tid & 7) * 8;
    pg8::u32x4 w;
    w.x = pg8::cvt_pk_bf16(T[(kc + 0) * 65 + nl], T[(kc + 1) * 65 + nl]); w.y = pg8::cvt_pk_bf16(T[(kc + 2) * 65 + nl], T[(kc + 3) * 65 + nl]);
    w.z = pg8::cvt_pk_bf16(T[(kc + 4) * 65 + nl], T[(kc + 5) * 65 + nl]); w.w = pg8::cvt_pk_bf16(T[(kc + 6) * 65 + nl], T[(kc + 7) * 65 + nl]);
    *(pg8::u32x4*)(dst + (size_t)(n0 + nl) * K + k0 + kc) = w;
}
__device__ __forceinline__ void ph_prologue(float* lds, const Params& P) {
    constexpr int NJ_EXP = NLAYER * NEXP * 384, NJ_IN = NLAYER * 576, NJ_OUT = NLAYER * 256;
    bf16_t* WIN = (bf16_t*)(P.ws + WS_WIN); bf16_t* WOUT = (bf16_t*)(P.ws + WS_WOUT); bf16_t* WGU = (bf16_t*)(P.ws + WS_WGU); bf16_t* WD = (bf16_t*)(P.ws + WS_WD);
    for (int j = blockIdx.x; j < NJ_EXP + NJ_IN + NJ_OUT; j += gridDim.x) {
        if (j < NJ_EXP) {
            const int le = j / 384, r = j % 384;
            if (r < 256) { const int n0 = (r >> 4) * 64, k0 = (r & 15) * 64, pn = n0 >> 8, within = n0 & 255;
                const float* s = (within < 128 ? P.in[I_EWG] : P.in[I_EWU]) + (size_t)le * D * DE;
                tc_tile(lds, s, DE, pn * 128 + (within & 127), k0, WGU + (size_t)le * 1024 * D, D, n0);
            } else { const int r2 = r - 256, n0 = (r2 >> 3) * 64, k0 = (r2 & 7) * 64;
                tc_tile(lds, P.in[I_EWD] + (size_t)le * DE * D, D, n0, k0, WD + (size_t)le * D * DE, DE, n0); }
        } else if (j < NJ_EXP + NJ_IN) {
            const int j2 = j - NJ_EXP, l = j2 / 576, r = j2 % 576, n0 = (r >> 4) * 64, k0 = (r & 15) * 64;
            tc_tile(lds, P.in[I_WIN] + (size_t)l * D * INW, INW, n0 < ZCI ? n0 : n0 + 8, k0, WIN + (size_t)l * NMAIN * D, D, n0);
        } else {
            const int j3 = j - NJ_EXP - NJ_IN, l = j3 / 256, r = j3 % 256, n0 = (r >> 4) * 64, k0 = (r & 15) * 64;
            tc_tile(lds, P.in[I_WOUT] + (size_t)l * D * D, D, n0, k0, WOUT + (size_t)l * D * D, D, n0);
        }
    }
    __syncthreads();
}

template <bool DUAL, class AF, class EF>
__device__ __forceinline__ void gemm_tile(float* lds, AF arow, int K, const float* B0, const float* B1, int ldb, int n0, int N, EF epi) {
    float* As = lds;
    float* Bs0 = lds + 32 * 132;
    float* Bs1 = Bs0 + 32 * 128;
    const int tid = tid_opaque(), ty = tid >> 4, tx = tid & 15;
    float acc0[4][8], acc1[4][8];
#pragma unroll
    for (int i = 0; i < 4; ++i)
#pragma unroll
        for (int j = 0; j < 8; ++j) { acc0[i][j] = 0.f; acc1[i][j] = 0.f; }
    const float* ap0 = arow((tid >> 3));
    const float* ap1 = arow((tid >> 3) + 64);
    const int akk = (tid & 7) * 4;
    const int bn = n0 + (tid & 31) * 4; const bool bok = bn < N;
    for (int k0 = 0; k0 < K; k0 += 32) {
        const float4 av0 = ap0 ? *(const float4*)(ap0 + k0 + akk) : make_float4(0.f, 0.f, 0.f, 0.f);
        const float4 av1 = ap1 ? *(const float4*)(ap1 + k0 + akk) : make_float4(0.f, 0.f, 0.f, 0.f);
        const int kb0 = k0 + (tid >> 5), kb1 = kb0 + 16;
        const float4 bv00 = bok ? *(const float4*)(B0 + (size_t)kb0 * ldb + bn) : make_float4(0.f, 0.f, 0.f, 0.f);
        const float4 bv01 = bok ? *(const float4*)(B0 + (size_t)kb1 * ldb + bn) : make_float4(0.f, 0.f, 0.f, 0.f);
        const float4 bv10 = (DUAL && bok) ? *(const float4*)(B1 + (size_t)kb0 * ldb + bn) : bv00;
        const float4 bv11 = (DUAL && bok) ? *(const float4*)(B1 + (size_t)kb1 * ldb + bn) : bv01;
        __syncthreads();
        { const int r = (tid >> 3);
          As[(akk + 0) * 132 + r] = av0.x; As[(akk + 1) * 132 + r] = av0.y; As[(akk + 2) * 132 + r] = av0.z; As[(akk + 3) * 132 + r] = av0.w;
          As[(akk + 0) * 132 + r + 64] = av1.x; As[(akk + 1) * 132 + r + 64] = av1.y; As[(akk + 2) * 132 + r + 64] = av1.z; As[(akk + 3) * 132 + r + 64] = av1.w; }
        { const int k = (tid >> 5);
          *(float4*)&Bs0[k * 128 + (tid & 31) * 4] = bv00; *(float4*)&Bs0[(k + 16) * 128 + (tid & 31) * 4] = bv01;
          if (DUAL) { *(float4*)&Bs1[k * 128 + (tid & 31) * 4] = bv10; *(float4*)&Bs1[(k + 16) * 128 + (tid & 31) * 4] = bv11; } }
        __syncthreads();
#pragma unroll 4
        for (int k = 0; k < 32; ++k) {
            const float4 a = *(const float4*)&As[k * 132 + ty * 4];
            const float4 b0 = *(const float4*)&Bs0[k * 128 + tx * 4], b1 = *(const float4*)&Bs0[k * 128 + 64 + tx * 4];
            const float aa[4] = {a.x, a.y, a.z, a.w};
            const float bb[8] = {b0.x, b0.y, b0.z, b0.w, b1.x, b1.y, b1.z, b1.w};
#pragma unroll
            for (int i = 0; i < 4; ++i)
#pragma unroll
                for (int j = 0; j < 8; ++j) acc0[i][j] = fmaf(aa[i], bb[j], acc0[i][j]);
            if (DUAL) {
                const float4 c0 = *(const float4*)&Bs1[k * 128 + tx * 4], c1 = *(const float4*)&Bs1[k * 128 + 64 + tx * 4];
                const float cc[8] = {c0.x, c0.y, c0.z, c0.w, c1.x, c1.y, c1.z, c1.w};
#pragma unroll
                for (int i = 0; i < 4; ++i)
#pragma unroll
                    for (int j = 0; j < 8; ++j) acc1[i][j] = fmaf(aa[i], cc[j], acc1[i][j]);
            }
        }
    }
#pragma unroll
    for (int i = 0; i < 4; ++i)
#pragma unroll
        for (int j = 0; j < 8; ++j) {
            const int r = ty * 4 + i, c = n0 + (j < 4 ? tx * 4 + j : 64 + tx * 4 + (j - 4));
            if (c < N) epi(r, c, acc0[i][j], acc1[i][j]);
        }
    __syncthreads();
}

__device__ __forceinline__ void ph_inproj(LAS unsigned char* ldsb, const bf16_t* xn, const bf16_t* wt, float* z) {
    pg8::StaticOrder S; S.init(NTOK, NMAIN, D, D, gridDim.x, blockIdx.x, xn, wt);
    pg8::EpiZ E{z};
    pg8::gemm_phase<pg8::EpiZ, pg8::StaticOrder, false>(ldsb, D, D, S, E);
}

__device__ __forceinline__ void attn_wave(const float* z, const float* sinks, bf16_t* mix, int u, int lane) {
    const int b = u >> 10, hq = (u >> 8) & 3, t0 = (u & 255) * 32, t = t0 + (lane >> 1), g = hq >> 1, dh = (lane & 1) * 32;
    float q[32];
    { const float4* qp = (const float4*)(z + (size_t)(b * S + t) * INW + ZQ + hq * 64 + dh);
#pragma unroll
      for (int i = 0; i < 8; ++i) { const float4 v = qp[i]; q[4 * i] = v.x * 0.125f; q[4 * i + 1] = v.y * 0.125f; q[4 * i + 2] = v.z * 0.125f; q[4 * i + 3] = v.w * 0.125f; } }
    float m = sinks[hq], l = 1.f; float o[32];
#pragma unroll
    for (int d = 0; d < 32; ++d) o[d] = 0.f;
    const int jlo = (t0 - 127) > 0 ? (t0 - 127) : 0, jhi = t0 + 31;
    for (int j = jlo; j <= jhi; ++j) {
        const float4* kp = (const float4*)(z + (size_t)(b * S + j) * INW + ZK + g * 64 + dh);
        const float4* vp = (const float4*)(z + (size_t)(b * S + j) * INW + ZV + g * 64 + dh);
        float s = 0.f;
#pragma unroll
        for (int i = 0; i < 8; ++i) { const float4 kv = kp[i]; s += q[4 * i] * kv.x + q[4 * i + 1] * kv.y + q[4 * i + 2] * kv.z + q[4 * i + 3] * kv.w; }
        s += __shfl_xor(s, 1);
        const bool valid = (j <= t) && (j > t - 128);
        const float mn = valid ? fmaxf(m, s) : m;
        const float corr = expf(m - mn), p = valid ? expf(s - mn) : 0.f;
        l = l * corr + p; m = mn;
#pragma unroll
        for (int i = 0; i < 8; ++i) { const float4 vv = vp[i];
            o[4 * i] = o[4 * i] * corr + p * vv.x; o[4 * i + 1] = o[4 * i + 1] * corr + p * vv.y; o[4 * i + 2] = o[4 * i + 2] * corr + p * vv.z; o[4 * i + 3] = o[4 * i + 3] * corr + p * vv.w; }
    }
    const float inv = 1.f / l;
    pg8::u32x4* op = (pg8::u32x4*)(mix + (size_t)(b * S + t) * D + hq * 64 + dh);
#pragma unroll
    for (int i = 0; i < 4; ++i) { pg8::u32x4 w; w.x = pg8::cvt_pk_bf16(o[8 * i] * inv, o[8 * i + 1] * inv); w.y = pg8::cvt_pk_bf16(o[8 * i + 2] * inv, o[8 * i + 3] * inv);
        w.z = pg8::cvt_pk_bf16(o[8 * i + 4] * inv, o[8 * i + 5] * inv); w.w = pg8::cvt_pk_bf16(o[8 * i + 6] * inv, o[8 * i + 7] * inv); op[i] = w; }
}

__device__ __forceinline__ void s5_wave(float* wl  , float* z, const Params& P, int l, int u, int lane) {
    const int b = u >> 4, g = u & 15, p = lane;
    float* XS = wl;
    float* CT = wl + 16 * 130;
    const int gp = (l * 16 + g) * 64 + p;
    const float ar = P.in[I_ARE][gp], ai = P.in[I_AIM][gp], dt = expf(P.in[I_LDT][l * 16 + g]);
    const float er = expf(ar * dt); const float abr = er * cosf(ai * dt), abi = er * sinf(ai * dt);
    const float xr_ = abr - 1.f, xi_ = abi, den = ar * ar + ai * ai;
    const float cr = (xr_ * ar + xi_ * ai) / den, ci = (xi_ * ar - xr_ * ai) / den;
    float bbr[16], bbi[16];
#pragma unroll
    for (int h = 0; h < 16; ++h) { const float br = P.in[I_BRE][(size_t)gp * 16 + h], bi = P.in[I_BIM][(size_t)gp * 16 + h]; bbr[h] = cr * br - ci * bi; bbi[h] = cr * bi + ci * br; }
#pragma unroll
    for (int h = 0; h < 16; ++h) { const int ci_ = ((l * 16 + g) * 16 + h) * 64 + p; CT[h * 130 + 2 * p] = P.in[I_CRE][ci_]; CT[h * 130 + 2 * p + 1] = P.in[I_CIM][ci_]; }
    const int tt_o = lane >> 2, hq = lane & 3;
    float dsk[4];
#pragma unroll
    for (int k = 0; k < 4; ++k) dsk[k] = P.in[I_SD][l * 256 + g * 16 + hq * 4 + k];
    float sr = 0.f, si = 0.f;
    wave_lds_fence();
    for (int t0 = 0; t0 < S; t0 += 16) {
#pragma unroll 4
        for (int tt = 0; tt < 16; ++tt) {
            const float4* up = (const float4*)(z + (size_t)(b * S + t0 + tt) * INW + ZSU + g * 16);
            float bur = 0.f, bui = 0.f;
#pragma unroll
            for (int i = 0; i < 4; ++i) { const float4 uu = up[i];
                bur += bbr[4 * i] * uu.x + bbr[4 * i + 1] * uu.y + bbr[4 * i + 2] * uu.z + bbr[4 * i + 3] * uu.w;
                bui += bbi[4 * i] * uu.x + bbi[4 * i + 1] * uu.y + bbi[4 * i + 2] * uu.z + bbi[4 * i + 3] * uu.w; }
            const float nr = abr * sr - abi * si + bur, ni = abr * si + abi * sr + bui; sr = nr; si = ni;
            XS[tt * 130 + 2 * p] = sr; XS[tt * 130 + 2 * p + 1] = si;
        }
        wave_lds_fence();
        float y[4] = {0.f, 0.f, 0.f, 0.f};
        for (int p2 = 0; p2 < 64; ++p2) {
            const float xr = XS[tt_o * 130 + 2 * p2], xi = XS[tt_o * 130 + 2 * p2 + 1];
#pragma unroll
            for (int k = 0; k < 4; ++k) y[k] += CT[(hq * 4 + k) * 130 + 2 * p2] * xr - CT[(hq * 4 + k) * 130 + 2 * p2 + 1] * xi;
        }
        float4* up = (float4*)(z + (size_t)(b * S + t0 + tt_o) * INW + ZSU + g * 16 + hq * 4);
        const float4 uu = *up;
        float4 o; o.x = gelu_tanh(y[0] + dsk[0] * uu.x); o.y = gelu_tanh(y[1] + dsk[1] * uu.y); o.z = gelu_tanh(y[2] + dsk[2] * uu.z); o.w = gelu_tanh(y[3] + dsk[3] * uu.w);
        *up = o;
        wave_lds_fence();
    }
}

namespace ml {
using pg8::bf16x8; using pg8::f32x4; using pg8::u32x4; using pg8::u32x2;
constexpr int L = 128, NCH = S / L, NU = NB * 4 * NCH;
constexpr int QP = 144, TP = 272;
constexpr int OFF_Q = 0, OFF_K = OFF_Q + 128 * QP, OFF_VT = OFF_K + 128 * QP, OFF_KT = OFF_VT + 64 * TP, OFF_F = OFF_KT + 64 * TP;
constexpr int LDS_END = OFF_F + 4 * 128 * 4 + 64;
constexpr size_t O_CL = 0, O_CST = O_CL + (size_t)NU * 4096 * 4, O_NL = O_CST + (size_t)NU * 4096 * 2, O_NST = O_NL + (size_t)NU * 64 * 4,
                 O_MLOC = O_NST + (size_t)NU * 64 * 4, O_BL = O_MLOC + (size_t)NU * 4, O_MST = O_BL + (size_t)NU * 4, O_END = O_MST + (size_t)NU * 4;
__device__ __forceinline__ f32x4 mfma16(bf16x8 a, bf16x8 b, f32x4 c) { return __builtin_amdgcn_mfma_f32_16x16x32_bf16(a, b, c, 0, 0, 0); }
__device__ __forceinline__ float bf_lo(unsigned w) { return __uint_as_float(w << 16); }
__device__ __forceinline__ float bf_hi(unsigned w) { return __uint_as_float(w & 0xffff0000u); }
__device__ __forceinline__ unsigned short bf1(float x) { return (unsigned short)(pg8::cvt_pk_bf16(x, 0.f) & 0xffffu); }

__device__ __forceinline__ void stage_gates(LAS unsigned char* lds, const float* z, const Params& P, int l, int head, int tok0, int tid) {
    LAS float* LF = (LAS float*)(lds + OFF_F); LAS float* IG = LF + 128; LAS float* Bc = LF + 256; LAS float* G2 = LF + 384; LAS float* scal = LF + 512;
    if (tid < 128) { const float* zr = z + (size_t)(tok0 + tid) * INW;
        const float ipre = zr[ZCI + head] + P.in[I_GATEB][l * 8 + head], fpre = zr[ZCF + head] + P.in[I_GATEB][l * 8 + 4 + head];
        LF[tid] = fminf(fpre, 0.f) - log1pf(expf(-fabsf(fpre))); IG[tid] = ipre; }
    __syncthreads();
    if (tid < 64) { const float a = LF[2 * tid], b2 = LF[2 * tid + 1]; const float s = a + b2; float inc = s;
#pragma unroll
        for (int o = 1; o < 64; o <<= 1) { const float v = __shfl_up(inc, o); if (tid >= o) inc += v; }
        const float exc = inc - s; const float b0 = exc + a, b1 = exc + s;
        Bc[2 * tid] = b0; Bc[2 * tid + 1] = b1; const float g0 = IG[2 * tid] - b0, g1 = IG[2 * tid + 1] - b1; G2[2 * tid] = g0; G2[2 * tid + 1] = g1;
        float gm = fmaxf(g0, g1);
#pragma unroll
        for (int o = 32; o > 0; o >>= 1) gm = fmaxf(gm, __shfl_xor(gm, o));
        if (tid == 63) { scal[0] = gm; scal[1] = b1; } }
    __syncthreads();
}
__device__ __forceinline__ void conv8(const float* z, const float* cw, int b, int pos, int which, int head, int c0, float (&o)[8]) {
    const int col = (which ? ZCK : ZCQ) + head * 64 + c0, cc = which * 256 + head * 64 + c0;
    float x[8];
#pragma unroll
    for (int e = 0; e < 8; ++e) x[e] = 0.f;
#pragma unroll
    for (int j = 0; j < 4; ++j) { const int tg = pos - 3 + j;
        if (tg >= 0) { const float4* zp = (const float4*)(z + (size_t)(b * S + tg) * INW + col); const float4 v0 = zp[0], v1 = zp[1];
            const float4 w0 = *(const float4*)(cw + j * 512 + cc), w1 = *(const float4*)(cw + j * 512 + cc + 4);
            x[0] += w0.x * v0.x; x[1] += w0.y * v0.y; x[2] += w0.z * v0.z; x[3] += w0.w * v0.w; x[4] += w1.x * v1.x; x[5] += w1.y * v1.y; x[6] += w1.z * v1.z; x[7] += w1.w * v1.w; } }
    const float sc = which ? 0.125f : 1.f;
#pragma unroll
    for (int e = 0; e < 8; ++e) o[e] = x[e] * sc / (1.f + __expf(-x[e]));
}
__device__ __forceinline__ void stage_vt(LAS unsigned char* lds, const float* z, int head, int tok0, int tid) {
#pragma unroll
    for (int it = 0; it < 2; ++it) { const int idx = tid + it * NTHREADS, s = idx & 127, cg = idx >> 7;
        const float4* zp = (const float4*)(z + (size_t)(tok0 + s) * INW + ZCV + head * 64 + cg * 8); const float4 v0 = zp[0], v1 = zp[1];
        const float vv[8] = {v0.x, v0.y, v0.z, v0.w, v1.x, v1.y, v1.z, v1.w};
#pragma unroll
        for (int e = 0; e < 8; ++e) *(LAS unsigned short*)(lds + OFF_VT + (cg * 8 + e) * TP + s * 2) = bf1(vv[e]); }
}

__device__ __forceinline__ void p1_unit(LAS unsigned char* lds, const float* z, const Params& P, int l, int u, unsigned char* wsm) {
    const int tid = tid_opaque(), lane = tid & 63, wid = __builtin_amdgcn_readfirstlane(tid >> 6), r = lane & 15, qd = lane >> 4;
    const int b = u >> 8, head = (u >> 6) & 3, c = u & 63, tok0 = b * S + c * L;
    LAS float* G2 = (LAS float*)(lds + OFF_F) + 384; LAS float* scal = (LAS float*)(lds + OFF_F) + 512;
    __syncthreads();
    stage_gates(lds, z, P, l, head, tok0, tid);
    const float gmax = scal[0], bL = scal[1];
    stage_vt(lds, z, head, tok0, tid);
    const float* cw = P.in[I_CONVW] + (size_t)l * 4 * 512;
#pragma unroll
    for (int it = 0; it < 2; ++it) { const int idx = tid + it * NTHREADS, s = idx & 127, cg = idx >> 7;
        float o[8]; conv8(z, cw, b, c * L + s, 1, head, cg * 8, o);
        const float ws = __expf(G2[s] - gmax);
#pragma unroll
        for (int e = 0; e < 8; ++e) *(LAS unsigned short*)(lds + OFF_KT + (cg * 8 + e) * TP + s * 2) = bf1(o[e] * ws); }
    __syncthreads();
    const int kt = wid >> 1;
    float* CL = (float*)(wsm + O_CL) + (size_t)u * 4096;
#pragma unroll
    for (int i = 0; i < 2; ++i) { const int vt = (wid & 1) * 2 + i; f32x4 acc = {0.f, 0.f, 0.f, 0.f};
#pragma unroll
        for (int ks = 0; ks < 4; ++ks) { const bf16x8 a = *(const LAS bf16x8*)(lds + OFF_KT + (16 * kt + r) * TP + (32 * ks + 8 * qd) * 2), bb = *(const LAS bf16x8*)(lds + OFF_VT + (16 * vt + r) * TP + (32 * ks + 8 * qd) * 2);
            acc = mfma16(a, bb, acc); }
        *(f32x4*)(CL + (size_t)(16 * vt + r) * 64 + 16 * kt + 4 * qd) = acc; }
    if (tid < 64) { float sum = 0.f;
        for (int s2 = 0; s2 < 128; s2 += 2) { const unsigned w2 = *(const LAS unsigned*)(lds + OFF_KT + tid * TP + s2 * 2); sum += bf_lo(w2) + bf_hi(w2); }
        ((float*)(wsm + O_NL))[(size_t)u * 64 + tid] = sum; }
    if (tid == 0) { ((float*)(wsm + O_MLOC))[u] = bL + gmax; ((float*)(wsm + O_BL))[u] = bL; }
}
__device__ __forceinline__ void p2_scan(unsigned char* wsm) {
    const int tid = tid_opaque();
    const float* CL = (const float*)(wsm + O_CL); const float* NL = (const float*)(wsm + O_NL); const float* MLOC = (const float*)(wsm + O_MLOC); const float* BL = (const float*)(wsm + O_BL);
    bf16_t* CST = (bf16_t*)(wsm + O_CST); float* NST = (float*)(wsm + O_NST); float* MST = (float*)(wsm + O_MST);
    for (int idx = blockIdx.x * NTHREADS + tid; idx < 32 * 4096; idx += gridDim.x * NTHREADS) {
        const int bh = idx >> 12, e = idx & 4095;
        float C = 0.f, nn = 0.f, m = 0.f;
#pragma unroll 4
        for (int c = 0; c < NCH; ++c) { const int u = bh * NCH + c;
            CST[(size_t)u * 4096 + e] = bf1(C);
            if (e < 64) NST[(size_t)u * 64 + e] = nn;
            if (e == 0) MST[u] = m;
            const float mloc = MLOC[u], bL = BL[u], mn = fmaxf(bL + m, mloc), dec = __expf(bL + m - mn), wl = __expf(mloc - mn);
            C = dec * C + wl * CL[(size_t)u * 4096 + e];
            if (e < 64) nn = dec * nn + wl * NL[(size_t)u * 64 + e];
            m = mn; }
    }
}
__device__ __forceinline__ void p3_unit(LAS unsigned char* lds, const float* z, const Params& P, int l, int u, const unsigned char* wsm, bf16_t* mix) {
    const int tid = tid_opaque(), lane = tid & 63, wid = __builtin_amdgcn_readfirstlane(tid >> 6), r = lane & 15, qd = lane >> 4;
    const int b = u >> 8, head = (u >> 6) & 3, c = u & 63, tok0 = b * S + c * L;
    LAS float* Bc = (LAS float*)(lds + OFF_F) + 256; LAS float* G2 = (LAS float*)(lds + OFF_F) + 384;
    __syncthreads();
    stage_gates(lds, z, P, l, head, tok0, tid);
    stage_vt(lds, z, head, tok0, tid);
    const float* cw = P.in[I_CONVW] + (size_t)l * 4 * 512;
#pragma unroll
    for (int it = 0; it < 4; ++it) { const int idx = tid + it * NTHREADS, which = idx >> 10, s = (idx >> 3) & 127, cg = idx & 7;
        float o[8]; conv8(z, cw, b, c * L + s, which, head, cg * 8, o);
        u32x4 w; w.x = pg8::cvt_pk_bf16(o[0], o[1]); w.y = pg8::cvt_pk_bf16(o[2], o[3]); w.z = pg8::cvt_pk_bf16(o[4], o[5]); w.w = pg8::cvt_pk_bf16(o[6], o[7]);
        *(LAS u32x4*)(lds + (which ? OFF_K : OFF_Q) + s * QP + cg * 16) = w; }
    __syncthreads();
    const int w = wid, t = 16 * w + r;
    const bf16x8 bq0 = *(const LAS bf16x8*)(lds + OFF_Q + t * QP + qd * 16), bq1 = *(const LAS bf16x8*)(lds + OFF_Q + t * QP + 64 + qd * 16);
    f32x4 accS[8];
#pragma unroll
    for (int ct = 0; ct < 8; ++ct) { accS[ct] = (f32x4){0.f, 0.f, 0.f, 0.f};
        if (ct <= w) { const bf16x8 a0 = *(const LAS bf16x8*)(lds + OFF_K + (16 * ct + r) * QP + qd * 16), a1 = *(const LAS bf16x8*)(lds + OFF_K + (16 * ct + r) * QP + 64 + qd * 16);
            accS[ct] = mfma16(a0, bq0, accS[ct]); accS[ct] = mfma16(a1, bq1, accS[ct]); } }
    const float bt = Bc[t], mst = ((const float*)(wsm + O_MST))[u];
    float ld[8][4]; float mloc = -3.0e38f;
#pragma unroll
    for (int ct = 0; ct < 8; ++ct) { const f32x4 g = *(const LAS f32x4*)(G2 + 16 * ct + 4 * qd);
#pragma unroll
        for (int j = 0; j < 4; ++j) { const bool valid = (ct < w) || (ct == w && 4 * qd + j <= r); ld[ct][j] = valid ? bt + g[j] : -3.0e38f; mloc = fmaxf(mloc, ld[ct][j]); } }
    mloc = fmaxf(mloc, __shfl_xor(mloc, 16)); mloc = fmaxf(mloc, __shfl_xor(mloc, 32));
    const float mt = fmaxf(bt + mst, mloc);
    float den = 0.f;
#pragma unroll
    for (int ct = 0; ct < 8; ++ct)
#pragma unroll
        for (int j = 0; j < 4; ++j) { const float pe = __expf(ld[ct][j] - mt) * accS[ct][j]; accS[ct][j] = pe; den += pe; }
    den += __shfl_xor(den, 16); den += __shfl_xor(den, 32);
    const bf16_t* cst = (const bf16_t*)(wsm + O_CST) + (size_t)u * 4096; const float* nst = (const float*)(wsm + O_NST) + (size_t)u * 64;
    f32x4 accN[4];
#pragma unroll
    for (int dt = 0; dt < 4; ++dt) { const bf16x8 c0 = *(const bf16x8*)(cst + (16 * dt + r) * 64 + 8 * qd), c1 = *(const bf16x8*)(cst + (16 * dt + r) * 64 + 32 + 8 * qd);
        accN[dt] = mfma16(c0, bq0, (f32x4){0.f, 0.f, 0.f, 0.f}); accN[dt] = mfma16(c1, bq1, accN[dt]); }
    const float winter = __expf(bt + mst - mt);
    float nq = 0.f;
    { const float4 n0 = *(const float4*)(nst + 8 * qd), n1 = *(const float4*)(nst + 8 * qd + 4), n2 = *(const float4*)(nst + 32 + 8 * qd), n3 = *(const float4*)(nst + 36 + 8 * qd);
      const u32x4 q0 = __builtin_bit_cast(u32x4, bq0), q1 = __builtin_bit_cast(u32x4, bq1);
      nq = bf_lo(q0.x) * n0.x + bf_hi(q0.x) * n0.y + bf_lo(q0.y) * n0.z + bf_hi(q0.y) * n0.w + bf_lo(q0.z) * n1.x + bf_hi(q0.z) * n1.y + bf_lo(q0.w) * n1.z + bf_hi(q0.w) * n1.w
         + bf_lo(q1.x) * n2.x + bf_hi(q1.x) * n2.y + bf_lo(q1.y) * n2.z + bf_hi(q1.y) * n2.w + bf_lo(q1.z) * n3.x + bf_hi(q1.z) * n3.y + bf_lo(q1.w) * n3.z + bf_hi(q1.w) * n3.w; }
    nq += __shfl_xor(nq, 16); nq += __shfl_xor(nq, 32);
    den += winter * nq;
#pragma unroll
    for (int dt = 0; dt < 4; ++dt) accN[dt] = accN[dt] * winter;
#pragma unroll
    for (int kk = 0; kk < 4; ++kk) if (2 * kk <= w) {
        u32x4 pw; pw.x = pg8::cvt_pk_bf16(accS[2 * kk][0], accS[2 * kk][1]); pw.y = pg8::cvt_pk_bf16(accS[2 * kk][2], accS[2 * kk][3]);
        pw.z = pg8::cvt_pk_bf16(accS[2 * kk + 1][0], accS[2 * kk + 1][1]); pw.w = pg8::cvt_pk_bf16(accS[2 * kk + 1][2], accS[2 * kk + 1][3]);
        const bf16x8 pf = __builtin_bit_cast(bf16x8, pw);
#pragma unroll
        for (int dt = 0; dt < 4; ++dt) { const u32x2 v0 = *(const LAS u32x2*)(lds + OFF_VT + (16 * dt + r) * TP + (32 * kk + 4 * qd) * 2), v1 = *(const LAS u32x2*)(lds + OFF_VT + (16 * dt + r) * TP + (32 * kk + 16 + 4 * qd) * 2);
            u32x4 vw; vw.x = v0.x; vw.y = v0.y; vw.z = v1.x; vw.w = v1.y;
            accN[dt] = mfma16(__builtin_bit_cast(bf16x8, vw), pf, accN[dt]); } }
    const float inv = 1.f / fmaxf(fabsf(den), __expf(-mt));
    float ss = 0.f;
#pragma unroll
    for (int dt = 0; dt < 4; ++dt) { accN[dt] = accN[dt] * inv; ss += accN[dt][0] * accN[dt][0] + accN[dt][1] * accN[dt][1] + accN[dt][2] * accN[dt][2] + accN[dt][3] * accN[dt][3]; }
    ss += __shfl_xor(ss, 16); ss += __shfl_xor(ss, 32);
    const float rs = rsqrtf(ss * (1.f / 64.f) + EPS);
    const float* ng = P.in[I_MNG] + l * 256 + head * 64; const float* cop = z + (size_t)(tok0 + t) * INW + ZCO + head * 64;
    bf16_t* op = mix + (size_t)(tok0 + t) * D + 512 + head * 64;
#pragma unroll
    for (int dt = 0; dt < 4; ++dt) { const int d0 = 16 * dt + 4 * qd; const float4 g = *(const float4*)(ng + d0), co = *(const float4*)(cop + d0);
        u32x2 o; o.x = pg8::cvt_pk_bf16(accN[dt][0] * rs * g.x / (1.f + __expf(-co.x)), accN[dt][1] * rs * g.y / (1.f + __expf(-co.y)));
        o.y = pg8::cvt_pk_bf16(accN[dt][2] * rs * g.z / (1.f + __expf(-co.z)), accN[dt][3] * rs * g.w / (1.f + __expf(-co.w)));
        *(u32x2*)(op + d0) = o; }
}
static_assert(O_END <= 64 * MiB && LDS_END <= 128 * 1024, "mLSTM scratch fits");
}

__device__ __forceinline__ void sgu_ln_wave(float* z, const float* lng, const float* lnb, int tok, int lane) {
    float4* p = (float4*)(z + (size_t)tok * INW + ZGV) + lane;
    float4 v = *p; v.x = gelu_tanh(v.x); v.y = gelu_tanh(v.y); v.z = gelu_tanh(v.z); v.w = gelu_tanh(v.w);
    const float mu = wave_sum(v.x + v.y + v.z + v.w) * (1.f / 256.f);
    const float dx = v.x - mu, dy = v.y - mu, dz = v.z - mu, dw = v.w - mu;
    const float var = wave_sum(dx * dx + dy * dy + dz * dz + dw * dw) * (1.f / 256.f);
    const float rs = rsqrtf(var + EPS);
    const float4 g = ((const float4*)lng)[lane], bb = ((const float4*)lnb)[lane];
    *p = make_float4(dx * rs * g.x + bb.x, dy * rs * g.y + bb.y, dz * rs * g.z + bb.z, dw * rs * g.w + bb.w);
}

__device__ __forceinline__ void ph_mix1(float* lds, const Params& P, int l, float* z, bf16_t* mix, unsigned char* wsm) {
    const int G = gridDim.x, bid = blockIdx.x, wave = tid_opaque() >> 6, lane = tid_opaque() & 63;
    for (int u = bid; u < ml::NU; u += G) ml::p1_unit((LAS unsigned char*)lds, z, P, l, u, wsm);
    __syncthreads();
    {
        const int rb = G - 1 - bid;
        for (int u = rb * 8 + wave; u < 128; u += G * 8) s5_wave(lds + wave * (2 * 16 * 130), z, P, l, u, lane);
    }
    const bool split = (G >= 96);
    const int nlight = split ? G - 48 : G, lid = split ? bid - 32 : bid;
    if (lid >= 0 && lid < nlight) {
        const float* sinks = P.in[I_SINK] + l * 4;
        for (int u = lid * 8 + wave; u < 8192; u += nlight * 8) attn_wave(z, sinks, mix, u, lane);
        for (int tok = lid * 8 + wave; tok < NTOK; tok += nlight * 8) sgu_ln_wave(z, P.in[I_LNG] + l * 256, P.in[I_LNB] + l * 256, tok, lane);
    }
}

__device__ __forceinline__ void ph_mix2(float* lds, const Params& P, int l, const float* z, bf16_t* mix, const unsigned char* wsm) {
    const int wave = tid_opaque() >> 6, lane = tid_opaque() & 63, tid = tid_opaque();
    const float* gw = P.in[I_GLUW] + (size_t)l * 256 * 256; const float* gb = P.in[I_GLUB] + l * 256;
    for (int u = blockIdx.x; u < (NTOK / 128) * 2; u += gridDim.x) {
        const int m0 = (u >> 1) * 128, n0 = (u & 1) * 128;
        gemm_tile<false>(lds, [&](int r) { return z + (size_t)(m0 + r) * INW + ZSU; }, 256, gw, gw, 256, n0, 256,
                         [&](int r, int c, float v, float) { const float y = z[(size_t)(m0 + r) * INW + ZSU + c]; mix[(size_t)(m0 + r) * D + 256 + c] = (bf16_t)(pg8::cvt_pk_bf16(y * sigm(v + gb[c]), 0.f) & 0xffffu); });
    }
    for (int u = blockIdx.x; u < ml::NU; u += gridDim.x) ml::p3_unit((LAS unsigned char*)lds, z, P, l, u, wsm, mix);
    __syncthreads();
    const float* sw = P.in[I_SGUW] + (size_t)l * 4 * 128 * 128; const float* sb = P.in[I_SGUB] + l * 4 * 128;
    for (int u = blockIdx.x; u < NTOK / 128; u += gridDim.x) {
        const int tok0 = u * 128;
        __syncthreads();
        for (int idx = tid; idx < 128 * 64; idx += NTHREADS) { const int s = idx >> 6, c4 = idx & 63;
            *(float4*)&lds[s * 256 + c4 * 4] = *((const float4*)(z + (size_t)(tok0 + s) * INW + ZGV) + c4); }
        __syncthreads();
        const int c = tid & 255, half = tid >> 8, g = c >> 6;
        for (int tt = 0; tt < 64; ++tt) {
            const int t = half * 64 + tt;
            const float* wr = sw + ((size_t)g * 128 + t) * 128;
            float acc = 0.f;
            for (int s = 0; s <= t; ++s) acc += wr[s] * lds[s * 256 + c];
            const float gu = z[(size_t)(tok0 + t) * INW + ZGU + c];
            mix[(size_t)(tok0 + t) * D + 768 + c] = (bf16_t)(pg8::cvt_pk_bf16(gelu_tanh(gu) * (acc + sb[g * 128 + t]), 0.f) & 0xffffu);
        }
    }
    __syncthreads();
}

__device__ __forceinline__ void ph_outproj(LAS unsigned char* ldsb, const bf16_t* mix, const bf16_t* wt, const float* xsrc, float* xout) {
    pg8::StaticOrder S; S.init(NTOK, D, D, D, gridDim.x, blockIdx.x, mix, wt);
    pg8::EpiRes E{xsrc, xout};
    pg8::gemm_phase<pg8::EpiRes, pg8::StaticOrder, false>(ldsb, D, D, S, E);
}

__device__ __forceinline__ void ph_norm_router(const Params& P, int l, const float* x, bf16_t* H, unsigned* cnt, int2* lists) {
    const int wave = tid_opaque() >> 6, lane = tid_opaque() & 63;
    const float* gn = P.in[I_NFG] + l * D;
    const float* wg = P.in[I_RGW] + (size_t)l * D * 4; const float* we = P.in[I_REW] + (size_t)l * D * 32;
    const float* bg = P.in[I_RGB] + l * 4; const float* be = P.in[I_REB] + l * 32;
    for (int r = blockIdx.x * 8 + wave; r < NTOK; r += gridDim.x * 8) {
        const float* xr = x + (size_t)r * D; bf16_t* hr = H + (size_t)r * D;
        float ss = 0.f;
        { const float4* p = (const float4*)xr;
#pragma unroll
          for (int i = 0; i < 4; ++i) { const float4 v = p[lane + 64 * i]; ss += v.x * v.x + v.y * v.y + v.z * v.z + v.w * v.w; } }
        ss = wave_sum(ss);
        const float rs = rsqrtf(ss * (1.f / D) + EPS);
        float lg[36];
#pragma unroll
        for (int c = 0; c < 36; ++c) lg[c] = 0.f;
#pragma unroll 1
        for (int kk = 0; kk < 16; ++kk) {
            const int k = kk * 64 + lane;
            const float hv = xr[k] * rs * gn[k];
            hr[k] = (bf16_t)(pg8::cvt_pk_bf16(hv, 0.f) & 0xffffu);
            const float4 w4 = *(const float4*)(wg + (size_t)k * 4);
            lg[0] += hv * w4.x; lg[1] += hv * w4.y; lg[2] += hv * w4.z; lg[3] += hv * w4.w;
#pragma unroll
            for (int e4 = 0; e4 < 8; ++e4) { const float4 w = *(const float4*)(we + (size_t)k * 32 + e4 * 4);
                lg[4 + e4 * 4] += hv * w.x; lg[5 + e4 * 4] += hv * w.y; lg[6 + e4 * 4] += hv * w.z; lg[7 + e4 * 4] += hv * w.w; }
        }
#pragma unroll
        for (int c = 0; c < 36; ++c) lg[c] = wave_sum(lg[c]);
        if (lane == 0) {
            float gl[4];
#pragma unroll
            for (int j = 0; j < 4; ++j) gl[j] = lg[j] + bg[j];
            int sel = 0; float gm = gl[0];
#pragma unroll
            for (int j = 1; j < 4; ++j) if (gl[j] > gm) { gm = gl[j]; sel = j; }
            float gs = 0.f;
#pragma unroll
            for (int j = 0; j < 4; ++j) gs += expf(gl[j] - gm);
            const float pg = 1.f / gs;
            float ein[8];
#pragma unroll
            for (int j = 0; j < 8; ++j) { const float a0 = lg[4 + j] + be[j], a1 = lg[12 + j] + be[8 + j], a2 = lg[20 + j] + be[16 + j], a3 = lg[28 + j] + be[24 + j];
                ein[j] = sel == 0 ? a0 : (sel == 1 ? a1 : (sel == 2 ? a2 : a3)); }
            int i1 = 0; float v1 = ein[0];
#pragma unroll
            for (int j = 1; j < 8; ++j) if (ein[j] > v1) { v1 = ein[j]; i1 = j; }
            int i2 = -1; float v2 = -3.0e38f;
#pragma unroll
            for (int j = 0; j < 8; ++j) if (j != i1 && ein[j] > v2) { v2 = ein[j]; i2 = j; }
            const float e2 = expf(v2 - v1), den = 1.f / (1.f + e2);
            const float w1 = den * pg, w2 = e2 * den * pg;
            const int ex1 = sel * 8 + i1, ex2 = sel * 8 + i2;
            const unsigned p1 = atomicAdd(&cnt[ex1], 1u), p2 = atomicAdd(&cnt[ex2], 1u);
            lists[(size_t)ex1 * NTOK + p1] = make_int2(r, __float_as_int(w1));
            lists[(size_t)ex2 * NTOK + p2] = make_int2(r, __float_as_int(w2));
        }
    }
}

__device__ __forceinline__ int moe_build_tab(LAS unsigned char* ldsb, const unsigned* cnt) {
    LAS pg8::i32x4* tab = (LAS pg8::i32x4*)(ldsb + TAB_OFF);
    __syncthreads();
    int base = 0;
#pragma unroll 1
    for (int e = 0; e < NEXP; ++e) { const int c = __builtin_amdgcn_readfirstlane((int)cnt[e]), nt = (c + 255) >> 8;
        if ((int)tid_opaque() < nt) tab[base + tid_opaque()] = (pg8::i32x4){e, (int)tid_opaque() * 256, c, 0};
        base += nt; }
    __syncthreads();
    return base;
}
__device__ __forceinline__ void ph_moe1(LAS unsigned char* ldsb, const Params& P, int l, const bf16_t* H, const unsigned* cnt, const int2* lists, bf16_t* act) {
    const int ntiles = moe_build_tab(ldsb, cnt);
    pg8::MoeOrder S; S.tab = (const LAS pg8::i32x4*)(ldsb + TAB_OFF); S.ntiles = ntiles; S.npn = 4; S.G = gridDim.x; S.c = blockIdx.x;
    S.A = (const char*)H; S.atile = 0; S.Bt = (const char*)(P.ws + WS_WGU) + (size_t)l * NEXP * 1024 * D * 2; S.bexp = (size_t)1024 * D * 2; S.btile = (size_t)256 * D * 2; S.lists = lists;
    pg8::EpiAct E{act};
    pg8::gemm_phase<pg8::EpiAct, pg8::MoeOrder, true>(ldsb, D, D, S, E);
}
__device__ __forceinline__ void ph_moe2(LAS unsigned char* ldsb, const Params& P, int l, const bf16_t* act, const unsigned* cnt, const int2* lists, float* x) {
    const int ntiles = moe_build_tab(ldsb, cnt);
    pg8::MoeOrder S; S.tab = (const LAS pg8::i32x4*)(ldsb + TAB_OFF); S.ntiles = ntiles; S.npn = 4; S.G = gridDim.x; S.c = blockIdx.x;
    S.A = (const char*)act; S.atile = (size_t)256 * DE * 2; S.Bt = (const char*)(P.ws + WS_WD) + (size_t)l * NEXP * D * DE * 2; S.bexp = (size_t)D * DE * 2; S.btile = (size_t)256 * DE * 2; S.lists = lists;
    pg8::EpiDown E{x, lists};
    pg8::gemm_phase<pg8::EpiDown, pg8::MoeOrder, false>(ldsb, DE, DE, S, E);
}

__global__ void __launch_bounds__(NTHREADS, 2) fwd_kernel(Params P) {
    extern __shared__ __attribute__((aligned(16))) unsigned char lds_raw[];
    float* lds = (float*)lds_raw;
    volatile LAS unsigned* xbw = (volatile LAS unsigned*)(lds_raw + LDS_BYTES - 16);
    if (threadIdx.x == 0) { xbw[0] = 0u; xbw[1] = 0u; }
    __syncthreads();
    unsigned* ctl = (unsigned*)(P.ws + WS_CTL);
    const bool multi = (P.ph_hi - P.ph_lo) > 1;
    XcdBarrier bar; bar.bar = ctl; bar.x = 0; bar.st = xbw;
    if (multi) bar = xcd_barrier_post(ctl, xbw);
    float* z = (float*)(P.ws + WS_Z); bf16_t* mix = (bf16_t*)(P.ws + WS_MIX); unsigned char* wsm = P.ws + WS_HRAW;
    bf16_t* H = (bf16_t*)(P.ws + WS_H); bf16_t* act = (bf16_t*)(P.ws + WS_ACT);
    int2* lists = (int2*)(P.ws + WS_LIST);
    LAS unsigned char* ldsb = (LAS unsigned char*)lds_raw;
    const int lo = P.ph_lo, hi = P.ph_hi;
#define IN(k) (lo <= (k) && (k) < hi)
#define SEAM(k) do { if (IN(k) && IN((k) + 1)) xcd_barrier(bar); } while (0)
    if (IN(0)) { ph_prologue(lds, P); } SEAM(0);
    for (int l = 0; l < NLAYER; ++l) {
        const int pb = 1 + l * PH_PER_LAYER;
        const float* xsrc = (l == 0) ? P.in[I_X] : P.out;
        unsigned* cnt = ctl + CW_CNT + l * 64;
        if (IN(pb + 0)) { ph_norm1(xsrc, P.in[I_NMG] + l * D, P.in[I_WIN] + (size_t)l * D * INW, mix, z); } SEAM(pb + 0);
        if (IN(pb + 1)) { ph_inproj(ldsb, mix, (const bf16_t*)(P.ws + WS_WIN) + (size_t)l * NMAIN * D, z); } SEAM(pb + 1);
        if (IN(pb + 2)) { ph_mix1(lds, P, l, z, mix, wsm); } SEAM(pb + 2);
        if (IN(pb + 3)) { ml::p2_scan(wsm); } SEAM(pb + 3);
        if (IN(pb + 4)) { ph_mix2(lds, P, l, z, mix, wsm); } SEAM(pb + 4);
        if (IN(pb + 5)) { ph_outproj(ldsb, mix, (const bf16_t*)(P.ws + WS_WOUT) + (size_t)l * D * D, xsrc, P.out); } SEAM(pb + 5);
        if (IN(pb + 6)) { ph_norm_router(P, l, P.out, H, cnt, lists); } SEAM(pb + 6);
        if (IN(pb + 7)) { ph_moe1(ldsb, P, l, H, cnt, lists, act); } SEAM(pb + 7);
        if (IN(pb + 8)) { ph_moe2(ldsb, P, l, act, cnt, lists, P.out); } SEAM(pb + 8);
    }
    if (IN(1 + NLAYER * PH_PER_LAYER)) ph_rmsnorm(P.out, P.in[I_NFIN], P.out);
#undef IN
#undef SEAM
}

#ifndef N_LAUNCH_MODE
#define N_LAUNCH_MODE 1
#endif
extern "C" void kernel_launch(void* const* d_in, const int* in_sizes, int n_in, void* d_out, int out_size, void* d_ws, size_t ws_size, hipStream_t stream) {
    static int grid = 0;
    if (grid == 0) {
        if (n_in != 31 || out_size != NTOK * D || ws_size < WS_END) { fprintf(stderr, "kernel_launch: unexpected shapes n_in %d out %d ws %zu (need %zu)\n", n_in, out_size, ws_size, (size_t)WS_END); grid = -1; return; }
        int dev = 0, cus = 0, per_cu = 0;
        if (hipGetDevice(&dev) != hipSuccess || hipDeviceGetAttribute(&cus, hipDeviceAttributeMultiprocessorCount, dev) != hipSuccess) { grid = -1; return; }
        if (hipFuncSetAttribute((const void*)fwd_kernel, hipFuncAttributeMaxDynamicSharedMemorySize, LDS_BYTES) != hipSuccess) { fprintf(stderr, "kernel_launch: hipFuncSetAttribute failed\n"); grid = -1; return; }
        if (hipOccupancyMaxActiveBlocksPerMultiprocessor(&per_cu, (const void*)fwd_kernel, NTHREADS, LDS_BYTES) != hipSuccess || per_cu < 1) { fprintf(stderr, "kernel_launch: occupancy query says %d\n", per_cu); }
        (void)hipGetLastError();
        grid = cus;
    }
    if (grid < 0) return;
    (void)hipMemsetAsync((char*)d_ws + WS_CTL, 0, CTL_BYTES, stream);
    Params p{};
    for (int i = 0; i < 31; ++i) p.in[i] = (const float*)d_in[i];
    p.out = (float*)d_out; p.ws = (unsigned char*)d_ws;
#if N_LAUNCH_MODE == 1
    p.ph_lo = 0; p.ph_hi = N_PHASES;
    hipLaunchKernelGGL(fwd_kernel, dim3(grid), dim3(NTHREADS), LDS_BYTES, stream, p);
#else
    for (int ph = 0; ph < N_PHASES; ++ph) { p.ph_lo = ph; p.ph_hi = ph + 1; hipLaunchKernelGGL(fwd_kernel, dim3(grid), dim3(NTHREADS), LDS_BYTES, stream, p); }
#endif
}
```

```cpp
#include <hip/hip_runtime.h>
#include <stdint.h>
#include <stdio.h>

#define LAS __attribute__((address_space(3)))

constexpr int D = 1024, NB = 8, S = 8192, NTOK = NB * S, INW = 2312, NLAYER = 2;
constexpr int NEXP = 32, DE = 512;
constexpr float EPS = 1e-6f;
constexpr int ZW = 2304;
constexpr int ZQ = 0, ZK = 256, ZV = 384, ZSU = 512, ZCQ = 768, ZCK = 1024, ZCV = 1280, ZCO = 1536, ZGU = 1792, ZGV = 2048, WCI = 1536;
constexpr int NTHREADS = 512;
constexpr int LDS_BYTES = 144 * 1024;
constexpr int TAB_OFF = 128 * 1024;
constexpr int PH_PER_LAYER = 9, N_PHASES = 1 + NLAYER * PH_PER_LAYER + 1;
constexpr int NMAIN = 2304;
typedef unsigned short bf16_t;

constexpr size_t MiB = 1u << 20;
constexpr size_t WS_CTL = 0, CTL_BYTES = 1 * MiB;
constexpr size_t WS_Z = WS_CTL + CTL_BYTES;
constexpr size_t Z_BYTES = (size_t)NTOK * ZW * 2;
constexpr size_t WS_H = WS_Z;
constexpr size_t WS_ACT = WS_Z + (size_t)NTOK * D * 2;
constexpr int PMAX = 2 * NTOK + NEXP * 256;
static_assert((size_t)NTOK * D * 2 + (size_t)PMAX * DE * 2 <= Z_BYTES, "alias fits");
constexpr size_t WS_MIX = WS_Z + Z_BYTES;
constexpr size_t WS_HRAW = WS_MIX + (size_t)NTOK * D * 2;
constexpr size_t WS_S5 = WS_HRAW + 64 * MiB;
constexpr size_t WS_GATES = WS_S5 + 48 * MiB;
constexpr size_t WS_LIST = WS_GATES + (size_t)NTOK * 8 * 4;
constexpr size_t WS_WIN = WS_LIST + (size_t)NEXP * NTOK * 8;
constexpr size_t WS_WOUT = WS_WIN + (size_t)NLAYER * NMAIN * D * 2;
constexpr size_t WS_WGU = WS_WOUT + (size_t)NLAYER * D * D * 2;
constexpr size_t WS_WD = WS_WGU + (size_t)NLAYER * NEXP * 1024 * D * 2;
constexpr size_t WS_TB = WS_WD + (size_t)NLAYER * NEXP * D * DE * 2;
constexpr size_t WS_END = WS_TB + (size_t)NLAYER * 4 * MiB;
namespace s5 {
constexpr size_t T_KMAT = 0, T_F = T_KMAT + (size_t)16 * 16 * 256 * 2, T_G = T_F + (size_t)16 * 256 * 128 * 2, T_A16 = T_G + (size_t)16 * 128 * 256 * 2,
                 T_GLUW = T_A16 + (size_t)16 * 64 * 8, T_LAYER = T_GLUW + (size_t)256 * 256 * 2;
}
constexpr int CW_CNT = 8192;

#define XB_TMO      128
#define XB_XCNT(j)  (256  + 64 * (j))
#define XB_XSUB(j)  (1280 + 64 * (j))
#define XB_XGEN(j)  (2304 + 64 * (j))
#define XB_TOP      3328
#define XB_TOPGEN   3392
#define XCD_BAR_WORDS 3456
#define XB_SPIN_CAP (1u << 22)
__device__ __forceinline__ unsigned xb_ld(unsigned* p)              { return __hip_atomic_load(p, __ATOMIC_RELAXED, __HIP_MEMORY_SCOPE_AGENT); }
__device__ __forceinline__ unsigned xb_add(unsigned* p, unsigned v) { return __hip_atomic_fetch_add(p, v, __ATOMIC_RELAXED, __HIP_MEMORY_SCOPE_AGENT); }
__device__ __forceinline__ unsigned xb_xcc_id() { return (unsigned)__builtin_amdgcn_s_getreg((3 << 11) | 20) & 0xFu; }
#define XB_SPIN(cond, bar) do { unsigned _sp = 0; while (cond) { __builtin_amdgcn_s_sleep(1); \
    if ((++_sp & 255u) == 0u) { if (xb_ld(&(bar)[XB_TMO])) break; if (_sp > XB_SPIN_CAP) { atomicAdd(&(bar)[XB_TMO], 1u); break; } } } } while (0)
struct XcdBarrier { unsigned* bar; unsigned x; volatile LAS unsigned* st; };
__device__ __forceinline__ XcdBarrier xcd_barrier_post(unsigned* bar, volatile LAS unsigned* st) {
    XcdBarrier b; b.bar = bar; b.x = xb_xcc_id(); b.st = st;
    if (threadIdx.x == 0) (void)xb_add(&bar[XB_XCNT(b.x)], 1u);
    return b;
}
__device__ __forceinline__ void xcd_barrier_complete(unsigned* bar, unsigned x, unsigned& nloc, unsigned& nx) {
    const unsigned G = gridDim.x * gridDim.y * gridDim.z;
    unsigned sum, cnt, mine, sp = 0u;
    for (;;) {
        sum = 0u; cnt = 0u; mine = 0u;
#pragma unroll
        for (unsigned j = 0; j < 16; ++j) { const unsigned c = xb_ld(&bar[XB_XCNT(j)]); sum += c; cnt += (c > 0u) ? 1u : 0u; mine = (j == x) ? c : mine; }
        if (sum == G) break;
        __builtin_amdgcn_s_sleep(1);
        if ((++sp & 255u) == 0u) { if (xb_ld(&bar[XB_TMO])) break; if (sp > XB_SPIN_CAP) { atomicAdd(&bar[XB_TMO], 1u); break; } }
    }
    nloc = mine > 0u ? mine : 1u; nx = cnt > 0u ? cnt : 1u;
}
__device__ __forceinline__ void xcd_barrier(const XcdBarrier& b) {
    asm volatile("s_waitcnt vmcnt(0)" ::: "memory");
    __syncthreads();
    if (threadIdx.x == 0) {
        unsigned* bar = b.bar;
        __builtin_amdgcn_s_waitcnt(0);
        unsigned nloc = b.st[0], nx = b.st[1];
        if (nloc == 0u) { xcd_barrier_complete(bar, b.x, nloc, nx); b.st[0] = nloc; b.st[1] = nx; }
        const unsigned old = xb_add(&bar[XB_XSUB(b.x)], 1u);
        const unsigned gen = old / nloc;
        if (old + 1u == (gen + 1u) * nloc) {
            __builtin_amdgcn_fence(__ATOMIC_RELEASE, "agent");
            asm volatile("s_waitcnt vmcnt(0)" ::: "memory");
            const unsigned og = xb_add(&bar[XB_TOP], 1u);
            const unsigned tg = og / nx;
            if (og + 1u == (tg + 1u) * nx) xb_add(&bar[XB_TOPGEN], 1u);
            else XB_SPIN(xb_ld(&bar[XB_TOPGEN]) == tg, bar);
            __builtin_amdgcn_fence(__ATOMIC_ACQUIRE, "agent");
            xb_add(&bar[XB_XGEN(b.x)], 1u);
            asm volatile("s_waitcnt vmcnt(0)" ::: "memory");
        } else {
            XB_SPIN(xb_ld(&bar[XB_XGEN(b.x)]) == gen, bar);
            __builtin_amdgcn_fence(__ATOMIC_ACQUIRE, "agent");
            asm volatile("s_waitcnt vmcnt(0)" ::: "memory");
        }
    }
    __syncthreads();
}

__device__ __forceinline__ int tid_opaque() { int t = threadIdx.x; asm volatile("" : "+v"(t)); return t; }
__device__ __forceinline__ float wave_sum(float v) {
#pragma unroll
    for (int o = 32; o > 0; o >>= 1) v += __shfl_xor(v, o);
    return v;
}
__device__ __forceinline__ float gelu_tanh(float x) {
    const float u = 0.7978845608028654f * (x + 0.044715f * x * x * x);
    return 0.5f * x * (1.f + tanhf(u));
}
__device__ __forceinline__ float sigm(float x) { return 1.f / (1.f + expf(-x)); }
__device__ __forceinline__ float bfl(unsigned w) { return __uint_as_float(w << 16); }
__device__ __forceinline__ float bfh(unsigned w) { return __uint_as_float(w & 0xffff0000u); }
typedef unsigned u32x4_t __attribute__((ext_vector_type(4)));
typedef unsigned u32x2_t __attribute__((ext_vector_type(2)));
__device__ __forceinline__ void ld8(const bf16_t* p, float (&o)[8]) { const u32x4_t w = *(const u32x4_t*)p; o[0] = bfl(w.x); o[1] = bfh(w.x); o[2] = bfl(w.y); o[3] = bfh(w.y); o[4] = bfl(w.z); o[5] = bfh(w.z); o[6] = bfl(w.w); o[7] = bfh(w.w); }
__device__ __forceinline__ void wave_lds_fence() {
    __builtin_amdgcn_fence(__ATOMIC_RELEASE, "wavefront"); __builtin_amdgcn_wave_barrier(); __builtin_amdgcn_fence(__ATOMIC_ACQUIRE, "wavefront");
}

struct Params {
    const float* in[31];
    float* out;
    unsigned char* ws;
    int ph_lo, ph_hi;
};
enum { I_X = 0, I_NMG, I_WIN, I_SINK, I_ARE, I_AIM, I_BRE, I_BIM, I_CRE, I_CIM, I_SD, I_LDT, I_GLUW, I_GLUB, I_CONVW, I_GATEB, I_MNG,
       I_LNG, I_LNB, I_SGUW, I_SGUB, I_WOUT, I_NFG, I_RGW, I_RGB, I_REW, I_REB, I_EWG, I_EWU, I_EWD, I_NFIN };

namespace pg8 {
#define PG8_LAS __attribute__((address_space(3)))
typedef short bf16x8 __attribute__((ext_vector_type(8)));
typedef float f32x4 __attribute__((ext_vector_type(4)));
typedef unsigned u32x4 __attribute__((ext_vector_type(4)));
typedef unsigned u32x2 __attribute__((ext_vector_type(2)));
typedef int i32x4 __attribute__((ext_vector_type(4)));
constexpr int BM = 256, BK = 64, HALF = 128, HTB = HALF * BK * 2, STAGE_BYTES = 8 * HTB, NXCD = 8, WGM = 8;
__host__ __device__ __forceinline__ int lds_byte(int r, int c) { const int st = (r >> 4) * 2 + (c >> 5), rr = r & 15, cc = c & 31, ob = rr * 64 + cc * 2; return st * 1024 + (ob ^ (((ob >> 9) & 1) << 5)); }
__host__ __device__ __forceinline__ void stage_rc(int b, int& R, int& C) { const int st = b / 1024, sb = b % 1024, swz = sb ^ (((sb >> 9) & 1) << 5); R = (st >> 1) * 16 + swz / 64; C = (st & 1) * 32 + (swz % 64) / 2; }
__host__ __device__ __forceinline__ int perm32(int rho) { const int n = rho >> 4, i = rho & 15; return 8 * (i >> 2) + 4 * n + (i & 3); }
__device__ __forceinline__ unsigned cvt_pk_bf16(float lo, float hi) { unsigned r; asm volatile("v_cvt_pk_bf16_f32 %0, %1, %2" : "=v"(r) : "v"(lo), "v"(hi)); return r; }

struct Unit { int pm, pn; const char* A; const char* B; int e, pos0, cnt; };

struct StaticOrder {
    int nM, nN, nwg, G, c; const char* A; const char* Bt; size_t atile, btile;
    __device__ void init(int M, int N, int K, int lda, int G_, int c_, const void* A_, const void* Bt_) { nM = M / BM; nN = N / BM; nwg = nM * nN; G = G_; c = c_; A = (const char*)A_; Bt = (const char*)Bt_; atile = (size_t)BM * lda * 2; btile = (size_t)BM * K * 2; }
    __device__ __forceinline__ bool next(int i, Unit& u) const {
        const long L = (long)i * G + c; if (L >= nwg) return false;
        int wgid = (int)L; { const int q = nwg / NXCD, r = nwg % NXCD, xcd = wgid % NXCD, off = wgid / NXCD; wgid = (xcd < r ? xcd * (q + 1) : r * (q + 1) + (xcd - r) * q) + off; }
        const int nig = WGM * nN, gid = wgid / nig, fm = gid * WGM, gsz = (nM - fm) < WGM ? (nM - fm) : WGM;
        u.pm = fm + ((wgid % nig) % gsz); u.pn = (wgid % nig) / gsz; u.A = A + (size_t)u.pm * atile; u.B = Bt + (size_t)u.pn * btile; u.e = 0; u.pos0 = 0; u.cnt = 0; return true;
    }
    __device__ __forceinline__ void aoff(const Unit&, unsigned (&)[2], unsigned (&)[2], const int (&)[2], const int (&)[2]) const {}
};

template <class Epi, class Sched, bool GATHER>
__device__ __forceinline__ void gemm_phase(PG8_LAS unsigned char* lds, const int K, const int lda, const Sched& S, const Epi& E) {
    const int tid = tid_opaque(), wid = __builtin_amdgcn_readfirstlane(tid >> 6), lane = tid & 63, wr = wid >> 2, wc = wid & 3, fr = lane & 15, fq = lane >> 4;
    const int nt = K / BK;
    unsigned vA0[2], vA1[2], vB[2], nA0[2], nA1[2]; int Rs[2], Cs[2];
#pragma unroll
    for (int i = 0; i < 2; ++i) { int R, C; stage_rc(tid * 16 + i * 8192, R, C); const int Rb = Epi::PERM ? ((R & ~31) + perm32(R & 31)) : R;
        Rs[i] = R; Cs[i] = C; vA0[i] = (unsigned)(R * lda + C) * 2u; vA1[i] = vA0[i] + (unsigned)(HALF * lda) * 2u; vB[i] = (unsigned)(Rb * K + C) * 2u; nA0[i] = vA0[i]; nA1[i] = vA1[i]; }
    const size_t kstep = (size_t)(BK * 2);
    const size_t hstep = (size_t)HALF * K * 2;
    const unsigned ldsw = (unsigned)wid * 1024u;
    const int aoff = lds_byte(wr * 64 + fr, fq * 8), boff = lds_byte(wc * 32 + fr, fq * 8);
#define PG8_SA(b, h) (((b) * 2 + (h)) * HTB)
#define PG8_SB(b, h) ((4 + (b) * 2 + (h)) * HTB)
#define PG8_STAGE(bufoff, gbase, voff) do { _Pragma("unroll") for (int _i = 0; _i < 2; ++_i) \
        __builtin_amdgcn_global_load_lds((const unsigned*)((const char*)(gbase) + (voff)[_i]), (PG8_LAS unsigned*)(lds + (bufoff) + ldsw + _i * 8192), 16, 0, 0); } while (0)
#define PG8_LDA(dst, b, h) do { _Pragma("unroll") for (int m = 0; m < 4; ++m) _Pragma("unroll") for (int k = 0; k < 2; ++k) dst[m][k] = *(const PG8_LAS bf16x8*)(lds + PG8_SA(b, h) + aoff + m * 2048 + k * 1024); } while (0)
#define PG8_LDB(dst, b, h) do { _Pragma("unroll") for (int n = 0; n < 2; ++n) _Pragma("unroll") for (int k = 0; k < 2; ++k) dst[n][k] = *(const PG8_LAS bf16x8*)(lds + PG8_SB(b, h) + boff + n * 2048 + k * 1024); } while (0)
#define PG8_MMA(ai, bj, At, Bt) do { __builtin_amdgcn_s_setprio(1); _Pragma("unroll") for (int m = 0; m < 4; ++m) _Pragma("unroll") for (int n = 0; n < 2; ++n) _Pragma("unroll") for (int k = 0; k < 2; ++k) \
        acc[ai][bj][m][n] = __builtin_amdgcn_mfma_f32_16x16x32_bf16(Bt[n][k], At[m][k], acc[ai][bj][m][n], 0, 0, 0); __builtin_amdgcn_s_setprio(0); } while (0)
#define PG8_WAIT_V(n) asm volatile("s_waitcnt vmcnt(" #n ")" ::: "memory")
#define PG8_WAIT_L(n) asm volatile("s_waitcnt lgkmcnt(" #n ")" ::: "memory")
#define PG8_BAR __builtin_amdgcn_s_barrier()
#define PG8_SCHED __builtin_amdgcn_sched_barrier(0)
    Unit cur, nxt; int ui = 0;
    if (!S.next(0, cur)) return;
    if constexpr (GATHER) { S.aoff(cur, vA0, vA1, Rs, Cs); PG8_WAIT_V(0); }
    f32x4 acc[2][2][4][2];
#pragma unroll
    for (int a = 0; a < 2; ++a)
#pragma unroll
        for (int b = 0; b < 2; ++b)
#pragma unroll
            for (int m = 0; m < 4; ++m)
#pragma unroll
                for (int n = 0; n < 2; ++n) acc[a][b][m][n] = (f32x4){0.f, 0.f, 0.f, 0.f};
    bf16x8 At[4][2], B0[2][2], B1[2][2];
    const char* cA = cur.A; const char* cB = cur.B;
    PG8_STAGE(PG8_SB(0, 0), cB, vB); PG8_STAGE(PG8_SB(0, 1), cB + hstep, vB); PG8_STAGE(PG8_SA(0, 0), cA, vA0); PG8_STAGE(PG8_SA(0, 1), cA, vA1);
    if (wr == 1) PG8_BAR;
    PG8_WAIT_V(2); PG8_BAR;
    PG8_STAGE(PG8_SB(1, 0), cB + kstep, vB); PG8_STAGE(PG8_SA(1, 0), cA + kstep, vA0); PG8_STAGE(PG8_SB(1, 1), cB + hstep + kstep, vB);
    PG8_WAIT_V(6); PG8_BAR;
    for (;;) {
        const bool has_next = S.next(ui + 1, nxt);
        const char* nA = has_next ? nxt.A : cA; const char* nB = has_next ? nxt.B : cB;
        if constexpr (GATHER) {
            if (has_next) { S.aoff(nxt, nA0, nA1, Rs, Cs); }
            else {
#pragma unroll
                for (int i = 0; i < 2; ++i) { nA0[i] = vA0[i]; nA1[i] = vA1[i]; } }
        }
        for (int t = 0; t < nt; t += 2) {
            const bool last = (t == nt - 2);
            const char* a1 = cA + (size_t)(t + 1) * kstep;
            const char* a2 = last ? nA : cA + (size_t)(t + 2) * kstep; const char* b2 = last ? nB : cB + (size_t)(t + 2) * kstep;
            const char* a3 = a2 + kstep; const char* b3 = b2 + kstep;
            unsigned x0[2], x1[2];
#pragma unroll
            for (int i = 0; i < 2; ++i) { x0[i] = (GATHER && last) ? nA0[i] : vA0[i]; x1[i] = (GATHER && last) ? nA1[i] : vA1[i]; }
            PG8_LDB(B0, 0, 0); PG8_LDB(B1, 0, 1); PG8_SCHED; PG8_LDA(At, 0, 0); PG8_STAGE(PG8_SA(1, 1), a1, vA1);
            PG8_WAIT_V(8); PG8_WAIT_L(0); PG8_BAR; PG8_MMA(0, 0, At, B0); PG8_MMA(0, 1, At, B1); PG8_BAR; PG8_SCHED;
            PG8_LDA(At, 0, 1); PG8_STAGE(PG8_SB(0, 0), b2, vB); PG8_STAGE(PG8_SB(0, 1), b2 + hstep, vB); PG8_STAGE(PG8_SA(0, 0), a2, x0);
            PG8_WAIT_V(8); PG8_WAIT_L(0); PG8_BAR; PG8_MMA(1, 0, At, B0); PG8_MMA(1, 1, At, B1); PG8_BAR; PG8_SCHED;
            PG8_LDB(B0, 1, 0); PG8_LDB(B1, 1, 1); PG8_SCHED; PG8_LDA(At, 1, 0); PG8_STAGE(PG8_SA(0, 1), a2, x1);
            PG8_WAIT_V(8); PG8_WAIT_L(0); PG8_BAR; PG8_MMA(0, 0, At, B0); PG8_MMA(0, 1, At, B1); PG8_BAR; PG8_SCHED;
            PG8_LDA(At, 1, 1); PG8_STAGE(PG8_SB(1, 0), b3, vB); PG8_STAGE(PG8_SB(1, 1), b3 + hstep, vB); PG8_STAGE(PG8_SA(1, 0), a3, x0);
            PG8_WAIT_V(8); PG8_WAIT_L(0); PG8_BAR; PG8_MMA(1, 0, At, B0); PG8_MMA(1, 1, At, B1); PG8_BAR; PG8_SCHED;
        }
        if (wr == 0) PG8_BAR;
        E(acc, cur, wr, wc, fr, fq);
        if (!has_next) break;
#pragma unroll
        for (int a = 0; a < 2; ++a)
#pragma unroll
            for (int b = 0; b < 2; ++b)
#pragma unroll
                for (int m = 0; m < 4; ++m)
#pragma unroll
                    for (int n = 0; n < 2; ++n) acc[a][b][m][n] = (f32x4){0.f, 0.f, 0.f, 0.f};
        cur = nxt; cA = nA; cB = nB; ++ui;
        if constexpr (GATHER) {
#pragma unroll
            for (int i = 0; i < 2; ++i) { vA0[i] = nA0[i]; vA1[i] = nA1[i]; } }
        if (wr == 1) PG8_BAR;
    }
    PG8_WAIT_V(0);
    PG8_BAR;
#undef PG8_SA
#undef PG8_SB
#undef PG8_STAGE
#undef PG8_LDA
#undef PG8_LDB
#undef PG8_MMA
#undef PG8_WAIT_V
#undef PG8_WAIT_L
#undef PG8_BAR
#undef PG8_SCHED
}

struct EpiZ {
    static constexpr bool PERM = true;
    bf16_t* Z;
    __device__ __forceinline__ void operator()(const f32x4 (&acc)[2][2][4][2], const Unit& u, int wr, int wc, int fr, int fq) const {
        const int row0 = u.pm * BM + wr * 64 + fr, col0 = u.pn * BM + wc * 32 + 8 * fq;
#pragma unroll
        for (int ai = 0; ai < 2; ++ai)
#pragma unroll
            for (int m = 0; m < 4; ++m) { bf16_t* rowp = Z + (size_t)(row0 + ai * HALF + m * 16) * ZW + col0;
#pragma unroll
                for (int bj = 0; bj < 2; ++bj) { const f32x4 v0 = acc[ai][bj][m][0], v1 = acc[ai][bj][m][1];
                    u32x4 w; w.x = cvt_pk_bf16(v0[0], v0[1]); w.y = cvt_pk_bf16(v0[2], v0[3]); w.z = cvt_pk_bf16(v1[0], v1[1]); w.w = cvt_pk_bf16(v1[2], v1[3]);
                    *(u32x4*)(rowp + bj * HALF) = w; } }
    }
};
struct EpiRes {
    static constexpr bool PERM = false;
    const float* X; float* O;
    __device__ __forceinline__ void operator()(const f32x4 (&acc)[2][2][4][2], const Unit& u, int wr, int wc, int fr, int fq) const {
        const int row0 = u.pm * BM + wr * 64 + fr, col0 = u.pn * BM + wc * 32 + 4 * fq;
#pragma unroll
        for (int ai = 0; ai < 2; ++ai)
#pragma unroll
            for (int m = 0; m < 4; ++m) { const size_t off = (size_t)(row0 + ai * HALF + m * 16) * D + col0;
#pragma unroll
                for (int bj = 0; bj < 2; ++bj)
#pragma unroll
                    for (int n = 0; n < 2; ++n) { const f32x4 xs = *(const f32x4*)(X + off + bj * HALF + n * 16); *(f32x4*)(O + off + bj * HALF + n * 16) = xs + acc[ai][bj][m][n]; }
                asm volatile("" ::: "memory"); }
    }
};
struct EpiAct {
    static constexpr bool PERM = true;
    bf16_t* ACT;
    __device__ __forceinline__ void operator()(const f32x4 (&acc)[2][2][4][2], const Unit& u, int wr, int wc, int fr, int fq) const {
        const int row0 = u.pm * BM + wr * 64 + fr, col0 = u.pn * HALF + wc * 32 + 8 * fq;
#pragma unroll
        for (int ai = 0; ai < 2; ++ai)
#pragma unroll
            for (int m = 0; m < 4; ++m) { bf16_t* rowp = ACT + (size_t)(row0 + ai * HALF + m * 16) * DE + col0;
                float o[8];
#pragma unroll
                for (int n = 0; n < 2; ++n)
#pragma unroll
                    for (int j = 0; j < 4; ++j) { const float g = acc[ai][0][m][n][j], up = acc[ai][1][m][n][j]; o[n * 4 + j] = g * up * __builtin_amdgcn_rcpf(1.f + __expf(-g)); }
                u32x4 w; w.x = cvt_pk_bf16(o[0], o[1]); w.y = cvt_pk_bf16(o[2], o[3]); w.z = cvt_pk_bf16(o[4], o[5]); w.w = cvt_pk_bf16(o[6], o[7]);
                *(u32x4*)rowp = w; }
    }
};
struct EpiDown {
    static constexpr bool PERM = false;
    float* X; const int2* lists;
    __device__ __forceinline__ void operator()(const f32x4 (&acc)[2][2][4][2], const Unit& u, int wr, int wc, int fr, int fq) const {
        const int col0 = u.pn * BM + wc * 32 + 4 * fq; const int2* lst = lists + (size_t)u.e * NTOK + u.pos0;
#pragma unroll
        for (int ai = 0; ai < 2; ++ai)
#pragma unroll
            for (int m = 0; m < 4; ++m) { const int r = ai * HALF + wr * 64 + m * 16 + fr;
                if (u.pos0 + r < u.cnt) { const int2 tw = lst[r]; const float w = __int_as_float(tw.y); float* rowp = X + (size_t)tw.x * D + col0;
#pragma unroll
                    for (int bj = 0; bj < 2; ++bj)
#pragma unroll
                        for (int n = 0; n < 2; ++n)
#pragma unroll
                            for (int j = 0; j < 4; ++j) unsafeAtomicAdd(rowp + bj * HALF + n * 16 + j, w * acc[ai][bj][m][n][j]); } }
    }
};
struct MoeOrder {
    const PG8_LAS i32x4* tab; int ntiles, npn, G, c; const char* A; size_t atile; const char* Bt; size_t bexp, btile; const int2* lists;
    __device__ __forceinline__ bool next(int i, Unit& u) const {
        const int L = i * G + c; const int T = L / npn; if (T >= ntiles) return false;
        const i32x4 te = tab[T]; u.pm = T; u.pn = L - T * npn; u.e = __builtin_amdgcn_readfirstlane(te.x); u.pos0 = __builtin_amdgcn_readfirstlane(te.y); u.cnt = __builtin_amdgcn_readfirstlane(te.z);
        u.A = A + (size_t)T * atile; u.B = Bt + (size_t)u.e * bexp + (size_t)u.pn * btile; return true;
    }
    __device__ __forceinline__ void aoff(const Unit& u, unsigned (&o0)[2], unsigned (&o1)[2], const int (&Rs)[2], const int (&Cs)[2]) const {
        const int2* lst = lists + (size_t)u.e * NTOK;
#pragma unroll
        for (int i = 0; i < 2; ++i) { const int p0 = u.pos0 + Rs[i], p1 = p0 + HALF;
            const int t0 = (p0 < u.cnt) ? lst[p0].x : 0, t1 = (p1 < u.cnt) ? lst[p1].x : 0;
            o0[i] = (unsigned)t0 * (unsigned)(D * 2) + (unsigned)Cs[i] * 2u; o1[i] = (unsigned)t1 * (unsigned)(D * 2) + (unsigned)Cs[i] * 2u; }
    }
};
}

__device__ __forceinline__ void ph_rmsnorm(const float* src, const float* g, float* dst) {
    const int wave = tid_opaque() >> 6, lane = tid_opaque() & 63;
    const float4* g4 = (const float4*)g;
    for (int r = blockIdx.x * 8 + wave; r < NTOK; r += gridDim.x * 8) {
        const float4* p = (const float4*)(src + (size_t)r * D);
        float4 v[4]; float ss = 0.f;
#pragma unroll
        for (int i = 0; i < 4; ++i) { v[i] = p[lane + 64 * i]; ss += v[i].x * v[i].x + v[i].y * v[i].y + v[i].z * v[i].z + v[i].w * v[i].w; }
        ss = wave_sum(ss);
        const float rs = rsqrtf(ss * (1.f / D) + EPS);
        float4* q = (float4*)(dst + (size_t)r * D);
#pragma unroll
        for (int i = 0; i < 4; ++i) { const float4 gg = g4[lane + 64 * i]; float4 o; o.x = v[i].x * rs * gg.x; o.y = v[i].y * rs * gg.y; o.z = v[i].z * rs * gg.z; o.w = v[i].w * rs * gg.w; q[lane + 64 * i] = o; }
    }
}
__device__ __forceinline__ void ph_norm1(const float* src, const float* g, const float* win, bf16_t* xn, float* gates) {
    const int wave = tid_opaque() >> 6, lane = tid_opaque() & 63;
    const float4* g4 = (const float4*)g;
    for (int r = blockIdx.x * 8 + wave; r < NTOK; r += gridDim.x * 8) {
        const float4* p = (const float4*)(src + (size_t)r * D);
        float4 v[4]; float ss = 0.f;
#pragma unroll
        for (int i = 0; i < 4; ++i) { v[i] = p[lane + 64 * i]; ss += v[i].x * v[i].x + v[i].y * v[i].y + v[i].z * v[i].z + v[i].w * v[i].w; }
        ss = wave_sum(ss);
        const float rs = rsqrtf(ss * (1.f / D) + EPS);
        float gt[8];
#pragma unroll
        for (int c = 0; c < 8; ++c) gt[c] = 0.f;
        pg8::u32x2* q = (pg8::u32x2*)(xn + (size_t)r * D);
#pragma unroll
        for (int i = 0; i < 4; ++i) { const float4 gg = g4[lane + 64 * i]; const float o[4] = {v[i].x * rs * gg.x, v[i].y * rs * gg.y, v[i].z * rs * gg.z, v[i].w * rs * gg.w};
            pg8::u32x2 w; w.x = pg8::cvt_pk_bf16(o[0], o[1]); w.y = pg8::cvt_pk_bf16(o[2], o[3]); q[lane + 64 * i] = w;
#pragma unroll
            for (int j = 0; j < 4; ++j) { const float* wr = win + (size_t)((lane + 64 * i) * 4 + j) * INW + WCI; const float4 w0 = *(const float4*)wr, w1 = *(const float4*)(wr + 4);
                gt[0] += o[j] * w0.x; gt[1] += o[j] * w0.y; gt[2] += o[j] * w0.z; gt[3] += o[j] * w0.w; gt[4] += o[j] * w1.x; gt[5] += o[j] * w1.y; gt[6] += o[j] * w1.z; gt[7] += o[j] * w1.w; } }
#pragma unroll
        for (int c = 0; c < 8; ++c) gt[c] = wave_sum(gt[c]);
        if (lane == 0) { float4* zp = (float4*)(gates + (size_t)r * 8); zp[0] = make_float4(gt[0], gt[1], gt[2], gt[3]); zp[1] = make_float4(gt[4], gt[5], gt[6], gt[7]); }
    }
}
__device__ __forceinline__ void tc_tile(float* T  , const float* src, int src_ld, int c0, int k0, bf16_t* dst, int K, int n0) {
    const int tid = tid_opaque();
    __syncthreads();
#pragma unroll
    for (int i = 0; i < 2; ++i) { const int kk = (tid >> 4) + 32 * i, c4 = (tid & 15) * 4;
        const float4 v = *(const float4*)(src + (size_t)(k0 + kk) * src_ld + c0 + c4);
        T[kk * 65 + c4] = v.x; T[kk * 65 + c4 + 1] = v.y; T[kk * 65 + c4 + 2] = v.z; T[kk * 65 + c4 + 3] = v.w; }
    __syncthreads();
    const int nl = tid >> 3, kc = (tid & 7) * 8;
    pg8::u32x4 w;
    w.x = pg8::cvt_pk_bf16(T[(kc + 0) * 65 + nl], T[(kc + 1) * 65 + nl]); w.y = pg8::cvt_pk_bf16(T[(kc + 2) * 65 + nl], T[(kc + 3) * 65 + nl]);
    w.z = pg8::cvt_pk_bf16(T[(kc + 4) * 65 + nl], T[(kc + 5) * 65 + nl]); w.w = pg8::cvt_pk_bf16(T[(kc + 6) * 65 + nl], T[(kc + 7) * 65 + nl]);
    *(pg8::u32x4*)(dst + (size_t)(n0 + nl) * K + k0 + kc) = w;
}
__device__ __forceinline__ void s5_build_tables_fwd(float* ldsf, const Params& P, int l, int g, unsigned char* tb);
__device__ __forceinline__ void ph_prologue(float* lds, const Params& P) {
    constexpr int NJ_EXP = NLAYER * NEXP * 384, NJ_IN = NLAYER * 576, NJ_OUT = NLAYER * 256;
    bf16_t* WIN = (bf16_t*)(P.ws + WS_WIN); bf16_t* WOUT = (bf16_t*)(P.ws + WS_WOUT); bf16_t* WGU = (bf16_t*)(P.ws + WS_WGU); bf16_t* WD = (bf16_t*)(P.ws + WS_WD);
    constexpr int NJ_TB = NLAYER * 16, NJ_GLU = NLAYER * 16;
    for (int j = blockIdx.x; j < NJ_EXP + NJ_IN + NJ_OUT + NJ_TB + NJ_GLU; j += gridDim.x) {
        if (j < NJ_EXP) {
            const int le = j / 384, r = j % 384;
            if (r < 256) { const int n0 = (r >> 4) * 64, k0 = (r & 15) * 64, pn = n0 >> 8, within = n0 & 255;
                const float* s = (within < 128 ? P.in[I_EWG] : P.in[I_EWU]) + (size_t)le * D * DE;
                tc_tile(lds, s, DE, pn * 128 + (within & 127), k0, WGU + (size_t)le * 1024 * D, D, n0);
            } else { const int r2 = r - 256, n0 = (r2 >> 3) * 64, k0 = (r2 & 7) * 64;
                tc_tile(lds, P.in[I_EWD] + (size_t)le * DE * D, D, n0, k0, WD + (size_t)le * D * DE, DE, n0); }
        } else if (j < NJ_EXP + NJ_IN) {
            const int j2 = j - NJ_EXP, l = j2 / 576, r = j2 % 576, n0 = (r >> 4) * 64, k0 = (r & 15) * 64;
            tc_tile(lds, P.in[I_WIN] + (size_t)l * D * INW, INW, n0 < WCI ? n0 : n0 + 8, k0, WIN + (size_t)l * NMAIN * D, D, n0);
        } else if (j >= NJ_EXP + NJ_IN + NJ_OUT + NJ_TB) {
            const int j5 = j - (NJ_EXP + NJ_IN + NJ_OUT + NJ_TB), l = j5 >> 4, r = j5 & 15, n0 = (r >> 2) * 64, k0 = (r & 3) * 64;
            tc_tile(lds, P.in[I_GLUW] + (size_t)l * 256 * 256, 256, n0, k0, (bf16_t*)(P.ws + WS_TB + (size_t)l * 4 * MiB + s5::T_GLUW), 256, n0);
        } else if (j >= NJ_EXP + NJ_IN + NJ_OUT) {
            const int j4 = j - (NJ_EXP + NJ_IN + NJ_OUT);
            s5_build_tables_fwd(lds, P, j4 >> 4, j4 & 15, P.ws + WS_TB + (size_t)(j4 >> 4) * 4 * MiB);
        } else {
            const int j3 = j - NJ_EXP - NJ_IN, l = j3 / 256, r = j3 % 256, n0 = (r >> 4) * 64, k0 = (r & 15) * 64;
            tc_tile(lds, P.in[I_WOUT] + (size_t)l * D * D, D, n0, k0, WOUT + (size_t)l * D * D, D, n0);
        }
    }
    __syncthreads();
}

template <bool DUAL, class AF, class EF>
__device__ __forceinline__ void gemm_tile(float* lds, AF arow, int K, const float* B0, const float* B1, int ldb, int n0, int N, EF epi) {
    float* As = lds;
    float* Bs0 = lds + 32 * 132;
    float* Bs1 = Bs0 + 32 * 128;
    const int tid = tid_opaque(), ty = tid >> 4, tx = tid & 15;
    float acc0[4][8], acc1[4][8];
#pragma unroll
    for (int i = 0; i < 4; ++i)
#pragma unroll
        for (int j = 0; j < 8; ++j) { acc0[i][j] = 0.f; acc1[i][j] = 0.f; }
    const float* ap0 = arow((tid >> 3));
    const float* ap1 = arow((tid >> 3) + 64);
    const int akk = (tid & 7) * 4;
    const int bn = n0 + (tid & 31) * 4; const bool bok = bn < N;
    for (int k0 = 0; k0 < K; k0 += 32) {
        const float4 av0 = ap0 ? *(const float4*)(ap0 + k0 + akk) : make_float4(0.f, 0.f, 0.f, 0.f);
        const float4 av1 = ap1 ? *(const float4*)(ap1 + k0 + akk) : make_float4(0.f, 0.f, 0.f, 0.f);
        const int kb0 = k0 + (tid >> 5), kb1 = kb0 + 16;
        const float4 bv00 = bok ? *(const float4*)(B0 + (size_t)kb0 * ldb + bn) : make_float4(0.f, 0.f, 0.f, 0.f);
        const float4 bv01 = bok ? *(const float4*)(B0 + (size_t)kb1 * ldb + bn) : make_float4(0.f, 0.f, 0.f, 0.f);
        const float4 bv10 = (DUAL && bok) ? *(const float4*)(B1 + (size_t)kb0 * ldb + bn) : bv00;
        const float4 bv11 = (DUAL && bok) ? *(const float4*)(B1 + (size_t)kb1 * ldb + bn) : bv01;
        __syncthreads();
        { const int r = (tid >> 3);
          As[(akk + 0) * 132 + r] = av0.x; As[(akk + 1) * 132 + r] = av0.y; As[(akk + 2) * 132 + r] = av0.z; As[(akk + 3) * 132 + r] = av0.w;
          As[(akk + 0) * 132 + r + 64] = av1.x; As[(akk + 1) * 132 + r + 64] = av1.y; As[(akk + 2) * 132 + r + 64] = av1.z; As[(akk + 3) * 132 + r + 64] = av1.w; }
        { const int k = (tid >> 5);
          *(float4*)&Bs0[k * 128 + (tid & 31) * 4] = bv00; *(float4*)&Bs0[(k + 16) * 128 + (tid & 31) * 4] = bv01;
          if (DUAL) { *(float4*)&Bs1[k * 128 + (tid & 31) * 4] = bv10; *(float4*)&Bs1[(k + 16) * 128 + (tid & 31) * 4] = bv11; } }
        __syncthreads();
#pragma unroll 4
        for (int k = 0; k < 32; ++k) {
            const float4 a = *(const float4*)&As[k * 132 + ty * 4];
            const float4 b0 = *(const float4*)&Bs0[k * 128 + tx * 4], b1 = *(const float4*)&Bs0[k * 128 + 64 + tx * 4];
            const float aa[4] = {a.x, a.y, a.z, a.w};
            const float bb[8] = {b0.x, b0.y, b0.z, b0.w, b1.x, b1.y, b1.z, b1.w};
#pragma unroll
            for (int i = 0; i < 4; ++i)
#pragma unroll
                for (int j = 0; j < 8; ++j) acc0[i][j] = fmaf(aa[i], bb[j], acc0[i][j]);
            if (DUAL) {
                const float4 c0 = *(const float4*)&Bs1[k * 128 + tx * 4], c1 = *(const float4*)&Bs1[k * 128 + 64 + tx * 4];
                const float cc[8] = {c0.x, c0.y, c0.z, c0.w, c1.x, c1.y, c1.z, c1.w};
#pragma unroll
                for (int i = 0; i < 4; ++i)
#pragma unroll
                    for (int j = 0; j < 8; ++j) acc1[i][j] = fmaf(aa[i], cc[j], acc1[i][j]);
            }
        }
    }
#pragma unroll
    for (int i = 0; i < 4; ++i)
#pragma unroll
        for (int j = 0; j < 8; ++j) {
            const int r = ty * 4 + i, c = n0 + (j < 4 ? tx * 4 + j : 64 + tx * 4 + (j - 4));
            if (c < N) epi(r, c, acc0[i][j], acc1[i][j]);
        }
    __syncthreads();
}

__device__ __forceinline__ void ph_inproj(LAS unsigned char* ldsb, const bf16_t* xn, const bf16_t* wt, bf16_t* z) {
    pg8::StaticOrder S; S.init(NTOK, NMAIN, D, D, gridDim.x, blockIdx.x, xn, wt);
    pg8::EpiZ E{z};
    pg8::gemm_phase<pg8::EpiZ, pg8::StaticOrder, false>(ldsb, D, D, S, E);
}

__device__ __forceinline__ void attn_wave(const bf16_t* z, const float* sinks, bf16_t* mix, int u, int lane) {
    const int b = u >> 10, hq = (u >> 8) & 3, t0 = (u & 255) * 32, t = t0 + (lane >> 1), g = hq >> 1, dh = (lane & 1) * 32;
    float q[32];
    { const bf16_t* qp = z + (size_t)(b * S + t) * ZW + ZQ + hq * 64 + dh;
#pragma unroll
      for (int i = 0; i < 4; ++i) { float v[8]; ld8(qp + 8 * i, v);
#pragma unroll
        for (int e = 0; e < 8; ++e) q[8 * i + e] = v[e] * 0.125f; } }
    float m = sinks[hq], l = 1.f; float o[32];
#pragma unroll
    for (int d = 0; d < 32; ++d) o[d] = 0.f;
    const int jlo = (t0 - 127) > 0 ? (t0 - 127) : 0, jhi = t0 + 31;
    for (int j = jlo; j <= jhi; ++j) {
        const bf16_t* kp = z + (size_t)(b * S + j) * ZW + ZK + g * 64 + dh;
        const bf16_t* vp = z + (size_t)(b * S + j) * ZW + ZV + g * 64 + dh;
        float s = 0.f;
#pragma unroll
        for (int i = 0; i < 4; ++i) { float kv[8]; ld8(kp + 8 * i, kv);
#pragma unroll
            for (int e = 0; e < 8; ++e) s += q[8 * i + e] * kv[e]; }
        s += __shfl_xor(s, 1);
        const bool valid = (j <= t) && (j > t - 128);
        const float mn = valid ? fmaxf(m, s) : m;
        const float corr = expf(m - mn), p = valid ? expf(s - mn) : 0.f;
        l = l * corr + p; m = mn;
#pragma unroll
        for (int i = 0; i < 4; ++i) { float vv[8]; ld8(vp + 8 * i, vv);
#pragma unroll
            for (int e = 0; e < 8; ++e) o[8 * i + e] = o[8 * i + e] * corr + p * vv[e]; }
    }
    const float inv = 1.f / l;
    pg8::u32x4* op = (pg8::u32x4*)(mix + (size_t)(b * S + t) * D + hq * 64 + dh);
#pragma unroll
    for (int i = 0; i < 4; ++i) { pg8::u32x4 w; w.x = pg8::cvt_pk_bf16(o[8 * i] * inv, o[8 * i + 1] * inv); w.y = pg8::cvt_pk_bf16(o[8 * i + 2] * inv, o[8 * i + 3] * inv);
        w.z = pg8::cvt_pk_bf16(o[8 * i + 4] * inv, o[8 * i + 5] * inv); w.w = pg8::cvt_pk_bf16(o[8 * i + 6] * inv, o[8 * i + 7] * inv); op[i] = w; }
}

namespace ml {
using pg8::bf16x8; using pg8::f32x4; using pg8::u32x4; using pg8::u32x2;
constexpr int L = 128, NCH = S / L, NU = NB * 4 * NCH;
constexpr int QP = 144, TP = 272;
constexpr int OFF_Q = 0, OFF_K = OFF_Q + 128 * QP, OFF_VT = OFF_K + 128 * QP, OFF_KT = OFF_VT + 64 * TP, OFF_F = OFF_KT + 64 * TP;
constexpr int LDS_END = OFF_F + 4 * 128 * 4 + 64;
constexpr size_t O_CL = 0, O_CST = O_CL + (size_t)NU * 4096 * 4, O_NL = O_CST + (size_t)NU * 4096 * 2, O_NST = O_NL + (size_t)NU * 64 * 4,
                 O_MLOC = O_NST + (size_t)NU * 64 * 4, O_BL = O_MLOC + (size_t)NU * 4, O_MST = O_BL + (size_t)NU * 4, O_END = O_MST + (size_t)NU * 4;
__device__ __forceinline__ f32x4 mfma16(bf16x8 a, bf16x8 b, f32x4 c) { return __builtin_amdgcn_mfma_f32_16x16x32_bf16(a, b, c, 0, 0, 0); }
__device__ __forceinline__ float bf_lo(unsigned w) { return __uint_as_float(w << 16); }
__device__ __forceinline__ float bf_hi(unsigned w) { return __uint_as_float(w & 0xffff0000u); }
__device__ __forceinline__ unsigned short bf1(float x) { return (unsigned short)(pg8::cvt_pk_bf16(x, 0.f) & 0xffffu); }

__device__ __forceinline__ void stage_gates(LAS unsigned char* lds, const float* gates, const Params& P, int l, int head, int tok0, int tid) {
    LAS float* LF = (LAS float*)(lds + OFF_F); LAS float* IG = LF + 128; LAS float* Bc = LF + 256; LAS float* G2 = LF + 384; LAS float* scal = LF + 512;
    if (tid < 128) { const float* zr = gates + (size_t)(tok0 + tid) * 8;
        const float ipre = zr[head] + P.in[I_GATEB][l * 8 + head], fpre = zr[4 + head] + P.in[I_GATEB][l * 8 + 4 + head];
        LF[tid] = fminf(fpre, 0.f) - log1pf(expf(-fabsf(fpre))); IG[tid] = ipre; }
    __syncthreads();
    if (tid < 64) { const float a = LF[2 * tid], b2 = LF[2 * tid + 1]; const float s = a + b2; float inc = s;
#pragma unroll
        for (int o = 1; o < 64; o <<= 1) { const float v = __shfl_up(inc, o); if (tid >= o) inc += v; }
        const float exc = inc - s; const float b0 = exc + a, b1 = exc + s;
        Bc[2 * tid] = b0; Bc[2 * tid + 1] = b1; const float g0 = IG[2 * tid] - b0, g1 = IG[2 * tid + 1] - b1; G2[2 * tid] = g0; G2[2 * tid + 1] = g1;
        float gm = fmaxf(g0, g1);
#pragma unroll
        for (int o = 32; o > 0; o >>= 1) gm = fmaxf(gm, __shfl_xor(gm, o));
        if (tid == 63) { scal[0] = gm; scal[1] = b1; } }
    __syncthreads();
}
__device__ __forceinline__ void conv8(const bf16_t* z, const float* cw, int b, int pos, int which, int head, int c0, float (&o)[8]) {
    const int col = (which ? ZCK : ZCQ) + head * 64 + c0, cc = which * 256 + head * 64 + c0;
    float x[8];
#pragma unroll
    for (int e = 0; e < 8; ++e) x[e] = 0.f;
#pragma unroll
    for (int j = 0; j < 4; ++j) { const int tg = pos - 3 + j;
        if (tg >= 0) { float v[8]; ld8(z + (size_t)(b * S + tg) * ZW + col, v);
            const float4 w0 = *(const float4*)(cw + j * 512 + cc), w1 = *(const float4*)(cw + j * 512 + cc + 4);
            x[0] += w0.x * v[0]; x[1] += w0.y * v[1]; x[2] += w0.z * v[2]; x[3] += w0.w * v[3]; x[4] += w1.x * v[4]; x[5] += w1.y * v[5]; x[6] += w1.z * v[6]; x[7] += w1.w * v[7]; } }
    const float sc = which ? 0.125f : 1.f;
#pragma unroll
    for (int e = 0; e < 8; ++e) o[e] = x[e] * sc / (1.f + __expf(-x[e]));
}
__device__ __forceinline__ void stage_vt(LAS unsigned char* lds, const bf16_t* z, int head, int tok0, int tid) {
#pragma unroll
    for (int it = 0; it < 2; ++it) { const int idx = tid + it * NTHREADS, s = idx & 127, cg = idx >> 7;
        const u32x4 w = *(const u32x4*)(z + (size_t)(tok0 + s) * ZW + ZCV + head * 64 + cg * 8);
        const unsigned ww[4] = {w.x, w.y, w.z, w.w};
#pragma unroll
        for (int e = 0; e < 8; ++e) *(LAS unsigned short*)(lds + OFF_VT + (cg * 8 + e) * TP + s * 2) = (unsigned short)((e & 1) ? (ww[e >> 1] >> 16) : (ww[e >> 1] & 0xffffu)); }
}

__device__ __forceinline__ void p1_unit(LAS unsigned char* lds, const bf16_t* z, const float* gates, const Params& P, int l, int u, unsigned char* wsm) {
    const int tid = tid_opaque(), lane = tid & 63, wid = __builtin_amdgcn_readfirstlane(tid >> 6), r = lane & 15, qd = lane >> 4;
    const int b = u >> 8, head = (u >> 6) & 3, c = u & 63, tok0 = b * S + c * L;
    LAS float* G2 = (LAS float*)(lds + OFF_F) + 384; LAS float* scal = (LAS float*)(lds + OFF_F) + 512;
    __syncthreads();
    stage_gates(lds, gates, P, l, head, tok0, tid);
    const float gmax = scal[0], bL = scal[1];
    stage_vt(lds, z, head, tok0, tid);
    const float* cw = P.in[I_CONVW] + (size_t)l * 4 * 512;
#pragma unroll
    for (int it = 0; it < 2; ++it) { const int idx = tid + it * NTHREADS, s = idx & 127, cg = idx >> 7;
        float o[8]; conv8(z, cw, b, c * L + s, 1, head, cg * 8, o);
        const float ws = __expf(G2[s] - gmax);
#pragma unroll
        for (int e = 0; e < 8; ++e) *(LAS unsigned short*)(lds + OFF_KT + (cg * 8 + e) * TP + s * 2) = bf1(o[e] * ws); }
    __syncthreads();
    const int kt = wid >> 1;
    float* CL = (float*)(wsm + O_CL) + (size_t)u * 4096;
#pragma unroll
    for (int i = 0; i < 2; ++i) { const int vt = (wid & 1) * 2 + i; f32x4 acc = {0.f, 0.f, 0.f, 0.f};
#pragma unroll
        for (int ks = 0; ks < 4; ++ks) { const bf16x8 a = *(const LAS bf16x8*)(lds + OFF_KT + (16 * kt + r) * TP + (32 * ks + 8 * qd) * 2), bb = *(const LAS bf16x8*)(lds + OFF_VT + (16 * vt + r) * TP + (32 * ks + 8 * qd) * 2);
            acc = mfma16(a, bb, acc); }
        *(f32x4*)(CL + (size_t)(16 * vt + r) * 64 + 16 * kt + 4 * qd) = acc; }
    if (tid < 64) { float sum = 0.f;
        for (int s2 = 0; s2 < 128; s2 += 2) { const unsigned w2 = *(const LAS unsigned*)(lds + OFF_KT + tid * TP + s2 * 2); sum += bf_lo(w2) + bf_hi(w2); }
        ((float*)(wsm + O_NL))[(size_t)u * 64 + tid] = sum; }
    if (tid == 0) { ((float*)(wsm + O_MLOC))[u] = bL + gmax; ((float*)(wsm + O_BL))[u] = bL; }
}
__device__ __forceinline__ void p2_scan(unsigned char* wsm) {
    const int tid = tid_opaque();
    const float* CL = (const float*)(wsm + O_CL); const float* NL = (const float*)(wsm + O_NL); const float* MLOC = (const float*)(wsm + O_MLOC); const float* BL = (const float*)(wsm + O_BL);
    bf16_t* CST = (bf16_t*)(wsm + O_CST); float* NST = (float*)(wsm + O_NST); float* MST = (float*)(wsm + O_MST);
    for (int idx = blockIdx.x * NTHREADS + tid; idx < 32 * 4096; idx += gridDim.x * NTHREADS) {
        const int bh = idx >> 12, e = idx & 4095;
        float C = 0.f, nn = 0.f, m = 0.f;
#pragma unroll 4
        for (int c = 0; c < NCH; ++c) { const int u = bh * NCH + c;
            CST[(size_t)u * 4096 + e] = bf1(C);
            if (e < 64) NST[(size_t)u * 64 + e] = nn;
            if (e == 0) MST[u] = m;
            const float mloc = MLOC[u], bL = BL[u], mn = fmaxf(bL + m, mloc), dec = __expf(bL + m - mn), wl = __expf(mloc - mn);
            C = dec * C + wl * CL[(size_t)u * 4096 + e];
            if (e < 64) nn = dec * nn + wl * NL[(size_t)u * 64 + e];
            m = mn; }
    }
}
__device__ __forceinline__ void p3_unit(LAS unsigned char* lds, const bf16_t* z, const float* gates, const Params& P, int l, int u, const unsigned char* wsm, bf16_t* mix) {
    const int tid = tid_opaque(), lane = tid & 63, wid = __builtin_amdgcn_readfirstlane(tid >> 6), r = lane & 15, qd = lane >> 4;
    const int b = u >> 8, head = (u >> 6) & 3, c = u & 63, tok0 = b * S + c * L;
    LAS float* Bc = (LAS float*)(lds + OFF_F) + 256; LAS float* G2 = (LAS float*)(lds + OFF_F) + 384;
    __syncthreads();
    stage_gates(lds, gates, P, l, head, tok0, tid);
    stage_vt(lds, z, head, tok0, tid);
    const float* cw = P.in[I_CONVW] + (size_t)l * 4 * 512;
#pragma unroll
    for (int it = 0; it < 4; ++it) { const int idx = tid + it * NTHREADS, which = idx >> 10, s = (idx >> 3) & 127, cg = idx & 7;
        float o[8]; conv8(z, cw, b, c * L + s, which, head, cg * 8, o);
        u32x4 w; w.x = pg8::cvt_pk_bf16(o[0], o[1]); w.y = pg8::cvt_pk_bf16(o[2], o[3]); w.z = pg8::cvt_pk_bf16(o[4], o[5]); w.w = pg8::cvt_pk_bf16(o[6], o[7]);
        *(LAS u32x4*)(lds + (which ? OFF_K : OFF_Q) + s * QP + cg * 16) = w; }
    __syncthreads();
    const int w = wid, t = 16 * w + r;
    const bf16x8 bq0 = *(const LAS bf16x8*)(lds + OFF_Q + t * QP + qd * 16), bq1 = *(const LAS bf16x8*)(lds + OFF_Q + t * QP + 64 + qd * 16);
    f32x4 accS[8];
#pragma unroll
    for (int ct = 0; ct < 8; ++ct) { accS[ct] = (f32x4){0.f, 0.f, 0.f, 0.f};
        if (ct <= w) { const bf16x8 a0 = *(const LAS bf16x8*)(lds + OFF_K + (16 * ct + r) * QP + qd * 16), a1 = *(const LAS bf16x8*)(lds + OFF_K + (16 * ct + r) * QP + 64 + qd * 16);
            accS[ct] = mfma16(a0, bq0, accS[ct]); accS[ct] = mfma16(a1, bq1, accS[ct]); } }
    const float bt = Bc[t], mst = ((const float*)(wsm + O_MST))[u];
    float ld[8][4]; float mloc = -3.0e38f;
#pragma unroll
    for (int ct = 0; ct < 8; ++ct) { const f32x4 g = *(const LAS f32x4*)(G2 + 16 * ct + 4 * qd);
#pragma unroll
        for (int j = 0; j < 4; ++j) { const bool valid = (ct < w) || (ct == w && 4 * qd + j <= r); ld[ct][j] = valid ? bt + g[j] : -3.0e38f; mloc = fmaxf(mloc, ld[ct][j]); } }
    mloc = fmaxf(mloc, __shfl_xor(mloc, 16)); mloc = fmaxf(mloc, __shfl_xor(mloc, 32));
    const float mt = fmaxf(bt + mst, mloc);
    float den = 0.f;
#pragma unroll
    for (int ct = 0; ct < 8; ++ct)
#pragma unroll
        for (int j = 0; j < 4; ++j) { const float pe = __expf(ld[ct][j] - mt) * accS[ct][j]; accS[ct][j] = pe; den += pe; }
    den += __shfl_xor(den, 16); den += __shfl_xor(den, 32);
    const bf16_t* cst = (const bf16_t*)(wsm + O_CST) + (size_t)u * 4096; const float* nst = (const float*)(wsm + O_NST) + (size_t)u * 64;
    f32x4 accN[4];
#pragma unroll
    for (int dt = 0; dt < 4; ++dt) { const bf16x8 c0 = *(const bf16x8*)(cst + (16 * dt + r) * 64 + 8 * qd), c1 = *(const bf16x8*)(cst + (16 * dt + r) * 64 + 32 + 8 * qd);
        accN[dt] = mfma16(c0, bq0, (f32x4){0.f, 0.f, 0.f, 0.f}); accN[dt] = mfma16(c1, bq1, accN[dt]); }
    const float winter = __expf(bt + mst - mt);
    float nq = 0.f;
    { const float4 n0 = *(const float4*)(nst + 8 * qd), n1 = *(const float4*)(nst + 8 * qd + 4), n2 = *(const float4*)(nst + 32 + 8 * qd), n3 = *(const float4*)(nst + 36 + 8 * qd);
      const u32x4 q0 = __builtin_bit_cast(u32x4, bq0), q1 = __builtin_bit_cast(u32x4, bq1);
      nq = bf_lo(q0.x) * n0.x + bf_hi(q0.x) * n0.y + bf_lo(q0.y) * n0.z + bf_hi(q0.y) * n0.w + bf_lo(q0.z) * n1.x + bf_hi(q0.z) * n1.y + bf_lo(q0.w) * n1.z + bf_hi(q0.w) * n1.w
         + bf_lo(q1.x) * n2.x + bf_hi(q1.x) * n2.y + bf_lo(q1.y) * n2.z + bf_hi(q1.y) * n2.w + bf_lo(q1.z) * n3.x + bf_hi(q1.z) * n3.y + bf_lo(q1.w) * n3.z + bf_hi(q1.w) * n3.w; }
    nq += __shfl_xor(nq, 16); nq += __shfl_xor(nq, 32);
    den += winter * nq;
#pragma unroll
    for (int dt = 0; dt < 4; ++dt) accN[dt] = accN[dt] * winter;
#pragma unroll
    for (int kk = 0; kk < 4; ++kk) if (2 * kk <= w) {
        u32x4 pw; pw.x = pg8::cvt_pk_bf16(accS[2 * kk][0], accS[2 * kk][1]); pw.y = pg8::cvt_pk_bf16(accS[2 * kk][2], accS[2 * kk][3]);
        pw.z = pg8::cvt_pk_bf16(accS[2 * kk + 1][0], accS[2 * kk + 1][1]); pw.w = pg8::cvt_pk_bf16(accS[2 * kk + 1][2], accS[2 * kk + 1][3]);
        const bf16x8 pf = __builtin_bit_cast(bf16x8, pw);
#pragma unroll
        for (int dt = 0; dt < 4; ++dt) { const u32x2 v0 = *(const LAS u32x2*)(lds + OFF_VT + (16 * dt + r) * TP + (32 * kk + 4 * qd) * 2), v1 = *(const LAS u32x2*)(lds + OFF_VT + (16 * dt + r) * TP + (32 * kk + 16 + 4 * qd) * 2);
            u32x4 vw; vw.x = v0.x; vw.y = v0.y; vw.z = v1.x; vw.w = v1.y;
            accN[dt] = mfma16(__builtin_bit_cast(bf16x8, vw), pf, accN[dt]); } }
    const float inv = 1.f / fmaxf(fabsf(den), __expf(-mt));
    float ss = 0.f;
#pragma unroll
    for (int dt = 0; dt < 4; ++dt) { accN[dt] = accN[dt] * inv; ss += accN[dt][0] * accN[dt][0] + accN[dt][1] * accN[dt][1] + accN[dt][2] * accN[dt][2] + accN[dt][3] * accN[dt][3]; }
    ss += __shfl_xor(ss, 16); ss += __shfl_xor(ss, 32);
    const float rs = rsqrtf(ss * (1.f / 64.f) + EPS);
    const float* ng = P.in[I_MNG] + l * 256 + head * 64; const bf16_t* cop = z + (size_t)(tok0 + t) * ZW + ZCO + head * 64;
    bf16_t* op = mix + (size_t)(tok0 + t) * D + 512 + head * 64;
#pragma unroll
    for (int dt = 0; dt < 4; ++dt) { const int d0 = 16 * dt + 4 * qd; const float4 g = *(const float4*)(ng + d0); const u32x2 cw2 = *(const u32x2*)(cop + d0); const float4 co = make_float4(bf_lo(cw2.x), bf_hi(cw2.x), bf_lo(cw2.y), bf_hi(cw2.y));
        u32x2 o; o.x = pg8::cvt_pk_bf16(accN[dt][0] * rs * g.x / (1.f + __expf(-co.x)), accN[dt][1] * rs * g.y / (1.f + __expf(-co.y)));
        o.y = pg8::cvt_pk_bf16(accN[dt][2] * rs * g.z / (1.f + __expf(-co.z)), accN[dt][3] * rs * g.w / (1.f + __expf(-co.w)));
        *(u32x2*)(op + d0) = o; }
}
static_assert(O_END <= 64 * MiB && LDS_END <= 128 * 1024, "mLSTM scratch fits");
}

namespace s5 {
using pg8::bf16x8; using pg8::f32x4; using pg8::u32x4; using pg8::u32x2;
constexpr int LC = 16, NINST = NTOK / LC;
constexpr size_t O_E = 0, O_XC = O_E + (size_t)NINST * 16 * 128 * 4, O_END = O_XC + (size_t)NINST * 16 * 128 * 2;
constexpr int YP = 528;
__device__ __forceinline__ f32x4 mfma16(bf16x8 a, bf16x8 b, f32x4 c) { return __builtin_amdgcn_mfma_f32_16x16x32_bf16(a, b, c, 0, 0, 0); }

__device__ __forceinline__ void build_tables(float* ldsf, const Params& P, int l, int g, unsigned char* tb) {
    const int tid = tid_opaque();
    float* apw = ldsf; float* bb = apw + 17 * 64 * 2; float* cc = bb + 64 * 16 * 2;
    __syncthreads();
    if (tid < 64) { const int gp = (l * 16 + g) * 64 + tid;
        const float ar = P.in[I_ARE][gp], ai = P.in[I_AIM][gp], dt = expf(P.in[I_LDT][l * 16 + g]);
        for (int tau = 0; tau <= 16; ++tau) { const float er = expf(ar * dt * tau), ang = ai * dt * tau; apw[(tau * 64 + tid) * 2] = er * cosf(ang); apw[(tau * 64 + tid) * 2 + 1] = er * sinf(ang); }
        const float abr = apw[(64 + tid) * 2], abi = apw[(64 + tid) * 2 + 1];
        const float xr_ = abr - 1.f, xi_ = abi, den = ar * ar + ai * ai;
        const float cr = (xr_ * ar + xi_ * ai) / den, ci = (xi_ * ar - xr_ * ai) / den;
        for (int h = 0; h < 16; ++h) { const float br = P.in[I_BRE][(size_t)gp * 16 + h], bi = P.in[I_BIM][(size_t)gp * 16 + h]; bb[(tid * 16 + h) * 2] = cr * br - ci * bi; bb[(tid * 16 + h) * 2 + 1] = cr * bi + ci * br; }
        float* a16 = (float*)(tb + T_A16) + (size_t)(g * 64 + tid) * 2; a16[0] = apw[(16 * 64 + tid) * 2]; a16[1] = apw[(16 * 64 + tid) * 2 + 1]; }
    for (int idx = tid; idx < 16 * 64; idx += NTHREADS) { const int h = idx >> 6, p = idx & 63; const int ci_ = ((l * 16 + g) * 16 + h) * 64 + p; cc[idx * 2] = P.in[I_CRE][ci_]; cc[idx * 2 + 1] = P.in[I_CIM][ci_]; }
    __syncthreads();
    bf16_t* KM = (bf16_t*)(tb + T_KMAT) + (size_t)g * 16 * 256; bf16_t* FT = (bf16_t*)(tb + T_F) + (size_t)g * 256 * 128; bf16_t* GT = (bf16_t*)(tb + T_G) + (size_t)g * 128 * 256;
    for (int idx = tid; idx < 16 * 256; idx += NTHREADS) { const int tau = idx >> 8, h = (idx >> 4) & 15, hp = idx & 15; float s = 0.f;
        for (int p = 0; p < 64; ++p) { const float cr = cc[(h * 64 + p) * 2], ci = cc[(h * 64 + p) * 2 + 1], ar = apw[(tau * 64 + p) * 2], ai = apw[(tau * 64 + p) * 2 + 1], br = bb[(p * 16 + hp) * 2], bi = bb[(p * 16 + hp) * 2 + 1];
            const float er = ar * br - ai * bi, ei = ar * bi + ai * br; s += cr * er - ci * ei; }
        KM[idx] = ml::bf1(s); }
    for (int idx = tid; idx < 256 * 64; idx += NTHREADS) { const int n = idx >> 6, p = idx & 63, t = n >> 4, h = n & 15;
        const float cr = cc[(h * 64 + p) * 2], ci = cc[(h * 64 + p) * 2 + 1], ar = apw[((t + 1) * 64 + p) * 2], ai = apw[((t + 1) * 64 + p) * 2 + 1];
        FT[(size_t)n * 128 + p] = ml::bf1(cr * ar - ci * ai); FT[(size_t)n * 128 + 64 + p] = ml::bf1(-(cr * ai + ci * ar)); }
    for (int idx = tid; idx < 64 * 256; idx += NTHREADS) { const int p = idx >> 8, k = idx & 255, s = k >> 4, hp = k & 15;
        const float ar = apw[((15 - s) * 64 + p) * 2], ai = apw[((15 - s) * 64 + p) * 2 + 1], br = bb[(p * 16 + hp) * 2], bi = bb[(p * 16 + hp) * 2 + 1];
        GT[(size_t)p * 256 + k] = ml::bf1(ar * br - ai * bi); GT[(size_t)(64 + p) * 256 + k] = ml::bf1(ar * bi + ai * br); }
}
__device__ __forceinline__ void load_u_frags(const bf16_t* z, int tok0, int g, int r, int qd, bf16x8 (&uf)[8]) {
#pragma unroll
    for (int ks = 0; ks < 8; ++ks) uf[ks] = *(const bf16x8*)(z + (size_t)(tok0 + 16 * r + 2 * ks + (qd >> 1)) * ZW + ZSU + 16 * g + 8 * (qd & 1));
}
__device__ __forceinline__ void p1_unit(const bf16_t* z, const unsigned char* tb, int u, unsigned char* wss) {
    const int tid = tid_opaque(), lane = tid & 63, wid = __builtin_amdgcn_readfirstlane(tid >> 6), r = lane & 15, qd = lane >> 4;
    const int tok0 = u * 256, inst0 = u * 16;
    float* E = (float*)(wss + O_E);
#pragma unroll 1
    for (int g = 0; g < 16; ++g) {
        bf16x8 uf[8]; load_u_frags(z, tok0, g, r, qd, uf);
        const bf16_t* GT = (const bf16_t*)(tb + T_G) + (size_t)g * 128 * 256 + (size_t)(16 * wid + r) * 256 + 8 * qd;
        f32x4 acc = {0.f, 0.f, 0.f, 0.f};
#pragma unroll
        for (int ks = 0; ks < 8; ++ks) acc = mfma16(*(const bf16x8*)(GT + 32 * ks), uf[ks], acc);
        *(f32x4*)(E + ((size_t)(inst0 + r) * 16 + g) * 128 + 16 * wid + 4 * qd) = acc;
    }
}
__device__ __forceinline__ void p2_scan(const unsigned char* tb, unsigned char* wss) {
    const int tid = tid_opaque();
    const float* E = (const float*)(wss + O_E); bf16_t* XC = (bf16_t*)(wss + O_XC);
    for (int idx = blockIdx.x * NTHREADS + tid; idx < NB * 16 * 64; idx += gridDim.x * NTHREADS) {
        const int b = idx >> 10, g = (idx >> 6) & 15, p = idx & 63;
        const float* a16 = (const float*)(tb + T_A16) + (size_t)(g * 64 + p) * 2; const float ar = a16[0], ai = a16[1];
        float xr = 0.f, xi = 0.f;
#pragma unroll 8
        for (int c = 0; c < S / LC; ++c) { const size_t o = ((size_t)(b * (S / LC) + c) * 16 + g) * 128;
            XC[o + p] = ml::bf1(xr); XC[o + 64 + p] = ml::bf1(xi);
            const float er = E[o + p], ei = E[o + 64 + p];
            const float nr = ar * xr - ai * xi + er, ni = ar * xi + ai * xr + ei; xr = nr; xi = ni; }
    }
}
__device__ __forceinline__ void p3_unit(LAS unsigned char* lds, const bf16_t* z, const Params& P, int l, const unsigned char* tb, int u, const unsigned char* wss, bf16_t* mix) {
    const int tid = tid_opaque(), lane = tid & 63, wid = __builtin_amdgcn_readfirstlane(tid >> 6), r = lane & 15, qd = lane >> 4;
    const int tok0 = u * 256, inst0 = u * 16;
    const bf16_t* XC = (const bf16_t*)(wss + O_XC);
    __syncthreads();
#pragma unroll 1
    for (int g = 0; g < 16; ++g) {
        bf16x8 uf[8]; load_u_frags(z, tok0, g, r, qd, uf);
        bf16x8 xf[4];
#pragma unroll
        for (int ks = 0; ks < 4; ++ks) xf[ks] = *(const bf16x8*)(XC + ((size_t)(inst0 + r) * 16 + g) * 128 + 32 * ks + 8 * qd);
        const bf16_t* KM = (const bf16_t*)(tb + T_KMAT) + (size_t)g * 16 * 256; const bf16_t* FT = (const bf16_t*)(tb + T_F) + (size_t)g * 256 * 128;
        const float4 dsk = *(const float4*)(P.in[I_SD] + l * 256 + g * 16 + 4 * qd);
#pragma unroll
        for (int tt = 0; tt < 2; ++tt) { const int t = 2 * wid + tt;
            f32x4 acc = {0.f, 0.f, 0.f, 0.f};
#pragma unroll
            for (int ks = 0; ks < 8; ++ks) if (2 * ks <= t) { const int tau = t - 2 * ks - (qd >> 1);
                bf16x8 kf = {0, 0, 0, 0, 0, 0, 0, 0};
                if (tau >= 0) kf = *(const bf16x8*)(KM + (size_t)tau * 256 + r * 16 + 8 * (qd & 1));
                acc = mfma16(kf, uf[ks], acc); }
#pragma unroll
            for (int ks = 0; ks < 4; ++ks) acc = mfma16(*(const bf16x8*)(FT + (size_t)(t * 16 + r) * 128 + 32 * ks + 8 * qd), xf[ks], acc);
            const int tok = tok0 + 16 * r + t;
            const u32x2 uw = *(const u32x2*)(z + (size_t)tok * ZW + ZSU + 16 * g + 4 * qd);
            const float y0 = gelu_tanh(acc[0] + dsk.x * ml::bf_lo(uw.x)), y1 = gelu_tanh(acc[1] + dsk.y * ml::bf_hi(uw.x)), y2 = gelu_tanh(acc[2] + dsk.z * ml::bf_lo(uw.y)), y3 = gelu_tanh(acc[3] + dsk.w * ml::bf_hi(uw.y));
            u32x2 o; o.x = pg8::cvt_pk_bf16(y0, y1); o.y = pg8::cvt_pk_bf16(y2, y3);
            *(LAS u32x2*)(lds + (16 * r + t) * YP + (16 * g + 4 * qd) * 2) = o; }
    }
    __syncthreads();
    const bf16_t* GW = (const bf16_t*)(tb + T_GLUW);
    bf16x8 wf[2][8];
#pragma unroll
    for (int nt = 0; nt < 2; ++nt)
#pragma unroll
        for (int ks = 0; ks < 8; ++ks) wf[nt][ks] = *(const bf16x8*)(GW + (size_t)(32 * wid + 16 * nt + r) * 256 + 32 * ks + 8 * qd);
    const float* gb = P.in[I_GLUB] + l * 256;
    const float4 gb0 = *(const float4*)(gb + 32 * wid + 4 * qd), gb1 = *(const float4*)(gb + 32 * wid + 16 + 4 * qd);
#pragma unroll 2
    for (int mt = 0; mt < 16; ++mt) {
        f32x4 a0 = {0.f, 0.f, 0.f, 0.f}, a1 = {0.f, 0.f, 0.f, 0.f};
#pragma unroll
        for (int ks = 0; ks < 8; ++ks) { const bf16x8 yf = *(const LAS bf16x8*)(lds + (16 * mt + r) * YP + (32 * ks + 8 * qd) * 2); a0 = mfma16(wf[0][ks], yf, a0); a1 = mfma16(wf[1][ks], yf, a1); }
        const int row = 16 * mt + r;
        const u32x2 y0 = *(const LAS u32x2*)(lds + row * YP + (32 * wid + 4 * qd) * 2), y1 = *(const LAS u32x2*)(lds + row * YP + (32 * wid + 16 + 4 * qd) * 2);
        bf16_t* op = mix + (size_t)(tok0 + row) * D + 256 + 32 * wid + 4 * qd;
        u32x2 o;
        o.x = pg8::cvt_pk_bf16(ml::bf_lo(y0.x) / (1.f + __expf(-(a0[0] + gb0.x))), ml::bf_hi(y0.x) / (1.f + __expf(-(a0[1] + gb0.y))));
        o.y = pg8::cvt_pk_bf16(ml::bf_lo(y0.y) / (1.f + __expf(-(a0[2] + gb0.z))), ml::bf_hi(y0.y) / (1.f + __expf(-(a0[3] + gb0.w))));
        *(u32x2*)op = o;
        o.x = pg8::cvt_pk_bf16(ml::bf_lo(y1.x) / (1.f + __expf(-(a1[0] + gb1.x))), ml::bf_hi(y1.x) / (1.f + __expf(-(a1[1] + gb1.y))));
        o.y = pg8::cvt_pk_bf16(ml::bf_lo(y1.y) / (1.f + __expf(-(a1[2] + gb1.z))), ml::bf_hi(y1.y) / (1.f + __expf(-(a1[3] + gb1.w))));
        *(u32x2*)(op + 16) = o;
    }
}
static_assert(T_LAYER <= 4 * MiB && O_END <= 48 * MiB && 256 * YP <= LDS_BYTES - 64, "S5 scratch fits");
}
__device__ __forceinline__ void s5_build_tables_fwd(float* ldsf, const Params& P, int l, int g, unsigned char* tb) { s5::build_tables(ldsf, P, l, g, tb); }

__device__ __forceinline__ void sgu_ln_wave(bf16_t* z, const float* lng, const float* lnb, int tok, int lane) {
    u32x2_t* p = (u32x2_t*)(z + (size_t)tok * ZW + ZGV) + lane;
    const u32x2_t w = *p; float4 v; v.x = gelu_tanh(bfl(w.x)); v.y = gelu_tanh(bfh(w.x)); v.z = gelu_tanh(bfl(w.y)); v.w = gelu_tanh(bfh(w.y));
    const float mu = wave_sum(v.x + v.y + v.z + v.w) * (1.f / 256.f);
    const float dx = v.x - mu, dy = v.y - mu, dz = v.z - mu, dw = v.w - mu;
    const float var = wave_sum(dx * dx + dy * dy + dz * dz + dw * dw) * (1.f / 256.f);
    const float rs = rsqrtf(var + EPS);
    const float4 g = ((const float4*)lng)[lane], bb = ((const float4*)lnb)[lane];
    u32x2_t o; o.x = pg8::cvt_pk_bf16(dx * rs * g.x + bb.x, dy * rs * g.y + bb.y); o.y = pg8::cvt_pk_bf16(dz * rs * g.z + bb.z, dw * rs * g.w + bb.w);
    *p = o;
}

__device__ __forceinline__ void ph_mix1(float* lds, const Params& P, int l, bf16_t* z, const float* gates, bf16_t* mix, unsigned char* wsm, unsigned char* wss, const unsigned char* tb) {
    const int G = gridDim.x, bid = blockIdx.x, wave = tid_opaque() >> 6, lane = tid_opaque() & 63;
    for (int u = bid; u < ml::NU; u += G) ml::p1_unit((LAS unsigned char*)lds, z, gates, P, l, u, wsm);
    __syncthreads();
    for (int u = bid; u < NTOK / 256; u += G) s5::p1_unit(z, tb, u, wss);
    {
        const float* sinks = P.in[I_SINK] + l * 4;
        for (int u = bid * 8 + wave; u < 8192; u += G * 8) attn_wave(z, sinks, mix, u, lane);
        for (int tok = bid * 8 + wave; tok < NTOK; tok += G * 8) sgu_ln_wave(z, P.in[I_LNG] + l * 256, P.in[I_LNB] + l * 256, tok, lane);
    }
}

__device__ __forceinline__ void ph_mix2(float* lds, const Params& P, int l, const bf16_t* z, const float* gates, bf16_t* mix, const unsigned char* wsm, const unsigned char* wss, const unsigned char* tb) {
    const int tid = tid_opaque();
    for (int u = blockIdx.x; u < NTOK / 256; u += gridDim.x) s5::p3_unit((LAS unsigned char*)lds, z, P, l, tb, u, wss, mix);
    __syncthreads();
    for (int u = blockIdx.x; u < ml::NU; u += gridDim.x) ml::p3_unit((LAS unsigned char*)lds, z, gates, P, l, u, wsm, mix);
    __syncthreads();
    const float* sw = P.in[I_SGUW] + (size_t)l * 4 * 128 * 128; const float* sb = P.in[I_SGUB] + l * 4 * 128;
    for (int u = blockIdx.x; u < NTOK / 128; u += gridDim.x) {
        const int tok0 = u * 128;
        __syncthreads();
        for (int idx = tid; idx < 128 * 32; idx += NTHREADS) { const int s = idx >> 5, c8 = idx & 31; float v[8]; ld8(z + (size_t)(tok0 + s) * ZW + ZGV + c8 * 8, v);
            *(float4*)&lds[s * 256 + c8 * 8] = make_float4(v[0], v[1], v[2], v[3]); *(float4*)&lds[s * 256 + c8 * 8 + 4] = make_float4(v[4], v[5], v[6], v[7]); }
        __syncthreads();
        const int c = tid & 255, half = tid >> 8, g = c >> 6;
        for (int tt = 0; tt < 64; ++tt) {
            const int t = half * 64 + tt;
            const float* wr = sw + ((size_t)g * 128 + t) * 128;
            float acc = 0.f;
            for (int s = 0; s <= t; ++s) acc += wr[s] * lds[s * 256 + c];
            const float gu = __uint_as_float((unsigned)z[(size_t)(tok0 + t) * ZW + ZGU + c] << 16);
            mix[(size_t)(tok0 + t) * D + 768 + c] = (bf16_t)(pg8::cvt_pk_bf16(gelu_tanh(gu) * (acc + sb[g * 128 + t]), 0.f) & 0xffffu);
        }
    }
    __syncthreads();
}

__device__ __forceinline__ void ph_outproj(LAS unsigned char* ldsb, const bf16_t* mix, const bf16_t* wt, const float* xsrc, float* xout) {
    pg8::StaticOrder S; S.init(NTOK, D, D, D, gridDim.x, blockIdx.x, mix, wt);
    pg8::EpiRes E{xsrc, xout};
    pg8::gemm_phase<pg8::EpiRes, pg8::StaticOrder, false>(ldsb, D, D, S, E);
}

__device__ __forceinline__ void ph_norm_router(const Params& P, int l, const float* x, bf16_t* H, unsigned* cnt, int2* lists) {
    const int wave = tid_opaque() >> 6, lane = tid_opaque() & 63;
    const float* gn = P.in[I_NFG] + l * D;
    const float* wg = P.in[I_RGW] + (size_t)l * D * 4; const float* we = P.in[I_REW] + (size_t)l * D * 32;
    const float* bg = P.in[I_RGB] + l * 4; const float* be = P.in[I_REB] + l * 32;
    for (int r = blockIdx.x * 8 + wave; r < NTOK; r += gridDim.x * 8) {
        const float* xr = x + (size_t)r * D; bf16_t* hr = H + (size_t)r * D;
        float ss = 0.f;
        { const float4* p = (const float4*)xr;
#pragma unroll
          for (int i = 0; i < 4; ++i) { const float4 v = p[lane + 64 * i]; ss += v.x * v.x + v.y * v.y + v.z * v.z + v.w * v.w; } }
        ss = wave_sum(ss);
        const float rs = rsqrtf(ss * (1.f / D) + EPS);
        float lg[36];
#pragma unroll
        for (int c = 0; c < 36; ++c) lg[c] = 0.f;
#pragma unroll 1
        for (int kk = 0; kk < 16; ++kk) {
            const int k = kk * 64 + lane;
            const float hv = xr[k] * rs * gn[k];
            hr[k] = (bf16_t)(pg8::cvt_pk_bf16(hv, 0.f) & 0xffffu);
            const float4 w4 = *(const float4*)(wg + (size_t)k * 4);
            lg[0] += hv * w4.x; lg[1] += hv * w4.y; lg[2] += hv * w4.z; lg[3] += hv * w4.w;
#pragma unroll
            for (int e4 = 0; e4 < 8; ++e4) { const float4 w = *(const float4*)(we + (size_t)k * 32 + e4 * 4);
                lg[4 + e4 * 4] += hv * w.x; lg[5 + e4 * 4] += hv * w.y; lg[6 + e4 * 4] += hv * w.z; lg[7 + e4 * 4] += hv * w.w; }
        }
#pragma unroll
        for (int c = 0; c < 36; ++c) lg[c] = wave_sum(lg[c]);
        if (lane == 0) {
            float gl[4];
#pragma unroll
            for (int j = 0; j < 4; ++j) gl[j] = lg[j] + bg[j];
            int sel = 0; float gm = gl[0];
#pragma unroll
            for (int j = 1; j < 4; ++j) if (gl[j] > gm) { gm = gl[j]; sel = j; }
            float gs = 0.f;
#pragma unroll
            for (int j = 0; j < 4; ++j) gs += expf(gl[j] - gm);
            const float pg = 1.f / gs;
            float ein[8];
#pragma unroll
            for (int j = 0; j < 8; ++j) { const float a0 = lg[4 + j] + be[j], a1 = lg[12 + j] + be[8 + j], a2 = lg[20 + j] + be[16 + j], a3 = lg[28 + j] + be[24 + j];
                ein[j] = sel == 0 ? a0 : (sel == 1 ? a1 : (sel == 2 ? a2 : a3)); }
            int i1 = 0; float v1 = ein[0];
#pragma unroll
            for (int j = 1; j < 8; ++j) if (ein[j] > v1) { v1 = ein[j]; i1 = j; }
            int i2 = -1; float v2 = -3.0e38f;
#pragma unroll
            for (int j = 0; j < 8; ++j) if (j != i1 && ein[j] > v2) { v2 = ein[j]; i2 = j; }
            const float e2 = expf(v2 - v1), den = 1.f / (1.f + e2);
            const float w1 = den * pg, w2 = e2 * den * pg;
            const int ex1 = sel * 8 + i1, ex2 = sel * 8 + i2;
            const unsigned p1 = atomicAdd(&cnt[ex1], 1u), p2 = atomicAdd(&cnt[ex2], 1u);
            lists[(size_t)ex1 * NTOK + p1] = make_int2(r, __float_as_int(w1));
            lists[(size_t)ex2 * NTOK + p2] = make_int2(r, __float_as_int(w2));
        }
    }
}

__device__ __forceinline__ int moe_build_tab(LAS unsigned char* ldsb, const unsigned* cnt) {
    LAS pg8::i32x4* tab = (LAS pg8::i32x4*)(ldsb + TAB_OFF);
    __syncthreads();
    int base = 0;
#pragma unroll 1
    for (int e = 0; e < NEXP; ++e) { const int c = __builtin_amdgcn_readfirstlane((int)cnt[e]), nt = (c + 255) >> 8;
        if ((int)tid_opaque() < nt) tab[base + tid_opaque()] = (pg8::i32x4){e, (int)tid_opaque() * 256, c, 0};
        base += nt; }
    __syncthreads();
    return base;
}
__device__ __forceinline__ void ph_moe1(LAS unsigned char* ldsb, const Params& P, int l, const bf16_t* H, const unsigned* cnt, const int2* lists, bf16_t* act) {
    const int ntiles = moe_build_tab(ldsb, cnt);
    pg8::MoeOrder S; S.tab = (const LAS pg8::i32x4*)(ldsb + TAB_OFF); S.ntiles = ntiles; S.npn = 4; S.G = gridDim.x; S.c = blockIdx.x;
    S.A = (const char*)H; S.atile = 0; S.Bt = (const char*)(P.ws + WS_WGU) + (size_t)l * NEXP * 1024 * D * 2; S.bexp = (size_t)1024 * D * 2; S.btile = (size_t)256 * D * 2; S.lists = lists;
    pg8::EpiAct E{act};
    pg8::gemm_phase<pg8::EpiAct, pg8::MoeOrder, true>(ldsb, D, D, S, E);
}
__device__ __forceinline__ void ph_moe2(LAS unsigned char* ldsb, const Params& P, int l, const bf16_t* act, const unsigned* cnt, const int2* lists, float* x) {
    const int ntiles = moe_build_tab(ldsb, cnt);
    pg8::MoeOrder S; S.tab = (const LAS pg8::i32x4*)(ldsb + TAB_OFF); S.ntiles = ntiles; S.npn = 4; S.G = gridDim.x; S.c = blockIdx.x;
    S.A = (const char*)act; S.atile = (size_t)256 * DE * 2; S.Bt = (const char*)(P.ws + WS_WD) + (size_t)l * NEXP * D * DE * 2; S.bexp = (size_t)D * DE * 2; S.btile = (size_t)256 * DE * 2; S.lists = lists;
    pg8::EpiDown E{x, lists};
    pg8::gemm_phase<pg8::EpiDown, pg8::MoeOrder, false>(ldsb, DE, DE, S, E);
}

__global__ void __launch_bounds__(NTHREADS, 2) fwd_kernel(Params P) {
    extern __shared__ __attribute__((aligned(16))) unsigned char lds_raw[];
    float* lds = (float*)lds_raw;
    volatile LAS unsigned* xbw = (volatile LAS unsigned*)(lds_raw + LDS_BYTES - 16);
    if (threadIdx.x == 0) { xbw[0] = 0u; xbw[1] = 0u; }
    __syncthreads();
    unsigned* ctl = (unsigned*)(P.ws + WS_CTL);
    const bool multi = (P.ph_hi - P.ph_lo) > 1;
    XcdBarrier bar; bar.bar = ctl; bar.x = 0; bar.st = xbw;
    if (multi) bar = xcd_barrier_post(ctl, xbw);
    bf16_t* z = (bf16_t*)(P.ws + WS_Z); float* gates = (float*)(P.ws + WS_GATES); unsigned char* wss = P.ws + WS_S5; bf16_t* mix = (bf16_t*)(P.ws + WS_MIX); unsigned char* wsm = P.ws + WS_HRAW;
    bf16_t* H = (bf16_t*)(P.ws + WS_H); bf16_t* act = (bf16_t*)(P.ws + WS_ACT);
    int2* lists = (int2*)(P.ws + WS_LIST);
    LAS unsigned char* ldsb = (LAS unsigned char*)lds_raw;
    const int lo = P.ph_lo, hi = P.ph_hi;
#define IN(k) (lo <= (k) && (k) < hi)
#define SEAM(k) do { if (IN(k) && IN((k) + 1)) xcd_barrier(bar); } while (0)
    if (IN(0)) { ph_prologue(lds, P); } SEAM(0);
    for (int l = 0; l < NLAYER; ++l) {
        const int pb = 1 + l * PH_PER_LAYER;
        const float* xsrc = (l == 0) ? P.in[I_X] : P.out;
        unsigned* cnt = ctl + CW_CNT + l * 64;
        const unsigned char* tb = P.ws + WS_TB + (size_t)l * 4 * MiB;
        if (IN(pb + 0)) { ph_norm1(xsrc, P.in[I_NMG] + l * D, P.in[I_WIN] + (size_t)l * D * INW, mix, gates); } SEAM(pb + 0);
        if (IN(pb + 1)) { ph_inproj(ldsb, mix, (const bf16_t*)(P.ws + WS_WIN) + (size_t)l * NMAIN * D, z); } SEAM(pb + 1);
        if (IN(pb + 2)) { ph_mix1(lds, P, l, z, gates, mix, wsm, wss, tb); } SEAM(pb + 2);
        if (IN(pb + 3)) { ml::p2_scan(wsm); s5::p2_scan(tb, wss); } SEAM(pb + 3);
        if (IN(pb + 4)) { ph_mix2(lds, P, l, z, gates, mix, wsm, wss, tb); } SEAM(pb + 4);
        if (IN(pb + 5)) { ph_outproj(ldsb, mix, (const bf16_t*)(P.ws + WS_WOUT) + (size_t)l * D * D, xsrc, P.out); } SEAM(pb + 5);
        if (IN(pb + 6)) { ph_norm_router(P, l, P.out, H, cnt, lists); } SEAM(pb + 6);
        if (IN(pb + 7)) { ph_moe1(ldsb, P, l, H, cnt, lists, act); } SEAM(pb + 7);
        if (IN(pb + 8)) { ph_moe2(ldsb, P, l, act, cnt, lists, P.out); } SEAM(pb + 8);
    }
    if (IN(1 + NLAYER * PH_PER_LAYER)) ph_rmsnorm(P.out, P.in[I_NFIN], P.out);
#undef IN
#undef SEAM
}

#ifndef N_LAUNCH_MODE
#define N_LAUNCH_MODE 1
#endif
extern "C" void kernel_launch(void* const* d_in, const int* in_sizes, int n_in, void* d_out, int out_size, void* d_ws, size_t ws_size, hipStream_t stream) {
    static int grid = 0;
    if (grid == 0) {
        if (n_in != 31 || out_size != NTOK * D || ws_size < WS_END) { fprintf(stderr, "kernel_launch: unexpected shapes n_in %d out %d ws %zu (need %zu)\n", n_in, out_size, ws_size, (size_t)WS_END); grid = -1; return; }
        int dev = 0, cus = 0, per_cu = 0;
        if (hipGetDevice(&dev) != hipSuccess || hipDeviceGetAttribute(&cus, hipDeviceAttributeMultiprocessorCount, dev) != hipSuccess) { grid = -1; return; }
        if (hipFuncSetAttribute((const void*)fwd_kernel, hipFuncAttributeMaxDynamicSharedMemorySize, LDS_BYTES) != hipSuccess) { fprintf(stderr, "kernel_launch: hipFuncSetAttribute failed\n"); grid = -1; return; }
        if (hipOccupancyMaxActiveBlocksPerMultiprocessor(&per_cu, (const void*)fwd_kernel, NTHREADS, LDS_BYTES) != hipSuccess || per_cu < 1) { fprintf(stderr, "kernel_launch: occupancy query says %d\n", per_cu); }
        (void)hipGetLastError();
        grid = cus;
    }
    if (grid < 0) return;
    (void)hipMemsetAsync((char*)d_ws + WS_CTL, 0, CTL_BYTES, stream);
    Params p{};
    for (int i = 0; i < 31; ++i) p.in[i] = (const float*)d_in[i];
    p.out = (float*)d_out; p.ws = (unsigned char*)d_ws;
#if N_LAUNCH_MODE == 1
    p.ph_lo = 0; p.ph_hi = N_PHASES;
    hipLaunchKernelGGL(fwd_kernel, dim3(grid), dim3(NTHREADS), LDS_BYTES, stream, p);
#else
    for (int ph = 0; ph < N_PHASES; ++ph) { p.ph_lo = ph; p.ph_hi = ph + 1; hipLaunchKernelGGL(fwd_kernel, dim3(grid), dim3(NTHREADS), LDS_BYTES, stream, p); }
#endif
}
```

```cpp
#include <hip/hip_runtime.h>
#include <stdint.h>
#include <stdio.h>

#define LAS __attribute__((address_space(3)))

constexpr int D = 1024, NB = 8, S = 8192, NTOK = NB * S, INW = 2312, NLAYER = 2;
constexpr int NEXP = 32, DE = 512;
constexpr float EPS = 1e-6f;
constexpr int ZW = 2304;
constexpr int ZQ = 0, ZK = 256, ZV = 384, ZSU = 512, ZCQ = 768, ZCK = 1024, ZCV = 1280, ZCO = 1536, ZGU = 1792, ZGV = 2048, WCI = 1536;
constexpr int NTHREADS = 512;
constexpr int LDS_BYTES = 144 * 1024;
constexpr int TAB_OFF = 128 * 1024;
constexpr int PH_PER_LAYER = 9, N_PHASES = 1 + NLAYER * PH_PER_LAYER + 1;
constexpr int NMAIN = 2304;
typedef unsigned short bf16_t;

constexpr size_t MiB = 1u << 20;
constexpr size_t WS_CTL = 0, CTL_BYTES = 1 * MiB;
constexpr size_t WS_Z = WS_CTL + CTL_BYTES;
constexpr size_t Z_BYTES = (size_t)NTOK * ZW * 2;
constexpr size_t WS_H = WS_Z;
constexpr size_t WS_YB = WS_Z;
constexpr int PMAX = 2 * NTOK + NEXP * 256;
static_assert((size_t)PMAX * D * 2 <= Z_BYTES, "YB alias fits");
constexpr size_t WS_MIX = WS_Z + Z_BYTES;
constexpr size_t WS_ACT = WS_MIX;
static_assert((size_t)PMAX * DE * 2 <= (size_t)NTOK * D * 2 + 64 * MiB, "ACT alias fits");
constexpr size_t WS_HRAW = WS_MIX + (size_t)NTOK * D * 2;
constexpr size_t WS_S5 = WS_HRAW + 64 * MiB;
constexpr size_t WS_GATES = WS_S5 + 48 * MiB;
constexpr size_t WS_LIST = WS_GATES + (size_t)NTOK * 8 * 4;
constexpr size_t WS_WIN = WS_LIST + (size_t)NEXP * NTOK * 8;
constexpr size_t WS_WOUT = WS_WIN + (size_t)NLAYER * NMAIN * D * 2;
constexpr size_t WS_WGU = WS_WOUT + (size_t)NLAYER * D * D * 2;
constexpr size_t WS_WD = WS_WGU + (size_t)NLAYER * NEXP * 1024 * D * 2;
constexpr size_t WS_TB = WS_WD + (size_t)NLAYER * NEXP * D * DE * 2;
constexpr size_t WS_RS = WS_TB + (size_t)NLAYER * 4 * MiB;
constexpr size_t WS_RT = WS_RS + (size_t)NTOK * 4;
constexpr size_t WS_INV = WS_RT + (size_t)NLAYER * 256 * 1024;
constexpr size_t WS_END = WS_INV + (size_t)NLAYER * NTOK * 8;
namespace s5 {
constexpr size_t T_KMAT = 0, T_F = T_KMAT + (size_t)16 * 16 * 256 * 2, T_G = T_F + (size_t)16 * 256 * 128 * 2, T_A16 = T_G + (size_t)16 * 128 * 256 * 2,
                 T_GLUW = T_A16 + (size_t)16 * 64 * 8, T_SGUW = T_GLUW + (size_t)256 * 256 * 2, T_LAYER = T_SGUW + (size_t)4 * 128 * 128 * 2;
}
constexpr int CW_CNT = 8192;

#define XB_TMO      128
#define XB_XCNT(j)  (256  + 64 * (j))
#define XB_XSUB(j)  (1280 + 64 * (j))
#define XB_XGEN(j)  (2304 + 64 * (j))
#define XB_TOP      3328
#define XB_TOPGEN   3392
#define XCD_BAR_WORDS 3456
#define XB_SPIN_CAP (1u << 22)
__device__ __forceinline__ unsigned xb_ld(unsigned* p)              { return __hip_atomic_load(p, __ATOMIC_RELAXED, __HIP_MEMORY_SCOPE_AGENT); }
__device__ __forceinline__ unsigned xb_add(unsigned* p, unsigned v) { return __hip_atomic_fetch_add(p, v, __ATOMIC_RELAXED, __HIP_MEMORY_SCOPE_AGENT); }
__device__ __forceinline__ unsigned xb_xcc_id() { return (unsigned)__builtin_amdgcn_s_getreg((3 << 11) | 20) & 0xFu; }
#define XB_SPIN(cond, bar) do { unsigned _sp = 0; while (cond) { __builtin_amdgcn_s_sleep(1); \
    if ((++_sp & 255u) == 0u) { if (xb_ld(&(bar)[XB_TMO])) break; if (_sp > XB_SPIN_CAP) { atomicAdd(&(bar)[XB_TMO], 1u); break; } } } } while (0)
struct XcdBarrier { unsigned* bar; unsigned x; volatile LAS unsigned* st; };
__device__ __forceinline__ XcdBarrier xcd_barrier_post(unsigned* bar, volatile LAS unsigned* st) {
    XcdBarrier b; b.bar = bar; b.x = xb_xcc_id(); b.st = st;
    if (threadIdx.x == 0) (void)xb_add(&bar[XB_XCNT(b.x)], 1u);
    return b;
}
__device__ __forceinline__ void xcd_barrier_complete(unsigned* bar, unsigned x, unsigned& nloc, unsigned& nx) {
    const unsigned G = gridDim.x * gridDim.y * gridDim.z;
    unsigned sum, cnt, mine, sp = 0u;
    for (;;) {
        sum = 0u; cnt = 0u; mine = 0u;
#pragma unroll
        for (unsigned j = 0; j < 16; ++j) { const unsigned c = xb_ld(&bar[XB_XCNT(j)]); sum += c; cnt += (c > 0u) ? 1u : 0u; mine = (j == x) ? c : mine; }
        if (sum == G) break;
        __builtin_amdgcn_s_sleep(1);
        if ((++sp & 255u) == 0u) { if (xb_ld(&bar[XB_TMO])) break; if (sp > XB_SPIN_CAP) { atomicAdd(&bar[XB_TMO], 1u); break; } }
    }
    nloc = mine > 0u ? mine : 1u; nx = cnt > 0u ? cnt : 1u;
}
__device__ __forceinline__ void xcd_barrier(const XcdBarrier& b) {
    asm volatile("s_waitcnt vmcnt(0)" ::: "memory");
    __syncthreads();
    if (threadIdx.x == 0) {
        unsigned* bar = b.bar;
        __builtin_amdgcn_s_waitcnt(0);
        unsigned nloc = b.st[0], nx = b.st[1];
        if (nloc == 0u) { xcd_barrier_complete(bar, b.x, nloc, nx); b.st[0] = nloc; b.st[1] = nx; }
        const unsigned old = xb_add(&bar[XB_XSUB(b.x)], 1u);
        const unsigned gen = old / nloc;
        if (old + 1u == (gen + 1u) * nloc) {
            __builtin_amdgcn_fence(__ATOMIC_RELEASE, "agent");
            asm volatile("s_waitcnt vmcnt(0)" ::: "memory");
            const unsigned og = xb_add(&bar[XB_TOP], 1u);
            const unsigned tg = og / nx;
            if (og + 1u == (tg + 1u) * nx) xb_add(&bar[XB_TOPGEN], 1u);
            else XB_SPIN(xb_ld(&bar[XB_TOPGEN]) == tg, bar);
            __builtin_amdgcn_fence(__ATOMIC_ACQUIRE, "agent");
            xb_add(&bar[XB_XGEN(b.x)], 1u);
            asm volatile("s_waitcnt vmcnt(0)" ::: "memory");
        } else {
            XB_SPIN(xb_ld(&bar[XB_XGEN(b.x)]) == gen, bar);
            __builtin_amdgcn_fence(__ATOMIC_ACQUIRE, "agent");
            asm volatile("s_waitcnt vmcnt(0)" ::: "memory");
        }
    }
    __syncthreads();
}

__device__ __forceinline__ int tid_opaque() { int t = threadIdx.x; asm volatile("" : "+v"(t)); return t; }
__device__ __forceinline__ float wave_sum(float v) {
#pragma unroll
    for (int o = 32; o > 0; o >>= 1) v += __shfl_xor(v, o);
    return v;
}
__device__ __forceinline__ float gelu_tanh(float x) {
    const float u = 0.7978845608028654f * (x + 0.044715f * x * x * x);
    return 0.5f * x * (1.f + tanhf(u));
}
__device__ __forceinline__ float sigm(float x) { return 1.f / (1.f + expf(-x)); }
__device__ __forceinline__ float bfl(unsigned w) { return __uint_as_float(w << 16); }
__device__ __forceinline__ float bfh(unsigned w) { return __uint_as_float(w & 0xffff0000u); }
typedef unsigned u32x4_t __attribute__((ext_vector_type(4)));
typedef unsigned u32x2_t __attribute__((ext_vector_type(2)));
__device__ __forceinline__ void ld8(const bf16_t* p, float (&o)[8]) { const u32x4_t w = *(const u32x4_t*)p; o[0] = bfl(w.x); o[1] = bfh(w.x); o[2] = bfl(w.y); o[3] = bfh(w.y); o[4] = bfl(w.z); o[5] = bfh(w.z); o[6] = bfl(w.w); o[7] = bfh(w.w); }
__device__ __forceinline__ void wave_lds_fence() {
    __builtin_amdgcn_fence(__ATOMIC_RELEASE, "wavefront"); __builtin_amdgcn_wave_barrier(); __builtin_amdgcn_fence(__ATOMIC_ACQUIRE, "wavefront");
}

struct Params {
    const float* in[31];
    float* out;
    unsigned char* ws;
    int ph_lo, ph_hi;
};
struct Params;
__device__ __forceinline__ const Params* params_fresh() { auto p = __builtin_amdgcn_kernarg_segment_ptr(); asm volatile("" : "+s"(p)); return (const Params*)p; }
#define PF (*params_fresh())
enum { I_X = 0, I_NMG, I_WIN, I_SINK, I_ARE, I_AIM, I_BRE, I_BIM, I_CRE, I_CIM, I_SD, I_LDT, I_GLUW, I_GLUB, I_CONVW, I_GATEB, I_MNG,
       I_LNG, I_LNB, I_SGUW, I_SGUB, I_WOUT, I_NFG, I_RGW, I_RGB, I_REW, I_REB, I_EWG, I_EWU, I_EWD, I_NFIN };

namespace pg8 {
#define PG8_LAS __attribute__((address_space(3)))
typedef short bf16x8 __attribute__((ext_vector_type(8)));
typedef float f32x4 __attribute__((ext_vector_type(4)));
typedef unsigned u32x4 __attribute__((ext_vector_type(4)));
typedef unsigned u32x2 __attribute__((ext_vector_type(2)));
typedef int i32x4 __attribute__((ext_vector_type(4)));
constexpr int BM = 256, BK = 64, HALF = 128, HTB = HALF * BK * 2, STAGE_BYTES = 8 * HTB, NXCD = 8, WGM = 8;
__host__ __device__ __forceinline__ int lds_byte(int r, int c) { const int st = (r >> 4) * 2 + (c >> 5), rr = r & 15, cc = c & 31, ob = rr * 64 + cc * 2; return st * 1024 + (ob ^ (((ob >> 9) & 1) << 5)); }
__host__ __device__ __forceinline__ void stage_rc(int b, int& R, int& C) { const int st = b / 1024, sb = b % 1024, swz = sb ^ (((sb >> 9) & 1) << 5); R = (st >> 1) * 16 + swz / 64; C = (st & 1) * 32 + (swz % 64) / 2; }
__host__ __device__ __forceinline__ int perm32(int rho) { const int n = rho >> 4, i = rho & 15; return 8 * (i >> 2) + 4 * n + (i & 3); }
__device__ __forceinline__ unsigned cvt_pk_bf16(float lo, float hi) { unsigned r; asm volatile("v_cvt_pk_bf16_f32 %0, %1, %2" : "=v"(r) : "v"(lo), "v"(hi)); return r; }

struct Unit { int pm, pn; const char* A; const char* B; int e, pos0, cnt; };

struct StaticOrder {
    int nM, nN, nwg, G, c; const char* A; const char* Bt; size_t atile, btile;
    __device__ void init(int M, int N, int K, int lda, int G_, int c_, const void* A_, const void* Bt_) { nM = M / BM; nN = N / BM; nwg = nM * nN; G = G_; c = c_; A = (const char*)A_; Bt = (const char*)Bt_; atile = (size_t)BM * lda * 2; btile = (size_t)BM * K * 2; }
    __device__ __forceinline__ bool next(int i, Unit& u) const {
        const long L = (long)i * G + c; if (L >= nwg) return false;
        int wgid = (int)L; { const int q = nwg / NXCD, r = nwg % NXCD, xcd = wgid % NXCD, off = wgid / NXCD; wgid = (xcd < r ? xcd * (q + 1) : r * (q + 1) + (xcd - r) * q) + off; }
        const int nig = WGM * nN, gid = wgid / nig, fm = gid * WGM, gsz = (nM - fm) < WGM ? (nM - fm) : WGM;
        u.pm = fm + ((wgid % nig) % gsz); u.pn = (wgid % nig) / gsz; u.A = A + (size_t)u.pm * atile; u.B = Bt + (size_t)u.pn * btile; u.e = 0; u.pos0 = 0; u.cnt = 0; return true;
    }
    __device__ __forceinline__ void aoff(const Unit&, unsigned (&)[2], unsigned (&)[2], const int (&)[2], const int (&)[2]) const {}
};

template <class Epi, class Sched, bool GATHER>
__device__ __forceinline__ void gemm_phase(PG8_LAS unsigned char* lds, const int K, const int lda, const Sched& S, const Epi& E) {
    const int tid = tid_opaque(), wid = __builtin_amdgcn_readfirstlane(tid >> 6), lane = tid & 63, wr = wid >> 2, wc = wid & 3, fr = lane & 15, fq = lane >> 4;
    const int nt = K / BK;
    unsigned vA0[2], vA1[2], vB[2], nA0[2], nA1[2]; int Rs[2], Cs[2];
#pragma unroll
    for (int i = 0; i < 2; ++i) { int R, C; stage_rc(tid * 16 + i * 8192, R, C); const int Rb = Epi::PERM ? ((R & ~31) + perm32(R & 31)) : R;
        Rs[i] = R; Cs[i] = C; vA0[i] = (unsigned)(R * lda + C) * 2u; vA1[i] = vA0[i] + (unsigned)(HALF * lda) * 2u; vB[i] = (unsigned)(Rb * K + C) * 2u; nA0[i] = vA0[i]; nA1[i] = vA1[i]; }
    const size_t kstep = (size_t)(BK * 2);
    const size_t hstep = (size_t)HALF * K * 2;
    const unsigned ldsw = (unsigned)wid * 1024u;
    const int aoff = lds_byte(wr * 64 + fr, fq * 8), boff = lds_byte(wc * 32 + fr, fq * 8);
#define PG8_SA(b, h) (((b) * 2 + (h)) * HTB)
#define PG8_SB(b, h) ((4 + (b) * 2 + (h)) * HTB)
#define PG8_STAGE(bufoff, gbase, voff) do { _Pragma("unroll") for (int _i = 0; _i < 2; ++_i) \
        __builtin_amdgcn_global_load_lds((const unsigned*)((const char*)(gbase) + (voff)[_i]), (PG8_LAS unsigned*)(lds + (bufoff) + ldsw + _i * 8192), 16, 0, 0); } while (0)
#define PG8_LDA(dst, b, h) do { _Pragma("unroll") for (int m = 0; m < 4; ++m) _Pragma("unroll") for (int k = 0; k < 2; ++k) dst[m][k] = *(const PG8_LAS bf16x8*)(lds + PG8_SA(b, h) + aoff + m * 2048 + k * 1024); } while (0)
#define PG8_LDB(dst, b, h) do { _Pragma("unroll") for (int n = 0; n < 2; ++n) _Pragma("unroll") for (int k = 0; k < 2; ++k) dst[n][k] = *(const PG8_LAS bf16x8*)(lds + PG8_SB(b, h) + boff + n * 2048 + k * 1024); } while (0)
#define PG8_MMA(ai, bj, At, Bt) do { __builtin_amdgcn_s_setprio(1); _Pragma("unroll") for (int m = 0; m < 4; ++m) _Pragma("unroll") for (int n = 0; n < 2; ++n) _Pragma("unroll") for (int k = 0; k < 2; ++k) \
        acc[ai][bj][m][n] = __builtin_amdgcn_mfma_f32_16x16x32_bf16(Bt[n][k], At[m][k], acc[ai][bj][m][n], 0, 0, 0); __builtin_amdgcn_s_setprio(0); } while (0)
#define PG8_WAIT_V(n) asm volatile("s_waitcnt vmcnt(" #n ")" ::: "memory")
#define PG8_WAIT_L(n) asm volatile("s_waitcnt lgkmcnt(" #n ")" ::: "memory")
#define PG8_BAR __builtin_amdgcn_s_barrier()
#define PG8_SCHED __builtin_amdgcn_sched_barrier(0)
    Unit cur, nxt; int ui = 0;
    if (!S.next(0, cur)) return;
    if constexpr (GATHER) { S.aoff(cur, vA0, vA1, Rs, Cs); PG8_WAIT_V(0); }
    f32x4 acc[2][2][4][2];
#pragma unroll
    for (int a = 0; a < 2; ++a)
#pragma unroll
        for (int b = 0; b < 2; ++b)
#pragma unroll
            for (int m = 0; m < 4; ++m)
#pragma unroll
                for (int n = 0; n < 2; ++n) acc[a][b][m][n] = (f32x4){0.f, 0.f, 0.f, 0.f};
    bf16x8 At[4][2], B0[2][2], B1[2][2];
    const char* cA = cur.A; const char* cB = cur.B;
    PG8_STAGE(PG8_SB(0, 0), cB, vB); PG8_STAGE(PG8_SB(0, 1), cB + hstep, vB); PG8_STAGE(PG8_SA(0, 0), cA, vA0); PG8_STAGE(PG8_SA(0, 1), cA, vA1);
    if (wr == 1) PG8_BAR;
    PG8_WAIT_V(2); PG8_BAR;
    PG8_STAGE(PG8_SB(1, 0), cB + kstep, vB); PG8_STAGE(PG8_SA(1, 0), cA + kstep, vA0); PG8_STAGE(PG8_SB(1, 1), cB + hstep + kstep, vB);
    PG8_WAIT_V(6); PG8_BAR;
    for (;;) {
        const bool has_next = S.next(ui + 1, nxt);
        const char* nA = has_next ? nxt.A : cA; const char* nB = has_next ? nxt.B : cB;
        if constexpr (GATHER) {
            if (has_next) { S.aoff(nxt, nA0, nA1, Rs, Cs); }
            else {
#pragma unroll
                for (int i = 0; i < 2; ++i) { nA0[i] = vA0[i]; nA1[i] = vA1[i]; } }
        }
        for (int t = 0; t < nt; t += 2) {
            const bool last = (t == nt - 2);
            const char* a1 = cA + (size_t)(t + 1) * kstep;
            const char* a2 = last ? nA : cA + (size_t)(t + 2) * kstep; const char* b2 = last ? nB : cB + (size_t)(t + 2) * kstep;
            const char* a3 = a2 + kstep; const char* b3 = b2 + kstep;
            unsigned x0[2], x1[2];
#pragma unroll
            for (int i = 0; i < 2; ++i) { x0[i] = (GATHER && last) ? nA0[i] : vA0[i]; x1[i] = (GATHER && last) ? nA1[i] : vA1[i]; }
            PG8_LDB(B0, 0, 0); PG8_LDB(B1, 0, 1); PG8_SCHED; PG8_LDA(At, 0, 0); PG8_STAGE(PG8_SA(1, 1), a1, vA1);
            PG8_WAIT_V(8); PG8_WAIT_L(0); PG8_BAR; PG8_MMA(0, 0, At, B0); PG8_MMA(0, 1, At, B1); PG8_BAR; PG8_SCHED;
            PG8_LDA(At, 0, 1); PG8_STAGE(PG8_SB(0, 0), b2, vB); PG8_STAGE(PG8_SB(0, 1), b2 + hstep, vB); PG8_STAGE(PG8_SA(0, 0), a2, x0);
            PG8_WAIT_V(8); PG8_WAIT_L(0); PG8_BAR; PG8_MMA(1, 0, At, B0); PG8_MMA(1, 1, At, B1); PG8_BAR; PG8_SCHED;
            PG8_LDB(B0, 1, 0); PG8_LDB(B1, 1, 1); PG8_SCHED; PG8_LDA(At, 1, 0); PG8_STAGE(PG8_SA(0, 1), a2, x1);
            PG8_WAIT_V(8); PG8_WAIT_L(0); PG8_BAR; PG8_MMA(0, 0, At, B0); PG8_MMA(0, 1, At, B1); PG8_BAR; PG8_SCHED;
            PG8_LDA(At, 1, 1); PG8_STAGE(PG8_SB(1, 0), b3, vB); PG8_STAGE(PG8_SB(1, 1), b3 + hstep, vB); PG8_STAGE(PG8_SA(1, 0), a3, x0);
            PG8_WAIT_V(8); PG8_WAIT_L(0); PG8_BAR; PG8_MMA(1, 0, At, B0); PG8_MMA(1, 1, At, B1); PG8_BAR; PG8_SCHED;
        }
        if (wr == 0) PG8_BAR;
        E(acc, cur, wr, wc, fr, fq);
        if (!has_next) break;
#pragma unroll
        for (int a = 0; a < 2; ++a)
#pragma unroll
            for (int b = 0; b < 2; ++b)
#pragma unroll
                for (int m = 0; m < 4; ++m)
#pragma unroll
                    for (int n = 0; n < 2; ++n) acc[a][b][m][n] = (f32x4){0.f, 0.f, 0.f, 0.f};
        cur = nxt; cA = nA; cB = nB; ++ui;
        if constexpr (GATHER) {
#pragma unroll
            for (int i = 0; i < 2; ++i) { vA0[i] = nA0[i]; vA1[i] = nA1[i]; } }
        if (wr == 1) PG8_BAR;
    }
    PG8_WAIT_V(0);
    PG8_BAR;
#undef PG8_SA
#undef PG8_SB
#undef PG8_STAGE
#undef PG8_LDA
#undef PG8_LDB
#undef PG8_MMA
#undef PG8_WAIT_V
#undef PG8_WAIT_L
#undef PG8_BAR
#undef PG8_SCHED
}

struct EpiZ {
    static constexpr bool PERM = true;
    bf16_t* Z; const float* RS;
    __device__ __forceinline__ void operator()(const f32x4 (&acc)[2][2][4][2], const Unit& u, int wr, int wc, int fr, int fq) const {
        const int row0 = u.pm * BM + wr * 64 + fr, col0 = u.pn * BM + wc * 32 + 8 * fq;
#pragma unroll
        for (int ai = 0; ai < 2; ++ai)
#pragma unroll
            for (int m = 0; m < 4; ++m) { bf16_t* rowp = Z + (size_t)(row0 + ai * HALF + m * 16) * ZW + col0; const float rs = RS[row0 + ai * HALF + m * 16];
#pragma unroll
                for (int bj = 0; bj < 2; ++bj) { const f32x4 v0 = acc[ai][bj][m][0] * rs, v1 = acc[ai][bj][m][1] * rs;
                    u32x4 w; w.x = cvt_pk_bf16(v0[0], v0[1]); w.y = cvt_pk_bf16(v0[2], v0[3]); w.z = cvt_pk_bf16(v1[0], v1[1]); w.w = cvt_pk_bf16(v1[2], v1[3]);
                    *(u32x4*)(rowp + bj * HALF) = w; } }
    }
};
struct EpiRes {
    static constexpr bool PERM = false;
    const float* X; float* O;
    __device__ __forceinline__ void operator()(const f32x4 (&acc)[2][2][4][2], const Unit& u, int wr, int wc, int fr, int fq) const {
        const int row0 = u.pm * BM + wr * 64 + fr, col0 = u.pn * BM + wc * 32 + 4 * fq;
#pragma unroll
        for (int ai = 0; ai < 2; ++ai)
#pragma unroll
            for (int m = 0; m < 4; ++m) { const size_t off = (size_t)(row0 + ai * HALF + m * 16) * D + col0;
#pragma unroll
                for (int bj = 0; bj < 2; ++bj)
#pragma unroll
                    for (int n = 0; n < 2; ++n) { const f32x4 xs = *(const f32x4*)(X + off + bj * HALF + n * 16); *(f32x4*)(O + off + bj * HALF + n * 16) = xs + acc[ai][bj][m][n]; }
                asm volatile("" ::: "memory"); }
    }
};
struct EpiAct {
    static constexpr bool PERM = true;
    bf16_t* ACT; const int2* lists; const float* RS;
    __device__ __forceinline__ void operator()(const f32x4 (&acc)[2][2][4][2], const Unit& u, int wr, int wc, int fr, int fq) const {
        const int row0 = u.pm * BM + wr * 64 + fr, col0 = u.pn * HALF + wc * 32 + 8 * fq; const int2* lst = lists + (size_t)u.e * NTOK + u.pos0;
#pragma unroll
        for (int ai = 0; ai < 2; ++ai)
#pragma unroll
            for (int m = 0; m < 4; ++m) { const int r = ai * HALF + wr * 64 + m * 16 + fr; bf16_t* rowp = ACT + (size_t)(row0 + ai * HALF + m * 16) * DE + col0;
                float rs = 0.f; if (u.pos0 + r < u.cnt) rs = RS[lst[r].x];
                float o[8];
#pragma unroll
                for (int n = 0; n < 2; ++n)
#pragma unroll
                    for (int j = 0; j < 4; ++j) { const float g = acc[ai][0][m][n][j] * rs, up = acc[ai][1][m][n][j] * rs; o[n * 4 + j] = g * up * __builtin_amdgcn_rcpf(1.f + __expf(-g)); }
                u32x4 w; w.x = cvt_pk_bf16(o[0], o[1]); w.y = cvt_pk_bf16(o[2], o[3]); w.z = cvt_pk_bf16(o[4], o[5]); w.w = cvt_pk_bf16(o[6], o[7]);
                *(u32x4*)rowp = w; }
    }
};
struct EpiY {
    static constexpr bool PERM = true;
    bf16_t* YB; const int2* lists;
    __device__ __forceinline__ void operator()(const f32x4 (&acc)[2][2][4][2], const Unit& u, int wr, int wc, int fr, int fq) const {
        const int row0 = u.pm * BM + wr * 64 + fr, col0 = u.pn * BM + wc * 32 + 8 * fq; const int2* lst = lists + (size_t)u.e * NTOK + u.pos0;
#pragma unroll
        for (int ai = 0; ai < 2; ++ai)
#pragma unroll
            for (int m = 0; m < 4; ++m) { const int r = ai * HALF + wr * 64 + m * 16 + fr;
                if (u.pos0 + r < u.cnt) { const float w = __int_as_float(lst[r].y); bf16_t* rowp = YB + (size_t)(row0 + ai * HALF + m * 16) * D + col0;
#pragma unroll
                    for (int bj = 0; bj < 2; ++bj) { const f32x4 v0 = acc[ai][bj][m][0] * w, v1 = acc[ai][bj][m][1] * w;
                        u32x4 o; o.x = cvt_pk_bf16(v0[0], v0[1]); o.y = cvt_pk_bf16(v0[2], v0[3]); o.z = cvt_pk_bf16(v1[0], v1[1]); o.w = cvt_pk_bf16(v1[2], v1[3]);
                        *(u32x4*)(rowp + bj * HALF) = o; } } }
    }
};
struct MoeOrder {
    const PG8_LAS i32x4* tab; int ntiles, npn, G, c; const char* A; size_t atile; const char* Bt; size_t bexp, btile; const int2* lists;
    __device__ __forceinline__ bool next(int i, Unit& u) const {
        const int L = i * G + c; const int T = L / npn; if (T >= ntiles) return false;
        const i32x4 te = tab[T]; u.pm = T; u.pn = L - T * npn; u.e = __builtin_amdgcn_readfirstlane(te.x); u.pos0 = __builtin_amdgcn_readfirstlane(te.y); u.cnt = __builtin_amdgcn_readfirstlane(te.z);
        u.A = A + (size_t)T * atile; u.B = Bt + (size_t)u.e * bexp + (size_t)u.pn * btile; return true;
    }
    __device__ __forceinline__ void aoff(const Unit& u, unsigned (&o0)[2], unsigned (&o1)[2], const int (&Rs)[2], const int (&Cs)[2]) const {
        const int2* lst = lists + (size_t)u.e * NTOK;
#pragma unroll
        for (int i = 0; i < 2; ++i) { const int p0 = u.pos0 + Rs[i], p1 = p0 + HALF;
            const int t0 = (p0 < u.cnt) ? lst[p0].x : 0, t1 = (p1 < u.cnt) ? lst[p1].x : 0;
            o0[i] = (unsigned)t0 * (unsigned)(D * 2) + (unsigned)Cs[i] * 2u; o1[i] = (unsigned)t1 * (unsigned)(D * 2) + (unsigned)Cs[i] * 2u; }
    }
};
}

__device__ __forceinline__ void tc_tile(float* T  , const float* src, int src_ld, int c0, int k0, bf16_t* dst, int K, int n0) {
    const int tid = tid_opaque();
    __syncthreads();
#pragma unroll
    for (int i = 0; i < 2; ++i) { const int kk = (tid >> 4) + 32 * i, c4 = (tid & 15) * 4;
        const float4 v = *(const float4*)(src + (size_t)(k0 + kk) * src_ld + c0 + c4);
        T[kk * 65 + c4] = v.x; T[kk * 65 + c4 + 1] = v.y; T[kk * 65 + c4 + 2] = v.z; T[kk * 65 + c4 + 3] = v.w; }
    __syncthreads();
    const int nl = tid >> 3, kc = (tid & 7) * 8;
    pg8::u32x4 w;
    w.x = pg8::cvt_pk_bf16(T[(kc + 0) * 65 + nl], T[(kc + 1) * 65 + nl]); w.y = pg8::cvt_pk_bf16(T[(kc + 2) * 65 + nl], T[(kc + 3) * 65 + nl]);
    w.z = pg8::cvt_pk_bf16(T[(kc + 4) * 65 + nl], T[(kc + 5) * 65 + nl]); w.w = pg8::cvt_pk_bf16(T[(kc + 6) * 65 + nl], T[(kc + 7) * 65 + nl]);
    *(pg8::u32x4*)(dst + (size_t)(n0 + nl) * K + k0 + kc) = w;
}
__device__ __forceinline__ void s5_build_tables_fwd(float* ldsf, const Params& P, int l, int g, unsigned char* tb);
__device__ __forceinline__ void ph_prologue(float* lds, const Params& P) {
    constexpr int NJ_EXP = NLAYER * NEXP * 384, NJ_IN = NLAYER * 576, NJ_OUT = NLAYER * 256;
    bf16_t* WIN = (bf16_t*)(P.ws + WS_WIN); bf16_t* WOUT = (bf16_t*)(P.ws + WS_WOUT); bf16_t* WGU = (bf16_t*)(P.ws + WS_WGU); bf16_t* WD = (bf16_t*)(P.ws + WS_WD);
    constexpr int NJ_TB = NLAYER * 16, NJ_GLU = NLAYER * 16, NJ_SGU = NLAYER * 4, NJ_RT = NLAYER * 16;
    for (int j = blockIdx.x; j < NJ_EXP + NJ_IN + NJ_OUT + NJ_TB + NJ_GLU + NJ_SGU + NJ_RT; j += gridDim.x) {
        if (j >= NJ_EXP + NJ_IN + NJ_OUT + NJ_TB + NJ_GLU + NJ_SGU) { const int j7 = j - (NJ_EXP + NJ_IN + NJ_OUT + NJ_TB + NJ_GLU + NJ_SGU), l = j7 / 16, n0 = (j7 % 16) * 4;
            bf16_t* wh = (bf16_t*)(P.ws + WS_RT + (size_t)l * 256 * 1024); bf16_t* wl = wh + 48 * D;
            for (int idx = tid_opaque(); idx < 4 * D; idx += NTHREADS) { const int n = n0 + (idx >> 10), k = idx & (D - 1);
                const float w = (n < 4) ? P.in[I_RGW][((size_t)l * D + k) * 4 + n] : ((n < 36) ? P.in[I_REW][((size_t)l * D + k) * 32 + (n - 4)] : ((n >= 48 && n < 56) ? P.in[I_WIN][((size_t)l * D + k) * INW + WCI + (n - 48)] : 0.f));
                const unsigned hb = pg8::cvt_pk_bf16(w, 0.f) & 0xffffu; const bf16_t lb = (bf16_t)(pg8::cvt_pk_bf16(w - __uint_as_float(hb << 16), 0.f) & 0xffffu);
                if (n < 48) { wh[(size_t)n * D + k] = (bf16_t)hb; wl[(size_t)n * D + k] = lb; } else { wh[(size_t)(96 + n - 48) * D + k] = (bf16_t)hb; wh[(size_t)(112 + n - 48) * D + k] = lb; } }
            continue; }
        if (j >= NJ_EXP + NJ_IN + NJ_OUT + NJ_TB + NJ_GLU) { const int j6 = j - (NJ_EXP + NJ_IN + NJ_OUT + NJ_TB + NJ_GLU), l = j6 >> 2, g = j6 & 3;
            bf16_t* wbp = (bf16_t*)(P.ws + WS_TB + (size_t)l * 4 * MiB + s5::T_SGUW) + (size_t)g * 128 * 128; const float* ws_ = P.in[I_SGUW] + ((size_t)l * 4 + g) * 128 * 128;
            for (int idx = tid_opaque(); idx < 128 * 128; idx += NTHREADS) { const int t = idx >> 7, s = idx & 127; wbp[idx] = (s <= t) ? (bf16_t)(pg8::cvt_pk_bf16(ws_[idx], 0.f) & 0xffffu) : (bf16_t)0; }
            continue; }
        if (j < NJ_EXP) {
            const int le = j / 384, r = j % 384;
            if (r < 256) { const int n0 = (r >> 4) * 64, k0 = (r & 15) * 64, pn = n0 >> 8, within = n0 & 255;
                const float* s = (within < 128 ? P.in[I_EWG] : P.in[I_EWU]) + (size_t)le * D * DE;
                tc_tile(lds, s, DE, pn * 128 + (within & 127), k0, WGU + (size_t)le * 1024 * D, D, n0);
            } else { const int r2 = r - 256, n0 = (r2 >> 3) * 64, k0 = (r2 & 7) * 64;
                tc_tile(lds, P.in[I_EWD] + (size_t)le * DE * D, D, n0, k0, WD + (size_t)le * D * DE, DE, n0); }
        } else if (j < NJ_EXP + NJ_IN) {
            const int j2 = j - NJ_EXP, l = j2 / 576, r = j2 % 576, n0 = (r >> 4) * 64, k0 = (r & 15) * 64;
            tc_tile(lds, P.in[I_WIN] + (size_t)l * D * INW, INW, n0 < WCI ? n0 : n0 + 8, k0, WIN + (size_t)l * NMAIN * D, D, n0);
        } else if (j >= NJ_EXP + NJ_IN + NJ_OUT + NJ_TB) {
            const int j5 = j - (NJ_EXP + NJ_IN + NJ_OUT + NJ_TB), l = j5 >> 4, r = j5 & 15, n0 = (r >> 2) * 64, k0 = (r & 3) * 64;
            tc_tile(lds, P.in[I_GLUW] + (size_t)l * 256 * 256, 256, n0, k0, (bf16_t*)(P.ws + WS_TB + (size_t)l * 4 * MiB + s5::T_GLUW), 256, n0);
        } else if (j >= NJ_EXP + NJ_IN + NJ_OUT) {
            const int j4 = j - (NJ_EXP + NJ_IN + NJ_OUT);
            s5_build_tables_fwd(lds, P, j4 >> 4, j4 & 15, P.ws + WS_TB + (size_t)(j4 >> 4) * 4 * MiB);
        } else {
            const int j3 = j - NJ_EXP - NJ_IN, l = j3 / 256, r = j3 % 256, n0 = (r >> 4) * 64, k0 = (r & 15) * 64;
            tc_tile(lds, P.in[I_WOUT] + (size_t)l * D * D, D, n0, k0, WOUT + (size_t)l * D * D, D, n0);
        }
    }
    __syncthreads();
}

template <bool DUAL, class AF, class EF>
__device__ __forceinline__ void gemm_tile(float* lds, AF arow, int K, const float* B0, const float* B1, int ldb, int n0, int N, EF epi) {
    float* As = lds;
    float* Bs0 = lds + 32 * 132;
    float* Bs1 = Bs0 + 32 * 128;
    const int tid = tid_opaque(), ty = tid >> 4, tx = tid & 15;
    float acc0[4][8], acc1[4][8];
#pragma unroll
    for (int i = 0; i < 4; ++i)
#pragma unroll
        for (int j = 0; j < 8; ++j) { acc0[i][j] = 0.f; acc1[i][j] = 0.f; }
    const float* ap0 = arow((tid >> 3));
    const float* ap1 = arow((tid >> 3) + 64);
    const int akk = (tid & 7) * 4;
    const int bn = n0 + (tid & 31) * 4; const bool bok = bn < N;
    for (int k0 = 0; k0 < K; k0 += 32) {
        const float4 av0 = ap0 ? *(const float4*)(ap0 + k0 + akk) : make_float4(0.f, 0.f, 0.f, 0.f);
        const float4 av1 = ap1 ? *(const float4*)(ap1 + k0 + akk) : make_float4(0.f, 0.f, 0.f, 0.f);
        const int kb0 = k0 + (tid >> 5), kb1 = kb0 + 16;
        const float4 bv00 = bok ? *(const float4*)(B0 + (size_t)kb0 * ldb + bn) : make_float4(0.f, 0.f, 0.f, 0.f);
        const float4 bv01 = bok ? *(const float4*)(B0 + (size_t)kb1 * ldb + bn) : make_float4(0.f, 0.f, 0.f, 0.f);
        const float4 bv10 = (DUAL && bok) ? *(const float4*)(B1 + (size_t)kb0 * ldb + bn) : bv00;
        const float4 bv11 = (DUAL && bok) ? *(const float4*)(B1 + (size_t)kb1 * ldb + bn) : bv01;
        __syncthreads();
        { const int r = (tid >> 3);
          As[(akk + 0) * 132 + r] = av0.x; As[(akk + 1) * 132 + r] = av0.y; As[(akk + 2) * 132 + r] = av0.z; As[(akk + 3) * 132 + r] = av0.w;
          As[(akk + 0) * 132 + r + 64] = av1.x; As[(akk + 1) * 132 + r + 64] = av1.y; As[(akk + 2) * 132 + r + 64] = av1.z; As[(akk + 3) * 132 + r + 64] = av1.w; }
        { const int k = (tid >> 5);
          *(float4*)&Bs0[k * 128 + (tid & 31) * 4] = bv00; *(float4*)&Bs0[(k + 16) * 128 + (tid & 31) * 4] = bv01;
          if (DUAL) { *(float4*)&Bs1[k * 128 + (tid & 31) * 4] = bv10; *(float4*)&Bs1[(k + 16) * 128 + (tid & 31) * 4] = bv11; } }
        __syncthreads();
#pragma unroll 4
        for (int k = 0; k < 32; ++k) {
            const float4 a = *(const float4*)&As[k * 132 + ty * 4];
            const float4 b0 = *(const float4*)&Bs0[k * 128 + tx * 4], b1 = *(const float4*)&Bs0[k * 128 + 64 + tx * 4];
            const float aa[4] = {a.x, a.y, a.z, a.w};
            const float bb[8] = {b0.x, b0.y, b0.z, b0.w, b1.x, b1.y, b1.z, b1.w};
#pragma unroll
            for (int i = 0; i < 4; ++i)
#pragma unroll
                for (int j = 0; j < 8; ++j) acc0[i][j] = fmaf(aa[i], bb[j], acc0[i][j]);
            if (DUAL) {
                const float4 c0 = *(const float4*)&Bs1[k * 128 + tx * 4], c1 = *(const float4*)&Bs1[k * 128 + 64 + tx * 4];
                const float cc[8] = {c0.x, c0.y, c0.z, c0.w, c1.x, c1.y, c1.z, c1.w};
#pragma unroll
                for (int i = 0; i < 4; ++i)
#pragma unroll
                    for (int j = 0; j < 8; ++j) acc1[i][j] = fmaf(aa[i], cc[j], acc1[i][j]);
            }
        }
    }
#pragma unroll
    for (int i = 0; i < 4; ++i)
#pragma unroll
        for (int j = 0; j < 8; ++j) {
            const int r = ty * 4 + i, c = n0 + (j < 4 ? tx * 4 + j : 64 + tx * 4 + (j - 4));
            if (c < N) epi(r, c, acc0[i][j], acc1[i][j]);
        }
    __syncthreads();
}

__device__ __forceinline__ void ph_inproj(LAS unsigned char* ldsb, const bf16_t* xn, const bf16_t* wt, bf16_t* z, const float* RS) {
    pg8::StaticOrder S; S.init(NTOK, NMAIN, D, D, gridDim.x, blockIdx.x, xn, wt);
    pg8::EpiZ E{z, RS};
    pg8::gemm_phase<pg8::EpiZ, pg8::StaticOrder, false>(ldsb, D, D, S, E);
}

namespace ml {
using pg8::bf16x8; using pg8::f32x4; using pg8::u32x4; using pg8::u32x2;
constexpr int L = 128, NCH = S / L, NU = NB * 4 * NCH;
constexpr int QP = 144, TP = 272;
constexpr int OFF_Q = 0, OFF_K = OFF_Q + 128 * QP, OFF_VT = OFF_K + 128 * QP, OFF_KT = OFF_VT + 64 * TP, OFF_F = OFF_KT + 64 * TP;
constexpr int LDS_END = OFF_F + 4 * 128 * 4 + 64;
constexpr size_t O_CL = 0, O_CST = O_CL + (size_t)NU * 4096 * 4, O_NL = O_CST + (size_t)NU * 4096 * 2, O_NST = O_NL + (size_t)NU * 64 * 4,
                 O_MLOC = O_NST + (size_t)NU * 64 * 4, O_BL = O_MLOC + (size_t)NU * 4, O_MST = O_BL + (size_t)NU * 4, O_END = O_MST + (size_t)NU * 4;
__device__ __forceinline__ f32x4 mfma16(bf16x8 a, bf16x8 b, f32x4 c) { return __builtin_amdgcn_mfma_f32_16x16x32_bf16(a, b, c, 0, 0, 0); }
__device__ __forceinline__ float bf_lo(unsigned w) { return __uint_as_float(w << 16); }
__device__ __forceinline__ float bf_hi(unsigned w) { return __uint_as_float(w & 0xffff0000u); }
__device__ __forceinline__ unsigned short bf1(float x) { return (unsigned short)(pg8::cvt_pk_bf16(x, 0.f) & 0xffffu); }

__device__ __forceinline__ void stage_gates(LAS unsigned char* lds, const float* gates, const Params& P, int l, int head, int tok0, int tid) {
    LAS float* LF = (LAS float*)(lds + OFF_F); LAS float* IG = LF + 128; LAS float* Bc = LF + 256; LAS float* G2 = LF + 384; LAS float* scal = LF + 512;
    if (tid < 128) { const float* zr = gates + (size_t)(tok0 + tid) * 8;
        const float ipre = zr[head] + P.in[I_GATEB][l * 8 + head], fpre = zr[4 + head] + P.in[I_GATEB][l * 8 + 4 + head];
        LF[tid] = fminf(fpre, 0.f) - log1pf(expf(-fabsf(fpre))); IG[tid] = ipre; }
    __syncthreads();
    if (tid < 64) { const float a = LF[2 * tid], b2 = LF[2 * tid + 1]; const float s = a + b2; float inc = s;
#pragma unroll
        for (int o = 1; o < 64; o <<= 1) { const float v = __shfl_up(inc, o); if (tid >= o) inc += v; }
        const float exc = inc - s; const float b0 = exc + a, b1 = exc + s;
        Bc[2 * tid] = b0; Bc[2 * tid + 1] = b1; const float g0 = IG[2 * tid] - b0, g1 = IG[2 * tid + 1] - b1; G2[2 * tid] = g0; G2[2 * tid + 1] = g1;
        float gm = fmaxf(g0, g1);
#pragma unroll
        for (int o = 32; o > 0; o >>= 1) gm = fmaxf(gm, __shfl_xor(gm, o));
        if (tid == 63) { scal[0] = gm; scal[1] = b1; } }
    __syncthreads();
}
__device__ __forceinline__ void conv8(const bf16_t* z, const float* cw, int b, int pos, int which, int head, int c0, float (&o)[8]) {
    const int col = (which ? ZCK : ZCQ) + head * 64 + c0, cc = which * 256 + head * 64 + c0;
    float x[8];
#pragma unroll
    for (int e = 0; e < 8; ++e) x[e] = 0.f;
#pragma unroll
    for (int j = 0; j < 4; ++j) { const int tg = pos - 3 + j;
        if (tg >= 0) { float v[8]; ld8(z + (size_t)(b * S + tg) * ZW + col, v);
            const float4 w0 = *(const float4*)(cw + j * 512 + cc), w1 = *(const float4*)(cw + j * 512 + cc + 4);
            x[0] += w0.x * v[0]; x[1] += w0.y * v[1]; x[2] += w0.z * v[2]; x[3] += w0.w * v[3]; x[4] += w1.x * v[4]; x[5] += w1.y * v[5]; x[6] += w1.z * v[6]; x[7] += w1.w * v[7]; } }
    const float sc = which ? 0.125f : 1.f;
#pragma unroll
    for (int e = 0; e < 8; ++e) o[e] = x[e] * sc / (1.f + __expf(-x[e]));
}
__device__ __forceinline__ void stage_vt(LAS unsigned char* lds, const bf16_t* z, int head, int tok0, int tid) {
#pragma unroll
    for (int it = 0; it < 2; ++it) { const int idx = tid + it * NTHREADS, s = idx & 127, cg = idx >> 7;
        const u32x4 w = *(const u32x4*)(z + (size_t)(tok0 + s) * ZW + ZCV + head * 64 + cg * 8);
        const unsigned ww[4] = {w.x, w.y, w.z, w.w};
#pragma unroll
        for (int e = 0; e < 8; ++e) *(LAS unsigned short*)(lds + OFF_VT + (cg * 8 + e) * TP + s * 2) = (unsigned short)((e & 1) ? (ww[e >> 1] >> 16) : (ww[e >> 1] & 0xffffu)); }
}

__device__ __forceinline__ void p1_unit(LAS unsigned char* lds, const bf16_t* z, const float* gates, const Params& P, int l, int u, unsigned char* wsm) {
    const int tid = tid_opaque(), lane = tid & 63, wid = __builtin_amdgcn_readfirstlane(tid >> 6), r = lane & 15, qd = lane >> 4;
    const int b = u >> 8, head = (u >> 6) & 3, c = u & 63, tok0 = b * S + c * L;
    LAS float* G2 = (LAS float*)(lds + OFF_F) + 384; LAS float* scal = (LAS float*)(lds + OFF_F) + 512;
    __syncthreads();
    stage_gates(lds, gates, P, l, head, tok0, tid);
    const float gmax = scal[0], bL = scal[1];
    stage_vt(lds, z, head, tok0, tid);
    const float* cw = P.in[I_CONVW] + (size_t)l * 4 * 512;
#pragma unroll
    for (int it = 0; it < 2; ++it) { const int idx = tid + it * NTHREADS, s = idx & 127, cg = idx >> 7;
        float o[8]; conv8(z, cw, b, c * L + s, 1, head, cg * 8, o);
        const float ws = __expf(G2[s] - gmax);
#pragma unroll
        for (int e = 0; e < 8; ++e) *(LAS unsigned short*)(lds + OFF_KT + (cg * 8 + e) * TP + s * 2) = bf1(o[e] * ws); }
    __syncthreads();
    const int kt = wid >> 1;
    float* CL = (float*)(wsm + O_CL) + (size_t)u * 4096;
#pragma unroll
    for (int i = 0; i < 2; ++i) { const int vt = (wid & 1) * 2 + i; f32x4 acc = {0.f, 0.f, 0.f, 0.f};
#pragma unroll
        for (int ks = 0; ks < 4; ++ks) { const bf16x8 a = *(const LAS bf16x8*)(lds + OFF_KT + (16 * kt + r) * TP + (32 * ks + 8 * qd) * 2), bb = *(const LAS bf16x8*)(lds + OFF_VT + (16 * vt + r) * TP + (32 * ks + 8 * qd) * 2);
            acc = mfma16(a, bb, acc); }
        *(f32x4*)(CL + (size_t)(16 * vt + r) * 64 + 16 * kt + 4 * qd) = acc; }
    if (tid < 64) { float sum = 0.f;
        for (int s2 = 0; s2 < 128; s2 += 2) { const unsigned w2 = *(const LAS unsigned*)(lds + OFF_KT + tid * TP + s2 * 2); sum += bf_lo(w2) + bf_hi(w2); }
        ((float*)(wsm + O_NL))[(size_t)u * 64 + tid] = sum; }
    if (tid == 0) { ((float*)(wsm + O_MLOC))[u] = bL + gmax; ((float*)(wsm + O_BL))[u] = bL; }
}
__device__ __forceinline__ void p2_scan(unsigned char* wsm) {
    const int tid = tid_opaque();
    const float* __restrict__ CL = (const float*)(wsm + O_CL); const float* __restrict__ NL = (const float*)(wsm + O_NL); const float* __restrict__ MLOC = (const float*)(wsm + O_MLOC); const float* __restrict__ BL = (const float*)(wsm + O_BL);
    bf16_t* __restrict__ CST = (bf16_t*)(wsm + O_CST); float* __restrict__ NST = (float*)(wsm + O_NST); float* __restrict__ MST = (float*)(wsm + O_MST);
    for (int idx = blockIdx.x * NTHREADS + tid; idx < 32 * 4096; idx += gridDim.x * NTHREADS) {
        const int bh = idx >> 12, e = idx & 4095;
        float C = 0.f, nn = 0.f, m = 0.f;
#pragma unroll 4
        for (int c = 0; c < NCH; ++c) { const int u = bh * NCH + c;
            CST[(size_t)u * 4096 + e] = bf1(C);
            if (e < 64) NST[(size_t)u * 64 + e] = nn;
            if (e == 0) MST[u] = m;
            const float mloc = MLOC[u], bL = BL[u], mn = fmaxf(bL + m, mloc), dec = __expf(bL + m - mn), wl = __expf(mloc - mn);
            C = dec * C + wl * CL[(size_t)u * 4096 + e];
            if (e < 64) nn = dec * nn + wl * NL[(size_t)u * 64 + e];
            m = mn; }
    }
}
__device__ __forceinline__ void p3_unit(LAS unsigned char* lds, const bf16_t* z, const float* gates, const Params& P, int l, int u, const unsigned char* wsm, bf16_t* mix) {
    const int tid = tid_opaque(), lane = tid & 63, wid = __builtin_amdgcn_readfirstlane(tid >> 6), r = lane & 15, qd = lane >> 4;
    const int b = u >> 8, head = (u >> 6) & 3, c = u & 63, tok0 = b * S + c * L;
    LAS float* Bc = (LAS float*)(lds + OFF_F) + 256; LAS float* G2 = (LAS float*)(lds + OFF_F) + 384;
    __syncthreads();
    stage_gates(lds, gates, P, l, head, tok0, tid);
    stage_vt(lds, z, head, tok0, tid);
    const float* cw = P.in[I_CONVW] + (size_t)l * 4 * 512;
#pragma unroll
    for (int it = 0; it < 4; ++it) { const int idx = tid + it * NTHREADS, which = idx >> 10, s = (idx >> 3) & 127, cg = idx & 7;
        float o[8]; conv8(z, cw, b, c * L + s, which, head, cg * 8, o);
        u32x4 w; w.x = pg8::cvt_pk_bf16(o[0], o[1]); w.y = pg8::cvt_pk_bf16(o[2], o[3]); w.z = pg8::cvt_pk_bf16(o[4], o[5]); w.w = pg8::cvt_pk_bf16(o[6], o[7]);
        *(LAS u32x4*)(lds + (which ? OFF_K : OFF_Q) + s * QP + cg * 16) = w; }
    __syncthreads();
    const int w = wid, t = 16 * w + r;
    const bf16x8 bq0 = *(const LAS bf16x8*)(lds + OFF_Q + t * QP + qd * 16), bq1 = *(const LAS bf16x8*)(lds + OFF_Q + t * QP + 64 + qd * 16);
    f32x4 accS[8];
#pragma unroll
    for (int ct = 0; ct < 8; ++ct) { accS[ct] = (f32x4){0.f, 0.f, 0.f, 0.f};
        if (ct <= w) { const bf16x8 a0 = *(const LAS bf16x8*)(lds + OFF_K + (16 * ct + r) * QP + qd * 16), a1 = *(const LAS bf16x8*)(lds + OFF_K + (16 * ct + r) * QP + 64 + qd * 16);
            accS[ct] = mfma16(a0, bq0, accS[ct]); accS[ct] = mfma16(a1, bq1, accS[ct]); } }
    const float bt = Bc[t], mst = ((const float*)(wsm + O_MST))[u];
    float ld[8][4]; float mloc = -3.0e38f;
#pragma unroll
    for (int ct = 0; ct < 8; ++ct) { const f32x4 g = *(const LAS f32x4*)(G2 + 16 * ct + 4 * qd);
#pragma unroll
        for (int j = 0; j < 4; ++j) { const bool valid = (ct < w) || (ct == w && 4 * qd + j <= r); ld[ct][j] = valid ? bt + g[j] : -3.0e38f; mloc = fmaxf(mloc, ld[ct][j]); } }
    mloc = fmaxf(mloc, __shfl_xor(mloc, 16)); mloc = fmaxf(mloc, __shfl_xor(mloc, 32));
    const float mt = fmaxf(bt + mst, mloc);
    float den = 0.f;
#pragma unroll
    for (int ct = 0; ct < 8; ++ct)
#pragma unroll
        for (int j = 0; j < 4; ++j) { const float pe = __expf(ld[ct][j] - mt) * accS[ct][j]; accS[ct][j] = pe; den += pe; }
    den += __shfl_xor(den, 16); den += __shfl_xor(den, 32);
    const bf16_t* cst = (const bf16_t*)(wsm + O_CST) + (size_t)u * 4096; const float* nst = (const float*)(wsm + O_NST) + (size_t)u * 64;
    f32x4 accN[4];
#pragma unroll
    for (int dt = 0; dt < 4; ++dt) { const bf16x8 c0 = *(const bf16x8*)(cst + (16 * dt + r) * 64 + 8 * qd), c1 = *(const bf16x8*)(cst + (16 * dt + r) * 64 + 32 + 8 * qd);
        accN[dt] = mfma16(c0, bq0, (f32x4){0.f, 0.f, 0.f, 0.f}); accN[dt] = mfma16(c1, bq1, accN[dt]); }
    const float winter = __expf(bt + mst - mt);
    float nq = 0.f;
    { const float4 n0 = *(const float4*)(nst + 8 * qd), n1 = *(const float4*)(nst + 8 * qd + 4), n2 = *(const float4*)(nst + 32 + 8 * qd), n3 = *(const float4*)(nst + 36 + 8 * qd);
      const u32x4 q0 = __builtin_bit_cast(u32x4, bq0), q1 = __builtin_bit_cast(u32x4, bq1);
      nq = bf_lo(q0.x) * n0.x + bf_hi(q0.x) * n0.y + bf_lo(q0.y) * n0.z + bf_hi(q0.y) * n0.w + bf_lo(q0.z) * n1.x + bf_hi(q0.z) * n1.y + bf_lo(q0.w) * n1.z + bf_hi(q0.w) * n1.w
         + bf_lo(q1.x) * n2.x + bf_hi(q1.x) * n2.y + bf_lo(q1.y) * n2.z + bf_hi(q1.y) * n2.w + bf_lo(q1.z) * n3.x + bf_hi(q1.z) * n3.y + bf_lo(q1.w) * n3.z + bf_hi(q1.w) * n3.w; }
    nq += __shfl_xor(nq, 16); nq += __shfl_xor(nq, 32);
    den += winter * nq;
#pragma unroll
    for (int dt = 0; dt < 4; ++dt) accN[dt] = accN[dt] * winter;
#pragma unroll
    for (int kk = 0; kk < 4; ++kk) if (2 * kk <= w) {
        u32x4 pw; pw.x = pg8::cvt_pk_bf16(accS[2 * kk][0], accS[2 * kk][1]); pw.y = pg8::cvt_pk_bf16(accS[2 * kk][2], accS[2 * kk][3]);
        pw.z = pg8::cvt_pk_bf16(accS[2 * kk + 1][0], accS[2 * kk + 1][1]); pw.w = pg8::cvt_pk_bf16(accS[2 * kk + 1][2], accS[2 * kk + 1][3]);
        const bf16x8 pf = __builtin_bit_cast(bf16x8, pw);
#pragma unroll
        for (int dt = 0; dt < 4; ++dt) { const u32x2 v0 = *(const LAS u32x2*)(lds + OFF_VT + (16 * dt + r) * TP + (32 * kk + 4 * qd) * 2), v1 = *(const LAS u32x2*)(lds + OFF_VT + (16 * dt + r) * TP + (32 * kk + 16 + 4 * qd) * 2);
            u32x4 vw; vw.x = v0.x; vw.y = v0.y; vw.z = v1.x; vw.w = v1.y;
            accN[dt] = mfma16(__builtin_bit_cast(bf16x8, vw), pf, accN[dt]); } }
    const float inv = 1.f / fmaxf(fabsf(den), __expf(-mt));
    float ss = 0.f;
#pragma unroll
    for (int dt = 0; dt < 4; ++dt) { accN[dt] = accN[dt] * inv; ss += accN[dt][0] * accN[dt][0] + accN[dt][1] * accN[dt][1] + accN[dt][2] * accN[dt][2] + accN[dt][3] * accN[dt][3]; }
    ss += __shfl_xor(ss, 16); ss += __shfl_xor(ss, 32);
    const float rs = rsqrtf(ss * (1.f / 64.f) + EPS);
    const float* ng = P.in[I_MNG] + l * 256 + head * 64; const bf16_t* cop = z + (size_t)(tok0 + t) * ZW + ZCO + head * 64;
    bf16_t* op = mix + (size_t)(tok0 + t) * D + 512 + head * 64;
#pragma unroll
    for (int dt = 0; dt < 4; ++dt) { const int d0 = 16 * dt + 4 * qd; const float4 g = *(const float4*)(ng + d0); const u32x2 cw2 = *(const u32x2*)(cop + d0); const float4 co = make_float4(bf_lo(cw2.x), bf_hi(cw2.x), bf_lo(cw2.y), bf_hi(cw2.y));
        u32x2 o; o.x = pg8::cvt_pk_bf16(accN[dt][0] * rs * g.x / (1.f + __expf(-co.x)), accN[dt][1] * rs * g.y / (1.f + __expf(-co.y)));
        o.y = pg8::cvt_pk_bf16(accN[dt][2] * rs * g.z / (1.f + __expf(-co.z)), accN[dt][3] * rs * g.w / (1.f + __expf(-co.w)));
        *(u32x2*)(op + d0) = o; }
}
static_assert(O_END <= 64 * MiB && LDS_END <= 128 * 1024, "mLSTM scratch fits");
}

namespace s5 {
using pg8::bf16x8; using pg8::f32x4; using pg8::u32x4; using pg8::u32x2;
constexpr int LC = 16, NINST = NTOK / LC;
constexpr size_t O_E = 0, O_XC = O_E + (size_t)NINST * 16 * 128 * 4, O_END = O_XC + (size_t)NINST * 16 * 128 * 2;
constexpr int YP = 528;
__device__ __forceinline__ f32x4 mfma16(bf16x8 a, bf16x8 b, f32x4 c) { return __builtin_amdgcn_mfma_f32_16x16x32_bf16(a, b, c, 0, 0, 0); }

__device__ __forceinline__ void build_tables(float* ldsf, const Params& P, int l, int g, unsigned char* tb) {
    const int tid = tid_opaque();
    float* apw = ldsf; float* bb = apw + 17 * 64 * 2; float* cc = bb + 64 * 16 * 2;
    __syncthreads();
    if (tid < 64) { const int gp = (l * 16 + g) * 64 + tid;
        const float ar = P.in[I_ARE][gp], ai = P.in[I_AIM][gp], dt = expf(P.in[I_LDT][l * 16 + g]);
        for (int tau = 0; tau <= 16; ++tau) { const float er = expf(ar * dt * tau), ang = ai * dt * tau; apw[(tau * 64 + tid) * 2] = er * cosf(ang); apw[(tau * 64 + tid) * 2 + 1] = er * sinf(ang); }
        const float abr = apw[(64 + tid) * 2], abi = apw[(64 + tid) * 2 + 1];
        const float xr_ = abr - 1.f, xi_ = abi, den = ar * ar + ai * ai;
        const float cr = (xr_ * ar + xi_ * ai) / den, ci = (xi_ * ar - xr_ * ai) / den;
        for (int h = 0; h < 16; ++h) { const float br = P.in[I_BRE][(size_t)gp * 16 + h], bi = P.in[I_BIM][(size_t)gp * 16 + h]; bb[(tid * 16 + h) * 2] = cr * br - ci * bi; bb[(tid * 16 + h) * 2 + 1] = cr * bi + ci * br; }
        float* a16 = (float*)(tb + T_A16) + (size_t)(g * 64 + tid) * 2; a16[0] = apw[(16 * 64 + tid) * 2]; a16[1] = apw[(16 * 64 + tid) * 2 + 1]; }
    for (int idx = tid; idx < 16 * 64; idx += NTHREADS) { const int h = idx >> 6, p = idx & 63; const int ci_ = ((l * 16 + g) * 16 + h) * 64 + p; cc[idx * 2] = P.in[I_CRE][ci_]; cc[idx * 2 + 1] = P.in[I_CIM][ci_]; }
    __syncthreads();
    bf16_t* KM = (bf16_t*)(tb + T_KMAT) + (size_t)g * 16 * 256; bf16_t* FT = (bf16_t*)(tb + T_F) + (size_t)g * 256 * 128; bf16_t* GT = (bf16_t*)(tb + T_G) + (size_t)g * 128 * 256;
    for (int idx = tid; idx < 16 * 256; idx += NTHREADS) { const int tau = idx >> 8, h = (idx >> 4) & 15, hp = idx & 15; float s = 0.f;
        for (int p = 0; p < 64; ++p) { const float cr = cc[(h * 64 + p) * 2], ci = cc[(h * 64 + p) * 2 + 1], ar = apw[(tau * 64 + p) * 2], ai = apw[(tau * 64 + p) * 2 + 1], br = bb[(p * 16 + hp) * 2], bi = bb[(p * 16 + hp) * 2 + 1];
            const float er = ar * br - ai * bi, ei = ar * bi + ai * br; s += cr * er - ci * ei; }
        KM[idx] = ml::bf1(s); }
    for (int idx = tid; idx < 256 * 64; idx += NTHREADS) { const int n = idx >> 6, p = idx & 63, t = n >> 4, h = n & 15;
        const float cr = cc[(h * 64 + p) * 2], ci = cc[(h * 64 + p) * 2 + 1], ar = apw[((t + 1) * 64 + p) * 2], ai = apw[((t + 1) * 64 + p) * 2 + 1];
        FT[(size_t)n * 128 + p] = ml::bf1(cr * ar - ci * ai); FT[(size_t)n * 128 + 64 + p] = ml::bf1(-(cr * ai + ci * ar)); }
    for (int idx = tid; idx < 64 * 256; idx += NTHREADS) { const int p = idx >> 8, k = idx & 255, s = k >> 4, hp = k & 15;
        const float ar = apw[((15 - s) * 64 + p) * 2], ai = apw[((15 - s) * 64 + p) * 2 + 1], br = bb[(p * 16 + hp) * 2], bi = bb[(p * 16 + hp) * 2 + 1];
        GT[(size_t)p * 256 + k] = ml::bf1(ar * br - ai * bi); GT[(size_t)(64 + p) * 256 + k] = ml::bf1(ar * bi + ai * br); }
}
__device__ __forceinline__ void load_u_frags(const bf16_t* z, int tok0, int g, int r, int qd, bf16x8 (&uf)[8]) {
#pragma unroll
    for (int ks = 0; ks < 8; ++ks) uf[ks] = *(const bf16x8*)(z + (size_t)(tok0 + 16 * r + 2 * ks + (qd >> 1)) * ZW + ZSU + 16 * g + 8 * (qd & 1));
}
__device__ __forceinline__ void p1_unit(const bf16_t* z, const unsigned char* tb, int u, unsigned char* wss) {
    const int tid = tid_opaque(), lane = tid & 63, wid = __builtin_amdgcn_readfirstlane(tid >> 6), r = lane & 15, qd = lane >> 4;
    const int tok0 = u * 256, inst0 = u * 16;
    float* E = (float*)(wss + O_E);
#pragma unroll 1
    for (int g = 0; g < 16; ++g) {
        bf16x8 uf[8]; load_u_frags(z, tok0, g, r, qd, uf);
        const bf16_t* GT = (const bf16_t*)(tb + T_G) + (size_t)g * 128 * 256 + (size_t)(16 * wid + r) * 256 + 8 * qd;
        f32x4 acc = {0.f, 0.f, 0.f, 0.f};
#pragma unroll
        for (int ks = 0; ks < 8; ++ks) acc = mfma16(*(const bf16x8*)(GT + 32 * ks), uf[ks], acc);
        *(f32x4*)(E + ((size_t)(inst0 + r) * 16 + g) * 128 + 16 * wid + 4 * qd) = acc;
    }
}
__device__ __forceinline__ void p2_scan(const unsigned char* tb, unsigned char* wss) {
    const int tid = tid_opaque();
    const float* __restrict__ E = (const float*)(wss + O_E); bf16_t* __restrict__ XC = (bf16_t*)(wss + O_XC);
    for (int idx = blockIdx.x * NTHREADS + tid; idx < NB * 16 * 64; idx += gridDim.x * NTHREADS) {
        const int b = idx >> 10, g = (idx >> 6) & 15, p = idx & 63;
        const float* a16 = (const float*)(tb + T_A16) + (size_t)(g * 64 + p) * 2; const float ar = a16[0], ai = a16[1];
        float xr = 0.f, xi = 0.f;
#pragma unroll 8
        for (int c = 0; c < S / LC; ++c) { const size_t o = ((size_t)(b * (S / LC) + c) * 16 + g) * 128;
            XC[o + p] = ml::bf1(xr); XC[o + 64 + p] = ml::bf1(xi);
            const float er = E[o + p], ei = E[o + 64 + p];
            const float nr = ar * xr - ai * xi + er, ni = ar * xi + ai * xr + ei; xr = nr; xi = ni; }
    }
}
__device__ __forceinline__ void p3_unit(LAS unsigned char* lds, const bf16_t* z, const Params& P, int l, const unsigned char* tb, int u, const unsigned char* wss, bf16_t* mix) {
    const int tid = tid_opaque(), lane = tid & 63, wid = __builtin_amdgcn_readfirstlane(tid >> 6), r = lane & 15, qd = lane >> 4;
    const int tok0 = u * 256, inst0 = u * 16;
    const bf16_t* XC = (const bf16_t*)(wss + O_XC);
    __syncthreads();
#pragma unroll 1
    for (int g = 0; g < 16; ++g) {
        bf16x8 uf[8]; load_u_frags(z, tok0, g, r, qd, uf);
        bf16x8 xf[4];
#pragma unroll
        for (int ks = 0; ks < 4; ++ks) xf[ks] = *(const bf16x8*)(XC + ((size_t)(inst0 + r) * 16 + g) * 128 + 32 * ks + 8 * qd);
        const bf16_t* KM = (const bf16_t*)(tb + T_KMAT) + (size_t)g * 16 * 256; const bf16_t* FT = (const bf16_t*)(tb + T_F) + (size_t)g * 256 * 128;
        const float4 dsk = *(const float4*)(P.in[I_SD] + l * 256 + g * 16 + 4 * qd);
#pragma unroll
        for (int tt = 0; tt < 2; ++tt) { const int t = 2 * wid + tt;
            f32x4 acc = {0.f, 0.f, 0.f, 0.f};
#pragma unroll
            for (int ks = 0; ks < 8; ++ks) if (2 * ks <= t) { const int tau = t - 2 * ks - (qd >> 1);
                bf16x8 kf = {0, 0, 0, 0, 0, 0, 0, 0};
                if (tau >= 0) kf = *(const bf16x8*)(KM + (size_t)tau * 256 + r * 16 + 8 * (qd & 1));
                acc = mfma16(kf, uf[ks], acc); }
#pragma unroll
            for (int ks = 0; ks < 4; ++ks) acc = mfma16(*(const bf16x8*)(FT + (size_t)(t * 16 + r) * 128 + 32 * ks + 8 * qd), xf[ks], acc);
            const int tok = tok0 + 16 * r + t;
            const u32x2 uw = *(const u32x2*)(z + (size_t)tok * ZW + ZSU + 16 * g + 4 * qd);
            const float y0 = gelu_tanh(acc[0] + dsk.x * ml::bf_lo(uw.x)), y1 = gelu_tanh(acc[1] + dsk.y * ml::bf_hi(uw.x)), y2 = gelu_tanh(acc[2] + dsk.z * ml::bf_lo(uw.y)), y3 = gelu_tanh(acc[3] + dsk.w * ml::bf_hi(uw.y));
            u32x2 o; o.x = pg8::cvt_pk_bf16(y0, y1); o.y = pg8::cvt_pk_bf16(y2, y3);
            *(LAS u32x2*)(lds + (16 * r + t) * YP + (16 * g + 4 * qd) * 2) = o; }
    }
    __syncthreads();
    const bf16_t* GW = (const bf16_t*)(tb + T_GLUW);
    bf16x8 wf[2][8];
#pragma unroll
    for (int nt = 0; nt < 2; ++nt)
#pragma unroll
        for (int ks = 0; ks < 8; ++ks) wf[nt][ks] = *(const bf16x8*)(GW + (size_t)(32 * wid + 16 * nt + r) * 256 + 32 * ks + 8 * qd);
    const float* gb = P.in[I_GLUB] + l * 256;
    const float4 gb0 = *(const float4*)(gb + 32 * wid + 4 * qd), gb1 = *(const float4*)(gb + 32 * wid + 16 + 4 * qd);
#pragma unroll 2
    for (int mt = 0; mt < 16; ++mt) {
        f32x4 a0 = {0.f, 0.f, 0.f, 0.f}, a1 = {0.f, 0.f, 0.f, 0.f};
#pragma unroll
        for (int ks = 0; ks < 8; ++ks) { const bf16x8 yf = *(const LAS bf16x8*)(lds + (16 * mt + r) * YP + (32 * ks + 8 * qd) * 2); a0 = mfma16(wf[0][ks], yf, a0); a1 = mfma16(wf[1][ks], yf, a1); }
        const int row = 16 * mt + r;
        const u32x2 y0 = *(const LAS u32x2*)(lds + row * YP + (32 * wid + 4 * qd) * 2), y1 = *(const LAS u32x2*)(lds + row * YP + (32 * wid + 16 + 4 * qd) * 2);
        bf16_t* op = mix + (size_t)(tok0 + row) * D + 256 + 32 * wid + 4 * qd;
        u32x2 o;
        o.x = pg8::cvt_pk_bf16(ml::bf_lo(y0.x) / (1.f + __expf(-(a0[0] + gb0.x))), ml::bf_hi(y0.x) / (1.f + __expf(-(a0[1] + gb0.y))));
        o.y = pg8::cvt_pk_bf16(ml::bf_lo(y0.y) / (1.f + __expf(-(a0[2] + gb0.z))), ml::bf_hi(y0.y) / (1.f + __expf(-(a0[3] + gb0.w))));
        *(u32x2*)op = o;
        o.x = pg8::cvt_pk_bf16(ml::bf_lo(y1.x) / (1.f + __expf(-(a1[0] + gb1.x))), ml::bf_hi(y1.x) / (1.f + __expf(-(a1[1] + gb1.y))));
        o.y = pg8::cvt_pk_bf16(ml::bf_lo(y1.y) / (1.f + __expf(-(a1[2] + gb1.z))), ml::bf_hi(y1.y) / (1.f + __expf(-(a1[3] + gb1.w))));
        *(u32x2*)(op + 16) = o;
    }
}
static_assert(T_LAYER <= 4 * MiB && O_END <= 48 * MiB && 256 * YP <= LDS_BYTES - 64, "S5 scratch fits");
}
__device__ __forceinline__ void s5_build_tables_fwd(float* ldsf, const Params& P, int l, int g, unsigned char* tb) { s5::build_tables(ldsf, P, l, g, tb); }

namespace at {
using pg8::bf16x8; using pg8::f32x4; using pg8::u32x4; using pg8::u32x2;
constexpr int KP = 144, VP = 528, OFF_K = 0, OFF_VT = 256 * KP, LDS_END = OFF_VT + 64 * VP;
__device__ __forceinline__ void unit(LAS unsigned char* lds, const bf16_t* z, const float* sinks, bf16_t* mix, int u) {
    const int tid = tid_opaque(), lane = tid & 63, wid = __builtin_amdgcn_readfirstlane(tid >> 6), r = lane & 15, qd = lane >> 4;
    const int b = u >> 7, g = (u >> 6) & 1, n = u & 63, tokb = b * S + 128 * n;
    __syncthreads();
#pragma unroll
    for (int it = 0; it < 4; ++it) { const int idx = tid + it * NTHREADS, kl = idx >> 3, cg = idx & 7; const bool ok = (n > 0) || (kl >= 128);
        u32x4 w = {0u, 0u, 0u, 0u}; if (ok) w = *(const u32x4*)(z + (size_t)(tokb - 128 + kl) * ZW + ZK + g * 64 + cg * 8);
        *(LAS u32x4*)(lds + OFF_K + kl * KP + cg * 16) = w; }
#pragma unroll
    for (int it = 0; it < 4; ++it) { const int idx = tid + it * NTHREADS, kl = idx & 255, cg = idx >> 8; const bool ok = (n > 0) || (kl >= 128);
        u32x4 w = {0u, 0u, 0u, 0u}; if (ok) w = *(const u32x4*)(z + (size_t)(tokb - 128 + kl) * ZW + ZV + g * 64 + cg * 8);
        const unsigned ww[4] = {w.x, w.y, w.z, w.w};
#pragma unroll
        for (int e = 0; e < 8; ++e) *(LAS unsigned short*)(lds + OFF_VT + (cg * 8 + e) * VP + kl * 2) = (unsigned short)((e & 1) ? (ww[e >> 1] >> 16) : (ww[e >> 1] & 0xffffu)); }
    __syncthreads();
    const int hq = 2 * g + (wid >> 2);
    const float sink = sinks[hq];
#pragma unroll 1
    for (int qt = 0; qt < 2; ++qt) {
        const int i0 = (wid & 3) * 32 + qt * 16, kt0 = i0 >> 4, tok = tokb + i0 + r;
        const bf16x8 bq0 = *(const bf16x8*)(z + (size_t)tok * ZW + ZQ + hq * 64 + 8 * qd), bq1 = *(const bf16x8*)(z + (size_t)tok * ZW + ZQ + hq * 64 + 32 + 8 * qd);
        f32x4 accS[9];
#pragma unroll
        for (int c = 0; c < 9; ++c) { const int kt = kt0 + c;
            const bf16x8 a0 = *(const LAS bf16x8*)(lds + OFF_K + (16 * kt + r) * KP + qd * 16), a1 = *(const LAS bf16x8*)(lds + OFF_K + (16 * kt + r) * KP + 64 + qd * 16);
            accS[c] = ml::mfma16(a0, bq0, (f32x4){0.f, 0.f, 0.f, 0.f}); accS[c] = ml::mfma16(a1, bq1, accS[c]); }
        float m = sink;
#pragma unroll
        for (int c = 0; c < 9; ++c)
#pragma unroll
            for (int j = 0; j < 4; ++j) { const int e = 4 * qd + j;
                bool valid = (c == 0) ? (e > r) : ((c == 8) ? (e <= r) : true);
                valid = valid && ((n > 0) || (kt0 + c >= 8));
                const float s = valid ? accS[c][j] * 0.125f : -3.0e38f; accS[c][j] = s; m = fmaxf(m, s); }
        m = fmaxf(m, __shfl_xor(m, 16)); m = fmaxf(m, __shfl_xor(m, 32));
        float l = 0.f;
#pragma unroll
        for (int c = 0; c < 9; ++c)
#pragma unroll
            for (int j = 0; j < 4; ++j) { const float p = __expf(accS[c][j] - m); accS[c][j] = p; l += p; }
        l += __shfl_xor(l, 16); l += __shfl_xor(l, 32);
        l += __expf(sink - m);
        f32x4 accO[4];
#pragma unroll
        for (int dt = 0; dt < 4; ++dt) accO[dt] = (f32x4){0.f, 0.f, 0.f, 0.f};
#pragma unroll
        for (int kk = 0; kk < 5; ++kk) {
            u32x4 pw; pw.x = pg8::cvt_pk_bf16(accS[2 * kk][0], accS[2 * kk][1]); pw.y = pg8::cvt_pk_bf16(accS[2 * kk][2], accS[2 * kk][3]);
            if (kk < 4) { pw.z = pg8::cvt_pk_bf16(accS[2 * kk + 1][0], accS[2 * kk + 1][1]); pw.w = pg8::cvt_pk_bf16(accS[2 * kk + 1][2], accS[2 * kk + 1][3]); } else { pw.z = 0u; pw.w = 0u; }
            const bf16x8 pf = __builtin_bit_cast(bf16x8, pw);
            const int base = 16 * (kt0 + 2 * kk);
#pragma unroll
            for (int dt = 0; dt < 4; ++dt) { const u32x2 v0 = *(const LAS u32x2*)(lds + OFF_VT + (16 * dt + r) * VP + (base + 4 * qd) * 2);
                u32x2 v1 = {0u, 0u}; if (kk < 4) v1 = *(const LAS u32x2*)(lds + OFF_VT + (16 * dt + r) * VP + (base + 16 + 4 * qd) * 2);
                u32x4 vw; vw.x = v0.x; vw.y = v0.y; vw.z = v1.x; vw.w = v1.y;
                accO[dt] = ml::mfma16(__builtin_bit_cast(bf16x8, vw), pf, accO[dt]); } }
        const float inv = 1.f / l;
        bf16_t* op = mix + (size_t)tok * D + hq * 64;
#pragma unroll
        for (int dt = 0; dt < 4; ++dt) { u32x2 o; o.x = pg8::cvt_pk_bf16(accO[dt][0] * inv, accO[dt][1] * inv); o.y = pg8::cvt_pk_bf16(accO[dt][2] * inv, accO[dt][3] * inv);
            *(u32x2*)(op + 16 * dt + 4 * qd) = o; }
    }
}
}

namespace sg {
using pg8::bf16x8; using pg8::f32x4; using pg8::u32x4; using pg8::u32x2;
constexpr int TP = 272, OFF_VT = 0, OFF_ST = 256 * TP, LDS_END = OFF_ST + 128 * 4 * 2 * 4;
__device__ __forceinline__ void unit(LAS unsigned char* lds, const bf16_t* z, const Params& P, int l, const bf16_t* wb  , bf16_t* mix, int u) {
    const int tid = tid_opaque(), lane = tid & 63, wid = __builtin_amdgcn_readfirstlane(tid >> 6), r = lane & 15, qd = lane >> 4;
    const int tok0 = u * 128;
    LAS float* ST = (LAS float*)(lds + OFF_ST);
    __syncthreads();
    const int s = tid & 127, cq = tid >> 7;
    const bf16_t* gp = z + (size_t)(tok0 + s) * ZW + ZGV + cq * 64;
    float sm = 0.f, sq = 0.f;
#pragma unroll 2
    for (int i = 0; i < 8; ++i) { float v[8]; ld8(gp + 8 * i, v);
#pragma unroll
        for (int e = 0; e < 8; ++e) { const float ge = gelu_tanh(v[e]); sm += ge; sq += ge * ge; } }
    ST[(s * 4 + cq) * 2] = sm; ST[(s * 4 + cq) * 2 + 1] = sq;
    __syncthreads();
    { float tsm = 0.f, tsq = 0.f;
#pragma unroll
      for (int q = 0; q < 4; ++q) { tsm += ST[(s * 4 + q) * 2]; tsq += ST[(s * 4 + q) * 2 + 1]; }
      const float mu = tsm * (1.f / 256.f), var = fmaxf(tsq * (1.f / 256.f) - mu * mu, 0.f), rs = rsqrtf(var + EPS);
      const float* lg = P.in[I_LNG] + l * 256 + cq * 64; const float* lb = P.in[I_LNB] + l * 256 + cq * 64;
#pragma unroll 1
      for (int i = 0; i < 8; ++i) { float v[8]; ld8(gp + 8 * i, v);
          const float4 g0 = *(const float4*)(lg + 8 * i), g1 = *(const float4*)(lg + 8 * i + 4), b0 = *(const float4*)(lb + 8 * i), b1 = *(const float4*)(lb + 8 * i + 4);
          const float gg[8] = {g0.x, g0.y, g0.z, g0.w, g1.x, g1.y, g1.z, g1.w}, bb[8] = {b0.x, b0.y, b0.z, b0.w, b1.x, b1.y, b1.z, b1.w};
#pragma unroll
          for (int e = 0; e < 8; ++e) *(LAS unsigned short*)(lds + OFF_VT + (cq * 64 + 8 * i + e) * TP + s * 2) = ml::bf1((gelu_tanh(v[e]) - mu) * rs * gg[e] + bb[e]); } }
    __syncthreads();
    const int t = 16 * wid + r;
#pragma unroll 1
    for (int g = 0; g < 4; ++g) {
        bf16x8 wf[4];
#pragma unroll
        for (int ks = 0; ks < 4; ++ks) wf[ks] = *(const bf16x8*)(wb + ((size_t)g * 128 + t) * 128 + 32 * ks + 8 * qd);
        const float bias = P.in[I_SGUB][l * 512 + g * 128 + t];
#pragma unroll
        for (int ct = 0; ct < 4; ++ct) { f32x4 acc = {0.f, 0.f, 0.f, 0.f};
#pragma unroll
            for (int ks = 0; ks < 4; ++ks) if (2 * ks <= wid) acc = ml::mfma16(*(const LAS bf16x8*)(lds + OFF_VT + (g * 64 + 16 * ct + r) * TP + (32 * ks + 8 * qd) * 2), wf[ks], acc);
            const int c0 = g * 64 + 16 * ct + 4 * qd;
            const u32x2 gw = *(const u32x2*)(z + (size_t)(tok0 + t) * ZW + ZGU + c0);
            u32x2 o; o.x = pg8::cvt_pk_bf16(gelu_tanh(bfl(gw.x)) * (acc[0] + bias), gelu_tanh(bfh(gw.x)) * (acc[1] + bias)); o.y = pg8::cvt_pk_bf16(gelu_tanh(bfl(gw.y)) * (acc[2] + bias), gelu_tanh(bfh(gw.y)) * (acc[3] + bias));
            *(u32x2*)(mix + (size_t)(tok0 + t) * D + 768 + c0) = o; }
    }
}
}

__device__ __forceinline__ void ph_mix1(float* lds, const Params& P, int l, bf16_t* z, const float* gates, bf16_t* mix, unsigned char* wsm, unsigned char* wss, const unsigned char* tb) {
    const int G = gridDim.x, bid = blockIdx.x;
    for (int u = bid; u < ml::NU; u += G) ml::p1_unit((LAS unsigned char*)lds, z, gates, P, l, u, wsm);
    __syncthreads();
    for (int u = bid; u < NTOK / 256; u += G) s5::p1_unit(z, tb, u, wss);
    __syncthreads();
    for (int u = bid; u < 1024; u += G) at::unit((LAS unsigned char*)lds, z, P.in[I_SINK] + l * 4, mix, u);
    __syncthreads();
    for (int u = bid; u < NTOK / 128; u += G) sg::unit((LAS unsigned char*)lds, z, P, l, (const bf16_t*)(tb + s5::T_SGUW), mix, u);
    __syncthreads();
}

__device__ __forceinline__ void ph_mix2(float* lds, const Params& P, int l, const bf16_t* z, const float* gates, bf16_t* mix, const unsigned char* wsm, const unsigned char* wss, const unsigned char* tb) {
    for (int u = blockIdx.x; u < NTOK / 256; u += gridDim.x) s5::p3_unit((LAS unsigned char*)lds, z, P, l, tb, u, wss, mix);
    __syncthreads();
    for (int u = blockIdx.x; u < ml::NU; u += gridDim.x) ml::p3_unit((LAS unsigned char*)lds, z, gates, P, l, u, wsm, mix);
    __syncthreads();
}

__device__ __forceinline__ void ph_outproj(LAS unsigned char* ldsb, const bf16_t* mix, const bf16_t* wt, const float* xsrc, float* xout) {
    pg8::StaticOrder S; S.init(NTOK, D, D, D, gridDim.x, blockIdx.x, mix, wt);
    pg8::EpiRes E{xsrc, xout};
    pg8::gemm_phase<pg8::EpiRes, pg8::StaticOrder, false>(ldsb, D, D, S, E);
}

namespace rp {
using pg8::bf16x8; using pg8::f32x4; using pg8::u32x4;
constexpr size_t T_HI = 0, T_LO = (size_t)48 * D * 2, T_GHI = 2 * T_LO, T_GLO = T_GHI + (size_t)16 * D * 2, T_SIZE = T_GLO + (size_t)16 * D * 2;
static_assert(T_SIZE <= 256 * 1024, "row-pass tables fit their slot");
template <int NT, bool COMBINE> struct StepIn { float4 xa[2], xb[2]; u32x4 y1[2], y2[2]; float4 g0, g1; bf16x8 wh[NT], wl[NT]; };
__device__ __forceinline__ void build_base(LAS int* base, const unsigned* cnt) {
    __syncthreads();
    if (tid_opaque() == 0) { int b = 0; for (int e = 0; e < NEXP; ++e) { base[e] = b; b += (((int)cnt[e] + 255) >> 8) << 8; } }
    __syncthreads();
}
template <int NT, bool COMBINE>
__device__ __forceinline__ void run(LAS unsigned char* lds, const Params& P, int l, const float* x, float* xo, const bf16_t* YB, const unsigned* inv, const unsigned* cntprev,
                                    const float* gn, const bf16_t* WH, const bf16_t* WL, bf16_t* XN, float* RS, float* gates, unsigned* cnt, int2* lists, unsigned* invout) {
    const int tid = tid_opaque(), lane = tid & 63, wid = __builtin_amdgcn_readfirstlane(tid >> 6), r = lane & 15, qd = lane >> 4;
    LAS int* BASE = (LAS int*)(lds + 64 * 1024);
    LAS float* LG = (LAS float*)lds + wid * (32 * 49);
    if (COMBINE) build_base(BASE, cntprev);
    for (int rb = blockIdx.x * 8 + wid; rb < NTOK / 32; rb += gridDim.x * 8) {
        const int row0 = rb * 32;
        size_t yr1[2] = {0, 0}, yr2[2] = {0, 0};
        if (COMBINE) {
#pragma unroll
            for (int mt = 0; mt < 2; ++mt) { const int row = row0 + 16 * mt + r; const unsigned i1 = inv[2 * row], i2 = inv[2 * row + 1];
                yr1[mt] = (size_t)(BASE[i1 >> 16] + (int)(i1 & 0xffffu)) * D; yr2[mt] = (size_t)(BASE[i2 >> 16] + (int)(i2 & 0xffffu)) * D; } }
        f32x4 acc[2][NT];
#pragma unroll
        for (int mt = 0; mt < 2; ++mt)
#pragma unroll
            for (int nt = 0; nt < NT; ++nt) acc[mt][nt] = (f32x4){0.f, 0.f, 0.f, 0.f};
        float ssq[2] = {0.f, 0.f};
        StepIn<NT, COMBINE> sb[2];
        auto load = [&](StepIn<NT, COMBINE>& s, int ks) {
            const int k0 = 32 * ks + 8 * qd;
#pragma unroll
            for (int mt = 0; mt < 2; ++mt) { const float* xp = x + (size_t)(row0 + 16 * mt + r) * D + k0; s.xa[mt] = *(const float4*)xp; s.xb[mt] = *(const float4*)(xp + 4);
                if (COMBINE) { s.y1[mt] = *(const u32x4*)(YB + yr1[mt] + k0); s.y2[mt] = *(const u32x4*)(YB + yr2[mt] + k0); } }
            s.g0 = *(const float4*)(gn + k0); s.g1 = *(const float4*)(gn + k0 + 4);
#pragma unroll
            for (int nt = 0; nt < NT; ++nt) { s.wh[nt] = *(const bf16x8*)(WH + (size_t)(16 * nt + r) * D + k0); s.wl[nt] = *(const bf16x8*)(WL + (size_t)(16 * nt + r) * D + k0); }
        };
        auto process = [&](const StepIn<NT, COMBINE>& s, int ks) {
            const int k0 = 32 * ks + 8 * qd;
            bf16x8 xh[2], xl[2];
#pragma unroll
            for (int mt = 0; mt < 2; ++mt) { float4 a = s.xa[mt], b = s.xb[mt];
                if (COMBINE) { const u32x4 p = s.y1[mt], q = s.y2[mt];
                    a.x += bfl(p.x) + bfl(q.x); a.y += bfh(p.x) + bfh(q.x); a.z += bfl(p.y) + bfl(q.y); a.w += bfh(p.y) + bfh(q.y);
                    b.x += bfl(p.z) + bfl(q.z); b.y += bfh(p.z) + bfh(q.z); b.z += bfl(p.w) + bfl(q.w); b.w += bfh(p.w) + bfh(q.w);
                    float* op = xo + (size_t)(row0 + 16 * mt + r) * D + k0; *(float4*)op = a; *(float4*)(op + 4) = b; }
                ssq[mt] += a.x * a.x + a.y * a.y + a.z * a.z + a.w * a.w + b.x * b.x + b.y * b.y + b.z * b.z + b.w * b.w;
                const float v[8] = {a.x * s.g0.x, a.y * s.g0.y, a.z * s.g0.z, a.w * s.g0.w, b.x * s.g1.x, b.y * s.g1.y, b.z * s.g1.z, b.w * s.g1.w};
                u32x4 h; h.x = pg8::cvt_pk_bf16(v[0], v[1]); h.y = pg8::cvt_pk_bf16(v[2], v[3]); h.z = pg8::cvt_pk_bf16(v[4], v[5]); h.w = pg8::cvt_pk_bf16(v[6], v[7]);
                *(u32x4*)(XN + (size_t)(row0 + 16 * mt + r) * D + k0) = h;
                u32x4 lo; lo.x = pg8::cvt_pk_bf16(v[0] - bfl(h.x), v[1] - bfh(h.x)); lo.y = pg8::cvt_pk_bf16(v[2] - bfl(h.y), v[3] - bfh(h.y)); lo.z = pg8::cvt_pk_bf16(v[4] - bfl(h.z), v[5] - bfh(h.z)); lo.w = pg8::cvt_pk_bf16(v[6] - bfl(h.w), v[7] - bfh(h.w));
                xh[mt] = __builtin_bit_cast(bf16x8, h); xl[mt] = __builtin_bit_cast(bf16x8, lo); }
#pragma unroll
            for (int nt = 0; nt < NT; ++nt)
#pragma unroll
                for (int mt = 0; mt < 2; ++mt) { acc[mt][nt] = ml::mfma16(s.wh[nt], xh[mt], acc[mt][nt]); acc[mt][nt] = ml::mfma16(s.wl[nt], xh[mt], acc[mt][nt]); acc[mt][nt] = ml::mfma16(s.wh[nt], xl[mt], acc[mt][nt]); }
        };
        load(sb[0], 0);
#pragma unroll 1
        for (int ks = 0; ks < 32; ks += 2) {
            load(sb[1], ks + 1);
            process(sb[0], ks);
            if (ks + 2 < 32) load(sb[0], ks + 2);
            process(sb[1], ks + 1);
        }
        float rsv[2];
#pragma unroll
        for (int mt = 0; mt < 2; ++mt) { float s = ssq[mt]; s += __shfl_xor(s, 16); s += __shfl_xor(s, 32); rsv[mt] = rsqrtf(s * (1.f / D) + EPS);
            if (qd == 0) RS[row0 + 16 * mt + r] = rsv[mt]; }
        if (NT == 1) {
#pragma unroll
            for (int mt = 0; mt < 2; ++mt) if (qd < 2) { const f32x4 gv = acc[mt][0] * rsv[mt]; *(f32x4*)(gates + (size_t)(row0 + 16 * mt + r) * 8 + 4 * qd) = gv; }
        } else {
            const float* bg = P.in[I_RGB] + l * 4; const float* be = P.in[I_REB] + l * 32;
#pragma unroll
            for (int mt = 0; mt < 2; ++mt)
#pragma unroll
                for (int nt = 0; nt < NT; ++nt)
#pragma unroll
                    for (int j = 0; j < 4; ++j) LG[(16 * mt + r) * 49 + 16 * nt + 4 * qd + j] = acc[mt][nt][j] * rsv[mt];
            wave_lds_fence();
            if (lane < 32) {
                const LAS float* lg = LG + lane * 49; const int row = row0 + lane;
                float gl[4];
#pragma unroll
                for (int j = 0; j < 4; ++j) gl[j] = lg[j] + bg[j];
                int sel = 0; float gm = gl[0];
#pragma unroll
                for (int j = 1; j < 4; ++j) if (gl[j] > gm) { gm = gl[j]; sel = j; }
                float gs = 0.f;
#pragma unroll
                for (int j = 0; j < 4; ++j) gs += expf(gl[j] - gm);
                const float pg = 1.f / gs;
                float ein[8];
#pragma unroll
                for (int j = 0; j < 8; ++j) ein[j] = lg[4 + sel * 8 + j] + be[sel * 8 + j];
                int i1 = 0; float v1 = ein[0];
#pragma unroll
                for (int j = 1; j < 8; ++j) if (ein[j] > v1) { v1 = ein[j]; i1 = j; }
                int i2 = -1; float v2 = -3.0e38f;
#pragma unroll
                for (int j = 0; j < 8; ++j) if (j != i1 && ein[j] > v2) { v2 = ein[j]; i2 = j; }
                const float e2 = expf(v2 - v1), den = 1.f / (1.f + e2);
                const float w1 = den * pg, w2 = e2 * den * pg;
                const int ex1 = sel * 8 + i1, ex2 = sel * 8 + i2;
                const unsigned p1 = atomicAdd(&cnt[ex1], 1u), p2 = atomicAdd(&cnt[ex2], 1u);
                lists[(size_t)ex1 * NTOK + p1] = make_int2(row, __float_as_int(w1));
                lists[(size_t)ex2 * NTOK + p2] = make_int2(row, __float_as_int(w2));
                invout[2 * row] = ((unsigned)ex1 << 16) | p1; invout[2 * row + 1] = ((unsigned)ex2 << 16) | p2;
            }
            wave_lds_fence();
        }
    }
}
__device__ __forceinline__ void final_norm(LAS unsigned char* lds, float* xo, const bf16_t* YB, const unsigned* inv, const unsigned* cntprev, const float* g) {
    const int tid = tid_opaque(), wave = tid >> 6, lane = tid & 63;
    LAS int* BASE = (LAS int*)(lds + 64 * 1024);
    build_base(BASE, cntprev);
    const float4* g4 = (const float4*)g;
    for (int r = blockIdx.x * 8 + wave; r < NTOK; r += gridDim.x * 8) {
        const unsigned i1 = inv[2 * r], i2 = inv[2 * r + 1];
        const bf16_t* y1 = YB + (size_t)(BASE[i1 >> 16] + (int)(i1 & 0xffffu)) * D; const bf16_t* y2 = YB + (size_t)(BASE[i2 >> 16] + (int)(i2 & 0xffffu)) * D;
        float4* p = (float4*)(xo + (size_t)r * D);
        float4 v[4]; float ss = 0.f;
#pragma unroll
        for (int i = 0; i < 4; ++i) { v[i] = p[lane + 64 * i]; const u32x2_t a = *((const u32x2_t*)y1 + lane + 64 * i), b = *((const u32x2_t*)y2 + lane + 64 * i);
            v[i].x += bfl(a.x) + bfl(b.x); v[i].y += bfh(a.x) + bfh(b.x); v[i].z += bfl(a.y) + bfl(b.y); v[i].w += bfh(a.y) + bfh(b.y);
            ss += v[i].x * v[i].x + v[i].y * v[i].y + v[i].z * v[i].z + v[i].w * v[i].w; }
        ss = wave_sum(ss);
        const float rs = rsqrtf(ss * (1.f / D) + EPS);
#pragma unroll
        for (int i = 0; i < 4; ++i) { const float4 gg = g4[lane + 64 * i]; float4 o; o.x = v[i].x * rs * gg.x; o.y = v[i].y * rs * gg.y; o.z = v[i].z * rs * gg.z; o.w = v[i].w * rs * gg.w; p[lane + 64 * i] = o; }
    }
}
}

__device__ __forceinline__ int moe_build_tab(LAS unsigned char* ldsb, const unsigned* cnt) {
    LAS pg8::i32x4* tab = (LAS pg8::i32x4*)(ldsb + TAB_OFF);
    __syncthreads();
    int base = 0;
#pragma unroll 1
    for (int e = 0; e < NEXP; ++e) { const int c = __builtin_amdgcn_readfirstlane((int)cnt[e]), nt = (c + 255) >> 8;
        if ((int)tid_opaque() < nt) tab[base + tid_opaque()] = (pg8::i32x4){e, (int)tid_opaque() * 256, c, 0};
        base += nt; }
    __syncthreads();
    return base;
}
__device__ __forceinline__ void ph_moe1(LAS unsigned char* ldsb, const Params& P, int l, const bf16_t* H, const unsigned* cnt, const int2* lists, bf16_t* act) {
    const int ntiles = moe_build_tab(ldsb, cnt);
    pg8::MoeOrder S; S.tab = (const LAS pg8::i32x4*)(ldsb + TAB_OFF); S.ntiles = ntiles; S.npn = 4; S.G = gridDim.x; S.c = blockIdx.x;
    S.A = (const char*)H; S.atile = 0; S.Bt = (const char*)(P.ws + WS_WGU) + (size_t)l * NEXP * 1024 * D * 2; S.bexp = (size_t)1024 * D * 2; S.btile = (size_t)256 * D * 2; S.lists = lists;
    pg8::EpiAct E{act, lists, (const float*)(P.ws + WS_RS)};
    pg8::gemm_phase<pg8::EpiAct, pg8::MoeOrder, true>(ldsb, D, D, S, E);
}
__device__ __forceinline__ void ph_moe2(LAS unsigned char* ldsb, const Params& P, int l, const bf16_t* act, const unsigned* cnt, const int2* lists, bf16_t* yb) {
    const int ntiles = moe_build_tab(ldsb, cnt);
    pg8::MoeOrder S; S.tab = (const LAS pg8::i32x4*)(ldsb + TAB_OFF); S.ntiles = ntiles; S.npn = 4; S.G = gridDim.x; S.c = blockIdx.x;
    S.A = (const char*)act; S.atile = (size_t)256 * DE * 2; S.Bt = (const char*)(P.ws + WS_WD) + (size_t)l * NEXP * D * DE * 2; S.bexp = (size_t)D * DE * 2; S.btile = (size_t)256 * DE * 2; S.lists = lists;
    pg8::EpiY E{yb, lists};
    pg8::gemm_phase<pg8::EpiY, pg8::MoeOrder, false>(ldsb, DE, DE, S, E);
}

#ifndef PROBE_PH
#define PROBE_PH -1
#endif
#ifndef PROBE_REPS
#define PROBE_REPS 4
#endif
__global__ void __launch_bounds__(NTHREADS, 2) fwd_kernel(Params P) {
    extern __shared__ __attribute__((aligned(16))) unsigned char lds_raw[];
    float* lds = (float*)lds_raw;
    volatile LAS unsigned* xbw = (volatile LAS unsigned*)(lds_raw + LDS_BYTES - 16);
    if (threadIdx.x == 0) { xbw[0] = 0u; xbw[1] = 0u; }
    __syncthreads();
    unsigned char* const ws = P.ws;
    unsigned* ctl = (unsigned*)(ws + WS_CTL);
    const bool multi = (P.ph_hi - P.ph_lo) > 1;
    XcdBarrier bar; bar.bar = ctl; bar.x = 0; bar.st = xbw;
    if (multi) bar = xcd_barrier_post(ctl, xbw);
    bf16_t* z = (bf16_t*)(ws + WS_Z); float* gates = (float*)(ws + WS_GATES); unsigned char* wss = ws + WS_S5; bf16_t* mix = (bf16_t*)(ws + WS_MIX); unsigned char* wsm = ws + WS_HRAW;
    bf16_t* H = (bf16_t*)(ws + WS_H); bf16_t* act = (bf16_t*)(ws + WS_ACT); bf16_t* yb = (bf16_t*)(ws + WS_YB); float* rsb = (float*)(ws + WS_RS);
    int2* lists = (int2*)(ws + WS_LIST);
    LAS unsigned char* ldsb = (LAS unsigned char*)lds_raw;
    const int lo = P.ph_lo, hi = P.ph_hi;
#define IN(k) (lo <= (k) && (k) < hi)
#define SEAM(k) do { if (IN(k) && IN((k) + 1)) xcd_barrier(bar); } while (0)
#if PROBE_PH >= 0
#define RUNPH(k, ...) do { if (IN(k)) { const int nrep = ((k) == PROBE_PH) ? 1 + PROBE_REPS : 1; for (int rep = 0; rep < nrep; ++rep) { __VA_ARGS__; if (rep + 1 < nrep) xcd_barrier(bar); } } SEAM(k); } while (0)
#else
#define RUNPH(k, ...) do { if (IN(k)) { constexpr int rep = 0; (void)rep; __VA_ARGS__; } SEAM(k); } while (0)
#endif
    RUNPH(0, ph_prologue(lds, PF));
    for (int l = 0; l < NLAYER; ++l) {
        const int pb = 1 + l * PH_PER_LAYER;
        unsigned* cnt = ctl + CW_CNT + l * 64;
        const unsigned char* tb = ws + WS_TB + (size_t)l * 4 * MiB;
        const unsigned char* rtb = ws + WS_RT + (size_t)l * 256 * 1024;
        unsigned* inv = (unsigned*)(ws + WS_INV) + (size_t)l * NTOK * 2;
        RUNPH(pb + 0, { const Params& Q = PF;
            if (l == 0) rp::run<1, false>(ldsb, Q, l, Q.in[I_X], nullptr, nullptr, nullptr, nullptr, Q.in[I_NMG] + l * D, (const bf16_t*)(rtb + rp::T_GHI), (const bf16_t*)(rtb + rp::T_GLO), mix, rsb, gates, nullptr, nullptr, nullptr);
            else        rp::run<1, true >(ldsb, Q, l, Q.out, Q.out, yb, inv - (size_t)NTOK * 2, cnt - 64, Q.in[I_NMG] + l * D, (const bf16_t*)(rtb + rp::T_GHI), (const bf16_t*)(rtb + rp::T_GLO), mix, rsb, gates, nullptr, nullptr, nullptr); });
        RUNPH(pb + 1, ph_inproj(ldsb, mix, (const bf16_t*)(ws + WS_WIN) + (size_t)l * NMAIN * D, z, rsb));
        RUNPH(pb + 2, ph_mix1(lds, PF, l, z, gates, mix, wsm, wss, tb));
        RUNPH(pb + 3, { ml::p2_scan(wsm); s5::p2_scan(tb, wss); });
        RUNPH(pb + 4, ph_mix2(lds, PF, l, z, gates, mix, wsm, wss, tb));
        RUNPH(pb + 5, { const Params& Q = PF; ph_outproj(ldsb, mix, (const bf16_t*)(ws + WS_WOUT) + (size_t)l * D * D, (l == 0) ? Q.in[I_X] : Q.out, Q.out); });
        RUNPH(pb + 6, { if (rep > 0) { if (blockIdx.x == 0 && threadIdx.x < 64) cnt[threadIdx.x] = 0u; xcd_barrier(bar); }
                        const Params& Q = PF; rp::run<3, false>(ldsb, Q, l, Q.out, nullptr, nullptr, nullptr, nullptr, Q.in[I_NFG] + l * D, (const bf16_t*)(rtb + rp::T_HI), (const bf16_t*)(rtb + rp::T_LO), H, rsb, nullptr, cnt, lists, inv); });
        RUNPH(pb + 7, ph_moe1(ldsb, PF, l, H, cnt, lists, act));
        RUNPH(pb + 8, ph_moe2(ldsb, PF, l, act, cnt, lists, yb));
    }
    RUNPH(1 + NLAYER * PH_PER_LAYER, { const Params& Q = PF; rp::final_norm(ldsb, Q.out, yb, (const unsigned*)(ws + WS_INV) + (size_t)(NLAYER - 1) * NTOK * 2, ctl + CW_CNT + (NLAYER - 1) * 64, Q.in[I_NFIN]); });
#undef RUNPH
#undef IN
#undef SEAM
}

#ifndef N_LAUNCH_MODE
#define N_LAUNCH_MODE 1
#endif
extern "C" void kernel_launch(void* const* d_in, const int* in_sizes, int n_in, void* d_out, int out_size, void* d_ws, size_t ws_size, hipStream_t stream) {
    static int grid = 0;
    if (grid == 0) {
        if (n_in != 31 || out_size != NTOK * D || ws_size < WS_END) { fprintf(stderr, "kernel_launch: unexpected shapes n_in %d out %d ws %zu (need %zu)\n", n_in, out_size, ws_size, (size_t)WS_END); grid = -1; return; }
        int dev = 0, cus = 0, per_cu = 0;
        if (hipGetDevice(&dev) != hipSuccess || hipDeviceGetAttribute(&cus, hipDeviceAttributeMultiprocessorCount, dev) != hipSuccess) { grid = -1; return; }
        if (hipFuncSetAttribute((const void*)fwd_kernel, hipFuncAttributeMaxDynamicSharedMemorySize, LDS_BYTES) != hipSuccess) { fprintf(stderr, "kernel_launch: hipFuncSetAttribute failed\n"); grid = -1; return; }
        if (hipOccupancyMaxActiveBlocksPerMultiprocessor(&per_cu, (const void*)fwd_kernel, NTHREADS, LDS_BYTES) != hipSuccess || per_cu < 1) { fprintf(stderr, "kernel_launch: occupancy query says %d\n", per_cu); }
        (void)hipGetLastError();
        grid = cus;
    }
    if (grid < 0) return;
    (void)hipMemsetAsync((char*)d_ws + WS_CTL, 0, CTL_BYTES, stream);
    Params p{};
    for (int i = 0; i < 31; ++i) p.in[i] = (const float*)d_in[i];
    p.out = (float*)d_out; p.ws = (unsigned char*)d_ws;
#if N_LAUNCH_MODE == 1
    p.ph_lo = 0; p.ph_hi = N_PHASES;
    hipLaunchKernelGGL(fwd_kernel, dim3(grid), dim3(NTHREADS), LDS_BYTES, stream, p);
#else
    for (int ph = 0; ph < N_PHASES; ++ph) { p.ph_lo = ph; p.ph_hi = ph + 1; hipLaunchKernelGGL(fwd_kernel, dim3(grid), dim3(NTHREADS), LDS_BYTES, stream, p); }
#endif
}
```

```cpp
#include <hip/hip_runtime.h>
#include <stdint.h>
#include <stdio.h>

#define LAS __attribute__((address_space(3)))

constexpr int D = 1024, NB = 8, S = 8192, NTOK = NB * S, INW = 2312, NLAYER = 2;
constexpr int NEXP = 32, DE = 512;
constexpr float EPS = 1e-6f;
constexpr int ZW = 2304;
constexpr int ZQ = 0, ZK = 256, ZV = 384, ZSU = 512, ZCQ = 768, ZCK = 1024, ZCV = 1280, ZCO = 1536, ZGU = 1792, ZGV = 2048, WCI = 1536;
constexpr int NTHREADS = 512;
constexpr int LDS_BYTES = 144 * 1024;
constexpr int TAB_OFF = 128 * 1024;
constexpr int PH_PER_LAYER = 9, N_PHASES = 1 + NLAYER * PH_PER_LAYER + 1;
constexpr int NMAIN = 2304;
typedef unsigned short bf16_t;

constexpr size_t MiB = 1u << 20;
constexpr size_t WS_CTL = 0, CTL_BYTES = 1 * MiB;
constexpr size_t WS_Z = WS_CTL + CTL_BYTES;
constexpr size_t Z_BYTES = (size_t)NTOK * ZW * 2;
constexpr size_t WS_H = WS_Z;
constexpr size_t WS_YB = WS_Z;
constexpr int PMAX = 2 * NTOK + NEXP * 256;
static_assert((size_t)PMAX * D * 2 <= Z_BYTES, "YB alias fits");
constexpr size_t WS_MIX = WS_Z + Z_BYTES;
constexpr size_t WS_ACT = WS_MIX;
static_assert((size_t)PMAX * DE * 2 <= (size_t)NTOK * D * 2 + 64 * MiB, "ACT alias fits");
constexpr size_t WS_HRAW = WS_MIX + (size_t)NTOK * D * 2;
constexpr size_t WS_S5 = WS_HRAW + 64 * MiB;
constexpr size_t WS_GATES = WS_S5 + 48 * MiB;
constexpr size_t WS_LIST = WS_GATES + (size_t)NTOK * 8 * 4;
constexpr size_t WS_WIN = WS_LIST + (size_t)NEXP * NTOK * 8;
constexpr size_t WS_WOUT = WS_WIN + (size_t)NLAYER * NMAIN * D * 2;
constexpr size_t WS_WGU = WS_WOUT + (size_t)NLAYER * D * D * 2;
constexpr size_t WS_WD = WS_WGU + (size_t)NLAYER * NEXP * 1024 * D * 2;
constexpr size_t WS_TB = WS_WD + (size_t)NLAYER * NEXP * D * DE * 2;
constexpr size_t WS_RS = WS_TB + (size_t)NLAYER * 4 * MiB;
constexpr size_t WS_RT = WS_RS + (size_t)NTOK * 4;
constexpr size_t WS_INV = WS_RT + (size_t)NLAYER * 256 * 1024;
constexpr size_t WS_END = WS_INV + (size_t)NLAYER * NTOK * 8;
namespace s5 {
constexpr size_t T_KMAT = 0, T_F = T_KMAT + (size_t)16 * 16 * 256 * 2, T_G = T_F + (size_t)16 * 256 * 128 * 2, T_A16 = T_G + (size_t)16 * 128 * 256 * 2,
                 T_GLUW = T_A16 + (size_t)16 * 64 * 8, T_SGUW = T_GLUW + (size_t)256 * 256 * 2, T_LAYER = T_SGUW + (size_t)4 * 128 * 128 * 2;
}
constexpr int CW_CNT = 8192;

#define XB_TMO      128
#define XB_XCNT(j)  (256  + 64 * (j))
#define XB_XSUB(j)  (1280 + 64 * (j))
#define XB_XGEN(j)  (2304 + 64 * (j))
#define XB_TOP      3328
#define XB_TOPGEN   3392
#define XCD_BAR_WORDS 3456
#define XB_SPIN_CAP (1u << 22)
__device__ __forceinline__ unsigned xb_ld(unsigned* p)              { return __hip_atomic_load(p, __ATOMIC_RELAXED, __HIP_MEMORY_SCOPE_AGENT); }
__device__ __forceinline__ unsigned xb_add(unsigned* p, unsigned v) { return __hip_atomic_fetch_add(p, v, __ATOMIC_RELAXED, __HIP_MEMORY_SCOPE_AGENT); }
__device__ __forceinline__ unsigned xb_xcc_id() { return (unsigned)__builtin_amdgcn_s_getreg((3 << 11) | 20) & 0xFu; }
#define XB_SPIN(cond, bar) do { unsigned _sp = 0; while (cond) { __builtin_amdgcn_s_sleep(1); \
    if ((++_sp & 255u) == 0u) { if (xb_ld(&(bar)[XB_TMO])) break; if (_sp > XB_SPIN_CAP) { atomicAdd(&(bar)[XB_TMO], 1u); break; } } } } while (0)
struct XcdBarrier { unsigned* bar; unsigned x; volatile LAS unsigned* st; };
__device__ __forceinline__ XcdBarrier xcd_barrier_post(unsigned* bar, volatile LAS unsigned* st) {
    XcdBarrier b; b.bar = bar; b.x = xb_xcc_id(); b.st = st;
    if (threadIdx.x == 0) (void)xb_add(&bar[XB_XCNT(b.x)], 1u);
    return b;
}
__device__ __forceinline__ void xcd_barrier_complete(unsigned* bar, unsigned x, unsigned& nloc, unsigned& nx) {
    const unsigned G = gridDim.x * gridDim.y * gridDim.z;
    unsigned sum, cnt, mine, sp = 0u;
    for (;;) {
        sum = 0u; cnt = 0u; mine = 0u;
#pragma unroll
        for (unsigned j = 0; j < 16; ++j) { const unsigned c = xb_ld(&bar[XB_XCNT(j)]); sum += c; cnt += (c > 0u) ? 1u : 0u; mine = (j == x) ? c : mine; }
        if (sum == G) break;
        __builtin_amdgcn_s_sleep(1);
        if ((++sp & 255u) == 0u) { if (xb_ld(&bar[XB_TMO])) break; if (sp > XB_SPIN_CAP) { atomicAdd(&bar[XB_TMO], 1u); break; } }
    }
    nloc = mine > 0u ? mine : 1u; nx = cnt > 0u ? cnt : 1u;
}
__device__ __forceinline__ void xcd_barrier(const XcdBarrier& b) {
    asm volatile("s_waitcnt vmcnt(0)" ::: "memory");
    __syncthreads();
    if (threadIdx.x == 0) {
        unsigned* bar = b.bar;
        __builtin_amdgcn_s_waitcnt(0);
        unsigned nloc = b.st[0], nx = b.st[1];
        if (nloc == 0u) { xcd_barrier_complete(bar, b.x, nloc, nx); b.st[0] = nloc; b.st[1] = nx; }
        const unsigned old = xb_add(&bar[XB_XSUB(b.x)], 1u);
        const unsigned gen = old / nloc;
        if (old + 1u == (gen + 1u) * nloc) {
            __builtin_amdgcn_fence(__ATOMIC_RELEASE, "agent");
            asm volatile("s_waitcnt vmcnt(0)" ::: "memory");
            const unsigned og = xb_add(&bar[XB_TOP], 1u);
            const unsigned tg = og / nx;
            if (og + 1u == (tg + 1u) * nx) xb_add(&bar[XB_TOPGEN], 1u);
            else XB_SPIN(xb_ld(&bar[XB_TOPGEN]) == tg, bar);
            __builtin_amdgcn_fence(__ATOMIC_ACQUIRE, "agent");
            xb_add(&bar[XB_XGEN(b.x)], 1u);
            asm volatile("s_waitcnt vmcnt(0)" ::: "memory");
        } else {
            XB_SPIN(xb_ld(&bar[XB_XGEN(b.x)]) == gen, bar);
            __builtin_amdgcn_fence(__ATOMIC_ACQUIRE, "agent");
            asm volatile("s_waitcnt vmcnt(0)" ::: "memory");
        }
    }
    __syncthreads();
}

__device__ __forceinline__ int tid_opaque() { int t = threadIdx.x; asm volatile("" : "+v"(t)); return t; }
__device__ __forceinline__ float wave_sum(float v) {
#pragma unroll
    for (int o = 32; o > 0; o >>= 1) v += __shfl_xor(v, o);
    return v;
}
__device__ __forceinline__ float gelu_tanh(float x) {
    const float u = 0.7978845608028654f * (x + 0.044715f * x * x * x);
    return 0.5f * x * (1.f + tanhf(u));
}
__device__ __forceinline__ float sigm(float x) { return 1.f / (1.f + expf(-x)); }
__device__ __forceinline__ float bfl(unsigned w) { return __uint_as_float(w << 16); }
__device__ __forceinline__ float bfh(unsigned w) { return __uint_as_float(w & 0xffff0000u); }
typedef unsigned u32x4_t __attribute__((ext_vector_type(4)));
typedef unsigned u32x2_t __attribute__((ext_vector_type(2)));
__device__ __forceinline__ void ld8(const bf16_t* p, float (&o)[8]) { const u32x4_t w = *(const u32x4_t*)p; o[0] = bfl(w.x); o[1] = bfh(w.x); o[2] = bfl(w.y); o[3] = bfh(w.y); o[4] = bfl(w.z); o[5] = bfh(w.z); o[6] = bfl(w.w); o[7] = bfh(w.w); }
__device__ __forceinline__ void wave_lds_fence() {
    __builtin_amdgcn_fence(__ATOMIC_RELEASE, "wavefront"); __builtin_amdgcn_wave_barrier(); __builtin_amdgcn_fence(__ATOMIC_ACQUIRE, "wavefront");
}

struct Params {
    const float* in[31];
    float* out;
    unsigned char* ws;
    int ph_lo, ph_hi;
};
struct Params;
__device__ __forceinline__ const Params* params_fresh() { auto p = __builtin_amdgcn_kernarg_segment_ptr(); asm volatile("" : "+s"(p)); return (const Params*)p; }
#define PF (*params_fresh())
enum { I_X = 0, I_NMG, I_WIN, I_SINK, I_ARE, I_AIM, I_BRE, I_BIM, I_CRE, I_CIM, I_SD, I_LDT, I_GLUW, I_GLUB, I_CONVW, I_GATEB, I_MNG,
       I_LNG, I_LNB, I_SGUW, I_SGUB, I_WOUT, I_NFG, I_RGW, I_RGB, I_REW, I_REB, I_EWG, I_EWU, I_EWD, I_NFIN };

namespace pg8 {
#define PG8_LAS __attribute__((address_space(3)))
typedef short bf16x8 __attribute__((ext_vector_type(8)));
typedef float f32x4 __attribute__((ext_vector_type(4)));
typedef unsigned u32x4 __attribute__((ext_vector_type(4)));
typedef unsigned u32x2 __attribute__((ext_vector_type(2)));
typedef int i32x4 __attribute__((ext_vector_type(4)));
constexpr int BM = 256, BK = 64, HALF = 128, HTB = HALF * BK * 2, STAGE_BYTES = 8 * HTB, NXCD = 8, WGM = 8;
__host__ __device__ __forceinline__ int lds_byte(int r, int c) { const int st = (r >> 4) * 2 + (c >> 5), rr = r & 15, cc = c & 31, ob = rr * 64 + cc * 2; return st * 1024 + (ob ^ (((ob >> 9) & 1) << 5)); }
__host__ __device__ __forceinline__ void stage_rc(int b, int& R, int& C) { const int st = b / 1024, sb = b % 1024, swz = sb ^ (((sb >> 9) & 1) << 5); R = (st >> 1) * 16 + swz / 64; C = (st & 1) * 32 + (swz % 64) / 2; }
__host__ __device__ __forceinline__ int perm32(int rho) { const int n = rho >> 4, i = rho & 15; return 8 * (i >> 2) + 4 * n + (i & 3); }
__device__ __forceinline__ unsigned cvt_pk_bf16(float lo, float hi) { unsigned r; asm volatile("v_cvt_pk_bf16_f32 %0, %1, %2" : "=v"(r) : "v"(lo), "v"(hi)); return r; }

struct Unit { int pm, pn; const char* A; const char* B; int e, pos0, cnt; };

struct StaticOrder {
    int nM, nN, nwg, G, c; const char* A; const char* Bt; size_t atile, btile;
    __device__ void init(int M, int N, int K, int lda, int G_, int c_, const void* A_, const void* Bt_) { nM = M / BM; nN = N / BM; nwg = nM * nN; G = G_; c = c_; A = (const char*)A_; Bt = (const char*)Bt_; atile = (size_t)BM * lda * 2; btile = (size_t)BM * K * 2; }
    __device__ __forceinline__ bool next(int i, Unit& u) const {
        const long L = (long)i * G + c; if (L >= nwg) return false;
        int wgid = (int)L; { const int q = nwg / NXCD, r = nwg % NXCD, xcd = wgid % NXCD, off = wgid / NXCD; wgid = (xcd < r ? xcd * (q + 1) : r * (q + 1) + (xcd - r) * q) + off; }
        const int nig = WGM * nN, gid = wgid / nig, fm = gid * WGM, gsz = (nM - fm) < WGM ? (nM - fm) : WGM;
        u.pm = fm + ((wgid % nig) % gsz); u.pn = (wgid % nig) / gsz; u.A = A + (size_t)u.pm * atile; u.B = Bt + (size_t)u.pn * btile; u.e = 0; u.pos0 = 0; u.cnt = 0; return true;
    }
    __device__ __forceinline__ void aoff(const Unit&, unsigned (&)[2], unsigned (&)[2], const int (&)[2], const int (&)[2]) const {}
};

template <class Epi, class Sched, bool GATHER>
__device__ __forceinline__ void gemm_phase(PG8_LAS unsigned char* lds, const int K, const int lda, const Sched& S, const Epi& E) {
    const int tid = tid_opaque(), wid = __builtin_amdgcn_readfirstlane(tid >> 6), lane = tid & 63, wr = wid >> 2, wc = wid & 3, fr = lane & 15, fq = lane >> 4;
    const int nt = K / BK;
    unsigned vA0[2], vA1[2], vB[2], nA0[2], nA1[2]; int Rs[2], Cs[2];
#pragma unroll
    for (int i = 0; i < 2; ++i) { int R, C; stage_rc(tid * 16 + i * 8192, R, C); const int Rb = Epi::PERM ? ((R & ~31) + perm32(R & 31)) : R;
        Rs[i] = R; Cs[i] = C; vA0[i] = (unsigned)(R * lda + C) * 2u; vA1[i] = vA0[i] + (unsigned)(HALF * lda) * 2u; vB[i] = (unsigned)(Rb * K + C) * 2u; nA0[i] = vA0[i]; nA1[i] = vA1[i]; }
    const size_t kstep = (size_t)(BK * 2);
    const size_t hstep = (size_t)HALF * K * 2;
    const unsigned ldsw = (unsigned)wid * 1024u;
    const int aoff = lds_byte(wr * 64 + fr, fq * 8), boff = lds_byte(wc * 32 + fr, fq * 8);
#define PG8_SA(b, h) (((b) * 2 + (h)) * HTB)
#define PG8_SB(b, h) ((4 + (b) * 2 + (h)) * HTB)
#define PG8_STAGE(bufoff, gbase, voff) do { _Pragma("unroll") for (int _i = 0; _i < 2; ++_i) \
        __builtin_amdgcn_global_load_lds((const unsigned*)((const char*)(gbase) + (voff)[_i]), (PG8_LAS unsigned*)(lds + (bufoff) + ldsw + _i * 8192), 16, 0, 0); } while (0)
#define PG8_LDA(dst, b, h) do { _Pragma("unroll") for (int m = 0; m < 4; ++m) _Pragma("unroll") for (int k = 0; k < 2; ++k) dst[m][k] = *(const PG8_LAS bf16x8*)(lds + PG8_SA(b, h) + aoff + m * 2048 + k * 1024); } while (0)
#define PG8_LDB(dst, b, h) do { _Pragma("unroll") for (int n = 0; n < 2; ++n) _Pragma("unroll") for (int k = 0; k < 2; ++k) dst[n][k] = *(const PG8_LAS bf16x8*)(lds + PG8_SB(b, h) + boff + n * 2048 + k * 1024); } while (0)
#define PG8_MMA(ai, bj, At, Bt) do { __builtin_amdgcn_s_setprio(1); _Pragma("unroll") for (int m = 0; m < 4; ++m) _Pragma("unroll") for (int n = 0; n < 2; ++n) _Pragma("unroll") for (int k = 0; k < 2; ++k) \
        acc[ai][bj][m][n] = __builtin_amdgcn_mfma_f32_16x16x32_bf16(Bt[n][k], At[m][k], acc[ai][bj][m][n], 0, 0, 0); __builtin_amdgcn_s_setprio(0); } while (0)
#define PG8_WAIT_V(n) asm volatile("s_waitcnt vmcnt(" #n ")" ::: "memory")
#define PG8_WAIT_L(n) asm volatile("s_waitcnt lgkmcnt(" #n ")" ::: "memory")
#define PG8_BAR __builtin_amdgcn_s_barrier()
#define PG8_SCHED __builtin_amdgcn_sched_barrier(0)
    Unit cur, nxt; int ui = 0;
    if (!S.next(0, cur)) return;
    if constexpr (GATHER) { S.aoff(cur, vA0, vA1, Rs, Cs); PG8_WAIT_V(0); }
    f32x4 acc[2][2][4][2];
#pragma unroll
    for (int a = 0; a < 2; ++a)
#pragma unroll
        for (int b = 0; b < 2; ++b)
#pragma unroll
            for (int m = 0; m < 4; ++m)
#pragma unroll
                for (int n = 0; n < 2; ++n) acc[a][b][m][n] = (f32x4){0.f, 0.f, 0.f, 0.f};
    bf16x8 At[4][2], B0[2][2], B1[2][2];
    const char* cA = cur.A; const char* cB = cur.B;
    PG8_STAGE(PG8_SB(0, 0), cB, vB); PG8_STAGE(PG8_SB(0, 1), cB + hstep, vB); PG8_STAGE(PG8_SA(0, 0), cA, vA0); PG8_STAGE(PG8_SA(0, 1), cA, vA1);
    if (wr == 1) PG8_BAR;
    PG8_WAIT_V(2); PG8_BAR;
    PG8_STAGE(PG8_SB(1, 0), cB + kstep, vB); PG8_STAGE(PG8_SA(1, 0), cA + kstep, vA0); PG8_STAGE(PG8_SB(1, 1), cB + hstep + kstep, vB);
    PG8_WAIT_V(6); PG8_BAR;
    for (;;) {
        const bool has_next = S.next(ui + 1, nxt);
        const char* nA = has_next ? nxt.A : cA; const char* nB = has_next ? nxt.B : cB;
        if constexpr (GATHER) {
            if (has_next) { S.aoff(nxt, nA0, nA1, Rs, Cs); }
            else {
#pragma unroll
                for (int i = 0; i < 2; ++i) { nA0[i] = vA0[i]; nA1[i] = vA1[i]; } }
        }
        for (int t = 0; t < nt; t += 2) {
            const bool last = (t == nt - 2);
            const char* a1 = cA + (size_t)(t + 1) * kstep;
            const char* a2 = last ? nA : cA + (size_t)(t + 2) * kstep; const char* b2 = last ? nB : cB + (size_t)(t + 2) * kstep;
            const char* a3 = a2 + kstep; const char* b3 = b2 + kstep;
            unsigned x0[2], x1[2];
#pragma unroll
            for (int i = 0; i < 2; ++i) { x0[i] = (GATHER && last) ? nA0[i] : vA0[i]; x1[i] = (GATHER && last) ? nA1[i] : vA1[i]; }
            PG8_LDB(B0, 0, 0); PG8_LDB(B1, 0, 1); PG8_SCHED; PG8_LDA(At, 0, 0); PG8_STAGE(PG8_SA(1, 1), a1, vA1);
            PG8_WAIT_V(8); PG8_WAIT_L(0); PG8_BAR; PG8_MMA(0, 0, At, B0); PG8_MMA(0, 1, At, B1); PG8_BAR; PG8_SCHED;
            PG8_LDA(At, 0, 1); PG8_STAGE(PG8_SB(0, 0), b2, vB); PG8_STAGE(PG8_SB(0, 1), b2 + hstep, vB); PG8_STAGE(PG8_SA(0, 0), a2, x0);
            PG8_WAIT_V(8); PG8_WAIT_L(0); PG8_BAR; PG8_MMA(1, 0, At, B0); PG8_MMA(1, 1, At, B1); PG8_BAR; PG8_SCHED;
            PG8_LDB(B0, 1, 0); PG8_LDB(B1, 1, 1); PG8_SCHED; PG8_LDA(At, 1, 0); PG8_STAGE(PG8_SA(0, 1), a2, x1);
            PG8_WAIT_V(8); PG8_WAIT_L(0); PG8_BAR; PG8_MMA(0, 0, At, B0); PG8_MMA(0, 1, At, B1); PG8_BAR; PG8_SCHED;
            PG8_LDA(At, 1, 1); PG8_STAGE(PG8_SB(1, 0), b3, vB); PG8_STAGE(PG8_SB(1, 1), b3 + hstep, vB); PG8_STAGE(PG8_SA(1, 0), a3, x0);
            PG8_WAIT_V(8); PG8_WAIT_L(0); PG8_BAR; PG8_MMA(1, 0, At, B0); PG8_MMA(1, 1, At, B1); PG8_BAR; PG8_SCHED;
        }
        if (wr == 0) PG8_BAR;
        E(acc, cur, wr, wc, fr, fq);
        if (!has_next) break;
#pragma unroll
        for (int a = 0; a < 2; ++a)
#pragma unroll
            for (int b = 0; b < 2; ++b)
#pragma unroll
                for (int m = 0; m < 4; ++m)
#pragma unroll
                    for (int n = 0; n < 2; ++n) acc[a][b][m][n] = (f32x4){0.f, 0.f, 0.f, 0.f};
        cur = nxt; cA = nA; cB = nB; ++ui;
        if constexpr (GATHER) {
#pragma unroll
            for (int i = 0; i < 2; ++i) { vA0[i] = nA0[i]; vA1[i] = nA1[i]; } }
        if (wr == 1) PG8_BAR;
    }
    PG8_WAIT_V(0);
    PG8_BAR;
#undef PG8_SA
#undef PG8_SB
#undef PG8_STAGE
#undef PG8_LDA
#undef PG8_LDB
#undef PG8_MMA
#undef PG8_WAIT_V
#undef PG8_WAIT_L
#undef PG8_BAR
#undef PG8_SCHED
}

struct EpiZ {
    static constexpr bool PERM = true;
    bf16_t* Z; const float* RS;
    __device__ __forceinline__ void operator()(const f32x4 (&acc)[2][2][4][2], const Unit& u, int wr, int wc, int fr, int fq) const {
        const int row0 = u.pm * BM + wr * 64 + fr, col0 = u.pn * BM + wc * 32 + 8 * fq;
#pragma unroll
        for (int ai = 0; ai < 2; ++ai)
#pragma unroll
            for (int m = 0; m < 4; ++m) { bf16_t* rowp = Z + (size_t)(row0 + ai * HALF + m * 16) * ZW + col0; const float rs = RS[row0 + ai * HALF + m * 16];
#pragma unroll
                for (int bj = 0; bj < 2; ++bj) { const f32x4 v0 = acc[ai][bj][m][0] * rs, v1 = acc[ai][bj][m][1] * rs;
                    u32x4 w; w.x = cvt_pk_bf16(v0[0], v0[1]); w.y = cvt_pk_bf16(v0[2], v0[3]); w.z = cvt_pk_bf16(v1[0], v1[1]); w.w = cvt_pk_bf16(v1[2], v1[3]);
                    *(u32x4*)(rowp + bj * HALF) = w; } }
    }
};
struct EpiRes {
    static constexpr bool PERM = false;
    const float* X; float* O;
    __device__ __forceinline__ void operator()(const f32x4 (&acc)[2][2][4][2], const Unit& u, int wr, int wc, int fr, int fq) const {
        const int row0 = u.pm * BM + wr * 64 + fr, col0 = u.pn * BM + wc * 32 + 4 * fq;
#pragma unroll
        for (int ai = 0; ai < 2; ++ai)
#pragma unroll
            for (int m = 0; m < 4; ++m) { const size_t off = (size_t)(row0 + ai * HALF + m * 16) * D + col0;
#pragma unroll
                for (int bj = 0; bj < 2; ++bj)
#pragma unroll
                    for (int n = 0; n < 2; ++n) { const f32x4 xs = *(const f32x4*)(X + off + bj * HALF + n * 16); *(f32x4*)(O + off + bj * HALF + n * 16) = xs + acc[ai][bj][m][n]; }
                asm volatile("" ::: "memory"); }
    }
};
struct EpiAct {
    static constexpr bool PERM = true;
    bf16_t* ACT; const int2* lists; const float* RS;
    __device__ __forceinline__ void operator()(const f32x4 (&acc)[2][2][4][2], const Unit& u, int wr, int wc, int fr, int fq) const {
        const int row0 = u.pm * BM + wr * 64 + fr, col0 = u.pn * HALF + wc * 32 + 8 * fq; const int2* lst = lists + (size_t)u.e * NTOK + u.pos0;
#pragma unroll
        for (int ai = 0; ai < 2; ++ai)
#pragma unroll
            for (int m = 0; m < 4; ++m) { const int r = ai * HALF + wr * 64 + m * 16 + fr; bf16_t* rowp = ACT + (size_t)(row0 + ai * HALF + m * 16) * DE + col0;
                float rs = 0.f; if (u.pos0 + r < u.cnt) rs = RS[lst[r].x];
                float o[8];
#pragma unroll
                for (int n = 0; n < 2; ++n)
#pragma unroll
                    for (int j = 0; j < 4; ++j) { const float g = acc[ai][0][m][n][j] * rs, up = acc[ai][1][m][n][j] * rs; o[n * 4 + j] = g * up * __builtin_amdgcn_rcpf(1.f + __expf(-g)); }
                u32x4 w; w.x = cvt_pk_bf16(o[0], o[1]); w.y = cvt_pk_bf16(o[2], o[3]); w.z = cvt_pk_bf16(o[4], o[5]); w.w = cvt_pk_bf16(o[6], o[7]);
                *(u32x4*)rowp = w; }
    }
};
struct EpiY {
    static constexpr bool PERM = true;
    bf16_t* YB; const int2* lists;
    __device__ __forceinline__ void operator()(const f32x4 (&acc)[2][2][4][2], const Unit& u, int wr, int wc, int fr, int fq) const {
        const int row0 = u.pm * BM + wr * 64 + fr, col0 = u.pn * BM + wc * 32 + 8 * fq; const int2* lst = lists + (size_t)u.e * NTOK + u.pos0;
#pragma unroll
        for (int ai = 0; ai < 2; ++ai)
#pragma unroll
            for (int m = 0; m < 4; ++m) { const int r = ai * HALF + wr * 64 + m * 16 + fr;
                if (u.pos0 + r < u.cnt) { const float w = __int_as_float(lst[r].y); bf16_t* rowp = YB + (size_t)(row0 + ai * HALF + m * 16) * D + col0;
#pragma unroll
                    for (int bj = 0; bj < 2; ++bj) { const f32x4 v0 = acc[ai][bj][m][0] * w, v1 = acc[ai][bj][m][1] * w;
                        u32x4 o; o.x = cvt_pk_bf16(v0[0], v0[1]); o.y = cvt_pk_bf16(v0[2], v0[3]); o.z = cvt_pk_bf16(v1[0], v1[1]); o.w = cvt_pk_bf16(v1[2], v1[3]);
                        *(u32x4*)(rowp + bj * HALF) = o; } } }
    }
};
struct MoeOrder {
    const PG8_LAS i32x4* tab; int ntiles, npn, G, c; const char* A; size_t atile; const char* Bt; size_t bexp, btile; const int2* lists;
    __device__ __forceinline__ bool next(int i, Unit& u) const {
        const int L = i * G + c; const int T = L / npn; if (T >= ntiles) return false;
        const i32x4 te = tab[T]; u.pm = T; u.pn = L - T * npn; u.e = __builtin_amdgcn_readfirstlane(te.x); u.pos0 = __builtin_amdgcn_readfirstlane(te.y); u.cnt = __builtin_amdgcn_readfirstlane(te.z);
        u.A = A + (size_t)T * atile; u.B = Bt + (size_t)u.e * bexp + (size_t)u.pn * btile; return true;
    }
    __device__ __forceinline__ void aoff(const Unit& u, unsigned (&o0)[2], unsigned (&o1)[2], const int (&Rs)[2], const int (&Cs)[2]) const {
        const int2* lst = lists + (size_t)u.e * NTOK;
#pragma unroll
        for (int i = 0; i < 2; ++i) { const int p0 = u.pos0 + Rs[i], p1 = p0 + HALF;
            const int t0 = (p0 < u.cnt) ? lst[p0].x : 0, t1 = (p1 < u.cnt) ? lst[p1].x : 0;
            o0[i] = (unsigned)t0 * (unsigned)(D * 2) + (unsigned)Cs[i] * 2u; o1[i] = (unsigned)t1 * (unsigned)(D * 2) + (unsigned)Cs[i] * 2u; }
    }
};
}

__device__ __forceinline__ void tc_tile(float* T  , const float* src, int src_ld, int c0, int k0, bf16_t* dst, int K, int n0) {
    const int tid = tid_opaque();
    __syncthreads();
#pragma unroll
    for (int i = 0; i < 2; ++i) { const int kk = (tid >> 4) + 32 * i, c4 = (tid & 15) * 4;
        const float4 v = *(const float4*)(src + (size_t)(k0 + kk) * src_ld + c0 + c4);
        T[kk * 65 + c4] = v.x; T[kk * 65 + c4 + 1] = v.y; T[kk * 65 + c4 + 2] = v.z; T[kk * 65 + c4 + 3] = v.w; }
    __syncthreads();
    const int nl = tid >> 3, kc = (tid & 7) * 8;
    pg8::u32x4 w;
    w.x = pg8::cvt_pk_bf16(T[(kc + 0) * 65 + nl], T[(kc + 1) * 65 + nl]); w.y = pg8::cvt_pk_bf16(T[(kc + 2) * 65 + nl], T[(kc + 3) * 65 + nl]);
    w.z = pg8::cvt_pk_bf16(T[(kc + 4) * 65 + nl], T[(kc + 5) * 65 + nl]); w.w = pg8::cvt_pk_bf16(T[(kc + 6) * 65 + nl], T[(kc + 7) * 65 + nl]);
    *(pg8::u32x4*)(dst + (size_t)(n0 + nl) * K + k0 + kc) = w;
}
__device__ __forceinline__ void s5_build_tables_fwd(float* ldsf, const Params& P, int l, int g, unsigned char* tb);
__device__ __forceinline__ void ph_prologue(float* lds, const Params& P) {
    constexpr int NJ_EXP = NLAYER * NEXP * 384, NJ_IN = NLAYER * 576, NJ_OUT = NLAYER * 256;
    bf16_t* WIN = (bf16_t*)(P.ws + WS_WIN); bf16_t* WOUT = (bf16_t*)(P.ws + WS_WOUT); bf16_t* WGU = (bf16_t*)(P.ws + WS_WGU); bf16_t* WD = (bf16_t*)(P.ws + WS_WD);
    constexpr int NJ_TB = NLAYER * 16, NJ_GLU = NLAYER * 16, NJ_SGU = NLAYER * 4, NJ_RT = NLAYER * 16;
    for (int j = blockIdx.x; j < NJ_EXP + NJ_IN + NJ_OUT + NJ_TB + NJ_GLU + NJ_SGU + NJ_RT; j += gridDim.x) {
        if (j >= NJ_EXP + NJ_IN + NJ_OUT + NJ_TB + NJ_GLU + NJ_SGU) { const int j7 = j - (NJ_EXP + NJ_IN + NJ_OUT + NJ_TB + NJ_GLU + NJ_SGU), l = j7 / 16, n0 = (j7 % 16) * 4;
            bf16_t* wh = (bf16_t*)(P.ws + WS_RT + (size_t)l * 256 * 1024); bf16_t* wl = wh + 48 * D;
            for (int idx = tid_opaque(); idx < 4 * D; idx += NTHREADS) { const int n = n0 + (idx >> 10), k = idx & (D - 1);
                const float w = (n < 4) ? P.in[I_RGW][((size_t)l * D + k) * 4 + n] : ((n < 36) ? P.in[I_REW][((size_t)l * D + k) * 32 + (n - 4)] : ((n >= 48 && n < 56) ? P.in[I_WIN][((size_t)l * D + k) * INW + WCI + (n - 48)] : 0.f));
                const unsigned hb = pg8::cvt_pk_bf16(w, 0.f) & 0xffffu; const bf16_t lb = (bf16_t)(pg8::cvt_pk_bf16(w - __uint_as_float(hb << 16), 0.f) & 0xffffu);
                if (n < 48) { wh[(size_t)n * D + k] = (bf16_t)hb; wl[(size_t)n * D + k] = lb; } else { wh[(size_t)(96 + n - 48) * D + k] = (bf16_t)hb; wh[(size_t)(112 + n - 48) * D + k] = lb; } }
            continue; }
        if (j >= NJ_EXP + NJ_IN + NJ_OUT + NJ_TB + NJ_GLU) { const int j6 = j - (NJ_EXP + NJ_IN + NJ_OUT + NJ_TB + NJ_GLU), l = j6 >> 2, g = j6 & 3;
            bf16_t* wbp = (bf16_t*)(P.ws + WS_TB + (size_t)l * 4 * MiB + s5::T_SGUW) + (size_t)g * 128 * 128; const float* ws_ = P.in[I_SGUW] + ((size_t)l * 4 + g) * 128 * 128;
            for (int idx = tid_opaque(); idx < 128 * 128; idx += NTHREADS) { const int t = idx >> 7, s = idx & 127; wbp[idx] = (s <= t) ? (bf16_t)(pg8::cvt_pk_bf16(ws_[idx], 0.f) & 0xffffu) : (bf16_t)0; }
            continue; }
        if (j < NJ_EXP) {
            const int le = j / 384, r = j % 384;
            if (r < 256) { const int n0 = (r >> 4) * 64, k0 = (r & 15) * 64, pn = n0 >> 8, within = n0 & 255;
                const float* s = (within < 128 ? P.in[I_EWG] : P.in[I_EWU]) + (size_t)le * D * DE;
                tc_tile(lds, s, DE, pn * 128 + (within & 127), k0, WGU + (size_t)le * 1024 * D, D, n0);
            } else { const int r2 = r - 256, n0 = (r2 >> 3) * 64, k0 = (r2 & 7) * 64;
                tc_tile(lds, P.in[I_EWD] + (size_t)le * DE * D, D, n0, k0, WD + (size_t)le * D * DE, DE, n0); }
        } else if (j < NJ_EXP + NJ_IN) {
            const int j2 = j - NJ_EXP, l = j2 / 576, r = j2 % 576, n0 = (r >> 4) * 64, k0 = (r & 15) * 64;
            tc_tile(lds, P.in[I_WIN] + (size_t)l * D * INW, INW, n0 < WCI ? n0 : n0 + 8, k0, WIN + (size_t)l * NMAIN * D, D, n0);
        } else if (j >= NJ_EXP + NJ_IN + NJ_OUT + NJ_TB) {
            const int j5 = j - (NJ_EXP + NJ_IN + NJ_OUT + NJ_TB), l = j5 >> 4, r = j5 & 15, n0 = (r >> 2) * 64, k0 = (r & 3) * 64;
            tc_tile(lds, P.in[I_GLUW] + (size_t)l * 256 * 256, 256, n0, k0, (bf16_t*)(P.ws + WS_TB + (size_t)l * 4 * MiB + s5::T_GLUW), 256, n0);
        } else if (j >= NJ_EXP + NJ_IN + NJ_OUT) {
            const int j4 = j - (NJ_EXP + NJ_IN + NJ_OUT);
            s5_build_tables_fwd(lds, P, j4 >> 4, j4 & 15, P.ws + WS_TB + (size_t)(j4 >> 4) * 4 * MiB);
        } else {
            const int j3 = j - NJ_EXP - NJ_IN, l = j3 / 256, r = j3 % 256, n0 = (r >> 4) * 64, k0 = (r & 15) * 64;
            tc_tile(lds, P.in[I_WOUT] + (size_t)l * D * D, D, n0, k0, WOUT + (size_t)l * D * D, D, n0);
        }
    }
    __syncthreads();
}

template <bool DUAL, class AF, class EF>
__device__ __forceinline__ void gemm_tile(float* lds, AF arow, int K, const float* B0, const float* B1, int ldb, int n0, int N, EF epi) {
    float* As = lds;
    float* Bs0 = lds + 32 * 132;
    float* Bs1 = Bs0 + 32 * 128;
    const int tid = tid_opaque(), ty = tid >> 4, tx = tid & 15;
    float acc0[4][8], acc1[4][8];
#pragma unroll
    for (int i = 0; i < 4; ++i)
#pragma unroll
        for (int j = 0; j < 8; ++j) { acc0[i][j] = 0.f; acc1[i][j] = 0.f; }
    const float* ap0 = arow((tid >> 3));
    const float* ap1 = arow((tid >> 3) + 64);
    const int akk = (tid & 7) * 4;
    const int bn = n0 + (tid & 31) * 4; const bool bok = bn < N;
    for (int k0 = 0; k0 < K; k0 += 32) {
        const float4 av0 = ap0 ? *(const float4*)(ap0 + k0 + akk) : make_float4(0.f, 0.f, 0.f, 0.f);
        const float4 av1 = ap1 ? *(const float4*)(ap1 + k0 + akk) : make_float4(0.f, 0.f, 0.f, 0.f);
        const int kb0 = k0 + (tid >> 5), kb1 = kb0 + 16;
        const float4 bv00 = bok ? *(const float4*)(B0 + (size_t)kb0 * ldb + bn) : make_float4(0.f, 0.f, 0.f, 0.f);
        const float4 bv01 = bok ? *(const float4*)(B0 + (size_t)kb1 * ldb + bn) : make_float4(0.f, 0.f, 0.f, 0.f);
        const float4 bv10 = (DUAL && bok) ? *(const float4*)(B1 + (size_t)kb0 * ldb + bn) : bv00;
        const float4 bv11 = (DUAL && bok) ? *(const float4*)(B1 + (size_t)kb1 * ldb + bn) : bv01;
        __syncthreads();
        { const int r = (tid >> 3);
          As[(akk + 0) * 132 + r] = av0.x; As[(akk + 1) * 132 + r] = av0.y; As[(akk + 2) * 132 + r] = av0.z; As[(akk + 3) * 132 + r] = av0.w;
          As[(akk + 0) * 132 + r + 64] = av1.x; As[(akk + 1) * 132 + r + 64] = av1.y; As[(akk + 2) * 132 + r + 64] = av1.z; As[(akk + 3) * 132 + r + 64] = av1.w; }
        { const int k = (tid >> 5);
          *(float4*)&Bs0[k * 128 + (tid & 31) * 4] = bv00; *(float4*)&Bs0[(k + 16) * 128 + (tid & 31) * 4] = bv01;
          if (DUAL) { *(float4*)&Bs1[k * 128 + (tid & 31) * 4] = bv10; *(float4*)&Bs1[(k + 16) * 128 + (tid & 31) * 4] = bv11; } }
        __syncthreads();
#pragma unroll 4
        for (int k = 0; k < 32; ++k) {
            const float4 a = *(const float4*)&As[k * 132 + ty * 4];
            const float4 b0 = *(const float4*)&Bs0[k * 128 + tx * 4], b1 = *(const float4*)&Bs0[k * 128 + 64 + tx * 4];
            const float aa[4] = {a.x, a.y, a.z, a.w};
            const float bb[8] = {b0.x, b0.y, b0.z, b0.w, b1.x, b1.y, b1.z, b1.w};
#pragma unroll
            for (int i = 0; i < 4; ++i)
#pragma unroll
                for (int j = 0; j < 8; ++j) acc0[i][j] = fmaf(aa[i], bb[j], acc0[i][j]);
            if (DUAL) {
                const float4 c0 = *(const float4*)&Bs1[k * 128 + tx * 4], c1 = *(const float4*)&Bs1[k * 128 + 64 + tx * 4];
                const float cc[8] = {c0.x, c0.y, c0.z, c0.w, c1.x, c1.y, c1.z, c1.w};
#pragma unroll
                for (int i = 0; i < 4; ++i)
#pragma unroll
                    for (int j = 0; j < 8; ++j) acc1[i][j] = fmaf(aa[i], cc[j], acc1[i][j]);
            }
        }
    }
#pragma unroll
    for (int i = 0; i < 4; ++i)
#pragma unroll
        for (int j = 0; j < 8; ++j) {
            const int r = ty * 4 + i, c = n0 + (j < 4 ? tx * 4 + j : 64 + tx * 4 + (j - 4));
            if (c < N) epi(r, c, acc0[i][j], acc1[i][j]);
        }
    __syncthreads();
}

__device__ __forceinline__ void ph_inproj(LAS unsigned char* ldsb, const bf16_t* xn, const bf16_t* wt, bf16_t* z, const float* RS) {
    pg8::StaticOrder S; S.init(NTOK, NMAIN, D, D, gridDim.x, blockIdx.x, xn, wt);
    pg8::EpiZ E{z, RS};
    pg8::gemm_phase<pg8::EpiZ, pg8::StaticOrder, false>(ldsb, D, D, S, E);
}

namespace ml {
using pg8::bf16x8; using pg8::f32x4; using pg8::u32x4; using pg8::u32x2;
constexpr int L = 128, NCH = S / L, NU = NB * 4 * NCH;
constexpr int QP = 144, TP = 272;
constexpr int OFF_Q = 0, OFF_K = OFF_Q + 128 * QP, OFF_VT = OFF_K + 128 * QP, OFF_KT = OFF_VT + 64 * TP, OFF_F = OFF_KT + 64 * TP;
constexpr int LDS_END = OFF_F + 4 * 128 * 4 + 64;
constexpr size_t O_CL = 0, O_CST = O_CL + (size_t)NU * 4096 * 4, O_NL = O_CST + (size_t)NU * 4096 * 2, O_NST = O_NL + (size_t)NU * 64 * 4,
                 O_MLOC = O_NST + (size_t)NU * 64 * 4, O_BL = O_MLOC + (size_t)NU * 4, O_MST = O_BL + (size_t)NU * 4, O_END = O_MST + (size_t)NU * 4;
__device__ __forceinline__ f32x4 mfma16(bf16x8 a, bf16x8 b, f32x4 c) { return __builtin_amdgcn_mfma_f32_16x16x32_bf16(a, b, c, 0, 0, 0); }
__device__ __forceinline__ float bf_lo(unsigned w) { return __uint_as_float(w << 16); }
__device__ __forceinline__ float bf_hi(unsigned w) { return __uint_as_float(w & 0xffff0000u); }
__device__ __forceinline__ unsigned short bf1(float x) { return (unsigned short)(pg8::cvt_pk_bf16(x, 0.f) & 0xffffu); }

__device__ __forceinline__ void stage_gates(LAS unsigned char* lds, const float* gates, const Params& P, int l, int head, int tok0, int tid) {
    LAS float* LF = (LAS float*)(lds + OFF_F); LAS float* IG = LF + 128; LAS float* Bc = LF + 256; LAS float* G2 = LF + 384; LAS float* scal = LF + 512;
    if (tid < 128) { const float* zr = gates + (size_t)(tok0 + tid) * 8;
        const float ipre = zr[head] + P.in[I_GATEB][l * 8 + head], fpre = zr[4 + head] + P.in[I_GATEB][l * 8 + 4 + head];
        LF[tid] = fminf(fpre, 0.f) - log1pf(expf(-fabsf(fpre))); IG[tid] = ipre; }
    __syncthreads();
    if (tid < 64) { const float a = LF[2 * tid], b2 = LF[2 * tid + 1]; const float s = a + b2; float inc = s;
#pragma unroll
        for (int o = 1; o < 64; o <<= 1) { const float v = __shfl_up(inc, o); if (tid >= o) inc += v; }
        const float exc = inc - s; const float b0 = exc + a, b1 = exc + s;
        Bc[2 * tid] = b0; Bc[2 * tid + 1] = b1; const float g0 = IG[2 * tid] - b0, g1 = IG[2 * tid + 1] - b1; G2[2 * tid] = g0; G2[2 * tid + 1] = g1;
        float gm = fmaxf(g0, g1);
#pragma unroll
        for (int o = 32; o > 0; o >>= 1) gm = fmaxf(gm, __shfl_xor(gm, o));
        if (tid == 63) { scal[0] = gm; scal[1] = b1; } }
    __syncthreads();
}
__device__ __forceinline__ void conv8(const bf16_t* z, const float* cw, int b, int pos, int which, int head, int c0, float (&o)[8]) {
    const int col = (which ? ZCK : ZCQ) + head * 64 + c0, cc = which * 256 + head * 64 + c0;
    float x[8];
#pragma unroll
    for (int e = 0; e < 8; ++e) x[e] = 0.f;
#pragma unroll
    for (int j = 0; j < 4; ++j) { const int tg = pos - 3 + j;
        if (tg >= 0) { float v[8]; ld8(z + (size_t)(b * S + tg) * ZW + col, v);
            const float4 w0 = *(const float4*)(cw + j * 512 + cc), w1 = *(const float4*)(cw + j * 512 + cc + 4);
            x[0] += w0.x * v[0]; x[1] += w0.y * v[1]; x[2] += w0.z * v[2]; x[3] += w0.w * v[3]; x[4] += w1.x * v[4]; x[5] += w1.y * v[5]; x[6] += w1.z * v[6]; x[7] += w1.w * v[7]; } }
    const float sc = which ? 0.125f : 1.f;
#pragma unroll
    for (int e = 0; e < 8; ++e) o[e] = x[e] * sc / (1.f + __expf(-x[e]));
}
__device__ __forceinline__ void stage_vt(LAS unsigned char* lds, const bf16_t* z, int head, int tok0, int tid) {
#pragma unroll
    for (int it = 0; it < 2; ++it) { const int idx = tid + it * NTHREADS, s = idx & 127, cg = idx >> 7;
        const u32x4 w = *(const u32x4*)(z + (size_t)(tok0 + s) * ZW + ZCV + head * 64 + cg * 8);
        const unsigned ww[4] = {w.x, w.y, w.z, w.w};
#pragma unroll
        for (int e = 0; e < 8; ++e) *(LAS unsigned short*)(lds + OFF_VT + (cg * 8 + e) * TP + s * 2) = (unsigned short)((e & 1) ? (ww[e >> 1] >> 16) : (ww[e >> 1] & 0xffffu)); }
}

__device__ __forceinline__ void p1_unit(LAS unsigned char* lds, const bf16_t* z, const float* gates, const Params& P, int l, int u, unsigned char* wsm) {
    const int tid = tid_opaque(), lane = tid & 63, wid = __builtin_amdgcn_readfirstlane(tid >> 6), r = lane & 15, qd = lane >> 4;
    const int b = u >> 8, head = (u >> 6) & 3, c = u & 63, tok0 = b * S + c * L;
    LAS float* G2 = (LAS float*)(lds + OFF_F) + 384; LAS float* scal = (LAS float*)(lds + OFF_F) + 512;
    __syncthreads();
    stage_gates(lds, gates, P, l, head, tok0, tid);
    const float gmax = scal[0], bL = scal[1];
    stage_vt(lds, z, head, tok0, tid);
    const float* cw = P.in[I_CONVW] + (size_t)l * 4 * 512;
#pragma unroll
    for (int it = 0; it < 2; ++it) { const int idx = tid + it * NTHREADS, s = idx & 127, cg = idx >> 7;
        float o[8]; conv8(z, cw, b, c * L + s, 1, head, cg * 8, o);
        const float ws = __expf(G2[s] - gmax);
#pragma unroll
        for (int e = 0; e < 8; ++e) *(LAS unsigned short*)(lds + OFF_KT + (cg * 8 + e) * TP + s * 2) = bf1(o[e] * ws); }
    __syncthreads();
    const int kt = wid >> 1;
    float* CL = (float*)(wsm + O_CL) + (size_t)u * 4096;
#pragma unroll
    for (int i = 0; i < 2; ++i) { const int vt = (wid & 1) * 2 + i; f32x4 acc = {0.f, 0.f, 0.f, 0.f};
#pragma unroll
        for (int ks = 0; ks < 4; ++ks) { const bf16x8 a = *(const LAS bf16x8*)(lds + OFF_KT + (16 * kt + r) * TP + (32 * ks + 8 * qd) * 2), bb = *(const LAS bf16x8*)(lds + OFF_VT + (16 * vt + r) * TP + (32 * ks + 8 * qd) * 2);
            acc = mfma16(a, bb, acc); }
        *(f32x4*)(CL + (size_t)(16 * vt + r) * 64 + 16 * kt + 4 * qd) = acc; }
    if (tid < 64) { float sum = 0.f;
        for (int s2 = 0; s2 < 128; s2 += 2) { const unsigned w2 = *(const LAS unsigned*)(lds + OFF_KT + tid * TP + s2 * 2); sum += bf_lo(w2) + bf_hi(w2); }
        ((float*)(wsm + O_NL))[(size_t)u * 64 + tid] = sum; }
    if (tid == 0) { ((float*)(wsm + O_MLOC))[u] = bL + gmax; ((float*)(wsm + O_BL))[u] = bL; }
}
__device__ __forceinline__ void p2_scan(unsigned char* wsm) {
    const int tid = tid_opaque();
    const float* __restrict__ CL = (const float*)(wsm + O_CL); const float* __restrict__ NL = (const float*)(wsm + O_NL); const float* __restrict__ MLOC = (const float*)(wsm + O_MLOC); const float* __restrict__ BL = (const float*)(wsm + O_BL);
    bf16_t* __restrict__ CST = (bf16_t*)(wsm + O_CST); float* __restrict__ NST = (float*)(wsm + O_NST); float* __restrict__ MST = (float*)(wsm + O_MST);
    for (int idx = blockIdx.x * NTHREADS + tid; idx < 32 * 4096; idx += gridDim.x * NTHREADS) {
        const int bh = idx >> 12, e = idx & 4095;
        float C = 0.f, nn = 0.f, m = 0.f;
#pragma unroll 16
        for (int c = 0; c < NCH; ++c) { const int u = bh * NCH + c;
            CST[(size_t)u * 4096 + e] = bf1(C);
            if (e < 64) NST[(size_t)u * 64 + e] = nn;
            if (e == 0) MST[u] = m;
            const float mloc = MLOC[u], bL = BL[u], mn = fmaxf(bL + m, mloc), dec = __expf(bL + m - mn), wl = __expf(mloc - mn);
            C = dec * C + wl * CL[(size_t)u * 4096 + e];
            if (e < 64) nn = dec * nn + wl * NL[(size_t)u * 64 + e];
            m = mn; }
    }
}
__device__ __forceinline__ void p3_unit(LAS unsigned char* lds, const bf16_t* z, const float* gates, const Params& P, int l, int u, const unsigned char* wsm, bf16_t* mix) {
    const int tid = tid_opaque(), lane = tid & 63, wid = __builtin_amdgcn_readfirstlane(tid >> 6), r = lane & 15, qd = lane >> 4;
    const int b = u >> 8, head = (u >> 6) & 3, c = u & 63, tok0 = b * S + c * L;
    LAS float* Bc = (LAS float*)(lds + OFF_F) + 256; LAS float* G2 = (LAS float*)(lds + OFF_F) + 384;
    __syncthreads();
    stage_gates(lds, gates, P, l, head, tok0, tid);
    stage_vt(lds, z, head, tok0, tid);
    const float* cw = P.in[I_CONVW] + (size_t)l * 4 * 512;
#pragma unroll
    for (int it = 0; it < 4; ++it) { const int idx = tid + it * NTHREADS, which = idx >> 10, s = (idx >> 3) & 127, cg = idx & 7;
        float o[8]; conv8(z, cw, b, c * L + s, which, head, cg * 8, o);
        u32x4 w; w.x = pg8::cvt_pk_bf16(o[0], o[1]); w.y = pg8::cvt_pk_bf16(o[2], o[3]); w.z = pg8::cvt_pk_bf16(o[4], o[5]); w.w = pg8::cvt_pk_bf16(o[6], o[7]);
        *(LAS u32x4*)(lds + (which ? OFF_K : OFF_Q) + s * QP + cg * 16) = w; }
    __syncthreads();
    const int w = wid, t = 16 * w + r;
    const bf16x8 bq0 = *(const LAS bf16x8*)(lds + OFF_Q + t * QP + qd * 16), bq1 = *(const LAS bf16x8*)(lds + OFF_Q + t * QP + 64 + qd * 16);
    f32x4 accS[8];
#pragma unroll
    for (int ct = 0; ct < 8; ++ct) { accS[ct] = (f32x4){0.f, 0.f, 0.f, 0.f};
        if (ct <= w) { const bf16x8 a0 = *(const LAS bf16x8*)(lds + OFF_K + (16 * ct + r) * QP + qd * 16), a1 = *(const LAS bf16x8*)(lds + OFF_K + (16 * ct + r) * QP + 64 + qd * 16);
            accS[ct] = mfma16(a0, bq0, accS[ct]); accS[ct] = mfma16(a1, bq1, accS[ct]); } }
    const float bt = Bc[t], mst = ((const float*)(wsm + O_MST))[u];
    float ld[8][4]; float mloc = -3.0e38f;
#pragma unroll
    for (int ct = 0; ct < 8; ++ct) { const f32x4 g = *(const LAS f32x4*)(G2 + 16 * ct + 4 * qd);
#pragma unroll
        for (int j = 0; j < 4; ++j) { const bool valid = (ct < w) || (ct == w && 4 * qd + j <= r); ld[ct][j] = valid ? bt + g[j] : -3.0e38f; mloc = fmaxf(mloc, ld[ct][j]); } }
    mloc = fmaxf(mloc, __shfl_xor(mloc, 16)); mloc = fmaxf(mloc, __shfl_xor(mloc, 32));
    const float mt = fmaxf(bt + mst, mloc);
    float den = 0.f;
#pragma unroll
    for (int ct = 0; ct < 8; ++ct)
#pragma unroll
        for (int j = 0; j < 4; ++j) { const float pe = __expf(ld[ct][j] - mt) * accS[ct][j]; accS[ct][j] = pe; den += pe; }
    den += __shfl_xor(den, 16); den += __shfl_xor(den, 32);
    const bf16_t* cst = (const bf16_t*)(wsm + O_CST) + (size_t)u * 4096; const float* nst = (const float*)(wsm + O_NST) + (size_t)u * 64;
    f32x4 accN[4];
#pragma unroll
    for (int dt = 0; dt < 4; ++dt) { const bf16x8 c0 = *(const bf16x8*)(cst + (16 * dt + r) * 64 + 8 * qd), c1 = *(const bf16x8*)(cst + (16 * dt + r) * 64 + 32 + 8 * qd);
        accN[dt] = mfma16(c0, bq0, (f32x4){0.f, 0.f, 0.f, 0.f}); accN[dt] = mfma16(c1, bq1, accN[dt]); }
    const float winter = __expf(bt + mst - mt);
    float nq = 0.f;
    { const float4 n0 = *(const float4*)(nst + 8 * qd), n1 = *(const float4*)(nst + 8 * qd + 4), n2 = *(const float4*)(nst + 32 + 8 * qd), n3 = *(const float4*)(nst + 36 + 8 * qd);
      const u32x4 q0 = __builtin_bit_cast(u32x4, bq0), q1 = __builtin_bit_cast(u32x4, bq1);
      nq = bf_lo(q0.x) * n0.x + bf_hi(q0.x) * n0.y + bf_lo(q0.y) * n0.z + bf_hi(q0.y) * n0.w + bf_lo(q0.z) * n1.x + bf_hi(q0.z) * n1.y + bf_lo(q0.w) * n1.z + bf_hi(q0.w) * n1.w
         + bf_lo(q1.x) * n2.x + bf_hi(q1.x) * n2.y + bf_lo(q1.y) * n2.z + bf_hi(q1.y) * n2.w + bf_lo(q1.z) * n3.x + bf_hi(q1.z) * n3.y + bf_lo(q1.w) * n3.z + bf_hi(q1.w) * n3.w; }
    nq += __shfl_xor(nq, 16); nq += __shfl_xor(nq, 32);
    den += winter * nq;
#pragma unroll
    for (int dt = 0; dt < 4; ++dt) accN[dt] = accN[dt] * winter;
#pragma unroll
    for (int kk = 0; kk < 4; ++kk) if (2 * kk <= w) {
        u32x4 pw; pw.x = pg8::cvt_pk_bf16(accS[2 * kk][0], accS[2 * kk][1]); pw.y = pg8::cvt_pk_bf16(accS[2 * kk][2], accS[2 * kk][3]);
        pw.z = pg8::cvt_pk_bf16(accS[2 * kk + 1][0], accS[2 * kk + 1][1]); pw.w = pg8::cvt_pk_bf16(accS[2 * kk + 1][2], accS[2 * kk + 1][3]);
        const bf16x8 pf = __builtin_bit_cast(bf16x8, pw);
#pragma unroll
        for (int dt = 0; dt < 4; ++dt) { const u32x2 v0 = *(const LAS u32x2*)(lds + OFF_VT + (16 * dt + r) * TP + (32 * kk + 4 * qd) * 2), v1 = *(const LAS u32x2*)(lds + OFF_VT + (16 * dt + r) * TP + (32 * kk + 16 + 4 * qd) * 2);
            u32x4 vw; vw.x = v0.x; vw.y = v0.y; vw.z = v1.x; vw.w = v1.y;
            accN[dt] = mfma16(__builtin_bit_cast(bf16x8, vw), pf, accN[dt]); } }
    const float inv = 1.f / fmaxf(fabsf(den), __expf(-mt));
    float ss = 0.f;
#pragma unroll
    for (int dt = 0; dt < 4; ++dt) { accN[dt] = accN[dt] * inv; ss += accN[dt][0] * accN[dt][0] + accN[dt][1] * accN[dt][1] + accN[dt][2] * accN[dt][2] + accN[dt][3] * accN[dt][3]; }
    ss += __shfl_xor(ss, 16); ss += __shfl_xor(ss, 32);
    const float rs = rsqrtf(ss * (1.f / 64.f) + EPS);
    const float* ng = P.in[I_MNG] + l * 256 + head * 64; const bf16_t* cop = z + (size_t)(tok0 + t) * ZW + ZCO + head * 64;
    bf16_t* op = mix + (size_t)(tok0 + t) * D + 512 + head * 64;
#pragma unroll
    for (int dt = 0; dt < 4; ++dt) { const int d0 = 16 * dt + 4 * qd; const float4 g = *(const float4*)(ng + d0); const u32x2 cw2 = *(const u32x2*)(cop + d0); const float4 co = make_float4(bf_lo(cw2.x), bf_hi(cw2.x), bf_lo(cw2.y), bf_hi(cw2.y));
        u32x2 o; o.x = pg8::cvt_pk_bf16(accN[dt][0] * rs * g.x / (1.f + __expf(-co.x)), accN[dt][1] * rs * g.y / (1.f + __expf(-co.y)));
        o.y = pg8::cvt_pk_bf16(accN[dt][2] * rs * g.z / (1.f + __expf(-co.z)), accN[dt][3] * rs * g.w / (1.f + __expf(-co.w)));
        *(u32x2*)(op + d0) = o; }
}
static_assert(O_END <= 64 * MiB && LDS_END <= 128 * 1024, "mLSTM scratch fits");
}

namespace s5 {
using pg8::bf16x8; using pg8::f32x4; using pg8::u32x4; using pg8::u32x2;
constexpr int LC = 16, NINST = NTOK / LC;
constexpr size_t O_E = 0, O_XC = O_E + (size_t)NINST * 16 * 128 * 4, O_END = O_XC + (size_t)NINST * 16 * 128 * 2;
constexpr int YP = 528;
__device__ __forceinline__ f32x4 mfma16(bf16x8 a, bf16x8 b, f32x4 c) { return __builtin_amdgcn_mfma_f32_16x16x32_bf16(a, b, c, 0, 0, 0); }

__device__ __forceinline__ void build_tables(float* ldsf, const Params& P, int l, int g, unsigned char* tb) {
    const int tid = tid_opaque();
    float* apw = ldsf; float* bb = apw + 17 * 64 * 2; float* cc = bb + 64 * 16 * 2;
    __syncthreads();
    if (tid < 64) { const int gp = (l * 16 + g) * 64 + tid;
        const float ar = P.in[I_ARE][gp], ai = P.in[I_AIM][gp], dt = expf(P.in[I_LDT][l * 16 + g]);
        for (int tau = 0; tau <= 16; ++tau) { const float er = expf(ar * dt * tau), ang = ai * dt * tau; apw[(tau * 64 + tid) * 2] = er * cosf(ang); apw[(tau * 64 + tid) * 2 + 1] = er * sinf(ang); }
        const float abr = apw[(64 + tid) * 2], abi = apw[(64 + tid) * 2 + 1];
        const float xr_ = abr - 1.f, xi_ = abi, den = ar * ar + ai * ai;
        const float cr = (xr_ * ar + xi_ * ai) / den, ci = (xi_ * ar - xr_ * ai) / den;
        for (int h = 0; h < 16; ++h) { const float br = P.in[I_BRE][(size_t)gp * 16 + h], bi = P.in[I_BIM][(size_t)gp * 16 + h]; bb[(tid * 16 + h) * 2] = cr * br - ci * bi; bb[(tid * 16 + h) * 2 + 1] = cr * bi + ci * br; }
        float* a16 = (float*)(tb + T_A16) + (size_t)(g * 64 + tid) * 2; a16[0] = apw[(16 * 64 + tid) * 2]; a16[1] = apw[(16 * 64 + tid) * 2 + 1]; }
    for (int idx = tid; idx < 16 * 64; idx += NTHREADS) { const int h = idx >> 6, p = idx & 63; const int ci_ = ((l * 16 + g) * 16 + h) * 64 + p; cc[idx * 2] = P.in[I_CRE][ci_]; cc[idx * 2 + 1] = P.in[I_CIM][ci_]; }
    __syncthreads();
    bf16_t* KM = (bf16_t*)(tb + T_KMAT) + (size_t)g * 16 * 256; bf16_t* FT = (bf16_t*)(tb + T_F) + (size_t)g * 256 * 128; bf16_t* GT = (bf16_t*)(tb + T_G) + (size_t)g * 128 * 256;
    for (int idx = tid; idx < 16 * 256; idx += NTHREADS) { const int tau = idx >> 8, h = (idx >> 4) & 15, hp = idx & 15; float s = 0.f;
        for (int p = 0; p < 64; ++p) { const float cr = cc[(h * 64 + p) * 2], ci = cc[(h * 64 + p) * 2 + 1], ar = apw[(tau * 64 + p) * 2], ai = apw[(tau * 64 + p) * 2 + 1], br = bb[(p * 16 + hp) * 2], bi = bb[(p * 16 + hp) * 2 + 1];
            const float er = ar * br - ai * bi, ei = ar * bi + ai * br; s += cr * er - ci * ei; }
        KM[idx] = ml::bf1(s); }
    for (int idx = tid; idx < 256 * 64; idx += NTHREADS) { const int n = idx >> 6, p = idx & 63, t = n >> 4, h = n & 15;
        const float cr = cc[(h * 64 + p) * 2], ci = cc[(h * 64 + p) * 2 + 1], ar = apw[((t + 1) * 64 + p) * 2], ai = apw[((t + 1) * 64 + p) * 2 + 1];
        FT[(size_t)n * 128 + p] = ml::bf1(cr * ar - ci * ai); FT[(size_t)n * 128 + 64 + p] = ml::bf1(-(cr * ai + ci * ar)); }
    for (int idx = tid; idx < 64 * 256; idx += NTHREADS) { const int p = idx >> 8, k = idx & 255, s = k >> 4, hp = k & 15;
        const float ar = apw[((15 - s) * 64 + p) * 2], ai = apw[((15 - s) * 64 + p) * 2 + 1], br = bb[(p * 16 + hp) * 2], bi = bb[(p * 16 + hp) * 2 + 1];
        GT[(size_t)p * 256 + k] = ml::bf1(ar * br - ai * bi); GT[(size_t)(64 + p) * 256 + k] = ml::bf1(ar * bi + ai * br); }
}
__device__ __forceinline__ void load_u_frags(const bf16_t* z, int tok0, int g, int r, int qd, bf16x8 (&uf)[8]) {
#pragma unroll
    for (int ks = 0; ks < 8; ++ks) uf[ks] = *(const bf16x8*)(z + (size_t)(tok0 + 16 * r + 2 * ks + (qd >> 1)) * ZW + ZSU + 16 * g + 8 * (qd & 1));
}
__device__ __forceinline__ void p1_unit(const bf16_t* z, const unsigned char* tb, int u, unsigned char* wss) {
    const int tid = tid_opaque(), lane = tid & 63, wid = __builtin_amdgcn_readfirstlane(tid >> 6), r = lane & 15, qd = lane >> 4;
    const int tok0 = u * 256, inst0 = u * 16;
    float* E = (float*)(wss + O_E);
#pragma unroll 1
    for (int g = 0; g < 16; ++g) {
        bf16x8 uf[8]; load_u_frags(z, tok0, g, r, qd, uf);
        const bf16_t* GT = (const bf16_t*)(tb + T_G) + (size_t)g * 128 * 256 + (size_t)(16 * wid + r) * 256 + 8 * qd;
        f32x4 acc = {0.f, 0.f, 0.f, 0.f};
#pragma unroll
        for (int ks = 0; ks < 8; ++ks) acc = mfma16(*(const bf16x8*)(GT + 32 * ks), uf[ks], acc);
        *(f32x4*)(E + ((size_t)(inst0 + r) * 16 + g) * 128 + 16 * wid + 4 * qd) = acc;
    }
}
__device__ __forceinline__ void p2_scan(LAS unsigned char* lds, const unsigned char* tb, unsigned char* wss) {
    const int tid = tid_opaque(), p = tid & 63, seg = tid >> 6;
    const float* __restrict__ E = (const float*)(wss + O_E); bf16_t* __restrict__ XC = (bf16_t*)(wss + O_XC);
    LAS float* SE = (LAS float*)lds;
    for (int u = blockIdx.x; u < NB * 16; u += gridDim.x) {
        const int b = u >> 4, g = u & 15;
        const float* a16 = (const float*)(tb + T_A16) + (size_t)(g * 64 + p) * 2; const float ar = a16[0], ai = a16[1];
        const size_t o0 = ((size_t)(b * (S / LC) + seg * 64) * 16 + g) * 128 + p; constexpr size_t cs = (size_t)16 * 128;
        float xr = 0.f, xi = 0.f;
#pragma unroll 16
        for (int c = 0; c < 64; ++c) { const float er = E[o0 + c * cs], ei = E[o0 + c * cs + 64]; const float nr = ar * xr - ai * xi + er, ni = ar * xi + ai * xr + ei; xr = nr; xi = ni; }
        __syncthreads();
        SE[(seg * 64 + p) * 2] = xr; SE[(seg * 64 + p) * 2 + 1] = xi;
        __syncthreads();
        float br = ar, bi = ai;
#pragma unroll
        for (int i = 0; i < 6; ++i) { const float nr = br * br - bi * bi, ni = 2.f * br * bi; br = nr; bi = ni; }
        xr = 0.f; xi = 0.f;
        for (int s2 = 0; s2 < seg; ++s2) { const float er = SE[(s2 * 64 + p) * 2], ei = SE[(s2 * 64 + p) * 2 + 1]; const float nr = br * xr - bi * xi + er, ni = br * xi + bi * xr + ei; xr = nr; xi = ni; }
#pragma unroll 16
        for (int c = 0; c < 64; ++c) { XC[o0 + c * cs] = ml::bf1(xr); XC[o0 + c * cs + 64] = ml::bf1(xi);
            const float er = E[o0 + c * cs], ei = E[o0 + c * cs + 64]; const float nr = ar * xr - ai * xi + er, ni = ar * xi + ai * xr + ei; xr = nr; xi = ni; }
    }
    __syncthreads();
}
__device__ __forceinline__ void p3_unit(LAS unsigned char* lds, const bf16_t* z, const Params& P, int l, const unsigned char* tb, int u, const unsigned char* wss, bf16_t* mix) {
    const int tid = tid_opaque(), lane = tid & 63, wid = __builtin_amdgcn_readfirstlane(tid >> 6), r = lane & 15, qd = lane >> 4;
    const int tok0 = u * 256, inst0 = u * 16;
    const bf16_t* XC = (const bf16_t*)(wss + O_XC);
    __syncthreads();
#pragma unroll 1
    for (int g = 0; g < 16; ++g) {
        bf16x8 uf[8]; load_u_frags(z, tok0, g, r, qd, uf);
        bf16x8 xf[4];
#pragma unroll
        for (int ks = 0; ks < 4; ++ks) xf[ks] = *(const bf16x8*)(XC + ((size_t)(inst0 + r) * 16 + g) * 128 + 32 * ks + 8 * qd);
        const bf16_t* KM = (const bf16_t*)(tb + T_KMAT) + (size_t)g * 16 * 256; const bf16_t* FT = (const bf16_t*)(tb + T_F) + (size_t)g * 256 * 128;
        const float4 dsk = *(const float4*)(P.in[I_SD] + l * 256 + g * 16 + 4 * qd);
#pragma unroll
        for (int tt = 0; tt < 2; ++tt) { const int t = 2 * wid + tt;
            f32x4 acc = {0.f, 0.f, 0.f, 0.f};
#pragma unroll
            for (int ks = 0; ks < 8; ++ks) if (2 * ks <= t) { const int tau = t - 2 * ks - (qd >> 1);
                bf16x8 kf = {0, 0, 0, 0, 0, 0, 0, 0};
                if (tau >= 0) kf = *(const bf16x8*)(KM + (size_t)tau * 256 + r * 16 + 8 * (qd & 1));
                acc = mfma16(kf, uf[ks], acc); }
#pragma unroll
            for (int ks = 0; ks < 4; ++ks) acc = mfma16(*(const bf16x8*)(FT + (size_t)(t * 16 + r) * 128 + 32 * ks + 8 * qd), xf[ks], acc);
            const int tok = tok0 + 16 * r + t;
            const u32x2 uw = *(const u32x2*)(z + (size_t)tok * ZW + ZSU + 16 * g + 4 * qd);
            const float y0 = gelu_tanh(acc[0] + dsk.x * ml::bf_lo(uw.x)), y1 = gelu_tanh(acc[1] + dsk.y * ml::bf_hi(uw.x)), y2 = gelu_tanh(acc[2] + dsk.z * ml::bf_lo(uw.y)), y3 = gelu_tanh(acc[3] + dsk.w * ml::bf_hi(uw.y));
            u32x2 o; o.x = pg8::cvt_pk_bf16(y0, y1); o.y = pg8::cvt_pk_bf16(y2, y3);
            *(LAS u32x2*)(lds + (16 * r + t) * YP + (16 * g + 4 * qd) * 2) = o; }
    }
    __syncthreads();
    const bf16_t* GW = (const bf16_t*)(tb + T_GLUW);
    bf16x8 wf[2][8];
#pragma unroll
    for (int nt = 0; nt < 2; ++nt)
#pragma unroll
        for (int ks = 0; ks < 8; ++ks) wf[nt][ks] = *(const bf16x8*)(GW + (size_t)(32 * wid + 16 * nt + r) * 256 + 32 * ks + 8 * qd);
    const float* gb = P.in[I_GLUB] + l * 256;
    const float4 gb0 = *(const float4*)(gb + 32 * wid + 4 * qd), gb1 = *(const float4*)(gb + 32 * wid + 16 + 4 * qd);
#pragma unroll 2
    for (int mt = 0; mt < 16; ++mt) {
        f32x4 a0 = {0.f, 0.f, 0.f, 0.f}, a1 = {0.f, 0.f, 0.f, 0.f};
#pragma unroll
        for (int ks = 0; ks < 8; ++ks) { const bf16x8 yf = *(const LAS bf16x8*)(lds + (16 * mt + r) * YP + (32 * ks + 8 * qd) * 2); a0 = mfma16(wf[0][ks], yf, a0); a1 = mfma16(wf[1][ks], yf, a1); }
        const int row = 16 * mt + r;
        const u32x2 y0 = *(const LAS u32x2*)(lds + row * YP + (32 * wid + 4 * qd) * 2), y1 = *(const LAS u32x2*)(lds + row * YP + (32 * wid + 16 + 4 * qd) * 2);
        bf16_t* op = mix + (size_t)(tok0 + row) * D + 256 + 32 * wid + 4 * qd;
        u32x2 o;
        o.x = pg8::cvt_pk_bf16(ml::bf_lo(y0.x) / (1.f + __expf(-(a0[0] + gb0.x))), ml::bf_hi(y0.x) / (1.f + __expf(-(a0[1] + gb0.y))));
        o.y = pg8::cvt_pk_bf16(ml::bf_lo(y0.y) / (1.f + __expf(-(a0[2] + gb0.z))), ml::bf_hi(y0.y) / (1.f + __expf(-(a0[3] + gb0.w))));
        *(u32x2*)op = o;
        o.x = pg8::cvt_pk_bf16(ml::bf_lo(y1.x) / (1.f + __expf(-(a1[0] + gb1.x))), ml::bf_hi(y1.x) / (1.f + __expf(-(a1[1] + gb1.y))));
        o.y = pg8::cvt_pk_bf16(ml::bf_lo(y1.y) / (1.f + __expf(-(a1[2] + gb1.z))), ml::bf_hi(y1.y) / (1.f + __expf(-(a1[3] + gb1.w))));
        *(u32x2*)(op + 16) = o;
    }
}
static_assert(T_LAYER <= 4 * MiB && O_END <= 48 * MiB && 256 * YP <= LDS_BYTES - 64, "S5 scratch fits");
}
__device__ __forceinline__ void s5_build_tables_fwd(float* ldsf, const Params& P, int l, int g, unsigned char* tb) { s5::build_tables(ldsf, P, l, g, tb); }

namespace at {
using pg8::bf16x8; using pg8::f32x4; using pg8::u32x4; using pg8::u32x2;
constexpr int KP = 144, VP = 528, OFF_K = 0, OFF_VT = 256 * KP, LDS_END = OFF_VT + 64 * VP;
__device__ __forceinline__ void unit(LAS unsigned char* lds, const bf16_t* z, const float* sinks, bf16_t* mix, int u) {
    const int tid = tid_opaque(), lane = tid & 63, wid = __builtin_amdgcn_readfirstlane(tid >> 6), r = lane & 15, qd = lane >> 4;
    const int b = u >> 7, g = (u >> 6) & 1, n = u & 63, tokb = b * S + 128 * n;
    __syncthreads();
#pragma unroll
    for (int it = 0; it < 4; ++it) { const int idx = tid + it * NTHREADS, kl = idx >> 3, cg = idx & 7; const bool ok = (n > 0) || (kl >= 128);
        u32x4 w = {0u, 0u, 0u, 0u}; if (ok) w = *(const u32x4*)(z + (size_t)(tokb - 128 + kl) * ZW + ZK + g * 64 + cg * 8);
        *(LAS u32x4*)(lds + OFF_K + kl * KP + cg * 16) = w; }
#pragma unroll
    for (int it = 0; it < 4; ++it) { const int idx = tid + it * NTHREADS, kl = idx & 255, cg = idx >> 8; const bool ok = (n > 0) || (kl >= 128);
        u32x4 w = {0u, 0u, 0u, 0u}; if (ok) w = *(const u32x4*)(z + (size_t)(tokb - 128 + kl) * ZW + ZV + g * 64 + cg * 8);
        const unsigned ww[4] = {w.x, w.y, w.z, w.w};
#pragma unroll
        for (int e = 0; e < 8; ++e) *(LAS unsigned short*)(lds + OFF_VT + (cg * 8 + e) * VP + kl * 2) = (unsigned short)((e & 1) ? (ww[e >> 1] >> 16) : (ww[e >> 1] & 0xffffu)); }
    __syncthreads();
    const int hq = 2 * g + (wid >> 2);
    const float sink = sinks[hq];
#pragma unroll 1
    for (int qt = 0; qt < 2; ++qt) {
        const int i0 = (wid & 3) * 32 + qt * 16, kt0 = i0 >> 4, tok = tokb + i0 + r;
        const bf16x8 bq0 = *(const bf16x8*)(z + (size_t)tok * ZW + ZQ + hq * 64 + 8 * qd), bq1 = *(const bf16x8*)(z + (size_t)tok * ZW + ZQ + hq * 64 + 32 + 8 * qd);
        f32x4 accS[9];
#pragma unroll
        for (int c = 0; c < 9; ++c) { const int kt = kt0 + c;
            const bf16x8 a0 = *(const LAS bf16x8*)(lds + OFF_K + (16 * kt + r) * KP + qd * 16), a1 = *(const LAS bf16x8*)(lds + OFF_K + (16 * kt + r) * KP + 64 + qd * 16);
            accS[c] = ml::mfma16(a0, bq0, (f32x4){0.f, 0.f, 0.f, 0.f}); accS[c] = ml::mfma16(a1, bq1, accS[c]); }
        float m = sink;
#pragma unroll
        for (int c = 0; c < 9; ++c)
#pragma unroll
            for (int j = 0; j < 4; ++j) { const int e = 4 * qd + j;
                bool valid = (c == 0) ? (e > r) : ((c == 8) ? (e <= r) : true);
                valid = valid && ((n > 0) || (kt0 + c >= 8));
                const float s = valid ? accS[c][j] * 0.125f : -3.0e38f; accS[c][j] = s; m = fmaxf(m, s); }
        m = fmaxf(m, __shfl_xor(m, 16)); m = fmaxf(m, __shfl_xor(m, 32));
        float l = 0.f;
#pragma unroll
        for (int c = 0; c < 9; ++c)
#pragma unroll
            for (int j = 0; j < 4; ++j) { const float p = __expf(accS[c][j] - m); accS[c][j] = p; l += p; }
        l += __shfl_xor(l, 16); l += __shfl_xor(l, 32);
        l += __expf(sink - m);
        f32x4 accO[4];
#pragma unroll
        for (int dt = 0; dt < 4; ++dt) accO[dt] = (f32x4){0.f, 0.f, 0.f, 0.f};
#pragma unroll
        for (int kk = 0; kk < 5; ++kk) {
            u32x4 pw; pw.x = pg8::cvt_pk_bf16(accS[2 * kk][0], accS[2 * kk][1]); pw.y = pg8::cvt_pk_bf16(accS[2 * kk][2], accS[2 * kk][3]);
            if (kk < 4) { pw.z = pg8::cvt_pk_bf16(accS[2 * kk + 1][0], accS[2 * kk + 1][1]); pw.w = pg8::cvt_pk_bf16(accS[2 * kk + 1][2], accS[2 * kk + 1][3]); } else { pw.z = 0u; pw.w = 0u; }
            const bf16x8 pf = __builtin_bit_cast(bf16x8, pw);
            const int base = 16 * (kt0 + 2 * kk);
#pragma unroll
            for (int dt = 0; dt < 4; ++dt) { const u32x2 v0 = *(const LAS u32x2*)(lds + OFF_VT + (16 * dt + r) * VP + (base + 4 * qd) * 2);
                u32x2 v1 = {0u, 0u}; if (kk < 4) v1 = *(const LAS u32x2*)(lds + OFF_VT + (16 * dt + r) * VP + (base + 16 + 4 * qd) * 2);
                u32x4 vw; vw.x = v0.x; vw.y = v0.y; vw.z = v1.x; vw.w = v1.y;
                accO[dt] = ml::mfma16(__builtin_bit_cast(bf16x8, vw), pf, accO[dt]); } }
        const float inv = 1.f / l;
        bf16_t* op = mix + (size_t)tok * D + hq * 64;
#pragma unroll
        for (int dt = 0; dt < 4; ++dt) { u32x2 o; o.x = pg8::cvt_pk_bf16(accO[dt][0] * inv, accO[dt][1] * inv); o.y = pg8::cvt_pk_bf16(accO[dt][2] * inv, accO[dt][3] * inv);
            *(u32x2*)(op + 16 * dt + 4 * qd) = o; }
    }
}
}

namespace sg {
using pg8::bf16x8; using pg8::f32x4; using pg8::u32x4; using pg8::u32x2;
constexpr int TP = 272, OFF_VT = 0, OFF_ST = 256 * TP, LDS_END = OFF_ST + 128 * 4 * 2 * 4;
__device__ __forceinline__ void unit(LAS unsigned char* lds, const bf16_t* z, const Params& P, int l, const bf16_t* wb  , bf16_t* mix, int u) {
    const int tid = tid_opaque(), lane = tid & 63, wid = __builtin_amdgcn_readfirstlane(tid >> 6), r = lane & 15, qd = lane >> 4;
    const int tok0 = u * 128;
    LAS float* ST = (LAS float*)(lds + OFF_ST);
    __syncthreads();
    const int s = tid & 127, cq = tid >> 7;
    const bf16_t* gp = z + (size_t)(tok0 + s) * ZW + ZGV + cq * 64;
    float sm = 0.f, sq = 0.f;
#pragma unroll 2
    for (int i = 0; i < 8; ++i) { float v[8]; ld8(gp + 8 * i, v);
#pragma unroll
        for (int e = 0; e < 8; ++e) { const float ge = gelu_tanh(v[e]); sm += ge; sq += ge * ge; } }
    ST[(s * 4 + cq) * 2] = sm; ST[(s * 4 + cq) * 2 + 1] = sq;
    __syncthreads();
    { float tsm = 0.f, tsq = 0.f;
#pragma unroll
      for (int q = 0; q < 4; ++q) { tsm += ST[(s * 4 + q) * 2]; tsq += ST[(s * 4 + q) * 2 + 1]; }
      const float mu = tsm * (1.f / 256.f), var = fmaxf(tsq * (1.f / 256.f) - mu * mu, 0.f), rs = rsqrtf(var + EPS);
      const float* lg = P.in[I_LNG] + l * 256 + cq * 64; const float* lb = P.in[I_LNB] + l * 256 + cq * 64;
#pragma unroll 1
      for (int i = 0; i < 8; ++i) { float v[8]; ld8(gp + 8 * i, v);
          const float4 g0 = *(const float4*)(lg + 8 * i), g1 = *(const float4*)(lg + 8 * i + 4), b0 = *(const float4*)(lb + 8 * i), b1 = *(const float4*)(lb + 8 * i + 4);
          const float gg[8] = {g0.x, g0.y, g0.z, g0.w, g1.x, g1.y, g1.z, g1.w}, bb[8] = {b0.x, b0.y, b0.z, b0.w, b1.x, b1.y, b1.z, b1.w};
#pragma unroll
          for (int e = 0; e < 8; ++e) *(LAS unsigned short*)(lds + OFF_VT + (cq * 64 + 8 * i + e) * TP + s * 2) = ml::bf1((gelu_tanh(v[e]) - mu) * rs * gg[e] + bb[e]); } }
    __syncthreads();
    const int t = 16 * wid + r;
#pragma unroll 1
    for (int g = 0; g < 4; ++g) {
        bf16x8 wf[4];
#pragma unroll
        for (int ks = 0; ks < 4; ++ks) wf[ks] = *(const bf16x8*)(wb + ((size_t)g * 128 + t) * 128 + 32 * ks + 8 * qd);
        const float bias = P.in[I_SGUB][l * 512 + g * 128 + t];
#pragma unroll
        for (int ct = 0; ct < 4; ++ct) { f32x4 acc = {0.f, 0.f, 0.f, 0.f};
#pragma unroll
            for (int ks = 0; ks < 4; ++ks) if (2 * ks <= wid) acc = ml::mfma16(*(const LAS bf16x8*)(lds + OFF_VT + (g * 64 + 16 * ct + r) * TP + (32 * ks + 8 * qd) * 2), wf[ks], acc);
            const int c0 = g * 64 + 16 * ct + 4 * qd;
            const u32x2 gw = *(const u32x2*)(z + (size_t)(tok0 + t) * ZW + ZGU + c0);
            u32x2 o; o.x = pg8::cvt_pk_bf16(gelu_tanh(bfl(gw.x)) * (acc[0] + bias), gelu_tanh(bfh(gw.x)) * (acc[1] + bias)); o.y = pg8::cvt_pk_bf16(gelu_tanh(bfl(gw.y)) * (acc[2] + bias), gelu_tanh(bfh(gw.y)) * (acc[3] + bias));
            *(u32x2*)(mix + (size_t)(tok0 + t) * D + 768 + c0) = o; }
    }
}
}

__device__ __forceinline__ void ph_mix1(float* lds, const Params& P, int l, bf16_t* z, const float* gates, bf16_t* mix, unsigned char* wsm, unsigned char* wss, const unsigned char* tb) {
    const int G = gridDim.x, bid = blockIdx.x;
    for (int u = bid; u < ml::NU; u += G) ml::p1_unit((LAS unsigned char*)lds, z, gates, P, l, u, wsm);
    __syncthreads();
    for (int u = bid; u < NTOK / 256; u += G) s5::p1_unit(z, tb, u, wss);
    __syncthreads();
    for (int u = bid; u < 1024; u += G) at::unit((LAS unsigned char*)lds, z, P.in[I_SINK] + l * 4, mix, u);
    __syncthreads();
    for (int u = bid; u < NTOK / 128; u += G) sg::unit((LAS unsigned char*)lds, z, P, l, (const bf16_t*)(tb + s5::T_SGUW), mix, u);
    __syncthreads();
}

__device__ __forceinline__ void ph_mix2(float* lds, const Params& P, int l, const bf16_t* z, const float* gates, bf16_t* mix, const unsigned char* wsm, const unsigned char* wss, const unsigned char* tb) {
    for (int u = blockIdx.x; u < NTOK / 256; u += gridDim.x) s5::p3_unit((LAS unsigned char*)lds, z, P, l, tb, u, wss, mix);
    __syncthreads();
    for (int u = blockIdx.x; u < ml::NU; u += gridDim.x) ml::p3_unit((LAS unsigned char*)lds, z, gates, P, l, u, wsm, mix);
    __syncthreads();
}

__device__ __forceinline__ void ph_outproj(LAS unsigned char* ldsb, const bf16_t* mix, const bf16_t* wt, const float* xsrc, float* xout) {
    pg8::StaticOrder S; S.init(NTOK, D, D, D, gridDim.x, blockIdx.x, mix, wt);
    pg8::EpiRes E{xsrc, xout};
    pg8::gemm_phase<pg8::EpiRes, pg8::StaticOrder, false>(ldsb, D, D, S, E);
}

namespace rp {
using pg8::bf16x8; using pg8::f32x4; using pg8::u32x4;
constexpr size_t T_HI = 0, T_LO = (size_t)48 * D * 2, T_GHI = 2 * T_LO, T_GLO = T_GHI + (size_t)16 * D * 2, T_SIZE = T_GLO + (size_t)16 * D * 2;
static_assert(T_SIZE <= 256 * 1024, "row-pass tables fit their slot");
template <int NT, bool COMBINE> struct StepIn { float4 xa[2], xb[2]; u32x4 y1[2], y2[2]; float4 g0, g1; bf16x8 wh[NT], wl[NT]; };
__device__ __forceinline__ void build_base(LAS int* base, const unsigned* cnt) {
    __syncthreads();
    if (tid_opaque() == 0) { int b = 0; for (int e = 0; e < NEXP; ++e) { base[e] = b; b += (((int)cnt[e] + 255) >> 8) << 8; } }
    __syncthreads();
}
template <int NT, bool COMBINE>
__device__ __forceinline__ void run(LAS unsigned char* lds, const Params& P, int l, const float* x, float* xo, const bf16_t* YB, const unsigned* inv, const unsigned* cntprev,
                                    const float* gn, const bf16_t* WH, const bf16_t* WL, bf16_t* XN, float* RS, float* gates, unsigned* cnt, int2* lists, unsigned* invout) {
    const int tid = tid_opaque(), lane = tid & 63, wid = __builtin_amdgcn_readfirstlane(tid >> 6), r = lane & 15, qd = lane >> 4;
    LAS int* BASE = (LAS int*)(lds + 64 * 1024);
    LAS float* LG = (LAS float*)lds + wid * (32 * 49);
    if (COMBINE) build_base(BASE, cntprev);
    LAS unsigned* LCNT = (LAS unsigned*)(lds + 64 * 1024 + 256); LAS unsigned* GBASE = LCNT + 32;
    for (int rb0 = blockIdx.x * 8; rb0 < NTOK / 32; rb0 += gridDim.x * 8) {
        const int rb = rb0 + wid; const bool live = rb < NTOK / 32;
        const int row0 = (live ? rb : rb0) * 32;
        if (NT == 1 && !live) continue;
        size_t yr1[2] = {0, 0}, yr2[2] = {0, 0};
        if (COMBINE) {
#pragma unroll
            for (int mt = 0; mt < 2; ++mt) { const int row = row0 + 16 * mt + r; const unsigned i1 = inv[2 * row], i2 = inv[2 * row + 1];
                yr1[mt] = (size_t)(BASE[i1 >> 16] + (int)(i1 & 0xffffu)) * D; yr2[mt] = (size_t)(BASE[i2 >> 16] + (int)(i2 & 0xffffu)) * D; } }
        f32x4 acc[2][NT];
#pragma unroll
        for (int mt = 0; mt < 2; ++mt)
#pragma unroll
            for (int nt = 0; nt < NT; ++nt) acc[mt][nt] = (f32x4){0.f, 0.f, 0.f, 0.f};
        float ssq[2] = {0.f, 0.f};
        StepIn<NT, COMBINE> sb[2];
        auto load = [&](StepIn<NT, COMBINE>& s, int ks) {
            const int k0 = 32 * ks + 8 * qd;
#pragma unroll
            for (int mt = 0; mt < 2; ++mt) { const float* xp = x + (size_t)(row0 + 16 * mt + r) * D + k0; s.xa[mt] = *(const float4*)xp; s.xb[mt] = *(const float4*)(xp + 4);
                if (COMBINE) { s.y1[mt] = *(const u32x4*)(YB + yr1[mt] + k0); s.y2[mt] = *(const u32x4*)(YB + yr2[mt] + k0); } }
            s.g0 = *(const float4*)(gn + k0); s.g1 = *(const float4*)(gn + k0 + 4);
#pragma unroll
            for (int nt = 0; nt < NT; ++nt) { s.wh[nt] = *(const bf16x8*)(WH + (size_t)(16 * nt + r) * D + k0); s.wl[nt] = *(const bf16x8*)(WL + (size_t)(16 * nt + r) * D + k0); }
        };
        auto process = [&](const StepIn<NT, COMBINE>& s, int ks) {
            const int k0 = 32 * ks + 8 * qd;
            bf16x8 xh[2], xl[2];
#pragma unroll
            for (int mt = 0; mt < 2; ++mt) { float4 a = s.xa[mt], b = s.xb[mt];
                if (COMBINE) { const u32x4 p = s.y1[mt], q = s.y2[mt];
                    a.x += bfl(p.x) + bfl(q.x); a.y += bfh(p.x) + bfh(q.x); a.z += bfl(p.y) + bfl(q.y); a.w += bfh(p.y) + bfh(q.y);
                    b.x += bfl(p.z) + bfl(q.z); b.y += bfh(p.z) + bfh(q.z); b.z += bfl(p.w) + bfl(q.w); b.w += bfh(p.w) + bfh(q.w);
                    float* op = xo + (size_t)(row0 + 16 * mt + r) * D + k0; *(float4*)op = a; *(float4*)(op + 4) = b; }
                ssq[mt] += a.x * a.x + a.y * a.y + a.z * a.z + a.w * a.w + b.x * b.x + b.y * b.y + b.z * b.z + b.w * b.w;
                const float v[8] = {a.x * s.g0.x, a.y * s.g0.y, a.z * s.g0.z, a.w * s.g0.w, b.x * s.g1.x, b.y * s.g1.y, b.z * s.g1.z, b.w * s.g1.w};
                u32x4 h; h.x = pg8::cvt_pk_bf16(v[0], v[1]); h.y = pg8::cvt_pk_bf16(v[2], v[3]); h.z = pg8::cvt_pk_bf16(v[4], v[5]); h.w = pg8::cvt_pk_bf16(v[6], v[7]);
                *(u32x4*)(XN + (size_t)(row0 + 16 * mt + r) * D + k0) = h;
                u32x4 lo; lo.x = pg8::cvt_pk_bf16(v[0] - bfl(h.x), v[1] - bfh(h.x)); lo.y = pg8::cvt_pk_bf16(v[2] - bfl(h.y), v[3] - bfh(h.y)); lo.z = pg8::cvt_pk_bf16(v[4] - bfl(h.z), v[5] - bfh(h.z)); lo.w = pg8::cvt_pk_bf16(v[6] - bfl(h.w), v[7] - bfh(h.w));
                xh[mt] = __builtin_bit_cast(bf16x8, h); xl[mt] = __builtin_bit_cast(bf16x8, lo); }
#pragma unroll
            for (int nt = 0; nt < NT; ++nt)
#pragma unroll
                for (int mt = 0; mt < 2; ++mt) { acc[mt][nt] = ml::mfma16(s.wh[nt], xh[mt], acc[mt][nt]); acc[mt][nt] = ml::mfma16(s.wl[nt], xh[mt], acc[mt][nt]); acc[mt][nt] = ml::mfma16(s.wh[nt], xl[mt], acc[mt][nt]); }
        };
        load(sb[0], 0);
#pragma unroll 1
        for (int ks = 0; ks < 32; ks += 2) {
            load(sb[1], ks + 1);
            process(sb[0], ks);
            if (ks + 2 < 32) load(sb[0], ks + 2);
            process(sb[1], ks + 1);
        }
        float rsv[2];
#pragma unroll
        for (int mt = 0; mt < 2; ++mt) { float s = ssq[mt]; s += __shfl_xor(s, 16); s += __shfl_xor(s, 32); rsv[mt] = rsqrtf(s * (1.f / D) + EPS);
            if (qd == 0) RS[row0 + 16 * mt + r] = rsv[mt]; }
        if (NT == 1) {
#pragma unroll
            for (int mt = 0; mt < 2; ++mt) if (qd < 2) { const f32x4 gv = acc[mt][0] * rsv[mt]; *(f32x4*)(gates + (size_t)(row0 + 16 * mt + r) * 8 + 4 * qd) = gv; }
        } else {
            const float* bg = P.in[I_RGB] + l * 4; const float* be = P.in[I_REB] + l * 32;
#pragma unroll
            for (int mt = 0; mt < 2; ++mt)
#pragma unroll
                for (int nt = 0; nt < NT; ++nt)
#pragma unroll
                    for (int j = 0; j < 4; ++j) LG[(16 * mt + r) * 49 + 16 * nt + 4 * qd + j] = acc[mt][nt][j] * rsv[mt];
            wave_lds_fence();
            if (tid < 32) LCNT[tid] = 0u;
            __syncthreads();
            int ex1 = 0, ex2 = 0; float w1 = 0.f, w2 = 0.f; unsigned lp1 = 0u, lp2 = 0u;
            if (lane < 32 && live) {
                const LAS float* lg = LG + lane * 49;
                float gl[4];
#pragma unroll
                for (int j = 0; j < 4; ++j) gl[j] = lg[j] + bg[j];
                int sel = 0; float gm = gl[0];
#pragma unroll
                for (int j = 1; j < 4; ++j) if (gl[j] > gm) { gm = gl[j]; sel = j; }
                float gs = 0.f;
#pragma unroll
                for (int j = 0; j < 4; ++j) gs += expf(gl[j] - gm);
                const float pg = 1.f / gs;
                float ein[8];
#pragma unroll
                for (int j = 0; j < 8; ++j) ein[j] = lg[4 + sel * 8 + j] + be[sel * 8 + j];
                int i1 = 0; float v1 = ein[0];
#pragma unroll
                for (int j = 1; j < 8; ++j) if (ein[j] > v1) { v1 = ein[j]; i1 = j; }
                int i2 = -1; float v2 = -3.0e38f;
#pragma unroll
                for (int j = 0; j < 8; ++j) if (j != i1 && ein[j] > v2) { v2 = ein[j]; i2 = j; }
                const float e2 = expf(v2 - v1), den = 1.f / (1.f + e2);
                w1 = den * pg; w2 = e2 * den * pg;
                ex1 = sel * 8 + i1; ex2 = sel * 8 + i2;
                lp1 = atomicAdd((unsigned*)&LCNT[ex1], 1u); lp2 = atomicAdd((unsigned*)&LCNT[ex2], 1u);
            }
            __syncthreads();
            if (tid < 32) { const unsigned c = LCNT[tid]; GBASE[tid] = c ? atomicAdd(&cnt[tid], c) : 0u; }
            __syncthreads();
            if (lane < 32 && live) { const int row = row0 + lane; const unsigned p1 = GBASE[ex1] + lp1, p2 = GBASE[ex2] + lp2;
                lists[(size_t)ex1 * NTOK + p1] = make_int2(row, __float_as_int(w1));
                lists[(size_t)ex2 * NTOK + p2] = make_int2(row, __float_as_int(w2));
                invout[2 * row] = ((unsigned)ex1 << 16) | p1; invout[2 * row + 1] = ((unsigned)ex2 << 16) | p2; }
        }
    }
}
__device__ __forceinline__ void final_norm(LAS unsigned char* lds, float* xo, const bf16_t* YB, const unsigned* inv, const unsigned* cntprev, const float* g) {
    const int tid = tid_opaque(), wave = tid >> 6, lane = tid & 63;
    LAS int* BASE = (LAS int*)(lds + 64 * 1024);
    build_base(BASE, cntprev);
    const float4* g4 = (const float4*)g;
    for (int r = blockIdx.x * 8 + wave; r < NTOK; r += gridDim.x * 8) {
        const unsigned i1 = inv[2 * r], i2 = inv[2 * r + 1];
        const bf16_t* y1 = YB + (size_t)(BASE[i1 >> 16] + (int)(i1 & 0xffffu)) * D; const bf16_t* y2 = YB + (size_t)(BASE[i2 >> 16] + (int)(i2 & 0xffffu)) * D;
        float4* p = (float4*)(xo + (size_t)r * D);
        float4 v[4]; float ss = 0.f;
#pragma unroll
        for (int i = 0; i < 4; ++i) { v[i] = p[lane + 64 * i]; const u32x2_t a = *((const u32x2_t*)y1 + lane + 64 * i), b = *((const u32x2_t*)y2 + lane + 64 * i);
            v[i].x += bfl(a.x) + bfl(b.x); v[i].y += bfh(a.x) + bfh(b.x); v[i].z += bfl(a.y) + bfl(b.y); v[i].w += bfh(a.y) + bfh(b.y);
            ss += v[i].x * v[i].x + v[i].y * v[i].y + v[i].z * v[i].z + v[i].w * v[i].w; }
        ss = wave_sum(ss);
        const float rs = rsqrtf(ss * (1.f / D) + EPS);
#pragma unroll
        for (int i = 0; i < 4; ++i) { const float4 gg = g4[lane + 64 * i]; float4 o; o.x = v[i].x * rs * gg.x; o.y = v[i].y * rs * gg.y; o.z = v[i].z * rs * gg.z; o.w = v[i].w * rs * gg.w; p[lane + 64 * i] = o; }
    }
}
}

__device__ __forceinline__ int moe_build_tab(LAS unsigned char* ldsb, const unsigned* cnt) {
    LAS pg8::i32x4* tab = (LAS pg8::i32x4*)(ldsb + TAB_OFF);
    __syncthreads();
    int base = 0;
#pragma unroll 1
    for (int e = 0; e < NEXP; ++e) { const int c = __builtin_amdgcn_readfirstlane((int)cnt[e]), nt = (c + 255) >> 8;
        if ((int)tid_opaque() < nt) tab[base + tid_opaque()] = (pg8::i32x4){e, (int)tid_opaque() * 256, c, 0};
        base += nt; }
    __syncthreads();
    return base;
}
__device__ __forceinline__ void ph_moe1(LAS unsigned char* ldsb, const Params& P, int l, const bf16_t* H, const unsigned* cnt, const int2* lists, bf16_t* act) {
    const int ntiles = moe_build_tab(ldsb, cnt);
    pg8::MoeOrder S; S.tab = (const LAS pg8::i32x4*)(ldsb + TAB_OFF); S.ntiles = ntiles; S.npn = 4; S.G = gridDim.x; S.c = blockIdx.x;
    S.A = (const char*)H; S.atile = 0; S.Bt = (const char*)(P.ws + WS_WGU) + (size_t)l * NEXP * 1024 * D * 2; S.bexp = (size_t)1024 * D * 2; S.btile = (size_t)256 * D * 2; S.lists = lists;
    pg8::EpiAct E{act, lists, (const float*)(P.ws + WS_RS)};
    pg8::gemm_phase<pg8::EpiAct, pg8::MoeOrder, true>(ldsb, D, D, S, E);
}
__device__ __forceinline__ void ph_moe2(LAS unsigned char* ldsb, const Params& P, int l, const bf16_t* act, const unsigned* cnt, const int2* lists, bf16_t* yb) {
    const int ntiles = moe_build_tab(ldsb, cnt);
    pg8::MoeOrder S; S.tab = (const LAS pg8::i32x4*)(ldsb + TAB_OFF); S.ntiles = ntiles; S.npn = 4; S.G = gridDim.x; S.c = blockIdx.x;
    S.A = (const char*)act; S.atile = (size_t)256 * DE * 2; S.Bt = (const char*)(P.ws + WS_WD) + (size_t)l * NEXP * D * DE * 2; S.bexp = (size_t)D * DE * 2; S.btile = (size_t)256 * DE * 2; S.lists = lists;
    pg8::EpiY E{yb, lists};
    pg8::gemm_phase<pg8::EpiY, pg8::MoeOrder, false>(ldsb, DE, DE, S, E);
}

#ifndef PROBE_PH
#define PROBE_PH -1
#endif
#ifndef PROBE_REPS
#define PROBE_REPS 4
#endif
__global__ void __launch_bounds__(NTHREADS, 2) fwd_kernel(Params P) {
    extern __shared__ __attribute__((aligned(16))) unsigned char lds_raw[];
    float* lds = (float*)lds_raw;
    volatile LAS unsigned* xbw = (volatile LAS unsigned*)(lds_raw + LDS_BYTES - 16);
    if (threadIdx.x == 0) { xbw[0] = 0u; xbw[1] = 0u; }
    __syncthreads();
    unsigned char* const ws = P.ws;
    unsigned* ctl = (unsigned*)(ws + WS_CTL);
    const bool multi = (P.ph_hi - P.ph_lo) > 1;
    XcdBarrier bar; bar.bar = ctl; bar.x = 0; bar.st = xbw;
    if (multi) bar = xcd_barrier_post(ctl, xbw);
    bf16_t* z = (bf16_t*)(ws + WS_Z); float* gates = (float*)(ws + WS_GATES); unsigned char* wss = ws + WS_S5; bf16_t* mix = (bf16_t*)(ws + WS_MIX); unsigned char* wsm = ws + WS_HRAW;
    bf16_t* H = (bf16_t*)(ws + WS_H); bf16_t* act = (bf16_t*)(ws + WS_ACT); bf16_t* yb = (bf16_t*)(ws + WS_YB); float* rsb = (float*)(ws + WS_RS);
    int2* lists = (int2*)(ws + WS_LIST);
    LAS unsigned char* ldsb = (LAS unsigned char*)lds_raw;
    const int lo = P.ph_lo, hi = P.ph_hi;
#define IN(k) (lo <= (k) && (k) < hi)
#define SEAM(k) do { if (IN(k) && IN((k) + 1)) xcd_barrier(bar); } while (0)
#if PROBE_PH >= 0
#define RUNPH(k, ...) do { if (IN(k)) { const int nrep = ((k) == PROBE_PH) ? 1 + PROBE_REPS : 1; for (int rep = 0; rep < nrep; ++rep) { __VA_ARGS__; if (rep + 1 < nrep) xcd_barrier(bar); } } SEAM(k); } while (0)
#else
#define RUNPH(k, ...) do { if (IN(k)) { constexpr int rep = 0; (void)rep; __VA_ARGS__; } SEAM(k); } while (0)
#endif
    RUNPH(0, ph_prologue(lds, PF));
    for (int l = 0; l < NLAYER; ++l) {
        const int pb = 1 + l * PH_PER_LAYER;
        unsigned* cnt = ctl + CW_CNT + l * 64;
        const unsigned char* tb = ws + WS_TB + (size_t)l * 4 * MiB;
        const unsigned char* rtb = ws + WS_RT + (size_t)l * 256 * 1024;
        unsigned* inv = (unsigned*)(ws + WS_INV) + (size_t)l * NTOK * 2;
        RUNPH(pb + 0, { const Params& Q = PF;
            if (l == 0) rp::run<1, false>(ldsb, Q, l, Q.in[I_X], nullptr, nullptr, nullptr, nullptr, Q.in[I_NMG] + l * D, (const bf16_t*)(rtb + rp::T_GHI), (const bf16_t*)(rtb + rp::T_GLO), mix, rsb, gates, nullptr, nullptr, nullptr);
            else        rp::run<1, true >(ldsb, Q, l, Q.out, Q.out, yb, inv - (size_t)NTOK * 2, cnt - 64, Q.in[I_NMG] + l * D, (const bf16_t*)(rtb + rp::T_GHI), (const bf16_t*)(rtb + rp::T_GLO), mix, rsb, gates, nullptr, nullptr, nullptr); });
        RUNPH(pb + 1, ph_inproj(ldsb, mix, (const bf16_t*)(ws + WS_WIN) + (size_t)l * NMAIN * D, z, rsb));
        RUNPH(pb + 2, ph_mix1(lds, PF, l, z, gates, mix, wsm, wss, tb));
        RUNPH(pb + 3, { s5::p2_scan(ldsb, tb, wss); ml::p2_scan(wsm); });
        RUNPH(pb + 4, ph_mix2(lds, PF, l, z, gates, mix, wsm, wss, tb));
        RUNPH(pb + 5, { const Params& Q = PF; ph_outproj(ldsb, mix, (const bf16_t*)(ws + WS_WOUT) + (size_t)l * D * D, (l == 0) ? Q.in[I_X] : Q.out, Q.out); });
        RUNPH(pb + 6, { if (rep > 0) { if (blockIdx.x == 0 && threadIdx.x < 64) cnt[threadIdx.x] = 0u; xcd_barrier(bar); }
                        const Params& Q = PF; rp::run<3, false>(ldsb, Q, l, Q.out, nullptr, nullptr, nullptr, nullptr, Q.in[I_NFG] + l * D, (const bf16_t*)(rtb + rp::T_HI), (const bf16_t*)(rtb + rp::T_LO), H, rsb, nullptr, cnt, lists, inv); });
        RUNPH(pb + 7, ph_moe1(ldsb, PF, l, H, cnt, lists, act));
        RUNPH(pb + 8, ph_moe2(ldsb, PF, l, act, cnt, lists, yb));
    }
    RUNPH(1 + NLAYER * PH_PER_LAYER, { const Params& Q = PF; rp::final_norm(ldsb, Q.out, yb, (const unsigned*)(ws + WS_INV) + (size_t)(NLAYER - 1) * NTOK * 2, ctl + CW_CNT + (NLAYER - 1) * 64, Q.in[I_NFIN]); });
#undef RUNPH
#undef IN
#undef SEAM
}

#ifndef N_LAUNCH_MODE
#define N_LAUNCH_MODE 1
#endif
extern "C" void kernel_launch(void* const* d_in, const int* in_sizes, int n_in, void* d_out, int out_size, void* d_ws, size_t ws_size, hipStream_t stream) {
    static int grid = 0;
    if (grid == 0) {
        if (n_in != 31 || out_size != NTOK * D || ws_size < WS_END) { fprintf(stderr, "kernel_launch: unexpected shapes n_in %d out %d ws %zu (need %zu)\n", n_in, out_size, ws_size, (size_t)WS_END); grid = -1; return; }
        int dev = 0, cus = 0, per_cu = 0;
        if (hipGetDevice(&dev) != hipSuccess || hipDeviceGetAttribute(&cus, hipDeviceAttributeMultiprocessorCount, dev) != hipSuccess) { grid = -1; return; }
        if (hipFuncSetAttribute((const void*)fwd_kernel, hipFuncAttributeMaxDynamicSharedMemorySize, LDS_BYTES) != hipSuccess) { fprintf(stderr, "kernel_launch: hipFuncSetAttribute failed\n"); grid = -1; return; }
        if (hipOccupancyMaxActiveBlocksPerMultiprocessor(&per_cu, (const void*)fwd_kernel, NTHREADS, LDS_BYTES) != hipSuccess || per_cu < 1) { fprintf(stderr, "kernel_launch: occupancy query says %d\n", per_cu); }
        (void)hipGetLastError();
        grid = cus;
    }
    if (grid < 0) return;
    (void)hipMemsetAsync((char*)d_ws + WS_CTL, 0, CTL_BYTES, stream);
    Params p{};
    for (int i = 0; i < 31; ++i) p.in[i] = (const float*)d_in[i];
    p.out = (float*)d_out; p.ws = (unsigned char*)d_ws;
#if N_LAUNCH_MODE == 1
    p.ph_lo = 0; p.ph_hi = N_PHASES;
    hipLaunchKernelGGL(fwd_kernel, dim3(grid), dim3(NTHREADS), LDS_BYTES, stream, p);
#else
    for (int ph = 0; ph < N_PHASES; ++ph) { p.ph_lo = ph; p.ph_hi = ph + 1; hipLaunchKernelGGL(fwd_kernel, dim3(grid), dim3(NTHREADS), LDS_BYTES, stream, p); }
#endif
}
```

```cpp
#include <hip/hip_runtime.h>
#include <stdint.h>
#include <stdio.h>

#define LAS __attribute__((address_space(3)))

constexpr int D = 1024, NB = 8, S = 8192, NTOK = NB * S, INW = 2312, NLAYER = 2;
constexpr int NEXP = 32, DE = 512;
constexpr float EPS = 1e-6f;
constexpr int ZW = 2304;
constexpr int ZQ = 0, ZK = 256, ZV = 384, ZSU = 512, ZCQ = 768, ZCK = 1024, ZCV = 1280, ZCO = 1536, ZGU = 1792, ZGV = 2048, WCI = 1536;
#ifndef INPROJ_WGM
#define INPROJ_WGM 8
#endif
constexpr int NTHREADS = 512;
constexpr int LDS_BYTES = 144 * 1024;
constexpr int TAB_OFF = 128 * 1024;
constexpr int PH_PER_LAYER = 9, N_PHASES = 1 + NLAYER * PH_PER_LAYER + 1;
constexpr int NMAIN = 2304;
typedef unsigned short bf16_t;

constexpr size_t MiB = 1u << 20;
constexpr size_t WS_CTL = 0, CTL_BYTES = 1 * MiB;
constexpr size_t WS_Z = WS_CTL + CTL_BYTES;
constexpr size_t Z_BYTES = (size_t)NTOK * ZW * 2;
constexpr size_t WS_H = WS_Z;
constexpr size_t WS_YB = WS_Z;
constexpr int PMAX = 2 * NTOK + NEXP * 256;
static_assert((size_t)PMAX * D * 2 <= Z_BYTES, "YB alias fits");
constexpr size_t WS_MIX = WS_Z + Z_BYTES;
constexpr size_t WS_ACT = WS_MIX;
static_assert((size_t)PMAX * DE * 2 <= (size_t)NTOK * D * 2 + 64 * MiB, "ACT alias fits");
constexpr size_t WS_HRAW = WS_MIX + (size_t)NTOK * D * 2;
constexpr size_t WS_S5 = WS_HRAW + 64 * MiB;
constexpr size_t WS_GATES = WS_S5 + 48 * MiB;
constexpr size_t WS_LIST = WS_GATES + (size_t)NTOK * 8 * 4;
constexpr size_t WS_WIN = WS_LIST + (size_t)NEXP * NTOK * 8;
constexpr size_t WS_WOUT = WS_WIN + (size_t)NLAYER * NMAIN * D * 2;
constexpr size_t WS_WGU = WS_WOUT + (size_t)NLAYER * D * D * 2;
constexpr size_t WS_WD = WS_WGU + (size_t)NLAYER * NEXP * 1024 * D * 2;
constexpr size_t WS_TB = WS_WD + (size_t)NLAYER * NEXP * D * DE * 2;
constexpr size_t WS_RS = WS_TB + (size_t)NLAYER * 4 * MiB;
constexpr size_t WS_RT = WS_RS + (size_t)NTOK * 4;
constexpr size_t WS_INV = WS_RT + (size_t)NLAYER * 256 * 1024;
constexpr size_t WS_END = WS_INV + (size_t)NLAYER * NTOK * 8;
namespace s5 {
constexpr size_t T_KMAT = 0, T_F = T_KMAT + (size_t)16 * 32 * 256 * 2, T_G = T_F + (size_t)16 * 256 * 128 * 2, T_A16 = T_G + (size_t)16 * 128 * 256 * 2,
                 T_GLUW = T_A16 + (size_t)16 * 64 * 8, T_SGUW = T_GLUW + (size_t)256 * 256 * 2, T_LAYER = T_SGUW + (size_t)4 * 128 * 128 * 2;
}
constexpr int CW_Q = 4096;
constexpr int CW_CNT = 8192;

#define XB_TMO      128
#define XB_XCNT(j)  (256  + 64 * (j))
#define XB_XSUB(j)  (1280 + 64 * (j))
#define XB_XGEN(j)  (2304 + 64 * (j))
#define XB_TOP      3328
#define XB_TOPGEN   3392
#define XCD_BAR_WORDS 3456
#define XB_SPIN_CAP (1u << 22)
__device__ __forceinline__ unsigned xb_ld(unsigned* p)              { return __hip_atomic_load(p, __ATOMIC_RELAXED, __HIP_MEMORY_SCOPE_AGENT); }
__device__ __forceinline__ unsigned xb_add(unsigned* p, unsigned v) { return __hip_atomic_fetch_add(p, v, __ATOMIC_RELAXED, __HIP_MEMORY_SCOPE_AGENT); }
__device__ __forceinline__ unsigned xb_xcc_id() { return (unsigned)__builtin_amdgcn_s_getreg((3 << 11) | 20) & 0xFu; }
#define XB_SPIN(cond, bar) do { unsigned _sp = 0; while (cond) { __builtin_amdgcn_s_sleep(1); \
    if ((++_sp & 255u) == 0u) { if (xb_ld(&(bar)[XB_TMO])) break; if (_sp > XB_SPIN_CAP) { atomicAdd(&(bar)[XB_TMO], 1u); break; } } } } while (0)
struct XcdBarrier { unsigned* bar; unsigned x; volatile LAS unsigned* st; };
__device__ __forceinline__ XcdBarrier xcd_barrier_post(unsigned* bar, volatile LAS unsigned* st) {
    XcdBarrier b; b.bar = bar; b.x = xb_xcc_id(); b.st = st;
    if (threadIdx.x == 0) (void)xb_add(&bar[XB_XCNT(b.x)], 1u);
    return b;
}
__device__ __forceinline__ void xcd_barrier_complete(unsigned* bar, unsigned x, unsigned& nloc, unsigned& nx) {
    const unsigned G = gridDim.x * gridDim.y * gridDim.z;
    unsigned sum, cnt, mine, sp = 0u;
    for (;;) {
        sum = 0u; cnt = 0u; mine = 0u;
#pragma unroll
        for (unsigned j = 0; j < 16; ++j) { const unsigned c = xb_ld(&bar[XB_XCNT(j)]); sum += c; cnt += (c > 0u) ? 1u : 0u; mine = (j == x) ? c : mine; }
        if (sum == G) break;
        __builtin_amdgcn_s_sleep(1);
        if ((++sp & 255u) == 0u) { if (xb_ld(&bar[XB_TMO])) break; if (sp > XB_SPIN_CAP) { atomicAdd(&bar[XB_TMO], 1u); break; } }
    }
    nloc = mine > 0u ? mine : 1u; nx = cnt > 0u ? cnt : 1u;
}
__device__ __forceinline__ void xcd_barrier(const XcdBarrier& b) {
    asm volatile("s_waitcnt vmcnt(0)" ::: "memory");
    __syncthreads();
    if (threadIdx.x == 0) {
        unsigned* bar = b.bar;
        __builtin_amdgcn_s_waitcnt(0);
        unsigned nloc = b.st[0], nx = b.st[1];
        if (nloc == 0u) { xcd_barrier_complete(bar, b.x, nloc, nx); b.st[0] = nloc; b.st[1] = nx; }
        const unsigned old = xb_add(&bar[XB_XSUB(b.x)], 1u);
        const unsigned gen = old / nloc;
        if (old + 1u == (gen + 1u) * nloc) {
            __builtin_amdgcn_fence(__ATOMIC_RELEASE, "agent");
            asm volatile("s_waitcnt vmcnt(0)" ::: "memory");
            const unsigned og = xb_add(&bar[XB_TOP], 1u);
            const unsigned tg = og / nx;
            if (og + 1u == (tg + 1u) * nx) xb_add(&bar[XB_TOPGEN], 1u);
            else XB_SPIN(xb_ld(&bar[XB_TOPGEN]) == tg, bar);
            __builtin_amdgcn_fence(__ATOMIC_ACQUIRE, "agent");
            xb_add(&bar[XB_XGEN(b.x)], 1u);
            asm volatile("s_waitcnt vmcnt(0)" ::: "memory");
        } else {
            XB_SPIN(xb_ld(&bar[XB_XGEN(b.x)]) == gen, bar);
            __builtin_amdgcn_fence(__ATOMIC_ACQUIRE, "agent");
            asm volatile("s_waitcnt vmcnt(0)" ::: "memory");
        }
    }
    __syncthreads();
}

__device__ __forceinline__ int tid_opaque() { int t = threadIdx.x; asm volatile("" : "+v"(t)); return t; }
__device__ __forceinline__ float wave_sum(float v) {
#pragma unroll
    for (int o = 32; o > 0; o >>= 1) v += __shfl_xor(v, o);
    return v;
}
__device__ __forceinline__ float gelu_tanh(float x) {
    const float u2 = 1.5957691216057308f * (x + 0.044715f * x * x * x);
    return x * __builtin_amdgcn_rcpf(1.f + __expf(-u2));
}
__device__ __forceinline__ float sigm(float x) { return 1.f / (1.f + expf(-x)); }
__device__ __forceinline__ float bfl(unsigned w) { return __uint_as_float(w << 16); }
__device__ __forceinline__ float bfh(unsigned w) { return __uint_as_float(w & 0xffff0000u); }
typedef unsigned u32x4_t __attribute__((ext_vector_type(4)));
typedef unsigned u32x2_t __attribute__((ext_vector_type(2)));
__device__ __forceinline__ void ld8(const bf16_t* p, float (&o)[8]) { const u32x4_t w = *(const u32x4_t*)p; o[0] = bfl(w.x); o[1] = bfh(w.x); o[2] = bfl(w.y); o[3] = bfh(w.y); o[4] = bfl(w.z); o[5] = bfh(w.z); o[6] = bfl(w.w); o[7] = bfh(w.w); }
__device__ __forceinline__ void wave_lds_fence() {
    __builtin_amdgcn_fence(__ATOMIC_RELEASE, "wavefront"); __builtin_amdgcn_wave_barrier(); __builtin_amdgcn_fence(__ATOMIC_ACQUIRE, "wavefront");
}

struct Params {
    const float* in[31];
    float* out;
    unsigned char* ws;
    int ph_lo, ph_hi;
};
struct Params;
__device__ __forceinline__ const Params* params_fresh() { auto p = __builtin_amdgcn_kernarg_segment_ptr(); asm volatile("" : "+s"(p)); return (const Params*)p; }
#define PF (*params_fresh())
enum { I_X = 0, I_NMG, I_WIN, I_SINK, I_ARE, I_AIM, I_BRE, I_BIM, I_CRE, I_CIM, I_SD, I_LDT, I_GLUW, I_GLUB, I_CONVW, I_GATEB, I_MNG,
       I_LNG, I_LNB, I_SGUW, I_SGUB, I_WOUT, I_NFG, I_RGW, I_RGB, I_REW, I_REB, I_EWG, I_EWU, I_EWD, I_NFIN };

namespace pg8 {
#define PG8_LAS __attribute__((address_space(3)))
typedef short bf16x8 __attribute__((ext_vector_type(8)));
typedef float f32x4 __attribute__((ext_vector_type(4)));
typedef unsigned u32x4 __attribute__((ext_vector_type(4)));
typedef unsigned u32x2 __attribute__((ext_vector_type(2)));
typedef int i32x4 __attribute__((ext_vector_type(4)));
constexpr int BM = 256, BK = 64, HALF = 128, HTB = HALF * BK * 2, STAGE_BYTES = 8 * HTB, NXCD = 8, WGM = 8;
__host__ __device__ __forceinline__ int lds_byte(int r, int c) { const int st = (r >> 4) * 2 + (c >> 5), rr = r & 15, cc = c & 31, ob = rr * 64 + cc * 2; return st * 1024 + (ob ^ (((ob >> 9) & 1) << 5)); }
__host__ __device__ __forceinline__ void stage_rc(int b, int& R, int& C) { const int st = b / 1024, sb = b % 1024, swz = sb ^ (((sb >> 9) & 1) << 5); R = (st >> 1) * 16 + swz / 64; C = (st & 1) * 32 + (swz % 64) / 2; }
__host__ __device__ __forceinline__ int perm32(int rho) { const int n = rho >> 4, i = rho & 15; return 8 * (i >> 2) + 4 * n + (i & 3); }
__device__ __forceinline__ unsigned cvt_pk_bf16(float lo, float hi) { unsigned r; asm volatile("v_cvt_pk_bf16_f32 %0, %1, %2" : "=v"(r) : "v"(lo), "v"(hi)); return r; }

struct Unit { int pm, pn; const char* A; const char* B; int e, pos0, cnt; };

struct StaticOrder {
    int nM, nN, nwg, G, c, wgm, pmmask = -1; const char* A; const char* Bt; size_t atile, btile;
    __device__ void init(int M, int N, int K, int lda, int G_, int c_, const void* A_, const void* Bt_, int wgm_ = WGM) { wgm = wgm_; nM = M / BM; nN = N / BM; nwg = nM * nN; G = G_; c = c_; A = (const char*)A_; Bt = (const char*)Bt_; atile = (size_t)BM * lda * 2; btile = (size_t)BM * K * 2; }
    __device__ __forceinline__ bool next(int i, Unit& u) const {
        const long L = (long)i * G + c; if (L >= nwg) return false;
        int wgid = (int)L; { const int q = nwg / NXCD, r = nwg % NXCD, xcd = wgid % NXCD, off = wgid / NXCD; wgid = (xcd < r ? xcd * (q + 1) : r * (q + 1) + (xcd - r) * q) + off; }
        const int nig = wgm * nN, gid = wgid / nig, fm = gid * wgm, gsz = (nM - fm) < wgm ? (nM - fm) : wgm;
        u.pm = fm + ((wgid % nig) % gsz); u.pn = (wgid % nig) / gsz; u.A = A + (size_t)(u.pm & pmmask) * atile; u.B = Bt + (size_t)u.pn * btile; u.e = 0; u.pos0 = 0; u.cnt = 0; return true;
    }
    __device__ __forceinline__ void aoff(const Unit&, unsigned (&)[2], unsigned (&)[2], const int (&)[2], const int (&)[2]) const {}
};

template <class Epi, class Sched, bool GATHER>
__device__ __forceinline__ void gemm_phase(PG8_LAS unsigned char* lds, const int K, const int lda, const Sched& S, const Epi& E) {
    const int tid = tid_opaque(), wid = __builtin_amdgcn_readfirstlane(tid >> 6), lane = tid & 63, wr = wid >> 2, wc = wid & 3, fr = lane & 15, fq = lane >> 4;
    const int nt = K / BK;
    unsigned vA0[2], vA1[2], vB[2], nA0[2], nA1[2]; int Rs[2], Cs[2];
#pragma unroll
    for (int i = 0; i < 2; ++i) { int R, C; stage_rc(tid * 16 + i * 8192, R, C); const int Rb = Epi::PERM ? ((R & ~31) + perm32(R & 31)) : R;
        Rs[i] = R; Cs[i] = C; vA0[i] = (unsigned)(R * lda + C) * 2u; vA1[i] = vA0[i] + (unsigned)(HALF * lda) * 2u; vB[i] = (unsigned)(Rb * K + C) * 2u; nA0[i] = vA0[i]; nA1[i] = vA1[i]; }
    const size_t kstep = (size_t)(BK * 2);
    const size_t hstep = (size_t)HALF * K * 2;
    const unsigned ldsw = (unsigned)wid * 1024u;
    const int aoff = lds_byte(wr * 64 + fr, fq * 8), boff = lds_byte(wc * 32 + fr, fq * 8);
#define PG8_SA(b, h) (((b) * 2 + (h)) * HTB)
#define PG8_SB(b, h) ((4 + (b) * 2 + (h)) * HTB)
#define PG8_STAGE(bufoff, gbase, voff) do { _Pragma("unroll") for (int _i = 0; _i < 2; ++_i) \
        __builtin_amdgcn_global_load_lds((const unsigned*)((const char*)(gbase) + (voff)[_i]), (PG8_LAS unsigned*)(lds + (bufoff) + ldsw + _i * 8192), 16, 0, 0); } while (0)
#define PG8_LDA(dst, b, h) do { _Pragma("unroll") for (int m = 0; m < 4; ++m) _Pragma("unroll") for (int k = 0; k < 2; ++k) dst[m][k] = *(const PG8_LAS bf16x8*)(lds + PG8_SA(b, h) + aoff + m * 2048 + k * 1024); } while (0)
#define PG8_LDB(dst, b, h) do { _Pragma("unroll") for (int n = 0; n < 2; ++n) _Pragma("unroll") for (int k = 0; k < 2; ++k) dst[n][k] = *(const PG8_LAS bf16x8*)(lds + PG8_SB(b, h) + boff + n * 2048 + k * 1024); } while (0)
#define PG8_MMA(ai, bj, At, Bt) do { __builtin_amdgcn_s_setprio(1); _Pragma("unroll") for (int m = 0; m < 4; ++m) _Pragma("unroll") for (int n = 0; n < 2; ++n) _Pragma("unroll") for (int k = 0; k < 2; ++k) \
        acc[ai][bj][m][n] = __builtin_amdgcn_mfma_f32_16x16x32_bf16(Bt[n][k], At[m][k], acc[ai][bj][m][n], 0, 0, 0); __builtin_amdgcn_s_setprio(0); } while (0)
#define PG8_WAIT_V(n) asm volatile("s_waitcnt vmcnt(" #n ")" ::: "memory")
#define PG8_WAIT_L(n) asm volatile("s_waitcnt lgkmcnt(" #n ")" ::: "memory")
#define PG8_BAR __builtin_amdgcn_s_barrier()
#define PG8_SCHED __builtin_amdgcn_sched_barrier(0)
    Unit cur, nxt; int ui = 0;
    if (!S.next(0, cur)) return;
    if constexpr (GATHER) { S.aoff(cur, vA0, vA1, Rs, Cs); PG8_WAIT_V(0); }
    f32x4 acc[2][2][4][2];
#pragma unroll
    for (int a = 0; a < 2; ++a)
#pragma unroll
        for (int b = 0; b < 2; ++b)
#pragma unroll
            for (int m = 0; m < 4; ++m)
#pragma unroll
                for (int n = 0; n < 2; ++n) acc[a][b][m][n] = (f32x4){0.f, 0.f, 0.f, 0.f};
    bf16x8 At[4][2], B0[2][2], B1[2][2];
    const char* cA = cur.A; const char* cB = cur.B;
    PG8_STAGE(PG8_SB(0, 0), cB, vB); PG8_STAGE(PG8_SB(0, 1), cB + hstep, vB); PG8_STAGE(PG8_SA(0, 0), cA, vA0); PG8_STAGE(PG8_SA(0, 1), cA, vA1);
    if (wr == 1) PG8_BAR;
    PG8_WAIT_V(2); PG8_BAR;
    PG8_STAGE(PG8_SB(1, 0), cB + kstep, vB); PG8_STAGE(PG8_SA(1, 0), cA + kstep, vA0); PG8_STAGE(PG8_SB(1, 1), cB + hstep + kstep, vB);
    PG8_WAIT_V(6); PG8_BAR;
    for (;;) {
        const bool has_next = S.next(ui + 1, nxt);
        const char* nA = has_next ? nxt.A : cA; const char* nB = has_next ? nxt.B : cB;
        if constexpr (GATHER) {
            if (has_next) { S.aoff(nxt, nA0, nA1, Rs, Cs); }
            else {
#pragma unroll
                for (int i = 0; i < 2; ++i) { nA0[i] = vA0[i]; nA1[i] = vA1[i]; } }
        }
        for (int t = 0; t < nt; t += 2) {
            const bool last = (t == nt - 2);
            const char* a1 = cA + (size_t)(t + 1) * kstep;
            const char* a2 = last ? nA : cA + (size_t)(t + 2) * kstep; const char* b2 = last ? nB : cB + (size_t)(t + 2) * kstep;
            const char* a3 = a2 + kstep; const char* b3 = b2 + kstep;
            unsigned x0[2], x1[2];
#pragma unroll
            for (int i = 0; i < 2; ++i) { x0[i] = (GATHER && last) ? nA0[i] : vA0[i]; x1[i] = (GATHER && last) ? nA1[i] : vA1[i]; }
            PG8_LDB(B0, 0, 0); PG8_LDB(B1, 0, 1); PG8_SCHED; PG8_LDA(At, 0, 0); PG8_STAGE(PG8_SA(1, 1), a1, vA1);
            PG8_WAIT_V(8); PG8_WAIT_L(0); PG8_BAR; PG8_MMA(0, 0, At, B0); PG8_MMA(0, 1, At, B1); PG8_BAR; PG8_SCHED;
            PG8_LDA(At, 0, 1); PG8_STAGE(PG8_SB(0, 0), b2, vB); PG8_STAGE(PG8_SB(0, 1), b2 + hstep, vB); PG8_STAGE(PG8_SA(0, 0), a2, x0);
            PG8_WAIT_V(8); PG8_WAIT_L(0); PG8_BAR; PG8_MMA(1, 0, At, B0); PG8_MMA(1, 1, At, B1); PG8_BAR; PG8_SCHED;
            PG8_LDB(B0, 1, 0); PG8_LDB(B1, 1, 1); PG8_SCHED; PG8_LDA(At, 1, 0); PG8_STAGE(PG8_SA(0, 1), a2, x1);
            PG8_WAIT_V(8); PG8_WAIT_L(0); PG8_BAR; PG8_MMA(0, 0, At, B0); PG8_MMA(0, 1, At, B1); PG8_BAR; PG8_SCHED;
            PG8_LDA(At, 1, 1); PG8_STAGE(PG8_SB(1, 0), b3, vB); PG8_STAGE(PG8_SB(1, 1), b3 + hstep, vB); PG8_STAGE(PG8_SA(1, 0), a3, x0);
            PG8_WAIT_V(8); PG8_WAIT_L(0); PG8_BAR; PG8_MMA(1, 0, At, B0); PG8_MMA(1, 1, At, B1); PG8_BAR; PG8_SCHED;
        }
        if (wr == 0) PG8_BAR;
        E(acc, cur, wr, wc, fr, fq);
        if (!has_next) break;
#pragma unroll
        for (int a = 0; a < 2; ++a)
#pragma unroll
            for (int b = 0; b < 2; ++b)
#pragma unroll
                for (int m = 0; m < 4; ++m)
#pragma unroll
                    for (int n = 0; n < 2; ++n) acc[a][b][m][n] = (f32x4){0.f, 0.f, 0.f, 0.f};
        cur = nxt; cA = nA; cB = nB; ++ui;
        if constexpr (GATHER) {
#pragma unroll
            for (int i = 0; i < 2; ++i) { vA0[i] = nA0[i]; vA1[i] = nA1[i]; } }
        if (wr == 1) PG8_BAR;
    }
    PG8_WAIT_V(0);
    PG8_BAR;
#undef PG8_SA
#undef PG8_SB
#undef PG8_STAGE
#undef PG8_LDA
#undef PG8_LDB
#undef PG8_MMA
#undef PG8_WAIT_V
#undef PG8_WAIT_L
#undef PG8_BAR
#undef PG8_SCHED
}

struct EpiZ {
    static constexpr bool PERM = true;
    bf16_t* Z; const float* RS; int skip;
    __device__ __forceinline__ void operator()(const f32x4 (&acc)[2][2][4][2], const Unit& u, int wr, int wc, int fr, int fq) const {
        if (skip) return;
        const int row0 = u.pm * BM + wr * 64 + fr, col0 = u.pn * BM + wc * 32 + 8 * fq;
#pragma unroll
        for (int ai = 0; ai < 2; ++ai)
#pragma unroll
            for (int m = 0; m < 4; ++m) { bf16_t* rowp = Z + (size_t)(row0 + ai * HALF + m * 16) * ZW + col0; const float rs = RS[row0 + ai * HALF + m * 16];
#pragma unroll
                for (int bj = 0; bj < 2; ++bj) { const f32x4 v0 = acc[ai][bj][m][0] * rs, v1 = acc[ai][bj][m][1] * rs;
                    u32x4 w; w.x = cvt_pk_bf16(v0[0], v0[1]); w.y = cvt_pk_bf16(v0[2], v0[3]); w.z = cvt_pk_bf16(v1[0], v1[1]); w.w = cvt_pk_bf16(v1[2], v1[3]);
                    *(u32x4*)(rowp + bj * HALF) = w; } }
    }
};
struct EpiRes {
    static constexpr bool PERM = false;
    const float* X; float* O;
    __device__ __forceinline__ void operator()(const f32x4 (&acc)[2][2][4][2], const Unit& u, int wr, int wc, int fr, int fq) const {
        const int row0 = u.pm * BM + wr * 64 + fr, col0 = u.pn * BM + wc * 32 + 4 * fq;
#pragma unroll
        for (int ai = 0; ai < 2; ++ai)
#pragma unroll
            for (int m = 0; m < 4; ++m) { const size_t off = (size_t)(row0 + ai * HALF + m * 16) * D + col0;
#pragma unroll
                for (int bj = 0; bj < 2; ++bj)
#pragma unroll
                    for (int n = 0; n < 2; ++n) { const f32x4 xs = *(const f32x4*)(X + off + bj * HALF + n * 16); *(f32x4*)(O + off + bj * HALF + n * 16) = xs + acc[ai][bj][m][n]; }
                asm volatile("" ::: "memory"); }
    }
};
struct EpiAct {
    static constexpr bool PERM = true;
    bf16_t* ACT; const int2* lists; const float* RS;
    __device__ __forceinline__ void operator()(const f32x4 (&acc)[2][2][4][2], const Unit& u, int wr, int wc, int fr, int fq) const {
        const int row0 = u.pm * BM + wr * 64 + fr, col0 = u.pn * HALF + wc * 32 + 8 * fq; const int2* lst = lists + (size_t)u.e * NTOK + u.pos0;
#pragma unroll
        for (int ai = 0; ai < 2; ++ai)
#pragma unroll
            for (int m = 0; m < 4; ++m) { const int r = ai * HALF + wr * 64 + m * 16 + fr; bf16_t* rowp = ACT + (size_t)(row0 + ai * HALF + m * 16) * DE + col0;
                float rs = 0.f; if (u.pos0 + r < u.cnt) rs = RS[lst[r].x];
                float o[8];
#pragma unroll
                for (int n = 0; n < 2; ++n)
#pragma unroll
                    for (int j = 0; j < 4; ++j) { const float g = acc[ai][0][m][n][j] * rs, up = acc[ai][1][m][n][j] * rs; o[n * 4 + j] = g * up * __builtin_amdgcn_rcpf(1.f + __expf(-g)); }
                u32x4 w; w.x = cvt_pk_bf16(o[0], o[1]); w.y = cvt_pk_bf16(o[2], o[3]); w.z = cvt_pk_bf16(o[4], o[5]); w.w = cvt_pk_bf16(o[6], o[7]);
                *(u32x4*)rowp = w; }
    }
};
struct EpiY {
    static constexpr bool PERM = true;
    bf16_t* YB; const int2* lists;
    __device__ __forceinline__ void operator()(const f32x4 (&acc)[2][2][4][2], const Unit& u, int wr, int wc, int fr, int fq) const {
        const int row0 = u.pm * BM + wr * 64 + fr, col0 = u.pn * BM + wc * 32 + 8 * fq; const int2* lst = lists + (size_t)u.e * NTOK + u.pos0;
#pragma unroll
        for (int ai = 0; ai < 2; ++ai)
#pragma unroll
            for (int m = 0; m < 4; ++m) { const int r = ai * HALF + wr * 64 + m * 16 + fr;
                if (u.pos0 + r < u.cnt) { const float w = __int_as_float(lst[r].y); bf16_t* rowp = YB + (size_t)(row0 + ai * HALF + m * 16) * D + col0;
#pragma unroll
                    for (int bj = 0; bj < 2; ++bj) { const f32x4 v0 = acc[ai][bj][m][0] * w, v1 = acc[ai][bj][m][1] * w;
                        u32x4 o; o.x = cvt_pk_bf16(v0[0], v0[1]); o.y = cvt_pk_bf16(v0[2], v0[3]); o.z = cvt_pk_bf16(v1[0], v1[1]); o.w = cvt_pk_bf16(v1[2], v1[3]);
                        *(u32x4*)(rowp + bj * HALF) = o; } } }
    }
};
struct MoeOrder {
    const PG8_LAS i32x4* tab; int ntiles, npn, G, c; const char* A; size_t atile; const char* Bt; size_t bexp, btile; const int2* lists;
    __device__ __forceinline__ bool next(int i, Unit& u) const {
        const int L = i * G + c; const int T = L / npn; if (T >= ntiles) return false;
        const i32x4 te = tab[T]; u.pm = T; u.pn = L - T * npn; u.e = __builtin_amdgcn_readfirstlane(te.x); u.pos0 = __builtin_amdgcn_readfirstlane(te.y); u.cnt = __builtin_amdgcn_readfirstlane(te.z);
        u.A = A + (size_t)T * atile; u.B = Bt + (size_t)u.e * bexp + (size_t)u.pn * btile; return true;
    }
    __device__ __forceinline__ void aoff(const Unit& u, unsigned (&o0)[2], unsigned (&o1)[2], const int (&Rs)[2], const int (&Cs)[2]) const {
        const int2* lst = lists + (size_t)u.e * NTOK;
#pragma unroll
        for (int i = 0; i < 2; ++i) { const int p0 = u.pos0 + Rs[i], p1 = p0 + HALF;
            const int t0 = (p0 < u.cnt) ? lst[p0].x : 0, t1 = (p1 < u.cnt) ? lst[p1].x : 0;
            o0[i] = (unsigned)t0 * (unsigned)(D * 2) + (unsigned)Cs[i] * 2u; o1[i] = (unsigned)t1 * (unsigned)(D * 2) + (unsigned)Cs[i] * 2u; }
    }
};
}

__device__ __forceinline__ void tc_strip(float* T, const float* src, int src_ld, int c0, int k0, bf16_t* dst, int K, int n0) {
    const int tid = tid_opaque();
    float4 v[8];
#pragma unroll
    for (int i = 0; i < 8; ++i) { const int kk = (tid >> 4) + 32 * i, c4 = (tid & 15) * 4; v[i] = *(const float4*)(src + (size_t)(k0 + kk) * src_ld + c0 + c4); }
    __syncthreads();
#pragma unroll
    for (int i = 0; i < 8; ++i) { const int kk = (tid >> 4) + 32 * i, c4 = (tid & 15) * 4;
        T[kk * 65 + c4] = v[i].x; T[kk * 65 + c4 + 1] = v[i].y; T[kk * 65 + c4 + 2] = v[i].z; T[kk * 65 + c4 + 3] = v[i].w; }
    __syncthreads();
    const int nl = tid >> 3, kc = (tid & 7) * 32;
#pragma unroll
    for (int q = 0; q < 4; ++q) { const int kq = kc + 8 * q; pg8::u32x4 w;
        w.x = pg8::cvt_pk_bf16(T[(kq + 0) * 65 + nl], T[(kq + 1) * 65 + nl]); w.y = pg8::cvt_pk_bf16(T[(kq + 2) * 65 + nl], T[(kq + 3) * 65 + nl]);
        w.z = pg8::cvt_pk_bf16(T[(kq + 4) * 65 + nl], T[(kq + 5) * 65 + nl]); w.w = pg8::cvt_pk_bf16(T[(kq + 6) * 65 + nl], T[(kq + 7) * 65 + nl]);
        *(pg8::u32x4*)(dst + (size_t)(n0 + nl) * K + k0 + kq) = w; }
}
__device__ __forceinline__ void s5_build_tables_fwd(float* ldsf, const Params& P, int l, int g, unsigned char* tb);
__device__ __forceinline__ void ph_prologue(float* lds, const Params& P) {
    constexpr int NJ_EXP = NLAYER * NEXP * 96, NJ_IN = NLAYER * 144, NJ_OUT = NLAYER * 64, NJ_TB = NLAYER * 16, NJ_GLU = NLAYER * 4, NJ_SGU = NLAYER * 4, NJ_RT = NLAYER * 16;
    bf16_t* WIN = (bf16_t*)(P.ws + WS_WIN); bf16_t* WOUT = (bf16_t*)(P.ws + WS_WOUT); bf16_t* WGU = (bf16_t*)(P.ws + WS_WGU); bf16_t* WD = (bf16_t*)(P.ws + WS_WD);
    constexpr int NJ_ALL = NJ_EXP + NJ_IN + NJ_OUT + NJ_TB + NJ_GLU + NJ_SGU + NJ_RT, NJ_SMALL = NJ_TB + NJ_GLU + NJ_SGU + NJ_RT;
    unsigned* qhead = (unsigned*)(P.ws + WS_CTL) + CW_Q;
    LAS int* jslot = (LAS int*)((LAS unsigned char*)lds + LDS_BYTES - 64);
    for (;;) {
        __syncthreads();
        if (tid_opaque() == 0) *jslot = (int)atomicAdd(qhead, 1u);
        __syncthreads();
        const int jj = __builtin_amdgcn_readfirstlane(*jslot);
        if (jj >= NJ_ALL) break;
        const int j = (jj < NJ_SMALL) ? (NJ_ALL - NJ_SMALL + jj) : (jj - NJ_SMALL);
        if (j < NJ_EXP) {
            const int le = j / 96, r = j % 96;
            if (r < 64) { const int n0 = (r >> 2) * 64, k0 = (r & 3) * 256, pn = n0 >> 8, within = n0 & 255;
                const float* s = (within < 128 ? P.in[I_EWG] : P.in[I_EWU]) + (size_t)le * D * DE;
                tc_strip(lds, s, DE, pn * 128 + (within & 127), k0, WGU + (size_t)le * 1024 * D, D, n0);
            } else { const int r2 = r - 64, n0 = (r2 >> 1) * 64, k0 = (r2 & 1) * 256;
                tc_strip(lds, P.in[I_EWD] + (size_t)le * DE * D, D, n0, k0, WD + (size_t)le * D * DE, DE, n0); }
        } else if (j < NJ_EXP + NJ_IN) {
            const int j2 = j - NJ_EXP, l = j2 / 144, r = j2 % 144, n0 = (r >> 2) * 64, k0 = (r & 3) * 256;
            tc_strip(lds, P.in[I_WIN] + (size_t)l * D * INW, INW, n0 < WCI ? n0 : n0 + 8, k0, WIN + (size_t)l * NMAIN * D, D, n0);
        } else if (j < NJ_EXP + NJ_IN + NJ_OUT) {
            const int j3 = j - NJ_EXP - NJ_IN, l = j3 / 64, r = j3 % 64, n0 = (r >> 2) * 64, k0 = (r & 3) * 256;
            tc_strip(lds, P.in[I_WOUT] + (size_t)l * D * D, D, n0, k0, WOUT + (size_t)l * D * D, D, n0);
        } else if (j < NJ_EXP + NJ_IN + NJ_OUT + NJ_TB) {
            const int j4 = j - (NJ_EXP + NJ_IN + NJ_OUT);
            s5_build_tables_fwd(lds, P, j4 >> 4, j4 & 15, P.ws + WS_TB + (size_t)(j4 >> 4) * 4 * MiB);
        } else if (j < NJ_EXP + NJ_IN + NJ_OUT + NJ_TB + NJ_GLU) {
            const int j5 = j - (NJ_EXP + NJ_IN + NJ_OUT + NJ_TB), l = j5 >> 2, n0 = (j5 & 3) * 64;
            tc_strip(lds, P.in[I_GLUW] + (size_t)l * 256 * 256, 256, n0, 0, (bf16_t*)(P.ws + WS_TB + (size_t)l * 4 * MiB + s5::T_GLUW), 256, n0);
        } else if (j < NJ_EXP + NJ_IN + NJ_OUT + NJ_TB + NJ_GLU + NJ_SGU) {
            const int j6 = j - (NJ_EXP + NJ_IN + NJ_OUT + NJ_TB + NJ_GLU), l = j6 >> 2, g = j6 & 3;
            bf16_t* wbp = (bf16_t*)(P.ws + WS_TB + (size_t)l * 4 * MiB + s5::T_SGUW) + (size_t)g * 128 * 128; const float* ws_ = P.in[I_SGUW] + ((size_t)l * 4 + g) * 128 * 128;
            for (int idx = tid_opaque(); idx < 128 * 128; idx += NTHREADS) { const int t = idx >> 7, s = idx & 127; wbp[idx] = (s <= t) ? (bf16_t)(pg8::cvt_pk_bf16(ws_[idx], 0.f) & 0xffffu) : (bf16_t)0; }
        } else {
            const int j7 = j - (NJ_EXP + NJ_IN + NJ_OUT + NJ_TB + NJ_GLU + NJ_SGU), l = j7 / 16, n0 = (j7 % 16) * 4;
            bf16_t* wh = (bf16_t*)(P.ws + WS_RT + (size_t)l * 256 * 1024); bf16_t* wl = wh + 48 * D;
            for (int idx = tid_opaque(); idx < 4 * D; idx += NTHREADS) { const int n = n0 + (idx >> 10), k = idx & (D - 1);
                const float w = (n < 4) ? P.in[I_RGW][((size_t)l * D + k) * 4 + n] : ((n < 36) ? P.in[I_REW][((size_t)l * D + k) * 32 + (n - 4)] : ((n >= 48 && n < 56) ? P.in[I_WIN][((size_t)l * D + k) * INW + WCI + (n - 48)] : 0.f));
                const unsigned hb = pg8::cvt_pk_bf16(w, 0.f) & 0xffffu; const bf16_t lb = (bf16_t)(pg8::cvt_pk_bf16(w - __uint_as_float(hb << 16), 0.f) & 0xffffu);
                if (n < 48) { wh[(size_t)n * D + k] = (bf16_t)hb; wl[(size_t)n * D + k] = lb; } else { wh[(size_t)(96 + n - 48) * D + k] = (bf16_t)hb; wh[(size_t)(112 + n - 48) * D + k] = lb; } }
        }
    }
    __syncthreads();
}

template <bool DUAL, class AF, class EF>
__device__ __forceinline__ void gemm_tile(float* lds, AF arow, int K, const float* B0, const float* B1, int ldb, int n0, int N, EF epi) {
    float* As = lds;
    float* Bs0 = lds + 32 * 132;
    float* Bs1 = Bs0 + 32 * 128;
    const int tid = tid_opaque(), ty = tid >> 4, tx = tid & 15;
    float acc0[4][8], acc1[4][8];
#pragma unroll
    for (int i = 0; i < 4; ++i)
#pragma unroll
        for (int j = 0; j < 8; ++j) { acc0[i][j] = 0.f; acc1[i][j] = 0.f; }
    const float* ap0 = arow((tid >> 3));
    const float* ap1 = arow((tid >> 3) + 64);
    const int akk = (tid & 7) * 4;
    const int bn = n0 + (tid & 31) * 4; const bool bok = bn < N;
    for (int k0 = 0; k0 < K; k0 += 32) {
        const float4 av0 = ap0 ? *(const float4*)(ap0 + k0 + akk) : make_float4(0.f, 0.f, 0.f, 0.f);
        const float4 av1 = ap1 ? *(const float4*)(ap1 + k0 + akk) : make_float4(0.f, 0.f, 0.f, 0.f);
        const int kb0 = k0 + (tid >> 5), kb1 = kb0 + 16;
        const float4 bv00 = bok ? *(const float4*)(B0 + (size_t)kb0 * ldb + bn) : make_float4(0.f, 0.f, 0.f, 0.f);
        const float4 bv01 = bok ? *(const float4*)(B0 + (size_t)kb1 * ldb + bn) : make_float4(0.f, 0.f, 0.f, 0.f);
        const float4 bv10 = (DUAL && bok) ? *(const float4*)(B1 + (size_t)kb0 * ldb + bn) : bv00;
        const float4 bv11 = (DUAL && bok) ? *(const float4*)(B1 + (size_t)kb1 * ldb + bn) : bv01;
        __syncthreads();
        { const int r = (tid >> 3);
          As[(akk + 0) * 132 + r] = av0.x; As[(akk + 1) * 132 + r] = av0.y; As[(akk + 2) * 132 + r] = av0.z; As[(akk + 3) * 132 + r] = av0.w;
          As[(akk + 0) * 132 + r + 64] = av1.x; As[(akk + 1) * 132 + r + 64] = av1.y; As[(akk + 2) * 132 + r + 64] = av1.z; As[(akk + 3) * 132 + r + 64] = av1.w; }
        { const int k = (tid >> 5);
          *(float4*)&Bs0[k * 128 + (tid & 31) * 4] = bv00; *(float4*)&Bs0[(k + 16) * 128 + (tid & 31) * 4] = bv01;
          if (DUAL) { *(float4*)&Bs1[k * 128 + (tid & 31) * 4] = bv10; *(float4*)&Bs1[(k + 16) * 128 + (tid & 31) * 4] = bv11; } }
        __syncthreads();
#pragma unroll 4
        for (int k = 0; k < 32; ++k) {
            const float4 a = *(const float4*)&As[k * 132 + ty * 4];
            const float4 b0 = *(const float4*)&Bs0[k * 128 + tx * 4], b1 = *(const float4*)&Bs0[k * 128 + 64 + tx * 4];
            const float aa[4] = {a.x, a.y, a.z, a.w};
            const float bb[8] = {b0.x, b0.y, b0.z, b0.w, b1.x, b1.y, b1.z, b1.w};
#pragma unroll
            for (int i = 0; i < 4; ++i)
#pragma unroll
                for (int j = 0; j < 8; ++j) acc0[i][j] = fmaf(aa[i], bb[j], acc0[i][j]);
            if (DUAL) {
                const float4 c0 = *(const float4*)&Bs1[k * 128 + tx * 4], c1 = *(const float4*)&Bs1[k * 128 + 64 + tx * 4];
                const float cc[8] = {c0.x, c0.y, c0.z, c0.w, c1.x, c1.y, c1.z, c1.w};
#pragma unroll
                for (int i = 0; i < 4; ++i)
#pragma unroll
                    for (int j = 0; j < 8; ++j) acc1[i][j] = fmaf(aa[i], cc[j], acc1[i][j]);
            }
        }
    }
#pragma unroll
    for (int i = 0; i < 4; ++i)
#pragma unroll
        for (int j = 0; j < 8; ++j) {
            const int r = ty * 4 + i, c = n0 + (j < 4 ? tx * 4 + j : 64 + tx * 4 + (j - 4));
            if (c < N) epi(r, c, acc0[i][j], acc1[i][j]);
        }
    __syncthreads();
}

__device__ __forceinline__ void ph_inproj(LAS unsigned char* ldsb, const bf16_t* xn, const bf16_t* wt, bf16_t* z, const float* RS, int skip) {
    pg8::StaticOrder S; S.init(NTOK, NMAIN, D, D, gridDim.x, blockIdx.x, xn, wt, INPROJ_WGM);
    if (skip & 2) S.pmmask = 15;
    pg8::EpiZ E{z, RS, skip & 1};
    pg8::gemm_phase<pg8::EpiZ, pg8::StaticOrder, false>(ldsb, D, D, S, E);
}

namespace ml {
using pg8::bf16x8; using pg8::f32x4; using pg8::u32x4; using pg8::u32x2;
constexpr int L = 128, NCH = S / L, NU = NB * 4 * NCH;
constexpr int QP = 144, TP = 272;
constexpr int OFF_Q = 0, OFF_K = OFF_Q + 128 * QP, OFF_VT = OFF_K + 128 * QP, OFF_KT = OFF_VT + 64 * TP, OFF_F = OFF_KT + 64 * TP;
constexpr int LDS_END = OFF_F + 4 * 128 * 4 + 64;
constexpr size_t O_CL = 0, O_CST = O_CL + (size_t)NU * 4096 * 4, O_NL = O_CST + (size_t)NU * 4096 * 2, O_NST = O_NL + (size_t)NU * 64 * 4,
                 O_MLOC = O_NST + (size_t)NU * 64 * 4, O_BL = O_MLOC + (size_t)NU * 4, O_MST = O_BL + (size_t)NU * 4, O_END = O_MST + (size_t)NU * 4;
__device__ __forceinline__ f32x4 mfma16(bf16x8 a, bf16x8 b, f32x4 c) { return __builtin_amdgcn_mfma_f32_16x16x32_bf16(a, b, c, 0, 0, 0); }
__device__ __forceinline__ float bf_lo(unsigned w) { return __uint_as_float(w << 16); }
__device__ __forceinline__ float bf_hi(unsigned w) { return __uint_as_float(w & 0xffff0000u); }
__device__ __forceinline__ unsigned short bf1(float x) { return (unsigned short)(pg8::cvt_pk_bf16(x, 0.f) & 0xffffu); }

__device__ __forceinline__ void stage_gates(LAS unsigned char* lds, const float* gates, const Params& P, int l, int head, int tok0, int tid) {
    LAS float* LF = (LAS float*)(lds + OFF_F); LAS float* IG = LF + 128; LAS float* Bc = LF + 256; LAS float* G2 = LF + 384; LAS float* scal = LF + 512;
    if (tid < 128) { const float* zr = gates + (size_t)(tok0 + tid) * 8;
        const float ipre = zr[head] + P.in[I_GATEB][l * 8 + head], fpre = zr[4 + head] + P.in[I_GATEB][l * 8 + 4 + head];
        LF[tid] = fminf(fpre, 0.f) - log1pf(expf(-fabsf(fpre))); IG[tid] = ipre; }
    __syncthreads();
    if (tid < 64) { const float a = LF[2 * tid], b2 = LF[2 * tid + 1]; const float s = a + b2; float inc = s;
#pragma unroll
        for (int o = 1; o < 64; o <<= 1) { const float v = __shfl_up(inc, o); if (tid >= o) inc += v; }
        const float exc = inc - s; const float b0 = exc + a, b1 = exc + s;
        Bc[2 * tid] = b0; Bc[2 * tid + 1] = b1; const float g0 = IG[2 * tid] - b0, g1 = IG[2 * tid + 1] - b1; G2[2 * tid] = g0; G2[2 * tid + 1] = g1;
        float gm = fmaxf(g0, g1);
#pragma unroll
        for (int o = 32; o > 0; o >>= 1) gm = fmaxf(gm, __shfl_xor(gm, o));
        if (tid == 63) { scal[0] = gm; scal[1] = b1; } }
    __syncthreads();
}
__device__ __forceinline__ void conv8(const bf16_t* z, const float* cw, int b, int pos, int which, int head, int c0, float (&o)[8]) {
    const int col = (which ? ZCK : ZCQ) + head * 64 + c0, cc = which * 256 + head * 64 + c0;
    float x[8];
#pragma unroll
    for (int e = 0; e < 8; ++e) x[e] = 0.f;
    u32x4 raw[4];
#pragma unroll
    for (int j = 0; j < 4; ++j) { const int tg = pos - 3 + j; raw[j] = *(const u32x4*)(z + (size_t)(b * S + (tg > 0 ? tg : 0)) * ZW + col); }
#pragma unroll
    for (int j = 0; j < 4; ++j) { const float mk = (pos - 3 + j >= 0) ? 1.f : 0.f;
        const float4 w0 = *(const float4*)(cw + j * 512 + cc), w1 = *(const float4*)(cw + j * 512 + cc + 4);
        x[0] += mk * w0.x * bf_lo(raw[j].x); x[1] += mk * w0.y * bf_hi(raw[j].x); x[2] += mk * w0.z * bf_lo(raw[j].y); x[3] += mk * w0.w * bf_hi(raw[j].y);
        x[4] += mk * w1.x * bf_lo(raw[j].z); x[5] += mk * w1.y * bf_hi(raw[j].z); x[6] += mk * w1.z * bf_lo(raw[j].w); x[7] += mk * w1.w * bf_hi(raw[j].w); }
    const float sc = which ? 0.125f : 1.f;
#pragma unroll
    for (int e = 0; e < 8; ++e) o[e] = x[e] * sc / (1.f + __expf(-x[e]));
}
__device__ __forceinline__ void stage_vt(LAS unsigned char* lds, const bf16_t* z, int head, int tok0, int tid) {
#pragma unroll
    for (int it = 0; it < 2; ++it) { const int idx = tid + it * NTHREADS, s = idx & 127, cg = idx >> 7;
        const u32x4 w = *(const u32x4*)(z + (size_t)(tok0 + s) * ZW + ZCV + head * 64 + cg * 8);
        const unsigned ww[4] = {w.x, w.y, w.z, w.w};
#pragma unroll
        for (int e = 0; e < 8; ++e) *(LAS unsigned short*)(lds + OFF_VT + (cg * 8 + e) * TP + s * 2) = (unsigned short)((e & 1) ? (ww[e >> 1] >> 16) : (ww[e >> 1] & 0xffffu)); }
}

__device__ __forceinline__ void p1_unit(LAS unsigned char* lds, const bf16_t* z, const float* gates, const Params& P, int l, int u, unsigned char* wsm) {
    const int tid = tid_opaque(), lane = tid & 63, wid = __builtin_amdgcn_readfirstlane(tid >> 6), r = lane & 15, qd = lane >> 4;
    const int b = u >> 8, head = (u >> 6) & 3, c = u & 63, tok0 = b * S + c * L;
    LAS float* G2 = (LAS float*)(lds + OFF_F) + 384; LAS float* scal = (LAS float*)(lds + OFF_F) + 512;
    __syncthreads();
    stage_gates(lds, gates, P, l, head, tok0, tid);
    const float gmax = scal[0], bL = scal[1];
    stage_vt(lds, z, head, tok0, tid);
    const float* cw = P.in[I_CONVW] + (size_t)l * 4 * 512;
#pragma unroll
    for (int it = 0; it < 2; ++it) { const int idx = tid + it * NTHREADS, s = idx & 127, cg = idx >> 7;
        float o[8]; conv8(z, cw, b, c * L + s, 1, head, cg * 8, o);
        const float ws = __expf(G2[s] - gmax);
#pragma unroll
        for (int e = 0; e < 8; ++e) *(LAS unsigned short*)(lds + OFF_KT + (cg * 8 + e) * TP + s * 2) = bf1(o[e] * ws); }
    __syncthreads();
    const int kt = wid >> 1;
    float* CL = (float*)(wsm + O_CL) + (size_t)u * 4096;
#pragma unroll
    for (int i = 0; i < 2; ++i) { const int vt = (wid & 1) * 2 + i; f32x4 acc = {0.f, 0.f, 0.f, 0.f};
#pragma unroll
        for (int ks = 0; ks < 4; ++ks) { const bf16x8 a = *(const LAS bf16x8*)(lds + OFF_KT + (16 * kt + r) * TP + (32 * ks + 8 * qd) * 2), bb = *(const LAS bf16x8*)(lds + OFF_VT + (16 * vt + r) * TP + (32 * ks + 8 * qd) * 2);
            acc = mfma16(a, bb, acc); }
        *(f32x4*)(CL + (size_t)(16 * vt + r) * 64 + 16 * kt + 4 * qd) = acc; }
    if (tid < 64) { float sum = 0.f;
        for (int s2 = 0; s2 < 128; s2 += 2) { const unsigned w2 = *(const LAS unsigned*)(lds + OFF_KT + tid * TP + s2 * 2); sum += bf_lo(w2) + bf_hi(w2); }
        ((float*)(wsm + O_NL))[(size_t)u * 64 + tid] = sum; }
    if (tid == 0) { ((float*)(wsm + O_MLOC))[u] = bL + gmax; ((float*)(wsm + O_BL))[u] = bL; }
}
__device__ __forceinline__ void p2_scan(unsigned char* wsm) {
    const int tid = tid_opaque();
    const float* CL = (const float*)(wsm + O_CL); const float* NL = (const float*)(wsm + O_NL); const float* MLOC = (const float*)(wsm + O_MLOC); const float* BL = (const float*)(wsm + O_BL);
    bf16_t* CST = (bf16_t*)(wsm + O_CST); float* NST = (float*)(wsm + O_NST); float* MST = (float*)(wsm + O_MST);
    for (int idx = blockIdx.x * NTHREADS + tid; idx < 32 * 4096; idx += gridDim.x * NTHREADS) {
        const int bh = idx >> 12, e = idx & 4095;
        float C = 0.f, nn = 0.f, m = 0.f;
#pragma unroll 1
        for (int c0 = 0; c0 < NCH; c0 += 16) {
            float cl[16], ml_[16], bl[16], nl[16];
#pragma unroll
            for (int i = 0; i < 16; ++i) { const int u = bh * NCH + c0 + i; cl[i] = CL[(size_t)u * 4096 + e]; ml_[i] = MLOC[u]; bl[i] = BL[u]; nl[i] = NL[(size_t)u * 64 + (e & 63)]; }
            unsigned short cs[16]; float ns[16], ms[16];
#pragma unroll
            for (int i = 0; i < 16; ++i) { cs[i] = bf1(C); ns[i] = nn; ms[i] = m;
                const float mn = fmaxf(bl[i] + m, ml_[i]), dec = __expf(bl[i] + m - mn), wl = __expf(ml_[i] - mn);
                C = dec * C + wl * cl[i]; nn = dec * nn + wl * nl[i]; m = mn; }
#pragma unroll
            for (int i = 0; i < 16; ++i) { const int u = bh * NCH + c0 + i; CST[(size_t)u * 4096 + e] = cs[i]; if (e < 64) NST[(size_t)u * 64 + e] = ns[i]; if (e == 0) MST[u] = ms[i]; }
        }
    }
}
__device__ __forceinline__ void p3_unit(LAS unsigned char* lds, const bf16_t* z, const float* gates, const Params& P, int l, int u, const unsigned char* wsm, bf16_t* mix) {
    const int tid = tid_opaque(), lane = tid & 63, wid = __builtin_amdgcn_readfirstlane(tid >> 6), r = lane & 15, qd = lane >> 4;
    const int b = u >> 8, head = (u >> 6) & 3, c = u & 63, tok0 = b * S + c * L;
    LAS float* Bc = (LAS float*)(lds + OFF_F) + 256; LAS float* G2 = (LAS float*)(lds + OFF_F) + 384;
    __syncthreads();
    stage_gates(lds, gates, P, l, head, tok0, tid);
    stage_vt(lds, z, head, tok0, tid);
    const float* cw = P.in[I_CONVW] + (size_t)l * 4 * 512;
#pragma unroll
    for (int it = 0; it < 4; ++it) { const int idx = tid + it * NTHREADS, which = idx >> 10, s = (idx >> 3) & 127, cg = idx & 7;
        float o[8]; conv8(z, cw, b, c * L + s, which, head, cg * 8, o);
        u32x4 w; w.x = pg8::cvt_pk_bf16(o[0], o[1]); w.y = pg8::cvt_pk_bf16(o[2], o[3]); w.z = pg8::cvt_pk_bf16(o[4], o[5]); w.w = pg8::cvt_pk_bf16(o[6], o[7]);
        *(LAS u32x4*)(lds + (which ? OFF_K : OFF_Q) + s * QP + cg * 16) = w; }
    __syncthreads();
    const int w = wid, t = 16 * w + r;
    const bf16x8 bq0 = *(const LAS bf16x8*)(lds + OFF_Q + t * QP + qd * 16), bq1 = *(const LAS bf16x8*)(lds + OFF_Q + t * QP + 64 + qd * 16);
    f32x4 accS[8];
#pragma unroll
    for (int ct = 0; ct < 8; ++ct) { accS[ct] = (f32x4){0.f, 0.f, 0.f, 0.f};
        if (ct <= w) { const bf16x8 a0 = *(const LAS bf16x8*)(lds + OFF_K + (16 * ct + r) * QP + qd * 16), a1 = *(const LAS bf16x8*)(lds + OFF_K + (16 * ct + r) * QP + 64 + qd * 16);
            accS[ct] = mfma16(a0, bq0, accS[ct]); accS[ct] = mfma16(a1, bq1, accS[ct]); } }
    const float bt = Bc[t], mst = ((const float*)(wsm + O_MST))[u];
    float ld[8][4]; float mloc = -3.0e38f;
#pragma unroll
    for (int ct = 0; ct < 8; ++ct) { const f32x4 g = *(const LAS f32x4*)(G2 + 16 * ct + 4 * qd);
#pragma unroll
        for (int j = 0; j < 4; ++j) { const bool valid = (ct < w) || (ct == w && 4 * qd + j <= r); ld[ct][j] = valid ? bt + g[j] : -3.0e38f; mloc = fmaxf(mloc, ld[ct][j]); } }
    mloc = fmaxf(mloc, __shfl_xor(mloc, 16)); mloc = fmaxf(mloc, __shfl_xor(mloc, 32));
    const float mt = fmaxf(bt + mst, mloc);
    float den = 0.f;
#pragma unroll
    for (int ct = 0; ct < 8; ++ct)
#pragma unroll
        for (int j = 0; j < 4; ++j) { const float pe = __expf(ld[ct][j] - mt) * accS[ct][j]; accS[ct][j] = pe; den += pe; }
    den += __shfl_xor(den, 16); den += __shfl_xor(den, 32);
    const bf16_t* cst = (const bf16_t*)(wsm + O_CST) + (size_t)u * 4096; const float* nst = (const float*)(wsm + O_NST) + (size_t)u * 64;
    f32x4 accN[4];
#pragma unroll
    for (int dt = 0; dt < 4; ++dt) { const bf16x8 c0 = *(const bf16x8*)(cst + (16 * dt + r) * 64 + 8 * qd), c1 = *(const bf16x8*)(cst + (16 * dt + r) * 64 + 32 + 8 * qd);
        accN[dt] = mfma16(c0, bq0, (f32x4){0.f, 0.f, 0.f, 0.f}); accN[dt] = mfma16(c1, bq1, accN[dt]); }
    const float winter = __expf(bt + mst - mt);
    float nq = 0.f;
    { const float4 n0 = *(const float4*)(nst + 8 * qd), n1 = *(const float4*)(nst + 8 * qd + 4), n2 = *(const float4*)(nst + 32 + 8 * qd), n3 = *(const float4*)(nst + 36 + 8 * qd);
      const u32x4 q0 = __builtin_bit_cast(u32x4, bq0), q1 = __builtin_bit_cast(u32x4, bq1);
      nq = bf_lo(q0.x) * n0.x + bf_hi(q0.x) * n0.y + bf_lo(q0.y) * n0.z + bf_hi(q0.y) * n0.w + bf_lo(q0.z) * n1.x + bf_hi(q0.z) * n1.y + bf_lo(q0.w) * n1.z + bf_hi(q0.w) * n1.w
         + bf_lo(q1.x) * n2.x + bf_hi(q1.x) * n2.y + bf_lo(q1.y) * n2.z + bf_hi(q1.y) * n2.w + bf_lo(q1.z) * n3.x + bf_hi(q1.z) * n3.y + bf_lo(q1.w) * n3.z + bf_hi(q1.w) * n3.w; }
    nq += __shfl_xor(nq, 16); nq += __shfl_xor(nq, 32);
    den += winter * nq;
#pragma unroll
    for (int dt = 0; dt < 4; ++dt) accN[dt] = accN[dt] * winter;
#pragma unroll
    for (int kk = 0; kk < 4; ++kk) if (2 * kk <= w) {
        u32x4 pw; pw.x = pg8::cvt_pk_bf16(accS[2 * kk][0], accS[2 * kk][1]); pw.y = pg8::cvt_pk_bf16(accS[2 * kk][2], accS[2 * kk][3]);
        pw.z = pg8::cvt_pk_bf16(accS[2 * kk + 1][0], accS[2 * kk + 1][1]); pw.w = pg8::cvt_pk_bf16(accS[2 * kk + 1][2], accS[2 * kk + 1][3]);
        const bf16x8 pf = __builtin_bit_cast(bf16x8, pw);
#pragma unroll
        for (int dt = 0; dt < 4; ++dt) { const u32x2 v0 = *(const LAS u32x2*)(lds + OFF_VT + (16 * dt + r) * TP + (32 * kk + 4 * qd) * 2), v1 = *(const LAS u32x2*)(lds + OFF_VT + (16 * dt + r) * TP + (32 * kk + 16 + 4 * qd) * 2);
            u32x4 vw; vw.x = v0.x; vw.y = v0.y; vw.z = v1.x; vw.w = v1.y;
            accN[dt] = mfma16(__builtin_bit_cast(bf16x8, vw), pf, accN[dt]); } }
    const float inv = 1.f / fmaxf(fabsf(den), __expf(-mt));
    float ss = 0.f;
#pragma unroll
    for (int dt = 0; dt < 4; ++dt) { accN[dt] = accN[dt] * inv; ss += accN[dt][0] * accN[dt][0] + accN[dt][1] * accN[dt][1] + accN[dt][2] * accN[dt][2] + accN[dt][3] * accN[dt][3]; }
    ss += __shfl_xor(ss, 16); ss += __shfl_xor(ss, 32);
    const float rs = rsqrtf(ss * (1.f / 64.f) + EPS);
    const float* ng = P.in[I_MNG] + l * 256 + head * 64; const bf16_t* cop = z + (size_t)(tok0 + t) * ZW + ZCO + head * 64;
    bf16_t* op = mix + (size_t)(tok0 + t) * D + 512 + head * 64;
#pragma unroll
    for (int dt = 0; dt < 4; ++dt) { const int d0 = 16 * dt + 4 * qd; const float4 g = *(const float4*)(ng + d0); const u32x2 cw2 = *(const u32x2*)(cop + d0); const float4 co = make_float4(bf_lo(cw2.x), bf_hi(cw2.x), bf_lo(cw2.y), bf_hi(cw2.y));
        u32x2 o; o.x = pg8::cvt_pk_bf16(accN[dt][0] * rs * g.x / (1.f + __expf(-co.x)), accN[dt][1] * rs * g.y / (1.f + __expf(-co.y)));
        o.y = pg8::cvt_pk_bf16(accN[dt][2] * rs * g.z / (1.f + __expf(-co.z)), accN[dt][3] * rs * g.w / (1.f + __expf(-co.w)));
        *(u32x2*)(op + d0) = o; }
}
static_assert(O_END <= 64 * MiB && LDS_END <= 128 * 1024, "mLSTM scratch fits");
}

namespace s5 {
using pg8::bf16x8; using pg8::f32x4; using pg8::u32x4; using pg8::u32x2;
constexpr int LC = 16, NINST = NTOK / LC;
constexpr size_t O_E = 0, O_XC = O_E + (size_t)NINST * 16 * 128 * 4, O_END = O_XC + (size_t)NINST * 16 * 128 * 2;
constexpr int YP = 528;
__device__ __forceinline__ f32x4 mfma16(bf16x8 a, bf16x8 b, f32x4 c) { return __builtin_amdgcn_mfma_f32_16x16x32_bf16(a, b, c, 0, 0, 0); }

__device__ __forceinline__ void build_tables(float* ldsf, const Params& P, int l, int g, unsigned char* tb) {
    const int tid = tid_opaque();
    float* apw = ldsf; float* bb = apw + 17 * 64 * 2; float* cc = bb + 64 * 16 * 2;
    __syncthreads();
    if (tid < 64) { const int gp = (l * 16 + g) * 64 + tid;
        const float ar = P.in[I_ARE][gp], ai = P.in[I_AIM][gp], dt = expf(P.in[I_LDT][l * 16 + g]);
        for (int tau = 0; tau <= 16; ++tau) { const float er = expf(ar * dt * tau), ang = ai * dt * tau; apw[(tau * 64 + tid) * 2] = er * cosf(ang); apw[(tau * 64 + tid) * 2 + 1] = er * sinf(ang); }
        const float abr = apw[(64 + tid) * 2], abi = apw[(64 + tid) * 2 + 1];
        const float xr_ = abr - 1.f, xi_ = abi, den = ar * ar + ai * ai;
        const float cr = (xr_ * ar + xi_ * ai) / den, ci = (xi_ * ar - xr_ * ai) / den;
        for (int h = 0; h < 16; ++h) { const float br = P.in[I_BRE][(size_t)gp * 16 + h], bi = P.in[I_BIM][(size_t)gp * 16 + h]; bb[(tid * 16 + h) * 2] = cr * br - ci * bi; bb[(tid * 16 + h) * 2 + 1] = cr * bi + ci * br; }
        float* a16 = (float*)(tb + T_A16) + (size_t)(g * 64 + tid) * 2; a16[0] = apw[(16 * 64 + tid) * 2]; a16[1] = apw[(16 * 64 + tid) * 2 + 1]; }
    for (int idx = tid; idx < 16 * 64; idx += NTHREADS) { const int h = idx >> 6, p = idx & 63; const int ci_ = ((l * 16 + g) * 16 + h) * 64 + p; cc[idx * 2] = P.in[I_CRE][ci_]; cc[idx * 2 + 1] = P.in[I_CIM][ci_]; }
    __syncthreads();
    bf16_t* KM = (bf16_t*)(tb + T_KMAT) + (size_t)g * 32 * 256;
    for (int idx = tid; idx < 15 * 256; idx += NTHREADS) KM[idx] = (bf16_t)0; bf16_t* FT = (bf16_t*)(tb + T_F) + (size_t)g * 256 * 128; bf16_t* GT = (bf16_t*)(tb + T_G) + (size_t)g * 128 * 256;
    for (int idx = tid; idx < 16 * 256; idx += NTHREADS) { const int tau = idx >> 8, h = (idx >> 4) & 15, hp = idx & 15; float s = 0.f;
        for (int p = 0; p < 64; ++p) { const float cr = cc[(h * 64 + p) * 2], ci = cc[(h * 64 + p) * 2 + 1], ar = apw[(tau * 64 + p) * 2], ai = apw[(tau * 64 + p) * 2 + 1], br = bb[(p * 16 + hp) * 2], bi = bb[(p * 16 + hp) * 2 + 1];
            const float er = ar * br - ai * bi, ei = ar * bi + ai * br; s += cr * er - ci * ei; }
        KM[15 * 256 + idx] = ml::bf1(s); }
    for (int idx = tid; idx < 256 * 64; idx += NTHREADS) { const int n = idx >> 6, p = idx & 63, t = n >> 4, h = n & 15;
        const float cr = cc[(h * 64 + p) * 2], ci = cc[(h * 64 + p) * 2 + 1], ar = apw[((t + 1) * 64 + p) * 2], ai = apw[((t + 1) * 64 + p) * 2 + 1];
        FT[(size_t)n * 128 + p] = ml::bf1(cr * ar - ci * ai); FT[(size_t)n * 128 + 64 + p] = ml::bf1(-(cr * ai + ci * ar)); }
    for (int idx = tid; idx < 64 * 256; idx += NTHREADS) { const int p = idx >> 8, k = idx & 255, s = k >> 4, hp = k & 15;
        const float ar = apw[((15 - s) * 64 + p) * 2], ai = apw[((15 - s) * 64 + p) * 2 + 1], br = bb[(p * 16 + hp) * 2], bi = bb[(p * 16 + hp) * 2 + 1];
        GT[(size_t)p * 256 + k] = ml::bf1(ar * br - ai * bi); GT[(size_t)(64 + p) * 256 + k] = ml::bf1(ar * bi + ai * br); }
}
__device__ __forceinline__ void load_u_frags(const bf16_t* z, int tok0, int g, int r, int qd, bf16x8 (&uf)[8]) {
#pragma unroll
    for (int ks = 0; ks < 8; ++ks) uf[ks] = *(const bf16x8*)(z + (size_t)(tok0 + 16 * r + 2 * ks + (qd >> 1)) * ZW + ZSU + 16 * g + 8 * (qd & 1));
}
__device__ __forceinline__ void p1_unit(const bf16_t* z, const unsigned char* tb, int u, unsigned char* wss) {
    const int tid = tid_opaque(), lane = tid & 63, wid = __builtin_amdgcn_readfirstlane(tid >> 6), r = lane & 15, qd = lane >> 4;
    const int tok0 = u * 256, inst0 = u * 16;
    float* E = (float*)(wss + O_E);
#pragma unroll 1
    for (int gi = 0; gi < 2; ++gi) { const int g = 2 * wid + gi;
        bf16x8 uf[8]; load_u_frags(z, tok0, g, r, qd, uf);
        const bf16_t* GT = (const bf16_t*)(tb + T_G) + (size_t)g * 128 * 256 + (size_t)r * 256 + 8 * qd;
        bf16x8 gf[2][8];
#pragma unroll
        for (int ks = 0; ks < 8; ++ks) gf[0][ks] = *(const bf16x8*)(GT + 32 * ks);
#pragma unroll
        for (int nt = 0; nt < 8; ++nt) {
            if (nt + 1 < 8) {
#pragma unroll
                for (int ks = 0; ks < 8; ++ks) gf[(nt + 1) & 1][ks] = *(const bf16x8*)(GT + (size_t)(16 * (nt + 1)) * 256 + 32 * ks); }
            f32x4 acc = {0.f, 0.f, 0.f, 0.f};
#pragma unroll
            for (int ks = 0; ks < 8; ++ks) acc = mfma16(gf[nt & 1][ks], uf[ks], acc);
            *(f32x4*)(E + ((size_t)(inst0 + r) * 16 + g) * 128 + 16 * nt + 4 * qd) = acc; }
    }
}
__device__ __forceinline__ void p2_scan(LAS unsigned char* lds, const unsigned char* tb, unsigned char* wss) {
    const int tid = tid_opaque(), p = tid & 63, seg = tid >> 6;
    const float* __restrict__ E = (const float*)(wss + O_E); bf16_t* __restrict__ XC = (bf16_t*)(wss + O_XC);
    LAS float* SE = (LAS float*)lds;
    for (int u = blockIdx.x; u < NB * 16; u += gridDim.x) {
        const int b = u >> 4, g = u & 15;
        const float* a16 = (const float*)(tb + T_A16) + (size_t)(g * 64 + p) * 2; const float ar = a16[0], ai = a16[1];
        const size_t o0 = ((size_t)(b * (S / LC) + seg * 64) * 16 + g) * 128 + p; constexpr size_t cs = (size_t)16 * 128;
        float xr = 0.f, xi = 0.f;
#pragma unroll 1
        for (int c0 = 0; c0 < 64; c0 += 16) { float er[16], ei[16];
#pragma unroll
            for (int i = 0; i < 16; ++i) { er[i] = E[o0 + (c0 + i) * cs]; ei[i] = E[o0 + (c0 + i) * cs + 64]; }
#pragma unroll
            for (int i = 0; i < 16; ++i) { const float nr = ar * xr - ai * xi + er[i], ni = ar * xi + ai * xr + ei[i]; xr = nr; xi = ni; } }
        __syncthreads();
        SE[(seg * 64 + p) * 2] = xr; SE[(seg * 64 + p) * 2 + 1] = xi;
        __syncthreads();
        float br = ar, bi = ai;
#pragma unroll
        for (int i = 0; i < 6; ++i) { const float nr = br * br - bi * bi, ni = 2.f * br * bi; br = nr; bi = ni; }
        xr = 0.f; xi = 0.f;
        for (int s2 = 0; s2 < seg; ++s2) { const float er = SE[(s2 * 64 + p) * 2], ei = SE[(s2 * 64 + p) * 2 + 1]; const float nr = br * xr - bi * xi + er, ni = br * xi + bi * xr + ei; xr = nr; xi = ni; }
#pragma unroll 1
        for (int c0 = 0; c0 < 64; c0 += 16) { float er[16], ei[16]; unsigned short sr[16], si[16];
#pragma unroll
            for (int i = 0; i < 16; ++i) { er[i] = E[o0 + (c0 + i) * cs]; ei[i] = E[o0 + (c0 + i) * cs + 64]; }
#pragma unroll
            for (int i = 0; i < 16; ++i) { sr[i] = ml::bf1(xr); si[i] = ml::bf1(xi); const float nr = ar * xr - ai * xi + er[i], ni = ar * xi + ai * xr + ei[i]; xr = nr; xi = ni; }
#pragma unroll
            for (int i = 0; i < 16; ++i) { XC[o0 + (c0 + i) * cs] = sr[i]; XC[o0 + (c0 + i) * cs + 64] = si[i]; } }
    }
    __syncthreads();
}
__device__ __forceinline__ void p3_unit(LAS unsigned char* lds, const bf16_t* z, const Params& P, int l, const unsigned char* tb, int u, const unsigned char* wss, bf16_t* mix) {
    const int tid = tid_opaque(), lane = tid & 63, wid = __builtin_amdgcn_readfirstlane(tid >> 6), r = lane & 15, qd = lane >> 4;
    const int tok0 = u * 256, inst0 = u * 16;
    const bf16_t* XC = (const bf16_t*)(wss + O_XC);
    __syncthreads();
#pragma unroll 1
    for (int gi = 0; gi < 2; ++gi) { const int g = 2 * wid + gi;
        bf16x8 uf[8]; load_u_frags(z, tok0, g, r, qd, uf);
        bf16x8 xf[4];
#pragma unroll
        for (int ks = 0; ks < 4; ++ks) xf[ks] = *(const bf16x8*)(XC + ((size_t)(inst0 + r) * 16 + g) * 128 + 32 * ks + 8 * qd);
        const bf16_t* KM = (const bf16_t*)(tb + T_KMAT) + (size_t)g * 32 * 256 + (size_t)(15 - (qd >> 1)) * 256 + r * 16 + 8 * (qd & 1);
        const bf16_t* FT = (const bf16_t*)(tb + T_F) + (size_t)g * 256 * 128 + (size_t)r * 128 + 8 * qd;
        const bf16_t* up = z + (size_t)(tok0 + 16 * r) * ZW + ZSU + 16 * g + 4 * qd;
        const float4 dsk = *(const float4*)(P.in[I_SD] + l * 256 + g * 16 + 4 * qd);
        bf16x8 kf[2][8], ff[2][4]; u32x2 uw[2];
#pragma unroll
        for (int ks = 0; ks < 8; ++ks) kf[0][ks] = *(const bf16x8*)(KM + (ptrdiff_t)(0 - 2 * ks) * 256);
#pragma unroll
        for (int ks = 0; ks < 4; ++ks) ff[0][ks] = *(const bf16x8*)(FT + 32 * ks);
        uw[0] = *(const u32x2*)up;
#pragma unroll
        for (int t = 0; t < 16; ++t) {
            if (t + 1 < 16) {
#pragma unroll
                for (int ks = 0; ks < 8; ++ks) kf[(t + 1) & 1][ks] = *(const bf16x8*)(KM + (ptrdiff_t)(t + 1 - 2 * ks) * 256);
#pragma unroll
                for (int ks = 0; ks < 4; ++ks) ff[(t + 1) & 1][ks] = *(const bf16x8*)(FT + (size_t)(t + 1) * 16 * 128 + 32 * ks);
                uw[(t + 1) & 1] = *(const u32x2*)(up + (size_t)(t + 1) * ZW); }
            f32x4 acc = {0.f, 0.f, 0.f, 0.f};
#pragma unroll
            for (int ks = 0; ks < 8; ++ks) if (2 * ks <= t) acc = mfma16(kf[t & 1][ks], uf[ks], acc);
#pragma unroll
            for (int ks = 0; ks < 4; ++ks) acc = mfma16(ff[t & 1][ks], xf[ks], acc);
            const u32x2 uu = uw[t & 1];
            const float y0 = gelu_tanh(acc[0] + dsk.x * ml::bf_lo(uu.x)), y1 = gelu_tanh(acc[1] + dsk.y * ml::bf_hi(uu.x)), y2 = gelu_tanh(acc[2] + dsk.z * ml::bf_lo(uu.y)), y3 = gelu_tanh(acc[3] + dsk.w * ml::bf_hi(uu.y));
            u32x2 o; o.x = pg8::cvt_pk_bf16(y0, y1); o.y = pg8::cvt_pk_bf16(y2, y3);
            *(LAS u32x2*)(lds + (16 * r + t) * YP + (16 * g + 4 * qd) * 2) = o; }
    }
    __syncthreads();
    const bf16_t* GW = (const bf16_t*)(tb + T_GLUW);
    bf16x8 wf[2][8];
#pragma unroll
    for (int nt = 0; nt < 2; ++nt)
#pragma unroll
        for (int ks = 0; ks < 8; ++ks) wf[nt][ks] = *(const bf16x8*)(GW + (size_t)(32 * wid + 16 * nt + r) * 256 + 32 * ks + 8 * qd);
    const float* gb = P.in[I_GLUB] + l * 256;
    const float4 gb0 = *(const float4*)(gb + 32 * wid + 4 * qd), gb1 = *(const float4*)(gb + 32 * wid + 16 + 4 * qd);
#pragma unroll 2
    for (int mt = 0; mt < 16; ++mt) {
        f32x4 a0 = {0.f, 0.f, 0.f, 0.f}, a1 = {0.f, 0.f, 0.f, 0.f};
#pragma unroll
        for (int ks = 0; ks < 8; ++ks) { const bf16x8 yf = *(const LAS bf16x8*)(lds + (16 * mt + r) * YP + (32 * ks + 8 * qd) * 2); a0 = mfma16(wf[0][ks], yf, a0); a1 = mfma16(wf[1][ks], yf, a1); }
        const int row = 16 * mt + r;
        const u32x2 y0 = *(const LAS u32x2*)(lds + row * YP + (32 * wid + 4 * qd) * 2), y1 = *(const LAS u32x2*)(lds + row * YP + (32 * wid + 16 + 4 * qd) * 2);
        bf16_t* op = mix + (size_t)(tok0 + row) * D + 256 + 32 * wid + 4 * qd;
        u32x2 o;
        o.x = pg8::cvt_pk_bf16(ml::bf_lo(y0.x) / (1.f + __expf(-(a0[0] + gb0.x))), ml::bf_hi(y0.x) / (1.f + __expf(-(a0[1] + gb0.y))));
        o.y = pg8::cvt_pk_bf16(ml::bf_lo(y0.y) / (1.f + __expf(-(a0[2] + gb0.z))), ml::bf_hi(y0.y) / (1.f + __expf(-(a0[3] + gb0.w))));
        *(u32x2*)op = o;
        o.x = pg8::cvt_pk_bf16(ml::bf_lo(y1.x) / (1.f + __expf(-(a1[0] + gb1.x))), ml::bf_hi(y1.x) / (1.f + __expf(-(a1[1] + gb1.y))));
        o.y = pg8::cvt_pk_bf16(ml::bf_lo(y1.y) / (1.f + __expf(-(a1[2] + gb1.z))), ml::bf_hi(y1.y) / (1.f + __expf(-(a1[3] + gb1.w))));
        *(u32x2*)(op + 16) = o;
    }
}
static_assert(T_LAYER <= 4 * MiB && O_END <= 48 * MiB && 256 * YP <= LDS_BYTES - 64, "S5 scratch fits");
}
__device__ __forceinline__ void s5_build_tables_fwd(float* ldsf, const Params& P, int l, int g, unsigned char* tb) { s5::build_tables(ldsf, P, l, g, tb); }

namespace at {
using pg8::bf16x8; using pg8::f32x4; using pg8::u32x4; using pg8::u32x2;
constexpr int KP = 144, VP = 528, OFF_K = 0, OFF_VT = 256 * KP, LDS_END = OFF_VT + 64 * VP;
__device__ __forceinline__ void unit(LAS unsigned char* lds, const bf16_t* z, const float* sinks, bf16_t* mix, int u) {
    const int tid = tid_opaque(), lane = tid & 63, wid = __builtin_amdgcn_readfirstlane(tid >> 6), r = lane & 15, qd = lane >> 4;
    const int b = u >> 7, g = (u >> 6) & 1, n = u & 63, tokb = b * S + 128 * n;
    __syncthreads();
#pragma unroll
    for (int it = 0; it < 4; ++it) { const int idx = tid + it * NTHREADS, kl = idx >> 3, cg = idx & 7; const bool ok = (n > 0) || (kl >= 128);
        u32x4 w = *(const u32x4*)(z + (size_t)(ok ? tokb - 128 + kl : tokb) * ZW + ZK + g * 64 + cg * 8); if (!ok) w = (u32x4){0u, 0u, 0u, 0u};
        *(LAS u32x4*)(lds + OFF_K + kl * KP + cg * 16) = w; }
#pragma unroll
    for (int it = 0; it < 4; ++it) { const int idx = tid + it * NTHREADS, kl = idx & 255, cg = idx >> 8; const bool ok = (n > 0) || (kl >= 128);
        u32x4 w = *(const u32x4*)(z + (size_t)(ok ? tokb - 128 + kl : tokb) * ZW + ZV + g * 64 + cg * 8); if (!ok) w = (u32x4){0u, 0u, 0u, 0u};
        const unsigned ww[4] = {w.x, w.y, w.z, w.w};
#pragma unroll
        for (int e = 0; e < 8; ++e) *(LAS unsigned short*)(lds + OFF_VT + (cg * 8 + e) * VP + kl * 2) = (unsigned short)((e & 1) ? (ww[e >> 1] >> 16) : (ww[e >> 1] & 0xffffu)); }
    __syncthreads();
    const int hq = 2 * g + (wid >> 2);
    const float sink = sinks[hq];
#pragma unroll 1
    for (int qt = 0; qt < 2; ++qt) {
        const int i0 = (wid & 3) * 32 + qt * 16, kt0 = i0 >> 4, tok = tokb + i0 + r;
        const bf16x8 bq0 = *(const bf16x8*)(z + (size_t)tok * ZW + ZQ + hq * 64 + 8 * qd), bq1 = *(const bf16x8*)(z + (size_t)tok * ZW + ZQ + hq * 64 + 32 + 8 * qd);
        f32x4 accS[9];
#pragma unroll
        for (int c = 0; c < 9; ++c) { const int kt = kt0 + c;
            const bf16x8 a0 = *(const LAS bf16x8*)(lds + OFF_K + (16 * kt + r) * KP + qd * 16), a1 = *(const LAS bf16x8*)(lds + OFF_K + (16 * kt + r) * KP + 64 + qd * 16);
            accS[c] = ml::mfma16(a0, bq0, (f32x4){0.f, 0.f, 0.f, 0.f}); accS[c] = ml::mfma16(a1, bq1, accS[c]); }
        float m = sink;
#pragma unroll
        for (int c = 0; c < 9; ++c)
#pragma unroll
            for (int j = 0; j < 4; ++j) { const int e = 4 * qd + j;
                bool valid = (c == 0) ? (e > r) : ((c == 8) ? (e <= r) : true);
                valid = valid && ((n > 0) || (kt0 + c >= 8));
                const float s = valid ? accS[c][j] * 0.125f : -3.0e38f; accS[c][j] = s; m = fmaxf(m, s); }
        m = fmaxf(m, __shfl_xor(m, 16)); m = fmaxf(m, __shfl_xor(m, 32));
        float l = 0.f;
#pragma unroll
        for (int c = 0; c < 9; ++c)
#pragma unroll
            for (int j = 0; j < 4; ++j) { const float p = __expf(accS[c][j] - m); accS[c][j] = p; l += p; }
        l += __shfl_xor(l, 16); l += __shfl_xor(l, 32);
        l += __expf(sink - m);
        f32x4 accO[4];
#pragma unroll
        for (int dt = 0; dt < 4; ++dt) accO[dt] = (f32x4){0.f, 0.f, 0.f, 0.f};
#pragma unroll
        for (int kk = 0; kk < 5; ++kk) {
            u32x4 pw; pw.x = pg8::cvt_pk_bf16(accS[2 * kk][0], accS[2 * kk][1]); pw.y = pg8::cvt_pk_bf16(accS[2 * kk][2], accS[2 * kk][3]);
            if (kk < 4) { pw.z = pg8::cvt_pk_bf16(accS[2 * kk + 1][0], accS[2 * kk + 1][1]); pw.w = pg8::cvt_pk_bf16(accS[2 * kk + 1][2], accS[2 * kk + 1][3]); } else { pw.z = 0u; pw.w = 0u; }
            const bf16x8 pf = __builtin_bit_cast(bf16x8, pw);
            const int base = 16 * (kt0 + 2 * kk);
#pragma unroll
            for (int dt = 0; dt < 4; ++dt) { const u32x2 v0 = *(const LAS u32x2*)(lds + OFF_VT + (16 * dt + r) * VP + (base + 4 * qd) * 2);
                u32x2 v1 = {0u, 0u}; if (kk < 4) v1 = *(const LAS u32x2*)(lds + OFF_VT + (16 * dt + r) * VP + (base + 16 + 4 * qd) * 2);
                u32x4 vw; vw.x = v0.x; vw.y = v0.y; vw.z = v1.x; vw.w = v1.y;
                accO[dt] = ml::mfma16(__builtin_bit_cast(bf16x8, vw), pf, accO[dt]); } }
        const float inv = 1.f / l;
        bf16_t* op = mix + (size_t)tok * D + hq * 64;
#pragma unroll
        for (int dt = 0; dt < 4; ++dt) { u32x2 o; o.x = pg8::cvt_pk_bf16(accO[dt][0] * inv, accO[dt][1] * inv); o.y = pg8::cvt_pk_bf16(accO[dt][2] * inv, accO[dt][3] * inv);
            *(u32x2*)(op + 16 * dt + 4 * qd) = o; }
    }
}
}

namespace sg {
using pg8::bf16x8; using pg8::f32x4; using pg8::u32x4; using pg8::u32x2;
constexpr int TP = 272, OFF_VT = 0, OFF_ST = 256 * TP, LDS_END = OFF_ST + 128 * 4 * 2 * 4;
__device__ __forceinline__ void unit(LAS unsigned char* lds, const bf16_t* z, const Params& P, int l, const bf16_t* wb  , bf16_t* mix, int u) {
    const int tid = tid_opaque(), lane = tid & 63, wid = __builtin_amdgcn_readfirstlane(tid >> 6), r = lane & 15, qd = lane >> 4;
    const int tok0 = u * 128;
    LAS float* ST = (LAS float*)(lds + OFF_ST);
    __syncthreads();
    const int s = tid & 127, cq = tid >> 7;
    const bf16_t* gp = z + (size_t)(tok0 + s) * ZW + ZGV + cq * 64;
    float sm = 0.f, sq = 0.f;
#pragma unroll 2
    for (int i = 0; i < 8; ++i) { float v[8]; ld8(gp + 8 * i, v);
#pragma unroll
        for (int e = 0; e < 8; ++e) { const float ge = gelu_tanh(v[e]); sm += ge; sq += ge * ge; } }
    ST[(s * 4 + cq) * 2] = sm; ST[(s * 4 + cq) * 2 + 1] = sq;
    __syncthreads();
    { float tsm = 0.f, tsq = 0.f;
#pragma unroll
      for (int q = 0; q < 4; ++q) { tsm += ST[(s * 4 + q) * 2]; tsq += ST[(s * 4 + q) * 2 + 1]; }
      const float mu = tsm * (1.f / 256.f), var = fmaxf(tsq * (1.f / 256.f) - mu * mu, 0.f), rs = rsqrtf(var + EPS);
      const float* lg = P.in[I_LNG] + l * 256 + cq * 64; const float* lb = P.in[I_LNB] + l * 256 + cq * 64;
#pragma unroll 1
      for (int i = 0; i < 8; ++i) { float v[8]; ld8(gp + 8 * i, v);
          const float4 g0 = *(const float4*)(lg + 8 * i), g1 = *(const float4*)(lg + 8 * i + 4), b0 = *(const float4*)(lb + 8 * i), b1 = *(const float4*)(lb + 8 * i + 4);
          const float gg[8] = {g0.x, g0.y, g0.z, g0.w, g1.x, g1.y, g1.z, g1.w}, bb[8] = {b0.x, b0.y, b0.z, b0.w, b1.x, b1.y, b1.z, b1.w};
#pragma unroll
          for (int e = 0; e < 8; ++e) *(LAS unsigned short*)(lds + OFF_VT + (cq * 64 + 8 * i + e) * TP + s * 2) = ml::bf1((gelu_tanh(v[e]) - mu) * rs * gg[e] + bb[e]); } }
    __syncthreads();
    const int t = 16 * wid + r;
#pragma unroll 1
    for (int g = 0; g < 4; ++g) {
        bf16x8 wf[4];
#pragma unroll
        for (int ks = 0; ks < 4; ++ks) wf[ks] = *(const bf16x8*)(wb + ((size_t)g * 128 + t) * 128 + 32 * ks + 8 * qd);
        const float bias = P.in[I_SGUB][l * 512 + g * 128 + t];
#pragma unroll
        for (int ct = 0; ct < 4; ++ct) { f32x4 acc = {0.f, 0.f, 0.f, 0.f};
#pragma unroll
            for (int ks = 0; ks < 4; ++ks) if (2 * ks <= wid) acc = ml::mfma16(*(const LAS bf16x8*)(lds + OFF_VT + (g * 64 + 16 * ct + r) * TP + (32 * ks + 8 * qd) * 2), wf[ks], acc);
            const int c0 = g * 64 + 16 * ct + 4 * qd;
            const u32x2 gw = *(const u32x2*)(z + (size_t)(tok0 + t) * ZW + ZGU + c0);
            u32x2 o; o.x = pg8::cvt_pk_bf16(gelu_tanh(bfl(gw.x)) * (acc[0] + bias), gelu_tanh(bfh(gw.x)) * (acc[1] + bias)); o.y = pg8::cvt_pk_bf16(gelu_tanh(bfl(gw.y)) * (acc[2] + bias), gelu_tanh(bfh(gw.y)) * (acc[3] + bias));
            *(u32x2*)(mix + (size_t)(tok0 + t) * D + 768 + c0) = o; }
    }
}
}

__device__ __forceinline__ void ph_mix1(float* lds, const Params& P, int l, bf16_t* z, const float* gates, bf16_t* mix, unsigned char* wsm, unsigned char* wss, const unsigned char* tb, int sub) {
    const int G = gridDim.x, bid = blockIdx.x;
    if (sub & 1) for (int u = bid; u < ml::NU; u += G) ml::p1_unit((LAS unsigned char*)lds, z, gates, P, l, u, wsm);
    __syncthreads();
    if (sub & 2) for (int u = bid; u < NTOK / 256; u += G) s5::p1_unit(z, tb, u, wss);
    __syncthreads();
    if (sub & 4) for (int u = bid; u < 1024; u += G) at::unit((LAS unsigned char*)lds, z, P.in[I_SINK] + l * 4, mix, u);
    __syncthreads();
    if (sub & 8) for (int u = bid; u < NTOK / 128; u += G) sg::unit((LAS unsigned char*)lds, z, P, l, (const bf16_t*)(tb + s5::T_SGUW), mix, u);
    __syncthreads();
}

__device__ __forceinline__ void ph_mix2(float* lds, const Params& P, int l, const bf16_t* z, const float* gates, bf16_t* mix, const unsigned char* wsm, const unsigned char* wss, const unsigned char* tb, int sub) {
    if (sub & 1) for (int u = blockIdx.x; u < NTOK / 256; u += gridDim.x) s5::p3_unit((LAS unsigned char*)lds, z, P, l, tb, u, wss, mix);
    __syncthreads();
    if (sub & 2) for (int u = blockIdx.x; u < ml::NU; u += gridDim.x) ml::p3_unit((LAS unsigned char*)lds, z, gates, P, l, u, wsm, mix);
    __syncthreads();
}

__device__ __forceinline__ void ph_outproj(LAS unsigned char* ldsb, const bf16_t* mix, const bf16_t* wt, const float* xsrc, float* xout) {
    pg8::StaticOrder S; S.init(NTOK, D, D, D, gridDim.x, blockIdx.x, mix, wt);
    pg8::EpiRes E{xsrc, xout};
    pg8::gemm_phase<pg8::EpiRes, pg8::StaticOrder, false>(ldsb, D, D, S, E);
}

namespace rp {
using pg8::bf16x8; using pg8::f32x4; using pg8::u32x4;
constexpr size_t T_HI = 0, T_LO = (size_t)48 * D * 2, T_GHI = 2 * T_LO, T_GLO = T_GHI + (size_t)16 * D * 2, T_SIZE = T_GLO + (size_t)16 * D * 2;
static_assert(T_SIZE <= 256 * 1024, "row-pass tables fit their slot");
template <int NT, bool COMBINE> struct StepIn { float4 xa[2], xb[2]; u32x4 y1[2], y2[2]; float4 g0, g1; };
template <int NT> struct StepW { bf16x8 wh[NT], wl[NT]; };
__device__ __forceinline__ void build_base(LAS int* base, const unsigned* cnt) {
    __syncthreads();
    if (tid_opaque() == 0) { int b = 0; for (int e = 0; e < NEXP; ++e) { base[e] = b; b += (((int)cnt[e] + 255) >> 8) << 8; } }
    __syncthreads();
}
template <int NT, bool COMBINE>
__device__ __forceinline__ void run(LAS unsigned char* lds, const Params& P, int l, const float* x, float* xo, const bf16_t* YB, const unsigned* inv, const unsigned* cntprev,
                                    const float* gn, const bf16_t* WH, const bf16_t* WL, bf16_t* XN, float* RS, float* gates, unsigned* cnt, int2* lists, unsigned* invout) {
    const int tid = tid_opaque(), lane = tid & 63, wid = __builtin_amdgcn_readfirstlane(tid >> 6), r = lane & 15, qd = lane >> 4;
    LAS int* BASE = (LAS int*)(lds + 64 * 1024);
    LAS float* LG = (LAS float*)lds + wid * (32 * 49);
    if (COMBINE) build_base(BASE, cntprev);
    LAS unsigned* LCNT = (LAS unsigned*)(lds + 64 * 1024 + 256); LAS unsigned* GBASE = LCNT + 32;
    for (int rb0 = blockIdx.x * 8; rb0 < NTOK / 32; rb0 += gridDim.x * 8) {
        const int rb = rb0 + wid; const bool live = rb < NTOK / 32;
        const int row0 = (live ? rb : rb0) * 32;
        if (NT == 1 && !live) continue;
        size_t yr1[2] = {0, 0}, yr2[2] = {0, 0};
        if (COMBINE) {
#pragma unroll
            for (int mt = 0; mt < 2; ++mt) { const int row = row0 + 16 * mt + r; const unsigned i1 = inv[2 * row], i2 = inv[2 * row + 1];
                yr1[mt] = (size_t)(BASE[i1 >> 16] + (int)(i1 & 0xffffu)) * D; yr2[mt] = (size_t)(BASE[i2 >> 16] + (int)(i2 & 0xffffu)) * D; } }
        f32x4 acc[2][NT];
#pragma unroll
        for (int mt = 0; mt < 2; ++mt)
#pragma unroll
            for (int nt = 0; nt < NT; ++nt) acc[mt][nt] = (f32x4){0.f, 0.f, 0.f, 0.f};
        float ssq[2] = {0.f, 0.f};
        StepIn<NT, COMBINE> sb[3]; StepW<NT> sw[2];
        auto load = [&](StepIn<NT, COMBINE>& s, int ks) {
            const int k0 = 32 * ks + 8 * qd;
#pragma unroll
            for (int mt = 0; mt < 2; ++mt) { const float* xp = x + (size_t)(row0 + 16 * mt + r) * D + k0; s.xa[mt] = *(const float4*)xp; s.xb[mt] = *(const float4*)(xp + 4);
                if (COMBINE) { s.y1[mt] = *(const u32x4*)(YB + yr1[mt] + k0); s.y2[mt] = *(const u32x4*)(YB + yr2[mt] + k0); } }
            s.g0 = *(const float4*)(gn + k0); s.g1 = *(const float4*)(gn + k0 + 4);
        };
        auto loadw = [&](StepW<NT>& s, int ks) {
            const int k0 = 32 * ks + 8 * qd;
#pragma unroll
            for (int nt = 0; nt < NT; ++nt) { s.wh[nt] = *(const bf16x8*)(WH + (size_t)(16 * nt + r) * D + k0); s.wl[nt] = *(const bf16x8*)(WL + (size_t)(16 * nt + r) * D + k0); }
        };
        auto process = [&](const StepIn<NT, COMBINE>& s, const StepW<NT>& sw_, int ks) {
            const int k0 = 32 * ks + 8 * qd;
            bf16x8 xh[2], xl[2];
#pragma unroll
            for (int mt = 0; mt < 2; ++mt) { float4 a = s.xa[mt], b = s.xb[mt];
                if (COMBINE) { const u32x4 p = s.y1[mt], q = s.y2[mt];
                    a.x += bfl(p.x) + bfl(q.x); a.y += bfh(p.x) + bfh(q.x); a.z += bfl(p.y) + bfl(q.y); a.w += bfh(p.y) + bfh(q.y);
                    b.x += bfl(p.z) + bfl(q.z); b.y += bfh(p.z) + bfh(q.z); b.z += bfl(p.w) + bfl(q.w); b.w += bfh(p.w) + bfh(q.w);
                    float* op = xo + (size_t)(row0 + 16 * mt + r) * D + k0; *(float4*)op = a; *(float4*)(op + 4) = b; }
                ssq[mt] += a.x * a.x + a.y * a.y + a.z * a.z + a.w * a.w + b.x * b.x + b.y * b.y + b.z * b.z + b.w * b.w;
                const float v[8] = {a.x * s.g0.x, a.y * s.g0.y, a.z * s.g0.z, a.w * s.g0.w, b.x * s.g1.x, b.y * s.g1.y, b.z * s.g1.z, b.w * s.g1.w};
                u32x4 h; h.x = pg8::cvt_pk_bf16(v[0], v[1]); h.y = pg8::cvt_pk_bf16(v[2], v[3]); h.z = pg8::cvt_pk_bf16(v[4], v[5]); h.w = pg8::cvt_pk_bf16(v[6], v[7]);
                *(u32x4*)(XN + (size_t)(row0 + 16 * mt + r) * D + k0) = h;
                u32x4 lo; lo.x = pg8::cvt_pk_bf16(v[0] - bfl(h.x), v[1] - bfh(h.x)); lo.y = pg8::cvt_pk_bf16(v[2] - bfl(h.y), v[3] - bfh(h.y)); lo.z = pg8::cvt_pk_bf16(v[4] - bfl(h.z), v[5] - bfh(h.z)); lo.w = pg8::cvt_pk_bf16(v[6] - bfl(h.w), v[7] - bfh(h.w));
                xh[mt] = __builtin_bit_cast(bf16x8, h); xl[mt] = __builtin_bit_cast(bf16x8, lo); }
#pragma unroll
            for (int nt = 0; nt < NT; ++nt)
#pragma unroll
                for (int mt = 0; mt < 2; ++mt) { acc[mt][nt] = ml::mfma16(sw_.wh[nt], xh[mt], acc[mt][nt]); acc[mt][nt] = ml::mfma16(sw_.wl[nt], xh[mt], acc[mt][nt]); acc[mt][nt] = ml::mfma16(sw_.wh[nt], xl[mt], acc[mt][nt]); }
        };
        if (COMBINE || NT > 1) {
            load(sb[0], 0); loadw(sw[0], 0);
#pragma unroll 1
            for (int ks = 0; ks < 32; ks += 2) {
                load(sb[1], ks + 1); loadw(sw[1], ks + 1);
                process(sb[0], sw[0], ks);
                if (ks + 2 < 32) { load(sb[0], ks + 2); loadw(sw[0], ks + 2); }
                process(sb[1], sw[1], ks + 1);
            }
        } else {
            load(sb[0], 0); load(sb[1], 1); loadw(sw[0], 0);
#define RP_STEP(i, xs, ws) do { if ((i) + 2 < 32) load(sb[((xs) + 2) % 3], (i) + 2); if ((i) + 1 < 32) loadw(sw[((ws) + 1) % 2], (i) + 1); process(sb[xs], sw[ws], (i)); } while (0)
#pragma unroll 1
            for (int ks = 0; ks < 30; ks += 6) { RP_STEP(ks, 0, 0); RP_STEP(ks + 1, 1, 1); RP_STEP(ks + 2, 2, 0); RP_STEP(ks + 3, 0, 1); RP_STEP(ks + 4, 1, 0); RP_STEP(ks + 5, 2, 1); }
            RP_STEP(30, 0, 0); RP_STEP(31, 1, 1);
#undef RP_STEP
        }
        float rsv[2];
#pragma unroll
        for (int mt = 0; mt < 2; ++mt) { float s = ssq[mt]; s += __shfl_xor(s, 16); s += __shfl_xor(s, 32); rsv[mt] = rsqrtf(s * (1.f / D) + EPS);
            if (qd == 0) RS[row0 + 16 * mt + r] = rsv[mt]; }
        if (NT == 1) {
#pragma unroll
            for (int mt = 0; mt < 2; ++mt) if (qd < 2) { const f32x4 gv = acc[mt][0] * rsv[mt]; *(f32x4*)(gates + (size_t)(row0 + 16 * mt + r) * 8 + 4 * qd) = gv; }
        } else {
            const float* bg = P.in[I_RGB] + l * 4; const float* be = P.in[I_REB] + l * 32;
#pragma unroll
            for (int mt = 0; mt < 2; ++mt)
#pragma unroll
                for (int nt = 0; nt < NT; ++nt)
#pragma unroll
                    for (int j = 0; j < 4; ++j) LG[(16 * mt + r) * 49 + 16 * nt + 4 * qd + j] = acc[mt][nt][j] * rsv[mt];
            wave_lds_fence();
            if (tid < 32) LCNT[tid] = 0u;
            __syncthreads();
            int ex1 = 0, ex2 = 0; float w1 = 0.f, w2 = 0.f; unsigned lp1 = 0u, lp2 = 0u;
            if (lane < 32 && live) {
                const LAS float* lg = LG + lane * 49;
                float gl[4];
#pragma unroll
                for (int j = 0; j < 4; ++j) gl[j] = lg[j] + bg[j];
                int sel = 0; float gm = gl[0];
#pragma unroll
                for (int j = 1; j < 4; ++j) if (gl[j] > gm) { gm = gl[j]; sel = j; }
                float gs = 0.f;
#pragma unroll
                for (int j = 0; j < 4; ++j) gs += expf(gl[j] - gm);
                const float pg = 1.f / gs;
                float ein[8];
#pragma unroll
                for (int j = 0; j < 8; ++j) ein[j] = lg[4 + sel * 8 + j] + be[sel * 8 + j];
                int i1 = 0; float v1 = ein[0];
#pragma unroll
                for (int j = 1; j < 8; ++j) if (ein[j] > v1) { v1 = ein[j]; i1 = j; }
                int i2 = -1; float v2 = -3.0e38f;
#pragma unroll
                for (int j = 0; j < 8; ++j) if (j != i1 && ein[j] > v2) { v2 = ein[j]; i2 = j; }
                const float e2 = expf(v2 - v1), den = 1.f / (1.f + e2);
                w1 = den * pg; w2 = e2 * den * pg;
                ex1 = sel * 8 + i1; ex2 = sel * 8 + i2;
                lp1 = atomicAdd((unsigned*)&LCNT[ex1], 1u); lp2 = atomicAdd((unsigned*)&LCNT[ex2], 1u);
            }
            __syncthreads();
            if (tid < 32) { const unsigned c = LCNT[tid]; GBASE[tid] = c ? atomicAdd(&cnt[tid], c) : 0u; }
            __syncthreads();
            if (lane < 32 && live) { const int row = row0 + lane; const unsigned p1 = GBASE[ex1] + lp1, p2 = GBASE[ex2] + lp2;
                lists[(size_t)ex1 * NTOK + p1] = make_int2(row, __float_as_int(w1));
                lists[(size_t)ex2 * NTOK + p2] = make_int2(row, __float_as_int(w2));
                invout[2 * row] = ((unsigned)ex1 << 16) | p1; invout[2 * row + 1] = ((unsigned)ex2 << 16) | p2; }
        }
    }
}
__device__ __forceinline__ void final_norm(LAS unsigned char* lds, float* xo, const bf16_t* YB, const unsigned* inv, const unsigned* cntprev, const float* g) {
    const int tid = tid_opaque(), wave = tid >> 6, lane = tid & 63;
    LAS int* BASE = (LAS int*)(lds + 64 * 1024);
    build_base(BASE, cntprev);
    const float4* g4 = (const float4*)g;
    for (int r = blockIdx.x * 8 + wave; r < NTOK; r += gridDim.x * 8) {
        const unsigned i1 = inv[2 * r], i2 = inv[2 * r + 1];
        const bf16_t* y1 = YB + (size_t)(BASE[i1 >> 16] + (int)(i1 & 0xffffu)) * D; const bf16_t* y2 = YB + (size_t)(BASE[i2 >> 16] + (int)(i2 & 0xffffu)) * D;
        float4* p = (float4*)(xo + (size_t)r * D);
        float4 v[4]; float ss = 0.f;
#pragma unroll
        for (int i = 0; i < 4; ++i) { v[i] = p[lane + 64 * i]; const u32x2_t a = *((const u32x2_t*)y1 + lane + 64 * i), b = *((const u32x2_t*)y2 + lane + 64 * i);
            v[i].x += bfl(a.x) + bfl(b.x); v[i].y += bfh(a.x) + bfh(b.x); v[i].z += bfl(a.y) + bfl(b.y); v[i].w += bfh(a.y) + bfh(b.y);
            ss += v[i].x * v[i].x + v[i].y * v[i].y + v[i].z * v[i].z + v[i].w * v[i].w; }
        ss = wave_sum(ss);
        const float rs = rsqrtf(ss * (1.f / D) + EPS);
#pragma unroll
        for (int i = 0; i < 4; ++i) { const float4 gg = g4[lane + 64 * i]; float4 o; o.x = v[i].x * rs * gg.x; o.y = v[i].y * rs * gg.y; o.z = v[i].z * rs * gg.z; o.w = v[i].w * rs * gg.w; p[lane + 64 * i] = o; }
    }
}
}

__device__ __forceinline__ int moe_build_tab(LAS unsigned char* ldsb, const unsigned* cnt) {
    LAS pg8::i32x4* tab = (LAS pg8::i32x4*)(ldsb + TAB_OFF);
    __syncthreads();
    int base = 0;
#pragma unroll 1
    for (int e = 0; e < NEXP; ++e) { const int c = __builtin_amdgcn_readfirstlane((int)cnt[e]), nt = (c + 255) >> 8;
        if ((int)tid_opaque() < nt) tab[base + tid_opaque()] = (pg8::i32x4){e, (int)tid_opaque() * 256, c, 0};
        base += nt; }
    __syncthreads();
    return base;
}
__device__ __forceinline__ void ph_moe1(LAS unsigned char* ldsb, const Params& P, int l, const bf16_t* H, const unsigned* cnt, const int2* lists, bf16_t* act) {
    const int ntiles = moe_build_tab(ldsb, cnt);
    pg8::MoeOrder S; S.tab = (const LAS pg8::i32x4*)(ldsb + TAB_OFF); S.ntiles = ntiles; S.npn = 4; S.G = gridDim.x; S.c = blockIdx.x;
    S.A = (const char*)H; S.atile = 0; S.Bt = (const char*)(P.ws + WS_WGU) + (size_t)l * NEXP * 1024 * D * 2; S.bexp = (size_t)1024 * D * 2; S.btile = (size_t)256 * D * 2; S.lists = lists;
    pg8::EpiAct E{act, lists, (const float*)(P.ws + WS_RS)};
    pg8::gemm_phase<pg8::EpiAct, pg8::MoeOrder, true>(ldsb, D, D, S, E);
}
__device__ __forceinline__ void ph_moe2(LAS unsigned char* ldsb, const Params& P, int l, const bf16_t* act, const unsigned* cnt, const int2* lists, bf16_t* yb) {
    const int ntiles = moe_build_tab(ldsb, cnt);
    pg8::MoeOrder S; S.tab = (const LAS pg8::i32x4*)(ldsb + TAB_OFF); S.ntiles = ntiles; S.npn = 4; S.G = gridDim.x; S.c = blockIdx.x;
    S.A = (const char*)act; S.atile = (size_t)256 * DE * 2; S.Bt = (const char*)(P.ws + WS_WD) + (size_t)l * NEXP * D * DE * 2; S.bexp = (size_t)D * DE * 2; S.btile = (size_t)256 * DE * 2; S.lists = lists;
    pg8::EpiY E{yb, lists};
    pg8::gemm_phase<pg8::EpiY, pg8::MoeOrder, false>(ldsb, DE, DE, S, E);
}

#ifndef PROBE_PH
#define PROBE_PH -1
#endif
#ifndef PROBE_SUB
#define PROBE_SUB 15
#endif
#ifndef PROBE_REPS
#define PROBE_REPS 4
#endif
__global__ void __launch_bounds__(NTHREADS, 2) fwd_kernel(Params P) {
    extern __shared__ __attribute__((aligned(16))) unsigned char lds_raw[];
    float* lds = (float*)lds_raw;
    volatile LAS unsigned* xbw = (volatile LAS unsigned*)(lds_raw + LDS_BYTES - 16);
    if (threadIdx.x == 0) { xbw[0] = 0u; xbw[1] = 0u; }
    __syncthreads();
    unsigned char* const ws = P.ws;
    unsigned* ctl = (unsigned*)(ws + WS_CTL);
    const bool multi = (P.ph_hi - P.ph_lo) > 1;
    XcdBarrier bar; bar.bar = ctl; bar.x = 0; bar.st = xbw;
    if (multi) bar = xcd_barrier_post(ctl, xbw);
    bf16_t* z = (bf16_t*)(ws + WS_Z); float* gates = (float*)(ws + WS_GATES); unsigned char* wss = ws + WS_S5; bf16_t* mix = (bf16_t*)(ws + WS_MIX); unsigned char* wsm = ws + WS_HRAW;
    bf16_t* H = (bf16_t*)(ws + WS_H); bf16_t* act = (bf16_t*)(ws + WS_ACT); bf16_t* yb = (bf16_t*)(ws + WS_YB); float* rsb = (float*)(ws + WS_RS);
    int2* lists = (int2*)(ws + WS_LIST);
    LAS unsigned char* ldsb = (LAS unsigned char*)lds_raw;
    const int lo = P.ph_lo, hi = P.ph_hi;
#define IN(k) (lo <= (k) && (k) < hi)
#define SEAM(k) do { if (IN(k) && IN((k) + 1)) xcd_barrier(bar); } while (0)
#if PROBE_PH >= 0
#define RUNPH(k, ...) do { if (IN(k)) { const int nrep = ((k) == PROBE_PH) ? 1 + PROBE_REPS : 1; for (int rep = 0; rep < nrep; ++rep) { __VA_ARGS__; if (rep + 1 < nrep) xcd_barrier(bar); } } SEAM(k); } while (0)
#else
#define RUNPH(k, ...) do { if (IN(k)) { constexpr int rep = 0; (void)rep; __VA_ARGS__; } SEAM(k); } while (0)
#endif
    RUNPH(0, ph_prologue(lds, PF));
    for (int l = 0; l < NLAYER; ++l) {
        const int pb = 1 + l * PH_PER_LAYER;
        unsigned* cnt = ctl + CW_CNT + l * 64;
        const unsigned char* tb = ws + WS_TB + (size_t)l * 4 * MiB;
        const unsigned char* rtb = ws + WS_RT + (size_t)l * 256 * 1024;
        unsigned* inv = (unsigned*)(ws + WS_INV) + (size_t)l * NTOK * 2;
        RUNPH(pb + 0, { const Params& Q = PF;
            if (l == 0) rp::run<1, false>(ldsb, Q, l, Q.in[I_X], nullptr, nullptr, nullptr, nullptr, Q.in[I_NMG] + l * D, (const bf16_t*)(rtb + rp::T_GHI), (const bf16_t*)(rtb + rp::T_GLO), mix, rsb, gates, nullptr, nullptr, nullptr);
            else        rp::run<1, true >(ldsb, Q, l, Q.out, Q.out, yb, inv - (size_t)NTOK * 2, cnt - 64, Q.in[I_NMG] + l * D, (const bf16_t*)(rtb + rp::T_GHI), (const bf16_t*)(rtb + rp::T_GLO), mix, rsb, gates, nullptr, nullptr, nullptr); });
        RUNPH(pb + 1, ph_inproj(ldsb, mix, (const bf16_t*)(ws + WS_WIN) + (size_t)l * NMAIN * D, z, rsb, (rep > 0 && PROBE_SUB <= 3) ? PROBE_SUB : 0));
        RUNPH(pb + 2, ph_mix1(lds, PF, l, z, gates, mix, wsm, wss, tb, rep == 0 ? 15 : PROBE_SUB));
        RUNPH(pb + 3, { s5::p2_scan(ldsb, tb, wss); ml::p2_scan(wsm); });
        RUNPH(pb + 4, ph_mix2(lds, PF, l, z, gates, mix, wsm, wss, tb, rep == 0 ? 15 : PROBE_SUB));
        RUNPH(pb + 5, { const Params& Q = PF; ph_outproj(ldsb, mix, (const bf16_t*)(ws + WS_WOUT) + (size_t)l * D * D, (l == 0) ? Q.in[I_X] : Q.out, Q.out); });
        RUNPH(pb + 6, { if (rep > 0) { if (blockIdx.x == 0 && threadIdx.x < 64) cnt[threadIdx.x] = 0u; xcd_barrier(bar); }
                        const Params& Q = PF; rp::run<3, false>(ldsb, Q, l, Q.out, nullptr, nullptr, nullptr, nullptr, Q.in[I_NFG] + l * D, (const bf16_t*)(rtb + rp::T_HI), (const bf16_t*)(rtb + rp::T_LO), H, rsb, nullptr, cnt, lists, inv); });
        RUNPH(pb + 7, ph_moe1(ldsb, PF, l, H, cnt, lists, act));
        RUNPH(pb + 8, ph_moe2(ldsb, PF, l, act, cnt, lists, yb));
    }
    RUNPH(1 + NLAYER * PH_PER_LAYER, { const Params& Q = PF; rp::final_norm(ldsb, Q.out, yb, (const unsigned*)(ws + WS_INV) + (size_t)(NLAYER - 1) * NTOK * 2, ctl + CW_CNT + (NLAYER - 1) * 64, Q.in[I_NFIN]); });
#undef RUNPH
#undef IN
#undef SEAM
}

#ifndef N_LAUNCH_MODE
#define N_LAUNCH_MODE 1
#endif
extern "C" void kernel_launch(void* const* d_in, const int* in_sizes, int n_in, void* d_out, int out_size, void* d_ws, size_t ws_size, hipStream_t stream) {
    static int grid = 0;
    if (grid == 0) {
        if (n_in != 31 || out_size != NTOK * D || ws_size < WS_END) { fprintf(stderr, "kernel_launch: unexpected shapes n_in %d out %d ws %zu (need %zu)\n", n_in, out_size, ws_size, (size_t)WS_END); grid = -1; return; }
        int dev = 0, cus = 0, per_cu = 0;
        if (hipGetDevice(&dev) != hipSuccess || hipDeviceGetAttribute(&cus, hipDeviceAttributeMultiprocessorCount, dev) != hipSuccess) { grid = -1; return; }
        if (hipFuncSetAttribute((const void*)fwd_kernel, hipFuncAttributeMaxDynamicSharedMemorySize, LDS_BYTES) != hipSuccess) { fprintf(stderr, "kernel_launch: hipFuncSetAttribute failed\n"); grid = -1; return; }
        if (hipOccupancyMaxActiveBlocksPerMultiprocessor(&per_cu, (const void*)fwd_kernel, NTHREADS, LDS_BYTES) != hipSuccess || per_cu < 1) { fprintf(stderr, "kernel_launch: occupancy query says %d\n", per_cu); }
        (void)hipGetLastError();
        grid = cus;
    }
    if (grid < 0) return;
    (void)hipMemsetAsync((char*)d_ws + WS_CTL, 0, CTL_BYTES, stream);
    Params p{};
    for (int i = 0; i < 31; ++i) p.in[i] = (const float*)d_in[i];
    p.out = (float*)d_out; p.ws = (unsigned char*)d_ws;
#if N_LAUNCH_MODE == 1
    p.ph_lo = 0; p.ph_hi = N_PHASES;
    hipLaunchKernelGGL(fwd_kernel, dim3(grid), dim3(NTHREADS), LDS_BYTES, stream, p);
#else
    for (int ph = 0; ph < N_PHASES; ++ph) { p.ph_lo = ph; p.ph_hi = ph + 1; hipLaunchKernelGGL(fwd_kernel, dim3(grid), dim3(NTHREADS), LDS_BYTES, stream, p); }
#endif
}
```

```cpp
#include <hip/hip_runtime.h>
#include <stdint.h>
#include <stdio.h>

#define LAS __attribute__((address_space(3)))

constexpr int D = 1024, NB = 8, S = 8192, NTOK = NB * S, INW = 2312, NLAYER = 2;
constexpr int NEXP = 32, DE = 512;
constexpr float EPS = 1e-6f;
constexpr int ZW = 2304;
constexpr int ZQ = 0, ZK = 256, ZV = 384, ZSU = 512, ZCQ = 768, ZCK = 1024, ZCV = 1280, ZCO = 1536, ZGU = 1792, ZGV = 2048, WCI = 1536;
#ifndef INPROJ_WGM
#define INPROJ_WGM 8
#endif
constexpr int NTHREADS = 512;
constexpr int LDS_BYTES = 144 * 1024;
constexpr int TAB_OFF = 128 * 1024;
constexpr int PH_PER_LAYER = 9, N_PHASES = 1 + NLAYER * PH_PER_LAYER + 1;
constexpr int NMAIN = 2304;
typedef unsigned short bf16_t;

constexpr size_t MiB = 1u << 20;
constexpr size_t WS_CTL = 0, CTL_BYTES = 1 * MiB;
constexpr size_t WS_Z = WS_CTL + CTL_BYTES;
constexpr size_t Z_BYTES = (size_t)NTOK * ZW * 2;
constexpr size_t WS_H = WS_Z;
constexpr size_t WS_YB = WS_Z;
constexpr int PMAX = 2 * NTOK + NEXP * 256;
static_assert((size_t)PMAX * D * 2 <= Z_BYTES, "YB alias fits");
constexpr size_t WS_MIX = WS_Z + Z_BYTES;
constexpr size_t WS_ACT = WS_MIX;
static_assert((size_t)PMAX * DE * 2 <= (size_t)NTOK * D * 2 + 64 * MiB, "ACT alias fits");
constexpr size_t WS_HRAW = WS_MIX + (size_t)NTOK * D * 2;
constexpr size_t WS_S5 = WS_HRAW + 64 * MiB;
constexpr size_t WS_GATES = WS_S5 + 48 * MiB;
constexpr size_t WS_LIST = WS_GATES + (size_t)NTOK * 8 * 4;
constexpr size_t WS_WIN = WS_LIST + (size_t)NEXP * NTOK * 8;
constexpr size_t WS_WOUT = WS_WIN + (size_t)NLAYER * NMAIN * D * 2;
constexpr size_t WS_WGU = WS_WOUT + (size_t)NLAYER * D * D * 2;
constexpr size_t WS_WD = WS_WGU + (size_t)NLAYER * NEXP * 1024 * D * 2;
constexpr size_t WS_TB = WS_WD + (size_t)NLAYER * NEXP * D * DE * 2;
constexpr size_t WS_RS = WS_TB + (size_t)NLAYER * 4 * MiB;
constexpr size_t WS_RT = WS_RS + (size_t)NTOK * 4;
constexpr size_t WS_INV = WS_RT + (size_t)NLAYER * 256 * 1024;
constexpr size_t WS_END = WS_INV + (size_t)NLAYER * NTOK * 8;
namespace s5 {
constexpr size_t T_KMAT = 0, T_F = T_KMAT + (size_t)16 * 32 * 256 * 2, T_G = T_F + (size_t)16 * 256 * 128 * 2, T_A16 = T_G + (size_t)16 * 128 * 256 * 2,
                 T_GLUW = T_A16 + (size_t)16 * 64 * 8, T_SGUW = T_GLUW + (size_t)256 * 256 * 2, T_LAYER = T_SGUW + (size_t)4 * 128 * 128 * 2;
}
constexpr int CW_Q = 4096;
constexpr int CW_CNT = 8192;

#define XB_TMO      128
#define XB_XCNT(j)  (256  + 64 * (j))
#define XB_XSUB(j)  (1280 + 64 * (j))
#define XB_XGEN(j)  (2304 + 64 * (j))
#define XB_TOP      3328
#define XB_TOPGEN   3392
#define XCD_BAR_WORDS 3456
#define XB_SPIN_CAP (1u << 22)
__device__ __forceinline__ unsigned xb_ld(unsigned* p)              { return __hip_atomic_load(p, __ATOMIC_RELAXED, __HIP_MEMORY_SCOPE_AGENT); }
__device__ __forceinline__ unsigned xb_add(unsigned* p, unsigned v) { return __hip_atomic_fetch_add(p, v, __ATOMIC_RELAXED, __HIP_MEMORY_SCOPE_AGENT); }
__device__ __forceinline__ unsigned xb_xcc_id() { return (unsigned)__builtin_amdgcn_s_getreg((3 << 11) | 20) & 0xFu; }
#define XB_SPIN(cond, bar) do { unsigned _sp = 0; while (cond) { __builtin_amdgcn_s_sleep(1); \
    if ((++_sp & 255u) == 0u) { if (xb_ld(&(bar)[XB_TMO])) break; if (_sp > XB_SPIN_CAP) { atomicAdd(&(bar)[XB_TMO], 1u); break; } } } } while (0)
struct XcdBarrier { unsigned* bar; unsigned x; volatile LAS unsigned* st; };
__device__ __forceinline__ XcdBarrier xcd_barrier_post(unsigned* bar, volatile LAS unsigned* st) {
    XcdBarrier b; b.bar = bar; b.x = xb_xcc_id(); b.st = st;
    if (threadIdx.x == 0) (void)xb_add(&bar[XB_XCNT(b.x)], 1u);
    return b;
}
__device__ __forceinline__ void xcd_barrier_complete(unsigned* bar, unsigned x, unsigned& nloc, unsigned& nx) {
    const unsigned G = gridDim.x * gridDim.y * gridDim.z;
    unsigned sum, cnt, mine, sp = 0u;
    for (;;) {
        sum = 0u; cnt = 0u; mine = 0u;
#pragma unroll
        for (unsigned j = 0; j < 16; ++j) { const unsigned c = xb_ld(&bar[XB_XCNT(j)]); sum += c; cnt += (c > 0u) ? 1u : 0u; mine = (j == x) ? c : mine; }
        if (sum == G) break;
        __builtin_amdgcn_s_sleep(1);
        if ((++sp & 255u) == 0u) { if (xb_ld(&bar[XB_TMO])) break; if (sp > XB_SPIN_CAP) { atomicAdd(&bar[XB_TMO], 1u); break; } }
    }
    nloc = mine > 0u ? mine : 1u; nx = cnt > 0u ? cnt : 1u;
}
__device__ __forceinline__ void xcd_barrier(const XcdBarrier& b) {
    asm volatile("s_waitcnt vmcnt(0)" ::: "memory");
    __syncthreads();
    if (threadIdx.x == 0) {
        unsigned* bar = b.bar;
        __builtin_amdgcn_s_waitcnt(0);
        unsigned nloc = b.st[0], nx = b.st[1];
        if (nloc == 0u) { xcd_barrier_complete(bar, b.x, nloc, nx); b.st[0] = nloc; b.st[1] = nx; }
        const unsigned old = xb_add(&bar[XB_XSUB(b.x)], 1u);
        const unsigned gen = old / nloc;
        if (old + 1u == (gen + 1u) * nloc) {
            __builtin_amdgcn_fence(__ATOMIC_RELEASE, "agent");
            asm volatile("s_waitcnt vmcnt(0)" ::: "memory");
            const unsigned og = xb_add(&bar[XB_TOP], 1u);
            const unsigned tg = og / nx;
            if (og + 1u == (tg + 1u) * nx) xb_add(&bar[XB_TOPGEN], 1u);
            else XB_SPIN(xb_ld(&bar[XB_TOPGEN]) == tg, bar);
            __builtin_amdgcn_fence(__ATOMIC_ACQUIRE, "agent");
            xb_add(&bar[XB_XGEN(b.x)], 1u);
            asm volatile("s_waitcnt vmcnt(0)" ::: "memory");
        } else {
            XB_SPIN(xb_ld(&bar[XB_XGEN(b.x)]) == gen, bar);
            __builtin_amdgcn_fence(__ATOMIC_ACQUIRE, "agent");
            asm volatile("s_waitcnt vmcnt(0)" ::: "memory");
        }
    }
    __syncthreads();
}

__device__ __forceinline__ int tid_opaque() { int t = threadIdx.x; asm volatile("" : "+v"(t)); return t; }
__device__ __forceinline__ float wave_sum(float v) {
#pragma unroll
    for (int o = 32; o > 0; o >>= 1) v += __shfl_xor(v, o);
    return v;
}
__device__ __forceinline__ float gelu_tanh(float x) {
    const float u2 = 1.5957691216057308f * (x + 0.044715f * x * x * x);
    return x * __builtin_amdgcn_rcpf(1.f + __expf(-u2));
}
__device__ __forceinline__ float sigm(float x) { return 1.f / (1.f + expf(-x)); }
__device__ __forceinline__ float bfl(unsigned w) { return __uint_as_float(w << 16); }
__device__ __forceinline__ float bfh(unsigned w) { return __uint_as_float(w & 0xffff0000u); }
typedef unsigned u32x4_t __attribute__((ext_vector_type(4)));
typedef unsigned u32x2_t __attribute__((ext_vector_type(2)));
__device__ __forceinline__ void ld8(const bf16_t* p, float (&o)[8]) { const u32x4_t w = *(const u32x4_t*)p; o[0] = bfl(w.x); o[1] = bfh(w.x); o[2] = bfl(w.y); o[3] = bfh(w.y); o[4] = bfl(w.z); o[5] = bfh(w.z); o[6] = bfl(w.w); o[7] = bfh(w.w); }
__device__ __forceinline__ void wave_lds_fence() {
    __builtin_amdgcn_fence(__ATOMIC_RELEASE, "wavefront"); __builtin_amdgcn_wave_barrier(); __builtin_amdgcn_fence(__ATOMIC_ACQUIRE, "wavefront");
}

struct Params {
    const float* in[31];
    float* out;
    unsigned char* ws;
    int ph_lo, ph_hi;
};
struct Params;
__device__ __forceinline__ const Params* params_fresh() { auto p = __builtin_amdgcn_kernarg_segment_ptr(); asm volatile("" : "+s"(p)); return (const Params*)p; }
#define PF (*params_fresh())
enum { I_X = 0, I_NMG, I_WIN, I_SINK, I_ARE, I_AIM, I_BRE, I_BIM, I_CRE, I_CIM, I_SD, I_LDT, I_GLUW, I_GLUB, I_CONVW, I_GATEB, I_MNG,
       I_LNG, I_LNB, I_SGUW, I_SGUB, I_WOUT, I_NFG, I_RGW, I_RGB, I_REW, I_REB, I_EWG, I_EWU, I_EWD, I_NFIN };

namespace pg8 {
#define PG8_LAS __attribute__((address_space(3)))
typedef short bf16x8 __attribute__((ext_vector_type(8)));
typedef float f32x4 __attribute__((ext_vector_type(4)));
typedef unsigned u32x4 __attribute__((ext_vector_type(4)));
typedef unsigned u32x2 __attribute__((ext_vector_type(2)));
typedef int i32x4 __attribute__((ext_vector_type(4)));
constexpr int BM = 256, BK = 64, HALF = 128, HTB = HALF * BK * 2, STAGE_BYTES = 8 * HTB, NXCD = 8, WGM = 8;
__host__ __device__ __forceinline__ int lds_byte(int r, int c) { const int st = (r >> 4) * 2 + (c >> 5), rr = r & 15, cc = c & 31, ob = rr * 64 + cc * 2; return st * 1024 + (ob ^ (((ob >> 9) & 1) << 5)); }
__host__ __device__ __forceinline__ void stage_rc(int b, int& R, int& C) { const int st = b / 1024, sb = b % 1024, swz = sb ^ (((sb >> 9) & 1) << 5); R = (st >> 1) * 16 + swz / 64; C = (st & 1) * 32 + (swz % 64) / 2; }
__host__ __device__ __forceinline__ int perm32(int rho) { const int n = rho >> 4, i = rho & 15; return 8 * (i >> 2) + 4 * n + (i & 3); }
__device__ __forceinline__ unsigned cvt_pk_bf16(float lo, float hi) { unsigned r; asm volatile("v_cvt_pk_bf16_f32 %0, %1, %2" : "=v"(r) : "v"(lo), "v"(hi)); return r; }

struct Unit { int pm, pn; const char* A; const char* B; int e, pos0, cnt; };

struct StaticOrder {
    int nM, nN, nwg, G, c, wgm, pmmask = -1; const char* A; const char* Bt; size_t atile, btile;
    __device__ void init(int M, int N, int K, int lda, int G_, int c_, const void* A_, const void* Bt_, int wgm_ = WGM) { wgm = wgm_; nM = M / BM; nN = N / BM; nwg = nM * nN; G = G_; c = c_; A = (const char*)A_; Bt = (const char*)Bt_; atile = (size_t)BM * lda * 2; btile = (size_t)BM * K * 2; }
    __device__ __forceinline__ bool next(int i, Unit& u) const {
        const long L = (long)i * G + c; if (L >= nwg) return false;
        int wgid = (int)L; { const int q = nwg / NXCD, r = nwg % NXCD, xcd = wgid % NXCD, off = wgid / NXCD; wgid = (xcd < r ? xcd * (q + 1) : r * (q + 1) + (xcd - r) * q) + off; }
        const int nig = wgm * nN, gid = wgid / nig, fm = gid * wgm, gsz = (nM - fm) < wgm ? (nM - fm) : wgm;
        u.pm = fm + ((wgid % nig) % gsz); u.pn = (wgid % nig) / gsz; u.A = A + (size_t)(u.pm & pmmask) * atile; u.B = Bt + (size_t)u.pn * btile; u.e = 0; u.pos0 = 0; u.cnt = 0; return true;
    }
    __device__ __forceinline__ void aoff(const Unit&, unsigned (&)[2], unsigned (&)[2], const int (&)[2], const int (&)[2]) const {}
};

template <class Epi, class Sched, bool GATHER>
__device__ __forceinline__ void gemm_phase(PG8_LAS unsigned char* lds, const int K, const int lda, const Sched& S, const Epi& E) {
    const int tid = tid_opaque(), wid = __builtin_amdgcn_readfirstlane(tid >> 6), lane = tid & 63, wr = wid >> 2, wc = wid & 3, fr = lane & 15, fq = lane >> 4;
    const int nt = K / BK;
    unsigned vA0[2], vA1[2], vB[2], nA0[2], nA1[2]; int Rs[2], Cs[2];
#pragma unroll
    for (int i = 0; i < 2; ++i) { int R, C; stage_rc(tid * 16 + i * 8192, R, C); const int Rb = Epi::PERM ? ((R & ~31) + perm32(R & 31)) : R;
        Rs[i] = R; Cs[i] = C; vA0[i] = (unsigned)(R * lda + C) * 2u; vA1[i] = vA0[i] + (unsigned)(HALF * lda) * 2u; vB[i] = (unsigned)(Rb * K + C) * 2u; nA0[i] = vA0[i]; nA1[i] = vA1[i]; }
    const size_t kstep = (size_t)(BK * 2);
    const size_t hstep = (size_t)HALF * K * 2;
    const unsigned ldsw = (unsigned)wid * 1024u;
    const int aoff = lds_byte(wr * 64 + fr, fq * 8), boff = lds_byte(wc * 32 + fr, fq * 8);
#define PG8_SA(b, h) (((b) * 2 + (h)) * HTB)
#define PG8_SB(b, h) ((4 + (b) * 2 + (h)) * HTB)
#define PG8_STAGE(bufoff, gbase, voff) do { _Pragma("unroll") for (int _i = 0; _i < 2; ++_i) \
        __builtin_amdgcn_global_load_lds((const unsigned*)((const char*)(gbase) + (voff)[_i]), (PG8_LAS unsigned*)(lds + (bufoff) + ldsw + _i * 8192), 16, 0, 0); } while (0)
#define PG8_LDA(dst, b, h) do { _Pragma("unroll") for (int m = 0; m < 4; ++m) _Pragma("unroll") for (int k = 0; k < 2; ++k) dst[m][k] = *(const PG8_LAS bf16x8*)(lds + PG8_SA(b, h) + aoff + m * 2048 + k * 1024); } while (0)
#define PG8_LDB(dst, b, h) do { _Pragma("unroll") for (int n = 0; n < 2; ++n) _Pragma("unroll") for (int k = 0; k < 2; ++k) dst[n][k] = *(const PG8_LAS bf16x8*)(lds + PG8_SB(b, h) + boff + n * 2048 + k * 1024); } while (0)
#define PG8_MMA(ai, bj, At, Bt) do { __builtin_amdgcn_s_setprio(1); _Pragma("unroll") for (int m = 0; m < 4; ++m) _Pragma("unroll") for (int n = 0; n < 2; ++n) _Pragma("unroll") for (int k = 0; k < 2; ++k) \
        acc[ai][bj][m][n] = __builtin_amdgcn_mfma_f32_16x16x32_bf16(Bt[n][k], At[m][k], acc[ai][bj][m][n], 0, 0, 0); __builtin_amdgcn_s_setprio(0); } while (0)
#define PG8_WAIT_V(n) asm volatile("s_waitcnt vmcnt(" #n ")" ::: "memory")
#define PG8_WAIT_L(n) asm volatile("s_waitcnt lgkmcnt(" #n ")" ::: "memory")
#define PG8_BAR __builtin_amdgcn_s_barrier()
#define PG8_SCHED __builtin_amdgcn_sched_barrier(0)
    Unit cur, nxt; int ui = 0;
    if (!S.next(0, cur)) return;
    if constexpr (GATHER) { S.aoff(cur, vA0, vA1, Rs, Cs); PG8_WAIT_V(0); }
    f32x4 acc[2][2][4][2];
#pragma unroll
    for (int a = 0; a < 2; ++a)
#pragma unroll
        for (int b = 0; b < 2; ++b)
#pragma unroll
            for (int m = 0; m < 4; ++m)
#pragma unroll
                for (int n = 0; n < 2; ++n) acc[a][b][m][n] = (f32x4){0.f, 0.f, 0.f, 0.f};
    bf16x8 At[4][2], B0[2][2], B1[2][2];
    const char* cA = cur.A; const char* cB = cur.B;
    PG8_STAGE(PG8_SB(0, 0), cB, vB); PG8_STAGE(PG8_SB(0, 1), cB + hstep, vB); PG8_STAGE(PG8_SA(0, 0), cA, vA0); PG8_STAGE(PG8_SA(0, 1), cA, vA1);
    if (wr == 1) PG8_BAR;
    PG8_WAIT_V(2); PG8_BAR;
    PG8_STAGE(PG8_SB(1, 0), cB + kstep, vB); PG8_STAGE(PG8_SA(1, 0), cA + kstep, vA0); PG8_STAGE(PG8_SB(1, 1), cB + hstep + kstep, vB);
    PG8_WAIT_V(6); PG8_BAR;
    for (;;) {
        const bool has_next = S.next(ui + 1, nxt);
        const char* nA = has_next ? nxt.A : cA; const char* nB = has_next ? nxt.B : cB;
        if constexpr (GATHER) {
            if (has_next) { S.aoff(nxt, nA0, nA1, Rs, Cs); }
            else {
#pragma unroll
                for (int i = 0; i < 2; ++i) { nA0[i] = vA0[i]; nA1[i] = vA1[i]; } }
        }
        for (int t = 0; t < nt; t += 2) {
            const bool last = (t == nt - 2);
            const char* a1 = cA + (size_t)(t + 1) * kstep;
            const char* a2 = last ? nA : cA + (size_t)(t + 2) * kstep; const char* b2 = last ? nB : cB + (size_t)(t + 2) * kstep;
            const char* a3 = a2 + kstep; const char* b3 = b2 + kstep;
            unsigned x0[2], x1[2];
#pragma unroll
            for (int i = 0; i < 2; ++i) { x0[i] = (GATHER && last) ? nA0[i] : vA0[i]; x1[i] = (GATHER && last) ? nA1[i] : vA1[i]; }
            PG8_LDB(B0, 0, 0); PG8_LDB(B1, 0, 1); PG8_SCHED; PG8_LDA(At, 0, 0); PG8_STAGE(PG8_SA(1, 1), a1, vA1);
            PG8_WAIT_V(8); PG8_WAIT_L(0); PG8_BAR; PG8_MMA(0, 0, At, B0); PG8_MMA(0, 1, At, B1); PG8_BAR; PG8_SCHED;
            PG8_LDA(At, 0, 1); PG8_STAGE(PG8_SB(0, 0), b2, vB); PG8_STAGE(PG8_SB(0, 1), b2 + hstep, vB); PG8_STAGE(PG8_SA(0, 0), a2, x0);
            PG8_WAIT_V(8); PG8_WAIT_L(0); PG8_BAR; PG8_MMA(1, 0, At, B0); PG8_MMA(1, 1, At, B1); PG8_BAR; PG8_SCHED;
            PG8_LDB(B0, 1, 0); PG8_LDB(B1, 1, 1); PG8_SCHED; PG8_LDA(At, 1, 0); PG8_STAGE(PG8_SA(0, 1), a2, x1);
            PG8_WAIT_V(8); PG8_WAIT_L(0); PG8_BAR; PG8_MMA(0, 0, At, B0); PG8_MMA(0, 1, At, B1); PG8_BAR; PG8_SCHED;
            PG8_LDA(At, 1, 1); PG8_STAGE(PG8_SB(1, 0), b3, vB); PG8_STAGE(PG8_SB(1, 1), b3 + hstep, vB); PG8_STAGE(PG8_SA(1, 0), a3, x0);
            PG8_WAIT_V(8); PG8_WAIT_L(0); PG8_BAR; PG8_MMA(1, 0, At, B0); PG8_MMA(1, 1, At, B1); PG8_BAR; PG8_SCHED;
        }
        if (wr == 0) PG8_BAR;
        E(acc, cur, wr, wc, fr, fq);
        if (!has_next) break;
#pragma unroll
        for (int a = 0; a < 2; ++a)
#pragma unroll
            for (int b = 0; b < 2; ++b)
#pragma unroll
                for (int m = 0; m < 4; ++m)
#pragma unroll
                    for (int n = 0; n < 2; ++n) acc[a][b][m][n] = (f32x4){0.f, 0.f, 0.f, 0.f};
        cur = nxt; cA = nA; cB = nB; ++ui;
        if constexpr (GATHER) {
#pragma unroll
            for (int i = 0; i < 2; ++i) { vA0[i] = nA0[i]; vA1[i] = nA1[i]; } }
        if (wr == 1) PG8_BAR;
    }
    PG8_WAIT_V(0);
    PG8_BAR;
#undef PG8_SA
#undef PG8_SB
#undef PG8_STAGE
#undef PG8_LDA
#undef PG8_LDB
#undef PG8_MMA
#undef PG8_WAIT_V
#undef PG8_WAIT_L
#undef PG8_BAR
#undef PG8_SCHED
}

struct EpiZ {
    static constexpr bool PERM = true;
    bf16_t* Z; const float* RS; int skip;
    __device__ __forceinline__ void operator()(const f32x4 (&acc)[2][2][4][2], const Unit& u, int wr, int wc, int fr, int fq) const {
        if (skip) return;
        const int row0 = u.pm * BM + wr * 64 + fr, col0 = u.pn * BM + wc * 32 + 8 * fq;
#pragma unroll
        for (int ai = 0; ai < 2; ++ai)
#pragma unroll
            for (int m = 0; m < 4; ++m) { bf16_t* rowp = Z + (size_t)(row0 + ai * HALF + m * 16) * ZW + col0; const float rs = RS[row0 + ai * HALF + m * 16];
#pragma unroll
                for (int bj = 0; bj < 2; ++bj) { const f32x4 v0 = acc[ai][bj][m][0] * rs, v1 = acc[ai][bj][m][1] * rs;
                    u32x4 w; w.x = cvt_pk_bf16(v0[0], v0[1]); w.y = cvt_pk_bf16(v0[2], v0[3]); w.z = cvt_pk_bf16(v1[0], v1[1]); w.w = cvt_pk_bf16(v1[2], v1[3]);
                    *(u32x4*)(rowp + bj * HALF) = w; } }
    }
};
struct EpiRes {
    static constexpr bool PERM = false;
    const float* X; float* O;
    __device__ __forceinline__ void operator()(const f32x4 (&acc)[2][2][4][2], const Unit& u, int wr, int wc, int fr, int fq) const {
        const int row0 = u.pm * BM + wr * 64 + fr, col0 = u.pn * BM + wc * 32 + 4 * fq;
#pragma unroll
        for (int ai = 0; ai < 2; ++ai)
#pragma unroll
            for (int m = 0; m < 4; ++m) { const size_t off = (size_t)(row0 + ai * HALF + m * 16) * D + col0;
#pragma unroll
                for (int bj = 0; bj < 2; ++bj)
#pragma unroll
                    for (int n = 0; n < 2; ++n) { const f32x4 xs = *(const f32x4*)(X + off + bj * HALF + n * 16); *(f32x4*)(O + off + bj * HALF + n * 16) = xs + acc[ai][bj][m][n]; }
                asm volatile("" ::: "memory"); }
    }
};
struct EpiAct {
    static constexpr bool PERM = true;
    bf16_t* ACT; const int2* lists; const float* RS;
    __device__ __forceinline__ void operator()(const f32x4 (&acc)[2][2][4][2], const Unit& u, int wr, int wc, int fr, int fq) const {
        const int row0 = u.pm * BM + wr * 64 + fr, col0 = u.pn * HALF + wc * 32 + 8 * fq; const int2* lst = lists + (size_t)u.e * NTOK + u.pos0;
#pragma unroll
        for (int ai = 0; ai < 2; ++ai)
#pragma unroll
            for (int m = 0; m < 4; ++m) { const int r = ai * HALF + wr * 64 + m * 16 + fr; bf16_t* rowp = ACT + (size_t)(row0 + ai * HALF + m * 16) * DE + col0;
                float rs = 0.f; if (u.pos0 + r < u.cnt) rs = RS[lst[r].x];
                float o[8];
#pragma unroll
                for (int n = 0; n < 2; ++n)
#pragma unroll
                    for (int j = 0; j < 4; ++j) { const float g = acc[ai][0][m][n][j] * rs, up = acc[ai][1][m][n][j] * rs; o[n * 4 + j] = g * up * __builtin_amdgcn_rcpf(1.f + __expf(-g)); }
                u32x4 w; w.x = cvt_pk_bf16(o[0], o[1]); w.y = cvt_pk_bf16(o[2], o[3]); w.z = cvt_pk_bf16(o[4], o[5]); w.w = cvt_pk_bf16(o[6], o[7]);
                *(u32x4*)rowp = w; }
    }
};
struct EpiY {
    static constexpr bool PERM = true;
    bf16_t* YB; const int2* lists;
    __device__ __forceinline__ void operator()(const f32x4 (&acc)[2][2][4][2], const Unit& u, int wr, int wc, int fr, int fq) const {
        const int row0 = u.pm * BM + wr * 64 + fr, col0 = u.pn * BM + wc * 32 + 8 * fq; const int2* lst = lists + (size_t)u.e * NTOK + u.pos0;
#pragma unroll
        for (int ai = 0; ai < 2; ++ai)
#pragma unroll
            for (int m = 0; m < 4; ++m) { const int r = ai * HALF + wr * 64 + m * 16 + fr;
                if (u.pos0 + r < u.cnt) { const float w = __int_as_float(lst[r].y); bf16_t* rowp = YB + (size_t)(row0 + ai * HALF + m * 16) * D + col0;
#pragma unroll
                    for (int bj = 0; bj < 2; ++bj) { const f32x4 v0 = acc[ai][bj][m][0] * w, v1 = acc[ai][bj][m][1] * w;
                        u32x4 o; o.x = cvt_pk_bf16(v0[0], v0[1]); o.y = cvt_pk_bf16(v0[2], v0[3]); o.z = cvt_pk_bf16(v1[0], v1[1]); o.w = cvt_pk_bf16(v1[2], v1[3]);
                        *(u32x4*)(rowp + bj * HALF) = o; } } }
    }
};
struct MoeOrder {
    const PG8_LAS i32x4* tab; int ntiles, npn, G, c; const char* A; size_t atile; const char* Bt; size_t bexp, btile; const int2* lists;
    __device__ __forceinline__ bool next(int i, Unit& u) const {
        const int L = i * G + c; const int T = L / npn; if (T >= ntiles) return false;
        const i32x4 te = tab[T]; u.pm = T; u.pn = L - T * npn; u.e = __builtin_amdgcn_readfirstlane(te.x); u.pos0 = __builtin_amdgcn_readfirstlane(te.y); u.cnt = __builtin_amdgcn_readfirstlane(te.z);
        u.A = A + (size_t)T * atile; u.B = Bt + (size_t)u.e * bexp + (size_t)u.pn * btile; return true;
    }
    __device__ __forceinline__ void aoff(const Unit& u, unsigned (&o0)[2], unsigned (&o1)[2], const int (&Rs)[2], const int (&Cs)[2]) const {
        const int2* lst = lists + (size_t)u.e * NTOK;
#pragma unroll
        for (int i = 0; i < 2; ++i) { const int p0 = u.pos0 + Rs[i], p1 = p0 + HALF;
            const int t0 = (p0 < u.cnt) ? lst[p0].x : 0, t1 = (p1 < u.cnt) ? lst[p1].x : 0;
            o0[i] = (unsigned)t0 * (unsigned)(D * 2) + (unsigned)Cs[i] * 2u; o1[i] = (unsigned)t1 * (unsigned)(D * 2) + (unsigned)Cs[i] * 2u; }
    }
};
}

__device__ __forceinline__ void tc_strip(float* T, const float* src, int src_ld, int c0, int k0, bf16_t* dst, int K, int n0) {
    const int tid = tid_opaque();
    float4 v[8];
#pragma unroll
    for (int i = 0; i < 8; ++i) { const int kk = (tid >> 4) + 32 * i, c4 = (tid & 15) * 4; v[i] = *(const float4*)(src + (size_t)(k0 + kk) * src_ld + c0 + c4); }
    __syncthreads();
#pragma unroll
    for (int i = 0; i < 8; ++i) { const int kk = (tid >> 4) + 32 * i, c4 = (tid & 15) * 4;
        T[kk * 65 + c4] = v[i].x; T[kk * 65 + c4 + 1] = v[i].y; T[kk * 65 + c4 + 2] = v[i].z; T[kk * 65 + c4 + 3] = v[i].w; }
    __syncthreads();
    const int nl = tid >> 3, kc = (tid & 7) * 32;
#pragma unroll
    for (int q = 0; q < 4; ++q) { const int kq = kc + 8 * q; pg8::u32x4 w;
        w.x = pg8::cvt_pk_bf16(T[(kq + 0) * 65 + nl], T[(kq + 1) * 65 + nl]); w.y = pg8::cvt_pk_bf16(T[(kq + 2) * 65 + nl], T[(kq + 3) * 65 + nl]);
        w.z = pg8::cvt_pk_bf16(T[(kq + 4) * 65 + nl], T[(kq + 5) * 65 + nl]); w.w = pg8::cvt_pk_bf16(T[(kq + 6) * 65 + nl], T[(kq + 7) * 65 + nl]);
        *(pg8::u32x4*)(dst + (size_t)(n0 + nl) * K + k0 + kq) = w; }
}
__device__ __forceinline__ void s5_build_tables_fwd(float* ldsf, const Params& P, int l, int g, unsigned char* tb);
__device__ __forceinline__ void ph_prologue(float* lds, const Params& P) {
    constexpr int NJ_EXP = NLAYER * NEXP * 96, NJ_IN = NLAYER * 144, NJ_OUT = NLAYER * 64, NJ_TB = NLAYER * 16, NJ_GLU = NLAYER * 4, NJ_SGU = NLAYER * 4, NJ_RT = NLAYER * 16;
    bf16_t* WIN = (bf16_t*)(P.ws + WS_WIN); bf16_t* WOUT = (bf16_t*)(P.ws + WS_WOUT); bf16_t* WGU = (bf16_t*)(P.ws + WS_WGU); bf16_t* WD = (bf16_t*)(P.ws + WS_WD);
    constexpr int NJ_ALL = NJ_EXP + NJ_IN + NJ_OUT + NJ_TB + NJ_GLU + NJ_SGU + NJ_RT, NJ_SMALL = NJ_TB + NJ_GLU + NJ_SGU + NJ_RT;
    unsigned* qhead = (unsigned*)(P.ws + WS_CTL) + CW_Q;
    LAS int* jslot = (LAS int*)((LAS unsigned char*)lds + LDS_BYTES - 64);
    for (;;) {
        __syncthreads();
        if (tid_opaque() == 0) *jslot = (int)atomicAdd(qhead, 1u);
        __syncthreads();
        const int jj = __builtin_amdgcn_readfirstlane(*jslot);
        if (jj >= NJ_ALL) break;
        const int j = (jj < NJ_SMALL) ? (NJ_ALL - NJ_SMALL + jj) : (jj - NJ_SMALL);
        if (j < NJ_EXP) {
            const int le = j / 96, r = j % 96;
            if (r < 64) { const int n0 = (r >> 2) * 64, k0 = (r & 3) * 256, pn = n0 >> 8, within = n0 & 255;
                const float* s = (within < 128 ? P.in[I_EWG] : P.in[I_EWU]) + (size_t)le * D * DE;
                tc_strip(lds, s, DE, pn * 128 + (within & 127), k0, WGU + (size_t)le * 1024 * D, D, n0);
            } else { const int r2 = r - 64, n0 = (r2 >> 1) * 64, k0 = (r2 & 1) * 256;
                tc_strip(lds, P.in[I_EWD] + (size_t)le * DE * D, D, n0, k0, WD + (size_t)le * D * DE, DE, n0); }
        } else if (j < NJ_EXP + NJ_IN) {
            const int j2 = j - NJ_EXP, l = j2 / 144, r = j2 % 144, n0 = (r >> 2) * 64, k0 = (r & 3) * 256;
            tc_strip(lds, P.in[I_WIN] + (size_t)l * D * INW, INW, n0 < WCI ? n0 : n0 + 8, k0, WIN + (size_t)l * NMAIN * D, D, n0);
        } else if (j < NJ_EXP + NJ_IN + NJ_OUT) {
            const int j3 = j - NJ_EXP - NJ_IN, l = j3 / 64, r = j3 % 64, n0 = (r >> 2) * 64, k0 = (r & 3) * 256;
            tc_strip(lds, P.in[I_WOUT] + (size_t)l * D * D, D, n0, k0, WOUT + (size_t)l * D * D, D, n0);
        } else if (j < NJ_EXP + NJ_IN + NJ_OUT + NJ_TB) {
            const int j4 = j - (NJ_EXP + NJ_IN + NJ_OUT);
            s5_build_tables_fwd(lds, P, j4 >> 4, j4 & 15, P.ws + WS_TB + (size_t)(j4 >> 4) * 4 * MiB);
        } else if (j < NJ_EXP + NJ_IN + NJ_OUT + NJ_TB + NJ_GLU) {
            const int j5 = j - (NJ_EXP + NJ_IN + NJ_OUT + NJ_TB), l = j5 >> 2, n0 = (j5 & 3) * 64;
            tc_strip(lds, P.in[I_GLUW] + (size_t)l * 256 * 256, 256, n0, 0, (bf16_t*)(P.ws + WS_TB + (size_t)l * 4 * MiB + s5::T_GLUW), 256, n0);
        } else if (j < NJ_EXP + NJ_IN + NJ_OUT + NJ_TB + NJ_GLU + NJ_SGU) {
            const int j6 = j - (NJ_EXP + NJ_IN + NJ_OUT + NJ_TB + NJ_GLU), l = j6 >> 2, g = j6 & 3;
            bf16_t* wbp = (bf16_t*)(P.ws + WS_TB + (size_t)l * 4 * MiB + s5::T_SGUW) + (size_t)g * 128 * 128; const float* ws_ = P.in[I_SGUW] + ((size_t)l * 4 + g) * 128 * 128;
            for (int idx = tid_opaque(); idx < 128 * 128; idx += NTHREADS) { const int t = idx >> 7, s = idx & 127; wbp[idx] = (s <= t) ? (bf16_t)(pg8::cvt_pk_bf16(ws_[idx], 0.f) & 0xffffu) : (bf16_t)0; }
        } else {
            const int j7 = j - (NJ_EXP + NJ_IN + NJ_OUT + NJ_TB + NJ_GLU + NJ_SGU), l = j7 / 16, n0 = (j7 % 16) * 4;
            bf16_t* wh = (bf16_t*)(P.ws + WS_RT + (size_t)l * 256 * 1024); bf16_t* wl = wh + 48 * D;
            for (int idx = tid_opaque(); idx < 4 * D; idx += NTHREADS) { const int n = n0 + (idx >> 10), k = idx & (D - 1);
                const float w = (n < 4) ? P.in[I_RGW][((size_t)l * D + k) * 4 + n] : ((n < 36) ? P.in[I_REW][((size_t)l * D + k) * 32 + (n - 4)] : ((n >= 48 && n < 56) ? P.in[I_WIN][((size_t)l * D + k) * INW + WCI + (n - 48)] : 0.f));
                const unsigned hb = pg8::cvt_pk_bf16(w, 0.f) & 0xffffu; const bf16_t lb = (bf16_t)(pg8::cvt_pk_bf16(w - __uint_as_float(hb << 16), 0.f) & 0xffffu);
                if (n < 48) { wh[(size_t)n * D + k] = (bf16_t)hb; wl[(size_t)n * D + k] = lb; } else { wh[(size_t)(96 + n - 48) * D + k] = (bf16_t)hb; wh[(size_t)(112 + n - 48) * D + k] = lb; } }
        }
    }
    __syncthreads();
}

template <bool DUAL, class AF, class EF>
__device__ __forceinline__ void gemm_tile(float* lds, AF arow, int K, const float* B0, const float* B1, int ldb, int n0, int N, EF epi) {
    float* As = lds;
    float* Bs0 = lds + 32 * 132;
    float* Bs1 = Bs0 + 32 * 128;
    const int tid = tid_opaque(), ty = tid >> 4, tx = tid & 15;
    float acc0[4][8], acc1[4][8];
#pragma unroll
    for (int i = 0; i < 4; ++i)
#pragma unroll
        for (int j = 0; j < 8; ++j) { acc0[i][j] = 0.f; acc1[i][j] = 0.f; }
    const float* ap0 = arow((tid >> 3));
    const float* ap1 = arow((tid >> 3) + 64);
    const int akk = (tid & 7) * 4;
    const int bn = n0 + (tid & 31) * 4; const bool bok = bn < N;
    for (int k0 = 0; k0 < K; k0 += 32) {
        const float4 av0 = ap0 ? *(const float4*)(ap0 + k0 + akk) : make_float4(0.f, 0.f, 0.f, 0.f);
        const float4 av1 = ap1 ? *(const float4*)(ap1 + k0 + akk) : make_float4(0.f, 0.f, 0.f, 0.f);
        const int kb0 = k0 + (tid >> 5), kb1 = kb0 + 16;
        const float4 bv00 = bok ? *(const float4*)(B0 + (size_t)kb0 * ldb + bn) : make_float4(0.f, 0.f, 0.f, 0.f);
        const float4 bv01 = bok ? *(const float4*)(B0 + (size_t)kb1 * ldb + bn) : make_float4(0.f, 0.f, 0.f, 0.f);
        const float4 bv10 = (DUAL && bok) ? *(const float4*)(B1 + (size_t)kb0 * ldb + bn) : bv00;
        const float4 bv11 = (DUAL && bok) ? *(const float4*)(B1 + (size_t)kb1 * ldb + bn) : bv01;
        __syncthreads();
        { const int r = (tid >> 3);
          As[(akk + 0) * 132 + r] = av0.x; As[(akk + 1) * 132 + r] = av0.y; As[(akk + 2) * 132 + r] = av0.z; As[(akk + 3) * 132 + r] = av0.w;
          As[(akk + 0) * 132 + r + 64] = av1.x; As[(akk + 1) * 132 + r + 64] = av1.y; As[(akk + 2) * 132 + r + 64] = av1.z; As[(akk + 3) * 132 + r + 64] = av1.w; }
        { const int k = (tid >> 5);
          *(float4*)&Bs0[k * 128 + (tid & 31) * 4] = bv00; *(float4*)&Bs0[(k + 16) * 128 + (tid & 31) * 4] = bv01;
          if (DUAL) { *(float4*)&Bs1[k * 128 + (tid & 31) * 4] = bv10; *(float4*)&Bs1[(k + 16) * 128 + (tid & 31) * 4] = bv11; } }
        __syncthreads();
#pragma unroll 4
        for (int k = 0; k < 32; ++k) {
            const float4 a = *(const float4*)&As[k * 132 + ty * 4];
            const float4 b0 = *(const float4*)&Bs0[k * 128 + tx * 4], b1 = *(const float4*)&Bs0[k * 128 + 64 + tx * 4];
            const float aa[4] = {a.x, a.y, a.z, a.w};
            const float bb[8] = {b0.x, b0.y, b0.z, b0.w, b1.x, b1.y, b1.z, b1.w};
#pragma unroll
            for (int i = 0; i < 4; ++i)
#pragma unroll
                for (int j = 0; j < 8; ++j) acc0[i][j] = fmaf(aa[i], bb[j], acc0[i][j]);
            if (DUAL) {
                const float4 c0 = *(const float4*)&Bs1[k * 128 + tx * 4], c1 = *(const float4*)&Bs1[k * 128 + 64 + tx * 4];
                const float cc[8] = {c0.x, c0.y, c0.z, c0.w, c1.x, c1.y, c1.z, c1.w};
#pragma unroll
                for (int i = 0; i < 4; ++i)
#pragma unroll
                    for (int j = 0; j < 8; ++j) acc1[i][j] = fmaf(aa[i], cc[j], acc1[i][j]);
            }
        }
    }
#pragma unroll
    for (int i = 0; i < 4; ++i)
#pragma unroll
        for (int j = 0; j < 8; ++j) {
            const int r = ty * 4 + i, c = n0 + (j < 4 ? tx * 4 + j : 64 + tx * 4 + (j - 4));
            if (c < N) epi(r, c, acc0[i][j], acc1[i][j]);
        }
    __syncthreads();
}

__device__ __forceinline__ void ph_inproj(LAS unsigned char* ldsb, const bf16_t* xn, const bf16_t* wt, bf16_t* z, const float* RS, int skip) {
    pg8::StaticOrder S; S.init(NTOK, NMAIN, D, D, gridDim.x, blockIdx.x, xn, wt, INPROJ_WGM);
    if (skip & 2) S.pmmask = 15;
    pg8::EpiZ E{z, RS, skip & 1};
    pg8::gemm_phase<pg8::EpiZ, pg8::StaticOrder, false>(ldsb, D, D, S, E);
}

namespace ml {
using pg8::bf16x8; using pg8::f32x4; using pg8::u32x4; using pg8::u32x2;
constexpr int L = 128, NCH = S / L, NU = NB * 4 * NCH;
constexpr int QP = 144, TP = 272;
constexpr int OFF_Q = 0, OFF_K = OFF_Q + 128 * QP, OFF_VT = OFF_K + 128 * QP, OFF_KT = OFF_VT + 64 * TP, OFF_F = OFF_KT + 64 * TP;
constexpr int LDS_END = OFF_F + 4 * 128 * 4 + 64;
constexpr size_t O_CL = 0, O_CST = O_CL + (size_t)NU * 4096 * 4, O_NL = O_CST + (size_t)NU * 4096 * 2, O_NST = O_NL + (size_t)NU * 64 * 4,
                 O_MLOC = O_NST + (size_t)NU * 64 * 4, O_BL = O_MLOC + (size_t)NU * 4, O_MST = O_BL + (size_t)NU * 4, O_END = O_MST + (size_t)NU * 4;
__device__ __forceinline__ f32x4 mfma16(bf16x8 a, bf16x8 b, f32x4 c) { return __builtin_amdgcn_mfma_f32_16x16x32_bf16(a, b, c, 0, 0, 0); }
__device__ __forceinline__ float bf_lo(unsigned w) { return __uint_as_float(w << 16); }
__device__ __forceinline__ float bf_hi(unsigned w) { return __uint_as_float(w & 0xffff0000u); }
__device__ __forceinline__ unsigned short bf1(float x) { return (unsigned short)(pg8::cvt_pk_bf16(x, 0.f) & 0xffffu); }

__device__ __forceinline__ void stage_gates(LAS unsigned char* lds, const float* gates, const Params& P, int l, int head, int tok0, int tid) {
    LAS float* LF = (LAS float*)(lds + OFF_F); LAS float* IG = LF + 128; LAS float* Bc = LF + 256; LAS float* G2 = LF + 384; LAS float* scal = LF + 512;
    if (tid < 128) { const float* zr = gates + (size_t)(tok0 + tid) * 8;
        const float ipre = zr[head] + P.in[I_GATEB][l * 8 + head], fpre = zr[4 + head] + P.in[I_GATEB][l * 8 + 4 + head];
        LF[tid] = fminf(fpre, 0.f) - log1pf(expf(-fabsf(fpre))); IG[tid] = ipre; }
    __syncthreads();
    if (tid < 64) { const float a = LF[2 * tid], b2 = LF[2 * tid + 1]; const float s = a + b2; float inc = s;
#pragma unroll
        for (int o = 1; o < 64; o <<= 1) { const float v = __shfl_up(inc, o); if (tid >= o) inc += v; }
        const float exc = inc - s; const float b0 = exc + a, b1 = exc + s;
        Bc[2 * tid] = b0; Bc[2 * tid + 1] = b1; const float g0 = IG[2 * tid] - b0, g1 = IG[2 * tid + 1] - b1; G2[2 * tid] = g0; G2[2 * tid + 1] = g1;
        float gm = fmaxf(g0, g1);
#pragma unroll
        for (int o = 32; o > 0; o >>= 1) gm = fmaxf(gm, __shfl_xor(gm, o));
        if (tid == 63) { scal[0] = gm; scal[1] = b1; } }
    __syncthreads();
}
__device__ __forceinline__ void conv8_load(const bf16_t* z, int b, int pos, int which, int head, int c0, u32x4 (&raw)[4]) {
    const int col = (which ? ZCK : ZCQ) + head * 64 + c0;
#pragma unroll
    for (int j = 0; j < 4; ++j) { const int tg = pos - 3 + j; raw[j] = *(const u32x4*)(z + (size_t)(b * S + (tg > 0 ? tg : 0)) * ZW + col); }
}
__device__ __forceinline__ void conv8_finish(const u32x4 (&raw)[4], const float* cw, int pos, int which, int head, int c0, float (&o)[8]) {
    const int cc = which * 256 + head * 64 + c0;
    float x[8];
#pragma unroll
    for (int e = 0; e < 8; ++e) x[e] = 0.f;
#pragma unroll
    for (int j = 0; j < 4; ++j) { const float mk = (pos - 3 + j >= 0) ? 1.f : 0.f;
        const float4 w0 = *(const float4*)(cw + j * 512 + cc), w1 = *(const float4*)(cw + j * 512 + cc + 4);
        x[0] += mk * w0.x * bf_lo(raw[j].x); x[1] += mk * w0.y * bf_hi(raw[j].x); x[2] += mk * w0.z * bf_lo(raw[j].y); x[3] += mk * w0.w * bf_hi(raw[j].y);
        x[4] += mk * w1.x * bf_lo(raw[j].z); x[5] += mk * w1.y * bf_hi(raw[j].z); x[6] += mk * w1.z * bf_lo(raw[j].w); x[7] += mk * w1.w * bf_hi(raw[j].w); }
    const float sc = which ? 0.125f : 1.f;
#pragma unroll
    for (int e = 0; e < 8; ++e) o[e] = x[e] * sc / (1.f + __expf(-x[e]));
}
__device__ __forceinline__ void vt_load(const bf16_t* z, int head, int tok0, int tid, u32x4 (&w)[2]) {
#pragma unroll
    for (int it = 0; it < 2; ++it) { const int idx = tid + it * NTHREADS, s = idx & 127, cg = idx >> 7; w[it] = *(const u32x4*)(z + (size_t)(tok0 + s) * ZW + ZCV + head * 64 + cg * 8); }
}
__device__ __forceinline__ void vt_store(LAS unsigned char* lds, int tid, const u32x4 (&w)[2]) {
#pragma unroll
    for (int it = 0; it < 2; ++it) { const int idx = tid + it * NTHREADS, s = idx & 127, cg = idx >> 7; const unsigned ww[4] = {w[it].x, w[it].y, w[it].z, w[it].w};
#pragma unroll
        for (int e = 0; e < 8; ++e) *(LAS unsigned short*)(lds + OFF_VT + (cg * 8 + e) * TP + s * 2) = (unsigned short)((e & 1) ? (ww[e >> 1] >> 16) : (ww[e >> 1] & 0xffffu)); }
}

__device__ __forceinline__ void p1_unit(LAS unsigned char* lds, const bf16_t* z, const float* gates, const Params& P, int l, int u, unsigned char* wsm) {
    const int tid = tid_opaque(), lane = tid & 63, wid = __builtin_amdgcn_readfirstlane(tid >> 6), r = lane & 15, qd = lane >> 4;
    const int b = u >> 8, head = (u >> 6) & 3, c = u & 63, tok0 = b * S + c * L;
    LAS float* G2 = (LAS float*)(lds + OFF_F) + 384; LAS float* scal = (LAS float*)(lds + OFF_F) + 512;
    u32x4 vraw[2], kraw[2][4];
    vt_load(z, head, tok0, tid, vraw);
#pragma unroll
    for (int it = 0; it < 2; ++it) { const int idx = tid + it * NTHREADS; conv8_load(z, b, c * L + (idx & 127), 1, head, (idx >> 7) * 8, kraw[it]); }
    __syncthreads();
    stage_gates(lds, gates, P, l, head, tok0, tid);
    const float gmax = scal[0], bL = scal[1];
    vt_store(lds, tid, vraw);
    const float* cw = P.in[I_CONVW] + (size_t)l * 4 * 512;
#pragma unroll
    for (int it = 0; it < 2; ++it) { const int idx = tid + it * NTHREADS, s = idx & 127, cg = idx >> 7;
        float o[8]; conv8_finish(kraw[it], cw, c * L + s, 1, head, cg * 8, o);
        const float ws = __expf(G2[s] - gmax);
#pragma unroll
        for (int e = 0; e < 8; ++e) *(LAS unsigned short*)(lds + OFF_KT + (cg * 8 + e) * TP + s * 2) = bf1(o[e] * ws); }
    __syncthreads();
    const int kt = wid >> 1;
    float* CL = (float*)(wsm + O_CL) + (size_t)u * 4096;
#pragma unroll
    for (int i = 0; i < 2; ++i) { const int vt = (wid & 1) * 2 + i; f32x4 acc = {0.f, 0.f, 0.f, 0.f};
#pragma unroll
        for (int ks = 0; ks < 4; ++ks) { const bf16x8 a = *(const LAS bf16x8*)(lds + OFF_KT + (16 * kt + r) * TP + (32 * ks + 8 * qd) * 2), bb = *(const LAS bf16x8*)(lds + OFF_VT + (16 * vt + r) * TP + (32 * ks + 8 * qd) * 2);
            acc = mfma16(a, bb, acc); }
        *(f32x4*)(CL + (size_t)(16 * vt + r) * 64 + 16 * kt + 4 * qd) = acc; }
    if (tid < 64) { float sum = 0.f;
        for (int s2 = 0; s2 < 128; s2 += 2) { const unsigned w2 = *(const LAS unsigned*)(lds + OFF_KT + tid * TP + s2 * 2); sum += bf_lo(w2) + bf_hi(w2); }
        ((float*)(wsm + O_NL))[(size_t)u * 64 + tid] = sum; }
    if (tid == 0) { ((float*)(wsm + O_MLOC))[u] = bL + gmax; ((float*)(wsm + O_BL))[u] = bL; }
}
__device__ __forceinline__ void p2_scan(unsigned char* wsm) {
    const int tid = tid_opaque();
    const float* CL = (const float*)(wsm + O_CL); const float* NL = (const float*)(wsm + O_NL); const float* MLOC = (const float*)(wsm + O_MLOC); const float* BL = (const float*)(wsm + O_BL);
    bf16_t* CST = (bf16_t*)(wsm + O_CST); float* NST = (float*)(wsm + O_NST); float* MST = (float*)(wsm + O_MST);
    for (int idx = blockIdx.x * NTHREADS + tid; idx < 32 * 4096; idx += gridDim.x * NTHREADS) {
        const int bh = idx >> 12, e = idx & 4095;
        float C = 0.f, nn = 0.f, m = 0.f;
#pragma unroll 1
        for (int c0 = 0; c0 < NCH; c0 += 16) {
            float cl[16], ml_[16], bl[16], nl[16];
#pragma unroll
            for (int i = 0; i < 16; ++i) { const int u = bh * NCH + c0 + i; cl[i] = CL[(size_t)u * 4096 + e]; ml_[i] = MLOC[u]; bl[i] = BL[u]; nl[i] = NL[(size_t)u * 64 + (e & 63)]; }
            unsigned short cs[16]; float ns[16], ms[16];
#pragma unroll
            for (int i = 0; i < 16; ++i) { cs[i] = bf1(C); ns[i] = nn; ms[i] = m;
                const float mn = fmaxf(bl[i] + m, ml_[i]), dec = __expf(bl[i] + m - mn), wl = __expf(ml_[i] - mn);
                C = dec * C + wl * cl[i]; nn = dec * nn + wl * nl[i]; m = mn; }
#pragma unroll
            for (int i = 0; i < 16; ++i) { const int u = bh * NCH + c0 + i; CST[(size_t)u * 4096 + e] = cs[i]; if (e < 64) NST[(size_t)u * 64 + e] = ns[i]; if (e == 0) MST[u] = ms[i]; }
        }
    }
}
__device__ __forceinline__ void p3_unit(LAS unsigned char* lds, const bf16_t* z, const float* gates, const Params& P, int l, int u, const unsigned char* wsm, bf16_t* mix) {
    const int tid = tid_opaque(), lane = tid & 63, wid = __builtin_amdgcn_readfirstlane(tid >> 6), r = lane & 15, qd = lane >> 4;
    const int b = u >> 8, head = (u >> 6) & 3, c = u & 63, tok0 = b * S + c * L;
    LAS float* Bc = (LAS float*)(lds + OFF_F) + 256; LAS float* G2 = (LAS float*)(lds + OFF_F) + 384;
    u32x4 vraw[2], qkraw[4][4];
    vt_load(z, head, tok0, tid, vraw);
#pragma unroll
    for (int it = 0; it < 4; ++it) { const int idx = tid + it * NTHREADS; conv8_load(z, b, c * L + ((idx >> 3) & 127), idx >> 10, head, (idx & 7) * 8, qkraw[it]); }
    __syncthreads();
    stage_gates(lds, gates, P, l, head, tok0, tid);
    vt_store(lds, tid, vraw);
    const float* cw = P.in[I_CONVW] + (size_t)l * 4 * 512;
#pragma unroll
    for (int it = 0; it < 4; ++it) { const int idx = tid + it * NTHREADS, which = idx >> 10, s = (idx >> 3) & 127, cg = idx & 7;
        float o[8]; conv8_finish(qkraw[it], cw, c * L + s, which, head, cg * 8, o);
        u32x4 w; w.x = pg8::cvt_pk_bf16(o[0], o[1]); w.y = pg8::cvt_pk_bf16(o[2], o[3]); w.z = pg8::cvt_pk_bf16(o[4], o[5]); w.w = pg8::cvt_pk_bf16(o[6], o[7]);
        *(LAS u32x4*)(lds + (which ? OFF_K : OFF_Q) + s * QP + cg * 16) = w; }
    __syncthreads();
    const int w = wid, t = 16 * w + r;
    const bf16x8 bq0 = *(const LAS bf16x8*)(lds + OFF_Q + t * QP + qd * 16), bq1 = *(const LAS bf16x8*)(lds + OFF_Q + t * QP + 64 + qd * 16);
    f32x4 accS[8];
#pragma unroll
    for (int ct = 0; ct < 8; ++ct) { accS[ct] = (f32x4){0.f, 0.f, 0.f, 0.f};
        if (ct <= w) { const bf16x8 a0 = *(const LAS bf16x8*)(lds + OFF_K + (16 * ct + r) * QP + qd * 16), a1 = *(const LAS bf16x8*)(lds + OFF_K + (16 * ct + r) * QP + 64 + qd * 16);
            accS[ct] = mfma16(a0, bq0, accS[ct]); accS[ct] = mfma16(a1, bq1, accS[ct]); } }
    const float bt = Bc[t], mst = ((const float*)(wsm + O_MST))[u];
    float ld[8][4]; float mloc = -3.0e38f;
#pragma unroll
    for (int ct = 0; ct < 8; ++ct) { const f32x4 g = *(const LAS f32x4*)(G2 + 16 * ct + 4 * qd);
#pragma unroll
        for (int j = 0; j < 4; ++j) { const bool valid = (ct < w) || (ct == w && 4 * qd + j <= r); ld[ct][j] = valid ? bt + g[j] : -3.0e38f; mloc = fmaxf(mloc, ld[ct][j]); } }
    mloc = fmaxf(mloc, __shfl_xor(mloc, 16)); mloc = fmaxf(mloc, __shfl_xor(mloc, 32));
    const float mt = fmaxf(bt + mst, mloc);
    float den = 0.f;
#pragma unroll
    for (int ct = 0; ct < 8; ++ct)
#pragma unroll
        for (int j = 0; j < 4; ++j) { const float pe = __expf(ld[ct][j] - mt) * accS[ct][j]; accS[ct][j] = pe; den += pe; }
    den += __shfl_xor(den, 16); den += __shfl_xor(den, 32);
    const bf16_t* cst = (const bf16_t*)(wsm + O_CST) + (size_t)u * 4096; const float* nst = (const float*)(wsm + O_NST) + (size_t)u * 64;
    f32x4 accN[4];
#pragma unroll
    for (int dt = 0; dt < 4; ++dt) { const bf16x8 c0 = *(const bf16x8*)(cst + (16 * dt + r) * 64 + 8 * qd), c1 = *(const bf16x8*)(cst + (16 * dt + r) * 64 + 32 + 8 * qd);
        accN[dt] = mfma16(c0, bq0, (f32x4){0.f, 0.f, 0.f, 0.f}); accN[dt] = mfma16(c1, bq1, accN[dt]); }
    const float winter = __expf(bt + mst - mt);
    float nq = 0.f;
    { const float4 n0 = *(const float4*)(nst + 8 * qd), n1 = *(const float4*)(nst + 8 * qd + 4), n2 = *(const float4*)(nst + 32 + 8 * qd), n3 = *(const float4*)(nst + 36 + 8 * qd);
      const u32x4 q0 = __builtin_bit_cast(u32x4, bq0), q1 = __builtin_bit_cast(u32x4, bq1);
      nq = bf_lo(q0.x) * n0.x + bf_hi(q0.x) * n0.y + bf_lo(q0.y) * n0.z + bf_hi(q0.y) * n0.w + bf_lo(q0.z) * n1.x + bf_hi(q0.z) * n1.y + bf_lo(q0.w) * n1.z + bf_hi(q0.w) * n1.w
         + bf_lo(q1.x) * n2.x + bf_hi(q1.x) * n2.y + bf_lo(q1.y) * n2.z + bf_hi(q1.y) * n2.w + bf_lo(q1.z) * n3.x + bf_hi(q1.z) * n3.y + bf_lo(q1.w) * n3.z + bf_hi(q1.w) * n3.w; }
    nq += __shfl_xor(nq, 16); nq += __shfl_xor(nq, 32);
    den += winter * nq;
#pragma unroll
    for (int dt = 0; dt < 4; ++dt) accN[dt] = accN[dt] * winter;
#pragma unroll
    for (int kk = 0; kk < 4; ++kk) if (2 * kk <= w) {
        u32x4 pw; pw.x = pg8::cvt_pk_bf16(accS[2 * kk][0], accS[2 * kk][1]); pw.y = pg8::cvt_pk_bf16(accS[2 * kk][2], accS[2 * kk][3]);
        pw.z = pg8::cvt_pk_bf16(accS[2 * kk + 1][0], accS[2 * kk + 1][1]); pw.w = pg8::cvt_pk_bf16(accS[2 * kk + 1][2], accS[2 * kk + 1][3]);
        const bf16x8 pf = __builtin_bit_cast(bf16x8, pw);
#pragma unroll
        for (int dt = 0; dt < 4; ++dt) { const u32x2 v0 = *(const LAS u32x2*)(lds + OFF_VT + (16 * dt + r) * TP + (32 * kk + 4 * qd) * 2), v1 = *(const LAS u32x2*)(lds + OFF_VT + (16 * dt + r) * TP + (32 * kk + 16 + 4 * qd) * 2);
            u32x4 vw; vw.x = v0.x; vw.y = v0.y; vw.z = v1.x; vw.w = v1.y;
            accN[dt] = mfma16(__builtin_bit_cast(bf16x8, vw), pf, accN[dt]); } }
    const float inv = 1.f / fmaxf(fabsf(den), __expf(-mt));
    float ss = 0.f;
#pragma unroll
    for (int dt = 0; dt < 4; ++dt) { accN[dt] = accN[dt] * inv; ss += accN[dt][0] * accN[dt][0] + accN[dt][1] * accN[dt][1] + accN[dt][2] * accN[dt][2] + accN[dt][3] * accN[dt][3]; }
    ss += __shfl_xor(ss, 16); ss += __shfl_xor(ss, 32);
    const float rs = rsqrtf(ss * (1.f / 64.f) + EPS);
    const float* ng = P.in[I_MNG] + l * 256 + head * 64; const bf16_t* cop = z + (size_t)(tok0 + t) * ZW + ZCO + head * 64;
    bf16_t* op = mix + (size_t)(tok0 + t) * D + 512 + head * 64;
#pragma unroll
    for (int dt = 0; dt < 4; ++dt) { const int d0 = 16 * dt + 4 * qd; const float4 g = *(const float4*)(ng + d0); const u32x2 cw2 = *(const u32x2*)(cop + d0); const float4 co = make_float4(bf_lo(cw2.x), bf_hi(cw2.x), bf_lo(cw2.y), bf_hi(cw2.y));
        u32x2 o; o.x = pg8::cvt_pk_bf16(accN[dt][0] * rs * g.x / (1.f + __expf(-co.x)), accN[dt][1] * rs * g.y / (1.f + __expf(-co.y)));
        o.y = pg8::cvt_pk_bf16(accN[dt][2] * rs * g.z / (1.f + __expf(-co.z)), accN[dt][3] * rs * g.w / (1.f + __expf(-co.w)));
        *(u32x2*)(op + d0) = o; }
}
static_assert(O_END <= 64 * MiB && LDS_END <= 128 * 1024, "mLSTM scratch fits");
}

namespace s5 {
using pg8::bf16x8; using pg8::f32x4; using pg8::u32x4; using pg8::u32x2;
constexpr int LC = 16, NINST = NTOK / LC;
constexpr size_t O_E = 0, O_XC = O_E + (size_t)NINST * 16 * 128 * 4, O_END = O_XC + (size_t)NINST * 16 * 128 * 2;
constexpr int YP = 528;
__device__ __forceinline__ f32x4 mfma16(bf16x8 a, bf16x8 b, f32x4 c) { return __builtin_amdgcn_mfma_f32_16x16x32_bf16(a, b, c, 0, 0, 0); }

__device__ __forceinline__ void build_tables(float* ldsf, const Params& P, int l, int g, unsigned char* tb) {
    const int tid = tid_opaque();
    float* apw = ldsf; float* bb = apw + 17 * 64 * 2; float* cc = bb + 64 * 16 * 2;
    __syncthreads();
    if (tid < 64) { const int gp = (l * 16 + g) * 64 + tid;
        const float ar = P.in[I_ARE][gp], ai = P.in[I_AIM][gp], dt = expf(P.in[I_LDT][l * 16 + g]);
        for (int tau = 0; tau <= 16; ++tau) { const float er = expf(ar * dt * tau), ang = ai * dt * tau; apw[(tau * 64 + tid) * 2] = er * cosf(ang); apw[(tau * 64 + tid) * 2 + 1] = er * sinf(ang); }
        const float abr = apw[(64 + tid) * 2], abi = apw[(64 + tid) * 2 + 1];
        const float xr_ = abr - 1.f, xi_ = abi, den = ar * ar + ai * ai;
        const float cr = (xr_ * ar + xi_ * ai) / den, ci = (xi_ * ar - xr_ * ai) / den;
        for (int h = 0; h < 16; ++h) { const float br = P.in[I_BRE][(size_t)gp * 16 + h], bi = P.in[I_BIM][(size_t)gp * 16 + h]; bb[(tid * 16 + h) * 2] = cr * br - ci * bi; bb[(tid * 16 + h) * 2 + 1] = cr * bi + ci * br; }
        float* a16 = (float*)(tb + T_A16) + (size_t)(g * 64 + tid) * 2; a16[0] = apw[(16 * 64 + tid) * 2]; a16[1] = apw[(16 * 64 + tid) * 2 + 1]; }
    for (int idx = tid; idx < 16 * 64; idx += NTHREADS) { const int h = idx >> 6, p = idx & 63; const int ci_ = ((l * 16 + g) * 16 + h) * 64 + p; cc[idx * 2] = P.in[I_CRE][ci_]; cc[idx * 2 + 1] = P.in[I_CIM][ci_]; }
    __syncthreads();
    bf16_t* KM = (bf16_t*)(tb + T_KMAT) + (size_t)g * 32 * 256;
    for (int idx = tid; idx < 15 * 256; idx += NTHREADS) KM[idx] = (bf16_t)0; bf16_t* FT = (bf16_t*)(tb + T_F) + (size_t)g * 256 * 128; bf16_t* GT = (bf16_t*)(tb + T_G) + (size_t)g * 128 * 256;
    for (int idx = tid; idx < 16 * 256; idx += NTHREADS) { const int tau = idx >> 8, h = (idx >> 4) & 15, hp = idx & 15; float s = 0.f;
        for (int p = 0; p < 64; ++p) { const float cr = cc[(h * 64 + p) * 2], ci = cc[(h * 64 + p) * 2 + 1], ar = apw[(tau * 64 + p) * 2], ai = apw[(tau * 64 + p) * 2 + 1], br = bb[(p * 16 + hp) * 2], bi = bb[(p * 16 + hp) * 2 + 1];
            const float er = ar * br - ai * bi, ei = ar * bi + ai * br; s += cr * er - ci * ei; }
        KM[15 * 256 + idx] = ml::bf1(s); }
    for (int idx = tid; idx < 256 * 64; idx += NTHREADS) { const int n = idx >> 6, p = idx & 63, t = n >> 4, h = n & 15;
        const float cr = cc[(h * 64 + p) * 2], ci = cc[(h * 64 + p) * 2 + 1], ar = apw[((t + 1) * 64 + p) * 2], ai = apw[((t + 1) * 64 + p) * 2 + 1];
        FT[(size_t)n * 128 + p] = ml::bf1(cr * ar - ci * ai); FT[(size_t)n * 128 + 64 + p] = ml::bf1(-(cr * ai + ci * ar)); }
    for (int idx = tid; idx < 64 * 256; idx += NTHREADS) { const int p = idx >> 8, k = idx & 255, s = k >> 4, hp = k & 15;
        const float ar = apw[((15 - s) * 64 + p) * 2], ai = apw[((15 - s) * 64 + p) * 2 + 1], br = bb[(p * 16 + hp) * 2], bi = bb[(p * 16 + hp) * 2 + 1];
        GT[(size_t)p * 256 + k] = ml::bf1(ar * br - ai * bi); GT[(size_t)(64 + p) * 256 + k] = ml::bf1(ar * bi + ai * br); }
}
__device__ __forceinline__ void load_u_frags(const bf16_t* z, int tok0, int g, int r, int qd, bf16x8 (&uf)[8]) {
#pragma unroll
    for (int ks = 0; ks < 8; ++ks) uf[ks] = *(const bf16x8*)(z + (size_t)(tok0 + 16 * r + 2 * ks + (qd >> 1)) * ZW + ZSU + 16 * g + 8 * (qd & 1));
}
__device__ __forceinline__ void p1_unit(const bf16_t* z, const unsigned char* tb, int u, unsigned char* wss) {
    const int tid = tid_opaque(), lane = tid & 63, wid = __builtin_amdgcn_readfirstlane(tid >> 6), r = lane & 15, qd = lane >> 4;
    const int tok0 = u * 256, inst0 = u * 16;
    float* E = (float*)(wss + O_E);
#pragma unroll 1
    for (int gi = 0; gi < 2; ++gi) { const int g = 2 * wid + gi;
        bf16x8 uf[8]; load_u_frags(z, tok0, g, r, qd, uf);
        const bf16_t* GT = (const bf16_t*)(tb + T_G) + (size_t)g * 128 * 256 + (size_t)r * 256 + 8 * qd;
        bf16x8 gf[2][8];
#pragma unroll
        for (int ks = 0; ks < 8; ++ks) gf[0][ks] = *(const bf16x8*)(GT + 32 * ks);
#pragma unroll
        for (int nt = 0; nt < 8; ++nt) {
            if (nt + 1 < 8) {
#pragma unroll
                for (int ks = 0; ks < 8; ++ks) gf[(nt + 1) & 1][ks] = *(const bf16x8*)(GT + (size_t)(16 * (nt + 1)) * 256 + 32 * ks); }
            f32x4 acc = {0.f, 0.f, 0.f, 0.f};
#pragma unroll
            for (int ks = 0; ks < 8; ++ks) acc = mfma16(gf[nt & 1][ks], uf[ks], acc);
            *(f32x4*)(E + ((size_t)(inst0 + r) * 16 + g) * 128 + 16 * nt + 4 * qd) = acc; }
    }
}
__device__ __forceinline__ void p2_scan(LAS unsigned char* lds, const unsigned char* tb, unsigned char* wss) {
    const int tid = tid_opaque(), p = tid & 63, seg = tid >> 6;
    const float* __restrict__ E = (const float*)(wss + O_E); bf16_t* __restrict__ XC = (bf16_t*)(wss + O_XC);
    LAS float* SE = (LAS float*)lds;
    for (int u = blockIdx.x; u < NB * 16; u += gridDim.x) {
        const int b = u >> 4, g = u & 15;
        const float* a16 = (const float*)(tb + T_A16) + (size_t)(g * 64 + p) * 2; const float ar = a16[0], ai = a16[1];
        const size_t o0 = ((size_t)(b * (S / LC) + seg * 64) * 16 + g) * 128 + p; constexpr size_t cs = (size_t)16 * 128;
        float xr = 0.f, xi = 0.f;
#pragma unroll 1
        for (int c0 = 0; c0 < 64; c0 += 16) { float er[16], ei[16];
#pragma unroll
            for (int i = 0; i < 16; ++i) { er[i] = E[o0 + (c0 + i) * cs]; ei[i] = E[o0 + (c0 + i) * cs + 64]; }
#pragma unroll
            for (int i = 0; i < 16; ++i) { const float nr = ar * xr - ai * xi + er[i], ni = ar * xi + ai * xr + ei[i]; xr = nr; xi = ni; } }
        __syncthreads();
        SE[(seg * 64 + p) * 2] = xr; SE[(seg * 64 + p) * 2 + 1] = xi;
        __syncthreads();
        float br = ar, bi = ai;
#pragma unroll
        for (int i = 0; i < 6; ++i) { const float nr = br * br - bi * bi, ni = 2.f * br * bi; br = nr; bi = ni; }
        xr = 0.f; xi = 0.f;
        for (int s2 = 0; s2 < seg; ++s2) { const float er = SE[(s2 * 64 + p) * 2], ei = SE[(s2 * 64 + p) * 2 + 1]; const float nr = br * xr - bi * xi + er, ni = br * xi + bi * xr + ei; xr = nr; xi = ni; }
#pragma unroll 1
        for (int c0 = 0; c0 < 64; c0 += 16) { float er[16], ei[16]; unsigned short sr[16], si[16];
#pragma unroll
            for (int i = 0; i < 16; ++i) { er[i] = E[o0 + (c0 + i) * cs]; ei[i] = E[o0 + (c0 + i) * cs + 64]; }
#pragma unroll
            for (int i = 0; i < 16; ++i) { sr[i] = ml::bf1(xr); si[i] = ml::bf1(xi); const float nr = ar * xr - ai * xi + er[i], ni = ar * xi + ai * xr + ei[i]; xr = nr; xi = ni; }
#pragma unroll
            for (int i = 0; i < 16; ++i) { XC[o0 + (c0 + i) * cs] = sr[i]; XC[o0 + (c0 + i) * cs + 64] = si[i]; } }
    }
    __syncthreads();
}
__device__ __forceinline__ void p3_unit(LAS unsigned char* lds, const bf16_t* z, const Params& P, int l, const unsigned char* tb, int u, const unsigned char* wss, bf16_t* mix) {
    const int tid = tid_opaque(), lane = tid & 63, wid = __builtin_amdgcn_readfirstlane(tid >> 6), r = lane & 15, qd = lane >> 4;
    const int tok0 = u * 256, inst0 = u * 16;
    const bf16_t* XC = (const bf16_t*)(wss + O_XC);
    __syncthreads();
#pragma unroll 1
    for (int gi = 0; gi < 2; ++gi) { const int g = 2 * wid + gi;
        bf16x8 uf[8]; load_u_frags(z, tok0, g, r, qd, uf);
        bf16x8 xf[4];
#pragma unroll
        for (int ks = 0; ks < 4; ++ks) xf[ks] = *(const bf16x8*)(XC + ((size_t)(inst0 + r) * 16 + g) * 128 + 32 * ks + 8 * qd);
        const bf16_t* KM = (const bf16_t*)(tb + T_KMAT) + (size_t)g * 32 * 256 + (size_t)(15 - (qd >> 1)) * 256 + r * 16 + 8 * (qd & 1);
        const bf16_t* FT = (const bf16_t*)(tb + T_F) + (size_t)g * 256 * 128 + (size_t)r * 128 + 8 * qd;
        const bf16_t* up = z + (size_t)(tok0 + 16 * r) * ZW + ZSU + 16 * g + 4 * qd;
        const float4 dsk = *(const float4*)(P.in[I_SD] + l * 256 + g * 16 + 4 * qd);
        bf16x8 kf[2][8], ff[2][4]; u32x2 uw[2];
#pragma unroll
        for (int ks = 0; ks < 8; ++ks) kf[0][ks] = *(const bf16x8*)(KM + (ptrdiff_t)(0 - 2 * ks) * 256);
#pragma unroll
        for (int ks = 0; ks < 4; ++ks) ff[0][ks] = *(const bf16x8*)(FT + 32 * ks);
        uw[0] = *(const u32x2*)up;
#pragma unroll
        for (int t = 0; t < 16; ++t) {
            if (t + 1 < 16) {
#pragma unroll
                for (int ks = 0; ks < 8; ++ks) kf[(t + 1) & 1][ks] = *(const bf16x8*)(KM + (ptrdiff_t)(t + 1 - 2 * ks) * 256);
#pragma unroll
                for (int ks = 0; ks < 4; ++ks) ff[(t + 1) & 1][ks] = *(const bf16x8*)(FT + (size_t)(t + 1) * 16 * 128 + 32 * ks);
                uw[(t + 1) & 1] = *(const u32x2*)(up + (size_t)(t + 1) * ZW); }
            f32x4 acc = {0.f, 0.f, 0.f, 0.f};
#pragma unroll
            for (int ks = 0; ks < 8; ++ks) if (2 * ks <= t) acc = mfma16(kf[t & 1][ks], uf[ks], acc);
#pragma unroll
            for (int ks = 0; ks < 4; ++ks) acc = mfma16(ff[t & 1][ks], xf[ks], acc);
            const u32x2 uu = uw[t & 1];
            const float y0 = gelu_tanh(acc[0] + dsk.x * ml::bf_lo(uu.x)), y1 = gelu_tanh(acc[1] + dsk.y * ml::bf_hi(uu.x)), y2 = gelu_tanh(acc[2] + dsk.z * ml::bf_lo(uu.y)), y3 = gelu_tanh(acc[3] + dsk.w * ml::bf_hi(uu.y));
            u32x2 o; o.x = pg8::cvt_pk_bf16(y0, y1); o.y = pg8::cvt_pk_bf16(y2, y3);
            *(LAS u32x2*)(lds + (16 * r + t) * YP + (16 * g + 4 * qd) * 2) = o; }
    }
    __syncthreads();
    const bf16_t* GW = (const bf16_t*)(tb + T_GLUW);
    bf16x8 wf[2][8];
#pragma unroll
    for (int nt = 0; nt < 2; ++nt)
#pragma unroll
        for (int ks = 0; ks < 8; ++ks) wf[nt][ks] = *(const bf16x8*)(GW + (size_t)(32 * wid + 16 * nt + r) * 256 + 32 * ks + 8 * qd);
    const float* gb = P.in[I_GLUB] + l * 256;
    const float4 gb0 = *(const float4*)(gb + 32 * wid + 4 * qd), gb1 = *(const float4*)(gb + 32 * wid + 16 + 4 * qd);
#pragma unroll 2
    for (int mt = 0; mt < 16; ++mt) {
        f32x4 a0 = {0.f, 0.f, 0.f, 0.f}, a1 = {0.f, 0.f, 0.f, 0.f};
#pragma unroll
        for (int ks = 0; ks < 8; ++ks) { const bf16x8 yf = *(const LAS bf16x8*)(lds + (16 * mt + r) * YP + (32 * ks + 8 * qd) * 2); a0 = mfma16(wf[0][ks], yf, a0); a1 = mfma16(wf[1][ks], yf, a1); }
        const int row = 16 * mt + r;
        const u32x2 y0 = *(const LAS u32x2*)(lds + row * YP + (32 * wid + 4 * qd) * 2), y1 = *(const LAS u32x2*)(lds + row * YP + (32 * wid + 16 + 4 * qd) * 2);
        bf16_t* op = mix + (size_t)(tok0 + row) * D + 256 + 32 * wid + 4 * qd;
        u32x2 o;
        o.x = pg8::cvt_pk_bf16(ml::bf_lo(y0.x) / (1.f + __expf(-(a0[0] + gb0.x))), ml::bf_hi(y0.x) / (1.f + __expf(-(a0[1] + gb0.y))));
        o.y = pg8::cvt_pk_bf16(ml::bf_lo(y0.y) / (1.f + __expf(-(a0[2] + gb0.z))), ml::bf_hi(y0.y) / (1.f + __expf(-(a0[3] + gb0.w))));
        *(u32x2*)op = o;
        o.x = pg8::cvt_pk_bf16(ml::bf_lo(y1.x) / (1.f + __expf(-(a1[0] + gb1.x))), ml::bf_hi(y1.x) / (1.f + __expf(-(a1[1] + gb1.y))));
        o.y = pg8::cvt_pk_bf16(ml::bf_lo(y1.y) / (1.f + __expf(-(a1[2] + gb1.z))), ml::bf_hi(y1.y) / (1.f + __expf(-(a1[3] + gb1.w))));
        *(u32x2*)(op + 16) = o;
    }
}
static_assert(T_LAYER <= 4 * MiB && O_END <= 48 * MiB && 256 * YP <= LDS_BYTES - 64, "S5 scratch fits");
}
__device__ __forceinline__ void s5_build_tables_fwd(float* ldsf, const Params& P, int l, int g, unsigned char* tb) { s5::build_tables(ldsf, P, l, g, tb); }

namespace at {
using pg8::bf16x8; using pg8::f32x4; using pg8::u32x4; using pg8::u32x2;
constexpr int KP = 144, VP = 528, OFF_K = 0, OFF_VT = 256 * KP, LDS_END = OFF_VT + 64 * VP;
__device__ __forceinline__ void unit(LAS unsigned char* lds, const bf16_t* z, const float* sinks, bf16_t* mix, int u) {
    const int tid = tid_opaque(), lane = tid & 63, wid = __builtin_amdgcn_readfirstlane(tid >> 6), r = lane & 15, qd = lane >> 4;
    const int b = u >> 7, g = (u >> 6) & 1, n = u & 63, tokb = b * S + 128 * n;
    const int hq = 2 * g + (wid >> 2);
    const float sink = sinks[hq];
    __syncthreads();
#pragma unroll
    for (int it = 0; it < 4; ++it) { const int idx = tid + it * NTHREADS, kl = idx >> 3, cg = idx & 7; const bool ok = (n > 0) || (kl >= 128);
        u32x4 w = *(const u32x4*)(z + (size_t)(ok ? tokb - 128 + kl : tokb) * ZW + ZK + g * 64 + cg * 8); if (!ok) w = (u32x4){0u, 0u, 0u, 0u};
        *(LAS u32x4*)(lds + OFF_K + kl * KP + cg * 16) = w; }
#pragma unroll
    for (int it = 0; it < 4; ++it) { const int idx = tid + it * NTHREADS, kl = idx & 255, cg = idx >> 8; const bool ok = (n > 0) || (kl >= 128);
        u32x4 w = *(const u32x4*)(z + (size_t)(ok ? tokb - 128 + kl : tokb) * ZW + ZV + g * 64 + cg * 8); if (!ok) w = (u32x4){0u, 0u, 0u, 0u};
        const unsigned ww[4] = {w.x, w.y, w.z, w.w};
#pragma unroll
        for (int e = 0; e < 8; ++e) *(LAS unsigned short*)(lds + OFF_VT + (cg * 8 + e) * VP + kl * 2) = (unsigned short)((e & 1) ? (ww[e >> 1] >> 16) : (ww[e >> 1] & 0xffffu)); }
    __syncthreads();
#pragma unroll 1
    for (int qt = 0; qt < 2; ++qt) {
        const int i0 = (wid & 3) * 32 + qt * 16, kt0 = i0 >> 4, tok = tokb + i0 + r;
        const bf16x8 bq0 = *(const bf16x8*)(z + (size_t)tok * ZW + ZQ + hq * 64 + 8 * qd), bq1 = *(const bf16x8*)(z + (size_t)tok * ZW + ZQ + hq * 64 + 32 + 8 * qd);
        f32x4 accS[9];
#pragma unroll
        for (int c = 0; c < 9; ++c) { const int kt = kt0 + c;
            const bf16x8 a0 = *(const LAS bf16x8*)(lds + OFF_K + (16 * kt + r) * KP + qd * 16), a1 = *(const LAS bf16x8*)(lds + OFF_K + (16 * kt + r) * KP + 64 + qd * 16);
            accS[c] = ml::mfma16(a0, bq0, (f32x4){0.f, 0.f, 0.f, 0.f}); accS[c] = ml::mfma16(a1, bq1, accS[c]); }
        float m = sink;
#pragma unroll
        for (int c = 0; c < 9; ++c)
#pragma unroll
            for (int j = 0; j < 4; ++j) { const int e = 4 * qd + j;
                bool valid = (c == 0) ? (e > r) : ((c == 8) ? (e <= r) : true);
                valid = valid && ((n > 0) || (kt0 + c >= 8));
                const float s = valid ? accS[c][j] * 0.125f : -3.0e38f; accS[c][j] = s; m = fmaxf(m, s); }
        m = fmaxf(m, __shfl_xor(m, 16)); m = fmaxf(m, __shfl_xor(m, 32));
        float l = 0.f;
#pragma unroll
        for (int c = 0; c < 9; ++c)
#pragma unroll
            for (int j = 0; j < 4; ++j) { const float p = __expf(accS[c][j] - m); accS[c][j] = p; l += p; }
        l += __shfl_xor(l, 16); l += __shfl_xor(l, 32);
        l += __expf(sink - m);
        f32x4 accO[4];
#pragma unroll
        for (int dt = 0; dt < 4; ++dt) accO[dt] = (f32x4){0.f, 0.f, 0.f, 0.f};
#pragma unroll
        for (int kk = 0; kk < 5; ++kk) {
            u32x4 pw; pw.x = pg8::cvt_pk_bf16(accS[2 * kk][0], accS[2 * kk][1]); pw.y = pg8::cvt_pk_bf16(accS[2 * kk][2], accS[2 * kk][3]);
            if (kk < 4) { pw.z = pg8::cvt_pk_bf16(accS[2 * kk + 1][0], accS[2 * kk + 1][1]); pw.w = pg8::cvt_pk_bf16(accS[2 * kk + 1][2], accS[2 * kk + 1][3]); } else { pw.z = 0u; pw.w = 0u; }
            const bf16x8 pf = __builtin_bit_cast(bf16x8, pw);
            const int base = 16 * (kt0 + 2 * kk);
#pragma unroll
            for (int dt = 0; dt < 4; ++dt) { const u32x2 v0 = *(const LAS u32x2*)(lds + OFF_VT + (16 * dt + r) * VP + (base + 4 * qd) * 2);
                u32x2 v1 = {0u, 0u}; if (kk < 4) v1 = *(const LAS u32x2*)(lds + OFF_VT + (16 * dt + r) * VP + (base + 16 + 4 * qd) * 2);
                u32x4 vw; vw.x = v0.x; vw.y = v0.y; vw.z = v1.x; vw.w = v1.y;
                accO[dt] = ml::mfma16(__builtin_bit_cast(bf16x8, vw), pf, accO[dt]); } }
        const float inv = 1.f / l;
        bf16_t* op = mix + (size_t)tok * D + hq * 64;
#pragma unroll
        for (int dt = 0; dt < 4; ++dt) { u32x2 o; o.x = pg8::cvt_pk_bf16(accO[dt][0] * inv, accO[dt][1] * inv); o.y = pg8::cvt_pk_bf16(accO[dt][2] * inv, accO[dt][3] * inv);
            *(u32x2*)(op + 16 * dt + 4 * qd) = o; }
    }
}
}

namespace sg {
using pg8::bf16x8; using pg8::f32x4; using pg8::u32x4; using pg8::u32x2;
constexpr int TP = 272, OFF_VT = 0, OFF_ST = 256 * TP, LDS_END = OFF_ST + 128 * 4 * 2 * 4;
__device__ __forceinline__ void unit(LAS unsigned char* lds, const bf16_t* z, const Params& P, int l, const bf16_t* wb  , bf16_t* mix, int u) {
    const int tid = tid_opaque(), lane = tid & 63, wid = __builtin_amdgcn_readfirstlane(tid >> 6), r = lane & 15, qd = lane >> 4;
    const int tok0 = u * 128;
    LAS float* ST = (LAS float*)(lds + OFF_ST);
    __syncthreads();
    const int s = tid & 127, cq = tid >> 7;
    const bf16_t* gp = z + (size_t)(tok0 + s) * ZW + ZGV + cq * 64;
    u32x4 raw[8];
#pragma unroll
    for (int i = 0; i < 8; ++i) raw[i] = *(const u32x4*)(gp + 8 * i);
    const int t = 16 * wid + r;
    bf16x8 wf[2][4];
#pragma unroll
    for (int ks = 0; ks < 4; ++ks) wf[0][ks] = *(const bf16x8*)(wb + (size_t)t * 128 + 32 * ks + 8 * qd);
    float sm = 0.f, sq = 0.f;
#pragma unroll
    for (int i = 0; i < 8; ++i) { const unsigned ww[4] = {raw[i].x, raw[i].y, raw[i].z, raw[i].w};
#pragma unroll
        for (int e = 0; e < 8; ++e) { const float ge = gelu_tanh((e & 1) ? bfh(ww[e >> 1]) : bfl(ww[e >> 1])); sm += ge; sq += ge * ge; } }
    ST[(s * 4 + cq) * 2] = sm; ST[(s * 4 + cq) * 2 + 1] = sq;
    __syncthreads();
    { float tsm = 0.f, tsq = 0.f;
#pragma unroll
      for (int q = 0; q < 4; ++q) { tsm += ST[(s * 4 + q) * 2]; tsq += ST[(s * 4 + q) * 2 + 1]; }
      const float mu = tsm * (1.f / 256.f), var = fmaxf(tsq * (1.f / 256.f) - mu * mu, 0.f), rs = rsqrtf(var + EPS);
      const float* lg = P.in[I_LNG] + l * 256 + cq * 64; const float* lb = P.in[I_LNB] + l * 256 + cq * 64;
#pragma unroll
      for (int i = 0; i < 8; ++i) { const unsigned ww[4] = {raw[i].x, raw[i].y, raw[i].z, raw[i].w};
          const float4 g0 = *(const float4*)(lg + 8 * i), g1 = *(const float4*)(lg + 8 * i + 4), b0 = *(const float4*)(lb + 8 * i), b1 = *(const float4*)(lb + 8 * i + 4);
          const float gg[8] = {g0.x, g0.y, g0.z, g0.w, g1.x, g1.y, g1.z, g1.w}, bb[8] = {b0.x, b0.y, b0.z, b0.w, b1.x, b1.y, b1.z, b1.w};
#pragma unroll
          for (int e = 0; e < 8; ++e) *(LAS unsigned short*)(lds + OFF_VT + (cq * 64 + 8 * i + e) * TP + s * 2) = ml::bf1((gelu_tanh((e & 1) ? bfh(ww[e >> 1]) : bfl(ww[e >> 1])) - mu) * rs * gg[e] + bb[e]); } }
    __syncthreads();
#pragma unroll
    for (int g = 0; g < 4; ++g) {
        if (g + 1 < 4) {
#pragma unroll
            for (int ks = 0; ks < 4; ++ks) wf[(g + 1) & 1][ks] = *(const bf16x8*)(wb + ((size_t)(g + 1) * 128 + t) * 128 + 32 * ks + 8 * qd); }
        const float bias = P.in[I_SGUB][l * 512 + g * 128 + t];
        u32x2 gw[4];
#pragma unroll
        for (int ct = 0; ct < 4; ++ct) gw[ct] = *(const u32x2*)(z + (size_t)(tok0 + t) * ZW + ZGU + g * 64 + 16 * ct + 4 * qd);
#pragma unroll
        for (int ct = 0; ct < 4; ++ct) { f32x4 acc = {0.f, 0.f, 0.f, 0.f};
#pragma unroll
            for (int ks = 0; ks < 4; ++ks) if (2 * ks <= wid) acc = ml::mfma16(*(const LAS bf16x8*)(lds + OFF_VT + (g * 64 + 16 * ct + r) * TP + (32 * ks + 8 * qd) * 2), wf[g & 1][ks], acc);
            const int c0 = g * 64 + 16 * ct + 4 * qd;
            u32x2 o; o.x = pg8::cvt_pk_bf16(gelu_tanh(bfl(gw[ct].x)) * (acc[0] + bias), gelu_tanh(bfh(gw[ct].x)) * (acc[1] + bias)); o.y = pg8::cvt_pk_bf16(gelu_tanh(bfl(gw[ct].y)) * (acc[2] + bias), gelu_tanh(bfh(gw[ct].y)) * (acc[3] + bias));
            *(u32x2*)(mix + (size_t)(tok0 + t) * D + 768 + c0) = o; }
    }
}
}

__device__ __forceinline__ void ph_mix1(float* lds, const Params& P, int l, bf16_t* z, const float* gates, bf16_t* mix, unsigned char* wsm, unsigned char* wss, const unsigned char* tb, int sub) {
    const int G = gridDim.x, bid = blockIdx.x;
    if (sub & 1) for (int u = bid; u < ml::NU; u += G) ml::p1_unit((LAS unsigned char*)lds, z, gates, P, l, u, wsm);
    __syncthreads();
    if (sub & 2) for (int u = bid; u < NTOK / 256; u += G) s5::p1_unit(z, tb, u, wss);
    __syncthreads();
    if (sub & 4) for (int u = bid; u < 1024; u += G) at::unit((LAS unsigned char*)lds, z, P.in[I_SINK] + l * 4, mix, u);
    __syncthreads();
    if (sub & 8) for (int u = bid; u < NTOK / 128; u += G) sg::unit((LAS unsigned char*)lds, z, P, l, (const bf16_t*)(tb + s5::T_SGUW), mix, u);
    __syncthreads();
}

__device__ __forceinline__ void ph_mix2(float* lds, const Params& P, int l, const bf16_t* z, const float* gates, bf16_t* mix, const unsigned char* wsm, const unsigned char* wss, const unsigned char* tb, int sub) {
    if (sub & 1) for (int u = blockIdx.x; u < NTOK / 256; u += gridDim.x) s5::p3_unit((LAS unsigned char*)lds, z, P, l, tb, u, wss, mix);
    __syncthreads();
    if (sub & 2) for (int u = blockIdx.x; u < ml::NU; u += gridDim.x) ml::p3_unit((LAS unsigned char*)lds, z, gates, P, l, u, wsm, mix);
    __syncthreads();
}

__device__ __forceinline__ void ph_outproj(LAS unsigned char* ldsb, const bf16_t* mix, const bf16_t* wt, const float* xsrc, float* xout) {
    pg8::StaticOrder S; S.init(NTOK, D, D, D, gridDim.x, blockIdx.x, mix, wt);
    pg8::EpiRes E{xsrc, xout};
    pg8::gemm_phase<pg8::EpiRes, pg8::StaticOrder, false>(ldsb, D, D, S, E);
}

namespace rp {
using pg8::bf16x8; using pg8::f32x4; using pg8::u32x4;
constexpr size_t T_HI = 0, T_LO = (size_t)48 * D * 2, T_GHI = 2 * T_LO, T_GLO = T_GHI + (size_t)16 * D * 2, T_SIZE = T_GLO + (size_t)16 * D * 2;
static_assert(T_SIZE <= 256 * 1024, "row-pass tables fit their slot");
template <int NT, bool COMBINE> struct StepIn { float4 xa[2], xb[2]; u32x4 y1[2], y2[2]; float4 g0, g1; };
template <int NT> struct StepW { bf16x8 wh[NT], wl[NT]; };
__device__ __forceinline__ void build_base(LAS int* base, const unsigned* cnt) {
    __syncthreads();
    if (tid_opaque() == 0) { int b = 0; for (int e = 0; e < NEXP; ++e) { base[e] = b; b += (((int)cnt[e] + 255) >> 8) << 8; } }
    __syncthreads();
}
template <int NT, bool COMBINE>
__device__ __forceinline__ void run(LAS unsigned char* lds, const Params& P, int l, const float* x, float* xo, const bf16_t* YB, const unsigned* inv, const unsigned* cntprev,
                                    const float* gn, const bf16_t* WH, const bf16_t* WL, bf16_t* XN, float* RS, float* gates, unsigned* cnt, int2* lists, unsigned* invout) {
    const int tid = tid_opaque(), lane = tid & 63, wid = __builtin_amdgcn_readfirstlane(tid >> 6), r = lane & 15, qd = lane >> 4;
    LAS int* BASE = (LAS int*)(lds + 64 * 1024);
    LAS float* LG = (LAS float*)lds + wid * (32 * 49);
    if (COMBINE) build_base(BASE, cntprev);
    LAS unsigned* LCNT = (LAS unsigned*)(lds + 64 * 1024 + 256); LAS unsigned* GBASE = LCNT + 32;
    for (int rb0 = blockIdx.x * 8; rb0 < NTOK / 32; rb0 += gridDim.x * 8) {
        const int rb = rb0 + wid; const bool live = rb < NTOK / 32;
        const int row0 = (live ? rb : rb0) * 32;
        if (NT == 1 && !live) continue;
        size_t yr1[2] = {0, 0}, yr2[2] = {0, 0};
        if (COMBINE) {
#pragma unroll
            for (int mt = 0; mt < 2; ++mt) { const int row = row0 + 16 * mt + r; const unsigned i1 = inv[2 * row], i2 = inv[2 * row + 1];
                yr1[mt] = (size_t)(BASE[i1 >> 16] + (int)(i1 & 0xffffu)) * D; yr2[mt] = (size_t)(BASE[i2 >> 16] + (int)(i2 & 0xffffu)) * D; } }
        f32x4 acc[2][NT];
#pragma unroll
        for (int mt = 0; mt < 2; ++mt)
#pragma unroll
            for (int nt = 0; nt < NT; ++nt) acc[mt][nt] = (f32x4){0.f, 0.f, 0.f, 0.f};
        float ssq[2] = {0.f, 0.f};
        StepIn<NT, COMBINE> sb[3]; StepW<NT> sw[2];
        auto load = [&](StepIn<NT, COMBINE>& s, int ks) {
            const int k0 = 32 * ks + 8 * qd;
#pragma unroll
            for (int mt = 0; mt < 2; ++mt) { const float* xp = x + (size_t)(row0 + 16 * mt + r) * D + k0; s.xa[mt] = *(const float4*)xp; s.xb[mt] = *(const float4*)(xp + 4);
                if (COMBINE) { s.y1[mt] = *(const u32x4*)(YB + yr1[mt] + k0); s.y2[mt] = *(const u32x4*)(YB + yr2[mt] + k0); } }
            s.g0 = *(const float4*)(gn + k0); s.g1 = *(const float4*)(gn + k0 + 4);
        };
        auto loadw = [&](StepW<NT>& s, int ks) {
            const int k0 = 32 * ks + 8 * qd;
#pragma unroll
            for (int nt = 0; nt < NT; ++nt) { s.wh[nt] = *(const bf16x8*)(WH + (size_t)(16 * nt + r) * D + k0); s.wl[nt] = *(const bf16x8*)(WL + (size_t)(16 * nt + r) * D + k0); }
        };
        auto process = [&](const StepIn<NT, COMBINE>& s, const StepW<NT>& sw_, int ks) {
            const int k0 = 32 * ks + 8 * qd;
            bf16x8 xh[2], xl[2];
#pragma unroll
            for (int mt = 0; mt < 2; ++mt) { float4 a = s.xa[mt], b = s.xb[mt];
                if (COMBINE) { const u32x4 p = s.y1[mt], q = s.y2[mt];
                    a.x += bfl(p.x) + bfl(q.x); a.y += bfh(p.x) + bfh(q.x); a.z += bfl(p.y) + bfl(q.y); a.w += bfh(p.y) + bfh(q.y);
                    b.x += bfl(p.z) + bfl(q.z); b.y += bfh(p.z) + bfh(q.z); b.z += bfl(p.w) + bfl(q.w); b.w += bfh(p.w) + bfh(q.w);
                    float* op = xo + (size_t)(row0 + 16 * mt + r) * D + k0; *(float4*)op = a; *(float4*)(op + 4) = b; }
                ssq[mt] += a.x * a.x + a.y * a.y + a.z * a.z + a.w * a.w + b.x * b.x + b.y * b.y + b.z * b.z + b.w * b.w;
                const float v[8] = {a.x * s.g0.x, a.y * s.g0.y, a.z * s.g0.z, a.w * s.g0.w, b.x * s.g1.x, b.y * s.g1.y, b.z * s.g1.z, b.w * s.g1.w};
                u32x4 h; h.x = pg8::cvt_pk_bf16(v[0], v[1]); h.y = pg8::cvt_pk_bf16(v[2], v[3]); h.z = pg8::cvt_pk_bf16(v[4], v[5]); h.w = pg8::cvt_pk_bf16(v[6], v[7]);
                *(u32x4*)(XN + (size_t)(row0 + 16 * mt + r) * D + k0) = h;
                u32x4 lo; lo.x = pg8::cvt_pk_bf16(v[0] - bfl(h.x), v[1] - bfh(h.x)); lo.y = pg8::cvt_pk_bf16(v[2] - bfl(h.y), v[3] - bfh(h.y)); lo.z = pg8::cvt_pk_bf16(v[4] - bfl(h.z), v[5] - bfh(h.z)); lo.w = pg8::cvt_pk_bf16(v[6] - bfl(h.w), v[7] - bfh(h.w));
                xh[mt] = __builtin_bit_cast(bf16x8, h); xl[mt] = __builtin_bit_cast(bf16x8, lo); }
#pragma unroll
            for (int nt = 0; nt < NT; ++nt)
#pragma unroll
                for (int mt = 0; mt < 2; ++mt) { acc[mt][nt] = ml::mfma16(sw_.wh[nt], xh[mt], acc[mt][nt]); acc[mt][nt] = ml::mfma16(sw_.wl[nt], xh[mt], acc[mt][nt]); acc[mt][nt] = ml::mfma16(sw_.wh[nt], xl[mt], acc[mt][nt]); }
        };
        if (COMBINE || NT > 1) {
            load(sb[0], 0); loadw(sw[0], 0);
#pragma unroll 1
            for (int ks = 0; ks < 32; ks += 2) {
                load(sb[1], ks + 1); loadw(sw[1], ks + 1);
                process(sb[0], sw[0], ks);
                if (ks + 2 < 32) { load(sb[0], ks + 2); loadw(sw[0], ks + 2); }
                process(sb[1], sw[1], ks + 1);
            }
        } else {
            load(sb[0], 0); load(sb[1], 1); loadw(sw[0], 0);
#define RP_STEP(i, xs, ws) do { if ((i) + 2 < 32) load(sb[((xs) + 2) % 3], (i) + 2); if ((i) + 1 < 32) loadw(sw[((ws) + 1) % 2], (i) + 1); process(sb[xs], sw[ws], (i)); } while (0)
#pragma unroll 1
            for (int ks = 0; ks < 30; ks += 6) { RP_STEP(ks, 0, 0); RP_STEP(ks + 1, 1, 1); RP_STEP(ks + 2, 2, 0); RP_STEP(ks + 3, 0, 1); RP_STEP(ks + 4, 1, 0); RP_STEP(ks + 5, 2, 1); }
            RP_STEP(30, 0, 0); RP_STEP(31, 1, 1);
#undef RP_STEP
        }
        float rsv[2];
#pragma unroll
        for (int mt = 0; mt < 2; ++mt) { float s = ssq[mt]; s += __shfl_xor(s, 16); s += __shfl_xor(s, 32); rsv[mt] = rsqrtf(s * (1.f / D) + EPS);
            if (qd == 0) RS[row0 + 16 * mt + r] = rsv[mt]; }
        if (NT == 1) {
#pragma unroll
            for (int mt = 0; mt < 2; ++mt) if (qd < 2) { const f32x4 gv = acc[mt][0] * rsv[mt]; *(f32x4*)(gates + (size_t)(row0 + 16 * mt + r) * 8 + 4 * qd) = gv; }
        } else {
            const float* bg = P.in[I_RGB] + l * 4; const float* be = P.in[I_REB] + l * 32;
#pragma unroll
            for (int mt = 0; mt < 2; ++mt)
#pragma unroll
                for (int nt = 0; nt < NT; ++nt)
#pragma unroll
                    for (int j = 0; j < 4; ++j) LG[(16 * mt + r) * 49 + 16 * nt + 4 * qd + j] = acc[mt][nt][j] * rsv[mt];
            wave_lds_fence();
            if (tid < 32) LCNT[tid] = 0u;
            __syncthreads();
            int ex1 = 0, ex2 = 0; float w1 = 0.f, w2 = 0.f; unsigned lp1 = 0u, lp2 = 0u;
            if (lane < 32 && live) {
                const LAS float* lg = LG + lane * 49;
                float gl[4];
#pragma unroll
                for (int j = 0; j < 4; ++j) gl[j] = lg[j] + bg[j];
                int sel = 0; float gm = gl[0];
#pragma unroll
                for (int j = 1; j < 4; ++j) if (gl[j] > gm) { gm = gl[j]; sel = j; }
                float gs = 0.f;
#pragma unroll
                for (int j = 0; j < 4; ++j) gs += expf(gl[j] - gm);
                const float pg = 1.f / gs;
                float ein[8];
#pragma unroll
                for (int j = 0; j < 8; ++j) ein[j] = lg[4 + sel * 8 + j] + be[sel * 8 + j];
                int i1 = 0; float v1 = ein[0];
#pragma unroll
                for (int j = 1; j < 8; ++j) if (ein[j] > v1) { v1 = ein[j]; i1 = j; }
                int i2 = -1; float v2 = -3.0e38f;
#pragma unroll
                for (int j = 0; j < 8; ++j) if (j != i1 && ein[j] > v2) { v2 = ein[j]; i2 = j; }
                const float e2 = expf(v2 - v1), den = 1.f / (1.f + e2);
                w1 = den * pg; w2 = e2 * den * pg;
                ex1 = sel * 8 + i1; ex2 = sel * 8 + i2;
                lp1 = atomicAdd((unsigned*)&LCNT[ex1], 1u); lp2 = atomicAdd((unsigned*)&LCNT[ex2], 1u);
            }
            __syncthreads();
            if (tid < 32) { const unsigned c = LCNT[tid]; GBASE[tid] = c ? atomicAdd(&cnt[tid], c) : 0u; }
            __syncthreads();
            if (lane < 32 && live) { const int row = row0 + lane; const unsigned p1 = GBASE[ex1] + lp1, p2 = GBASE[ex2] + lp2;
                lists[(size_t)ex1 * NTOK + p1] = make_int2(row, __float_as_int(w1));
                lists[(size_t)ex2 * NTOK + p2] = make_int2(row, __float_as_int(w2));
                invout[2 * row] = ((unsigned)ex1 << 16) | p1; invout[2 * row + 1] = ((unsigned)ex2 << 16) | p2; }
        }
    }
}
__device__ __forceinline__ void final_norm(LAS unsigned char* lds, float* xo, const bf16_t* YB, const unsigned* inv, const unsigned* cntprev, const float* g) {
    const int tid = tid_opaque(), wave = tid >> 6, lane = tid & 63;
    LAS int* BASE = (LAS int*)(lds + 64 * 1024);
    build_base(BASE, cntprev);
    const float4* g4 = (const float4*)g;
    for (int r = blockIdx.x * 8 + wave; r < NTOK; r += gridDim.x * 8) {
        const unsigned i1 = inv[2 * r], i2 = inv[2 * r + 1];
        const bf16_t* y1 = YB + (size_t)(BASE[i1 >> 16] + (int)(i1 & 0xffffu)) * D; const bf16_t* y2 = YB + (size_t)(BASE[i2 >> 16] + (int)(i2 & 0xffffu)) * D;
        float4* p = (float4*)(xo + (size_t)r * D);
        float4 v[4]; float ss = 0.f;
#pragma unroll
        for (int i = 0; i < 4; ++i) { v[i] = p[lane + 64 * i]; const u32x2_t a = *((const u32x2_t*)y1 + lane + 64 * i), b = *((const u32x2_t*)y2 + lane + 64 * i);
            v[i].x += bfl(a.x) + bfl(b.x); v[i].y += bfh(a.x) + bfh(b.x); v[i].z += bfl(a.y) + bfl(b.y); v[i].w += bfh(a.y) + bfh(b.y);
            ss += v[i].x * v[i].x + v[i].y * v[i].y + v[i].z * v[i].z + v[i].w * v[i].w; }
        ss = wave_sum(ss);
        const float rs = rsqrtf(ss * (1.f / D) + EPS);
#pragma unroll
        for (int i = 0; i < 4; ++i) { const float4 gg = g4[lane + 64 * i]; float4 o; o.x = v[i].x * rs * gg.x; o.y = v[i].y * rs * gg.y; o.z = v[i].z * rs * gg.z; o.w = v[i].w * rs * gg.w; p[lane + 64 * i] = o; }
    }
}
}

__device__ __forceinline__ int moe_build_tab(LAS unsigned char* ldsb, const unsigned* cnt) {
    LAS pg8::i32x4* tab = (LAS pg8::i32x4*)(ldsb + TAB_OFF);
    __syncthreads();
    int base = 0;
#pragma unroll 1
    for (int e = 0; e < NEXP; ++e) { const int c = __builtin_amdgcn_readfirstlane((int)cnt[e]), nt = (c + 255) >> 8;
        if ((int)tid_opaque() < nt) tab[base + tid_opaque()] = (pg8::i32x4){e, (int)tid_opaque() * 256, c, 0};
        base += nt; }
    __syncthreads();
    return base;
}
__device__ __forceinline__ void ph_moe1(LAS unsigned char* ldsb, const Params& P, int l, const bf16_t* H, const unsigned* cnt, const int2* lists, bf16_t* act) {
    const int ntiles = moe_build_tab(ldsb, cnt);
    pg8::MoeOrder S; S.tab = (const LAS pg8::i32x4*)(ldsb + TAB_OFF); S.ntiles = ntiles; S.npn = 4; S.G = gridDim.x; S.c = blockIdx.x;
    S.A = (const char*)H; S.atile = 0; S.Bt = (const char*)(P.ws + WS_WGU) + (size_t)l * NEXP * 1024 * D * 2; S.bexp = (size_t)1024 * D * 2; S.btile = (size_t)256 * D * 2; S.lists = lists;
    pg8::EpiAct E{act, lists, (const float*)(P.ws + WS_RS)};
    pg8::gemm_phase<pg8::EpiAct, pg8::MoeOrder, true>(ldsb, D, D, S, E);
}
__device__ __forceinline__ void ph_moe2(LAS unsigned char* ldsb, const Params& P, int l, const bf16_t* act, const unsigned* cnt, const int2* lists, bf16_t* yb) {
    const int ntiles = moe_build_tab(ldsb, cnt);
    pg8::MoeOrder S; S.tab = (const LAS pg8::i32x4*)(ldsb + TAB_OFF); S.ntiles = ntiles; S.npn = 4; S.G = gridDim.x; S.c = blockIdx.x;
    S.A = (const char*)act; S.atile = (size_t)256 * DE * 2; S.Bt = (const char*)(P.ws + WS_WD) + (size_t)l * NEXP * D * DE * 2; S.bexp = (size_t)D * DE * 2; S.btile = (size_t)256 * DE * 2; S.lists = lists;
    pg8::EpiY E{yb, lists};
    pg8::gemm_phase<pg8::EpiY, pg8::MoeOrder, false>(ldsb, DE, DE, S, E);
}

#ifndef PROBE_PH
#define PROBE_PH -1
#endif
#ifndef PROBE_SUB
#define PROBE_SUB 15
#endif
#ifndef PROBE_REPS
#define PROBE_REPS 4
#endif
__global__ void __launch_bounds__(NTHREADS, 2) fwd_kernel(Params P) {
    extern __shared__ __attribute__((aligned(16))) unsigned char lds_raw[];
    float* lds = (float*)lds_raw;
    volatile LAS unsigned* xbw = (volatile LAS unsigned*)(lds_raw + LDS_BYTES - 16);
    if (threadIdx.x == 0) { xbw[0] = 0u; xbw[1] = 0u; }
    __syncthreads();
    unsigned char* const ws = P.ws;
    unsigned* ctl = (unsigned*)(ws + WS_CTL);
    const bool multi = (P.ph_hi - P.ph_lo) > 1;
    XcdBarrier bar; bar.bar = ctl; bar.x = 0; bar.st = xbw;
    if (multi) bar = xcd_barrier_post(ctl, xbw);
    bf16_t* z = (bf16_t*)(ws + WS_Z); float* gates = (float*)(ws + WS_GATES); unsigned char* wss = ws + WS_S5; bf16_t* mix = (bf16_t*)(ws + WS_MIX); unsigned char* wsm = ws + WS_HRAW;
    bf16_t* H = (bf16_t*)(ws + WS_H); bf16_t* act = (bf16_t*)(ws + WS_ACT); bf16_t* yb = (bf16_t*)(ws + WS_YB); float* rsb = (float*)(ws + WS_RS);
    int2* lists = (int2*)(ws + WS_LIST);
    LAS unsigned char* ldsb = (LAS unsigned char*)lds_raw;
    const int lo = P.ph_lo, hi = P.ph_hi;
#define IN(k) (lo <= (k) && (k) < hi)
#define SEAM(k) do { if (IN(k) && IN((k) + 1)) xcd_barrier(bar); } while (0)
#if PROBE_PH >= 0
#define RUNPH(k, ...) do { if (IN(k)) { const int nrep = ((k) == PROBE_PH) ? 1 + PROBE_REPS : 1; for (int rep = 0; rep < nrep; ++rep) { __VA_ARGS__; if (rep + 1 < nrep) xcd_barrier(bar); } } SEAM(k); } while (0)
#else
#define RUNPH(k, ...) do { if (IN(k)) { constexpr int rep = 0; (void)rep; __VA_ARGS__; } SEAM(k); } while (0)
#endif
    RUNPH(0, ph_prologue(lds, PF));
    for (int l = 0; l < NLAYER; ++l) {
        const int pb = 1 + l * PH_PER_LAYER;
        unsigned* cnt = ctl + CW_CNT + l * 64;
        const unsigned char* tb = ws + WS_TB + (size_t)l * 4 * MiB;
        const unsigned char* rtb = ws + WS_RT + (size_t)l * 256 * 1024;
        unsigned* inv = (unsigned*)(ws + WS_INV) + (size_t)l * NTOK * 2;
        RUNPH(pb + 0, { const Params& Q = PF;
            if (l == 0) rp::run<1, false>(ldsb, Q, l, Q.in[I_X], nullptr, nullptr, nullptr, nullptr, Q.in[I_NMG] + l * D, (const bf16_t*)(rtb + rp::T_GHI), (const bf16_t*)(rtb + rp::T_GLO), mix, rsb, gates, nullptr, nullptr, nullptr);
            else        rp::run<1, true >(ldsb, Q, l, Q.out, Q.out, yb, inv - (size_t)NTOK * 2, cnt - 64, Q.in[I_NMG] + l * D, (const bf16_t*)(rtb + rp::T_GHI), (const bf16_t*)(rtb + rp::T_GLO), mix, rsb, gates, nullptr, nullptr, nullptr); });
        RUNPH(pb + 1, ph_inproj(ldsb, mix, (const bf16_t*)(ws + WS_WIN) + (size_t)l * NMAIN * D, z, rsb, (rep > 0 && PROBE_SUB <= 3) ? PROBE_SUB : 0));
        RUNPH(pb + 2, ph_mix1(lds, PF, l, z, gates, mix, wsm, wss, tb, rep == 0 ? 15 : PROBE_SUB));
        RUNPH(pb + 3, { s5::p2_scan(ldsb, tb, wss); ml::p2_scan(wsm); });
        RUNPH(pb + 4, ph_mix2(lds, PF, l, z, gates, mix, wsm, wss, tb, rep == 0 ? 15 : PROBE_SUB));
        RUNPH(pb + 5, { const Params& Q = PF; ph_outproj(ldsb, mix, (const bf16_t*)(ws + WS_WOUT) + (size_t)l * D * D, (l == 0) ? Q.in[I_X] : Q.out, Q.out); });
        RUNPH(pb + 6, { if (rep > 0) { if (blockIdx.x == 0 && threadIdx.x < 64) cnt[threadIdx.x] = 0u; xcd_barrier(bar); }
                        const Params& Q = PF; rp::run<3, false>(ldsb, Q, l, Q.out, nullptr, nullptr, nullptr, nullptr, Q.in[I_NFG] + l * D, (const bf16_t*)(rtb + rp::T_HI), (const bf16_t*)(rtb + rp::T_LO), H, rsb, nullptr, cnt, lists, inv); });
        RUNPH(pb + 7, ph_moe1(ldsb, PF, l, H, cnt, lists, act));
        RUNPH(pb + 8, ph_moe2(ldsb, PF, l, act, cnt, lists, yb));
    }
    RUNPH(1 + NLAYER * PH_PER_LAYER, { const Params& Q = PF; rp::final_norm(ldsb, Q.out, yb, (const unsigned*)(ws + WS_INV) + (size_t)(NLAYER - 1) * NTOK * 2, ctl + CW_CNT + (NLAYER - 1) * 64, Q.in[I_NFIN]); });
#undef RUNPH
#undef IN
#undef SEAM
}

#ifndef N_LAUNCH_MODE
#define N_LAUNCH_MODE 1
#endif
extern "C" void kernel_launch(void* const* d_in, const int* in_sizes, int n_in, void* d_out, int out_size, void* d_ws, size_t ws_size, hipStream_t stream) {
    static int grid = 0;
    if (grid == 0) {
        if (n_in != 31 || out_size != NTOK * D || ws_size < WS_END) { fprintf(stderr, "kernel_launch: unexpected shapes n_in %d out %d ws %zu (need %zu)\n", n_in, out_size, ws_size, (size_t)WS_END); grid = -1; return; }
        int dev = 0, cus = 0, per_cu = 0;
        if (hipGetDevice(&dev) != hipSuccess || hipDeviceGetAttribute(&cus, hipDeviceAttributeMultiprocessorCount, dev) != hipSuccess) { grid = -1; return; }
        if (hipFuncSetAttribute((const void*)fwd_kernel, hipFuncAttributeMaxDynamicSharedMemorySize, LDS_BYTES) != hipSuccess) { fprintf(stderr, "kernel_launch: hipFuncSetAttribute failed\n"); grid = -1; return; }
        if (hipOccupancyMaxActiveBlocksPerMultiprocessor(&per_cu, (const void*)fwd_kernel, NTHREADS, LDS_BYTES) != hipSuccess || per_cu < 1) { fprintf(stderr, "kernel_launch: occupancy query says %d\n", per_cu); }
        (void)hipGetLastError();
        grid = cus;
    }
    if (grid < 0) return;
    (void)hipMemsetAsync((char*)d_ws + WS_CTL, 0, CTL_BYTES, stream);
    Params p{};
    for (int i = 0; i < 31; ++i) p.in[i] = (const float*)d_in[i];
    p.out = (float*)d_out; p.ws = (unsigned char*)d_ws;
#if N_LAUNCH_MODE == 1
    p.ph_lo = 0; p.ph_hi = N_PHASES;
    hipLaunchKernelGGL(fwd_kernel, dim3(grid), dim3(NTHREADS), LDS_BYTES, stream, p);
#else
    for (int ph = 0; ph < N_PHASES; ++ph) { p.ph_lo = ph; p.ph_hi = ph + 1; hipLaunchKernelGGL(fwd_kernel, dim3(grid), dim3(NTHREADS), LDS_BYTES, stream, p); }
#endif
}
```

```cpp
#include <hip/hip_runtime.h>
#include <stdint.h>
#include <stdio.h>

#define LAS __attribute__((address_space(3)))

constexpr int D = 1024, NB = 8, S = 8192, NTOK = NB * S, INW = 2312, NLAYER = 2;
constexpr int NEXP = 32, DE = 512;
constexpr float EPS = 1e-6f;
constexpr int ZW = 2304;
constexpr int ZQ = 0, ZK = 256, ZV = 384, ZSU = 512, ZCQ = 768, ZCK = 1024, ZCV = 1280, ZCO = 1536, ZGU = 1792, ZGV = 2048, WCI = 1536;
#ifndef INPROJ_WGM
#define INPROJ_WGM 8
#endif
constexpr int NTHREADS = 512;
constexpr int LDS_BYTES = 144 * 1024;
constexpr int TAB_OFF = 128 * 1024;
constexpr int PH_PER_LAYER = 9, N_PHASES = 1 + NLAYER * PH_PER_LAYER + 1;
constexpr int NMAIN = 2304;
typedef unsigned short bf16_t;

constexpr size_t MiB = 1u << 20;
constexpr size_t WS_CTL = 0, CTL_BYTES = 1 * MiB;
constexpr size_t WS_Z = WS_CTL + CTL_BYTES;
constexpr size_t Z_BYTES = (size_t)NTOK * ZW * 2;
constexpr size_t WS_H = WS_Z;
constexpr size_t WS_YB = WS_Z;
constexpr int PMAX = 2 * NTOK + NEXP * 256;
static_assert((size_t)PMAX * D * 2 <= Z_BYTES, "YB alias fits");
constexpr size_t WS_MIX = WS_Z + Z_BYTES;
constexpr size_t WS_ACT = WS_MIX;
static_assert((size_t)PMAX * DE * 2 <= (size_t)NTOK * D * 2 + 64 * MiB, "ACT alias fits");
constexpr size_t WS_HRAW = WS_MIX + (size_t)NTOK * D * 2;
constexpr size_t WS_S5 = WS_HRAW + 64 * MiB;
constexpr size_t WS_GATES = WS_S5 + 48 * MiB;
constexpr size_t WS_LIST = WS_GATES + (size_t)NTOK * 8 * 4;
constexpr size_t WS_WIN = WS_LIST + (size_t)NEXP * NTOK * 8;
constexpr size_t WS_WOUT = WS_WIN + (size_t)NLAYER * NMAIN * D * 2;
constexpr size_t WS_WGU = WS_WOUT + (size_t)NLAYER * D * D * 2;
constexpr size_t WS_WD = WS_WGU + (size_t)NLAYER * NEXP * 1024 * D * 2;
constexpr size_t WS_TB = WS_WD + (size_t)NLAYER * NEXP * D * DE * 2;
constexpr size_t WS_RS = WS_TB + (size_t)NLAYER * 4 * MiB;
constexpr size_t WS_RT = WS_RS + (size_t)NTOK * 4;
constexpr size_t WS_INV = WS_RT + (size_t)NLAYER * 256 * 1024;
constexpr size_t WS_END = WS_INV + (size_t)NLAYER * NTOK * 8;
namespace s5 {
constexpr size_t T_KMAT = 0, T_F = T_KMAT + (size_t)16 * 32 * 256 * 2, T_G = T_F + (size_t)16 * 256 * 128 * 2, T_A16 = T_G + (size_t)16 * 128 * 256 * 2,
                 T_GLUW = T_A16 + (size_t)16 * 64 * 8, T_SGUW = T_GLUW + (size_t)256 * 256 * 2, T_LAYER = T_SGUW + (size_t)4 * 128 * 128 * 2;
}
constexpr int CW_Q = 4096;
constexpr int CW_CNT = 8192;

#define XB_TMO      128
#define XB_XCNT(j)  (256  + 64 * (j))
#define XB_XSUB(j)  (1280 + 64 * (j))
#define XB_XGEN(j)  (2304 + 64 * (j))
#define XB_TOP      3328
#define XB_TOPGEN   3392
#define XCD_BAR_WORDS 3456
#define XB_SPIN_CAP (1u << 22)
__device__ __forceinline__ unsigned xb_ld(unsigned* p)              { return __hip_atomic_load(p, __ATOMIC_RELAXED, __HIP_MEMORY_SCOPE_AGENT); }
__device__ __forceinline__ unsigned xb_add(unsigned* p, unsigned v) { return __hip_atomic_fetch_add(p, v, __ATOMIC_RELAXED, __HIP_MEMORY_SCOPE_AGENT); }
__device__ __forceinline__ unsigned xb_xcc_id() { return (unsigned)__builtin_amdgcn_s_getreg((3 << 11) | 20) & 0xFu; }
#define XB_SPIN(cond, bar) do { unsigned _sp = 0; while (cond) { __builtin_amdgcn_s_sleep(1); \
    if ((++_sp & 255u) == 0u) { if (xb_ld(&(bar)[XB_TMO])) break; if (_sp > XB_SPIN_CAP) { atomicAdd(&(bar)[XB_TMO], 1u); break; } } } } while (0)
struct XcdBarrier { unsigned* bar; unsigned x; volatile LAS unsigned* st; };
__device__ __forceinline__ XcdBarrier xcd_barrier_post(unsigned* bar, volatile LAS unsigned* st) {
    XcdBarrier b; b.bar = bar; b.x = xb_xcc_id(); b.st = st;
    if (threadIdx.x == 0) (void)xb_add(&bar[XB_XCNT(b.x)], 1u);
    return b;
}
__device__ __forceinline__ void xcd_barrier_complete(unsigned* bar, unsigned x, unsigned& nloc, unsigned& nx) {
    const unsigned G = gridDim.x * gridDim.y * gridDim.z;
    unsigned sum, cnt, mine, sp = 0u;
    for (;;) {
        sum = 0u; cnt = 0u; mine = 0u;
#pragma unroll
        for (unsigned j = 0; j < 16; ++j) { const unsigned c = xb_ld(&bar[XB_XCNT(j)]); sum += c; cnt += (c > 0u) ? 1u : 0u; mine = (j == x) ? c : mine; }
        if (sum == G) break;
        __builtin_amdgcn_s_sleep(1);
        if ((++sp & 255u) == 0u) { if (xb_ld(&bar[XB_TMO])) break; if (sp > XB_SPIN_CAP) { atomicAdd(&bar[XB_TMO], 1u); break; } }
    }
    nloc = mine > 0u ? mine : 1u; nx = cnt > 0u ? cnt : 1u;
}
__device__ __forceinline__ void xcd_barrier(const XcdBarrier& b) {
    asm volatile("s_waitcnt vmcnt(0)" ::: "memory");
    __syncthreads();
    if (threadIdx.x == 0) {
        unsigned* bar = b.bar;
        __builtin_amdgcn_s_waitcnt(0);
        unsigned nloc = b.st[0], nx = b.st[1];
        if (nloc == 0u) { xcd_barrier_complete(bar, b.x, nloc, nx); b.st[0] = nloc; b.st[1] = nx; }
        const unsigned old = xb_add(&bar[XB_XSUB(b.x)], 1u);
        const unsigned gen = old / nloc;
        if (old + 1u == (gen + 1u) * nloc) {
            __builtin_amdgcn_fence(__ATOMIC_RELEASE, "agent");
            asm volatile("s_waitcnt vmcnt(0)" ::: "memory");
            const unsigned og = xb_add(&bar[XB_TOP], 1u);
            const unsigned tg = og / nx;
            if (og + 1u == (tg + 1u) * nx) xb_add(&bar[XB_TOPGEN], 1u);
            else XB_SPIN(xb_ld(&bar[XB_TOPGEN]) == tg, bar);
            __builtin_amdgcn_fence(__ATOMIC_ACQUIRE, "agent");
            xb_add(&bar[XB_XGEN(b.x)], 1u);
            asm volatile("s_waitcnt vmcnt(0)" ::: "memory");
        } else {
            XB_SPIN(xb_ld(&bar[XB_XGEN(b.x)]) == gen, bar);
            __builtin_amdgcn_fence(__ATOMIC_ACQUIRE, "agent");
            asm volatile("s_waitcnt vmcnt(0)" ::: "memory");
        }
    }
    __syncthreads();
}

__device__ __forceinline__ int tid_opaque() { int t = threadIdx.x; asm volatile("" : "+v"(t)); return t; }
__device__ __forceinline__ float wave_sum(float v) {
#pragma unroll
    for (int o = 32; o > 0; o >>= 1) v += __shfl_xor(v, o);
    return v;
}
__device__ __forceinline__ float gelu_tanh(float x) {
    const float u2 = 1.5957691216057308f * (x + 0.044715f * x * x * x);
    return x * __builtin_amdgcn_rcpf(1.f + __expf(-u2));
}
__device__ __forceinline__ float sigm(float x) { return 1.f / (1.f + expf(-x)); }
__device__ __forceinline__ float bfl(unsigned w) { return __uint_as_float(w << 16); }
__device__ __forceinline__ float bfh(unsigned w) { return __uint_as_float(w & 0xffff0000u); }
typedef unsigned u32x4_t __attribute__((ext_vector_type(4)));
typedef unsigned u32x2_t __attribute__((ext_vector_type(2)));
__device__ __forceinline__ void ld8(const bf16_t* p, float (&o)[8]) { const u32x4_t w = *(const u32x4_t*)p; o[0] = bfl(w.x); o[1] = bfh(w.x); o[2] = bfl(w.y); o[3] = bfh(w.y); o[4] = bfl(w.z); o[5] = bfh(w.z); o[6] = bfl(w.w); o[7] = bfh(w.w); }
__device__ __forceinline__ void wave_lds_fence() {
    __builtin_amdgcn_fence(__ATOMIC_RELEASE, "wavefront"); __builtin_amdgcn_wave_barrier(); __builtin_amdgcn_fence(__ATOMIC_ACQUIRE, "wavefront");
}

struct Params {
    const float* in[31];
    float* out;
    unsigned char* ws;
    int ph_lo, ph_hi;
};
struct Params;
__device__ __forceinline__ const Params* params_fresh() { auto p = __builtin_amdgcn_kernarg_segment_ptr(); asm volatile("" : "+s"(p)); return (const Params*)p; }
#define PF (*params_fresh())
enum { I_X = 0, I_NMG, I_WIN, I_SINK, I_ARE, I_AIM, I_BRE, I_BIM, I_CRE, I_CIM, I_SD, I_LDT, I_GLUW, I_GLUB, I_CONVW, I_GATEB, I_MNG,
       I_LNG, I_LNB, I_SGUW, I_SGUB, I_WOUT, I_NFG, I_RGW, I_RGB, I_REW, I_REB, I_EWG, I_EWU, I_EWD, I_NFIN };

namespace pg8 {
#define PG8_LAS __attribute__((address_space(3)))
typedef short bf16x8 __attribute__((ext_vector_type(8)));
typedef float f32x4 __attribute__((ext_vector_type(4)));
typedef unsigned u32x4 __attribute__((ext_vector_type(4)));
typedef unsigned u32x2 __attribute__((ext_vector_type(2)));
typedef int i32x4 __attribute__((ext_vector_type(4)));
constexpr int BM = 256, BK = 64, HALF = 128, HTB = HALF * BK * 2, STAGE_BYTES = 8 * HTB, NXCD = 8, WGM = 8;
__host__ __device__ __forceinline__ int lds_byte(int r, int c) { const int st = (r >> 4) * 2 + (c >> 5), rr = r & 15, cc = c & 31, ob = rr * 64 + cc * 2; return st * 1024 + (ob ^ (((ob >> 9) & 1) << 5)); }
__host__ __device__ __forceinline__ void stage_rc(int b, int& R, int& C) { const int st = b / 1024, sb = b % 1024, swz = sb ^ (((sb >> 9) & 1) << 5); R = (st >> 1) * 16 + swz / 64; C = (st & 1) * 32 + (swz % 64) / 2; }
__host__ __device__ __forceinline__ int perm32(int rho) { const int n = rho >> 4, i = rho & 15; return 8 * (i >> 2) + 4 * n + (i & 3); }
__device__ __forceinline__ unsigned cvt_pk_bf16(float lo, float hi) { unsigned r; asm volatile("v_cvt_pk_bf16_f32 %0, %1, %2" : "=v"(r) : "v"(lo), "v"(hi)); return r; }

struct Unit { int pm, pn; const char* A; const char* B; int e, pos0, cnt; };

struct StaticOrder {
    int nM, nN, nwg, G, c, wgm, pmmask = -1; const char* A; const char* Bt; size_t atile, btile;
    __device__ void init(int M, int N, int K, int lda, int G_, int c_, const void* A_, const void* Bt_, int wgm_ = WGM) { wgm = wgm_; nM = M / BM; nN = N / BM; nwg = nM * nN; G = G_; c = c_; A = (const char*)A_; Bt = (const char*)Bt_; atile = (size_t)BM * lda * 2; btile = (size_t)BM * K * 2; }
    __device__ __forceinline__ bool next(int i, Unit& u) const {
        const long L = (long)i * G + c; if (L >= nwg) return false;
        int wgid = (int)L; { const int q = nwg / NXCD, r = nwg % NXCD, xcd = wgid % NXCD, off = wgid / NXCD; wgid = (xcd < r ? xcd * (q + 1) : r * (q + 1) + (xcd - r) * q) + off; }
        const int nig = wgm * nN, gid = wgid / nig, fm = gid * wgm, gsz = (nM - fm) < wgm ? (nM - fm) : wgm;
        u.pm = fm + ((wgid % nig) % gsz); u.pn = (wgid % nig) / gsz; u.A = A + (size_t)(u.pm & pmmask) * atile; u.B = Bt + (size_t)u.pn * btile; u.e = 0; u.pos0 = 0; u.cnt = 0; return true;
    }
    __device__ __forceinline__ void aoff(const Unit&, unsigned (&)[2], unsigned (&)[2], const int (&)[2], const int (&)[2]) const {}
};

template <class Epi, class Sched, bool GATHER>
__device__ __forceinline__ void gemm_phase(PG8_LAS unsigned char* lds, const int K, const int lda, const Sched& S, const Epi& E) {
    const int tid = tid_opaque(), wid = __builtin_amdgcn_readfirstlane(tid >> 6), lane = tid & 63, wr = wid >> 2, wc = wid & 3, fr = lane & 15, fq = lane >> 4;
    const int nt = K / BK;
    unsigned vA0[2], vA1[2], vB[2], nA0[2], nA1[2]; int Rs[2], Cs[2];
#pragma unroll
    for (int i = 0; i < 2; ++i) { int R, C; stage_rc(tid * 16 + i * 8192, R, C); const int Rb = Epi::PERM ? ((R & ~31) + perm32(R & 31)) : R;
        Rs[i] = R; Cs[i] = C; vA0[i] = (unsigned)(R * lda + C) * 2u; vA1[i] = vA0[i] + (unsigned)(HALF * lda) * 2u; vB[i] = (unsigned)(Rb * K + C) * 2u; nA0[i] = vA0[i]; nA1[i] = vA1[i]; }
    const size_t kstep = (size_t)(BK * 2);
    const size_t hstep = (size_t)HALF * K * 2;
    const unsigned ldsw = (unsigned)wid * 1024u;
    const int aoff = lds_byte(wr * 64 + fr, fq * 8), boff = lds_byte(wc * 32 + fr, fq * 8);
#define PG8_SA(b, h) (((b) * 2 + (h)) * HTB)
#define PG8_SB(b, h) ((4 + (b) * 2 + (h)) * HTB)
#define PG8_STAGE(bufoff, gbase, voff) do { _Pragma("unroll") for (int _i = 0; _i < 2; ++_i) \
        __builtin_amdgcn_global_load_lds((const unsigned*)((const char*)(gbase) + (voff)[_i]), (PG8_LAS unsigned*)(lds + (bufoff) + ldsw + _i * 8192), 16, 0, 0); } while (0)
#define PG8_LDA(dst, b, h) do { _Pragma("unroll") for (int m = 0; m < 4; ++m) _Pragma("unroll") for (int k = 0; k < 2; ++k) dst[m][k] = *(const PG8_LAS bf16x8*)(lds + PG8_SA(b, h) + aoff + m * 2048 + k * 1024); } while (0)
#define PG8_LDB(dst, b, h) do { _Pragma("unroll") for (int n = 0; n < 2; ++n) _Pragma("unroll") for (int k = 0; k < 2; ++k) dst[n][k] = *(const PG8_LAS bf16x8*)(lds + PG8_SB(b, h) + boff + n * 2048 + k * 1024); } while (0)
#define PG8_MMA(ai, bj, At, Bt) do { __builtin_amdgcn_s_setprio(1); _Pragma("unroll") for (int m = 0; m < 4; ++m) _Pragma("unroll") for (int n = 0; n < 2; ++n) _Pragma("unroll") for (int k = 0; k < 2; ++k) \
        acc[ai][bj][m][n] = __builtin_amdgcn_mfma_f32_16x16x32_bf16(Bt[n][k], At[m][k], acc[ai][bj][m][n], 0, 0, 0); __builtin_amdgcn_s_setprio(0); } while (0)
#define PG8_WAIT_V(n) asm volatile("s_waitcnt vmcnt(" #n ")" ::: "memory")
#define PG8_WAIT_L(n) asm volatile("s_waitcnt lgkmcnt(" #n ")" ::: "memory")
#define PG8_BAR __builtin_amdgcn_s_barrier()
#define PG8_SCHED __builtin_amdgcn_sched_barrier(0)
    Unit cur, nxt; int ui = 0;
    if (!S.next(0, cur)) return;
    if constexpr (GATHER) { S.aoff(cur, vA0, vA1, Rs, Cs); PG8_WAIT_V(0); }
    f32x4 acc[2][2][4][2];
#pragma unroll
    for (int a = 0; a < 2; ++a)
#pragma unroll
        for (int b = 0; b < 2; ++b)
#pragma unroll
            for (int m = 0; m < 4; ++m)
#pragma unroll
                for (int n = 0; n < 2; ++n) acc[a][b][m][n] = (f32x4){0.f, 0.f, 0.f, 0.f};
    bf16x8 At[4][2], B0[2][2], B1[2][2];
    const char* cA = cur.A; const char* cB = cur.B;
    PG8_STAGE(PG8_SB(0, 0), cB, vB); PG8_STAGE(PG8_SB(0, 1), cB + hstep, vB); PG8_STAGE(PG8_SA(0, 0), cA, vA0); PG8_STAGE(PG8_SA(0, 1), cA, vA1);
    if (wr == 1) PG8_BAR;
    PG8_WAIT_V(2); PG8_BAR;
    PG8_STAGE(PG8_SB(1, 0), cB + kstep, vB); PG8_STAGE(PG8_SA(1, 0), cA + kstep, vA0); PG8_STAGE(PG8_SB(1, 1), cB + hstep + kstep, vB);
    PG8_WAIT_V(6); PG8_BAR;
    for (;;) {
        const bool has_next = S.next(ui + 1, nxt);
        const char* nA = has_next ? nxt.A : cA; const char* nB = has_next ? nxt.B : cB;
        if constexpr (GATHER) {
            if (has_next) { S.aoff(nxt, nA0, nA1, Rs, Cs); }
            else {
#pragma unroll
                for (int i = 0; i < 2; ++i) { nA0[i] = vA0[i]; nA1[i] = vA1[i]; } }
        }
        for (int t = 0; t < nt; t += 2) {
            const bool last = (t == nt - 2);
            const char* a1 = cA + (size_t)(t + 1) * kstep;
            const char* a2 = last ? nA : cA + (size_t)(t + 2) * kstep; const char* b2 = last ? nB : cB + (size_t)(t + 2) * kstep;
            const char* a3 = a2 + kstep; const char* b3 = b2 + kstep;
            unsigned x0[2], x1[2];
#pragma unroll
            for (int i = 0; i < 2; ++i) { x0[i] = (GATHER && last) ? nA0[i] : vA0[i]; x1[i] = (GATHER && last) ? nA1[i] : vA1[i]; }
            PG8_LDB(B0, 0, 0); PG8_LDB(B1, 0, 1); PG8_SCHED; PG8_LDA(At, 0, 0); PG8_STAGE(PG8_SA(1, 1), a1, vA1);
            PG8_WAIT_V(8); PG8_WAIT_L(0); PG8_BAR; PG8_MMA(0, 0, At, B0); PG8_MMA(0, 1, At, B1); PG8_BAR; PG8_SCHED;
            PG8_LDA(At, 0, 1); PG8_STAGE(PG8_SB(0, 0), b2, vB); PG8_STAGE(PG8_SB(0, 1), b2 + hstep, vB); PG8_STAGE(PG8_SA(0, 0), a2, x0);
            PG8_WAIT_V(8); PG8_WAIT_L(0); PG8_BAR; PG8_MMA(1, 0, At, B0); PG8_MMA(1, 1, At, B1); PG8_BAR; PG8_SCHED;
            PG8_LDB(B0, 1, 0); PG8_LDB(B1, 1, 1); PG8_SCHED; PG8_LDA(At, 1, 0); PG8_STAGE(PG8_SA(0, 1), a2, x1);
            PG8_WAIT_V(8); PG8_WAIT_L(0); PG8_BAR; PG8_MMA(0, 0, At, B0); PG8_MMA(0, 1, At, B1); PG8_BAR; PG8_SCHED;
            PG8_LDA(At, 1, 1); PG8_STAGE(PG8_SB(1, 0), b3, vB); PG8_STAGE(PG8_SB(1, 1), b3 + hstep, vB); PG8_STAGE(PG8_SA(1, 0), a3, x0);
            PG8_WAIT_V(8); PG8_WAIT_L(0); PG8_BAR; PG8_MMA(1, 0, At, B0); PG8_MMA(1, 1, At, B1); PG8_BAR; PG8_SCHED;
        }
        if (wr == 0) PG8_BAR;
        E(acc, cur, wr, wc, fr, fq);
        if (!has_next) break;
#pragma unroll
        for (int a = 0; a < 2; ++a)
#pragma unroll
            for (int b = 0; b < 2; ++b)
#pragma unroll
                for (int m = 0; m < 4; ++m)
#pragma unroll
                    for (int n = 0; n < 2; ++n) acc[a][b][m][n] = (f32x4){0.f, 0.f, 0.f, 0.f};
        cur = nxt; cA = nA; cB = nB; ++ui;
        if constexpr (GATHER) {
#pragma unroll
            for (int i = 0; i < 2; ++i) { vA0[i] = nA0[i]; vA1[i] = nA1[i]; } }
        if (wr == 1) PG8_BAR;
    }
    PG8_WAIT_V(0);
    PG8_BAR;
#undef PG8_SA
#undef PG8_SB
#undef PG8_STAGE
#undef PG8_LDA
#undef PG8_LDB
#undef PG8_MMA
#undef PG8_WAIT_V
#undef PG8_WAIT_L
#undef PG8_BAR
#undef PG8_SCHED
}

struct EpiZ {
    static constexpr bool PERM = true;
    bf16_t* Z; const float* RS; int skip;
    __device__ __forceinline__ void operator()(const f32x4 (&acc)[2][2][4][2], const Unit& u, int wr, int wc, int fr, int fq) const {
        if (skip) return;
        const int row0 = u.pm * BM + wr * 64 + fr, col0 = u.pn * BM + wc * 32 + 8 * fq;
        float rsv[2][4];
#pragma unroll
        for (int ai = 0; ai < 2; ++ai)
#pragma unroll
            for (int m = 0; m < 4; ++m) rsv[ai][m] = RS[row0 + ai * HALF + m * 16];
#pragma unroll
        for (int ai = 0; ai < 2; ++ai)
#pragma unroll
            for (int m = 0; m < 4; ++m) { bf16_t* rowp = Z + (size_t)(row0 + ai * HALF + m * 16) * ZW + col0; const float rs = rsv[ai][m];
#pragma unroll
                for (int bj = 0; bj < 2; ++bj) { const f32x4 v0 = acc[ai][bj][m][0] * rs, v1 = acc[ai][bj][m][1] * rs;
                    u32x4 w; w.x = cvt_pk_bf16(v0[0], v0[1]); w.y = cvt_pk_bf16(v0[2], v0[3]); w.z = cvt_pk_bf16(v1[0], v1[1]); w.w = cvt_pk_bf16(v1[2], v1[3]);
                    *(u32x4*)(rowp + bj * HALF) = w; } }
    }
};
struct EpiRes {
    static constexpr bool PERM = false;
    const float* X; float* O;
    __device__ __forceinline__ void operator()(const f32x4 (&acc)[2][2][4][2], const Unit& u, int wr, int wc, int fr, int fq) const {
        const int row0 = u.pm * BM + wr * 64 + fr, col0 = u.pn * BM + wc * 32 + 4 * fq;
#pragma unroll
        for (int ai = 0; ai < 2; ++ai)
#pragma unroll
            for (int mp = 0; mp < 2; ++mp) {
                f32x4 xs[2][2][2];
#pragma unroll
                for (int mm = 0; mm < 2; ++mm) { const size_t off = (size_t)(row0 + ai * HALF + (2 * mp + mm) * 16) * D + col0;
#pragma unroll
                    for (int bj = 0; bj < 2; ++bj)
#pragma unroll
                        for (int n = 0; n < 2; ++n) xs[mm][bj][n] = *(const f32x4*)(X + off + bj * HALF + n * 16); }
#pragma unroll
                for (int mm = 0; mm < 2; ++mm) { const size_t off = (size_t)(row0 + ai * HALF + (2 * mp + mm) * 16) * D + col0;
#pragma unroll
                    for (int bj = 0; bj < 2; ++bj)
#pragma unroll
                        for (int n = 0; n < 2; ++n) *(f32x4*)(O + off + bj * HALF + n * 16) = xs[mm][bj][n] + acc[ai][bj][2 * mp + mm][n]; }
            }
    }
};
struct EpiAct {
    static constexpr bool PERM = true;
    bf16_t* ACT; const int2* lists; const float* RS;
    __device__ __forceinline__ void operator()(const f32x4 (&acc)[2][2][4][2], const Unit& u, int wr, int wc, int fr, int fq) const {
        const int row0 = u.pm * BM + wr * 64 + fr, col0 = u.pn * HALF + wc * 32 + 8 * fq; const int2* lst = lists + (size_t)u.e * NTOK + u.pos0;
        int tk[2][4]; float rsv[2][4];
#pragma unroll
        for (int ai = 0; ai < 2; ++ai)
#pragma unroll
            for (int m = 0; m < 4; ++m) { const int r = ai * HALF + wr * 64 + m * 16 + fr; const int rc = (u.pos0 + r < u.cnt) ? r : 0; tk[ai][m] = lst[rc].x; }
        asm volatile("" : "+v"(tk[0][0]), "+v"(tk[0][1]), "+v"(tk[0][2]), "+v"(tk[0][3]), "+v"(tk[1][0]), "+v"(tk[1][1]), "+v"(tk[1][2]), "+v"(tk[1][3]));
#pragma unroll
        for (int ai = 0; ai < 2; ++ai)
#pragma unroll
            for (int m = 0; m < 4; ++m) rsv[ai][m] = RS[tk[ai][m]];
        asm volatile("" : "+v"(rsv[0][0]), "+v"(rsv[0][1]), "+v"(rsv[0][2]), "+v"(rsv[0][3]), "+v"(rsv[1][0]), "+v"(rsv[1][1]), "+v"(rsv[1][2]), "+v"(rsv[1][3]));
#pragma unroll
        for (int ai = 0; ai < 2; ++ai)
#pragma unroll
            for (int m = 0; m < 4; ++m) { const int r = ai * HALF + wr * 64 + m * 16 + fr; if (!(u.pos0 + r < u.cnt)) rsv[ai][m] = 0.f; }
#pragma unroll
        for (int ai = 0; ai < 2; ++ai)
#pragma unroll
            for (int m = 0; m < 4; ++m) { bf16_t* rowp = ACT + (size_t)(row0 + ai * HALF + m * 16) * DE + col0;
                const float rs = rsv[ai][m];
                float o[8];
#pragma unroll
                for (int n = 0; n < 2; ++n)
#pragma unroll
                    for (int j = 0; j < 4; ++j) { const float g = acc[ai][0][m][n][j] * rs, up = acc[ai][1][m][n][j] * rs; o[n * 4 + j] = g * up * __builtin_amdgcn_rcpf(1.f + __expf(-g)); }
                u32x4 w; w.x = cvt_pk_bf16(o[0], o[1]); w.y = cvt_pk_bf16(o[2], o[3]); w.z = cvt_pk_bf16(o[4], o[5]); w.w = cvt_pk_bf16(o[6], o[7]);
                *(u32x4*)rowp = w; }
    }
};
struct EpiY {
    static constexpr bool PERM = true;
    bf16_t* YB; const int2* lists;
    __device__ __forceinline__ void operator()(const f32x4 (&acc)[2][2][4][2], const Unit& u, int wr, int wc, int fr, int fq) const {
        const int row0 = u.pm * BM + wr * 64 + fr, col0 = u.pn * BM + wc * 32 + 8 * fq; const int2* lst = lists + (size_t)u.e * NTOK + u.pos0;
        float wv[2][4];
#pragma unroll
        for (int ai = 0; ai < 2; ++ai)
#pragma unroll
            for (int m = 0; m < 4; ++m) { const int r = ai * HALF + wr * 64 + m * 16 + fr; wv[ai][m] = __int_as_float(lst[(u.pos0 + r < u.cnt) ? r : 0].y); }
#pragma unroll
        for (int ai = 0; ai < 2; ++ai)
#pragma unroll
            for (int m = 0; m < 4; ++m) { const int r = ai * HALF + wr * 64 + m * 16 + fr;
                if (u.pos0 + r < u.cnt) { const float w = wv[ai][m]; bf16_t* rowp = YB + (size_t)(row0 + ai * HALF + m * 16) * D + col0;
#pragma unroll
                    for (int bj = 0; bj < 2; ++bj) { const f32x4 v0 = acc[ai][bj][m][0] * w, v1 = acc[ai][bj][m][1] * w;
                        u32x4 o; o.x = cvt_pk_bf16(v0[0], v0[1]); o.y = cvt_pk_bf16(v0[2], v0[3]); o.z = cvt_pk_bf16(v1[0], v1[1]); o.w = cvt_pk_bf16(v1[2], v1[3]);
                        *(u32x4*)(rowp + bj * HALF) = o; } } }
    }
};
struct MoeOrder {
    const PG8_LAS i32x4* tab; int ntiles, npn, G, c; const char* A; size_t atile; const char* Bt; size_t bexp, btile; const int2* lists;
    __device__ __forceinline__ bool next(int i, Unit& u) const {
        const int L = i * G + c; const int T = L / npn; if (T >= ntiles) return false;
        const i32x4 te = tab[T]; u.pm = T; u.pn = L - T * npn; u.e = __builtin_amdgcn_readfirstlane(te.x); u.pos0 = __builtin_amdgcn_readfirstlane(te.y); u.cnt = __builtin_amdgcn_readfirstlane(te.z);
        u.A = A + (size_t)T * atile; u.B = Bt + (size_t)u.e * bexp + (size_t)u.pn * btile; return true;
    }
    __device__ __forceinline__ void aoff(const Unit& u, unsigned (&o0)[2], unsigned (&o1)[2], const int (&Rs)[2], const int (&Cs)[2]) const {
        const int2* lst = lists + (size_t)u.e * NTOK;
#pragma unroll
        for (int i = 0; i < 2; ++i) { const int p0 = u.pos0 + Rs[i], p1 = p0 + HALF;
            const int t0 = (p0 < u.cnt) ? lst[p0].x : 0, t1 = (p1 < u.cnt) ? lst[p1].x : 0;
            o0[i] = (unsigned)t0 * (unsigned)(D * 2) + (unsigned)Cs[i] * 2u; o1[i] = (unsigned)t1 * (unsigned)(D * 2) + (unsigned)Cs[i] * 2u; }
    }
};
}

__device__ __forceinline__ void tc_strip(float* T, const float* src, int src_ld, int c0, int k0, bf16_t* dst, int K, int n0) {
    const int tid = tid_opaque();
    float4 v[8];
#pragma unroll
    for (int i = 0; i < 8; ++i) { const int kk = (tid >> 4) + 32 * i, c4 = (tid & 15) * 4; v[i] = *(const float4*)(src + (size_t)(k0 + kk) * src_ld + c0 + c4); }
    __syncthreads();
#pragma unroll
    for (int i = 0; i < 8; ++i) { const int kk = (tid >> 4) + 32 * i, c4 = (tid & 15) * 4;
        T[kk * 65 + c4] = v[i].x; T[kk * 65 + c4 + 1] = v[i].y; T[kk * 65 + c4 + 2] = v[i].z; T[kk * 65 + c4 + 3] = v[i].w; }
    __syncthreads();
    const int nl = tid >> 3, kc = (tid & 7) * 32;
#pragma unroll
    for (int q = 0; q < 4; ++q) { const int kq = kc + 8 * q; pg8::u32x4 w;
        w.x = pg8::cvt_pk_bf16(T[(kq + 0) * 65 + nl], T[(kq + 1) * 65 + nl]); w.y = pg8::cvt_pk_bf16(T[(kq + 2) * 65 + nl], T[(kq + 3) * 65 + nl]);
        w.z = pg8::cvt_pk_bf16(T[(kq + 4) * 65 + nl], T[(kq + 5) * 65 + nl]); w.w = pg8::cvt_pk_bf16(T[(kq + 6) * 65 + nl], T[(kq + 7) * 65 + nl]);
        *(pg8::u32x4*)(dst + (size_t)(n0 + nl) * K + k0 + kq) = w; }
}
__device__ __forceinline__ void s5_build_tables_fwd(float* ldsf, const Params& P, int l, int g, unsigned char* tb);
__device__ __forceinline__ void ph_prologue(float* lds, const Params& P) {
    constexpr int NJ_EXP = NLAYER * NEXP * 96, NJ_IN = NLAYER * 144, NJ_OUT = NLAYER * 64, NJ_TB = NLAYER * 16, NJ_GLU = NLAYER * 4, NJ_SGU = NLAYER * 4, NJ_RT = NLAYER * 16;
    bf16_t* WIN = (bf16_t*)(P.ws + WS_WIN); bf16_t* WOUT = (bf16_t*)(P.ws + WS_WOUT); bf16_t* WGU = (bf16_t*)(P.ws + WS_WGU); bf16_t* WD = (bf16_t*)(P.ws + WS_WD);
    constexpr int NJ_ALL = NJ_EXP + NJ_IN + NJ_OUT + NJ_TB + NJ_GLU + NJ_SGU + NJ_RT, NJ_SMALL = NJ_TB + NJ_GLU + NJ_SGU + NJ_RT;
    unsigned* qhead = (unsigned*)(P.ws + WS_CTL) + CW_Q;
    LAS int* jslot = (LAS int*)((LAS unsigned char*)lds + LDS_BYTES - 64);
    for (;;) {
        __syncthreads();
        if (tid_opaque() == 0) *jslot = (int)atomicAdd(qhead, 1u);
        __syncthreads();
        const int jj = __builtin_amdgcn_readfirstlane(*jslot);
        if (jj >= NJ_ALL) break;
        const int j = (jj < NJ_SMALL) ? (NJ_ALL - NJ_SMALL + jj) : (jj - NJ_SMALL);
        if (j < NJ_EXP) {
            const int le = j / 96, r = j % 96;
            if (r < 64) { const int n0 = (r >> 2) * 64, k0 = (r & 3) * 256, pn = n0 >> 8, within = n0 & 255;
                const float* s = (within < 128 ? P.in[I_EWG] : P.in[I_EWU]) + (size_t)le * D * DE;
                tc_strip(lds, s, DE, pn * 128 + (within & 127), k0, WGU + (size_t)le * 1024 * D, D, n0);
            } else { const int r2 = r - 64, n0 = (r2 >> 1) * 64, k0 = (r2 & 1) * 256;
                tc_strip(lds, P.in[I_EWD] + (size_t)le * DE * D, D, n0, k0, WD + (size_t)le * D * DE, DE, n0); }
        } else if (j < NJ_EXP + NJ_IN) {
            const int j2 = j - NJ_EXP, l = j2 / 144, r = j2 % 144, n0 = (r >> 2) * 64, k0 = (r & 3) * 256;
            tc_strip(lds, P.in[I_WIN] + (size_t)l * D * INW, INW, n0 < WCI ? n0 : n0 + 8, k0, WIN + (size_t)l * NMAIN * D, D, n0);
        } else if (j < NJ_EXP + NJ_IN + NJ_OUT) {
            const int j3 = j - NJ_EXP - NJ_IN, l = j3 / 64, r = j3 % 64, n0 = (r >> 2) * 64, k0 = (r & 3) * 256;
            tc_strip(lds, P.in[I_WOUT] + (size_t)l * D * D, D, n0, k0, WOUT + (size_t)l * D * D, D, n0);
        } else if (j < NJ_EXP + NJ_IN + NJ_OUT + NJ_TB) {
            const int j4 = j - (NJ_EXP + NJ_IN + NJ_OUT);
            s5_build_tables_fwd(lds, P, j4 >> 4, j4 & 15, P.ws + WS_TB + (size_t)(j4 >> 4) * 4 * MiB);
        } else if (j < NJ_EXP + NJ_IN + NJ_OUT + NJ_TB + NJ_GLU) {
            const int j5 = j - (NJ_EXP + NJ_IN + NJ_OUT + NJ_TB), l = j5 >> 2, n0 = (j5 & 3) * 64;
            tc_strip(lds, P.in[I_GLUW] + (size_t)l * 256 * 256, 256, n0, 0, (bf16_t*)(P.ws + WS_TB + (size_t)l * 4 * MiB + s5::T_GLUW), 256, n0);
        } else if (j < NJ_EXP + NJ_IN + NJ_OUT + NJ_TB + NJ_GLU + NJ_SGU) {
            const int j6 = j - (NJ_EXP + NJ_IN + NJ_OUT + NJ_TB + NJ_GLU), l = j6 >> 2, g = j6 & 3;
            bf16_t* wbp = (bf16_t*)(P.ws + WS_TB + (size_t)l * 4 * MiB + s5::T_SGUW) + (size_t)g * 128 * 128; const float* ws_ = P.in[I_SGUW] + ((size_t)l * 4 + g) * 128 * 128;
            for (int idx = tid_opaque(); idx < 128 * 128; idx += NTHREADS) { const int t = idx >> 7, s = idx & 127; wbp[idx] = (s <= t) ? (bf16_t)(pg8::cvt_pk_bf16(ws_[idx], 0.f) & 0xffffu) : (bf16_t)0; }
        } else {
            const int j7 = j - (NJ_EXP + NJ_IN + NJ_OUT + NJ_TB + NJ_GLU + NJ_SGU), l = j7 / 16, n0 = (j7 % 16) * 4;
            bf16_t* wh = (bf16_t*)(P.ws + WS_RT + (size_t)l * 256 * 1024); bf16_t* wl = wh + 48 * D;
            for (int idx = tid_opaque(); idx < 4 * D; idx += NTHREADS) { const int n = n0 + (idx >> 10), k = idx & (D - 1);
                const float w = (n < 4) ? P.in[I_RGW][((size_t)l * D + k) * 4 + n] : ((n < 36) ? P.in[I_REW][((size_t)l * D + k) * 32 + (n - 4)] : ((n >= 48 && n < 56) ? P.in[I_WIN][((size_t)l * D + k) * INW + WCI + (n - 48)] : 0.f));
                const unsigned hb = pg8::cvt_pk_bf16(w, 0.f) & 0xffffu; const bf16_t lb = (bf16_t)(pg8::cvt_pk_bf16(w - __uint_as_float(hb << 16), 0.f) & 0xffffu);
                if (n < 48) { wh[(size_t)n * D + k] = (bf16_t)hb; wl[(size_t)n * D + k] = lb; } else { wh[(size_t)(96 + n - 48) * D + k] = (bf16_t)hb; wh[(size_t)(112 + n - 48) * D + k] = lb; } }
        }
    }
    __syncthreads();
}

template <bool DUAL, class AF, class EF>
__device__ __forceinline__ void gemm_tile(float* lds, AF arow, int K, const float* B0, const float* B1, int ldb, int n0, int N, EF epi) {
    float* As = lds;
    float* Bs0 = lds + 32 * 132;
    float* Bs1 = Bs0 + 32 * 128;
    const int tid = tid_opaque(), ty = tid >> 4, tx = tid & 15;
    float acc0[4][8], acc1[4][8];
#pragma unroll
    for (int i = 0; i < 4; ++i)
#pragma unroll
        for (int j = 0; j < 8; ++j) { acc0[i][j] = 0.f; acc1[i][j] = 0.f; }
    const float* ap0 = arow((tid >> 3));
    const float* ap1 = arow((tid >> 3) + 64);
    const int akk = (tid & 7) * 4;
    const int bn = n0 + (tid & 31) * 4; const bool bok = bn < N;
    for (int k0 = 0; k0 < K; k0 += 32) {
        const float4 av0 = ap0 ? *(const float4*)(ap0 + k0 + akk) : make_float4(0.f, 0.f, 0.f, 0.f);
        const float4 av1 = ap1 ? *(const float4*)(ap1 + k0 + akk) : make_float4(0.f, 0.f, 0.f, 0.f);
        const int kb0 = k0 + (tid >> 5), kb1 = kb0 + 16;
        const float4 bv00 = bok ? *(const float4*)(B0 + (size_t)kb0 * ldb + bn) : make_float4(0.f, 0.f, 0.f, 0.f);
        const float4 bv01 = bok ? *(const float4*)(B0 + (size_t)kb1 * ldb + bn) : make_float4(0.f, 0.f, 0.f, 0.f);
        const float4 bv10 = (DUAL && bok) ? *(const float4*)(B1 + (size_t)kb0 * ldb + bn) : bv00;
        const float4 bv11 = (DUAL && bok) ? *(const float4*)(B1 + (size_t)kb1 * ldb + bn) : bv01;
        __syncthreads();
        { const int r = (tid >> 3);
          As[(akk + 0) * 132 + r] = av0.x; As[(akk + 1) * 132 + r] = av0.y; As[(akk + 2) * 132 + r] = av0.z; As[(akk + 3) * 132 + r] = av0.w;
          As[(akk + 0) * 132 + r + 64] = av1.x; As[(akk + 1) * 132 + r + 64] = av1.y; As[(akk + 2) * 132 + r + 64] = av1.z; As[(akk + 3) * 132 + r + 64] = av1.w; }
        { const int k = (tid >> 5);
          *(float4*)&Bs0[k * 128 + (tid & 31) * 4] = bv00; *(float4*)&Bs0[(k + 16) * 128 + (tid & 31) * 4] = bv01;
          if (DUAL) { *(float4*)&Bs1[k * 128 + (tid & 31) * 4] = bv10; *(float4*)&Bs1[(k + 16) * 128 + (tid & 31) * 4] = bv11; } }
        __syncthreads();
#pragma unroll 4
        for (int k = 0; k < 32; ++k) {
            const float4 a = *(const float4*)&As[k * 132 + ty * 4];
            const float4 b0 = *(const float4*)&Bs0[k * 128 + tx * 4], b1 = *(const float4*)&Bs0[k * 128 + 64 + tx * 4];
            const float aa[4] = {a.x, a.y, a.z, a.w};
            const float bb[8] = {b0.x, b0.y, b0.z, b0.w, b1.x, b1.y, b1.z, b1.w};
#pragma unroll
            for (int i = 0; i < 4; ++i)
#pragma unroll
                for (int j = 0; j < 8; ++j) acc0[i][j] = fmaf(aa[i], bb[j], acc0[i][j]);
            if (DUAL) {
                const float4 c0 = *(const float4*)&Bs1[k * 128 + tx * 4], c1 = *(const float4*)&Bs1[k * 128 + 64 + tx * 4];
                const float cc[8] = {c0.x, c0.y, c0.z, c0.w, c1.x, c1.y, c1.z, c1.w};
#pragma unroll
                for (int i = 0; i < 4; ++i)
#pragma unroll
                    for (int j = 0; j < 8; ++j) acc1[i][j] = fmaf(aa[i], cc[j], acc1[i][j]);
            }
        }
    }
#pragma unroll
    for (int i = 0; i < 4; ++i)
#pragma unroll
        for (int j = 0; j < 8; ++j) {
            const int r = ty * 4 + i, c = n0 + (j < 4 ? tx * 4 + j : 64 + tx * 4 + (j - 4));
            if (c < N) epi(r, c, acc0[i][j], acc1[i][j]);
        }
    __syncthreads();
}

__device__ __forceinline__ void ph_inproj(LAS unsigned char* ldsb, const bf16_t* xn, const bf16_t* wt, bf16_t* z, const float* RS, int skip) {
    pg8::StaticOrder S; S.init(NTOK, NMAIN, D, D, gridDim.x, blockIdx.x, xn, wt, INPROJ_WGM);
    if (skip & 2) S.pmmask = 15;
    pg8::EpiZ E{z, RS, skip & 1};
    pg8::gemm_phase<pg8::EpiZ, pg8::StaticOrder, false>(ldsb, D, D, S, E);
}

namespace ml {
using pg8::bf16x8; using pg8::f32x4; using pg8::u32x4; using pg8::u32x2;
constexpr int L = 128, NCH = S / L, NU = NB * 4 * NCH;
constexpr int QP = 144, TP = 272;
constexpr int OFF_Q = 0, OFF_K = OFF_Q + 128 * QP, OFF_VT = OFF_K + 128 * QP, OFF_KT = OFF_VT + 64 * TP, OFF_F = OFF_KT + 64 * TP;
constexpr int LDS_END = OFF_F + 4 * 128 * 4 + 64;
constexpr size_t O_CL = 0, O_CST = O_CL + (size_t)NU * 4096 * 4, O_NL = O_CST + (size_t)NU * 4096 * 2, O_NST = O_NL + (size_t)NU * 64 * 4,
                 O_MLOC = O_NST + (size_t)NU * 64 * 4, O_BL = O_MLOC + (size_t)NU * 4, O_MST = O_BL + (size_t)NU * 4, O_END = O_MST + (size_t)NU * 4;
__device__ __forceinline__ f32x4 mfma16(bf16x8 a, bf16x8 b, f32x4 c) { return __builtin_amdgcn_mfma_f32_16x16x32_bf16(a, b, c, 0, 0, 0); }
__device__ __forceinline__ float bf_lo(unsigned w) { return __uint_as_float(w << 16); }
__device__ __forceinline__ float bf_hi(unsigned w) { return __uint_as_float(w & 0xffff0000u); }
__device__ __forceinline__ unsigned short bf1(float x) { return (unsigned short)(pg8::cvt_pk_bf16(x, 0.f) & 0xffffu); }

__device__ __forceinline__ void stage_gates(LAS unsigned char* lds, const float* gates, const Params& P, int l, int head, int tok0, int tid) {
    LAS float* LF = (LAS float*)(lds + OFF_F); LAS float* IG = LF + 128; LAS float* Bc = LF + 256; LAS float* G2 = LF + 384; LAS float* scal = LF + 512;
    if (tid < 128) { const float* zr = gates + (size_t)(tok0 + tid) * 8;
        const float ipre = zr[head] + P.in[I_GATEB][l * 8 + head], fpre = zr[4 + head] + P.in[I_GATEB][l * 8 + 4 + head];
        LF[tid] = fminf(fpre, 0.f) - log1pf(expf(-fabsf(fpre))); IG[tid] = ipre; }
    __syncthreads();
    if (tid < 64) { const float a = LF[2 * tid], b2 = LF[2 * tid + 1]; const float s = a + b2; float inc = s;
#pragma unroll
        for (int o = 1; o < 64; o <<= 1) { const float v = __shfl_up(inc, o); if (tid >= o) inc += v; }
        const float exc = inc - s; const float b0 = exc + a, b1 = exc + s;
        Bc[2 * tid] = b0; Bc[2 * tid + 1] = b1; const float g0 = IG[2 * tid] - b0, g1 = IG[2 * tid + 1] - b1; G2[2 * tid] = g0; G2[2 * tid + 1] = g1;
        float gm = fmaxf(g0, g1);
#pragma unroll
        for (int o = 32; o > 0; o >>= 1) gm = fmaxf(gm, __shfl_xor(gm, o));
        if (tid == 63) { scal[0] = gm; scal[1] = b1; } }
    __syncthreads();
}
__device__ __forceinline__ void conv8_load(const bf16_t* z, int b, int pos, int which, int head, int c0, u32x4 (&raw)[4]) {
    const int col = (which ? ZCK : ZCQ) + head * 64 + c0;
#pragma unroll
    for (int j = 0; j < 4; ++j) { const int tg = pos - 3 + j; raw[j] = *(const u32x4*)(z + (size_t)(b * S + (tg > 0 ? tg : 0)) * ZW + col); }
}
__device__ __forceinline__ void conv8_finish(const u32x4 (&raw)[4], const float* cw, int pos, int which, int head, int c0, float (&o)[8]) {
    const int cc = which * 256 + head * 64 + c0;
    float x[8];
#pragma unroll
    for (int e = 0; e < 8; ++e) x[e] = 0.f;
    float4 wa[4], wb[4];
#pragma unroll
    for (int j = 0; j < 4; ++j) { wa[j] = *(const float4*)(cw + j * 512 + cc); wb[j] = *(const float4*)(cw + j * 512 + cc + 4); }
    __builtin_amdgcn_sched_barrier(0);
#pragma unroll
    for (int j = 0; j < 4; ++j) { const float mk = (pos - 3 + j >= 0) ? 1.f : 0.f;
        const float4 w0 = wa[j], w1 = wb[j];
        x[0] += mk * w0.x * bf_lo(raw[j].x); x[1] += mk * w0.y * bf_hi(raw[j].x); x[2] += mk * w0.z * bf_lo(raw[j].y); x[3] += mk * w0.w * bf_hi(raw[j].y);
        x[4] += mk * w1.x * bf_lo(raw[j].z); x[5] += mk * w1.y * bf_hi(raw[j].z); x[6] += mk * w1.z * bf_lo(raw[j].w); x[7] += mk * w1.w * bf_hi(raw[j].w); }
    const float sc = which ? 0.125f : 1.f;
#pragma unroll
    for (int e = 0; e < 8; ++e) o[e] = x[e] * sc / (1.f + __expf(-x[e]));
}
__device__ __forceinline__ void vt_load(const bf16_t* z, int head, int tok0, int tid, u32x4 (&w)[2]) {
#pragma unroll
    for (int it = 0; it < 2; ++it) { const int idx = tid + it * NTHREADS, s = idx & 127, cg = idx >> 7; w[it] = *(const u32x4*)(z + (size_t)(tok0 + s) * ZW + ZCV + head * 64 + cg * 8); }
}
__device__ __forceinline__ void vt_store(LAS unsigned char* lds, int tid, const u32x4 (&w)[2]) {
#pragma unroll
    for (int it = 0; it < 2; ++it) { const int idx = tid + it * NTHREADS, s = idx & 127, cg = idx >> 7; const unsigned ww[4] = {w[it].x, w[it].y, w[it].z, w[it].w};
#pragma unroll
        for (int e = 0; e < 8; ++e) *(LAS unsigned short*)(lds + OFF_VT + (cg * 8 + e) * TP + s * 2) = (unsigned short)((e & 1) ? (ww[e >> 1] >> 16) : (ww[e >> 1] & 0xffffu)); }
}

__device__ __forceinline__ void p1_unit(LAS unsigned char* lds, const bf16_t* z, const float* gates, const Params& P, int l, int u, unsigned char* wsm) {
    const int tid = tid_opaque(), lane = tid & 63, wid = __builtin_amdgcn_readfirstlane(tid >> 6), r = lane & 15, qd = lane >> 4;
    const int b = u >> 8, head = (u >> 6) & 3, c = u & 63, tok0 = b * S + c * L;
    LAS float* G2 = (LAS float*)(lds + OFF_F) + 384; LAS float* scal = (LAS float*)(lds + OFF_F) + 512;
    u32x4 vraw[2], kraw[2][4];
    vt_load(z, head, tok0, tid, vraw);
#pragma unroll
    for (int it = 0; it < 2; ++it) { const int idx = tid + it * NTHREADS; conv8_load(z, b, c * L + (idx & 127), 1, head, (idx >> 7) * 8, kraw[it]); }
    __syncthreads();
    stage_gates(lds, gates, P, l, head, tok0, tid);
    const float gmax = scal[0], bL = scal[1];
    vt_store(lds, tid, vraw);
    const float* cw = P.in[I_CONVW] + (size_t)l * 4 * 512;
#pragma unroll
    for (int it = 0; it < 2; ++it) { const int idx = tid + it * NTHREADS, s = idx & 127, cg = idx >> 7;
        float o[8]; conv8_finish(kraw[it], cw, c * L + s, 1, head, cg * 8, o);
        const float ws = __expf(G2[s] - gmax);
#pragma unroll
        for (int e = 0; e < 8; ++e) *(LAS unsigned short*)(lds + OFF_KT + (cg * 8 + e) * TP + s * 2) = bf1(o[e] * ws); }
    __syncthreads();
    const int kt = wid >> 1;
    float* CL = (float*)(wsm + O_CL) + (size_t)u * 4096;
#pragma unroll
    for (int i = 0; i < 2; ++i) { const int vt = (wid & 1) * 2 + i; f32x4 acc = {0.f, 0.f, 0.f, 0.f};
#pragma unroll
        for (int ks = 0; ks < 4; ++ks) { const bf16x8 a = *(const LAS bf16x8*)(lds + OFF_KT + (16 * kt + r) * TP + (32 * ks + 8 * qd) * 2), bb = *(const LAS bf16x8*)(lds + OFF_VT + (16 * vt + r) * TP + (32 * ks + 8 * qd) * 2);
            acc = mfma16(a, bb, acc); }
        *(f32x4*)(CL + (size_t)(16 * vt + r) * 64 + 16 * kt + 4 * qd) = acc; }
    if (tid < 64) { float sum = 0.f;
        for (int s2 = 0; s2 < 128; s2 += 2) { const unsigned w2 = *(const LAS unsigned*)(lds + OFF_KT + tid * TP + s2 * 2); sum += bf_lo(w2) + bf_hi(w2); }
        ((float*)(wsm + O_NL))[(size_t)u * 64 + tid] = sum; }
    if (tid == 0) { ((float*)(wsm + O_MLOC))[u] = bL + gmax; ((float*)(wsm + O_BL))[u] = bL; }
}
__device__ __forceinline__ void p2_scan(unsigned char* wsm) {
    const int tid = tid_opaque();
    const float* CL = (const float*)(wsm + O_CL); const float* NL = (const float*)(wsm + O_NL); const float* MLOC = (const float*)(wsm + O_MLOC); const float* BL = (const float*)(wsm + O_BL);
    bf16_t* CST = (bf16_t*)(wsm + O_CST); float* NST = (float*)(wsm + O_NST); float* MST = (float*)(wsm + O_MST);
    for (int idx = blockIdx.x * NTHREADS + tid; idx < 32 * 4096; idx += gridDim.x * NTHREADS) {
        const int bh = idx >> 12, e = idx & 4095;
        float C = 0.f, nn = 0.f, m = 0.f;
#pragma unroll 1
        for (int c0 = 0; c0 < NCH; c0 += 16) {
            float cl[16], ml_[16], bl[16], nl[16];
#pragma unroll
            for (int i = 0; i < 16; ++i) { const int u = bh * NCH + c0 + i; cl[i] = CL[(size_t)u * 4096 + e]; ml_[i] = MLOC[u]; bl[i] = BL[u]; nl[i] = NL[(size_t)u * 64 + (e & 63)]; }
            unsigned short cs[16]; float ns[16], ms[16];
#pragma unroll
            for (int i = 0; i < 16; ++i) { cs[i] = bf1(C); ns[i] = nn; ms[i] = m;
                const float mn = fmaxf(bl[i] + m, ml_[i]), dec = __expf(bl[i] + m - mn), wl = __expf(ml_[i] - mn);
                C = dec * C + wl * cl[i]; nn = dec * nn + wl * nl[i]; m = mn; }
#pragma unroll
            for (int i = 0; i < 16; ++i) { const int u = bh * NCH + c0 + i; CST[(size_t)u * 4096 + e] = cs[i]; if (e < 64) NST[(size_t)u * 64 + e] = ns[i]; if (e == 0) MST[u] = ms[i]; }
        }
    }
}
__device__ __forceinline__ void p3_unit(LAS unsigned char* lds, const bf16_t* z, const float* gates, const Params& P, int l, int u, const unsigned char* wsm, bf16_t* mix) {
    const int tid = tid_opaque(), lane = tid & 63, wid = __builtin_amdgcn_readfirstlane(tid >> 6), r = lane & 15, qd = lane >> 4;
    const int b = u >> 8, head = (u >> 6) & 3, c = u & 63, tok0 = b * S + c * L;
    LAS float* Bc = (LAS float*)(lds + OFF_F) + 256; LAS float* G2 = (LAS float*)(lds + OFF_F) + 384;
    u32x4 vraw[2], qkraw[4][4];
    vt_load(z, head, tok0, tid, vraw);
#pragma unroll
    for (int it = 0; it < 4; ++it) { const int idx = tid + it * NTHREADS; conv8_load(z, b, c * L + ((idx >> 3) & 127), idx >> 10, head, (idx & 7) * 8, qkraw[it]); }
    __syncthreads();
    stage_gates(lds, gates, P, l, head, tok0, tid);
    vt_store(lds, tid, vraw);
    const float* cw = P.in[I_CONVW] + (size_t)l * 4 * 512;
#pragma unroll
    for (int it = 0; it < 4; ++it) { const int idx = tid + it * NTHREADS, which = idx >> 10, s = (idx >> 3) & 127, cg = idx & 7;
        float o[8]; conv8_finish(qkraw[it], cw, c * L + s, which, head, cg * 8, o);
        u32x4 w; w.x = pg8::cvt_pk_bf16(o[0], o[1]); w.y = pg8::cvt_pk_bf16(o[2], o[3]); w.z = pg8::cvt_pk_bf16(o[4], o[5]); w.w = pg8::cvt_pk_bf16(o[6], o[7]);
        *(LAS u32x4*)(lds + (which ? OFF_K : OFF_Q) + s * QP + cg * 16) = w; }
    __syncthreads();
    const int w = wid, t = 16 * w + r;
    const bf16x8 bq0 = *(const LAS bf16x8*)(lds + OFF_Q + t * QP + qd * 16), bq1 = *(const LAS bf16x8*)(lds + OFF_Q + t * QP + 64 + qd * 16);
    f32x4 accS[8];
#pragma unroll
    for (int ct = 0; ct < 8; ++ct) { accS[ct] = (f32x4){0.f, 0.f, 0.f, 0.f};
        if (ct <= w) { const bf16x8 a0 = *(const LAS bf16x8*)(lds + OFF_K + (16 * ct + r) * QP + qd * 16), a1 = *(const LAS bf16x8*)(lds + OFF_K + (16 * ct + r) * QP + 64 + qd * 16);
            accS[ct] = mfma16(a0, bq0, accS[ct]); accS[ct] = mfma16(a1, bq1, accS[ct]); } }
    const float bt = Bc[t], mst = ((const float*)(wsm + O_MST))[u];
    float ld[8][4]; float mloc = -3.0e38f;
#pragma unroll
    for (int ct = 0; ct < 8; ++ct) { const f32x4 g = *(const LAS f32x4*)(G2 + 16 * ct + 4 * qd);
#pragma unroll
        for (int j = 0; j < 4; ++j) { const bool valid = (ct < w) || (ct == w && 4 * qd + j <= r); ld[ct][j] = valid ? bt + g[j] : -3.0e38f; mloc = fmaxf(mloc, ld[ct][j]); } }
    mloc = fmaxf(mloc, __shfl_xor(mloc, 16)); mloc = fmaxf(mloc, __shfl_xor(mloc, 32));
    const float mt = fmaxf(bt + mst, mloc);
    float den = 0.f;
#pragma unroll
    for (int ct = 0; ct < 8; ++ct)
#pragma unroll
        for (int j = 0; j < 4; ++j) { const float pe = __expf(ld[ct][j] - mt) * accS[ct][j]; accS[ct][j] = pe; den += pe; }
    den += __shfl_xor(den, 16); den += __shfl_xor(den, 32);
    const bf16_t* cst = (const bf16_t*)(wsm + O_CST) + (size_t)u * 4096; const float* nst = (const float*)(wsm + O_NST) + (size_t)u * 64;
    f32x4 accN[4];
#pragma unroll
    for (int dt = 0; dt < 4; ++dt) { const bf16x8 c0 = *(const bf16x8*)(cst + (16 * dt + r) * 64 + 8 * qd), c1 = *(const bf16x8*)(cst + (16 * dt + r) * 64 + 32 + 8 * qd);
        accN[dt] = mfma16(c0, bq0, (f32x4){0.f, 0.f, 0.f, 0.f}); accN[dt] = mfma16(c1, bq1, accN[dt]); }
    const float winter = __expf(bt + mst - mt);
    float nq = 0.f;
    { const float4 n0 = *(const float4*)(nst + 8 * qd), n1 = *(const float4*)(nst + 8 * qd + 4), n2 = *(const float4*)(nst + 32 + 8 * qd), n3 = *(const float4*)(nst + 36 + 8 * qd);
      const u32x4 q0 = __builtin_bit_cast(u32x4, bq0), q1 = __builtin_bit_cast(u32x4, bq1);
      nq = bf_lo(q0.x) * n0.x + bf_hi(q0.x) * n0.y + bf_lo(q0.y) * n0.z + bf_hi(q0.y) * n0.w + bf_lo(q0.z) * n1.x + bf_hi(q0.z) * n1.y + bf_lo(q0.w) * n1.z + bf_hi(q0.w) * n1.w
         + bf_lo(q1.x) * n2.x + bf_hi(q1.x) * n2.y + bf_lo(q1.y) * n2.z + bf_hi(q1.y) * n2.w + bf_lo(q1.z) * n3.x + bf_hi(q1.z) * n3.y + bf_lo(q1.w) * n3.z + bf_hi(q1.w) * n3.w; }
    nq += __shfl_xor(nq, 16); nq += __shfl_xor(nq, 32);
    den += winter * nq;
#pragma unroll
    for (int dt = 0; dt < 4; ++dt) accN[dt] = accN[dt] * winter;
#pragma unroll
    for (int kk = 0; kk < 4; ++kk) if (2 * kk <= w) {
        u32x4 pw; pw.x = pg8::cvt_pk_bf16(accS[2 * kk][0], accS[2 * kk][1]); pw.y = pg8::cvt_pk_bf16(accS[2 * kk][2], accS[2 * kk][3]);
        pw.z = pg8::cvt_pk_bf16(accS[2 * kk + 1][0], accS[2 * kk + 1][1]); pw.w = pg8::cvt_pk_bf16(accS[2 * kk + 1][2], accS[2 * kk + 1][3]);
        const bf16x8 pf = __builtin_bit_cast(bf16x8, pw);
#pragma unroll
        for (int dt = 0; dt < 4; ++dt) { const u32x2 v0 = *(const LAS u32x2*)(lds + OFF_VT + (16 * dt + r) * TP + (32 * kk + 4 * qd) * 2), v1 = *(const LAS u32x2*)(lds + OFF_VT + (16 * dt + r) * TP + (32 * kk + 16 + 4 * qd) * 2);
            u32x4 vw; vw.x = v0.x; vw.y = v0.y; vw.z = v1.x; vw.w = v1.y;
            accN[dt] = mfma16(__builtin_bit_cast(bf16x8, vw), pf, accN[dt]); } }
    const float inv = 1.f / fmaxf(fabsf(den), __expf(-mt));
    float ss = 0.f;
#pragma unroll
    for (int dt = 0; dt < 4; ++dt) { accN[dt] = accN[dt] * inv; ss += accN[dt][0] * accN[dt][0] + accN[dt][1] * accN[dt][1] + accN[dt][2] * accN[dt][2] + accN[dt][3] * accN[dt][3]; }
    ss += __shfl_xor(ss, 16); ss += __shfl_xor(ss, 32);
    const float rs = rsqrtf(ss * (1.f / 64.f) + EPS);
    const float* ng = P.in[I_MNG] + l * 256 + head * 64; const bf16_t* cop = z + (size_t)(tok0 + t) * ZW + ZCO + head * 64;
    bf16_t* op = mix + (size_t)(tok0 + t) * D + 512 + head * 64;
#pragma unroll
    for (int dt = 0; dt < 4; ++dt) { const int d0 = 16 * dt + 4 * qd; const float4 g = *(const float4*)(ng + d0); const u32x2 cw2 = *(const u32x2*)(cop + d0); const float4 co = make_float4(bf_lo(cw2.x), bf_hi(cw2.x), bf_lo(cw2.y), bf_hi(cw2.y));
        u32x2 o; o.x = pg8::cvt_pk_bf16(accN[dt][0] * rs * g.x / (1.f + __expf(-co.x)), accN[dt][1] * rs * g.y / (1.f + __expf(-co.y)));
        o.y = pg8::cvt_pk_bf16(accN[dt][2] * rs * g.z / (1.f + __expf(-co.z)), accN[dt][3] * rs * g.w / (1.f + __expf(-co.w)));
        *(u32x2*)(op + d0) = o; }
}
static_assert(O_END <= 64 * MiB && LDS_END <= 128 * 1024, "mLSTM scratch fits");
}

namespace s5 {
using pg8::bf16x8; using pg8::f32x4; using pg8::u32x4; using pg8::u32x2;
constexpr int LC = 16, NINST = NTOK / LC;
constexpr size_t O_E = 0, O_XC = O_E + (size_t)NINST * 16 * 128 * 4, O_END = O_XC + (size_t)NINST * 16 * 128 * 2;
constexpr int YP = 528;
__device__ __forceinline__ f32x4 mfma16(bf16x8 a, bf16x8 b, f32x4 c) { return __builtin_amdgcn_mfma_f32_16x16x32_bf16(a, b, c, 0, 0, 0); }

__device__ __forceinline__ void build_tables(float* ldsf, const Params& P, int l, int g, unsigned char* tb) {
    const int tid = tid_opaque();
    float* apw = ldsf; float* bb = apw + 17 * 64 * 2; float* cc = bb + 64 * 16 * 2;
    __syncthreads();
    if (tid < 64) { const int gp = (l * 16 + g) * 64 + tid;
        const float ar = P.in[I_ARE][gp], ai = P.in[I_AIM][gp], dt = expf(P.in[I_LDT][l * 16 + g]);
        for (int tau = 0; tau <= 16; ++tau) { const float er = expf(ar * dt * tau), ang = ai * dt * tau; apw[(tau * 64 + tid) * 2] = er * cosf(ang); apw[(tau * 64 + tid) * 2 + 1] = er * sinf(ang); }
        const float abr = apw[(64 + tid) * 2], abi = apw[(64 + tid) * 2 + 1];
        const float xr_ = abr - 1.f, xi_ = abi, den = ar * ar + ai * ai;
        const float cr = (xr_ * ar + xi_ * ai) / den, ci = (xi_ * ar - xr_ * ai) / den;
        for (int h = 0; h < 16; ++h) { const float br = P.in[I_BRE][(size_t)gp * 16 + h], bi = P.in[I_BIM][(size_t)gp * 16 + h]; bb[(tid * 16 + h) * 2] = cr * br - ci * bi; bb[(tid * 16 + h) * 2 + 1] = cr * bi + ci * br; }
        float* a16 = (float*)(tb + T_A16) + (size_t)(g * 64 + tid) * 2; a16[0] = apw[(16 * 64 + tid) * 2]; a16[1] = apw[(16 * 64 + tid) * 2 + 1]; }
    for (int idx = tid; idx < 16 * 64; idx += NTHREADS) { const int h = idx >> 6, p = idx & 63; const int ci_ = ((l * 16 + g) * 16 + h) * 64 + p; cc[idx * 2] = P.in[I_CRE][ci_]; cc[idx * 2 + 1] = P.in[I_CIM][ci_]; }
    __syncthreads();
    bf16_t* KM = (bf16_t*)(tb + T_KMAT) + (size_t)g * 32 * 256;
    for (int idx = tid; idx < 15 * 256; idx += NTHREADS) KM[idx] = (bf16_t)0; bf16_t* FT = (bf16_t*)(tb + T_F) + (size_t)g * 256 * 128; bf16_t* GT = (bf16_t*)(tb + T_G) + (size_t)g * 128 * 256;
    for (int idx = tid; idx < 16 * 256; idx += NTHREADS) { const int tau = idx >> 8, h = (idx >> 4) & 15, hp = idx & 15; float s = 0.f;
        for (int p = 0; p < 64; ++p) { const float cr = cc[(h * 64 + p) * 2], ci = cc[(h * 64 + p) * 2 + 1], ar = apw[(tau * 64 + p) * 2], ai = apw[(tau * 64 + p) * 2 + 1], br = bb[(p * 16 + hp) * 2], bi = bb[(p * 16 + hp) * 2 + 1];
            const float er = ar * br - ai * bi, ei = ar * bi + ai * br; s += cr * er - ci * ei; }
        KM[15 * 256 + idx] = ml::bf1(s); }
    for (int idx = tid; idx < 256 * 64; idx += NTHREADS) { const int n = idx >> 6, p = idx & 63, t = n >> 4, h = n & 15;
        const float cr = cc[(h * 64 + p) * 2], ci = cc[(h * 64 + p) * 2 + 1], ar = apw[((t + 1) * 64 + p) * 2], ai = apw[((t + 1) * 64 + p) * 2 + 1];
        FT[(size_t)n * 128 + p] = ml::bf1(cr * ar - ci * ai); FT[(size_t)n * 128 + 64 + p] = ml::bf1(-(cr * ai + ci * ar)); }
    for (int idx = tid; idx < 64 * 256; idx += NTHREADS) { const int p = idx >> 8, k = idx & 255, s = k >> 4, hp = k & 15;
        const float ar = apw[((15 - s) * 64 + p) * 2], ai = apw[((15 - s) * 64 + p) * 2 + 1], br = bb[(p * 16 + hp) * 2], bi = bb[(p * 16 + hp) * 2 + 1];
        GT[(size_t)p * 256 + k] = ml::bf1(ar * br - ai * bi); GT[(size_t)(64 + p) * 256 + k] = ml::bf1(ar * bi + ai * br); }
}
__device__ __forceinline__ void load_u_frags(const bf16_t* z, int tok0, int g, int r, int qd, bf16x8 (&uf)[8]) {
#pragma unroll
    for (int ks = 0; ks < 8; ++ks) uf[ks] = *(const bf16x8*)(z + (size_t)(tok0 + 16 * r + 2 * ks + (qd >> 1)) * ZW + ZSU + 16 * g + 8 * (qd & 1));
}
__device__ __forceinline__ void p1_unit(const bf16_t* z, const unsigned char* tb, int u, unsigned char* wss) {
    const int tid = tid_opaque(), lane = tid & 63, wid = __builtin_amdgcn_readfirstlane(tid >> 6), r = lane & 15, qd = lane >> 4;
    const int tok0 = u * 256, inst0 = u * 16;
    float* E = (float*)(wss + O_E);
#pragma unroll 1
    for (int gi = 0; gi < 2; ++gi) { const int g = 2 * wid + gi;
        bf16x8 uf[8]; load_u_frags(z, tok0, g, r, qd, uf);
        const bf16_t* GT = (const bf16_t*)(tb + T_G) + (size_t)g * 128 * 256 + (size_t)r * 256 + 8 * qd;
        bf16x8 gf[2][8];
#pragma unroll
        for (int ks = 0; ks < 8; ++ks) gf[0][ks] = *(const bf16x8*)(GT + 32 * ks);
#pragma unroll
        for (int nt = 0; nt < 8; ++nt) {
            if (nt + 1 < 8) {
#pragma unroll
                for (int ks = 0; ks < 8; ++ks) gf[(nt + 1) & 1][ks] = *(const bf16x8*)(GT + (size_t)(16 * (nt + 1)) * 256 + 32 * ks); }
            __builtin_amdgcn_sched_barrier(0);
            f32x4 acc = {0.f, 0.f, 0.f, 0.f};
#pragma unroll
            for (int ks = 0; ks < 8; ++ks) acc = mfma16(gf[nt & 1][ks], uf[ks], acc);
            *(f32x4*)(E + ((size_t)(inst0 + r) * 16 + g) * 128 + 16 * nt + 4 * qd) = acc;
            __builtin_amdgcn_sched_barrier(0); }
    }
}
__device__ __forceinline__ void p2_scan(LAS unsigned char* lds, const unsigned char* tb, unsigned char* wss) {
    const int tid = tid_opaque(), p = tid & 63, seg = tid >> 6;
    const float* __restrict__ E = (const float*)(wss + O_E); bf16_t* __restrict__ XC = (bf16_t*)(wss + O_XC);
    LAS float* SE = (LAS float*)lds;
    for (int u = blockIdx.x; u < NB * 16; u += gridDim.x) {
        const int b = u >> 4, g = u & 15;
        const float* a16 = (const float*)(tb + T_A16) + (size_t)(g * 64 + p) * 2; const float ar = a16[0], ai = a16[1];
        const size_t o0 = ((size_t)(b * (S / LC) + seg * 64) * 16 + g) * 128 + p; constexpr size_t cs = (size_t)16 * 128;
        float xr = 0.f, xi = 0.f;
#pragma unroll 1
        for (int c0 = 0; c0 < 64; c0 += 16) { float er[16], ei[16];
#pragma unroll
            for (int i = 0; i < 16; ++i) { er[i] = E[o0 + (c0 + i) * cs]; ei[i] = E[o0 + (c0 + i) * cs + 64]; }
#pragma unroll
            for (int i = 0; i < 16; ++i) { const float nr = ar * xr - ai * xi + er[i], ni = ar * xi + ai * xr + ei[i]; xr = nr; xi = ni; } }
        __syncthreads();
        SE[(seg * 64 + p) * 2] = xr; SE[(seg * 64 + p) * 2 + 1] = xi;
        __syncthreads();
        float br = ar, bi = ai;
#pragma unroll
        for (int i = 0; i < 6; ++i) { const float nr = br * br - bi * bi, ni = 2.f * br * bi; br = nr; bi = ni; }
        xr = 0.f; xi = 0.f;
        for (int s2 = 0; s2 < seg; ++s2) { const float er = SE[(s2 * 64 + p) * 2], ei = SE[(s2 * 64 + p) * 2 + 1]; const float nr = br * xr - bi * xi + er, ni = br * xi + bi * xr + ei; xr = nr; xi = ni; }
#pragma unroll 1
        for (int c0 = 0; c0 < 64; c0 += 16) { float er[16], ei[16]; unsigned short sr[16], si[16];
#pragma unroll
            for (int i = 0; i < 16; ++i) { er[i] = E[o0 + (c0 + i) * cs]; ei[i] = E[o0 + (c0 + i) * cs + 64]; }
#pragma unroll
            for (int i = 0; i < 16; ++i) { sr[i] = ml::bf1(xr); si[i] = ml::bf1(xi); const float nr = ar * xr - ai * xi + er[i], ni = ar * xi + ai * xr + ei[i]; xr = nr; xi = ni; }
#pragma unroll
            for (int i = 0; i < 16; ++i) { XC[o0 + (c0 + i) * cs] = sr[i]; XC[o0 + (c0 + i) * cs + 64] = si[i]; } }
    }
    __syncthreads();
}
__device__ __forceinline__ void p3_unit(LAS unsigned char* lds, const bf16_t* z, const Params& P, int l, const unsigned char* tb, int u, const unsigned char* wss, bf16_t* mix) {
    const int tid = tid_opaque(), lane = tid & 63, wid = __builtin_amdgcn_readfirstlane(tid >> 6), r = lane & 15, qd = lane >> 4;
    const int tok0 = u * 256, inst0 = u * 16;
    const bf16_t* XC = (const bf16_t*)(wss + O_XC);
    __syncthreads();
#pragma unroll 1
    for (int gi = 0; gi < 2; ++gi) { const int g = 2 * wid + gi;
        bf16x8 uf[8]; load_u_frags(z, tok0, g, r, qd, uf);
        bf16x8 xf[4];
#pragma unroll
        for (int ks = 0; ks < 4; ++ks) xf[ks] = *(const bf16x8*)(XC + ((size_t)(inst0 + r) * 16 + g) * 128 + 32 * ks + 8 * qd);
        const bf16_t* KM = (const bf16_t*)(tb + T_KMAT) + (size_t)g * 32 * 256 + (size_t)(15 - (qd >> 1)) * 256 + r * 16 + 8 * (qd & 1);
        const bf16_t* FT = (const bf16_t*)(tb + T_F) + (size_t)g * 256 * 128 + (size_t)r * 128 + 8 * qd;
        const bf16_t* up = z + (size_t)(tok0 + 16 * r) * ZW + ZSU + 16 * g + 4 * qd;
        const float4 dsk = *(const float4*)(P.in[I_SD] + l * 256 + g * 16 + 4 * qd);
        bf16x8 kf[2][8], ff[2][4]; u32x2 uw[2];
#pragma unroll
        for (int ks = 0; ks < 8; ++ks) kf[0][ks] = *(const bf16x8*)(KM + (ptrdiff_t)(0 - 2 * ks) * 256);
#pragma unroll
        for (int ks = 0; ks < 4; ++ks) ff[0][ks] = *(const bf16x8*)(FT + 32 * ks);
        uw[0] = *(const u32x2*)up;
#pragma unroll
        for (int t = 0; t < 16; ++t) {
            if (t + 1 < 16) {
#pragma unroll
                for (int ks = 0; ks < 8; ++ks) kf[(t + 1) & 1][ks] = *(const bf16x8*)(KM + (ptrdiff_t)(t + 1 - 2 * ks) * 256);
#pragma unroll
                for (int ks = 0; ks < 4; ++ks) ff[(t + 1) & 1][ks] = *(const bf16x8*)(FT + (size_t)(t + 1) * 16 * 128 + 32 * ks);
                uw[(t + 1) & 1] = *(const u32x2*)(up + (size_t)(t + 1) * ZW); }
            __builtin_amdgcn_sched_barrier(0);
            f32x4 acc = {0.f, 0.f, 0.f, 0.f};
#pragma unroll
            for (int ks = 0; ks < 8; ++ks) if (2 * ks <= t) acc = mfma16(kf[t & 1][ks], uf[ks], acc);
#pragma unroll
            for (int ks = 0; ks < 4; ++ks) acc = mfma16(ff[t & 1][ks], xf[ks], acc);
            const u32x2 uu = uw[t & 1];
            const float y0 = gelu_tanh(acc[0] + dsk.x * ml::bf_lo(uu.x)), y1 = gelu_tanh(acc[1] + dsk.y * ml::bf_hi(uu.x)), y2 = gelu_tanh(acc[2] + dsk.z * ml::bf_lo(uu.y)), y3 = gelu_tanh(acc[3] + dsk.w * ml::bf_hi(uu.y));
            u32x2 o; o.x = pg8::cvt_pk_bf16(y0, y1); o.y = pg8::cvt_pk_bf16(y2, y3);
            *(LAS u32x2*)(lds + (16 * r + t) * YP + (16 * g + 4 * qd) * 2) = o;
            __builtin_amdgcn_sched_barrier(0); }
    }
    __syncthreads();
    const bf16_t* GW = (const bf16_t*)(tb + T_GLUW);
    bf16x8 wf[2][8];
#pragma unroll
    for (int nt = 0; nt < 2; ++nt)
#pragma unroll
        for (int ks = 0; ks < 8; ++ks) wf[nt][ks] = *(const bf16x8*)(GW + (size_t)(32 * wid + 16 * nt + r) * 256 + 32 * ks + 8 * qd);
    const float* gb = P.in[I_GLUB] + l * 256;
    const float4 gb0 = *(const float4*)(gb + 32 * wid + 4 * qd), gb1 = *(const float4*)(gb + 32 * wid + 16 + 4 * qd);
#pragma unroll 2
    for (int mt = 0; mt < 16; ++mt) {
        f32x4 a0 = {0.f, 0.f, 0.f, 0.f}, a1 = {0.f, 0.f, 0.f, 0.f};
#pragma unroll
        for (int ks = 0; ks < 8; ++ks) { const bf16x8 yf = *(const LAS bf16x8*)(lds + (16 * mt + r) * YP + (32 * ks + 8 * qd) * 2); a0 = mfma16(wf[0][ks], yf, a0); a1 = mfma16(wf[1][ks], yf, a1); }
        const int row = 16 * mt + r;
        const u32x2 y0 = *(const LAS u32x2*)(lds + row * YP + (32 * wid + 4 * qd) * 2), y1 = *(const LAS u32x2*)(lds + row * YP + (32 * wid + 16 + 4 * qd) * 2);
        bf16_t* op = mix + (size_t)(tok0 + row) * D + 256 + 32 * wid + 4 * qd;
        u32x2 o;
        o.x = pg8::cvt_pk_bf16(ml::bf_lo(y0.x) / (1.f + __expf(-(a0[0] + gb0.x))), ml::bf_hi(y0.x) / (1.f + __expf(-(a0[1] + gb0.y))));
        o.y = pg8::cvt_pk_bf16(ml::bf_lo(y0.y) / (1.f + __expf(-(a0[2] + gb0.z))), ml::bf_hi(y0.y) / (1.f + __expf(-(a0[3] + gb0.w))));
        *(u32x2*)op = o;
        o.x = pg8::cvt_pk_bf16(ml::bf_lo(y1.x) / (1.f + __expf(-(a1[0] + gb1.x))), ml::bf_hi(y1.x) / (1.f + __expf(-(a1[1] + gb1.y))));
        o.y = pg8::cvt_pk_bf16(ml::bf_lo(y1.y) / (1.f + __expf(-(a1[2] + gb1.z))), ml::bf_hi(y1.y) / (1.f + __expf(-(a1[3] + gb1.w))));
        *(u32x2*)(op + 16) = o;
    }
}
static_assert(T_LAYER <= 4 * MiB && O_END <= 48 * MiB && 256 * YP <= LDS_BYTES - 64, "S5 scratch fits");
}
__device__ __forceinline__ void s5_build_tables_fwd(float* ldsf, const Params& P, int l, int g, unsigned char* tb) { s5::build_tables(ldsf, P, l, g, tb); }

namespace at {
using pg8::bf16x8; using pg8::f32x4; using pg8::u32x4; using pg8::u32x2;
constexpr int KP = 144, VP = 528, OFF_K = 0, OFF_VT = 256 * KP, LDS_END = OFF_VT + 64 * VP;
__device__ __forceinline__ void unit(LAS unsigned char* lds, const bf16_t* z, const float* sinks, bf16_t* mix, int u) {
    const int tid = tid_opaque(), lane = tid & 63, wid = __builtin_amdgcn_readfirstlane(tid >> 6), r = lane & 15, qd = lane >> 4;
    const int b = u >> 7, g = (u >> 6) & 1, n = u & 63, tokb = b * S + 128 * n;
    const int hq = 2 * g + (wid >> 2);
    const float sink = sinks[hq];
    __syncthreads();
#pragma unroll
    for (int it = 0; it < 4; ++it) { const int idx = tid + it * NTHREADS, kl = idx >> 3, cg = idx & 7; const bool ok = (n > 0) || (kl >= 128);
        u32x4 w = *(const u32x4*)(z + (size_t)(ok ? tokb - 128 + kl : tokb) * ZW + ZK + g * 64 + cg * 8); if (!ok) w = (u32x4){0u, 0u, 0u, 0u};
        *(LAS u32x4*)(lds + OFF_K + kl * KP + cg * 16) = w; }
#pragma unroll
    for (int it = 0; it < 4; ++it) { const int idx = tid + it * NTHREADS, kl = idx & 255, cg = idx >> 8; const bool ok = (n > 0) || (kl >= 128);
        u32x4 w = *(const u32x4*)(z + (size_t)(ok ? tokb - 128 + kl : tokb) * ZW + ZV + g * 64 + cg * 8); if (!ok) w = (u32x4){0u, 0u, 0u, 0u};
        const unsigned ww[4] = {w.x, w.y, w.z, w.w};
#pragma unroll
        for (int e = 0; e < 8; ++e) *(LAS unsigned short*)(lds + OFF_VT + (cg * 8 + e) * VP + kl * 2) = (unsigned short)((e & 1) ? (ww[e >> 1] >> 16) : (ww[e >> 1] & 0xffffu)); }
    __syncthreads();
#pragma unroll 1
    for (int qt = 0; qt < 2; ++qt) {
        const int i0 = (wid & 3) * 32 + qt * 16, kt0 = i0 >> 4, tok = tokb + i0 + r;
        const bf16x8 bq0 = *(const bf16x8*)(z + (size_t)tok * ZW + ZQ + hq * 64 + 8 * qd), bq1 = *(const bf16x8*)(z + (size_t)tok * ZW + ZQ + hq * 64 + 32 + 8 * qd);
        f32x4 accS[9];
#pragma unroll
        for (int c = 0; c < 9; ++c) { const int kt = kt0 + c;
            const bf16x8 a0 = *(const LAS bf16x8*)(lds + OFF_K + (16 * kt + r) * KP + qd * 16), a1 = *(const LAS bf16x8*)(lds + OFF_K + (16 * kt + r) * KP + 64 + qd * 16);
            accS[c] = ml::mfma16(a0, bq0, (f32x4){0.f, 0.f, 0.f, 0.f}); accS[c] = ml::mfma16(a1, bq1, accS[c]); }
        float m = sink;
#pragma unroll
        for (int c = 0; c < 9; ++c)
#pragma unroll
            for (int j = 0; j < 4; ++j) { const int e = 4 * qd + j;
                bool valid = (c == 0) ? (e > r) : ((c == 8) ? (e <= r) : true);
                valid = valid && ((n > 0) || (kt0 + c >= 8));
                const float s = valid ? accS[c][j] * 0.125f : -3.0e38f; accS[c][j] = s; m = fmaxf(m, s); }
        m = fmaxf(m, __shfl_xor(m, 16)); m = fmaxf(m, __shfl_xor(m, 32));
        float l = 0.f;
#pragma unroll
        for (int c = 0; c < 9; ++c)
#pragma unroll
            for (int j = 0; j < 4; ++j) { const float p = __expf(accS[c][j] - m); accS[c][j] = p; l += p; }
        l += __shfl_xor(l, 16); l += __shfl_xor(l, 32);
        l += __expf(sink - m);
        f32x4 accO[4];
#pragma unroll
        for (int dt = 0; dt < 4; ++dt) accO[dt] = (f32x4){0.f, 0.f, 0.f, 0.f};
#pragma unroll
        for (int kk = 0; kk < 5; ++kk) {
            u32x4 pw; pw.x = pg8::cvt_pk_bf16(accS[2 * kk][0], accS[2 * kk][1]); pw.y = pg8::cvt_pk_bf16(accS[2 * kk][2], accS[2 * kk][3]);
            if (kk < 4) { pw.z = pg8::cvt_pk_bf16(accS[2 * kk + 1][0], accS[2 * kk + 1][1]); pw.w = pg8::cvt_pk_bf16(accS[2 * kk + 1][2], accS[2 * kk + 1][3]); } else { pw.z = 0u; pw.w = 0u; }
            const bf16x8 pf = __builtin_bit_cast(bf16x8, pw);
            const int base = 16 * (kt0 + 2 * kk);
#pragma unroll
            for (int dt = 0; dt < 4; ++dt) { const u32x2 v0 = *(const LAS u32x2*)(lds + OFF_VT + (16 * dt + r) * VP + (base + 4 * qd) * 2);
                u32x2 v1 = {0u, 0u}; if (kk < 4) v1 = *(const LAS u32x2*)(lds + OFF_VT + (16 * dt + r) * VP + (base + 16 + 4 * qd) * 2);
                u32x4 vw; vw.x = v0.x; vw.y = v0.y; vw.z = v1.x; vw.w = v1.y;
                accO[dt] = ml::mfma16(__builtin_bit_cast(bf16x8, vw), pf, accO[dt]); } }
        const float inv = 1.f / l;
        bf16_t* op = mix + (size_t)tok * D + hq * 64;
#pragma unroll
        for (int dt = 0; dt < 4; ++dt) { u32x2 o; o.x = pg8::cvt_pk_bf16(accO[dt][0] * inv, accO[dt][1] * inv); o.y = pg8::cvt_pk_bf16(accO[dt][2] * inv, accO[dt][3] * inv);
            *(u32x2*)(op + 16 * dt + 4 * qd) = o; }
    }
}
}

namespace sg {
using pg8::bf16x8; using pg8::f32x4; using pg8::u32x4; using pg8::u32x2;
constexpr int TP = 272, OFF_VT = 0, OFF_ST = 256 * TP, LDS_END = OFF_ST + 128 * 4 * 2 * 4;
__device__ __forceinline__ void unit(LAS unsigned char* lds, const bf16_t* z, const Params& P, int l, const bf16_t* wb  , bf16_t* mix, int u) {
    const int tid = tid_opaque(), lane = tid & 63, wid = __builtin_amdgcn_readfirstlane(tid >> 6), r = lane & 15, qd = lane >> 4;
    const int tok0 = u * 128;
    LAS float* ST = (LAS float*)(lds + OFF_ST);
    __syncthreads();
    const int s = tid & 127, cq = tid >> 7;
    const bf16_t* gp = z + (size_t)(tok0 + s) * ZW + ZGV + cq * 64;
    u32x4 raw[8];
#pragma unroll
    for (int i = 0; i < 8; ++i) raw[i] = *(const u32x4*)(gp + 8 * i);
    const int t = 16 * wid + r;
    bf16x8 wf[2][4];
#pragma unroll
    for (int ks = 0; ks < 4; ++ks) wf[0][ks] = *(const bf16x8*)(wb + (size_t)t * 128 + 32 * ks + 8 * qd);
    float sm = 0.f, sq = 0.f;
#pragma unroll
    for (int i = 0; i < 8; ++i) { const unsigned ww[4] = {raw[i].x, raw[i].y, raw[i].z, raw[i].w};
#pragma unroll
        for (int e = 0; e < 8; ++e) { const float ge = gelu_tanh((e & 1) ? bfh(ww[e >> 1]) : bfl(ww[e >> 1])); sm += ge; sq += ge * ge; } }
    ST[(s * 4 + cq) * 2] = sm; ST[(s * 4 + cq) * 2 + 1] = sq;
    __syncthreads();
    { float tsm = 0.f, tsq = 0.f;
#pragma unroll
      for (int q = 0; q < 4; ++q) { tsm += ST[(s * 4 + q) * 2]; tsq += ST[(s * 4 + q) * 2 + 1]; }
      const float mu = tsm * (1.f / 256.f), var = fmaxf(tsq * (1.f / 256.f) - mu * mu, 0.f), rs = rsqrtf(var + EPS);
      const float* lg = P.in[I_LNG] + l * 256 + cq * 64; const float* lb = P.in[I_LNB] + l * 256 + cq * 64;
#pragma unroll
      for (int i = 0; i < 8; ++i) { const unsigned ww[4] = {raw[i].x, raw[i].y, raw[i].z, raw[i].w};
          const float4 g0 = *(const float4*)(lg + 8 * i), g1 = *(const float4*)(lg + 8 * i + 4), b0 = *(const float4*)(lb + 8 * i), b1 = *(const float4*)(lb + 8 * i + 4);
          const float gg[8] = {g0.x, g0.y, g0.z, g0.w, g1.x, g1.y, g1.z, g1.w}, bb[8] = {b0.x, b0.y, b0.z, b0.w, b1.x, b1.y, b1.z, b1.w};
#pragma unroll
          for (int e = 0; e < 8; ++e) *(LAS unsigned short*)(lds + OFF_VT + (cq * 64 + 8 * i + e) * TP + s * 2) = ml::bf1((gelu_tanh((e & 1) ? bfh(ww[e >> 1]) : bfl(ww[e >> 1])) - mu) * rs * gg[e] + bb[e]); } }
    __syncthreads();
#pragma unroll
    for (int g = 0; g < 4; ++g) {
        if (g + 1 < 4) {
#pragma unroll
            for (int ks = 0; ks < 4; ++ks) wf[(g + 1) & 1][ks] = *(const bf16x8*)(wb + ((size_t)(g + 1) * 128 + t) * 128 + 32 * ks + 8 * qd); }
        const float bias = P.in[I_SGUB][l * 512 + g * 128 + t];
        u32x2 gw[4];
#pragma unroll
        for (int ct = 0; ct < 4; ++ct) gw[ct] = *(const u32x2*)(z + (size_t)(tok0 + t) * ZW + ZGU + g * 64 + 16 * ct + 4 * qd);
#pragma unroll
        for (int ct = 0; ct < 4; ++ct) { f32x4 acc = {0.f, 0.f, 0.f, 0.f};
#pragma unroll
            for (int ks = 0; ks < 4; ++ks) if (2 * ks <= wid) acc = ml::mfma16(*(const LAS bf16x8*)(lds + OFF_VT + (g * 64 + 16 * ct + r) * TP + (32 * ks + 8 * qd) * 2), wf[g & 1][ks], acc);
            const int c0 = g * 64 + 16 * ct + 4 * qd;
            u32x2 o; o.x = pg8::cvt_pk_bf16(gelu_tanh(bfl(gw[ct].x)) * (acc[0] + bias), gelu_tanh(bfh(gw[ct].x)) * (acc[1] + bias)); o.y = pg8::cvt_pk_bf16(gelu_tanh(bfl(gw[ct].y)) * (acc[2] + bias), gelu_tanh(bfh(gw[ct].y)) * (acc[3] + bias));
            *(u32x2*)(mix + (size_t)(tok0 + t) * D + 768 + c0) = o; }
    }
}
}

__device__ __forceinline__ void ph_mix1(float* lds, const Params& P, int l, bf16_t* z, const float* gates, bf16_t* mix, unsigned char* wsm, unsigned char* wss, const unsigned char* tb, int sub) {
    const int G = gridDim.x, bid = blockIdx.x;
    if (sub & 1) for (int u = bid; u < ml::NU; u += G) ml::p1_unit((LAS unsigned char*)lds, z, gates, P, l, u, wsm);
    __syncthreads();
    if (sub & 2) for (int u = bid; u < NTOK / 256; u += G) s5::p1_unit(z, tb, u, wss);
    __syncthreads();
    if (sub & 4) for (int u = bid; u < 1024; u += G) at::unit((LAS unsigned char*)lds, z, P.in[I_SINK] + l * 4, mix, u);
    __syncthreads();
    if (sub & 8) for (int u = bid; u < NTOK / 128; u += G) sg::unit((LAS unsigned char*)lds, z, P, l, (const bf16_t*)(tb + s5::T_SGUW), mix, u);
    __syncthreads();
}

__device__ __forceinline__ void ph_mix2(float* lds, const Params& P, int l, const bf16_t* z, const float* gates, bf16_t* mix, const unsigned char* wsm, const unsigned char* wss, const unsigned char* tb, int sub) {
    if (sub & 1) for (int u = blockIdx.x; u < NTOK / 256; u += gridDim.x) s5::p3_unit((LAS unsigned char*)lds, z, P, l, tb, u, wss, mix);
    __syncthreads();
    if (sub & 2) for (int u = blockIdx.x; u < ml::NU; u += gridDim.x) ml::p3_unit((LAS unsigned char*)lds, z, gates, P, l, u, wsm, mix);
    __syncthreads();
}

__device__ __forceinline__ void ph_outproj(LAS unsigned char* ldsb, const bf16_t* mix, const bf16_t* wt, const float* xsrc, float* xout) {
    pg8::StaticOrder S; S.init(NTOK, D, D, D, gridDim.x, blockIdx.x, mix, wt);
    pg8::EpiRes E{xsrc, xout};
    pg8::gemm_phase<pg8::EpiRes, pg8::StaticOrder, false>(ldsb, D, D, S, E);
}

namespace rp {
using pg8::bf16x8; using pg8::f32x4; using pg8::u32x4;
constexpr size_t T_HI = 0, T_LO = (size_t)48 * D * 2, T_GHI = 2 * T_LO, T_GLO = T_GHI + (size_t)16 * D * 2, T_SIZE = T_GLO + (size_t)16 * D * 2;
static_assert(T_SIZE <= 256 * 1024, "row-pass tables fit their slot");
template <int NT, bool COMBINE> struct StepIn { float4 xa[2], xb[2]; u32x4 y1[2], y2[2]; float4 g0, g1; };
template <int NT> struct StepW { bf16x8 wh[NT], wl[NT]; };
__device__ __forceinline__ void build_base(LAS int* base, const unsigned* cnt) {
    __syncthreads();
    if (tid_opaque() == 0) { int b = 0; for (int e = 0; e < NEXP; ++e) { base[e] = b; b += (((int)cnt[e] + 255) >> 8) << 8; } }
    __syncthreads();
}
template <int NT, bool COMBINE>
__device__ __forceinline__ void run(LAS unsigned char* lds, const Params& P, int l, const float* x, float* xo, const bf16_t* YB, const unsigned* inv, const unsigned* cntprev,
                                    const float* gn, const bf16_t* WH, const bf16_t* WL, bf16_t* XN, float* RS, float* gates, unsigned* cnt, int2* lists, unsigned* invout) {
    const int tid = tid_opaque(), lane = tid & 63, wid = __builtin_amdgcn_readfirstlane(tid >> 6), r = lane & 15, qd = lane >> 4;
    LAS int* BASE = (LAS int*)(lds + 64 * 1024);
    LAS float* LG = (LAS float*)lds + wid * (32 * 49);
    if (COMBINE) build_base(BASE, cntprev);
    LAS unsigned* LCNT = (LAS unsigned*)(lds + 64 * 1024 + 256); LAS unsigned* GBASE = LCNT + 32;
    for (int rb0 = blockIdx.x * 8; rb0 < NTOK / 32; rb0 += gridDim.x * 8) {
        const int rb = rb0 + wid; const bool live = rb < NTOK / 32;
        const int row0 = (live ? rb : rb0) * 32;
        if (NT == 1 && !live) continue;
        size_t yr1[2] = {0, 0}, yr2[2] = {0, 0};
        if (COMBINE) {
#pragma unroll
            for (int mt = 0; mt < 2; ++mt) { const int row = row0 + 16 * mt + r; const unsigned i1 = inv[2 * row], i2 = inv[2 * row + 1];
                yr1[mt] = (size_t)(BASE[i1 >> 16] + (int)(i1 & 0xffffu)) * D; yr2[mt] = (size_t)(BASE[i2 >> 16] + (int)(i2 & 0xffffu)) * D; } }
        f32x4 acc[2][NT];
#pragma unroll
        for (int mt = 0; mt < 2; ++mt)
#pragma unroll
            for (int nt = 0; nt < NT; ++nt) acc[mt][nt] = (f32x4){0.f, 0.f, 0.f, 0.f};
        float ssq[2] = {0.f, 0.f};
        StepIn<NT, COMBINE> sb[3]; StepW<NT> sw[2];
        auto load = [&](StepIn<NT, COMBINE>& s, int ks) {
            const int k0 = 32 * ks + 8 * qd;
#pragma unroll
            for (int mt = 0; mt < 2; ++mt) { const float* xp = x + (size_t)(row0 + 16 * mt + r) * D + k0; s.xa[mt] = *(const float4*)xp; s.xb[mt] = *(const float4*)(xp + 4);
                if (COMBINE) { s.y1[mt] = *(const u32x4*)(YB + yr1[mt] + k0); s.y2[mt] = *(const u32x4*)(YB + yr2[mt] + k0); } }
            s.g0 = *(const float4*)(gn + k0); s.g1 = *(const float4*)(gn + k0 + 4);
        };
        auto loadw = [&](StepW<NT>& s, int ks) {
            const int k0 = 32 * ks + 8 * qd;
#pragma unroll
            for (int nt = 0; nt < NT; ++nt) { s.wh[nt] = *(const bf16x8*)(WH + (size_t)(16 * nt + r) * D + k0); s.wl[nt] = *(const bf16x8*)(WL + (size_t)(16 * nt + r) * D + k0); }
        };
        auto process = [&](const StepIn<NT, COMBINE>& s, const StepW<NT>& sw_, int ks) {
            const int k0 = 32 * ks + 8 * qd;
            bf16x8 xh[2], xl[2];
#pragma unroll
            for (int mt = 0; mt < 2; ++mt) { float4 a = s.xa[mt], b = s.xb[mt];
                if (COMBINE) { const u32x4 p = s.y1[mt], q = s.y2[mt];
                    a.x += bfl(p.x) + bfl(q.x); a.y += bfh(p.x) + bfh(q.x); a.z += bfl(p.y) + bfl(q.y); a.w += bfh(p.y) + bfh(q.y);
                    b.x += bfl(p.z) + bfl(q.z); b.y += bfh(p.z) + bfh(q.z); b.z += bfl(p.w) + bfl(q.w); b.w += bfh(p.w) + bfh(q.w);
                    float* op = xo + (size_t)(row0 + 16 * mt + r) * D + k0; *(float4*)op = a; *(float4*)(op + 4) = b; }
                ssq[mt] += a.x * a.x + a.y * a.y + a.z * a.z + a.w * a.w + b.x * b.x + b.y * b.y + b.z * b.z + b.w * b.w;
                const float v[8] = {a.x * s.g0.x, a.y * s.g0.y, a.z * s.g0.z, a.w * s.g0.w, b.x * s.g1.x, b.y * s.g1.y, b.z * s.g1.z, b.w * s.g1.w};
                u32x4 h; h.x = pg8::cvt_pk_bf16(v[0], v[1]); h.y = pg8::cvt_pk_bf16(v[2], v[3]); h.z = pg8::cvt_pk_bf16(v[4], v[5]); h.w = pg8::cvt_pk_bf16(v[6], v[7]);
                *(u32x4*)(XN + (size_t)(row0 + 16 * mt + r) * D + k0) = h;
                u32x4 lo; lo.x = pg8::cvt_pk_bf16(v[0] - bfl(h.x), v[1] - bfh(h.x)); lo.y = pg8::cvt_pk_bf16(v[2] - bfl(h.y), v[3] - bfh(h.y)); lo.z = pg8::cvt_pk_bf16(v[4] - bfl(h.z), v[5] - bfh(h.z)); lo.w = pg8::cvt_pk_bf16(v[6] - bfl(h.w), v[7] - bfh(h.w));
                xh[mt] = __builtin_bit_cast(bf16x8, h); xl[mt] = __builtin_bit_cast(bf16x8, lo); }
#pragma unroll
            for (int nt = 0; nt < NT; ++nt)
#pragma unroll
                for (int mt = 0; mt < 2; ++mt) { acc[mt][nt] = ml::mfma16(sw_.wh[nt], xh[mt], acc[mt][nt]); acc[mt][nt] = ml::mfma16(sw_.wl[nt], xh[mt], acc[mt][nt]); acc[mt][nt] = ml::mfma16(sw_.wh[nt], xl[mt], acc[mt][nt]); }
        };
        if (COMBINE || NT > 1) {
            load(sb[0], 0); loadw(sw[0], 0);
#pragma unroll 1
            for (int ks = 0; ks < 32; ks += 2) {
                load(sb[1], ks + 1); loadw(sw[1], ks + 1);
                process(sb[0], sw[0], ks);
                if (ks + 2 < 32) { load(sb[0], ks + 2); loadw(sw[0], ks + 2); }
                process(sb[1], sw[1], ks + 1);
            }
        } else {
            load(sb[0], 0); load(sb[1], 1); loadw(sw[0], 0);
#define RP_STEP(i, xs, ws) do { if ((i) + 2 < 32) load(sb[((xs) + 2) % 3], (i) + 2); if ((i) + 1 < 32) loadw(sw[((ws) + 1) % 2], (i) + 1); process(sb[xs], sw[ws], (i)); } while (0)
#pragma unroll 1
            for (int ks = 0; ks < 30; ks += 6) { RP_STEP(ks, 0, 0); RP_STEP(ks + 1, 1, 1); RP_STEP(ks + 2, 2, 0); RP_STEP(ks + 3, 0, 1); RP_STEP(ks + 4, 1, 0); RP_STEP(ks + 5, 2, 1); }
            RP_STEP(30, 0, 0); RP_STEP(31, 1, 1);
#undef RP_STEP
        }
        float rsv[2];
#pragma unroll
        for (int mt = 0; mt < 2; ++mt) { float s = ssq[mt]; s += __shfl_xor(s, 16); s += __shfl_xor(s, 32); rsv[mt] = rsqrtf(s * (1.f / D) + EPS);
            if (qd == 0) RS[row0 + 16 * mt + r] = rsv[mt]; }
        if (NT == 1) {
#pragma unroll
            for (int mt = 0; mt < 2; ++mt) if (qd < 2) { const f32x4 gv = acc[mt][0] * rsv[mt]; *(f32x4*)(gates + (size_t)(row0 + 16 * mt + r) * 8 + 4 * qd) = gv; }
        } else {
            const float* bg = P.in[I_RGB] + l * 4; const float* be = P.in[I_REB] + l * 32;
#pragma unroll
            for (int mt = 0; mt < 2; ++mt)
#pragma unroll
                for (int nt = 0; nt < NT; ++nt)
#pragma unroll
                    for (int j = 0; j < 4; ++j) LG[(16 * mt + r) * 49 + 16 * nt + 4 * qd + j] = acc[mt][nt][j] * rsv[mt];
            wave_lds_fence();
            if (tid < 32) LCNT[tid] = 0u;
            __syncthreads();
            int ex1 = 0, ex2 = 0; float w1 = 0.f, w2 = 0.f; unsigned lp1 = 0u, lp2 = 0u;
            if (lane < 32 && live) {
                const LAS float* lg = LG + lane * 49;
                float gl[4];
#pragma unroll
                for (int j = 0; j < 4; ++j) gl[j] = lg[j] + bg[j];
                int sel = 0; float gm = gl[0];
#pragma unroll
                for (int j = 1; j < 4; ++j) if (gl[j] > gm) { gm = gl[j]; sel = j; }
                float gs = 0.f;
#pragma unroll
                for (int j = 0; j < 4; ++j) gs += expf(gl[j] - gm);
                const float pg = 1.f / gs;
                float ein[8];
#pragma unroll
                for (int j = 0; j < 8; ++j) ein[j] = lg[4 + sel * 8 + j] + be[sel * 8 + j];
                int i1 = 0; float v1 = ein[0];
#pragma unroll
                for (int j = 1; j < 8; ++j) if (ein[j] > v1) { v1 = ein[j]; i1 = j; }
                int i2 = -1; float v2 = -3.0e38f;
#pragma unroll
                for (int j = 0; j < 8; ++j) if (j != i1 && ein[j] > v2) { v2 = ein[j]; i2 = j; }
                const float e2 = expf(v2 - v1), den = 1.f / (1.f + e2);
                w1 = den * pg; w2 = e2 * den * pg;
                ex1 = sel * 8 + i1; ex2 = sel * 8 + i2;
                lp1 = atomicAdd((unsigned*)&LCNT[ex1], 1u); lp2 = atomicAdd((unsigned*)&LCNT[ex2], 1u);
            }
            __syncthreads();
            if (tid < 32) { const unsigned c = LCNT[tid]; GBASE[tid] = c ? atomicAdd(&cnt[tid], c) : 0u; }
            __syncthreads();
            if (lane < 32 && live) { const int row = row0 + lane; const unsigned p1 = GBASE[ex1] + lp1, p2 = GBASE[ex2] + lp2;
                lists[(size_t)ex1 * NTOK + p1] = make_int2(row, __float_as_int(w1));
                lists[(size_t)ex2 * NTOK + p2] = make_int2(row, __float_as_int(w2));
                invout[2 * row] = ((unsigned)ex1 << 16) | p1; invout[2 * row + 1] = ((unsigned)ex2 << 16) | p2; }
        }
    }
}
__device__ __forceinline__ void final_norm(LAS unsigned char* lds, float* xo, const bf16_t* YB, const unsigned* inv, const unsigned* cntprev, const float* g) {
    const int tid = tid_opaque(), wave = tid >> 6, lane = tid & 63;
    LAS int* BASE = (LAS int*)(lds + 64 * 1024);
    build_base(BASE, cntprev);
    const float4* g4 = (const float4*)g;
    for (int r = blockIdx.x * 8 + wave; r < NTOK; r += gridDim.x * 8) {
        const unsigned i1 = inv[2 * r], i2 = inv[2 * r + 1];
        const bf16_t* y1 = YB + (size_t)(BASE[i1 >> 16] + (int)(i1 & 0xffffu)) * D; const bf16_t* y2 = YB + (size_t)(BASE[i2 >> 16] + (int)(i2 & 0xffffu)) * D;
        float4* p = (float4*)(xo + (size_t)r * D);
        float4 v[4]; float ss = 0.f;
#pragma unroll
        for (int i = 0; i < 4; ++i) { v[i] = p[lane + 64 * i]; const u32x2_t a = *((const u32x2_t*)y1 + lane + 64 * i), b = *((const u32x2_t*)y2 + lane + 64 * i);
            v[i].x += bfl(a.x) + bfl(b.x); v[i].y += bfh(a.x) + bfh(b.x); v[i].z += bfl(a.y) + bfl(b.y); v[i].w += bfh(a.y) + bfh(b.y);
            ss += v[i].x * v[i].x + v[i].y * v[i].y + v[i].z * v[i].z + v[i].w * v[i].w; }
        ss = wave_sum(ss);
        const float rs = rsqrtf(ss * (1.f / D) + EPS);
#pragma unroll
        for (int i = 0; i < 4; ++i) { const float4 gg = g4[lane + 64 * i]; float4 o; o.x = v[i].x * rs * gg.x; o.y = v[i].y * rs * gg.y; o.z = v[i].z * rs * gg.z; o.w = v[i].w * rs * gg.w; p[lane + 64 * i] = o; }
    }
}
}

__device__ __forceinline__ int moe_build_tab(LAS unsigned char* ldsb, const unsigned* cnt) {
    LAS pg8::i32x4* tab = (LAS pg8::i32x4*)(ldsb + TAB_OFF);
    __syncthreads();
    int base = 0;
#pragma unroll 1
    for (int e = 0; e < NEXP; ++e) { const int c = __builtin_amdgcn_readfirstlane((int)cnt[e]), nt = (c + 255) >> 8;
        if ((int)tid_opaque() < nt) tab[base + tid_opaque()] = (pg8::i32x4){e, (int)tid_opaque() * 256, c, 0};
        base += nt; }
    __syncthreads();
    return base;
}
__device__ __forceinline__ void ph_moe1(LAS unsigned char* ldsb, const Params& P, int l, const bf16_t* H, const unsigned* cnt, const int2* lists, bf16_t* act) {
    const int ntiles = moe_build_tab(ldsb, cnt);
    pg8::MoeOrder S; S.tab = (const LAS pg8::i32x4*)(ldsb + TAB_OFF); S.ntiles = ntiles; S.npn = 4; S.G = gridDim.x; S.c = blockIdx.x;
    S.A = (const char*)H; S.atile = 0; S.Bt = (const char*)(P.ws + WS_WGU) + (size_t)l * NEXP * 1024 * D * 2; S.bexp = (size_t)1024 * D * 2; S.btile = (size_t)256 * D * 2; S.lists = lists;
    pg8::EpiAct E{act, lists, (const float*)(P.ws + WS_RS)};
    pg8::gemm_phase<pg8::EpiAct, pg8::MoeOrder, true>(ldsb, D, D, S, E);
}
__device__ __forceinline__ void ph_moe2(LAS unsigned char* ldsb, const Params& P, int l, const bf16_t* act, const unsigned* cnt, const int2* lists, bf16_t* yb) {
    const int ntiles = moe_build_tab(ldsb, cnt);
    pg8::MoeOrder S; S.tab = (const LAS pg8::i32x4*)(ldsb + TAB_OFF); S.ntiles = ntiles; S.npn = 4; S.G = gridDim.x; S.c = blockIdx.x;
    S.A = (const char*)act; S.atile = (size_t)256 * DE * 2; S.Bt = (const char*)(P.ws + WS_WD) + (size_t)l * NEXP * D * DE * 2; S.bexp = (size_t)D * DE * 2; S.btile = (size_t)256 * DE * 2; S.lists = lists;
    pg8::EpiY E{yb, lists};
    pg8::gemm_phase<pg8::EpiY, pg8::MoeOrder, false>(ldsb, DE, DE, S, E);
}

#ifndef PROBE_PH
#define PROBE_PH -1
#endif
#ifndef PROBE_SUB
#define PROBE_SUB 15
#endif
#ifndef PROBE_REPS
#define PROBE_REPS 4
#endif
__global__ void __launch_bounds__(NTHREADS, 2) fwd_kernel(Params P) {
    extern __shared__ __attribute__((aligned(16))) unsigned char lds_raw[];
    float* lds = (float*)lds_raw;
    volatile LAS unsigned* xbw = (volatile LAS unsigned*)(lds_raw + LDS_BYTES - 16);
    if (threadIdx.x == 0) { xbw[0] = 0u; xbw[1] = 0u; }
    __syncthreads();
    unsigned char* const ws = P.ws;
    unsigned* ctl = (unsigned*)(ws + WS_CTL);
    const bool multi = (P.ph_hi - P.ph_lo) > 1;
    XcdBarrier bar; bar.bar = ctl; bar.x = 0; bar.st = xbw;
    if (multi) bar = xcd_barrier_post(ctl, xbw);
    bf16_t* z = (bf16_t*)(ws + WS_Z); float* gates = (float*)(ws + WS_GATES); unsigned char* wss = ws + WS_S5; bf16_t* mix = (bf16_t*)(ws + WS_MIX); unsigned char* wsm = ws + WS_HRAW;
    bf16_t* H = (bf16_t*)(ws + WS_H); bf16_t* act = (bf16_t*)(ws + WS_ACT); bf16_t* yb = (bf16_t*)(ws + WS_YB); float* rsb = (float*)(ws + WS_RS);
    int2* lists = (int2*)(ws + WS_LIST);
    LAS unsigned char* ldsb = (LAS unsigned char*)lds_raw;
    const int lo = P.ph_lo, hi = P.ph_hi;
#define IN(k) (lo <= (k) && (k) < hi)
#define SEAM(k) do { if (IN(k) && IN((k) + 1)) xcd_barrier(bar); } while (0)
#if PROBE_PH >= 0
#define RUNPH(k, ...) do { if (IN(k)) { const int nrep = ((k) == PROBE_PH) ? 1 + PROBE_REPS : 1; for (int rep = 0; rep < nrep; ++rep) { __VA_ARGS__; if (rep + 1 < nrep) xcd_barrier(bar); } } SEAM(k); } while (0)
#else
#define RUNPH(k, ...) do { if (IN(k)) { constexpr int rep = 0; (void)rep; __VA_ARGS__; } SEAM(k); } while (0)
#endif
    RUNPH(0, ph_prologue(lds, PF));
    for (int l = 0; l < NLAYER; ++l) {
        const int pb = 1 + l * PH_PER_LAYER;
        unsigned* cnt = ctl + CW_CNT + l * 64;
        const unsigned char* tb = ws + WS_TB + (size_t)l * 4 * MiB;
        const unsigned char* rtb = ws + WS_RT + (size_t)l * 256 * 1024;
        unsigned* inv = (unsigned*)(ws + WS_INV) + (size_t)l * NTOK * 2;
        RUNPH(pb + 0, { const Params& Q = PF;
            if (l == 0) rp::run<1, false>(ldsb, Q, l, Q.in[I_X], nullptr, nullptr, nullptr, nullptr, Q.in[I_NMG] + l * D, (const bf16_t*)(rtb + rp::T_GHI), (const bf16_t*)(rtb + rp::T_GLO), mix, rsb, gates, nullptr, nullptr, nullptr);
            else        rp::run<1, true >(ldsb, Q, l, Q.out, Q.out, yb, inv - (size_t)NTOK * 2, cnt - 64, Q.in[I_NMG] + l * D, (const bf16_t*)(rtb + rp::T_GHI), (const bf16_t*)(rtb + rp::T_GLO), mix, rsb, gates, nullptr, nullptr, nullptr); });
        RUNPH(pb + 1, ph_inproj(ldsb, mix, (const bf16_t*)(ws + WS_WIN) + (size_t)l * NMAIN * D, z, rsb, (rep > 0 && PROBE_SUB <= 3) ? PROBE_SUB : 0));
        RUNPH(pb + 2, ph_mix1(lds, PF, l, z, gates, mix, wsm, wss, tb, rep == 0 ? 15 : PROBE_SUB));
        RUNPH(pb + 3, { s5::p2_scan(ldsb, tb, wss); ml::p2_scan(wsm); });
        RUNPH(pb + 4, ph_mix2(lds, PF, l, z, gates, mix, wsm, wss, tb, rep == 0 ? 15 : PROBE_SUB));
        RUNPH(pb + 5, { const Params& Q = PF; ph_outproj(ldsb, mix, (const bf16_t*)(ws + WS_WOUT) + (size_t)l * D * D, (l == 0) ? Q.in[I_X] : Q.out, Q.out); });
        RUNPH(pb + 6, { if (rep > 0) { if (blockIdx.x == 0 && threadIdx.x < 64) cnt[threadIdx.x] = 0u; xcd_barrier(bar); }
                        const Params& Q = PF; rp::run<3, false>(ldsb, Q, l, Q.out, nullptr, nullptr, nullptr, nullptr, Q.in[I_NFG] + l * D, (const bf16_t*)(rtb + rp::T_HI), (const bf16_t*)(rtb + rp::T_LO), H, rsb, nullptr, cnt, lists, inv); });
        RUNPH(pb + 7, ph_moe1(ldsb, PF, l, H, cnt, lists, act));
        RUNPH(pb + 8, ph_moe2(ldsb, PF, l, act, cnt, lists, yb));
    }
    RUNPH(1 + NLAYER * PH_PER_LAYER, { const Params& Q = PF; rp::final_norm(ldsb, Q.out, yb, (const unsigned*)(ws + WS_INV) + (size_t)(NLAYER - 1) * NTOK * 2, ctl + CW_CNT + (NLAYER - 1) * 64, Q.in[I_NFIN]); });
#undef RUNPH
#undef IN
#undef SEAM
}

#ifndef N_LAUNCH_MODE
#define N_LAUNCH_MODE 1
#endif
extern "C" void kernel_launch(void* const* d_in, const int* in_sizes, int n_in, void* d_out, int out_size, void* d_ws, size_t ws_size, hipStream_t stream) {
    static int grid = 0;
    if (grid == 0) {
        if (n_in != 31 || out_size != NTOK * D || ws_size < WS_END) { fprintf(stderr, "kernel_launch: unexpected shapes n_in %d out %d ws %zu (need %zu)\n", n_in, out_size, ws_size, (size_t)WS_END); grid = -1; return; }
        int dev = 0, cus = 0, per_cu = 0;
        if (hipGetDevice(&dev) != hipSuccess || hipDeviceGetAttribute(&cus, hipDeviceAttributeMultiprocessorCount, dev) != hipSuccess) { grid = -1; return; }
        if (hipFuncSetAttribute((const void*)fwd_kernel, hipFuncAttributeMaxDynamicSharedMemorySize, LDS_BYTES) != hipSuccess) { fprintf(stderr, "kernel_launch: hipFuncSetAttribute failed\n"); grid = -1; return; }
        if (hipOccupancyMaxActiveBlocksPerMultiprocessor(&per_cu, (const void*)fwd_kernel, NTHREADS, LDS_BYTES) != hipSuccess || per_cu < 1) { fprintf(stderr, "kernel_launch: occupancy query says %d\n", per_cu); }
        (void)hipGetLastError();
        grid = cus;
    }
    if (grid < 0) return;
    (void)hipMemsetAsync((char*)d_ws + WS_CTL, 0, CTL_BYTES, stream);
    Params p{};
    for (int i = 0; i < 31; ++i) p.in[i] = (const float*)d_in[i];
    p.out = (float*)d_out; p.ws = (unsigned char*)d_ws;
#if N_LAUNCH_MODE == 1
    p.ph_lo = 0; p.ph_hi = N_PHASES;
    hipLaunchKernelGGL(fwd_kernel, dim3(grid), dim3(NTHREADS), LDS_BYTES, stream, p);
#else
    for (int ph = 0; ph < N_PHASES; ++ph) { p.ph_lo = ph; p.ph_hi = ph + 1; hipLaunchKernelGGL(fwd_kernel, dim3(grid), dim3(NTHREADS), LDS_BYTES, stream, p); }
#endif
}
```

```cpp
#include <hip/hip_runtime.h>
#include <stdint.h>
#include <stdio.h>

#define LAS __attribute__((address_space(3)))

constexpr int D = 1024, NB = 8, S = 8192, NTOK = NB * S, INW = 2312, NLAYER = 2;
constexpr int NEXP = 32, DE = 512;
constexpr float EPS = 1e-6f;
constexpr int ZW = 2304;
constexpr int ZQ = 0, ZK = 256, ZV = 384, ZSU = 512, ZCQ = 768, ZCK = 1024, ZCV = 1280, ZCO = 1536, ZGU = 1792, ZGV = 2048, WCI = 1536;
#ifndef INPROJ_WGM
#define INPROJ_WGM 8
#endif
constexpr int NTHREADS = 512;
constexpr int LDS_BYTES = 144 * 1024;
constexpr int TAB_OFF = 128 * 1024;
constexpr int PH_PER_LAYER = 9, N_PHASES = 1 + NLAYER * PH_PER_LAYER + 1;
constexpr int NMAIN = 2304;
typedef unsigned short bf16_t;

constexpr size_t MiB = 1u << 20;
constexpr size_t WS_CTL = 0, CTL_BYTES = 1 * MiB;
constexpr size_t WS_Z = WS_CTL + CTL_BYTES;
constexpr size_t Z_BYTES = (size_t)NTOK * ZW * 2;
constexpr size_t WS_H = WS_Z;
constexpr size_t WS_YB = WS_Z;
constexpr int PMAX = 2 * NTOK + NEXP * 256;
static_assert((size_t)PMAX * D * 2 <= Z_BYTES, "YB alias fits");
constexpr size_t WS_MIX = WS_Z + Z_BYTES;
constexpr size_t WS_ACT = WS_MIX;
static_assert((size_t)PMAX * DE * 2 <= (size_t)NTOK * D * 2 + 64 * MiB, "ACT alias fits");
constexpr size_t WS_HRAW = WS_MIX + (size_t)NTOK * D * 2;
constexpr size_t WS_S5 = WS_HRAW + 64 * MiB;
constexpr size_t WS_GATES = WS_S5 + 48 * MiB;
constexpr size_t WS_LIST = WS_GATES + (size_t)NTOK * 8 * 4;
constexpr size_t WS_WIN = WS_LIST + (size_t)NEXP * NTOK * 8;
constexpr size_t WS_WOUT = WS_WIN + (size_t)NLAYER * NMAIN * D * 2;
constexpr size_t WS_WGU = WS_WOUT + (size_t)NLAYER * D * D * 2;
constexpr size_t WS_WD = WS_WGU + (size_t)NLAYER * NEXP * 1024 * D * 2;
constexpr size_t WS_TB = WS_WD + (size_t)NLAYER * NEXP * D * DE * 2;
constexpr size_t WS_RS = WS_TB + (size_t)NLAYER * 4 * MiB;
constexpr size_t WS_RT = WS_RS + (size_t)NTOK * 4;
constexpr size_t WS_INV = WS_RT + (size_t)NLAYER * 256 * 1024;
constexpr size_t WS_XB = WS_INV + (size_t)NLAYER * NTOK * 8;
constexpr size_t WS_END = WS_XB + (size_t)NTOK * D * 2;
namespace s5 {
constexpr size_t T_KMAT = 0, T_F = T_KMAT + (size_t)16 * 32 * 256 * 2, T_G = T_F + (size_t)16 * 256 * 128 * 2, T_A16 = T_G + (size_t)16 * 128 * 256 * 2,
                 T_GLUW = T_A16 + (size_t)16 * 64 * 8, T_SGUW = T_GLUW + (size_t)256 * 256 * 2, T_LAYER = T_SGUW + (size_t)4 * 128 * 128 * 2;
}
constexpr int CW_Q = 4096;
constexpr int CW_CNT = 8192;

#define XB_TMO      128
#define XB_XCNT(j)  (256  + 64 * (j))
#define XB_XSUB(j)  (1280 + 64 * (j))
#define XB_XGEN(j)  (2304 + 64 * (j))
#define XB_TOP      3328
#define XB_TOPGEN   3392
#define XCD_BAR_WORDS 3456
#define XB_SPIN_CAP (1u << 22)
__device__ __forceinline__ unsigned xb_ld(unsigned* p)              { return __hip_atomic_load(p, __ATOMIC_RELAXED, __HIP_MEMORY_SCOPE_AGENT); }
__device__ __forceinline__ unsigned xb_add(unsigned* p, unsigned v) { return __hip_atomic_fetch_add(p, v, __ATOMIC_RELAXED, __HIP_MEMORY_SCOPE_AGENT); }
__device__ __forceinline__ unsigned xb_xcc_id() { return (unsigned)__builtin_amdgcn_s_getreg((3 << 11) | 20) & 0xFu; }
#define XB_SPIN(cond, bar) do { unsigned _sp = 0; while (cond) { __builtin_amdgcn_s_sleep(1); \
    if ((++_sp & 255u) == 0u) { if (xb_ld(&(bar)[XB_TMO])) break; if (_sp > XB_SPIN_CAP) { atomicAdd(&(bar)[XB_TMO], 1u); break; } } } } while (0)
struct XcdBarrier { unsigned* bar; unsigned x; volatile LAS unsigned* st; };
__device__ __forceinline__ XcdBarrier xcd_barrier_post(unsigned* bar, volatile LAS unsigned* st) {
    XcdBarrier b; b.bar = bar; b.x = xb_xcc_id(); b.st = st;
    if (threadIdx.x == 0) (void)xb_add(&bar[XB_XCNT(b.x)], 1u);
    return b;
}
__device__ __forceinline__ void xcd_barrier_complete(unsigned* bar, unsigned x, unsigned& nloc, unsigned& nx) {
    const unsigned G = gridDim.x * gridDim.y * gridDim.z;
    unsigned sum, cnt, mine, sp = 0u;
    for (;;) {
        sum = 0u; cnt = 0u; mine = 0u;
#pragma unroll
        for (unsigned j = 0; j < 16; ++j) { const unsigned c = xb_ld(&bar[XB_XCNT(j)]); sum += c; cnt += (c > 0u) ? 1u : 0u; mine = (j == x) ? c : mine; }
        if (sum == G) break;
        __builtin_amdgcn_s_sleep(1);
        if ((++sp & 255u) == 0u) { if (xb_ld(&bar[XB_TMO])) break; if (sp > XB_SPIN_CAP) { atomicAdd(&bar[XB_TMO], 1u); break; } }
    }
    nloc = mine > 0u ? mine : 1u; nx = cnt > 0u ? cnt : 1u;
}
__device__ __forceinline__ void xcd_barrier(const XcdBarrier& b) {
    asm volatile("s_waitcnt vmcnt(0)" ::: "memory");
    __syncthreads();
    if (threadIdx.x == 0) {
        unsigned* bar = b.bar;
        __builtin_amdgcn_s_waitcnt(0);
        unsigned nloc = b.st[0], nx = b.st[1];
        if (nloc == 0u) { xcd_barrier_complete(bar, b.x, nloc, nx); b.st[0] = nloc; b.st[1] = nx; }
        const unsigned old = xb_add(&bar[XB_XSUB(b.x)], 1u);
        const unsigned gen = old / nloc;
        if (old + 1u == (gen + 1u) * nloc) {
            __builtin_amdgcn_fence(__ATOMIC_RELEASE, "agent");
            asm volatile("s_waitcnt vmcnt(0)" ::: "memory");
            const unsigned og = xb_add(&bar[XB_TOP], 1u);
            const unsigned tg = og / nx;
            if (og + 1u == (tg + 1u) * nx) xb_add(&bar[XB_TOPGEN], 1u);
            else XB_SPIN(xb_ld(&bar[XB_TOPGEN]) == tg, bar);
            __builtin_amdgcn_fence(__ATOMIC_ACQUIRE, "agent");
            xb_add(&bar[XB_XGEN(b.x)], 1u);
            asm volatile("s_waitcnt vmcnt(0)" ::: "memory");
        } else {
            XB_SPIN(xb_ld(&bar[XB_XGEN(b.x)]) == gen, bar);
            __builtin_amdgcn_fence(__ATOMIC_ACQUIRE, "agent");
            asm volatile("s_waitcnt vmcnt(0)" ::: "memory");
        }
    }
    __syncthreads();
}

__device__ __forceinline__ int tid_opaque() { int t = threadIdx.x; asm volatile("" : "+v"(t)); return t; }
__device__ __forceinline__ float wave_sum(float v) {
#pragma unroll
    for (int o = 32; o > 0; o >>= 1) v += __shfl_xor(v, o);
    return v;
}
__device__ __forceinline__ float gelu_tanh(float x) {
    const float u2 = 1.5957691216057308f * (x + 0.044715f * x * x * x);
    return x * __builtin_amdgcn_rcpf(1.f + __expf(-u2));
}
__device__ __forceinline__ float sigm(float x) { return 1.f / (1.f + expf(-x)); }
__device__ __forceinline__ float bfl(unsigned w) { return __uint_as_float(w << 16); }
__device__ __forceinline__ float bfh(unsigned w) { return __uint_as_float(w & 0xffff0000u); }
typedef unsigned u32x4_t __attribute__((ext_vector_type(4)));
typedef unsigned u32x2_t __attribute__((ext_vector_type(2)));
__device__ __forceinline__ void ld8(const bf16_t* p, float (&o)[8]) { const u32x4_t w = *(const u32x4_t*)p; o[0] = bfl(w.x); o[1] = bfh(w.x); o[2] = bfl(w.y); o[3] = bfh(w.y); o[4] = bfl(w.z); o[5] = bfh(w.z); o[6] = bfl(w.w); o[7] = bfh(w.w); }
__device__ __forceinline__ void wave_lds_fence() {
    __builtin_amdgcn_fence(__ATOMIC_RELEASE, "wavefront"); __builtin_amdgcn_wave_barrier(); __builtin_amdgcn_fence(__ATOMIC_ACQUIRE, "wavefront");
}

struct Params {
    const float* in[31];
    float* out;
    unsigned char* ws;
    int ph_lo, ph_hi;
};
struct Params;
__device__ __forceinline__ const Params* params_fresh() { auto p = __builtin_amdgcn_kernarg_segment_ptr(); asm volatile("" : "+s"(p)); return (const Params*)p; }
#define PF (*params_fresh())
enum { I_X = 0, I_NMG, I_WIN, I_SINK, I_ARE, I_AIM, I_BRE, I_BIM, I_CRE, I_CIM, I_SD, I_LDT, I_GLUW, I_GLUB, I_CONVW, I_GATEB, I_MNG,
       I_LNG, I_LNB, I_SGUW, I_SGUB, I_WOUT, I_NFG, I_RGW, I_RGB, I_REW, I_REB, I_EWG, I_EWU, I_EWD, I_NFIN };

namespace pg8 {
#define PG8_LAS __attribute__((address_space(3)))
typedef short bf16x8 __attribute__((ext_vector_type(8)));
typedef float f32x4 __attribute__((ext_vector_type(4)));
typedef unsigned u32x4 __attribute__((ext_vector_type(4)));
typedef unsigned u32x2 __attribute__((ext_vector_type(2)));
typedef int i32x4 __attribute__((ext_vector_type(4)));
constexpr int BM = 256, BK = 64, HALF = 128, HTB = HALF * BK * 2, STAGE_BYTES = 8 * HTB, NXCD = 8, WGM = 8;
__host__ __device__ __forceinline__ int lds_byte(int r, int c) { const int st = (r >> 4) * 2 + (c >> 5), rr = r & 15, cc = c & 31, ob = rr * 64 + cc * 2; return st * 1024 + (ob ^ (((ob >> 9) & 1) << 5)); }
__host__ __device__ __forceinline__ void stage_rc(int b, int& R, int& C) { const int st = b / 1024, sb = b % 1024, swz = sb ^ (((sb >> 9) & 1) << 5); R = (st >> 1) * 16 + swz / 64; C = (st & 1) * 32 + (swz % 64) / 2; }
__host__ __device__ __forceinline__ int perm32(int rho) { const int n = rho >> 4, i = rho & 15; return 8 * (i >> 2) + 4 * n + (i & 3); }
__device__ __forceinline__ unsigned cvt_pk_bf16(float lo, float hi) { unsigned r; asm volatile("v_cvt_pk_bf16_f32 %0, %1, %2" : "=v"(r) : "v"(lo), "v"(hi)); return r; }

struct Unit { int pm, pn; const char* A; const char* B; int e, pos0, cnt; };

struct StaticOrder {
    int nM, nN, nwg, G, c, wgm, pmmask = -1; const char* A; const char* Bt; size_t atile, btile;
    __device__ void init(int M, int N, int K, int lda, int G_, int c_, const void* A_, const void* Bt_, int wgm_ = WGM) { wgm = wgm_; nM = M / BM; nN = N / BM; nwg = nM * nN; G = G_; c = c_; A = (const char*)A_; Bt = (const char*)Bt_; atile = (size_t)BM * lda * 2; btile = (size_t)BM * K * 2; }
    __device__ __forceinline__ bool next(int i, Unit& u) const {
        const long L = (long)i * G + c; if (L >= nwg) return false;
        int wgid = (int)L; { const int q = nwg / NXCD, r = nwg % NXCD, xcd = wgid % NXCD, off = wgid / NXCD; wgid = (xcd < r ? xcd * (q + 1) : r * (q + 1) + (xcd - r) * q) + off; }
        const int nig = wgm * nN, gid = wgid / nig, fm = gid * wgm, gsz = (nM - fm) < wgm ? (nM - fm) : wgm;
        u.pm = fm + ((wgid % nig) % gsz); u.pn = (wgid % nig) / gsz; u.A = A + (size_t)(u.pm & pmmask) * atile; u.B = Bt + (size_t)u.pn * btile; u.e = 0; u.pos0 = 0; u.cnt = 0; return true;
    }
    __device__ __forceinline__ void aoff(const Unit&, unsigned (&)[2], unsigned (&)[2], const int (&)[2], const int (&)[2]) const {}
};

template <class Epi, class Sched, bool GATHER>
__device__ __forceinline__ void gemm_phase(PG8_LAS unsigned char* lds, const int K, const int lda, const Sched& S, const Epi& E) {
    const int tid = tid_opaque(), wid = __builtin_amdgcn_readfirstlane(tid >> 6), lane = tid & 63, wr = wid >> 2, wc = wid & 3, fr = lane & 15, fq = lane >> 4;
    const int nt = K / BK;
    unsigned vA0[2], vA1[2], vB[2], nA0[2], nA1[2]; int Rs[2], Cs[2];
#pragma unroll
    for (int i = 0; i < 2; ++i) { int R, C; stage_rc(tid * 16 + i * 8192, R, C); const int Rb = Epi::PERM ? ((R & ~31) + perm32(R & 31)) : R;
        Rs[i] = R; Cs[i] = C; vA0[i] = (unsigned)(R * lda + C) * 2u; vA1[i] = vA0[i] + (unsigned)(HALF * lda) * 2u; vB[i] = (unsigned)(Rb * K + C) * 2u; nA0[i] = vA0[i]; nA1[i] = vA1[i]; }
    const size_t kstep = (size_t)(BK * 2);
    const size_t hstep = (size_t)HALF * K * 2;
    const unsigned ldsw = (unsigned)wid * 1024u;
    const int aoff = lds_byte(wr * 64 + fr, fq * 8), boff = lds_byte(wc * 32 + fr, fq * 8);
#define PG8_SA(b, h) (((b) * 2 + (h)) * HTB)
#define PG8_SB(b, h) ((4 + (b) * 2 + (h)) * HTB)
#define PG8_STAGE(bufoff, gbase, voff) do { _Pragma("unroll") for (int _i = 0; _i < 2; ++_i) \
        __builtin_amdgcn_global_load_lds((const unsigned*)((const char*)(gbase) + (voff)[_i]), (PG8_LAS unsigned*)(lds + (bufoff) + ldsw + _i * 8192), 16, 0, 0); } while (0)
#define PG8_LDA(dst, b, h) do { _Pragma("unroll") for (int m = 0; m < 4; ++m) _Pragma("unroll") for (int k = 0; k < 2; ++k) dst[m][k] = *(const PG8_LAS bf16x8*)(lds + PG8_SA(b, h) + aoff + m * 2048 + k * 1024); } while (0)
#define PG8_LDB(dst, b, h) do { _Pragma("unroll") for (int n = 0; n < 2; ++n) _Pragma("unroll") for (int k = 0; k < 2; ++k) dst[n][k] = *(const PG8_LAS bf16x8*)(lds + PG8_SB(b, h) + boff + n * 2048 + k * 1024); } while (0)
#define PG8_MMA(ai, bj, At, Bt) do { __builtin_amdgcn_s_setprio(1); _Pragma("unroll") for (int m = 0; m < 4; ++m) _Pragma("unroll") for (int n = 0; n < 2; ++n) _Pragma("unroll") for (int k = 0; k < 2; ++k) \
        acc[ai][bj][m][n] = __builtin_amdgcn_mfma_f32_16x16x32_bf16(Bt[n][k], At[m][k], acc[ai][bj][m][n], 0, 0, 0); __builtin_amdgcn_s_setprio(0); } while (0)
#define PG8_WAIT_V(n) asm volatile("s_waitcnt vmcnt(" #n ")" ::: "memory")
#define PG8_WAIT_L(n) asm volatile("s_waitcnt lgkmcnt(" #n ")" ::: "memory")
#define PG8_BAR __builtin_amdgcn_s_barrier()
#define PG8_SCHED __builtin_amdgcn_sched_barrier(0)
    Unit cur, nxt; int ui = 0;
    if (!S.next(0, cur)) return;
    if constexpr (GATHER) { S.aoff(cur, vA0, vA1, Rs, Cs); PG8_WAIT_V(0); }
    f32x4 acc[2][2][4][2];
#pragma unroll
    for (int a = 0; a < 2; ++a)
#pragma unroll
        for (int b = 0; b < 2; ++b)
#pragma unroll
            for (int m = 0; m < 4; ++m)
#pragma unroll
                for (int n = 0; n < 2; ++n) acc[a][b][m][n] = (f32x4){0.f, 0.f, 0.f, 0.f};
    bf16x8 At[4][2], B0[2][2], B1[2][2];
    const char* cA = cur.A; const char* cB = cur.B;
    PG8_STAGE(PG8_SB(0, 0), cB, vB); PG8_STAGE(PG8_SB(0, 1), cB + hstep, vB); PG8_STAGE(PG8_SA(0, 0), cA, vA0); PG8_STAGE(PG8_SA(0, 1), cA, vA1);
    if (wr == 1) PG8_BAR;
    PG8_WAIT_V(2); PG8_BAR;
    PG8_STAGE(PG8_SB(1, 0), cB + kstep, vB); PG8_STAGE(PG8_SA(1, 0), cA + kstep, vA0); PG8_STAGE(PG8_SB(1, 1), cB + hstep + kstep, vB);
    PG8_WAIT_V(6); PG8_BAR;
    for (;;) {
        const bool has_next = S.next(ui + 1, nxt);
        const char* nA = has_next ? nxt.A : cA; const char* nB = has_next ? nxt.B : cB;
        if constexpr (GATHER) {
            if (has_next) { S.aoff(nxt, nA0, nA1, Rs, Cs); }
            else {
#pragma unroll
                for (int i = 0; i < 2; ++i) { nA0[i] = vA0[i]; nA1[i] = vA1[i]; } }
        }
        for (int t = 0; t < nt; t += 2) {
            const bool last = (t == nt - 2);
            const char* a1 = cA + (size_t)(t + 1) * kstep;
            const char* a2 = last ? nA : cA + (size_t)(t + 2) * kstep; const char* b2 = last ? nB : cB + (size_t)(t + 2) * kstep;
            const char* a3 = a2 + kstep; const char* b3 = b2 + kstep;
            unsigned x0[2], x1[2];
#pragma unroll
            for (int i = 0; i < 2; ++i) { x0[i] = (GATHER && last) ? nA0[i] : vA0[i]; x1[i] = (GATHER && last) ? nA1[i] : vA1[i]; }
            PG8_LDB(B0, 0, 0); PG8_LDB(B1, 0, 1); PG8_SCHED; PG8_LDA(At, 0, 0); PG8_STAGE(PG8_SA(1, 1), a1, vA1);
            PG8_WAIT_V(8); PG8_WAIT_L(0); PG8_BAR; PG8_MMA(0, 0, At, B0); PG8_MMA(0, 1, At, B1); PG8_BAR; PG8_SCHED;
            PG8_LDA(At, 0, 1); PG8_STAGE(PG8_SB(0, 0), b2, vB); PG8_STAGE(PG8_SB(0, 1), b2 + hstep, vB); PG8_STAGE(PG8_SA(0, 0), a2, x0);
            PG8_WAIT_V(8); PG8_WAIT_L(0); PG8_BAR; PG8_MMA(1, 0, At, B0); PG8_MMA(1, 1, At, B1); PG8_BAR; PG8_SCHED;
            PG8_LDB(B0, 1, 0); PG8_LDB(B1, 1, 1); PG8_SCHED; PG8_LDA(At, 1, 0); PG8_STAGE(PG8_SA(0, 1), a2, x1);
            PG8_WAIT_V(8); PG8_WAIT_L(0); PG8_BAR; PG8_MMA(0, 0, At, B0); PG8_MMA(0, 1, At, B1); PG8_BAR; PG8_SCHED;
            PG8_LDA(At, 1, 1); PG8_STAGE(PG8_SB(1, 0), b3, vB); PG8_STAGE(PG8_SB(1, 1), b3 + hstep, vB); PG8_STAGE(PG8_SA(1, 0), a3, x0);
            PG8_WAIT_V(8); PG8_WAIT_L(0); PG8_BAR; PG8_MMA(1, 0, At, B0); PG8_MMA(1, 1, At, B1); PG8_BAR; PG8_SCHED;
        }
        if (wr == 0) PG8_BAR;
        E(acc, cur, wr, wc, fr, fq);
        if (!has_next) break;
#pragma unroll
        for (int a = 0; a < 2; ++a)
#pragma unroll
            for (int b = 0; b < 2; ++b)
#pragma unroll
                for (int m = 0; m < 4; ++m)
#pragma unroll
                    for (int n = 0; n < 2; ++n) acc[a][b][m][n] = (f32x4){0.f, 0.f, 0.f, 0.f};
        cur = nxt; cA = nA; cB = nB; ++ui;
        if constexpr (GATHER) {
#pragma unroll
            for (int i = 0; i < 2; ++i) { vA0[i] = nA0[i]; vA1[i] = nA1[i]; } }
        if (wr == 1) PG8_BAR;
    }
    PG8_WAIT_V(0);
    PG8_BAR;
#undef PG8_SA
#undef PG8_SB
#undef PG8_STAGE
#undef PG8_LDA
#undef PG8_LDB
#undef PG8_MMA
#undef PG8_WAIT_V
#undef PG8_WAIT_L
#undef PG8_BAR
#undef PG8_SCHED
}

struct EpiZ {
    static constexpr bool PERM = true;
    bf16_t* Z; const float* RS; int skip;
    __device__ __forceinline__ void operator()(const f32x4 (&acc)[2][2][4][2], const Unit& u, int wr, int wc, int fr, int fq) const {
        if (skip) return;
        const int row0 = u.pm * BM + wr * 64 + fr, col0 = u.pn * BM + wc * 32 + 8 * fq;
        float rsv[2][4];
#pragma unroll
        for (int ai = 0; ai < 2; ++ai)
#pragma unroll
            for (int m = 0; m < 4; ++m) rsv[ai][m] = RS[row0 + ai * HALF + m * 16];
#pragma unroll
        for (int ai = 0; ai < 2; ++ai)
#pragma unroll
            for (int m = 0; m < 4; ++m) { bf16_t* rowp = Z + (size_t)(row0 + ai * HALF + m * 16) * ZW + col0; const float rs = rsv[ai][m];
#pragma unroll
                for (int bj = 0; bj < 2; ++bj) { const f32x4 v0 = acc[ai][bj][m][0] * rs, v1 = acc[ai][bj][m][1] * rs;
                    u32x4 w; w.x = cvt_pk_bf16(v0[0], v0[1]); w.y = cvt_pk_bf16(v0[2], v0[3]); w.z = cvt_pk_bf16(v1[0], v1[1]); w.w = cvt_pk_bf16(v1[2], v1[3]);
                    *(u32x4*)(rowp + bj * HALF) = w; } }
    }
};
template <bool SRCF32> struct EpiResB {
    static constexpr bool PERM = true;
    const float* XF; bf16_t* XB;
    __device__ __forceinline__ void operator()(const f32x4 (&acc)[2][2][4][2], const Unit& u, int wr, int wc, int fr, int fq) const {
        const int row0 = u.pm * BM + wr * 64 + fr, col0 = u.pn * BM + wc * 32 + 8 * fq;
#pragma unroll
        for (int ai = 0; ai < 2; ++ai)
#pragma unroll
            for (int mp = 0; mp < 2; ++mp) {
                f32x4 xs[2][2][2];
#pragma unroll
                for (int mm = 0; mm < 2; ++mm) { const size_t off = (size_t)(row0 + ai * HALF + (2 * mp + mm) * 16) * D + col0;
#pragma unroll
                    for (int bj = 0; bj < 2; ++bj) {
                        if (SRCF32) { xs[mm][bj][0] = *(const f32x4*)(XF + off + bj * HALF); xs[mm][bj][1] = *(const f32x4*)(XF + off + bj * HALF + 4); }
                        else { const u32x4 w = *(const u32x4*)(XB + off + bj * HALF);
                            xs[mm][bj][0] = (f32x4){__uint_as_float(w.x << 16), __uint_as_float(w.x & 0xffff0000u), __uint_as_float(w.y << 16), __uint_as_float(w.y & 0xffff0000u)};
                            xs[mm][bj][1] = (f32x4){__uint_as_float(w.z << 16), __uint_as_float(w.z & 0xffff0000u), __uint_as_float(w.w << 16), __uint_as_float(w.w & 0xffff0000u)}; } } }
#pragma unroll
                for (int mm = 0; mm < 2; ++mm) { const size_t off = (size_t)(row0 + ai * HALF + (2 * mp + mm) * 16) * D + col0;
#pragma unroll
                    for (int bj = 0; bj < 2; ++bj) { const f32x4 v0 = xs[mm][bj][0] + acc[ai][bj][2 * mp + mm][0], v1 = xs[mm][bj][1] + acc[ai][bj][2 * mp + mm][1];
                        u32x4 o; o.x = cvt_pk_bf16(v0[0], v0[1]); o.y = cvt_pk_bf16(v0[2], v0[3]); o.z = cvt_pk_bf16(v1[0], v1[1]); o.w = cvt_pk_bf16(v1[2], v1[3]);
                        *(u32x4*)(XB + off + bj * HALF) = o; } }
            }
    }
};
struct EpiAct {
    static constexpr bool PERM = true;
    bf16_t* ACT; const int2* lists; const float* RS;
    __device__ __forceinline__ void operator()(const f32x4 (&acc)[2][2][4][2], const Unit& u, int wr, int wc, int fr, int fq) const {
        const int row0 = u.pm * BM + wr * 64 + fr, col0 = u.pn * HALF + wc * 32 + 8 * fq; const int2* lst = lists + (size_t)u.e * NTOK + u.pos0;
        int tk[2][4]; float rsv[2][4];
#pragma unroll
        for (int ai = 0; ai < 2; ++ai)
#pragma unroll
            for (int m = 0; m < 4; ++m) { const int r = ai * HALF + wr * 64 + m * 16 + fr; const int rc = (u.pos0 + r < u.cnt) ? r : 0; tk[ai][m] = lst[rc].x; }
        asm volatile("" : "+v"(tk[0][0]), "+v"(tk[0][1]), "+v"(tk[0][2]), "+v"(tk[0][3]), "+v"(tk[1][0]), "+v"(tk[1][1]), "+v"(tk[1][2]), "+v"(tk[1][3]));
#pragma unroll
        for (int ai = 0; ai < 2; ++ai)
#pragma unroll
            for (int m = 0; m < 4; ++m) rsv[ai][m] = RS[tk[ai][m]];
        asm volatile("" : "+v"(rsv[0][0]), "+v"(rsv[0][1]), "+v"(rsv[0][2]), "+v"(rsv[0][3]), "+v"(rsv[1][0]), "+v"(rsv[1][1]), "+v"(rsv[1][2]), "+v"(rsv[1][3]));
#pragma unroll
        for (int ai = 0; ai < 2; ++ai)
#pragma unroll
            for (int m = 0; m < 4; ++m) { const int r = ai * HALF + wr * 64 + m * 16 + fr; if (!(u.pos0 + r < u.cnt)) rsv[ai][m] = 0.f; }
#pragma unroll
        for (int ai = 0; ai < 2; ++ai)
#pragma unroll
            for (int m = 0; m < 4; ++m) { bf16_t* rowp = ACT + (size_t)(row0 + ai * HALF + m * 16) * DE + col0;
                const float rs = rsv[ai][m];
                float o[8];
#pragma unroll
                for (int n = 0; n < 2; ++n)
#pragma unroll
                    for (int j = 0; j < 4; ++j) { const float g = acc[ai][0][m][n][j] * rs, up = acc[ai][1][m][n][j] * rs; o[n * 4 + j] = g * up * __builtin_amdgcn_rcpf(1.f + __expf(-g)); }
                u32x4 w; w.x = cvt_pk_bf16(o[0], o[1]); w.y = cvt_pk_bf16(o[2], o[3]); w.z = cvt_pk_bf16(o[4], o[5]); w.w = cvt_pk_bf16(o[6], o[7]);
                *(u32x4*)rowp = w; }
    }
};
struct EpiY {
    static constexpr bool PERM = true;
    bf16_t* YB; const int2* lists;
    __device__ __forceinline__ void operator()(const f32x4 (&acc)[2][2][4][2], const Unit& u, int wr, int wc, int fr, int fq) const {
        const int row0 = u.pm * BM + wr * 64 + fr, col0 = u.pn * BM + wc * 32 + 8 * fq; const int2* lst = lists + (size_t)u.e * NTOK + u.pos0;
        float wv[2][4];
#pragma unroll
        for (int ai = 0; ai < 2; ++ai)
#pragma unroll
            for (int m = 0; m < 4; ++m) { const int r = ai * HALF + wr * 64 + m * 16 + fr; wv[ai][m] = __int_as_float(lst[(u.pos0 + r < u.cnt) ? r : 0].y); }
#pragma unroll
        for (int ai = 0; ai < 2; ++ai)
#pragma unroll
            for (int m = 0; m < 4; ++m) { const int r = ai * HALF + wr * 64 + m * 16 + fr;
                if (u.pos0 + r < u.cnt) { const float w = wv[ai][m]; bf16_t* rowp = YB + (size_t)(row0 + ai * HALF + m * 16) * D + col0;
#pragma unroll
                    for (int bj = 0; bj < 2; ++bj) { const f32x4 v0 = acc[ai][bj][m][0] * w, v1 = acc[ai][bj][m][1] * w;
                        u32x4 o; o.x = cvt_pk_bf16(v0[0], v0[1]); o.y = cvt_pk_bf16(v0[2], v0[3]); o.z = cvt_pk_bf16(v1[0], v1[1]); o.w = cvt_pk_bf16(v1[2], v1[3]);
                        *(u32x4*)(rowp + bj * HALF) = o; } } }
    }
};
struct MoeOrder {
    const PG8_LAS i32x4* tab; int ntiles, npn, G, c; const char* A; size_t atile; const char* Bt; size_t bexp, btile; const int2* lists;
    __device__ __forceinline__ bool next(int i, Unit& u) const {
        const int L = i * G + c; const int T = L / npn; if (T >= ntiles) return false;
        const i32x4 te = tab[T]; u.pm = T; u.pn = L - T * npn; u.e = __builtin_amdgcn_readfirstlane(te.x); u.pos0 = __builtin_amdgcn_readfirstlane(te.y); u.cnt = __builtin_amdgcn_readfirstlane(te.z);
        u.A = A + (size_t)T * atile; u.B = Bt + (size_t)u.e * bexp + (size_t)u.pn * btile; return true;
    }
    __device__ __forceinline__ void aoff(const Unit& u, unsigned (&o0)[2], unsigned (&o1)[2], const int (&Rs)[2], const int (&Cs)[2]) const {
        const int2* lst = lists + (size_t)u.e * NTOK;
#pragma unroll
        for (int i = 0; i < 2; ++i) { const int p0 = u.pos0 + Rs[i], p1 = p0 + HALF;
            const int t0 = (p0 < u.cnt) ? lst[p0].x : 0, t1 = (p1 < u.cnt) ? lst[p1].x : 0;
            o0[i] = (unsigned)t0 * (unsigned)(D * 2) + (unsigned)Cs[i] * 2u; o1[i] = (unsigned)t1 * (unsigned)(D * 2) + (unsigned)Cs[i] * 2u; }
    }
};
}

__device__ __forceinline__ void tc_strip(float* T, const float* src, int src_ld, int c0, int k0, bf16_t* dst, int K, int n0) {
    const int tid = tid_opaque();
    float4 v[8];
#pragma unroll
    for (int i = 0; i < 8; ++i) { const int kk = (tid >> 4) + 32 * i, c4 = (tid & 15) * 4; v[i] = *(const float4*)(src + (size_t)(k0 + kk) * src_ld + c0 + c4); }
    __syncthreads();
#pragma unroll
    for (int i = 0; i < 8; ++i) { const int kk = (tid >> 4) + 32 * i, c4 = (tid & 15) * 4;
        T[kk * 65 + c4] = v[i].x; T[kk * 65 + c4 + 1] = v[i].y; T[kk * 65 + c4 + 2] = v[i].z; T[kk * 65 + c4 + 3] = v[i].w; }
    __syncthreads();
    const int nl = tid >> 3, kc = (tid & 7) * 32;
#pragma unroll
    for (int q = 0; q < 4; ++q) { const int kq = kc + 8 * q; pg8::u32x4 w;
        w.x = pg8::cvt_pk_bf16(T[(kq + 0) * 65 + nl], T[(kq + 1) * 65 + nl]); w.y = pg8::cvt_pk_bf16(T[(kq + 2) * 65 + nl], T[(kq + 3) * 65 + nl]);
        w.z = pg8::cvt_pk_bf16(T[(kq + 4) * 65 + nl], T[(kq + 5) * 65 + nl]); w.w = pg8::cvt_pk_bf16(T[(kq + 6) * 65 + nl], T[(kq + 7) * 65 + nl]);
        *(pg8::u32x4*)(dst + (size_t)(n0 + nl) * K + k0 + kq) = w; }
}
__device__ __forceinline__ void s5_build_tables_fwd(float* ldsf, const Params& P, int l, int g, unsigned char* tb);
__device__ __forceinline__ void ph_prologue(float* lds, const Params& P) {
    constexpr int NJ_EXP = NLAYER * NEXP * 96, NJ_IN = NLAYER * 144, NJ_OUT = NLAYER * 64, NJ_TB = NLAYER * 16, NJ_GLU = NLAYER * 4, NJ_SGU = NLAYER * 4, NJ_RT = NLAYER * 16;
    bf16_t* WIN = (bf16_t*)(P.ws + WS_WIN); bf16_t* WOUT = (bf16_t*)(P.ws + WS_WOUT); bf16_t* WGU = (bf16_t*)(P.ws + WS_WGU); bf16_t* WD = (bf16_t*)(P.ws + WS_WD);
    constexpr int NJ_ALL = NJ_EXP + NJ_IN + NJ_OUT + NJ_TB + NJ_GLU + NJ_SGU + NJ_RT, NJ_SMALL = NJ_TB + NJ_GLU + NJ_SGU + NJ_RT;
    unsigned* qhead = (unsigned*)(P.ws + WS_CTL) + CW_Q;
    LAS int* jslot = (LAS int*)((LAS unsigned char*)lds + LDS_BYTES - 64);
    for (;;) {
        __syncthreads();
        if (tid_opaque() == 0) *jslot = (int)atomicAdd(qhead, 1u);
        __syncthreads();
        const int jj = __builtin_amdgcn_readfirstlane(*jslot);
        if (jj >= NJ_ALL) break;
        const int j = (jj < NJ_SMALL) ? (NJ_ALL - NJ_SMALL + jj) : (jj - NJ_SMALL);
        if (j < NJ_EXP) {
            const int le = j / 96, r = j % 96;
            if (r < 64) { const int n0 = (r >> 2) * 64, k0 = (r & 3) * 256, pn = n0 >> 8, within = n0 & 255;
                const float* s = (within < 128 ? P.in[I_EWG] : P.in[I_EWU]) + (size_t)le * D * DE;
                tc_strip(lds, s, DE, pn * 128 + (within & 127), k0, WGU + (size_t)le * 1024 * D, D, n0);
            } else { const int r2 = r - 64, n0 = (r2 >> 1) * 64, k0 = (r2 & 1) * 256;
                tc_strip(lds, P.in[I_EWD] + (size_t)le * DE * D, D, n0, k0, WD + (size_t)le * D * DE, DE, n0); }
        } else if (j < NJ_EXP + NJ_IN) {
            const int j2 = j - NJ_EXP, l = j2 / 144, r = j2 % 144, n0 = (r >> 2) * 64, k0 = (r & 3) * 256;
            tc_strip(lds, P.in[I_WIN] + (size_t)l * D * INW, INW, n0 < WCI ? n0 : n0 + 8, k0, WIN + (size_t)l * NMAIN * D, D, n0);
        } else if (j < NJ_EXP + NJ_IN + NJ_OUT) {
            const int j3 = j - NJ_EXP - NJ_IN, l = j3 / 64, r = j3 % 64, n0 = (r >> 2) * 64, k0 = (r & 3) * 256;
            tc_strip(lds, P.in[I_WOUT] + (size_t)l * D * D, D, n0, k0, WOUT + (size_t)l * D * D, D, n0);
        } else if (j < NJ_EXP + NJ_IN + NJ_OUT + NJ_TB) {
            const int j4 = j - (NJ_EXP + NJ_IN + NJ_OUT);
            s5_build_tables_fwd(lds, P, j4 >> 4, j4 & 15, P.ws + WS_TB + (size_t)(j4 >> 4) * 4 * MiB);
        } else if (j < NJ_EXP + NJ_IN + NJ_OUT + NJ_TB + NJ_GLU) {
            const int j5 = j - (NJ_EXP + NJ_IN + NJ_OUT + NJ_TB), l = j5 >> 2, n0 = (j5 & 3) * 64;
            tc_strip(lds, P.in[I_GLUW] + (size_t)l * 256 * 256, 256, n0, 0, (bf16_t*)(P.ws + WS_TB + (size_t)l * 4 * MiB + s5::T_GLUW), 256, n0);
        } else if (j < NJ_EXP + NJ_IN + NJ_OUT + NJ_TB + NJ_GLU + NJ_SGU) {
            const int j6 = j - (NJ_EXP + NJ_IN + NJ_OUT + NJ_TB + NJ_GLU), l = j6 >> 2, g = j6 & 3;
            bf16_t* wbp = (bf16_t*)(P.ws + WS_TB + (size_t)l * 4 * MiB + s5::T_SGUW) + (size_t)g * 128 * 128; const float* ws_ = P.in[I_SGUW] + ((size_t)l * 4 + g) * 128 * 128;
            for (int idx = tid_opaque(); idx < 128 * 128; idx += NTHREADS) { const int t = idx >> 7, s = idx & 127; wbp[idx] = (s <= t) ? (bf16_t)(pg8::cvt_pk_bf16(ws_[idx], 0.f) & 0xffffu) : (bf16_t)0; }
        } else {
            const int j7 = j - (NJ_EXP + NJ_IN + NJ_OUT + NJ_TB + NJ_GLU + NJ_SGU), l = j7 / 16, n0 = (j7 % 16) * 4;
            bf16_t* wh = (bf16_t*)(P.ws + WS_RT + (size_t)l * 256 * 1024); bf16_t* wl = wh + 48 * D;
            for (int idx = tid_opaque(); idx < 4 * D; idx += NTHREADS) { const int n = n0 + (idx >> 10), k = idx & (D - 1);
                const float w = (n < 4) ? P.in[I_RGW][((size_t)l * D + k) * 4 + n] : ((n < 36) ? P.in[I_REW][((size_t)l * D + k) * 32 + (n - 4)] : ((n >= 48 && n < 56) ? P.in[I_WIN][((size_t)l * D + k) * INW + WCI + (n - 48)] : 0.f));
                const unsigned hb = pg8::cvt_pk_bf16(w, 0.f) & 0xffffu; const bf16_t lb = (bf16_t)(pg8::cvt_pk_bf16(w - __uint_as_float(hb << 16), 0.f) & 0xffffu);
                if (n < 48) { wh[(size_t)n * D + k] = (bf16_t)hb; wl[(size_t)n * D + k] = lb; } else { wh[(size_t)(96 + n - 48) * D + k] = (bf16_t)hb; wh[(size_t)(112 + n - 48) * D + k] = lb; } }
        }
    }
    __syncthreads();
}

template <bool DUAL, class AF, class EF>
__device__ __forceinline__ void gemm_tile(float* lds, AF arow, int K, const float* B0, const float* B1, int ldb, int n0, int N, EF epi) {
    float* As = lds;
    float* Bs0 = lds + 32 * 132;
    float* Bs1 = Bs0 + 32 * 128;
    const int tid = tid_opaque(), ty = tid >> 4, tx = tid & 15;
    float acc0[4][8], acc1[4][8];
#pragma unroll
    for (int i = 0; i < 4; ++i)
#pragma unroll
        for (int j = 0; j < 8; ++j) { acc0[i][j] = 0.f; acc1[i][j] = 0.f; }
    const float* ap0 = arow((tid >> 3));
    const float* ap1 = arow((tid >> 3) + 64);
    const int akk = (tid & 7) * 4;
    const int bn = n0 + (tid & 31) * 4; const bool bok = bn < N;
    for (int k0 = 0; k0 < K; k0 += 32) {
        const float4 av0 = ap0 ? *(const float4*)(ap0 + k0 + akk) : make_float4(0.f, 0.f, 0.f, 0.f);
        const float4 av1 = ap1 ? *(const float4*)(ap1 + k0 + akk) : make_float4(0.f, 0.f, 0.f, 0.f);
        const int kb0 = k0 + (tid >> 5), kb1 = kb0 + 16;
        const float4 bv00 = bok ? *(const float4*)(B0 + (size_t)kb0 * ldb + bn) : make_float4(0.f, 0.f, 0.f, 0.f);
        const float4 bv01 = bok ? *(const float4*)(B0 + (size_t)kb1 * ldb + bn) : make_float4(0.f, 0.f, 0.f, 0.f);
        const float4 bv10 = (DUAL && bok) ? *(const float4*)(B1 + (size_t)kb0 * ldb + bn) : bv00;
        const float4 bv11 = (DUAL && bok) ? *(const float4*)(B1 + (size_t)kb1 * ldb + bn) : bv01;
        __syncthreads();
        { const int r = (tid >> 3);
          As[(akk + 0) * 132 + r] = av0.x; As[(akk + 1) * 132 + r] = av0.y; As[(akk + 2) * 132 + r] = av0.z; As[(akk + 3) * 132 + r] = av0.w;
          As[(akk + 0) * 132 + r + 64] = av1.x; As[(akk + 1) * 132 + r + 64] = av1.y; As[(akk + 2) * 132 + r + 64] = av1.z; As[(akk + 3) * 132 + r + 64] = av1.w; }
        { const int k = (tid >> 5);
          *(float4*)&Bs0[k * 128 + (tid & 31) * 4] = bv00; *(float4*)&Bs0[(k + 16) * 128 + (tid & 31) * 4] = bv01;
          if (DUAL) { *(float4*)&Bs1[k * 128 + (tid & 31) * 4] = bv10; *(float4*)&Bs1[(k + 16) * 128 + (tid & 31) * 4] = bv11; } }
        __syncthreads();
#pragma unroll 4
        for (int k = 0; k < 32; ++k) {
            const float4 a = *(const float4*)&As[k * 132 + ty * 4];
            const float4 b0 = *(const float4*)&Bs0[k * 128 + tx * 4], b1 = *(const float4*)&Bs0[k * 128 + 64 + tx * 4];
            const float aa[4] = {a.x, a.y, a.z, a.w};
            const float bb[8] = {b0.x, b0.y, b0.z, b0.w, b1.x, b1.y, b1.z, b1.w};
#pragma unroll
            for (int i = 0; i < 4; ++i)
#pragma unroll
                for (int j = 0; j < 8; ++j) acc0[i][j] = fmaf(aa[i], bb[j], acc0[i][j]);
            if (DUAL) {
                const float4 c0 = *(const float4*)&Bs1[k * 128 + tx * 4], c1 = *(const float4*)&Bs1[k * 128 + 64 + tx * 4];
                const float cc[8] = {c0.x, c0.y, c0.z, c0.w, c1.x, c1.y, c1.z, c1.w};
#pragma unroll
                for (int i = 0; i < 4; ++i)
#pragma unroll
                    for (int j = 0; j < 8; ++j) acc1[i][j] = fmaf(aa[i], cc[j], acc1[i][j]);
            }
        }
    }
#pragma unroll
    for (int i = 0; i < 4; ++i)
#pragma unroll
        for (int j = 0; j < 8; ++j) {
            const int r = ty * 4 + i, c = n0 + (j < 4 ? tx * 4 + j : 64 + tx * 4 + (j - 4));
            if (c < N) epi(r, c, acc0[i][j], acc1[i][j]);
        }
    __syncthreads();
}

__device__ __forceinline__ void ph_inproj(LAS unsigned char* ldsb, const bf16_t* xn, const bf16_t* wt, bf16_t* z, const float* RS, int skip) {
    pg8::StaticOrder S; S.init(NTOK, NMAIN, D, D, gridDim.x, blockIdx.x, xn, wt, INPROJ_WGM);
    if (skip & 2) S.pmmask = 15;
    pg8::EpiZ E{z, RS, skip & 1};
    pg8::gemm_phase<pg8::EpiZ, pg8::StaticOrder, false>(ldsb, D, D, S, E);
}

namespace ml {
using pg8::bf16x8; using pg8::f32x4; using pg8::u32x4; using pg8::u32x2;
constexpr int L = 128, NCH = S / L, NU = NB * 4 * NCH;
constexpr int QP = 144, TP = 272;
constexpr int OFF_Q = 0, OFF_K = OFF_Q + 128 * QP, OFF_VT = OFF_K + 128 * QP, OFF_KT = OFF_VT + 64 * TP, OFF_F = OFF_KT + 64 * TP;
constexpr int LDS_END = OFF_F + 4 * 128 * 4 + 64;
constexpr size_t O_CL = 0, O_CST = O_CL + (size_t)NU * 4096 * 4, O_NL = O_CST + (size_t)NU * 4096 * 2, O_NST = O_NL + (size_t)NU * 64 * 4,
                 O_MLOC = O_NST + (size_t)NU * 64 * 4, O_BL = O_MLOC + (size_t)NU * 4, O_MST = O_BL + (size_t)NU * 4, O_END = O_MST + (size_t)NU * 4;
__device__ __forceinline__ f32x4 mfma16(bf16x8 a, bf16x8 b, f32x4 c) { return __builtin_amdgcn_mfma_f32_16x16x32_bf16(a, b, c, 0, 0, 0); }
__device__ __forceinline__ float bf_lo(unsigned w) { return __uint_as_float(w << 16); }
__device__ __forceinline__ float bf_hi(unsigned w) { return __uint_as_float(w & 0xffff0000u); }
__device__ __forceinline__ unsigned short bf1(float x) { return (unsigned short)(pg8::cvt_pk_bf16(x, 0.f) & 0xffffu); }

__device__ __forceinline__ void stage_gates(LAS unsigned char* lds, const float* gates, const Params& P, int l, int head, int tok0, int tid) {
    LAS float* LF = (LAS float*)(lds + OFF_F); LAS float* IG = LF + 128; LAS float* Bc = LF + 256; LAS float* G2 = LF + 384; LAS float* scal = LF + 512;
    if (tid < 128) { const float* zr = gates + (size_t)(tok0 + tid) * 8;
        const float ipre = zr[head] + P.in[I_GATEB][l * 8 + head], fpre = zr[4 + head] + P.in[I_GATEB][l * 8 + 4 + head];
        LF[tid] = fminf(fpre, 0.f) - log1pf(expf(-fabsf(fpre))); IG[tid] = ipre; }
    __syncthreads();
    if (tid < 64) { const float a = LF[2 * tid], b2 = LF[2 * tid + 1]; const float s = a + b2; float inc = s;
#pragma unroll
        for (int o = 1; o < 64; o <<= 1) { const float v = __shfl_up(inc, o); if (tid >= o) inc += v; }
        const float exc = inc - s; const float b0 = exc + a, b1 = exc + s;
        Bc[2 * tid] = b0; Bc[2 * tid + 1] = b1; const float g0 = IG[2 * tid] - b0, g1 = IG[2 * tid + 1] - b1; G2[2 * tid] = g0; G2[2 * tid + 1] = g1;
        float gm = fmaxf(g0, g1);
#pragma unroll
        for (int o = 32; o > 0; o >>= 1) gm = fmaxf(gm, __shfl_xor(gm, o));
        if (tid == 63) { scal[0] = gm; scal[1] = b1; } }
    __syncthreads();
}
__device__ __forceinline__ void conv8_load(const bf16_t* z, int b, int pos, int which, int head, int c0, u32x4 (&raw)[4]) {
    const int col = (which ? ZCK : ZCQ) + head * 64 + c0;
#pragma unroll
    for (int j = 0; j < 4; ++j) { const int tg = pos - 3 + j; raw[j] = *(const u32x4*)(z + (size_t)(b * S + (tg > 0 ? tg : 0)) * ZW + col); }
}
__device__ __forceinline__ void conv8_finish(const u32x4 (&raw)[4], const float* cw, int pos, int which, int head, int c0, float (&o)[8]) {
    const int cc = which * 256 + head * 64 + c0;
    float x[8];
#pragma unroll
    for (int e = 0; e < 8; ++e) x[e] = 0.f;
    float4 wa[4], wb[4];
#pragma unroll
    for (int j = 0; j < 4; ++j) { wa[j] = *(const float4*)(cw + j * 512 + cc); wb[j] = *(const float4*)(cw + j * 512 + cc + 4); }
    __builtin_amdgcn_sched_barrier(0);
#pragma unroll
    for (int j = 0; j < 4; ++j) { const float mk = (pos - 3 + j >= 0) ? 1.f : 0.f;
        const float4 w0 = wa[j], w1 = wb[j];
        x[0] += mk * w0.x * bf_lo(raw[j].x); x[1] += mk * w0.y * bf_hi(raw[j].x); x[2] += mk * w0.z * bf_lo(raw[j].y); x[3] += mk * w0.w * bf_hi(raw[j].y);
        x[4] += mk * w1.x * bf_lo(raw[j].z); x[5] += mk * w1.y * bf_hi(raw[j].z); x[6] += mk * w1.z * bf_lo(raw[j].w); x[7] += mk * w1.w * bf_hi(raw[j].w); }
    const float sc = which ? 0.125f : 1.f;
#pragma unroll
    for (int e = 0; e < 8; ++e) o[e] = x[e] * sc / (1.f + __expf(-x[e]));
}
__device__ __forceinline__ void vt_load(const bf16_t* z, int head, int tok0, int tid, u32x4 (&w)[2]) {
#pragma unroll
    for (int it = 0; it < 2; ++it) { const int idx = tid + it * NTHREADS, s = idx & 127, cg = idx >> 7; w[it] = *(const u32x4*)(z + (size_t)(tok0 + s) * ZW + ZCV + head * 64 + cg * 8); }
}
__device__ __forceinline__ void vt_store(LAS unsigned char* lds, int tid, const u32x4 (&w)[2]) {
#pragma unroll
    for (int it = 0; it < 2; ++it) { const int idx = tid + it * NTHREADS, s = idx & 127, cg = idx >> 7; const unsigned ww[4] = {w[it].x, w[it].y, w[it].z, w[it].w};
#pragma unroll
        for (int e = 0; e < 8; ++e) *(LAS unsigned short*)(lds + OFF_VT + (cg * 8 + e) * TP + s * 2) = (unsigned short)((e & 1) ? (ww[e >> 1] >> 16) : (ww[e >> 1] & 0xffffu)); }
}

__device__ __forceinline__ void p1_unit(LAS unsigned char* lds, const bf16_t* z, const float* gates, const Params& P, int l, int u, unsigned char* wsm) {
    const int tid = tid_opaque(), lane = tid & 63, wid = __builtin_amdgcn_readfirstlane(tid >> 6), r = lane & 15, qd = lane >> 4;
    const int b = u >> 8, head = (u >> 6) & 3, c = u & 63, tok0 = b * S + c * L;
    LAS float* G2 = (LAS float*)(lds + OFF_F) + 384; LAS float* scal = (LAS float*)(lds + OFF_F) + 512;
    u32x4 vraw[2], kraw[2][4];
    vt_load(z, head, tok0, tid, vraw);
#pragma unroll
    for (int it = 0; it < 2; ++it) { const int idx = tid + it * NTHREADS; conv8_load(z, b, c * L + (idx & 127), 1, head, (idx >> 7) * 8, kraw[it]); }
    __syncthreads();
    stage_gates(lds, gates, P, l, head, tok0, tid);
    const float gmax = scal[0], bL = scal[1];
    vt_store(lds, tid, vraw);
    const float* cw = P.in[I_CONVW] + (size_t)l * 4 * 512;
#pragma unroll
    for (int it = 0; it < 2; ++it) { const int idx = tid + it * NTHREADS, s = idx & 127, cg = idx >> 7;
        float o[8]; conv8_finish(kraw[it], cw, c * L + s, 1, head, cg * 8, o);
        const float ws = __expf(G2[s] - gmax);
#pragma unroll
        for (int e = 0; e < 8; ++e) *(LAS unsigned short*)(lds + OFF_KT + (cg * 8 + e) * TP + s * 2) = bf1(o[e] * ws); }
    __syncthreads();
    const int kt = wid >> 1;
    float* CL = (float*)(wsm + O_CL) + (size_t)u * 4096;
#pragma unroll
    for (int i = 0; i < 2; ++i) { const int vt = (wid & 1) * 2 + i; f32x4 acc = {0.f, 0.f, 0.f, 0.f};
#pragma unroll
        for (int ks = 0; ks < 4; ++ks) { const bf16x8 a = *(const LAS bf16x8*)(lds + OFF_KT + (16 * kt + r) * TP + (32 * ks + 8 * qd) * 2), bb = *(const LAS bf16x8*)(lds + OFF_VT + (16 * vt + r) * TP + (32 * ks + 8 * qd) * 2);
            acc = mfma16(a, bb, acc); }
        *(f32x4*)(CL + (size_t)(16 * vt + r) * 64 + 16 * kt + 4 * qd) = acc; }
    if (tid < 64) { float sum = 0.f;
        for (int s2 = 0; s2 < 128; s2 += 2) { const unsigned w2 = *(const LAS unsigned*)(lds + OFF_KT + tid * TP + s2 * 2); sum += bf_lo(w2) + bf_hi(w2); }
        ((float*)(wsm + O_NL))[(size_t)u * 64 + tid] = sum; }
    if (tid == 0) { ((float*)(wsm + O_MLOC))[u] = bL + gmax; ((float*)(wsm + O_BL))[u] = bL; }
}
__device__ __forceinline__ void p2_scan(unsigned char* wsm) {
    const int tid = tid_opaque();
    const float* CL = (const float*)(wsm + O_CL); const float* NL = (const float*)(wsm + O_NL); const float* MLOC = (const float*)(wsm + O_MLOC); const float* BL = (const float*)(wsm + O_BL);
    bf16_t* CST = (bf16_t*)(wsm + O_CST); float* NST = (float*)(wsm + O_NST); float* MST = (float*)(wsm + O_MST);
    for (int idx = blockIdx.x * NTHREADS + tid; idx < 32 * 4096; idx += gridDim.x * NTHREADS) {
        const int bh = idx >> 12, e = idx & 4095;
        float C = 0.f, nn = 0.f, m = 0.f;
#pragma unroll 1
        for (int c0 = 0; c0 < NCH; c0 += 16) {
            float cl[16], ml_[16], bl[16], nl[16];
#pragma unroll
            for (int i = 0; i < 16; ++i) { const int u = bh * NCH + c0 + i; cl[i] = CL[(size_t)u * 4096 + e]; ml_[i] = MLOC[u]; bl[i] = BL[u]; nl[i] = NL[(size_t)u * 64 + (e & 63)]; }
            unsigned short cs[16]; float ns[16], ms[16];
#pragma unroll
            for (int i = 0; i < 16; ++i) { cs[i] = bf1(C); ns[i] = nn; ms[i] = m;
                const float mn = fmaxf(bl[i] + m, ml_[i]), dec = __expf(bl[i] + m - mn), wl = __expf(ml_[i] - mn);
                C = dec * C + wl * cl[i]; nn = dec * nn + wl * nl[i]; m = mn; }
#pragma unroll
            for (int i = 0; i < 16; ++i) { const int u = bh * NCH + c0 + i; CST[(size_t)u * 4096 + e] = cs[i]; if (e < 64) NST[(size_t)u * 64 + e] = ns[i]; if (e == 0) MST[u] = ms[i]; }
        }
    }
}
__device__ __forceinline__ void p3_unit(LAS unsigned char* lds, const bf16_t* z, const float* gates, const Params& P, int l, int u, const unsigned char* wsm, bf16_t* mix) {
    const int tid = tid_opaque(), lane = tid & 63, wid = __builtin_amdgcn_readfirstlane(tid >> 6), r = lane & 15, qd = lane >> 4;
    const int b = u >> 8, head = (u >> 6) & 3, c = u & 63, tok0 = b * S + c * L;
    LAS float* Bc = (LAS float*)(lds + OFF_F) + 256; LAS float* G2 = (LAS float*)(lds + OFF_F) + 384;
    u32x4 vraw[2], qkraw[4][4];
    vt_load(z, head, tok0, tid, vraw);
#pragma unroll
    for (int it = 0; it < 4; ++it) { const int idx = tid + it * NTHREADS; conv8_load(z, b, c * L + ((idx >> 3) & 127), idx >> 10, head, (idx & 7) * 8, qkraw[it]); }
    __syncthreads();
    stage_gates(lds, gates, P, l, head, tok0, tid);
    vt_store(lds, tid, vraw);
    const float* cw = P.in[I_CONVW] + (size_t)l * 4 * 512;
#pragma unroll
    for (int it = 0; it < 4; ++it) { const int idx = tid + it * NTHREADS, which = idx >> 10, s = (idx >> 3) & 127, cg = idx & 7;
        float o[8]; conv8_finish(qkraw[it], cw, c * L + s, which, head, cg * 8, o);
        u32x4 w; w.x = pg8::cvt_pk_bf16(o[0], o[1]); w.y = pg8::cvt_pk_bf16(o[2], o[3]); w.z = pg8::cvt_pk_bf16(o[4], o[5]); w.w = pg8::cvt_pk_bf16(o[6], o[7]);
        *(LAS u32x4*)(lds + (which ? OFF_K : OFF_Q) + s * QP + cg * 16) = w; }
    __syncthreads();
    const int w = wid, t = 16 * w + r;
    const bf16x8 bq0 = *(const LAS bf16x8*)(lds + OFF_Q + t * QP + qd * 16), bq1 = *(const LAS bf16x8*)(lds + OFF_Q + t * QP + 64 + qd * 16);
    f32x4 accS[8];
#pragma unroll
    for (int ct = 0; ct < 8; ++ct) { accS[ct] = (f32x4){0.f, 0.f, 0.f, 0.f};
        if (ct <= w) { const bf16x8 a0 = *(const LAS bf16x8*)(lds + OFF_K + (16 * ct + r) * QP + qd * 16), a1 = *(const LAS bf16x8*)(lds + OFF_K + (16 * ct + r) * QP + 64 + qd * 16);
            accS[ct] = mfma16(a0, bq0, accS[ct]); accS[ct] = mfma16(a1, bq1, accS[ct]); } }
    const float bt = Bc[t], mst = ((const float*)(wsm + O_MST))[u];
    float ld[8][4]; float mloc = -3.0e38f;
#pragma unroll
    for (int ct = 0; ct < 8; ++ct) { const f32x4 g = *(const LAS f32x4*)(G2 + 16 * ct + 4 * qd);
#pragma unroll
        for (int j = 0; j < 4; ++j) { const bool valid = (ct < w) || (ct == w && 4 * qd + j <= r); ld[ct][j] = valid ? bt + g[j] : -3.0e38f; mloc = fmaxf(mloc, ld[ct][j]); } }
    mloc = fmaxf(mloc, __shfl_xor(mloc, 16)); mloc = fmaxf(mloc, __shfl_xor(mloc, 32));
    const float mt = fmaxf(bt + mst, mloc);
    float den = 0.f;
#pragma unroll
    for (int ct = 0; ct < 8; ++ct)
#pragma unroll
        for (int j = 0; j < 4; ++j) { const float pe = __expf(ld[ct][j] - mt) * accS[ct][j]; accS[ct][j] = pe; den += pe; }
    den += __shfl_xor(den, 16); den += __shfl_xor(den, 32);
    const bf16_t* cst = (const bf16_t*)(wsm + O_CST) + (size_t)u * 4096; const float* nst = (const float*)(wsm + O_NST) + (size_t)u * 64;
    f32x4 accN[4];
#pragma unroll
    for (int dt = 0; dt < 4; ++dt) { const bf16x8 c0 = *(const bf16x8*)(cst + (16 * dt + r) * 64 + 8 * qd), c1 = *(const bf16x8*)(cst + (16 * dt + r) * 64 + 32 + 8 * qd);
        accN[dt] = mfma16(c0, bq0, (f32x4){0.f, 0.f, 0.f, 0.f}); accN[dt] = mfma16(c1, bq1, accN[dt]); }
    const float winter = __expf(bt + mst - mt);
    float nq = 0.f;
    { const float4 n0 = *(const float4*)(nst + 8 * qd), n1 = *(const float4*)(nst + 8 * qd + 4), n2 = *(const float4*)(nst + 32 + 8 * qd), n3 = *(const float4*)(nst + 36 + 8 * qd);
      const u32x4 q0 = __builtin_bit_cast(u32x4, bq0), q1 = __builtin_bit_cast(u32x4, bq1);
      nq = bf_lo(q0.x) * n0.x + bf_hi(q0.x) * n0.y + bf_lo(q0.y) * n0.z + bf_hi(q0.y) * n0.w + bf_lo(q0.z) * n1.x + bf_hi(q0.z) * n1.y + bf_lo(q0.w) * n1.z + bf_hi(q0.w) * n1.w
         + bf_lo(q1.x) * n2.x + bf_hi(q1.x) * n2.y + bf_lo(q1.y) * n2.z + bf_hi(q1.y) * n2.w + bf_lo(q1.z) * n3.x + bf_hi(q1.z) * n3.y + bf_lo(q1.w) * n3.z + bf_hi(q1.w) * n3.w; }
    nq += __shfl_xor(nq, 16); nq += __shfl_xor(nq, 32);
    den += winter * nq;
#pragma unroll
    for (int dt = 0; dt < 4; ++dt) accN[dt] = accN[dt] * winter;
#pragma unroll
    for (int kk = 0; kk < 4; ++kk) if (2 * kk <= w) {
        u32x4 pw; pw.x = pg8::cvt_pk_bf16(accS[2 * kk][0], accS[2 * kk][1]); pw.y = pg8::cvt_pk_bf16(accS[2 * kk][2], accS[2 * kk][3]);
        pw.z = pg8::cvt_pk_bf16(accS[2 * kk + 1][0], accS[2 * kk + 1][1]); pw.w = pg8::cvt_pk_bf16(accS[2 * kk + 1][2], accS[2 * kk + 1][3]);
        const bf16x8 pf = __builtin_bit_cast(bf16x8, pw);
#pragma unroll
        for (int dt = 0; dt < 4; ++dt) { const u32x2 v0 = *(const LAS u32x2*)(lds + OFF_VT + (16 * dt + r) * TP + (32 * kk + 4 * qd) * 2), v1 = *(const LAS u32x2*)(lds + OFF_VT + (16 * dt + r) * TP + (32 * kk + 16 + 4 * qd) * 2);
            u32x4 vw; vw.x = v0.x; vw.y = v0.y; vw.z = v1.x; vw.w = v1.y;
            accN[dt] = mfma16(__builtin_bit_cast(bf16x8, vw), pf, accN[dt]); } }
    const float inv = 1.f / fmaxf(fabsf(den), __expf(-mt));
    float ss = 0.f;
#pragma unroll
    for (int dt = 0; dt < 4; ++dt) { accN[dt] = accN[dt] * inv; ss += accN[dt][0] * accN[dt][0] + accN[dt][1] * accN[dt][1] + accN[dt][2] * accN[dt][2] + accN[dt][3] * accN[dt][3]; }
    ss += __shfl_xor(ss, 16); ss += __shfl_xor(ss, 32);
    const float rs = rsqrtf(ss * (1.f / 64.f) + EPS);
    const float* ng = P.in[I_MNG] + l * 256 + head * 64; const bf16_t* cop = z + (size_t)(tok0 + t) * ZW + ZCO + head * 64;
    bf16_t* op = mix + (size_t)(tok0 + t) * D + 512 + head * 64;
#pragma unroll
    for (int dt = 0; dt < 4; ++dt) { const int d0 = 16 * dt + 4 * qd; const float4 g = *(const float4*)(ng + d0); const u32x2 cw2 = *(const u32x2*)(cop + d0); const float4 co = make_float4(bf_lo(cw2.x), bf_hi(cw2.x), bf_lo(cw2.y), bf_hi(cw2.y));
        u32x2 o; o.x = pg8::cvt_pk_bf16(accN[dt][0] * rs * g.x / (1.f + __expf(-co.x)), accN[dt][1] * rs * g.y / (1.f + __expf(-co.y)));
        o.y = pg8::cvt_pk_bf16(accN[dt][2] * rs * g.z / (1.f + __expf(-co.z)), accN[dt][3] * rs * g.w / (1.f + __expf(-co.w)));
        *(u32x2*)(op + d0) = o; }
}
static_assert(O_END <= 64 * MiB && LDS_END <= 128 * 1024, "mLSTM scratch fits");
}

namespace s5 {
using pg8::bf16x8; using pg8::f32x4; using pg8::u32x4; using pg8::u32x2;
constexpr int LC = 16, NINST = NTOK / LC;
constexpr size_t O_E = 0, O_XC = O_E + (size_t)NINST * 16 * 128 * 4, O_END = O_XC + (size_t)NINST * 16 * 128 * 2;
constexpr int YP = 528;
__device__ __forceinline__ f32x4 mfma16(bf16x8 a, bf16x8 b, f32x4 c) { return __builtin_amdgcn_mfma_f32_16x16x32_bf16(a, b, c, 0, 0, 0); }

__device__ __forceinline__ void build_tables(float* ldsf, const Params& P, int l, int g, unsigned char* tb) {
    const int tid = tid_opaque();
    float* apw = ldsf; float* bb = apw + 17 * 64 * 2; float* cc = bb + 64 * 16 * 2;
    __syncthreads();
    if (tid < 64) { const int gp = (l * 16 + g) * 64 + tid;
        const float ar = P.in[I_ARE][gp], ai = P.in[I_AIM][gp], dt = expf(P.in[I_LDT][l * 16 + g]);
        for (int tau = 0; tau <= 16; ++tau) { const float er = expf(ar * dt * tau), ang = ai * dt * tau; apw[(tau * 64 + tid) * 2] = er * cosf(ang); apw[(tau * 64 + tid) * 2 + 1] = er * sinf(ang); }
        const float abr = apw[(64 + tid) * 2], abi = apw[(64 + tid) * 2 + 1];
        const float xr_ = abr - 1.f, xi_ = abi, den = ar * ar + ai * ai;
        const float cr = (xr_ * ar + xi_ * ai) / den, ci = (xi_ * ar - xr_ * ai) / den;
        for (int h = 0; h < 16; ++h) { const float br = P.in[I_BRE][(size_t)gp * 16 + h], bi = P.in[I_BIM][(size_t)gp * 16 + h]; bb[(tid * 16 + h) * 2] = cr * br - ci * bi; bb[(tid * 16 + h) * 2 + 1] = cr * bi + ci * br; }
        float* a16 = (float*)(tb + T_A16) + (size_t)(g * 64 + tid) * 2; a16[0] = apw[(16 * 64 + tid) * 2]; a16[1] = apw[(16 * 64 + tid) * 2 + 1]; }
    for (int idx = tid; idx < 16 * 64; idx += NTHREADS) { const int h = idx >> 6, p = idx & 63; const int ci_ = ((l * 16 + g) * 16 + h) * 64 + p; cc[idx * 2] = P.in[I_CRE][ci_]; cc[idx * 2 + 1] = P.in[I_CIM][ci_]; }
    __syncthreads();
    bf16_t* KM = (bf16_t*)(tb + T_KMAT) + (size_t)g * 32 * 256;
    for (int idx = tid; idx < 15 * 256; idx += NTHREADS) KM[idx] = (bf16_t)0; bf16_t* FT = (bf16_t*)(tb + T_F) + (size_t)g * 256 * 128; bf16_t* GT = (bf16_t*)(tb + T_G) + (size_t)g * 128 * 256;
    for (int idx = tid; idx < 16 * 256; idx += NTHREADS) { const int tau = idx >> 8, h = (idx >> 4) & 15, hp = idx & 15; float s = 0.f;
        for (int p = 0; p < 64; ++p) { const float cr = cc[(h * 64 + p) * 2], ci = cc[(h * 64 + p) * 2 + 1], ar = apw[(tau * 64 + p) * 2], ai = apw[(tau * 64 + p) * 2 + 1], br = bb[(p * 16 + hp) * 2], bi = bb[(p * 16 + hp) * 2 + 1];
            const float er = ar * br - ai * bi, ei = ar * bi + ai * br; s += cr * er - ci * ei; }
        KM[15 * 256 + idx] = ml::bf1(s); }
    for (int idx = tid; idx < 256 * 64; idx += NTHREADS) { const int n = idx >> 6, p = idx & 63, t = n >> 4, h = n & 15;
        const float cr = cc[(h * 64 + p) * 2], ci = cc[(h * 64 + p) * 2 + 1], ar = apw[((t + 1) * 64 + p) * 2], ai = apw[((t + 1) * 64 + p) * 2 + 1];
        FT[(size_t)n * 128 + p] = ml::bf1(cr * ar - ci * ai); FT[(size_t)n * 128 + 64 + p] = ml::bf1(-(cr * ai + ci * ar)); }
    for (int idx = tid; idx < 64 * 256; idx += NTHREADS) { const int p = idx >> 8, k = idx & 255, s = k >> 4, hp = k & 15;
        const float ar = apw[((15 - s) * 64 + p) * 2], ai = apw[((15 - s) * 64 + p) * 2 + 1], br = bb[(p * 16 + hp) * 2], bi = bb[(p * 16 + hp) * 2 + 1];
        GT[(size_t)p * 256 + k] = ml::bf1(ar * br - ai * bi); GT[(size_t)(64 + p) * 256 + k] = ml::bf1(ar * bi + ai * br); }
}
__device__ __forceinline__ void load_u_frags(const bf16_t* z, int tok0, int g, int r, int qd, bf16x8 (&uf)[8]) {
#pragma unroll
    for (int ks = 0; ks < 8; ++ks) uf[ks] = *(const bf16x8*)(z + (size_t)(tok0 + 16 * r + 2 * ks + (qd >> 1)) * ZW + ZSU + 16 * g + 8 * (qd & 1));
}
__device__ __forceinline__ void p1_unit(const bf16_t* z, const unsigned char* tb, int u, unsigned char* wss) {
    const int tid = tid_opaque(), lane = tid & 63, wid = __builtin_amdgcn_readfirstlane(tid >> 6), r = lane & 15, qd = lane >> 4;
    const int tok0 = u * 256, inst0 = u * 16;
    float* E = (float*)(wss + O_E);
#pragma unroll 1
    for (int gi = 0; gi < 2; ++gi) { const int g = 2 * wid + gi;
        bf16x8 uf[8]; load_u_frags(z, tok0, g, r, qd, uf);
        const bf16_t* GT = (const bf16_t*)(tb + T_G) + (size_t)g * 128 * 256 + (size_t)r * 256 + 8 * qd;
        bf16x8 gf[2][8];
#pragma unroll
        for (int ks = 0; ks < 8; ++ks) gf[0][ks] = *(const bf16x8*)(GT + 32 * ks);
#pragma unroll
        for (int nt = 0; nt < 8; ++nt) {
            if (nt + 1 < 8) {
#pragma unroll
                for (int ks = 0; ks < 8; ++ks) gf[(nt + 1) & 1][ks] = *(const bf16x8*)(GT + (size_t)(16 * (nt + 1)) * 256 + 32 * ks); }
            __builtin_amdgcn_sched_barrier(0);
            f32x4 acc = {0.f, 0.f, 0.f, 0.f};
#pragma unroll
            for (int ks = 0; ks < 8; ++ks) acc = mfma16(gf[nt & 1][ks], uf[ks], acc);
            *(f32x4*)(E + ((size_t)(inst0 + r) * 16 + g) * 128 + 16 * nt + 4 * qd) = acc;
            __builtin_amdgcn_sched_barrier(0); }
    }
}
__device__ __forceinline__ void p2_scan(LAS unsigned char* lds, const unsigned char* tb, unsigned char* wss) {
    const int tid = tid_opaque(), p = tid & 63, seg = tid >> 6;
    const float* __restrict__ E = (const float*)(wss + O_E); bf16_t* __restrict__ XC = (bf16_t*)(wss + O_XC);
    LAS float* SE = (LAS float*)lds;
    for (int u = blockIdx.x; u < NB * 16; u += gridDim.x) {
        const int b = u >> 4, g = u & 15;
        const float* a16 = (const float*)(tb + T_A16) + (size_t)(g * 64 + p) * 2; const float ar = a16[0], ai = a16[1];
        const size_t o0 = ((size_t)(b * (S / LC) + seg * 64) * 16 + g) * 128 + p; constexpr size_t cs = (size_t)16 * 128;
        float xr = 0.f, xi = 0.f;
#pragma unroll 1
        for (int c0 = 0; c0 < 64; c0 += 16) { float er[16], ei[16];
#pragma unroll
            for (int i = 0; i < 16; ++i) { er[i] = E[o0 + (c0 + i) * cs]; ei[i] = E[o0 + (c0 + i) * cs + 64]; }
#pragma unroll
            for (int i = 0; i < 16; ++i) { const float nr = ar * xr - ai * xi + er[i], ni = ar * xi + ai * xr + ei[i]; xr = nr; xi = ni; } }
        __syncthreads();
        SE[(seg * 64 + p) * 2] = xr; SE[(seg * 64 + p) * 2 + 1] = xi;
        __syncthreads();
        float br = ar, bi = ai;
#pragma unroll
        for (int i = 0; i < 6; ++i) { const float nr = br * br - bi * bi, ni = 2.f * br * bi; br = nr; bi = ni; }
        xr = 0.f; xi = 0.f;
        for (int s2 = 0; s2 < seg; ++s2) { const float er = SE[(s2 * 64 + p) * 2], ei = SE[(s2 * 64 + p) * 2 + 1]; const float nr = br * xr - bi * xi + er, ni = br * xi + bi * xr + ei; xr = nr; xi = ni; }
#pragma unroll 1
        for (int c0 = 0; c0 < 64; c0 += 16) { float er[16], ei[16]; unsigned short sr[16], si[16];
#pragma unroll
            for (int i = 0; i < 16; ++i) { er[i] = E[o0 + (c0 + i) * cs]; ei[i] = E[o0 + (c0 + i) * cs + 64]; }
#pragma unroll
            for (int i = 0; i < 16; ++i) { sr[i] = ml::bf1(xr); si[i] = ml::bf1(xi); const float nr = ar * xr - ai * xi + er[i], ni = ar * xi + ai * xr + ei[i]; xr = nr; xi = ni; }
#pragma unroll
            for (int i = 0; i < 16; ++i) { XC[o0 + (c0 + i) * cs] = sr[i]; XC[o0 + (c0 + i) * cs + 64] = si[i]; } }
    }
    __syncthreads();
}
__device__ __forceinline__ void p3_unit(LAS unsigned char* lds, const bf16_t* z, const Params& P, int l, const unsigned char* tb, int u, const unsigned char* wss, bf16_t* mix) {
    const int tid = tid_opaque(), lane = tid & 63, wid = __builtin_amdgcn_readfirstlane(tid >> 6), r = lane & 15, qd = lane >> 4;
    const int tok0 = u * 256, inst0 = u * 16;
    const bf16_t* XC = (const bf16_t*)(wss + O_XC);
    __syncthreads();
#pragma unroll 1
    for (int gi = 0; gi < 2; ++gi) { const int g = 2 * wid + gi;
        bf16x8 uf[8]; load_u_frags(z, tok0, g, r, qd, uf);
        bf16x8 xf[4];
#pragma unroll
        for (int ks = 0; ks < 4; ++ks) xf[ks] = *(const bf16x8*)(XC + ((size_t)(inst0 + r) * 16 + g) * 128 + 32 * ks + 8 * qd);
        const bf16_t* KM = (const bf16_t*)(tb + T_KMAT) + (size_t)g * 32 * 256 + (size_t)(15 - (qd >> 1)) * 256 + r * 16 + 8 * (qd & 1);
        const bf16_t* FT = (const bf16_t*)(tb + T_F) + (size_t)g * 256 * 128 + (size_t)r * 128 + 8 * qd;
        const bf16_t* up = z + (size_t)(tok0 + 16 * r) * ZW + ZSU + 16 * g + 4 * qd;
        const float4 dsk = *(const float4*)(P.in[I_SD] + l * 256 + g * 16 + 4 * qd);
        bf16x8 kf[2][8], ff[2][4]; u32x2 uw[2];
#pragma unroll
        for (int ks = 0; ks < 8; ++ks) kf[0][ks] = *(const bf16x8*)(KM + (ptrdiff_t)(0 - 2 * ks) * 256);
#pragma unroll
        for (int ks = 0; ks < 4; ++ks) ff[0][ks] = *(const bf16x8*)(FT + 32 * ks);
        uw[0] = *(const u32x2*)up;
#pragma unroll
        for (int t = 0; t < 16; ++t) {
            if (t + 1 < 16) {
#pragma unroll
                for (int ks = 0; ks < 8; ++ks) kf[(t + 1) & 1][ks] = *(const bf16x8*)(KM + (ptrdiff_t)(t + 1 - 2 * ks) * 256);
#pragma unroll
                for (int ks = 0; ks < 4; ++ks) ff[(t + 1) & 1][ks] = *(const bf16x8*)(FT + (size_t)(t + 1) * 16 * 128 + 32 * ks);
                uw[(t + 1) & 1] = *(const u32x2*)(up + (size_t)(t + 1) * ZW); }
            __builtin_amdgcn_sched_barrier(0);
            f32x4 acc = {0.f, 0.f, 0.f, 0.f};
#pragma unroll
            for (int ks = 0; ks < 8; ++ks) if (2 * ks <= t) acc = mfma16(kf[t & 1][ks], uf[ks], acc);
#pragma unroll
            for (int ks = 0; ks < 4; ++ks) acc = mfma16(ff[t & 1][ks], xf[ks], acc);
            const u32x2 uu = uw[t & 1];
            const float y0 = gelu_tanh(acc[0] + dsk.x * ml::bf_lo(uu.x)), y1 = gelu_tanh(acc[1] + dsk.y * ml::bf_hi(uu.x)), y2 = gelu_tanh(acc[2] + dsk.z * ml::bf_lo(uu.y)), y3 = gelu_tanh(acc[3] + dsk.w * ml::bf_hi(uu.y));
            u32x2 o; o.x = pg8::cvt_pk_bf16(y0, y1); o.y = pg8::cvt_pk_bf16(y2, y3);
            *(LAS u32x2*)(lds + (16 * r + t) * YP + (16 * g + 4 * qd) * 2) = o;
            __builtin_amdgcn_sched_barrier(0); }
    }
    __syncthreads();
    const bf16_t* GW = (const bf16_t*)(tb + T_GLUW);
    bf16x8 wf[2][8];
#pragma unroll
    for (int nt = 0; nt < 2; ++nt)
#pragma unroll
        for (int ks = 0; ks < 8; ++ks) wf[nt][ks] = *(const bf16x8*)(GW + (size_t)(32 * wid + 16 * nt + r) * 256 + 32 * ks + 8 * qd);
    const float* gb = P.in[I_GLUB] + l * 256;
    const float4 gb0 = *(const float4*)(gb + 32 * wid + 4 * qd), gb1 = *(const float4*)(gb + 32 * wid + 16 + 4 * qd);
#pragma unroll 2
    for (int mt = 0; mt < 16; ++mt) {
        f32x4 a0 = {0.f, 0.f, 0.f, 0.f}, a1 = {0.f, 0.f, 0.f, 0.f};
#pragma unroll
        for (int ks = 0; ks < 8; ++ks) { const bf16x8 yf = *(const LAS bf16x8*)(lds + (16 * mt + r) * YP + (32 * ks + 8 * qd) * 2); a0 = mfma16(wf[0][ks], yf, a0); a1 = mfma16(wf[1][ks], yf, a1); }
        const int row = 16 * mt + r;
        const u32x2 y0 = *(const LAS u32x2*)(lds + row * YP + (32 * wid + 4 * qd) * 2), y1 = *(const LAS u32x2*)(lds + row * YP + (32 * wid + 16 + 4 * qd) * 2);
        bf16_t* op = mix + (size_t)(tok0 + row) * D + 256 + 32 * wid + 4 * qd;
        u32x2 o;
        o.x = pg8::cvt_pk_bf16(ml::bf_lo(y0.x) / (1.f + __expf(-(a0[0] + gb0.x))), ml::bf_hi(y0.x) / (1.f + __expf(-(a0[1] + gb0.y))));
        o.y = pg8::cvt_pk_bf16(ml::bf_lo(y0.y) / (1.f + __expf(-(a0[2] + gb0.z))), ml::bf_hi(y0.y) / (1.f + __expf(-(a0[3] + gb0.w))));
        *(u32x2*)op = o;
        o.x = pg8::cvt_pk_bf16(ml::bf_lo(y1.x) / (1.f + __expf(-(a1[0] + gb1.x))), ml::bf_hi(y1.x) / (1.f + __expf(-(a1[1] + gb1.y))));
        o.y = pg8::cvt_pk_bf16(ml::bf_lo(y1.y) / (1.f + __expf(-(a1[2] + gb1.z))), ml::bf_hi(y1.y) / (1.f + __expf(-(a1[3] + gb1.w))));
        *(u32x2*)(op + 16) = o;
    }
}
static_assert(T_LAYER <= 4 * MiB && O_END <= 48 * MiB && 256 * YP <= LDS_BYTES - 64, "S5 scratch fits");
}
__device__ __forceinline__ void s5_build_tables_fwd(float* ldsf, const Params& P, int l, int g, unsigned char* tb) { s5::build_tables(ldsf, P, l, g, tb); }

namespace at {
using pg8::bf16x8; using pg8::f32x4; using pg8::u32x4; using pg8::u32x2;
constexpr int KP = 144, VP = 528, OFF_K = 0, OFF_VT = 256 * KP, LDS_END = OFF_VT + 64 * VP;
__device__ __forceinline__ void unit(LAS unsigned char* lds, const bf16_t* z, const float* sinks, bf16_t* mix, int u) {
    const int tid = tid_opaque(), lane = tid & 63, wid = __builtin_amdgcn_readfirstlane(tid >> 6), r = lane & 15, qd = lane >> 4;
    const int b = u >> 7, g = (u >> 6) & 1, n = u & 63, tokb = b * S + 128 * n;
    const int hq = 2 * g + (wid >> 2);
    const float sink = sinks[hq];
    __syncthreads();
#pragma unroll
    for (int it = 0; it < 4; ++it) { const int idx = tid + it * NTHREADS, kl = idx >> 3, cg = idx & 7; const bool ok = (n > 0) || (kl >= 128);
        u32x4 w = *(const u32x4*)(z + (size_t)(ok ? tokb - 128 + kl : tokb) * ZW + ZK + g * 64 + cg * 8); if (!ok) w = (u32x4){0u, 0u, 0u, 0u};
        *(LAS u32x4*)(lds + OFF_K + kl * KP + cg * 16) = w; }
#pragma unroll
    for (int it = 0; it < 4; ++it) { const int idx = tid + it * NTHREADS, kl = idx & 255, cg = idx >> 8; const bool ok = (n > 0) || (kl >= 128);
        u32x4 w = *(const u32x4*)(z + (size_t)(ok ? tokb - 128 + kl : tokb) * ZW + ZV + g * 64 + cg * 8); if (!ok) w = (u32x4){0u, 0u, 0u, 0u};
        const unsigned ww[4] = {w.x, w.y, w.z, w.w};
#pragma unroll
        for (int e = 0; e < 8; ++e) *(LAS unsigned short*)(lds + OFF_VT + (cg * 8 + e) * VP + kl * 2) = (unsigned short)((e & 1) ? (ww[e >> 1] >> 16) : (ww[e >> 1] & 0xffffu)); }
    __syncthreads();
#pragma unroll 1
    for (int qt = 0; qt < 2; ++qt) {
        const int i0 = (wid & 3) * 32 + qt * 16, kt0 = i0 >> 4, tok = tokb + i0 + r;
        const bf16x8 bq0 = *(const bf16x8*)(z + (size_t)tok * ZW + ZQ + hq * 64 + 8 * qd), bq1 = *(const bf16x8*)(z + (size_t)tok * ZW + ZQ + hq * 64 + 32 + 8 * qd);
        f32x4 accS[9];
#pragma unroll
        for (int c = 0; c < 9; ++c) { const int kt = kt0 + c;
            const bf16x8 a0 = *(const LAS bf16x8*)(lds + OFF_K + (16 * kt + r) * KP + qd * 16), a1 = *(const LAS bf16x8*)(lds + OFF_K + (16 * kt + r) * KP + 64 + qd * 16);
            accS[c] = ml::mfma16(a0, bq0, (f32x4){0.f, 0.f, 0.f, 0.f}); accS[c] = ml::mfma16(a1, bq1, accS[c]); }
        float m = sink;
#pragma unroll
        for (int c = 0; c < 9; ++c)
#pragma unroll
            for (int j = 0; j < 4; ++j) { const int e = 4 * qd + j;
                bool valid = (c == 0) ? (e > r) : ((c == 8) ? (e <= r) : true);
                valid = valid && ((n > 0) || (kt0 + c >= 8));
                const float s = valid ? accS[c][j] * 0.125f : -3.0e38f; accS[c][j] = s; m = fmaxf(m, s); }
        m = fmaxf(m, __shfl_xor(m, 16)); m = fmaxf(m, __shfl_xor(m, 32));
        float l = 0.f;
#pragma unroll
        for (int c = 0; c < 9; ++c)
#pragma unroll
            for (int j = 0; j < 4; ++j) { const float p = __expf(accS[c][j] - m); accS[c][j] = p; l += p; }
        l += __shfl_xor(l, 16); l += __shfl_xor(l, 32);
        l += __expf(sink - m);
        f32x4 accO[4];
#pragma unroll
        for (int dt = 0; dt < 4; ++dt) accO[dt] = (f32x4){0.f, 0.f, 0.f, 0.f};
#pragma unroll
        for (int kk = 0; kk < 5; ++kk) {
            u32x4 pw; pw.x = pg8::cvt_pk_bf16(accS[2 * kk][0], accS[2 * kk][1]); pw.y = pg8::cvt_pk_bf16(accS[2 * kk][2], accS[2 * kk][3]);
            if (kk < 4) { pw.z = pg8::cvt_pk_bf16(accS[2 * kk + 1][0], accS[2 * kk + 1][1]); pw.w = pg8::cvt_pk_bf16(accS[2 * kk + 1][2], accS[2 * kk + 1][3]); } else { pw.z = 0u; pw.w = 0u; }
            const bf16x8 pf = __builtin_bit_cast(bf16x8, pw);
            const int base = 16 * (kt0 + 2 * kk);
#pragma unroll
            for (int dt = 0; dt < 4; ++dt) { const u32x2 v0 = *(const LAS u32x2*)(lds + OFF_VT + (16 * dt + r) * VP + (base + 4 * qd) * 2);
                u32x2 v1 = {0u, 0u}; if (kk < 4) v1 = *(const LAS u32x2*)(lds + OFF_VT + (16 * dt + r) * VP + (base + 16 + 4 * qd) * 2);
                u32x4 vw; vw.x = v0.x; vw.y = v0.y; vw.z = v1.x; vw.w = v1.y;
                accO[dt] = ml::mfma16(__builtin_bit_cast(bf16x8, vw), pf, accO[dt]); } }
        const float inv = 1.f / l;
        bf16_t* op = mix + (size_t)tok * D + hq * 64;
#pragma unroll
        for (int dt = 0; dt < 4; ++dt) { u32x2 o; o.x = pg8::cvt_pk_bf16(accO[dt][0] * inv, accO[dt][1] * inv); o.y = pg8::cvt_pk_bf16(accO[dt][2] * inv, accO[dt][3] * inv);
            *(u32x2*)(op + 16 * dt + 4 * qd) = o; }
    }
}
}

namespace sg {
using pg8::bf16x8; using pg8::f32x4; using pg8::u32x4; using pg8::u32x2;
constexpr int TP = 272, OFF_VT = 0, OFF_ST = 256 * TP, LDS_END = OFF_ST + 128 * 4 * 2 * 4;
__device__ __forceinline__ void unit(LAS unsigned char* lds, const bf16_t* z, const Params& P, int l, const bf16_t* wb  , bf16_t* mix, int u) {
    const int tid = tid_opaque(), lane = tid & 63, wid = __builtin_amdgcn_readfirstlane(tid >> 6), r = lane & 15, qd = lane >> 4;
    const int tok0 = u * 128;
    LAS float* ST = (LAS float*)(lds + OFF_ST);
    __syncthreads();
    const int s = tid & 127, cq = tid >> 7;
    const bf16_t* gp = z + (size_t)(tok0 + s) * ZW + ZGV + cq * 64;
    u32x4 raw[8];
#pragma unroll
    for (int i = 0; i < 8; ++i) raw[i] = *(const u32x4*)(gp + 8 * i);
    const int t = 16 * wid + r;
    bf16x8 wf[2][4];
#pragma unroll
    for (int ks = 0; ks < 4; ++ks) wf[0][ks] = *(const bf16x8*)(wb + (size_t)t * 128 + 32 * ks + 8 * qd);
    float sm = 0.f, sq = 0.f;
#pragma unroll
    for (int i = 0; i < 8; ++i) { const unsigned ww[4] = {raw[i].x, raw[i].y, raw[i].z, raw[i].w};
#pragma unroll
        for (int e = 0; e < 8; ++e) { const float ge = gelu_tanh((e & 1) ? bfh(ww[e >> 1]) : bfl(ww[e >> 1])); sm += ge; sq += ge * ge; } }
    ST[(s * 4 + cq) * 2] = sm; ST[(s * 4 + cq) * 2 + 1] = sq;
    __syncthreads();
    { float tsm = 0.f, tsq = 0.f;
#pragma unroll
      for (int q = 0; q < 4; ++q) { tsm += ST[(s * 4 + q) * 2]; tsq += ST[(s * 4 + q) * 2 + 1]; }
      const float mu = tsm * (1.f / 256.f), var = fmaxf(tsq * (1.f / 256.f) - mu * mu, 0.f), rs = rsqrtf(var + EPS);
      const float* lg = P.in[I_LNG] + l * 256 + cq * 64; const float* lb = P.in[I_LNB] + l * 256 + cq * 64;
#pragma unroll
      for (int i = 0; i < 8; ++i) { const unsigned ww[4] = {raw[i].x, raw[i].y, raw[i].z, raw[i].w};
          const float4 g0 = *(const float4*)(lg + 8 * i), g1 = *(const float4*)(lg + 8 * i + 4), b0 = *(const float4*)(lb + 8 * i), b1 = *(const float4*)(lb + 8 * i + 4);
          const float gg[8] = {g0.x, g0.y, g0.z, g0.w, g1.x, g1.y, g1.z, g1.w}, bb[8] = {b0.x, b0.y, b0.z, b0.w, b1.x, b1.y, b1.z, b1.w};
#pragma unroll
          for (int e = 0; e < 8; ++e) *(LAS unsigned short*)(lds + OFF_VT + (cq * 64 + 8 * i + e) * TP + s * 2) = ml::bf1((gelu_tanh((e & 1) ? bfh(ww[e >> 1]) : bfl(ww[e >> 1])) - mu) * rs * gg[e] + bb[e]); } }
    __syncthreads();
#pragma unroll
    for (int g = 0; g < 4; ++g) {
        if (g + 1 < 4) {
#pragma unroll
            for (int ks = 0; ks < 4; ++ks) wf[(g + 1) & 1][ks] = *(const bf16x8*)(wb + ((size_t)(g + 1) * 128 + t) * 128 + 32 * ks + 8 * qd); }
        const float bias = P.in[I_SGUB][l * 512 + g * 128 + t];
        u32x2 gw[4];
#pragma unroll
        for (int ct = 0; ct < 4; ++ct) gw[ct] = *(const u32x2*)(z + (size_t)(tok0 + t) * ZW + ZGU + g * 64 + 16 * ct + 4 * qd);
#pragma unroll
        for (int ct = 0; ct < 4; ++ct) { f32x4 acc = {0.f, 0.f, 0.f, 0.f};
#pragma unroll
            for (int ks = 0; ks < 4; ++ks) if (2 * ks <= wid) acc = ml::mfma16(*(const LAS bf16x8*)(lds + OFF_VT + (g * 64 + 16 * ct + r) * TP + (32 * ks + 8 * qd) * 2), wf[g & 1][ks], acc);
            const int c0 = g * 64 + 16 * ct + 4 * qd;
            u32x2 o; o.x = pg8::cvt_pk_bf16(gelu_tanh(bfl(gw[ct].x)) * (acc[0] + bias), gelu_tanh(bfh(gw[ct].x)) * (acc[1] + bias)); o.y = pg8::cvt_pk_bf16(gelu_tanh(bfl(gw[ct].y)) * (acc[2] + bias), gelu_tanh(bfh(gw[ct].y)) * (acc[3] + bias));
            *(u32x2*)(mix + (size_t)(tok0 + t) * D + 768 + c0) = o; }
    }
}
}

__device__ __forceinline__ void ph_mix1(float* lds, const Params& P, int l, bf16_t* z, const float* gates, bf16_t* mix, unsigned char* wsm, unsigned char* wss, const unsigned char* tb, int sub) {
    const int G = gridDim.x, bid = blockIdx.x;
    if (sub & 1) for (int u = bid; u < ml::NU; u += G) ml::p1_unit((LAS unsigned char*)lds, z, gates, P, l, u, wsm);
    __syncthreads();
    if (sub & 2) for (int u = bid; u < NTOK / 256; u += G) s5::p1_unit(z, tb, u, wss);
    __syncthreads();
    if (sub & 4) for (int u = bid; u < 1024; u += G) at::unit((LAS unsigned char*)lds, z, P.in[I_SINK] + l * 4, mix, u);
    __syncthreads();
    if (sub & 8) for (int u = bid; u < NTOK / 128; u += G) sg::unit((LAS unsigned char*)lds, z, P, l, (const bf16_t*)(tb + s5::T_SGUW), mix, u);
    __syncthreads();
}

__device__ __forceinline__ void ph_mix2(float* lds, const Params& P, int l, const bf16_t* z, const float* gates, bf16_t* mix, const unsigned char* wsm, const unsigned char* wss, const unsigned char* tb, int sub) {
    if (sub & 1) for (int u = blockIdx.x; u < NTOK / 256; u += gridDim.x) s5::p3_unit((LAS unsigned char*)lds, z, P, l, tb, u, wss, mix);
    __syncthreads();
    if (sub & 2) for (int u = blockIdx.x; u < ml::NU; u += gridDim.x) ml::p3_unit((LAS unsigned char*)lds, z, gates, P, l, u, wsm, mix);
    __syncthreads();
}

template <bool SRCF32>
__device__ __forceinline__ void ph_outproj(LAS unsigned char* ldsb, const bf16_t* mix, const bf16_t* wt, const float* xf, bf16_t* xb) {
    pg8::StaticOrder S; S.init(NTOK, D, D, D, gridDim.x, blockIdx.x, mix, wt);
    pg8::EpiResB<SRCF32> E{xf, xb};
    pg8::gemm_phase<pg8::EpiResB<SRCF32>, pg8::StaticOrder, false>(ldsb, D, D, S, E);
}

namespace rp {
using pg8::bf16x8; using pg8::f32x4; using pg8::u32x4;
constexpr size_t T_HI = 0, T_LO = (size_t)48 * D * 2, T_GHI = 2 * T_LO, T_GLO = T_GHI + (size_t)16 * D * 2, T_SIZE = T_GLO + (size_t)16 * D * 2;
static_assert(T_SIZE <= 256 * 1024, "row-pass tables fit their slot");
template <int NT, bool COMBINE> struct StepIn { float4 xa[2], xb[2]; u32x4 xr[2]; u32x4 y1[2], y2[2]; float4 g0, g1; };
template <int NT> struct StepW { bf16x8 wh[NT], wl[NT]; };
__device__ __forceinline__ void build_base(LAS int* base, const unsigned* cnt) {
    __syncthreads();
    if (tid_opaque() == 0) { int b = 0; for (int e = 0; e < NEXP; ++e) { base[e] = b; b += (((int)cnt[e] + 255) >> 8) << 8; } }
    __syncthreads();
}
template <int NT, bool COMBINE, bool XBF>
__device__ __forceinline__ void run(LAS unsigned char* lds, const Params& P, int l, const float* x, bf16_t* xq, const bf16_t* YB, const unsigned* inv, const unsigned* cntprev,
                                    const float* gn, const bf16_t* WH, const bf16_t* WL, bf16_t* XN, float* RS, float* gates, unsigned* cnt, int2* lists, unsigned* invout) {
    const int tid = tid_opaque(), lane = tid & 63, wid = __builtin_amdgcn_readfirstlane(tid >> 6), r = lane & 15, qd = lane >> 4;
    LAS int* BASE = (LAS int*)(lds + 64 * 1024);
    LAS float* LG = (LAS float*)lds + wid * (32 * 49);
    if (COMBINE) build_base(BASE, cntprev);
    LAS unsigned* LCNT = (LAS unsigned*)(lds + 64 * 1024 + 256); LAS unsigned* GBASE = LCNT + 32;
    for (int rb0 = blockIdx.x * 8; rb0 < NTOK / 32; rb0 += gridDim.x * 8) {
        const int rb = rb0 + wid; const bool live = rb < NTOK / 32;
        const int row0 = (live ? rb : rb0) * 32;
        if (NT == 1 && !live) continue;
        size_t yr1[2] = {0, 0}, yr2[2] = {0, 0};
        if (COMBINE) {
#pragma unroll
            for (int mt = 0; mt < 2; ++mt) { const int row = row0 + 16 * mt + r; const unsigned i1 = inv[2 * row], i2 = inv[2 * row + 1];
                yr1[mt] = (size_t)(BASE[i1 >> 16] + (int)(i1 & 0xffffu)) * D; yr2[mt] = (size_t)(BASE[i2 >> 16] + (int)(i2 & 0xffffu)) * D; } }
        f32x4 acc[2][NT];
#pragma unroll
        for (int mt = 0; mt < 2; ++mt)
#pragma unroll
            for (int nt = 0; nt < NT; ++nt) acc[mt][nt] = (f32x4){0.f, 0.f, 0.f, 0.f};
        float ssq[2] = {0.f, 0.f};
        StepIn<NT, COMBINE> sb[3]; StepW<NT> sw[2];
        auto load = [&](StepIn<NT, COMBINE>& s, int ks) {
            const int k0 = 32 * ks + 8 * qd;
#pragma unroll
            for (int mt = 0; mt < 2; ++mt) {
                if (XBF) s.xr[mt] = *(const u32x4*)(xq + (size_t)(row0 + 16 * mt + r) * D + k0);
                else { const float* xp = x + (size_t)(row0 + 16 * mt + r) * D + k0; s.xa[mt] = *(const float4*)xp; s.xb[mt] = *(const float4*)(xp + 4); }
                if (COMBINE) { s.y1[mt] = *(const u32x4*)(YB + yr1[mt] + k0); s.y2[mt] = *(const u32x4*)(YB + yr2[mt] + k0); } }
            s.g0 = *(const float4*)(gn + k0); s.g1 = *(const float4*)(gn + k0 + 4);
        };
        auto loadw = [&](StepW<NT>& s, int ks) {
            const int k0 = 32 * ks + 8 * qd;
#pragma unroll
            for (int nt = 0; nt < NT; ++nt) { s.wh[nt] = *(const bf16x8*)(WH + (size_t)(16 * nt + r) * D + k0); s.wl[nt] = *(const bf16x8*)(WL + (size_t)(16 * nt + r) * D + k0); }
        };
        auto process = [&](const StepIn<NT, COMBINE>& s, const StepW<NT>& sw_, int ks) {
            const int k0 = 32 * ks + 8 * qd;
            bf16x8 xh[2], xl[2];
#pragma unroll
            for (int mt = 0; mt < 2; ++mt) { float4 a = s.xa[mt], b = s.xb[mt];
                if (XBF) { const u32x4 w = s.xr[mt]; a = make_float4(bfl(w.x), bfh(w.x), bfl(w.y), bfh(w.y)); b = make_float4(bfl(w.z), bfh(w.z), bfl(w.w), bfh(w.w)); }
                if (COMBINE) { const u32x4 p = s.y1[mt], q = s.y2[mt];
                    a.x += bfl(p.x) + bfl(q.x); a.y += bfh(p.x) + bfh(q.x); a.z += bfl(p.y) + bfl(q.y); a.w += bfh(p.y) + bfh(q.y);
                    b.x += bfl(p.z) + bfl(q.z); b.y += bfh(p.z) + bfh(q.z); b.z += bfl(p.w) + bfl(q.w); b.w += bfh(p.w) + bfh(q.w);
                    u32x4 o; o.x = pg8::cvt_pk_bf16(a.x, a.y); o.y = pg8::cvt_pk_bf16(a.z, a.w); o.z = pg8::cvt_pk_bf16(b.x, b.y); o.w = pg8::cvt_pk_bf16(b.z, b.w);
                    *(u32x4*)(xq + (size_t)(row0 + 16 * mt + r) * D + k0) = o;
                    a = make_float4(bfl(o.x), bfh(o.x), bfl(o.y), bfh(o.y)); b = make_float4(bfl(o.z), bfh(o.z), bfl(o.w), bfh(o.w)); }
                ssq[mt] += a.x * a.x + a.y * a.y + a.z * a.z + a.w * a.w + b.x * b.x + b.y * b.y + b.z * b.z + b.w * b.w;
                const float v[8] = {a.x * s.g0.x, a.y * s.g0.y, a.z * s.g0.z, a.w * s.g0.w, b.x * s.g1.x, b.y * s.g1.y, b.z * s.g1.z, b.w * s.g1.w};
                u32x4 h; h.x = pg8::cvt_pk_bf16(v[0], v[1]); h.y = pg8::cvt_pk_bf16(v[2], v[3]); h.z = pg8::cvt_pk_bf16(v[4], v[5]); h.w = pg8::cvt_pk_bf16(v[6], v[7]);
                *(u32x4*)(XN + (size_t)(row0 + 16 * mt + r) * D + k0) = h;
                u32x4 lo; lo.x = pg8::cvt_pk_bf16(v[0] - bfl(h.x), v[1] - bfh(h.x)); lo.y = pg8::cvt_pk_bf16(v[2] - bfl(h.y), v[3] - bfh(h.y)); lo.z = pg8::cvt_pk_bf16(v[4] - bfl(h.z), v[5] - bfh(h.z)); lo.w = pg8::cvt_pk_bf16(v[6] - bfl(h.w), v[7] - bfh(h.w));
                xh[mt] = __builtin_bit_cast(bf16x8, h); xl[mt] = __builtin_bit_cast(bf16x8, lo); }
#pragma unroll
            for (int nt = 0; nt < NT; ++nt)
#pragma unroll
                for (int mt = 0; mt < 2; ++mt) { acc[mt][nt] = ml::mfma16(sw_.wh[nt], xh[mt], acc[mt][nt]); acc[mt][nt] = ml::mfma16(sw_.wl[nt], xh[mt], acc[mt][nt]); acc[mt][nt] = ml::mfma16(sw_.wh[nt], xl[mt], acc[mt][nt]); }
        };
        if (COMBINE || NT > 1) {
            load(sb[0], 0); loadw(sw[0], 0);
#pragma unroll 1
            for (int ks = 0; ks < 32; ks += 2) {
                load(sb[1], ks + 1); loadw(sw[1], ks + 1);
                process(sb[0], sw[0], ks);
                if (ks + 2 < 32) { load(sb[0], ks + 2); loadw(sw[0], ks + 2); }
                process(sb[1], sw[1], ks + 1);
            }
        } else {
            load(sb[0], 0); load(sb[1], 1); loadw(sw[0], 0);
#define RP_STEP(i, xs, ws) do { if ((i) + 2 < 32) load(sb[((xs) + 2) % 3], (i) + 2); if ((i) + 1 < 32) loadw(sw[((ws) + 1) % 2], (i) + 1); process(sb[xs], sw[ws], (i)); } while (0)
#pragma unroll 1
            for (int ks = 0; ks < 30; ks += 6) { RP_STEP(ks, 0, 0); RP_STEP(ks + 1, 1, 1); RP_STEP(ks + 2, 2, 0); RP_STEP(ks + 3, 0, 1); RP_STEP(ks + 4, 1, 0); RP_STEP(ks + 5, 2, 1); }
            RP_STEP(30, 0, 0); RP_STEP(31, 1, 1);
#undef RP_STEP
        }
        float rsv[2];
#pragma unroll
        for (int mt = 0; mt < 2; ++mt) { float s = ssq[mt]; s += __shfl_xor(s, 16); s += __shfl_xor(s, 32); rsv[mt] = rsqrtf(s * (1.f / D) + EPS);
            if (qd == 0) RS[row0 + 16 * mt + r] = rsv[mt]; }
        if (NT == 1) {
#pragma unroll
            for (int mt = 0; mt < 2; ++mt) if (qd < 2) { const f32x4 gv = acc[mt][0] * rsv[mt]; *(f32x4*)(gates + (size_t)(row0 + 16 * mt + r) * 8 + 4 * qd) = gv; }
        } else {
            const float* bg = P.in[I_RGB] + l * 4; const float* be = P.in[I_REB] + l * 32;
#pragma unroll
            for (int mt = 0; mt < 2; ++mt)
#pragma unroll
                for (int nt = 0; nt < NT; ++nt)
#pragma unroll
                    for (int j = 0; j < 4; ++j) LG[(16 * mt + r) * 49 + 16 * nt + 4 * qd + j] = acc[mt][nt][j] * rsv[mt];
            wave_lds_fence();
            if (tid < 32) LCNT[tid] = 0u;
            __syncthreads();
            int ex1 = 0, ex2 = 0; float w1 = 0.f, w2 = 0.f; unsigned lp1 = 0u, lp2 = 0u;
            if (lane < 32 && live) {
                const LAS float* lg = LG + lane * 49;
                float gl[4];
#pragma unroll
                for (int j = 0; j < 4; ++j) gl[j] = lg[j] + bg[j];
                int sel = 0; float gm = gl[0];
#pragma unroll
                for (int j = 1; j < 4; ++j) if (gl[j] > gm) { gm = gl[j]; sel = j; }
                float gs = 0.f;
#pragma unroll
                for (int j = 0; j < 4; ++j) gs += expf(gl[j] - gm);
                const float pg = 1.f / gs;
                float ein[8];
#pragma unroll
                for (int j = 0; j < 8; ++j) ein[j] = lg[4 + sel * 8 + j] + be[sel * 8 + j];
                int i1 = 0; float v1 = ein[0];
#pragma unroll
                for (int j = 1; j < 8; ++j) if (ein[j] > v1) { v1 = ein[j]; i1 = j; }
                int i2 = -1; float v2 = -3.0e38f;
#pragma unroll
                for (int j = 0; j < 8; ++j) if (j != i1 && ein[j] > v2) { v2 = ein[j]; i2 = j; }
                const float e2 = expf(v2 - v1), den = 1.f / (1.f + e2);
                w1 = den * pg; w2 = e2 * den * pg;
                ex1 = sel * 8 + i1; ex2 = sel * 8 + i2;
                lp1 = atomicAdd((unsigned*)&LCNT[ex1], 1u); lp2 = atomicAdd((unsigned*)&LCNT[ex2], 1u);
            }
            __syncthreads();
            if (tid < 32) { const unsigned c = LCNT[tid]; GBASE[tid] = c ? atomicAdd(&cnt[tid], c) : 0u; }
            __syncthreads();
            if (lane < 32 && live) { const int row = row0 + lane; const unsigned p1 = GBASE[ex1] + lp1, p2 = GBASE[ex2] + lp2;
                lists[(size_t)ex1 * NTOK + p1] = make_int2(row, __float_as_int(w1));
                lists[(size_t)ex2 * NTOK + p2] = make_int2(row, __float_as_int(w2));
                invout[2 * row] = ((unsigned)ex1 << 16) | p1; invout[2 * row + 1] = ((unsigned)ex2 << 16) | p2; }
        }
    }
}
__device__ __forceinline__ void final_norm(LAS unsigned char* lds, const bf16_t* xb, float* out, const bf16_t* YB, const unsigned* inv, const unsigned* cntprev, const float* g) {
    const int tid = tid_opaque(), wave = tid >> 6, lane = tid & 63;
    LAS int* BASE = (LAS int*)(lds + 64 * 1024);
    build_base(BASE, cntprev);
    const float4* g4 = (const float4*)g;
    for (int r = blockIdx.x * 8 + wave; r < NTOK; r += gridDim.x * 8) {
        const unsigned i1 = inv[2 * r], i2 = inv[2 * r + 1];
        const bf16_t* y1 = YB + (size_t)(BASE[i1 >> 16] + (int)(i1 & 0xffffu)) * D; const bf16_t* y2 = YB + (size_t)(BASE[i2 >> 16] + (int)(i2 & 0xffffu)) * D;
        const u32x2_t* xp = (const u32x2_t*)(xb + (size_t)r * D);
        float4 v[4]; float ss = 0.f;
#pragma unroll
        for (int i = 0; i < 4; ++i) { const u32x2_t xw = xp[lane + 64 * i], a = *((const u32x2_t*)y1 + lane + 64 * i), b = *((const u32x2_t*)y2 + lane + 64 * i);
            v[i].x = bfl(xw.x) + bfl(a.x) + bfl(b.x); v[i].y = bfh(xw.x) + bfh(a.x) + bfh(b.x); v[i].z = bfl(xw.y) + bfl(a.y) + bfl(b.y); v[i].w = bfh(xw.y) + bfh(a.y) + bfh(b.y);
            ss += v[i].x * v[i].x + v[i].y * v[i].y + v[i].z * v[i].z + v[i].w * v[i].w; }
        ss = wave_sum(ss);
        const float rs = rsqrtf(ss * (1.f / D) + EPS);
        float4* p = (float4*)(out + (size_t)r * D);
#pragma unroll
        for (int i = 0; i < 4; ++i) { const float4 gg = g4[lane + 64 * i]; float4 o; o.x = v[i].x * rs * gg.x; o.y = v[i].y * rs * gg.y; o.z = v[i].z * rs * gg.z; o.w = v[i].w * rs * gg.w; p[lane + 64 * i] = o; }
    }
}
}

__device__ __forceinline__ int moe_build_tab(LAS unsigned char* ldsb, const unsigned* cnt) {
    LAS pg8::i32x4* tab = (LAS pg8::i32x4*)(ldsb + TAB_OFF);
    __syncthreads();
    int base = 0;
#pragma unroll 1
    for (int e = 0; e < NEXP; ++e) { const int c = __builtin_amdgcn_readfirstlane((int)cnt[e]), nt = (c + 255) >> 8;
        if ((int)tid_opaque() < nt) tab[base + tid_opaque()] = (pg8::i32x4){e, (int)tid_opaque() * 256, c, 0};
        base += nt; }
    __syncthreads();
    return base;
}
__device__ __forceinline__ void ph_moe1(LAS unsigned char* ldsb, const Params& P, int l, const bf16_t* H, const unsigned* cnt, const int2* lists, bf16_t* act) {
    const int ntiles = moe_build_tab(ldsb, cnt);
    pg8::MoeOrder S; S.tab = (const LAS pg8::i32x4*)(ldsb + TAB_OFF); S.ntiles = ntiles; S.npn = 4; S.G = gridDim.x; S.c = blockIdx.x;
    S.A = (const char*)H; S.atile = 0; S.Bt = (const char*)(P.ws + WS_WGU) + (size_t)l * NEXP * 1024 * D * 2; S.bexp = (size_t)1024 * D * 2; S.btile = (size_t)256 * D * 2; S.lists = lists;
    pg8::EpiAct E{act, lists, (const float*)(P.ws + WS_RS)};
    pg8::gemm_phase<pg8::EpiAct, pg8::MoeOrder, true>(ldsb, D, D, S, E);
}
__device__ __forceinline__ void ph_moe2(LAS unsigned char* ldsb, const Params& P, int l, const bf16_t* act, const unsigned* cnt, const int2* lists, bf16_t* yb) {
    const int ntiles = moe_build_tab(ldsb, cnt);
    pg8::MoeOrder S; S.tab = (const LAS pg8::i32x4*)(ldsb + TAB_OFF); S.ntiles = ntiles; S.npn = 4; S.G = gridDim.x; S.c = blockIdx.x;
    S.A = (const char*)act; S.atile = (size_t)256 * DE * 2; S.Bt = (const char*)(P.ws + WS_WD) + (size_t)l * NEXP * D * DE * 2; S.bexp = (size_t)D * DE * 2; S.btile = (size_t)256 * DE * 2; S.lists = lists;
    pg8::EpiY E{yb, lists};
    pg8::gemm_phase<pg8::EpiY, pg8::MoeOrder, false>(ldsb, DE, DE, S, E);
}

#ifndef PROBE_PH
#define PROBE_PH -1
#endif
#ifndef PROBE_SUB
#define PROBE_SUB 15
#endif
#ifndef PROBE_REPS
#define PROBE_REPS 4
#endif
__global__ void __launch_bounds__(NTHREADS, 2) fwd_kernel(Params P) {
    extern __shared__ __attribute__((aligned(16))) unsigned char lds_raw[];
    float* lds = (float*)lds_raw;
    volatile LAS unsigned* xbw = (volatile LAS unsigned*)(lds_raw + LDS_BYTES - 16);
    if (threadIdx.x == 0) { xbw[0] = 0u; xbw[1] = 0u; }
    __syncthreads();
    unsigned char* const ws = P.ws;
    unsigned* ctl = (unsigned*)(ws + WS_CTL);
    const bool multi = (P.ph_hi - P.ph_lo) > 1;
    XcdBarrier bar; bar.bar = ctl; bar.x = 0; bar.st = xbw;
    if (multi) bar = xcd_barrier_post(ctl, xbw);
    bf16_t* z = (bf16_t*)(ws + WS_Z); float* gates = (float*)(ws + WS_GATES); unsigned char* wss = ws + WS_S5; bf16_t* mix = (bf16_t*)(ws + WS_MIX); unsigned char* wsm = ws + WS_HRAW;
    bf16_t* H = (bf16_t*)(ws + WS_H); bf16_t* act = (bf16_t*)(ws + WS_ACT); bf16_t* yb = (bf16_t*)(ws + WS_YB); bf16_t* xbuf = (bf16_t*)(ws + WS_XB); float* rsb = (float*)(ws + WS_RS);
    int2* lists = (int2*)(ws + WS_LIST);
    LAS unsigned char* ldsb = (LAS unsigned char*)lds_raw;
    const int lo = P.ph_lo, hi = P.ph_hi;
#define IN(k) (lo <= (k) && (k) < hi)
#define SEAM(k) do { if (IN(k) && IN((k) + 1)) xcd_barrier(bar); } while (0)
#if PROBE_PH >= 0
#define RUNPH(k, ...) do { if (IN(k)) { const int nrep = ((k) == PROBE_PH) ? 1 + PROBE_REPS : 1; for (int rep = 0; rep < nrep; ++rep) { __VA_ARGS__; if (rep + 1 < nrep) xcd_barrier(bar); } } SEAM(k); } while (0)
#else
#define RUNPH(k, ...) do { if (IN(k)) { constexpr int rep = 0; (void)rep; __VA_ARGS__; } SEAM(k); } while (0)
#endif
    RUNPH(0, ph_prologue(lds, PF));
    for (int l = 0; l < NLAYER; ++l) {
        const int pb = 1 + l * PH_PER_LAYER;
        unsigned* cnt = ctl + CW_CNT + l * 64;
        const unsigned char* tb = ws + WS_TB + (size_t)l * 4 * MiB;
        const unsigned char* rtb = ws + WS_RT + (size_t)l * 256 * 1024;
        unsigned* inv = (unsigned*)(ws + WS_INV) + (size_t)l * NTOK * 2;
        RUNPH(pb + 0, { const Params& Q = PF;
            if (l == 0) rp::run<1, false, false>(ldsb, Q, l, Q.in[I_X], nullptr, nullptr, nullptr, nullptr, Q.in[I_NMG] + l * D, (const bf16_t*)(rtb + rp::T_GHI), (const bf16_t*)(rtb + rp::T_GLO), mix, rsb, gates, nullptr, nullptr, nullptr);
            else        rp::run<1, true, true>(ldsb, Q, l, nullptr, xbuf, yb, inv - (size_t)NTOK * 2, cnt - 64, Q.in[I_NMG] + l * D, (const bf16_t*)(rtb + rp::T_GHI), (const bf16_t*)(rtb + rp::T_GLO), mix, rsb, gates, nullptr, nullptr, nullptr); });
        RUNPH(pb + 1, ph_inproj(ldsb, mix, (const bf16_t*)(ws + WS_WIN) + (size_t)l * NMAIN * D, z, rsb, (rep > 0 && PROBE_SUB <= 3) ? PROBE_SUB : 0));
        RUNPH(pb + 2, ph_mix1(lds, PF, l, z, gates, mix, wsm, wss, tb, rep == 0 ? 15 : PROBE_SUB));
        RUNPH(pb + 3, { s5::p2_scan(ldsb, tb, wss); ml::p2_scan(wsm); });
        RUNPH(pb + 4, ph_mix2(lds, PF, l, z, gates, mix, wsm, wss, tb, rep == 0 ? 15 : PROBE_SUB));
        RUNPH(pb + 5, { const Params& Q = PF; if (l == 0) ph_outproj<true>(ldsb, mix, (const bf16_t*)(ws + WS_WOUT) + (size_t)l * D * D, Q.in[I_X], xbuf); else ph_outproj<false>(ldsb, mix, (const bf16_t*)(ws + WS_WOUT) + (size_t)l * D * D, nullptr, xbuf); });
        RUNPH(pb + 6, { if (rep > 0) { if (blockIdx.x == 0 && threadIdx.x < 64) cnt[threadIdx.x] = 0u; xcd_barrier(bar); }
                        const Params& Q = PF; rp::run<3, false, true>(ldsb, Q, l, nullptr, xbuf, nullptr, nullptr, nullptr, Q.in[I_NFG] + l * D, (const bf16_t*)(rtb + rp::T_HI), (const bf16_t*)(rtb + rp::T_LO), H, rsb, nullptr, cnt, lists, inv); });
        RUNPH(pb + 7, ph_moe1(ldsb, PF, l, H, cnt, lists, act));
        RUNPH(pb + 8, ph_moe2(ldsb, PF, l, act, cnt, lists, yb));
    }
    RUNPH(1 + NLAYER * PH_PER_LAYER, { const Params& Q = PF; rp::final_norm(ldsb, xbuf, Q.out, yb, (const unsigned*)(ws + WS_INV) + (size_t)(NLAYER - 1) * NTOK * 2, ctl + CW_CNT + (NLAYER - 1) * 64, Q.in[I_NFIN]); });
#undef RUNPH
#undef IN
#undef SEAM
}

#ifndef N_LAUNCH_MODE
#define N_LAUNCH_MODE 1
#endif
extern "C" void kernel_launch(void* const* d_in, const int* in_sizes, int n_in, void* d_out, int out_size, void* d_ws, size_t ws_size, hipStream_t stream) {
    static int grid = 0;
    if (grid == 0) {
        if (n_in != 31 || out_size != NTOK * D || ws_size < WS_END) { fprintf(stderr, "kernel_launch: unexpected shapes n_in %d out %d ws %zu (need %zu)\n", n_in, out_size, ws_size, (size_t)WS_END); grid = -1; return; }
        int dev = 0, cus = 0, per_cu = 0;
        if (hipGetDevice(&dev) != hipSuccess || hipDeviceGetAttribute(&cus, hipDeviceAttributeMultiprocessorCount, dev) != hipSuccess) { grid = -1; return; }
        if (hipFuncSetAttribute((const void*)fwd_kernel, hipFuncAttributeMaxDynamicSharedMemorySize, LDS_BYTES) != hipSuccess) { fprintf(stderr, "kernel_launch: hipFuncSetAttribute failed\n"); grid = -1; return; }
        if (hipOccupancyMaxActiveBlocksPerMultiprocessor(&per_cu, (const void*)fwd_kernel, NTHREADS, LDS_BYTES) != hipSuccess || per_cu < 1) { fprintf(stderr, "kernel_launch: occupancy query says %d\n", per_cu); }
        (void)hipGetLastError();
        grid = cus;
    }
    if (grid < 0) return;
    (void)hipMemsetAsync((char*)d_ws + WS_CTL, 0, CTL_BYTES, stream);
    Params p{};
    for (int i = 0; i < 31; ++i) p.in[i] = (const float*)d_in[i];
    p.out = (float*)d_out; p.ws = (unsigned char*)d_ws;
#if N_LAUNCH_MODE == 1
    p.ph_lo = 0; p.ph_hi = N_PHASES;
    hipLaunchKernelGGL(fwd_kernel, dim3(grid), dim3(NTHREADS), LDS_BYTES, stream, p);
#else
    for (int ph = 0; ph < N_PHASES; ++ph) { p.ph_lo = ph; p.ph_hi = ph + 1; hipLaunchKernelGGL(fwd_kernel, dim3(grid), dim3(NTHREADS), LDS_BYTES, stream, p); }
#endif
}
```

```cpp
#include <hip/hip_runtime.h>
#include <stdint.h>
#include <stdio.h>

#define LAS __attribute__((address_space(3)))

constexpr int D = 1024, NB = 8, S = 8192, NTOK = NB * S, INW = 2312, NLAYER = 2;
constexpr int NEXP = 32, DE = 512;
constexpr float EPS = 1e-6f;
constexpr int ZW = 2304;
constexpr int ZQ = 0, ZK = 256, ZV = 384, ZSU = 512, ZCQ = 768, ZCK = 1024, ZCV = 1280, ZCO = 1536, ZGU = 1792, ZGV = 2048, WCI = 1536;
#ifndef INPROJ_WGM
#define INPROJ_WGM 8
#endif
constexpr int NTHREADS = 512;
constexpr int LDS_BYTES = 144 * 1024;
constexpr int TAB_OFF = 128 * 1024;
constexpr int PH_PER_LAYER = 9, N_PHASES = 1 + NLAYER * PH_PER_LAYER + 1;
constexpr int NMAIN = 2304;
typedef unsigned short bf16_t;

constexpr size_t MiB = 1u << 20;
constexpr size_t WS_CTL = 0, CTL_BYTES = 1 * MiB;
constexpr size_t WS_Z = WS_CTL + CTL_BYTES;
constexpr size_t Z_BYTES = (size_t)NTOK * ZW * 2;
constexpr size_t WS_H = WS_Z;
constexpr size_t WS_YB = WS_Z;
constexpr int PMAX = 2 * NTOK + NEXP * 256;
static_assert((size_t)PMAX * D * 2 <= Z_BYTES, "YB alias fits");
constexpr size_t WS_MIX = WS_Z + Z_BYTES;
constexpr size_t WS_ACT = WS_MIX;
static_assert((size_t)PMAX * DE * 2 <= (size_t)NTOK * D * 2 + 64 * MiB, "ACT alias fits");
constexpr size_t WS_HRAW = WS_MIX + (size_t)NTOK * D * 2;
constexpr size_t WS_S5 = WS_HRAW + 64 * MiB;
constexpr size_t WS_GATES = WS_S5 + 48 * MiB;
constexpr size_t WS_LIST = WS_GATES + (size_t)NTOK * 8 * 4;
constexpr size_t WS_WIN = WS_LIST + (size_t)NEXP * NTOK * 8;
constexpr size_t WS_WOUT = WS_WIN + (size_t)NLAYER * NMAIN * D * 2;
constexpr size_t WS_WGU = WS_WOUT + (size_t)NLAYER * D * D * 2;
constexpr size_t WS_WD = WS_WGU + (size_t)NLAYER * NEXP * 1024 * D * 2;
constexpr size_t WS_TB = WS_WD + (size_t)NLAYER * NEXP * D * DE * 2;
constexpr size_t WS_RS = WS_TB + (size_t)NLAYER * 4 * MiB;
constexpr size_t WS_RT = WS_RS + (size_t)NTOK * 4;
constexpr size_t WS_INV = WS_RT + (size_t)NLAYER * 256 * 1024;
constexpr size_t WS_XB = WS_INV + (size_t)NLAYER * NTOK * 8;
constexpr size_t WS_END = WS_XB + (size_t)NTOK * D * 2;
namespace s5 {
constexpr size_t T_KMAT = 0, T_F = T_KMAT + (size_t)16 * 32 * 256 * 2, T_G = T_F + (size_t)16 * 256 * 128 * 2, T_A16 = T_G + (size_t)16 * 128 * 256 * 2,
                 T_GLUW = T_A16 + (size_t)16 * 64 * 8, T_SGUW = T_GLUW + (size_t)256 * 256 * 2, T_LAYER = T_SGUW + (size_t)4 * 128 * 128 * 2;
}
constexpr int CW_Q = 4096;
constexpr int CW_CNT = 8192;

#define XB_TMO      128
#define XB_XCNT(j)  (256  + 64 * (j))
#define XB_XSUB(j)  (1280 + 64 * (j))
#define XB_XGEN(j)  (2304 + 64 * (j))
#define XB_TOP      3328
#define XB_TOPGEN   3392
#define XCD_BAR_WORDS 3456
#define XB_SPIN_CAP (1u << 22)
__device__ __forceinline__ unsigned xb_ld(unsigned* p)              { return __hip_atomic_load(p, __ATOMIC_RELAXED, __HIP_MEMORY_SCOPE_AGENT); }
__device__ __forceinline__ unsigned xb_add(unsigned* p, unsigned v) { return __hip_atomic_fetch_add(p, v, __ATOMIC_RELAXED, __HIP_MEMORY_SCOPE_AGENT); }
__device__ __forceinline__ unsigned xb_xcc_id() { return (unsigned)__builtin_amdgcn_s_getreg((3 << 11) | 20) & 0xFu; }
#define XB_SPIN(cond, bar) do { unsigned _sp = 0; while (cond) { __builtin_amdgcn_s_sleep(1); \
    if ((++_sp & 255u) == 0u) { if (xb_ld(&(bar)[XB_TMO])) break; if (_sp > XB_SPIN_CAP) { atomicAdd(&(bar)[XB_TMO], 1u); break; } } } } while (0)
struct XcdBarrier { unsigned* bar; unsigned x; volatile LAS unsigned* st; };
__device__ __forceinline__ XcdBarrier xcd_barrier_post(unsigned* bar, volatile LAS unsigned* st) {
    XcdBarrier b; b.bar = bar; b.x = xb_xcc_id(); b.st = st;
    if (threadIdx.x == 0) (void)xb_add(&bar[XB_XCNT(b.x)], 1u);
    return b;
}
__device__ __forceinline__ void xcd_barrier_complete(unsigned* bar, unsigned x, unsigned& nloc, unsigned& nx) {
    const unsigned G = gridDim.x * gridDim.y * gridDim.z;
    unsigned sum, cnt, mine, sp = 0u;
    for (;;) {
        sum = 0u; cnt = 0u; mine = 0u;
#pragma unroll
        for (unsigned j = 0; j < 16; ++j) { const unsigned c = xb_ld(&bar[XB_XCNT(j)]); sum += c; cnt += (c > 0u) ? 1u : 0u; mine = (j == x) ? c : mine; }
        if (sum == G) break;
        __builtin_amdgcn_s_sleep(1);
        if ((++sp & 255u) == 0u) { if (xb_ld(&bar[XB_TMO])) break; if (sp > XB_SPIN_CAP) { atomicAdd(&bar[XB_TMO], 1u); break; } }
    }
    nloc = mine > 0u ? mine : 1u; nx = cnt > 0u ? cnt : 1u;
}
__device__ __forceinline__ void xcd_barrier(const XcdBarrier& b) {
    asm volatile("s_waitcnt vmcnt(0)" ::: "memory");
    __syncthreads();
    if (threadIdx.x == 0) {
        unsigned* bar = b.bar;
        __builtin_amdgcn_s_waitcnt(0);
        unsigned nloc = b.st[0], nx = b.st[1];
        if (nloc == 0u) { xcd_barrier_complete(bar, b.x, nloc, nx); b.st[0] = nloc; b.st[1] = nx; }
        const unsigned old = xb_add(&bar[XB_XSUB(b.x)], 1u);
        const unsigned gen = old / nloc;
        if (old + 1u == (gen + 1u) * nloc) {
            __builtin_amdgcn_fence(__ATOMIC_RELEASE, "agent");
            asm volatile("s_waitcnt vmcnt(0)" ::: "memory");
            const unsigned og = xb_add(&bar[XB_TOP], 1u);
            const unsigned tg = og / nx;
            if (og + 1u == (tg + 1u) * nx) xb_add(&bar[XB_TOPGEN], 1u);
            else XB_SPIN(xb_ld(&bar[XB_TOPGEN]) == tg, bar);
            __builtin_amdgcn_fence(__ATOMIC_ACQUIRE, "agent");
            xb_add(&bar[XB_XGEN(b.x)], 1u);
            asm volatile("s_waitcnt vmcnt(0)" ::: "memory");
        } else {
            XB_SPIN(xb_ld(&bar[XB_XGEN(b.x)]) == gen, bar);
            __builtin_amdgcn_fence(__ATOMIC_ACQUIRE, "agent");
            asm volatile("s_waitcnt vmcnt(0)" ::: "memory");
        }
    }
    __syncthreads();
}

__device__ __forceinline__ int tid_opaque() { int t = threadIdx.x; asm volatile("" : "+v"(t)); return t; }
__device__ __forceinline__ float wave_sum(float v) {
#pragma unroll
    for (int o = 32; o > 0; o >>= 1) v += __shfl_xor(v, o);
    return v;
}
__device__ __forceinline__ float gelu_tanh(float x) {
    const float u2 = 1.5957691216057308f * (x + 0.044715f * x * x * x);
    return x * __builtin_amdgcn_rcpf(1.f + __expf(-u2));
}
__device__ __forceinline__ float sigm(float x) { return 1.f / (1.f + expf(-x)); }
__device__ __forceinline__ float bfl(unsigned w) { return __uint_as_float(w << 16); }
__device__ __forceinline__ float bfh(unsigned w) { return __uint_as_float(w & 0xffff0000u); }
typedef unsigned u32x4_t __attribute__((ext_vector_type(4)));
typedef unsigned u32x2_t __attribute__((ext_vector_type(2)));
__device__ __forceinline__ void ld8(const bf16_t* p, float (&o)[8]) { const u32x4_t w = *(const u32x4_t*)p; o[0] = bfl(w.x); o[1] = bfh(w.x); o[2] = bfl(w.y); o[3] = bfh(w.y); o[4] = bfl(w.z); o[5] = bfh(w.z); o[6] = bfl(w.w); o[7] = bfh(w.w); }
__device__ __forceinline__ void wave_lds_fence() {
    __builtin_amdgcn_fence(__ATOMIC_RELEASE, "wavefront"); __builtin_amdgcn_wave_barrier(); __builtin_amdgcn_fence(__ATOMIC_ACQUIRE, "wavefront");
}

struct Params {
    const float* in[31];
    float* out;
    unsigned char* ws;
    int ph_lo, ph_hi;
};
struct Params;
__device__ __forceinline__ const Params* params_fresh() { auto p = __builtin_amdgcn_kernarg_segment_ptr(); asm volatile("" : "+s"(p)); return (const Params*)p; }
#define PF (*params_fresh())
enum { I_X = 0, I_NMG, I_WIN, I_SINK, I_ARE, I_AIM, I_BRE, I_BIM, I_CRE, I_CIM, I_SD, I_LDT, I_GLUW, I_GLUB, I_CONVW, I_GATEB, I_MNG,
       I_LNG, I_LNB, I_SGUW, I_SGUB, I_WOUT, I_NFG, I_RGW, I_RGB, I_REW, I_REB, I_EWG, I_EWU, I_EWD, I_NFIN };

namespace pg8 {
#define PG8_LAS __attribute__((address_space(3)))
typedef short bf16x8 __attribute__((ext_vector_type(8)));
typedef float f32x4 __attribute__((ext_vector_type(4)));
typedef unsigned u32x4 __attribute__((ext_vector_type(4)));
typedef unsigned u32x2 __attribute__((ext_vector_type(2)));
typedef int i32x4 __attribute__((ext_vector_type(4)));
constexpr int BM = 256, BK = 64, HALF = 128, HTB = HALF * BK * 2, STAGE_BYTES = 8 * HTB, NXCD = 8, WGM = 8;
__host__ __device__ __forceinline__ int lds_byte(int r, int c) { const int st = (r >> 4) * 2 + (c >> 5), rr = r & 15, cc = c & 31, ob = rr * 64 + cc * 2; return st * 1024 + (ob ^ (((ob >> 9) & 1) << 5)); }
__host__ __device__ __forceinline__ void stage_rc(int b, int& R, int& C) { const int st = b / 1024, sb = b % 1024, swz = sb ^ (((sb >> 9) & 1) << 5); R = (st >> 1) * 16 + swz / 64; C = (st & 1) * 32 + (swz % 64) / 2; }
__host__ __device__ __forceinline__ int perm32(int rho) { const int n = rho >> 4, i = rho & 15; return 8 * (i >> 2) + 4 * n + (i & 3); }
__device__ __forceinline__ unsigned cvt_pk_bf16(float lo, float hi) { unsigned r; asm volatile("v_cvt_pk_bf16_f32 %0, %1, %2" : "=v"(r) : "v"(lo), "v"(hi)); return r; }

struct Unit { int pm, pn; const char* A; const char* B; int e, pos0, cnt; };

struct StaticOrder {
    int nM, nN, nwg, G, c, wgm, pmmask = -1; const char* A; const char* Bt; size_t atile, btile;
    __device__ void init(int M, int N, int K, int lda, int G_, int c_, const void* A_, const void* Bt_, int wgm_ = WGM) { wgm = wgm_; nM = M / BM; nN = N / BM; nwg = nM * nN; G = G_; c = c_; A = (const char*)A_; Bt = (const char*)Bt_; atile = (size_t)BM * lda * 2; btile = (size_t)BM * K * 2; }
    __device__ __forceinline__ bool next(int i, Unit& u) const {
        const long L = (long)i * G + c; if (L >= nwg) return false;
        int wgid = (int)L; { const int q = nwg / NXCD, r = nwg % NXCD, xcd = wgid % NXCD, off = wgid / NXCD; wgid = (xcd < r ? xcd * (q + 1) : r * (q + 1) + (xcd - r) * q) + off; }
        const int nig = wgm * nN, gid = wgid / nig, fm = gid * wgm, gsz = (nM - fm) < wgm ? (nM - fm) : wgm;
        u.pm = fm + ((wgid % nig) % gsz); u.pn = (wgid % nig) / gsz; u.A = A + (size_t)(u.pm & pmmask) * atile; u.B = Bt + (size_t)u.pn * btile; u.e = 0; u.pos0 = 0; u.cnt = 0; return true;
    }
    __device__ __forceinline__ void aoff(const Unit&, unsigned (&)[2], unsigned (&)[2], const int (&)[2], const int (&)[2]) const {}
};

template <class Epi, class Sched, bool GATHER>
__device__ __forceinline__ void gemm_phase(PG8_LAS unsigned char* lds, const int K, const int lda, const Sched& S, const Epi& E) {
    const int tid = tid_opaque(), wid = __builtin_amdgcn_readfirstlane(tid >> 6), lane = tid & 63, wr = wid >> 2, wc = wid & 3, fr = lane & 15, fq = lane >> 4;
    const int nt = K / BK;
    unsigned vA0[2], vA1[2], vB[2], nA0[2], nA1[2]; int Rs[2], Cs[2];
#pragma unroll
    for (int i = 0; i < 2; ++i) { int R, C; stage_rc(tid * 16 + i * 8192, R, C); const int Rb = Epi::PERM ? ((R & ~31) + perm32(R & 31)) : R;
        Rs[i] = R; Cs[i] = C; vA0[i] = (unsigned)(R * lda + C) * 2u; vA1[i] = vA0[i] + (unsigned)(HALF * lda) * 2u; vB[i] = (unsigned)(Rb * K + C) * 2u; nA0[i] = vA0[i]; nA1[i] = vA1[i]; }
    const size_t kstep = (size_t)(BK * 2);
    const size_t hstep = (size_t)HALF * K * 2;
    const unsigned ldsw = (unsigned)wid * 1024u;
    const int aoff = lds_byte(wr * 64 + fr, fq * 8), boff = lds_byte(wc * 32 + fr, fq * 8);
#define PG8_SA(b, h) (((b) * 2 + (h)) * HTB)
#define PG8_SB(b, h) ((4 + (b) * 2 + (h)) * HTB)
#define PG8_STAGE(bufoff, gbase, voff) do { _Pragma("unroll") for (int _i = 0; _i < 2; ++_i) \
        __builtin_amdgcn_global_load_lds((const unsigned*)((const char*)(gbase) + (voff)[_i]), (PG8_LAS unsigned*)(lds + (bufoff) + ldsw + _i * 8192), 16, 0, 0); } while (0)
#define PG8_LDA(dst, b, h) do { _Pragma("unroll") for (int m = 0; m < 4; ++m) _Pragma("unroll") for (int k = 0; k < 2; ++k) dst[m][k] = *(const PG8_LAS bf16x8*)(lds + PG8_SA(b, h) + aoff + m * 2048 + k * 1024); } while (0)
#define PG8_LDB(dst, b, h) do { _Pragma("unroll") for (int n = 0; n < 2; ++n) _Pragma("unroll") for (int k = 0; k < 2; ++k) dst[n][k] = *(const PG8_LAS bf16x8*)(lds + PG8_SB(b, h) + boff + n * 2048 + k * 1024); } while (0)
#define PG8_MMA(ai, bj, At, Bt) do { __builtin_amdgcn_s_setprio(1); _Pragma("unroll") for (int m = 0; m < 4; ++m) _Pragma("unroll") for (int n = 0; n < 2; ++n) _Pragma("unroll") for (int k = 0; k < 2; ++k) \
        acc[ai][bj][m][n] = __builtin_amdgcn_mfma_f32_16x16x32_bf16(Bt[n][k], At[m][k], acc[ai][bj][m][n], 0, 0, 0); __builtin_amdgcn_s_setprio(0); } while (0)
#define PG8_WAIT_V(n) asm volatile("s_waitcnt vmcnt(" #n ")" ::: "memory")
#define PG8_WAIT_L(n) asm volatile("s_waitcnt lgkmcnt(" #n ")" ::: "memory")
#define PG8_BAR __builtin_amdgcn_s_barrier()
#define PG8_SCHED __builtin_amdgcn_sched_barrier(0)
    Unit cur, nxt; int ui = 0;
    if (!S.next(0, cur)) return;
    if constexpr (GATHER) { S.aoff(cur, vA0, vA1, Rs, Cs); PG8_WAIT_V(0); }
    f32x4 acc[2][2][4][2];
#pragma unroll
    for (int a = 0; a < 2; ++a)
#pragma unroll
        for (int b = 0; b < 2; ++b)
#pragma unroll
            for (int m = 0; m < 4; ++m)
#pragma unroll
                for (int n = 0; n < 2; ++n) acc[a][b][m][n] = (f32x4){0.f, 0.f, 0.f, 0.f};
    bf16x8 At[4][2], B0[2][2], B1[2][2];
    const char* cA = cur.A; const char* cB = cur.B;
    PG8_STAGE(PG8_SB(0, 0), cB, vB); PG8_STAGE(PG8_SB(0, 1), cB + hstep, vB); PG8_STAGE(PG8_SA(0, 0), cA, vA0); PG8_STAGE(PG8_SA(0, 1), cA, vA1);
    if (wr == 1) PG8_BAR;
    PG8_WAIT_V(2); PG8_BAR;
    PG8_STAGE(PG8_SB(1, 0), cB + kstep, vB); PG8_STAGE(PG8_SA(1, 0), cA + kstep, vA0); PG8_STAGE(PG8_SB(1, 1), cB + hstep + kstep, vB);
    PG8_WAIT_V(6); PG8_BAR;
    for (;;) {
        const bool has_next = S.next(ui + 1, nxt);
        const char* nA = has_next ? nxt.A : cA; const char* nB = has_next ? nxt.B : cB;
        if constexpr (GATHER) {
            if (has_next) { S.aoff(nxt, nA0, nA1, Rs, Cs); }
            else {
#pragma unroll
                for (int i = 0; i < 2; ++i) { nA0[i] = vA0[i]; nA1[i] = vA1[i]; } }
        }
        for (int t = 0; t < nt; t += 2) {
            const bool last = (t == nt - 2);
            const char* a1 = cA + (size_t)(t + 1) * kstep;
            const char* a2 = last ? nA : cA + (size_t)(t + 2) * kstep; const char* b2 = last ? nB : cB + (size_t)(t + 2) * kstep;
            const char* a3 = a2 + kstep; const char* b3 = b2 + kstep;
            unsigned x0[2], x1[2];
#pragma unroll
            for (int i = 0; i < 2; ++i) { x0[i] = (GATHER && last) ? nA0[i] : vA0[i]; x1[i] = (GATHER && last) ? nA1[i] : vA1[i]; }
            PG8_LDB(B0, 0, 0); PG8_LDB(B1, 0, 1); PG8_SCHED; PG8_LDA(At, 0, 0); PG8_STAGE(PG8_SA(1, 1), a1, vA1);
            PG8_WAIT_V(8); PG8_WAIT_L(0); PG8_BAR; PG8_MMA(0, 0, At, B0); PG8_MMA(0, 1, At, B1); PG8_BAR; PG8_SCHED;
            PG8_LDA(At, 0, 1); PG8_STAGE(PG8_SB(0, 0), b2, vB); PG8_STAGE(PG8_SB(0, 1), b2 + hstep, vB); PG8_STAGE(PG8_SA(0, 0), a2, x0);
            PG8_WAIT_V(8); PG8_WAIT_L(0); PG8_BAR; PG8_MMA(1, 0, At, B0); PG8_MMA(1, 1, At, B1); PG8_BAR; PG8_SCHED;
            PG8_LDB(B0, 1, 0); PG8_LDB(B1, 1, 1); PG8_SCHED; PG8_LDA(At, 1, 0); PG8_STAGE(PG8_SA(0, 1), a2, x1);
            PG8_WAIT_V(8); PG8_WAIT_L(0); PG8_BAR; PG8_MMA(0, 0, At, B0); PG8_MMA(0, 1, At, B1); PG8_BAR; PG8_SCHED;
            PG8_LDA(At, 1, 1); PG8_STAGE(PG8_SB(1, 0), b3, vB); PG8_STAGE(PG8_SB(1, 1), b3 + hstep, vB); PG8_STAGE(PG8_SA(1, 0), a3, x0);
            PG8_WAIT_V(8); PG8_WAIT_L(0); PG8_BAR; PG8_MMA(1, 0, At, B0); PG8_MMA(1, 1, At, B1); PG8_BAR; PG8_SCHED;
        }
        if (wr == 0) PG8_BAR;
        E(acc, cur, wr, wc, fr, fq);
        if (!has_next) break;
#pragma unroll
        for (int a = 0; a < 2; ++a)
#pragma unroll
            for (int b = 0; b < 2; ++b)
#pragma unroll
                for (int m = 0; m < 4; ++m)
#pragma unroll
                    for (int n = 0; n < 2; ++n) acc[a][b][m][n] = (f32x4){0.f, 0.f, 0.f, 0.f};
        cur = nxt; cA = nA; cB = nB; ++ui;
        if constexpr (GATHER) {
#pragma unroll
            for (int i = 0; i < 2; ++i) { vA0[i] = nA0[i]; vA1[i] = nA1[i]; } }
        if (wr == 1) PG8_BAR;
    }
    PG8_WAIT_V(0);
    PG8_BAR;
#undef PG8_SA
#undef PG8_SB
#undef PG8_STAGE
#undef PG8_LDA
#undef PG8_LDB
#undef PG8_MMA
#undef PG8_WAIT_V
#undef PG8_WAIT_L
#undef PG8_BAR
#undef PG8_SCHED
}

struct EpiZ {
    static constexpr bool PERM = true;
    bf16_t* Z; const float* RS; int skip;
    __device__ __forceinline__ void operator()(const f32x4 (&acc)[2][2][4][2], const Unit& u, int wr, int wc, int fr, int fq) const {
        if (skip) return;
        const int row0 = u.pm * BM + wr * 64 + fr, col0 = u.pn * BM + wc * 32 + 8 * fq;
        float rsv[2][4];
#pragma unroll
        for (int ai = 0; ai < 2; ++ai)
#pragma unroll
            for (int m = 0; m < 4; ++m) rsv[ai][m] = RS[row0 + ai * HALF + m * 16];
#pragma unroll
        for (int ai = 0; ai < 2; ++ai)
#pragma unroll
            for (int m = 0; m < 4; ++m) { bf16_t* rowp = Z + (size_t)(row0 + ai * HALF + m * 16) * ZW + col0; const float rs = rsv[ai][m];
#pragma unroll
                for (int bj = 0; bj < 2; ++bj) { const f32x4 v0 = acc[ai][bj][m][0] * rs, v1 = acc[ai][bj][m][1] * rs;
                    u32x4 w; w.x = cvt_pk_bf16(v0[0], v0[1]); w.y = cvt_pk_bf16(v0[2], v0[3]); w.z = cvt_pk_bf16(v1[0], v1[1]); w.w = cvt_pk_bf16(v1[2], v1[3]);
                    *(u32x4*)(rowp + bj * HALF) = w; } }
    }
};
template <bool SRCF32> struct EpiResB {
    static constexpr bool PERM = true;
    const float* XF; bf16_t* XB;
    __device__ __forceinline__ void operator()(const f32x4 (&acc)[2][2][4][2], const Unit& u, int wr, int wc, int fr, int fq) const {
        const int row0 = u.pm * BM + wr * 64 + fr, col0 = u.pn * BM + wc * 32 + 8 * fq;
#pragma unroll
        for (int ai = 0; ai < 2; ++ai) {
            f32x4 xf[4][2][2]; u32x4 xw[4][2];
#pragma unroll
            for (int m = 0; m < 4; ++m) { const size_t off = (size_t)(row0 + ai * HALF + m * 16) * D + col0;
#pragma unroll
                for (int bj = 0; bj < 2; ++bj) {
                    if (SRCF32) { xf[m][bj][0] = *(const f32x4*)(XF + off + bj * HALF); xf[m][bj][1] = *(const f32x4*)(XF + off + bj * HALF + 4); }
                    else xw[m][bj] = *(const u32x4*)(XB + off + bj * HALF); } }
            __builtin_amdgcn_sched_barrier(0);
#pragma unroll
            for (int m = 0; m < 4; ++m) { const size_t off = (size_t)(row0 + ai * HALF + m * 16) * D + col0;
#pragma unroll
                for (int bj = 0; bj < 2; ++bj) { f32x4 x0, x1;
                    if (SRCF32) { x0 = xf[m][bj][0]; x1 = xf[m][bj][1]; }
                    else { const u32x4 w = xw[m][bj];
                        x0 = (f32x4){__uint_as_float(w.x << 16), __uint_as_float(w.x & 0xffff0000u), __uint_as_float(w.y << 16), __uint_as_float(w.y & 0xffff0000u)};
                        x1 = (f32x4){__uint_as_float(w.z << 16), __uint_as_float(w.z & 0xffff0000u), __uint_as_float(w.w << 16), __uint_as_float(w.w & 0xffff0000u)}; }
                    const f32x4 v0 = x0 + acc[ai][bj][m][0], v1 = x1 + acc[ai][bj][m][1];
                    u32x4 o; o.x = cvt_pk_bf16(v0[0], v0[1]); o.y = cvt_pk_bf16(v0[2], v0[3]); o.z = cvt_pk_bf16(v1[0], v1[1]); o.w = cvt_pk_bf16(v1[2], v1[3]);
                    *(u32x4*)(XB + off + bj * HALF) = o; } }
            __builtin_amdgcn_sched_barrier(0);
        }
    }
};
struct EpiAct {
    static constexpr bool PERM = true;
    bf16_t* ACT; const int2* lists; const float* RS;
    __device__ __forceinline__ void operator()(const f32x4 (&acc)[2][2][4][2], const Unit& u, int wr, int wc, int fr, int fq) const {
        const int row0 = u.pm * BM + wr * 64 + fr, col0 = u.pn * HALF + wc * 32 + 8 * fq; const int2* lst = lists + (size_t)u.e * NTOK + u.pos0;
        int tk[2][4]; float rsv[2][4];
#pragma unroll
        for (int ai = 0; ai < 2; ++ai)
#pragma unroll
            for (int m = 0; m < 4; ++m) { const int r = ai * HALF + wr * 64 + m * 16 + fr; const int rc = (u.pos0 + r < u.cnt) ? r : 0; tk[ai][m] = lst[rc].x; }
        asm volatile("" : "+v"(tk[0][0]), "+v"(tk[0][1]), "+v"(tk[0][2]), "+v"(tk[0][3]), "+v"(tk[1][0]), "+v"(tk[1][1]), "+v"(tk[1][2]), "+v"(tk[1][3]));
#pragma unroll
        for (int ai = 0; ai < 2; ++ai)
#pragma unroll
            for (int m = 0; m < 4; ++m) rsv[ai][m] = RS[tk[ai][m]];
        asm volatile("" : "+v"(rsv[0][0]), "+v"(rsv[0][1]), "+v"(rsv[0][2]), "+v"(rsv[0][3]), "+v"(rsv[1][0]), "+v"(rsv[1][1]), "+v"(rsv[1][2]), "+v"(rsv[1][3]));
#pragma unroll
        for (int ai = 0; ai < 2; ++ai)
#pragma unroll
            for (int m = 0; m < 4; ++m) { const int r = ai * HALF + wr * 64 + m * 16 + fr; if (!(u.pos0 + r < u.cnt)) rsv[ai][m] = 0.f; }
#pragma unroll
        for (int ai = 0; ai < 2; ++ai)
#pragma unroll
            for (int m = 0; m < 4; ++m) { bf16_t* rowp = ACT + (size_t)(row0 + ai * HALF + m * 16) * DE + col0;
                const float rs = rsv[ai][m];
                float o[8];
#pragma unroll
                for (int n = 0; n < 2; ++n)
#pragma unroll
                    for (int j = 0; j < 4; ++j) { const float g = acc[ai][0][m][n][j] * rs, up = acc[ai][1][m][n][j] * rs; o[n * 4 + j] = g * up * __builtin_amdgcn_rcpf(1.f + __expf(-g)); }
                u32x4 w; w.x = cvt_pk_bf16(o[0], o[1]); w.y = cvt_pk_bf16(o[2], o[3]); w.z = cvt_pk_bf16(o[4], o[5]); w.w = cvt_pk_bf16(o[6], o[7]);
                *(u32x4*)rowp = w; }
    }
};
struct EpiY {
    static constexpr bool PERM = true;
    bf16_t* YB; const int2* lists;
    __device__ __forceinline__ void operator()(const f32x4 (&acc)[2][2][4][2], const Unit& u, int wr, int wc, int fr, int fq) const {
        const int row0 = u.pm * BM + wr * 64 + fr, col0 = u.pn * BM + wc * 32 + 8 * fq; const int2* lst = lists + (size_t)u.e * NTOK + u.pos0;
        float wv[2][4];
#pragma unroll
        for (int ai = 0; ai < 2; ++ai)
#pragma unroll
            for (int m = 0; m < 4; ++m) { const int r = ai * HALF + wr * 64 + m * 16 + fr; wv[ai][m] = __int_as_float(lst[(u.pos0 + r < u.cnt) ? r : 0].y); }
#pragma unroll
        for (int ai = 0; ai < 2; ++ai)
#pragma unroll
            for (int m = 0; m < 4; ++m) { const int r = ai * HALF + wr * 64 + m * 16 + fr;
                if (u.pos0 + r < u.cnt) { const float w = wv[ai][m]; bf16_t* rowp = YB + (size_t)(row0 + ai * HALF + m * 16) * D + col0;
#pragma unroll
                    for (int bj = 0; bj < 2; ++bj) { const f32x4 v0 = acc[ai][bj][m][0] * w, v1 = acc[ai][bj][m][1] * w;
                        u32x4 o; o.x = cvt_pk_bf16(v0[0], v0[1]); o.y = cvt_pk_bf16(v0[2], v0[3]); o.z = cvt_pk_bf16(v1[0], v1[1]); o.w = cvt_pk_bf16(v1[2], v1[3]);
                        *(u32x4*)(rowp + bj * HALF) = o; } } }
    }
};
struct MoeOrder {
    const PG8_LAS i32x4* tab; int ntiles, npn, G, c; const char* A; size_t atile; const char* Bt; size_t bexp, btile; const int2* lists;
    __device__ __forceinline__ bool next(int i, Unit& u) const {
        const int L = i * G + c; const int T = L / npn; if (T >= ntiles) return false;
        const i32x4 te = tab[T]; u.pm = T; u.pn = L - T * npn; u.e = __builtin_amdgcn_readfirstlane(te.x); u.pos0 = __builtin_amdgcn_readfirstlane(te.y); u.cnt = __builtin_amdgcn_readfirstlane(te.z);
        u.A = A + (size_t)T * atile; u.B = Bt + (size_t)u.e * bexp + (size_t)u.pn * btile; return true;
    }
    __device__ __forceinline__ void aoff(const Unit& u, unsigned (&o0)[2], unsigned (&o1)[2], const int (&Rs)[2], const int (&Cs)[2]) const {
        const int2* lst = lists + (size_t)u.e * NTOK;
#pragma unroll
        for (int i = 0; i < 2; ++i) { const int p0 = u.pos0 + Rs[i], p1 = p0 + HALF;
            const int t0 = (p0 < u.cnt) ? lst[p0].x : 0, t1 = (p1 < u.cnt) ? lst[p1].x : 0;
            o0[i] = (unsigned)t0 * (unsigned)(D * 2) + (unsigned)Cs[i] * 2u; o1[i] = (unsigned)t1 * (unsigned)(D * 2) + (unsigned)Cs[i] * 2u; }
    }
};
}

__device__ __forceinline__ void tc_strip(float* T, const float* src, int src_ld, int c0, int k0, bf16_t* dst, int K, int n0) {
    const int tid = tid_opaque();
    float4 v[8];
#pragma unroll
    for (int i = 0; i < 8; ++i) { const int kk = (tid >> 4) + 32 * i, c4 = (tid & 15) * 4; v[i] = *(const float4*)(src + (size_t)(k0 + kk) * src_ld + c0 + c4); }
    __syncthreads();
#pragma unroll
    for (int i = 0; i < 8; ++i) { const int kk = (tid >> 4) + 32 * i, c4 = (tid & 15) * 4;
        T[kk * 65 + c4] = v[i].x; T[kk * 65 + c4 + 1] = v[i].y; T[kk * 65 + c4 + 2] = v[i].z; T[kk * 65 + c4 + 3] = v[i].w; }
    __syncthreads();
    const int nl = tid >> 3, kc = (tid & 7) * 32;
#pragma unroll
    for (int q = 0; q < 4; ++q) { const int kq = kc + 8 * q; pg8::u32x4 w;
        w.x = pg8::cvt_pk_bf16(T[(kq + 0) * 65 + nl], T[(kq + 1) * 65 + nl]); w.y = pg8::cvt_pk_bf16(T[(kq + 2) * 65 + nl], T[(kq + 3) * 65 + nl]);
        w.z = pg8::cvt_pk_bf16(T[(kq + 4) * 65 + nl], T[(kq + 5) * 65 + nl]); w.w = pg8::cvt_pk_bf16(T[(kq + 6) * 65 + nl], T[(kq + 7) * 65 + nl]);
        *(pg8::u32x4*)(dst + (size_t)(n0 + nl) * K + k0 + kq) = w; }
}
__device__ __forceinline__ void s5_build_tables_fwd(float* ldsf, const Params& P, int l, int g, unsigned char* tb);
__device__ __forceinline__ void ph_prologue(float* lds, const Params& P) {
    constexpr int NJ_EXP = NLAYER * NEXP * 96, NJ_IN = NLAYER * 144, NJ_OUT = NLAYER * 64, NJ_TB = NLAYER * 16, NJ_GLU = NLAYER * 4, NJ_SGU = NLAYER * 4, NJ_RT = NLAYER * 16;
    bf16_t* WIN = (bf16_t*)(P.ws + WS_WIN); bf16_t* WOUT = (bf16_t*)(P.ws + WS_WOUT); bf16_t* WGU = (bf16_t*)(P.ws + WS_WGU); bf16_t* WD = (bf16_t*)(P.ws + WS_WD);
    constexpr int NJ_ALL = NJ_EXP + NJ_IN + NJ_OUT + NJ_TB + NJ_GLU + NJ_SGU + NJ_RT, NJ_SMALL = NJ_TB + NJ_GLU + NJ_SGU + NJ_RT;
    unsigned* qhead = (unsigned*)(P.ws + WS_CTL) + CW_Q;
    LAS int* jslot = (LAS int*)((LAS unsigned char*)lds + LDS_BYTES - 64);
    for (;;) {
        __syncthreads();
        if (tid_opaque() == 0) *jslot = (int)atomicAdd(qhead, 1u);
        __syncthreads();
        const int jj = __builtin_amdgcn_readfirstlane(*jslot);
        if (jj >= NJ_ALL) break;
        const int j = (jj < NJ_SMALL) ? (NJ_ALL - NJ_SMALL + jj) : (jj - NJ_SMALL);
        if (j < NJ_EXP) {
            const int le = j / 96, r = j % 96;
            if (r < 64) { const int n0 = (r >> 2) * 64, k0 = (r & 3) * 256, pn = n0 >> 8, within = n0 & 255;
                const float* s = (within < 128 ? P.in[I_EWG] : P.in[I_EWU]) + (size_t)le * D * DE;
                tc_strip(lds, s, DE, pn * 128 + (within & 127), k0, WGU + (size_t)le * 1024 * D, D, n0);
            } else { const int r2 = r - 64, n0 = (r2 >> 1) * 64, k0 = (r2 & 1) * 256;
                tc_strip(lds, P.in[I_EWD] + (size_t)le * DE * D, D, n0, k0, WD + (size_t)le * D * DE, DE, n0); }
        } else if (j < NJ_EXP + NJ_IN) {
            const int j2 = j - NJ_EXP, l = j2 / 144, r = j2 % 144, n0 = (r >> 2) * 64, k0 = (r & 3) * 256;
            tc_strip(lds, P.in[I_WIN] + (size_t)l * D * INW, INW, n0 < WCI ? n0 : n0 + 8, k0, WIN + (size_t)l * NMAIN * D, D, n0);
        } else if (j < NJ_EXP + NJ_IN + NJ_OUT) {
            const int j3 = j - NJ_EXP - NJ_IN, l = j3 / 64, r = j3 % 64, n0 = (r >> 2) * 64, k0 = (r & 3) * 256;
            tc_strip(lds, P.in[I_WOUT] + (size_t)l * D * D, D, n0, k0, WOUT + (size_t)l * D * D, D, n0);
        } else if (j < NJ_EXP + NJ_IN + NJ_OUT + NJ_TB) {
            const int j4 = j - (NJ_EXP + NJ_IN + NJ_OUT);
            s5_build_tables_fwd(lds, P, j4 >> 4, j4 & 15, P.ws + WS_TB + (size_t)(j4 >> 4) * 4 * MiB);
        } else if (j < NJ_EXP + NJ_IN + NJ_OUT + NJ_TB + NJ_GLU) {
            const int j5 = j - (NJ_EXP + NJ_IN + NJ_OUT + NJ_TB), l = j5 >> 2, n0 = (j5 & 3) * 64;
            tc_strip(lds, P.in[I_GLUW] + (size_t)l * 256 * 256, 256, n0, 0, (bf16_t*)(P.ws + WS_TB + (size_t)l * 4 * MiB + s5::T_GLUW), 256, n0);
        } else if (j < NJ_EXP + NJ_IN + NJ_OUT + NJ_TB + NJ_GLU + NJ_SGU) {
            const int j6 = j - (NJ_EXP + NJ_IN + NJ_OUT + NJ_TB + NJ_GLU), l = j6 >> 2, g = j6 & 3;
            bf16_t* wbp = (bf16_t*)(P.ws + WS_TB + (size_t)l * 4 * MiB + s5::T_SGUW) + (size_t)g * 128 * 128; const float* ws_ = P.in[I_SGUW] + ((size_t)l * 4 + g) * 128 * 128;
            for (int idx = tid_opaque(); idx < 128 * 128; idx += NTHREADS) { const int t = idx >> 7, s = idx & 127; wbp[idx] = (s <= t) ? (bf16_t)(pg8::cvt_pk_bf16(ws_[idx], 0.f) & 0xffffu) : (bf16_t)0; }
        } else {
            const int j7 = j - (NJ_EXP + NJ_IN + NJ_OUT + NJ_TB + NJ_GLU + NJ_SGU), l = j7 / 16, n0 = (j7 % 16) * 4;
            bf16_t* wh = (bf16_t*)(P.ws + WS_RT + (size_t)l * 256 * 1024); bf16_t* wl = wh + 48 * D;
            for (int idx = tid_opaque(); idx < 4 * D; idx += NTHREADS) { const int n = n0 + (idx >> 10), k = idx & (D - 1);
                const float w = (n < 4) ? P.in[I_RGW][((size_t)l * D + k) * 4 + n] : ((n < 36) ? P.in[I_REW][((size_t)l * D + k) * 32 + (n - 4)] : ((n >= 48 && n < 56) ? P.in[I_WIN][((size_t)l * D + k) * INW + WCI + (n - 48)] : 0.f));
                const unsigned hb = pg8::cvt_pk_bf16(w, 0.f) & 0xffffu; const bf16_t lb = (bf16_t)(pg8::cvt_pk_bf16(w - __uint_as_float(hb << 16), 0.f) & 0xffffu);
                if (n < 48) { wh[(size_t)n * D + k] = (bf16_t)hb; wl[(size_t)n * D + k] = lb; } else { wh[(size_t)(96 + n - 48) * D + k] = (bf16_t)hb; wh[(size_t)(112 + n - 48) * D + k] = lb; } }
        }
    }
    __syncthreads();
}

template <bool DUAL, class AF, class EF>
__device__ __forceinline__ void gemm_tile(float* lds, AF arow, int K, const float* B0, const float* B1, int ldb, int n0, int N, EF epi) {
    float* As = lds;
    float* Bs0 = lds + 32 * 132;
    float* Bs1 = Bs0 + 32 * 128;
    const int tid = tid_opaque(), ty = tid >> 4, tx = tid & 15;
    float acc0[4][8], acc1[4][8];
#pragma unroll
    for (int i = 0; i < 4; ++i)
#pragma unroll
        for (int j = 0; j < 8; ++j) { acc0[i][j] = 0.f; acc1[i][j] = 0.f; }
    const float* ap0 = arow((tid >> 3));
    const float* ap1 = arow((tid >> 3) + 64);
    const int akk = (tid & 7) * 4;
    const int bn = n0 + (tid & 31) * 4; const bool bok = bn < N;
    for (int k0 = 0; k0 < K; k0 += 32) {
        const float4 av0 = ap0 ? *(const float4*)(ap0 + k0 + akk) : make_float4(0.f, 0.f, 0.f, 0.f);
        const float4 av1 = ap1 ? *(const float4*)(ap1 + k0 + akk) : make_float4(0.f, 0.f, 0.f, 0.f);
        const int kb0 = k0 + (tid >> 5), kb1 = kb0 + 16;
        const float4 bv00 = bok ? *(const float4*)(B0 + (size_t)kb0 * ldb + bn) : make_float4(0.f, 0.f, 0.f, 0.f);
        const float4 bv01 = bok ? *(const float4*)(B0 + (size_t)kb1 * ldb + bn) : make_float4(0.f, 0.f, 0.f, 0.f);
        const float4 bv10 = (DUAL && bok) ? *(const float4*)(B1 + (size_t)kb0 * ldb + bn) : bv00;
        const float4 bv11 = (DUAL && bok) ? *(const float4*)(B1 + (size_t)kb1 * ldb + bn) : bv01;
        __syncthreads();
        { const int r = (tid >> 3);
          As[(akk + 0) * 132 + r] = av0.x; As[(akk + 1) * 132 + r] = av0.y; As[(akk + 2) * 132 + r] = av0.z; As[(akk + 3) * 132 + r] = av0.w;
          As[(akk + 0) * 132 + r + 64] = av1.x; As[(akk + 1) * 132 + r + 64] = av1.y; As[(akk + 2) * 132 + r + 64] = av1.z; As[(akk + 3) * 132 + r + 64] = av1.w; }
        { const int k = (tid >> 5);
          *(float4*)&Bs0[k * 128 + (tid & 31) * 4] = bv00; *(float4*)&Bs0[(k + 16) * 128 + (tid & 31) * 4] = bv01;
          if (DUAL) { *(float4*)&Bs1[k * 128 + (tid & 31) * 4] = bv10; *(float4*)&Bs1[(k + 16) * 128 + (tid & 31) * 4] = bv11; } }
        __syncthreads();
#pragma unroll 4
        for (int k = 0; k < 32; ++k) {
            const float4 a = *(const float4*)&As[k * 132 + ty * 4];
            const float4 b0 = *(const float4*)&Bs0[k * 128 + tx * 4], b1 = *(const float4*)&Bs0[k * 128 + 64 + tx * 4];
            const float aa[4] = {a.x, a.y, a.z, a.w};
            const float bb[8] = {b0.x, b0.y, b0.z, b0.w, b1.x, b1.y, b1.z, b1.w};
#pragma unroll
            for (int i = 0; i < 4; ++i)
#pragma unroll
                for (int j = 0; j < 8; ++j) acc0[i][j] = fmaf(aa[i], bb[j], acc0[i][j]);
            if (DUAL) {
                const float4 c0 = *(const float4*)&Bs1[k * 128 + tx * 4], c1 = *(const float4*)&Bs1[k * 128 + 64 + tx * 4];
                const float cc[8] = {c0.x, c0.y, c0.z, c0.w, c1.x, c1.y, c1.z, c1.w};
#pragma unroll
                for (int i = 0; i < 4; ++i)
#pragma unroll
                    for (int j = 0; j < 8; ++j) acc1[i][j] = fmaf(aa[i], cc[j], acc1[i][j]);
            }
        }
    }
#pragma unroll
    for (int i = 0; i < 4; ++i)
#pragma unroll
        for (int j = 0; j < 8; ++j) {
            const int r = ty * 4 + i, c = n0 + (j < 4 ? tx * 4 + j : 64 + tx * 4 + (j - 4));
            if (c < N) epi(r, c, acc0[i][j], acc1[i][j]);
        }
    __syncthreads();
}

__device__ __forceinline__ void ph_inproj(LAS unsigned char* ldsb, const bf16_t* xn, const bf16_t* wt, bf16_t* z, const float* RS, int skip) {
    pg8::StaticOrder S; S.init(NTOK, NMAIN, D, D, gridDim.x, blockIdx.x, xn, wt, INPROJ_WGM);
    if (skip & 2) S.pmmask = 15;
    pg8::EpiZ E{z, RS, skip & 1};
    pg8::gemm_phase<pg8::EpiZ, pg8::StaticOrder, false>(ldsb, D, D, S, E);
}

namespace ml {
using pg8::bf16x8; using pg8::f32x4; using pg8::u32x4; using pg8::u32x2;
constexpr int L = 128, NCH = S / L, NU = NB * 4 * NCH;
constexpr int QP = 144, TP = 272;
constexpr int OFF_Q = 0, OFF_K = OFF_Q + 128 * QP, OFF_VT = OFF_K + 128 * QP, OFF_KT = OFF_VT + 64 * TP, OFF_F = OFF_KT + 64 * TP;
constexpr int LDS_END = OFF_F + 4 * 128 * 4 + 64;
constexpr size_t O_CL = 0, O_CST = O_CL + (size_t)NU * 4096 * 4, O_NL = O_CST + (size_t)NU * 4096 * 2, O_NST = O_NL + (size_t)NU * 64 * 4,
                 O_MLOC = O_NST + (size_t)NU * 64 * 4, O_BL = O_MLOC + (size_t)NU * 4, O_MST = O_BL + (size_t)NU * 4, O_END = O_MST + (size_t)NU * 4;
__device__ __forceinline__ f32x4 mfma16(bf16x8 a, bf16x8 b, f32x4 c) { return __builtin_amdgcn_mfma_f32_16x16x32_bf16(a, b, c, 0, 0, 0); }
__device__ __forceinline__ float bf_lo(unsigned w) { return __uint_as_float(w << 16); }
__device__ __forceinline__ float bf_hi(unsigned w) { return __uint_as_float(w & 0xffff0000u); }
__device__ __forceinline__ unsigned short bf1(float x) { return (unsigned short)(pg8::cvt_pk_bf16(x, 0.f) & 0xffffu); }

__device__ __forceinline__ void stage_gates(LAS unsigned char* lds, const float* gates, const Params& P, int l, int head, int tok0, int tid) {
    LAS float* LF = (LAS float*)(lds + OFF_F); LAS float* IG = LF + 128; LAS float* Bc = LF + 256; LAS float* G2 = LF + 384; LAS float* scal = LF + 512;
    if (tid < 128) { const float* zr = gates + (size_t)(tok0 + tid) * 8;
        const float ipre = zr[head] + P.in[I_GATEB][l * 8 + head], fpre = zr[4 + head] + P.in[I_GATEB][l * 8 + 4 + head];
        LF[tid] = fminf(fpre, 0.f) - log1pf(expf(-fabsf(fpre))); IG[tid] = ipre; }
    __syncthreads();
    if (tid < 64) { const float a = LF[2 * tid], b2 = LF[2 * tid + 1]; const float s = a + b2; float inc = s;
#pragma unroll
        for (int o = 1; o < 64; o <<= 1) { const float v = __shfl_up(inc, o); if (tid >= o) inc += v; }
        const float exc = inc - s; const float b0 = exc + a, b1 = exc + s;
        Bc[2 * tid] = b0; Bc[2 * tid + 1] = b1; const float g0 = IG[2 * tid] - b0, g1 = IG[2 * tid + 1] - b1; G2[2 * tid] = g0; G2[2 * tid + 1] = g1;
        float gm = fmaxf(g0, g1);
#pragma unroll
        for (int o = 32; o > 0; o >>= 1) gm = fmaxf(gm, __shfl_xor(gm, o));
        if (tid == 63) { scal[0] = gm; scal[1] = b1; } }
    __syncthreads();
}
__device__ __forceinline__ void conv8_load(const bf16_t* z, int b, int pos, int which, int head, int c0, u32x4 (&raw)[4]) {
    const int col = (which ? ZCK : ZCQ) + head * 64 + c0;
#pragma unroll
    for (int j = 0; j < 4; ++j) { const int tg = pos - 3 + j; raw[j] = *(const u32x4*)(z + (size_t)(b * S + (tg > 0 ? tg : 0)) * ZW + col); }
}
__device__ __forceinline__ void conv8_finish(const u32x4 (&raw)[4], const float* cw, int pos, int which, int head, int c0, float (&o)[8]) {
    const int cc = which * 256 + head * 64 + c0;
    float x[8];
#pragma unroll
    for (int e = 0; e < 8; ++e) x[e] = 0.f;
    float4 wa[4], wb[4];
#pragma unroll
    for (int j = 0; j < 4; ++j) { wa[j] = *(const float4*)(cw + j * 512 + cc); wb[j] = *(const float4*)(cw + j * 512 + cc + 4); }
    __builtin_amdgcn_sched_barrier(0);
#pragma unroll
    for (int j = 0; j < 4; ++j) { const float mk = (pos - 3 + j >= 0) ? 1.f : 0.f;
        const float4 w0 = wa[j], w1 = wb[j];
        x[0] += mk * w0.x * bf_lo(raw[j].x); x[1] += mk * w0.y * bf_hi(raw[j].x); x[2] += mk * w0.z * bf_lo(raw[j].y); x[3] += mk * w0.w * bf_hi(raw[j].y);
        x[4] += mk * w1.x * bf_lo(raw[j].z); x[5] += mk * w1.y * bf_hi(raw[j].z); x[6] += mk * w1.z * bf_lo(raw[j].w); x[7] += mk * w1.w * bf_hi(raw[j].w); }
    const float sc = which ? 0.125f : 1.f;
#pragma unroll
    for (int e = 0; e < 8; ++e) o[e] = x[e] * sc / (1.f + __expf(-x[e]));
}
__device__ __forceinline__ void vt_load(const bf16_t* z, int head, int tok0, int tid, u32x4 (&w)[2]) {
#pragma unroll
    for (int it = 0; it < 2; ++it) { const int idx = tid + it * NTHREADS, s = idx & 127, cg = idx >> 7; w[it] = *(const u32x4*)(z + (size_t)(tok0 + s) * ZW + ZCV + head * 64 + cg * 8); }
}
__device__ __forceinline__ void vt_store(LAS unsigned char* lds, int tid, const u32x4 (&w)[2]) {
#pragma unroll
    for (int it = 0; it < 2; ++it) { const int idx = tid + it * NTHREADS, s = idx & 127, cg = idx >> 7; const unsigned ww[4] = {w[it].x, w[it].y, w[it].z, w[it].w};
#pragma unroll
        for (int e = 0; e < 8; ++e) *(LAS unsigned short*)(lds + OFF_VT + (cg * 8 + e) * TP + s * 2) = (unsigned short)((e & 1) ? (ww[e >> 1] >> 16) : (ww[e >> 1] & 0xffffu)); }
}

__device__ __forceinline__ void p1_unit(LAS unsigned char* lds, const bf16_t* z, const float* gates, const Params& P, int l, int u, unsigned char* wsm) {
    const int tid = tid_opaque(), lane = tid & 63, wid = __builtin_amdgcn_readfirstlane(tid >> 6), r = lane & 15, qd = lane >> 4;
    const int b = u >> 8, head = (u >> 6) & 3, c = u & 63, tok0 = b * S + c * L;
    LAS float* G2 = (LAS float*)(lds + OFF_F) + 384; LAS float* scal = (LAS float*)(lds + OFF_F) + 512;
    u32x4 vraw[2], kraw[2][4];
    vt_load(z, head, tok0, tid, vraw);
#pragma unroll
    for (int it = 0; it < 2; ++it) { const int idx = tid + it * NTHREADS; conv8_load(z, b, c * L + (idx & 127), 1, head, (idx >> 7) * 8, kraw[it]); }
    __syncthreads();
    stage_gates(lds, gates, P, l, head, tok0, tid);
    const float gmax = scal[0], bL = scal[1];
    vt_store(lds, tid, vraw);
    const float* cw = P.in[I_CONVW] + (size_t)l * 4 * 512;
#pragma unroll
    for (int it = 0; it < 2; ++it) { const int idx = tid + it * NTHREADS, s = idx & 127, cg = idx >> 7;
        float o[8]; conv8_finish(kraw[it], cw, c * L + s, 1, head, cg * 8, o);
        const float ws = __expf(G2[s] - gmax);
#pragma unroll
        for (int e = 0; e < 8; ++e) *(LAS unsigned short*)(lds + OFF_KT + (cg * 8 + e) * TP + s * 2) = bf1(o[e] * ws); }
    __syncthreads();
    const int kt = wid >> 1;
    float* CL = (float*)(wsm + O_CL) + (size_t)u * 4096;
#pragma unroll
    for (int i = 0; i < 2; ++i) { const int vt = (wid & 1) * 2 + i; f32x4 acc = {0.f, 0.f, 0.f, 0.f};
#pragma unroll
        for (int ks = 0; ks < 4; ++ks) { const bf16x8 a = *(const LAS bf16x8*)(lds + OFF_KT + (16 * kt + r) * TP + (32 * ks + 8 * qd) * 2), bb = *(const LAS bf16x8*)(lds + OFF_VT + (16 * vt + r) * TP + (32 * ks + 8 * qd) * 2);
            acc = mfma16(a, bb, acc); }
        *(f32x4*)(CL + (size_t)(16 * vt + r) * 64 + 16 * kt + 4 * qd) = acc; }
    if (tid < 64) { float sum = 0.f;
        for (int s2 = 0; s2 < 128; s2 += 2) { const unsigned w2 = *(const LAS unsigned*)(lds + OFF_KT + tid * TP + s2 * 2); sum += bf_lo(w2) + bf_hi(w2); }
        ((float*)(wsm + O_NL))[(size_t)u * 64 + tid] = sum; }
    if (tid == 0) { ((float*)(wsm + O_MLOC))[u] = bL + gmax; ((float*)(wsm + O_BL))[u] = bL; }
}
__device__ __forceinline__ void p2_scan(unsigned char* wsm) {
    const int tid = tid_opaque();
    const float* CL = (const float*)(wsm + O_CL); const float* NL = (const float*)(wsm + O_NL); const float* MLOC = (const float*)(wsm + O_MLOC); const float* BL = (const float*)(wsm + O_BL);
    bf16_t* CST = (bf16_t*)(wsm + O_CST); float* NST = (float*)(wsm + O_NST); float* MST = (float*)(wsm + O_MST);
    for (int idx = blockIdx.x * NTHREADS + tid; idx < 32 * 4096; idx += gridDim.x * NTHREADS) {
        const int bh = idx >> 12, e = idx & 4095;
        float C = 0.f, nn = 0.f, m = 0.f;
#pragma unroll 1
        for (int c0 = 0; c0 < NCH; c0 += 16) {
            float cl[16], ml_[16], bl[16], nl[16];
#pragma unroll
            for (int i = 0; i < 16; ++i) { const int u = bh * NCH + c0 + i; cl[i] = CL[(size_t)u * 4096 + e]; ml_[i] = MLOC[u]; bl[i] = BL[u]; nl[i] = NL[(size_t)u * 64 + (e & 63)]; }
            unsigned short cs[16]; float ns[16], ms[16];
#pragma unroll
            for (int i = 0; i < 16; ++i) { cs[i] = bf1(C); ns[i] = nn; ms[i] = m;
                const float mn = fmaxf(bl[i] + m, ml_[i]), dec = __expf(bl[i] + m - mn), wl = __expf(ml_[i] - mn);
                C = dec * C + wl * cl[i]; nn = dec * nn + wl * nl[i]; m = mn; }
#pragma unroll
            for (int i = 0; i < 16; ++i) { const int u = bh * NCH + c0 + i; CST[(size_t)u * 4096 + e] = cs[i]; if (e < 64) NST[(size_t)u * 64 + e] = ns[i]; if (e == 0) MST[u] = ms[i]; }
        }
    }
}
__device__ __forceinline__ void p3_unit(LAS unsigned char* lds, const bf16_t* z, const float* gates, const Params& P, int l, int u, const unsigned char* wsm, bf16_t* mix) {
    const int tid = tid_opaque(), lane = tid & 63, wid = __builtin_amdgcn_readfirstlane(tid >> 6), r = lane & 15, qd = lane >> 4;
    const int b = u >> 8, head = (u >> 6) & 3, c = u & 63, tok0 = b * S + c * L;
    LAS float* Bc = (LAS float*)(lds + OFF_F) + 256; LAS float* G2 = (LAS float*)(lds + OFF_F) + 384;
    u32x4 vraw[2], qkraw[4][4];
    vt_load(z, head, tok0, tid, vraw);
#pragma unroll
    for (int it = 0; it < 4; ++it) { const int idx = tid + it * NTHREADS; conv8_load(z, b, c * L + ((idx >> 3) & 127), idx >> 10, head, (idx & 7) * 8, qkraw[it]); }
    __syncthreads();
    stage_gates(lds, gates, P, l, head, tok0, tid);
    vt_store(lds, tid, vraw);
    const float* cw = P.in[I_CONVW] + (size_t)l * 4 * 512;
#pragma unroll
    for (int it = 0; it < 4; ++it) { const int idx = tid + it * NTHREADS, which = idx >> 10, s = (idx >> 3) & 127, cg = idx & 7;
        float o[8]; conv8_finish(qkraw[it], cw, c * L + s, which, head, cg * 8, o);
        u32x4 w; w.x = pg8::cvt_pk_bf16(o[0], o[1]); w.y = pg8::cvt_pk_bf16(o[2], o[3]); w.z = pg8::cvt_pk_bf16(o[4], o[5]); w.w = pg8::cvt_pk_bf16(o[6], o[7]);
        *(LAS u32x4*)(lds + (which ? OFF_K : OFF_Q) + s * QP + cg * 16) = w; }
    __syncthreads();
    const int w = wid, t = 16 * w + r;
    const bf16x8 bq0 = *(const LAS bf16x8*)(lds + OFF_Q + t * QP + qd * 16), bq1 = *(const LAS bf16x8*)(lds + OFF_Q + t * QP + 64 + qd * 16);
    f32x4 accS[8];
#pragma unroll
    for (int ct = 0; ct < 8; ++ct) { accS[ct] = (f32x4){0.f, 0.f, 0.f, 0.f};
        if (ct <= w) { const bf16x8 a0 = *(const LAS bf16x8*)(lds + OFF_K + (16 * ct + r) * QP + qd * 16), a1 = *(const LAS bf16x8*)(lds + OFF_K + (16 * ct + r) * QP + 64 + qd * 16);
            accS[ct] = mfma16(a0, bq0, accS[ct]); accS[ct] = mfma16(a1, bq1, accS[ct]); } }
    const float bt = Bc[t], mst = ((const float*)(wsm + O_MST))[u];
    float ld[8][4]; float mloc = -3.0e38f;
#pragma unroll
    for (int ct = 0; ct < 8; ++ct) { const f32x4 g = *(const LAS f32x4*)(G2 + 16 * ct + 4 * qd);
#pragma unroll
        for (int j = 0; j < 4; ++j) { const bool valid = (ct < w) || (ct == w && 4 * qd + j <= r); ld[ct][j] = valid ? bt + g[j] : -3.0e38f; mloc = fmaxf(mloc, ld[ct][j]); } }
    mloc = fmaxf(mloc, __shfl_xor(mloc, 16)); mloc = fmaxf(mloc, __shfl_xor(mloc, 32));
    const float mt = fmaxf(bt + mst, mloc);
    float den = 0.f;
#pragma unroll
    for (int ct = 0; ct < 8; ++ct)
#pragma unroll
        for (int j = 0; j < 4; ++j) { const float pe = __expf(ld[ct][j] - mt) * accS[ct][j]; accS[ct][j] = pe; den += pe; }
    den += __shfl_xor(den, 16); den += __shfl_xor(den, 32);
    const bf16_t* cst = (const bf16_t*)(wsm + O_CST) + (size_t)u * 4096; const float* nst = (const float*)(wsm + O_NST) + (size_t)u * 64;
    f32x4 accN[4];
#pragma unroll
    for (int dt = 0; dt < 4; ++dt) { const bf16x8 c0 = *(const bf16x8*)(cst + (16 * dt + r) * 64 + 8 * qd), c1 = *(const bf16x8*)(cst + (16 * dt + r) * 64 + 32 + 8 * qd);
        accN[dt] = mfma16(c0, bq0, (f32x4){0.f, 0.f, 0.f, 0.f}); accN[dt] = mfma16(c1, bq1, accN[dt]); }
    const float winter = __expf(bt + mst - mt);
    float nq = 0.f;
    { const float4 n0 = *(const float4*)(nst + 8 * qd), n1 = *(const float4*)(nst + 8 * qd + 4), n2 = *(const float4*)(nst + 32 + 8 * qd), n3 = *(const float4*)(nst + 36 + 8 * qd);
      const u32x4 q0 = __builtin_bit_cast(u32x4, bq0), q1 = __builtin_bit_cast(u32x4, bq1);
      nq = bf_lo(q0.x) * n0.x + bf_hi(q0.x) * n0.y + bf_lo(q0.y) * n0.z + bf_hi(q0.y) * n0.w + bf_lo(q0.z) * n1.x + bf_hi(q0.z) * n1.y + bf_lo(q0.w) * n1.z + bf_hi(q0.w) * n1.w
         + bf_lo(q1.x) * n2.x + bf_hi(q1.x) * n2.y + bf_lo(q1.y) * n2.z + bf_hi(q1.y) * n2.w + bf_lo(q1.z) * n3.x + bf_hi(q1.z) * n3.y + bf_lo(q1.w) * n3.z + bf_hi(q1.w) * n3.w; }
    nq += __shfl_xor(nq, 16); nq += __shfl_xor(nq, 32);
    den += winter * nq;
#pragma unroll
    for (int dt = 0; dt < 4; ++dt) accN[dt] = accN[dt] * winter;
#pragma unroll
    for (int kk = 0; kk < 4; ++kk) if (2 * kk <= w) {
        u32x4 pw; pw.x = pg8::cvt_pk_bf16(accS[2 * kk][0], accS[2 * kk][1]); pw.y = pg8::cvt_pk_bf16(accS[2 * kk][2], accS[2 * kk][3]);
        pw.z = pg8::cvt_pk_bf16(accS[2 * kk + 1][0], accS[2 * kk + 1][1]); pw.w = pg8::cvt_pk_bf16(accS[2 * kk + 1][2], accS[2 * kk + 1][3]);
        const bf16x8 pf = __builtin_bit_cast(bf16x8, pw);
#pragma unroll
        for (int dt = 0; dt < 4; ++dt) { const u32x2 v0 = *(const LAS u32x2*)(lds + OFF_VT + (16 * dt + r) * TP + (32 * kk + 4 * qd) * 2), v1 = *(const LAS u32x2*)(lds + OFF_VT + (16 * dt + r) * TP + (32 * kk + 16 + 4 * qd) * 2);
            u32x4 vw; vw.x = v0.x; vw.y = v0.y; vw.z = v1.x; vw.w = v1.y;
            accN[dt] = mfma16(__builtin_bit_cast(bf16x8, vw), pf, accN[dt]); } }
    const float inv = 1.f / fmaxf(fabsf(den), __expf(-mt));
    float ss = 0.f;
#pragma unroll
    for (int dt = 0; dt < 4; ++dt) { accN[dt] = accN[dt] * inv; ss += accN[dt][0] * accN[dt][0] + accN[dt][1] * accN[dt][1] + accN[dt][2] * accN[dt][2] + accN[dt][3] * accN[dt][3]; }
    ss += __shfl_xor(ss, 16); ss += __shfl_xor(ss, 32);
    const float rs = rsqrtf(ss * (1.f / 64.f) + EPS);
    const float* ng = P.in[I_MNG] + l * 256 + head * 64; const bf16_t* cop = z + (size_t)(tok0 + t) * ZW + ZCO + head * 64;
    bf16_t* op = mix + (size_t)(tok0 + t) * D + 512 + head * 64;
#pragma unroll
    for (int dt = 0; dt < 4; ++dt) { const int d0 = 16 * dt + 4 * qd; const float4 g = *(const float4*)(ng + d0); const u32x2 cw2 = *(const u32x2*)(cop + d0); const float4 co = make_float4(bf_lo(cw2.x), bf_hi(cw2.x), bf_lo(cw2.y), bf_hi(cw2.y));
        u32x2 o; o.x = pg8::cvt_pk_bf16(accN[dt][0] * rs * g.x / (1.f + __expf(-co.x)), accN[dt][1] * rs * g.y / (1.f + __expf(-co.y)));
        o.y = pg8::cvt_pk_bf16(accN[dt][2] * rs * g.z / (1.f + __expf(-co.z)), accN[dt][3] * rs * g.w / (1.f + __expf(-co.w)));
        *(u32x2*)(op + d0) = o; }
}
static_assert(O_END <= 64 * MiB && LDS_END <= 128 * 1024, "mLSTM scratch fits");
}

namespace s5 {
using pg8::bf16x8; using pg8::f32x4; using pg8::u32x4; using pg8::u32x2;
constexpr int LC = 16, NINST = NTOK / LC;
constexpr size_t O_E = 0, O_XC = O_E + (size_t)NINST * 16 * 128 * 4, O_END = O_XC + (size_t)NINST * 16 * 128 * 2;
constexpr int YP = 528;
__device__ __forceinline__ f32x4 mfma16(bf16x8 a, bf16x8 b, f32x4 c) { return __builtin_amdgcn_mfma_f32_16x16x32_bf16(a, b, c, 0, 0, 0); }

__device__ __forceinline__ void build_tables(float* ldsf, const Params& P, int l, int g, unsigned char* tb) {
    const int tid = tid_opaque();
    float* apw = ldsf; float* bb = apw + 17 * 64 * 2; float* cc = bb + 64 * 16 * 2;
    __syncthreads();
    if (tid < 64) { const int gp = (l * 16 + g) * 64 + tid;
        const float ar = P.in[I_ARE][gp], ai = P.in[I_AIM][gp], dt = expf(P.in[I_LDT][l * 16 + g]);
        for (int tau = 0; tau <= 16; ++tau) { const float er = expf(ar * dt * tau), ang = ai * dt * tau; apw[(tau * 64 + tid) * 2] = er * cosf(ang); apw[(tau * 64 + tid) * 2 + 1] = er * sinf(ang); }
        const float abr = apw[(64 + tid) * 2], abi = apw[(64 + tid) * 2 + 1];
        const float xr_ = abr - 1.f, xi_ = abi, den = ar * ar + ai * ai;
        const float cr = (xr_ * ar + xi_ * ai) / den, ci = (xi_ * ar - xr_ * ai) / den;
        for (int h = 0; h < 16; ++h) { const float br = P.in[I_BRE][(size_t)gp * 16 + h], bi = P.in[I_BIM][(size_t)gp * 16 + h]; bb[(tid * 16 + h) * 2] = cr * br - ci * bi; bb[(tid * 16 + h) * 2 + 1] = cr * bi + ci * br; }
        float* a16 = (float*)(tb + T_A16) + (size_t)(g * 64 + tid) * 2; a16[0] = apw[(16 * 64 + tid) * 2]; a16[1] = apw[(16 * 64 + tid) * 2 + 1]; }
    for (int idx = tid; idx < 16 * 64; idx += NTHREADS) { const int h = idx >> 6, p = idx & 63; const int ci_ = ((l * 16 + g) * 16 + h) * 64 + p; cc[idx * 2] = P.in[I_CRE][ci_]; cc[idx * 2 + 1] = P.in[I_CIM][ci_]; }
    __syncthreads();
    bf16_t* KM = (bf16_t*)(tb + T_KMAT) + (size_t)g * 32 * 256;
    for (int idx = tid; idx < 15 * 256; idx += NTHREADS) KM[idx] = (bf16_t)0; bf16_t* FT = (bf16_t*)(tb + T_F) + (size_t)g * 256 * 128; bf16_t* GT = (bf16_t*)(tb + T_G) + (size_t)g * 128 * 256;
    for (int idx = tid; idx < 16 * 256; idx += NTHREADS) { const int tau = idx >> 8, h = (idx >> 4) & 15, hp = idx & 15; float s = 0.f;
        for (int p = 0; p < 64; ++p) { const float cr = cc[(h * 64 + p) * 2], ci = cc[(h * 64 + p) * 2 + 1], ar = apw[(tau * 64 + p) * 2], ai = apw[(tau * 64 + p) * 2 + 1], br = bb[(p * 16 + hp) * 2], bi = bb[(p * 16 + hp) * 2 + 1];
            const float er = ar * br - ai * bi, ei = ar * bi + ai * br; s += cr * er - ci * ei; }
        KM[15 * 256 + idx] = ml::bf1(s); }
    for (int idx = tid; idx < 256 * 64; idx += NTHREADS) { const int n = idx >> 6, p = idx & 63, t = n >> 4, h = n & 15;
        const float cr = cc[(h * 64 + p) * 2], ci = cc[(h * 64 + p) * 2 + 1], ar = apw[((t + 1) * 64 + p) * 2], ai = apw[((t + 1) * 64 + p) * 2 + 1];
        FT[(size_t)n * 128 + p] = ml::bf1(cr * ar - ci * ai); FT[(size_t)n * 128 + 64 + p] = ml::bf1(-(cr * ai + ci * ar)); }
    for (int idx = tid; idx < 64 * 256; idx += NTHREADS) { const int p = idx >> 8, k = idx & 255, s = k >> 4, hp = k & 15;
        const float ar = apw[((15 - s) * 64 + p) * 2], ai = apw[((15 - s) * 64 + p) * 2 + 1], br = bb[(p * 16 + hp) * 2], bi = bb[(p * 16 + hp) * 2 + 1];
        GT[(size_t)p * 256 + k] = ml::bf1(ar * br - ai * bi); GT[(size_t)(64 + p) * 256 + k] = ml::bf1(ar * bi + ai * br); }
}
__device__ __forceinline__ void load_u_frags(const bf16_t* z, int tok0, int g, int r, int qd, bf16x8 (&uf)[8]) {
#pragma unroll
    for (int ks = 0; ks < 8; ++ks) uf[ks] = *(const bf16x8*)(z + (size_t)(tok0 + 16 * r + 2 * ks + (qd >> 1)) * ZW + ZSU + 16 * g + 8 * (qd & 1));
}
__device__ __forceinline__ void p1_unit(const bf16_t* z, const unsigned char* tb, int u, unsigned char* wss) {
    const int tid = tid_opaque(), lane = tid & 63, wid = __builtin_amdgcn_readfirstlane(tid >> 6), r = lane & 15, qd = lane >> 4;
    const int tok0 = u * 256, inst0 = u * 16;
    float* E = (float*)(wss + O_E);
#pragma unroll 1
    for (int gi = 0; gi < 2; ++gi) { const int g = 2 * wid + gi;
        bf16x8 uf[8]; load_u_frags(z, tok0, g, r, qd, uf);
        const bf16_t* GT = (const bf16_t*)(tb + T_G) + (size_t)g * 128 * 256 + (size_t)r * 256 + 8 * qd;
        bf16x8 gf[2][8];
#pragma unroll
        for (int ks = 0; ks < 8; ++ks) gf[0][ks] = *(const bf16x8*)(GT + 32 * ks);
#pragma unroll
        for (int nt = 0; nt < 8; ++nt) {
            if (nt + 1 < 8) {
#pragma unroll
                for (int ks = 0; ks < 8; ++ks) gf[(nt + 1) & 1][ks] = *(const bf16x8*)(GT + (size_t)(16 * (nt + 1)) * 256 + 32 * ks); }
            __builtin_amdgcn_sched_barrier(0);
            f32x4 acc = {0.f, 0.f, 0.f, 0.f};
#pragma unroll
            for (int ks = 0; ks < 8; ++ks) acc = mfma16(gf[nt & 1][ks], uf[ks], acc);
            *(f32x4*)(E + ((size_t)(inst0 + r) * 16 + g) * 128 + 16 * nt + 4 * qd) = acc;
            __builtin_amdgcn_sched_barrier(0); }
    }
}
__device__ __forceinline__ void p2_scan(LAS unsigned char* lds, const unsigned char* tb, unsigned char* wss) {
    const int tid = tid_opaque(), p = tid & 63, seg = tid >> 6;
    const float* __restrict__ E = (const float*)(wss + O_E); bf16_t* __restrict__ XC = (bf16_t*)(wss + O_XC);
    LAS float* SE = (LAS float*)lds;
    for (int u = blockIdx.x; u < NB * 16; u += gridDim.x) {
        const int b = u >> 4, g = u & 15;
        const float* a16 = (const float*)(tb + T_A16) + (size_t)(g * 64 + p) * 2; const float ar = a16[0], ai = a16[1];
        const size_t o0 = ((size_t)(b * (S / LC) + seg * 64) * 16 + g) * 128 + p; constexpr size_t cs = (size_t)16 * 128;
        float xr = 0.f, xi = 0.f;
#pragma unroll 1
        for (int c0 = 0; c0 < 64; c0 += 16) { float er[16], ei[16];
#pragma unroll
            for (int i = 0; i < 16; ++i) { er[i] = E[o0 + (c0 + i) * cs]; ei[i] = E[o0 + (c0 + i) * cs + 64]; }
#pragma unroll
            for (int i = 0; i < 16; ++i) { const float nr = ar * xr - ai * xi + er[i], ni = ar * xi + ai * xr + ei[i]; xr = nr; xi = ni; } }
        __syncthreads();
        SE[(seg * 64 + p) * 2] = xr; SE[(seg * 64 + p) * 2 + 1] = xi;
        __syncthreads();
        float br = ar, bi = ai;
#pragma unroll
        for (int i = 0; i < 6; ++i) { const float nr = br * br - bi * bi, ni = 2.f * br * bi; br = nr; bi = ni; }
        xr = 0.f; xi = 0.f;
        for (int s2 = 0; s2 < seg; ++s2) { const float er = SE[(s2 * 64 + p) * 2], ei = SE[(s2 * 64 + p) * 2 + 1]; const float nr = br * xr - bi * xi + er, ni = br * xi + bi * xr + ei; xr = nr; xi = ni; }
#pragma unroll 1
        for (int c0 = 0; c0 < 64; c0 += 16) { float er[16], ei[16]; unsigned short sr[16], si[16];
#pragma unroll
            for (int i = 0; i < 16; ++i) { er[i] = E[o0 + (c0 + i) * cs]; ei[i] = E[o0 + (c0 + i) * cs + 64]; }
#pragma unroll
            for (int i = 0; i < 16; ++i) { sr[i] = ml::bf1(xr); si[i] = ml::bf1(xi); const float nr = ar * xr - ai * xi + er[i], ni = ar * xi + ai * xr + ei[i]; xr = nr; xi = ni; }
#pragma unroll
            for (int i = 0; i < 16; ++i) { XC[o0 + (c0 + i) * cs] = sr[i]; XC[o0 + (c0 + i) * cs + 64] = si[i]; } }
    }
    __syncthreads();
}
__device__ __forceinline__ void p3_unit(LAS unsigned char* lds, const bf16_t* z, const Params& P, int l, const unsigned char* tb, int u, const unsigned char* wss, bf16_t* mix) {
    const int tid = tid_opaque(), lane = tid & 63, wid = __builtin_amdgcn_readfirstlane(tid >> 6), r = lane & 15, qd = lane >> 4;
    const int tok0 = u * 256, inst0 = u * 16;
    const bf16_t* XC = (const bf16_t*)(wss + O_XC);
    __syncthreads();
#pragma unroll 1
    for (int gi = 0; gi < 2; ++gi) { const int g = 2 * wid + gi;
        bf16x8 uf[8]; load_u_frags(z, tok0, g, r, qd, uf);
        bf16x8 xf[4];
#pragma unroll
        for (int ks = 0; ks < 4; ++ks) xf[ks] = *(const bf16x8*)(XC + ((size_t)(inst0 + r) * 16 + g) * 128 + 32 * ks + 8 * qd);
        const bf16_t* KM = (const bf16_t*)(tb + T_KMAT) + (size_t)g * 32 * 256 + (size_t)(15 - (qd >> 1)) * 256 + r * 16 + 8 * (qd & 1);
        const bf16_t* FT = (const bf16_t*)(tb + T_F) + (size_t)g * 256 * 128 + (size_t)r * 128 + 8 * qd;
        const bf16_t* up = z + (size_t)(tok0 + 16 * r) * ZW + ZSU + 16 * g + 4 * qd;
        const float4 dsk = *(const float4*)(P.in[I_SD] + l * 256 + g * 16 + 4 * qd);
        bf16x8 kf[2][8], ff[2][4]; u32x2 uw[2];
#pragma unroll
        for (int ks = 0; ks < 8; ++ks) kf[0][ks] = *(const bf16x8*)(KM + (ptrdiff_t)(0 - 2 * ks) * 256);
#pragma unroll
        for (int ks = 0; ks < 4; ++ks) ff[0][ks] = *(const bf16x8*)(FT + 32 * ks);
        uw[0] = *(const u32x2*)up;
#pragma unroll
        for (int t = 0; t < 16; ++t) {
            if (t + 1 < 16) {
#pragma unroll
                for (int ks = 0; ks < 8; ++ks) kf[(t + 1) & 1][ks] = *(const bf16x8*)(KM + (ptrdiff_t)(t + 1 - 2 * ks) * 256);
#pragma unroll
                for (int ks = 0; ks < 4; ++ks) ff[(t + 1) & 1][ks] = *(const bf16x8*)(FT + (size_t)(t + 1) * 16 * 128 + 32 * ks);
                uw[(t + 1) & 1] = *(const u32x2*)(up + (size_t)(t + 1) * ZW); }
            __builtin_amdgcn_sched_barrier(0);
            f32x4 acc = {0.f, 0.f, 0.f, 0.f};
#pragma unroll
            for (int ks = 0; ks < 8; ++ks) if (2 * ks <= t) acc = mfma16(kf[t & 1][ks], uf[ks], acc);
#pragma unroll
            for (int ks = 0; ks < 4; ++ks) acc = mfma16(ff[t & 1][ks], xf[ks], acc);
            const u32x2 uu = uw[t & 1];
            const float y0 = gelu_tanh(acc[0] + dsk.x * ml::bf_lo(uu.x)), y1 = gelu_tanh(acc[1] + dsk.y * ml::bf_hi(uu.x)), y2 = gelu_tanh(acc[2] + dsk.z * ml::bf_lo(uu.y)), y3 = gelu_tanh(acc[3] + dsk.w * ml::bf_hi(uu.y));
            u32x2 o; o.x = pg8::cvt_pk_bf16(y0, y1); o.y = pg8::cvt_pk_bf16(y2, y3);
            *(LAS u32x2*)(lds + (16 * r + t) * YP + (16 * g + 4 * qd) * 2) = o;
            __builtin_amdgcn_sched_barrier(0); }
    }
    __syncthreads();
    const bf16_t* GW = (const bf16_t*)(tb + T_GLUW);
    bf16x8 wf[2][8];
#pragma unroll
    for (int nt = 0; nt < 2; ++nt)
#pragma unroll
        for (int ks = 0; ks < 8; ++ks) wf[nt][ks] = *(const bf16x8*)(GW + (size_t)(32 * wid + 16 * nt + r) * 256 + 32 * ks + 8 * qd);
    const float* gb = P.in[I_GLUB] + l * 256;
    const float4 gb0 = *(const float4*)(gb + 32 * wid + 4 * qd), gb1 = *(const float4*)(gb + 32 * wid + 16 + 4 * qd);
#pragma unroll 2
    for (int mt = 0; mt < 16; ++mt) {
        f32x4 a0 = {0.f, 0.f, 0.f, 0.f}, a1 = {0.f, 0.f, 0.f, 0.f};
#pragma unroll
        for (int ks = 0; ks < 8; ++ks) { const bf16x8 yf = *(const LAS bf16x8*)(lds + (16 * mt + r) * YP + (32 * ks + 8 * qd) * 2); a0 = mfma16(wf[0][ks], yf, a0); a1 = mfma16(wf[1][ks], yf, a1); }
        const int row = 16 * mt + r;
        const u32x2 y0 = *(const LAS u32x2*)(lds + row * YP + (32 * wid + 4 * qd) * 2), y1 = *(const LAS u32x2*)(lds + row * YP + (32 * wid + 16 + 4 * qd) * 2);
        bf16_t* op = mix + (size_t)(tok0 + row) * D + 256 + 32 * wid + 4 * qd;
        u32x2 o;
        o.x = pg8::cvt_pk_bf16(ml::bf_lo(y0.x) / (1.f + __expf(-(a0[0] + gb0.x))), ml::bf_hi(y0.x) / (1.f + __expf(-(a0[1] + gb0.y))));
        o.y = pg8::cvt_pk_bf16(ml::bf_lo(y0.y) / (1.f + __expf(-(a0[2] + gb0.z))), ml::bf_hi(y0.y) / (1.f + __expf(-(a0[3] + gb0.w))));
        *(u32x2*)op = o;
        o.x = pg8::cvt_pk_bf16(ml::bf_lo(y1.x) / (1.f + __expf(-(a1[0] + gb1.x))), ml::bf_hi(y1.x) / (1.f + __expf(-(a1[1] + gb1.y))));
        o.y = pg8::cvt_pk_bf16(ml::bf_lo(y1.y) / (1.f + __expf(-(a1[2] + gb1.z))), ml::bf_hi(y1.y) / (1.f + __expf(-(a1[3] + gb1.w))));
        *(u32x2*)(op + 16) = o;
    }
}
static_assert(T_LAYER <= 4 * MiB && O_END <= 48 * MiB && 256 * YP <= LDS_BYTES - 64, "S5 scratch fits");
}
__device__ __forceinline__ void s5_build_tables_fwd(float* ldsf, const Params& P, int l, int g, unsigned char* tb) { s5::build_tables(ldsf, P, l, g, tb); }

namespace at {
using pg8::bf16x8; using pg8::f32x4; using pg8::u32x4; using pg8::u32x2;
constexpr int KP = 144, VP = 528, OFF_K = 0, OFF_VT = 256 * KP, LDS_END = OFF_VT + 64 * VP;
__device__ __forceinline__ void unit(LAS unsigned char* lds, const bf16_t* z, const float* sinks, bf16_t* mix, int u) {
    const int tid = tid_opaque(), lane = tid & 63, wid = __builtin_amdgcn_readfirstlane(tid >> 6), r = lane & 15, qd = lane >> 4;
    const int b = u >> 7, g = (u >> 6) & 1, n = u & 63, tokb = b * S + 128 * n;
    const int hq = 2 * g + (wid >> 2);
    const float sink = sinks[hq];
    __syncthreads();
    u32x4 kw[4], vw[4];
#pragma unroll
    for (int it = 0; it < 4; ++it) { const int idx = tid + it * NTHREADS, kl = idx >> 3, cg = idx & 7; const bool ok = (n > 0) || (kl >= 128);
        kw[it] = *(const u32x4*)(z + (size_t)(ok ? tokb - 128 + kl : tokb) * ZW + ZK + g * 64 + cg * 8); }
#pragma unroll
    for (int it = 0; it < 4; ++it) { const int idx = tid + it * NTHREADS, kl = idx & 255, cg = idx >> 8; const bool ok = (n > 0) || (kl >= 128);
        vw[it] = *(const u32x4*)(z + (size_t)(ok ? tokb - 128 + kl : tokb) * ZW + ZV + g * 64 + cg * 8); }
    __builtin_amdgcn_sched_barrier(0);
#pragma unroll
    for (int it = 0; it < 4; ++it) { const int idx = tid + it * NTHREADS, kl = idx >> 3, cg = idx & 7; const bool ok = (n > 0) || (kl >= 128);
        u32x4 w = kw[it]; if (!ok) w = (u32x4){0u, 0u, 0u, 0u};
        *(LAS u32x4*)(lds + OFF_K + kl * KP + cg * 16) = w; }
#pragma unroll
    for (int it = 0; it < 4; ++it) { const int idx = tid + it * NTHREADS, kl = idx & 255, cg = idx >> 8; const bool ok = (n > 0) || (kl >= 128);
        u32x4 w = vw[it]; if (!ok) w = (u32x4){0u, 0u, 0u, 0u};
        const unsigned ww[4] = {w.x, w.y, w.z, w.w};
#pragma unroll
        for (int e = 0; e < 8; ++e) *(LAS unsigned short*)(lds + OFF_VT + (cg * 8 + e) * VP + kl * 2) = (unsigned short)((e & 1) ? (ww[e >> 1] >> 16) : (ww[e >> 1] & 0xffffu)); }
    __syncthreads();
#pragma unroll 1
    for (int qt = 0; qt < 2; ++qt) {
        const int i0 = (wid & 3) * 32 + qt * 16, kt0 = i0 >> 4, tok = tokb + i0 + r;
        const bf16x8 bq0 = *(const bf16x8*)(z + (size_t)tok * ZW + ZQ + hq * 64 + 8 * qd), bq1 = *(const bf16x8*)(z + (size_t)tok * ZW + ZQ + hq * 64 + 32 + 8 * qd);
        f32x4 accS[9];
#pragma unroll
        for (int c = 0; c < 9; ++c) { const int kt = kt0 + c;
            const bf16x8 a0 = *(const LAS bf16x8*)(lds + OFF_K + (16 * kt + r) * KP + qd * 16), a1 = *(const LAS bf16x8*)(lds + OFF_K + (16 * kt + r) * KP + 64 + qd * 16);
            accS[c] = ml::mfma16(a0, bq0, (f32x4){0.f, 0.f, 0.f, 0.f}); accS[c] = ml::mfma16(a1, bq1, accS[c]); }
        float m = sink;
#pragma unroll
        for (int c = 0; c < 9; ++c)
#pragma unroll
            for (int j = 0; j < 4; ++j) { const int e = 4 * qd + j;
                bool valid = (c == 0) ? (e > r) : ((c == 8) ? (e <= r) : true);
                valid = valid && ((n > 0) || (kt0 + c >= 8));
                const float s = valid ? accS[c][j] * 0.125f : -3.0e38f; accS[c][j] = s; m = fmaxf(m, s); }
        m = fmaxf(m, __shfl_xor(m, 16)); m = fmaxf(m, __shfl_xor(m, 32));
        float l = 0.f;
#pragma unroll
        for (int c = 0; c < 9; ++c)
#pragma unroll
            for (int j = 0; j < 4; ++j) { const float p = __expf(accS[c][j] - m); accS[c][j] = p; l += p; }
        l += __shfl_xor(l, 16); l += __shfl_xor(l, 32);
        l += __expf(sink - m);
        f32x4 accO[4];
#pragma unroll
        for (int dt = 0; dt < 4; ++dt) accO[dt] = (f32x4){0.f, 0.f, 0.f, 0.f};
#pragma unroll
        for (int kk = 0; kk < 5; ++kk) {
            u32x4 pw; pw.x = pg8::cvt_pk_bf16(accS[2 * kk][0], accS[2 * kk][1]); pw.y = pg8::cvt_pk_bf16(accS[2 * kk][2], accS[2 * kk][3]);
            if (kk < 4) { pw.z = pg8::cvt_pk_bf16(accS[2 * kk + 1][0], accS[2 * kk + 1][1]); pw.w = pg8::cvt_pk_bf16(accS[2 * kk + 1][2], accS[2 * kk + 1][3]); } else { pw.z = 0u; pw.w = 0u; }
            const bf16x8 pf = __builtin_bit_cast(bf16x8, pw);
            const int base = 16 * (kt0 + 2 * kk);
#pragma unroll
            for (int dt = 0; dt < 4; ++dt) { const u32x2 v0 = *(const LAS u32x2*)(lds + OFF_VT + (16 * dt + r) * VP + (base + 4 * qd) * 2);
                u32x2 v1 = {0u, 0u}; if (kk < 4) v1 = *(const LAS u32x2*)(lds + OFF_VT + (16 * dt + r) * VP + (base + 16 + 4 * qd) * 2);
                u32x4 vw; vw.x = v0.x; vw.y = v0.y; vw.z = v1.x; vw.w = v1.y;
                accO[dt] = ml::mfma16(__builtin_bit_cast(bf16x8, vw), pf, accO[dt]); } }
        const float inv = 1.f / l;
        bf16_t* op = mix + (size_t)tok * D + hq * 64;
#pragma unroll
        for (int dt = 0; dt < 4; ++dt) { u32x2 o; o.x = pg8::cvt_pk_bf16(accO[dt][0] * inv, accO[dt][1] * inv); o.y = pg8::cvt_pk_bf16(accO[dt][2] * inv, accO[dt][3] * inv);
            *(u32x2*)(op + 16 * dt + 4 * qd) = o; }
    }
}
}

namespace sg {
using pg8::bf16x8; using pg8::f32x4; using pg8::u32x4; using pg8::u32x2;
constexpr int TP = 272, OFF_VT = 0, OFF_ST = 256 * TP, LDS_END = OFF_ST + 128 * 4 * 2 * 4;
__device__ __forceinline__ void unit(LAS unsigned char* lds, const bf16_t* z, const Params& P, int l, const bf16_t* wb  , bf16_t* mix, int u) {
    const int tid = tid_opaque(), lane = tid & 63, wid = __builtin_amdgcn_readfirstlane(tid >> 6), r = lane & 15, qd = lane >> 4;
    const int tok0 = u * 128;
    LAS float* ST = (LAS float*)(lds + OFF_ST);
    __syncthreads();
    const int s = tid & 127, cq = tid >> 7;
    const bf16_t* gp = z + (size_t)(tok0 + s) * ZW + ZGV + cq * 64;
    u32x4 raw[8];
#pragma unroll
    for (int i = 0; i < 8; ++i) raw[i] = *(const u32x4*)(gp + 8 * i);
    const int t = 16 * wid + r;
    bf16x8 wf[2][4];
#pragma unroll
    for (int ks = 0; ks < 4; ++ks) wf[0][ks] = *(const bf16x8*)(wb + (size_t)t * 128 + 32 * ks + 8 * qd);
    float sm = 0.f, sq = 0.f;
#pragma unroll
    for (int i = 0; i < 8; ++i) { const unsigned ww[4] = {raw[i].x, raw[i].y, raw[i].z, raw[i].w};
#pragma unroll
        for (int e = 0; e < 8; ++e) { const float ge = gelu_tanh((e & 1) ? bfh(ww[e >> 1]) : bfl(ww[e >> 1])); sm += ge; sq += ge * ge; } }
    ST[(s * 4 + cq) * 2] = sm; ST[(s * 4 + cq) * 2 + 1] = sq;
    __syncthreads();
    { float tsm = 0.f, tsq = 0.f;
#pragma unroll
      for (int q = 0; q < 4; ++q) { tsm += ST[(s * 4 + q) * 2]; tsq += ST[(s * 4 + q) * 2 + 1]; }
      const float mu = tsm * (1.f / 256.f), var = fmaxf(tsq * (1.f / 256.f) - mu * mu, 0.f), rs = rsqrtf(var + EPS);
      const float* lg = P.in[I_LNG] + l * 256 + cq * 64; const float* lb = P.in[I_LNB] + l * 256 + cq * 64;
#pragma unroll
      for (int i = 0; i < 8; ++i) { const unsigned ww[4] = {raw[i].x, raw[i].y, raw[i].z, raw[i].w};
          const float4 g0 = *(const float4*)(lg + 8 * i), g1 = *(const float4*)(lg + 8 * i + 4), b0 = *(const float4*)(lb + 8 * i), b1 = *(const float4*)(lb + 8 * i + 4);
          const float gg[8] = {g0.x, g0.y, g0.z, g0.w, g1.x, g1.y, g1.z, g1.w}, bb[8] = {b0.x, b0.y, b0.z, b0.w, b1.x, b1.y, b1.z, b1.w};
#pragma unroll
          for (int e = 0; e < 8; ++e) *(LAS unsigned short*)(lds + OFF_VT + (cq * 64 + 8 * i + e) * TP + s * 2) = ml::bf1((gelu_tanh((e & 1) ? bfh(ww[e >> 1]) : bfl(ww[e >> 1])) - mu) * rs * gg[e] + bb[e]); } }
    __syncthreads();
#pragma unroll
    for (int g = 0; g < 4; ++g) {
        if (g + 1 < 4) {
#pragma unroll
            for (int ks = 0; ks < 4; ++ks) wf[(g + 1) & 1][ks] = *(const bf16x8*)(wb + ((size_t)(g + 1) * 128 + t) * 128 + 32 * ks + 8 * qd); }
        const float bias = P.in[I_SGUB][l * 512 + g * 128 + t];
        u32x2 gw[4];
#pragma unroll
        for (int ct = 0; ct < 4; ++ct) gw[ct] = *(const u32x2*)(z + (size_t)(tok0 + t) * ZW + ZGU + g * 64 + 16 * ct + 4 * qd);
#pragma unroll
        for (int ct = 0; ct < 4; ++ct) { f32x4 acc = {0.f, 0.f, 0.f, 0.f};
#pragma unroll
            for (int ks = 0; ks < 4; ++ks) if (2 * ks <= wid) acc = ml::mfma16(*(const LAS bf16x8*)(lds + OFF_VT + (g * 64 + 16 * ct + r) * TP + (32 * ks + 8 * qd) * 2), wf[g & 1][ks], acc);
            const int c0 = g * 64 + 16 * ct + 4 * qd;
            u32x2 o; o.x = pg8::cvt_pk_bf16(gelu_tanh(bfl(gw[ct].x)) * (acc[0] + bias), gelu_tanh(bfh(gw[ct].x)) * (acc[1] + bias)); o.y = pg8::cvt_pk_bf16(gelu_tanh(bfl(gw[ct].y)) * (acc[2] + bias), gelu_tanh(bfh(gw[ct].y)) * (acc[3] + bias));
            *(u32x2*)(mix + (size_t)(tok0 + t) * D + 768 + c0) = o; }
    }
}
}

__device__ __forceinline__ void ph_mix1(float* lds, const Params& P, int l, bf16_t* z, const float* gates, bf16_t* mix, unsigned char* wsm, unsigned char* wss, const unsigned char* tb, int sub) {
    const int G = gridDim.x, bid = blockIdx.x;
    if (sub & 1) for (int u = bid; u < ml::NU; u += G) ml::p1_unit((LAS unsigned char*)lds, z, gates, P, l, u, wsm);
    __syncthreads();
    if (sub & 2) for (int u = bid; u < NTOK / 256; u += G) s5::p1_unit(z, tb, u, wss);
    __syncthreads();
    if (sub & 4) for (int u = bid; u < 1024; u += G) at::unit((LAS unsigned char*)lds, z, P.in[I_SINK] + l * 4, mix, u);
    __syncthreads();
    if (sub & 8) for (int u = bid; u < NTOK / 128; u += G) sg::unit((LAS unsigned char*)lds, z, P, l, (const bf16_t*)(tb + s5::T_SGUW), mix, u);
    __syncthreads();
}

__device__ __forceinline__ void ph_mix2(float* lds, const Params& P, int l, const bf16_t* z, const float* gates, bf16_t* mix, const unsigned char* wsm, const unsigned char* wss, const unsigned char* tb, int sub) {
    if (sub & 1) for (int u = blockIdx.x; u < NTOK / 256; u += gridDim.x) s5::p3_unit((LAS unsigned char*)lds, z, P, l, tb, u, wss, mix);
    __syncthreads();
    if (sub & 2) for (int u = blockIdx.x; u < ml::NU; u += gridDim.x) ml::p3_unit((LAS unsigned char*)lds, z, gates, P, l, u, wsm, mix);
    __syncthreads();
}

template <bool SRCF32>
__device__ __forceinline__ void ph_outproj(LAS unsigned char* ldsb, const bf16_t* mix, const bf16_t* wt, const float* xf, bf16_t* xb) {
    pg8::StaticOrder S; S.init(NTOK, D, D, D, gridDim.x, blockIdx.x, mix, wt);
    pg8::EpiResB<SRCF32> E{xf, xb};
    pg8::gemm_phase<pg8::EpiResB<SRCF32>, pg8::StaticOrder, false>(ldsb, D, D, S, E);
}

namespace rp {
using pg8::bf16x8; using pg8::f32x4; using pg8::u32x4;
constexpr size_t T_HI = 0, T_LO = (size_t)48 * D * 2, T_GHI = 2 * T_LO, T_GLO = T_GHI + (size_t)16 * D * 2, T_SIZE = T_GLO + (size_t)16 * D * 2;
static_assert(T_SIZE <= 256 * 1024, "row-pass tables fit their slot");
template <int NT, bool COMBINE> struct StepIn { float4 xa[2], xb[2]; u32x4 xr[2]; u32x4 y1[2], y2[2]; float4 g0, g1; };
template <int NT> struct StepW { bf16x8 wh[NT], wl[NT]; };
__device__ __forceinline__ void build_base(LAS int* base, const unsigned* cnt) {
    __syncthreads();
    if (tid_opaque() == 0) { int b = 0; for (int e = 0; e < NEXP; ++e) { base[e] = b; b += (((int)cnt[e] + 255) >> 8) << 8; } }
    __syncthreads();
}
template <int NT, bool COMBINE, bool XBF>
__device__ __forceinline__ void run(LAS unsigned char* lds, const Params& P, int l, const float* x, bf16_t* xq, const bf16_t* YB, const unsigned* inv, const unsigned* cntprev,
                                    const float* gn, const bf16_t* WH, const bf16_t* WL, bf16_t* XN, float* RS, float* gates, unsigned* cnt, int2* lists, unsigned* invout) {
    const int tid = tid_opaque(), lane = tid & 63, wid = __builtin_amdgcn_readfirstlane(tid >> 6), r = lane & 15, qd = lane >> 4;
    LAS int* BASE = (LAS int*)(lds + 64 * 1024);
    LAS float* LG = (LAS float*)lds + wid * (32 * 49);
    if (COMBINE) build_base(BASE, cntprev);
    LAS unsigned* LCNT = (LAS unsigned*)(lds + 64 * 1024 + 256); LAS unsigned* GBASE = LCNT + 32;
    for (int rb0 = blockIdx.x * 8; rb0 < NTOK / 32; rb0 += gridDim.x * 8) {
        const int rb = rb0 + wid; const bool live = rb < NTOK / 32;
        const int row0 = (live ? rb : rb0) * 32;
        if (NT == 1 && !live) continue;
        size_t yr1[2] = {0, 0}, yr2[2] = {0, 0};
        if (COMBINE) {
#pragma unroll
            for (int mt = 0; mt < 2; ++mt) { const int row = row0 + 16 * mt + r; const unsigned i1 = inv[2 * row], i2 = inv[2 * row + 1];
                yr1[mt] = (size_t)(BASE[i1 >> 16] + (int)(i1 & 0xffffu)) * D; yr2[mt] = (size_t)(BASE[i2 >> 16] + (int)(i2 & 0xffffu)) * D; } }
        f32x4 acc[2][NT];
#pragma unroll
        for (int mt = 0; mt < 2; ++mt)
#pragma unroll
            for (int nt = 0; nt < NT; ++nt) acc[mt][nt] = (f32x4){0.f, 0.f, 0.f, 0.f};
        float ssq[2] = {0.f, 0.f};
        StepIn<NT, COMBINE> sb[3]; StepW<NT> sw[2];
        auto load = [&](StepIn<NT, COMBINE>& s, int ks) {
            const int k0 = 32 * ks + 8 * qd;
#pragma unroll
            for (int mt = 0; mt < 2; ++mt) {
                if (XBF) s.xr[mt] = *(const u32x4*)(xq + (size_t)(row0 + 16 * mt + r) * D + k0);
                else { const float* xp = x + (size_t)(row0 + 16 * mt + r) * D + k0; s.xa[mt] = *(const float4*)xp; s.xb[mt] = *(const float4*)(xp + 4); }
                if (COMBINE) { s.y1[mt] = *(const u32x4*)(YB + yr1[mt] + k0); s.y2[mt] = *(const u32x4*)(YB + yr2[mt] + k0); } }
            s.g0 = *(const float4*)(gn + k0); s.g1 = *(const float4*)(gn + k0 + 4);
        };
        auto loadw = [&](StepW<NT>& s, int ks) {
            const int k0 = 32 * ks + 8 * qd;
#pragma unroll
            for (int nt = 0; nt < NT; ++nt) { s.wh[nt] = *(const bf16x8*)(WH + (size_t)(16 * nt + r) * D + k0); s.wl[nt] = *(const bf16x8*)(WL + (size_t)(16 * nt + r) * D + k0); }
        };
        auto process = [&](const StepIn<NT, COMBINE>& s, const StepW<NT>& sw_, int ks) {
            const int k0 = 32 * ks + 8 * qd;
            bf16x8 xh[2], xl[2];
#pragma unroll
            for (int mt = 0; mt < 2; ++mt) { float4 a = s.xa[mt], b = s.xb[mt];
                if (XBF) { const u32x4 w = s.xr[mt]; a = make_float4(bfl(w.x), bfh(w.x), bfl(w.y), bfh(w.y)); b = make_float4(bfl(w.z), bfh(w.z), bfl(w.w), bfh(w.w)); }
                if (COMBINE) { const u32x4 p = s.y1[mt], q = s.y2[mt];
                    a.x += bfl(p.x) + bfl(q.x); a.y += bfh(p.x) + bfh(q.x); a.z += bfl(p.y) + bfl(q.y); a.w += bfh(p.y) + bfh(q.y);
                    b.x += bfl(p.z) + bfl(q.z); b.y += bfh(p.z) + bfh(q.z); b.z += bfl(p.w) + bfl(q.w); b.w += bfh(p.w) + bfh(q.w);
                    u32x4 o; o.x = pg8::cvt_pk_bf16(a.x, a.y); o.y = pg8::cvt_pk_bf16(a.z, a.w); o.z = pg8::cvt_pk_bf16(b.x, b.y); o.w = pg8::cvt_pk_bf16(b.z, b.w);
                    *(u32x4*)(xq + (size_t)(row0 + 16 * mt + r) * D + k0) = o;
                    a = make_float4(bfl(o.x), bfh(o.x), bfl(o.y), bfh(o.y)); b = make_float4(bfl(o.z), bfh(o.z), bfl(o.w), bfh(o.w)); }
                ssq[mt] += a.x * a.x + a.y * a.y + a.z * a.z + a.w * a.w + b.x * b.x + b.y * b.y + b.z * b.z + b.w * b.w;
                const float v[8] = {a.x * s.g0.x, a.y * s.g0.y, a.z * s.g0.z, a.w * s.g0.w, b.x * s.g1.x, b.y * s.g1.y, b.z * s.g1.z, b.w * s.g1.w};
                u32x4 h; h.x = pg8::cvt_pk_bf16(v[0], v[1]); h.y = pg8::cvt_pk_bf16(v[2], v[3]); h.z = pg8::cvt_pk_bf16(v[4], v[5]); h.w = pg8::cvt_pk_bf16(v[6], v[7]);
                *(u32x4*)(XN + (size_t)(row0 + 16 * mt + r) * D + k0) = h;
                u32x4 lo; lo.x = pg8::cvt_pk_bf16(v[0] - bfl(h.x), v[1] - bfh(h.x)); lo.y = pg8::cvt_pk_bf16(v[2] - bfl(h.y), v[3] - bfh(h.y)); lo.z = pg8::cvt_pk_bf16(v[4] - bfl(h.z), v[5] - bfh(h.z)); lo.w = pg8::cvt_pk_bf16(v[6] - bfl(h.w), v[7] - bfh(h.w));
                xh[mt] = __builtin_bit_cast(bf16x8, h); xl[mt] = __builtin_bit_cast(bf16x8, lo); }
#pragma unroll
            for (int nt = 0; nt < NT; ++nt)
#pragma unroll
                for (int mt = 0; mt < 2; ++mt) { acc[mt][nt] = ml::mfma16(sw_.wh[nt], xh[mt], acc[mt][nt]); acc[mt][nt] = ml::mfma16(sw_.wl[nt], xh[mt], acc[mt][nt]); acc[mt][nt] = ml::mfma16(sw_.wh[nt], xl[mt], acc[mt][nt]); }
        };
        if (COMBINE || NT > 1) {
            load(sb[0], 0); loadw(sw[0], 0);
#pragma unroll 1
            for (int ks = 0; ks < 32; ks += 2) {
                load(sb[1], ks + 1); loadw(sw[1], ks + 1);
                process(sb[0], sw[0], ks);
                if (ks + 2 < 32) { load(sb[0], ks + 2); loadw(sw[0], ks + 2); }
                process(sb[1], sw[1], ks + 1);
            }
        } else {
            load(sb[0], 0); load(sb[1], 1); loadw(sw[0], 0);
#define RP_STEP(i, xs, ws) do { if ((i) + 2 < 32) load(sb[((xs) + 2) % 3], (i) + 2); if ((i) + 1 < 32) loadw(sw[((ws) + 1) % 2], (i) + 1); process(sb[xs], sw[ws], (i)); } while (0)
#pragma unroll 1
            for (int ks = 0; ks < 30; ks += 6) { RP_STEP(ks, 0, 0); RP_STEP(ks + 1, 1, 1); RP_STEP(ks + 2, 2, 0); RP_STEP(ks + 3, 0, 1); RP_STEP(ks + 4, 1, 0); RP_STEP(ks + 5, 2, 1); }
            RP_STEP(30, 0, 0); RP_STEP(31, 1, 1);
#undef RP_STEP
        }
        float rsv[2];
#pragma unroll
        for (int mt = 0; mt < 2; ++mt) { float s = ssq[mt]; s += __shfl_xor(s, 16); s += __shfl_xor(s, 32); rsv[mt] = rsqrtf(s * (1.f / D) + EPS);
            if (qd == 0) RS[row0 + 16 * mt + r] = rsv[mt]; }
        if (NT == 1) {
#pragma unroll
            for (int mt = 0; mt < 2; ++mt) if (qd < 2) { const f32x4 gv = acc[mt][0] * rsv[mt]; *(f32x4*)(gates + (size_t)(row0 + 16 * mt + r) * 8 + 4 * qd) = gv; }
        } else {
            const float* bg = P.in[I_RGB] + l * 4; const float* be = P.in[I_REB] + l * 32;
#pragma unroll
            for (int mt = 0; mt < 2; ++mt)
#pragma unroll
                for (int nt = 0; nt < NT; ++nt)
#pragma unroll
                    for (int j = 0; j < 4; ++j) LG[(16 * mt + r) * 49 + 16 * nt + 4 * qd + j] = acc[mt][nt][j] * rsv[mt];
            wave_lds_fence();
            if (tid < 32) LCNT[tid] = 0u;
            __syncthreads();
            int ex1 = 0, ex2 = 0; float w1 = 0.f, w2 = 0.f; unsigned lp1 = 0u, lp2 = 0u;
            if (lane < 32 && live) {
                const LAS float* lg = LG + lane * 49;
                float gl[4];
#pragma unroll
                for (int j = 0; j < 4; ++j) gl[j] = lg[j] + bg[j];
                int sel = 0; float gm = gl[0];
#pragma unroll
                for (int j = 1; j < 4; ++j) if (gl[j] > gm) { gm = gl[j]; sel = j; }
                float gs = 0.f;
#pragma unroll
                for (int j = 0; j < 4; ++j) gs += expf(gl[j] - gm);
                const float pg = 1.f / gs;
                float ein[8];
#pragma unroll
                for (int j = 0; j < 8; ++j) ein[j] = lg[4 + sel * 8 + j] + be[sel * 8 + j];
                int i1 = 0; float v1 = ein[0];
#pragma unroll
                for (int j = 1; j < 8; ++j) if (ein[j] > v1) { v1 = ein[j]; i1 = j; }
                int i2 = -1; float v2 = -3.0e38f;
#pragma unroll
                for (int j = 0; j < 8; ++j) if (j != i1 && ein[j] > v2) { v2 = ein[j]; i2 = j; }
                const float e2 = expf(v2 - v1), den = 1.f / (1.f + e2);
                w1 = den * pg; w2 = e2 * den * pg;
                ex1 = sel * 8 + i1; ex2 = sel * 8 + i2;
                lp1 = atomicAdd((unsigned*)&LCNT[ex1], 1u); lp2 = atomicAdd((unsigned*)&LCNT[ex2], 1u);
            }
            __syncthreads();
            if (tid < 32) { const unsigned c = LCNT[tid]; GBASE[tid] = c ? atomicAdd(&cnt[tid], c) : 0u; }
            __syncthreads();
            if (lane < 32 && live) { const int row = row0 + lane; const unsigned p1 = GBASE[ex1] + lp1, p2 = GBASE[ex2] + lp2;
                lists[(size_t)ex1 * NTOK + p1] = make_int2(row, __float_as_int(w1));
                lists[(size_t)ex2 * NTOK + p2] = make_int2(row, __float_as_int(w2));
                invout[2 * row] = ((unsigned)ex1 << 16) | p1; invout[2 * row + 1] = ((unsigned)ex2 << 16) | p2; }
        }
    }
}
__device__ __forceinline__ void final_norm(LAS unsigned char* lds, const bf16_t* xb, float* out, const bf16_t* YB, const unsigned* inv, const unsigned* cntprev, const float* g) {
    const int tid = tid_opaque(), wave = tid >> 6, lane = tid & 63;
    LAS int* BASE = (LAS int*)(lds + 64 * 1024);
    build_base(BASE, cntprev);
    const float4* g4 = (const float4*)g;
    for (int r = blockIdx.x * 8 + wave; r < NTOK; r += gridDim.x * 8) {
        const unsigned i1 = inv[2 * r], i2 = inv[2 * r + 1];
        const bf16_t* y1 = YB + (size_t)(BASE[i1 >> 16] + (int)(i1 & 0xffffu)) * D; const bf16_t* y2 = YB + (size_t)(BASE[i2 >> 16] + (int)(i2 & 0xffffu)) * D;
        const u32x2_t* xp = (const u32x2_t*)(xb + (size_t)r * D);
        float4 v[4]; float ss = 0.f;
#pragma unroll
        for (int i = 0; i < 4; ++i) { const u32x2_t xw = xp[lane + 64 * i], a = *((const u32x2_t*)y1 + lane + 64 * i), b = *((const u32x2_t*)y2 + lane + 64 * i);
            v[i].x = bfl(xw.x) + bfl(a.x) + bfl(b.x); v[i].y = bfh(xw.x) + bfh(a.x) + bfh(b.x); v[i].z = bfl(xw.y) + bfl(a.y) + bfl(b.y); v[i].w = bfh(xw.y) + bfh(a.y) + bfh(b.y);
            ss += v[i].x * v[i].x + v[i].y * v[i].y + v[i].z * v[i].z + v[i].w * v[i].w; }
        ss = wave_sum(ss);
        const float rs = rsqrtf(ss * (1.f / D) + EPS);
        float4* p = (float4*)(out + (size_t)r * D);
#pragma unroll
        for (int i = 0; i < 4; ++i) { const float4 gg = g4[lane + 64 * i]; float4 o; o.x = v[i].x * rs * gg.x; o.y = v[i].y * rs * gg.y; o.z = v[i].z * rs * gg.z; o.w = v[i].w * rs * gg.w; p[lane + 64 * i] = o; }
    }
}
}

__device__ __forceinline__ int moe_build_tab(LAS unsigned char* ldsb, const unsigned* cnt) {
    LAS pg8::i32x4* tab = (LAS pg8::i32x4*)(ldsb + TAB_OFF);
    __syncthreads();
    int base = 0;
#pragma unroll 1
    for (int e = 0; e < NEXP; ++e) { const int c = __builtin_amdgcn_readfirstlane((int)cnt[e]), nt = (c + 255) >> 8;
        if ((int)tid_opaque() < nt) tab[base + tid_opaque()] = (pg8::i32x4){e, (int)tid_opaque() * 256, c, 0};
        base += nt; }
    __syncthreads();
    return base;
}
__device__ __forceinline__ void ph_moe1(LAS unsigned char* ldsb, const Params& P, int l, const bf16_t* H, const unsigned* cnt, const int2* lists, bf16_t* act) {
    const int ntiles = moe_build_tab(ldsb, cnt);
    pg8::MoeOrder S; S.tab = (const LAS pg8::i32x4*)(ldsb + TAB_OFF); S.ntiles = ntiles; S.npn = 4; S.G = gridDim.x; S.c = blockIdx.x;
    S.A = (const char*)H; S.atile = 0; S.Bt = (const char*)(P.ws + WS_WGU) + (size_t)l * NEXP * 1024 * D * 2; S.bexp = (size_t)1024 * D * 2; S.btile = (size_t)256 * D * 2; S.lists = lists;
    pg8::EpiAct E{act, lists, (const float*)(P.ws + WS_RS)};
    pg8::gemm_phase<pg8::EpiAct, pg8::MoeOrder, true>(ldsb, D, D, S, E);
}
__device__ __forceinline__ void ph_moe2(LAS unsigned char* ldsb, const Params& P, int l, const bf16_t* act, const unsigned* cnt, const int2* lists, bf16_t* yb) {
    const int ntiles = moe_build_tab(ldsb, cnt);
    pg8::MoeOrder S; S.tab = (const LAS pg8::i32x4*)(ldsb + TAB_OFF); S.ntiles = ntiles; S.npn = 4; S.G = gridDim.x; S.c = blockIdx.x;
    S.A = (const char*)act; S.atile = (size_t)256 * DE * 2; S.Bt = (const char*)(P.ws + WS_WD) + (size_t)l * NEXP * D * DE * 2; S.bexp = (size_t)D * DE * 2; S.btile = (size_t)256 * DE * 2; S.lists = lists;
    pg8::EpiY E{yb, lists};
    pg8::gemm_phase<pg8::EpiY, pg8::MoeOrder, false>(ldsb, DE, DE, S, E);
}

#ifndef PROBE_PH
#define PROBE_PH -1
#endif
#ifndef PROBE_SUB
#define PROBE_SUB 15
#endif
#ifndef PROBE_REPS
#define PROBE_REPS 4
#endif
__global__ void __launch_bounds__(NTHREADS, 2) fwd_kernel(Params P) {
    extern __shared__ __attribute__((aligned(16))) unsigned char lds_raw[];
    float* lds = (float*)lds_raw;
    volatile LAS unsigned* xbw = (volatile LAS unsigned*)(lds_raw + LDS_BYTES - 16);
    if (threadIdx.x == 0) { xbw[0] = 0u; xbw[1] = 0u; }
    __syncthreads();
    unsigned char* const ws = P.ws;
    unsigned* ctl = (unsigned*)(ws + WS_CTL);
    const bool multi = (P.ph_hi - P.ph_lo) > 1;
    XcdBarrier bar; bar.bar = ctl; bar.x = 0; bar.st = xbw;
    if (multi) bar = xcd_barrier_post(ctl, xbw);
    bf16_t* z = (bf16_t*)(ws + WS_Z); float* gates = (float*)(ws + WS_GATES); unsigned char* wss = ws + WS_S5; bf16_t* mix = (bf16_t*)(ws + WS_MIX); unsigned char* wsm = ws + WS_HRAW;
    bf16_t* H = (bf16_t*)(ws + WS_H); bf16_t* act = (bf16_t*)(ws + WS_ACT); bf16_t* yb = (bf16_t*)(ws + WS_YB); bf16_t* xbuf = (bf16_t*)(ws + WS_XB); float* rsb = (float*)(ws + WS_RS);
    int2* lists = (int2*)(ws + WS_LIST);
    LAS unsigned char* ldsb = (LAS unsigned char*)lds_raw;
    const int lo = P.ph_lo, hi = P.ph_hi;
#define IN(k) (lo <= (k) && (k) < hi)
#define SEAM(k) do { if (IN(k) && IN((k) + 1)) xcd_barrier(bar); } while (0)
#if PROBE_PH >= 0
#define RUNPH(k, ...) do { if (IN(k)) { const int nrep = ((k) == PROBE_PH) ? 1 + PROBE_REPS : 1; for (int rep = 0; rep < nrep; ++rep) { __VA_ARGS__; if (rep + 1 < nrep) xcd_barrier(bar); } } SEAM(k); } while (0)
#else
#define RUNPH(k, ...) do { if (IN(k)) { constexpr int rep = 0; (void)rep; __VA_ARGS__; } SEAM(k); } while (0)
#endif
    RUNPH(0, ph_prologue(lds, PF));
    for (int l = 0; l < NLAYER; ++l) {
        const int pb = 1 + l * PH_PER_LAYER;
        unsigned* cnt = ctl + CW_CNT + l * 64;
        const unsigned char* tb = ws + WS_TB + (size_t)l * 4 * MiB;
        const unsigned char* rtb = ws + WS_RT + (size_t)l * 256 * 1024;
        unsigned* inv = (unsigned*)(ws + WS_INV) + (size_t)l * NTOK * 2;
        RUNPH(pb + 0, { const Params& Q = PF;
            if (l == 0) rp::run<1, false, false>(ldsb, Q, l, Q.in[I_X], nullptr, nullptr, nullptr, nullptr, Q.in[I_NMG] + l * D, (const bf16_t*)(rtb + rp::T_GHI), (const bf16_t*)(rtb + rp::T_GLO), mix, rsb, gates, nullptr, nullptr, nullptr);
            else        rp::run<1, true, true>(ldsb, Q, l, nullptr, xbuf, yb, inv - (size_t)NTOK * 2, cnt - 64, Q.in[I_NMG] + l * D, (const bf16_t*)(rtb + rp::T_GHI), (const bf16_t*)(rtb + rp::T_GLO), mix, rsb, gates, nullptr, nullptr, nullptr); });
        RUNPH(pb + 1, ph_inproj(ldsb, mix, (const bf16_t*)(ws + WS_WIN) + (size_t)l * NMAIN * D, z, rsb, (rep > 0 && PROBE_SUB <= 3) ? PROBE_SUB : 0));
        RUNPH(pb + 2, ph_mix1(lds, PF, l, z, gates, mix, wsm, wss, tb, rep == 0 ? 15 : PROBE_SUB));
        RUNPH(pb + 3, { s5::p2_scan(ldsb, tb, wss); ml::p2_scan(wsm); });
        RUNPH(pb + 4, ph_mix2(lds, PF, l, z, gates, mix, wsm, wss, tb, rep == 0 ? 15 : PROBE_SUB));
        RUNPH(pb + 5, { const Params& Q = PF; if (l == 0) ph_outproj<true>(ldsb, mix, (const bf16_t*)(ws + WS_WOUT) + (size_t)l * D * D, Q.in[I_X], xbuf); else ph_outproj<false>(ldsb, mix, (const bf16_t*)(ws + WS_WOUT) + (size_t)l * D * D, nullptr, xbuf); });
        RUNPH(pb + 6, { if (rep > 0) { if (blockIdx.x == 0 && threadIdx.x < 64) cnt[threadIdx.x] = 0u; xcd_barrier(bar); }
                        const Params& Q = PF; rp::run<3, false, true>(ldsb, Q, l, nullptr, xbuf, nullptr, nullptr, nullptr, Q.in[I_NFG] + l * D, (const bf16_t*)(rtb + rp::T_HI), (const bf16_t*)(rtb + rp::T_LO), H, rsb, nullptr, cnt, lists, inv); });
        RUNPH(pb + 7, ph_moe1(ldsb, PF, l, H, cnt, lists, act));
        RUNPH(pb + 8, ph_moe2(ldsb, PF, l, act, cnt, lists, yb));
    }
    RUNPH(1 + NLAYER * PH_PER_LAYER, { const Params& Q = PF; rp::final_norm(ldsb, xbuf, Q.out, yb, (const unsigned*)(ws + WS_INV) + (size_t)(NLAYER - 1) * NTOK * 2, ctl + CW_CNT + (NLAYER - 1) * 64, Q.in[I_NFIN]); });
#undef RUNPH
#undef IN
#undef SEAM
}

#ifndef N_LAUNCH_MODE
#define N_LAUNCH_MODE 1
#endif
extern "C" void kernel_launch(void* const* d_in, const int* in_sizes, int n_in, void* d_out, int out_size, void* d_ws, size_t ws_size, hipStream_t stream) {
    static int grid = 0;
    if (grid == 0) {
        if (n_in != 31 || out_size != NTOK * D || ws_size < WS_END) { fprintf(stderr, "kernel_launch: unexpected shapes n_in %d out %d ws %zu (need %zu)\n", n_in, out_size, ws_size, (size_t)WS_END); grid = -1; return; }
        int dev = 0, cus = 0, per_cu = 0;
        if (hipGetDevice(&dev) != hipSuccess || hipDeviceGetAttribute(&cus, hipDeviceAttributeMultiprocessorCount, dev) != hipSuccess) { grid = -1; return; }
        if (hipFuncSetAttribute((const void*)fwd_kernel, hipFuncAttributeMaxDynamicSharedMemorySize, LDS_BYTES) != hipSuccess) { fprintf(stderr, "kernel_launch: hipFuncSetAttribute failed\n"); grid = -1; return; }
        if (hipOccupancyMaxActiveBlocksPerMultiprocessor(&per_cu, (const void*)fwd_kernel, NTHREADS, LDS_BYTES) != hipSuccess || per_cu < 1) { fprintf(stderr, "kernel_launch: occupancy query says %d\n", per_cu); }
        (void)hipGetLastError();
        grid = cus;
    }
    if (grid < 0) return;
    (void)hipMemsetAsync((char*)d_ws + WS_CTL, 0, CTL_BYTES, stream);
    Params p{};
    for (int i = 0; i < 31; ++i) p.in[i] = (const float*)d_in[i];
    p.out = (float*)d_out; p.ws = (unsigned char*)d_ws;
#if N_LAUNCH_MODE == 1
    p.ph_lo = 0; p.ph_hi = N_PHASES;
    hipLaunchKernelGGL(fwd_kernel, dim3(grid), dim3(NTHREADS), LDS_BYTES, stream, p);
#else
    for (int ph = 0; ph < N_PHASES; ++ph) { p.ph_lo = ph; p.ph_hi = ph + 1; hipLaunchKernelGGL(fwd_kernel, dim3(grid), dim3(NTHREADS), LDS_BYTES, stream, p); }
#endif
}
```

```cpp
#include <hip/hip_runtime.h>
#include <stdint.h>
#include <stdio.h>

#define LAS __attribute__((address_space(3)))

constexpr int D = 1024, NB = 8, S = 8192, NTOK = NB * S, INW = 2312, NLAYER = 2;
constexpr int NEXP = 32, DE = 512;
constexpr float EPS = 1e-6f;
constexpr int ZW = 2304;
constexpr int ZQ = 0, ZK = 256, ZV = 384, ZSU = 512, ZCQ = 768, ZCK = 1024, ZCV = 1280, ZCO = 1536, ZGU = 1792, ZGV = 2048, WCI = 1536;
#ifndef INPROJ_WGM
#define INPROJ_WGM 8
#endif
constexpr int NTHREADS = 512;
constexpr int LDS_BYTES = 144 * 1024;
constexpr int TAB_OFF = 128 * 1024;
constexpr int PH_PER_LAYER = 9, N_PHASES = 1 + NLAYER * PH_PER_LAYER + 1;
constexpr int NMAIN = 2304;
typedef unsigned short bf16_t;

constexpr size_t MiB = 1u << 20;
constexpr size_t WS_CTL = 0, CTL_BYTES = 1 * MiB;
constexpr size_t WS_Z = WS_CTL + CTL_BYTES;
constexpr size_t Z_BYTES = (size_t)NTOK * ZW * 2;
constexpr size_t WS_H = WS_Z;
constexpr size_t WS_YB = WS_Z;
constexpr int PMAX = 2 * NTOK + NEXP * 256;
static_assert((size_t)PMAX * D * 2 <= Z_BYTES, "YB alias fits");
constexpr size_t WS_MIX = WS_Z + Z_BYTES;
constexpr size_t WS_ACT = WS_MIX;
static_assert((size_t)PMAX * DE * 2 <= (size_t)NTOK * D * 2 + 64 * MiB, "ACT alias fits");
constexpr size_t WS_HRAW = WS_MIX + (size_t)NTOK * D * 2;
constexpr size_t WS_S5 = WS_HRAW + 64 * MiB;
constexpr size_t WS_GATES = WS_S5 + 48 * MiB;
constexpr size_t WS_LIST = WS_GATES + (size_t)NTOK * 8 * 4;
constexpr size_t WS_WIN = WS_LIST + (size_t)NEXP * NTOK * 8;
constexpr size_t WS_WOUT = WS_WIN + (size_t)NLAYER * NMAIN * D * 2;
constexpr size_t WS_WGU = WS_WOUT + (size_t)NLAYER * D * D * 2;
constexpr size_t WS_WD = WS_WGU + (size_t)NLAYER * NEXP * 1024 * D * 2;
constexpr size_t WS_TB = WS_WD + (size_t)NLAYER * NEXP * D * DE * 2;
constexpr size_t WS_RS = WS_TB + (size_t)NLAYER * 4 * MiB;
constexpr size_t WS_RT = WS_RS + (size_t)NTOK * 4;
constexpr size_t WS_INV = WS_RT + (size_t)NLAYER * 256 * 1024;
constexpr size_t WS_XB = WS_INV + (size_t)NLAYER * NTOK * 8;
constexpr size_t WS_END = WS_XB + (size_t)NTOK * D * 2;
namespace s5 {
constexpr size_t T_KMAT = 0, T_F = T_KMAT + (size_t)16 * 32 * 256 * 2, T_G = T_F + (size_t)16 * 256 * 128 * 2, T_A16 = T_G + (size_t)16 * 128 * 256 * 2,
                 T_GLUW = T_A16 + (size_t)16 * 64 * 8, T_SGUW = T_GLUW + (size_t)256 * 256 * 2, T_LAYER = T_SGUW + (size_t)4 * 128 * 128 * 2;
}
constexpr int CW_Q = 4096;
constexpr int CW_CNT = 8192;

#define XB_TMO      128
#define XB_XCNT(j)  (256  + 64 * (j))
#define XB_XSUB(j)  (1280 + 64 * (j))
#define XB_XGEN(j)  (2304 + 64 * (j))
#define XB_TOP      3328
#define XB_TOPGEN   3392
#define XCD_BAR_WORDS 3456
#define XB_SPIN_CAP (1u << 22)
__device__ __forceinline__ unsigned xb_ld(unsigned* p)              { return __hip_atomic_load(p, __ATOMIC_RELAXED, __HIP_MEMORY_SCOPE_AGENT); }
__device__ __forceinline__ unsigned xb_add(unsigned* p, unsigned v) { return __hip_atomic_fetch_add(p, v, __ATOMIC_RELAXED, __HIP_MEMORY_SCOPE_AGENT); }
__device__ __forceinline__ unsigned xb_xcc_id() { return (unsigned)__builtin_amdgcn_s_getreg((3 << 11) | 20) & 0xFu; }
#define XB_SPIN(cond, bar) do { unsigned _sp = 0; while (cond) { __builtin_amdgcn_s_sleep(1); \
    if ((++_sp & 255u) == 0u) { if (xb_ld(&(bar)[XB_TMO])) break; if (_sp > XB_SPIN_CAP) { atomicAdd(&(bar)[XB_TMO], 1u); break; } } } } while (0)
struct XcdBarrier { unsigned* bar; unsigned x; volatile LAS unsigned* st; };
__device__ __forceinline__ XcdBarrier xcd_barrier_post(unsigned* bar, volatile LAS unsigned* st) {
    XcdBarrier b; b.bar = bar; b.x = xb_xcc_id(); b.st = st;
    if (threadIdx.x == 0) (void)xb_add(&bar[XB_XCNT(b.x)], 1u);
    return b;
}
__device__ __forceinline__ void xcd_barrier_complete(unsigned* bar, unsigned x, unsigned& nloc, unsigned& nx) {
    const unsigned G = gridDim.x * gridDim.y * gridDim.z;
    unsigned sum, cnt, mine, sp = 0u;
    for (;;) {
        sum = 0u; cnt = 0u; mine = 0u;
#pragma unroll
        for (unsigned j = 0; j < 16; ++j) { const unsigned c = xb_ld(&bar[XB_XCNT(j)]); sum += c; cnt += (c > 0u) ? 1u : 0u; mine = (j == x) ? c : mine; }
        if (sum == G) break;
        __builtin_amdgcn_s_sleep(1);
        if ((++sp & 255u) == 0u) { if (xb_ld(&bar[XB_TMO])) break; if (sp > XB_SPIN_CAP) { atomicAdd(&bar[XB_TMO], 1u); break; } }
    }
    nloc = mine > 0u ? mine : 1u; nx = cnt > 0u ? cnt : 1u;
}
__device__ __forceinline__ void xcd_barrier(const XcdBarrier& b) {
    asm volatile("s_waitcnt vmcnt(0)" ::: "memory");
    __syncthreads();
    if (threadIdx.x == 0) {
        unsigned* bar = b.bar;
        __builtin_amdgcn_s_waitcnt(0);
        unsigned nloc = b.st[0], nx = b.st[1];
        if (nloc == 0u) { xcd_barrier_complete(bar, b.x, nloc, nx); b.st[0] = nloc; b.st[1] = nx; }
        const unsigned old = xb_add(&bar[XB_XSUB(b.x)], 1u);
        const unsigned gen = old / nloc;
        if (old + 1u == (gen + 1u) * nloc) {
            __builtin_amdgcn_fence(__ATOMIC_RELEASE, "agent");
            asm volatile("s_waitcnt vmcnt(0)" ::: "memory");
            const unsigned og = xb_add(&bar[XB_TOP], 1u);
            const unsigned tg = og / nx;
            if (og + 1u == (tg + 1u) * nx) xb_add(&bar[XB_TOPGEN], 1u);
            else XB_SPIN(xb_ld(&bar[XB_TOPGEN]) == tg, bar);
            __builtin_amdgcn_fence(__ATOMIC_ACQUIRE, "agent");
            xb_add(&bar[XB_XGEN(b.x)], 1u);
            asm volatile("s_waitcnt vmcnt(0)" ::: "memory");
        } else {
            XB_SPIN(xb_ld(&bar[XB_XGEN(b.x)]) == gen, bar);
            __builtin_amdgcn_fence(__ATOMIC_ACQUIRE, "agent");
            asm volatile("s_waitcnt vmcnt(0)" ::: "memory");
        }
    }
    __syncthreads();
}

__device__ __forceinline__ int tid_opaque() { int t = threadIdx.x; asm volatile("" : "+v"(t)); return t; }
__device__ __forceinline__ float wave_sum(float v) {
#pragma unroll
    for (int o = 32; o > 0; o >>= 1) v += __shfl_xor(v, o);
    return v;
}
__device__ __forceinline__ float gelu_tanh(float x) {
    const float u2 = 1.5957691216057308f * (x + 0.044715f * x * x * x);
    return x * __builtin_amdgcn_rcpf(1.f + __expf(-u2));
}
__device__ __forceinline__ float sigm(float x) { return 1.f / (1.f + expf(-x)); }
__device__ __forceinline__ float rsig(float x) { return __builtin_amdgcn_rcpf(1.f + __expf(-x)); }
__device__ __forceinline__ float bfl(unsigned w) { return __uint_as_float(w << 16); }
__device__ __forceinline__ float bfh(unsigned w) { return __uint_as_float(w & 0xffff0000u); }
typedef unsigned u32x4_t __attribute__((ext_vector_type(4)));
typedef unsigned u32x2_t __attribute__((ext_vector_type(2)));
__device__ __forceinline__ void ld8(const bf16_t* p, float (&o)[8]) { const u32x4_t w = *(const u32x4_t*)p; o[0] = bfl(w.x); o[1] = bfh(w.x); o[2] = bfl(w.y); o[3] = bfh(w.y); o[4] = bfl(w.z); o[5] = bfh(w.z); o[6] = bfl(w.w); o[7] = bfh(w.w); }
__device__ __forceinline__ void wave_lds_fence() {
    __builtin_amdgcn_fence(__ATOMIC_RELEASE, "wavefront"); __builtin_amdgcn_wave_barrier(); __builtin_amdgcn_fence(__ATOMIC_ACQUIRE, "wavefront");
}

struct Params {
    const float* in[31];
    float* out;
    unsigned char* ws;
    int ph_lo, ph_hi;
};
struct Params;
__device__ __forceinline__ const Params* params_fresh() { auto p = __builtin_amdgcn_kernarg_segment_ptr(); asm volatile("" : "+s"(p)); return (const Params*)p; }
#define PF (*params_fresh())
enum { I_X = 0, I_NMG, I_WIN, I_SINK, I_ARE, I_AIM, I_BRE, I_BIM, I_CRE, I_CIM, I_SD, I_LDT, I_GLUW, I_GLUB, I_CONVW, I_GATEB, I_MNG,
       I_LNG, I_LNB, I_SGUW, I_SGUB, I_WOUT, I_NFG, I_RGW, I_RGB, I_REW, I_REB, I_EWG, I_EWU, I_EWD, I_NFIN };

namespace pg8 {
#define PG8_LAS __attribute__((address_space(3)))
typedef short bf16x8 __attribute__((ext_vector_type(8)));
typedef float f32x4 __attribute__((ext_vector_type(4)));
typedef unsigned u32x4 __attribute__((ext_vector_type(4)));
typedef unsigned u32x2 __attribute__((ext_vector_type(2)));
typedef int i32x4 __attribute__((ext_vector_type(4)));
constexpr int BM = 256, BK = 64, HALF = 128, HTB = HALF * BK * 2, STAGE_BYTES = 8 * HTB, NXCD = 8, WGM = 8;
__host__ __device__ __forceinline__ int lds_byte(int r, int c) { const int st = (r >> 4) * 2 + (c >> 5), rr = r & 15, cc = c & 31, ob = rr * 64 + cc * 2; return st * 1024 + (ob ^ (((ob >> 9) & 1) << 5)); }
__host__ __device__ __forceinline__ void stage_rc(int b, int& R, int& C) { const int st = b / 1024, sb = b % 1024, swz = sb ^ (((sb >> 9) & 1) << 5); R = (st >> 1) * 16 + swz / 64; C = (st & 1) * 32 + (swz % 64) / 2; }
__host__ __device__ __forceinline__ int perm32(int rho) { const int n = rho >> 4, i = rho & 15; return 8 * (i >> 2) + 4 * n + (i & 3); }
__device__ __forceinline__ unsigned cvt_pk_bf16(float lo, float hi) { unsigned r; asm volatile("v_cvt_pk_bf16_f32 %0, %1, %2" : "=v"(r) : "v"(lo), "v"(hi)); return r; }

struct Unit { int pm, pn; const char* A; const char* B; int e, pos0, cnt; };

struct StaticOrder {
    int nM, nN, nwg, G, c, wgm, pmmask = -1; const char* A; const char* Bt; size_t atile, btile;
    __device__ void init(int M, int N, int K, int lda, int G_, int c_, const void* A_, const void* Bt_, int wgm_ = WGM) { wgm = wgm_; nM = M / BM; nN = N / BM; nwg = nM * nN; G = G_; c = c_; A = (const char*)A_; Bt = (const char*)Bt_; atile = (size_t)BM * lda * 2; btile = (size_t)BM * K * 2; }
    __device__ __forceinline__ bool next(int i, Unit& u) const {
        const long L = (long)i * G + c; if (L >= nwg) return false;
        int wgid = (int)L; { const int q = nwg / NXCD, r = nwg % NXCD, xcd = wgid % NXCD, off = wgid / NXCD; wgid = (xcd < r ? xcd * (q + 1) : r * (q + 1) + (xcd - r) * q) + off; }
        const int nig = wgm * nN, gid = wgid / nig, fm = gid * wgm, gsz = (nM - fm) < wgm ? (nM - fm) : wgm;
        u.pm = fm + ((wgid % nig) % gsz); u.pn = (wgid % nig) / gsz; u.A = A + (size_t)(u.pm & pmmask) * atile; u.B = Bt + (size_t)u.pn * btile; u.e = 0; u.pos0 = 0; u.cnt = 0; return true;
    }
    __device__ __forceinline__ void aoff(const Unit&, unsigned (&)[2], unsigned (&)[2], const int (&)[2], const int (&)[2]) const {}
};

template <class Epi, class Sched, bool GATHER>
__device__ __forceinline__ void gemm_phase(PG8_LAS unsigned char* lds, const int K, const int lda, const Sched& S, const Epi& E) {
    const int tid = tid_opaque(), wid = __builtin_amdgcn_readfirstlane(tid >> 6), lane = tid & 63, wr = wid >> 2, wc = wid & 3, fr = lane & 15, fq = lane >> 4;
    const int nt = K / BK;
    unsigned vA0[2], vA1[2], vB[2], nA0[2], nA1[2]; int Rs[2], Cs[2];
#pragma unroll
    for (int i = 0; i < 2; ++i) { int R, C; stage_rc(tid * 16 + i * 8192, R, C); const int Rb = Epi::PERM ? ((R & ~31) + perm32(R & 31)) : R;
        Rs[i] = R; Cs[i] = C; vA0[i] = (unsigned)(R * lda + C) * 2u; vA1[i] = vA0[i] + (unsigned)(HALF * lda) * 2u; vB[i] = (unsigned)(Rb * K + C) * 2u; nA0[i] = vA0[i]; nA1[i] = vA1[i]; }
    const size_t kstep = (size_t)(BK * 2);
    const size_t hstep = (size_t)HALF * K * 2;
    const unsigned ldsw = (unsigned)wid * 1024u;
    const int aoff = lds_byte(wr * 64 + fr, fq * 8), boff = lds_byte(wc * 32 + fr, fq * 8);
#define PG8_SA(b, h) (((b) * 2 + (h)) * HTB)
#define PG8_SB(b, h) ((4 + (b) * 2 + (h)) * HTB)
#define PG8_STAGE(bufoff, gbase, voff) do { _Pragma("unroll") for (int _i = 0; _i < 2; ++_i) \
        __builtin_amdgcn_global_load_lds((const unsigned*)((const char*)(gbase) + (voff)[_i]), (PG8_LAS unsigned*)(lds + (bufoff) + ldsw + _i * 8192), 16, 0, 0); } while (0)
#define PG8_LDA(dst, b, h) do { _Pragma("unroll") for (int m = 0; m < 4; ++m) _Pragma("unroll") for (int k = 0; k < 2; ++k) dst[m][k] = *(const PG8_LAS bf16x8*)(lds + PG8_SA(b, h) + aoff + m * 2048 + k * 1024); } while (0)
#define PG8_LDB(dst, b, h) do { _Pragma("unroll") for (int n = 0; n < 2; ++n) _Pragma("unroll") for (int k = 0; k < 2; ++k) dst[n][k] = *(const PG8_LAS bf16x8*)(lds + PG8_SB(b, h) + boff + n * 2048 + k * 1024); } while (0)
#define PG8_MMA(ai, bj, At, Bt) do { __builtin_amdgcn_s_setprio(1); _Pragma("unroll") for (int m = 0; m < 4; ++m) _Pragma("unroll") for (int n = 0; n < 2; ++n) _Pragma("unroll") for (int k = 0; k < 2; ++k) \
        acc[ai][bj][m][n] = __builtin_amdgcn_mfma_f32_16x16x32_bf16(Bt[n][k], At[m][k], acc[ai][bj][m][n], 0, 0, 0); __builtin_amdgcn_s_setprio(0); } while (0)
#define PG8_WAIT_V(n) asm volatile("s_waitcnt vmcnt(" #n ")" ::: "memory")
#define PG8_WAIT_L(n) asm volatile("s_waitcnt lgkmcnt(" #n ")" ::: "memory")
#define PG8_BAR __builtin_amdgcn_s_barrier()
#define PG8_SCHED __builtin_amdgcn_sched_barrier(0)
    Unit cur, nxt; int ui = 0;
    if (!S.next(0, cur)) return;
    if constexpr (GATHER) { S.aoff(cur, vA0, vA1, Rs, Cs); PG8_WAIT_V(0); }
    f32x4 acc[2][2][4][2];
#pragma unroll
    for (int a = 0; a < 2; ++a)
#pragma unroll
        for (int b = 0; b < 2; ++b)
#pragma unroll
            for (int m = 0; m < 4; ++m)
#pragma unroll
                for (int n = 0; n < 2; ++n) acc[a][b][m][n] = (f32x4){0.f, 0.f, 0.f, 0.f};
    bf16x8 At[4][2], B0[2][2], B1[2][2];
    const char* cA = cur.A; const char* cB = cur.B;
    PG8_STAGE(PG8_SB(0, 0), cB, vB); PG8_STAGE(PG8_SB(0, 1), cB + hstep, vB); PG8_STAGE(PG8_SA(0, 0), cA, vA0); PG8_STAGE(PG8_SA(0, 1), cA, vA1);
    if (wr == 1) PG8_BAR;
    PG8_WAIT_V(2); PG8_BAR;
    PG8_STAGE(PG8_SB(1, 0), cB + kstep, vB); PG8_STAGE(PG8_SA(1, 0), cA + kstep, vA0); PG8_STAGE(PG8_SB(1, 1), cB + hstep + kstep, vB);
    PG8_WAIT_V(6); PG8_BAR;
    for (;;) {
        const bool has_next = S.next(ui + 1, nxt);
        const char* nA = has_next ? nxt.A : cA; const char* nB = has_next ? nxt.B : cB;
        if constexpr (GATHER) {
            if (has_next) { S.aoff(nxt, nA0, nA1, Rs, Cs); }
            else {
#pragma unroll
                for (int i = 0; i < 2; ++i) { nA0[i] = vA0[i]; nA1[i] = vA1[i]; } }
        }
        for (int t = 0; t < nt; t += 2) {
            const bool last = (t == nt - 2);
            const char* a1 = cA + (size_t)(t + 1) * kstep;
            const char* a2 = last ? nA : cA + (size_t)(t + 2) * kstep; const char* b2 = last ? nB : cB + (size_t)(t + 2) * kstep;
            const char* a3 = a2 + kstep; const char* b3 = b2 + kstep;
            unsigned x0[2], x1[2];
#pragma unroll
            for (int i = 0; i < 2; ++i) { x0[i] = (GATHER && last) ? nA0[i] : vA0[i]; x1[i] = (GATHER && last) ? nA1[i] : vA1[i]; }
            PG8_LDB(B0, 0, 0); PG8_LDB(B1, 0, 1); PG8_SCHED; PG8_LDA(At, 0, 0); PG8_STAGE(PG8_SA(1, 1), a1, vA1);
            PG8_WAIT_V(8); PG8_WAIT_L(0); PG8_BAR; PG8_MMA(0, 0, At, B0); PG8_MMA(0, 1, At, B1); PG8_BAR; PG8_SCHED;
            PG8_LDA(At, 0, 1); PG8_STAGE(PG8_SB(0, 0), b2, vB); PG8_STAGE(PG8_SB(0, 1), b2 + hstep, vB); PG8_STAGE(PG8_SA(0, 0), a2, x0);
            PG8_WAIT_V(8); PG8_WAIT_L(0); PG8_BAR; PG8_MMA(1, 0, At, B0); PG8_MMA(1, 1, At, B1); PG8_BAR; PG8_SCHED;
            PG8_LDB(B0, 1, 0); PG8_LDB(B1, 1, 1); PG8_SCHED; PG8_LDA(At, 1, 0); PG8_STAGE(PG8_SA(0, 1), a2, x1);
            PG8_WAIT_V(8); PG8_WAIT_L(0); PG8_BAR; PG8_MMA(0, 0, At, B0); PG8_MMA(0, 1, At, B1); PG8_BAR; PG8_SCHED;
            PG8_LDA(At, 1, 1); PG8_STAGE(PG8_SB(1, 0), b3, vB); PG8_STAGE(PG8_SB(1, 1), b3 + hstep, vB); PG8_STAGE(PG8_SA(1, 0), a3, x0);
            PG8_WAIT_V(8); PG8_WAIT_L(0); PG8_BAR; PG8_MMA(1, 0, At, B0); PG8_MMA(1, 1, At, B1); PG8_BAR; PG8_SCHED;
        }
        if (wr == 0) PG8_BAR;
        E(acc, cur, wr, wc, fr, fq);
        if (!has_next) break;
#pragma unroll
        for (int a = 0; a < 2; ++a)
#pragma unroll
            for (int b = 0; b < 2; ++b)
#pragma unroll
                for (int m = 0; m < 4; ++m)
#pragma unroll
                    for (int n = 0; n < 2; ++n) acc[a][b][m][n] = (f32x4){0.f, 0.f, 0.f, 0.f};
        cur = nxt; cA = nA; cB = nB; ++ui;
        if constexpr (GATHER) {
#pragma unroll
            for (int i = 0; i < 2; ++i) { vA0[i] = nA0[i]; vA1[i] = nA1[i]; } }
        if (wr == 1) PG8_BAR;
    }
    PG8_WAIT_V(0);
    PG8_BAR;
#undef PG8_SA
#undef PG8_SB
#undef PG8_STAGE
#undef PG8_LDA
#undef PG8_LDB
#undef PG8_MMA
#undef PG8_WAIT_V
#undef PG8_WAIT_L
#undef PG8_BAR
#undef PG8_SCHED
}

struct EpiZ {
    static constexpr bool PERM = true;
    bf16_t* Z; const float* RS; int skip;
    __device__ __forceinline__ void operator()(const f32x4 (&acc)[2][2][4][2], const Unit& u, int wr, int wc, int fr, int fq) const {
        if (skip) return;
        const int row0 = u.pm * BM + wr * 64 + fr, col0 = u.pn * BM + wc * 32 + 8 * fq;
        float rsv[2][4];
#pragma unroll
        for (int ai = 0; ai < 2; ++ai)
#pragma unroll
            for (int m = 0; m < 4; ++m) rsv[ai][m] = RS[row0 + ai * HALF + m * 16];
#pragma unroll
        for (int ai = 0; ai < 2; ++ai)
#pragma unroll
            for (int m = 0; m < 4; ++m) { bf16_t* rowp = Z + (size_t)(row0 + ai * HALF + m * 16) * ZW + col0; const float rs = rsv[ai][m];
#pragma unroll
                for (int bj = 0; bj < 2; ++bj) { const f32x4 v0 = acc[ai][bj][m][0] * rs, v1 = acc[ai][bj][m][1] * rs;
                    u32x4 w; w.x = cvt_pk_bf16(v0[0], v0[1]); w.y = cvt_pk_bf16(v0[2], v0[3]); w.z = cvt_pk_bf16(v1[0], v1[1]); w.w = cvt_pk_bf16(v1[2], v1[3]);
                    *(u32x4*)(rowp + bj * HALF) = w; } }
    }
};
template <bool SRCF32> struct EpiResB {
    static constexpr bool PERM = true;
    const float* XF; bf16_t* XB;
    __device__ __forceinline__ void operator()(const f32x4 (&acc)[2][2][4][2], const Unit& u, int wr, int wc, int fr, int fq) const {
        const int row0 = u.pm * BM + wr * 64 + fr, col0 = u.pn * BM + wc * 32 + 8 * fq;
#pragma unroll
        for (int ai = 0; ai < 2; ++ai) {
            f32x4 xf[4][2][2]; u32x4 xw[4][2];
#pragma unroll
            for (int m = 0; m < 4; ++m) { const size_t off = (size_t)(row0 + ai * HALF + m * 16) * D + col0;
#pragma unroll
                for (int bj = 0; bj < 2; ++bj) {
                    if (SRCF32) { xf[m][bj][0] = *(const f32x4*)(XF + off + bj * HALF); xf[m][bj][1] = *(const f32x4*)(XF + off + bj * HALF + 4); }
                    else xw[m][bj] = *(const u32x4*)(XB + off + bj * HALF); } }
            __builtin_amdgcn_sched_barrier(0);
#pragma unroll
            for (int m = 0; m < 4; ++m) { const size_t off = (size_t)(row0 + ai * HALF + m * 16) * D + col0;
#pragma unroll
                for (int bj = 0; bj < 2; ++bj) { f32x4 x0, x1;
                    if (SRCF32) { x0 = xf[m][bj][0]; x1 = xf[m][bj][1]; }
                    else { const u32x4 w = xw[m][bj];
                        x0 = (f32x4){__uint_as_float(w.x << 16), __uint_as_float(w.x & 0xffff0000u), __uint_as_float(w.y << 16), __uint_as_float(w.y & 0xffff0000u)};
                        x1 = (f32x4){__uint_as_float(w.z << 16), __uint_as_float(w.z & 0xffff0000u), __uint_as_float(w.w << 16), __uint_as_float(w.w & 0xffff0000u)}; }
                    const f32x4 v0 = x0 + acc[ai][bj][m][0], v1 = x1 + acc[ai][bj][m][1];
                    u32x4 o; o.x = cvt_pk_bf16(v0[0], v0[1]); o.y = cvt_pk_bf16(v0[2], v0[3]); o.z = cvt_pk_bf16(v1[0], v1[1]); o.w = cvt_pk_bf16(v1[2], v1[3]);
                    *(u32x4*)(XB + off + bj * HALF) = o; } }
            __builtin_amdgcn_sched_barrier(0);
        }
    }
};
struct EpiAct {
    static constexpr bool PERM = true;
    bf16_t* ACT; const int2* lists; const float* RS;
    __device__ __forceinline__ void operator()(const f32x4 (&acc)[2][2][4][2], const Unit& u, int wr, int wc, int fr, int fq) const {
        const int row0 = u.pm * BM + wr * 64 + fr, col0 = u.pn * HALF + wc * 32 + 8 * fq; const int2* lst = lists + (size_t)u.e * NTOK + u.pos0;
        int tk[2][4]; float rsv[2][4];
#pragma unroll
        for (int ai = 0; ai < 2; ++ai)
#pragma unroll
            for (int m = 0; m < 4; ++m) { const int r = ai * HALF + wr * 64 + m * 16 + fr; const int rc = (u.pos0 + r < u.cnt) ? r : 0; tk[ai][m] = lst[rc].x; }
        asm volatile("" : "+v"(tk[0][0]), "+v"(tk[0][1]), "+v"(tk[0][2]), "+v"(tk[0][3]), "+v"(tk[1][0]), "+v"(tk[1][1]), "+v"(tk[1][2]), "+v"(tk[1][3]));
#pragma unroll
        for (int ai = 0; ai < 2; ++ai)
#pragma unroll
            for (int m = 0; m < 4; ++m) rsv[ai][m] = RS[tk[ai][m]];
        asm volatile("" : "+v"(rsv[0][0]), "+v"(rsv[0][1]), "+v"(rsv[0][2]), "+v"(rsv[0][3]), "+v"(rsv[1][0]), "+v"(rsv[1][1]), "+v"(rsv[1][2]), "+v"(rsv[1][3]));
#pragma unroll
        for (int ai = 0; ai < 2; ++ai)
#pragma unroll
            for (int m = 0; m < 4; ++m) { const int r = ai * HALF + wr * 64 + m * 16 + fr; if (!(u.pos0 + r < u.cnt)) rsv[ai][m] = 0.f; }
#pragma unroll
        for (int ai = 0; ai < 2; ++ai)
#pragma unroll
            for (int m = 0; m < 4; ++m) { bf16_t* rowp = ACT + (size_t)(row0 + ai * HALF + m * 16) * DE + col0;
                const float rs = rsv[ai][m];
                float o[8];
#pragma unroll
                for (int n = 0; n < 2; ++n)
#pragma unroll
                    for (int j = 0; j < 4; ++j) { const float g = acc[ai][0][m][n][j] * rs, up = acc[ai][1][m][n][j] * rs; o[n * 4 + j] = g * up * __builtin_amdgcn_rcpf(1.f + __expf(-g)); }
                u32x4 w; w.x = cvt_pk_bf16(o[0], o[1]); w.y = cvt_pk_bf16(o[2], o[3]); w.z = cvt_pk_bf16(o[4], o[5]); w.w = cvt_pk_bf16(o[6], o[7]);
                *(u32x4*)rowp = w; }
    }
};
struct EpiY {
    static constexpr bool PERM = true;
    bf16_t* YB; const int2* lists;
    __device__ __forceinline__ void operator()(const f32x4 (&acc)[2][2][4][2], const Unit& u, int wr, int wc, int fr, int fq) const {
        const int row0 = u.pm * BM + wr * 64 + fr, col0 = u.pn * BM + wc * 32 + 8 * fq; const int2* lst = lists + (size_t)u.e * NTOK + u.pos0;
        float wv[2][4];
#pragma unroll
        for (int ai = 0; ai < 2; ++ai)
#pragma unroll
            for (int m = 0; m < 4; ++m) { const int r = ai * HALF + wr * 64 + m * 16 + fr; wv[ai][m] = __int_as_float(lst[(u.pos0 + r < u.cnt) ? r : 0].y); }
#pragma unroll
        for (int ai = 0; ai < 2; ++ai)
#pragma unroll
            for (int m = 0; m < 4; ++m) { const int r = ai * HALF + wr * 64 + m * 16 + fr;
                if (u.pos0 + r < u.cnt) { const float w = wv[ai][m]; bf16_t* rowp = YB + (size_t)(row0 + ai * HALF + m * 16) * D + col0;
#pragma unroll
                    for (int bj = 0; bj < 2; ++bj) { const f32x4 v0 = acc[ai][bj][m][0] * w, v1 = acc[ai][bj][m][1] * w;
                        u32x4 o; o.x = cvt_pk_bf16(v0[0], v0[1]); o.y = cvt_pk_bf16(v0[2], v0[3]); o.z = cvt_pk_bf16(v1[0], v1[1]); o.w = cvt_pk_bf16(v1[2], v1[3]);
                        *(u32x4*)(rowp + bj * HALF) = o; } } }
    }
};
struct MoeOrder {
    const PG8_LAS i32x4* tab; int ntiles, npn, G, c; const char* A; size_t atile; const char* Bt; size_t bexp, btile; const int2* lists;
    __device__ __forceinline__ bool next(int i, Unit& u) const {
        const int L = i * G + c; const int T = L / npn; if (T >= ntiles) return false;
        const i32x4 te = tab[T]; u.pm = T; u.pn = L - T * npn; u.e = __builtin_amdgcn_readfirstlane(te.x); u.pos0 = __builtin_amdgcn_readfirstlane(te.y); u.cnt = __builtin_amdgcn_readfirstlane(te.z);
        u.A = A + (size_t)T * atile; u.B = Bt + (size_t)u.e * bexp + (size_t)u.pn * btile; return true;
    }
    __device__ __forceinline__ void aoff(const Unit& u, unsigned (&o0)[2], unsigned (&o1)[2], const int (&Rs)[2], const int (&Cs)[2]) const {
        const int2* lst = lists + (size_t)u.e * NTOK;
#pragma unroll
        for (int i = 0; i < 2; ++i) { const int p0 = u.pos0 + Rs[i], p1 = p0 + HALF;
            const int t0 = (p0 < u.cnt) ? lst[p0].x : 0, t1 = (p1 < u.cnt) ? lst[p1].x : 0;
            o0[i] = (unsigned)t0 * (unsigned)(D * 2) + (unsigned)Cs[i] * 2u; o1[i] = (unsigned)t1 * (unsigned)(D * 2) + (unsigned)Cs[i] * 2u; }
    }
};
}

__device__ __forceinline__ void tc_strip(float* T, const float* src, int src_ld, int c0, int k0, bf16_t* dst, int K, int n0) {
    const int tid = tid_opaque();
    float4 v[8];
#pragma unroll
    for (int i = 0; i < 8; ++i) { const int kk = (tid >> 4) + 32 * i, c4 = (tid & 15) * 4; v[i] = *(const float4*)(src + (size_t)(k0 + kk) * src_ld + c0 + c4); }
    __syncthreads();
#pragma unroll
    for (int i = 0; i < 8; ++i) { const int kk = (tid >> 4) + 32 * i, c4 = (tid & 15) * 4;
        T[kk * 65 + c4] = v[i].x; T[kk * 65 + c4 + 1] = v[i].y; T[kk * 65 + c4 + 2] = v[i].z; T[kk * 65 + c4 + 3] = v[i].w; }
    __syncthreads();
    const int nl = tid >> 3, kc = (tid & 7) * 32;
#pragma unroll
    for (int q = 0; q < 4; ++q) { const int kq = kc + 8 * q; pg8::u32x4 w;
        w.x = pg8::cvt_pk_bf16(T[(kq + 0) * 65 + nl], T[(kq + 1) * 65 + nl]); w.y = pg8::cvt_pk_bf16(T[(kq + 2) * 65 + nl], T[(kq + 3) * 65 + nl]);
        w.z = pg8::cvt_pk_bf16(T[(kq + 4) * 65 + nl], T[(kq + 5) * 65 + nl]); w.w = pg8::cvt_pk_bf16(T[(kq + 6) * 65 + nl], T[(kq + 7) * 65 + nl]);
        *(pg8::u32x4*)(dst + (size_t)(n0 + nl) * K + k0 + kq) = w; }
}
__device__ __forceinline__ void s5_build_tables_fwd(float* ldsf, const Params& P, int l, int g, unsigned char* tb);
__device__ __forceinline__ void ph_prologue(float* lds, const Params& P) {
    constexpr int NJ_EXP = NLAYER * NEXP * 96, NJ_IN = NLAYER * 144, NJ_OUT = NLAYER * 64, NJ_TB = NLAYER * 16, NJ_GLU = NLAYER * 4, NJ_SGU = NLAYER * 4, NJ_RT = NLAYER * 16;
    bf16_t* WIN = (bf16_t*)(P.ws + WS_WIN); bf16_t* WOUT = (bf16_t*)(P.ws + WS_WOUT); bf16_t* WGU = (bf16_t*)(P.ws + WS_WGU); bf16_t* WD = (bf16_t*)(P.ws + WS_WD);
    constexpr int NJ_ALL = NJ_EXP + NJ_IN + NJ_OUT + NJ_TB + NJ_GLU + NJ_SGU + NJ_RT, NJ_SMALL = NJ_TB + NJ_GLU + NJ_SGU + NJ_RT;
    unsigned* qhead = (unsigned*)(P.ws + WS_CTL) + CW_Q;
    LAS int* jslot = (LAS int*)((LAS unsigned char*)lds + LDS_BYTES - 64);
    for (;;) {
        __syncthreads();
        if (tid_opaque() == 0) *jslot = (int)atomicAdd(qhead, 1u);
        __syncthreads();
        const int jj = __builtin_amdgcn_readfirstlane(*jslot);
        if (jj >= NJ_ALL) break;
        const int j = (jj < NJ_SMALL) ? (NJ_ALL - NJ_SMALL + jj) : (jj - NJ_SMALL);
        if (j < NJ_EXP) {
            const int le = j / 96, r = j % 96;
            if (r < 64) { const int n0 = (r >> 2) * 64, k0 = (r & 3) * 256, pn = n0 >> 8, within = n0 & 255;
                const float* s = (within < 128 ? P.in[I_EWG] : P.in[I_EWU]) + (size_t)le * D * DE;
                tc_strip(lds, s, DE, pn * 128 + (within & 127), k0, WGU + (size_t)le * 1024 * D, D, n0);
            } else { const int r2 = r - 64, n0 = (r2 >> 1) * 64, k0 = (r2 & 1) * 256;
                tc_strip(lds, P.in[I_EWD] + (size_t)le * DE * D, D, n0, k0, WD + (size_t)le * D * DE, DE, n0); }
        } else if (j < NJ_EXP + NJ_IN) {
            const int j2 = j - NJ_EXP, l = j2 / 144, r = j2 % 144, n0 = (r >> 2) * 64, k0 = (r & 3) * 256;
            tc_strip(lds, P.in[I_WIN] + (size_t)l * D * INW, INW, n0 < WCI ? n0 : n0 + 8, k0, WIN + (size_t)l * NMAIN * D, D, n0);
        } else if (j < NJ_EXP + NJ_IN + NJ_OUT) {
            const int j3 = j - NJ_EXP - NJ_IN, l = j3 / 64, r = j3 % 64, n0 = (r >> 2) * 64, k0 = (r & 3) * 256;
            tc_strip(lds, P.in[I_WOUT] + (size_t)l * D * D, D, n0, k0, WOUT + (size_t)l * D * D, D, n0);
        } else if (j < NJ_EXP + NJ_IN + NJ_OUT + NJ_TB) {
            const int j4 = j - (NJ_EXP + NJ_IN + NJ_OUT);
            s5_build_tables_fwd(lds, P, j4 >> 4, j4 & 15, P.ws + WS_TB + (size_t)(j4 >> 4) * 4 * MiB);
        } else if (j < NJ_EXP + NJ_IN + NJ_OUT + NJ_TB + NJ_GLU) {
            const int j5 = j - (NJ_EXP + NJ_IN + NJ_OUT + NJ_TB), l = j5 >> 2, n0 = (j5 & 3) * 64;
            tc_strip(lds, P.in[I_GLUW] + (size_t)l * 256 * 256, 256, n0, 0, (bf16_t*)(P.ws + WS_TB + (size_t)l * 4 * MiB + s5::T_GLUW), 256, n0);
        } else if (j < NJ_EXP + NJ_IN + NJ_OUT + NJ_TB + NJ_GLU + NJ_SGU) {
            const int j6 = j - (NJ_EXP + NJ_IN + NJ_OUT + NJ_TB + NJ_GLU), l = j6 >> 2, g = j6 & 3;
            bf16_t* wbp = (bf16_t*)(P.ws + WS_TB + (size_t)l * 4 * MiB + s5::T_SGUW) + (size_t)g * 128 * 128; const float* ws_ = P.in[I_SGUW] + ((size_t)l * 4 + g) * 128 * 128;
            for (int idx = tid_opaque(); idx < 128 * 128; idx += NTHREADS) { const int t = idx >> 7, s = idx & 127; wbp[idx] = (s <= t) ? (bf16_t)(pg8::cvt_pk_bf16(ws_[idx], 0.f) & 0xffffu) : (bf16_t)0; }
        } else {
            const int j7 = j - (NJ_EXP + NJ_IN + NJ_OUT + NJ_TB + NJ_GLU + NJ_SGU), l = j7 / 16, n0 = (j7 % 16) * 4;
            bf16_t* wh = (bf16_t*)(P.ws + WS_RT + (size_t)l * 256 * 1024); bf16_t* wl = wh + 48 * D;
            for (int idx = tid_opaque(); idx < 4 * D; idx += NTHREADS) { const int n = n0 + (idx >> 10), k = idx & (D - 1);
                const float w = (n < 4) ? P.in[I_RGW][((size_t)l * D + k) * 4 + n] : ((n < 36) ? P.in[I_REW][((size_t)l * D + k) * 32 + (n - 4)] : ((n >= 48 && n < 56) ? P.in[I_WIN][((size_t)l * D + k) * INW + WCI + (n - 48)] : 0.f));
                const unsigned hb = pg8::cvt_pk_bf16(w, 0.f) & 0xffffu; const bf16_t lb = (bf16_t)(pg8::cvt_pk_bf16(w - __uint_as_float(hb << 16), 0.f) & 0xffffu);
                if (n < 48) { wh[(size_t)n * D + k] = (bf16_t)hb; wl[(size_t)n * D + k] = lb; } else { wh[(size_t)(96 + n - 48) * D + k] = (bf16_t)hb; wh[(size_t)(112 + n - 48) * D + k] = lb; } }
        }
    }
    __syncthreads();
}

template <bool DUAL, class AF, class EF>
__device__ __forceinline__ void gemm_tile(float* lds, AF arow, int K, const float* B0, const float* B1, int ldb, int n0, int N, EF epi) {
    float* As = lds;
    float* Bs0 = lds + 32 * 132;
    float* Bs1 = Bs0 + 32 * 128;
    const int tid = tid_opaque(), ty = tid >> 4, tx = tid & 15;
    float acc0[4][8], acc1[4][8];
#pragma unroll
    for (int i = 0; i < 4; ++i)
#pragma unroll
        for (int j = 0; j < 8; ++j) { acc0[i][j] = 0.f; acc1[i][j] = 0.f; }
    const float* ap0 = arow((tid >> 3));
    const float* ap1 = arow((tid >> 3) + 64);
    const int akk = (tid & 7) * 4;
    const int bn = n0 + (tid & 31) * 4; const bool bok = bn < N;
    for (int k0 = 0; k0 < K; k0 += 32) {
        const float4 av0 = ap0 ? *(const float4*)(ap0 + k0 + akk) : make_float4(0.f, 0.f, 0.f, 0.f);
        const float4 av1 = ap1 ? *(const float4*)(ap1 + k0 + akk) : make_float4(0.f, 0.f, 0.f, 0.f);
        const int kb0 = k0 + (tid >> 5), kb1 = kb0 + 16;
        const float4 bv00 = bok ? *(const float4*)(B0 + (size_t)kb0 * ldb + bn) : make_float4(0.f, 0.f, 0.f, 0.f);
        const float4 bv01 = bok ? *(const float4*)(B0 + (size_t)kb1 * ldb + bn) : make_float4(0.f, 0.f, 0.f, 0.f);
        const float4 bv10 = (DUAL && bok) ? *(const float4*)(B1 + (size_t)kb0 * ldb + bn) : bv00;
        const float4 bv11 = (DUAL && bok) ? *(const float4*)(B1 + (size_t)kb1 * ldb + bn) : bv01;
        __syncthreads();
        { const int r = (tid >> 3);
          As[(akk + 0) * 132 + r] = av0.x; As[(akk + 1) * 132 + r] = av0.y; As[(akk + 2) * 132 + r] = av0.z; As[(akk + 3) * 132 + r] = av0.w;
          As[(akk + 0) * 132 + r + 64] = av1.x; As[(akk + 1) * 132 + r + 64] = av1.y; As[(akk + 2) * 132 + r + 64] = av1.z; As[(akk + 3) * 132 + r + 64] = av1.w; }
        { const int k = (tid >> 5);
          *(float4*)&Bs0[k * 128 + (tid & 31) * 4] = bv00; *(float4*)&Bs0[(k + 16) * 128 + (tid & 31) * 4] = bv01;
          if (DUAL) { *(float4*)&Bs1[k * 128 + (tid & 31) * 4] = bv10; *(float4*)&Bs1[(k + 16) * 128 + (tid & 31) * 4] = bv11; } }
        __syncthreads();
#pragma unroll 4
        for (int k = 0; k < 32; ++k) {
            const float4 a = *(const float4*)&As[k * 132 + ty * 4];
            const float4 b0 = *(const float4*)&Bs0[k * 128 + tx * 4], b1 = *(const float4*)&Bs0[k * 128 + 64 + tx * 4];
            const float aa[4] = {a.x, a.y, a.z, a.w};
            const float bb[8] = {b0.x, b0.y, b0.z, b0.w, b1.x, b1.y, b1.z, b1.w};
#pragma unroll
            for (int i = 0; i < 4; ++i)
#pragma unroll
                for (int j = 0; j < 8; ++j) acc0[i][j] = fmaf(aa[i], bb[j], acc0[i][j]);
            if (DUAL) {
                const float4 c0 = *(const float4*)&Bs1[k * 128 + tx * 4], c1 = *(const float4*)&Bs1[k * 128 + 64 + tx * 4];
                const float cc[8] = {c0.x, c0.y, c0.z, c0.w, c1.x, c1.y, c1.z, c1.w};
#pragma unroll
                for (int i = 0; i < 4; ++i)
#pragma unroll
                    for (int j = 0; j < 8; ++j) acc1[i][j] = fmaf(aa[i], cc[j], acc1[i][j]);
            }
        }
    }
#pragma unroll
    for (int i = 0; i < 4; ++i)
#pragma unroll
        for (int j = 0; j < 8; ++j) {
            const int r = ty * 4 + i, c = n0 + (j < 4 ? tx * 4 + j : 64 + tx * 4 + (j - 4));
            if (c < N) epi(r, c, acc0[i][j], acc1[i][j]);
        }
    __syncthreads();
}

__device__ __forceinline__ void ph_inproj(LAS unsigned char* ldsb, const bf16_t* xn, const bf16_t* wt, bf16_t* z, const float* RS, int skip) {
    pg8::StaticOrder S; S.init(NTOK, NMAIN, D, D, gridDim.x, blockIdx.x, xn, wt, INPROJ_WGM);
    if (skip & 2) S.pmmask = 15;
    pg8::EpiZ E{z, RS, skip & 1};
    pg8::gemm_phase<pg8::EpiZ, pg8::StaticOrder, false>(ldsb, D, D, S, E);
}

namespace ml {
using pg8::bf16x8; using pg8::f32x4; using pg8::u32x4; using pg8::u32x2;
constexpr int L = 128, NCH = S / L, NU = NB * 4 * NCH;
constexpr int QP = 144, TP = 272;
constexpr int OFF_Q = 0, OFF_K = OFF_Q + 128 * QP, OFF_VT = OFF_K + 128 * QP, OFF_KT = OFF_VT + 64 * TP, OFF_F = OFF_KT + 64 * TP;
constexpr int LDS_END = OFF_F + 4 * 128 * 4 + 64;
constexpr size_t O_CL = 0, O_CST = O_CL + (size_t)NU * 4096 * 4, O_NL = O_CST + (size_t)NU * 4096 * 2, O_NST = O_NL + (size_t)NU * 64 * 4,
                 O_MLOC = O_NST + (size_t)NU * 64 * 4, O_BL = O_MLOC + (size_t)NU * 4, O_MST = O_BL + (size_t)NU * 4, O_END = O_MST + (size_t)NU * 4;
__device__ __forceinline__ f32x4 mfma16(bf16x8 a, bf16x8 b, f32x4 c) { return __builtin_amdgcn_mfma_f32_16x16x32_bf16(a, b, c, 0, 0, 0); }
__device__ __forceinline__ float bf_lo(unsigned w) { return __uint_as_float(w << 16); }
__device__ __forceinline__ float bf_hi(unsigned w) { return __uint_as_float(w & 0xffff0000u); }
__device__ __forceinline__ unsigned short bf1(float x) { return (unsigned short)(pg8::cvt_pk_bf16(x, 0.f) & 0xffffu); }

__device__ __forceinline__ void stage_gates(LAS unsigned char* lds, const float* gates, const Params& P, int l, int head, int tok0, int tid) {
    LAS float* LF = (LAS float*)(lds + OFF_F); LAS float* IG = LF + 128; LAS float* Bc = LF + 256; LAS float* G2 = LF + 384; LAS float* scal = LF + 512;
    if (tid < 128) { const float* zr = gates + (size_t)(tok0 + tid) * 8;
        const float ipre = zr[head] + P.in[I_GATEB][l * 8 + head], fpre = zr[4 + head] + P.in[I_GATEB][l * 8 + 4 + head];
        LF[tid] = fminf(fpre, 0.f) - log1pf(expf(-fabsf(fpre))); IG[tid] = ipre; }
    __syncthreads();
    if (tid < 64) { const float a = LF[2 * tid], b2 = LF[2 * tid + 1]; const float s = a + b2; float inc = s;
#pragma unroll
        for (int o = 1; o < 64; o <<= 1) { const float v = __shfl_up(inc, o); if (tid >= o) inc += v; }
        const float exc = inc - s; const float b0 = exc + a, b1 = exc + s;
        Bc[2 * tid] = b0; Bc[2 * tid + 1] = b1; const float g0 = IG[2 * tid] - b0, g1 = IG[2 * tid + 1] - b1; G2[2 * tid] = g0; G2[2 * tid + 1] = g1;
        float gm = fmaxf(g0, g1);
#pragma unroll
        for (int o = 32; o > 0; o >>= 1) gm = fmaxf(gm, __shfl_xor(gm, o));
        if (tid == 63) { scal[0] = gm; scal[1] = b1; } }
    __syncthreads();
}
__device__ __forceinline__ void conv8_load(const bf16_t* z, int b, int pos, int which, int head, int c0, u32x4 (&raw)[4]) {
    const int col = (which ? ZCK : ZCQ) + head * 64 + c0;
#pragma unroll
    for (int j = 0; j < 4; ++j) { const int tg = pos - 3 + j; raw[j] = *(const u32x4*)(z + (size_t)(b * S + (tg > 0 ? tg : 0)) * ZW + col); }
}
__device__ __forceinline__ void conv8_finish(const u32x4 (&raw)[4], const float* cw, int pos, int which, int head, int c0, float (&o)[8]) {
    const int cc = which * 256 + head * 64 + c0;
    float x[8];
#pragma unroll
    for (int e = 0; e < 8; ++e) x[e] = 0.f;
    float4 wa[4], wb[4];
#pragma unroll
    for (int j = 0; j < 4; ++j) { wa[j] = *(const float4*)(cw + j * 512 + cc); wb[j] = *(const float4*)(cw + j * 512 + cc + 4); }
    __builtin_amdgcn_sched_barrier(0);
#pragma unroll
    for (int j = 0; j < 4; ++j) { const float mk = (pos - 3 + j >= 0) ? 1.f : 0.f;
        const float4 w0 = wa[j], w1 = wb[j];
        x[0] += mk * w0.x * bf_lo(raw[j].x); x[1] += mk * w0.y * bf_hi(raw[j].x); x[2] += mk * w0.z * bf_lo(raw[j].y); x[3] += mk * w0.w * bf_hi(raw[j].y);
        x[4] += mk * w1.x * bf_lo(raw[j].z); x[5] += mk * w1.y * bf_hi(raw[j].z); x[6] += mk * w1.z * bf_lo(raw[j].w); x[7] += mk * w1.w * bf_hi(raw[j].w); }
    const float sc = which ? 0.125f : 1.f;
#pragma unroll
    for (int e = 0; e < 8; ++e) o[e] = x[e] * sc * rsig(x[e]);
}
__device__ __forceinline__ void vt_load(const bf16_t* z, int head, int tok0, int tid, u32x4 (&w)[2]) {
#pragma unroll
    for (int it = 0; it < 2; ++it) { const int idx = tid + it * NTHREADS, s = idx & 127, cg = idx >> 7; w[it] = *(const u32x4*)(z + (size_t)(tok0 + s) * ZW + ZCV + head * 64 + cg * 8); }
}
__device__ __forceinline__ void vt_store(LAS unsigned char* lds, int tid, const u32x4 (&w)[2]) {
#pragma unroll
    for (int it = 0; it < 2; ++it) { const int idx = tid + it * NTHREADS, s = idx & 127, cg = idx >> 7; const unsigned ww[4] = {w[it].x, w[it].y, w[it].z, w[it].w};
#pragma unroll
        for (int e = 0; e < 8; ++e) *(LAS unsigned short*)(lds + OFF_VT + (cg * 8 + e) * TP + s * 2) = (unsigned short)((e & 1) ? (ww[e >> 1] >> 16) : (ww[e >> 1] & 0xffffu)); }
}

__device__ __forceinline__ void p1_unit(LAS unsigned char* lds, const bf16_t* z, const float* gates, const Params& P, int l, int u, unsigned char* wsm) {
    const int tid = tid_opaque(), lane = tid & 63, wid = __builtin_amdgcn_readfirstlane(tid >> 6), r = lane & 15, qd = lane >> 4;
    const int b = u >> 8, head = (u >> 6) & 3, c = u & 63, tok0 = b * S + c * L;
    LAS float* G2 = (LAS float*)(lds + OFF_F) + 384; LAS float* scal = (LAS float*)(lds + OFF_F) + 512;
    u32x4 vraw[2], kraw[2][4];
    vt_load(z, head, tok0, tid, vraw);
#pragma unroll
    for (int it = 0; it < 2; ++it) { const int idx = tid + it * NTHREADS; conv8_load(z, b, c * L + (idx & 127), 1, head, (idx >> 7) * 8, kraw[it]); }
    __syncthreads();
    stage_gates(lds, gates, P, l, head, tok0, tid);
    const float gmax = scal[0], bL = scal[1];
    vt_store(lds, tid, vraw);
    const float* cw = P.in[I_CONVW] + (size_t)l * 4 * 512;
#pragma unroll
    for (int it = 0; it < 2; ++it) { const int idx = tid + it * NTHREADS, s = idx & 127, cg = idx >> 7;
        float o[8]; conv8_finish(kraw[it], cw, c * L + s, 1, head, cg * 8, o);
        const float ws = __expf(G2[s] - gmax);
#pragma unroll
        for (int e = 0; e < 8; ++e) *(LAS unsigned short*)(lds + OFF_KT + (cg * 8 + e) * TP + s * 2) = bf1(o[e] * ws); }
    __syncthreads();
    const int kt = wid >> 1;
    float* CL = (float*)(wsm + O_CL) + (size_t)u * 4096;
#pragma unroll
    for (int i = 0; i < 2; ++i) { const int vt = (wid & 1) * 2 + i; f32x4 acc = {0.f, 0.f, 0.f, 0.f};
#pragma unroll
        for (int ks = 0; ks < 4; ++ks) { const bf16x8 a = *(const LAS bf16x8*)(lds + OFF_KT + (16 * kt + r) * TP + (32 * ks + 8 * qd) * 2), bb = *(const LAS bf16x8*)(lds + OFF_VT + (16 * vt + r) * TP + (32 * ks + 8 * qd) * 2);
            acc = mfma16(a, bb, acc); }
        *(f32x4*)(CL + (size_t)(16 * vt + r) * 64 + 16 * kt + 4 * qd) = acc; }
    if (tid < 64) { float sum = 0.f;
        for (int s2 = 0; s2 < 128; s2 += 2) { const unsigned w2 = *(const LAS unsigned*)(lds + OFF_KT + tid * TP + s2 * 2); sum += bf_lo(w2) + bf_hi(w2); }
        ((float*)(wsm + O_NL))[(size_t)u * 64 + tid] = sum; }
    if (tid == 0) { ((float*)(wsm + O_MLOC))[u] = bL + gmax; ((float*)(wsm + O_BL))[u] = bL; }
}
__device__ __forceinline__ void p2_scan(unsigned char* wsm) {
    const int tid = tid_opaque();
    const float* CL = (const float*)(wsm + O_CL); const float* NL = (const float*)(wsm + O_NL); const float* MLOC = (const float*)(wsm + O_MLOC); const float* BL = (const float*)(wsm + O_BL);
    bf16_t* CST = (bf16_t*)(wsm + O_CST); float* NST = (float*)(wsm + O_NST); float* MST = (float*)(wsm + O_MST);
    for (int idx = blockIdx.x * NTHREADS + tid; idx < 32 * 4096; idx += gridDim.x * NTHREADS) {
        const int bh = idx >> 12, e = idx & 4095;
        float C = 0.f, nn = 0.f, m = 0.f;
#pragma unroll 1
        for (int c0 = 0; c0 < NCH; c0 += 16) {
            float cl[16], ml_[16], bl[16], nl[16];
#pragma unroll
            for (int i = 0; i < 16; ++i) { const int u = bh * NCH + c0 + i; cl[i] = CL[(size_t)u * 4096 + e]; ml_[i] = MLOC[u]; bl[i] = BL[u]; nl[i] = NL[(size_t)u * 64 + (e & 63)]; }
            unsigned short cs[16]; float ns[16], ms[16];
#pragma unroll
            for (int i = 0; i < 16; ++i) { cs[i] = bf1(C); ns[i] = nn; ms[i] = m;
                const float mn = fmaxf(bl[i] + m, ml_[i]), dec = __expf(bl[i] + m - mn), wl = __expf(ml_[i] - mn);
                C = dec * C + wl * cl[i]; nn = dec * nn + wl * nl[i]; m = mn; }
#pragma unroll
            for (int i = 0; i < 16; ++i) { const int u = bh * NCH + c0 + i; CST[(size_t)u * 4096 + e] = cs[i]; if (e < 64) NST[(size_t)u * 64 + e] = ns[i]; if (e == 0) MST[u] = ms[i]; }
        }
    }
}
__device__ __forceinline__ void p3_unit(LAS unsigned char* lds, const bf16_t* z, const float* gates, const Params& P, int l, int u, const unsigned char* wsm, bf16_t* mix) {
    const int tid = tid_opaque(), lane = tid & 63, wid = __builtin_amdgcn_readfirstlane(tid >> 6), r = lane & 15, qd = lane >> 4;
    const int b = u >> 8, head = (u >> 6) & 3, c = u & 63, tok0 = b * S + c * L;
    LAS float* Bc = (LAS float*)(lds + OFF_F) + 256; LAS float* G2 = (LAS float*)(lds + OFF_F) + 384;
    u32x4 vraw[2], qkraw[4][4];
    vt_load(z, head, tok0, tid, vraw);
#pragma unroll
    for (int it = 0; it < 4; ++it) { const int idx = tid + it * NTHREADS; conv8_load(z, b, c * L + ((idx >> 3) & 127), idx >> 10, head, (idx & 7) * 8, qkraw[it]); }
    __syncthreads();
    stage_gates(lds, gates, P, l, head, tok0, tid);
    vt_store(lds, tid, vraw);
    const float* cw = P.in[I_CONVW] + (size_t)l * 4 * 512;
#pragma unroll
    for (int it = 0; it < 4; ++it) { const int idx = tid + it * NTHREADS, which = idx >> 10, s = (idx >> 3) & 127, cg = idx & 7;
        float o[8]; conv8_finish(qkraw[it], cw, c * L + s, which, head, cg * 8, o);
        u32x4 w; w.x = pg8::cvt_pk_bf16(o[0], o[1]); w.y = pg8::cvt_pk_bf16(o[2], o[3]); w.z = pg8::cvt_pk_bf16(o[4], o[5]); w.w = pg8::cvt_pk_bf16(o[6], o[7]);
        *(LAS u32x4*)(lds + (which ? OFF_K : OFF_Q) + s * QP + cg * 16) = w; }
    __syncthreads();
    const int w = wid, t = 16 * w + r;
    const bf16x8 bq0 = *(const LAS bf16x8*)(lds + OFF_Q + t * QP + qd * 16), bq1 = *(const LAS bf16x8*)(lds + OFF_Q + t * QP + 64 + qd * 16);
    f32x4 accS[8];
#pragma unroll
    for (int ct = 0; ct < 8; ++ct) { accS[ct] = (f32x4){0.f, 0.f, 0.f, 0.f};
        if (ct <= w) { const bf16x8 a0 = *(const LAS bf16x8*)(lds + OFF_K + (16 * ct + r) * QP + qd * 16), a1 = *(const LAS bf16x8*)(lds + OFF_K + (16 * ct + r) * QP + 64 + qd * 16);
            accS[ct] = mfma16(a0, bq0, accS[ct]); accS[ct] = mfma16(a1, bq1, accS[ct]); } }
    const float bt = Bc[t], mst = ((const float*)(wsm + O_MST))[u];
    float ld[8][4]; float mloc = -3.0e38f;
#pragma unroll
    for (int ct = 0; ct < 8; ++ct) { const f32x4 g = *(const LAS f32x4*)(G2 + 16 * ct + 4 * qd);
#pragma unroll
        for (int j = 0; j < 4; ++j) { const bool valid = (ct < w) || (ct == w && 4 * qd + j <= r); ld[ct][j] = valid ? bt + g[j] : -3.0e38f; mloc = fmaxf(mloc, ld[ct][j]); } }
    mloc = fmaxf(mloc, __shfl_xor(mloc, 16)); mloc = fmaxf(mloc, __shfl_xor(mloc, 32));
    const float mt = fmaxf(bt + mst, mloc);
    float den = 0.f;
#pragma unroll
    for (int ct = 0; ct < 8; ++ct)
#pragma unroll
        for (int j = 0; j < 4; ++j) { const float pe = __expf(ld[ct][j] - mt) * accS[ct][j]; accS[ct][j] = pe; den += pe; }
    den += __shfl_xor(den, 16); den += __shfl_xor(den, 32);
    const bf16_t* cst = (const bf16_t*)(wsm + O_CST) + (size_t)u * 4096; const float* nst = (const float*)(wsm + O_NST) + (size_t)u * 64;
    f32x4 accN[4];
#pragma unroll
    for (int dt = 0; dt < 4; ++dt) { const bf16x8 c0 = *(const bf16x8*)(cst + (16 * dt + r) * 64 + 8 * qd), c1 = *(const bf16x8*)(cst + (16 * dt + r) * 64 + 32 + 8 * qd);
        accN[dt] = mfma16(c0, bq0, (f32x4){0.f, 0.f, 0.f, 0.f}); accN[dt] = mfma16(c1, bq1, accN[dt]); }
    const float winter = __expf(bt + mst - mt);
    float nq = 0.f;
    { const float4 n0 = *(const float4*)(nst + 8 * qd), n1 = *(const float4*)(nst + 8 * qd + 4), n2 = *(const float4*)(nst + 32 + 8 * qd), n3 = *(const float4*)(nst + 36 + 8 * qd);
      const u32x4 q0 = __builtin_bit_cast(u32x4, bq0), q1 = __builtin_bit_cast(u32x4, bq1);
      nq = bf_lo(q0.x) * n0.x + bf_hi(q0.x) * n0.y + bf_lo(q0.y) * n0.z + bf_hi(q0.y) * n0.w + bf_lo(q0.z) * n1.x + bf_hi(q0.z) * n1.y + bf_lo(q0.w) * n1.z + bf_hi(q0.w) * n1.w
         + bf_lo(q1.x) * n2.x + bf_hi(q1.x) * n2.y + bf_lo(q1.y) * n2.z + bf_hi(q1.y) * n2.w + bf_lo(q1.z) * n3.x + bf_hi(q1.z) * n3.y + bf_lo(q1.w) * n3.z + bf_hi(q1.w) * n3.w; }
    nq += __shfl_xor(nq, 16); nq += __shfl_xor(nq, 32);
    den += winter * nq;
#pragma unroll
    for (int dt = 0; dt < 4; ++dt) accN[dt] = accN[dt] * winter;
#pragma unroll
    for (int kk = 0; kk < 4; ++kk) if (2 * kk <= w) {
        u32x4 pw; pw.x = pg8::cvt_pk_bf16(accS[2 * kk][0], accS[2 * kk][1]); pw.y = pg8::cvt_pk_bf16(accS[2 * kk][2], accS[2 * kk][3]);
        pw.z = pg8::cvt_pk_bf16(accS[2 * kk + 1][0], accS[2 * kk + 1][1]); pw.w = pg8::cvt_pk_bf16(accS[2 * kk + 1][2], accS[2 * kk + 1][3]);
        const bf16x8 pf = __builtin_bit_cast(bf16x8, pw);
#pragma unroll
        for (int dt = 0; dt < 4; ++dt) { const u32x2 v0 = *(const LAS u32x2*)(lds + OFF_VT + (16 * dt + r) * TP + (32 * kk + 4 * qd) * 2), v1 = *(const LAS u32x2*)(lds + OFF_VT + (16 * dt + r) * TP + (32 * kk + 16 + 4 * qd) * 2);
            u32x4 vw; vw.x = v0.x; vw.y = v0.y; vw.z = v1.x; vw.w = v1.y;
            accN[dt] = mfma16(__builtin_bit_cast(bf16x8, vw), pf, accN[dt]); } }
    const float inv = 1.f / fmaxf(fabsf(den), __expf(-mt));
    float ss = 0.f;
#pragma unroll
    for (int dt = 0; dt < 4; ++dt) { accN[dt] = accN[dt] * inv; ss += accN[dt][0] * accN[dt][0] + accN[dt][1] * accN[dt][1] + accN[dt][2] * accN[dt][2] + accN[dt][3] * accN[dt][3]; }
    ss += __shfl_xor(ss, 16); ss += __shfl_xor(ss, 32);
    const float rs = rsqrtf(ss * (1.f / 64.f) + EPS);
    const float* ng = P.in[I_MNG] + l * 256 + head * 64; const bf16_t* cop = z + (size_t)(tok0 + t) * ZW + ZCO + head * 64;
    bf16_t* op = mix + (size_t)(tok0 + t) * D + 512 + head * 64;
#pragma unroll
    for (int dt = 0; dt < 4; ++dt) { const int d0 = 16 * dt + 4 * qd; const float4 g = *(const float4*)(ng + d0); const u32x2 cw2 = *(const u32x2*)(cop + d0); const float4 co = make_float4(bf_lo(cw2.x), bf_hi(cw2.x), bf_lo(cw2.y), bf_hi(cw2.y));
        u32x2 o; o.x = pg8::cvt_pk_bf16(accN[dt][0] * rs * g.x * rsig(co.x), accN[dt][1] * rs * g.y * rsig(co.y));
        o.y = pg8::cvt_pk_bf16(accN[dt][2] * rs * g.z * rsig(co.z), accN[dt][3] * rs * g.w * rsig(co.w));
        *(u32x2*)(op + d0) = o; }
}
static_assert(O_END <= 64 * MiB && LDS_END <= 128 * 1024, "mLSTM scratch fits");
}

namespace s5 {
using pg8::bf16x8; using pg8::f32x4; using pg8::u32x4; using pg8::u32x2;
constexpr int LC = 16, NINST = NTOK / LC;
constexpr size_t O_E = 0, O_XC = O_E + (size_t)NINST * 16 * 128 * 4, O_END = O_XC + (size_t)NINST * 16 * 128 * 2;
constexpr int YP = 528;
__device__ __forceinline__ f32x4 mfma16(bf16x8 a, bf16x8 b, f32x4 c) { return __builtin_amdgcn_mfma_f32_16x16x32_bf16(a, b, c, 0, 0, 0); }

__device__ __forceinline__ void build_tables(float* ldsf, const Params& P, int l, int g, unsigned char* tb) {
    const int tid = tid_opaque();
    float* apw = ldsf; float* bb = apw + 17 * 64 * 2; float* cc = bb + 64 * 16 * 2;
    __syncthreads();
    if (tid < 64) { const int gp = (l * 16 + g) * 64 + tid;
        const float ar = P.in[I_ARE][gp], ai = P.in[I_AIM][gp], dt = expf(P.in[I_LDT][l * 16 + g]);
        for (int tau = 0; tau <= 16; ++tau) { const float er = expf(ar * dt * tau), ang = ai * dt * tau; apw[(tau * 64 + tid) * 2] = er * cosf(ang); apw[(tau * 64 + tid) * 2 + 1] = er * sinf(ang); }
        const float abr = apw[(64 + tid) * 2], abi = apw[(64 + tid) * 2 + 1];
        const float xr_ = abr - 1.f, xi_ = abi, den = ar * ar + ai * ai;
        const float cr = (xr_ * ar + xi_ * ai) / den, ci = (xi_ * ar - xr_ * ai) / den;
        for (int h = 0; h < 16; ++h) { const float br = P.in[I_BRE][(size_t)gp * 16 + h], bi = P.in[I_BIM][(size_t)gp * 16 + h]; bb[(tid * 16 + h) * 2] = cr * br - ci * bi; bb[(tid * 16 + h) * 2 + 1] = cr * bi + ci * br; }
        float* a16 = (float*)(tb + T_A16) + (size_t)(g * 64 + tid) * 2; a16[0] = apw[(16 * 64 + tid) * 2]; a16[1] = apw[(16 * 64 + tid) * 2 + 1]; }
    for (int idx = tid; idx < 16 * 64; idx += NTHREADS) { const int h = idx >> 6, p = idx & 63; const int ci_ = ((l * 16 + g) * 16 + h) * 64 + p; cc[idx * 2] = P.in[I_CRE][ci_]; cc[idx * 2 + 1] = P.in[I_CIM][ci_]; }
    __syncthreads();
    bf16_t* KM = (bf16_t*)(tb + T_KMAT) + (size_t)g * 32 * 256;
    for (int idx = tid; idx < 15 * 256; idx += NTHREADS) KM[idx] = (bf16_t)0; bf16_t* FT = (bf16_t*)(tb + T_F) + (size_t)g * 256 * 128; bf16_t* GT = (bf16_t*)(tb + T_G) + (size_t)g * 128 * 256;
    for (int idx = tid; idx < 16 * 256; idx += NTHREADS) { const int tau = idx >> 8, h = (idx >> 4) & 15, hp = idx & 15; float s = 0.f;
        for (int p = 0; p < 64; ++p) { const float cr = cc[(h * 64 + p) * 2], ci = cc[(h * 64 + p) * 2 + 1], ar = apw[(tau * 64 + p) * 2], ai = apw[(tau * 64 + p) * 2 + 1], br = bb[(p * 16 + hp) * 2], bi = bb[(p * 16 + hp) * 2 + 1];
            const float er = ar * br - ai * bi, ei = ar * bi + ai * br; s += cr * er - ci * ei; }
        KM[15 * 256 + idx] = ml::bf1(s); }
    for (int idx = tid; idx < 256 * 64; idx += NTHREADS) { const int n = idx >> 6, p = idx & 63, t = n >> 4, h = n & 15;
        const float cr = cc[(h * 64 + p) * 2], ci = cc[(h * 64 + p) * 2 + 1], ar = apw[((t + 1) * 64 + p) * 2], ai = apw[((t + 1) * 64 + p) * 2 + 1];
        FT[(size_t)n * 128 + p] = ml::bf1(cr * ar - ci * ai); FT[(size_t)n * 128 + 64 + p] = ml::bf1(-(cr * ai + ci * ar)); }
    for (int idx = tid; idx < 64 * 256; idx += NTHREADS) { const int p = idx >> 8, k = idx & 255, s = k >> 4, hp = k & 15;
        const float ar = apw[((15 - s) * 64 + p) * 2], ai = apw[((15 - s) * 64 + p) * 2 + 1], br = bb[(p * 16 + hp) * 2], bi = bb[(p * 16 + hp) * 2 + 1];
        GT[(size_t)p * 256 + k] = ml::bf1(ar * br - ai * bi); GT[(size_t)(64 + p) * 256 + k] = ml::bf1(ar * bi + ai * br); }
}
__device__ __forceinline__ void load_u_frags(const bf16_t* z, int tok0, int g, int r, int qd, bf16x8 (&uf)[8]) {
#pragma unroll
    for (int ks = 0; ks < 8; ++ks) uf[ks] = *(const bf16x8*)(z + (size_t)(tok0 + 16 * r + 2 * ks + (qd >> 1)) * ZW + ZSU + 16 * g + 8 * (qd & 1));
}
__device__ __forceinline__ void p1_unit(const bf16_t* z, const unsigned char* tb, int u, unsigned char* wss) {
    const int tid = tid_opaque(), lane = tid & 63, wid = __builtin_amdgcn_readfirstlane(tid >> 6), r = lane & 15, qd = lane >> 4;
    const int tok0 = u * 256, inst0 = u * 16;
    float* E = (float*)(wss + O_E);
#pragma unroll 1
    for (int gi = 0; gi < 2; ++gi) { const int g = 2 * wid + gi;
        bf16x8 uf[8]; load_u_frags(z, tok0, g, r, qd, uf);
        const bf16_t* GT = (const bf16_t*)(tb + T_G) + (size_t)g * 128 * 256 + (size_t)r * 256 + 8 * qd;
        bf16x8 gf[2][8];
#pragma unroll
        for (int ks = 0; ks < 8; ++ks) gf[0][ks] = *(const bf16x8*)(GT + 32 * ks);
#pragma unroll
        for (int nt = 0; nt < 8; ++nt) {
            if (nt + 1 < 8) {
#pragma unroll
                for (int ks = 0; ks < 8; ++ks) gf[(nt + 1) & 1][ks] = *(const bf16x8*)(GT + (size_t)(16 * (nt + 1)) * 256 + 32 * ks); }
            __builtin_amdgcn_sched_barrier(0);
            f32x4 acc = {0.f, 0.f, 0.f, 0.f};
#pragma unroll
            for (int ks = 0; ks < 8; ++ks) acc = mfma16(gf[nt & 1][ks], uf[ks], acc);
            *(f32x4*)(E + ((size_t)(inst0 + r) * 16 + g) * 128 + 16 * nt + 4 * qd) = acc;
            __builtin_amdgcn_sched_barrier(0); }
    }
}
__device__ __forceinline__ void p2_scan(LAS unsigned char* lds, const unsigned char* tb, unsigned char* wss) {
    const int tid = tid_opaque(), p = tid & 63, seg = tid >> 6;
    const float* __restrict__ E = (const float*)(wss + O_E); bf16_t* __restrict__ XC = (bf16_t*)(wss + O_XC);
    LAS float* SE = (LAS float*)lds;
    for (int u = blockIdx.x; u < NB * 16; u += gridDim.x) {
        const int b = u >> 4, g = u & 15;
        const float* a16 = (const float*)(tb + T_A16) + (size_t)(g * 64 + p) * 2; const float ar = a16[0], ai = a16[1];
        const size_t o0 = ((size_t)(b * (S / LC) + seg * 64) * 16 + g) * 128 + p; constexpr size_t cs = (size_t)16 * 128;
        float xr = 0.f, xi = 0.f;
#pragma unroll 1
        for (int c0 = 0; c0 < 64; c0 += 16) { float er[16], ei[16];
#pragma unroll
            for (int i = 0; i < 16; ++i) { er[i] = E[o0 + (c0 + i) * cs]; ei[i] = E[o0 + (c0 + i) * cs + 64]; }
#pragma unroll
            for (int i = 0; i < 16; ++i) { const float nr = ar * xr - ai * xi + er[i], ni = ar * xi + ai * xr + ei[i]; xr = nr; xi = ni; } }
        __syncthreads();
        SE[(seg * 64 + p) * 2] = xr; SE[(seg * 64 + p) * 2 + 1] = xi;
        __syncthreads();
        float br = ar, bi = ai;
#pragma unroll
        for (int i = 0; i < 6; ++i) { const float nr = br * br - bi * bi, ni = 2.f * br * bi; br = nr; bi = ni; }
        xr = 0.f; xi = 0.f;
        for (int s2 = 0; s2 < seg; ++s2) { const float er = SE[(s2 * 64 + p) * 2], ei = SE[(s2 * 64 + p) * 2 + 1]; const float nr = br * xr - bi * xi + er, ni = br * xi + bi * xr + ei; xr = nr; xi = ni; }
#pragma unroll 1
        for (int c0 = 0; c0 < 64; c0 += 16) { float er[16], ei[16]; unsigned short sr[16], si[16];
#pragma unroll
            for (int i = 0; i < 16; ++i) { er[i] = E[o0 + (c0 + i) * cs]; ei[i] = E[o0 + (c0 + i) * cs + 64]; }
#pragma unroll
            for (int i = 0; i < 16; ++i) { sr[i] = ml::bf1(xr); si[i] = ml::bf1(xi); const float nr = ar * xr - ai * xi + er[i], ni = ar * xi + ai * xr + ei[i]; xr = nr; xi = ni; }
#pragma unroll
            for (int i = 0; i < 16; ++i) { XC[o0 + (c0 + i) * cs] = sr[i]; XC[o0 + (c0 + i) * cs + 64] = si[i]; } }
    }
    __syncthreads();
}
__device__ __forceinline__ void p3_unit(LAS unsigned char* lds, const bf16_t* z, const Params& P, int l, const unsigned char* tb, int u, const unsigned char* wss, bf16_t* mix) {
    const int tid = tid_opaque(), lane = tid & 63, wid = __builtin_amdgcn_readfirstlane(tid >> 6), r = lane & 15, qd = lane >> 4;
    const int tok0 = u * 256, inst0 = u * 16;
    const bf16_t* XC = (const bf16_t*)(wss + O_XC);
    __syncthreads();
#pragma unroll 1
    for (int gi = 0; gi < 2; ++gi) { const int g = 2 * wid + gi;
        bf16x8 uf[8]; load_u_frags(z, tok0, g, r, qd, uf);
        bf16x8 xf[4];
#pragma unroll
        for (int ks = 0; ks < 4; ++ks) xf[ks] = *(const bf16x8*)(XC + ((size_t)(inst0 + r) * 16 + g) * 128 + 32 * ks + 8 * qd);
        const bf16_t* KM = (const bf16_t*)(tb + T_KMAT) + (size_t)g * 32 * 256 + (size_t)(15 - (qd >> 1)) * 256 + r * 16 + 8 * (qd & 1);
        const bf16_t* FT = (const bf16_t*)(tb + T_F) + (size_t)g * 256 * 128 + (size_t)r * 128 + 8 * qd;
        const bf16_t* up = z + (size_t)(tok0 + 16 * r) * ZW + ZSU + 16 * g + 4 * qd;
        const float4 dsk = *(const float4*)(P.in[I_SD] + l * 256 + g * 16 + 4 * qd);
        bf16x8 kf[2][8], ff[2][4]; u32x2 uw[2];
#pragma unroll
        for (int ks = 0; ks < 8; ++ks) kf[0][ks] = *(const bf16x8*)(KM + (ptrdiff_t)(0 - 2 * ks) * 256);
#pragma unroll
        for (int ks = 0; ks < 4; ++ks) ff[0][ks] = *(const bf16x8*)(FT + 32 * ks);
        uw[0] = *(const u32x2*)up;
#pragma unroll
        for (int t = 0; t < 16; ++t) {
            if (t + 1 < 16) {
#pragma unroll
                for (int ks = 0; ks < 8; ++ks) kf[(t + 1) & 1][ks] = *(const bf16x8*)(KM + (ptrdiff_t)(t + 1 - 2 * ks) * 256);
#pragma unroll
                for (int ks = 0; ks < 4; ++ks) ff[(t + 1) & 1][ks] = *(const bf16x8*)(FT + (size_t)(t + 1) * 16 * 128 + 32 * ks);
                uw[(t + 1) & 1] = *(const u32x2*)(up + (size_t)(t + 1) * ZW); }
            __builtin_amdgcn_sched_barrier(0);
            f32x4 acc = {0.f, 0.f, 0.f, 0.f};
#pragma unroll
            for (int ks = 0; ks < 8; ++ks) if (2 * ks <= t) acc = mfma16(kf[t & 1][ks], uf[ks], acc);
#pragma unroll
            for (int ks = 0; ks < 4; ++ks) acc = mfma16(ff[t & 1][ks], xf[ks], acc);
            const u32x2 uu = uw[t & 1];
            const float y0 = gelu_tanh(acc[0] + dsk.x * ml::bf_lo(uu.x)), y1 = gelu_tanh(acc[1] + dsk.y * ml::bf_hi(uu.x)), y2 = gelu_tanh(acc[2] + dsk.z * ml::bf_lo(uu.y)), y3 = gelu_tanh(acc[3] + dsk.w * ml::bf_hi(uu.y));
            u32x2 o; o.x = pg8::cvt_pk_bf16(y0, y1); o.y = pg8::cvt_pk_bf16(y2, y3);
            *(LAS u32x2*)(lds + (16 * r + t) * YP + (16 * g + 4 * qd) * 2) = o;
            __builtin_amdgcn_sched_barrier(0); }
    }
    __syncthreads();
    const bf16_t* GW = (const bf16_t*)(tb + T_GLUW);
    bf16x8 wf[2][8];
#pragma unroll
    for (int nt = 0; nt < 2; ++nt)
#pragma unroll
        for (int ks = 0; ks < 8; ++ks) wf[nt][ks] = *(const bf16x8*)(GW + (size_t)(32 * wid + 16 * nt + r) * 256 + 32 * ks + 8 * qd);
    const float* gb = P.in[I_GLUB] + l * 256;
    const float4 gb0 = *(const float4*)(gb + 32 * wid + 4 * qd), gb1 = *(const float4*)(gb + 32 * wid + 16 + 4 * qd);
#pragma unroll 2
    for (int mt = 0; mt < 16; ++mt) {
        f32x4 a0 = {0.f, 0.f, 0.f, 0.f}, a1 = {0.f, 0.f, 0.f, 0.f};
#pragma unroll
        for (int ks = 0; ks < 8; ++ks) { const bf16x8 yf = *(const LAS bf16x8*)(lds + (16 * mt + r) * YP + (32 * ks + 8 * qd) * 2); a0 = mfma16(wf[0][ks], yf, a0); a1 = mfma16(wf[1][ks], yf, a1); }
        const int row = 16 * mt + r;
        const u32x2 y0 = *(const LAS u32x2*)(lds + row * YP + (32 * wid + 4 * qd) * 2), y1 = *(const LAS u32x2*)(lds + row * YP + (32 * wid + 16 + 4 * qd) * 2);
        bf16_t* op = mix + (size_t)(tok0 + row) * D + 256 + 32 * wid + 4 * qd;
        u32x2 o;
        o.x = pg8::cvt_pk_bf16(ml::bf_lo(y0.x) * rsig(a0[0] + gb0.x), ml::bf_hi(y0.x) * rsig(a0[1] + gb0.y));
        o.y = pg8::cvt_pk_bf16(ml::bf_lo(y0.y) * rsig(a0[2] + gb0.z), ml::bf_hi(y0.y) * rsig(a0[3] + gb0.w));
        *(u32x2*)op = o;
        o.x = pg8::cvt_pk_bf16(ml::bf_lo(y1.x) * rsig(a1[0] + gb1.x), ml::bf_hi(y1.x) * rsig(a1[1] + gb1.y));
        o.y = pg8::cvt_pk_bf16(ml::bf_lo(y1.y) * rsig(a1[2] + gb1.z), ml::bf_hi(y1.y) * rsig(a1[3] + gb1.w));
        *(u32x2*)(op + 16) = o;
    }
}
static_assert(T_LAYER <= 4 * MiB && O_END <= 48 * MiB && 256 * YP <= LDS_BYTES - 64, "S5 scratch fits");
}
__device__ __forceinline__ void s5_build_tables_fwd(float* ldsf, const Params& P, int l, int g, unsigned char* tb) { s5::build_tables(ldsf, P, l, g, tb); }

namespace at {
using pg8::bf16x8; using pg8::f32x4; using pg8::u32x4; using pg8::u32x2;
constexpr int KP = 144, VP = 528, OFF_K = 0, OFF_VT = 256 * KP, LDS_END = OFF_VT + 64 * VP;
__device__ __forceinline__ void unit(LAS unsigned char* lds, const bf16_t* z, const float* sinks, bf16_t* mix, int u) {
    const int tid = tid_opaque(), lane = tid & 63, wid = __builtin_amdgcn_readfirstlane(tid >> 6), r = lane & 15, qd = lane >> 4;
    const int b = u >> 7, g = (u >> 6) & 1, n = u & 63, tokb = b * S + 128 * n;
    const int hq = 2 * g + (wid >> 2);
    const float sink = sinks[hq];
    __syncthreads();
    u32x4 kw[4], vw[4];
#pragma unroll
    for (int it = 0; it < 4; ++it) { const int idx = tid + it * NTHREADS, kl = idx >> 3, cg = idx & 7; const bool ok = (n > 0) || (kl >= 128);
        kw[it] = *(const u32x4*)(z + (size_t)(ok ? tokb - 128 + kl : tokb) * ZW + ZK + g * 64 + cg * 8); }
#pragma unroll
    for (int it = 0; it < 4; ++it) { const int idx = tid + it * NTHREADS, kl = idx & 255, cg = idx >> 8; const bool ok = (n > 0) || (kl >= 128);
        vw[it] = *(const u32x4*)(z + (size_t)(ok ? tokb - 128 + kl : tokb) * ZW + ZV + g * 64 + cg * 8); }
    __builtin_amdgcn_sched_barrier(0);
#pragma unroll
    for (int it = 0; it < 4; ++it) { const int idx = tid + it * NTHREADS, kl = idx >> 3, cg = idx & 7; const bool ok = (n > 0) || (kl >= 128);
        u32x4 w = kw[it]; if (!ok) w = (u32x4){0u, 0u, 0u, 0u};
        *(LAS u32x4*)(lds + OFF_K + kl * KP + cg * 16) = w; }
#pragma unroll
    for (int it = 0; it < 4; ++it) { const int idx = tid + it * NTHREADS, kl = idx & 255, cg = idx >> 8; const bool ok = (n > 0) || (kl >= 128);
        u32x4 w = vw[it]; if (!ok) w = (u32x4){0u, 0u, 0u, 0u};
        const unsigned ww[4] = {w.x, w.y, w.z, w.w};
#pragma unroll
        for (int e = 0; e < 8; ++e) *(LAS unsigned short*)(lds + OFF_VT + (cg * 8 + e) * VP + kl * 2) = (unsigned short)((e & 1) ? (ww[e >> 1] >> 16) : (ww[e >> 1] & 0xffffu)); }
    __syncthreads();
#pragma unroll 1
    for (int qt = 0; qt < 2; ++qt) {
        const int i0 = (wid & 3) * 32 + qt * 16, kt0 = i0 >> 4, tok = tokb + i0 + r;
        const bf16x8 bq0 = *(const bf16x8*)(z + (size_t)tok * ZW + ZQ + hq * 64 + 8 * qd), bq1 = *(const bf16x8*)(z + (size_t)tok * ZW + ZQ + hq * 64 + 32 + 8 * qd);
        f32x4 accS[9];
#pragma unroll
        for (int c = 0; c < 9; ++c) { const int kt = kt0 + c;
            const bf16x8 a0 = *(const LAS bf16x8*)(lds + OFF_K + (16 * kt + r) * KP + qd * 16), a1 = *(const LAS bf16x8*)(lds + OFF_K + (16 * kt + r) * KP + 64 + qd * 16);
            accS[c] = ml::mfma16(a0, bq0, (f32x4){0.f, 0.f, 0.f, 0.f}); accS[c] = ml::mfma16(a1, bq1, accS[c]); }
        float m = sink;
#pragma unroll
        for (int c = 0; c < 9; ++c)
#pragma unroll
            for (int j = 0; j < 4; ++j) { const int e = 4 * qd + j;
                bool valid = (c == 0) ? (e > r) : ((c == 8) ? (e <= r) : true);
                valid = valid && ((n > 0) || (kt0 + c >= 8));
                const float s = valid ? accS[c][j] * 0.125f : -3.0e38f; accS[c][j] = s; m = fmaxf(m, s); }
        m = fmaxf(m, __shfl_xor(m, 16)); m = fmaxf(m, __shfl_xor(m, 32));
        float l = 0.f;
#pragma unroll
        for (int c = 0; c < 9; ++c)
#pragma unroll
            for (int j = 0; j < 4; ++j) { const float p = __expf(accS[c][j] - m); accS[c][j] = p; l += p; }
        l += __shfl_xor(l, 16); l += __shfl_xor(l, 32);
        l += __expf(sink - m);
        f32x4 accO[4];
#pragma unroll
        for (int dt = 0; dt < 4; ++dt) accO[dt] = (f32x4){0.f, 0.f, 0.f, 0.f};
#pragma unroll
        for (int kk = 0; kk < 5; ++kk) {
            u32x4 pw; pw.x = pg8::cvt_pk_bf16(accS[2 * kk][0], accS[2 * kk][1]); pw.y = pg8::cvt_pk_bf16(accS[2 * kk][2], accS[2 * kk][3]);
            if (kk < 4) { pw.z = pg8::cvt_pk_bf16(accS[2 * kk + 1][0], accS[2 * kk + 1][1]); pw.w = pg8::cvt_pk_bf16(accS[2 * kk + 1][2], accS[2 * kk + 1][3]); } else { pw.z = 0u; pw.w = 0u; }
            const bf16x8 pf = __builtin_bit_cast(bf16x8, pw);
            const int base = 16 * (kt0 + 2 * kk);
#pragma unroll
            for (int dt = 0; dt < 4; ++dt) { const u32x2 v0 = *(const LAS u32x2*)(lds + OFF_VT + (16 * dt + r) * VP + (base + 4 * qd) * 2);
                u32x2 v1 = {0u, 0u}; if (kk < 4) v1 = *(const LAS u32x2*)(lds + OFF_VT + (16 * dt + r) * VP + (base + 16 + 4 * qd) * 2);
                u32x4 vw; vw.x = v0.x; vw.y = v0.y; vw.z = v1.x; vw.w = v1.y;
                accO[dt] = ml::mfma16(__builtin_bit_cast(bf16x8, vw), pf, accO[dt]); } }
        const float inv = 1.f / l;
        bf16_t* op = mix + (size_t)tok * D + hq * 64;
#pragma unroll
        for (int dt = 0; dt < 4; ++dt) { u32x2 o; o.x = pg8::cvt_pk_bf16(accO[dt][0] * inv, accO[dt][1] * inv); o.y = pg8::cvt_pk_bf16(accO[dt][2] * inv, accO[dt][3] * inv);
            *(u32x2*)(op + 16 * dt + 4 * qd) = o; }
    }
}
}

namespace sg {
using pg8::bf16x8; using pg8::f32x4; using pg8::u32x4; using pg8::u32x2;
constexpr int TP = 272, OFF_VT = 0, OFF_ST = 256 * TP, LDS_END = OFF_ST + 128 * 4 * 2 * 4;
__device__ __forceinline__ void unit(LAS unsigned char* lds, const bf16_t* z, const Params& P, int l, const bf16_t* wb  , bf16_t* mix, int u) {
    const int tid = tid_opaque(), lane = tid & 63, wid = __builtin_amdgcn_readfirstlane(tid >> 6), r = lane & 15, qd = lane >> 4;
    const int tok0 = u * 128;
    LAS float* ST = (LAS float*)(lds + OFF_ST);
    __syncthreads();
    const int s = tid & 127, cq = tid >> 7;
    const bf16_t* gp = z + (size_t)(tok0 + s) * ZW + ZGV + cq * 64;
    u32x4 raw[8];
#pragma unroll
    for (int i = 0; i < 8; ++i) raw[i] = *(const u32x4*)(gp + 8 * i);
    const int t = 16 * wid + r;
    bf16x8 wf[2][4];
#pragma unroll
    for (int ks = 0; ks < 4; ++ks) wf[0][ks] = *(const bf16x8*)(wb + (size_t)t * 128 + 32 * ks + 8 * qd);
    float sm = 0.f, sq = 0.f;
#pragma unroll
    for (int i = 0; i < 8; ++i) { const unsigned ww[4] = {raw[i].x, raw[i].y, raw[i].z, raw[i].w};
#pragma unroll
        for (int e = 0; e < 8; ++e) { const float ge = gelu_tanh((e & 1) ? bfh(ww[e >> 1]) : bfl(ww[e >> 1])); sm += ge; sq += ge * ge; } }
    ST[(s * 4 + cq) * 2] = sm; ST[(s * 4 + cq) * 2 + 1] = sq;
    __syncthreads();
    { float tsm = 0.f, tsq = 0.f;
#pragma unroll
      for (int q = 0; q < 4; ++q) { tsm += ST[(s * 4 + q) * 2]; tsq += ST[(s * 4 + q) * 2 + 1]; }
      const float mu = tsm * (1.f / 256.f), var = fmaxf(tsq * (1.f / 256.f) - mu * mu, 0.f), rs = rsqrtf(var + EPS);
      const float* lg = P.in[I_LNG] + l * 256 + cq * 64; const float* lb = P.in[I_LNB] + l * 256 + cq * 64;
#pragma unroll
      for (int i = 0; i < 8; ++i) { const unsigned ww[4] = {raw[i].x, raw[i].y, raw[i].z, raw[i].w};
          const float4 g0 = *(const float4*)(lg + 8 * i), g1 = *(const float4*)(lg + 8 * i + 4), b0 = *(const float4*)(lb + 8 * i), b1 = *(const float4*)(lb + 8 * i + 4);
          const float gg[8] = {g0.x, g0.y, g0.z, g0.w, g1.x, g1.y, g1.z, g1.w}, bb[8] = {b0.x, b0.y, b0.z, b0.w, b1.x, b1.y, b1.z, b1.w};
#pragma unroll
          for (int e = 0; e < 8; ++e) *(LAS unsigned short*)(lds + OFF_VT + (cq * 64 + 8 * i + e) * TP + s * 2) = ml::bf1((gelu_tanh((e & 1) ? bfh(ww[e >> 1]) : bfl(ww[e >> 1])) - mu) * rs * gg[e] + bb[e]); } }
    __syncthreads();
#pragma unroll
    for (int g = 0; g < 4; ++g) {
        if (g + 1 < 4) {
#pragma unroll
            for (int ks = 0; ks < 4; ++ks) wf[(g + 1) & 1][ks] = *(const bf16x8*)(wb + ((size_t)(g + 1) * 128 + t) * 128 + 32 * ks + 8 * qd); }
        const float bias = P.in[I_SGUB][l * 512 + g * 128 + t];
        u32x2 gw[4];
#pragma unroll
        for (int ct = 0; ct < 4; ++ct) gw[ct] = *(const u32x2*)(z + (size_t)(tok0 + t) * ZW + ZGU + g * 64 + 16 * ct + 4 * qd);
#pragma unroll
        for (int ct = 0; ct < 4; ++ct) { f32x4 acc = {0.f, 0.f, 0.f, 0.f};
#pragma unroll
            for (int ks = 0; ks < 4; ++ks) if (2 * ks <= wid) acc = ml::mfma16(*(const LAS bf16x8*)(lds + OFF_VT + (g * 64 + 16 * ct + r) * TP + (32 * ks + 8 * qd) * 2), wf[g & 1][ks], acc);
            const int c0 = g * 64 + 16 * ct + 4 * qd;
            u32x2 o; o.x = pg8::cvt_pk_bf16(gelu_tanh(bfl(gw[ct].x)) * (acc[0] + bias), gelu_tanh(bfh(gw[ct].x)) * (acc[1] + bias)); o.y = pg8::cvt_pk_bf16(gelu_tanh(bfl(gw[ct].y)) * (acc[2] + bias), gelu_tanh(bfh(gw[ct].y)) * (acc[3] + bias));
            *(u32x2*)(mix + (size_t)(tok0 + t) * D + 768 + c0) = o; }
    }
}
}

__device__ __forceinline__ void ph_mix1(float* lds, const Params& P, int l, bf16_t* z, const float* gates, bf16_t* mix, unsigned char* wsm, unsigned char* wss, const unsigned char* tb, int sub) {
    const int G = gridDim.x, bid = blockIdx.x;
    if (sub & 1) for (int u = bid; u < ml::NU; u += G) ml::p1_unit((LAS unsigned char*)lds, z, gates, P, l, u, wsm);
    __syncthreads();
    if (sub & 2) for (int u = bid; u < NTOK / 256; u += G) s5::p1_unit(z, tb, u, wss);
    __syncthreads();
    if (sub & 4) for (int u = bid; u < 1024; u += G) at::unit((LAS unsigned char*)lds, z, P.in[I_SINK] + l * 4, mix, u);
    __syncthreads();
    if (sub & 8) for (int u = bid; u < NTOK / 128; u += G) sg::unit((LAS unsigned char*)lds, z, P, l, (const bf16_t*)(tb + s5::T_SGUW), mix, u);
    __syncthreads();
}

__device__ __forceinline__ void ph_mix2(float* lds, const Params& P, int l, const bf16_t* z, const float* gates, bf16_t* mix, const unsigned char* wsm, const unsigned char* wss, const unsigned char* tb, int sub) {
    if (sub & 1) for (int u = blockIdx.x; u < NTOK / 256; u += gridDim.x) s5::p3_unit((LAS unsigned char*)lds, z, P, l, tb, u, wss, mix);
    __syncthreads();
    if (sub & 2) for (int u = blockIdx.x; u < ml::NU; u += gridDim.x) ml::p3_unit((LAS unsigned char*)lds, z, gates, P, l, u, wsm, mix);
    __syncthreads();
}

template <bool SRCF32>
__device__ __forceinline__ void ph_outproj(LAS unsigned char* ldsb, const bf16_t* mix, const bf16_t* wt, const float* xf, bf16_t* xb) {
    pg8::StaticOrder S; S.init(NTOK, D, D, D, gridDim.x, blockIdx.x, mix, wt);
    pg8::EpiResB<SRCF32> E{xf, xb};
    pg8::gemm_phase<pg8::EpiResB<SRCF32>, pg8::StaticOrder, false>(ldsb, D, D, S, E);
}

namespace rp {
using pg8::bf16x8; using pg8::f32x4; using pg8::u32x4;
constexpr size_t T_HI = 0, T_LO = (size_t)48 * D * 2, T_GHI = 2 * T_LO, T_GLO = T_GHI + (size_t)16 * D * 2, T_SIZE = T_GLO + (size_t)16 * D * 2;
static_assert(T_SIZE <= 256 * 1024, "row-pass tables fit their slot");
template <int NT, bool COMBINE> struct StepIn { float4 xa[2], xb[2]; u32x4 xr[2]; u32x4 y1[2], y2[2]; float4 g0, g1; };
template <int NT> struct StepW { bf16x8 wh[NT], wl[NT]; };
__device__ __forceinline__ void build_base(LAS int* base, const unsigned* cnt) {
    __syncthreads();
    if (tid_opaque() == 0) { int b = 0; for (int e = 0; e < NEXP; ++e) { base[e] = b; b += (((int)cnt[e] + 255) >> 8) << 8; } }
    __syncthreads();
}
template <int NT, bool COMBINE, bool XBF>
__device__ __forceinline__ void run(LAS unsigned char* lds, const Params& P, int l, const float* x, bf16_t* xq, const bf16_t* YB, const unsigned* inv, const unsigned* cntprev,
                                    const float* gn, const bf16_t* WH, const bf16_t* WL, bf16_t* XN, float* RS, float* gates, unsigned* cnt, int2* lists, unsigned* invout) {
    const int tid = tid_opaque(), lane = tid & 63, wid = __builtin_amdgcn_readfirstlane(tid >> 6), r = lane & 15, qd = lane >> 4;
    LAS int* BASE = (LAS int*)(lds + 64 * 1024);
    LAS float* LG = (LAS float*)lds + wid * (32 * 49);
    if (COMBINE) build_base(BASE, cntprev);
    LAS unsigned* LCNT = (LAS unsigned*)(lds + 64 * 1024 + 256); LAS unsigned* GBASE = LCNT + 32;
    for (int rb0 = blockIdx.x * 8; rb0 < NTOK / 32; rb0 += gridDim.x * 8) {
        const int rb = rb0 + wid; const bool live = rb < NTOK / 32;
        const int row0 = (live ? rb : rb0) * 32;
        if (NT == 1 && !live) continue;
        size_t yr1[2] = {0, 0}, yr2[2] = {0, 0};
        if (COMBINE) {
#pragma unroll
            for (int mt = 0; mt < 2; ++mt) { const int row = row0 + 16 * mt + r; const unsigned i1 = inv[2 * row], i2 = inv[2 * row + 1];
                yr1[mt] = (size_t)(BASE[i1 >> 16] + (int)(i1 & 0xffffu)) * D; yr2[mt] = (size_t)(BASE[i2 >> 16] + (int)(i2 & 0xffffu)) * D; } }
        f32x4 acc[2][NT];
#pragma unroll
        for (int mt = 0; mt < 2; ++mt)
#pragma unroll
            for (int nt = 0; nt < NT; ++nt) acc[mt][nt] = (f32x4){0.f, 0.f, 0.f, 0.f};
        float ssq[2] = {0.f, 0.f};
        StepIn<NT, COMBINE> sb[3]; StepW<NT> sw[2];
        auto load = [&](StepIn<NT, COMBINE>& s, int ks) {
            const int k0 = 32 * ks + 8 * qd;
#pragma unroll
            for (int mt = 0; mt < 2; ++mt) {
                if (XBF) s.xr[mt] = *(const u32x4*)(xq + (size_t)(row0 + 16 * mt + r) * D + k0);
                else { const float* xp = x + (size_t)(row0 + 16 * mt + r) * D + k0; s.xa[mt] = *(const float4*)xp; s.xb[mt] = *(const float4*)(xp + 4); }
                if (COMBINE) { s.y1[mt] = *(const u32x4*)(YB + yr1[mt] + k0); s.y2[mt] = *(const u32x4*)(YB + yr2[mt] + k0); } }
            s.g0 = *(const float4*)(gn + k0); s.g1 = *(const float4*)(gn + k0 + 4);
        };
        auto loadw = [&](StepW<NT>& s, int ks) {
            const int k0 = 32 * ks + 8 * qd;
#pragma unroll
            for (int nt = 0; nt < NT; ++nt) { s.wh[nt] = *(const bf16x8*)(WH + (size_t)(16 * nt + r) * D + k0); s.wl[nt] = *(const bf16x8*)(WL + (size_t)(16 * nt + r) * D + k0); }
        };
        auto process = [&](const StepIn<NT, COMBINE>& s, const StepW<NT>& sw_, int ks) {
            const int k0 = 32 * ks + 8 * qd;
            bf16x8 xh[2], xl[2];
#pragma unroll
            for (int mt = 0; mt < 2; ++mt) { float4 a = s.xa[mt], b = s.xb[mt];
                if (XBF) { const u32x4 w = s.xr[mt]; a = make_float4(bfl(w.x), bfh(w.x), bfl(w.y), bfh(w.y)); b = make_float4(bfl(w.z), bfh(w.z), bfl(w.w), bfh(w.w)); }
                if (COMBINE) { const u32x4 p = s.y1[mt], q = s.y2[mt];
                    a.x += bfl(p.x) + bfl(q.x); a.y += bfh(p.x) + bfh(q.x); a.z += bfl(p.y) + bfl(q.y); a.w += bfh(p.y) + bfh(q.y);
                    b.x += bfl(p.z) + bfl(q.z); b.y += bfh(p.z) + bfh(q.z); b.z += bfl(p.w) + bfl(q.w); b.w += bfh(p.w) + bfh(q.w);
                    u32x4 o; o.x = pg8::cvt_pk_bf16(a.x, a.y); o.y = pg8::cvt_pk_bf16(a.z, a.w); o.z = pg8::cvt_pk_bf16(b.x, b.y); o.w = pg8::cvt_pk_bf16(b.z, b.w);
                    *(u32x4*)(xq + (size_t)(row0 + 16 * mt + r) * D + k0) = o;
                    a = make_float4(bfl(o.x), bfh(o.x), bfl(o.y), bfh(o.y)); b = make_float4(bfl(o.z), bfh(o.z), bfl(o.w), bfh(o.w)); }
                ssq[mt] += a.x * a.x + a.y * a.y + a.z * a.z + a.w * a.w + b.x * b.x + b.y * b.y + b.z * b.z + b.w * b.w;
                const float v[8] = {a.x * s.g0.x, a.y * s.g0.y, a.z * s.g0.z, a.w * s.g0.w, b.x * s.g1.x, b.y * s.g1.y, b.z * s.g1.z, b.w * s.g1.w};
                u32x4 h; h.x = pg8::cvt_pk_bf16(v[0], v[1]); h.y = pg8::cvt_pk_bf16(v[2], v[3]); h.z = pg8::cvt_pk_bf16(v[4], v[5]); h.w = pg8::cvt_pk_bf16(v[6], v[7]);
                *(u32x4*)(XN + (size_t)(row0 + 16 * mt + r) * D + k0) = h;
                u32x4 lo; lo.x = pg8::cvt_pk_bf16(v[0] - bfl(h.x), v[1] - bfh(h.x)); lo.y = pg8::cvt_pk_bf16(v[2] - bfl(h.y), v[3] - bfh(h.y)); lo.z = pg8::cvt_pk_bf16(v[4] - bfl(h.z), v[5] - bfh(h.z)); lo.w = pg8::cvt_pk_bf16(v[6] - bfl(h.w), v[7] - bfh(h.w));
                xh[mt] = __builtin_bit_cast(bf16x8, h); xl[mt] = __builtin_bit_cast(bf16x8, lo); }
#pragma unroll
            for (int nt = 0; nt < NT; ++nt)
#pragma unroll
                for (int mt = 0; mt < 2; ++mt) { acc[mt][nt] = ml::mfma16(sw_.wh[nt], xh[mt], acc[mt][nt]); acc[mt][nt] = ml::mfma16(sw_.wl[nt], xh[mt], acc[mt][nt]); acc[mt][nt] = ml::mfma16(sw_.wh[nt], xl[mt], acc[mt][nt]); }
        };
        if (COMBINE || NT > 1) {
            load(sb[0], 0); loadw(sw[0], 0);
#pragma unroll 1
            for (int ks = 0; ks < 32; ks += 2) {
                load(sb[1], ks + 1); loadw(sw[1], ks + 1);
                process(sb[0], sw[0], ks);
                if (ks + 2 < 32) { load(sb[0], ks + 2); loadw(sw[0], ks + 2); }
                process(sb[1], sw[1], ks + 1);
            }
        } else {
            load(sb[0], 0); load(sb[1], 1); loadw(sw[0], 0);
#define RP_STEP(i, xs, ws) do { if ((i) + 2 < 32) load(sb[((xs) + 2) % 3], (i) + 2); if ((i) + 1 < 32) loadw(sw[((ws) + 1) % 2], (i) + 1); process(sb[xs], sw[ws], (i)); } while (0)
#pragma unroll 1
            for (int ks = 0; ks < 30; ks += 6) { RP_STEP(ks, 0, 0); RP_STEP(ks + 1, 1, 1); RP_STEP(ks + 2, 2, 0); RP_STEP(ks + 3, 0, 1); RP_STEP(ks + 4, 1, 0); RP_STEP(ks + 5, 2, 1); }
            RP_STEP(30, 0, 0); RP_STEP(31, 1, 1);
#undef RP_STEP
        }
        float rsv[2];
#pragma unroll
        for (int mt = 0; mt < 2; ++mt) { float s = ssq[mt]; s += __shfl_xor(s, 16); s += __shfl_xor(s, 32); rsv[mt] = rsqrtf(s * (1.f / D) + EPS);
            if (qd == 0) RS[row0 + 16 * mt + r] = rsv[mt]; }
        if (NT == 1) {
#pragma unroll
            for (int mt = 0; mt < 2; ++mt) if (qd < 2) { const f32x4 gv = acc[mt][0] * rsv[mt]; *(f32x4*)(gates + (size_t)(row0 + 16 * mt + r) * 8 + 4 * qd) = gv; }
        } else {
            const float* bg = P.in[I_RGB] + l * 4; const float* be = P.in[I_REB] + l * 32;
#pragma unroll
            for (int mt = 0; mt < 2; ++mt)
#pragma unroll
                for (int nt = 0; nt < NT; ++nt)
#pragma unroll
                    for (int j = 0; j < 4; ++j) LG[(16 * mt + r) * 49 + 16 * nt + 4 * qd + j] = acc[mt][nt][j] * rsv[mt];
            wave_lds_fence();
            if (tid < 32) LCNT[tid] = 0u;
            __syncthreads();
            int ex1 = 0, ex2 = 0; float w1 = 0.f, w2 = 0.f; unsigned lp1 = 0u, lp2 = 0u;
            if (lane < 32 && live) {
                const LAS float* lg = LG + lane * 49;
                float gl[4];
#pragma unroll
                for (int j = 0; j < 4; ++j) gl[j] = lg[j] + bg[j];
                int sel = 0; float gm = gl[0];
#pragma unroll
                for (int j = 1; j < 4; ++j) if (gl[j] > gm) { gm = gl[j]; sel = j; }
                float gs = 0.f;
#pragma unroll
                for (int j = 0; j < 4; ++j) gs += expf(gl[j] - gm);
                const float pg = 1.f / gs;
                float ein[8];
#pragma unroll
                for (int j = 0; j < 8; ++j) ein[j] = lg[4 + sel * 8 + j] + be[sel * 8 + j];
                int i1 = 0; float v1 = ein[0];
#pragma unroll
                for (int j = 1; j < 8; ++j) if (ein[j] > v1) { v1 = ein[j]; i1 = j; }
                int i2 = -1; float v2 = -3.0e38f;
#pragma unroll
                for (int j = 0; j < 8; ++j) if (j != i1 && ein[j] > v2) { v2 = ein[j]; i2 = j; }
                const float e2 = expf(v2 - v1), den = 1.f / (1.f + e2);
                w1 = den * pg; w2 = e2 * den * pg;
                ex1 = sel * 8 + i1; ex2 = sel * 8 + i2;
                lp1 = atomicAdd((unsigned*)&LCNT[ex1], 1u); lp2 = atomicAdd((unsigned*)&LCNT[ex2], 1u);
            }
            __syncthreads();
            if (tid < 32) { const unsigned c = LCNT[tid]; GBASE[tid] = c ? atomicAdd(&cnt[tid], c) : 0u; }
            __syncthreads();
            if (lane < 32 && live) { const int row = row0 + lane; const unsigned p1 = GBASE[ex1] + lp1, p2 = GBASE[ex2] + lp2;
                lists[(size_t)ex1 * NTOK + p1] = make_int2(row, __float_as_int(w1));
                lists[(size_t)ex2 * NTOK + p2] = make_int2(row, __float_as_int(w2));
                invout[2 * row] = ((unsigned)ex1 << 16) | p1; invout[2 * row + 1] = ((unsigned)ex2 << 16) | p2; }
        }
    }
}
__device__ __forceinline__ void final_norm(LAS unsigned char* lds, const bf16_t* xb, float* out, const bf16_t* YB, const unsigned* inv, const unsigned* cntprev, const float* g) {
    const int tid = tid_opaque(), wave = tid >> 6, lane = tid & 63;
    LAS int* BASE = (LAS int*)(lds + 64 * 1024);
    build_base(BASE, cntprev);
    const float4* g4 = (const float4*)g;
    for (int r = blockIdx.x * 8 + wave; r < NTOK; r += gridDim.x * 8) {
        const unsigned i1 = inv[2 * r], i2 = inv[2 * r + 1];
        const bf16_t* y1 = YB + (size_t)(BASE[i1 >> 16] + (int)(i1 & 0xffffu)) * D; const bf16_t* y2 = YB + (size_t)(BASE[i2 >> 16] + (int)(i2 & 0xffffu)) * D;
        const u32x2_t* xp = (const u32x2_t*)(xb + (size_t)r * D);
        float4 v[4]; float ss = 0.f;
#pragma unroll
        for (int i = 0; i < 4; ++i) { const u32x2_t xw = xp[lane + 64 * i], a = *((const u32x2_t*)y1 + lane + 64 * i), b = *((const u32x2_t*)y2 + lane + 64 * i);
            v[i].x = bfl(xw.x) + bfl(a.x) + bfl(b.x); v[i].y = bfh(xw.x) + bfh(a.x) + bfh(b.x); v[i].z = bfl(xw.y) + bfl(a.y) + bfl(b.y); v[i].w = bfh(xw.y) + bfh(a.y) + bfh(b.y);
            ss += v[i].x * v[i].x + v[i].y * v[i].y + v[i].z * v[i].z + v[i].w * v[i].w; }
        ss = wave_sum(ss);
        const float rs = rsqrtf(ss * (1.f / D) + EPS);
        float4* p = (float4*)(out + (size_t)r * D);
#pragma unroll
        for (int i = 0; i < 4; ++i) { const float4 gg = g4[lane + 64 * i]; float4 o; o.x = v[i].x * rs * gg.x; o.y = v[i].y * rs * gg.y; o.z = v[i].z * rs * gg.z; o.w = v[i].w * rs * gg.w; p[lane + 64 * i] = o; }
    }
}
}

__device__ __forceinline__ int moe_build_tab(LAS unsigned char* ldsb, const unsigned* cnt) {
    LAS pg8::i32x4* tab = (LAS pg8::i32x4*)(ldsb + TAB_OFF);
    __syncthreads();
    int base = 0;
#pragma unroll 1
    for (int e = 0; e < NEXP; ++e) { const int c = __builtin_amdgcn_readfirstlane((int)cnt[e]), nt = (c + 255) >> 8;
        if ((int)tid_opaque() < nt) tab[base + tid_opaque()] = (pg8::i32x4){e, (int)tid_opaque() * 256, c, 0};
        base += nt; }
    __syncthreads();
    return base;
}
__device__ __forceinline__ void ph_moe1(LAS unsigned char* ldsb, const Params& P, int l, const bf16_t* H, const unsigned* cnt, const int2* lists, bf16_t* act) {
    const int ntiles = moe_build_tab(ldsb, cnt);
    pg8::MoeOrder S; S.tab = (const LAS pg8::i32x4*)(ldsb + TAB_OFF); S.ntiles = ntiles; S.npn = 4; S.G = gridDim.x; S.c = blockIdx.x;
    S.A = (const char*)H; S.atile = 0; S.Bt = (const char*)(P.ws + WS_WGU) + (size_t)l * NEXP * 1024 * D * 2; S.bexp = (size_t)1024 * D * 2; S.btile = (size_t)256 * D * 2; S.lists = lists;
    pg8::EpiAct E{act, lists, (const float*)(P.ws + WS_RS)};
    pg8::gemm_phase<pg8::EpiAct, pg8::MoeOrder, true>(ldsb, D, D, S, E);
}
__device__ __forceinline__ void ph_moe2(LAS unsigned char* ldsb, const Params& P, int l, const bf16_t* act, const unsigned* cnt, const int2* lists, bf16_t* yb) {
    const int ntiles = moe_build_tab(ldsb, cnt);
    pg8::MoeOrder S; S.tab = (const LAS pg8::i32x4*)(ldsb + TAB_OFF); S.ntiles = ntiles; S.npn = 4; S.G = gridDim.x; S.c = blockIdx.x;
    S.A = (const char*)act; S.atile = (size_t)256 * DE * 2; S.Bt = (const char*)(P.ws + WS_WD) + (size_t)l * NEXP * D * DE * 2; S.bexp = (size_t)D * DE * 2; S.btile = (size_t)256 * DE * 2; S.lists = lists;
    pg8::EpiY E{yb, lists};
    pg8::gemm_phase<pg8::EpiY, pg8::MoeOrder, false>(ldsb, DE, DE, S, E);
}

#ifndef PROBE_PH
#define PROBE_PH -1
#endif
#ifndef PROBE_SUB
#define PROBE_SUB 15
#endif
#ifndef PROBE_REPS
#define PROBE_REPS 4
#endif
__global__ void __launch_bounds__(NTHREADS, 2) fwd_kernel(Params P) {
    extern __shared__ __attribute__((aligned(16))) unsigned char lds_raw[];
    float* lds = (float*)lds_raw;
    volatile LAS unsigned* xbw = (volatile LAS unsigned*)(lds_raw + LDS_BYTES - 16);
    if (threadIdx.x == 0) { xbw[0] = 0u; xbw[1] = 0u; }
    __syncthreads();
    unsigned char* const ws = P.ws;
    unsigned* ctl = (unsigned*)(ws + WS_CTL);
    const bool multi = (P.ph_hi - P.ph_lo) > 1;
    XcdBarrier bar; bar.bar = ctl; bar.x = 0; bar.st = xbw;
    if (multi) bar = xcd_barrier_post(ctl, xbw);
    bf16_t* z = (bf16_t*)(ws + WS_Z); float* gates = (float*)(ws + WS_GATES); unsigned char* wss = ws + WS_S5; bf16_t* mix = (bf16_t*)(ws + WS_MIX); unsigned char* wsm = ws + WS_HRAW;
    bf16_t* H = (bf16_t*)(ws + WS_H); bf16_t* act = (bf16_t*)(ws + WS_ACT); bf16_t* yb = (bf16_t*)(ws + WS_YB); bf16_t* xbuf = (bf16_t*)(ws + WS_XB); float* rsb = (float*)(ws + WS_RS);
    int2* lists = (int2*)(ws + WS_LIST);
    LAS unsigned char* ldsb = (LAS unsigned char*)lds_raw;
    const int lo = P.ph_lo, hi = P.ph_hi;
#define IN(k) (lo <= (k) && (k) < hi)
#define SEAM(k) do { if (IN(k) && IN((k) + 1)) xcd_barrier(bar); } while (0)
#if PROBE_PH >= 0
#define RUNPH(k, ...) do { if (IN(k)) { const int nrep = ((k) == PROBE_PH) ? 1 + PROBE_REPS : 1; for (int rep = 0; rep < nrep; ++rep) { __VA_ARGS__; if (rep + 1 < nrep) xcd_barrier(bar); } } SEAM(k); } while (0)
#else
#define RUNPH(k, ...) do { if (IN(k)) { constexpr int rep = 0; (void)rep; __VA_ARGS__; } SEAM(k); } while (0)
#endif
    RUNPH(0, ph_prologue(lds, PF));
    for (int l = 0; l < NLAYER; ++l) {
        const int pb = 1 + l * PH_PER_LAYER;
        unsigned* cnt = ctl + CW_CNT + l * 64;
        const unsigned char* tb = ws + WS_TB + (size_t)l * 4 * MiB;
        const unsigned char* rtb = ws + WS_RT + (size_t)l * 256 * 1024;
        unsigned* inv = (unsigned*)(ws + WS_INV) + (size_t)l * NTOK * 2;
        RUNPH(pb + 0, { const Params& Q = PF;
            if (l == 0) rp::run<1, false, false>(ldsb, Q, l, Q.in[I_X], nullptr, nullptr, nullptr, nullptr, Q.in[I_NMG] + l * D, (const bf16_t*)(rtb + rp::T_GHI), (const bf16_t*)(rtb + rp::T_GLO), mix, rsb, gates, nullptr, nullptr, nullptr);
            else        rp::run<1, true, true>(ldsb, Q, l, nullptr, xbuf, yb, inv - (size_t)NTOK * 2, cnt - 64, Q.in[I_NMG] + l * D, (const bf16_t*)(rtb + rp::T_GHI), (const bf16_t*)(rtb + rp::T_GLO), mix, rsb, gates, nullptr, nullptr, nullptr); });
        RUNPH(pb + 1, ph_inproj(ldsb, mix, (const bf16_t*)(ws + WS_WIN) + (size_t)l * NMAIN * D, z, rsb, (rep > 0 && PROBE_SUB <= 3) ? PROBE_SUB : 0));
        RUNPH(pb + 2, ph_mix1(lds, PF, l, z, gates, mix, wsm, wss, tb, rep == 0 ? 15 : PROBE_SUB));
        RUNPH(pb + 3, { s5::p2_scan(ldsb, tb, wss); ml::p2_scan(wsm); });
        RUNPH(pb + 4, ph_mix2(lds, PF, l, z, gates, mix, wsm, wss, tb, rep == 0 ? 15 : PROBE_SUB));
        RUNPH(pb + 5, { const Params& Q = PF; if (l == 0) ph_outproj<true>(ldsb, mix, (const bf16_t*)(ws + WS_WOUT) + (size_t)l * D * D, Q.in[I_X], xbuf); else ph_outproj<false>(ldsb, mix, (const bf16_t*)(ws + WS_WOUT) + (size_t)l * D * D, nullptr, xbuf); });
        RUNPH(pb + 6, { if (rep > 0) { if (blockIdx.x == 0 && threadIdx.x < 64) cnt[threadIdx.x] = 0u; xcd_barrier(bar); }
                        const Params& Q = PF; rp::run<3, false, true>(ldsb, Q, l, nullptr, xbuf, nullptr, nullptr, nullptr, Q.in[I_NFG] + l * D, (const bf16_t*)(rtb + rp::T_HI), (const bf16_t*)(rtb + rp::T_LO), H, rsb, nullptr, cnt, lists, inv); });
        RUNPH(pb + 7, ph_moe1(ldsb, PF, l, H, cnt, lists, act));
        RUNPH(pb + 8, ph_moe2(ldsb, PF, l, act, cnt, lists, yb));
    }
    RUNPH(1 + NLAYER * PH_PER_LAYER, { const Params& Q = PF; rp::final_norm(ldsb, xbuf, Q.out, yb, (const unsigned*)(ws + WS_INV) + (size_t)(NLAYER - 1) * NTOK * 2, ctl + CW_CNT + (NLAYER - 1) * 64, Q.in[I_NFIN]); });
#undef RUNPH
#undef IN
#undef SEAM
}

#ifndef N_LAUNCH_MODE
#define N_LAUNCH_MODE 1
#endif
extern "C" void kernel_launch(void* const* d_in, const int* in_sizes, int n_in, void* d_out, int out_size, void* d_ws, size_t ws_size, hipStream_t stream) {
    static int grid = 0;
    if (grid == 0) {
        if (n_in != 31 || out_size != NTOK * D || ws_size < WS_END) { fprintf(stderr, "kernel_launch: unexpected shapes n_in %d out %d ws %zu (need %zu)\n", n_in, out_size, ws_size, (size_t)WS_END); grid = -1; return; }
        int dev = 0, cus = 0, per_cu = 0;
        if (hipGetDevice(&dev) != hipSuccess || hipDeviceGetAttribute(&cus, hipDeviceAttributeMultiprocessorCount, dev) != hipSuccess) { grid = -1; return; }
        if (hipFuncSetAttribute((const void*)fwd_kernel, hipFuncAttributeMaxDynamicSharedMemorySize, LDS_BYTES) != hipSuccess) { fprintf(stderr, "kernel_launch: hipFuncSetAttribute failed\n"); grid = -1; return; }
        if (hipOccupancyMaxActiveBlocksPerMultiprocessor(&per_cu, (const void*)fwd_kernel, NTHREADS, LDS_BYTES) != hipSuccess || per_cu < 1) { fprintf(stderr, "kernel_launch: occupancy query says %d\n", per_cu); }
        (void)hipGetLastError();
        grid = cus;
    }
    if (grid < 0) return;
    (void)hipMemsetAsync((char*)d_ws + WS_CTL, 0, CTL_BYTES, stream);
    Params p{};
    for (int i = 0; i < 31; ++i) p.in[i] = (const float*)d_in[i];
    p.out = (float*)d_out; p.ws = (unsigned char*)d_ws;
#if N_LAUNCH_MODE == 1
    p.ph_lo = 0; p.ph_hi = N_PHASES;
    hipLaunchKernelGGL(fwd_kernel, dim3(grid), dim3(NTHREADS), LDS_BYTES, stream, p);
#else
    for (int ph = 0; ph < N_PHASES; ++ph) { p.ph_lo = ph; p.ph_hi = ph + 1; hipLaunchKernelGGL(fwd_kernel, dim3(grid), dim3(NTHREADS), LDS_BYTES, stream, p); }
#endif
}
```

```cpp
#include <hip/hip_runtime.h>
#include <stdint.h>
#include <stdio.h>

#define LAS __attribute__((address_space(3)))

constexpr int D = 1024, NB = 8, S = 8192, NTOK = NB * S, INW = 2312, NLAYER = 2;
constexpr int NEXP = 32, DE = 512;
constexpr float EPS = 1e-6f;
constexpr int ZW = 2304;
constexpr int ZQ = 0, ZK = 256, ZV = 384, ZSU = 512, ZCQ = 768, ZCK = 1024, ZCV = 1280, ZCO = 1536, ZGU = 1792, ZGV = 2048, WCI = 1536;
#ifndef INPROJ_WGM
#define INPROJ_WGM 8
#endif
constexpr int NTHREADS = 512;
constexpr int LDS_BYTES = 144 * 1024;
constexpr int TAB_OFF = 128 * 1024;
constexpr int PH_PER_LAYER = 9, N_PHASES = 1 + NLAYER * PH_PER_LAYER + 1;
constexpr int NMAIN = 2304;
typedef unsigned short bf16_t;

constexpr size_t MiB = 1u << 20;
constexpr size_t WS_CTL = 0, CTL_BYTES = 1 * MiB;
constexpr size_t WS_Z = WS_CTL + CTL_BYTES;
constexpr size_t Z_BYTES = (size_t)NTOK * ZW * 2;
constexpr size_t WS_H = WS_Z;
constexpr size_t WS_YB = WS_Z;
constexpr int PMAX = 2 * NTOK + NEXP * 256;
static_assert((size_t)PMAX * D * 2 <= Z_BYTES, "YB alias fits");
constexpr size_t WS_MIX = WS_Z + Z_BYTES;
constexpr size_t WS_ACT = WS_MIX;
static_assert((size_t)PMAX * DE * 2 <= (size_t)NTOK * D * 2 + 64 * MiB, "ACT alias fits");
constexpr size_t WS_HRAW = WS_MIX + (size_t)NTOK * D * 2;
constexpr size_t WS_S5 = WS_HRAW + 64 * MiB;
constexpr size_t WS_GATES = WS_S5 + 48 * MiB;
constexpr size_t WS_LIST = WS_GATES + (size_t)NTOK * 8 * 4;
constexpr size_t WS_WIN = WS_LIST + (size_t)NEXP * NTOK * 8;
constexpr size_t WS_WOUT = WS_WIN + (size_t)NLAYER * NMAIN * D * 2;
constexpr size_t WS_WGU = WS_WOUT + (size_t)NLAYER * D * D * 2;
constexpr size_t WS_WD = WS_WGU + (size_t)NLAYER * NEXP * 1024 * D * 2;
constexpr size_t WS_TB = WS_WD + (size_t)NLAYER * NEXP * D * DE * 2;
constexpr size_t WS_RS = WS_TB + (size_t)NLAYER * 4 * MiB;
constexpr size_t WS_RT = WS_RS + (size_t)NTOK * 4;
constexpr size_t WS_INV = WS_RT + (size_t)NLAYER * 256 * 1024;
constexpr size_t WS_XB = WS_INV + (size_t)NLAYER * NTOK * 8;
constexpr size_t WS_END = WS_XB + (size_t)NTOK * D * 2;
namespace s5 {
constexpr size_t T_KMAT = 0, T_F = T_KMAT + (size_t)16 * 32 * 256 * 2, T_G = T_F + (size_t)16 * 256 * 128 * 2, T_A16 = T_G + (size_t)16 * 128 * 256 * 2,
                 T_GLUW = T_A16 + (size_t)16 * 64 * 8, T_SGUW = T_GLUW + (size_t)256 * 256 * 2, T_LAYER = T_SGUW + (size_t)4 * 128 * 128 * 2;
}
constexpr int CW_Q = 4096;
constexpr int CW_CNT = 8192;

#define XB_TMO      128
#define XB_XCNT(j)  (256  + 64 * (j))
#define XB_XSUB(j)  (1280 + 64 * (j))
#define XB_XGEN(j)  (2304 + 64 * (j))
#define XB_TOP      3328
#define XB_TOPGEN   3392
#define XCD_BAR_WORDS 3456
#define XB_SPIN_CAP (1u << 22)
__device__ __forceinline__ unsigned xb_ld(unsigned* p)              { return __hip_atomic_load(p, __ATOMIC_RELAXED, __HIP_MEMORY_SCOPE_AGENT); }
__device__ __forceinline__ unsigned xb_add(unsigned* p, unsigned v) { return __hip_atomic_fetch_add(p, v, __ATOMIC_RELAXED, __HIP_MEMORY_SCOPE_AGENT); }
__device__ __forceinline__ unsigned xb_xcc_id() { return (unsigned)__builtin_amdgcn_s_getreg((3 << 11) | 20) & 0xFu; }
#define XB_SPIN(cond, bar) do { unsigned _sp = 0; while (cond) { __builtin_amdgcn_s_sleep(1); \
    if ((++_sp & 255u) == 0u) { if (xb_ld(&(bar)[XB_TMO])) break; if (_sp > XB_SPIN_CAP) { atomicAdd(&(bar)[XB_TMO], 1u); break; } } } } while (0)
struct XcdBarrier { unsigned* bar; unsigned x; volatile LAS unsigned* st; };
__device__ __forceinline__ XcdBarrier xcd_barrier_post(unsigned* bar, volatile LAS unsigned* st) {
    XcdBarrier b; b.bar = bar; b.x = xb_xcc_id(); b.st = st;
    if (threadIdx.x == 0) (void)xb_add(&bar[XB_XCNT(b.x)], 1u);
    return b;
}
__device__ __forceinline__ void xcd_barrier_complete(unsigned* bar, unsigned x, unsigned& nloc, unsigned& nx) {
    const unsigned G = gridDim.x * gridDim.y * gridDim.z;
    unsigned sum, cnt, mine, sp = 0u;
    for (;;) {
        sum = 0u; cnt = 0u; mine = 0u;
#pragma unroll
        for (unsigned j = 0; j < 16; ++j) { const unsigned c = xb_ld(&bar[XB_XCNT(j)]); sum += c; cnt += (c > 0u) ? 1u : 0u; mine = (j == x) ? c : mine; }
        if (sum == G) break;
        __builtin_amdgcn_s_sleep(1);
        if ((++sp & 255u) == 0u) { if (xb_ld(&bar[XB_TMO])) break; if (sp > XB_SPIN_CAP) { atomicAdd(&bar[XB_TMO], 1u); break; } }
    }
    nloc = mine > 0u ? mine : 1u; nx = cnt > 0u ? cnt : 1u;
}
__device__ __forceinline__ void xcd_barrier(const XcdBarrier& b) {
    asm volatile("s_waitcnt vmcnt(0)" ::: "memory");
    __syncthreads();
    if (threadIdx.x == 0) {
        unsigned* bar = b.bar;
        __builtin_amdgcn_s_waitcnt(0);
        unsigned nloc = b.st[0], nx = b.st[1];
        if (nloc == 0u) { xcd_barrier_complete(bar, b.x, nloc, nx); b.st[0] = nloc; b.st[1] = nx; }
        const unsigned old = xb_add(&bar[XB_XSUB(b.x)], 1u);
        const unsigned gen = old / nloc;
        if (old + 1u == (gen + 1u) * nloc) {
            __builtin_amdgcn_fence(__ATOMIC_RELEASE, "agent");
            asm volatile("s_waitcnt vmcnt(0)" ::: "memory");
            const unsigned og = xb_add(&bar[XB_TOP], 1u);
            const unsigned tg = og / nx;
            if (og + 1u == (tg + 1u) * nx) xb_add(&bar[XB_TOPGEN], 1u);
            else XB_SPIN(xb_ld(&bar[XB_TOPGEN]) == tg, bar);
            __builtin_amdgcn_fence(__ATOMIC_ACQUIRE, "agent");
            xb_add(&bar[XB_XGEN(b.x)], 1u);
            asm volatile("s_waitcnt vmcnt(0)" ::: "memory");
        } else {
            XB_SPIN(xb_ld(&bar[XB_XGEN(b.x)]) == gen, bar);
            __builtin_amdgcn_fence(__ATOMIC_ACQUIRE, "agent");
            asm volatile("s_waitcnt vmcnt(0)" ::: "memory");
        }
    }
    __syncthreads();
}

__device__ __forceinline__ int tid_opaque() { int t = threadIdx.x; asm volatile("" : "+v"(t)); return t; }
__device__ __forceinline__ float wave_sum(float v) {
#pragma unroll
    for (int o = 32; o > 0; o >>= 1) v += __shfl_xor(v, o);
    return v;
}
__device__ __forceinline__ float gelu_tanh(float x) {
    const float u2 = 1.5957691216057308f * (x + 0.044715f * x * x * x);
    return x * __builtin_amdgcn_rcpf(1.f + __expf(-u2));
}
__device__ __forceinline__ float sigm(float x) { return 1.f / (1.f + expf(-x)); }
__device__ __forceinline__ float rsig(float x) { return __builtin_amdgcn_rcpf(1.f + __expf(-x)); }
__device__ __forceinline__ float bfl(unsigned w) { return __uint_as_float(w << 16); }
__device__ __forceinline__ float bfh(unsigned w) { return __uint_as_float(w & 0xffff0000u); }
typedef unsigned u32x4_t __attribute__((ext_vector_type(4)));
typedef unsigned u32x2_t __attribute__((ext_vector_type(2)));
__device__ __forceinline__ void ld8(const bf16_t* p, float (&o)[8]) { const u32x4_t w = *(const u32x4_t*)p; o[0] = bfl(w.x); o[1] = bfh(w.x); o[2] = bfl(w.y); o[3] = bfh(w.y); o[4] = bfl(w.z); o[5] = bfh(w.z); o[6] = bfl(w.w); o[7] = bfh(w.w); }
typedef short s16x4_t __attribute__((ext_vector_type(4)));
__device__ __forceinline__ u32x2_t lds_tr4(const LAS unsigned char* p) { const s16x4_t v = __builtin_amdgcn_ds_read_tr16_b64_v4i16((LAS s16x4_t*)p); return __builtin_bit_cast(u32x2_t, v); }
__device__ __forceinline__ void wave_lds_fence() {
    __builtin_amdgcn_fence(__ATOMIC_RELEASE, "wavefront"); __builtin_amdgcn_wave_barrier(); __builtin_amdgcn_fence(__ATOMIC_ACQUIRE, "wavefront");
}

struct Params {
    const float* in[31];
    float* out;
    unsigned char* ws;
    int ph_lo, ph_hi;
};
struct Params;
__device__ __forceinline__ const Params* params_fresh() { auto p = __builtin_amdgcn_kernarg_segment_ptr(); asm volatile("" : "+s"(p)); return (const Params*)p; }
#define PF (*params_fresh())
enum { I_X = 0, I_NMG, I_WIN, I_SINK, I_ARE, I_AIM, I_BRE, I_BIM, I_CRE, I_CIM, I_SD, I_LDT, I_GLUW, I_GLUB, I_CONVW, I_GATEB, I_MNG,
       I_LNG, I_LNB, I_SGUW, I_SGUB, I_WOUT, I_NFG, I_RGW, I_RGB, I_REW, I_REB, I_EWG, I_EWU, I_EWD, I_NFIN };

namespace pg8 {
#define PG8_LAS __attribute__((address_space(3)))
typedef short bf16x8 __attribute__((ext_vector_type(8)));
typedef float f32x4 __attribute__((ext_vector_type(4)));
typedef unsigned u32x4 __attribute__((ext_vector_type(4)));
typedef unsigned u32x2 __attribute__((ext_vector_type(2)));
typedef int i32x4 __attribute__((ext_vector_type(4)));
constexpr int BM = 256, BK = 64, HALF = 128, HTB = HALF * BK * 2, STAGE_BYTES = 8 * HTB, NXCD = 8, WGM = 8;
__host__ __device__ __forceinline__ int lds_byte(int r, int c) { const int st = (r >> 4) * 2 + (c >> 5), rr = r & 15, cc = c & 31, ob = rr * 64 + cc * 2; return st * 1024 + (ob ^ (((ob >> 9) & 1) << 5)); }
__host__ __device__ __forceinline__ void stage_rc(int b, int& R, int& C) { const int st = b / 1024, sb = b % 1024, swz = sb ^ (((sb >> 9) & 1) << 5); R = (st >> 1) * 16 + swz / 64; C = (st & 1) * 32 + (swz % 64) / 2; }
__host__ __device__ __forceinline__ int perm32(int rho) { const int n = rho >> 4, i = rho & 15; return 8 * (i >> 2) + 4 * n + (i & 3); }
__device__ __forceinline__ unsigned cvt_pk_bf16(float lo, float hi) { unsigned r; asm volatile("v_cvt_pk_bf16_f32 %0, %1, %2" : "=v"(r) : "v"(lo), "v"(hi)); return r; }

struct Unit { int pm, pn; const char* A; const char* B; int e, pos0, cnt; };

struct StaticOrder {
    int nM, nN, nwg, G, c, wgm, pmmask = -1; const char* A; const char* Bt; size_t atile, btile;
    __device__ void init(int M, int N, int K, int lda, int G_, int c_, const void* A_, const void* Bt_, int wgm_ = WGM) { wgm = wgm_; nM = M / BM; nN = N / BM; nwg = nM * nN; G = G_; c = c_; A = (const char*)A_; Bt = (const char*)Bt_; atile = (size_t)BM * lda * 2; btile = (size_t)BM * K * 2; }
    __device__ __forceinline__ bool next(int i, Unit& u) const {
        const long L = (long)i * G + c; if (L >= nwg) return false;
        int wgid = (int)L; { const int q = nwg / NXCD, r = nwg % NXCD, xcd = wgid % NXCD, off = wgid / NXCD; wgid = (xcd < r ? xcd * (q + 1) : r * (q + 1) + (xcd - r) * q) + off; }
        const int nig = wgm * nN, gid = wgid / nig, fm = gid * wgm, gsz = (nM - fm) < wgm ? (nM - fm) : wgm;
        u.pm = fm + ((wgid % nig) % gsz); u.pn = (wgid % nig) / gsz; u.A = A + (size_t)(u.pm & pmmask) * atile; u.B = Bt + (size_t)u.pn * btile; u.e = 0; u.pos0 = 0; u.cnt = 0; return true;
    }
    __device__ __forceinline__ void aoff(const Unit&, unsigned (&)[2], unsigned (&)[2], const int (&)[2], const int (&)[2]) const {}
};

template <class Epi, class Sched, bool GATHER>
__device__ __forceinline__ void gemm_phase(PG8_LAS unsigned char* lds, const int K, const int lda, const Sched& S, const Epi& E) {
    const int tid = tid_opaque(), wid = __builtin_amdgcn_readfirstlane(tid >> 6), lane = tid & 63, wr = wid >> 2, wc = wid & 3, fr = lane & 15, fq = lane >> 4;
    const int nt = K / BK;
    unsigned vA0[2], vA1[2], vB[2], nA0[2], nA1[2]; int Rs[2], Cs[2];
#pragma unroll
    for (int i = 0; i < 2; ++i) { int R, C; stage_rc(tid * 16 + i * 8192, R, C); const int Rb = Epi::PERM ? ((R & ~31) + perm32(R & 31)) : R;
        Rs[i] = R; Cs[i] = C; vA0[i] = (unsigned)(R * lda + C) * 2u; vA1[i] = vA0[i] + (unsigned)(HALF * lda) * 2u; vB[i] = (unsigned)(Rb * K + C) * 2u; nA0[i] = vA0[i]; nA1[i] = vA1[i]; }
    const size_t kstep = (size_t)(BK * 2);
    const size_t hstep = (size_t)HALF * K * 2;
    const unsigned ldsw = (unsigned)wid * 1024u;
    const int aoff = lds_byte(wr * 64 + fr, fq * 8), boff = lds_byte(wc * 32 + fr, fq * 8);
#define PG8_SA(b, h) (((b) * 2 + (h)) * HTB)
#define PG8_SB(b, h) ((4 + (b) * 2 + (h)) * HTB)
#define PG8_STAGE(bufoff, gbase, voff) do { _Pragma("unroll") for (int _i = 0; _i < 2; ++_i) \
        __builtin_amdgcn_global_load_lds((const unsigned*)((const char*)(gbase) + (voff)[_i]), (PG8_LAS unsigned*)(lds + (bufoff) + ldsw + _i * 8192), 16, 0, 0); } while (0)
#define PG8_LDA(dst, b, h) do { _Pragma("unroll") for (int m = 0; m < 4; ++m) _Pragma("unroll") for (int k = 0; k < 2; ++k) dst[m][k] = *(const PG8_LAS bf16x8*)(lds + PG8_SA(b, h) + aoff + m * 2048 + k * 1024); } while (0)
#define PG8_LDB(dst, b, h) do { _Pragma("unroll") for (int n = 0; n < 2; ++n) _Pragma("unroll") for (int k = 0; k < 2; ++k) dst[n][k] = *(const PG8_LAS bf16x8*)(lds + PG8_SB(b, h) + boff + n * 2048 + k * 1024); } while (0)
#define PG8_MMA(ai, bj, At, Bt) do { __builtin_amdgcn_s_setprio(1); _Pragma("unroll") for (int m = 0; m < 4; ++m) _Pragma("unroll") for (int n = 0; n < 2; ++n) _Pragma("unroll") for (int k = 0; k < 2; ++k) \
        acc[ai][bj][m][n] = __builtin_amdgcn_mfma_f32_16x16x32_bf16(Bt[n][k], At[m][k], acc[ai][bj][m][n], 0, 0, 0); __builtin_amdgcn_s_setprio(0); } while (0)
#define PG8_WAIT_V(n) asm volatile("s_waitcnt vmcnt(" #n ")" ::: "memory")
#define PG8_WAIT_L(n) asm volatile("s_waitcnt lgkmcnt(" #n ")" ::: "memory")
#define PG8_BAR __builtin_amdgcn_s_barrier()
#define PG8_SCHED __builtin_amdgcn_sched_barrier(0)
    Unit cur, nxt; int ui = 0;
    if (!S.next(0, cur)) return;
    if constexpr (GATHER) { S.aoff(cur, vA0, vA1, Rs, Cs); PG8_WAIT_V(0); }
    f32x4 acc[2][2][4][2];
#pragma unroll
    for (int a = 0; a < 2; ++a)
#pragma unroll
        for (int b = 0; b < 2; ++b)
#pragma unroll
            for (int m = 0; m < 4; ++m)
#pragma unroll
                for (int n = 0; n < 2; ++n) acc[a][b][m][n] = (f32x4){0.f, 0.f, 0.f, 0.f};
    bf16x8 At[4][2], B0[2][2], B1[2][2];
    const char* cA = cur.A; const char* cB = cur.B;
    PG8_STAGE(PG8_SB(0, 0), cB, vB); PG8_STAGE(PG8_SB(0, 1), cB + hstep, vB); PG8_STAGE(PG8_SA(0, 0), cA, vA0); PG8_STAGE(PG8_SA(0, 1), cA, vA1);
    if (wr == 1) PG8_BAR;
    PG8_WAIT_V(2); PG8_BAR;
    PG8_STAGE(PG8_SB(1, 0), cB + kstep, vB); PG8_STAGE(PG8_SA(1, 0), cA + kstep, vA0); PG8_STAGE(PG8_SB(1, 1), cB + hstep + kstep, vB);
    PG8_WAIT_V(6); PG8_BAR;
    for (;;) {
        const bool has_next = S.next(ui + 1, nxt);
        const char* nA = has_next ? nxt.A : cA; const char* nB = has_next ? nxt.B : cB;
        if constexpr (GATHER) {
            if (has_next) { S.aoff(nxt, nA0, nA1, Rs, Cs); }
            else {
#pragma unroll
                for (int i = 0; i < 2; ++i) { nA0[i] = vA0[i]; nA1[i] = vA1[i]; } }
        }
        for (int t = 0; t < nt; t += 2) {
            const bool last = (t == nt - 2);
            const char* a1 = cA + (size_t)(t + 1) * kstep;
            const char* a2 = last ? nA : cA + (size_t)(t + 2) * kstep; const char* b2 = last ? nB : cB + (size_t)(t + 2) * kstep;
            const char* a3 = a2 + kstep; const char* b3 = b2 + kstep;
            unsigned x0[2], x1[2];
#pragma unroll
            for (int i = 0; i < 2; ++i) { x0[i] = (GATHER && last) ? nA0[i] : vA0[i]; x1[i] = (GATHER && last) ? nA1[i] : vA1[i]; }
            PG8_LDB(B0, 0, 0); PG8_LDB(B1, 0, 1); PG8_SCHED; PG8_LDA(At, 0, 0); PG8_STAGE(PG8_SA(1, 1), a1, vA1);
            PG8_WAIT_V(8); PG8_WAIT_L(0); PG8_BAR; PG8_MMA(0, 0, At, B0); PG8_MMA(0, 1, At, B1); PG8_BAR; PG8_SCHED;
            PG8_LDA(At, 0, 1); PG8_STAGE(PG8_SB(0, 0), b2, vB); PG8_STAGE(PG8_SB(0, 1), b2 + hstep, vB); PG8_STAGE(PG8_SA(0, 0), a2, x0);
            PG8_WAIT_V(8); PG8_WAIT_L(0); PG8_BAR; PG8_MMA(1, 0, At, B0); PG8_MMA(1, 1, At, B1); PG8_BAR; PG8_SCHED;
            PG8_LDB(B0, 1, 0); PG8_LDB(B1, 1, 1); PG8_SCHED; PG8_LDA(At, 1, 0); PG8_STAGE(PG8_SA(0, 1), a2, x1);
            PG8_WAIT_V(8); PG8_WAIT_L(0); PG8_BAR; PG8_MMA(0, 0, At, B0); PG8_MMA(0, 1, At, B1); PG8_BAR; PG8_SCHED;
            PG8_LDA(At, 1, 1); PG8_STAGE(PG8_SB(1, 0), b3, vB); PG8_STAGE(PG8_SB(1, 1), b3 + hstep, vB); PG8_STAGE(PG8_SA(1, 0), a3, x0);
            PG8_WAIT_V(8); PG8_WAIT_L(0); PG8_BAR; PG8_MMA(1, 0, At, B0); PG8_MMA(1, 1, At, B1); PG8_BAR; PG8_SCHED;
        }
        if (wr == 0) PG8_BAR;
        E(acc, cur, wr, wc, fr, fq);
        if (!has_next) break;
#pragma unroll
        for (int a = 0; a < 2; ++a)
#pragma unroll
            for (int b = 0; b < 2; ++b)
#pragma unroll
                for (int m = 0; m < 4; ++m)
#pragma unroll
                    for (int n = 0; n < 2; ++n) acc[a][b][m][n] = (f32x4){0.f, 0.f, 0.f, 0.f};
        cur = nxt; cA = nA; cB = nB; ++ui;
        if constexpr (GATHER) {
#pragma unroll
            for (int i = 0; i < 2; ++i) { vA0[i] = nA0[i]; vA1[i] = nA1[i]; } }
        if (wr == 1) PG8_BAR;
    }
    PG8_WAIT_V(0);
    PG8_BAR;
#undef PG8_SA
#undef PG8_SB
#undef PG8_STAGE
#undef PG8_LDA
#undef PG8_LDB
#undef PG8_MMA
#undef PG8_WAIT_V
#undef PG8_WAIT_L
#undef PG8_BAR
#undef PG8_SCHED
}

struct EpiZ {
    static constexpr bool PERM = true;
    bf16_t* Z; const float* RS; int skip;
    __device__ __forceinline__ void operator()(const f32x4 (&acc)[2][2][4][2], const Unit& u, int wr, int wc, int fr, int fq) const {
        if (skip) return;
        const int row0 = u.pm * BM + wr * 64 + fr, col0 = u.pn * BM + wc * 32 + 8 * fq;
        float rsv[2][4];
#pragma unroll
        for (int ai = 0; ai < 2; ++ai)
#pragma unroll
            for (int m = 0; m < 4; ++m) rsv[ai][m] = RS[row0 + ai * HALF + m * 16];
#pragma unroll
        for (int ai = 0; ai < 2; ++ai)
#pragma unroll
            for (int m = 0; m < 4; ++m) { bf16_t* rowp = Z + (size_t)(row0 + ai * HALF + m * 16) * ZW + col0; const float rs = rsv[ai][m];
#pragma unroll
                for (int bj = 0; bj < 2; ++bj) { const f32x4 v0 = acc[ai][bj][m][0] * rs, v1 = acc[ai][bj][m][1] * rs;
                    u32x4 w; w.x = cvt_pk_bf16(v0[0], v0[1]); w.y = cvt_pk_bf16(v0[2], v0[3]); w.z = cvt_pk_bf16(v1[0], v1[1]); w.w = cvt_pk_bf16(v1[2], v1[3]);
                    *(u32x4*)(rowp + bj * HALF) = w; } }
    }
};
template <bool SRCF32> struct EpiResB {
    static constexpr bool PERM = true;
    const float* XF; bf16_t* XB;
    __device__ __forceinline__ void operator()(const f32x4 (&acc)[2][2][4][2], const Unit& u, int wr, int wc, int fr, int fq) const {
        const int row0 = u.pm * BM + wr * 64 + fr, col0 = u.pn * BM + wc * 32 + 8 * fq;
#pragma unroll
        for (int ai = 0; ai < 2; ++ai) {
            f32x4 xf[4][2][2]; u32x4 xw[4][2];
#pragma unroll
            for (int m = 0; m < 4; ++m) { const size_t off = (size_t)(row0 + ai * HALF + m * 16) * D + col0;
#pragma unroll
                for (int bj = 0; bj < 2; ++bj) {
                    if (SRCF32) { xf[m][bj][0] = *(const f32x4*)(XF + off + bj * HALF); xf[m][bj][1] = *(const f32x4*)(XF + off + bj * HALF + 4); }
                    else xw[m][bj] = *(const u32x4*)(XB + off + bj * HALF); } }
            __builtin_amdgcn_sched_barrier(0);
#pragma unroll
            for (int m = 0; m < 4; ++m) { const size_t off = (size_t)(row0 + ai * HALF + m * 16) * D + col0;
#pragma unroll
                for (int bj = 0; bj < 2; ++bj) { f32x4 x0, x1;
                    if (SRCF32) { x0 = xf[m][bj][0]; x1 = xf[m][bj][1]; }
                    else { const u32x4 w = xw[m][bj];
                        x0 = (f32x4){__uint_as_float(w.x << 16), __uint_as_float(w.x & 0xffff0000u), __uint_as_float(w.y << 16), __uint_as_float(w.y & 0xffff0000u)};
                        x1 = (f32x4){__uint_as_float(w.z << 16), __uint_as_float(w.z & 0xffff0000u), __uint_as_float(w.w << 16), __uint_as_float(w.w & 0xffff0000u)}; }
                    const f32x4 v0 = x0 + acc[ai][bj][m][0], v1 = x1 + acc[ai][bj][m][1];
                    u32x4 o; o.x = cvt_pk_bf16(v0[0], v0[1]); o.y = cvt_pk_bf16(v0[2], v0[3]); o.z = cvt_pk_bf16(v1[0], v1[1]); o.w = cvt_pk_bf16(v1[2], v1[3]);
                    *(u32x4*)(XB + off + bj * HALF) = o; } }
            __builtin_amdgcn_sched_barrier(0);
        }
    }
};
struct EpiAct {
    static constexpr bool PERM = true;
    bf16_t* ACT; const int2* lists; const float* RS;
    __device__ __forceinline__ void operator()(const f32x4 (&acc)[2][2][4][2], const Unit& u, int wr, int wc, int fr, int fq) const {
        const int row0 = u.pm * BM + wr * 64 + fr, col0 = u.pn * HALF + wc * 32 + 8 * fq; const int2* lst = lists + (size_t)u.e * NTOK + u.pos0;
        int tk[2][4]; float rsv[2][4];
#pragma unroll
        for (int ai = 0; ai < 2; ++ai)
#pragma unroll
            for (int m = 0; m < 4; ++m) { const int r = ai * HALF + wr * 64 + m * 16 + fr; const int rc = (u.pos0 + r < u.cnt) ? r : 0; tk[ai][m] = lst[rc].x; }
        asm volatile("" : "+v"(tk[0][0]), "+v"(tk[0][1]), "+v"(tk[0][2]), "+v"(tk[0][3]), "+v"(tk[1][0]), "+v"(tk[1][1]), "+v"(tk[1][2]), "+v"(tk[1][3]));
#pragma unroll
        for (int ai = 0; ai < 2; ++ai)
#pragma unroll
            for (int m = 0; m < 4; ++m) rsv[ai][m] = RS[tk[ai][m]];
        asm volatile("" : "+v"(rsv[0][0]), "+v"(rsv[0][1]), "+v"(rsv[0][2]), "+v"(rsv[0][3]), "+v"(rsv[1][0]), "+v"(rsv[1][1]), "+v"(rsv[1][2]), "+v"(rsv[1][3]));
#pragma unroll
        for (int ai = 0; ai < 2; ++ai)
#pragma unroll
            for (int m = 0; m < 4; ++m) { const int r = ai * HALF + wr * 64 + m * 16 + fr; if (!(u.pos0 + r < u.cnt)) rsv[ai][m] = 0.f; }
#pragma unroll
        for (int ai = 0; ai < 2; ++ai)
#pragma unroll
            for (int m = 0; m < 4; ++m) { bf16_t* rowp = ACT + (size_t)(row0 + ai * HALF + m * 16) * DE + col0;
                const float rs = rsv[ai][m];
                float o[8];
#pragma unroll
                for (int n = 0; n < 2; ++n)
#pragma unroll
                    for (int j = 0; j < 4; ++j) { const float g = acc[ai][0][m][n][j] * rs, up = acc[ai][1][m][n][j] * rs; o[n * 4 + j] = g * up * __builtin_amdgcn_rcpf(1.f + __expf(-g)); }
                u32x4 w; w.x = cvt_pk_bf16(o[0], o[1]); w.y = cvt_pk_bf16(o[2], o[3]); w.z = cvt_pk_bf16(o[4], o[5]); w.w = cvt_pk_bf16(o[6], o[7]);
                *(u32x4*)rowp = w; }
    }
};
struct EpiY {
    static constexpr bool PERM = true;
    bf16_t* YB; const int2* lists;
    __device__ __forceinline__ void operator()(const f32x4 (&acc)[2][2][4][2], const Unit& u, int wr, int wc, int fr, int fq) const {
        const int row0 = u.pm * BM + wr * 64 + fr, col0 = u.pn * BM + wc * 32 + 8 * fq; const int2* lst = lists + (size_t)u.e * NTOK + u.pos0;
        float wv[2][4];
#pragma unroll
        for (int ai = 0; ai < 2; ++ai)
#pragma unroll
            for (int m = 0; m < 4; ++m) { const int r = ai * HALF + wr * 64 + m * 16 + fr; wv[ai][m] = __int_as_float(lst[(u.pos0 + r < u.cnt) ? r : 0].y); }
#pragma unroll
        for (int ai = 0; ai < 2; ++ai)
#pragma unroll
            for (int m = 0; m < 4; ++m) { const int r = ai * HALF + wr * 64 + m * 16 + fr;
                if (u.pos0 + r < u.cnt) { const float w = wv[ai][m]; bf16_t* rowp = YB + (size_t)(row0 + ai * HALF + m * 16) * D + col0;
#pragma unroll
                    for (int bj = 0; bj < 2; ++bj) { const f32x4 v0 = acc[ai][bj][m][0] * w, v1 = acc[ai][bj][m][1] * w;
                        u32x4 o; o.x = cvt_pk_bf16(v0[0], v0[1]); o.y = cvt_pk_bf16(v0[2], v0[3]); o.z = cvt_pk_bf16(v1[0], v1[1]); o.w = cvt_pk_bf16(v1[2], v1[3]);
                        *(u32x4*)(rowp + bj * HALF) = o; } } }
    }
};
struct MoeOrder {
    const PG8_LAS i32x4* tab; int ntiles, npn, G, c; const char* A; size_t atile; const char* Bt; size_t bexp, btile; const int2* lists;
    __device__ __forceinline__ bool next(int i, Unit& u) const {
        const int L = i * G + c; const int T = L / npn; if (T >= ntiles) return false;
        const i32x4 te = tab[T]; u.pm = T; u.pn = L - T * npn; u.e = __builtin_amdgcn_readfirstlane(te.x); u.pos0 = __builtin_amdgcn_readfirstlane(te.y); u.cnt = __builtin_amdgcn_readfirstlane(te.z);
        u.A = A + (size_t)T * atile; u.B = Bt + (size_t)u.e * bexp + (size_t)u.pn * btile; return true;
    }
    __device__ __forceinline__ void aoff(const Unit& u, unsigned (&o0)[2], unsigned (&o1)[2], const int (&Rs)[2], const int (&Cs)[2]) const {
        const int2* lst = lists + (size_t)u.e * NTOK;
#pragma unroll
        for (int i = 0; i < 2; ++i) { const int p0 = u.pos0 + Rs[i], p1 = p0 + HALF;
            const int t0 = (p0 < u.cnt) ? lst[p0].x : 0, t1 = (p1 < u.cnt) ? lst[p1].x : 0;
            o0[i] = (unsigned)t0 * (unsigned)(D * 2) + (unsigned)Cs[i] * 2u; o1[i] = (unsigned)t1 * (unsigned)(D * 2) + (unsigned)Cs[i] * 2u; }
    }
};
}

__device__ __forceinline__ void tc_strip(float* T, const float* src, int src_ld, int c0, int k0, bf16_t* dst, int K, int n0) {
    const int tid = tid_opaque();
    float4 v[8];
#pragma unroll
    for (int i = 0; i < 8; ++i) { const int kk = (tid >> 4) + 32 * i, c4 = (tid & 15) * 4; v[i] = *(const float4*)(src + (size_t)(k0 + kk) * src_ld + c0 + c4); }
    __syncthreads();
#pragma unroll
    for (int i = 0; i < 8; ++i) { const int kk = (tid >> 4) + 32 * i, c4 = (tid & 15) * 4;
        T[kk * 65 + c4] = v[i].x; T[kk * 65 + c4 + 1] = v[i].y; T[kk * 65 + c4 + 2] = v[i].z; T[kk * 65 + c4 + 3] = v[i].w; }
    __syncthreads();
    const int nl = tid >> 3, kc = (tid & 7) * 32;
#pragma unroll
    for (int q = 0; q < 4; ++q) { const int kq = kc + 8 * q; pg8::u32x4 w;
        w.x = pg8::cvt_pk_bf16(T[(kq + 0) * 65 + nl], T[(kq + 1) * 65 + nl]); w.y = pg8::cvt_pk_bf16(T[(kq + 2) * 65 + nl], T[(kq + 3) * 65 + nl]);
        w.z = pg8::cvt_pk_bf16(T[(kq + 4) * 65 + nl], T[(kq + 5) * 65 + nl]); w.w = pg8::cvt_pk_bf16(T[(kq + 6) * 65 + nl], T[(kq + 7) * 65 + nl]);
        *(pg8::u32x4*)(dst + (size_t)(n0 + nl) * K + k0 + kq) = w; }
}
__device__ __forceinline__ void s5_build_tables_fwd(float* ldsf, const Params& P, int l, int g, unsigned char* tb);
__device__ __forceinline__ void ph_prologue(float* lds, const Params& P) {
    constexpr int NJ_EXP = NLAYER * NEXP * 96, NJ_IN = NLAYER * 144, NJ_OUT = NLAYER * 64, NJ_TB = NLAYER * 16, NJ_GLU = NLAYER * 4, NJ_SGU = NLAYER * 4, NJ_RT = NLAYER * 16;
    bf16_t* WIN = (bf16_t*)(P.ws + WS_WIN); bf16_t* WOUT = (bf16_t*)(P.ws + WS_WOUT); bf16_t* WGU = (bf16_t*)(P.ws + WS_WGU); bf16_t* WD = (bf16_t*)(P.ws + WS_WD);
    constexpr int NJ_ALL = NJ_EXP + NJ_IN + NJ_OUT + NJ_TB + NJ_GLU + NJ_SGU + NJ_RT, NJ_SMALL = NJ_TB + NJ_GLU + NJ_SGU + NJ_RT;
    unsigned* qhead = (unsigned*)(P.ws + WS_CTL) + CW_Q;
    LAS int* jslot = (LAS int*)((LAS unsigned char*)lds + LDS_BYTES - 64);
    for (;;) {
        __syncthreads();
        if (tid_opaque() == 0) *jslot = (int)atomicAdd(qhead, 1u);
        __syncthreads();
        const int jj = __builtin_amdgcn_readfirstlane(*jslot);
        if (jj >= NJ_ALL) break;
        const int j = (jj < NJ_SMALL) ? (NJ_ALL - NJ_SMALL + jj) : (jj - NJ_SMALL);
        if (j < NJ_EXP) {
            const int le = j / 96, r = j % 96;
            if (r < 64) { const int n0 = (r >> 2) * 64, k0 = (r & 3) * 256, pn = n0 >> 8, within = n0 & 255;
                const float* s = (within < 128 ? P.in[I_EWG] : P.in[I_EWU]) + (size_t)le * D * DE;
                tc_strip(lds, s, DE, pn * 128 + (within & 127), k0, WGU + (size_t)le * 1024 * D, D, n0);
            } else { const int r2 = r - 64, n0 = (r2 >> 1) * 64, k0 = (r2 & 1) * 256;
                tc_strip(lds, P.in[I_EWD] + (size_t)le * DE * D, D, n0, k0, WD + (size_t)le * D * DE, DE, n0); }
        } else if (j < NJ_EXP + NJ_IN) {
            const int j2 = j - NJ_EXP, l = j2 / 144, r = j2 % 144, n0 = (r >> 2) * 64, k0 = (r & 3) * 256;
            tc_strip(lds, P.in[I_WIN] + (size_t)l * D * INW, INW, n0 < WCI ? n0 : n0 + 8, k0, WIN + (size_t)l * NMAIN * D, D, n0);
        } else if (j < NJ_EXP + NJ_IN + NJ_OUT) {
            const int j3 = j - NJ_EXP - NJ_IN, l = j3 / 64, r = j3 % 64, n0 = (r >> 2) * 64, k0 = (r & 3) * 256;
            tc_strip(lds, P.in[I_WOUT] + (size_t)l * D * D, D, n0, k0, WOUT + (size_t)l * D * D, D, n0);
        } else if (j < NJ_EXP + NJ_IN + NJ_OUT + NJ_TB) {
            const int j4 = j - (NJ_EXP + NJ_IN + NJ_OUT);
            s5_build_tables_fwd(lds, P, j4 >> 4, j4 & 15, P.ws + WS_TB + (size_t)(j4 >> 4) * 4 * MiB);
        } else if (j < NJ_EXP + NJ_IN + NJ_OUT + NJ_TB + NJ_GLU) {
            const int j5 = j - (NJ_EXP + NJ_IN + NJ_OUT + NJ_TB), l = j5 >> 2, n0 = (j5 & 3) * 64;
            tc_strip(lds, P.in[I_GLUW] + (size_t)l * 256 * 256, 256, n0, 0, (bf16_t*)(P.ws + WS_TB + (size_t)l * 4 * MiB + s5::T_GLUW), 256, n0);
        } else if (j < NJ_EXP + NJ_IN + NJ_OUT + NJ_TB + NJ_GLU + NJ_SGU) {
            const int j6 = j - (NJ_EXP + NJ_IN + NJ_OUT + NJ_TB + NJ_GLU), l = j6 >> 2, g = j6 & 3;
            bf16_t* wbp = (bf16_t*)(P.ws + WS_TB + (size_t)l * 4 * MiB + s5::T_SGUW) + (size_t)g * 128 * 128; const float* ws_ = P.in[I_SGUW] + ((size_t)l * 4 + g) * 128 * 128;
            for (int idx = tid_opaque(); idx < 128 * 128; idx += NTHREADS) { const int t = idx >> 7, s = idx & 127; wbp[idx] = (s <= t) ? (bf16_t)(pg8::cvt_pk_bf16(ws_[idx], 0.f) & 0xffffu) : (bf16_t)0; }
        } else {
            const int j7 = j - (NJ_EXP + NJ_IN + NJ_OUT + NJ_TB + NJ_GLU + NJ_SGU), l = j7 / 16, n0 = (j7 % 16) * 4;
            bf16_t* wh = (bf16_t*)(P.ws + WS_RT + (size_t)l * 256 * 1024); bf16_t* wl = wh + 48 * D;
            for (int idx = tid_opaque(); idx < 4 * D; idx += NTHREADS) { const int n = n0 + (idx >> 10), k = idx & (D - 1);
                const float w = (n < 4) ? P.in[I_RGW][((size_t)l * D + k) * 4 + n] : ((n < 36) ? P.in[I_REW][((size_t)l * D + k) * 32 + (n - 4)] : ((n >= 48 && n < 56) ? P.in[I_WIN][((size_t)l * D + k) * INW + WCI + (n - 48)] : 0.f));
                const unsigned hb = pg8::cvt_pk_bf16(w, 0.f) & 0xffffu; const bf16_t lb = (bf16_t)(pg8::cvt_pk_bf16(w - __uint_as_float(hb << 16), 0.f) & 0xffffu);
                if (n < 48) { wh[(size_t)n * D + k] = (bf16_t)hb; wl[(size_t)n * D + k] = lb; } else { wh[(size_t)(96 + n - 48) * D + k] = (bf16_t)hb; wh[(size_t)(112 + n - 48) * D + k] = lb; } }
        }
    }
    __syncthreads();
}

template <bool DUAL, class AF, class EF>
__device__ __forceinline__ void gemm_tile(float* lds, AF arow, int K, const float* B0, const float* B1, int ldb, int n0, int N, EF epi) {
    float* As = lds;
    float* Bs0 = lds + 32 * 132;
    float* Bs1 = Bs0 + 32 * 128;
    const int tid = tid_opaque(), ty = tid >> 4, tx = tid & 15;
    float acc0[4][8], acc1[4][8];
#pragma unroll
    for (int i = 0; i < 4; ++i)
#pragma unroll
        for (int j = 0; j < 8; ++j) { acc0[i][j] = 0.f; acc1[i][j] = 0.f; }
    const float* ap0 = arow((tid >> 3));
    const float* ap1 = arow((tid >> 3) + 64);
    const int akk = (tid & 7) * 4;
    const int bn = n0 + (tid & 31) * 4; const bool bok = bn < N;
    for (int k0 = 0; k0 < K; k0 += 32) {
        const float4 av0 = ap0 ? *(const float4*)(ap0 + k0 + akk) : make_float4(0.f, 0.f, 0.f, 0.f);
        const float4 av1 = ap1 ? *(const float4*)(ap1 + k0 + akk) : make_float4(0.f, 0.f, 0.f, 0.f);
        const int kb0 = k0 + (tid >> 5), kb1 = kb0 + 16;
        const float4 bv00 = bok ? *(const float4*)(B0 + (size_t)kb0 * ldb + bn) : make_float4(0.f, 0.f, 0.f, 0.f);
        const float4 bv01 = bok ? *(const float4*)(B0 + (size_t)kb1 * ldb + bn) : make_float4(0.f, 0.f, 0.f, 0.f);
        const float4 bv10 = (DUAL && bok) ? *(const float4*)(B1 + (size_t)kb0 * ldb + bn) : bv00;
        const float4 bv11 = (DUAL && bok) ? *(const float4*)(B1 + (size_t)kb1 * ldb + bn) : bv01;
        __syncthreads();
        { const int r = (tid >> 3);
          As[(akk + 0) * 132 + r] = av0.x; As[(akk + 1) * 132 + r] = av0.y; As[(akk + 2) * 132 + r] = av0.z; As[(akk + 3) * 132 + r] = av0.w;
          As[(akk + 0) * 132 + r + 64] = av1.x; As[(akk + 1) * 132 + r + 64] = av1.y; As[(akk + 2) * 132 + r + 64] = av1.z; As[(akk + 3) * 132 + r + 64] = av1.w; }
        { const int k = (tid >> 5);
          *(float4*)&Bs0[k * 128 + (tid & 31) * 4] = bv00; *(float4*)&Bs0[(k + 16) * 128 + (tid & 31) * 4] = bv01;
          if (DUAL) { *(float4*)&Bs1[k * 128 + (tid & 31) * 4] = bv10; *(float4*)&Bs1[(k + 16) * 128 + (tid & 31) * 4] = bv11; } }
        __syncthreads();
#pragma unroll 4
        for (int k = 0; k < 32; ++k) {
            const float4 a = *(const float4*)&As[k * 132 + ty * 4];
            const float4 b0 = *(const float4*)&Bs0[k * 128 + tx * 4], b1 = *(const float4*)&Bs0[k * 128 + 64 + tx * 4];
            const float aa[4] = {a.x, a.y, a.z, a.w};
            const float bb[8] = {b0.x, b0.y, b0.z, b0.w, b1.x, b1.y, b1.z, b1.w};
#pragma unroll
            for (int i = 0; i < 4; ++i)
#pragma unroll
                for (int j = 0; j < 8; ++j) acc0[i][j] = fmaf(aa[i], bb[j], acc0[i][j]);
            if (DUAL) {
                const float4 c0 = *(const float4*)&Bs1[k * 128 + tx * 4], c1 = *(const float4*)&Bs1[k * 128 + 64 + tx * 4];
                const float cc[8] = {c0.x, c0.y, c0.z, c0.w, c1.x, c1.y, c1.z, c1.w};
#pragma unroll
                for (int i = 0; i < 4; ++i)
#pragma unroll
                    for (int j = 0; j < 8; ++j) acc1[i][j] = fmaf(aa[i], cc[j], acc1[i][j]);
            }
        }
    }
#pragma unroll
    for (int i = 0; i < 4; ++i)
#pragma unroll
        for (int j = 0; j < 8; ++j) {
            const int r = ty * 4 + i, c = n0 + (j < 4 ? tx * 4 + j : 64 + tx * 4 + (j - 4));
            if (c < N) epi(r, c, acc0[i][j], acc1[i][j]);
        }
    __syncthreads();
}

__device__ __forceinline__ void ph_inproj(LAS unsigned char* ldsb, const bf16_t* xn, const bf16_t* wt, bf16_t* z, const float* RS, int skip) {
    pg8::StaticOrder S; S.init(NTOK, NMAIN, D, D, gridDim.x, blockIdx.x, xn, wt, INPROJ_WGM);
    if (skip & 2) S.pmmask = 15;
    pg8::EpiZ E{z, RS, skip & 1};
    pg8::gemm_phase<pg8::EpiZ, pg8::StaticOrder, false>(ldsb, D, D, S, E);
}

namespace ml {
using pg8::bf16x8; using pg8::f32x4; using pg8::u32x4; using pg8::u32x2;
constexpr int L = 128, NCH = S / L, NU = NB * 4 * NCH;
constexpr int QP = 144;
constexpr int OFF_Q = 0, OFF_K = OFF_Q + 128 * QP, OFF_V = OFF_K + 128 * QP, OFF_KW = OFF_V + 128 * QP, OFF_F = OFF_KW + 128 * QP;
constexpr int LDS_END = OFF_F + 4 * 128 * 4 + 64;
constexpr size_t O_CL = 0, O_CST = O_CL + (size_t)NU * 4096 * 4, O_NL = O_CST + (size_t)NU * 4096 * 2, O_NST = O_NL + (size_t)NU * 64 * 4,
                 O_MLOC = O_NST + (size_t)NU * 64 * 4, O_BL = O_MLOC + (size_t)NU * 4, O_MST = O_BL + (size_t)NU * 4, O_END = O_MST + (size_t)NU * 4;
__device__ __forceinline__ f32x4 mfma16(bf16x8 a, bf16x8 b, f32x4 c) { return __builtin_amdgcn_mfma_f32_16x16x32_bf16(a, b, c, 0, 0, 0); }
__device__ __forceinline__ float bf_lo(unsigned w) { return __uint_as_float(w << 16); }
__device__ __forceinline__ float bf_hi(unsigned w) { return __uint_as_float(w & 0xffff0000u); }
__device__ __forceinline__ unsigned short bf1(float x) { return (unsigned short)(pg8::cvt_pk_bf16(x, 0.f) & 0xffffu); }

__device__ __forceinline__ void stage_gates(LAS unsigned char* lds, const float* gates, const Params& P, int l, int head, int tok0, int tid) {
    LAS float* LF = (LAS float*)(lds + OFF_F); LAS float* IG = LF + 128; LAS float* Bc = LF + 256; LAS float* G2 = LF + 384; LAS float* scal = LF + 512;
    if (tid < 128) { const float* zr = gates + (size_t)(tok0 + tid) * 8;
        const float ipre = zr[head] + P.in[I_GATEB][l * 8 + head], fpre = zr[4 + head] + P.in[I_GATEB][l * 8 + 4 + head];
        LF[tid] = fminf(fpre, 0.f) - log1pf(expf(-fabsf(fpre))); IG[tid] = ipre; }
    __syncthreads();
    if (tid < 64) { const float a = LF[2 * tid], b2 = LF[2 * tid + 1]; const float s = a + b2; float inc = s;
#pragma unroll
        for (int o = 1; o < 64; o <<= 1) { const float v = __shfl_up(inc, o); if (tid >= o) inc += v; }
        const float exc = inc - s; const float b0 = exc + a, b1 = exc + s;
        Bc[2 * tid] = b0; Bc[2 * tid + 1] = b1; const float g0 = IG[2 * tid] - b0, g1 = IG[2 * tid + 1] - b1; G2[2 * tid] = g0; G2[2 * tid + 1] = g1;
        float gm = fmaxf(g0, g1);
#pragma unroll
        for (int o = 32; o > 0; o >>= 1) gm = fmaxf(gm, __shfl_xor(gm, o));
        if (tid == 63) { scal[0] = gm; scal[1] = b1; } }
    __syncthreads();
}
__device__ __forceinline__ void conv8_load(const bf16_t* z, int b, int pos, int which, int head, int c0, u32x4 (&raw)[4]) {
    const int col = (which ? ZCK : ZCQ) + head * 64 + c0;
#pragma unroll
    for (int j = 0; j < 4; ++j) { const int tg = pos - 3 + j; raw[j] = *(const u32x4*)(z + (size_t)(b * S + (tg > 0 ? tg : 0)) * ZW + col); }
}
__device__ __forceinline__ void conv8_finish(const u32x4 (&raw)[4], const float* cw, int pos, int which, int head, int c0, float (&o)[8]) {
    const int cc = which * 256 + head * 64 + c0;
    float x[8];
#pragma unroll
    for (int e = 0; e < 8; ++e) x[e] = 0.f;
    float4 wa[4], wb[4];
#pragma unroll
    for (int j = 0; j < 4; ++j) { wa[j] = *(const float4*)(cw + j * 512 + cc); wb[j] = *(const float4*)(cw + j * 512 + cc + 4); }
    __builtin_amdgcn_sched_barrier(0);
#pragma unroll
    for (int j = 0; j < 4; ++j) { const float mk = (pos - 3 + j >= 0) ? 1.f : 0.f;
        const float4 w0 = wa[j], w1 = wb[j];
        x[0] += mk * w0.x * bf_lo(raw[j].x); x[1] += mk * w0.y * bf_hi(raw[j].x); x[2] += mk * w0.z * bf_lo(raw[j].y); x[3] += mk * w0.w * bf_hi(raw[j].y);
        x[4] += mk * w1.x * bf_lo(raw[j].z); x[5] += mk * w1.y * bf_hi(raw[j].z); x[6] += mk * w1.z * bf_lo(raw[j].w); x[7] += mk * w1.w * bf_hi(raw[j].w); }
    const float sc = which ? 0.125f : 1.f;
#pragma unroll
    for (int e = 0; e < 8; ++e) o[e] = x[e] * sc * rsig(x[e]);
}
__device__ __forceinline__ void vt_load(const bf16_t* z, int head, int tok0, int tid, u32x4 (&w)[2]) {
#pragma unroll
    for (int it = 0; it < 2; ++it) { const int idx = tid + it * NTHREADS, s = idx >> 3, cg = idx & 7; w[it] = *(const u32x4*)(z + (size_t)(tok0 + s) * ZW + ZCV + head * 64 + cg * 8); }
}
__device__ __forceinline__ void vt_store(LAS unsigned char* lds, int tid, const u32x4 (&w)[2]) {
#pragma unroll
    for (int it = 0; it < 2; ++it) { const int idx = tid + it * NTHREADS, s = idx >> 3, cg = idx & 7; *(LAS u32x4*)(lds + OFF_V + s * QP + cg * 16) = w[it]; }
}

__device__ __forceinline__ void p1_unit(LAS unsigned char* lds, const bf16_t* z, const float* gates, const Params& P, int l, int u, unsigned char* wsm) {
    const int tid = tid_opaque(), lane = tid & 63, wid = __builtin_amdgcn_readfirstlane(tid >> 6), r = lane & 15, qd = lane >> 4;
    const int b = u >> 8, head = (u >> 6) & 3, c = u & 63, tok0 = b * S + c * L;
    LAS float* G2 = (LAS float*)(lds + OFF_F) + 384; LAS float* scal = (LAS float*)(lds + OFF_F) + 512;
    u32x4 vraw[2], kraw[2][4];
    vt_load(z, head, tok0, tid, vraw);
#pragma unroll
    for (int it = 0; it < 2; ++it) { const int idx = tid + it * NTHREADS; conv8_load(z, b, c * L + (idx >> 3), 1, head, (idx & 7) * 8, kraw[it]); }
    __syncthreads();
    stage_gates(lds, gates, P, l, head, tok0, tid);
    const float gmax = scal[0], bL = scal[1];
    vt_store(lds, tid, vraw);
    const float* cw = P.in[I_CONVW] + (size_t)l * 4 * 512;
#pragma unroll
    for (int it = 0; it < 2; ++it) { const int idx = tid + it * NTHREADS, s = idx >> 3, cg = idx & 7;
        float o[8]; conv8_finish(kraw[it], cw, c * L + s, 1, head, cg * 8, o);
        const float ws = __expf(G2[s] - gmax);
        u32x4 w; w.x = pg8::cvt_pk_bf16(o[0] * ws, o[1] * ws); w.y = pg8::cvt_pk_bf16(o[2] * ws, o[3] * ws); w.z = pg8::cvt_pk_bf16(o[4] * ws, o[5] * ws); w.w = pg8::cvt_pk_bf16(o[6] * ws, o[7] * ws);
        *(LAS u32x4*)(lds + OFF_KW + s * QP + cg * 16) = w; }
    __syncthreads();
    const int kt = wid >> 1;
    float* CL = (float*)(wsm + O_CL) + (size_t)u * 4096;
#pragma unroll
    for (int i = 0; i < 2; ++i) { const int vt = (wid & 1) * 2 + i; f32x4 acc = {0.f, 0.f, 0.f, 0.f};
#pragma unroll
        for (int ks = 0; ks < 4; ++ks) {
            const LAS unsigned char* ap = lds + OFF_KW + (32 * ks + 8 * qd + (r >> 2)) * QP + (16 * kt + 4 * (r & 3)) * 2; const LAS unsigned char* bp = lds + OFF_V + (32 * ks + 8 * qd + (r >> 2)) * QP + (16 * vt + 4 * (r & 3)) * 2;
            const u32x2_t a0 = lds_tr4(ap), a1 = lds_tr4(ap + 4 * QP), b0 = lds_tr4(bp), b1 = lds_tr4(bp + 4 * QP);
            const u32x4 aw = {a0.x, a0.y, a1.x, a1.y}, bw = {b0.x, b0.y, b1.x, b1.y};
            acc = mfma16(__builtin_bit_cast(bf16x8, aw), __builtin_bit_cast(bf16x8, bw), acc); }
        *(f32x4*)(CL + (size_t)(16 * vt + r) * 64 + 16 * kt + 4 * qd) = acc; }
    if (tid < 64) { float sum = 0.f;
        for (int s2 = 0; s2 < 128; ++s2) sum += __uint_as_float((unsigned)*(const LAS unsigned short*)(lds + OFF_KW + s2 * QP + tid * 2) << 16);
        ((float*)(wsm + O_NL))[(size_t)u * 64 + tid] = sum; }
    if (tid == 0) { ((float*)(wsm + O_MLOC))[u] = bL + gmax; ((float*)(wsm + O_BL))[u] = bL; }
}
__device__ __forceinline__ void p2_scan(unsigned char* wsm) {
    const int tid = tid_opaque();
    const float* CL = (const float*)(wsm + O_CL); const float* NL = (const float*)(wsm + O_NL); const float* MLOC = (const float*)(wsm + O_MLOC); const float* BL = (const float*)(wsm + O_BL);
    bf16_t* CST = (bf16_t*)(wsm + O_CST); float* NST = (float*)(wsm + O_NST); float* MST = (float*)(wsm + O_MST);
    for (int idx = blockIdx.x * NTHREADS + tid; idx < 32 * 4096; idx += gridDim.x * NTHREADS) {
        const int bh = idx >> 12, e = idx & 4095;
        float C = 0.f, nn = 0.f, m = 0.f;
#pragma unroll 1
        for (int c0 = 0; c0 < NCH; c0 += 16) {
            float cl[16], ml_[16], bl[16], nl[16];
#pragma unroll
            for (int i = 0; i < 16; ++i) { const int u = bh * NCH + c0 + i; cl[i] = CL[(size_t)u * 4096 + e]; ml_[i] = MLOC[u]; bl[i] = BL[u]; nl[i] = NL[(size_t)u * 64 + (e & 63)]; }
            unsigned short cs[16]; float ns[16], ms[16];
#pragma unroll
            for (int i = 0; i < 16; ++i) { cs[i] = bf1(C); ns[i] = nn; ms[i] = m;
                const float mn = fmaxf(bl[i] + m, ml_[i]), dec = __expf(bl[i] + m - mn), wl = __expf(ml_[i] - mn);
                C = dec * C + wl * cl[i]; nn = dec * nn + wl * nl[i]; m = mn; }
#pragma unroll
            for (int i = 0; i < 16; ++i) { const int u = bh * NCH + c0 + i; CST[(size_t)u * 4096 + e] = cs[i]; if (e < 64) NST[(size_t)u * 64 + e] = ns[i]; if (e == 0) MST[u] = ms[i]; }
        }
    }
}
__device__ __forceinline__ void p3_unit(LAS unsigned char* lds, const bf16_t* z, const float* gates, const Params& P, int l, int u, const unsigned char* wsm, bf16_t* mix) {
    const int tid = tid_opaque(), lane = tid & 63, wid = __builtin_amdgcn_readfirstlane(tid >> 6), r = lane & 15, qd = lane >> 4;
    const int b = u >> 8, head = (u >> 6) & 3, c = u & 63, tok0 = b * S + c * L;
    LAS float* Bc = (LAS float*)(lds + OFF_F) + 256; LAS float* G2 = (LAS float*)(lds + OFF_F) + 384;
    u32x4 vraw[2], qkraw[4][4];
    vt_load(z, head, tok0, tid, vraw);
#pragma unroll
    for (int it = 0; it < 4; ++it) { const int idx = tid + it * NTHREADS; conv8_load(z, b, c * L + ((idx >> 3) & 127), idx >> 10, head, (idx & 7) * 8, qkraw[it]); }
    __syncthreads();
    stage_gates(lds, gates, P, l, head, tok0, tid);
    vt_store(lds, tid, vraw);
    const float* cw = P.in[I_CONVW] + (size_t)l * 4 * 512;
#pragma unroll
    for (int it = 0; it < 4; ++it) { const int idx = tid + it * NTHREADS, which = idx >> 10, s = (idx >> 3) & 127, cg = idx & 7;
        float o[8]; conv8_finish(qkraw[it], cw, c * L + s, which, head, cg * 8, o);
        u32x4 w; w.x = pg8::cvt_pk_bf16(o[0], o[1]); w.y = pg8::cvt_pk_bf16(o[2], o[3]); w.z = pg8::cvt_pk_bf16(o[4], o[5]); w.w = pg8::cvt_pk_bf16(o[6], o[7]);
        *(LAS u32x4*)(lds + (which ? OFF_K : OFF_Q) + s * QP + cg * 16) = w; }
    __syncthreads();
    const int w = wid, t = 16 * w + r;
    const bf16x8 bq0 = *(const LAS bf16x8*)(lds + OFF_Q + t * QP + qd * 16), bq1 = *(const LAS bf16x8*)(lds + OFF_Q + t * QP + 64 + qd * 16);
    f32x4 accS[8];
#pragma unroll
    for (int ct = 0; ct < 8; ++ct) { accS[ct] = (f32x4){0.f, 0.f, 0.f, 0.f};
        if (ct <= w) { const bf16x8 a0 = *(const LAS bf16x8*)(lds + OFF_K + (16 * ct + r) * QP + qd * 16), a1 = *(const LAS bf16x8*)(lds + OFF_K + (16 * ct + r) * QP + 64 + qd * 16);
            accS[ct] = mfma16(a0, bq0, accS[ct]); accS[ct] = mfma16(a1, bq1, accS[ct]); } }
    const float bt = Bc[t], mst = ((const float*)(wsm + O_MST))[u];
    float ld[8][4]; float mloc = -3.0e38f;
#pragma unroll
    for (int ct = 0; ct < 8; ++ct) { const f32x4 g = *(const LAS f32x4*)(G2 + 16 * ct + 4 * qd);
#pragma unroll
        for (int j = 0; j < 4; ++j) { const bool valid = (ct < w) || (ct == w && 4 * qd + j <= r); ld[ct][j] = valid ? bt + g[j] : -3.0e38f; mloc = fmaxf(mloc, ld[ct][j]); } }
    mloc = fmaxf(mloc, __shfl_xor(mloc, 16)); mloc = fmaxf(mloc, __shfl_xor(mloc, 32));
    const float mt = fmaxf(bt + mst, mloc);
    float den = 0.f;
#pragma unroll
    for (int ct = 0; ct < 8; ++ct)
#pragma unroll
        for (int j = 0; j < 4; ++j) { const float pe = __expf(ld[ct][j] - mt) * accS[ct][j]; accS[ct][j] = pe; den += pe; }
    den += __shfl_xor(den, 16); den += __shfl_xor(den, 32);
    const bf16_t* cst = (const bf16_t*)(wsm + O_CST) + (size_t)u * 4096; const float* nst = (const float*)(wsm + O_NST) + (size_t)u * 64;
    f32x4 accN[4];
#pragma unroll
    for (int dt = 0; dt < 4; ++dt) { const bf16x8 c0 = *(const bf16x8*)(cst + (16 * dt + r) * 64 + 8 * qd), c1 = *(const bf16x8*)(cst + (16 * dt + r) * 64 + 32 + 8 * qd);
        accN[dt] = mfma16(c0, bq0, (f32x4){0.f, 0.f, 0.f, 0.f}); accN[dt] = mfma16(c1, bq1, accN[dt]); }
    const float winter = __expf(bt + mst - mt);
    float nq = 0.f;
    { const float4 n0 = *(const float4*)(nst + 8 * qd), n1 = *(const float4*)(nst + 8 * qd + 4), n2 = *(const float4*)(nst + 32 + 8 * qd), n3 = *(const float4*)(nst + 36 + 8 * qd);
      const u32x4 q0 = __builtin_bit_cast(u32x4, bq0), q1 = __builtin_bit_cast(u32x4, bq1);
      nq = bf_lo(q0.x) * n0.x + bf_hi(q0.x) * n0.y + bf_lo(q0.y) * n0.z + bf_hi(q0.y) * n0.w + bf_lo(q0.z) * n1.x + bf_hi(q0.z) * n1.y + bf_lo(q0.w) * n1.z + bf_hi(q0.w) * n1.w
         + bf_lo(q1.x) * n2.x + bf_hi(q1.x) * n2.y + bf_lo(q1.y) * n2.z + bf_hi(q1.y) * n2.w + bf_lo(q1.z) * n3.x + bf_hi(q1.z) * n3.y + bf_lo(q1.w) * n3.z + bf_hi(q1.w) * n3.w; }
    nq += __shfl_xor(nq, 16); nq += __shfl_xor(nq, 32);
    den += winter * nq;
#pragma unroll
    for (int dt = 0; dt < 4; ++dt) accN[dt] = accN[dt] * winter;
#pragma unroll
    for (int kk = 0; kk < 4; ++kk) if (2 * kk <= w) {
        u32x4 pw; pw.x = pg8::cvt_pk_bf16(accS[2 * kk][0], accS[2 * kk][1]); pw.y = pg8::cvt_pk_bf16(accS[2 * kk][2], accS[2 * kk][3]);
        pw.z = pg8::cvt_pk_bf16(accS[2 * kk + 1][0], accS[2 * kk + 1][1]); pw.w = pg8::cvt_pk_bf16(accS[2 * kk + 1][2], accS[2 * kk + 1][3]);
        const bf16x8 pf = __builtin_bit_cast(bf16x8, pw);
#pragma unroll
        for (int dt = 0; dt < 4; ++dt) { const LAS unsigned char* vp = lds + OFF_V + (32 * kk + 4 * qd + (r >> 2)) * QP + (16 * dt + 4 * (r & 3)) * 2;
            const u32x2_t v0 = lds_tr4(vp), v1 = lds_tr4(vp + 16 * QP);
            u32x4 vw; vw.x = v0.x; vw.y = v0.y; vw.z = v1.x; vw.w = v1.y;
            accN[dt] = mfma16(__builtin_bit_cast(bf16x8, vw), pf, accN[dt]); } }
    const float inv = 1.f / fmaxf(fabsf(den), __expf(-mt));
    float ss = 0.f;
#pragma unroll
    for (int dt = 0; dt < 4; ++dt) { accN[dt] = accN[dt] * inv; ss += accN[dt][0] * accN[dt][0] + accN[dt][1] * accN[dt][1] + accN[dt][2] * accN[dt][2] + accN[dt][3] * accN[dt][3]; }
    ss += __shfl_xor(ss, 16); ss += __shfl_xor(ss, 32);
    const float rs = rsqrtf(ss * (1.f / 64.f) + EPS);
    const float* ng = P.in[I_MNG] + l * 256 + head * 64; const bf16_t* cop = z + (size_t)(tok0 + t) * ZW + ZCO + head * 64;
    bf16_t* op = mix + (size_t)(tok0 + t) * D + 512 + head * 64;
#pragma unroll
    for (int dt = 0; dt < 4; ++dt) { const int d0 = 16 * dt + 4 * qd; const float4 g = *(const float4*)(ng + d0); const u32x2 cw2 = *(const u32x2*)(cop + d0); const float4 co = make_float4(bf_lo(cw2.x), bf_hi(cw2.x), bf_lo(cw2.y), bf_hi(cw2.y));
        u32x2 o; o.x = pg8::cvt_pk_bf16(accN[dt][0] * rs * g.x * rsig(co.x), accN[dt][1] * rs * g.y * rsig(co.y));
        o.y = pg8::cvt_pk_bf16(accN[dt][2] * rs * g.z * rsig(co.z), accN[dt][3] * rs * g.w * rsig(co.w));
        *(u32x2*)(op + d0) = o; }
}
static_assert(O_END <= 64 * MiB && LDS_END <= 128 * 1024, "mLSTM scratch fits");
}

namespace s5 {
using pg8::bf16x8; using pg8::f32x4; using pg8::u32x4; using pg8::u32x2;
constexpr int LC = 16, NINST = NTOK / LC;
constexpr size_t O_E = 0, O_XC = O_E + (size_t)NINST * 16 * 128 * 4, O_END = O_XC + (size_t)NINST * 16 * 128 * 2;
constexpr int YP = 528;
__device__ __forceinline__ f32x4 mfma16(bf16x8 a, bf16x8 b, f32x4 c) { return __builtin_amdgcn_mfma_f32_16x16x32_bf16(a, b, c, 0, 0, 0); }

__device__ __forceinline__ void build_tables(float* ldsf, const Params& P, int l, int g, unsigned char* tb) {
    const int tid = tid_opaque();
    float* apw = ldsf; float* bb = apw + 17 * 64 * 2; float* cc = bb + 64 * 16 * 2;
    __syncthreads();
    if (tid < 64) { const int gp = (l * 16 + g) * 64 + tid;
        const float ar = P.in[I_ARE][gp], ai = P.in[I_AIM][gp], dt = expf(P.in[I_LDT][l * 16 + g]);
        for (int tau = 0; tau <= 16; ++tau) { const float er = expf(ar * dt * tau), ang = ai * dt * tau; apw[(tau * 64 + tid) * 2] = er * cosf(ang); apw[(tau * 64 + tid) * 2 + 1] = er * sinf(ang); }
        const float abr = apw[(64 + tid) * 2], abi = apw[(64 + tid) * 2 + 1];
        const float xr_ = abr - 1.f, xi_ = abi, den = ar * ar + ai * ai;
        const float cr = (xr_ * ar + xi_ * ai) / den, ci = (xi_ * ar - xr_ * ai) / den;
        for (int h = 0; h < 16; ++h) { const float br = P.in[I_BRE][(size_t)gp * 16 + h], bi = P.in[I_BIM][(size_t)gp * 16 + h]; bb[(tid * 16 + h) * 2] = cr * br - ci * bi; bb[(tid * 16 + h) * 2 + 1] = cr * bi + ci * br; }
        float* a16 = (float*)(tb + T_A16) + (size_t)(g * 64 + tid) * 2; a16[0] = apw[(16 * 64 + tid) * 2]; a16[1] = apw[(16 * 64 + tid) * 2 + 1]; }
    for (int idx = tid; idx < 16 * 64; idx += NTHREADS) { const int h = idx >> 6, p = idx & 63; const int ci_ = ((l * 16 + g) * 16 + h) * 64 + p; cc[idx * 2] = P.in[I_CRE][ci_]; cc[idx * 2 + 1] = P.in[I_CIM][ci_]; }
    __syncthreads();
    bf16_t* KM = (bf16_t*)(tb + T_KMAT) + (size_t)g * 32 * 256;
    for (int idx = tid; idx < 15 * 256; idx += NTHREADS) KM[idx] = (bf16_t)0; bf16_t* FT = (bf16_t*)(tb + T_F) + (size_t)g * 256 * 128; bf16_t* GT = (bf16_t*)(tb + T_G) + (size_t)g * 128 * 256;
    for (int idx = tid; idx < 16 * 256; idx += NTHREADS) { const int tau = idx >> 8, h = (idx >> 4) & 15, hp = idx & 15; float s = 0.f;
        for (int p = 0; p < 64; ++p) { const float cr = cc[(h * 64 + p) * 2], ci = cc[(h * 64 + p) * 2 + 1], ar = apw[(tau * 64 + p) * 2], ai = apw[(tau * 64 + p) * 2 + 1], br = bb[(p * 16 + hp) * 2], bi = bb[(p * 16 + hp) * 2 + 1];
            const float er = ar * br - ai * bi, ei = ar * bi + ai * br; s += cr * er - ci * ei; }
        KM[15 * 256 + idx] = ml::bf1(s); }
    for (int idx = tid; idx < 256 * 64; idx += NTHREADS) { const int n = idx >> 6, p = idx & 63, t = n >> 4, h = n & 15;
        const float cr = cc[(h * 64 + p) * 2], ci = cc[(h * 64 + p) * 2 + 1], ar = apw[((t + 1) * 64 + p) * 2], ai = apw[((t + 1) * 64 + p) * 2 + 1];
        FT[(size_t)n * 128 + p] = ml::bf1(cr * ar - ci * ai); FT[(size_t)n * 128 + 64 + p] = ml::bf1(-(cr * ai + ci * ar)); }
    for (int idx = tid; idx < 64 * 256; idx += NTHREADS) { const int p = idx >> 8, k = idx & 255, s = k >> 4, hp = k & 15;
        const float ar = apw[((15 - s) * 64 + p) * 2], ai = apw[((15 - s) * 64 + p) * 2 + 1], br = bb[(p * 16 + hp) * 2], bi = bb[(p * 16 + hp) * 2 + 1];
        GT[(size_t)p * 256 + k] = ml::bf1(ar * br - ai * bi); GT[(size_t)(64 + p) * 256 + k] = ml::bf1(ar * bi + ai * br); }
}
__device__ __forceinline__ void load_u_frags(const bf16_t* z, int tok0, int g, int r, int qd, bf16x8 (&uf)[8]) {
#pragma unroll
    for (int ks = 0; ks < 8; ++ks) uf[ks] = *(const bf16x8*)(z + (size_t)(tok0 + 16 * r + 2 * ks + (qd >> 1)) * ZW + ZSU + 16 * g + 8 * (qd & 1));
}
__device__ __forceinline__ void p1_unit(const bf16_t* z, const unsigned char* tb, int u, unsigned char* wss) {
    const int tid = tid_opaque(), lane = tid & 63, wid = __builtin_amdgcn_readfirstlane(tid >> 6), r = lane & 15, qd = lane >> 4;
    const int tok0 = u * 256, inst0 = u * 16;
    float* E = (float*)(wss + O_E);
#pragma unroll 1
    for (int gi = 0; gi < 2; ++gi) { const int g = 2 * wid + gi;
        bf16x8 uf[8]; load_u_frags(z, tok0, g, r, qd, uf);
        const bf16_t* GT = (const bf16_t*)(tb + T_G) + (size_t)g * 128 * 256 + (size_t)r * 256 + 8 * qd;
        bf16x8 gf[2][8];
#pragma unroll
        for (int ks = 0; ks < 8; ++ks) gf[0][ks] = *(const bf16x8*)(GT + 32 * ks);
#pragma unroll
        for (int nt = 0; nt < 8; ++nt) {
            if (nt + 1 < 8) {
#pragma unroll
                for (int ks = 0; ks < 8; ++ks) gf[(nt + 1) & 1][ks] = *(const bf16x8*)(GT + (size_t)(16 * (nt + 1)) * 256 + 32 * ks); }
            __builtin_amdgcn_sched_barrier(0);
            f32x4 acc = {0.f, 0.f, 0.f, 0.f};
#pragma unroll
            for (int ks = 0; ks < 8; ++ks) acc = mfma16(gf[nt & 1][ks], uf[ks], acc);
            *(f32x4*)(E + ((size_t)(inst0 + r) * 16 + g) * 128 + 16 * nt + 4 * qd) = acc;
            __builtin_amdgcn_sched_barrier(0); }
    }
}
__device__ __forceinline__ void p2_scan(LAS unsigned char* lds, const unsigned char* tb, unsigned char* wss) {
    const int tid = tid_opaque(), p = tid & 63, seg = tid >> 6;
    const float* __restrict__ E = (const float*)(wss + O_E); bf16_t* __restrict__ XC = (bf16_t*)(wss + O_XC);
    LAS float* SE = (LAS float*)lds;
    for (int u = blockIdx.x; u < NB * 16; u += gridDim.x) {
        const int b = u >> 4, g = u & 15;
        const float* a16 = (const float*)(tb + T_A16) + (size_t)(g * 64 + p) * 2; const float ar = a16[0], ai = a16[1];
        const size_t o0 = ((size_t)(b * (S / LC) + seg * 64) * 16 + g) * 128 + p; constexpr size_t cs = (size_t)16 * 128;
        float xr = 0.f, xi = 0.f;
#pragma unroll 1
        for (int c0 = 0; c0 < 64; c0 += 16) { float er[16], ei[16];
#pragma unroll
            for (int i = 0; i < 16; ++i) { er[i] = E[o0 + (c0 + i) * cs]; ei[i] = E[o0 + (c0 + i) * cs + 64]; }
#pragma unroll
            for (int i = 0; i < 16; ++i) { const float nr = ar * xr - ai * xi + er[i], ni = ar * xi + ai * xr + ei[i]; xr = nr; xi = ni; } }
        __syncthreads();
        SE[(seg * 64 + p) * 2] = xr; SE[(seg * 64 + p) * 2 + 1] = xi;
        __syncthreads();
        float br = ar, bi = ai;
#pragma unroll
        for (int i = 0; i < 6; ++i) { const float nr = br * br - bi * bi, ni = 2.f * br * bi; br = nr; bi = ni; }
        xr = 0.f; xi = 0.f;
        for (int s2 = 0; s2 < seg; ++s2) { const float er = SE[(s2 * 64 + p) * 2], ei = SE[(s2 * 64 + p) * 2 + 1]; const float nr = br * xr - bi * xi + er, ni = br * xi + bi * xr + ei; xr = nr; xi = ni; }
#pragma unroll 1
        for (int c0 = 0; c0 < 64; c0 += 16) { float er[16], ei[16]; unsigned short sr[16], si[16];
#pragma unroll
            for (int i = 0; i < 16; ++i) { er[i] = E[o0 + (c0 + i) * cs]; ei[i] = E[o0 + (c0 + i) * cs + 64]; }
#pragma unroll
            for (int i = 0; i < 16; ++i) { sr[i] = ml::bf1(xr); si[i] = ml::bf1(xi); const float nr = ar * xr - ai * xi + er[i], ni = ar * xi + ai * xr + ei[i]; xr = nr; xi = ni; }
#pragma unroll
            for (int i = 0; i < 16; ++i) { XC[o0 + (c0 + i) * cs] = sr[i]; XC[o0 + (c0 + i) * cs + 64] = si[i]; } }
    }
    __syncthreads();
}
__device__ __forceinline__ void p3_unit(LAS unsigned char* lds, const bf16_t* z, const Params& P, int l, const unsigned char* tb, int u, const unsigned char* wss, bf16_t* mix) {
    const int tid = tid_opaque(), lane = tid & 63, wid = __builtin_amdgcn_readfirstlane(tid >> 6), r = lane & 15, qd = lane >> 4;
    const int tok0 = u * 256, inst0 = u * 16;
    const bf16_t* XC = (const bf16_t*)(wss + O_XC);
    __syncthreads();
#pragma unroll 1
    for (int gi = 0; gi < 2; ++gi) { const int g = 2 * wid + gi;
        bf16x8 uf[8]; load_u_frags(z, tok0, g, r, qd, uf);
        bf16x8 xf[4];
#pragma unroll
        for (int ks = 0; ks < 4; ++ks) xf[ks] = *(const bf16x8*)(XC + ((size_t)(inst0 + r) * 16 + g) * 128 + 32 * ks + 8 * qd);
        const bf16_t* KM = (const bf16_t*)(tb + T_KMAT) + (size_t)g * 32 * 256 + (size_t)(15 - (qd >> 1)) * 256 + r * 16 + 8 * (qd & 1);
        const bf16_t* FT = (const bf16_t*)(tb + T_F) + (size_t)g * 256 * 128 + (size_t)r * 128 + 8 * qd;
        const bf16_t* up = z + (size_t)(tok0 + 16 * r) * ZW + ZSU + 16 * g + 4 * qd;
        const float4 dsk = *(const float4*)(P.in[I_SD] + l * 256 + g * 16 + 4 * qd);
        bf16x8 kf[2][8], ff[2][4]; u32x2 uw[2];
#pragma unroll
        for (int ks = 0; ks < 8; ++ks) kf[0][ks] = *(const bf16x8*)(KM + (ptrdiff_t)(0 - 2 * ks) * 256);
#pragma unroll
        for (int ks = 0; ks < 4; ++ks) ff[0][ks] = *(const bf16x8*)(FT + 32 * ks);
        uw[0] = *(const u32x2*)up;
#pragma unroll
        for (int t = 0; t < 16; ++t) {
            if (t + 1 < 16) {
#pragma unroll
                for (int ks = 0; ks < 8; ++ks) kf[(t + 1) & 1][ks] = *(const bf16x8*)(KM + (ptrdiff_t)(t + 1 - 2 * ks) * 256);
#pragma unroll
                for (int ks = 0; ks < 4; ++ks) ff[(t + 1) & 1][ks] = *(const bf16x8*)(FT + (size_t)(t + 1) * 16 * 128 + 32 * ks);
                uw[(t + 1) & 1] = *(const u32x2*)(up + (size_t)(t + 1) * ZW); }
            __builtin_amdgcn_sched_barrier(0);
            f32x4 acc = {0.f, 0.f, 0.f, 0.f};
#pragma unroll
            for (int ks = 0; ks < 8; ++ks) if (2 * ks <= t) acc = mfma16(kf[t & 1][ks], uf[ks], acc);
#pragma unroll
            for (int ks = 0; ks < 4; ++ks) acc = mfma16(ff[t & 1][ks], xf[ks], acc);
            const u32x2 uu = uw[t & 1];
            const float y0 = gelu_tanh(acc[0] + dsk.x * ml::bf_lo(uu.x)), y1 = gelu_tanh(acc[1] + dsk.y * ml::bf_hi(uu.x)), y2 = gelu_tanh(acc[2] + dsk.z * ml::bf_lo(uu.y)), y3 = gelu_tanh(acc[3] + dsk.w * ml::bf_hi(uu.y));
            u32x2 o; o.x = pg8::cvt_pk_bf16(y0, y1); o.y = pg8::cvt_pk_bf16(y2, y3);
            *(LAS u32x2*)(lds + (16 * r + t) * YP + (16 * g + 4 * qd) * 2) = o;
            __builtin_amdgcn_sched_barrier(0); }
    }
    __syncthreads();
    const bf16_t* GW = (const bf16_t*)(tb + T_GLUW);
    bf16x8 wf[2][8];
#pragma unroll
    for (int nt = 0; nt < 2; ++nt)
#pragma unroll
        for (int ks = 0; ks < 8; ++ks) wf[nt][ks] = *(const bf16x8*)(GW + (size_t)(32 * wid + 16 * nt + r) * 256 + 32 * ks + 8 * qd);
    const float* gb = P.in[I_GLUB] + l * 256;
    const float4 gb0 = *(const float4*)(gb + 32 * wid + 4 * qd), gb1 = *(const float4*)(gb + 32 * wid + 16 + 4 * qd);
#pragma unroll 2
    for (int mt = 0; mt < 16; ++mt) {
        f32x4 a0 = {0.f, 0.f, 0.f, 0.f}, a1 = {0.f, 0.f, 0.f, 0.f};
#pragma unroll
        for (int ks = 0; ks < 8; ++ks) { const bf16x8 yf = *(const LAS bf16x8*)(lds + (16 * mt + r) * YP + (32 * ks + 8 * qd) * 2); a0 = mfma16(wf[0][ks], yf, a0); a1 = mfma16(wf[1][ks], yf, a1); }
        const int row = 16 * mt + r;
        const u32x2 y0 = *(const LAS u32x2*)(lds + row * YP + (32 * wid + 4 * qd) * 2), y1 = *(const LAS u32x2*)(lds + row * YP + (32 * wid + 16 + 4 * qd) * 2);
        bf16_t* op = mix + (size_t)(tok0 + row) * D + 256 + 32 * wid + 4 * qd;
        u32x2 o;
        o.x = pg8::cvt_pk_bf16(ml::bf_lo(y0.x) * rsig(a0[0] + gb0.x), ml::bf_hi(y0.x) * rsig(a0[1] + gb0.y));
        o.y = pg8::cvt_pk_bf16(ml::bf_lo(y0.y) * rsig(a0[2] + gb0.z), ml::bf_hi(y0.y) * rsig(a0[3] + gb0.w));
        *(u32x2*)op = o;
        o.x = pg8::cvt_pk_bf16(ml::bf_lo(y1.x) * rsig(a1[0] + gb1.x), ml::bf_hi(y1.x) * rsig(a1[1] + gb1.y));
        o.y = pg8::cvt_pk_bf16(ml::bf_lo(y1.y) * rsig(a1[2] + gb1.z), ml::bf_hi(y1.y) * rsig(a1[3] + gb1.w));
        *(u32x2*)(op + 16) = o;
    }
}
static_assert(T_LAYER <= 4 * MiB && O_END <= 48 * MiB && 256 * YP <= LDS_BYTES - 64, "S5 scratch fits");
}
__device__ __forceinline__ void s5_build_tables_fwd(float* ldsf, const Params& P, int l, int g, unsigned char* tb) { s5::build_tables(ldsf, P, l, g, tb); }

namespace at {
using pg8::bf16x8; using pg8::f32x4; using pg8::u32x4; using pg8::u32x2;
constexpr int KP = 144, OFF_K = 0, OFF_V = 256 * KP, LDS_END = OFF_V + 256 * KP;
__device__ __forceinline__ void unit(LAS unsigned char* lds, const bf16_t* z, const float* sinks, bf16_t* mix, int u) {
    const int tid = tid_opaque(), lane = tid & 63, wid = __builtin_amdgcn_readfirstlane(tid >> 6), r = lane & 15, qd = lane >> 4;
    const int b = u >> 7, g = (u >> 6) & 1, n = u & 63, tokb = b * S + 128 * n;
    const int hq = 2 * g + (wid >> 2);
    const float sink = sinks[hq];
    __syncthreads();
    u32x4 kw[4], vw[4];
#pragma unroll
    for (int it = 0; it < 4; ++it) { const int idx = tid + it * NTHREADS, kl = idx >> 3, cg = idx & 7; const bool ok = (n > 0) || (kl >= 128);
        kw[it] = *(const u32x4*)(z + (size_t)(ok ? tokb - 128 + kl : tokb) * ZW + ZK + g * 64 + cg * 8); }
#pragma unroll
    for (int it = 0; it < 4; ++it) { const int idx = tid + it * NTHREADS, kl = idx >> 3, cg = idx & 7; const bool ok = (n > 0) || (kl >= 128);
        vw[it] = *(const u32x4*)(z + (size_t)(ok ? tokb - 128 + kl : tokb) * ZW + ZV + g * 64 + cg * 8); }
    __builtin_amdgcn_sched_barrier(0);
#pragma unroll
    for (int it = 0; it < 4; ++it) { const int idx = tid + it * NTHREADS, kl = idx >> 3, cg = idx & 7; const bool ok = (n > 0) || (kl >= 128);
        u32x4 w = kw[it]; if (!ok) w = (u32x4){0u, 0u, 0u, 0u};
        *(LAS u32x4*)(lds + OFF_K + kl * KP + cg * 16) = w; }
#pragma unroll
    for (int it = 0; it < 4; ++it) { const int idx = tid + it * NTHREADS, kl = idx >> 3, cg = idx & 7; const bool ok = (n > 0) || (kl >= 128);
        u32x4 w = vw[it]; if (!ok) w = (u32x4){0u, 0u, 0u, 0u};
        *(LAS u32x4*)(lds + OFF_V + kl * KP + cg * 16) = w; }
    __syncthreads();
#pragma unroll 1
    for (int qt = 0; qt < 2; ++qt) {
        const int i0 = (wid & 3) * 32 + qt * 16, kt0 = i0 >> 4, tok = tokb + i0 + r;
        const bf16x8 bq0 = *(const bf16x8*)(z + (size_t)tok * ZW + ZQ + hq * 64 + 8 * qd), bq1 = *(const bf16x8*)(z + (size_t)tok * ZW + ZQ + hq * 64 + 32 + 8 * qd);
        f32x4 accS[9];
#pragma unroll
        for (int c = 0; c < 9; ++c) { const int kt = kt0 + c;
            const bf16x8 a0 = *(const LAS bf16x8*)(lds + OFF_K + (16 * kt + r) * KP + qd * 16), a1 = *(const LAS bf16x8*)(lds + OFF_K + (16 * kt + r) * KP + 64 + qd * 16);
            accS[c] = ml::mfma16(a0, bq0, (f32x4){0.f, 0.f, 0.f, 0.f}); accS[c] = ml::mfma16(a1, bq1, accS[c]); }
        float m = sink;
#pragma unroll
        for (int c = 0; c < 9; ++c)
#pragma unroll
            for (int j = 0; j < 4; ++j) { const int e = 4 * qd + j;
                bool valid = (c == 0) ? (e > r) : ((c == 8) ? (e <= r) : true);
                valid = valid && ((n > 0) || (kt0 + c >= 8));
                const float s = valid ? accS[c][j] * 0.125f : -3.0e38f; accS[c][j] = s; m = fmaxf(m, s); }
        m = fmaxf(m, __shfl_xor(m, 16)); m = fmaxf(m, __shfl_xor(m, 32));
        float l = 0.f;
#pragma unroll
        for (int c = 0; c < 9; ++c)
#pragma unroll
            for (int j = 0; j < 4; ++j) { const float p = __expf(accS[c][j] - m); accS[c][j] = p; l += p; }
        l += __shfl_xor(l, 16); l += __shfl_xor(l, 32);
        l += __expf(sink - m);
        f32x4 accO[4];
#pragma unroll
        for (int dt = 0; dt < 4; ++dt) accO[dt] = (f32x4){0.f, 0.f, 0.f, 0.f};
#pragma unroll
        for (int kk = 0; kk < 5; ++kk) {
            u32x4 pw; pw.x = pg8::cvt_pk_bf16(accS[2 * kk][0], accS[2 * kk][1]); pw.y = pg8::cvt_pk_bf16(accS[2 * kk][2], accS[2 * kk][3]);
            if (kk < 4) { pw.z = pg8::cvt_pk_bf16(accS[2 * kk + 1][0], accS[2 * kk + 1][1]); pw.w = pg8::cvt_pk_bf16(accS[2 * kk + 1][2], accS[2 * kk + 1][3]); } else { pw.z = 0u; pw.w = 0u; }
            const bf16x8 pf = __builtin_bit_cast(bf16x8, pw);
            const int base = 16 * (kt0 + 2 * kk);
#pragma unroll
            for (int dt = 0; dt < 4; ++dt) { const LAS unsigned char* vp = lds + OFF_V + (base + 4 * qd + (r >> 2)) * KP + (16 * dt + 4 * (r & 3)) * 2;
                const u32x2_t v0 = lds_tr4(vp);
                u32x2_t v1 = {0u, 0u}; if (kk < 4) v1 = lds_tr4(vp + 16 * KP);
                u32x4 vw; vw.x = v0.x; vw.y = v0.y; vw.z = v1.x; vw.w = v1.y;
                accO[dt] = ml::mfma16(__builtin_bit_cast(bf16x8, vw), pf, accO[dt]); } }
        const float inv = 1.f / l;
        bf16_t* op = mix + (size_t)tok * D + hq * 64;
#pragma unroll
        for (int dt = 0; dt < 4; ++dt) { u32x2 o; o.x = pg8::cvt_pk_bf16(accO[dt][0] * inv, accO[dt][1] * inv); o.y = pg8::cvt_pk_bf16(accO[dt][2] * inv, accO[dt][3] * inv);
            *(u32x2*)(op + 16 * dt + 4 * qd) = o; }
    }
}
}

namespace sg {
using pg8::bf16x8; using pg8::f32x4; using pg8::u32x4; using pg8::u32x2;
constexpr int VP = 528, OFF_V = 0, OFF_ST = 128 * VP, LDS_END = OFF_ST + 128 * 4 * 2 * 4;
__device__ __forceinline__ void unit(LAS unsigned char* lds, const bf16_t* z, const Params& P, int l, const bf16_t* wb  , bf16_t* mix, int u) {
    const int tid = tid_opaque(), lane = tid & 63, wid = __builtin_amdgcn_readfirstlane(tid >> 6), r = lane & 15, qd = lane >> 4;
    const int tok0 = u * 128;
    LAS float* ST = (LAS float*)(lds + OFF_ST);
    __syncthreads();
    const int s = tid & 127, cq = tid >> 7;
    const bf16_t* gp = z + (size_t)(tok0 + s) * ZW + ZGV + cq * 64;
    u32x4 raw[8];
#pragma unroll
    for (int i = 0; i < 8; ++i) raw[i] = *(const u32x4*)(gp + 8 * i);
    const int t = 16 * wid + r;
    bf16x8 wf[2][4];
#pragma unroll
    for (int ks = 0; ks < 4; ++ks) wf[0][ks] = *(const bf16x8*)(wb + (size_t)t * 128 + 32 * ks + 8 * qd);
    float sm = 0.f, sq = 0.f;
#pragma unroll
    for (int i = 0; i < 8; ++i) { const unsigned ww[4] = {raw[i].x, raw[i].y, raw[i].z, raw[i].w};
#pragma unroll
        for (int e = 0; e < 8; ++e) { const float ge = gelu_tanh((e & 1) ? bfh(ww[e >> 1]) : bfl(ww[e >> 1])); sm += ge; sq += ge * ge; } }
    ST[(s * 4 + cq) * 2] = sm; ST[(s * 4 + cq) * 2 + 1] = sq;
    __syncthreads();
    { float tsm = 0.f, tsq = 0.f;
#pragma unroll
      for (int q = 0; q < 4; ++q) { tsm += ST[(s * 4 + q) * 2]; tsq += ST[(s * 4 + q) * 2 + 1]; }
      const float mu = tsm * (1.f / 256.f), var = fmaxf(tsq * (1.f / 256.f) - mu * mu, 0.f), rs = rsqrtf(var + EPS);
      const float* lg = P.in[I_LNG] + l * 256 + cq * 64; const float* lb = P.in[I_LNB] + l * 256 + cq * 64;
#pragma unroll
      for (int i = 0; i < 8; ++i) { const unsigned ww[4] = {raw[i].x, raw[i].y, raw[i].z, raw[i].w};
          const float4 g0 = *(const float4*)(lg + 8 * i), g1 = *(const float4*)(lg + 8 * i + 4), b0 = *(const float4*)(lb + 8 * i), b1 = *(const float4*)(lb + 8 * i + 4);
          const float gg[8] = {g0.x, g0.y, g0.z, g0.w, g1.x, g1.y, g1.z, g1.w}, bb[8] = {b0.x, b0.y, b0.z, b0.w, b1.x, b1.y, b1.z, b1.w};
          float o[8];
#pragma unroll
          for (int e = 0; e < 8; ++e) o[e] = (gelu_tanh((e & 1) ? bfh(ww[e >> 1]) : bfl(ww[e >> 1])) - mu) * rs * gg[e] + bb[e];
          u32x4 w; w.x = pg8::cvt_pk_bf16(o[0], o[1]); w.y = pg8::cvt_pk_bf16(o[2], o[3]); w.z = pg8::cvt_pk_bf16(o[4], o[5]); w.w = pg8::cvt_pk_bf16(o[6], o[7]);
          *(LAS u32x4*)(lds + OFF_V + s * VP + (cq * 64 + 8 * i) * 2) = w; } }
    __syncthreads();
    const LAS unsigned char* vtr = lds + OFF_V + (8 * qd + (r >> 2)) * VP + (4 * (r & 3)) * 2;
#pragma unroll
    for (int g = 0; g < 4; ++g) {
        if (g + 1 < 4) {
#pragma unroll
            for (int ks = 0; ks < 4; ++ks) wf[(g + 1) & 1][ks] = *(const bf16x8*)(wb + ((size_t)(g + 1) * 128 + t) * 128 + 32 * ks + 8 * qd); }
        const float bias = P.in[I_SGUB][l * 512 + g * 128 + t];
        u32x2 gw[4];
#pragma unroll
        for (int ct = 0; ct < 4; ++ct) gw[ct] = *(const u32x2*)(z + (size_t)(tok0 + t) * ZW + ZGU + g * 64 + 16 * ct + 4 * qd);
#pragma unroll
        for (int ct = 0; ct < 4; ++ct) { f32x4 acc = {0.f, 0.f, 0.f, 0.f};
#pragma unroll
            for (int ks = 0; ks < 4; ++ks) if (2 * ks <= wid) { const LAS unsigned char* ap = vtr + (32 * ks) * VP + (g * 64 + 16 * ct) * 2;
                const u32x2_t a0 = lds_tr4(ap), a1 = lds_tr4(ap + 4 * VP); const u32x4 aw = {a0.x, a0.y, a1.x, a1.y};
                acc = ml::mfma16(__builtin_bit_cast(bf16x8, aw), wf[g & 1][ks], acc); }
            const int c0 = g * 64 + 16 * ct + 4 * qd;
            u32x2 o; o.x = pg8::cvt_pk_bf16(gelu_tanh(bfl(gw[ct].x)) * (acc[0] + bias), gelu_tanh(bfh(gw[ct].x)) * (acc[1] + bias)); o.y = pg8::cvt_pk_bf16(gelu_tanh(bfl(gw[ct].y)) * (acc[2] + bias), gelu_tanh(bfh(gw[ct].y)) * (acc[3] + bias));
            *(u32x2*)(mix + (size_t)(tok0 + t) * D + 768 + c0) = o; }
    }
}
}

__device__ __forceinline__ void ph_mix1(float* lds, const Params& P, int l, bf16_t* z, const float* gates, bf16_t* mix, unsigned char* wsm, unsigned char* wss, const unsigned char* tb, int sub) {
    const int G = gridDim.x, bid = blockIdx.x;
    if (sub & 1) for (int u = bid; u < ml::NU; u += G) ml::p1_unit((LAS unsigned char*)lds, z, gates, P, l, u, wsm);
    __syncthreads();
    if (sub & 2) for (int u = bid; u < NTOK / 256; u += G) s5::p1_unit(z, tb, u, wss);
    __syncthreads();
    if (sub & 4) for (int u = bid; u < 1024; u += G) at::unit((LAS unsigned char*)lds, z, P.in[I_SINK] + l * 4, mix, u);
    __syncthreads();
    if (sub & 8) for (int u = bid; u < NTOK / 128; u += G) sg::unit((LAS unsigned char*)lds, z, P, l, (const bf16_t*)(tb + s5::T_SGUW), mix, u);
    __syncthreads();
}

__device__ __forceinline__ void ph_mix2(float* lds, const Params& P, int l, const bf16_t* z, const float* gates, bf16_t* mix, const unsigned char* wsm, const unsigned char* wss, const unsigned char* tb, int sub) {
    if (sub & 1) for (int u = blockIdx.x; u < NTOK / 256; u += gridDim.x) s5::p3_unit((LAS unsigned char*)lds, z, P, l, tb, u, wss, mix);
    __syncthreads();
    if (sub & 2) for (int u = blockIdx.x; u < ml::NU; u += gridDim.x) ml::p3_unit((LAS unsigned char*)lds, z, gates, P, l, u, wsm, mix);
    __syncthreads();
}

template <bool SRCF32>
__device__ __forceinline__ void ph_outproj(LAS unsigned char* ldsb, const bf16_t* mix, const bf16_t* wt, const float* xf, bf16_t* xb) {
    pg8::StaticOrder S; S.init(NTOK, D, D, D, gridDim.x, blockIdx.x, mix, wt);
    pg8::EpiResB<SRCF32> E{xf, xb};
    pg8::gemm_phase<pg8::EpiResB<SRCF32>, pg8::StaticOrder, false>(ldsb, D, D, S, E);
}

namespace rp {
using pg8::bf16x8; using pg8::f32x4; using pg8::u32x4;
constexpr size_t T_HI = 0, T_LO = (size_t)48 * D * 2, T_GHI = 2 * T_LO, T_GLO = T_GHI + (size_t)16 * D * 2, T_SIZE = T_GLO + (size_t)16 * D * 2;
static_assert(T_SIZE <= 256 * 1024, "row-pass tables fit their slot");
template <int NT, bool COMBINE> struct StepIn { float4 xa[2], xb[2]; u32x4 xr[2]; u32x4 y1[2], y2[2]; float4 g0, g1; };
template <int NT> struct StepW { bf16x8 wh[NT], wl[NT]; };
__device__ __forceinline__ void build_base(LAS int* base, const unsigned* cnt) {
    __syncthreads();
    if (tid_opaque() == 0) { int b = 0; for (int e = 0; e < NEXP; ++e) { base[e] = b; b += (((int)cnt[e] + 255) >> 8) << 8; } }
    __syncthreads();
}
template <int NT, bool COMBINE, bool XBF>
__device__ __forceinline__ void run(LAS unsigned char* lds, const Params& P, int l, const float* x, bf16_t* xq, const bf16_t* YB, const unsigned* inv, const unsigned* cntprev,
                                    const float* gn, const bf16_t* WH, const bf16_t* WL, bf16_t* XN, float* RS, float* gates, unsigned* cnt, int2* lists, unsigned* invout) {
    const int tid = tid_opaque(), lane = tid & 63, wid = __builtin_amdgcn_readfirstlane(tid >> 6), r = lane & 15, qd = lane >> 4;
    LAS int* BASE = (LAS int*)(lds + 64 * 1024);
    LAS float* LG = (LAS float*)lds + wid * (32 * 49);
    if (COMBINE) build_base(BASE, cntprev);
    LAS unsigned* LCNT = (LAS unsigned*)(lds + 64 * 1024 + 256); LAS unsigned* GBASE = LCNT + 32;
    for (int rb0 = blockIdx.x * 8; rb0 < NTOK / 32; rb0 += gridDim.x * 8) {
        const int rb = rb0 + wid; const bool live = rb < NTOK / 32;
        const int row0 = (live ? rb : rb0) * 32;
        if (NT == 1 && !live) continue;
        size_t yr1[2] = {0, 0}, yr2[2] = {0, 0};
        if (COMBINE) {
#pragma unroll
            for (int mt = 0; mt < 2; ++mt) { const int row = row0 + 16 * mt + r; const unsigned i1 = inv[2 * row], i2 = inv[2 * row + 1];
                yr1[mt] = (size_t)(BASE[i1 >> 16] + (int)(i1 & 0xffffu)) * D; yr2[mt] = (size_t)(BASE[i2 >> 16] + (int)(i2 & 0xffffu)) * D; } }
        f32x4 acc[2][NT];
#pragma unroll
        for (int mt = 0; mt < 2; ++mt)
#pragma unroll
            for (int nt = 0; nt < NT; ++nt) acc[mt][nt] = (f32x4){0.f, 0.f, 0.f, 0.f};
        float ssq[2] = {0.f, 0.f};
        StepIn<NT, COMBINE> sb[3]; StepW<NT> sw[2];
        auto load = [&](StepIn<NT, COMBINE>& s, int ks) {
            const int k0 = 32 * ks + 8 * qd;
#pragma unroll
            for (int mt = 0; mt < 2; ++mt) {
                if (XBF) s.xr[mt] = *(const u32x4*)(xq + (size_t)(row0 + 16 * mt + r) * D + k0);
                else { const float* xp = x + (size_t)(row0 + 16 * mt + r) * D + k0; s.xa[mt] = *(const float4*)xp; s.xb[mt] = *(const float4*)(xp + 4); }
                if (COMBINE) { s.y1[mt] = *(const u32x4*)(YB + yr1[mt] + k0); s.y2[mt] = *(const u32x4*)(YB + yr2[mt] + k0); } }
            s.g0 = *(const float4*)(gn + k0); s.g1 = *(const float4*)(gn + k0 + 4);
        };
        auto loadw = [&](StepW<NT>& s, int ks) {
            const int k0 = 32 * ks + 8 * qd;
#pragma unroll
            for (int nt = 0; nt < NT; ++nt) { s.wh[nt] = *(const bf16x8*)(WH + (size_t)(16 * nt + r) * D + k0); s.wl[nt] = *(const bf16x8*)(WL + (size_t)(16 * nt + r) * D + k0); }
        };
        auto process = [&](const StepIn<NT, COMBINE>& s, const StepW<NT>& sw_, int ks) {
            const int k0 = 32 * ks + 8 * qd;
            bf16x8 xh[2], xl[2];
#pragma unroll
            for (int mt = 0; mt < 2; ++mt) { float4 a = s.xa[mt], b = s.xb[mt];
                if (XBF) { const u32x4 w = s.xr[mt]; a = make_float4(bfl(w.x), bfh(w.x), bfl(w.y), bfh(w.y)); b = make_float4(bfl(w.z), bfh(w.z), bfl(w.w), bfh(w.w)); }
                if (COMBINE) { const u32x4 p = s.y1[mt], q = s.y2[mt];
                    a.x += bfl(p.x) + bfl(q.x); a.y += bfh(p.x) + bfh(q.x); a.z += bfl(p.y) + bfl(q.y); a.w += bfh(p.y) + bfh(q.y);
                    b.x += bfl(p.z) + bfl(q.z); b.y += bfh(p.z) + bfh(q.z); b.z += bfl(p.w) + bfl(q.w); b.w += bfh(p.w) + bfh(q.w);
                    u32x4 o; o.x = pg8::cvt_pk_bf16(a.x, a.y); o.y = pg8::cvt_pk_bf16(a.z, a.w); o.z = pg8::cvt_pk_bf16(b.x, b.y); o.w = pg8::cvt_pk_bf16(b.z, b.w);
                    *(u32x4*)(xq + (size_t)(row0 + 16 * mt + r) * D + k0) = o;
                    a = make_float4(bfl(o.x), bfh(o.x), bfl(o.y), bfh(o.y)); b = make_float4(bfl(o.z), bfh(o.z), bfl(o.w), bfh(o.w)); }
                ssq[mt] += a.x * a.x + a.y * a.y + a.z * a.z + a.w * a.w + b.x * b.x + b.y * b.y + b.z * b.z + b.w * b.w;
                const float v[8] = {a.x * s.g0.x, a.y * s.g0.y, a.z * s.g0.z, a.w * s.g0.w, b.x * s.g1.x, b.y * s.g1.y, b.z * s.g1.z, b.w * s.g1.w};
                u32x4 h; h.x = pg8::cvt_pk_bf16(v[0], v[1]); h.y = pg8::cvt_pk_bf16(v[2], v[3]); h.z = pg8::cvt_pk_bf16(v[4], v[5]); h.w = pg8::cvt_pk_bf16(v[6], v[7]);
                *(u32x4*)(XN + (size_t)(row0 + 16 * mt + r) * D + k0) = h;
                u32x4 lo; lo.x = pg8::cvt_pk_bf16(v[0] - bfl(h.x), v[1] - bfh(h.x)); lo.y = pg8::cvt_pk_bf16(v[2] - bfl(h.y), v[3] - bfh(h.y)); lo.z = pg8::cvt_pk_bf16(v[4] - bfl(h.z), v[5] - bfh(h.z)); lo.w = pg8::cvt_pk_bf16(v[6] - bfl(h.w), v[7] - bfh(h.w));
                xh[mt] = __builtin_bit_cast(bf16x8, h); xl[mt] = __builtin_bit_cast(bf16x8, lo); }
#pragma unroll
            for (int nt = 0; nt < NT; ++nt)
#pragma unroll
                for (int mt = 0; mt < 2; ++mt) { acc[mt][nt] = ml::mfma16(sw_.wh[nt], xh[mt], acc[mt][nt]); acc[mt][nt] = ml::mfma16(sw_.wl[nt], xh[mt], acc[mt][nt]); acc[mt][nt] = ml::mfma16(sw_.wh[nt], xl[mt], acc[mt][nt]); }
        };
        if (COMBINE || NT > 1) {
            load(sb[0], 0); loadw(sw[0], 0);
#pragma unroll 1
            for (int ks = 0; ks < 32; ks += 2) {
                load(sb[1], ks + 1); loadw(sw[1], ks + 1);
                process(sb[0], sw[0], ks);
                if (ks + 2 < 32) { load(sb[0], ks + 2); loadw(sw[0], ks + 2); }
                process(sb[1], sw[1], ks + 1);
            }
        } else {
            load(sb[0], 0); load(sb[1], 1); loadw(sw[0], 0);
#define RP_STEP(i, xs, ws) do { if ((i) + 2 < 32) load(sb[((xs) + 2) % 3], (i) + 2); if ((i) + 1 < 32) loadw(sw[((ws) + 1) % 2], (i) + 1); process(sb[xs], sw[ws], (i)); } while (0)
#pragma unroll 1
            for (int ks = 0; ks < 30; ks += 6) { RP_STEP(ks, 0, 0); RP_STEP(ks + 1, 1, 1); RP_STEP(ks + 2, 2, 0); RP_STEP(ks + 3, 0, 1); RP_STEP(ks + 4, 1, 0); RP_STEP(ks + 5, 2, 1); }
            RP_STEP(30, 0, 0); RP_STEP(31, 1, 1);
#undef RP_STEP
        }
        float rsv[2];
#pragma unroll
        for (int mt = 0; mt < 2; ++mt) { float s = ssq[mt]; s += __shfl_xor(s, 16); s += __shfl_xor(s, 32); rsv[mt] = rsqrtf(s * (1.f / D) + EPS);
            if (qd == 0) RS[row0 + 16 * mt + r] = rsv[mt]; }
        if (NT == 1) {
#pragma unroll
            for (int mt = 0; mt < 2; ++mt) if (qd < 2) { const f32x4 gv = acc[mt][0] * rsv[mt]; *(f32x4*)(gates + (size_t)(row0 + 16 * mt + r) * 8 + 4 * qd) = gv; }
        } else {
            const float* bg = P.in[I_RGB] + l * 4; const float* be = P.in[I_REB] + l * 32;
#pragma unroll
            for (int mt = 0; mt < 2; ++mt)
#pragma unroll
                for (int nt = 0; nt < NT; ++nt)
#pragma unroll
                    for (int j = 0; j < 4; ++j) LG[(16 * mt + r) * 49 + 16 * nt + 4 * qd + j] = acc[mt][nt][j] * rsv[mt];
            wave_lds_fence();
            if (tid < 32) LCNT[tid] = 0u;
            __syncthreads();
            int ex1 = 0, ex2 = 0; float w1 = 0.f, w2 = 0.f; unsigned lp1 = 0u, lp2 = 0u;
            if (lane < 32 && live) {
                const LAS float* lg = LG + lane * 49;
                float gl[4];
#pragma unroll
                for (int j = 0; j < 4; ++j) gl[j] = lg[j] + bg[j];
                int sel = 0; float gm = gl[0];
#pragma unroll
                for (int j = 1; j < 4; ++j) if (gl[j] > gm) { gm = gl[j]; sel = j; }
                float gs = 0.f;
#pragma unroll
                for (int j = 0; j < 4; ++j) gs += expf(gl[j] - gm);
                const float pg = 1.f / gs;
                float ein[8];
#pragma unroll
                for (int j = 0; j < 8; ++j) ein[j] = lg[4 + sel * 8 + j] + be[sel * 8 + j];
                int i1 = 0; float v1 = ein[0];
#pragma unroll
                for (int j = 1; j < 8; ++j) if (ein[j] > v1) { v1 = ein[j]; i1 = j; }
                int i2 = -1; float v2 = -3.0e38f;
#pragma unroll
                for (int j = 0; j < 8; ++j) if (j != i1 && ein[j] > v2) { v2 = ein[j]; i2 = j; }
                const float e2 = expf(v2 - v1), den = 1.f / (1.f + e2);
                w1 = den * pg; w2 = e2 * den * pg;
                ex1 = sel * 8 + i1; ex2 = sel * 8 + i2;
                lp1 = atomicAdd((unsigned*)&LCNT[ex1], 1u); lp2 = atomicAdd((unsigned*)&LCNT[ex2], 1u);
            }
            __syncthreads();
            if (tid < 32) { const unsigned c = LCNT[tid]; GBASE[tid] = c ? atomicAdd(&cnt[tid], c) : 0u; }
            __syncthreads();
            if (lane < 32 && live) { const int row = row0 + lane; const unsigned p1 = GBASE[ex1] + lp1, p2 = GBASE[ex2] + lp2;
                lists[(size_t)ex1 * NTOK + p1] = make_int2(row, __float_as_int(w1));
                lists[(size_t)ex2 * NTOK + p2] = make_int2(row, __float_as_int(w2));
                invout[2 * row] = ((unsigned)ex1 << 16) | p1; invout[2 * row + 1] = ((unsigned)ex2 << 16) | p2; }
        }
    }
}
__device__ __forceinline__ void final_norm(LAS unsigned char* lds, const bf16_t* xb, float* out, const bf16_t* YB, const unsigned* inv, const unsigned* cntprev, const float* g) {
    const int tid = tid_opaque(), wave = tid >> 6, lane = tid & 63;
    LAS int* BASE = (LAS int*)(lds + 64 * 1024);
    build_base(BASE, cntprev);
    const float4* g4 = (const float4*)g;
    for (int r = blockIdx.x * 8 + wave; r < NTOK; r += gridDim.x * 8) {
        const unsigned i1 = inv[2 * r], i2 = inv[2 * r + 1];
        const bf16_t* y1 = YB + (size_t)(BASE[i1 >> 16] + (int)(i1 & 0xffffu)) * D; const bf16_t* y2 = YB + (size_t)(BASE[i2 >> 16] + (int)(i2 & 0xffffu)) * D;
        const u32x2_t* xp = (const u32x2_t*)(xb + (size_t)r * D);
        float4 v[4]; float ss = 0.f;
#pragma unroll
        for (int i = 0; i < 4; ++i) { const u32x2_t xw = xp[lane + 64 * i], a = *((const u32x2_t*)y1 + lane + 64 * i), b = *((const u32x2_t*)y2 + lane + 64 * i);
            v[i].x = bfl(xw.x) + bfl(a.x) + bfl(b.x); v[i].y = bfh(xw.x) + bfh(a.x) + bfh(b.x); v[i].z = bfl(xw.y) + bfl(a.y) + bfl(b.y); v[i].w = bfh(xw.y) + bfh(a.y) + bfh(b.y);
            ss += v[i].x * v[i].x + v[i].y * v[i].y + v[i].z * v[i].z + v[i].w * v[i].w; }
        ss = wave_sum(ss);
        const float rs = rsqrtf(ss * (1.f / D) + EPS);
        float4* p = (float4*)(out + (size_t)r * D);
#pragma unroll
        for (int i = 0; i < 4; ++i) { const float4 gg = g4[lane + 64 * i]; float4 o; o.x = v[i].x * rs * gg.x; o.y = v[i].y * rs * gg.y; o.z = v[i].z * rs * gg.z; o.w = v[i].w * rs * gg.w; p[lane + 64 * i] = o; }
    }
}
}

__device__ __forceinline__ int moe_build_tab(LAS unsigned char* ldsb, const unsigned* cnt) {
    LAS pg8::i32x4* tab = (LAS pg8::i32x4*)(ldsb + TAB_OFF);
    __syncthreads();
    int base = 0;
#pragma unroll 1
    for (int e = 0; e < NEXP; ++e) { const int c = __builtin_amdgcn_readfirstlane((int)cnt[e]), nt = (c + 255) >> 8;
        if ((int)tid_opaque() < nt) tab[base + tid_opaque()] = (pg8::i32x4){e, (int)tid_opaque() * 256, c, 0};
        base += nt; }
    __syncthreads();
    return base;
}
__device__ __forceinline__ void ph_moe1(LAS unsigned char* ldsb, const Params& P, int l, const bf16_t* H, const unsigned* cnt, const int2* lists, bf16_t* act) {
    const int ntiles = moe_build_tab(ldsb, cnt);
    pg8::MoeOrder S; S.tab = (const LAS pg8::i32x4*)(ldsb + TAB_OFF); S.ntiles = ntiles; S.npn = 4; S.G = gridDim.x; S.c = blockIdx.x;
    S.A = (const char*)H; S.atile = 0; S.Bt = (const char*)(P.ws + WS_WGU) + (size_t)l * NEXP * 1024 * D * 2; S.bexp = (size_t)1024 * D * 2; S.btile = (size_t)256 * D * 2; S.lists = lists;
    pg8::EpiAct E{act, lists, (const float*)(P.ws + WS_RS)};
    pg8::gemm_phase<pg8::EpiAct, pg8::MoeOrder, true>(ldsb, D, D, S, E);
}
__device__ __forceinline__ void ph_moe2(LAS unsigned char* ldsb, const Params& P, int l, const bf16_t* act, const unsigned* cnt, const int2* lists, bf16_t* yb) {
    const int ntiles = moe_build_tab(ldsb, cnt);
    pg8::MoeOrder S; S.tab = (const LAS pg8::i32x4*)(ldsb + TAB_OFF); S.ntiles = ntiles; S.npn = 4; S.G = gridDim.x; S.c = blockIdx.x;
    S.A = (const char*)act; S.atile = (size_t)256 * DE * 2; S.Bt = (const char*)(P.ws + WS_WD) + (size_t)l * NEXP * D * DE * 2; S.bexp = (size_t)D * DE * 2; S.btile = (size_t)256 * DE * 2; S.lists = lists;
    pg8::EpiY E{yb, lists};
    pg8::gemm_phase<pg8::EpiY, pg8::MoeOrder, false>(ldsb, DE, DE, S, E);
}

#ifndef PROBE_PH
#define PROBE_PH -1
#endif
#ifndef PROBE_SUB
#define PROBE_SUB 15
#endif
#ifndef PROBE_REPS
#define PROBE_REPS 4
#endif
__global__ void __launch_bounds__(NTHREADS, 2) fwd_kernel(Params P) {
    extern __shared__ __attribute__((aligned(16))) unsigned char lds_raw[];
    float* lds = (float*)lds_raw;
    volatile LAS unsigned* xbw = (volatile LAS unsigned*)(lds_raw + LDS_BYTES - 16);
    if (threadIdx.x == 0) { xbw[0] = 0u; xbw[1] = 0u; }
    __syncthreads();
    unsigned char* const ws = P.ws;
    unsigned* ctl = (unsigned*)(ws + WS_CTL);
    const bool multi = (P.ph_hi - P.ph_lo) > 1;
    XcdBarrier bar; bar.bar = ctl; bar.x = 0; bar.st = xbw;
    if (multi) bar = xcd_barrier_post(ctl, xbw);
    bf16_t* z = (bf16_t*)(ws + WS_Z); float* gates = (float*)(ws + WS_GATES); unsigned char* wss = ws + WS_S5; bf16_t* mix = (bf16_t*)(ws + WS_MIX); unsigned char* wsm = ws + WS_HRAW;
    bf16_t* H = (bf16_t*)(ws + WS_H); bf16_t* act = (bf16_t*)(ws + WS_ACT); bf16_t* yb = (bf16_t*)(ws + WS_YB); bf16_t* xbuf = (bf16_t*)(ws + WS_XB); float* rsb = (float*)(ws + WS_RS);
    int2* lists = (int2*)(ws + WS_LIST);
    LAS unsigned char* ldsb = (LAS unsigned char*)lds_raw;
    const int lo = P.ph_lo, hi = P.ph_hi;
#define IN(k) (lo <= (k) && (k) < hi)
#define SEAM(k) do { if (IN(k) && IN((k) + 1)) xcd_barrier(bar); } while (0)
#if PROBE_PH >= 0
#define RUNPH(k, ...) do { if (IN(k)) { const int nrep = ((k) == PROBE_PH) ? 1 + PROBE_REPS : 1; for (int rep = 0; rep < nrep; ++rep) { __VA_ARGS__; if (rep + 1 < nrep) xcd_barrier(bar); } } SEAM(k); } while (0)
#else
#define RUNPH(k, ...) do { if (IN(k)) { constexpr int rep = 0; (void)rep; __VA_ARGS__; } SEAM(k); } while (0)
#endif
    RUNPH(0, ph_prologue(lds, PF));
    for (int l = 0; l < NLAYER; ++l) {
        const int pb = 1 + l * PH_PER_LAYER;
        unsigned* cnt = ctl + CW_CNT + l * 64;
        const unsigned char* tb = ws + WS_TB + (size_t)l * 4 * MiB;
        const unsigned char* rtb = ws + WS_RT + (size_t)l * 256 * 1024;
        unsigned* inv = (unsigned*)(ws + WS_INV) + (size_t)l * NTOK * 2;
        RUNPH(pb + 0, { const Params& Q = PF;
            if (l == 0) rp::run<1, false, false>(ldsb, Q, l, Q.in[I_X], nullptr, nullptr, nullptr, nullptr, Q.in[I_NMG] + l * D, (const bf16_t*)(rtb + rp::T_GHI), (const bf16_t*)(rtb + rp::T_GLO), mix, rsb, gates, nullptr, nullptr, nullptr);
            else        rp::run<1, true, true>(ldsb, Q, l, nullptr, xbuf, yb, inv - (size_t)NTOK * 2, cnt - 64, Q.in[I_NMG] + l * D, (const bf16_t*)(rtb + rp::T_GHI), (const bf16_t*)(rtb + rp::T_GLO), mix, rsb, gates, nullptr, nullptr, nullptr); });
        RUNPH(pb + 1, ph_inproj(ldsb, mix, (const bf16_t*)(ws + WS_WIN) + (size_t)l * NMAIN * D, z, rsb, (rep > 0 && PROBE_SUB <= 3) ? PROBE_SUB : 0));
        RUNPH(pb + 2, ph_mix1(lds, PF, l, z, gates, mix, wsm, wss, tb, rep == 0 ? 15 : PROBE_SUB));
        RUNPH(pb + 3, { s5::p2_scan(ldsb, tb, wss); ml::p2_scan(wsm); });
        RUNPH(pb + 4, ph_mix2(lds, PF, l, z, gates, mix, wsm, wss, tb, rep == 0 ? 15 : PROBE_SUB));
        RUNPH(pb + 5, { const Params& Q = PF; if (l == 0) ph_outproj<true>(ldsb, mix, (const bf16_t*)(ws + WS_WOUT) + (size_t)l * D * D, Q.in[I_X], xbuf); else ph_outproj<false>(ldsb, mix, (const bf16_t*)(ws + WS_WOUT) + (size_t)l * D * D, nullptr, xbuf); });
        RUNPH(pb + 6, { if (rep > 0) { if (blockIdx.x == 0 && threadIdx.x < 64) cnt[threadIdx.x] = 0u; xcd_barrier(bar); }
                        const Params& Q = PF; rp::run<3, false, true>(ldsb, Q, l, nullptr, xbuf, nullptr, nullptr, nullptr, Q.in[I_NFG] + l * D, (const bf16_t*)(rtb + rp::T_HI), (const bf16_t*)(rtb + rp::T_LO), H, rsb, nullptr, cnt, lists, inv); });
        RUNPH(pb + 7, ph_moe1(ldsb, PF, l, H, cnt, lists, act));
        RUNPH(pb + 8, ph_moe2(ldsb, PF, l, act, cnt, lists, yb));
    }
    RUNPH(1 + NLAYER * PH_PER_LAYER, { const Params& Q = PF; rp::final_norm(ldsb, xbuf, Q.out, yb, (const unsigned*)(ws + WS_INV) + (size_t)(NLAYER - 1) * NTOK * 2, ctl + CW_CNT + (NLAYER - 1) * 64, Q.in[I_NFIN]); });
#undef RUNPH
#undef IN
#undef SEAM
}

#ifndef N_LAUNCH_MODE
#define N_LAUNCH_MODE 1
#endif
extern "C" void kernel_launch(void* const* d_in, const int* in_sizes, int n_in, void* d_out, int out_size, void* d_ws, size_t ws_size, hipStream_t stream) {
    static int grid = 0;
    if (grid == 0) {
        if (n_in != 31 || out_size != NTOK * D || ws_size < WS_END) { fprintf(stderr, "kernel_launch: unexpected shapes n_in %d out %d ws %zu (need %zu)\n", n_in, out_size, ws_size, (size_t)WS_END); grid = -1; return; }
        int dev = 0, cus = 0, per_cu = 0;
        if (hipGetDevice(&dev) != hipSuccess || hipDeviceGetAttribute(&cus, hipDeviceAttributeMultiprocessorCount, dev) != hipSuccess) { grid = -1; return; }
        if (hipFuncSetAttribute((const void*)fwd_kernel, hipFuncAttributeMaxDynamicSharedMemorySize, LDS_BYTES) != hipSuccess) { fprintf(stderr, "kernel_launch: hipFuncSetAttribute failed\n"); grid = -1; return; }
        if (hipOccupancyMaxActiveBlocksPerMultiprocessor(&per_cu, (const void*)fwd_kernel, NTHREADS, LDS_BYTES) != hipSuccess || per_cu < 1) { fprintf(stderr, "kernel_launch: occupancy query says %d\n", per_cu); }
        (void)hipGetLastError();
        grid = cus;
    }
    if (grid < 0) return;
    (void)hipMemsetAsync((char*)d_ws + WS_CTL, 0, CTL_BYTES, stream);
    Params p{};
    for (int i = 0; i < 31; ++i) p.in[i] = (const float*)d_in[i];
    p.out = (float*)d_out; p.ws = (unsigned char*)d_ws;
#if N_LAUNCH_MODE == 1
    p.ph_lo = 0; p.ph_hi = N_PHASES;
    hipLaunchKernelGGL(fwd_kernel, dim3(grid), dim3(NTHREADS), LDS_BYTES, stream, p);
#else
    for (int ph = 0; ph < N_PHASES; ++ph) { p.ph_lo = ph; p.ph_hi = ph + 1; hipLaunchKernelGGL(fwd_kernel, dim3(grid), dim3(NTHREADS), LDS_BYTES, stream, p); }
#endif
}
```

```cpp
#include <hip/hip_runtime.h>
#include <stdint.h>
#include <stdio.h>

#define LAS __attribute__((address_space(3)))

constexpr int D = 1024, NB = 8, S = 8192, NTOK = NB * S, INW = 2312, NLAYER = 2;
constexpr int NEXP = 32, DE = 512;
constexpr float EPS = 1e-6f;
constexpr int ZW = 2304;
constexpr int ZQ = 0, ZK = 256, ZV = 384, ZSU = 512, ZCQ = 768, ZCK = 1024, ZCV = 1280, ZCO = 1536, ZGU = 1792, ZGV = 2048, WCI = 1536;
#ifndef INPROJ_WGM
#define INPROJ_WGM 8
#endif
constexpr int NTHREADS = 512;
constexpr int LDS_BYTES = 144 * 1024;
constexpr int TAB_OFF = 128 * 1024;
constexpr int PH_PER_LAYER = 9, N_PHASES = 1 + NLAYER * PH_PER_LAYER + 1;
constexpr int NMAIN = 2304;
typedef unsigned short bf16_t;

constexpr size_t MiB = 1u << 20;
constexpr size_t WS_CTL = 0, CTL_BYTES = 1 * MiB;
constexpr size_t WS_Z = WS_CTL + CTL_BYTES;
constexpr size_t Z_BYTES = (size_t)NTOK * ZW * 2;
constexpr size_t WS_H = WS_Z;
constexpr size_t WS_YB = WS_Z;
constexpr int PMAX = 2 * NTOK + NEXP * 256;
static_assert((size_t)PMAX * D * 2 <= Z_BYTES, "YB alias fits");
constexpr size_t WS_MIX = WS_Z + Z_BYTES;
constexpr size_t WS_ACT = WS_MIX;
static_assert((size_t)PMAX * DE * 2 <= (size_t)NTOK * D * 2 + 64 * MiB, "ACT alias fits");
constexpr size_t WS_HRAW = WS_MIX + (size_t)NTOK * D * 2;
constexpr size_t WS_S5 = WS_HRAW + 64 * MiB;
constexpr size_t WS_GATES = WS_S5 + 48 * MiB;
constexpr size_t WS_LIST = WS_GATES + (size_t)NTOK * 8 * 4;
constexpr size_t WS_WIN = WS_LIST + (size_t)NEXP * NTOK * 8;
constexpr size_t WS_WOUT = WS_WIN + (size_t)NLAYER * NMAIN * D * 2;
constexpr size_t WS_WGU = WS_WOUT + (size_t)NLAYER * D * D * 2;
constexpr size_t WS_WD = WS_WGU + (size_t)NLAYER * NEXP * 1024 * D * 2;
constexpr size_t WS_TB = WS_WD + (size_t)NLAYER * NEXP * D * DE * 2;
constexpr size_t WS_RS = WS_TB + (size_t)NLAYER * 4 * MiB;
constexpr size_t WS_RT = WS_RS + (size_t)NTOK * 4;
constexpr size_t WS_INV = WS_RT + (size_t)NLAYER * 256 * 1024;
constexpr size_t WS_XB = WS_INV + (size_t)NLAYER * NTOK * 8;
constexpr size_t WS_END = WS_XB + (size_t)NTOK * D * 2;
namespace s5 {
constexpr size_t T_KMAT = 0, T_F = T_KMAT + (size_t)16 * 32 * 256 * 2, T_G = T_F + (size_t)16 * 256 * 128 * 2, T_A16 = T_G + (size_t)16 * 128 * 256 * 2,
                 T_GLUW = T_A16 + (size_t)16 * 64 * 8, T_SGUW = T_GLUW + (size_t)256 * 256 * 2, T_LAYER = T_SGUW + (size_t)4 * 128 * 128 * 2;
}
constexpr int CW_Q = 4096;
constexpr int CW_CNT = 8192;

#define XB_TMO      128
#define XB_XCNT(j)  (256  + 64 * (j))
#define XB_XSUB(j)  (1280 + 64 * (j))
#define XB_XGEN(j)  (2304 + 64 * (j))
#define XB_TOP      3328
#define XB_TOPGEN   3392
#define XCD_BAR_WORDS 3456
#define XB_SPIN_CAP (1u << 22)
__device__ __forceinline__ unsigned xb_ld(unsigned* p)              { return __hip_atomic_load(p, __ATOMIC_RELAXED, __HIP_MEMORY_SCOPE_AGENT); }
__device__ __forceinline__ unsigned xb_add(unsigned* p, unsigned v) { return __hip_atomic_fetch_add(p, v, __ATOMIC_RELAXED, __HIP_MEMORY_SCOPE_AGENT); }
__device__ __forceinline__ unsigned xb_xcc_id() { return (unsigned)__builtin_amdgcn_s_getreg((3 << 11) | 20) & 0xFu; }
#define XB_SPIN(cond, bar) do { unsigned _sp = 0; while (cond) { __builtin_amdgcn_s_sleep(1); \
    if ((++_sp & 255u) == 0u) { if (xb_ld(&(bar)[XB_TMO])) break; if (_sp > XB_SPIN_CAP) { atomicAdd(&(bar)[XB_TMO], 1u); break; } } } } while (0)
struct XcdBarrier { unsigned* bar; unsigned x; volatile LAS unsigned* st; };
__device__ __forceinline__ XcdBarrier xcd_barrier_post(unsigned* bar, volatile LAS unsigned* st) {
    XcdBarrier b; b.bar = bar; b.x = xb_xcc_id(); b.st = st;
    if (threadIdx.x == 0) (void)xb_add(&bar[XB_XCNT(b.x)], 1u);
    return b;
}
__device__ __forceinline__ void xcd_barrier_complete(unsigned* bar, unsigned x, unsigned& nloc, unsigned& nx) {
    const unsigned G = gridDim.x * gridDim.y * gridDim.z;
    unsigned sum, cnt, mine, sp = 0u;
    for (;;) {
        sum = 0u; cnt = 0u; mine = 0u;
#pragma unroll
        for (unsigned j = 0; j < 16; ++j) { const unsigned c = xb_ld(&bar[XB_XCNT(j)]); sum += c; cnt += (c > 0u) ? 1u : 0u; mine = (j == x) ? c : mine; }
        if (sum == G) break;
        __builtin_amdgcn_s_sleep(1);
        if ((++sp & 255u) == 0u) { if (xb_ld(&bar[XB_TMO])) break; if (sp > XB_SPIN_CAP) { atomicAdd(&bar[XB_TMO], 1u); break; } }
    }
    nloc = mine > 0u ? mine : 1u; nx = cnt > 0u ? cnt : 1u;
}
__device__ __forceinline__ void xcd_barrier(const XcdBarrier& b) {
    asm volatile("s_waitcnt vmcnt(0)" ::: "memory");
    __syncthreads();
    if (threadIdx.x == 0) {
        unsigned* bar = b.bar;
        __builtin_amdgcn_s_waitcnt(0);
        unsigned nloc = b.st[0], nx = b.st[1];
        if (nloc == 0u) { xcd_barrier_complete(bar, b.x, nloc, nx); b.st[0] = nloc; b.st[1] = nx; }
        const unsigned old = xb_add(&bar[XB_XSUB(b.x)], 1u);
        const unsigned gen = old / nloc;
        if (old + 1u == (gen + 1u) * nloc) {
            __builtin_amdgcn_fence(__ATOMIC_RELEASE, "agent");
            asm volatile("s_waitcnt vmcnt(0)" ::: "memory");
            const unsigned og = xb_add(&bar[XB_TOP], 1u);
            const unsigned tg = og / nx;
            if (og + 1u == (tg + 1u) * nx) xb_add(&bar[XB_TOPGEN], 1u);
            else XB_SPIN(xb_ld(&bar[XB_TOPGEN]) == tg, bar);
            __builtin_amdgcn_fence(__ATOMIC_ACQUIRE, "agent");
            xb_add(&bar[XB_XGEN(b.x)], 1u);
            asm volatile("s_waitcnt vmcnt(0)" ::: "memory");
        } else {
            XB_SPIN(xb_ld(&bar[XB_XGEN(b.x)]) == gen, bar);
            __builtin_amdgcn_fence(__ATOMIC_ACQUIRE, "agent");
            asm volatile("s_waitcnt vmcnt(0)" ::: "memory");
        }
    }
    __syncthreads();
}

__device__ __forceinline__ int tid_opaque() { int t = threadIdx.x; asm volatile("" : "+v"(t)); return t; }
__device__ __forceinline__ float wave_sum(float v) {
#pragma unroll
    for (int o = 32; o > 0; o >>= 1) v += __shfl_xor(v, o);
    return v;
}
__device__ __forceinline__ float gelu_tanh(float x) {
    const float u2 = 1.5957691216057308f * (x + 0.044715f * x * x * x);
    return x * __builtin_amdgcn_rcpf(1.f + __expf(-u2));
}
__device__ __forceinline__ float sigm(float x) { return 1.f / (1.f + expf(-x)); }
__device__ __forceinline__ float rsig(float x) { return __builtin_amdgcn_rcpf(1.f + __expf(-x)); }
__device__ __forceinline__ float bfl(unsigned w) { return __uint_as_float(w << 16); }
__device__ __forceinline__ float bfh(unsigned w) { return __uint_as_float(w & 0xffff0000u); }
typedef unsigned u32x4_t __attribute__((ext_vector_type(4)));
typedef unsigned u32x2_t __attribute__((ext_vector_type(2)));
__device__ __forceinline__ void ld8(const bf16_t* p, float (&o)[8]) { const u32x4_t w = *(const u32x4_t*)p; o[0] = bfl(w.x); o[1] = bfh(w.x); o[2] = bfl(w.y); o[3] = bfh(w.y); o[4] = bfl(w.z); o[5] = bfh(w.z); o[6] = bfl(w.w); o[7] = bfh(w.w); }
typedef short s16x4_t __attribute__((ext_vector_type(4)));
__device__ __forceinline__ u32x2_t lds_tr4(const LAS unsigned char* p) { const s16x4_t v = __builtin_amdgcn_ds_read_tr16_b64_v4i16((LAS s16x4_t*)p); return __builtin_bit_cast(u32x2_t, v); }
__device__ __forceinline__ void wave_lds_fence() {
    __builtin_amdgcn_fence(__ATOMIC_RELEASE, "wavefront"); __builtin_amdgcn_wave_barrier(); __builtin_amdgcn_fence(__ATOMIC_ACQUIRE, "wavefront");
}

struct Params {
    const float* in[31];
    float* out;
    unsigned char* ws;
    int ph_lo, ph_hi;
};
struct Params;
__device__ __forceinline__ const Params* params_fresh() { auto p = __builtin_amdgcn_kernarg_segment_ptr(); asm volatile("" : "+s"(p)); return (const Params*)p; }
#define PF (*params_fresh())
enum { I_X = 0, I_NMG, I_WIN, I_SINK, I_ARE, I_AIM, I_BRE, I_BIM, I_CRE, I_CIM, I_SD, I_LDT, I_GLUW, I_GLUB, I_CONVW, I_GATEB, I_MNG,
       I_LNG, I_LNB, I_SGUW, I_SGUB, I_WOUT, I_NFG, I_RGW, I_RGB, I_REW, I_REB, I_EWG, I_EWU, I_EWD, I_NFIN };

namespace pg8 {
#define PG8_LAS __attribute__((address_space(3)))
typedef short bf16x8 __attribute__((ext_vector_type(8)));
typedef float f32x4 __attribute__((ext_vector_type(4)));
typedef unsigned u32x4 __attribute__((ext_vector_type(4)));
typedef unsigned u32x2 __attribute__((ext_vector_type(2)));
typedef int i32x4 __attribute__((ext_vector_type(4)));
constexpr int BM = 256, BK = 64, HALF = 128, HTB = HALF * BK * 2, STAGE_BYTES = 8 * HTB, NXCD = 8, WGM = 8;
__host__ __device__ __forceinline__ int lds_byte(int r, int c) { const int st = (r >> 4) * 2 + (c >> 5), rr = r & 15, cc = c & 31, ob = rr * 64 + cc * 2; return st * 1024 + (ob ^ (((ob >> 9) & 1) << 5)); }
__host__ __device__ __forceinline__ void stage_rc(int b, int& R, int& C) { const int st = b / 1024, sb = b % 1024, swz = sb ^ (((sb >> 9) & 1) << 5); R = (st >> 1) * 16 + swz / 64; C = (st & 1) * 32 + (swz % 64) / 2; }
__host__ __device__ __forceinline__ int perm32(int rho) { const int n = rho >> 4, i = rho & 15; return 8 * (i >> 2) + 4 * n + (i & 3); }
__device__ __forceinline__ unsigned cvt_pk_bf16(float lo, float hi) { unsigned r; asm volatile("v_cvt_pk_bf16_f32 %0, %1, %2" : "=v"(r) : "v"(lo), "v"(hi)); return r; }

struct Unit { int pm, pn; const char* A; const char* B; int e, pos0, cnt; };

struct StaticOrder {
    int nM, nN, nwg, G, c, wgm, pmmask = -1; const char* A; const char* Bt; size_t atile, btile;
    __device__ void init(int M, int N, int K, int lda, int G_, int c_, const void* A_, const void* Bt_, int wgm_ = WGM) { wgm = wgm_; nM = M / BM; nN = N / BM; nwg = nM * nN; G = G_; c = c_; A = (const char*)A_; Bt = (const char*)Bt_; atile = (size_t)BM * lda * 2; btile = (size_t)BM * K * 2; }
    __device__ __forceinline__ bool next(int i, Unit& u) const {
        const long L = (long)i * G + c; if (L >= nwg) return false;
        int wgid = (int)L; { const int q = nwg / NXCD, r = nwg % NXCD, xcd = wgid % NXCD, off = wgid / NXCD; wgid = (xcd < r ? xcd * (q + 1) : r * (q + 1) + (xcd - r) * q) + off; }
        const int nig = wgm * nN, gid = wgid / nig, fm = gid * wgm, gsz = (nM - fm) < wgm ? (nM - fm) : wgm;
        u.pm = fm + ((wgid % nig) % gsz); u.pn = (wgid % nig) / gsz; u.A = A + (size_t)(u.pm & pmmask) * atile; u.B = Bt + (size_t)u.pn * btile; u.e = 0; u.pos0 = 0; u.cnt = 0; return true;
    }
    __device__ __forceinline__ void aoff(const Unit&, unsigned (&)[2], unsigned (&)[2], const int (&)[2], const int (&)[2]) const {}
};

template <class Epi, class Sched, bool GATHER>
__device__ __forceinline__ void gemm_phase(PG8_LAS unsigned char* lds, const int K, const int lda, const Sched& S, const Epi& E) {
    const int tid = tid_opaque(), wid = __builtin_amdgcn_readfirstlane(tid >> 6), lane = tid & 63, wr = wid >> 2, wc = wid & 3, fr = lane & 15, fq = lane >> 4;
    const int nt = K / BK;
    unsigned vA0[2], vA1[2], vB[2], nA0[2], nA1[2]; int Rs[2], Cs[2];
#pragma unroll
    for (int i = 0; i < 2; ++i) { int R, C; stage_rc(tid * 16 + i * 8192, R, C); const int Rb = Epi::PERM ? ((R & ~31) + perm32(R & 31)) : R;
        Rs[i] = R; Cs[i] = C; vA0[i] = (unsigned)(R * lda + C) * 2u; vA1[i] = vA0[i] + (unsigned)(HALF * lda) * 2u; vB[i] = (unsigned)(Rb * K + C) * 2u; nA0[i] = vA0[i]; nA1[i] = vA1[i]; }
    const size_t kstep = (size_t)(BK * 2);
    const size_t hstep = (size_t)HALF * K * 2;
    const unsigned ldsw = (unsigned)wid * 1024u;
    const int aoff = lds_byte(wr * 64 + fr, fq * 8), boff = lds_byte(wc * 32 + fr, fq * 8);
#define PG8_SA(b, h) (((b) * 2 + (h)) * HTB)
#define PG8_SB(b, h) ((4 + (b) * 2 + (h)) * HTB)
#define PG8_STAGE(bufoff, gbase, voff) do { _Pragma("unroll") for (int _i = 0; _i < 2; ++_i) \
        __builtin_amdgcn_global_load_lds((const unsigned*)((const char*)(gbase) + (voff)[_i]), (PG8_LAS unsigned*)(lds + (bufoff) + ldsw + _i * 8192), 16, 0, 0); } while (0)
#define PG8_LDA(dst, b, h) do { _Pragma("unroll") for (int m = 0; m < 4; ++m) _Pragma("unroll") for (int k = 0; k < 2; ++k) dst[m][k] = *(const PG8_LAS bf16x8*)(lds + PG8_SA(b, h) + aoff + m * 2048 + k * 1024); } while (0)
#define PG8_LDB(dst, b, h) do { _Pragma("unroll") for (int n = 0; n < 2; ++n) _Pragma("unroll") for (int k = 0; k < 2; ++k) dst[n][k] = *(const PG8_LAS bf16x8*)(lds + PG8_SB(b, h) + boff + n * 2048 + k * 1024); } while (0)
#define PG8_MMA(ai, bj, At, Bt) do { __builtin_amdgcn_s_setprio(1); _Pragma("unroll") for (int m = 0; m < 4; ++m) _Pragma("unroll") for (int n = 0; n < 2; ++n) _Pragma("unroll") for (int k = 0; k < 2; ++k) \
        acc[ai][bj][m][n] = __builtin_amdgcn_mfma_f32_16x16x32_bf16(Bt[n][k], At[m][k], acc[ai][bj][m][n], 0, 0, 0); __builtin_amdgcn_s_setprio(0); } while (0)
#define PG8_WAIT_V(n) asm volatile("s_waitcnt vmcnt(" #n ")" ::: "memory")
#define PG8_WAIT_L(n) asm volatile("s_waitcnt lgkmcnt(" #n ")" ::: "memory")
#define PG8_BAR __builtin_amdgcn_s_barrier()
#define PG8_SCHED __builtin_amdgcn_sched_barrier(0)
    Unit cur, nxt; int ui = 0;
    if (!S.next(0, cur)) return;
    if constexpr (GATHER) { S.aoff(cur, vA0, vA1, Rs, Cs); PG8_WAIT_V(0); }
    f32x4 acc[2][2][4][2];
#pragma unroll
    for (int a = 0; a < 2; ++a)
#pragma unroll
        for (int b = 0; b < 2; ++b)
#pragma unroll
            for (int m = 0; m < 4; ++m)
#pragma unroll
                for (int n = 0; n < 2; ++n) acc[a][b][m][n] = (f32x4){0.f, 0.f, 0.f, 0.f};
    bf16x8 At[4][2], B0[2][2], B1[2][2];
    const char* cA = cur.A; const char* cB = cur.B;
    PG8_STAGE(PG8_SB(0, 0), cB, vB); PG8_STAGE(PG8_SB(0, 1), cB + hstep, vB); PG8_STAGE(PG8_SA(0, 0), cA, vA0); PG8_STAGE(PG8_SA(0, 1), cA, vA1);
    if (wr == 1) PG8_BAR;
    PG8_WAIT_V(2); PG8_BAR;
    PG8_STAGE(PG8_SB(1, 0), cB + kstep, vB); PG8_STAGE(PG8_SA(1, 0), cA + kstep, vA0); PG8_STAGE(PG8_SB(1, 1), cB + hstep + kstep, vB);
    PG8_WAIT_V(6); PG8_BAR;
    for (;;) {
        const bool has_next = S.next(ui + 1, nxt);
        const char* nA = has_next ? nxt.A : cA; const char* nB = has_next ? nxt.B : cB;
        if constexpr (GATHER) {
            if (has_next) { S.aoff(nxt, nA0, nA1, Rs, Cs); }
            else {
#pragma unroll
                for (int i = 0; i < 2; ++i) { nA0[i] = vA0[i]; nA1[i] = vA1[i]; } }
        }
        for (int t = 0; t < nt; t += 2) {
            const bool last = (t == nt - 2);
            const char* a1 = cA + (size_t)(t + 1) * kstep;
            const char* a2 = last ? nA : cA + (size_t)(t + 2) * kstep; const char* b2 = last ? nB : cB + (size_t)(t + 2) * kstep;
            const char* a3 = a2 + kstep; const char* b3 = b2 + kstep;
            unsigned x0[2], x1[2];
#pragma unroll
            for (int i = 0; i < 2; ++i) { x0[i] = (GATHER && last) ? nA0[i] : vA0[i]; x1[i] = (GATHER && last) ? nA1[i] : vA1[i]; }
            PG8_LDB(B0, 0, 0); PG8_LDB(B1, 0, 1); PG8_SCHED; PG8_LDA(At, 0, 0); PG8_STAGE(PG8_SA(1, 1), a1, vA1);
            PG8_WAIT_V(8); PG8_WAIT_L(0); PG8_BAR; PG8_MMA(0, 0, At, B0); PG8_MMA(0, 1, At, B1); PG8_BAR; PG8_SCHED;
            PG8_LDA(At, 0, 1); PG8_STAGE(PG8_SB(0, 0), b2, vB); PG8_STAGE(PG8_SB(0, 1), b2 + hstep, vB); PG8_STAGE(PG8_SA(0, 0), a2, x0);
            PG8_WAIT_V(8); PG8_WAIT_L(0); PG8_BAR; PG8_MMA(1, 0, At, B0); PG8_MMA(1, 1, At, B1); PG8_BAR; PG8_SCHED;
            PG8_LDB(B0, 1, 0); PG8_LDB(B1, 1, 1); PG8_SCHED; PG8_LDA(At, 1, 0); PG8_STAGE(PG8_SA(0, 1), a2, x1);
            PG8_WAIT_V(8); PG8_WAIT_L(0); PG8_BAR; PG8_MMA(0, 0, At, B0); PG8_MMA(0, 1, At, B1); PG8_BAR; PG8_SCHED;
            PG8_LDA(At, 1, 1); PG8_STAGE(PG8_SB(1, 0), b3, vB); PG8_STAGE(PG8_SB(1, 1), b3 + hstep, vB); PG8_STAGE(PG8_SA(1, 0), a3, x0);
            PG8_WAIT_V(8); PG8_WAIT_L(0); PG8_BAR; PG8_MMA(1, 0, At, B0); PG8_MMA(1, 1, At, B1); PG8_BAR; PG8_SCHED;
        }
        if (wr == 0) PG8_BAR;
        E(acc, cur, wr, wc, fr, fq);
        if (!has_next) break;
#pragma unroll
        for (int a = 0; a < 2; ++a)
#pragma unroll
            for (int b = 0; b < 2; ++b)
#pragma unroll
                for (int m = 0; m < 4; ++m)
#pragma unroll
                    for (int n = 0; n < 2; ++n) acc[a][b][m][n] = (f32x4){0.f, 0.f, 0.f, 0.f};
        cur = nxt; cA = nA; cB = nB; ++ui;
        if constexpr (GATHER) {
#pragma unroll
            for (int i = 0; i < 2; ++i) { vA0[i] = nA0[i]; vA1[i] = nA1[i]; } }
        if (wr == 1) PG8_BAR;
    }
    PG8_WAIT_V(0);
    PG8_BAR;
#undef PG8_SA
#undef PG8_SB
#undef PG8_STAGE
#undef PG8_LDA
#undef PG8_LDB
#undef PG8_MMA
#undef PG8_WAIT_V
#undef PG8_WAIT_L
#undef PG8_BAR
#undef PG8_SCHED
}

struct EpiZ {
    static constexpr bool PERM = true;
    bf16_t* Z; const float* RS; int skip;
    __device__ __forceinline__ void operator()(const f32x4 (&acc)[2][2][4][2], const Unit& u, int wr, int wc, int fr, int fq) const {
        if (skip) return;
        const int row0 = u.pm * BM + wr * 64 + fr, col0 = u.pn * BM + wc * 32 + 8 * fq;
        float rsv[2][4];
#pragma unroll
        for (int ai = 0; ai < 2; ++ai)
#pragma unroll
            for (int m = 0; m < 4; ++m) rsv[ai][m] = RS[row0 + ai * HALF + m * 16];
#pragma unroll
        for (int ai = 0; ai < 2; ++ai)
#pragma unroll
            for (int m = 0; m < 4; ++m) { bf16_t* rowp = Z + (size_t)(row0 + ai * HALF + m * 16) * ZW + col0; const float rs = rsv[ai][m];
#pragma unroll
                for (int bj = 0; bj < 2; ++bj) { const f32x4 v0 = acc[ai][bj][m][0] * rs, v1 = acc[ai][bj][m][1] * rs;
                    u32x4 w; w.x = cvt_pk_bf16(v0[0], v0[1]); w.y = cvt_pk_bf16(v0[2], v0[3]); w.z = cvt_pk_bf16(v1[0], v1[1]); w.w = cvt_pk_bf16(v1[2], v1[3]);
                    *(u32x4*)(rowp + bj * HALF) = w; } }
    }
};
template <bool SRCF32> struct EpiResB {
    static constexpr bool PERM = true;
    const float* XF; bf16_t* XB;
    __device__ __forceinline__ void operator()(const f32x4 (&acc)[2][2][4][2], const Unit& u, int wr, int wc, int fr, int fq) const {
        const int row0 = u.pm * BM + wr * 64 + fr, col0 = u.pn * BM + wc * 32 + 8 * fq;
#pragma unroll
        for (int ai = 0; ai < 2; ++ai) {
            f32x4 xf[4][2][2]; u32x4 xw[4][2];
#pragma unroll
            for (int m = 0; m < 4; ++m) { const size_t off = (size_t)(row0 + ai * HALF + m * 16) * D + col0;
#pragma unroll
                for (int bj = 0; bj < 2; ++bj) {
                    if (SRCF32) { xf[m][bj][0] = *(const f32x4*)(XF + off + bj * HALF); xf[m][bj][1] = *(const f32x4*)(XF + off + bj * HALF + 4); }
                    else xw[m][bj] = *(const u32x4*)(XB + off + bj * HALF); } }
            __builtin_amdgcn_sched_barrier(0);
#pragma unroll
            for (int m = 0; m < 4; ++m) { const size_t off = (size_t)(row0 + ai * HALF + m * 16) * D + col0;
#pragma unroll
                for (int bj = 0; bj < 2; ++bj) { f32x4 x0, x1;
                    if (SRCF32) { x0 = xf[m][bj][0]; x1 = xf[m][bj][1]; }
                    else { const u32x4 w = xw[m][bj];
                        x0 = (f32x4){__uint_as_float(w.x << 16), __uint_as_float(w.x & 0xffff0000u), __uint_as_float(w.y << 16), __uint_as_float(w.y & 0xffff0000u)};
                        x1 = (f32x4){__uint_as_float(w.z << 16), __uint_as_float(w.z & 0xffff0000u), __uint_as_float(w.w << 16), __uint_as_float(w.w & 0xffff0000u)}; }
                    const f32x4 v0 = x0 + acc[ai][bj][m][0], v1 = x1 + acc[ai][bj][m][1];
                    u32x4 o; o.x = cvt_pk_bf16(v0[0], v0[1]); o.y = cvt_pk_bf16(v0[2], v0[3]); o.z = cvt_pk_bf16(v1[0], v1[1]); o.w = cvt_pk_bf16(v1[2], v1[3]);
                    *(u32x4*)(XB + off + bj * HALF) = o; } }
            __builtin_amdgcn_sched_barrier(0);
        }
    }
};
struct EpiAct {
    static constexpr bool PERM = true;
    bf16_t* ACT; const int2* lists; const float* RS;
    __device__ __forceinline__ void operator()(const f32x4 (&acc)[2][2][4][2], const Unit& u, int wr, int wc, int fr, int fq) const {
        const int row0 = u.pm * BM + wr * 64 + fr, col0 = u.pn * HALF + wc * 32 + 8 * fq; const int2* lst = lists + (size_t)u.e * NTOK + u.pos0;
        int tk[2][4]; float rsv[2][4];
#pragma unroll
        for (int ai = 0; ai < 2; ++ai)
#pragma unroll
            for (int m = 0; m < 4; ++m) { const int r = ai * HALF + wr * 64 + m * 16 + fr; const int rc = (u.pos0 + r < u.cnt) ? r : 0; tk[ai][m] = lst[rc].x; }
        asm volatile("" : "+v"(tk[0][0]), "+v"(tk[0][1]), "+v"(tk[0][2]), "+v"(tk[0][3]), "+v"(tk[1][0]), "+v"(tk[1][1]), "+v"(tk[1][2]), "+v"(tk[1][3]));
#pragma unroll
        for (int ai = 0; ai < 2; ++ai)
#pragma unroll
            for (int m = 0; m < 4; ++m) rsv[ai][m] = RS[tk[ai][m]];
        asm volatile("" : "+v"(rsv[0][0]), "+v"(rsv[0][1]), "+v"(rsv[0][2]), "+v"(rsv[0][3]), "+v"(rsv[1][0]), "+v"(rsv[1][1]), "+v"(rsv[1][2]), "+v"(rsv[1][3]));
#pragma unroll
        for (int ai = 0; ai < 2; ++ai)
#pragma unroll
            for (int m = 0; m < 4; ++m) { const int r = ai * HALF + wr * 64 + m * 16 + fr; if (!(u.pos0 + r < u.cnt)) rsv[ai][m] = 0.f; }
#pragma unroll
        for (int ai = 0; ai < 2; ++ai)
#pragma unroll
            for (int m = 0; m < 4; ++m) { bf16_t* rowp = ACT + (size_t)(row0 + ai * HALF + m * 16) * DE + col0;
                const float rs = rsv[ai][m];
                float o[8];
#pragma unroll
                for (int n = 0; n < 2; ++n)
#pragma unroll
                    for (int j = 0; j < 4; ++j) { const float g = acc[ai][0][m][n][j] * rs, up = acc[ai][1][m][n][j] * rs; o[n * 4 + j] = g * up * __builtin_amdgcn_rcpf(1.f + __expf(-g)); }
                u32x4 w; w.x = cvt_pk_bf16(o[0], o[1]); w.y = cvt_pk_bf16(o[2], o[3]); w.z = cvt_pk_bf16(o[4], o[5]); w.w = cvt_pk_bf16(o[6], o[7]);
                *(u32x4*)rowp = w; }
    }
};
struct EpiY {
    static constexpr bool PERM = true;
    bf16_t* YB; const int2* lists;
    __device__ __forceinline__ void operator()(const f32x4 (&acc)[2][2][4][2], const Unit& u, int wr, int wc, int fr, int fq) const {
        const int row0 = u.pm * BM + wr * 64 + fr, col0 = u.pn * BM + wc * 32 + 8 * fq; const int2* lst = lists + (size_t)u.e * NTOK + u.pos0;
        float wv[2][4];
#pragma unroll
        for (int ai = 0; ai < 2; ++ai)
#pragma unroll
            for (int m = 0; m < 4; ++m) { const int r = ai * HALF + wr * 64 + m * 16 + fr; wv[ai][m] = __int_as_float(lst[(u.pos0 + r < u.cnt) ? r : 0].y); }
#pragma unroll
        for (int ai = 0; ai < 2; ++ai)
#pragma unroll
            for (int m = 0; m < 4; ++m) { const int r = ai * HALF + wr * 64 + m * 16 + fr;
                if (u.pos0 + r < u.cnt) { const float w = wv[ai][m]; bf16_t* rowp = YB + (size_t)(row0 + ai * HALF + m * 16) * D + col0;
#pragma unroll
                    for (int bj = 0; bj < 2; ++bj) { const f32x4 v0 = acc[ai][bj][m][0] * w, v1 = acc[ai][bj][m][1] * w;
                        u32x4 o; o.x = cvt_pk_bf16(v0[0], v0[1]); o.y = cvt_pk_bf16(v0[2], v0[3]); o.z = cvt_pk_bf16(v1[0], v1[1]); o.w = cvt_pk_bf16(v1[2], v1[3]);
                        *(u32x4*)(rowp + bj * HALF) = o; } } }
    }
};
struct MoeOrder {
    const PG8_LAS i32x4* tab; int ntiles, npn, G, c; const char* A; size_t atile; const char* Bt; size_t bexp, btile; const int2* lists;
    __device__ __forceinline__ bool next(int i, Unit& u) const {
        const int L = i * G + c; const int T = L / npn; if (T >= ntiles) return false;
        const i32x4 te = tab[T]; u.pm = T; u.pn = L - T * npn; u.e = __builtin_amdgcn_readfirstlane(te.x); u.pos0 = __builtin_amdgcn_readfirstlane(te.y); u.cnt = __builtin_amdgcn_readfirstlane(te.z);
        u.A = A + (size_t)T * atile; u.B = Bt + (size_t)u.e * bexp + (size_t)u.pn * btile; return true;
    }
    __device__ __forceinline__ void aoff(const Unit& u, unsigned (&o0)[2], unsigned (&o1)[2], const int (&Rs)[2], const int (&Cs)[2]) const {
        const int2* lst = lists + (size_t)u.e * NTOK;
#pragma unroll
        for (int i = 0; i < 2; ++i) { const int p0 = u.pos0 + Rs[i], p1 = p0 + HALF;
            const int t0 = (p0 < u.cnt) ? lst[p0].x : 0, t1 = (p1 < u.cnt) ? lst[p1].x : 0;
            o0[i] = (unsigned)t0 * (unsigned)(D * 2) + (unsigned)Cs[i] * 2u; o1[i] = (unsigned)t1 * (unsigned)(D * 2) + (unsigned)Cs[i] * 2u; }
    }
};
}

__device__ __forceinline__ void tc_strip(float* Tf, const float* src, int src_ld, int c0, int k0, bf16_t* dst, int K, int n0) {
    LAS unsigned char* T = (LAS unsigned char*)Tf;
    const int tid = tid_opaque(), lane = tid & 63, wid = tid >> 6, l = lane & 15, g = lane >> 4;
    float4 v[8];
#pragma unroll
    for (int i = 0; i < 8; ++i) { const int kk = (tid >> 4) + 32 * i, c4 = (tid & 15) * 4; v[i] = *(const float4*)(src + (size_t)(k0 + kk) * src_ld + c0 + c4); }
    __syncthreads();
#pragma unroll
    for (int i = 0; i < 8; ++i) { const int kk = (tid >> 4) + 32 * i, c4 = (tid & 15) * 4;
        u32x2_t w; w.x = pg8::cvt_pk_bf16(v[i].x, v[i].y); w.y = pg8::cvt_pk_bf16(v[i].z, v[i].w);
        *(LAS u32x2_t*)(T + kk * 144 + c4 * 2) = w; }
    __syncthreads();
#pragma unroll
    for (int nb = 0; nb < 4; ++nb) { const LAS unsigned char* p = T + (32 * wid + 8 * g + (l >> 2)) * 144 + (16 * nb + 4 * (l & 3)) * 2;
        const u32x2_t a0 = lds_tr4(p), a1 = lds_tr4(p + 4 * 144);
        const pg8::u32x4 w = {a0.x, a0.y, a1.x, a1.y};
        *(pg8::u32x4*)(dst + (size_t)(n0 + 16 * nb + l) * K + k0 + 32 * wid + 8 * g) = w; }
}
__device__ __forceinline__ void s5_build_tables_fwd(float* ldsf, const Params& P, int l, int g, unsigned char* tb);
__device__ __forceinline__ void ph_prologue(float* lds, const Params& P) {
    constexpr int NJ_EXP = NLAYER * NEXP * 96, NJ_IN = NLAYER * 144, NJ_OUT = NLAYER * 64, NJ_TB = NLAYER * 16, NJ_GLU = NLAYER * 4, NJ_SGU = NLAYER * 4, NJ_RT = NLAYER * 16;
    bf16_t* WIN = (bf16_t*)(P.ws + WS_WIN); bf16_t* WOUT = (bf16_t*)(P.ws + WS_WOUT); bf16_t* WGU = (bf16_t*)(P.ws + WS_WGU); bf16_t* WD = (bf16_t*)(P.ws + WS_WD);
    constexpr int NJ_ALL = NJ_EXP + NJ_IN + NJ_OUT + NJ_TB + NJ_GLU + NJ_SGU + NJ_RT, NJ_SMALL = NJ_TB + NJ_GLU + NJ_SGU + NJ_RT;
    unsigned* qhead = (unsigned*)(P.ws + WS_CTL) + CW_Q;
    LAS int* jslot = (LAS int*)((LAS unsigned char*)lds + LDS_BYTES - 64);
    for (;;) {
        __syncthreads();
        if (tid_opaque() == 0) *jslot = (int)atomicAdd(qhead, 1u);
        __syncthreads();
        const int jj = __builtin_amdgcn_readfirstlane(*jslot);
        if (jj >= NJ_ALL) break;
        const int j = (jj < NJ_SMALL) ? (NJ_ALL - NJ_SMALL + jj) : (jj - NJ_SMALL);
        if (j < NJ_EXP) {
            const int le = j / 96, r = j % 96;
            if (r < 64) { const int n0 = (r >> 2) * 64, k0 = (r & 3) * 256, pn = n0 >> 8, within = n0 & 255;
                const float* s = (within < 128 ? P.in[I_EWG] : P.in[I_EWU]) + (size_t)le * D * DE;
                tc_strip(lds, s, DE, pn * 128 + (within & 127), k0, WGU + (size_t)le * 1024 * D, D, n0);
            } else { const int r2 = r - 64, n0 = (r2 >> 1) * 64, k0 = (r2 & 1) * 256;
                tc_strip(lds, P.in[I_EWD] + (size_t)le * DE * D, D, n0, k0, WD + (size_t)le * D * DE, DE, n0); }
        } else if (j < NJ_EXP + NJ_IN) {
            const int j2 = j - NJ_EXP, l = j2 / 144, r = j2 % 144, n0 = (r >> 2) * 64, k0 = (r & 3) * 256;
            tc_strip(lds, P.in[I_WIN] + (size_t)l * D * INW, INW, n0 < WCI ? n0 : n0 + 8, k0, WIN + (size_t)l * NMAIN * D, D, n0);
        } else if (j < NJ_EXP + NJ_IN + NJ_OUT) {
            const int j3 = j - NJ_EXP - NJ_IN, l = j3 / 64, r = j3 % 64, n0 = (r >> 2) * 64, k0 = (r & 3) * 256;
            tc_strip(lds, P.in[I_WOUT] + (size_t)l * D * D, D, n0, k0, WOUT + (size_t)l * D * D, D, n0);
        } else if (j < NJ_EXP + NJ_IN + NJ_OUT + NJ_TB) {
            const int j4 = j - (NJ_EXP + NJ_IN + NJ_OUT);
            s5_build_tables_fwd(lds, P, j4 >> 4, j4 & 15, P.ws + WS_TB + (size_t)(j4 >> 4) * 4 * MiB);
        } else if (j < NJ_EXP + NJ_IN + NJ_OUT + NJ_TB + NJ_GLU) {
            const int j5 = j - (NJ_EXP + NJ_IN + NJ_OUT + NJ_TB), l = j5 >> 2, n0 = (j5 & 3) * 64;
            tc_strip(lds, P.in[I_GLUW] + (size_t)l * 256 * 256, 256, n0, 0, (bf16_t*)(P.ws + WS_TB + (size_t)l * 4 * MiB + s5::T_GLUW), 256, n0);
        } else if (j < NJ_EXP + NJ_IN + NJ_OUT + NJ_TB + NJ_GLU + NJ_SGU) {
            const int j6 = j - (NJ_EXP + NJ_IN + NJ_OUT + NJ_TB + NJ_GLU), l = j6 >> 2, g = j6 & 3;
            bf16_t* wbp = (bf16_t*)(P.ws + WS_TB + (size_t)l * 4 * MiB + s5::T_SGUW) + (size_t)g * 128 * 128; const float* ws_ = P.in[I_SGUW] + ((size_t)l * 4 + g) * 128 * 128;
            for (int idx = tid_opaque(); idx < 128 * 128; idx += NTHREADS) { const int t = idx >> 7, s = idx & 127; wbp[idx] = (s <= t) ? (bf16_t)(pg8::cvt_pk_bf16(ws_[idx], 0.f) & 0xffffu) : (bf16_t)0; }
        } else {
            const int j7 = j - (NJ_EXP + NJ_IN + NJ_OUT + NJ_TB + NJ_GLU + NJ_SGU), l = j7 / 16, n0 = (j7 % 16) * 4;
            bf16_t* wh = (bf16_t*)(P.ws + WS_RT + (size_t)l * 256 * 1024); bf16_t* wl = wh + 48 * D;
            for (int idx = tid_opaque(); idx < 4 * D; idx += NTHREADS) { const int n = n0 + (idx >> 10), k = idx & (D - 1);
                const float w = (n < 4) ? P.in[I_RGW][((size_t)l * D + k) * 4 + n] : ((n < 36) ? P.in[I_REW][((size_t)l * D + k) * 32 + (n - 4)] : ((n >= 48 && n < 56) ? P.in[I_WIN][((size_t)l * D + k) * INW + WCI + (n - 48)] : 0.f));
                const unsigned hb = pg8::cvt_pk_bf16(w, 0.f) & 0xffffu; const bf16_t lb = (bf16_t)(pg8::cvt_pk_bf16(w - __uint_as_float(hb << 16), 0.f) & 0xffffu);
                if (n < 48) { wh[(size_t)n * D + k] = (bf16_t)hb; wl[(size_t)n * D + k] = lb; } else { wh[(size_t)(96 + n - 48) * D + k] = (bf16_t)hb; wh[(size_t)(112 + n - 48) * D + k] = lb; } }
        }
    }
    __syncthreads();
}

template <bool DUAL, class AF, class EF>
__device__ __forceinline__ void gemm_tile(float* lds, AF arow, int K, const float* B0, const float* B1, int ldb, int n0, int N, EF epi) {
    float* As = lds;
    float* Bs0 = lds + 32 * 132;
    float* Bs1 = Bs0 + 32 * 128;
    const int tid = tid_opaque(), ty = tid >> 4, tx = tid & 15;
    float acc0[4][8], acc1[4][8];
#pragma unroll
    for (int i = 0; i < 4; ++i)
#pragma unroll
        for (int j = 0; j < 8; ++j) { acc0[i][j] = 0.f; acc1[i][j] = 0.f; }
    const float* ap0 = arow((tid >> 3));
    const float* ap1 = arow((tid >> 3) + 64);
    const int akk = (tid & 7) * 4;
    const int bn = n0 + (tid & 31) * 4; const bool bok = bn < N;
    for (int k0 = 0; k0 < K; k0 += 32) {
        const float4 av0 = ap0 ? *(const float4*)(ap0 + k0 + akk) : make_float4(0.f, 0.f, 0.f, 0.f);
        const float4 av1 = ap1 ? *(const float4*)(ap1 + k0 + akk) : make_float4(0.f, 0.f, 0.f, 0.f);
        const int kb0 = k0 + (tid >> 5), kb1 = kb0 + 16;
        const float4 bv00 = bok ? *(const float4*)(B0 + (size_t)kb0 * ldb + bn) : make_float4(0.f, 0.f, 0.f, 0.f);
        const float4 bv01 = bok ? *(const float4*)(B0 + (size_t)kb1 * ldb + bn) : make_float4(0.f, 0.f, 0.f, 0.f);
        const float4 bv10 = (DUAL && bok) ? *(const float4*)(B1 + (size_t)kb0 * ldb + bn) : bv00;
        const float4 bv11 = (DUAL && bok) ? *(const float4*)(B1 + (size_t)kb1 * ldb + bn) : bv01;
        __syncthreads();
        { const int r = (tid >> 3);
          As[(akk + 0) * 132 + r] = av0.x; As[(akk + 1) * 132 + r] = av0.y; As[(akk + 2) * 132 + r] = av0.z; As[(akk + 3) * 132 + r] = av0.w;
          As[(akk + 0) * 132 + r + 64] = av1.x; As[(akk + 1) * 132 + r + 64] = av1.y; As[(akk + 2) * 132 + r + 64] = av1.z; As[(akk + 3) * 132 + r + 64] = av1.w; }
        { const int k = (tid >> 5);
          *(float4*)&Bs0[k * 128 + (tid & 31) * 4] = bv00; *(float4*)&Bs0[(k + 16) * 128 + (tid & 31) * 4] = bv01;
          if (DUAL) { *(float4*)&Bs1[k * 128 + (tid & 31) * 4] = bv10; *(float4*)&Bs1[(k + 16) * 128 + (tid & 31) * 4] = bv11; } }
        __syncthreads();
#pragma unroll 4
        for (int k = 0; k < 32; ++k) {
            const float4 a = *(const float4*)&As[k * 132 + ty * 4];
            const float4 b0 = *(const float4*)&Bs0[k * 128 + tx * 4], b1 = *(const float4*)&Bs0[k * 128 + 64 + tx * 4];
            const float aa[4] = {a.x, a.y, a.z, a.w};
            const float bb[8] = {b0.x, b0.y, b0.z, b0.w, b1.x, b1.y, b1.z, b1.w};
#pragma unroll
            for (int i = 0; i < 4; ++i)
#pragma unroll
                for (int j = 0; j < 8; ++j) acc0[i][j] = fmaf(aa[i], bb[j], acc0[i][j]);
            if (DUAL) {
                const float4 c0 = *(const float4*)&Bs1[k * 128 + tx * 4], c1 = *(const float4*)&Bs1[k * 128 + 64 + tx * 4];
                const float cc[8] = {c0.x, c0.y, c0.z, c0.w, c1.x, c1.y, c1.z, c1.w};
#pragma unroll
                for (int i = 0; i < 4; ++i)
#pragma unroll
                    for (int j = 0; j < 8; ++j) acc1[i][j] = fmaf(aa[i], cc[j], acc1[i][j]);
            }
        }
    }
#pragma unroll
    for (int i = 0; i < 4; ++i)
#pragma unroll
        for (int j = 0; j < 8; ++j) {
            const int r = ty * 4 + i, c = n0 + (j < 4 ? tx * 4 + j : 64 + tx * 4 + (j - 4));
            if (c < N) epi(r, c, acc0[i][j], acc1[i][j]);
        }
    __syncthreads();
}

__device__ __forceinline__ void ph_inproj(LAS unsigned char* ldsb, const bf16_t* xn, const bf16_t* wt, bf16_t* z, const float* RS, int skip) {
    pg8::StaticOrder S; S.init(NTOK, NMAIN, D, D, gridDim.x, blockIdx.x, xn, wt, INPROJ_WGM);
    if (skip & 2) S.pmmask = 15;
    pg8::EpiZ E{z, RS, skip & 1};
    pg8::gemm_phase<pg8::EpiZ, pg8::StaticOrder, false>(ldsb, D, D, S, E);
}

namespace ml {
using pg8::bf16x8; using pg8::f32x4; using pg8::u32x4; using pg8::u32x2;
constexpr int L = 128, NCH = S / L, NU = NB * 4 * NCH;
constexpr int QP = 144;
constexpr int OFF_Q = 0, OFF_K = OFF_Q + 128 * QP, OFF_V = OFF_K + 128 * QP, OFF_KW = OFF_V + 128 * QP, OFF_F = OFF_KW + 128 * QP;
constexpr int LDS_END = OFF_F + 4 * 128 * 4 + 64;
constexpr size_t O_CL = 0, O_CST = O_CL + (size_t)NU * 4096 * 4, O_NL = O_CST + (size_t)NU * 4096 * 2, O_NST = O_NL + (size_t)NU * 64 * 4,
                 O_MLOC = O_NST + (size_t)NU * 64 * 4, O_BL = O_MLOC + (size_t)NU * 4, O_MST = O_BL + (size_t)NU * 4, O_END = O_MST + (size_t)NU * 4;
__device__ __forceinline__ f32x4 mfma16(bf16x8 a, bf16x8 b, f32x4 c) { return __builtin_amdgcn_mfma_f32_16x16x32_bf16(a, b, c, 0, 0, 0); }
__device__ __forceinline__ float bf_lo(unsigned w) { return __uint_as_float(w << 16); }
__device__ __forceinline__ float bf_hi(unsigned w) { return __uint_as_float(w & 0xffff0000u); }
__device__ __forceinline__ unsigned short bf1(float x) { return (unsigned short)(pg8::cvt_pk_bf16(x, 0.f) & 0xffffu); }

__device__ __forceinline__ void stage_gates(LAS unsigned char* lds, const float* gates, const Params& P, int l, int head, int tok0, int tid) {
    LAS float* LF = (LAS float*)(lds + OFF_F); LAS float* IG = LF + 128; LAS float* Bc = LF + 256; LAS float* G2 = LF + 384; LAS float* scal = LF + 512;
    if (tid < 128) { const float* zr = gates + (size_t)(tok0 + tid) * 8;
        const float ipre = zr[head] + P.in[I_GATEB][l * 8 + head], fpre = zr[4 + head] + P.in[I_GATEB][l * 8 + 4 + head];
        LF[tid] = fminf(fpre, 0.f) - log1pf(expf(-fabsf(fpre))); IG[tid] = ipre; }
    __syncthreads();
    if (tid < 64) { const float a = LF[2 * tid], b2 = LF[2 * tid + 1]; const float s = a + b2; float inc = s;
#pragma unroll
        for (int o = 1; o < 64; o <<= 1) { const float v = __shfl_up(inc, o); if (tid >= o) inc += v; }
        const float exc = inc - s; const float b0 = exc + a, b1 = exc + s;
        Bc[2 * tid] = b0; Bc[2 * tid + 1] = b1; const float g0 = IG[2 * tid] - b0, g1 = IG[2 * tid + 1] - b1; G2[2 * tid] = g0; G2[2 * tid + 1] = g1;
        float gm = fmaxf(g0, g1);
#pragma unroll
        for (int o = 32; o > 0; o >>= 1) gm = fmaxf(gm, __shfl_xor(gm, o));
        if (tid == 63) { scal[0] = gm; scal[1] = b1; } }
    __syncthreads();
}
__device__ __forceinline__ void conv8_load(const bf16_t* z, int b, int pos, int which, int head, int c0, u32x4 (&raw)[4]) {
    const int col = (which ? ZCK : ZCQ) + head * 64 + c0;
#pragma unroll
    for (int j = 0; j < 4; ++j) { const int tg = pos - 3 + j; raw[j] = *(const u32x4*)(z + (size_t)(b * S + (tg > 0 ? tg : 0)) * ZW + col); }
}
__device__ __forceinline__ void conv8_finish(const u32x4 (&raw)[4], const float* cw, int pos, int which, int head, int c0, float (&o)[8]) {
    const int cc = which * 256 + head * 64 + c0;
    float x[8];
#pragma unroll
    for (int e = 0; e < 8; ++e) x[e] = 0.f;
    float4 wa[4], wb[4];
#pragma unroll
    for (int j = 0; j < 4; ++j) { wa[j] = *(const float4*)(cw + j * 512 + cc); wb[j] = *(const float4*)(cw + j * 512 + cc + 4); }
    __builtin_amdgcn_sched_barrier(0);
#pragma unroll
    for (int j = 0; j < 4; ++j) { const float mk = (pos - 3 + j >= 0) ? 1.f : 0.f;
        const float4 w0 = wa[j], w1 = wb[j];
        x[0] += mk * w0.x * bf_lo(raw[j].x); x[1] += mk * w0.y * bf_hi(raw[j].x); x[2] += mk * w0.z * bf_lo(raw[j].y); x[3] += mk * w0.w * bf_hi(raw[j].y);
        x[4] += mk * w1.x * bf_lo(raw[j].z); x[5] += mk * w1.y * bf_hi(raw[j].z); x[6] += mk * w1.z * bf_lo(raw[j].w); x[7] += mk * w1.w * bf_hi(raw[j].w); }
    const float sc = which ? 0.125f : 1.f;
#pragma unroll
    for (int e = 0; e < 8; ++e) o[e] = x[e] * sc * rsig(x[e]);
}
__device__ __forceinline__ void vt_load(const bf16_t* z, int head, int tok0, int tid, u32x4 (&w)[2]) {
#pragma unroll
    for (int it = 0; it < 2; ++it) { const int idx = tid + it * NTHREADS, s = idx >> 3, cg = idx & 7; w[it] = *(const u32x4*)(z + (size_t)(tok0 + s) * ZW + ZCV + head * 64 + cg * 8); }
}
__device__ __forceinline__ void vt_store(LAS unsigned char* lds, int tid, const u32x4 (&w)[2]) {
#pragma unroll
    for (int it = 0; it < 2; ++it) { const int idx = tid + it * NTHREADS, s = idx >> 3, cg = idx & 7; *(LAS u32x4*)(lds + OFF_V + s * QP + cg * 16) = w[it]; }
}

__device__ __forceinline__ void p1_unit(LAS unsigned char* lds, const bf16_t* z, const float* gates, const Params& P, int l, int u, unsigned char* wsm) {
    const int tid = tid_opaque(), lane = tid & 63, wid = __builtin_amdgcn_readfirstlane(tid >> 6), r = lane & 15, qd = lane >> 4;
    const int b = u >> 8, head = (u >> 6) & 3, c = u & 63, tok0 = b * S + c * L;
    LAS float* G2 = (LAS float*)(lds + OFF_F) + 384; LAS float* scal = (LAS float*)(lds + OFF_F) + 512;
    u32x4 vraw[2], kraw[2][4];
    vt_load(z, head, tok0, tid, vraw);
#pragma unroll
    for (int it = 0; it < 2; ++it) { const int idx = tid + it * NTHREADS; conv8_load(z, b, c * L + (idx >> 3), 1, head, (idx & 7) * 8, kraw[it]); }
    __syncthreads();
    stage_gates(lds, gates, P, l, head, tok0, tid);
    const float gmax = scal[0], bL = scal[1];
    vt_store(lds, tid, vraw);
    const float* cw = P.in[I_CONVW] + (size_t)l * 4 * 512;
#pragma unroll
    for (int it = 0; it < 2; ++it) { const int idx = tid + it * NTHREADS, s = idx >> 3, cg = idx & 7;
        float o[8]; conv8_finish(kraw[it], cw, c * L + s, 1, head, cg * 8, o);
        const float ws = __expf(G2[s] - gmax);
        u32x4 w; w.x = pg8::cvt_pk_bf16(o[0] * ws, o[1] * ws); w.y = pg8::cvt_pk_bf16(o[2] * ws, o[3] * ws); w.z = pg8::cvt_pk_bf16(o[4] * ws, o[5] * ws); w.w = pg8::cvt_pk_bf16(o[6] * ws, o[7] * ws);
        *(LAS u32x4*)(lds + OFF_KW + s * QP + cg * 16) = w; }
    __syncthreads();
    const int kt = wid >> 1;
    float* CL = (float*)(wsm + O_CL) + (size_t)u * 4096;
#pragma unroll
    for (int i = 0; i < 2; ++i) { const int vt = (wid & 1) * 2 + i; f32x4 acc = {0.f, 0.f, 0.f, 0.f};
#pragma unroll
        for (int ks = 0; ks < 4; ++ks) {
            const LAS unsigned char* ap = lds + OFF_KW + (32 * ks + 8 * qd + (r >> 2)) * QP + (16 * kt + 4 * (r & 3)) * 2; const LAS unsigned char* bp = lds + OFF_V + (32 * ks + 8 * qd + (r >> 2)) * QP + (16 * vt + 4 * (r & 3)) * 2;
            const u32x2_t a0 = lds_tr4(ap), a1 = lds_tr4(ap + 4 * QP), b0 = lds_tr4(bp), b1 = lds_tr4(bp + 4 * QP);
            const u32x4 aw = {a0.x, a0.y, a1.x, a1.y}, bw = {b0.x, b0.y, b1.x, b1.y};
            acc = mfma16(__builtin_bit_cast(bf16x8, aw), __builtin_bit_cast(bf16x8, bw), acc); }
        *(f32x4*)(CL + (size_t)(16 * vt + r) * 64 + 16 * kt + 4 * qd) = acc; }
    if (tid < 64) { float sum = 0.f;
        for (int s2 = 0; s2 < 128; ++s2) sum += __uint_as_float((unsigned)*(const LAS unsigned short*)(lds + OFF_KW + s2 * QP + tid * 2) << 16);
        ((float*)(wsm + O_NL))[(size_t)u * 64 + tid] = sum; }
    if (tid == 0) { ((float*)(wsm + O_MLOC))[u] = bL + gmax; ((float*)(wsm + O_BL))[u] = bL; }
}
__device__ __forceinline__ void p2_scan(unsigned char* wsm) {
    const int tid = tid_opaque();
    const float* CL = (const float*)(wsm + O_CL); const float* NL = (const float*)(wsm + O_NL); const float* MLOC = (const float*)(wsm + O_MLOC); const float* BL = (const float*)(wsm + O_BL);
    bf16_t* CST = (bf16_t*)(wsm + O_CST); float* NST = (float*)(wsm + O_NST); float* MST = (float*)(wsm + O_MST);
    for (int idx = blockIdx.x * NTHREADS + tid; idx < 32 * 4096; idx += gridDim.x * NTHREADS) {
        const int bh = idx >> 12, e = idx & 4095;
        float C = 0.f, nn = 0.f, m = 0.f;
#pragma unroll 1
        for (int c0 = 0; c0 < NCH; c0 += 16) {
            float cl[16], ml_[16], bl[16], nl[16];
#pragma unroll
            for (int i = 0; i < 16; ++i) { const int u = bh * NCH + c0 + i; cl[i] = CL[(size_t)u * 4096 + e]; ml_[i] = MLOC[u]; bl[i] = BL[u]; nl[i] = NL[(size_t)u * 64 + (e & 63)]; }
            unsigned short cs[16]; float ns[16], ms[16];
#pragma unroll
            for (int i = 0; i < 16; ++i) { cs[i] = bf1(C); ns[i] = nn; ms[i] = m;
                const float mn = fmaxf(bl[i] + m, ml_[i]), dec = __expf(bl[i] + m - mn), wl = __expf(ml_[i] - mn);
                C = dec * C + wl * cl[i]; nn = dec * nn + wl * nl[i]; m = mn; }
#pragma unroll
            for (int i = 0; i < 16; ++i) { const int u = bh * NCH + c0 + i; CST[(size_t)u * 4096 + e] = cs[i]; if (e < 64) NST[(size_t)u * 64 + e] = ns[i]; if (e == 0) MST[u] = ms[i]; }
        }
    }
}
__device__ __forceinline__ void p3_unit(LAS unsigned char* lds, const bf16_t* z, const float* gates, const Params& P, int l, int u, const unsigned char* wsm, bf16_t* mix) {
    const int tid = tid_opaque(), lane = tid & 63, wid = __builtin_amdgcn_readfirstlane(tid >> 6), r = lane & 15, qd = lane >> 4;
    const int b = u >> 8, head = (u >> 6) & 3, c = u & 63, tok0 = b * S + c * L;
    LAS float* Bc = (LAS float*)(lds + OFF_F) + 256; LAS float* G2 = (LAS float*)(lds + OFF_F) + 384;
    u32x4 vraw[2], qkraw[4][4];
    vt_load(z, head, tok0, tid, vraw);
#pragma unroll
    for (int it = 0; it < 4; ++it) { const int idx = tid + it * NTHREADS; conv8_load(z, b, c * L + ((idx >> 3) & 127), idx >> 10, head, (idx & 7) * 8, qkraw[it]); }
    __syncthreads();
    stage_gates(lds, gates, P, l, head, tok0, tid);
    vt_store(lds, tid, vraw);
    const float* cw = P.in[I_CONVW] + (size_t)l * 4 * 512;
#pragma unroll
    for (int it = 0; it < 4; ++it) { const int idx = tid + it * NTHREADS, which = idx >> 10, s = (idx >> 3) & 127, cg = idx & 7;
        float o[8]; conv8_finish(qkraw[it], cw, c * L + s, which, head, cg * 8, o);
        u32x4 w; w.x = pg8::cvt_pk_bf16(o[0], o[1]); w.y = pg8::cvt_pk_bf16(o[2], o[3]); w.z = pg8::cvt_pk_bf16(o[4], o[5]); w.w = pg8::cvt_pk_bf16(o[6], o[7]);
        *(LAS u32x4*)(lds + (which ? OFF_K : OFF_Q) + s * QP + cg * 16) = w; }
    __syncthreads();
    const int w = wid, t = 16 * w + r;
    const bf16x8 bq0 = *(const LAS bf16x8*)(lds + OFF_Q + t * QP + qd * 16), bq1 = *(const LAS bf16x8*)(lds + OFF_Q + t * QP + 64 + qd * 16);
    f32x4 accS[8];
#pragma unroll
    for (int ct = 0; ct < 8; ++ct) { accS[ct] = (f32x4){0.f, 0.f, 0.f, 0.f};
        if (ct <= w) { const bf16x8 a0 = *(const LAS bf16x8*)(lds + OFF_K + (16 * ct + r) * QP + qd * 16), a1 = *(const LAS bf16x8*)(lds + OFF_K + (16 * ct + r) * QP + 64 + qd * 16);
            accS[ct] = mfma16(a0, bq0, accS[ct]); accS[ct] = mfma16(a1, bq1, accS[ct]); } }
    const float bt = Bc[t], mst = ((const float*)(wsm + O_MST))[u];
    float ld[8][4]; float mloc = -3.0e38f;
#pragma unroll
    for (int ct = 0; ct < 8; ++ct) { const f32x4 g = *(const LAS f32x4*)(G2 + 16 * ct + 4 * qd);
#pragma unroll
        for (int j = 0; j < 4; ++j) { const bool valid = (ct < w) || (ct == w && 4 * qd + j <= r); ld[ct][j] = valid ? bt + g[j] : -3.0e38f; mloc = fmaxf(mloc, ld[ct][j]); } }
    mloc = fmaxf(mloc, __shfl_xor(mloc, 16)); mloc = fmaxf(mloc, __shfl_xor(mloc, 32));
    const float mt = fmaxf(bt + mst, mloc);
    float den = 0.f;
#pragma unroll
    for (int ct = 0; ct < 8; ++ct)
#pragma unroll
        for (int j = 0; j < 4; ++j) { const float pe = __expf(ld[ct][j] - mt) * accS[ct][j]; accS[ct][j] = pe; den += pe; }
    den += __shfl_xor(den, 16); den += __shfl_xor(den, 32);
    const bf16_t* cst = (const bf16_t*)(wsm + O_CST) + (size_t)u * 4096; const float* nst = (const float*)(wsm + O_NST) + (size_t)u * 64;
    f32x4 accN[4];
#pragma unroll
    for (int dt = 0; dt < 4; ++dt) { const bf16x8 c0 = *(const bf16x8*)(cst + (16 * dt + r) * 64 + 8 * qd), c1 = *(const bf16x8*)(cst + (16 * dt + r) * 64 + 32 + 8 * qd);
        accN[dt] = mfma16(c0, bq0, (f32x4){0.f, 0.f, 0.f, 0.f}); accN[dt] = mfma16(c1, bq1, accN[dt]); }
    const float winter = __expf(bt + mst - mt);
    float nq = 0.f;
    { const float4 n0 = *(const float4*)(nst + 8 * qd), n1 = *(const float4*)(nst + 8 * qd + 4), n2 = *(const float4*)(nst + 32 + 8 * qd), n3 = *(const float4*)(nst + 36 + 8 * qd);
      const u32x4 q0 = __builtin_bit_cast(u32x4, bq0), q1 = __builtin_bit_cast(u32x4, bq1);
      nq = bf_lo(q0.x) * n0.x + bf_hi(q0.x) * n0.y + bf_lo(q0.y) * n0.z + bf_hi(q0.y) * n0.w + bf_lo(q0.z) * n1.x + bf_hi(q0.z) * n1.y + bf_lo(q0.w) * n1.z + bf_hi(q0.w) * n1.w
         + bf_lo(q1.x) * n2.x + bf_hi(q1.x) * n2.y + bf_lo(q1.y) * n2.z + bf_hi(q1.y) * n2.w + bf_lo(q1.z) * n3.x + bf_hi(q1.z) * n3.y + bf_lo(q1.w) * n3.z + bf_hi(q1.w) * n3.w; }
    nq += __shfl_xor(nq, 16); nq += __shfl_xor(nq, 32);
    den += winter * nq;
#pragma unroll
    for (int dt = 0; dt < 4; ++dt) accN[dt] = accN[dt] * winter;
#pragma unroll
    for (int kk = 0; kk < 4; ++kk) if (2 * kk <= w) {
        u32x4 pw; pw.x = pg8::cvt_pk_bf16(accS[2 * kk][0], accS[2 * kk][1]); pw.y = pg8::cvt_pk_bf16(accS[2 * kk][2], accS[2 * kk][3]);
        pw.z = pg8::cvt_pk_bf16(accS[2 * kk + 1][0], accS[2 * kk + 1][1]); pw.w = pg8::cvt_pk_bf16(accS[2 * kk + 1][2], accS[2 * kk + 1][3]);
        const bf16x8 pf = __builtin_bit_cast(bf16x8, pw);
#pragma unroll
        for (int dt = 0; dt < 4; ++dt) { const LAS unsigned char* vp = lds + OFF_V + (32 * kk + 4 * qd + (r >> 2)) * QP + (16 * dt + 4 * (r & 3)) * 2;
            const u32x2_t v0 = lds_tr4(vp), v1 = lds_tr4(vp + 16 * QP);
            u32x4 vw; vw.x = v0.x; vw.y = v0.y; vw.z = v1.x; vw.w = v1.y;
            accN[dt] = mfma16(__builtin_bit_cast(bf16x8, vw), pf, accN[dt]); } }
    const float inv = 1.f / fmaxf(fabsf(den), __expf(-mt));
    float ss = 0.f;
#pragma unroll
    for (int dt = 0; dt < 4; ++dt) { accN[dt] = accN[dt] * inv; ss += accN[dt][0] * accN[dt][0] + accN[dt][1] * accN[dt][1] + accN[dt][2] * accN[dt][2] + accN[dt][3] * accN[dt][3]; }
    ss += __shfl_xor(ss, 16); ss += __shfl_xor(ss, 32);
    const float rs = rsqrtf(ss * (1.f / 64.f) + EPS);
    const float* ng = P.in[I_MNG] + l * 256 + head * 64; const bf16_t* cop = z + (size_t)(tok0 + t) * ZW + ZCO + head * 64;
    bf16_t* op = mix + (size_t)(tok0 + t) * D + 512 + head * 64;
#pragma unroll
    for (int dt = 0; dt < 4; ++dt) { const int d0 = 16 * dt + 4 * qd; const float4 g = *(const float4*)(ng + d0); const u32x2 cw2 = *(const u32x2*)(cop + d0); const float4 co = make_float4(bf_lo(cw2.x), bf_hi(cw2.x), bf_lo(cw2.y), bf_hi(cw2.y));
        u32x2 o; o.x = pg8::cvt_pk_bf16(accN[dt][0] * rs * g.x * rsig(co.x), accN[dt][1] * rs * g.y * rsig(co.y));
        o.y = pg8::cvt_pk_bf16(accN[dt][2] * rs * g.z * rsig(co.z), accN[dt][3] * rs * g.w * rsig(co.w));
        *(u32x2*)(op + d0) = o; }
}
static_assert(O_END <= 64 * MiB && LDS_END <= 128 * 1024, "mLSTM scratch fits");
}

namespace s5 {
using pg8::bf16x8; using pg8::f32x4; using pg8::u32x4; using pg8::u32x2;
constexpr int LC = 16, NINST = NTOK / LC;
constexpr size_t O_E = 0, O_XC = O_E + (size_t)NINST * 16 * 128 * 4, O_END = O_XC + (size_t)NINST * 16 * 128 * 2;
constexpr int YP = 528;
__device__ __forceinline__ f32x4 mfma16(bf16x8 a, bf16x8 b, f32x4 c) { return __builtin_amdgcn_mfma_f32_16x16x32_bf16(a, b, c, 0, 0, 0); }

__device__ __forceinline__ void build_tables(float* ldsf, const Params& P, int l, int g, unsigned char* tb) {
    const int tid = tid_opaque();
    float* apw = ldsf; float* bb = apw + 17 * 64 * 2; float* cc = bb + 64 * 16 * 2;
    __syncthreads();
    if (tid < 64) { const int gp = (l * 16 + g) * 64 + tid;
        const float ar = P.in[I_ARE][gp], ai = P.in[I_AIM][gp], dt = expf(P.in[I_LDT][l * 16 + g]);
        for (int tau = 0; tau <= 16; ++tau) { const float er = expf(ar * dt * tau), ang = ai * dt * tau; apw[(tau * 64 + tid) * 2] = er * cosf(ang); apw[(tau * 64 + tid) * 2 + 1] = er * sinf(ang); }
        const float abr = apw[(64 + tid) * 2], abi = apw[(64 + tid) * 2 + 1];
        const float xr_ = abr - 1.f, xi_ = abi, den = ar * ar + ai * ai;
        const float cr = (xr_ * ar + xi_ * ai) / den, ci = (xi_ * ar - xr_ * ai) / den;
        for (int h = 0; h < 16; ++h) { const float br = P.in[I_BRE][(size_t)gp * 16 + h], bi = P.in[I_BIM][(size_t)gp * 16 + h]; bb[(tid * 16 + h) * 2] = cr * br - ci * bi; bb[(tid * 16 + h) * 2 + 1] = cr * bi + ci * br; }
        float* a16 = (float*)(tb + T_A16) + (size_t)(g * 64 + tid) * 2; a16[0] = apw[(16 * 64 + tid) * 2]; a16[1] = apw[(16 * 64 + tid) * 2 + 1]; }
    for (int idx = tid; idx < 16 * 64; idx += NTHREADS) { const int h = idx >> 6, p = idx & 63; const int ci_ = ((l * 16 + g) * 16 + h) * 64 + p; cc[idx * 2] = P.in[I_CRE][ci_]; cc[idx * 2 + 1] = P.in[I_CIM][ci_]; }
    __syncthreads();
    bf16_t* KM = (bf16_t*)(tb + T_KMAT) + (size_t)g * 32 * 256;
    for (int idx = tid; idx < 15 * 256; idx += NTHREADS) KM[idx] = (bf16_t)0; bf16_t* FT = (bf16_t*)(tb + T_F) + (size_t)g * 256 * 128; bf16_t* GT = (bf16_t*)(tb + T_G) + (size_t)g * 128 * 256;
    for (int idx = tid; idx < 16 * 256; idx += NTHREADS) { const int tau = idx >> 8, h = (idx >> 4) & 15, hp = idx & 15; float s = 0.f;
        for (int p = 0; p < 64; ++p) { const float cr = cc[(h * 64 + p) * 2], ci = cc[(h * 64 + p) * 2 + 1], ar = apw[(tau * 64 + p) * 2], ai = apw[(tau * 64 + p) * 2 + 1], br = bb[(p * 16 + hp) * 2], bi = bb[(p * 16 + hp) * 2 + 1];
            const float er = ar * br - ai * bi, ei = ar * bi + ai * br; s += cr * er - ci * ei; }
        KM[15 * 256 + idx] = ml::bf1(s); }
    for (int idx = tid; idx < 256 * 64; idx += NTHREADS) { const int n = idx >> 6, p = idx & 63, t = n >> 4, h = n & 15;
        const float cr = cc[(h * 64 + p) * 2], ci = cc[(h * 64 + p) * 2 + 1], ar = apw[((t + 1) * 64 + p) * 2], ai = apw[((t + 1) * 64 + p) * 2 + 1];
        FT[(size_t)n * 128 + p] = ml::bf1(cr * ar - ci * ai); FT[(size_t)n * 128 + 64 + p] = ml::bf1(-(cr * ai + ci * ar)); }
    for (int idx = tid; idx < 64 * 256; idx += NTHREADS) { const int p = idx >> 8, k = idx & 255, s = k >> 4, hp = k & 15;
        const float ar = apw[((15 - s) * 64 + p) * 2], ai = apw[((15 - s) * 64 + p) * 2 + 1], br = bb[(p * 16 + hp) * 2], bi = bb[(p * 16 + hp) * 2 + 1];
        GT[(size_t)p * 256 + k] = ml::bf1(ar * br - ai * bi); GT[(size_t)(64 + p) * 256 + k] = ml::bf1(ar * bi + ai * br); }
}
__device__ __forceinline__ void load_u_frags(const bf16_t* z, int tok0, int g, int r, int qd, bf16x8 (&uf)[8]) {
#pragma unroll
    for (int ks = 0; ks < 8; ++ks) uf[ks] = *(const bf16x8*)(z + (size_t)(tok0 + 16 * r + 2 * ks + (qd >> 1)) * ZW + ZSU + 16 * g + 8 * (qd & 1));
}
__device__ __forceinline__ void p1_unit(const bf16_t* z, const unsigned char* tb, int u, unsigned char* wss) {
    const int tid = tid_opaque(), lane = tid & 63, wid = __builtin_amdgcn_readfirstlane(tid >> 6), r = lane & 15, qd = lane >> 4;
    const int tok0 = u * 256, inst0 = u * 16;
    float* E = (float*)(wss + O_E);
#pragma unroll 1
    for (int gi = 0; gi < 2; ++gi) { const int g = 2 * wid + gi;
        bf16x8 uf[8]; load_u_frags(z, tok0, g, r, qd, uf);
        const bf16_t* GT = (const bf16_t*)(tb + T_G) + (size_t)g * 128 * 256 + (size_t)r * 256 + 8 * qd;
        bf16x8 gf[2][8];
#pragma unroll
        for (int ks = 0; ks < 8; ++ks) gf[0][ks] = *(const bf16x8*)(GT + 32 * ks);
#pragma unroll
        for (int nt = 0; nt < 8; ++nt) {
            if (nt + 1 < 8) {
#pragma unroll
                for (int ks = 0; ks < 8; ++ks) gf[(nt + 1) & 1][ks] = *(const bf16x8*)(GT + (size_t)(16 * (nt + 1)) * 256 + 32 * ks); }
            __builtin_amdgcn_sched_barrier(0);
            f32x4 acc = {0.f, 0.f, 0.f, 0.f};
#pragma unroll
            for (int ks = 0; ks < 8; ++ks) acc = mfma16(gf[nt & 1][ks], uf[ks], acc);
            *(f32x4*)(E + ((size_t)(inst0 + r) * 16 + g) * 128 + 16 * nt + 4 * qd) = acc;
            __builtin_amdgcn_sched_barrier(0); }
    }
}
__device__ __forceinline__ void p2_scan(LAS unsigned char* lds, const unsigned char* tb, unsigned char* wss) {
    const int tid = tid_opaque(), p = tid & 63, seg = tid >> 6;
    const float* __restrict__ E = (const float*)(wss + O_E); bf16_t* __restrict__ XC = (bf16_t*)(wss + O_XC);
    LAS float* SE = (LAS float*)lds;
    for (int u = blockIdx.x; u < NB * 16; u += gridDim.x) {
        const int b = u >> 4, g = u & 15;
        const float* a16 = (const float*)(tb + T_A16) + (size_t)(g * 64 + p) * 2; const float ar = a16[0], ai = a16[1];
        const size_t o0 = ((size_t)(b * (S / LC) + seg * 64) * 16 + g) * 128 + p; constexpr size_t cs = (size_t)16 * 128;
        float xr = 0.f, xi = 0.f;
#pragma unroll 1
        for (int c0 = 0; c0 < 64; c0 += 16) { float er[16], ei[16];
#pragma unroll
            for (int i = 0; i < 16; ++i) { er[i] = E[o0 + (c0 + i) * cs]; ei[i] = E[o0 + (c0 + i) * cs + 64]; }
#pragma unroll
            for (int i = 0; i < 16; ++i) { const float nr = ar * xr - ai * xi + er[i], ni = ar * xi + ai * xr + ei[i]; xr = nr; xi = ni; } }
        __syncthreads();
        SE[(seg * 64 + p) * 2] = xr; SE[(seg * 64 + p) * 2 + 1] = xi;
        __syncthreads();
        float br = ar, bi = ai;
#pragma unroll
        for (int i = 0; i < 6; ++i) { const float nr = br * br - bi * bi, ni = 2.f * br * bi; br = nr; bi = ni; }
        xr = 0.f; xi = 0.f;
        for (int s2 = 0; s2 < seg; ++s2) { const float er = SE[(s2 * 64 + p) * 2], ei = SE[(s2 * 64 + p) * 2 + 1]; const float nr = br * xr - bi * xi + er, ni = br * xi + bi * xr + ei; xr = nr; xi = ni; }
#pragma unroll 1
        for (int c0 = 0; c0 < 64; c0 += 16) { float er[16], ei[16]; unsigned short sr[16], si[16];
#pragma unroll
            for (int i = 0; i < 16; ++i) { er[i] = E[o0 + (c0 + i) * cs]; ei[i] = E[o0 + (c0 + i) * cs + 64]; }
#pragma unroll
            for (int i = 0; i < 16; ++i) { sr[i] = ml::bf1(xr); si[i] = ml::bf1(xi); const float nr = ar * xr - ai * xi + er[i], ni = ar * xi + ai * xr + ei[i]; xr = nr; xi = ni; }
#pragma unroll
            for (int i = 0; i < 16; ++i) { XC[o0 + (c0 + i) * cs] = sr[i]; XC[o0 + (c0 + i) * cs + 64] = si[i]; } }
    }
    __syncthreads();
}
__device__ __forceinline__ void p3_unit(LAS unsigned char* lds, const bf16_t* z, const Params& P, int l, const unsigned char* tb, int u, const unsigned char* wss, bf16_t* mix) {
    const int tid = tid_opaque(), lane = tid & 63, wid = __builtin_amdgcn_readfirstlane(tid >> 6), r = lane & 15, qd = lane >> 4;
    const int tok0 = u * 256, inst0 = u * 16;
    const bf16_t* XC = (const bf16_t*)(wss + O_XC);
    __syncthreads();
#pragma unroll 1
    for (int gi = 0; gi < 2; ++gi) { const int g = 2 * wid + gi;
        bf16x8 uf[8]; load_u_frags(z, tok0, g, r, qd, uf);
        bf16x8 xf[4];
#pragma unroll
        for (int ks = 0; ks < 4; ++ks) xf[ks] = *(const bf16x8*)(XC + ((size_t)(inst0 + r) * 16 + g) * 128 + 32 * ks + 8 * qd);
        const bf16_t* KM = (const bf16_t*)(tb + T_KMAT) + (size_t)g * 32 * 256 + (size_t)(15 - (qd >> 1)) * 256 + r * 16 + 8 * (qd & 1);
        const bf16_t* FT = (const bf16_t*)(tb + T_F) + (size_t)g * 256 * 128 + (size_t)r * 128 + 8 * qd;
        const bf16_t* up = z + (size_t)(tok0 + 16 * r) * ZW + ZSU + 16 * g + 4 * qd;
        const float4 dsk = *(const float4*)(P.in[I_SD] + l * 256 + g * 16 + 4 * qd);
        bf16x8 kf[2][8], ff[2][4]; u32x2 uw[2];
#pragma unroll
        for (int ks = 0; ks < 8; ++ks) kf[0][ks] = *(const bf16x8*)(KM + (ptrdiff_t)(0 - 2 * ks) * 256);
#pragma unroll
        for (int ks = 0; ks < 4; ++ks) ff[0][ks] = *(const bf16x8*)(FT + 32 * ks);
        uw[0] = *(const u32x2*)up;
#pragma unroll
        for (int t = 0; t < 16; ++t) {
            if (t + 1 < 16) {
#pragma unroll
                for (int ks = 0; ks < 8; ++ks) kf[(t + 1) & 1][ks] = *(const bf16x8*)(KM + (ptrdiff_t)(t + 1 - 2 * ks) * 256);
#pragma unroll
                for (int ks = 0; ks < 4; ++ks) ff[(t + 1) & 1][ks] = *(const bf16x8*)(FT + (size_t)(t + 1) * 16 * 128 + 32 * ks);
                uw[(t + 1) & 1] = *(const u32x2*)(up + (size_t)(t + 1) * ZW); }
            __builtin_amdgcn_sched_barrier(0);
            f32x4 acc = {0.f, 0.f, 0.f, 0.f};
#pragma unroll
            for (int ks = 0; ks < 8; ++ks) if (2 * ks <= t) acc = mfma16(kf[t & 1][ks], uf[ks], acc);
#pragma unroll
            for (int ks = 0; ks < 4; ++ks) acc = mfma16(ff[t & 1][ks], xf[ks], acc);
            const u32x2 uu = uw[t & 1];
            const float y0 = gelu_tanh(acc[0] + dsk.x * ml::bf_lo(uu.x)), y1 = gelu_tanh(acc[1] + dsk.y * ml::bf_hi(uu.x)), y2 = gelu_tanh(acc[2] + dsk.z * ml::bf_lo(uu.y)), y3 = gelu_tanh(acc[3] + dsk.w * ml::bf_hi(uu.y));
            u32x2 o; o.x = pg8::cvt_pk_bf16(y0, y1); o.y = pg8::cvt_pk_bf16(y2, y3);
            *(LAS u32x2*)(lds + (16 * r + t) * YP + (16 * g + 4 * qd) * 2) = o;
            __builtin_amdgcn_sched_barrier(0); }
    }
    __syncthreads();
    const bf16_t* GW = (const bf16_t*)(tb + T_GLUW);
    bf16x8 wf[2][8];
#pragma unroll
    for (int nt = 0; nt < 2; ++nt)
#pragma unroll
        for (int ks = 0; ks < 8; ++ks) wf[nt][ks] = *(const bf16x8*)(GW + (size_t)(32 * wid + 16 * nt + r) * 256 + 32 * ks + 8 * qd);
    const float* gb = P.in[I_GLUB] + l * 256;
    const float4 gb0 = *(const float4*)(gb + 32 * wid + 4 * qd), gb1 = *(const float4*)(gb + 32 * wid + 16 + 4 * qd);
#pragma unroll 2
    for (int mt = 0; mt < 16; ++mt) {
        f32x4 a0 = {0.f, 0.f, 0.f, 0.f}, a1 = {0.f, 0.f, 0.f, 0.f};
#pragma unroll
        for (int ks = 0; ks < 8; ++ks) { const bf16x8 yf = *(const LAS bf16x8*)(lds + (16 * mt + r) * YP + (32 * ks + 8 * qd) * 2); a0 = mfma16(wf[0][ks], yf, a0); a1 = mfma16(wf[1][ks], yf, a1); }
        const int row = 16 * mt + r;
        const u32x2 y0 = *(const LAS u32x2*)(lds + row * YP + (32 * wid + 4 * qd) * 2), y1 = *(const LAS u32x2*)(lds + row * YP + (32 * wid + 16 + 4 * qd) * 2);
        bf16_t* op = mix + (size_t)(tok0 + row) * D + 256 + 32 * wid + 4 * qd;
        u32x2 o;
        o.x = pg8::cvt_pk_bf16(ml::bf_lo(y0.x) * rsig(a0[0] + gb0.x), ml::bf_hi(y0.x) * rsig(a0[1] + gb0.y));
        o.y = pg8::cvt_pk_bf16(ml::bf_lo(y0.y) * rsig(a0[2] + gb0.z), ml::bf_hi(y0.y) * rsig(a0[3] + gb0.w));
        *(u32x2*)op = o;
        o.x = pg8::cvt_pk_bf16(ml::bf_lo(y1.x) * rsig(a1[0] + gb1.x), ml::bf_hi(y1.x) * rsig(a1[1] + gb1.y));
        o.y = pg8::cvt_pk_bf16(ml::bf_lo(y1.y) * rsig(a1[2] + gb1.z), ml::bf_hi(y1.y) * rsig(a1[3] + gb1.w));
        *(u32x2*)(op + 16) = o;
    }
}
static_assert(T_LAYER <= 4 * MiB && O_END <= 48 * MiB && 256 * YP <= LDS_BYTES - 64, "S5 scratch fits");
}
__device__ __forceinline__ void s5_build_tables_fwd(float* ldsf, const Params& P, int l, int g, unsigned char* tb) { s5::build_tables(ldsf, P, l, g, tb); }

namespace at {
using pg8::bf16x8; using pg8::f32x4; using pg8::u32x4; using pg8::u32x2;
constexpr int KP = 144, OFF_K = 0, OFF_V = 256 * KP, LDS_END = OFF_V + 256 * KP;
__device__ __forceinline__ void unit(LAS unsigned char* lds, const bf16_t* z, const float* sinks, bf16_t* mix, int u) {
    const int tid = tid_opaque(), lane = tid & 63, wid = __builtin_amdgcn_readfirstlane(tid >> 6), r = lane & 15, qd = lane >> 4;
    const int b = u >> 7, g = (u >> 6) & 1, n = u & 63, tokb = b * S + 128 * n;
    const int hq = 2 * g + (wid >> 2);
    const float sink = sinks[hq];
    __syncthreads();
    u32x4 kw[4], vw[4];
#pragma unroll
    for (int it = 0; it < 4; ++it) { const int idx = tid + it * NTHREADS, kl = idx >> 3, cg = idx & 7; const bool ok = (n > 0) || (kl >= 128);
        kw[it] = *(const u32x4*)(z + (size_t)(ok ? tokb - 128 + kl : tokb) * ZW + ZK + g * 64 + cg * 8); }
#pragma unroll
    for (int it = 0; it < 4; ++it) { const int idx = tid + it * NTHREADS, kl = idx >> 3, cg = idx & 7; const bool ok = (n > 0) || (kl >= 128);
        vw[it] = *(const u32x4*)(z + (size_t)(ok ? tokb - 128 + kl : tokb) * ZW + ZV + g * 64 + cg * 8); }
    __builtin_amdgcn_sched_barrier(0);
#pragma unroll
    for (int it = 0; it < 4; ++it) { const int idx = tid + it * NTHREADS, kl = idx >> 3, cg = idx & 7; const bool ok = (n > 0) || (kl >= 128);
        u32x4 w = kw[it]; if (!ok) w = (u32x4){0u, 0u, 0u, 0u};
        *(LAS u32x4*)(lds + OFF_K + kl * KP + cg * 16) = w; }
#pragma unroll
    for (int it = 0; it < 4; ++it) { const int idx = tid + it * NTHREADS, kl = idx >> 3, cg = idx & 7; const bool ok = (n > 0) || (kl >= 128);
        u32x4 w = vw[it]; if (!ok) w = (u32x4){0u, 0u, 0u, 0u};
        *(LAS u32x4*)(lds + OFF_V + kl * KP + cg * 16) = w; }
    __syncthreads();
#pragma unroll 1
    for (int qt = 0; qt < 2; ++qt) {
        const int i0 = (wid & 3) * 32 + qt * 16, kt0 = i0 >> 4, tok = tokb + i0 + r;
        const bf16x8 bq0 = *(const bf16x8*)(z + (size_t)tok * ZW + ZQ + hq * 64 + 8 * qd), bq1 = *(const bf16x8*)(z + (size_t)tok * ZW + ZQ + hq * 64 + 32 + 8 * qd);
        f32x4 accS[9];
#pragma unroll
        for (int c = 0; c < 9; ++c) { const int kt = kt0 + c;
            const bf16x8 a0 = *(const LAS bf16x8*)(lds + OFF_K + (16 * kt + r) * KP + qd * 16), a1 = *(const LAS bf16x8*)(lds + OFF_K + (16 * kt + r) * KP + 64 + qd * 16);
            accS[c] = ml::mfma16(a0, bq0, (f32x4){0.f, 0.f, 0.f, 0.f}); accS[c] = ml::mfma16(a1, bq1, accS[c]); }
        float m = sink;
#pragma unroll
        for (int c = 0; c < 9; ++c)
#pragma unroll
            for (int j = 0; j < 4; ++j) { const int e = 4 * qd + j;
                bool valid = (c == 0) ? (e > r) : ((c == 8) ? (e <= r) : true);
                valid = valid && ((n > 0) || (kt0 + c >= 8));
                const float s = valid ? accS[c][j] * 0.125f : -3.0e38f; accS[c][j] = s; m = fmaxf(m, s); }
        m = fmaxf(m, __shfl_xor(m, 16)); m = fmaxf(m, __shfl_xor(m, 32));
        float l = 0.f;
#pragma unroll
        for (int c = 0; c < 9; ++c)
#pragma unroll
            for (int j = 0; j < 4; ++j) { const float p = __expf(accS[c][j] - m); accS[c][j] = p; l += p; }
        l += __shfl_xor(l, 16); l += __shfl_xor(l, 32);
        l += __expf(sink - m);
        f32x4 accO[4];
#pragma unroll
        for (int dt = 0; dt < 4; ++dt) accO[dt] = (f32x4){0.f, 0.f, 0.f, 0.f};
#pragma unroll
        for (int kk = 0; kk < 5; ++kk) {
            u32x4 pw; pw.x = pg8::cvt_pk_bf16(accS[2 * kk][0], accS[2 * kk][1]); pw.y = pg8::cvt_pk_bf16(accS[2 * kk][2], accS[2 * kk][3]);
            if (kk < 4) { pw.z = pg8::cvt_pk_bf16(accS[2 * kk + 1][0], accS[2 * kk + 1][1]); pw.w = pg8::cvt_pk_bf16(accS[2 * kk + 1][2], accS[2 * kk + 1][3]); } else { pw.z = 0u; pw.w = 0u; }
            const bf16x8 pf = __builtin_bit_cast(bf16x8, pw);
            const int base = 16 * (kt0 + 2 * kk);
#pragma unroll
            for (int dt = 0; dt < 4; ++dt) { const LAS unsigned char* vp = lds + OFF_V + (base + 4 * qd + (r >> 2)) * KP + (16 * dt + 4 * (r & 3)) * 2;
                const u32x2_t v0 = lds_tr4(vp);
                u32x2_t v1 = {0u, 0u}; if (kk < 4) v1 = lds_tr4(vp + 16 * KP);
                u32x4 vw; vw.x = v0.x; vw.y = v0.y; vw.z = v1.x; vw.w = v1.y;
                accO[dt] = ml::mfma16(__builtin_bit_cast(bf16x8, vw), pf, accO[dt]); } }
        const float inv = 1.f / l;
        bf16_t* op = mix + (size_t)tok * D + hq * 64;
#pragma unroll
        for (int dt = 0; dt < 4; ++dt) { u32x2 o; o.x = pg8::cvt_pk_bf16(accO[dt][0] * inv, accO[dt][1] * inv); o.y = pg8::cvt_pk_bf16(accO[dt][2] * inv, accO[dt][3] * inv);
            *(u32x2*)(op + 16 * dt + 4 * qd) = o; }
    }
}
}

namespace sg {
using pg8::bf16x8; using pg8::f32x4; using pg8::u32x4; using pg8::u32x2;
constexpr int VP = 528, OFF_V = 0, OFF_ST = 128 * VP, LDS_END = OFF_ST + 128 * 4 * 2 * 4;
__device__ __forceinline__ void unit(LAS unsigned char* lds, const bf16_t* z, const Params& P, int l, const bf16_t* wb  , bf16_t* mix, int u) {
    const int tid = tid_opaque(), lane = tid & 63, wid = __builtin_amdgcn_readfirstlane(tid >> 6), r = lane & 15, qd = lane >> 4;
    const int tok0 = u * 128;
    LAS float* ST = (LAS float*)(lds + OFF_ST);
    __syncthreads();
    const int s = tid & 127, cq = tid >> 7;
    const bf16_t* gp = z + (size_t)(tok0 + s) * ZW + ZGV + cq * 64;
    u32x4 raw[8];
#pragma unroll
    for (int i = 0; i < 8; ++i) raw[i] = *(const u32x4*)(gp + 8 * i);
    const int t = 16 * wid + r;
    bf16x8 wf[2][4];
#pragma unroll
    for (int ks = 0; ks < 4; ++ks) wf[0][ks] = *(const bf16x8*)(wb + (size_t)t * 128 + 32 * ks + 8 * qd);
    float sm = 0.f, sq = 0.f;
#pragma unroll
    for (int i = 0; i < 8; ++i) { const unsigned ww[4] = {raw[i].x, raw[i].y, raw[i].z, raw[i].w};
#pragma unroll
        for (int e = 0; e < 8; ++e) { const float ge = gelu_tanh((e & 1) ? bfh(ww[e >> 1]) : bfl(ww[e >> 1])); sm += ge; sq += ge * ge; } }
    ST[(s * 4 + cq) * 2] = sm; ST[(s * 4 + cq) * 2 + 1] = sq;
    __syncthreads();
    { float tsm = 0.f, tsq = 0.f;
#pragma unroll
      for (int q = 0; q < 4; ++q) { tsm += ST[(s * 4 + q) * 2]; tsq += ST[(s * 4 + q) * 2 + 1]; }
      const float mu = tsm * (1.f / 256.f), var = fmaxf(tsq * (1.f / 256.f) - mu * mu, 0.f), rs = rsqrtf(var + EPS);
      const float* lg = P.in[I_LNG] + l * 256 + cq * 64; const float* lb = P.in[I_LNB] + l * 256 + cq * 64;
#pragma unroll
      for (int i = 0; i < 8; ++i) { const unsigned ww[4] = {raw[i].x, raw[i].y, raw[i].z, raw[i].w};
          const float4 g0 = *(const float4*)(lg + 8 * i), g1 = *(const float4*)(lg + 8 * i + 4), b0 = *(const float4*)(lb + 8 * i), b1 = *(const float4*)(lb + 8 * i + 4);
          const float gg[8] = {g0.x, g0.y, g0.z, g0.w, g1.x, g1.y, g1.z, g1.w}, bb[8] = {b0.x, b0.y, b0.z, b0.w, b1.x, b1.y, b1.z, b1.w};
          float o[8];
#pragma unroll
          for (int e = 0; e < 8; ++e) o[e] = (gelu_tanh((e & 1) ? bfh(ww[e >> 1]) : bfl(ww[e >> 1])) - mu) * rs * gg[e] + bb[e];
          u32x4 w; w.x = pg8::cvt_pk_bf16(o[0], o[1]); w.y = pg8::cvt_pk_bf16(o[2], o[3]); w.z = pg8::cvt_pk_bf16(o[4], o[5]); w.w = pg8::cvt_pk_bf16(o[6], o[7]);
          *(LAS u32x4*)(lds + OFF_V + s * VP + (cq * 64 + 8 * i) * 2) = w; } }
    __syncthreads();
    const LAS unsigned char* vtr = lds + OFF_V + (8 * qd + (r >> 2)) * VP + (4 * (r & 3)) * 2;
#pragma unroll
    for (int g = 0; g < 4; ++g) {
        if (g + 1 < 4) {
#pragma unroll
            for (int ks = 0; ks < 4; ++ks) wf[(g + 1) & 1][ks] = *(const bf16x8*)(wb + ((size_t)(g + 1) * 128 + t) * 128 + 32 * ks + 8 * qd); }
        const float bias = P.in[I_SGUB][l * 512 + g * 128 + t];
        u32x2 gw[4];
#pragma unroll
        for (int ct = 0; ct < 4; ++ct) gw[ct] = *(const u32x2*)(z + (size_t)(tok0 + t) * ZW + ZGU + g * 64 + 16 * ct + 4 * qd);
#pragma unroll
        for (int ct = 0; ct < 4; ++ct) { f32x4 acc = {0.f, 0.f, 0.f, 0.f};
#pragma unroll
            for (int ks = 0; ks < 4; ++ks) if (2 * ks <= wid) { const LAS unsigned char* ap = vtr + (32 * ks) * VP + (g * 64 + 16 * ct) * 2;
                const u32x2_t a0 = lds_tr4(ap), a1 = lds_tr4(ap + 4 * VP); const u32x4 aw = {a0.x, a0.y, a1.x, a1.y};
                acc = ml::mfma16(__builtin_bit_cast(bf16x8, aw), wf[g & 1][ks], acc); }
            const int c0 = g * 64 + 16 * ct + 4 * qd;
            u32x2 o; o.x = pg8::cvt_pk_bf16(gelu_tanh(bfl(gw[ct].x)) * (acc[0] + bias), gelu_tanh(bfh(gw[ct].x)) * (acc[1] + bias)); o.y = pg8::cvt_pk_bf16(gelu_tanh(bfl(gw[ct].y)) * (acc[2] + bias), gelu_tanh(bfh(gw[ct].y)) * (acc[3] + bias));
            *(u32x2*)(mix + (size_t)(tok0 + t) * D + 768 + c0) = o; }
    }
}
}

__device__ __forceinline__ void ph_mix1(float* lds, const Params& P, int l, bf16_t* z, const float* gates, bf16_t* mix, unsigned char* wsm, unsigned char* wss, const unsigned char* tb, int sub) {
    const int G = gridDim.x, bid = blockIdx.x;
    if (sub & 1) for (int u = bid; u < ml::NU; u += G) ml::p1_unit((LAS unsigned char*)lds, z, gates, P, l, u, wsm);
    __syncthreads();
    if (sub & 2) for (int u = bid; u < NTOK / 256; u += G) s5::p1_unit(z, tb, u, wss);
    __syncthreads();
    if (sub & 4) for (int u = bid; u < 1024; u += G) at::unit((LAS unsigned char*)lds, z, P.in[I_SINK] + l * 4, mix, u);
    __syncthreads();
    if (sub & 8) for (int u = bid; u < NTOK / 128; u += G) sg::unit((LAS unsigned char*)lds, z, P, l, (const bf16_t*)(tb + s5::T_SGUW), mix, u);
    __syncthreads();
}

__device__ __forceinline__ void ph_mix2(float* lds, const Params& P, int l, const bf16_t* z, const float* gates, bf16_t* mix, const unsigned char* wsm, const unsigned char* wss, const unsigned char* tb, int sub) {
    if (sub & 1) for (int u = blockIdx.x; u < NTOK / 256; u += gridDim.x) s5::p3_unit((LAS unsigned char*)lds, z, P, l, tb, u, wss, mix);
    __syncthreads();
    if (sub & 2) for (int u = blockIdx.x; u < ml::NU; u += gridDim.x) ml::p3_unit((LAS unsigned char*)lds, z, gates, P, l, u, wsm, mix);
    __syncthreads();
}

template <bool SRCF32>
__device__ __forceinline__ void ph_outproj(LAS unsigned char* ldsb, const bf16_t* mix, const bf16_t* wt, const float* xf, bf16_t* xb) {
    pg8::StaticOrder S; S.init(NTOK, D, D, D, gridDim.x, blockIdx.x, mix, wt);
    pg8::EpiResB<SRCF32> E{xf, xb};
    pg8::gemm_phase<pg8::EpiResB<SRCF32>, pg8::StaticOrder, false>(ldsb, D, D, S, E);
}

namespace rp {
using pg8::bf16x8; using pg8::f32x4; using pg8::u32x4;
constexpr size_t T_HI = 0, T_LO = (size_t)48 * D * 2, T_GHI = 2 * T_LO, T_GLO = T_GHI + (size_t)16 * D * 2, T_SIZE = T_GLO + (size_t)16 * D * 2;
static_assert(T_SIZE <= 256 * 1024, "row-pass tables fit their slot");
template <int NT, bool COMBINE> struct StepIn { float4 xa[2], xb[2]; u32x4 xr[2]; u32x4 y1[2], y2[2]; float4 g0, g1; };
template <int NT> struct StepW { bf16x8 wh[NT], wl[NT]; };
__device__ __forceinline__ void build_base(LAS int* base, const unsigned* cnt) {
    __syncthreads();
    if (tid_opaque() == 0) { int b = 0; for (int e = 0; e < NEXP; ++e) { base[e] = b; b += (((int)cnt[e] + 255) >> 8) << 8; } }
    __syncthreads();
}
template <int NT, bool COMBINE, bool XBF>
__device__ __forceinline__ void run(LAS unsigned char* lds, const Params& P, int l, const float* x, bf16_t* xq, const bf16_t* YB, const unsigned* inv, const unsigned* cntprev,
                                    const float* gn, const bf16_t* WH, const bf16_t* WL, bf16_t* XN, float* RS, float* gates, unsigned* cnt, int2* lists, unsigned* invout) {
    const int tid = tid_opaque(), lane = tid & 63, wid = __builtin_amdgcn_readfirstlane(tid >> 6), r = lane & 15, qd = lane >> 4;
    LAS int* BASE = (LAS int*)(lds + 64 * 1024);
    LAS float* LG = (LAS float*)lds + wid * (32 * 49);
    if (COMBINE) build_base(BASE, cntprev);
    LAS unsigned* LCNT = (LAS unsigned*)(lds + 64 * 1024 + 256); LAS unsigned* GBASE = LCNT + 32;
    for (int rb0 = blockIdx.x * 8; rb0 < NTOK / 32; rb0 += gridDim.x * 8) {
        const int rb = rb0 + wid; const bool live = rb < NTOK / 32;
        const int row0 = (live ? rb : rb0) * 32;
        if (NT == 1 && !live) continue;
        size_t yr1[2] = {0, 0}, yr2[2] = {0, 0};
        if (COMBINE) {
#pragma unroll
            for (int mt = 0; mt < 2; ++mt) { const int row = row0 + 16 * mt + r; const unsigned i1 = inv[2 * row], i2 = inv[2 * row + 1];
                yr1[mt] = (size_t)(BASE[i1 >> 16] + (int)(i1 & 0xffffu)) * D; yr2[mt] = (size_t)(BASE[i2 >> 16] + (int)(i2 & 0xffffu)) * D; } }
        f32x4 acc[2][NT];
#pragma unroll
        for (int mt = 0; mt < 2; ++mt)
#pragma unroll
            for (int nt = 0; nt < NT; ++nt) acc[mt][nt] = (f32x4){0.f, 0.f, 0.f, 0.f};
        float ssq[2] = {0.f, 0.f};
        StepIn<NT, COMBINE> sb[3]; StepW<NT> sw[2];
        auto load = [&](StepIn<NT, COMBINE>& s, int ks) {
            const int k0 = 32 * ks + 8 * qd;
#pragma unroll
            for (int mt = 0; mt < 2; ++mt) {
                if (XBF) s.xr[mt] = *(const u32x4*)(xq + (size_t)(row0 + 16 * mt + r) * D + k0);
                else { const float* xp = x + (size_t)(row0 + 16 * mt + r) * D + k0; s.xa[mt] = *(const float4*)xp; s.xb[mt] = *(const float4*)(xp + 4); }
                if (COMBINE) { s.y1[mt] = *(const u32x4*)(YB + yr1[mt] + k0); s.y2[mt] = *(const u32x4*)(YB + yr2[mt] + k0); } }
            s.g0 = *(const float4*)(gn + k0); s.g1 = *(const float4*)(gn + k0 + 4);
        };
        auto loadw = [&](StepW<NT>& s, int ks) {
            const int k0 = 32 * ks + 8 * qd;
#pragma unroll
            for (int nt = 0; nt < NT; ++nt) { s.wh[nt] = *(const bf16x8*)(WH + (size_t)(16 * nt + r) * D + k0); s.wl[nt] = *(const bf16x8*)(WL + (size_t)(16 * nt + r) * D + k0); }
        };
        auto process = [&](const StepIn<NT, COMBINE>& s, const StepW<NT>& sw_, int ks) {
            const int k0 = 32 * ks + 8 * qd;
            bf16x8 xh[2], xl[2];
#pragma unroll
            for (int mt = 0; mt < 2; ++mt) { float4 a = s.xa[mt], b = s.xb[mt];
                if (XBF) { const u32x4 w = s.xr[mt]; a = make_float4(bfl(w.x), bfh(w.x), bfl(w.y), bfh(w.y)); b = make_float4(bfl(w.z), bfh(w.z), bfl(w.w), bfh(w.w)); }
                if (COMBINE) { const u32x4 p = s.y1[mt], q = s.y2[mt];
                    a.x += bfl(p.x) + bfl(q.x); a.y += bfh(p.x) + bfh(q.x); a.z += bfl(p.y) + bfl(q.y); a.w += bfh(p.y) + bfh(q.y);
                    b.x += bfl(p.z) + bfl(q.z); b.y += bfh(p.z) + bfh(q.z); b.z += bfl(p.w) + bfl(q.w); b.w += bfh(p.w) + bfh(q.w);
                    u32x4 o; o.x = pg8::cvt_pk_bf16(a.x, a.y); o.y = pg8::cvt_pk_bf16(a.z, a.w); o.z = pg8::cvt_pk_bf16(b.x, b.y); o.w = pg8::cvt_pk_bf16(b.z, b.w);
                    *(u32x4*)(xq + (size_t)(row0 + 16 * mt + r) * D + k0) = o;
                    a = make_float4(bfl(o.x), bfh(o.x), bfl(o.y), bfh(o.y)); b = make_float4(bfl(o.z), bfh(o.z), bfl(o.w), bfh(o.w)); }
                ssq[mt] += a.x * a.x + a.y * a.y + a.z * a.z + a.w * a.w + b.x * b.x + b.y * b.y + b.z * b.z + b.w * b.w;
                const float v[8] = {a.x * s.g0.x, a.y * s.g0.y, a.z * s.g0.z, a.w * s.g0.w, b.x * s.g1.x, b.y * s.g1.y, b.z * s.g1.z, b.w * s.g1.w};
                u32x4 h; h.x = pg8::cvt_pk_bf16(v[0], v[1]); h.y = pg8::cvt_pk_bf16(v[2], v[3]); h.z = pg8::cvt_pk_bf16(v[4], v[5]); h.w = pg8::cvt_pk_bf16(v[6], v[7]);
                *(u32x4*)(XN + (size_t)(row0 + 16 * mt + r) * D + k0) = h;
                u32x4 lo; lo.x = pg8::cvt_pk_bf16(v[0] - bfl(h.x), v[1] - bfh(h.x)); lo.y = pg8::cvt_pk_bf16(v[2] - bfl(h.y), v[3] - bfh(h.y)); lo.z = pg8::cvt_pk_bf16(v[4] - bfl(h.z), v[5] - bfh(h.z)); lo.w = pg8::cvt_pk_bf16(v[6] - bfl(h.w), v[7] - bfh(h.w));
                xh[mt] = __builtin_bit_cast(bf16x8, h); xl[mt] = __builtin_bit_cast(bf16x8, lo); }
#pragma unroll
            for (int nt = 0; nt < NT; ++nt)
#pragma unroll
                for (int mt = 0; mt < 2; ++mt) { acc[mt][nt] = ml::mfma16(sw_.wh[nt], xh[mt], acc[mt][nt]); acc[mt][nt] = ml::mfma16(sw_.wl[nt], xh[mt], acc[mt][nt]); acc[mt][nt] = ml::mfma16(sw_.wh[nt], xl[mt], acc[mt][nt]); }
        };
        if (COMBINE || NT > 1) {
            load(sb[0], 0); loadw(sw[0], 0);
#pragma unroll 1
            for (int ks = 0; ks < 32; ks += 2) {
                load(sb[1], ks + 1); loadw(sw[1], ks + 1);
                process(sb[0], sw[0], ks);
                if (ks + 2 < 32) { load(sb[0], ks + 2); loadw(sw[0], ks + 2); }
                process(sb[1], sw[1], ks + 1);
            }
        } else {
            load(sb[0], 0); load(sb[1], 1); loadw(sw[0], 0);
#define RP_STEP(i, xs, ws) do { if ((i) + 2 < 32) load(sb[((xs) + 2) % 3], (i) + 2); if ((i) + 1 < 32) loadw(sw[((ws) + 1) % 2], (i) + 1); process(sb[xs], sw[ws], (i)); } while (0)
#pragma unroll 1
            for (int ks = 0; ks < 30; ks += 6) { RP_STEP(ks, 0, 0); RP_STEP(ks + 1, 1, 1); RP_STEP(ks + 2, 2, 0); RP_STEP(ks + 3, 0, 1); RP_STEP(ks + 4, 1, 0); RP_STEP(ks + 5, 2, 1); }
            RP_STEP(30, 0, 0); RP_STEP(31, 1, 1);
#undef RP_STEP
        }
        float rsv[2];
#pragma unroll
        for (int mt = 0; mt < 2; ++mt) { float s = ssq[mt]; s += __shfl_xor(s, 16); s += __shfl_xor(s, 32); rsv[mt] = rsqrtf(s * (1.f / D) + EPS);
            if (qd == 0) RS[row0 + 16 * mt + r] = rsv[mt]; }
        if (NT == 1) {
#pragma unroll
            for (int mt = 0; mt < 2; ++mt) if (qd < 2) { const f32x4 gv = acc[mt][0] * rsv[mt]; *(f32x4*)(gates + (size_t)(row0 + 16 * mt + r) * 8 + 4 * qd) = gv; }
        } else {
            const float* bg = P.in[I_RGB] + l * 4; const float* be = P.in[I_REB] + l * 32;
#pragma unroll
            for (int mt = 0; mt < 2; ++mt)
#pragma unroll
                for (int nt = 0; nt < NT; ++nt)
#pragma unroll
                    for (int j = 0; j < 4; ++j) LG[(16 * mt + r) * 49 + 16 * nt + 4 * qd + j] = acc[mt][nt][j] * rsv[mt];
            wave_lds_fence();
            if (tid < 32) LCNT[tid] = 0u;
            __syncthreads();
            int ex1 = 0, ex2 = 0; float w1 = 0.f, w2 = 0.f; unsigned lp1 = 0u, lp2 = 0u;
            if (lane < 32 && live) {
                const LAS float* lg = LG + lane * 49;
                float gl[4];
#pragma unroll
                for (int j = 0; j < 4; ++j) gl[j] = lg[j] + bg[j];
                int sel = 0; float gm = gl[0];
#pragma unroll
                for (int j = 1; j < 4; ++j) if (gl[j] > gm) { gm = gl[j]; sel = j; }
                float gs = 0.f;
#pragma unroll
                for (int j = 0; j < 4; ++j) gs += expf(gl[j] - gm);
                const float pg = 1.f / gs;
                float ein[8];
#pragma unroll
                for (int j = 0; j < 8; ++j) ein[j] = lg[4 + sel * 8 + j] + be[sel * 8 + j];
                int i1 = 0; float v1 = ein[0];
#pragma unroll
                for (int j = 1; j < 8; ++j) if (ein[j] > v1) { v1 = ein[j]; i1 = j; }
                int i2 = -1; float v2 = -3.0e38f;
#pragma unroll
                for (int j = 0; j < 8; ++j) if (j != i1 && ein[j] > v2) { v2 = ein[j]; i2 = j; }
                const float e2 = expf(v2 - v1), den = 1.f / (1.f + e2);
                w1 = den * pg; w2 = e2 * den * pg;
                ex1 = sel * 8 + i1; ex2 = sel * 8 + i2;
                lp1 = atomicAdd((unsigned*)&LCNT[ex1], 1u); lp2 = atomicAdd((unsigned*)&LCNT[ex2], 1u);
            }
            __syncthreads();
            if (tid < 32) { const unsigned c = LCNT[tid]; GBASE[tid] = c ? atomicAdd(&cnt[tid], c) : 0u; }
            __syncthreads();
            if (lane < 32 && live) { const int row = row0 + lane; const unsigned p1 = GBASE[ex1] + lp1, p2 = GBASE[ex2] + lp2;
                lists[(size_t)ex1 * NTOK + p1] = make_int2(row, __float_as_int(w1));
                lists[(size_t)ex2 * NTOK + p2] = make_int2(row, __float_as_int(w2));
                invout[2 * row] = ((unsigned)ex1 << 16) | p1; invout[2 * row + 1] = ((unsigned)ex2 << 16) | p2; }
        }
    }
}
__device__ __forceinline__ void final_norm(LAS unsigned char* lds, const bf16_t* xb, float* out, const bf16_t* YB, const unsigned* inv, const unsigned* cntprev, const float* g) {
    const int tid = tid_opaque(), wave = tid >> 6, lane = tid & 63;
    LAS int* BASE = (LAS int*)(lds + 64 * 1024);
    build_base(BASE, cntprev);
    const float4* g4 = (const float4*)g;
    for (int r = blockIdx.x * 8 + wave; r < NTOK; r += gridDim.x * 8) {
        const unsigned i1 = inv[2 * r], i2 = inv[2 * r + 1];
        const bf16_t* y1 = YB + (size_t)(BASE[i1 >> 16] + (int)(i1 & 0xffffu)) * D; const bf16_t* y2 = YB + (size_t)(BASE[i2 >> 16] + (int)(i2 & 0xffffu)) * D;
        const u32x2_t* xp = (const u32x2_t*)(xb + (size_t)r * D);
        float4 v[4]; float ss = 0.f;
#pragma unroll
        for (int i = 0; i < 4; ++i) { const u32x2_t xw = xp[lane + 64 * i], a = *((const u32x2_t*)y1 + lane + 64 * i), b = *((const u32x2_t*)y2 + lane + 64 * i);
            v[i].x = bfl(xw.x) + bfl(a.x) + bfl(b.x); v[i].y = bfh(xw.x) + bfh(a.x) + bfh(b.x); v[i].z = bfl(xw.y) + bfl(a.y) + bfl(b.y); v[i].w = bfh(xw.y) + bfh(a.y) + bfh(b.y);
            ss += v[i].x * v[i].x + v[i].y * v[i].y + v[i].z * v[i].z + v[i].w * v[i].w; }
        ss = wave_sum(ss);
        const float rs = rsqrtf(ss * (1.f / D) + EPS);
        float4* p = (float4*)(out + (size_t)r * D);
#pragma unroll
        for (int i = 0; i < 4; ++i) { const float4 gg = g4[lane + 64 * i]; float4 o; o.x = v[i].x * rs * gg.x; o.y = v[i].y * rs * gg.y; o.z = v[i].z * rs * gg.z; o.w = v[i].w * rs * gg.w; p[lane + 64 * i] = o; }
    }
}
}

__device__ __forceinline__ int moe_build_tab(LAS unsigned char* ldsb, const unsigned* cnt) {
    LAS pg8::i32x4* tab = (LAS pg8::i32x4*)(ldsb + TAB_OFF);
    __syncthreads();
    int base = 0;
#pragma unroll 1
    for (int e = 0; e < NEXP; ++e) { const int c = __builtin_amdgcn_readfirstlane((int)cnt[e]), nt = (c + 255) >> 8;
        if ((int)tid_opaque() < nt) tab[base + tid_opaque()] = (pg8::i32x4){e, (int)tid_opaque() * 256, c, 0};
        base += nt; }
    __syncthreads();
    return base;
}
__device__ __forceinline__ void ph_moe1(LAS unsigned char* ldsb, const Params& P, int l, const bf16_t* H, const unsigned* cnt, const int2* lists, bf16_t* act) {
    const int ntiles = moe_build_tab(ldsb, cnt);
    pg8::MoeOrder S; S.tab = (const LAS pg8::i32x4*)(ldsb + TAB_OFF); S.ntiles = ntiles; S.npn = 4; S.G = gridDim.x; S.c = blockIdx.x;
    S.A = (const char*)H; S.atile = 0; S.Bt = (const char*)(P.ws + WS_WGU) + (size_t)l * NEXP * 1024 * D * 2; S.bexp = (size_t)1024 * D * 2; S.btile = (size_t)256 * D * 2; S.lists = lists;
    pg8::EpiAct E{act, lists, (const float*)(P.ws + WS_RS)};
    pg8::gemm_phase<pg8::EpiAct, pg8::MoeOrder, true>(ldsb, D, D, S, E);
}
__device__ __forceinline__ void ph_moe2(LAS unsigned char* ldsb, const Params& P, int l, const bf16_t* act, const unsigned* cnt, const int2* lists, bf16_t* yb) {
    const int ntiles = moe_build_tab(ldsb, cnt);
    pg8::MoeOrder S; S.tab = (const LAS pg8::i32x4*)(ldsb + TAB_OFF); S.ntiles = ntiles; S.npn = 4; S.G = gridDim.x; S.c = blockIdx.x;
    S.A = (const char*)act; S.atile = (size_t)256 * DE * 2; S.Bt = (const char*)(P.ws + WS_WD) + (size_t)l * NEXP * D * DE * 2; S.bexp = (size_t)D * DE * 2; S.btile = (size_t)256 * DE * 2; S.lists = lists;
    pg8::EpiY E{yb, lists};
    pg8::gemm_phase<pg8::EpiY, pg8::MoeOrder, false>(ldsb, DE, DE, S, E);
}

#ifndef PROBE_PH
#define PROBE_PH -1
#endif
#ifndef PROBE_SUB
#define PROBE_SUB 15
#endif
#ifndef PROBE_REPS
#define PROBE_REPS 4
#endif
__global__ void __launch_bounds__(NTHREADS, 2) fwd_kernel(Params P) {
    extern __shared__ __attribute__((aligned(16))) unsigned char lds_raw[];
    float* lds = (float*)lds_raw;
    volatile LAS unsigned* xbw = (volatile LAS unsigned*)(lds_raw + LDS_BYTES - 16);
    if (threadIdx.x == 0) { xbw[0] = 0u; xbw[1] = 0u; }
    __syncthreads();
    unsigned char* const ws = P.ws;
    unsigned* ctl = (unsigned*)(ws + WS_CTL);
    const bool multi = (P.ph_hi - P.ph_lo) > 1;
    XcdBarrier bar; bar.bar = ctl; bar.x = 0; bar.st = xbw;
    if (multi) bar = xcd_barrier_post(ctl, xbw);
    bf16_t* z = (bf16_t*)(ws + WS_Z); float* gates = (float*)(ws + WS_GATES); unsigned char* wss = ws + WS_S5; bf16_t* mix = (bf16_t*)(ws + WS_MIX); unsigned char* wsm = ws + WS_HRAW;
    bf16_t* H = (bf16_t*)(ws + WS_H); bf16_t* act = (bf16_t*)(ws + WS_ACT); bf16_t* yb = (bf16_t*)(ws + WS_YB); bf16_t* xbuf = (bf16_t*)(ws + WS_XB); float* rsb = (float*)(ws + WS_RS);
    int2* lists = (int2*)(ws + WS_LIST);
    LAS unsigned char* ldsb = (LAS unsigned char*)lds_raw;
    const int lo = P.ph_lo, hi = P.ph_hi;
#define IN(k) (lo <= (k) && (k) < hi)
#define SEAM(k) do { if (IN(k) && IN((k) + 1)) xcd_barrier(bar); } while (0)
#if PROBE_PH >= 0
#define RUNPH(k, ...) do { if (IN(k)) { const int nrep = ((k) == PROBE_PH) ? 1 + PROBE_REPS : 1; for (int rep = 0; rep < nrep; ++rep) { __VA_ARGS__; if (rep + 1 < nrep) xcd_barrier(bar); } } SEAM(k); } while (0)
#else
#define RUNPH(k, ...) do { if (IN(k)) { constexpr int rep = 0; (void)rep; __VA_ARGS__; } SEAM(k); } while (0)
#endif
    RUNPH(0, ph_prologue(lds, PF));
    for (int l = 0; l < NLAYER; ++l) {
        const int pb = 1 + l * PH_PER_LAYER;
        unsigned* cnt = ctl + CW_CNT + l * 64;
        const unsigned char* tb = ws + WS_TB + (size_t)l * 4 * MiB;
        const unsigned char* rtb = ws + WS_RT + (size_t)l * 256 * 1024;
        unsigned* inv = (unsigned*)(ws + WS_INV) + (size_t)l * NTOK * 2;
        RUNPH(pb + 0, { const Params& Q = PF;
            if (l == 0) rp::run<1, false, false>(ldsb, Q, l, Q.in[I_X], nullptr, nullptr, nullptr, nullptr, Q.in[I_NMG] + l * D, (const bf16_t*)(rtb + rp::T_GHI), (const bf16_t*)(rtb + rp::T_GLO), mix, rsb, gates, nullptr, nullptr, nullptr);
            else        rp::run<1, true, true>(ldsb, Q, l, nullptr, xbuf, yb, inv - (size_t)NTOK * 2, cnt - 64, Q.in[I_NMG] + l * D, (const bf16_t*)(rtb + rp::T_GHI), (const bf16_t*)(rtb + rp::T_GLO), mix, rsb, gates, nullptr, nullptr, nullptr); });
        RUNPH(pb + 1, ph_inproj(ldsb, mix, (const bf16_t*)(ws + WS_WIN) + (size_t)l * NMAIN * D, z, rsb, (rep > 0 && PROBE_SUB <= 3) ? PROBE_SUB : 0));
        RUNPH(pb + 2, ph_mix1(lds, PF, l, z, gates, mix, wsm, wss, tb, rep == 0 ? 15 : PROBE_SUB));
        RUNPH(pb + 3, { s5::p2_scan(ldsb, tb, wss); ml::p2_scan(wsm); });
        RUNPH(pb + 4, ph_mix2(lds, PF, l, z, gates, mix, wsm, wss, tb, rep == 0 ? 15 : PROBE_SUB));
        RUNPH(pb + 5, { const Params& Q = PF; if (l == 0) ph_outproj<true>(ldsb, mix, (const bf16_t*)(ws + WS_WOUT) + (size_t)l * D * D, Q.in[I_X], xbuf); else ph_outproj<false>(ldsb, mix, (const bf16_t*)(ws + WS_WOUT) + (size_t)l * D * D, nullptr, xbuf); });
        RUNPH(pb + 6, { if (rep > 0) { if (blockIdx.x == 0 && threadIdx.x < 64) cnt[threadIdx.x] = 0u; xcd_barrier(bar); }
                        const Params& Q = PF; rp::run<3, false, true>(ldsb, Q, l, nullptr, xbuf, nullptr, nullptr, nullptr, Q.in[I_NFG] + l * D, (const bf16_t*)(rtb + rp::T_HI), (const bf16_t*)(rtb + rp::T_LO), H, rsb, nullptr, cnt, lists, inv); });
        RUNPH(pb + 7, ph_moe1(ldsb, PF, l, H, cnt, lists, act));
        RUNPH(pb + 8, ph_moe2(ldsb, PF, l, act, cnt, lists, yb));
    }
    RUNPH(1 + NLAYER * PH_PER_LAYER, { const Params& Q = PF; rp::final_norm(ldsb, xbuf, Q.out, yb, (const unsigned*)(ws + WS_INV) + (size_t)(NLAYER - 1) * NTOK * 2, ctl + CW_CNT + (NLAYER - 1) * 64, Q.in[I_NFIN]); });
#undef RUNPH
#undef IN
#undef SEAM
}

#ifndef N_LAUNCH_MODE
#define N_LAUNCH_MODE 1
#endif
extern "C" void kernel_launch(void* const* d_in, const int* in_sizes, int n_in, void* d_out, int out_size, void* d_ws, size_t ws_size, hipStream_t stream) {
    static int grid = 0;
    if (grid == 0) {
        if (n_in != 31 || out_size != NTOK * D || ws_size < WS_END) { fprintf(stderr, "kernel_launch: unexpected shapes n_in %d out %d ws %zu (need %zu)\n", n_in, out_size, ws_size, (size_t)WS_END); grid = -1; return; }
        int dev = 0, cus = 0, per_cu = 0;
        if (hipGetDevice(&dev) != hipSuccess || hipDeviceGetAttribute(&cus, hipDeviceAttributeMultiprocessorCount, dev) != hipSuccess) { grid = -1; return; }
        if (hipFuncSetAttribute((const void*)fwd_kernel, hipFuncAttributeMaxDynamicSharedMemorySize, LDS_BYTES) != hipSuccess) { fprintf(stderr, "kernel_launch: hipFuncSetAttribute failed\n"); grid = -1; return; }
        if (hipOccupancyMaxActiveBlocksPerMultiprocessor(&per_cu, (const void*)fwd_kernel, NTHREADS, LDS_BYTES) != hipSuccess || per_cu < 1) { fprintf(stderr, "kernel_launch: occupancy query says %d\n", per_cu); }
        (void)hipGetLastError();
        grid = cus;
    }
    if (grid < 0) return;
    (void)hipMemsetAsync((char*)d_ws + WS_CTL, 0, CTL_BYTES, stream);
    Params p{};
    for (int i = 0; i < 31; ++i) p.in[i] = (const float*)d_in[i];
    p.out = (float*)d_out; p.ws = (unsigned char*)d_ws;
#if N_LAUNCH_MODE == 1
    p.ph_lo = 0; p.ph_hi = N_PHASES;
    hipLaunchKernelGGL(fwd_kernel, dim3(grid), dim3(NTHREADS), LDS_BYTES, stream, p);
#else
    for (int ph = 0; ph < N_PHASES; ++ph) { p.ph_lo = ph; p.ph_hi = ph + 1; hipLaunchKernelGGL(fwd_kernel, dim3(grid), dim3(NTHREADS), LDS_BYTES, stream, p); }
#endif
}
```

```cpp
#include <hip/hip_runtime.h>
#include <stdint.h>
#include <stdio.h>

#define LAS __attribute__((address_space(3)))

constexpr int D = 1024, NB = 8, S = 8192, NTOK = NB * S, INW = 2312, NLAYER = 2;
constexpr int NEXP = 32, DE = 512;
constexpr float EPS = 1e-6f;
constexpr int ZW = 2304;
constexpr int ZQ = 0, ZK = 256, ZV = 384, ZSU = 512, ZCQ = 768, ZCK = 1024, ZCV = 1280, ZCO = 1536, ZGU = 1792, ZGV = 2048, WCI = 1536;
#ifndef INPROJ_WGM
#define INPROJ_WGM 8
#endif
constexpr int NTHREADS = 512;
constexpr int LDS_BYTES = 144 * 1024;
constexpr int TAB_OFF = 128 * 1024;
constexpr int PH_PER_LAYER = 9, N_PHASES = 1 + NLAYER * PH_PER_LAYER + 1;
constexpr int NMAIN = 2304;
typedef unsigned short bf16_t;

constexpr size_t MiB = 1u << 20;
constexpr size_t WS_CTL = 0, CTL_BYTES = 1 * MiB;
constexpr size_t WS_Z = WS_CTL + CTL_BYTES;
constexpr size_t Z_BYTES = (size_t)NTOK * ZW * 2;
constexpr size_t WS_H = WS_Z;
constexpr size_t WS_YB = WS_Z;
constexpr int PMAX = 2 * NTOK + NEXP * 256;
static_assert((size_t)PMAX * D * 2 <= Z_BYTES, "YB alias fits");
constexpr size_t WS_MIX = WS_Z + Z_BYTES;
constexpr size_t WS_ACT = WS_MIX;
static_assert((size_t)PMAX * DE * 2 <= (size_t)NTOK * D * 2 + 64 * MiB, "ACT alias fits");
constexpr size_t WS_HRAW = WS_MIX + (size_t)NTOK * D * 2;
constexpr size_t WS_S5 = WS_HRAW + 64 * MiB;
constexpr size_t WS_GATES = WS_S5 + 48 * MiB;
constexpr size_t WS_LIST = WS_GATES + (size_t)NTOK * 8 * 4;
constexpr size_t WS_WIN = WS_LIST + (size_t)NEXP * NTOK * 8;
constexpr size_t WS_WOUT = WS_WIN + (size_t)NLAYER * NMAIN * D * 2;
constexpr size_t WS_WGU = WS_WOUT + (size_t)NLAYER * D * D * 2;
constexpr size_t WS_WD = WS_WGU + (size_t)NLAYER * NEXP * 1024 * D * 2;
constexpr size_t WS_TB = WS_WD + (size_t)NLAYER * NEXP * D * DE * 2;
constexpr size_t WS_RS = WS_TB + (size_t)NLAYER * 4 * MiB;
constexpr size_t WS_RT = WS_RS + (size_t)NTOK * 4;
constexpr size_t WS_INV = WS_RT + (size_t)NLAYER * 256 * 1024;
constexpr size_t WS_XB = WS_INV + (size_t)NLAYER * NTOK * 8;
constexpr size_t WS_END = WS_XB + (size_t)NTOK * D * 2;
namespace s5 {
constexpr size_t T_KMAT = 0, T_F = T_KMAT + (size_t)16 * 32 * 256 * 2, T_G = T_F + (size_t)16 * 256 * 128 * 2, T_A16 = T_G + (size_t)16 * 128 * 256 * 2,
                 T_GLUW = T_A16 + (size_t)16 * 64 * 8, T_SGUW = T_GLUW + (size_t)256 * 256 * 2, T_LAYER = T_SGUW + (size_t)4 * 128 * 128 * 2;
}
constexpr int CW_Q = 4096;
constexpr int CW_CNT = 8192;

#define XB_TMO      128
#define XB_XCNT(j)  (256  + 64 * (j))
#define XB_XSUB(j)  (1280 + 64 * (j))
#define XB_XGEN(j)  (2304 + 64 * (j))
#define XB_TOP      3328
#define XB_TOPGEN   3392
#define XCD_BAR_WORDS 3456
#define XB_SPIN_CAP (1u << 22)
__device__ __forceinline__ unsigned xb_ld(unsigned* p)              { return __hip_atomic_load(p, __ATOMIC_RELAXED, __HIP_MEMORY_SCOPE_AGENT); }
__device__ __forceinline__ unsigned xb_add(unsigned* p, unsigned v) { return __hip_atomic_fetch_add(p, v, __ATOMIC_RELAXED, __HIP_MEMORY_SCOPE_AGENT); }
__device__ __forceinline__ unsigned xb_xcc_id() { return (unsigned)__builtin_amdgcn_s_getreg((3 << 11) | 20) & 0xFu; }
#define XB_SPIN(cond, bar) do { unsigned _sp = 0; while (cond) { __builtin_amdgcn_s_sleep(1); \
    if ((++_sp & 255u) == 0u) { if (xb_ld(&(bar)[XB_TMO])) break; if (_sp > XB_SPIN_CAP) { atomicAdd(&(bar)[XB_TMO], 1u); break; } } } } while (0)
struct XcdBarrier { unsigned* bar; unsigned x; volatile LAS unsigned* st; };
__device__ __forceinline__ XcdBarrier xcd_barrier_post(unsigned* bar, volatile LAS unsigned* st) {
    XcdBarrier b; b.bar = bar; b.x = xb_xcc_id(); b.st = st;
    if (threadIdx.x == 0) (void)xb_add(&bar[XB_XCNT(b.x)], 1u);
    return b;
}
__device__ __forceinline__ void xcd_barrier_complete(unsigned* bar, unsigned x, unsigned& nloc, unsigned& nx) {
    const unsigned G = gridDim.x * gridDim.y * gridDim.z;
    unsigned sum, cnt, mine, sp = 0u;
    for (;;) {
        sum = 0u; cnt = 0u; mine = 0u;
#pragma unroll
        for (unsigned j = 0; j < 16; ++j) { const unsigned c = xb_ld(&bar[XB_XCNT(j)]); sum += c; cnt += (c > 0u) ? 1u : 0u; mine = (j == x) ? c : mine; }
        if (sum == G) break;
        __builtin_amdgcn_s_sleep(1);
        if ((++sp & 255u) == 0u) { if (xb_ld(&bar[XB_TMO])) break; if (sp > XB_SPIN_CAP) { atomicAdd(&bar[XB_TMO], 1u); break; } }
    }
    nloc = mine > 0u ? mine : 1u; nx = cnt > 0u ? cnt : 1u;
}
__device__ __forceinline__ void xcd_barrier(const XcdBarrier& b) {
    asm volatile("s_waitcnt vmcnt(0)" ::: "memory");
    __syncthreads();
    if (threadIdx.x == 0) {
        unsigned* bar = b.bar;
        __builtin_amdgcn_s_waitcnt(0);
        unsigned nloc = b.st[0], nx = b.st[1];
        if (nloc == 0u) { xcd_barrier_complete(bar, b.x, nloc, nx); b.st[0] = nloc; b.st[1] = nx; }
        const unsigned old = xb_add(&bar[XB_XSUB(b.x)], 1u);
        const unsigned gen = old / nloc;
        if (old + 1u == (gen + 1u) * nloc) {
            __builtin_amdgcn_fence(__ATOMIC_RELEASE, "agent");
            asm volatile("s_waitcnt vmcnt(0)" ::: "memory");
            const unsigned og = xb_add(&bar[XB_TOP], 1u);
            const unsigned tg = og / nx;
            if (og + 1u == (tg + 1u) * nx) xb_add(&bar[XB_TOPGEN], 1u);
            else XB_SPIN(xb_ld(&bar[XB_TOPGEN]) == tg, bar);
            __builtin_amdgcn_fence(__ATOMIC_ACQUIRE, "agent");
            xb_add(&bar[XB_XGEN(b.x)], 1u);
            asm volatile("s_waitcnt vmcnt(0)" ::: "memory");
        } else {
            XB_SPIN(xb_ld(&bar[XB_XGEN(b.x)]) == gen, bar);
            __builtin_amdgcn_fence(__ATOMIC_ACQUIRE, "agent");
            asm volatile("s_waitcnt vmcnt(0)" ::: "memory");
        }
    }
    __syncthreads();
}

__device__ __forceinline__ int tid_opaque() { int t = threadIdx.x; asm volatile("" : "+v"(t)); return t; }
__device__ __forceinline__ float wave_sum(float v) {
#pragma unroll
    for (int o = 32; o > 0; o >>= 1) v += __shfl_xor(v, o);
    return v;
}
__device__ __forceinline__ float gelu_tanh(float x) {
    const float u2 = 1.5957691216057308f * (x + 0.044715f * x * x * x);
    return x * __builtin_amdgcn_rcpf(1.f + __expf(-u2));
}
__device__ __forceinline__ float sigm(float x) { return 1.f / (1.f + expf(-x)); }
__device__ __forceinline__ float rsig(float x) { return __builtin_amdgcn_rcpf(1.f + __expf(-x)); }
__device__ __forceinline__ float bfl(unsigned w) { return __uint_as_float(w << 16); }
__device__ __forceinline__ float bfh(unsigned w) { return __uint_as_float(w & 0xffff0000u); }
typedef unsigned u32x4_t __attribute__((ext_vector_type(4)));
typedef unsigned u32x2_t __attribute__((ext_vector_type(2)));
__device__ __forceinline__ void ld8(const bf16_t* p, float (&o)[8]) { const u32x4_t w = *(const u32x4_t*)p; o[0] = bfl(w.x); o[1] = bfh(w.x); o[2] = bfl(w.y); o[3] = bfh(w.y); o[4] = bfl(w.z); o[5] = bfh(w.z); o[6] = bfl(w.w); o[7] = bfh(w.w); }
typedef short s16x4_t __attribute__((ext_vector_type(4)));
__device__ __forceinline__ u32x2_t lds_tr4(const LAS unsigned char* p) { const s16x4_t v = __builtin_amdgcn_ds_read_tr16_b64_v4i16((LAS s16x4_t*)p); return __builtin_bit_cast(u32x2_t, v); }
__device__ __forceinline__ void wave_lds_fence() {
    __builtin_amdgcn_fence(__ATOMIC_RELEASE, "wavefront"); __builtin_amdgcn_wave_barrier(); __builtin_amdgcn_fence(__ATOMIC_ACQUIRE, "wavefront");
}

struct Params {
    const float* in[31];
    float* out;
    unsigned char* ws;
    int ph_lo, ph_hi;
};
struct Params;
__device__ __forceinline__ const Params* params_fresh() { auto p = __builtin_amdgcn_kernarg_segment_ptr(); asm volatile("" : "+s"(p)); return (const Params*)p; }
#define PF (*params_fresh())
enum { I_X = 0, I_NMG, I_WIN, I_SINK, I_ARE, I_AIM, I_BRE, I_BIM, I_CRE, I_CIM, I_SD, I_LDT, I_GLUW, I_GLUB, I_CONVW, I_GATEB, I_MNG,
       I_LNG, I_LNB, I_SGUW, I_SGUB, I_WOUT, I_NFG, I_RGW, I_RGB, I_REW, I_REB, I_EWG, I_EWU, I_EWD, I_NFIN };

namespace pg8 {
#define PG8_LAS __attribute__((address_space(3)))
typedef short bf16x8 __attribute__((ext_vector_type(8)));
typedef float f32x4 __attribute__((ext_vector_type(4)));
typedef unsigned u32x4 __attribute__((ext_vector_type(4)));
typedef unsigned u32x2 __attribute__((ext_vector_type(2)));
typedef int i32x4 __attribute__((ext_vector_type(4)));
constexpr int BM = 256, BK = 64, HALF = 128, HTB = HALF * BK * 2, STAGE_BYTES = 8 * HTB, NXCD = 8, WGM = 8;
__host__ __device__ __forceinline__ int lds_byte(int r, int c) { const int st = (r >> 4) * 2 + (c >> 5), rr = r & 15, cc = c & 31, ob = rr * 64 + cc * 2; return st * 1024 + (ob ^ (((ob >> 9) & 1) << 5)); }
__host__ __device__ __forceinline__ void stage_rc(int b, int& R, int& C) { const int st = b / 1024, sb = b % 1024, swz = sb ^ (((sb >> 9) & 1) << 5); R = (st >> 1) * 16 + swz / 64; C = (st & 1) * 32 + (swz % 64) / 2; }
__host__ __device__ __forceinline__ int perm32(int rho) { const int n = rho >> 4, i = rho & 15; return 8 * (i >> 2) + 4 * n + (i & 3); }
__device__ __forceinline__ unsigned cvt_pk_bf16(float lo, float hi) { unsigned r; asm volatile("v_cvt_pk_bf16_f32 %0, %1, %2" : "=v"(r) : "v"(lo), "v"(hi)); return r; }

struct Unit { int pm, pn; const char* A; const char* B; int e, pos0, cnt; };

struct StaticOrder {
    int nM, nN, nwg, G, c, wgm, pmmask = -1; const char* A; const char* Bt; size_t atile, btile;
    __device__ void init(int M, int N, int K, int lda, int G_, int c_, const void* A_, const void* Bt_, int wgm_ = WGM) { wgm = wgm_; nM = M / BM; nN = N / BM; nwg = nM * nN; G = G_; c = c_; A = (const char*)A_; Bt = (const char*)Bt_; atile = (size_t)BM * lda * 2; btile = (size_t)BM * K * 2; }
    __device__ __forceinline__ bool next(int i, Unit& u) const {
        const long L = (long)i * G + c; if (L >= nwg) return false;
        int wgid = (int)L; { const int q = nwg / NXCD, r = nwg % NXCD, xcd = wgid % NXCD, off = wgid / NXCD; wgid = (xcd < r ? xcd * (q + 1) : r * (q + 1) + (xcd - r) * q) + off; }
        const int nig = wgm * nN, gid = wgid / nig, fm = gid * wgm, gsz = (nM - fm) < wgm ? (nM - fm) : wgm;
        u.pm = fm + ((wgid % nig) % gsz); u.pn = (wgid % nig) / gsz; u.A = A + (size_t)(u.pm & pmmask) * atile; u.B = Bt + (size_t)u.pn * btile; u.e = 0; u.pos0 = 0; u.cnt = 0; return true;
    }
    __device__ __forceinline__ void aoff(const Unit&, unsigned (&)[2], unsigned (&)[2], const int (&)[2], const int (&)[2]) const {}
};

template <class Epi, class Sched, bool GATHER>
__device__ __forceinline__ void gemm_phase(PG8_LAS unsigned char* lds, const int K, const int lda, const Sched& S, const Epi& E) {
    const int tid = tid_opaque(), wid = __builtin_amdgcn_readfirstlane(tid >> 6), lane = tid & 63, wr = wid >> 2, wc = wid & 3, fr = lane & 15, fq = lane >> 4;
    const int nt = K / BK;
    unsigned vA0[2], vA1[2], vB[2], nA0[2], nA1[2]; int Rs[2], Cs[2];
#pragma unroll
    for (int i = 0; i < 2; ++i) { int R, C; stage_rc(tid * 16 + i * 8192, R, C); const int Rb = Epi::PERM ? ((R & ~31) + perm32(R & 31)) : R;
        Rs[i] = R; Cs[i] = C; vA0[i] = (unsigned)(R * lda + C) * 2u; vA1[i] = vA0[i] + (unsigned)(HALF * lda) * 2u; vB[i] = (unsigned)(Rb * K + C) * 2u; nA0[i] = vA0[i]; nA1[i] = vA1[i]; }
    const size_t kstep = (size_t)(BK * 2);
    const size_t hstep = (size_t)HALF * K * 2;
    const unsigned ldsw = (unsigned)wid * 1024u;
    const int aoff = lds_byte(wr * 64 + fr, fq * 8), boff = lds_byte(wc * 32 + fr, fq * 8);
#define PG8_SA(b, h) (((b) * 2 + (h)) * HTB)
#define PG8_SB(b, h) ((4 + (b) * 2 + (h)) * HTB)
#define PG8_STAGE(bufoff, gbase, voff) do { _Pragma("unroll") for (int _i = 0; _i < 2; ++_i) \
        __builtin_amdgcn_global_load_lds((const unsigned*)((const char*)(gbase) + (voff)[_i]), (PG8_LAS unsigned*)(lds + (bufoff) + ldsw + _i * 8192), 16, 0, 0); } while (0)
#define PG8_LDA(dst, b, h) do { _Pragma("unroll") for (int m = 0; m < 4; ++m) _Pragma("unroll") for (int k = 0; k < 2; ++k) dst[m][k] = *(const PG8_LAS bf16x8*)(lds + PG8_SA(b, h) + aoff + m * 2048 + k * 1024); } while (0)
#define PG8_LDB(dst, b, h) do { _Pragma("unroll") for (int n = 0; n < 2; ++n) _Pragma("unroll") for (int k = 0; k < 2; ++k) dst[n][k] = *(const PG8_LAS bf16x8*)(lds + PG8_SB(b, h) + boff + n * 2048 + k * 1024); } while (0)
#define PG8_MMA(ai, bj, At, Bt) do { __builtin_amdgcn_s_setprio(1); _Pragma("unroll") for (int m = 0; m < 4; ++m) _Pragma("unroll") for (int n = 0; n < 2; ++n) _Pragma("unroll") for (int k = 0; k < 2; ++k) \
        acc[ai][bj][m][n] = __builtin_amdgcn_mfma_f32_16x16x32_bf16(Bt[n][k], At[m][k], acc[ai][bj][m][n], 0, 0, 0); __builtin_amdgcn_s_setprio(0); } while (0)
#define PG8_WAIT_V(n) asm volatile("s_waitcnt vmcnt(" #n ")" ::: "memory")
#define PG8_WAIT_L(n) asm volatile("s_waitcnt lgkmcnt(" #n ")" ::: "memory")
#define PG8_BAR __builtin_amdgcn_s_barrier()
#define PG8_SCHED __builtin_amdgcn_sched_barrier(0)
    Unit cur, nxt; int ui = 0;
    if (!S.next(0, cur)) return;
    if constexpr (GATHER) { S.aoff(cur, vA0, vA1, Rs, Cs); PG8_WAIT_V(0); }
    f32x4 acc[2][2][4][2];
#pragma unroll
    for (int a = 0; a < 2; ++a)
#pragma unroll
        for (int b = 0; b < 2; ++b)
#pragma unroll
            for (int m = 0; m < 4; ++m)
#pragma unroll
                for (int n = 0; n < 2; ++n) acc[a][b][m][n] = (f32x4){0.f, 0.f, 0.f, 0.f};
    bf16x8 At[4][2], B0[2][2], B1[2][2];
    const char* cA = cur.A; const char* cB = cur.B;
    PG8_STAGE(PG8_SB(0, 0), cB, vB); PG8_STAGE(PG8_SB(0, 1), cB + hstep, vB); PG8_STAGE(PG8_SA(0, 0), cA, vA0); PG8_STAGE(PG8_SA(0, 1), cA, vA1);
    if (wr == 1) PG8_BAR;
    PG8_WAIT_V(2); PG8_BAR;
    PG8_STAGE(PG8_SB(1, 0), cB + kstep, vB); PG8_STAGE(PG8_SA(1, 0), cA + kstep, vA0); PG8_STAGE(PG8_SB(1, 1), cB + hstep + kstep, vB);
    PG8_WAIT_V(6); PG8_BAR;
    for (;;) {
        const bool has_next = S.next(ui + 1, nxt);
        const char* nA = has_next ? nxt.A : cA; const char* nB = has_next ? nxt.B : cB;
        if constexpr (GATHER) {
            if (has_next) { S.aoff(nxt, nA0, nA1, Rs, Cs); }
            else {
#pragma unroll
                for (int i = 0; i < 2; ++i) { nA0[i] = vA0[i]; nA1[i] = vA1[i]; } }
        }
        for (int t = 0; t < nt; t += 2) {
            const bool last = (t == nt - 2);
            const char* a1 = cA + (size_t)(t + 1) * kstep;
            const char* a2 = last ? nA : cA + (size_t)(t + 2) * kstep; const char* b2 = last ? nB : cB + (size_t)(t + 2) * kstep;
            const char* a3 = a2 + kstep; const char* b3 = b2 + kstep;
            unsigned x0[2], x1[2];
#pragma unroll
            for (int i = 0; i < 2; ++i) { x0[i] = (GATHER && last) ? nA0[i] : vA0[i]; x1[i] = (GATHER && last) ? nA1[i] : vA1[i]; }
            PG8_LDB(B0, 0, 0); PG8_LDB(B1, 0, 1); PG8_SCHED; PG8_LDA(At, 0, 0); PG8_STAGE(PG8_SA(1, 1), a1, vA1);
            PG8_WAIT_V(8); PG8_WAIT_L(0); PG8_BAR; PG8_MMA(0, 0, At, B0); PG8_MMA(0, 1, At, B1); PG8_BAR; PG8_SCHED;
            PG8_LDA(At, 0, 1); PG8_STAGE(PG8_SB(0, 0), b2, vB); PG8_STAGE(PG8_SB(0, 1), b2 + hstep, vB); PG8_STAGE(PG8_SA(0, 0), a2, x0);
            PG8_WAIT_V(8); PG8_WAIT_L(0); PG8_BAR; PG8_MMA(1, 0, At, B0); PG8_MMA(1, 1, At, B1); PG8_BAR; PG8_SCHED;
            PG8_LDB(B0, 1, 0); PG8_LDB(B1, 1, 1); PG8_SCHED; PG8_LDA(At, 1, 0); PG8_STAGE(PG8_SA(0, 1), a2, x1);
            PG8_WAIT_V(8); PG8_WAIT_L(0); PG8_BAR; PG8_MMA(0, 0, At, B0); PG8_MMA(0, 1, At, B1); PG8_BAR; PG8_SCHED;
            PG8_LDA(At, 1, 1); PG8_STAGE(PG8_SB(1, 0), b3, vB); PG8_STAGE(PG8_SB(1, 1), b3 + hstep, vB); PG8_STAGE(PG8_SA(1, 0), a3, x0);
            PG8_WAIT_V(8); PG8_WAIT_L(0); PG8_BAR; PG8_MMA(1, 0, At, B0); PG8_MMA(1, 1, At, B1); PG8_BAR; PG8_SCHED;
        }
        if (wr == 0) PG8_BAR;
        E(acc, cur, wr, wc, fr, fq);
        if (!has_next) break;
#pragma unroll
        for (int a = 0; a < 2; ++a)
#pragma unroll
            for (int b = 0; b < 2; ++b)
#pragma unroll
                for (int m = 0; m < 4; ++m)
#pragma unroll
                    for (int n = 0; n < 2; ++n) acc[a][b][m][n] = (f32x4){0.f, 0.f, 0.f, 0.f};
        cur = nxt; cA = nA; cB = nB; ++ui;
        if constexpr (GATHER) {
#pragma unroll
            for (int i = 0; i < 2; ++i) { vA0[i] = nA0[i]; vA1[i] = nA1[i]; } }
        if (wr == 1) PG8_BAR;
    }
    PG8_WAIT_V(0);
    PG8_BAR;
#undef PG8_SA
#undef PG8_SB
#undef PG8_STAGE
#undef PG8_LDA
#undef PG8_LDB
#undef PG8_MMA
#undef PG8_WAIT_V
#undef PG8_WAIT_L
#undef PG8_BAR
#undef PG8_SCHED
}

struct EpiZ {
    static constexpr bool PERM = true;
    bf16_t* Z; const float* RS; int skip;
    __device__ __forceinline__ void operator()(const f32x4 (&acc)[2][2][4][2], const Unit& u, int wr, int wc, int fr, int fq) const {
        if (skip) return;
        const int row0 = u.pm * BM + wr * 64 + fr, col0 = u.pn * BM + wc * 32 + 8 * fq;
        float rsv[2][4];
#pragma unroll
        for (int ai = 0; ai < 2; ++ai)
#pragma unroll
            for (int m = 0; m < 4; ++m) rsv[ai][m] = RS[row0 + ai * HALF + m * 16];
#pragma unroll
        for (int ai = 0; ai < 2; ++ai)
#pragma unroll
            for (int m = 0; m < 4; ++m) { bf16_t* rowp = Z + (size_t)(row0 + ai * HALF + m * 16) * ZW + col0; const float rs = rsv[ai][m];
#pragma unroll
                for (int bj = 0; bj < 2; ++bj) { const f32x4 v0 = acc[ai][bj][m][0] * rs, v1 = acc[ai][bj][m][1] * rs;
                    u32x4 w; w.x = cvt_pk_bf16(v0[0], v0[1]); w.y = cvt_pk_bf16(v0[2], v0[3]); w.z = cvt_pk_bf16(v1[0], v1[1]); w.w = cvt_pk_bf16(v1[2], v1[3]);
                    *(u32x4*)(rowp + bj * HALF) = w; } }
    }
};
template <bool SRCF32> struct EpiResB {
    static constexpr bool PERM = true;
    const float* XF; bf16_t* XB;
    __device__ __forceinline__ void operator()(const f32x4 (&acc)[2][2][4][2], const Unit& u, int wr, int wc, int fr, int fq) const {
        const int row0 = u.pm * BM + wr * 64 + fr, col0 = u.pn * BM + wc * 32 + 8 * fq;
#pragma unroll
        for (int ai = 0; ai < 2; ++ai) {
            f32x4 xf[4][2][2]; u32x4 xw[4][2];
#pragma unroll
            for (int m = 0; m < 4; ++m) { const size_t off = (size_t)(row0 + ai * HALF + m * 16) * D + col0;
#pragma unroll
                for (int bj = 0; bj < 2; ++bj) {
                    if (SRCF32) { xf[m][bj][0] = *(const f32x4*)(XF + off + bj * HALF); xf[m][bj][1] = *(const f32x4*)(XF + off + bj * HALF + 4); }
                    else xw[m][bj] = *(const u32x4*)(XB + off + bj * HALF); } }
            __builtin_amdgcn_sched_barrier(0);
#pragma unroll
            for (int m = 0; m < 4; ++m) { const size_t off = (size_t)(row0 + ai * HALF + m * 16) * D + col0;
#pragma unroll
                for (int bj = 0; bj < 2; ++bj) { f32x4 x0, x1;
                    if (SRCF32) { x0 = xf[m][bj][0]; x1 = xf[m][bj][1]; }
                    else { const u32x4 w = xw[m][bj];
                        x0 = (f32x4){__uint_as_float(w.x << 16), __uint_as_float(w.x & 0xffff0000u), __uint_as_float(w.y << 16), __uint_as_float(w.y & 0xffff0000u)};
                        x1 = (f32x4){__uint_as_float(w.z << 16), __uint_as_float(w.z & 0xffff0000u), __uint_as_float(w.w << 16), __uint_as_float(w.w & 0xffff0000u)}; }
                    const f32x4 v0 = x0 + acc[ai][bj][m][0], v1 = x1 + acc[ai][bj][m][1];
                    u32x4 o; o.x = cvt_pk_bf16(v0[0], v0[1]); o.y = cvt_pk_bf16(v0[2], v0[3]); o.z = cvt_pk_bf16(v1[0], v1[1]); o.w = cvt_pk_bf16(v1[2], v1[3]);
                    *(u32x4*)(XB + off + bj * HALF) = o; } }
            __builtin_amdgcn_sched_barrier(0);
        }
    }
};
struct EpiAct {
    static constexpr bool PERM = true;
    bf16_t* ACT; const int2* lists; const float* RS;
    __device__ __forceinline__ void operator()(const f32x4 (&acc)[2][2][4][2], const Unit& u, int wr, int wc, int fr, int fq) const {
        const int row0 = u.pm * BM + wr * 64 + fr, col0 = u.pn * HALF + wc * 32 + 8 * fq; const int2* lst = lists + (size_t)u.e * NTOK + u.pos0;
        int tk[2][4]; float rsv[2][4];
#pragma unroll
        for (int ai = 0; ai < 2; ++ai)
#pragma unroll
            for (int m = 0; m < 4; ++m) { const int r = ai * HALF + wr * 64 + m * 16 + fr; const int rc = (u.pos0 + r < u.cnt) ? r : 0; tk[ai][m] = lst[rc].x; }
        asm volatile("" : "+v"(tk[0][0]), "+v"(tk[0][1]), "+v"(tk[0][2]), "+v"(tk[0][3]), "+v"(tk[1][0]), "+v"(tk[1][1]), "+v"(tk[1][2]), "+v"(tk[1][3]));
#pragma unroll
        for (int ai = 0; ai < 2; ++ai)
#pragma unroll
            for (int m = 0; m < 4; ++m) rsv[ai][m] = RS[tk[ai][m]];
        asm volatile("" : "+v"(rsv[0][0]), "+v"(rsv[0][1]), "+v"(rsv[0][2]), "+v"(rsv[0][3]), "+v"(rsv[1][0]), "+v"(rsv[1][1]), "+v"(rsv[1][2]), "+v"(rsv[1][3]));
#pragma unroll
        for (int ai = 0; ai < 2; ++ai)
#pragma unroll
            for (int m = 0; m < 4; ++m) { const int r = ai * HALF + wr * 64 + m * 16 + fr; if (!(u.pos0 + r < u.cnt)) rsv[ai][m] = 0.f; }
#pragma unroll
        for (int ai = 0; ai < 2; ++ai)
#pragma unroll
            for (int m = 0; m < 4; ++m) { bf16_t* rowp = ACT + (size_t)(row0 + ai * HALF + m * 16) * DE + col0;
                const float rs = rsv[ai][m];
                float o[8];
#pragma unroll
                for (int n = 0; n < 2; ++n)
#pragma unroll
                    for (int j = 0; j < 4; ++j) { const float g = acc[ai][0][m][n][j] * rs, up = acc[ai][1][m][n][j] * rs; o[n * 4 + j] = g * up * __builtin_amdgcn_rcpf(1.f + __expf(-g)); }
                u32x4 w; w.x = cvt_pk_bf16(o[0], o[1]); w.y = cvt_pk_bf16(o[2], o[3]); w.z = cvt_pk_bf16(o[4], o[5]); w.w = cvt_pk_bf16(o[6], o[7]);
                *(u32x4*)rowp = w; }
    }
};
struct EpiY {
    static constexpr bool PERM = true;
    bf16_t* YB; const int2* lists;
    __device__ __forceinline__ void operator()(const f32x4 (&acc)[2][2][4][2], const Unit& u, int wr, int wc, int fr, int fq) const {
        const int row0 = u.pm * BM + wr * 64 + fr, col0 = u.pn * BM + wc * 32 + 8 * fq; const int2* lst = lists + (size_t)u.e * NTOK + u.pos0;
        float wv[2][4];
#pragma unroll
        for (int ai = 0; ai < 2; ++ai)
#pragma unroll
            for (int m = 0; m < 4; ++m) { const int r = ai * HALF + wr * 64 + m * 16 + fr; wv[ai][m] = __int_as_float(lst[(u.pos0 + r < u.cnt) ? r : 0].y); }
#pragma unroll
        for (int ai = 0; ai < 2; ++ai)
#pragma unroll
            for (int m = 0; m < 4; ++m) { const int r = ai * HALF + wr * 64 + m * 16 + fr;
                if (u.pos0 + r < u.cnt) { const float w = wv[ai][m]; bf16_t* rowp = YB + (size_t)(row0 + ai * HALF + m * 16) * D + col0;
#pragma unroll
                    for (int bj = 0; bj < 2; ++bj) { const f32x4 v0 = acc[ai][bj][m][0] * w, v1 = acc[ai][bj][m][1] * w;
                        u32x4 o; o.x = cvt_pk_bf16(v0[0], v0[1]); o.y = cvt_pk_bf16(v0[2], v0[3]); o.z = cvt_pk_bf16(v1[0], v1[1]); o.w = cvt_pk_bf16(v1[2], v1[3]);
                        *(u32x4*)(rowp + bj * HALF) = o; } } }
    }
};
struct MoeOrder {
    const PG8_LAS i32x4* tab; int ntiles, npn, G, c; const char* A; size_t atile; const char* Bt; size_t bexp, btile; const int2* lists;
    __device__ __forceinline__ bool next(int i, Unit& u) const {
        const int L = i * G + c; const int T = L / npn; if (T >= ntiles) return false;
        const i32x4 te = tab[T]; u.pm = T; u.pn = L - T * npn; u.e = __builtin_amdgcn_readfirstlane(te.x); u.pos0 = __builtin_amdgcn_readfirstlane(te.y); u.cnt = __builtin_amdgcn_readfirstlane(te.z);
        u.A = A + (size_t)T * atile; u.B = Bt + (size_t)u.e * bexp + (size_t)u.pn * btile; return true;
    }
    __device__ __forceinline__ void aoff(const Unit& u, unsigned (&o0)[2], unsigned (&o1)[2], const int (&Rs)[2], const int (&Cs)[2]) const {
        const int2* lst = lists + (size_t)u.e * NTOK;
#pragma unroll
        for (int i = 0; i < 2; ++i) { const int p0 = u.pos0 + Rs[i], p1 = p0 + HALF;
            const int t0 = (p0 < u.cnt) ? lst[p0].x : 0, t1 = (p1 < u.cnt) ? lst[p1].x : 0;
            o0[i] = (unsigned)t0 * (unsigned)(D * 2) + (unsigned)Cs[i] * 2u; o1[i] = (unsigned)t1 * (unsigned)(D * 2) + (unsigned)Cs[i] * 2u; }
    }
};
}

__device__ __forceinline__ void tc_strip(float* Tf, const float* src, int src_ld, int c0, int k0, bf16_t* dst, int K, int n0, const float* gk = nullptr) {
    LAS unsigned char* T = (LAS unsigned char*)Tf;
    const int tid = tid_opaque(), lane = tid & 63, wid = tid >> 6, l = lane & 15, g = lane >> 4;
    float4 v[8];
#pragma unroll
    for (int i = 0; i < 8; ++i) { const int kk = (tid >> 4) + 32 * i, c4 = (tid & 15) * 4; v[i] = *(const float4*)(src + (size_t)(k0 + kk) * src_ld + c0 + c4); }
    float gv[8];
#pragma unroll
    for (int i = 0; i < 8; ++i) gv[i] = gk ? gk[k0 + (tid >> 4) + 32 * i] : 1.f;
    __syncthreads();
#pragma unroll
    for (int i = 0; i < 8; ++i) { const int kk = (tid >> 4) + 32 * i, c4 = (tid & 15) * 4;
        u32x2_t w; w.x = pg8::cvt_pk_bf16(v[i].x * gv[i], v[i].y * gv[i]); w.y = pg8::cvt_pk_bf16(v[i].z * gv[i], v[i].w * gv[i]);
        *(LAS u32x2_t*)(T + kk * 144 + c4 * 2) = w; }
    __syncthreads();
#pragma unroll
    for (int nb = 0; nb < 4; ++nb) { const LAS unsigned char* p = T + (32 * wid + 8 * g + (l >> 2)) * 144 + (16 * nb + 4 * (l & 3)) * 2;
        const u32x2_t a0 = lds_tr4(p), a1 = lds_tr4(p + 4 * 144);
        const pg8::u32x4 w = {a0.x, a0.y, a1.x, a1.y};
        *(pg8::u32x4*)(dst + (size_t)(n0 + 16 * nb + l) * K + k0 + 32 * wid + 8 * g) = w; }
}
__device__ __forceinline__ void s5_build_tables_fwd(float* ldsf, const Params& P, int l, int g, unsigned char* tb);
__device__ __forceinline__ void ph_prologue(float* lds, const Params& P) {
    constexpr int NJ_EXP = NLAYER * NEXP * 96, NJ_IN = NLAYER * 144, NJ_OUT = NLAYER * 64, NJ_TB = NLAYER * 16, NJ_GLU = NLAYER * 4, NJ_SGU = NLAYER * 4, NJ_RT = NLAYER * 16;
    bf16_t* WIN = (bf16_t*)(P.ws + WS_WIN); bf16_t* WOUT = (bf16_t*)(P.ws + WS_WOUT); bf16_t* WGU = (bf16_t*)(P.ws + WS_WGU); bf16_t* WD = (bf16_t*)(P.ws + WS_WD);
    constexpr int NJ_ALL = NJ_EXP + NJ_IN + NJ_OUT + NJ_TB + NJ_GLU + NJ_SGU + NJ_RT, NJ_SMALL = NJ_TB + NJ_GLU + NJ_SGU + NJ_RT;
    unsigned* qhead = (unsigned*)(P.ws + WS_CTL) + CW_Q;
    LAS int* jslot = (LAS int*)((LAS unsigned char*)lds + LDS_BYTES - 64);
    for (;;) {
        __syncthreads();
        if (tid_opaque() == 0) *jslot = (int)atomicAdd(qhead, 1u);
        __syncthreads();
        const int jj = __builtin_amdgcn_readfirstlane(*jslot);
        if (jj >= NJ_ALL) break;
        const int j = (jj < NJ_SMALL) ? (NJ_ALL - NJ_SMALL + jj) : (jj - NJ_SMALL);
        if (j < NJ_EXP) {
            const int le = j / 96, r = j % 96;
            if (r < 64) { const int n0 = (r >> 2) * 64, k0 = (r & 3) * 256, pn = n0 >> 8, within = n0 & 255;
                const float* s = (within < 128 ? P.in[I_EWG] : P.in[I_EWU]) + (size_t)le * D * DE;
                tc_strip(lds, s, DE, pn * 128 + (within & 127), k0, WGU + (size_t)le * 1024 * D, D, n0, P.in[I_NFG] + (size_t)(le / NEXP) * D);
            } else { const int r2 = r - 64, n0 = (r2 >> 1) * 64, k0 = (r2 & 1) * 256;
                tc_strip(lds, P.in[I_EWD] + (size_t)le * DE * D, D, n0, k0, WD + (size_t)le * D * DE, DE, n0); }
        } else if (j < NJ_EXP + NJ_IN) {
            const int j2 = j - NJ_EXP, l = j2 / 144, r = j2 % 144, n0 = (r >> 2) * 64, k0 = (r & 3) * 256;
            tc_strip(lds, P.in[I_WIN] + (size_t)l * D * INW, INW, n0 < WCI ? n0 : n0 + 8, k0, WIN + (size_t)l * NMAIN * D, D, n0, P.in[I_NMG] + (size_t)l * D);
        } else if (j < NJ_EXP + NJ_IN + NJ_OUT) {
            const int j3 = j - NJ_EXP - NJ_IN, l = j3 / 64, r = j3 % 64, n0 = (r >> 2) * 64, k0 = (r & 3) * 256;
            tc_strip(lds, P.in[I_WOUT] + (size_t)l * D * D, D, n0, k0, WOUT + (size_t)l * D * D, D, n0);
        } else if (j < NJ_EXP + NJ_IN + NJ_OUT + NJ_TB) {
            const int j4 = j - (NJ_EXP + NJ_IN + NJ_OUT);
            s5_build_tables_fwd(lds, P, j4 >> 4, j4 & 15, P.ws + WS_TB + (size_t)(j4 >> 4) * 4 * MiB);
        } else if (j < NJ_EXP + NJ_IN + NJ_OUT + NJ_TB + NJ_GLU) {
            const int j5 = j - (NJ_EXP + NJ_IN + NJ_OUT + NJ_TB), l = j5 >> 2, n0 = (j5 & 3) * 64;
            tc_strip(lds, P.in[I_GLUW] + (size_t)l * 256 * 256, 256, n0, 0, (bf16_t*)(P.ws + WS_TB + (size_t)l * 4 * MiB + s5::T_GLUW), 256, n0);
        } else if (j < NJ_EXP + NJ_IN + NJ_OUT + NJ_TB + NJ_GLU + NJ_SGU) {
            const int j6 = j - (NJ_EXP + NJ_IN + NJ_OUT + NJ_TB + NJ_GLU), l = j6 >> 2, g = j6 & 3;
            bf16_t* wbp = (bf16_t*)(P.ws + WS_TB + (size_t)l * 4 * MiB + s5::T_SGUW) + (size_t)g * 128 * 128; const float* ws_ = P.in[I_SGUW] + ((size_t)l * 4 + g) * 128 * 128;
            for (int idx = tid_opaque(); idx < 128 * 128; idx += NTHREADS) { const int t = idx >> 7, s = idx & 127; wbp[idx] = (s <= t) ? (bf16_t)(pg8::cvt_pk_bf16(ws_[idx], 0.f) & 0xffffu) : (bf16_t)0; }
        } else {
            const int j7 = j - (NJ_EXP + NJ_IN + NJ_OUT + NJ_TB + NJ_GLU + NJ_SGU), l = j7 / 16, n0 = (j7 % 16) * 4;
            bf16_t* wh = (bf16_t*)(P.ws + WS_RT + (size_t)l * 256 * 1024); bf16_t* wl = wh + 48 * D;
            for (int idx = tid_opaque(); idx < 4 * D; idx += NTHREADS) { const int n = n0 + (idx >> 10), k = idx & (D - 1);
                const float w = (n < 4) ? P.in[I_RGW][((size_t)l * D + k) * 4 + n] * P.in[I_NFG][(size_t)l * D + k] : ((n < 36) ? P.in[I_REW][((size_t)l * D + k) * 32 + (n - 4)] * P.in[I_NFG][(size_t)l * D + k]
                              : ((n >= 48 && n < 56) ? P.in[I_WIN][((size_t)l * D + k) * INW + WCI + (n - 48)] * P.in[I_NMG][(size_t)l * D + k] : 0.f));
                const unsigned hb = pg8::cvt_pk_bf16(w, 0.f) & 0xffffu; const bf16_t lb = (bf16_t)(pg8::cvt_pk_bf16(w - __uint_as_float(hb << 16), 0.f) & 0xffffu);
                if (n < 48) { wh[(size_t)n * D + k] = (bf16_t)hb; wl[(size_t)n * D + k] = lb; } else { wh[(size_t)(96 + n - 48) * D + k] = (bf16_t)hb; wh[(size_t)(112 + n - 48) * D + k] = lb; } }
        }
    }
    __syncthreads();
}

template <bool DUAL, class AF, class EF>
__device__ __forceinline__ void gemm_tile(float* lds, AF arow, int K, const float* B0, const float* B1, int ldb, int n0, int N, EF epi) {
    float* As = lds;
    float* Bs0 = lds + 32 * 132;
    float* Bs1 = Bs0 + 32 * 128;
    const int tid = tid_opaque(), ty = tid >> 4, tx = tid & 15;
    float acc0[4][8], acc1[4][8];
#pragma unroll
    for (int i = 0; i < 4; ++i)
#pragma unroll
        for (int j = 0; j < 8; ++j) { acc0[i][j] = 0.f; acc1[i][j] = 0.f; }
    const float* ap0 = arow((tid >> 3));
    const float* ap1 = arow((tid >> 3) + 64);
    const int akk = (tid & 7) * 4;
    const int bn = n0 + (tid & 31) * 4; const bool bok = bn < N;
    for (int k0 = 0; k0 < K; k0 += 32) {
        const float4 av0 = ap0 ? *(const float4*)(ap0 + k0 + akk) : make_float4(0.f, 0.f, 0.f, 0.f);
        const float4 av1 = ap1 ? *(const float4*)(ap1 + k0 + akk) : make_float4(0.f, 0.f, 0.f, 0.f);
        const int kb0 = k0 + (tid >> 5), kb1 = kb0 + 16;
        const float4 bv00 = bok ? *(const float4*)(B0 + (size_t)kb0 * ldb + bn) : make_float4(0.f, 0.f, 0.f, 0.f);
        const float4 bv01 = bok ? *(const float4*)(B0 + (size_t)kb1 * ldb + bn) : make_float4(0.f, 0.f, 0.f, 0.f);
        const float4 bv10 = (DUAL && bok) ? *(const float4*)(B1 + (size_t)kb0 * ldb + bn) : bv00;
        const float4 bv11 = (DUAL && bok) ? *(const float4*)(B1 + (size_t)kb1 * ldb + bn) : bv01;
        __syncthreads();
        { const int r = (tid >> 3);
          As[(akk + 0) * 132 + r] = av0.x; As[(akk + 1) * 132 + r] = av0.y; As[(akk + 2) * 132 + r] = av0.z; As[(akk + 3) * 132 + r] = av0.w;
          As[(akk + 0) * 132 + r + 64] = av1.x; As[(akk + 1) * 132 + r + 64] = av1.y; As[(akk + 2) * 132 + r + 64] = av1.z; As[(akk + 3) * 132 + r + 64] = av1.w; }
        { const int k = (tid >> 5);
          *(float4*)&Bs0[k * 128 + (tid & 31) * 4] = bv00; *(float4*)&Bs0[(k + 16) * 128 + (tid & 31) * 4] = bv01;
          if (DUAL) { *(float4*)&Bs1[k * 128 + (tid & 31) * 4] = bv10; *(float4*)&Bs1[(k + 16) * 128 + (tid & 31) * 4] = bv11; } }
        __syncthreads();
#pragma unroll 4
        for (int k = 0; k < 32; ++k) {
            const float4 a = *(const float4*)&As[k * 132 + ty * 4];
            const float4 b0 = *(const float4*)&Bs0[k * 128 + tx * 4], b1 = *(const float4*)&Bs0[k * 128 + 64 + tx * 4];
            const float aa[4] = {a.x, a.y, a.z, a.w};
            const float bb[8] = {b0.x, b0.y, b0.z, b0.w, b1.x, b1.y, b1.z, b1.w};
#pragma unroll
            for (int i = 0; i < 4; ++i)
#pragma unroll
                for (int j = 0; j < 8; ++j) acc0[i][j] = fmaf(aa[i], bb[j], acc0[i][j]);
            if (DUAL) {
                const float4 c0 = *(const float4*)&Bs1[k * 128 + tx * 4], c1 = *(const float4*)&Bs1[k * 128 + 64 + tx * 4];
                const float cc[8] = {c0.x, c0.y, c0.z, c0.w, c1.x, c1.y, c1.z, c1.w};
#pragma unroll
                for (int i = 0; i < 4; ++i)
#pragma unroll
                    for (int j = 0; j < 8; ++j) acc1[i][j] = fmaf(aa[i], cc[j], acc1[i][j]);
            }
        }
    }
#pragma unroll
    for (int i = 0; i < 4; ++i)
#pragma unroll
        for (int j = 0; j < 8; ++j) {
            const int r = ty * 4 + i, c = n0 + (j < 4 ? tx * 4 + j : 64 + tx * 4 + (j - 4));
            if (c < N) epi(r, c, acc0[i][j], acc1[i][j]);
        }
    __syncthreads();
}

__device__ __forceinline__ void ph_inproj(LAS unsigned char* ldsb, const bf16_t* xn, const bf16_t* wt, bf16_t* z, const float* RS, int skip) {
    pg8::StaticOrder S; S.init(NTOK, NMAIN, D, D, gridDim.x, blockIdx.x, xn, wt, INPROJ_WGM);
    if (skip & 2) S.pmmask = 15;
    pg8::EpiZ E{z, RS, skip & 1};
    pg8::gemm_phase<pg8::EpiZ, pg8::StaticOrder, false>(ldsb, D, D, S, E);
}

namespace ml {
using pg8::bf16x8; using pg8::f32x4; using pg8::u32x4; using pg8::u32x2;
constexpr int L = 128, NCH = S / L, NU = NB * 4 * NCH;
constexpr int QP = 144;
constexpr int OFF_Q = 0, OFF_K = OFF_Q + 128 * QP, OFF_V = OFF_K + 128 * QP, OFF_KW = OFF_V + 128 * QP, OFF_F = OFF_KW + 128 * QP;
constexpr int LDS_END = OFF_F + 4 * 128 * 4 + 64;
constexpr size_t O_CL = 0, O_CST = O_CL + (size_t)NU * 4096 * 4, O_NL = O_CST + (size_t)NU * 4096 * 2, O_NST = O_NL + (size_t)NU * 64 * 4,
                 O_MLOC = O_NST + (size_t)NU * 64 * 4, O_BL = O_MLOC + (size_t)NU * 4, O_MST = O_BL + (size_t)NU * 4, O_END = O_MST + (size_t)NU * 4;
__device__ __forceinline__ f32x4 mfma16(bf16x8 a, bf16x8 b, f32x4 c) { return __builtin_amdgcn_mfma_f32_16x16x32_bf16(a, b, c, 0, 0, 0); }
__device__ __forceinline__ float bf_lo(unsigned w) { return __uint_as_float(w << 16); }
__device__ __forceinline__ float bf_hi(unsigned w) { return __uint_as_float(w & 0xffff0000u); }
__device__ __forceinline__ unsigned short bf1(float x) { return (unsigned short)(pg8::cvt_pk_bf16(x, 0.f) & 0xffffu); }

__device__ __forceinline__ void stage_gates(LAS unsigned char* lds, const float* gates, const Params& P, int l, int head, int tok0, int tid) {
    LAS float* LF = (LAS float*)(lds + OFF_F); LAS float* IG = LF + 128; LAS float* Bc = LF + 256; LAS float* G2 = LF + 384; LAS float* scal = LF + 512;
    if (tid < 128) { const float* zr = gates + (size_t)(tok0 + tid) * 8;
        const float ipre = zr[head] + P.in[I_GATEB][l * 8 + head], fpre = zr[4 + head] + P.in[I_GATEB][l * 8 + 4 + head];
        LF[tid] = fminf(fpre, 0.f) - log1pf(expf(-fabsf(fpre))); IG[tid] = ipre; }
    __syncthreads();
    if (tid < 64) { const float a = LF[2 * tid], b2 = LF[2 * tid + 1]; const float s = a + b2; float inc = s;
#pragma unroll
        for (int o = 1; o < 64; o <<= 1) { const float v = __shfl_up(inc, o); if (tid >= o) inc += v; }
        const float exc = inc - s; const float b0 = exc + a, b1 = exc + s;
        Bc[2 * tid] = b0; Bc[2 * tid + 1] = b1; const float g0 = IG[2 * tid] - b0, g1 = IG[2 * tid + 1] - b1; G2[2 * tid] = g0; G2[2 * tid + 1] = g1;
        float gm = fmaxf(g0, g1);
#pragma unroll
        for (int o = 32; o > 0; o >>= 1) gm = fmaxf(gm, __shfl_xor(gm, o));
        if (tid == 63) { scal[0] = gm; scal[1] = b1; } }
    __syncthreads();
}
__device__ __forceinline__ void conv8_load(const bf16_t* z, int b, int pos, int which, int head, int c0, u32x4 (&raw)[4]) {
    const int col = (which ? ZCK : ZCQ) + head * 64 + c0;
#pragma unroll
    for (int j = 0; j < 4; ++j) { const int tg = pos - 3 + j; raw[j] = *(const u32x4*)(z + (size_t)(b * S + (tg > 0 ? tg : 0)) * ZW + col); }
}
__device__ __forceinline__ void conv8_finish(const u32x4 (&raw)[4], const float* cw, int pos, int which, int head, int c0, float (&o)[8]) {
    const int cc = which * 256 + head * 64 + c0;
    float x[8];
#pragma unroll
    for (int e = 0; e < 8; ++e) x[e] = 0.f;
    float4 wa[4], wb[4];
#pragma unroll
    for (int j = 0; j < 4; ++j) { wa[j] = *(const float4*)(cw + j * 512 + cc); wb[j] = *(const float4*)(cw + j * 512 + cc + 4); }
    __builtin_amdgcn_sched_barrier(0);
#pragma unroll
    for (int j = 0; j < 4; ++j) { const float mk = (pos - 3 + j >= 0) ? 1.f : 0.f;
        const float4 w0 = wa[j], w1 = wb[j];
        x[0] += mk * w0.x * bf_lo(raw[j].x); x[1] += mk * w0.y * bf_hi(raw[j].x); x[2] += mk * w0.z * bf_lo(raw[j].y); x[3] += mk * w0.w * bf_hi(raw[j].y);
        x[4] += mk * w1.x * bf_lo(raw[j].z); x[5] += mk * w1.y * bf_hi(raw[j].z); x[6] += mk * w1.z * bf_lo(raw[j].w); x[7] += mk * w1.w * bf_hi(raw[j].w); }
    const float sc = which ? 0.125f : 1.f;
#pragma unroll
    for (int e = 0; e < 8; ++e) o[e] = x[e] * sc * rsig(x[e]);
}
__device__ __forceinline__ void vt_load(const bf16_t* z, int head, int tok0, int tid, u32x4 (&w)[2]) {
#pragma unroll
    for (int it = 0; it < 2; ++it) { const int idx = tid + it * NTHREADS, s = idx >> 3, cg = idx & 7; w[it] = *(const u32x4*)(z + (size_t)(tok0 + s) * ZW + ZCV + head * 64 + cg * 8); }
}
__device__ __forceinline__ void vt_store(LAS unsigned char* lds, int tid, const u32x4 (&w)[2]) {
#pragma unroll
    for (int it = 0; it < 2; ++it) { const int idx = tid + it * NTHREADS, s = idx >> 3, cg = idx & 7; *(LAS u32x4*)(lds + OFF_V + s * QP + cg * 16) = w[it]; }
}

__device__ __forceinline__ void p1_unit(LAS unsigned char* lds, const bf16_t* z, const float* gates, const Params& P, int l, int u, unsigned char* wsm) {
    const int tid = tid_opaque(), lane = tid & 63, wid = __builtin_amdgcn_readfirstlane(tid >> 6), r = lane & 15, qd = lane >> 4;
    const int b = u >> 8, head = (u >> 6) & 3, c = u & 63, tok0 = b * S + c * L;
    LAS float* G2 = (LAS float*)(lds + OFF_F) + 384; LAS float* scal = (LAS float*)(lds + OFF_F) + 512;
    u32x4 vraw[2], kraw[2][4];
    vt_load(z, head, tok0, tid, vraw);
#pragma unroll
    for (int it = 0; it < 2; ++it) { const int idx = tid + it * NTHREADS; conv8_load(z, b, c * L + (idx >> 3), 1, head, (idx & 7) * 8, kraw[it]); }
    __syncthreads();
    stage_gates(lds, gates, P, l, head, tok0, tid);
    const float gmax = scal[0], bL = scal[1];
    vt_store(lds, tid, vraw);
    const float* cw = P.in[I_CONVW] + (size_t)l * 4 * 512;
#pragma unroll
    for (int it = 0; it < 2; ++it) { const int idx = tid + it * NTHREADS, s = idx >> 3, cg = idx & 7;
        float o[8]; conv8_finish(kraw[it], cw, c * L + s, 1, head, cg * 8, o);
        const float ws = __expf(G2[s] - gmax);
        u32x4 w; w.x = pg8::cvt_pk_bf16(o[0] * ws, o[1] * ws); w.y = pg8::cvt_pk_bf16(o[2] * ws, o[3] * ws); w.z = pg8::cvt_pk_bf16(o[4] * ws, o[5] * ws); w.w = pg8::cvt_pk_bf16(o[6] * ws, o[7] * ws);
        *(LAS u32x4*)(lds + OFF_KW + s * QP + cg * 16) = w; }
    __syncthreads();
    const int kt = wid >> 1;
    float* CL = (float*)(wsm + O_CL) + (size_t)u * 4096;
#pragma unroll
    for (int i = 0; i < 2; ++i) { const int vt = (wid & 1) * 2 + i; f32x4 acc = {0.f, 0.f, 0.f, 0.f};
#pragma unroll
        for (int ks = 0; ks < 4; ++ks) {
            const LAS unsigned char* ap = lds + OFF_KW + (32 * ks + 8 * qd + (r >> 2)) * QP + (16 * kt + 4 * (r & 3)) * 2; const LAS unsigned char* bp = lds + OFF_V + (32 * ks + 8 * qd + (r >> 2)) * QP + (16 * vt + 4 * (r & 3)) * 2;
            const u32x2_t a0 = lds_tr4(ap), a1 = lds_tr4(ap + 4 * QP), b0 = lds_tr4(bp), b1 = lds_tr4(bp + 4 * QP);
            const u32x4 aw = {a0.x, a0.y, a1.x, a1.y}, bw = {b0.x, b0.y, b1.x, b1.y};
            acc = mfma16(__builtin_bit_cast(bf16x8, aw), __builtin_bit_cast(bf16x8, bw), acc); }
        *(f32x4*)(CL + (size_t)(16 * vt + r) * 64 + 16 * kt + 4 * qd) = acc; }
    if (tid < 64) { float sum = 0.f;
        for (int s2 = 0; s2 < 128; ++s2) sum += __uint_as_float((unsigned)*(const LAS unsigned short*)(lds + OFF_KW + s2 * QP + tid * 2) << 16);
        ((float*)(wsm + O_NL))[(size_t)u * 64 + tid] = sum; }
    if (tid == 0) { ((float*)(wsm + O_MLOC))[u] = bL + gmax; ((float*)(wsm + O_BL))[u] = bL; }
}
__device__ __forceinline__ void p2_scan(unsigned char* wsm) {
    const int tid = tid_opaque();
    const float* CL = (const float*)(wsm + O_CL); const float* NL = (const float*)(wsm + O_NL); const float* MLOC = (const float*)(wsm + O_MLOC); const float* BL = (const float*)(wsm + O_BL);
    bf16_t* CST = (bf16_t*)(wsm + O_CST); float* NST = (float*)(wsm + O_NST); float* MST = (float*)(wsm + O_MST);
    for (int idx = blockIdx.x * NTHREADS + tid; idx < 32 * 4096; idx += gridDim.x * NTHREADS) {
        const int bh = idx >> 12, e = idx & 4095;
        float C = 0.f, nn = 0.f, m = 0.f;
#pragma unroll 1
        for (int c0 = 0; c0 < NCH; c0 += 16) {
            float cl[16], ml_[16], bl[16], nl[16];
#pragma unroll
            for (int i = 0; i < 16; ++i) { const int u = bh * NCH + c0 + i; cl[i] = CL[(size_t)u * 4096 + e]; ml_[i] = MLOC[u]; bl[i] = BL[u]; nl[i] = NL[(size_t)u * 64 + (e & 63)]; }
            unsigned short cs[16]; float ns[16], ms[16];
#pragma unroll
            for (int i = 0; i < 16; ++i) { cs[i] = bf1(C); ns[i] = nn; ms[i] = m;
                const float mn = fmaxf(bl[i] + m, ml_[i]), dec = __expf(bl[i] + m - mn), wl = __expf(ml_[i] - mn);
                C = dec * C + wl * cl[i]; nn = dec * nn + wl * nl[i]; m = mn; }
#pragma unroll
            for (int i = 0; i < 16; ++i) { const int u = bh * NCH + c0 + i; CST[(size_t)u * 4096 + e] = cs[i]; if (e < 64) NST[(size_t)u * 64 + e] = ns[i]; if (e == 0) MST[u] = ms[i]; }
        }
    }
}
__device__ __forceinline__ void p3_unit(LAS unsigned char* lds, const bf16_t* z, const float* gates, const Params& P, int l, int u, const unsigned char* wsm, bf16_t* mix) {
    const int tid = tid_opaque(), lane = tid & 63, wid = __builtin_amdgcn_readfirstlane(tid >> 6), r = lane & 15, qd = lane >> 4;
    const int b = u >> 8, head = (u >> 6) & 3, c = u & 63, tok0 = b * S + c * L;
    LAS float* Bc = (LAS float*)(lds + OFF_F) + 256; LAS float* G2 = (LAS float*)(lds + OFF_F) + 384;
    u32x4 vraw[2], qkraw[4][4];
    vt_load(z, head, tok0, tid, vraw);
#pragma unroll
    for (int it = 0; it < 4; ++it) { const int idx = tid + it * NTHREADS; conv8_load(z, b, c * L + ((idx >> 3) & 127), idx >> 10, head, (idx & 7) * 8, qkraw[it]); }
    __syncthreads();
    stage_gates(lds, gates, P, l, head, tok0, tid);
    vt_store(lds, tid, vraw);
    const float* cw = P.in[I_CONVW] + (size_t)l * 4 * 512;
#pragma unroll
    for (int it = 0; it < 4; ++it) { const int idx = tid + it * NTHREADS, which = idx >> 10, s = (idx >> 3) & 127, cg = idx & 7;
        float o[8]; conv8_finish(qkraw[it], cw, c * L + s, which, head, cg * 8, o);
        u32x4 w; w.x = pg8::cvt_pk_bf16(o[0], o[1]); w.y = pg8::cvt_pk_bf16(o[2], o[3]); w.z = pg8::cvt_pk_bf16(o[4], o[5]); w.w = pg8::cvt_pk_bf16(o[6], o[7]);
        *(LAS u32x4*)(lds + (which ? OFF_K : OFF_Q) + s * QP + cg * 16) = w; }
    __syncthreads();
    const int w = wid, t = 16 * w + r;
    const bf16x8 bq0 = *(const LAS bf16x8*)(lds + OFF_Q + t * QP + qd * 16), bq1 = *(const LAS bf16x8*)(lds + OFF_Q + t * QP + 64 + qd * 16);
    f32x4 accS[8];
#pragma unroll
    for (int ct = 0; ct < 8; ++ct) { accS[ct] = (f32x4){0.f, 0.f, 0.f, 0.f};
        if (ct <= w) { const bf16x8 a0 = *(const LAS bf16x8*)(lds + OFF_K + (16 * ct + r) * QP + qd * 16), a1 = *(const LAS bf16x8*)(lds + OFF_K + (16 * ct + r) * QP + 64 + qd * 16);
            accS[ct] = mfma16(a0, bq0, accS[ct]); accS[ct] = mfma16(a1, bq1, accS[ct]); } }
    const float bt = Bc[t], mst = ((const float*)(wsm + O_MST))[u];
    float ld[8][4]; float mloc = -3.0e38f;
#pragma unroll
    for (int ct = 0; ct < 8; ++ct) { const f32x4 g = *(const LAS f32x4*)(G2 + 16 * ct + 4 * qd);
#pragma unroll
        for (int j = 0; j < 4; ++j) { const bool valid = (ct < w) || (ct == w && 4 * qd + j <= r); ld[ct][j] = valid ? bt + g[j] : -3.0e38f; mloc = fmaxf(mloc, ld[ct][j]); } }
    mloc = fmaxf(mloc, __shfl_xor(mloc, 16)); mloc = fmaxf(mloc, __shfl_xor(mloc, 32));
    const float mt = fmaxf(bt + mst, mloc);
    float den = 0.f;
#pragma unroll
    for (int ct = 0; ct < 8; ++ct)
#pragma unroll
        for (int j = 0; j < 4; ++j) { const float pe = __expf(ld[ct][j] - mt) * accS[ct][j]; accS[ct][j] = pe; den += pe; }
    den += __shfl_xor(den, 16); den += __shfl_xor(den, 32);
    const bf16_t* cst = (const bf16_t*)(wsm + O_CST) + (size_t)u * 4096; const float* nst = (const float*)(wsm + O_NST) + (size_t)u * 64;
    f32x4 accN[4];
#pragma unroll
    for (int dt = 0; dt < 4; ++dt) { const bf16x8 c0 = *(const bf16x8*)(cst + (16 * dt + r) * 64 + 8 * qd), c1 = *(const bf16x8*)(cst + (16 * dt + r) * 64 + 32 + 8 * qd);
        accN[dt] = mfma16(c0, bq0, (f32x4){0.f, 0.f, 0.f, 0.f}); accN[dt] = mfma16(c1, bq1, accN[dt]); }
    const float winter = __expf(bt + mst - mt);
    float nq = 0.f;
    { const float4 n0 = *(const float4*)(nst + 8 * qd), n1 = *(const float4*)(nst + 8 * qd + 4), n2 = *(const float4*)(nst + 32 + 8 * qd), n3 = *(const float4*)(nst + 36 + 8 * qd);
      const u32x4 q0 = __builtin_bit_cast(u32x4, bq0), q1 = __builtin_bit_cast(u32x4, bq1);
      nq = bf_lo(q0.x) * n0.x + bf_hi(q0.x) * n0.y + bf_lo(q0.y) * n0.z + bf_hi(q0.y) * n0.w + bf_lo(q0.z) * n1.x + bf_hi(q0.z) * n1.y + bf_lo(q0.w) * n1.z + bf_hi(q0.w) * n1.w
         + bf_lo(q1.x) * n2.x + bf_hi(q1.x) * n2.y + bf_lo(q1.y) * n2.z + bf_hi(q1.y) * n2.w + bf_lo(q1.z) * n3.x + bf_hi(q1.z) * n3.y + bf_lo(q1.w) * n3.z + bf_hi(q1.w) * n3.w; }
    nq += __shfl_xor(nq, 16); nq += __shfl_xor(nq, 32);
    den += winter * nq;
#pragma unroll
    for (int dt = 0; dt < 4; ++dt) accN[dt] = accN[dt] * winter;
#pragma unroll
    for (int kk = 0; kk < 4; ++kk) if (2 * kk <= w) {
        u32x4 pw; pw.x = pg8::cvt_pk_bf16(accS[2 * kk][0], accS[2 * kk][1]); pw.y = pg8::cvt_pk_bf16(accS[2 * kk][2], accS[2 * kk][3]);
        pw.z = pg8::cvt_pk_bf16(accS[2 * kk + 1][0], accS[2 * kk + 1][1]); pw.w = pg8::cvt_pk_bf16(accS[2 * kk + 1][2], accS[2 * kk + 1][3]);
        const bf16x8 pf = __builtin_bit_cast(bf16x8, pw);
#pragma unroll
        for (int dt = 0; dt < 4; ++dt) { const LAS unsigned char* vp = lds + OFF_V + (32 * kk + 4 * qd + (r >> 2)) * QP + (16 * dt + 4 * (r & 3)) * 2;
            const u32x2_t v0 = lds_tr4(vp), v1 = lds_tr4(vp + 16 * QP);
            u32x4 vw; vw.x = v0.x; vw.y = v0.y; vw.z = v1.x; vw.w = v1.y;
            accN[dt] = mfma16(__builtin_bit_cast(bf16x8, vw), pf, accN[dt]); } }
    const float inv = 1.f / fmaxf(fabsf(den), __expf(-mt));
    float ss = 0.f;
#pragma unroll
    for (int dt = 0; dt < 4; ++dt) { accN[dt] = accN[dt] * inv; ss += accN[dt][0] * accN[dt][0] + accN[dt][1] * accN[dt][1] + accN[dt][2] * accN[dt][2] + accN[dt][3] * accN[dt][3]; }
    ss += __shfl_xor(ss, 16); ss += __shfl_xor(ss, 32);
    const float rs = rsqrtf(ss * (1.f / 64.f) + EPS);
    const float* ng = P.in[I_MNG] + l * 256 + head * 64; const bf16_t* cop = z + (size_t)(tok0 + t) * ZW + ZCO + head * 64;
    bf16_t* op = mix + (size_t)(tok0 + t) * D + 512 + head * 64;
#pragma unroll
    for (int dt = 0; dt < 4; ++dt) { const int d0 = 16 * dt + 4 * qd; const float4 g = *(const float4*)(ng + d0); const u32x2 cw2 = *(const u32x2*)(cop + d0); const float4 co = make_float4(bf_lo(cw2.x), bf_hi(cw2.x), bf_lo(cw2.y), bf_hi(cw2.y));
        u32x2 o; o.x = pg8::cvt_pk_bf16(accN[dt][0] * rs * g.x * rsig(co.x), accN[dt][1] * rs * g.y * rsig(co.y));
        o.y = pg8::cvt_pk_bf16(accN[dt][2] * rs * g.z * rsig(co.z), accN[dt][3] * rs * g.w * rsig(co.w));
        *(u32x2*)(op + d0) = o; }
}
static_assert(O_END <= 64 * MiB && LDS_END <= 128 * 1024, "mLSTM scratch fits");
}

namespace s5 {
using pg8::bf16x8; using pg8::f32x4; using pg8::u32x4; using pg8::u32x2;
constexpr int LC = 16, NINST = NTOK / LC;
constexpr size_t O_E = 0, O_XC = O_E + (size_t)NINST * 16 * 128 * 4, O_END = O_XC + (size_t)NINST * 16 * 128 * 2;
constexpr int YP = 528;
__device__ __forceinline__ f32x4 mfma16(bf16x8 a, bf16x8 b, f32x4 c) { return __builtin_amdgcn_mfma_f32_16x16x32_bf16(a, b, c, 0, 0, 0); }

__device__ __forceinline__ void build_tables(float* ldsf, const Params& P, int l, int g, unsigned char* tb) {
    const int tid = tid_opaque();
    float* apw = ldsf; float* bb = apw + 17 * 64 * 2; float* cc = bb + 64 * 16 * 2;
    __syncthreads();
    if (tid < 64) { const int gp = (l * 16 + g) * 64 + tid;
        const float ar = P.in[I_ARE][gp], ai = P.in[I_AIM][gp], dt = expf(P.in[I_LDT][l * 16 + g]);
        for (int tau = 0; tau <= 16; ++tau) { const float er = expf(ar * dt * tau), ang = ai * dt * tau; apw[(tau * 64 + tid) * 2] = er * cosf(ang); apw[(tau * 64 + tid) * 2 + 1] = er * sinf(ang); }
        const float abr = apw[(64 + tid) * 2], abi = apw[(64 + tid) * 2 + 1];
        const float xr_ = abr - 1.f, xi_ = abi, den = ar * ar + ai * ai;
        const float cr = (xr_ * ar + xi_ * ai) / den, ci = (xi_ * ar - xr_ * ai) / den;
        for (int h = 0; h < 16; ++h) { const float br = P.in[I_BRE][(size_t)gp * 16 + h], bi = P.in[I_BIM][(size_t)gp * 16 + h]; bb[(tid * 16 + h) * 2] = cr * br - ci * bi; bb[(tid * 16 + h) * 2 + 1] = cr * bi + ci * br; }
        float* a16 = (float*)(tb + T_A16) + (size_t)(g * 64 + tid) * 2; a16[0] = apw[(16 * 64 + tid) * 2]; a16[1] = apw[(16 * 64 + tid) * 2 + 1]; }
    for (int idx = tid; idx < 16 * 64; idx += NTHREADS) { const int h = idx >> 6, p = idx & 63; const int ci_ = ((l * 16 + g) * 16 + h) * 64 + p; cc[idx * 2] = P.in[I_CRE][ci_]; cc[idx * 2 + 1] = P.in[I_CIM][ci_]; }
    __syncthreads();
    bf16_t* KM = (bf16_t*)(tb + T_KMAT) + (size_t)g * 32 * 256;
    for (int idx = tid; idx < 15 * 256; idx += NTHREADS) KM[idx] = (bf16_t)0; bf16_t* FT = (bf16_t*)(tb + T_F) + (size_t)g * 256 * 128; bf16_t* GT = (bf16_t*)(tb + T_G) + (size_t)g * 128 * 256;
    for (int idx = tid; idx < 16 * 256; idx += NTHREADS) { const int tau = idx >> 8, h = (idx >> 4) & 15, hp = idx & 15; float s = 0.f;
        for (int p = 0; p < 64; ++p) { const float cr = cc[(h * 64 + p) * 2], ci = cc[(h * 64 + p) * 2 + 1], ar = apw[(tau * 64 + p) * 2], ai = apw[(tau * 64 + p) * 2 + 1], br = bb[(p * 16 + hp) * 2], bi = bb[(p * 16 + hp) * 2 + 1];
            const float er = ar * br - ai * bi, ei = ar * bi + ai * br; s += cr * er - ci * ei; }
        KM[15 * 256 + idx] = ml::bf1(s); }
    for (int idx = tid; idx < 256 * 64; idx += NTHREADS) { const int n = idx >> 6, p = idx & 63, t = n >> 4, h = n & 15;
        const float cr = cc[(h * 64 + p) * 2], ci = cc[(h * 64 + p) * 2 + 1], ar = apw[((t + 1) * 64 + p) * 2], ai = apw[((t + 1) * 64 + p) * 2 + 1];
        FT[(size_t)n * 128 + p] = ml::bf1(cr * ar - ci * ai); FT[(size_t)n * 128 + 64 + p] = ml::bf1(-(cr * ai + ci * ar)); }
    for (int idx = tid; idx < 64 * 256; idx += NTHREADS) { const int p = idx >> 8, k = idx & 255, s = k >> 4, hp = k & 15;
        const float ar = apw[((15 - s) * 64 + p) * 2], ai = apw[((15 - s) * 64 + p) * 2 + 1], br = bb[(p * 16 + hp) * 2], bi = bb[(p * 16 + hp) * 2 + 1];
        GT[(size_t)p * 256 + k] = ml::bf1(ar * br - ai * bi); GT[(size_t)(64 + p) * 256 + k] = ml::bf1(ar * bi + ai * br); }
}
__device__ __forceinline__ void load_u_frags(const bf16_t* z, int tok0, int g, int r, int qd, bf16x8 (&uf)[8]) {
#pragma unroll
    for (int ks = 0; ks < 8; ++ks) uf[ks] = *(const bf16x8*)(z + (size_t)(tok0 + 16 * r + 2 * ks + (qd >> 1)) * ZW + ZSU + 16 * g + 8 * (qd & 1));
}
__device__ __forceinline__ void p1_unit(const bf16_t* z, const unsigned char* tb, int u, unsigned char* wss) {
    const int tid = tid_opaque(), lane = tid & 63, wid = __builtin_amdgcn_readfirstlane(tid >> 6), r = lane & 15, qd = lane >> 4;
    const int tok0 = u * 256, inst0 = u * 16;
    float* E = (float*)(wss + O_E);
#pragma unroll 1
    for (int gi = 0; gi < 2; ++gi) { const int g = 2 * wid + gi;
        bf16x8 uf[8]; load_u_frags(z, tok0, g, r, qd, uf);
        const bf16_t* GT = (const bf16_t*)(tb + T_G) + (size_t)g * 128 * 256 + (size_t)r * 256 + 8 * qd;
        bf16x8 gf[2][8];
#pragma unroll
        for (int ks = 0; ks < 8; ++ks) gf[0][ks] = *(const bf16x8*)(GT + 32 * ks);
#pragma unroll
        for (int nt = 0; nt < 8; ++nt) {
            if (nt + 1 < 8) {
#pragma unroll
                for (int ks = 0; ks < 8; ++ks) gf[(nt + 1) & 1][ks] = *(const bf16x8*)(GT + (size_t)(16 * (nt + 1)) * 256 + 32 * ks); }
            __builtin_amdgcn_sched_barrier(0);
            f32x4 acc = {0.f, 0.f, 0.f, 0.f};
#pragma unroll
            for (int ks = 0; ks < 8; ++ks) acc = mfma16(gf[nt & 1][ks], uf[ks], acc);
            *(f32x4*)(E + ((size_t)(inst0 + r) * 16 + g) * 128 + 16 * nt + 4 * qd) = acc;
            __builtin_amdgcn_sched_barrier(0); }
    }
}
__device__ __forceinline__ void p2_scan(LAS unsigned char* lds, const unsigned char* tb, unsigned char* wss) {
    const int tid = tid_opaque(), p = tid & 63, seg = tid >> 6;
    const float* __restrict__ E = (const float*)(wss + O_E); bf16_t* __restrict__ XC = (bf16_t*)(wss + O_XC);
    LAS float* SE = (LAS float*)lds;
    for (int u = blockIdx.x; u < NB * 16; u += gridDim.x) {
        const int b = u >> 4, g = u & 15;
        const float* a16 = (const float*)(tb + T_A16) + (size_t)(g * 64 + p) * 2; const float ar = a16[0], ai = a16[1];
        const size_t o0 = ((size_t)(b * (S / LC) + seg * 64) * 16 + g) * 128 + p; constexpr size_t cs = (size_t)16 * 128;
        float xr = 0.f, xi = 0.f;
#pragma unroll 1
        for (int c0 = 0; c0 < 64; c0 += 16) { float er[16], ei[16];
#pragma unroll
            for (int i = 0; i < 16; ++i) { er[i] = E[o0 + (c0 + i) * cs]; ei[i] = E[o0 + (c0 + i) * cs + 64]; }
#pragma unroll
            for (int i = 0; i < 16; ++i) { const float nr = ar * xr - ai * xi + er[i], ni = ar * xi + ai * xr + ei[i]; xr = nr; xi = ni; } }
        __syncthreads();
        SE[(seg * 64 + p) * 2] = xr; SE[(seg * 64 + p) * 2 + 1] = xi;
        __syncthreads();
        float br = ar, bi = ai;
#pragma unroll
        for (int i = 0; i < 6; ++i) { const float nr = br * br - bi * bi, ni = 2.f * br * bi; br = nr; bi = ni; }
        xr = 0.f; xi = 0.f;
        for (int s2 = 0; s2 < seg; ++s2) { const float er = SE[(s2 * 64 + p) * 2], ei = SE[(s2 * 64 + p) * 2 + 1]; const float nr = br * xr - bi * xi + er, ni = br * xi + bi * xr + ei; xr = nr; xi = ni; }
#pragma unroll 1
        for (int c0 = 0; c0 < 64; c0 += 16) { float er[16], ei[16]; unsigned short sr[16], si[16];
#pragma unroll
            for (int i = 0; i < 16; ++i) { er[i] = E[o0 + (c0 + i) * cs]; ei[i] = E[o0 + (c0 + i) * cs + 64]; }
#pragma unroll
            for (int i = 0; i < 16; ++i) { sr[i] = ml::bf1(xr); si[i] = ml::bf1(xi); const float nr = ar * xr - ai * xi + er[i], ni = ar * xi + ai * xr + ei[i]; xr = nr; xi = ni; }
#pragma unroll
            for (int i = 0; i < 16; ++i) { XC[o0 + (c0 + i) * cs] = sr[i]; XC[o0 + (c0 + i) * cs + 64] = si[i]; } }
    }
    __syncthreads();
}
__device__ __forceinline__ void p3_unit(LAS unsigned char* lds, const bf16_t* z, const Params& P, int l, const unsigned char* tb, int u, const unsigned char* wss, bf16_t* mix) {
    const int tid = tid_opaque(), lane = tid & 63, wid = __builtin_amdgcn_readfirstlane(tid >> 6), r = lane & 15, qd = lane >> 4;
    const int tok0 = u * 256, inst0 = u * 16;
    const bf16_t* XC = (const bf16_t*)(wss + O_XC);
    __syncthreads();
#pragma unroll 1
    for (int gi = 0; gi < 2; ++gi) { const int g = 2 * wid + gi;
        bf16x8 uf[8]; load_u_frags(z, tok0, g, r, qd, uf);
        bf16x8 xf[4];
#pragma unroll
        for (int ks = 0; ks < 4; ++ks) xf[ks] = *(const bf16x8*)(XC + ((size_t)(inst0 + r) * 16 + g) * 128 + 32 * ks + 8 * qd);
        const bf16_t* KM = (const bf16_t*)(tb + T_KMAT) + (size_t)g * 32 * 256 + (size_t)(15 - (qd >> 1)) * 256 + r * 16 + 8 * (qd & 1);
        const bf16_t* FT = (const bf16_t*)(tb + T_F) + (size_t)g * 256 * 128 + (size_t)r * 128 + 8 * qd;
        const bf16_t* up = z + (size_t)(tok0 + 16 * r) * ZW + ZSU + 16 * g + 4 * qd;
        const float4 dsk = *(const float4*)(P.in[I_SD] + l * 256 + g * 16 + 4 * qd);
        bf16x8 kf[2][8], ff[2][4]; u32x2 uw[2];
#pragma unroll
        for (int ks = 0; ks < 8; ++ks) kf[0][ks] = *(const bf16x8*)(KM + (ptrdiff_t)(0 - 2 * ks) * 256);
#pragma unroll
        for (int ks = 0; ks < 4; ++ks) ff[0][ks] = *(const bf16x8*)(FT + 32 * ks);
        uw[0] = *(const u32x2*)up;
#pragma unroll
        for (int t = 0; t < 16; ++t) {
            if (t + 1 < 16) {
#pragma unroll
                for (int ks = 0; ks < 8; ++ks) kf[(t + 1) & 1][ks] = *(const bf16x8*)(KM + (ptrdiff_t)(t + 1 - 2 * ks) * 256);
#pragma unroll
                for (int ks = 0; ks < 4; ++ks) ff[(t + 1) & 1][ks] = *(const bf16x8*)(FT + (size_t)(t + 1) * 16 * 128 + 32 * ks);
                uw[(t + 1) & 1] = *(const u32x2*)(up + (size_t)(t + 1) * ZW); }
            __builtin_amdgcn_sched_barrier(0);
            f32x4 acc = {0.f, 0.f, 0.f, 0.f};
#pragma unroll
            for (int ks = 0; ks < 8; ++ks) if (2 * ks <= t) acc = mfma16(kf[t & 1][ks], uf[ks], acc);
#pragma unroll
            for (int ks = 0; ks < 4; ++ks) acc = mfma16(ff[t & 1][ks], xf[ks], acc);
            const u32x2 uu = uw[t & 1];
            const float y0 = gelu_tanh(acc[0] + dsk.x * ml::bf_lo(uu.x)), y1 = gelu_tanh(acc[1] + dsk.y * ml::bf_hi(uu.x)), y2 = gelu_tanh(acc[2] + dsk.z * ml::bf_lo(uu.y)), y3 = gelu_tanh(acc[3] + dsk.w * ml::bf_hi(uu.y));
            u32x2 o; o.x = pg8::cvt_pk_bf16(y0, y1); o.y = pg8::cvt_pk_bf16(y2, y3);
            *(LAS u32x2*)(lds + (16 * r + t) * YP + (16 * g + 4 * qd) * 2) = o;
            __builtin_amdgcn_sched_barrier(0); }
    }
    __syncthreads();
    const bf16_t* GW = (const bf16_t*)(tb + T_GLUW);
    bf16x8 wf[2][8];
#pragma unroll
    for (int nt = 0; nt < 2; ++nt)
#pragma unroll
        for (int ks = 0; ks < 8; ++ks) wf[nt][ks] = *(const bf16x8*)(GW + (size_t)(32 * wid + 16 * nt + r) * 256 + 32 * ks + 8 * qd);
    const float* gb = P.in[I_GLUB] + l * 256;
    const float4 gb0 = *(const float4*)(gb + 32 * wid + 4 * qd), gb1 = *(const float4*)(gb + 32 * wid + 16 + 4 * qd);
#pragma unroll 2
    for (int mt = 0; mt < 16; ++mt) {
        f32x4 a0 = {0.f, 0.f, 0.f, 0.f}, a1 = {0.f, 0.f, 0.f, 0.f};
#pragma unroll
        for (int ks = 0; ks < 8; ++ks) { const bf16x8 yf = *(const LAS bf16x8*)(lds + (16 * mt + r) * YP + (32 * ks + 8 * qd) * 2); a0 = mfma16(wf[0][ks], yf, a0); a1 = mfma16(wf[1][ks], yf, a1); }
        const int row = 16 * mt + r;
        const u32x2 y0 = *(const LAS u32x2*)(lds + row * YP + (32 * wid + 4 * qd) * 2), y1 = *(const LAS u32x2*)(lds + row * YP + (32 * wid + 16 + 4 * qd) * 2);
        bf16_t* op = mix + (size_t)(tok0 + row) * D + 256 + 32 * wid + 4 * qd;
        u32x2 o;
        o.x = pg8::cvt_pk_bf16(ml::bf_lo(y0.x) * rsig(a0[0] + gb0.x), ml::bf_hi(y0.x) * rsig(a0[1] + gb0.y));
        o.y = pg8::cvt_pk_bf16(ml::bf_lo(y0.y) * rsig(a0[2] + gb0.z), ml::bf_hi(y0.y) * rsig(a0[3] + gb0.w));
        *(u32x2*)op = o;
        o.x = pg8::cvt_pk_bf16(ml::bf_lo(y1.x) * rsig(a1[0] + gb1.x), ml::bf_hi(y1.x) * rsig(a1[1] + gb1.y));
        o.y = pg8::cvt_pk_bf16(ml::bf_lo(y1.y) * rsig(a1[2] + gb1.z), ml::bf_hi(y1.y) * rsig(a1[3] + gb1.w));
        *(u32x2*)(op + 16) = o;
    }
}
static_assert(T_LAYER <= 4 * MiB && O_END <= 48 * MiB && 256 * YP <= LDS_BYTES - 64, "S5 scratch fits");
}
__device__ __forceinline__ void s5_build_tables_fwd(float* ldsf, const Params& P, int l, int g, unsigned char* tb) { s5::build_tables(ldsf, P, l, g, tb); }

namespace at {
using pg8::bf16x8; using pg8::f32x4; using pg8::u32x4; using pg8::u32x2;
constexpr int KP = 144, OFF_K = 0, OFF_V = 256 * KP, LDS_END = OFF_V + 256 * KP;
__device__ __forceinline__ void unit(LAS unsigned char* lds, const bf16_t* z, const float* sinks, bf16_t* mix, int u) {
    const int tid = tid_opaque(), lane = tid & 63, wid = __builtin_amdgcn_readfirstlane(tid >> 6), r = lane & 15, qd = lane >> 4;
    const int b = u >> 7, g = (u >> 6) & 1, n = u & 63, tokb = b * S + 128 * n;
    const int hq = 2 * g + (wid >> 2);
    const float sink = sinks[hq];
    __syncthreads();
    u32x4 kw[4], vw[4];
#pragma unroll
    for (int it = 0; it < 4; ++it) { const int idx = tid + it * NTHREADS, kl = idx >> 3, cg = idx & 7; const bool ok = (n > 0) || (kl >= 128);
        kw[it] = *(const u32x4*)(z + (size_t)(ok ? tokb - 128 + kl : tokb) * ZW + ZK + g * 64 + cg * 8); }
#pragma unroll
    for (int it = 0; it < 4; ++it) { const int idx = tid + it * NTHREADS, kl = idx >> 3, cg = idx & 7; const bool ok = (n > 0) || (kl >= 128);
        vw[it] = *(const u32x4*)(z + (size_t)(ok ? tokb - 128 + kl : tokb) * ZW + ZV + g * 64 + cg * 8); }
    __builtin_amdgcn_sched_barrier(0);
#pragma unroll
    for (int it = 0; it < 4; ++it) { const int idx = tid + it * NTHREADS, kl = idx >> 3, cg = idx & 7; const bool ok = (n > 0) || (kl >= 128);
        u32x4 w = kw[it]; if (!ok) w = (u32x4){0u, 0u, 0u, 0u};
        *(LAS u32x4*)(lds + OFF_K + kl * KP + cg * 16) = w; }
#pragma unroll
    for (int it = 0; it < 4; ++it) { const int idx = tid + it * NTHREADS, kl = idx >> 3, cg = idx & 7; const bool ok = (n > 0) || (kl >= 128);
        u32x4 w = vw[it]; if (!ok) w = (u32x4){0u, 0u, 0u, 0u};
        *(LAS u32x4*)(lds + OFF_V + kl * KP + cg * 16) = w; }
    __syncthreads();
#pragma unroll 1
    for (int qt = 0; qt < 2; ++qt) {
        const int i0 = (wid & 3) * 32 + qt * 16, kt0 = i0 >> 4, tok = tokb + i0 + r;
        const bf16x8 bq0 = *(const bf16x8*)(z + (size_t)tok * ZW + ZQ + hq * 64 + 8 * qd), bq1 = *(const bf16x8*)(z + (size_t)tok * ZW + ZQ + hq * 64 + 32 + 8 * qd);
        f32x4 accS[9];
#pragma unroll
        for (int c = 0; c < 9; ++c) { const int kt = kt0 + c;
            const bf16x8 a0 = *(const LAS bf16x8*)(lds + OFF_K + (16 * kt + r) * KP + qd * 16), a1 = *(const LAS bf16x8*)(lds + OFF_K + (16 * kt + r) * KP + 64 + qd * 16);
            accS[c] = ml::mfma16(a0, bq0, (f32x4){0.f, 0.f, 0.f, 0.f}); accS[c] = ml::mfma16(a1, bq1, accS[c]); }
        float m = sink;
#pragma unroll
        for (int c = 0; c < 9; ++c)
#pragma unroll
            for (int j = 0; j < 4; ++j) { const int e = 4 * qd + j;
                bool valid = (c == 0) ? (e > r) : ((c == 8) ? (e <= r) : true);
                valid = valid && ((n > 0) || (kt0 + c >= 8));
                const float s = valid ? accS[c][j] * 0.125f : -3.0e38f; accS[c][j] = s; m = fmaxf(m, s); }
        m = fmaxf(m, __shfl_xor(m, 16)); m = fmaxf(m, __shfl_xor(m, 32));
        float l = 0.f;
#pragma unroll
        for (int c = 0; c < 9; ++c)
#pragma unroll
            for (int j = 0; j < 4; ++j) { const float p = __expf(accS[c][j] - m); accS[c][j] = p; l += p; }
        l += __shfl_xor(l, 16); l += __shfl_xor(l, 32);
        l += __expf(sink - m);
        f32x4 accO[4];
#pragma unroll
        for (int dt = 0; dt < 4; ++dt) accO[dt] = (f32x4){0.f, 0.f, 0.f, 0.f};
#pragma unroll
        for (int kk = 0; kk < 5; ++kk) {
            u32x4 pw; pw.x = pg8::cvt_pk_bf16(accS[2 * kk][0], accS[2 * kk][1]); pw.y = pg8::cvt_pk_bf16(accS[2 * kk][2], accS[2 * kk][3]);
            if (kk < 4) { pw.z = pg8::cvt_pk_bf16(accS[2 * kk + 1][0], accS[2 * kk + 1][1]); pw.w = pg8::cvt_pk_bf16(accS[2 * kk + 1][2], accS[2 * kk + 1][3]); } else { pw.z = 0u; pw.w = 0u; }
            const bf16x8 pf = __builtin_bit_cast(bf16x8, pw);
            const int base = 16 * (kt0 + 2 * kk);
#pragma unroll
            for (int dt = 0; dt < 4; ++dt) { const LAS unsigned char* vp = lds + OFF_V + (base + 4 * qd + (r >> 2)) * KP + (16 * dt + 4 * (r & 3)) * 2;
                const u32x2_t v0 = lds_tr4(vp);
                u32x2_t v1 = {0u, 0u}; if (kk < 4) v1 = lds_tr4(vp + 16 * KP);
                u32x4 vw; vw.x = v0.x; vw.y = v0.y; vw.z = v1.x; vw.w = v1.y;
                accO[dt] = ml::mfma16(__builtin_bit_cast(bf16x8, vw), pf, accO[dt]); } }
        const float inv = 1.f / l;
        bf16_t* op = mix + (size_t)tok * D + hq * 64;
#pragma unroll
        for (int dt = 0; dt < 4; ++dt) { u32x2 o; o.x = pg8::cvt_pk_bf16(accO[dt][0] * inv, accO[dt][1] * inv); o.y = pg8::cvt_pk_bf16(accO[dt][2] * inv, accO[dt][3] * inv);
            *(u32x2*)(op + 16 * dt + 4 * qd) = o; }
    }
}
}

namespace sg {
using pg8::bf16x8; using pg8::f32x4; using pg8::u32x4; using pg8::u32x2;
constexpr int VP = 528, OFF_V = 0, OFF_ST = 128 * VP, LDS_END = OFF_ST + 128 * 4 * 2 * 4;
__device__ __forceinline__ void unit(LAS unsigned char* lds, const bf16_t* z, const Params& P, int l, const bf16_t* wb  , bf16_t* mix, int u) {
    const int tid = tid_opaque(), lane = tid & 63, wid = __builtin_amdgcn_readfirstlane(tid >> 6), r = lane & 15, qd = lane >> 4;
    const int tok0 = u * 128;
    LAS float* ST = (LAS float*)(lds + OFF_ST);
    __syncthreads();
    const int s = tid & 127, cq = tid >> 7;
    const bf16_t* gp = z + (size_t)(tok0 + s) * ZW + ZGV + cq * 64;
    u32x4 raw[8];
#pragma unroll
    for (int i = 0; i < 8; ++i) raw[i] = *(const u32x4*)(gp + 8 * i);
    const int t = 16 * wid + r;
    bf16x8 wf[2][4];
#pragma unroll
    for (int ks = 0; ks < 4; ++ks) wf[0][ks] = *(const bf16x8*)(wb + (size_t)t * 128 + 32 * ks + 8 * qd);
    float sm = 0.f, sq = 0.f;
#pragma unroll
    for (int i = 0; i < 8; ++i) { const unsigned ww[4] = {raw[i].x, raw[i].y, raw[i].z, raw[i].w};
#pragma unroll
        for (int e = 0; e < 8; ++e) { const float ge = gelu_tanh((e & 1) ? bfh(ww[e >> 1]) : bfl(ww[e >> 1])); sm += ge; sq += ge * ge; } }
    ST[(s * 4 + cq) * 2] = sm; ST[(s * 4 + cq) * 2 + 1] = sq;
    __syncthreads();
    { float tsm = 0.f, tsq = 0.f;
#pragma unroll
      for (int q = 0; q < 4; ++q) { tsm += ST[(s * 4 + q) * 2]; tsq += ST[(s * 4 + q) * 2 + 1]; }
      const float mu = tsm * (1.f / 256.f), var = fmaxf(tsq * (1.f / 256.f) - mu * mu, 0.f), rs = rsqrtf(var + EPS);
      const float* lg = P.in[I_LNG] + l * 256 + cq * 64; const float* lb = P.in[I_LNB] + l * 256 + cq * 64;
#pragma unroll
      for (int i = 0; i < 8; ++i) { const unsigned ww[4] = {raw[i].x, raw[i].y, raw[i].z, raw[i].w};
          const float4 g0 = *(const float4*)(lg + 8 * i), g1 = *(const float4*)(lg + 8 * i + 4), b0 = *(const float4*)(lb + 8 * i), b1 = *(const float4*)(lb + 8 * i + 4);
          const float gg[8] = {g0.x, g0.y, g0.z, g0.w, g1.x, g1.y, g1.z, g1.w}, bb[8] = {b0.x, b0.y, b0.z, b0.w, b1.x, b1.y, b1.z, b1.w};
          float o[8];
#pragma unroll
          for (int e = 0; e < 8; ++e) o[e] = (gelu_tanh((e & 1) ? bfh(ww[e >> 1]) : bfl(ww[e >> 1])) - mu) * rs * gg[e] + bb[e];
          u32x4 w; w.x = pg8::cvt_pk_bf16(o[0], o[1]); w.y = pg8::cvt_pk_bf16(o[2], o[3]); w.z = pg8::cvt_pk_bf16(o[4], o[5]); w.w = pg8::cvt_pk_bf16(o[6], o[7]);
          *(LAS u32x4*)(lds + OFF_V + s * VP + (cq * 64 + 8 * i) * 2) = w; } }
    __syncthreads();
    const LAS unsigned char* vtr = lds + OFF_V + (8 * qd + (r >> 2)) * VP + (4 * (r & 3)) * 2;
#pragma unroll
    for (int g = 0; g < 4; ++g) {
        if (g + 1 < 4) {
#pragma unroll
            for (int ks = 0; ks < 4; ++ks) wf[(g + 1) & 1][ks] = *(const bf16x8*)(wb + ((size_t)(g + 1) * 128 + t) * 128 + 32 * ks + 8 * qd); }
        const float bias = P.in[I_SGUB][l * 512 + g * 128 + t];
        u32x2 gw[4];
#pragma unroll
        for (int ct = 0; ct < 4; ++ct) gw[ct] = *(const u32x2*)(z + (size_t)(tok0 + t) * ZW + ZGU + g * 64 + 16 * ct + 4 * qd);
#pragma unroll
        for (int ct = 0; ct < 4; ++ct) { f32x4 acc = {0.f, 0.f, 0.f, 0.f};
#pragma unroll
            for (int ks = 0; ks < 4; ++ks) if (2 * ks <= wid) { const LAS unsigned char* ap = vtr + (32 * ks) * VP + (g * 64 + 16 * ct) * 2;
                const u32x2_t a0 = lds_tr4(ap), a1 = lds_tr4(ap + 4 * VP); const u32x4 aw = {a0.x, a0.y, a1.x, a1.y};
                acc = ml::mfma16(__builtin_bit_cast(bf16x8, aw), wf[g & 1][ks], acc); }
            const int c0 = g * 64 + 16 * ct + 4 * qd;
            u32x2 o; o.x = pg8::cvt_pk_bf16(gelu_tanh(bfl(gw[ct].x)) * (acc[0] + bias), gelu_tanh(bfh(gw[ct].x)) * (acc[1] + bias)); o.y = pg8::cvt_pk_bf16(gelu_tanh(bfl(gw[ct].y)) * (acc[2] + bias), gelu_tanh(bfh(gw[ct].y)) * (acc[3] + bias));
            *(u32x2*)(mix + (size_t)(tok0 + t) * D + 768 + c0) = o; }
    }
}
}

__device__ __forceinline__ void ph_mix1(float* lds, const Params& P, int l, bf16_t* z, const float* gates, bf16_t* mix, unsigned char* wsm, unsigned char* wss, const unsigned char* tb, int sub) {
    const int G = gridDim.x, bid = blockIdx.x;
    if (sub & 1) for (int u = bid; u < ml::NU; u += G) ml::p1_unit((LAS unsigned char*)lds, z, gates, P, l, u, wsm);
    __syncthreads();
    if (sub & 2) for (int u = bid; u < NTOK / 256; u += G) s5::p1_unit(z, tb, u, wss);
    __syncthreads();
    if (sub & 4) for (int u = bid; u < 1024; u += G) at::unit((LAS unsigned char*)lds, z, P.in[I_SINK] + l * 4, mix, u);
    __syncthreads();
    if (sub & 8) for (int u = bid; u < NTOK / 128; u += G) sg::unit((LAS unsigned char*)lds, z, P, l, (const bf16_t*)(tb + s5::T_SGUW), mix, u);
    __syncthreads();
}

__device__ __forceinline__ void ph_mix2(float* lds, const Params& P, int l, const bf16_t* z, const float* gates, bf16_t* mix, const unsigned char* wsm, const unsigned char* wss, const unsigned char* tb, int sub) {
    if (sub & 1) for (int u = blockIdx.x; u < NTOK / 256; u += gridDim.x) s5::p3_unit((LAS unsigned char*)lds, z, P, l, tb, u, wss, mix);
    __syncthreads();
    if (sub & 2) for (int u = blockIdx.x; u < ml::NU; u += gridDim.x) ml::p3_unit((LAS unsigned char*)lds, z, gates, P, l, u, wsm, mix);
    __syncthreads();
}

template <bool SRCF32>
__device__ __forceinline__ void ph_outproj(LAS unsigned char* ldsb, const bf16_t* mix, const bf16_t* wt, const float* xf, bf16_t* xb) {
    pg8::StaticOrder S; S.init(NTOK, D, D, D, gridDim.x, blockIdx.x, mix, wt);
    pg8::EpiResB<SRCF32> E{xf, xb};
    pg8::gemm_phase<pg8::EpiResB<SRCF32>, pg8::StaticOrder, false>(ldsb, D, D, S, E);
}

namespace rp {
using pg8::bf16x8; using pg8::f32x4; using pg8::u32x4;
constexpr size_t T_HI = 0, T_LO = (size_t)48 * D * 2, T_GHI = 2 * T_LO, T_GLO = T_GHI + (size_t)16 * D * 2, T_SIZE = T_GLO + (size_t)16 * D * 2;
static_assert(T_SIZE <= 256 * 1024, "row-pass tables fit their slot");
template <int NT, bool COMBINE> struct StepIn { float4 xa[2], xb[2]; u32x4 xr[2]; u32x4 y1[2], y2[2]; };
template <int NT> struct StepW { bf16x8 wh[NT], wl[NT]; };
__device__ __forceinline__ void build_base(LAS int* base, const unsigned* cnt) {
    __syncthreads();
    if (tid_opaque() == 0) { int b = 0; for (int e = 0; e < NEXP; ++e) { base[e] = b; b += (((int)cnt[e] + 255) >> 8) << 8; } }
    __syncthreads();
}
template <int NT, bool COMBINE, bool XBF>
__device__ __forceinline__ void run(LAS unsigned char* lds, const Params& P, int l, const float* x, bf16_t* xq, const bf16_t* YB, const unsigned* inv, const unsigned* cntprev,
                                    const bf16_t* WH, const bf16_t* WL, bf16_t* XN, float* RS, float* gates, unsigned* cnt, int2* lists, unsigned* invout) {
    const int tid = tid_opaque(), lane = tid & 63, wid = __builtin_amdgcn_readfirstlane(tid >> 6), r = lane & 15, qd = lane >> 4;
    LAS int* BASE = (LAS int*)(lds + 64 * 1024);
    LAS float* LG = (LAS float*)lds + wid * (32 * 49);
    if (COMBINE) build_base(BASE, cntprev);
    LAS unsigned* LCNT = (LAS unsigned*)(lds + 64 * 1024 + 256); LAS unsigned* GBASE = LCNT + 32;
    for (int rb0 = blockIdx.x * 8; rb0 < NTOK / 32; rb0 += gridDim.x * 8) {
        const int rb = rb0 + wid; const bool live = rb < NTOK / 32;
        const int row0 = (live ? rb : rb0) * 32;
        if (NT == 1 && !live) continue;
        size_t yr1[2] = {0, 0}, yr2[2] = {0, 0};
        if (COMBINE) {
#pragma unroll
            for (int mt = 0; mt < 2; ++mt) { const int row = row0 + 16 * mt + r; const unsigned i1 = inv[2 * row], i2 = inv[2 * row + 1];
                yr1[mt] = (size_t)(BASE[i1 >> 16] + (int)(i1 & 0xffffu)) * D; yr2[mt] = (size_t)(BASE[i2 >> 16] + (int)(i2 & 0xffffu)) * D; } }
        f32x4 acc[2][NT];
#pragma unroll
        for (int mt = 0; mt < 2; ++mt)
#pragma unroll
            for (int nt = 0; nt < NT; ++nt) acc[mt][nt] = (f32x4){0.f, 0.f, 0.f, 0.f};
        float ssq[2] = {0.f, 0.f};
        StepIn<NT, COMBINE> sb[3]; StepW<NT> sw[2];
        auto load = [&](StepIn<NT, COMBINE>& s, int ks) {
            const int k0 = 32 * ks + 8 * qd;
#pragma unroll
            for (int mt = 0; mt < 2; ++mt) {
                if (XBF) s.xr[mt] = *(const u32x4*)(xq + (size_t)(row0 + 16 * mt + r) * D + k0);
                else { const float* xp = x + (size_t)(row0 + 16 * mt + r) * D + k0; s.xa[mt] = *(const float4*)xp; s.xb[mt] = *(const float4*)(xp + 4); }
                if (COMBINE) { s.y1[mt] = *(const u32x4*)(YB + yr1[mt] + k0); s.y2[mt] = *(const u32x4*)(YB + yr2[mt] + k0); } }
        };
        auto loadw = [&](StepW<NT>& s, int ks) {
            const int k0 = 32 * ks + 8 * qd;
#pragma unroll
            for (int nt = 0; nt < NT; ++nt) { s.wh[nt] = *(const bf16x8*)(WH + (size_t)(16 * nt + r) * D + k0); s.wl[nt] = *(const bf16x8*)(WL + (size_t)(16 * nt + r) * D + k0); }
        };
        auto process = [&](const StepIn<NT, COMBINE>& s, const StepW<NT>& sw_, int ks) {
            const int k0 = 32 * ks + 8 * qd;
            bf16x8 xh[2], xl[2];
#pragma unroll
            for (int mt = 0; mt < 2; ++mt) { float4 a = s.xa[mt], b = s.xb[mt]; u32x4 h;
                if (XBF) { h = s.xr[mt]; a = make_float4(bfl(h.x), bfh(h.x), bfl(h.y), bfh(h.y)); b = make_float4(bfl(h.z), bfh(h.z), bfl(h.w), bfh(h.w)); }
                if (COMBINE) { const u32x4 p = s.y1[mt], q = s.y2[mt];
                    a.x += bfl(p.x) + bfl(q.x); a.y += bfh(p.x) + bfh(q.x); a.z += bfl(p.y) + bfl(q.y); a.w += bfh(p.y) + bfh(q.y);
                    b.x += bfl(p.z) + bfl(q.z); b.y += bfh(p.z) + bfh(q.z); b.z += bfl(p.w) + bfl(q.w); b.w += bfh(p.w) + bfh(q.w);
                    h.x = pg8::cvt_pk_bf16(a.x, a.y); h.y = pg8::cvt_pk_bf16(a.z, a.w); h.z = pg8::cvt_pk_bf16(b.x, b.y); h.w = pg8::cvt_pk_bf16(b.z, b.w);
                    *(u32x4*)(xq + (size_t)(row0 + 16 * mt + r) * D + k0) = h;
                    a = make_float4(bfl(h.x), bfh(h.x), bfl(h.y), bfh(h.y)); b = make_float4(bfl(h.z), bfh(h.z), bfl(h.w), bfh(h.w)); }
                ssq[mt] += a.x * a.x + a.y * a.y + a.z * a.z + a.w * a.w + b.x * b.x + b.y * b.y + b.z * b.z + b.w * b.w;
                if (!XBF) {
                    const float v[8] = {a.x, a.y, a.z, a.w, b.x, b.y, b.z, b.w};
                    h.x = pg8::cvt_pk_bf16(v[0], v[1]); h.y = pg8::cvt_pk_bf16(v[2], v[3]); h.z = pg8::cvt_pk_bf16(v[4], v[5]); h.w = pg8::cvt_pk_bf16(v[6], v[7]);
                    *(u32x4*)(XN + (size_t)(row0 + 16 * mt + r) * D + k0) = h;
                    u32x4 lo; lo.x = pg8::cvt_pk_bf16(v[0] - bfl(h.x), v[1] - bfh(h.x)); lo.y = pg8::cvt_pk_bf16(v[2] - bfl(h.y), v[3] - bfh(h.y)); lo.z = pg8::cvt_pk_bf16(v[4] - bfl(h.z), v[5] - bfh(h.z)); lo.w = pg8::cvt_pk_bf16(v[6] - bfl(h.w), v[7] - bfh(h.w));
                    xl[mt] = __builtin_bit_cast(bf16x8, lo); }
                xh[mt] = __builtin_bit_cast(bf16x8, h); }
#pragma unroll
            for (int nt = 0; nt < NT; ++nt)
#pragma unroll
                for (int mt = 0; mt < 2; ++mt) { acc[mt][nt] = ml::mfma16(sw_.wh[nt], xh[mt], acc[mt][nt]); acc[mt][nt] = ml::mfma16(sw_.wl[nt], xh[mt], acc[mt][nt]);
                    if (!XBF) acc[mt][nt] = ml::mfma16(sw_.wh[nt], xl[mt], acc[mt][nt]); }
        };
        if (COMBINE || NT > 1) {
            load(sb[0], 0); loadw(sw[0], 0);
#pragma unroll 1
            for (int ks = 0; ks < 32; ks += 2) {
                load(sb[1], ks + 1); loadw(sw[1], ks + 1);
                process(sb[0], sw[0], ks);
                if (ks + 2 < 32) { load(sb[0], ks + 2); loadw(sw[0], ks + 2); }
                process(sb[1], sw[1], ks + 1);
            }
        } else {
            load(sb[0], 0); load(sb[1], 1); loadw(sw[0], 0);
#define RP_STEP(i, xs, ws) do { if ((i) + 2 < 32) load(sb[((xs) + 2) % 3], (i) + 2); if ((i) + 1 < 32) loadw(sw[((ws) + 1) % 2], (i) + 1); process(sb[xs], sw[ws], (i)); } while (0)
#pragma unroll 1
            for (int ks = 0; ks < 30; ks += 6) { RP_STEP(ks, 0, 0); RP_STEP(ks + 1, 1, 1); RP_STEP(ks + 2, 2, 0); RP_STEP(ks + 3, 0, 1); RP_STEP(ks + 4, 1, 0); RP_STEP(ks + 5, 2, 1); }
            RP_STEP(30, 0, 0); RP_STEP(31, 1, 1);
#undef RP_STEP
        }
        float rsv[2];
#pragma unroll
        for (int mt = 0; mt < 2; ++mt) { float s = ssq[mt]; s += __shfl_xor(s, 16); s += __shfl_xor(s, 32); rsv[mt] = rsqrtf(s * (1.f / D) + EPS);
            if (qd == 0) RS[row0 + 16 * mt + r] = rsv[mt]; }
        if (NT == 1) {
#pragma unroll
            for (int mt = 0; mt < 2; ++mt) if (qd < 2) { const f32x4 gv = acc[mt][0] * rsv[mt]; *(f32x4*)(gates + (size_t)(row0 + 16 * mt + r) * 8 + 4 * qd) = gv; }
        } else {
            const float* bg = P.in[I_RGB] + l * 4; const float* be = P.in[I_REB] + l * 32;
#pragma unroll
            for (int mt = 0; mt < 2; ++mt)
#pragma unroll
                for (int nt = 0; nt < NT; ++nt)
#pragma unroll
                    for (int j = 0; j < 4; ++j) LG[(16 * mt + r) * 49 + 16 * nt + 4 * qd + j] = acc[mt][nt][j] * rsv[mt];
            wave_lds_fence();
            if (tid < 32) LCNT[tid] = 0u;
            __syncthreads();
            int ex1 = 0, ex2 = 0; float w1 = 0.f, w2 = 0.f; unsigned lp1 = 0u, lp2 = 0u;
            if (lane < 32 && live) {
                const LAS float* lg = LG + lane * 49;
                float gl[4];
#pragma unroll
                for (int j = 0; j < 4; ++j) gl[j] = lg[j] + bg[j];
                int sel = 0; float gm = gl[0];
#pragma unroll
                for (int j = 1; j < 4; ++j) if (gl[j] > gm) { gm = gl[j]; sel = j; }
                float gs = 0.f;
#pragma unroll
                for (int j = 0; j < 4; ++j) gs += expf(gl[j] - gm);
                const float pg = 1.f / gs;
                float ein[8];
#pragma unroll
                for (int j = 0; j < 8; ++j) ein[j] = lg[4 + sel * 8 + j] + be[sel * 8 + j];
                int i1 = 0; float v1 = ein[0];
#pragma unroll
                for (int j = 1; j < 8; ++j) if (ein[j] > v1) { v1 = ein[j]; i1 = j; }
                int i2 = -1; float v2 = -3.0e38f;
#pragma unroll
                for (int j = 0; j < 8; ++j) if (j != i1 && ein[j] > v2) { v2 = ein[j]; i2 = j; }
                const float e2 = expf(v2 - v1), den = 1.f / (1.f + e2);
                w1 = den * pg; w2 = e2 * den * pg;
                ex1 = sel * 8 + i1; ex2 = sel * 8 + i2;
                lp1 = atomicAdd((unsigned*)&LCNT[ex1], 1u); lp2 = atomicAdd((unsigned*)&LCNT[ex2], 1u);
            }
            __syncthreads();
            if (tid < 32) { const unsigned c = LCNT[tid]; GBASE[tid] = c ? atomicAdd(&cnt[tid], c) : 0u; }
            __syncthreads();
            if (lane < 32 && live) { const int row = row0 + lane; const unsigned p1 = GBASE[ex1] + lp1, p2 = GBASE[ex2] + lp2;
                lists[(size_t)ex1 * NTOK + p1] = make_int2(row, __float_as_int(w1));
                lists[(size_t)ex2 * NTOK + p2] = make_int2(row, __float_as_int(w2));
                invout[2 * row] = ((unsigned)ex1 << 16) | p1; invout[2 * row + 1] = ((unsigned)ex2 << 16) | p2; }
        }
    }
}
__device__ __forceinline__ void final_norm(LAS unsigned char* lds, const bf16_t* xb, float* out, const bf16_t* YB, const unsigned* inv, const unsigned* cntprev, const float* g) {
    const int tid = tid_opaque(), wave = tid >> 6, lane = tid & 63;
    LAS int* BASE = (LAS int*)(lds + 64 * 1024);
    build_base(BASE, cntprev);
    const float4* g4 = (const float4*)g;
    for (int r = blockIdx.x * 8 + wave; r < NTOK; r += gridDim.x * 8) {
        const unsigned i1 = inv[2 * r], i2 = inv[2 * r + 1];
        const bf16_t* y1 = YB + (size_t)(BASE[i1 >> 16] + (int)(i1 & 0xffffu)) * D; const bf16_t* y2 = YB + (size_t)(BASE[i2 >> 16] + (int)(i2 & 0xffffu)) * D;
        const u32x2_t* xp = (const u32x2_t*)(xb + (size_t)r * D);
        float4 v[4]; float ss = 0.f;
#pragma unroll
        for (int i = 0; i < 4; ++i) { const u32x2_t xw = xp[lane + 64 * i], a = *((const u32x2_t*)y1 + lane + 64 * i), b = *((const u32x2_t*)y2 + lane + 64 * i);
            v[i].x = bfl(xw.x) + bfl(a.x) + bfl(b.x); v[i].y = bfh(xw.x) + bfh(a.x) + bfh(b.x); v[i].z = bfl(xw.y) + bfl(a.y) + bfl(b.y); v[i].w = bfh(xw.y) + bfh(a.y) + bfh(b.y);
            ss += v[i].x * v[i].x + v[i].y * v[i].y + v[i].z * v[i].z + v[i].w * v[i].w; }
        ss = wave_sum(ss);
        const float rs = rsqrtf(ss * (1.f / D) + EPS);
        float4* p = (float4*)(out + (size_t)r * D);
#pragma unroll
        for (int i = 0; i < 4; ++i) { const float4 gg = g4[lane + 64 * i]; float4 o; o.x = v[i].x * rs * gg.x; o.y = v[i].y * rs * gg.y; o.z = v[i].z * rs * gg.z; o.w = v[i].w * rs * gg.w; p[lane + 64 * i] = o; }
    }
}
}

__device__ __forceinline__ int moe_build_tab(LAS unsigned char* ldsb, const unsigned* cnt) {
    LAS pg8::i32x4* tab = (LAS pg8::i32x4*)(ldsb + TAB_OFF);
    __syncthreads();
    int base = 0;
#pragma unroll 1
    for (int e = 0; e < NEXP; ++e) { const int c = __builtin_amdgcn_readfirstlane((int)cnt[e]), nt = (c + 255) >> 8;
        if ((int)tid_opaque() < nt) tab[base + tid_opaque()] = (pg8::i32x4){e, (int)tid_opaque() * 256, c, 0};
        base += nt; }
    __syncthreads();
    return base;
}
__device__ __forceinline__ void ph_moe1(LAS unsigned char* ldsb, const Params& P, int l, const bf16_t* H, const unsigned* cnt, const int2* lists, bf16_t* act) {
    const int ntiles = moe_build_tab(ldsb, cnt);
    pg8::MoeOrder S; S.tab = (const LAS pg8::i32x4*)(ldsb + TAB_OFF); S.ntiles = ntiles; S.npn = 4; S.G = gridDim.x; S.c = blockIdx.x;
    S.A = (const char*)H; S.atile = 0; S.Bt = (const char*)(P.ws + WS_WGU) + (size_t)l * NEXP * 1024 * D * 2; S.bexp = (size_t)1024 * D * 2; S.btile = (size_t)256 * D * 2; S.lists = lists;
    pg8::EpiAct E{act, lists, (const float*)(P.ws + WS_RS)};
    pg8::gemm_phase<pg8::EpiAct, pg8::MoeOrder, true>(ldsb, D, D, S, E);
}
__device__ __forceinline__ void ph_moe2(LAS unsigned char* ldsb, const Params& P, int l, const bf16_t* act, const unsigned* cnt, const int2* lists, bf16_t* yb) {
    const int ntiles = moe_build_tab(ldsb, cnt);
    pg8::MoeOrder S; S.tab = (const LAS pg8::i32x4*)(ldsb + TAB_OFF); S.ntiles = ntiles; S.npn = 4; S.G = gridDim.x; S.c = blockIdx.x;
    S.A = (const char*)act; S.atile = (size_t)256 * DE * 2; S.Bt = (const char*)(P.ws + WS_WD) + (size_t)l * NEXP * D * DE * 2; S.bexp = (size_t)D * DE * 2; S.btile = (size_t)256 * DE * 2; S.lists = lists;
    pg8::EpiY E{yb, lists};
    pg8::gemm_phase<pg8::EpiY, pg8::MoeOrder, false>(ldsb, DE, DE, S, E);
}

#ifndef PROBE_PH
#define PROBE_PH -1
#endif
#ifndef PROBE_SUB
#define PROBE_SUB 15
#endif
#ifndef PROBE_REPS
#define PROBE_REPS 4
#endif
__global__ void __launch_bounds__(NTHREADS, 2) fwd_kernel(Params P) {
    extern __shared__ __attribute__((aligned(16))) unsigned char lds_raw[];
    float* lds = (float*)lds_raw;
    volatile LAS unsigned* xbw = (volatile LAS unsigned*)(lds_raw + LDS_BYTES - 16);
    if (threadIdx.x == 0) { xbw[0] = 0u; xbw[1] = 0u; }
    __syncthreads();
    unsigned char* const ws = P.ws;
    unsigned* ctl = (unsigned*)(ws + WS_CTL);
    const bool multi = (P.ph_hi - P.ph_lo) > 1;
    XcdBarrier bar; bar.bar = ctl; bar.x = 0; bar.st = xbw;
    if (multi) bar = xcd_barrier_post(ctl, xbw);
    bf16_t* z = (bf16_t*)(ws + WS_Z); float* gates = (float*)(ws + WS_GATES); unsigned char* wss = ws + WS_S5; bf16_t* mix = (bf16_t*)(ws + WS_MIX); unsigned char* wsm = ws + WS_HRAW;
    bf16_t* act = (bf16_t*)(ws + WS_ACT); bf16_t* yb = (bf16_t*)(ws + WS_YB); bf16_t* xbuf = (bf16_t*)(ws + WS_XB); float* rsb = (float*)(ws + WS_RS);
    int2* lists = (int2*)(ws + WS_LIST);
    LAS unsigned char* ldsb = (LAS unsigned char*)lds_raw;
    const int lo = P.ph_lo, hi = P.ph_hi;
#define IN(k) (lo <= (k) && (k) < hi)
#define SEAM(k) do { if (IN(k) && IN((k) + 1)) xcd_barrier(bar); } while (0)
#if PROBE_PH >= 0
#define RUNPH(k, ...) do { if (IN(k)) { const int nrep = ((k) == PROBE_PH) ? 1 + PROBE_REPS : 1; for (int rep = 0; rep < nrep; ++rep) { __VA_ARGS__; if (rep + 1 < nrep) xcd_barrier(bar); } } SEAM(k); } while (0)
#else
#define RUNPH(k, ...) do { if (IN(k)) { constexpr int rep = 0; (void)rep; __VA_ARGS__; } SEAM(k); } while (0)
#endif
    RUNPH(0, ph_prologue(lds, PF));
    for (int l = 0; l < NLAYER; ++l) {
        const int pb = 1 + l * PH_PER_LAYER;
        unsigned* cnt = ctl + CW_CNT + l * 64;
        const unsigned char* tb = ws + WS_TB + (size_t)l * 4 * MiB;
        const unsigned char* rtb = ws + WS_RT + (size_t)l * 256 * 1024;
        unsigned* inv = (unsigned*)(ws + WS_INV) + (size_t)l * NTOK * 2;
        RUNPH(pb + 0, { const Params& Q = PF;
            if (l == 0) rp::run<1, false, false>(ldsb, Q, l, Q.in[I_X], nullptr, nullptr, nullptr, nullptr, (const bf16_t*)(rtb + rp::T_GHI), (const bf16_t*)(rtb + rp::T_GLO), xbuf, rsb, gates, nullptr, nullptr, nullptr);
            else        rp::run<1, true, true>(ldsb, Q, l, nullptr, xbuf, yb, inv - (size_t)NTOK * 2, cnt - 64, (const bf16_t*)(rtb + rp::T_GHI), (const bf16_t*)(rtb + rp::T_GLO), nullptr, rsb, gates, nullptr, nullptr, nullptr); });
        RUNPH(pb + 1, ph_inproj(ldsb, xbuf, (const bf16_t*)(ws + WS_WIN) + (size_t)l * NMAIN * D, z, rsb, (rep > 0 && PROBE_SUB <= 3) ? PROBE_SUB : 0));
        RUNPH(pb + 2, ph_mix1(lds, PF, l, z, gates, mix, wsm, wss, tb, rep == 0 ? 15 : PROBE_SUB));
        RUNPH(pb + 3, { s5::p2_scan(ldsb, tb, wss); ml::p2_scan(wsm); });
        RUNPH(pb + 4, ph_mix2(lds, PF, l, z, gates, mix, wsm, wss, tb, rep == 0 ? 15 : PROBE_SUB));
        RUNPH(pb + 5, ph_outproj<false>(ldsb, mix, (const bf16_t*)(ws + WS_WOUT) + (size_t)l * D * D, nullptr, xbuf));
        RUNPH(pb + 6, { if (rep > 0) { if (blockIdx.x == 0 && threadIdx.x < 64) cnt[threadIdx.x] = 0u; xcd_barrier(bar); }
                        const Params& Q = PF; rp::run<3, false, true>(ldsb, Q, l, nullptr, xbuf, nullptr, nullptr, nullptr, (const bf16_t*)(rtb + rp::T_HI), (const bf16_t*)(rtb + rp::T_LO), nullptr, rsb, nullptr, cnt, lists, inv); });
        RUNPH(pb + 7, ph_moe1(ldsb, PF, l, xbuf, cnt, lists, act));
        RUNPH(pb + 8, ph_moe2(ldsb, PF, l, act, cnt, lists, yb));
    }
    RUNPH(1 + NLAYER * PH_PER_LAYER, { const Params& Q = PF; rp::final_norm(ldsb, xbuf, Q.out, yb, (const unsigned*)(ws + WS_INV) + (size_t)(NLAYER - 1) * NTOK * 2, ctl + CW_CNT + (NLAYER - 1) * 64, Q.in[I_NFIN]); });
#undef RUNPH
#undef IN
#undef SEAM
}

#ifndef N_LAUNCH_MODE
#define N_LAUNCH_MODE 1
#endif
extern "C" void kernel_launch(void* const* d_in, const int* in_sizes, int n_in, void* d_out, int out_size, void* d_ws, size_t ws_size, hipStream_t stream) {
    static int grid = 0;
    if (grid == 0) {
        if (n_in != 31 || out_size != NTOK * D || ws_size < WS_END) { fprintf(stderr, "kernel_launch: unexpected shapes n_in %d out %d ws %zu (need %zu)\n", n_in, out_size, ws_size, (size_t)WS_END); grid = -1; return; }
        int dev = 0, cus = 0, per_cu = 0;
        if (hipGetDevice(&dev) != hipSuccess || hipDeviceGetAttribute(&cus, hipDeviceAttributeMultiprocessorCount, dev) != hipSuccess) { grid = -1; return; }
        if (hipFuncSetAttribute((const void*)fwd_kernel, hipFuncAttributeMaxDynamicSharedMemorySize, LDS_BYTES) != hipSuccess) { fprintf(stderr, "kernel_launch: hipFuncSetAttribute failed\n"); grid = -1; return; }
        if (hipOccupancyMaxActiveBlocksPerMultiprocessor(&per_cu, (const void*)fwd_kernel, NTHREADS, LDS_BYTES) != hipSuccess || per_cu < 1) { fprintf(stderr, "kernel_launch: occupancy query says %d\n", per_cu); }
        (void)hipGetLastError();
        grid = cus;
    }
    if (grid < 0) return;
    (void)hipMemsetAsync((char*)d_ws + WS_CTL, 0, CTL_BYTES, stream);
    Params p{};
    for (int i = 0; i < 31; ++i) p.in[i] = (const float*)d_in[i];
    p.out = (float*)d_out; p.ws = (unsigned char*)d_ws;
#if N_LAUNCH_MODE == 1
    p.ph_lo = 0; p.ph_hi = N_PHASES;
    hipLaunchKernelGGL(fwd_kernel, dim3(grid), dim3(NTHREADS), LDS_BYTES, stream, p);
#else
    for (int ph = 0; ph < N_PHASES; ++ph) { p.ph_lo = ph; p.ph_hi = ph + 1; hipLaunchKernelGGL(fwd_kernel, dim3(grid), dim3(NTHREADS), LDS_BYTES, stream, p); }
#endif
}
```

```cpp
#include <hip/hip_runtime.h>
#include <stdint.h>
#include <stdio.h>

#define LAS __attribute__((address_space(3)))

constexpr int D = 1024, NB = 8, S = 8192, NTOK = NB * S, INW = 2312, NLAYER = 2;
constexpr int NEXP = 32, DE = 512;
constexpr float EPS = 1e-6f;
constexpr int ZW = 2304;
__host__ __device__ __forceinline__ constexpr size_t zat(int row, int col) { return ((size_t)(col >> 8) * ((size_t)8 * 8192) + (size_t)row) * 256 + (size_t)(col & 255); }
constexpr int ZP = 256;
constexpr int ZQ = 0, ZK = 256, ZV = 384, ZSU = 512, ZCQ = 768, ZCK = 1024, ZCV = 1280, ZCO = 1536, ZGU = 1792, ZGV = 2048, WCI = 1536;
#ifndef INPROJ_WGM
#define INPROJ_WGM 16
#endif
constexpr int NTHREADS = 512;
constexpr int LDS_BYTES = 144 * 1024;
constexpr int TAB_OFF = 128 * 1024;
constexpr int PH_PER_LAYER = 9, N_PHASES = 1 + NLAYER * PH_PER_LAYER + 1;
constexpr int NMAIN = 2304;
typedef unsigned short bf16_t;

constexpr size_t MiB = 1u << 20;
constexpr size_t WS_CTL = 0, CTL_BYTES = 1 * MiB;
constexpr size_t WS_Z = WS_CTL + CTL_BYTES;
constexpr size_t Z_BYTES = (size_t)NTOK * ZW * 2;
constexpr size_t WS_H = WS_Z;
constexpr size_t WS_YB = WS_Z;
constexpr int PMAX = 2 * NTOK + NEXP * 256;
static_assert((size_t)PMAX * D * 2 <= Z_BYTES, "YB alias fits");
constexpr size_t WS_MIX = WS_Z + Z_BYTES;
constexpr size_t WS_ACT = WS_MIX;
static_assert((size_t)PMAX * DE * 2 <= (size_t)NTOK * D * 2 + 64 * MiB, "ACT alias fits");
constexpr size_t WS_HRAW = WS_MIX + (size_t)NTOK * D * 2;
constexpr size_t WS_S5 = WS_HRAW + 64 * MiB;
constexpr size_t WS_GATES = WS_S5 + 48 * MiB;
constexpr size_t WS_LIST = WS_GATES + (size_t)NTOK * 8 * 4;
constexpr size_t WS_WIN = WS_LIST + (size_t)NEXP * NTOK * 8;
constexpr size_t WS_WOUT = WS_WIN + (size_t)NLAYER * NMAIN * D * 2;
constexpr size_t WS_WGU = WS_WOUT + (size_t)NLAYER * D * D * 2;
constexpr size_t WS_WD = WS_WGU + (size_t)NLAYER * NEXP * 1024 * D * 2;
constexpr size_t WS_TB = WS_WD + (size_t)NLAYER * NEXP * D * DE * 2;
constexpr size_t WS_RS = WS_TB + (size_t)NLAYER * 4 * MiB;
constexpr size_t WS_RT = WS_RS + (size_t)NTOK * 4;
constexpr size_t WS_INV = WS_RT + (size_t)NLAYER * 256 * 1024;
constexpr size_t WS_XB = WS_INV + (size_t)NLAYER * NTOK * 8;
constexpr size_t WS_KC = WS_XB + (size_t)NTOK * D * 2;
constexpr size_t WS_GS = WS_KC + (size_t)NTOK * 256 * 2;
constexpr size_t WS_RSL = WS_GS + (size_t)NB * 4 * (S / 128) * 256 * 4;
constexpr size_t WS_END = WS_RSL + (size_t)NEXP * NTOK * 4;
namespace s5 {
constexpr size_t T_KMAT = 0, T_F = T_KMAT + (size_t)16 * 32 * 256 * 2, T_G = T_F + (size_t)16 * 256 * 128 * 2, T_A16 = T_G + (size_t)16 * 128 * 256 * 2,
                 T_GLUW = T_A16 + (size_t)16 * 64 * 8, T_SGUW = T_GLUW + (size_t)256 * 256 * 2, T_LAYER = T_SGUW + (size_t)4 * 128 * 128 * 2;
}
constexpr int CW_Q = 4096;
constexpr int CW_DONE = 4160;
constexpr int CW_CNT = 8192;

#define XB_TMO      128
#define XB_XCNT(j)  (256  + 64 * (j))
#define XB_XSUB(j)  (1280 + 64 * (j))
#define XB_XGEN(j)  (2304 + 64 * (j))
#define XB_TOP      3328
#define XB_TOPGEN   3392
#define XCD_BAR_WORDS 3456
#define XB_SPIN_CAP (1u << 22)
__device__ __forceinline__ unsigned xb_ld(unsigned* p)              { return __hip_atomic_load(p, __ATOMIC_RELAXED, __HIP_MEMORY_SCOPE_AGENT); }
__device__ __forceinline__ unsigned xb_add(unsigned* p, unsigned v) { return __hip_atomic_fetch_add(p, v, __ATOMIC_RELAXED, __HIP_MEMORY_SCOPE_AGENT); }
__device__ __forceinline__ unsigned xb_xcc_id() { return (unsigned)__builtin_amdgcn_s_getreg((3 << 11) | 20) & 0xFu; }
#define XB_SPIN(cond, bar) do { unsigned _sp = 0; while (cond) { __builtin_amdgcn_s_sleep(1); \
    if ((++_sp & 255u) == 0u) { if (xb_ld(&(bar)[XB_TMO])) break; if (_sp > XB_SPIN_CAP) { atomicAdd(&(bar)[XB_TMO], 1u); break; } } } } while (0)
struct XcdBarrier { unsigned* bar; unsigned x; volatile LAS unsigned* st; };
__device__ __forceinline__ XcdBarrier xcd_barrier_post(unsigned* bar, volatile LAS unsigned* st) {
    XcdBarrier b; b.bar = bar; b.x = xb_xcc_id(); b.st = st;
    if (threadIdx.x == 0) (void)xb_add(&bar[XB_XCNT(b.x)], 1u);
    return b;
}
__device__ __forceinline__ void xcd_barrier_complete(unsigned* bar, unsigned x, unsigned& nloc, unsigned& nx) {
    const unsigned G = gridDim.x * gridDim.y * gridDim.z;
    unsigned sum, cnt, mine, sp = 0u;
    for (;;) {
        sum = 0u; cnt = 0u; mine = 0u;
#pragma unroll
        for (unsigned j = 0; j < 16; ++j) { const unsigned c = xb_ld(&bar[XB_XCNT(j)]); sum += c; cnt += (c > 0u) ? 1u : 0u; mine = (j == x) ? c : mine; }
        if (sum == G) break;
        __builtin_amdgcn_s_sleep(1);
        if ((++sp & 255u) == 0u) { if (xb_ld(&bar[XB_TMO])) break; if (sp > XB_SPIN_CAP) { atomicAdd(&bar[XB_TMO], 1u); break; } }
    }
    nloc = mine > 0u ? mine : 1u; nx = cnt > 0u ? cnt : 1u;
}
__device__ __forceinline__ void xcd_barrier(const XcdBarrier& b) {
    asm volatile("s_waitcnt vmcnt(0)" ::: "memory");
    __syncthreads();
    if (threadIdx.x == 0) {
        unsigned* bar = b.bar;
        __builtin_amdgcn_s_waitcnt(0);
        unsigned nloc = b.st[0], nx = b.st[1];
        if (nloc == 0u) { xcd_barrier_complete(bar, b.x, nloc, nx); b.st[0] = nloc; b.st[1] = nx; }
        const unsigned old = xb_add(&bar[XB_XSUB(b.x)], 1u);
        const unsigned gen = old / nloc;
        if (old + 1u == (gen + 1u) * nloc) {
            __builtin_amdgcn_fence(__ATOMIC_RELEASE, "agent");
            asm volatile("s_waitcnt vmcnt(0)" ::: "memory");
            const unsigned og = xb_add(&bar[XB_TOP], 1u);
            const unsigned tg = og / nx;
            if (og + 1u == (tg + 1u) * nx) xb_add(&bar[XB_TOPGEN], 1u);
            else XB_SPIN(xb_ld(&bar[XB_TOPGEN]) == tg, bar);
            __builtin_amdgcn_fence(__ATOMIC_ACQUIRE, "agent");
            xb_add(&bar[XB_XGEN(b.x)], 1u);
            asm volatile("s_waitcnt vmcnt(0)" ::: "memory");
        } else {
            XB_SPIN(xb_ld(&bar[XB_XGEN(b.x)]) == gen, bar);
            __builtin_amdgcn_fence(__ATOMIC_ACQUIRE, "agent");
            asm volatile("s_waitcnt vmcnt(0)" ::: "memory");
        }
    }
    __syncthreads();
}

__device__ __forceinline__ int tid_opaque() { int t = threadIdx.x; asm volatile("" : "+v"(t)); return t; }
__device__ __forceinline__ float wave_sum(float v) {
#pragma unroll
    for (int o = 32; o > 0; o >>= 1) v += __shfl_xor(v, o);
    return v;
}
__device__ __forceinline__ float gelu_tanh(float x) {
    const float u2 = 1.5957691216057308f * (x + 0.044715f * x * x * x);
    return x * __builtin_amdgcn_rcpf(1.f + __expf(-u2));
}
__device__ __forceinline__ float sigm(float x) { return 1.f / (1.f + expf(-x)); }
__device__ __forceinline__ float rsig(float x) { return __builtin_amdgcn_rcpf(1.f + __expf(-x)); }
__device__ __forceinline__ float bfl(unsigned w) { return __uint_as_float(w << 16); }
__device__ __forceinline__ float bfh(unsigned w) { return __uint_as_float(w & 0xffff0000u); }
typedef unsigned u32x4_t __attribute__((ext_vector_type(4)));
typedef unsigned u32x2_t __attribute__((ext_vector_type(2)));
__device__ __forceinline__ void ld8(const bf16_t* p, float (&o)[8]) { const u32x4_t w = *(const u32x4_t*)p; o[0] = bfl(w.x); o[1] = bfh(w.x); o[2] = bfl(w.y); o[3] = bfh(w.y); o[4] = bfl(w.z); o[5] = bfh(w.z); o[6] = bfl(w.w); o[7] = bfh(w.w); }
typedef short s16x4_t __attribute__((ext_vector_type(4)));
__device__ __forceinline__ u32x2_t lds_tr4(const LAS unsigned char* p) { const s16x4_t v = __builtin_amdgcn_ds_read_tr16_b64_v4i16((LAS s16x4_t*)p); return __builtin_bit_cast(u32x2_t, v); }
__device__ __forceinline__ void wave_lds_fence() {
    __builtin_amdgcn_fence(__ATOMIC_RELEASE, "wavefront"); __builtin_amdgcn_wave_barrier(); __builtin_amdgcn_fence(__ATOMIC_ACQUIRE, "wavefront");
}

struct Params {
    const float* in[31];
    float* out;
    unsigned char* ws;
    int ph_lo, ph_hi;
};
struct Params;
__device__ __forceinline__ const Params* params_fresh() { auto p = __builtin_amdgcn_kernarg_segment_ptr(); asm volatile("" : "+s"(p)); return (const Params*)p; }
#define PF (*params_fresh())
enum { I_X = 0, I_NMG, I_WIN, I_SINK, I_ARE, I_AIM, I_BRE, I_BIM, I_CRE, I_CIM, I_SD, I_LDT, I_GLUW, I_GLUB, I_CONVW, I_GATEB, I_MNG,
       I_LNG, I_LNB, I_SGUW, I_SGUB, I_WOUT, I_NFG, I_RGW, I_RGB, I_REW, I_REB, I_EWG, I_EWU, I_EWD, I_NFIN };

namespace pg8 {
#define PG8_LAS __attribute__((address_space(3)))
typedef short bf16x8 __attribute__((ext_vector_type(8)));
typedef float f32x4 __attribute__((ext_vector_type(4)));
typedef unsigned u32x4 __attribute__((ext_vector_type(4)));
typedef unsigned u32x2 __attribute__((ext_vector_type(2)));
typedef int i32x4 __attribute__((ext_vector_type(4)));
constexpr int BM = 256, BK = 64, HALF = 128, HTB = HALF * BK * 2, STAGE_BYTES = 8 * HTB, NXCD = 8, WGM = 8;
__host__ __device__ __forceinline__ int lds_byte(int r, int c) { const int st = (r >> 4) * 2 + (c >> 5), rr = r & 15, cc = c & 31, ob = rr * 64 + cc * 2; return st * 1024 + (ob ^ (((ob >> 9) & 1) << 5)); }
__host__ __device__ __forceinline__ void stage_rc(int b, int& R, int& C) { const int st = b / 1024, sb = b % 1024, swz = sb ^ (((sb >> 9) & 1) << 5); R = (st >> 1) * 16 + swz / 64; C = (st & 1) * 32 + (swz % 64) / 2; }
__host__ __device__ __forceinline__ int perm32(int rho) { const int n = rho >> 4, i = rho & 15; return 8 * (i >> 2) + 4 * n + (i & 3); }
__device__ __forceinline__ unsigned cvt_pk_bf16(float lo, float hi) { unsigned r; asm volatile("v_cvt_pk_bf16_f32 %0, %1, %2" : "=v"(r) : "v"(lo), "v"(hi)); return r; }

struct Unit { int pm, pn; const char* A; const char* B; int e, pos0, cnt; };

struct StaticOrder {
    int nM, nN, nwg, G, c, wgm, pmmask = -1; const char* A; const char* Bt; size_t atile, btile;
    __device__ void init(int M, int N, int K, int lda, int G_, int c_, const void* A_, const void* Bt_, int wgm_ = WGM) { wgm = wgm_; nM = M / BM; nN = N / BM; nwg = nM * nN; G = G_; c = c_; A = (const char*)A_; Bt = (const char*)Bt_; atile = (size_t)BM * lda * 2; btile = (size_t)BM * K * 2; }
    __device__ __forceinline__ bool next(int i, Unit& u) const {
        const long L = (long)i * G + c; if (L >= nwg) return false;
        int wgid = (int)L; { const int q = nwg / NXCD, r = nwg % NXCD, xcd = wgid % NXCD, off = wgid / NXCD; wgid = (xcd < r ? xcd * (q + 1) : r * (q + 1) + (xcd - r) * q) + off; }
        const int nig = wgm * nN, gid = wgid / nig, fm = gid * wgm, gsz = (nM - fm) < wgm ? (nM - fm) : wgm;
        u.pm = fm + ((wgid % nig) % gsz); u.pn = (wgid % nig) / gsz; u.A = A + (size_t)(u.pm & pmmask) * atile; u.B = Bt + (size_t)u.pn * btile; u.e = 0; u.pos0 = 0; u.cnt = 0; return true;
    }
    __device__ __forceinline__ void aoff(const Unit&, unsigned (&)[2], unsigned (&)[2], const int (&)[2], const int (&)[2]) const {}
};

template <class Epi, class Sched, bool GATHER>
__device__ __forceinline__ void gemm_phase(PG8_LAS unsigned char* lds, const int K, const int lda, const Sched& S, const Epi& E) {
    const int tid = tid_opaque(), wid = __builtin_amdgcn_readfirstlane(tid >> 6), lane = tid & 63, wr = wid >> 2, wc = wid & 3, fr = lane & 15, fq = lane >> 4;
    const int nt = K / BK;
    unsigned vA0[2], vA1[2], vB[2], nA0[2], nA1[2]; int Rs[2], Cs[2];
#pragma unroll
    for (int i = 0; i < 2; ++i) { int R, C; stage_rc(tid * 16 + i * 8192, R, C); const int Rb = Epi::PERM ? ((R & ~31) + perm32(R & 31)) : R;
        Rs[i] = R; Cs[i] = C; vA0[i] = (unsigned)(R * lda + C) * 2u; vA1[i] = vA0[i] + (unsigned)(HALF * lda) * 2u; vB[i] = (unsigned)(Rb * K + C) * 2u; nA0[i] = vA0[i]; nA1[i] = vA1[i]; }
    const size_t kstep = (size_t)(BK * 2);
    const size_t hstep = (size_t)HALF * K * 2;
    const unsigned ldsw = (unsigned)wid * 1024u;
    const int aoff = lds_byte(wr * 64 + fr, fq * 8), boff = lds_byte(wc * 32 + fr, fq * 8);
#define PG8_SA(b, h) (((b) * 2 + (h)) * HTB)
#define PG8_SB(b, h) ((4 + (b) * 2 + (h)) * HTB)
#define PG8_STAGE(bufoff, gbase, voff) do { _Pragma("unroll") for (int _i = 0; _i < 2; ++_i) \
        __builtin_amdgcn_global_load_lds((const unsigned*)((const char*)(gbase) + (voff)[_i]), (PG8_LAS unsigned*)(lds + (bufoff) + ldsw + _i * 8192), 16, 0, 0); } while (0)
#define PG8_LDA(dst, b, h) do { _Pragma("unroll") for (int m = 0; m < 4; ++m) _Pragma("unroll") for (int k = 0; k < 2; ++k) dst[m][k] = *(const PG8_LAS bf16x8*)(lds + PG8_SA(b, h) + aoff + m * 2048 + k * 1024); } while (0)
#define PG8_LDB(dst, b, h) do { _Pragma("unroll") for (int n = 0; n < 2; ++n) _Pragma("unroll") for (int k = 0; k < 2; ++k) dst[n][k] = *(const PG8_LAS bf16x8*)(lds + PG8_SB(b, h) + boff + n * 2048 + k * 1024); } while (0)
#define PG8_MMA(ai, bj, At, Bt) do { __builtin_amdgcn_s_setprio(1); _Pragma("unroll") for (int m = 0; m < 4; ++m) _Pragma("unroll") for (int n = 0; n < 2; ++n) _Pragma("unroll") for (int k = 0; k < 2; ++k) \
        acc[ai][bj][m][n] = __builtin_amdgcn_mfma_f32_16x16x32_bf16(Bt[n][k], At[m][k], acc[ai][bj][m][n], 0, 0, 0); __builtin_amdgcn_s_setprio(0); } while (0)
#define PG8_WAIT_V(n) asm volatile("s_waitcnt vmcnt(" #n ")" ::: "memory")
#define PG8_WAIT_L(n) asm volatile("s_waitcnt lgkmcnt(" #n ")" ::: "memory")
#define PG8_WAIT_VR(rel) do { if constexpr (Epi::NST > 0) asm volatile("s_cmp_lg_u32 %0, 0\n\ts_cbranch_scc1 1f\n\ts_waitcnt vmcnt(8)\n\ts_branch 2f\n1:\ts_waitcnt vmcnt(%1)\n2:" :: "s"(rel), "n"(8 + Epi::NST) : "memory", "scc"); else PG8_WAIT_V(8); } while (0)
#define PG8_BAR __builtin_amdgcn_s_barrier()
#define PG8_SCHED __builtin_amdgcn_sched_barrier(0)
    Unit cur, nxt; int ui = 0;
    if (!S.next(0, cur)) return;
    if constexpr (GATHER) { S.aoff(cur, vA0, vA1, Rs, Cs); PG8_WAIT_V(0); }
    f32x4 acc[2][2][4][2];
#pragma unroll
    for (int a = 0; a < 2; ++a)
#pragma unroll
        for (int b = 0; b < 2; ++b)
#pragma unroll
            for (int m = 0; m < 4; ++m)
#pragma unroll
                for (int n = 0; n < 2; ++n) acc[a][b][m][n] = (f32x4){0.f, 0.f, 0.f, 0.f};
    bf16x8 At[4][2], B0[2][2], B1[2][2];
    const char* cA = cur.A; const char* cB = cur.B;
    PG8_STAGE(PG8_SB(0, 0), cB, vB); PG8_STAGE(PG8_SB(0, 1), cB + hstep, vB); PG8_STAGE(PG8_SA(0, 0), cA, vA0); PG8_STAGE(PG8_SA(0, 1), cA, vA1);
    if (wr == 1) PG8_BAR;
    PG8_WAIT_V(2); PG8_BAR;
    PG8_STAGE(PG8_SB(1, 0), cB + kstep, vB); PG8_STAGE(PG8_SA(1, 0), cA + kstep, vA0); PG8_STAGE(PG8_SB(1, 1), cB + hstep + kstep, vB);
    PG8_WAIT_V(6); PG8_BAR;
    for (;;) {
        const bool has_next = S.next(ui + 1, nxt);
        const char* nA = has_next ? nxt.A : cA; const char* nB = has_next ? nxt.B : cB;
        if constexpr (GATHER) {
            if (has_next) { S.aoff(nxt, nA0, nA1, Rs, Cs); }
            else {
#pragma unroll
                for (int i = 0; i < 2; ++i) { nA0[i] = vA0[i]; nA1[i] = vA1[i]; } }
        }
        for (int t = 0; t < nt; t += 2) {
            const bool last = (t == nt - 2);
            const char* a1 = cA + (size_t)(t + 1) * kstep;
            const char* a2 = last ? nA : cA + (size_t)(t + 2) * kstep; const char* b2 = last ? nB : cB + (size_t)(t + 2) * kstep;
            const char* a3 = a2 + kstep; const char* b3 = b2 + kstep;
            unsigned x0[2], x1[2];
#pragma unroll
            for (int i = 0; i < 2; ++i) { x0[i] = (GATHER && last) ? nA0[i] : vA0[i]; x1[i] = (GATHER && last) ? nA1[i] : vA1[i]; }
            const int rel = __builtin_amdgcn_readfirstlane((t == 0 && ui > 0) ? 1 : 0);
            PG8_LDB(B0, 0, 0); PG8_LDB(B1, 0, 1); PG8_SCHED; PG8_LDA(At, 0, 0); PG8_STAGE(PG8_SA(1, 1), a1, vA1);
            PG8_WAIT_VR(rel); PG8_WAIT_L(0); PG8_BAR; PG8_MMA(0, 0, At, B0); PG8_MMA(0, 1, At, B1); PG8_BAR; PG8_SCHED;
            PG8_LDA(At, 0, 1); PG8_STAGE(PG8_SB(0, 0), b2, vB); PG8_STAGE(PG8_SB(0, 1), b2 + hstep, vB); PG8_STAGE(PG8_SA(0, 0), a2, x0);
            PG8_WAIT_VR(rel); PG8_WAIT_L(0); PG8_BAR; PG8_MMA(1, 0, At, B0); PG8_MMA(1, 1, At, B1); PG8_BAR; PG8_SCHED;
            PG8_LDB(B0, 1, 0); PG8_LDB(B1, 1, 1); PG8_SCHED; PG8_LDA(At, 1, 0); PG8_STAGE(PG8_SA(0, 1), a2, x1);
            PG8_WAIT_VR(rel); PG8_WAIT_L(0); PG8_BAR; PG8_MMA(0, 0, At, B0); PG8_MMA(0, 1, At, B1); PG8_BAR; PG8_SCHED;
            PG8_LDA(At, 1, 1); PG8_STAGE(PG8_SB(1, 0), b3, vB); PG8_STAGE(PG8_SB(1, 1), b3 + hstep, vB); PG8_STAGE(PG8_SA(1, 0), a3, x0);
            PG8_WAIT_V(8); PG8_WAIT_L(0); PG8_BAR; PG8_MMA(1, 0, At, B0); PG8_MMA(1, 1, At, B1); PG8_BAR; PG8_SCHED;
        }
        if (wr == 0) PG8_BAR;
        if constexpr (Epi::NST > 0) {
            unsigned x1n[2];
#pragma unroll
            for (int i = 0; i < 2; ++i) x1n[i] = GATHER ? nA1[i] : vA1[i];
            PG8_STAGE(PG8_SA(1, 1), nA + kstep, x1n); }
        E(acc, cur, wr, wc, fr, fq);
        if (!has_next) break;
#pragma unroll
        for (int a = 0; a < 2; ++a)
#pragma unroll
            for (int b = 0; b < 2; ++b)
#pragma unroll
                for (int m = 0; m < 4; ++m)
#pragma unroll
                    for (int n = 0; n < 2; ++n) acc[a][b][m][n] = (f32x4){0.f, 0.f, 0.f, 0.f};
        cur = nxt; cA = nA; cB = nB; ++ui;
        if constexpr (GATHER) {
#pragma unroll
            for (int i = 0; i < 2; ++i) { vA0[i] = nA0[i]; vA1[i] = nA1[i]; } }
        if (wr == 1) PG8_BAR;
    }
    PG8_WAIT_V(0);
    PG8_BAR;
#undef PG8_SA
#undef PG8_SB
#undef PG8_STAGE
#undef PG8_LDA
#undef PG8_LDB
#undef PG8_MMA
#undef PG8_WAIT_V
#undef PG8_WAIT_L
#undef PG8_WAIT_VR
#undef PG8_BAR
#undef PG8_SCHED
}

struct EpiZ {
    static constexpr bool PERM = true; static constexpr int NST = 16;
    bf16_t* Z; const float* RS;
    __device__ __forceinline__ void operator()(const f32x4 (&acc)[2][2][4][2], const Unit& u, int wr, int wc, int fr, int fq) const {
        const int row0 = u.pm * BM + wr * 64 + fr, col0 = u.pn * BM + wc * 32 + 8 * fq;
        float rsv[2][4];
#pragma unroll
        for (int ai = 0; ai < 2; ++ai)
#pragma unroll
            for (int m = 0; m < 4; ++m) rsv[ai][m] = RS[row0 + ai * HALF + m * 16];
#pragma unroll
        for (int ai = 0; ai < 2; ++ai)
#pragma unroll
            for (int m = 0; m < 4; ++m) { bf16_t* rowp = Z + zat(row0 + ai * HALF + m * 16, col0); const float rs = rsv[ai][m];
#pragma unroll
                for (int bj = 0; bj < 2; ++bj) { const f32x4 v0 = acc[ai][bj][m][0] * rs, v1 = acc[ai][bj][m][1] * rs;
                    u32x4 w; w.x = cvt_pk_bf16(v0[0], v0[1]); w.y = cvt_pk_bf16(v0[2], v0[3]); w.z = cvt_pk_bf16(v1[0], v1[1]); w.w = cvt_pk_bf16(v1[2], v1[3]);
                    *(u32x4*)(rowp + bj * HALF) = w; } }
    }
};
template <bool SRCF32> struct EpiResB {
    static constexpr bool PERM = true; static constexpr int NST = 8;
    const float* XF; bf16_t* XB;
    __device__ __forceinline__ void operator()(const f32x4 (&acc)[2][2][4][2], const Unit& u, int wr, int wc, int fr, int fq) const {
        const int row0 = u.pm * BM + wr * 64 + fr, col0 = u.pn * BM + wc * 32 + 8 * fq;
#pragma unroll
        for (int ai = 0; ai < 2; ++ai) {
            f32x4 xf[4][2][2]; u32x4 xw[4][2];
#pragma unroll
            for (int m = 0; m < 4; ++m) { const size_t off = (size_t)(row0 + ai * HALF + m * 16) * D + col0;
#pragma unroll
                for (int bj = 0; bj < 2; ++bj) {
                    if (SRCF32) { xf[m][bj][0] = *(const f32x4*)(XF + off + bj * HALF); xf[m][bj][1] = *(const f32x4*)(XF + off + bj * HALF + 4); }
                    else xw[m][bj] = *(const u32x4*)(XB + off + bj * HALF); } }
            __builtin_amdgcn_sched_barrier(0);
#pragma unroll
            for (int m = 0; m < 4; ++m) { const size_t off = (size_t)(row0 + ai * HALF + m * 16) * D + col0;
#pragma unroll
                for (int bj = 0; bj < 2; ++bj) { f32x4 x0, x1;
                    if (SRCF32) { x0 = xf[m][bj][0]; x1 = xf[m][bj][1]; }
                    else { const u32x4 w = xw[m][bj];
                        x0 = (f32x4){__uint_as_float(w.x << 16), __uint_as_float(w.x & 0xffff0000u), __uint_as_float(w.y << 16), __uint_as_float(w.y & 0xffff0000u)};
                        x1 = (f32x4){__uint_as_float(w.z << 16), __uint_as_float(w.z & 0xffff0000u), __uint_as_float(w.w << 16), __uint_as_float(w.w & 0xffff0000u)}; }
                    const f32x4 v0 = x0 + acc[ai][bj][m][0], v1 = x1 + acc[ai][bj][m][1];
                    u32x4 o; o.x = cvt_pk_bf16(v0[0], v0[1]); o.y = cvt_pk_bf16(v0[2], v0[3]); o.z = cvt_pk_bf16(v1[0], v1[1]); o.w = cvt_pk_bf16(v1[2], v1[3]);
                    *(u32x4*)(XB + off + bj * HALF) = o; } }
            __builtin_amdgcn_sched_barrier(0);
        }
    }
};
struct EpiAct {
    static constexpr bool PERM = true; static constexpr int NST = 8;
    bf16_t* ACT; const float* RS;
    __device__ __forceinline__ void operator()(const f32x4 (&acc)[2][2][4][2], const Unit& u, int wr, int wc, int fr, int fq) const {
        const int row0 = u.pm * BM + wr * 64 + fr, col0 = u.pn * HALF + wc * 32 + 8 * fq;
        float rsv[2][4];
        const float* rl = RS + (size_t)u.e * NTOK + u.pos0;
#pragma unroll
        for (int ai = 0; ai < 2; ++ai)
#pragma unroll
            for (int m = 0; m < 4; ++m) { const int r = ai * HALF + wr * 64 + m * 16 + fr; const int rc = (u.pos0 + r < u.cnt) ? r : 0; rsv[ai][m] = rl[rc]; }
        asm volatile("" : "+v"(rsv[0][0]), "+v"(rsv[0][1]), "+v"(rsv[0][2]), "+v"(rsv[0][3]), "+v"(rsv[1][0]), "+v"(rsv[1][1]), "+v"(rsv[1][2]), "+v"(rsv[1][3]));
#pragma unroll
        for (int ai = 0; ai < 2; ++ai)
#pragma unroll
            for (int m = 0; m < 4; ++m) { const int r = ai * HALF + wr * 64 + m * 16 + fr; if (!(u.pos0 + r < u.cnt)) rsv[ai][m] = 0.f; }
#pragma unroll
        for (int ai = 0; ai < 2; ++ai)
#pragma unroll
            for (int m = 0; m < 4; ++m) { bf16_t* rowp = ACT + (size_t)(row0 + ai * HALF + m * 16) * DE + col0;
                const float rs = rsv[ai][m];
                float o[8];
#pragma unroll
                for (int n = 0; n < 2; ++n)
#pragma unroll
                    for (int j = 0; j < 4; ++j) { const float g = acc[ai][0][m][n][j] * rs, up = acc[ai][1][m][n][j] * rs; o[n * 4 + j] = g * up * __builtin_amdgcn_rcpf(1.f + __expf(-g)); }
                u32x4 w; w.x = cvt_pk_bf16(o[0], o[1]); w.y = cvt_pk_bf16(o[2], o[3]); w.z = cvt_pk_bf16(o[4], o[5]); w.w = cvt_pk_bf16(o[6], o[7]);
                *(u32x4*)rowp = w; }
    }
};
struct EpiY {
    static constexpr bool PERM = true; static constexpr int NST = 16;
    bf16_t* YB; const int2* lists;
    __device__ __forceinline__ void operator()(const f32x4 (&acc)[2][2][4][2], const Unit& u, int wr, int wc, int fr, int fq) const {
        const int row0 = u.pm * BM + wr * 64 + fr, col0 = u.pn * BM + wc * 32 + 8 * fq; const int2* lst = lists + (size_t)u.e * NTOK + u.pos0;
        float wv[2][4];
#pragma unroll
        for (int ai = 0; ai < 2; ++ai)
#pragma unroll
            for (int m = 0; m < 4; ++m) { const int r = ai * HALF + wr * 64 + m * 16 + fr; wv[ai][m] = __int_as_float(lst[(u.pos0 + r < u.cnt) ? r : 0].y); }
#pragma unroll
        for (int ai = 0; ai < 2; ++ai)
#pragma unroll
            for (int m = 0; m < 4; ++m) {
                { const float w = wv[ai][m]; bf16_t* rowp = YB + (size_t)(row0 + ai * HALF + m * 16) * D + col0;
#pragma unroll
                    for (int bj = 0; bj < 2; ++bj) { const f32x4 v0 = acc[ai][bj][m][0] * w, v1 = acc[ai][bj][m][1] * w;
                        u32x4 o; o.x = cvt_pk_bf16(v0[0], v0[1]); o.y = cvt_pk_bf16(v0[2], v0[3]); o.z = cvt_pk_bf16(v1[0], v1[1]); o.w = cvt_pk_bf16(v1[2], v1[3]);
                        *(u32x4*)(rowp + bj * HALF) = o; } } }
    }
};
struct MoeOrder {
    const PG8_LAS i32x4* tab; int ntiles, npn, G, c; const char* A; size_t atile; const char* Bt; size_t bexp, btile; const int2* lists;
    __device__ __forceinline__ bool next(int i, Unit& u) const {
        const int L = i * G + c; const int T = L / npn; if (T >= ntiles) return false;
        const i32x4 te = tab[T]; u.pm = T; u.pn = L - T * npn; u.e = __builtin_amdgcn_readfirstlane(te.x); u.pos0 = __builtin_amdgcn_readfirstlane(te.y); u.cnt = __builtin_amdgcn_readfirstlane(te.z);
        u.A = A + (size_t)T * atile; u.B = Bt + (size_t)u.e * bexp + (size_t)u.pn * btile; return true;
    }
    __device__ __forceinline__ void aoff(const Unit& u, unsigned (&o0)[2], unsigned (&o1)[2], const int (&Rs)[2], const int (&Cs)[2]) const {
        const int2* lst = lists + (size_t)u.e * NTOK;
#pragma unroll
        for (int i = 0; i < 2; ++i) { const int p0 = u.pos0 + Rs[i], p1 = p0 + HALF;
            const int t0 = (p0 < u.cnt) ? lst[p0].x : 0, t1 = (p1 < u.cnt) ? lst[p1].x : 0;
            o0[i] = (unsigned)t0 * (unsigned)(D * 2) + (unsigned)Cs[i] * 2u; o1[i] = (unsigned)t1 * (unsigned)(D * 2) + (unsigned)Cs[i] * 2u; }
    }
};
}

__device__ __forceinline__ void tc_strip(float* Tf, const float* src, int src_ld, int c0, int k0, bf16_t* dst, int K, int n0, const float* gk = nullptr) {
    LAS unsigned char* T = (LAS unsigned char*)Tf;
    const int tid = tid_opaque(), lane = tid & 63, wid = tid >> 6, l = lane & 15, g = lane >> 4;
    float4 v[8];
#pragma unroll
    for (int i = 0; i < 8; ++i) { const int kk = (tid >> 4) + 32 * i, c4 = (tid & 15) * 4; v[i] = *(const float4*)(src + (size_t)(k0 + kk) * src_ld + c0 + c4); }
    float gv[8];
#pragma unroll
    for (int i = 0; i < 8; ++i) gv[i] = gk ? gk[k0 + (tid >> 4) + 32 * i] : 1.f;
    __syncthreads();
#pragma unroll
    for (int i = 0; i < 8; ++i) { const int kk = (tid >> 4) + 32 * i, c4 = (tid & 15) * 4;
        u32x2_t w; w.x = pg8::cvt_pk_bf16(v[i].x * gv[i], v[i].y * gv[i]); w.y = pg8::cvt_pk_bf16(v[i].z * gv[i], v[i].w * gv[i]);
        *(LAS u32x2_t*)(T + kk * 144 + c4 * 2) = w; }
    __syncthreads();
#pragma unroll
    for (int nb = 0; nb < 4; ++nb) { const LAS unsigned char* p = T + (32 * wid + 8 * g + (l >> 2)) * 144 + (16 * nb + 4 * (l & 3)) * 2;
        const u32x2_t a0 = lds_tr4(p), a1 = lds_tr4(p + 4 * 144);
        const pg8::u32x4 w = {a0.x, a0.y, a1.x, a1.y};
        *(pg8::u32x4*)(dst + (size_t)(n0 + 16 * nb + l) * K + k0 + 32 * wid + 8 * g) = w; }
}
__device__ __forceinline__ void s5_build_tables_fwd(float* ldsf, const Params& P, int l, int g, unsigned char* tb);
__device__ __forceinline__ void ph_prologue(float* lds, const Params& P, int l, const unsigned* stop) {
    constexpr int NJ_EXP = NEXP * 96, NJ_IN = 144, NJ_OUT = 64, NJ_TB = 16, NJ_GLU = 4, NJ_SGU = 4, NJ_RT = 16;
    bf16_t* WIN = (bf16_t*)(P.ws + WS_WIN); bf16_t* WOUT = (bf16_t*)(P.ws + WS_WOUT); bf16_t* WGU = (bf16_t*)(P.ws + WS_WGU); bf16_t* WD = (bf16_t*)(P.ws + WS_WD);
    constexpr int NJ_ALL = NJ_EXP + NJ_IN + NJ_OUT + NJ_TB + NJ_GLU + NJ_SGU + NJ_RT, NJ_SMALL = NJ_TB + NJ_GLU + NJ_SGU + NJ_RT;
    unsigned* qhead = (unsigned*)(P.ws + WS_CTL) + CW_Q + l;
    LAS int* jslot = (LAS int*)((LAS unsigned char*)lds + LDS_BYTES - 64);
    for (;;) {
        __syncthreads();
        if (tid_opaque() == 0) { int v = NJ_ALL;
            if (!stop || __hip_atomic_load(stop, __ATOMIC_RELAXED, __HIP_MEMORY_SCOPE_AGENT) < gridDim.x) v = (int)atomicAdd(qhead, 1u);
            *jslot = v; }
        __syncthreads();
        const int jj = __builtin_amdgcn_readfirstlane(*jslot);
        if (jj >= NJ_ALL) break;
        const int j = (jj < NJ_SMALL) ? (NJ_ALL - NJ_SMALL + jj) : (jj - NJ_SMALL);
        if (j < NJ_EXP) {
            const int le = l * NEXP + j / 96, r = j % 96;
            if (r < 64) { const int n0 = (r >> 2) * 64, k0 = (r & 3) * 256, pn = n0 >> 8, within = n0 & 255;
                const float* s = (within < 128 ? P.in[I_EWG] : P.in[I_EWU]) + (size_t)le * D * DE;
                tc_strip(lds, s, DE, pn * 128 + (within & 127), k0, WGU + (size_t)le * 1024 * D, D, n0, P.in[I_NFG] + (size_t)(le / NEXP) * D);
            } else { const int r2 = r - 64, n0 = (r2 >> 1) * 64, k0 = (r2 & 1) * 256;
                tc_strip(lds, P.in[I_EWD] + (size_t)le * DE * D, D, n0, k0, WD + (size_t)le * D * DE, DE, n0); }
        } else if (j < NJ_EXP + NJ_IN) {
            const int r = j - NJ_EXP, n0 = (r >> 2) * 64, k0 = (r & 3) * 256;
            tc_strip(lds, P.in[I_WIN] + (size_t)l * D * INW, INW, n0 < WCI ? n0 : n0 + 8, k0, WIN + (size_t)l * NMAIN * D, D, n0, P.in[I_NMG] + (size_t)l * D);
        } else if (j < NJ_EXP + NJ_IN + NJ_OUT) {
            const int r = j - NJ_EXP - NJ_IN, n0 = (r >> 2) * 64, k0 = (r & 3) * 256;
            tc_strip(lds, P.in[I_WOUT] + (size_t)l * D * D, D, n0, k0, WOUT + (size_t)l * D * D, D, n0);
        } else if (j < NJ_EXP + NJ_IN + NJ_OUT + NJ_TB) {
            const int j4 = j - (NJ_EXP + NJ_IN + NJ_OUT);
            s5_build_tables_fwd(lds, P, l, j4, P.ws + WS_TB + (size_t)l * 4 * MiB);
        } else if (j < NJ_EXP + NJ_IN + NJ_OUT + NJ_TB + NJ_GLU) {
            const int j5 = j - (NJ_EXP + NJ_IN + NJ_OUT + NJ_TB), n0 = j5 * 64;
            tc_strip(lds, P.in[I_GLUW] + (size_t)l * 256 * 256, 256, n0, 0, (bf16_t*)(P.ws + WS_TB + (size_t)l * 4 * MiB + s5::T_GLUW), 256, n0);
        } else if (j < NJ_EXP + NJ_IN + NJ_OUT + NJ_TB + NJ_GLU + NJ_SGU) {
            const int g = j - (NJ_EXP + NJ_IN + NJ_OUT + NJ_TB + NJ_GLU);
            bf16_t* wbp = (bf16_t*)(P.ws + WS_TB + (size_t)l * 4 * MiB + s5::T_SGUW) + (size_t)g * 128 * 128; const float* ws_ = P.in[I_SGUW] + ((size_t)l * 4 + g) * 128 * 128;
            for (int idx = tid_opaque(); idx < 128 * 128; idx += NTHREADS) { const int t = idx >> 7, s = idx & 127; wbp[idx] = (s <= t) ? (bf16_t)(pg8::cvt_pk_bf16(ws_[idx], 0.f) & 0xffffu) : (bf16_t)0; }
        } else {
            const int j7 = j - (NJ_EXP + NJ_IN + NJ_OUT + NJ_TB + NJ_GLU + NJ_SGU), n0 = j7 * 4;
            bf16_t* wh = (bf16_t*)(P.ws + WS_RT + (size_t)l * 256 * 1024); bf16_t* wl = wh + 48 * D;
            for (int idx = tid_opaque(); idx < 4 * D; idx += NTHREADS) { const int n = n0 + (idx >> 10), k = idx & (D - 1);
                const float w = (n < 4) ? P.in[I_RGW][((size_t)l * D + k) * 4 + n] * P.in[I_NFG][(size_t)l * D + k] : ((n < 36) ? P.in[I_REW][((size_t)l * D + k) * 32 + (n - 4)] * P.in[I_NFG][(size_t)l * D + k]
                              : ((n >= 48 && n < 56) ? P.in[I_WIN][((size_t)l * D + k) * INW + WCI + (n - 48)] * P.in[I_NMG][(size_t)l * D + k] : 0.f));
                const unsigned hb = pg8::cvt_pk_bf16(w, 0.f) & 0xffffu; const bf16_t lb = (bf16_t)(pg8::cvt_pk_bf16(w - __uint_as_float(hb << 16), 0.f) & 0xffffu);
                if (n < 48) { wh[(size_t)n * D + k] = (bf16_t)hb; wl[(size_t)n * D + k] = lb; } else { wh[(size_t)(96 + n - 48) * D + k] = (bf16_t)hb; wh[(size_t)(112 + n - 48) * D + k] = lb; } }
        }
    }
    __syncthreads();
}

template <bool DUAL, class AF, class EF>
__device__ __forceinline__ void gemm_tile(float* lds, AF arow, int K, const float* B0, const float* B1, int ldb, int n0, int N, EF epi) {
    float* As = lds;
    float* Bs0 = lds + 32 * 132;
    float* Bs1 = Bs0 + 32 * 128;
    const int tid = tid_opaque(), ty = tid >> 4, tx = tid & 15;
    float acc0[4][8], acc1[4][8];
#pragma unroll
    for (int i = 0; i < 4; ++i)
#pragma unroll
        for (int j = 0; j < 8; ++j) { acc0[i][j] = 0.f; acc1[i][j] = 0.f; }
    const float* ap0 = arow((tid >> 3));
    const float* ap1 = arow((tid >> 3) + 64);
    const int akk = (tid & 7) * 4;
    const int bn = n0 + (tid & 31) * 4; const bool bok = bn < N;
    for (int k0 = 0; k0 < K; k0 += 32) {
        const float4 av0 = ap0 ? *(const float4*)(ap0 + k0 + akk) : make_float4(0.f, 0.f, 0.f, 0.f);
        const float4 av1 = ap1 ? *(const float4*)(ap1 + k0 + akk) : make_float4(0.f, 0.f, 0.f, 0.f);
        const int kb0 = k0 + (tid >> 5), kb1 = kb0 + 16;
        const float4 bv00 = bok ? *(const float4*)(B0 + (size_t)kb0 * ldb + bn) : make_float4(0.f, 0.f, 0.f, 0.f);
        const float4 bv01 = bok ? *(const float4*)(B0 + (size_t)kb1 * ldb + bn) : make_float4(0.f, 0.f, 0.f, 0.f);
        const float4 bv10 = (DUAL && bok) ? *(const float4*)(B1 + (size_t)kb0 * ldb + bn) : bv00;
        const float4 bv11 = (DUAL && bok) ? *(const float4*)(B1 + (size_t)kb1 * ldb + bn) : bv01;
        __syncthreads();
        { const int r = (tid >> 3);
          As[(akk + 0) * 132 + r] = av0.x; As[(akk + 1) * 132 + r] = av0.y; As[(akk + 2) * 132 + r] = av0.z; As[(akk + 3) * 132 + r] = av0.w;
          As[(akk + 0) * 132 + r + 64] = av1.x; As[(akk + 1) * 132 + r + 64] = av1.y; As[(akk + 2) * 132 + r + 64] = av1.z; As[(akk + 3) * 132 + r + 64] = av1.w; }
        { const int k = (tid >> 5);
          *(float4*)&Bs0[k * 128 + (tid & 31) * 4] = bv00; *(float4*)&Bs0[(k + 16) * 128 + (tid & 31) * 4] = bv01;
          if (DUAL) { *(float4*)&Bs1[k * 128 + (tid & 31) * 4] = bv10; *(float4*)&Bs1[(k + 16) * 128 + (tid & 31) * 4] = bv11; } }
        __syncthreads();
#pragma unroll 4
        for (int k = 0; k < 32; ++k) {
            const float4 a = *(const float4*)&As[k * 132 + ty * 4];
            const float4 b0 = *(const float4*)&Bs0[k * 128 + tx * 4], b1 = *(const float4*)&Bs0[k * 128 + 64 + tx * 4];
            const float aa[4] = {a.x, a.y, a.z, a.w};
            const float bb[8] = {b0.x, b0.y, b0.z, b0.w, b1.x, b1.y, b1.z, b1.w};
#pragma unroll
            for (int i = 0; i < 4; ++i)
#pragma unroll
                for (int j = 0; j < 8; ++j) acc0[i][j] = fmaf(aa[i], bb[j], acc0[i][j]);
            if (DUAL) {
                const float4 c0 = *(const float4*)&Bs1[k * 128 + tx * 4], c1 = *(const float4*)&Bs1[k * 128 + 64 + tx * 4];
                const float cc[8] = {c0.x, c0.y, c0.z, c0.w, c1.x, c1.y, c1.z, c1.w};
#pragma unroll
                for (int i = 0; i < 4; ++i)
#pragma unroll
                    for (int j = 0; j < 8; ++j) acc1[i][j] = fmaf(aa[i], cc[j], acc1[i][j]);
            }
        }
    }
#pragma unroll
    for (int i = 0; i < 4; ++i)
#pragma unroll
        for (int j = 0; j < 8; ++j) {
            const int r = ty * 4 + i, c = n0 + (j < 4 ? tx * 4 + j : 64 + tx * 4 + (j - 4));
            if (c < N) epi(r, c, acc0[i][j], acc1[i][j]);
        }
    __syncthreads();
}

__device__ __forceinline__ void ph_inproj(LAS unsigned char* ldsb, const bf16_t* xn, const bf16_t* wt, bf16_t* z, const float* RS, int skip) {
    pg8::StaticOrder S; S.init(NTOK, NMAIN, D, D, gridDim.x, blockIdx.x, xn, wt, INPROJ_WGM);
    if (skip & 2) S.pmmask = 15;
    pg8::EpiZ E{z, RS};
    pg8::gemm_phase<pg8::EpiZ, pg8::StaticOrder, false>(ldsb, D, D, S, E);
}

namespace ml {
using pg8::bf16x8; using pg8::f32x4; using pg8::u32x4; using pg8::u32x2;
constexpr int L = 128, NCH = S / L, NU = NB * 4 * NCH;
constexpr int QP = 144;
constexpr int OFF_Q = 0, OFF_K = OFF_Q + 128 * QP, OFF_V = OFF_K + 128 * QP, OFF_KW = OFF_V + 128 * QP, OFF_F = OFF_KW + 128 * QP;
constexpr int LDS_END = OFF_F + 4 * 128 * 4 + 64;
constexpr int OFF_CW = 96 * 1024;
constexpr size_t O_CL = 0, O_CST = O_CL + (size_t)NU * 4096 * 4, O_NL = O_CST + (size_t)NU * 4096 * 2, O_NST = O_NL + (size_t)NU * 64 * 4,
                 O_MLOC = O_NST + (size_t)NU * 64 * 4, O_BL = O_MLOC + (size_t)NU * 4, O_MST = O_BL + (size_t)NU * 4, O_END = O_MST + (size_t)NU * 4;
__device__ __forceinline__ f32x4 mfma16(bf16x8 a, bf16x8 b, f32x4 c) { return __builtin_amdgcn_mfma_f32_16x16x32_bf16(a, b, c, 0, 0, 0); }
__device__ __forceinline__ float bf_lo(unsigned w) { return __uint_as_float(w << 16); }
__device__ __forceinline__ float bf_hi(unsigned w) { return __uint_as_float(w & 0xffff0000u); }
__device__ __forceinline__ unsigned short bf1(float x) { return (unsigned short)(pg8::cvt_pk_bf16(x, 0.f) & 0xffffu); }

__device__ __forceinline__ void gates_pre(const float* gates, const Params& P, int l, int head, int tok0, int tid, float (&gv)[2]) {
    gv[0] = 0.f; gv[1] = 0.f;
    if (tid < 128) { const float* zr = gates + (size_t)(tok0 + tid) * 8; gv[0] = zr[head] + P.in[I_GATEB][l * 8 + head]; gv[1] = zr[4 + head] + P.in[I_GATEB][l * 8 + 4 + head]; }
}
__device__ __forceinline__ void stage_gates(LAS unsigned char* lds, const float (&gv)[2], int tid) {
    LAS float* LF = (LAS float*)(lds + OFF_F); LAS float* IG = LF + 128; LAS float* Bc = LF + 256; LAS float* G2 = LF + 384; LAS float* scal = LF + 512;
    if (tid < 128) { const float ipre = gv[0], fpre = gv[1];
        LF[tid] = fminf(fpre, 0.f) - log1pf(expf(-fabsf(fpre))); IG[tid] = ipre; }
    __syncthreads();
    if (tid < 64) { const float a = LF[2 * tid], b2 = LF[2 * tid + 1]; const float s = a + b2; float inc = s;
#pragma unroll
        for (int o = 1; o < 64; o <<= 1) { const float v = __shfl_up(inc, o); if (tid >= o) inc += v; }
        const float exc = inc - s; const float b0 = exc + a, b1 = exc + s;
        Bc[2 * tid] = b0; Bc[2 * tid + 1] = b1; const float g0 = IG[2 * tid] - b0, g1 = IG[2 * tid + 1] - b1; G2[2 * tid] = g0; G2[2 * tid + 1] = g1;
        float gm = fmaxf(g0, g1);
#pragma unroll
        for (int o = 32; o > 0; o >>= 1) gm = fmaxf(gm, __shfl_xor(gm, o));
        if (tid == 63) { scal[0] = gm; scal[1] = b1; } }
    __syncthreads();
}
__device__ __forceinline__ void conv8_load(const bf16_t* z, int b, int pos, int which, int head, int c0, u32x4 (&raw)[4]) {
    const int col = (which ? ZCK : ZCQ) + head * 64 + c0;
#pragma unroll
    for (int j = 0; j < 4; ++j) { const int tg = pos - 3 + j; raw[j] = *(const u32x4*)(z + zat(b * S + (tg > 0 ? tg : 0), col)); }
}
__device__ __forceinline__ void stage_convw(LAS unsigned char* lds, const Params& P, int l) {
    const float* cwg = P.in[I_CONVW] + (size_t)l * 4 * 512;
    __syncthreads();
    *(LAS pg8::f32x4*)(lds + OFF_CW + tid_opaque() * 16) = *(const pg8::f32x4*)(cwg + tid_opaque() * 4);
    if (tid_opaque() < 64) *(LAS pg8::f32x4*)(lds + OFF_CW + 8192 + tid_opaque() * 16) = *(const pg8::f32x4*)(P.in[I_MNG] + l * 256 + tid_opaque() * 4);
    __syncthreads();
}
__device__ __forceinline__ void conv8_finish(const u32x4 (&raw)[4], const LAS float* cw, int pos, int which, int head, int c0, float (&o)[8]) {
    const int cc = which * 256 + head * 64 + c0;
    float x[8];
#pragma unroll
    for (int e = 0; e < 8; ++e) x[e] = 0.f;
    pg8::f32x4 wa[4], wb[4];
#pragma unroll
    for (int j = 0; j < 4; ++j) { wa[j] = *(const LAS pg8::f32x4*)(cw + j * 512 + cc); wb[j] = *(const LAS pg8::f32x4*)(cw + j * 512 + cc + 4); }
#pragma unroll
    for (int j = 0; j < 4; ++j) { const float mk = (pos - 3 + j >= 0) ? 1.f : 0.f;
        const pg8::f32x4 w0 = wa[j], w1 = wb[j];
        x[0] += mk * w0.x * bf_lo(raw[j].x); x[1] += mk * w0.y * bf_hi(raw[j].x); x[2] += mk * w0.z * bf_lo(raw[j].y); x[3] += mk * w0.w * bf_hi(raw[j].y);
        x[4] += mk * w1.x * bf_lo(raw[j].z); x[5] += mk * w1.y * bf_hi(raw[j].z); x[6] += mk * w1.z * bf_lo(raw[j].w); x[7] += mk * w1.w * bf_hi(raw[j].w); }
    const float sc = which ? 0.125f : 1.f;
#pragma unroll
    for (int e = 0; e < 8; ++e) o[e] = x[e] * sc * rsig(x[e]);
}
__device__ __forceinline__ void vt_load(const bf16_t* z, int head, int tok0, int tid, u32x4 (&w)[2]) {
#pragma unroll
    for (int it = 0; it < 2; ++it) { const int idx = tid + it * NTHREADS, s = idx >> 3, cg = idx & 7; w[it] = *(const u32x4*)(z + zat(tok0 + s, ZCV + head * 64 + cg * 8)); }
}
__device__ __forceinline__ void vt_store(LAS unsigned char* lds, int tid, const u32x4 (&w)[2]) {
#pragma unroll
    for (int it = 0; it < 2; ++it) { const int idx = tid + it * NTHREADS, s = idx >> 3, cg = idx & 7; *(LAS u32x4*)(lds + OFF_V + s * QP + cg * 16) = w[it]; }
}

__device__ __forceinline__ void p1_unit(LAS unsigned char* lds, const bf16_t* z, const float* gates, const Params& P, int l, int u, unsigned char* wsm) {
    const int tid = tid_opaque(), lane = tid & 63, wid = __builtin_amdgcn_readfirstlane(tid >> 6), r = lane & 15, qd = lane >> 4;
    const int b = u >> 8, head = (u >> 6) & 3, c = u & 63, tok0 = b * S + c * L;
    LAS float* G2 = (LAS float*)(lds + OFF_F) + 384; LAS float* scal = (LAS float*)(lds + OFF_F) + 512;
    float gv[2]; gates_pre(gates, P, l, head, tok0, tid, gv);
    u32x4 vraw[2], kraw[2][4];
    vt_load(z, head, tok0, tid, vraw);
#pragma unroll
    for (int it = 0; it < 2; ++it) { const int idx = tid + it * NTHREADS; conv8_load(z, b, c * L + (idx >> 3), 1, head, (idx & 7) * 8, kraw[it]); }
    __syncthreads();
    stage_gates(lds, gv, tid);
    float gsave = 0.f; if (tid < 256) gsave = ((const LAS float*)(lds + OFF_F))[256 + tid];
    u32x4 kcv[2];
    const float gmax = scal[0], bL = scal[1];
    vt_store(lds, tid, vraw);
    const LAS float* cw = (const LAS float*)(lds + OFF_CW);
#pragma unroll
    for (int it = 0; it < 2; ++it) { const int idx = tid + it * NTHREADS, s = idx >> 3, cg = idx & 7;
        float o[8]; conv8_finish(kraw[it], cw, c * L + s, 1, head, cg * 8, o);
        kcv[it].x = pg8::cvt_pk_bf16(o[0], o[1]); kcv[it].y = pg8::cvt_pk_bf16(o[2], o[3]); kcv[it].z = pg8::cvt_pk_bf16(o[4], o[5]); kcv[it].w = pg8::cvt_pk_bf16(o[6], o[7]);
        const float ws = __expf(G2[s] - gmax);
        u32x4 w; w.x = pg8::cvt_pk_bf16(o[0] * ws, o[1] * ws); w.y = pg8::cvt_pk_bf16(o[2] * ws, o[3] * ws); w.z = pg8::cvt_pk_bf16(o[4] * ws, o[5] * ws); w.w = pg8::cvt_pk_bf16(o[6] * ws, o[7] * ws);
        *(LAS u32x4*)(lds + OFF_KW + s * QP + cg * 16) = w; }
    __syncthreads();
    const int kt = wid >> 1;
    float* CL = (float*)(wsm + O_CL) + (size_t)u * 4096;
    const bf16x8 ones = {0x3F80, 0x3F80, 0x3F80, 0x3F80, 0x3F80, 0x3F80, 0x3F80, 0x3F80};
    f32x4 accn = {0.f, 0.f, 0.f, 0.f};
#pragma unroll
    for (int i = 0; i < 2; ++i) { const int vt = (wid & 1) * 2 + i; f32x4 acc = {0.f, 0.f, 0.f, 0.f};
#pragma unroll
        for (int ks = 0; ks < 4; ++ks) {
            const LAS unsigned char* ap = lds + OFF_KW + (32 * ks + 8 * qd + (r >> 2)) * QP + (16 * kt + 4 * (r & 3)) * 2; const LAS unsigned char* bp = lds + OFF_V + (32 * ks + 8 * qd + (r >> 2)) * QP + (16 * vt + 4 * (r & 3)) * 2;
            const u32x2_t a0 = lds_tr4(ap), a1 = lds_tr4(ap + 4 * QP), b0 = lds_tr4(bp), b1 = lds_tr4(bp + 4 * QP);
            const u32x4 aw = {a0.x, a0.y, a1.x, a1.y}, bw = {b0.x, b0.y, b1.x, b1.y};
            acc = mfma16(__builtin_bit_cast(bf16x8, aw), __builtin_bit_cast(bf16x8, bw), acc);
            if (i == 0) accn = mfma16(__builtin_bit_cast(bf16x8, aw), ones, accn); }
        *(f32x4*)(CL + (size_t)(16 * vt + r) * 64 + 16 * kt + 4 * qd) = acc; }
    if ((wid & 1) == 0 && r == 0) *(f32x4*)((float*)(wsm + O_NL) + (size_t)u * 64 + 16 * kt + 4 * qd) = accn;
    if (tid == 0) { ((float*)(wsm + O_MLOC))[u] = bL + gmax; ((float*)(wsm + O_BL))[u] = bL; }
#pragma unroll
    for (int it = 0; it < 2; ++it) { const int idx = tid + it * NTHREADS, s = idx >> 3, cg = idx & 7; *(u32x4*)((bf16_t*)(P.ws + WS_KC) + (size_t)(tok0 + s) * 256 + head * 64 + cg * 8) = kcv[it]; }
    if (tid < 256) ((float*)(P.ws + WS_GS))[(size_t)u * 256 + tid] = gsave;
}
__device__ __forceinline__ void p2_scan(unsigned char* wsm) {
    const int tid = tid_opaque();
    const float* CL = (const float*)(wsm + O_CL); const float* NL = (const float*)(wsm + O_NL); const float* MLOC = (const float*)(wsm + O_MLOC); const float* BL = (const float*)(wsm + O_BL);
    bf16_t* CST = (bf16_t*)(wsm + O_CST); float* NST = (float*)(wsm + O_NST); float* MST = (float*)(wsm + O_MST);
    for (int idx = blockIdx.x * NTHREADS + tid; idx < 32 * 4096; idx += gridDim.x * NTHREADS) {
        const int bh = idx >> 12, e = idx & 4095;
        float C = 0.f, nn = 0.f, m = 0.f;
#pragma unroll 1
        for (int c0 = 0; c0 < NCH; c0 += 16) {
            float cl[16], ml_[16], bl[16], nl[16];
#pragma unroll
            for (int i = 0; i < 16; ++i) { const int u = bh * NCH + c0 + i; cl[i] = CL[(size_t)u * 4096 + e]; ml_[i] = MLOC[u]; bl[i] = BL[u]; nl[i] = NL[(size_t)u * 64 + (e & 63)]; }
            unsigned short cs[16]; float ns[16], ms[16];
#pragma unroll
            for (int i = 0; i < 16; ++i) { cs[i] = bf1(C); ns[i] = nn; ms[i] = m;
                const float mn = fmaxf(bl[i] + m, ml_[i]), dec = __expf(bl[i] + m - mn), wl = __expf(ml_[i] - mn);
                C = dec * C + wl * cl[i]; nn = dec * nn + wl * nl[i]; m = mn; }
#pragma unroll
            for (int i = 0; i < 16; ++i) { const int u = bh * NCH + c0 + i; CST[(size_t)u * 4096 + e] = cs[i]; if (e < 64) NST[(size_t)u * 64 + e] = ns[i]; if (e == 0) MST[u] = ms[i]; }
        }
    }
}
__device__ __forceinline__ void p3_unit(LAS unsigned char* lds, const bf16_t* z, const float* gates, const Params& P, int l, int u, const unsigned char* wsm, bf16_t* mix) {
    const int tid = tid_opaque(), lane = tid & 63, wid = __builtin_amdgcn_readfirstlane(tid >> 6), r = lane & 15, qd = lane >> 4;
    const int b = u >> 8, head = (u >> 6) & 3, c = u & 63, tok0 = b * S + c * L;
    LAS float* Bc = (LAS float*)(lds + OFF_F) + 256; LAS float* G2 = (LAS float*)(lds + OFF_F) + 384;
    float gsv = 0.f; if (tid < 256) gsv = ((const float*)(P.ws + WS_GS))[(size_t)u * 256 + tid];
    u32x4 vraw[2], coraw[2], qkraw[2][4], kcraw[2];
    vt_load(z, head, tok0, tid, vraw);
#pragma unroll
    for (int it = 0; it < 2; ++it) { const int idx = tid + it * NTHREADS, s = idx >> 3, cg = idx & 7; coraw[it] = *(const u32x4*)(z + zat(tok0 + s, ZCO + head * 64 + cg * 8)); }
#pragma unroll
    for (int it = 0; it < 2; ++it) { const int idx = tid + it * NTHREADS, s = idx >> 3, cg = idx & 7; kcraw[it] = *(const u32x4*)((const bf16_t*)(P.ws + WS_KC) + (size_t)(tok0 + s) * 256 + head * 64 + cg * 8); }
#pragma unroll
    for (int it = 0; it < 2; ++it) { const int idx = tid + it * NTHREADS; conv8_load(z, b, c * L + (idx >> 3), 0, head, (idx & 7) * 8, qkraw[it]); }
    __syncthreads();
    if (tid < 256) ((LAS float*)(lds + OFF_F))[256 + tid] = gsv;
    vt_store(lds, tid, vraw);
#pragma unroll
    for (int it = 0; it < 2; ++it) { const int idx = tid + it * NTHREADS, s = idx >> 3, cg = idx & 7; *(LAS u32x4*)(lds + OFF_K + s * QP + cg * 16) = kcraw[it]; }
#pragma unroll
    for (int it = 0; it < 2; ++it) { const int idx = tid + it * NTHREADS, s = idx >> 3, cg = idx & 7; *(LAS u32x4*)(lds + OFF_KW + s * QP + cg * 16) = coraw[it]; }
    const LAS float* cw = (const LAS float*)(lds + OFF_CW);
#pragma unroll
    for (int it = 0; it < 2; ++it) { const int idx = tid + it * NTHREADS, s = idx >> 3, cg = idx & 7;
        float o[8]; conv8_finish(qkraw[it], cw, c * L + s, 0, head, cg * 8, o);
        u32x4 w; w.x = pg8::cvt_pk_bf16(o[0], o[1]); w.y = pg8::cvt_pk_bf16(o[2], o[3]); w.z = pg8::cvt_pk_bf16(o[4], o[5]); w.w = pg8::cvt_pk_bf16(o[6], o[7]);
        *(LAS u32x4*)(lds + OFF_Q + s * QP + cg * 16) = w; }
    __syncthreads();
    const int w = wid, t = 16 * w + r;
    const bf16_t* cst = (const bf16_t*)(wsm + O_CST) + (size_t)u * 4096; const float* nst = (const float*)(wsm + O_NST) + (size_t)u * 64;
    bf16x8 cf[4][2]; f32x4 nf[4];
#pragma unroll
    for (int dt = 0; dt < 4; ++dt) { cf[dt][0] = *(const bf16x8*)(cst + (16 * dt + r) * 64 + 8 * qd); cf[dt][1] = *(const bf16x8*)(cst + (16 * dt + r) * 64 + 32 + 8 * qd); }
    nf[0] = *(const f32x4*)(nst + 8 * qd); nf[1] = *(const f32x4*)(nst + 8 * qd + 4); nf[2] = *(const f32x4*)(nst + 32 + 8 * qd); nf[3] = *(const f32x4*)(nst + 36 + 8 * qd);
    const float mst = ((const float*)(wsm + O_MST))[u];
    __builtin_amdgcn_sched_barrier(0);
    const bf16x8 bq0 = *(const LAS bf16x8*)(lds + OFF_Q + t * QP + qd * 16), bq1 = *(const LAS bf16x8*)(lds + OFF_Q + t * QP + 64 + qd * 16);
    f32x4 accS[8];
#pragma unroll
    for (int ct = 0; ct < 8; ++ct) { accS[ct] = (f32x4){0.f, 0.f, 0.f, 0.f};
        if (ct <= w) { const bf16x8 a0 = *(const LAS bf16x8*)(lds + OFF_K + (16 * ct + r) * QP + qd * 16), a1 = *(const LAS bf16x8*)(lds + OFF_K + (16 * ct + r) * QP + 64 + qd * 16);
            accS[ct] = mfma16(a0, bq0, accS[ct]); accS[ct] = mfma16(a1, bq1, accS[ct]); } }
    const float bt = Bc[t];
    float ld[8][4]; float mloc = -3.0e38f;
#pragma unroll
    for (int ct = 0; ct < 8; ++ct) { const f32x4 g = *(const LAS f32x4*)(G2 + 16 * ct + 4 * qd);
#pragma unroll
        for (int j = 0; j < 4; ++j) { const bool valid = (ct < w) || (ct == w && 4 * qd + j <= r); ld[ct][j] = valid ? bt + g[j] : -3.0e38f; mloc = fmaxf(mloc, ld[ct][j]); } }
    mloc = fmaxf(mloc, __shfl_xor(mloc, 16)); mloc = fmaxf(mloc, __shfl_xor(mloc, 32));
    const float mt = fmaxf(bt + mst, mloc);
    float den = 0.f;
#pragma unroll
    for (int ct = 0; ct < 8; ++ct)
#pragma unroll
        for (int j = 0; j < 4; ++j) { const float pe = __expf(ld[ct][j] - mt) * accS[ct][j]; accS[ct][j] = pe; den += pe; }
    den += __shfl_xor(den, 16); den += __shfl_xor(den, 32);
    f32x4 accN[4];
#pragma unroll
    for (int dt = 0; dt < 4; ++dt) { accN[dt] = mfma16(cf[dt][0], bq0, (f32x4){0.f, 0.f, 0.f, 0.f}); accN[dt] = mfma16(cf[dt][1], bq1, accN[dt]); }
    const float winter = __expf(bt + mst - mt);
    float nq = 0.f;
    { const f32x4 n0 = nf[0], n1 = nf[1], n2 = nf[2], n3 = nf[3];
      const u32x4 q0 = __builtin_bit_cast(u32x4, bq0), q1 = __builtin_bit_cast(u32x4, bq1);
      nq = bf_lo(q0.x) * n0.x + bf_hi(q0.x) * n0.y + bf_lo(q0.y) * n0.z + bf_hi(q0.y) * n0.w + bf_lo(q0.z) * n1.x + bf_hi(q0.z) * n1.y + bf_lo(q0.w) * n1.z + bf_hi(q0.w) * n1.w
         + bf_lo(q1.x) * n2.x + bf_hi(q1.x) * n2.y + bf_lo(q1.y) * n2.z + bf_hi(q1.y) * n2.w + bf_lo(q1.z) * n3.x + bf_hi(q1.z) * n3.y + bf_lo(q1.w) * n3.z + bf_hi(q1.w) * n3.w; }
    nq += __shfl_xor(nq, 16); nq += __shfl_xor(nq, 32);
    den += winter * nq;
#pragma unroll
    for (int dt = 0; dt < 4; ++dt) accN[dt] = accN[dt] * winter;
#pragma unroll
    for (int kk = 0; kk < 4; ++kk) if (2 * kk <= w) {
        u32x4 pw; pw.x = pg8::cvt_pk_bf16(accS[2 * kk][0], accS[2 * kk][1]); pw.y = pg8::cvt_pk_bf16(accS[2 * kk][2], accS[2 * kk][3]);
        pw.z = pg8::cvt_pk_bf16(accS[2 * kk + 1][0], accS[2 * kk + 1][1]); pw.w = pg8::cvt_pk_bf16(accS[2 * kk + 1][2], accS[2 * kk + 1][3]);
        const bf16x8 pf = __builtin_bit_cast(bf16x8, pw);
#pragma unroll
        for (int dt = 0; dt < 4; ++dt) { const LAS unsigned char* vp = lds + OFF_V + (32 * kk + 4 * qd + (r >> 2)) * QP + (16 * dt + 4 * (r & 3)) * 2;
            const u32x2_t v0 = lds_tr4(vp), v1 = lds_tr4(vp + 16 * QP);
            u32x4 vw; vw.x = v0.x; vw.y = v0.y; vw.z = v1.x; vw.w = v1.y;
            accN[dt] = mfma16(__builtin_bit_cast(bf16x8, vw), pf, accN[dt]); } }
    const float inv = 1.f / fmaxf(fabsf(den), __expf(-mt));
    float ss = 0.f;
#pragma unroll
    for (int dt = 0; dt < 4; ++dt) { accN[dt] = accN[dt] * inv; ss += accN[dt][0] * accN[dt][0] + accN[dt][1] * accN[dt][1] + accN[dt][2] * accN[dt][2] + accN[dt][3] * accN[dt][3]; }
    ss += __shfl_xor(ss, 16); ss += __shfl_xor(ss, 32);
    const float rs = rsqrtf(ss * (1.f / 64.f) + EPS);
    const LAS float* ng = (const LAS float*)(lds + OFF_CW + 8192) + head * 64; const LAS unsigned char* cop = lds + OFF_KW + t * QP;
    bf16_t* op = mix + (size_t)(tok0 + t) * D + 512 + head * 64;
#pragma unroll
    for (int dt = 0; dt < 4; ++dt) { const int d0 = 16 * dt + 4 * qd; const f32x4 g = *(const LAS f32x4*)(ng + d0); const u32x2_t cw2 = *(const LAS u32x2_t*)(cop + d0 * 2); const float4 co = make_float4(bf_lo(cw2.x), bf_hi(cw2.x), bf_lo(cw2.y), bf_hi(cw2.y));
        u32x2 o; o.x = pg8::cvt_pk_bf16(accN[dt][0] * rs * g.x * rsig(co.x), accN[dt][1] * rs * g.y * rsig(co.y));
        o.y = pg8::cvt_pk_bf16(accN[dt][2] * rs * g.z * rsig(co.z), accN[dt][3] * rs * g.w * rsig(co.w));
        *(u32x2*)(op + d0) = o; }
}
static_assert(O_END <= 64 * MiB && LDS_END <= 128 * 1024, "mLSTM scratch fits");
}

namespace s5 {
using pg8::bf16x8; using pg8::f32x4; using pg8::u32x4; using pg8::u32x2;
constexpr int LC = 16, NINST = NTOK / LC;
constexpr size_t O_E = 0, O_XC = O_E + (size_t)NINST * 16 * 128 * 4, O_END = O_XC + (size_t)NINST * 16 * 128 * 2;
constexpr int YP = 528;
__device__ __forceinline__ f32x4 mfma16(bf16x8 a, bf16x8 b, f32x4 c) { return __builtin_amdgcn_mfma_f32_16x16x32_bf16(a, b, c, 0, 0, 0); }

__device__ __forceinline__ void build_tables(float* ldsf, const Params& P, int l, int g, unsigned char* tb) {
    const int tid = tid_opaque();
    float* apw = ldsf; float* bb = apw + 17 * 64 * 2; float* cc = bb + 64 * 16 * 2;
    __syncthreads();
    if (tid < 64) { const int gp = (l * 16 + g) * 64 + tid;
        const float ar = P.in[I_ARE][gp], ai = P.in[I_AIM][gp], dt = expf(P.in[I_LDT][l * 16 + g]);
        for (int tau = 0; tau <= 16; ++tau) { const float er = expf(ar * dt * tau), ang = ai * dt * tau; apw[(tau * 64 + tid) * 2] = er * cosf(ang); apw[(tau * 64 + tid) * 2 + 1] = er * sinf(ang); }
        const float abr = apw[(64 + tid) * 2], abi = apw[(64 + tid) * 2 + 1];
        const float xr_ = abr - 1.f, xi_ = abi, den = ar * ar + ai * ai;
        const float cr = (xr_ * ar + xi_ * ai) / den, ci = (xi_ * ar - xr_ * ai) / den;
        for (int h = 0; h < 16; ++h) { const float br = P.in[I_BRE][(size_t)gp * 16 + h], bi = P.in[I_BIM][(size_t)gp * 16 + h]; bb[(tid * 16 + h) * 2] = cr * br - ci * bi; bb[(tid * 16 + h) * 2 + 1] = cr * bi + ci * br; }
        float* a16 = (float*)(tb + T_A16) + (size_t)(g * 64 + tid) * 2; a16[0] = apw[(16 * 64 + tid) * 2]; a16[1] = apw[(16 * 64 + tid) * 2 + 1]; }
    for (int idx = tid; idx < 16 * 64; idx += NTHREADS) { const int h = idx >> 6, p = idx & 63; const int ci_ = ((l * 16 + g) * 16 + h) * 64 + p; cc[idx * 2] = P.in[I_CRE][ci_]; cc[idx * 2 + 1] = P.in[I_CIM][ci_]; }
    __syncthreads();
    bf16_t* KM = (bf16_t*)(tb + T_KMAT) + (size_t)g * 32 * 256;
    for (int idx = tid; idx < 15 * 256; idx += NTHREADS) KM[idx] = (bf16_t)0; bf16_t* FT = (bf16_t*)(tb + T_F) + (size_t)g * 256 * 128; bf16_t* GT = (bf16_t*)(tb + T_G) + (size_t)g * 128 * 256;
    for (int idx = tid; idx < 16 * 256; idx += NTHREADS) { const int tau = idx >> 8, h = (idx >> 4) & 15, hp = idx & 15; float s = 0.f;
        for (int p = 0; p < 64; ++p) { const float cr = cc[(h * 64 + p) * 2], ci = cc[(h * 64 + p) * 2 + 1], ar = apw[(tau * 64 + p) * 2], ai = apw[(tau * 64 + p) * 2 + 1], br = bb[(p * 16 + hp) * 2], bi = bb[(p * 16 + hp) * 2 + 1];
            const float er = ar * br - ai * bi, ei = ar * bi + ai * br; s += cr * er - ci * ei; }
        KM[15 * 256 + idx] = ml::bf1(s); }
    for (int idx = tid; idx < 256 * 64; idx += NTHREADS) { const int n = idx >> 6, p = idx & 63, t = n >> 4, h = n & 15;
        const float cr = cc[(h * 64 + p) * 2], ci = cc[(h * 64 + p) * 2 + 1], ar = apw[((t + 1) * 64 + p) * 2], ai = apw[((t + 1) * 64 + p) * 2 + 1];
        FT[(size_t)n * 128 + p] = ml::bf1(cr * ar - ci * ai); FT[(size_t)n * 128 + 64 + p] = ml::bf1(-(cr * ai + ci * ar)); }
    for (int idx = tid; idx < 64 * 256; idx += NTHREADS) { const int p = idx >> 8, k = idx & 255, s = k >> 4, hp = k & 15;
        const float ar = apw[((15 - s) * 64 + p) * 2], ai = apw[((15 - s) * 64 + p) * 2 + 1], br = bb[(p * 16 + hp) * 2], bi = bb[(p * 16 + hp) * 2 + 1];
        GT[(size_t)p * 256 + k] = ml::bf1(ar * br - ai * bi); GT[(size_t)(64 + p) * 256 + k] = ml::bf1(ar * bi + ai * br); }
}
__device__ __forceinline__ void load_u_frags(const bf16_t* z, int tok0, int g, int r, int qd, bf16x8 (&uf)[8]) {
#pragma unroll
    for (int ks = 0; ks < 8; ++ks) uf[ks] = *(const bf16x8*)(z + zat(tok0 + 16 * r + 2 * ks + (qd >> 1), ZSU + 16 * g + 8 * (qd & 1)));
}
__device__ __forceinline__ void p1_unit(const bf16_t* z, const unsigned char* tb, int u, unsigned char* wss) {
    const int tid = tid_opaque(), lane = tid & 63, wid = __builtin_amdgcn_readfirstlane(tid >> 6), r = lane & 15, qd = lane >> 4;
    const int tok0 = u * 256, inst0 = u * 16;
    float* E = (float*)(wss + O_E);
#pragma unroll 1
    for (int gi = 0; gi < 2; ++gi) { const int g = 2 * wid + (gi ^ (((int)blockIdx.x >> 3) & 1));
        bf16x8 uf[8]; load_u_frags(z, tok0, g, r, qd, uf);
        const bf16_t* GT = (const bf16_t*)(tb + T_G) + (size_t)g * 128 * 256 + (size_t)r * 256 + 8 * qd;
        bf16x8 gf[2][8];
#pragma unroll
        for (int ks = 0; ks < 8; ++ks) gf[0][ks] = *(const bf16x8*)(GT + 32 * ks);
#pragma unroll
        for (int nt = 0; nt < 8; ++nt) {
            if (nt + 1 < 8) {
#pragma unroll
                for (int ks = 0; ks < 8; ++ks) gf[(nt + 1) & 1][ks] = *(const bf16x8*)(GT + (size_t)(16 * (nt + 1)) * 256 + 32 * ks); }
            __builtin_amdgcn_sched_barrier(0);
            f32x4 acc = {0.f, 0.f, 0.f, 0.f};
#pragma unroll
            for (int ks = 0; ks < 8; ++ks) acc = mfma16(gf[nt & 1][ks], uf[ks], acc);
            *(f32x4*)(E + ((size_t)(inst0 + r) * 16 + g) * 128 + 16 * nt + 4 * qd) = acc;
            __builtin_amdgcn_sched_barrier(0); }
    }
}
__device__ __forceinline__ void p2_scan(LAS unsigned char* lds, const unsigned char* tb, unsigned char* wss) {
    const int tid = tid_opaque(), pl = tid & 31, seg = tid >> 5;
    const float* __restrict__ E = (const float*)(wss + O_E); bf16_t* __restrict__ XC = (bf16_t*)(wss + O_XC);
    LAS float* SE = (LAS float*)lds;
    for (int u = blockIdx.x; u < NB * 16 * 2; u += gridDim.x) {
        const int b = u >> 5, g = (u >> 1) & 15, p = pl + 32 * (u & 1);
        const float* a16 = (const float*)(tb + T_A16) + (size_t)(g * 64 + p) * 2; const float ar = a16[0], ai = a16[1];
        const size_t o0 = ((size_t)(b * (S / LC) + seg * 32) * 16 + g) * 128 + p; constexpr size_t cs = (size_t)16 * 128;
        float xr = 0.f, xi = 0.f;
#pragma unroll 1
        for (int c0 = 0; c0 < 32; c0 += 16) { float er[16], ei[16];
#pragma unroll
            for (int i = 0; i < 16; ++i) { er[i] = E[o0 + (c0 + i) * cs]; ei[i] = E[o0 + (c0 + i) * cs + 64]; }
#pragma unroll
            for (int i = 0; i < 16; ++i) { const float nr = ar * xr - ai * xi + er[i], ni = ar * xi + ai * xr + ei[i]; xr = nr; xi = ni; } }
        __syncthreads();
        SE[(seg * 32 + pl) * 2] = xr; SE[(seg * 32 + pl) * 2 + 1] = xi;
        __syncthreads();
        float br = ar, bi = ai;
#pragma unroll
        for (int i = 0; i < 5; ++i) { const float nr = br * br - bi * bi, ni = 2.f * br * bi; br = nr; bi = ni; }
        xr = 0.f; xi = 0.f;
        for (int s2 = 0; s2 < seg; ++s2) { const float er = SE[(s2 * 32 + pl) * 2], ei = SE[(s2 * 32 + pl) * 2 + 1]; const float nr = br * xr - bi * xi + er, ni = br * xi + bi * xr + ei; xr = nr; xi = ni; }
#pragma unroll 1
        for (int c0 = 0; c0 < 32; c0 += 16) { float er[16], ei[16]; unsigned short sr[16], si[16];
#pragma unroll
            for (int i = 0; i < 16; ++i) { er[i] = E[o0 + (c0 + i) * cs]; ei[i] = E[o0 + (c0 + i) * cs + 64]; }
#pragma unroll
            for (int i = 0; i < 16; ++i) { sr[i] = ml::bf1(xr); si[i] = ml::bf1(xi); const float nr = ar * xr - ai * xi + er[i], ni = ar * xi + ai * xr + ei[i]; xr = nr; xi = ni; }
#pragma unroll
            for (int i = 0; i < 16; ++i) { XC[o0 + (c0 + i) * cs] = sr[i]; XC[o0 + (c0 + i) * cs + 64] = si[i]; } }
    }
    __syncthreads();
}
__device__ __forceinline__ void p3_unit(LAS unsigned char* lds, const bf16_t* z, const Params& P, int l, const unsigned char* tb, int u, const unsigned char* wss, bf16_t* mix) {
    const int tid = tid_opaque(), lane = tid & 63, wid = __builtin_amdgcn_readfirstlane(tid >> 6), r = lane & 15, qd = lane >> 4;
    const int tok0 = u * 256, inst0 = u * 16;
    const bf16_t* XC = (const bf16_t*)(wss + O_XC);
    __syncthreads();
#pragma unroll 1
    for (int gi = 0; gi < 2; ++gi) { const int g = 2 * wid + (gi ^ (((int)blockIdx.x >> 3) & 1));
        bf16x8 uf[8]; load_u_frags(z, tok0, g, r, qd, uf);
        bf16x8 xf[4];
#pragma unroll
        for (int ks = 0; ks < 4; ++ks) xf[ks] = *(const bf16x8*)(XC + ((size_t)(inst0 + r) * 16 + g) * 128 + 32 * ks + 8 * qd);
        const bf16_t* KM = (const bf16_t*)(tb + T_KMAT) + (size_t)g * 32 * 256 + (size_t)(15 - (qd >> 1)) * 256 + r * 16 + 8 * (qd & 1);
        const bf16_t* FT = (const bf16_t*)(tb + T_F) + (size_t)g * 256 * 128 + (size_t)r * 128 + 8 * qd;
        const bf16_t* up = z + zat(tok0 + 16 * r, ZSU + 16 * g + 4 * qd);
        const float4 dsk = *(const float4*)(P.in[I_SD] + l * 256 + g * 16 + 4 * qd);
        bf16x8 kd[16], ff[2][4]; u32x2 uw[2];
#pragma unroll
        for (int d = 0; d < 16; ++d) kd[d] = *(const bf16x8*)(KM + (ptrdiff_t)d * 256);
#pragma unroll
        for (int ks = 0; ks < 4; ++ks) ff[0][ks] = *(const bf16x8*)(FT + 32 * ks);
        uw[0] = *(const u32x2*)up;
#pragma unroll
        for (int t = 0; t < 16; ++t) {
            if (t + 1 < 16) {
#pragma unroll
                for (int ks = 0; ks < 4; ++ks) ff[(t + 1) & 1][ks] = *(const bf16x8*)(FT + (size_t)(t + 1) * 16 * 128 + 32 * ks);
                uw[(t + 1) & 1] = *(const u32x2*)(up + (size_t)(t + 1) * ZP); }
            __builtin_amdgcn_sched_barrier(0);
            f32x4 acc = {0.f, 0.f, 0.f, 0.f};
#pragma unroll
            for (int ks = 0; ks < 8; ++ks) if (2 * ks <= t) acc = mfma16(kd[t - 2 * ks], uf[ks], acc);
#pragma unroll
            for (int ks = 0; ks < 4; ++ks) acc = mfma16(ff[t & 1][ks], xf[ks], acc);
            const u32x2 uu = uw[t & 1];
            const float y0 = gelu_tanh(acc[0] + dsk.x * ml::bf_lo(uu.x)), y1 = gelu_tanh(acc[1] + dsk.y * ml::bf_hi(uu.x)), y2 = gelu_tanh(acc[2] + dsk.z * ml::bf_lo(uu.y)), y3 = gelu_tanh(acc[3] + dsk.w * ml::bf_hi(uu.y));
            u32x2 o; o.x = pg8::cvt_pk_bf16(y0, y1); o.y = pg8::cvt_pk_bf16(y2, y3);
            *(LAS u32x2*)(lds + (16 * r + t) * YP + (16 * g + 4 * qd) * 2) = o;
            __builtin_amdgcn_sched_barrier(0); }
    }
    __syncthreads();
    const bf16_t* GW = (const bf16_t*)(tb + T_GLUW);
    bf16x8 wf[2][8];
#pragma unroll
    for (int nt = 0; nt < 2; ++nt)
#pragma unroll
        for (int ks = 0; ks < 8; ++ks) wf[nt][ks] = *(const bf16x8*)(GW + (size_t)(32 * wid + 16 * nt + r) * 256 + 32 * ks + 8 * qd);
    const float* gb = P.in[I_GLUB] + l * 256;
    const float4 gb0 = *(const float4*)(gb + 32 * wid + 4 * qd), gb1 = *(const float4*)(gb + 32 * wid + 16 + 4 * qd);
#pragma unroll 2
    for (int mt = 0; mt < 16; ++mt) {
        f32x4 a0 = {0.f, 0.f, 0.f, 0.f}, a1 = {0.f, 0.f, 0.f, 0.f};
#pragma unroll
        for (int ks = 0; ks < 8; ++ks) { const bf16x8 yf = *(const LAS bf16x8*)(lds + (16 * mt + r) * YP + (32 * ks + 8 * qd) * 2); a0 = mfma16(wf[0][ks], yf, a0); a1 = mfma16(wf[1][ks], yf, a1); }
        const int row = 16 * mt + r;
        const u32x2 y0 = *(const LAS u32x2*)(lds + row * YP + (32 * wid + 4 * qd) * 2), y1 = *(const LAS u32x2*)(lds + row * YP + (32 * wid + 16 + 4 * qd) * 2);
        bf16_t* op = mix + (size_t)(tok0 + row) * D + 256 + 32 * wid + 4 * qd;
        u32x2 o;
        o.x = pg8::cvt_pk_bf16(ml::bf_lo(y0.x) * rsig(a0[0] + gb0.x), ml::bf_hi(y0.x) * rsig(a0[1] + gb0.y));
        o.y = pg8::cvt_pk_bf16(ml::bf_lo(y0.y) * rsig(a0[2] + gb0.z), ml::bf_hi(y0.y) * rsig(a0[3] + gb0.w));
        *(u32x2*)op = o;
        o.x = pg8::cvt_pk_bf16(ml::bf_lo(y1.x) * rsig(a1[0] + gb1.x), ml::bf_hi(y1.x) * rsig(a1[1] + gb1.y));
        o.y = pg8::cvt_pk_bf16(ml::bf_lo(y1.y) * rsig(a1[2] + gb1.z), ml::bf_hi(y1.y) * rsig(a1[3] + gb1.w));
        *(u32x2*)(op + 16) = o;
    }
}
static_assert(T_LAYER <= 4 * MiB && O_END <= 48 * MiB && 256 * YP <= LDS_BYTES - 64, "S5 scratch fits");
}
__device__ __forceinline__ void s5_build_tables_fwd(float* ldsf, const Params& P, int l, int g, unsigned char* tb) { s5::build_tables(ldsf, P, l, g, tb); }

namespace at {
using pg8::bf16x8; using pg8::f32x4; using pg8::u32x4; using pg8::u32x2;
constexpr int KP = 144, OFF_K = 0, OFF_V = 256 * KP, LDS_END = OFF_V + 256 * KP;
__device__ __forceinline__ void unit(LAS unsigned char* lds, const bf16_t* z, const float* sinks, bf16_t* mix, int u) {
    const int tid = tid_opaque(), lane = tid & 63, wid = __builtin_amdgcn_readfirstlane(tid >> 6), r = lane & 15, qd = lane >> 4;
    const int b = u >> 7, g = (u >> 6) & 1, n = u & 63, tokb = b * S + 128 * n;
    const int hq = 2 * g + (wid >> 2);
    const float sink = sinks[hq];
    __syncthreads();
    u32x4 kw[4], vw[4];
#pragma unroll
    for (int it = 0; it < 4; ++it) { const int idx = tid + it * NTHREADS, kl = idx >> 3, cg = idx & 7; const bool ok = (n > 0) || (kl >= 128);
        kw[it] = *(const u32x4*)(z + zat(ok ? tokb - 128 + kl : tokb, ZK + g * 64 + cg * 8)); }
#pragma unroll
    for (int it = 0; it < 4; ++it) { const int idx = tid + it * NTHREADS, kl = idx >> 3, cg = idx & 7; const bool ok = (n > 0) || (kl >= 128);
        vw[it] = *(const u32x4*)(z + zat(ok ? tokb - 128 + kl : tokb, ZV + g * 64 + cg * 8)); }
    bf16x8 bqa[2][2];
#pragma unroll
    for (int qt = 0; qt < 2; ++qt) { const int tokq = tokb + (wid & 3) * 32 + qt * 16 + r;
        bqa[qt][0] = *(const bf16x8*)(z + zat(tokq, ZQ + hq * 64 + 8 * qd)); bqa[qt][1] = *(const bf16x8*)(z + zat(tokq, ZQ + hq * 64 + 32 + 8 * qd)); }
    __builtin_amdgcn_sched_barrier(0);
#pragma unroll
    for (int it = 0; it < 4; ++it) { const int idx = tid + it * NTHREADS, kl = idx >> 3, cg = idx & 7; const bool ok = (n > 0) || (kl >= 128);
        u32x4 w = kw[it]; if (!ok) w = (u32x4){0u, 0u, 0u, 0u};
        *(LAS u32x4*)(lds + OFF_K + kl * KP + cg * 16) = w; }
#pragma unroll
    for (int it = 0; it < 4; ++it) { const int idx = tid + it * NTHREADS, kl = idx >> 3, cg = idx & 7; const bool ok = (n > 0) || (kl >= 128);
        u32x4 w = vw[it]; if (!ok) w = (u32x4){0u, 0u, 0u, 0u};
        *(LAS u32x4*)(lds + OFF_V + kl * KP + cg * 16) = w; }
    __syncthreads();
#pragma unroll
    for (int qt = 0; qt < 2; ++qt) {
        const int i0 = (wid & 3) * 32 + qt * 16, kt0 = i0 >> 4, tok = tokb + i0 + r;
        const bf16x8 bq0 = bqa[qt][0], bq1 = bqa[qt][1];
        f32x4 accS[9];
#pragma unroll
        for (int c = 0; c < 9; ++c) { const int kt = kt0 + c;
            const bf16x8 a0 = *(const LAS bf16x8*)(lds + OFF_K + (16 * kt + r) * KP + qd * 16), a1 = *(const LAS bf16x8*)(lds + OFF_K + (16 * kt + r) * KP + 64 + qd * 16);
            accS[c] = ml::mfma16(a0, bq0, (f32x4){0.f, 0.f, 0.f, 0.f}); accS[c] = ml::mfma16(a1, bq1, accS[c]); }
        float m = sink;
#pragma unroll
        for (int c = 0; c < 9; ++c)
#pragma unroll
            for (int j = 0; j < 4; ++j) { const int e = 4 * qd + j;
                bool valid = (c == 0) ? (e > r) : ((c == 8) ? (e <= r) : true);
                valid = valid && ((n > 0) || (kt0 + c >= 8));
                const float s = valid ? accS[c][j] * 0.125f : -3.0e38f; accS[c][j] = s; m = fmaxf(m, s); }
        m = fmaxf(m, __shfl_xor(m, 16)); m = fmaxf(m, __shfl_xor(m, 32));
        float l = 0.f;
#pragma unroll
        for (int c = 0; c < 9; ++c)
#pragma unroll
            for (int j = 0; j < 4; ++j) { const float p = __expf(accS[c][j] - m); accS[c][j] = p; l += p; }
        l += __shfl_xor(l, 16); l += __shfl_xor(l, 32);
        l += __expf(sink - m);
        f32x4 accO[4];
#pragma unroll
        for (int dt = 0; dt < 4; ++dt) accO[dt] = (f32x4){0.f, 0.f, 0.f, 0.f};
#pragma unroll
        for (int kk = 0; kk < 5; ++kk) {
            u32x4 pw; pw.x = pg8::cvt_pk_bf16(accS[2 * kk][0], accS[2 * kk][1]); pw.y = pg8::cvt_pk_bf16(accS[2 * kk][2], accS[2 * kk][3]);
            if (kk < 4) { pw.z = pg8::cvt_pk_bf16(accS[2 * kk + 1][0], accS[2 * kk + 1][1]); pw.w = pg8::cvt_pk_bf16(accS[2 * kk + 1][2], accS[2 * kk + 1][3]); } else { pw.z = 0u; pw.w = 0u; }
            const bf16x8 pf = __builtin_bit_cast(bf16x8, pw);
            const int base = 16 * (kt0 + 2 * kk);
#pragma unroll
            for (int dt = 0; dt < 4; ++dt) { const LAS unsigned char* vp = lds + OFF_V + (base + 4 * qd + (r >> 2)) * KP + (16 * dt + 4 * (r & 3)) * 2;
                const u32x2_t v0 = lds_tr4(vp);
                u32x2_t v1 = {0u, 0u}; if (kk < 4) v1 = lds_tr4(vp + 16 * KP);
                u32x4 vw; vw.x = v0.x; vw.y = v0.y; vw.z = v1.x; vw.w = v1.y;
                accO[dt] = ml::mfma16(__builtin_bit_cast(bf16x8, vw), pf, accO[dt]); } }
        const float inv = 1.f / l;
        bf16_t* op = mix + (size_t)tok * D + hq * 64;
#pragma unroll
        for (int dt = 0; dt < 4; ++dt) { u32x2 o; o.x = pg8::cvt_pk_bf16(accO[dt][0] * inv, accO[dt][1] * inv); o.y = pg8::cvt_pk_bf16(accO[dt][2] * inv, accO[dt][3] * inv);
            *(u32x2*)(op + 16 * dt + 4 * qd) = o; }
    }
}
}

namespace sg {
using pg8::bf16x8; using pg8::f32x4; using pg8::u32x4; using pg8::u32x2;
constexpr int OFF_LN = 96 * 1024;
constexpr int VP = 528, OFF_V = 0, OFF_ST = 128 * VP, LDS_END = OFF_ST + 128 * 4 * 2 * 4;
__device__ __forceinline__ void stage_ln(LAS unsigned char* lds, const Params& P, int l) {
    __syncthreads();
    if (tid_opaque() < 128) { const int i = tid_opaque(); *(LAS f32x4*)(lds + OFF_LN + i * 16) = *(const f32x4*)((i < 64 ? P.in[I_LNG] : P.in[I_LNB]) + l * 256 + (i & 63) * 4); }
    __syncthreads();
}
__device__ __forceinline__ void unit(LAS unsigned char* lds, const bf16_t* z, const Params& P, int l, const bf16_t* wb  , bf16_t* mix, int u) {
    const int tid = tid_opaque(), lane = tid & 63, wid = __builtin_amdgcn_readfirstlane(tid >> 6), r = lane & 15, qd = lane >> 4;
    const int tok0 = u * 128;
    LAS float* ST = (LAS float*)(lds + OFF_ST);
    __syncthreads();
    const int s = tid & 127, cq = tid >> 7;
    const bf16_t* gp = z + zat(tok0 + s, ZGV + cq * 64);
    u32x4 raw[8];
#pragma unroll
    for (int i = 0; i < 8; ++i) raw[i] = *(const u32x4*)(gp + 8 * i);
    const int t = 16 * wid + r;
    u32x2 gwa[4][4]; float biasa[4];
#pragma unroll
    for (int g = 0; g < 4; ++g) { biasa[g] = P.in[I_SGUB][l * 512 + g * 128 + t];
#pragma unroll
        for (int ct = 0; ct < 4; ++ct) gwa[g][ct] = *(const u32x2*)(z + zat(tok0 + t, ZGU + g * 64 + 16 * ct + 4 * qd)); }
    bf16x8 wf[2][4];
#pragma unroll
    for (int ks = 0; ks < 4; ++ks) wf[0][ks] = *(const bf16x8*)(wb + (size_t)t * 128 + 32 * ks + 8 * qd);
    float sm = 0.f, sq = 0.f;
    float gel[8][8];
#pragma unroll
    for (int i = 0; i < 8; ++i) { const unsigned ww[4] = {raw[i].x, raw[i].y, raw[i].z, raw[i].w};
#pragma unroll
        for (int e = 0; e < 8; ++e) { const float ge = gelu_tanh((e & 1) ? bfh(ww[e >> 1]) : bfl(ww[e >> 1])); gel[i][e] = ge; sm += ge; sq += ge * ge; } }
    ST[(s * 4 + cq) * 2] = sm; ST[(s * 4 + cq) * 2 + 1] = sq;
    __syncthreads();
    { float tsm = 0.f, tsq = 0.f;
#pragma unroll
      for (int q = 0; q < 4; ++q) { tsm += ST[(s * 4 + q) * 2]; tsq += ST[(s * 4 + q) * 2 + 1]; }
      const float mu = tsm * (1.f / 256.f), var = fmaxf(tsq * (1.f / 256.f) - mu * mu, 0.f), rs = rsqrtf(var + EPS);
      const LAS float* lg = (const LAS float*)(lds + OFF_LN) + cq * 64; const LAS float* lb = lg + 256;
#pragma unroll
      for (int i = 0; i < 8; ++i) {
          const f32x4 g0 = *(const LAS f32x4*)(lg + 8 * i), g1 = *(const LAS f32x4*)(lg + 8 * i + 4), b0 = *(const LAS f32x4*)(lb + 8 * i), b1 = *(const LAS f32x4*)(lb + 8 * i + 4);
          const float gg[8] = {g0.x, g0.y, g0.z, g0.w, g1.x, g1.y, g1.z, g1.w}, bb[8] = {b0.x, b0.y, b0.z, b0.w, b1.x, b1.y, b1.z, b1.w};
          float o[8];
#pragma unroll
          for (int e = 0; e < 8; ++e) o[e] = (gel[i][e] - mu) * rs * gg[e] + bb[e];
          u32x4 w; w.x = pg8::cvt_pk_bf16(o[0], o[1]); w.y = pg8::cvt_pk_bf16(o[2], o[3]); w.z = pg8::cvt_pk_bf16(o[4], o[5]); w.w = pg8::cvt_pk_bf16(o[6], o[7]);
          *(LAS u32x4*)(lds + OFF_V + s * VP + (cq * 64 + 8 * i) * 2) = w; } }
    __syncthreads();
    const LAS unsigned char* vtr = lds + OFF_V + (8 * qd + (r >> 2)) * VP + (4 * (r & 3)) * 2;
#pragma unroll
    for (int g = 0; g < 4; ++g) {
        if (g + 1 < 4) {
#pragma unroll
            for (int ks = 0; ks < 4; ++ks) wf[(g + 1) & 1][ks] = *(const bf16x8*)(wb + ((size_t)(g + 1) * 128 + t) * 128 + 32 * ks + 8 * qd); }
        const float bias = biasa[g];
        u32x2 gw[4];
#pragma unroll
        for (int ct = 0; ct < 4; ++ct) gw[ct] = gwa[g][ct];
#pragma unroll
        for (int ct = 0; ct < 4; ++ct) { f32x4 acc = {0.f, 0.f, 0.f, 0.f};
#pragma unroll
            for (int ks = 0; ks < 4; ++ks) if (2 * ks <= wid) { const LAS unsigned char* ap = vtr + (32 * ks) * VP + (g * 64 + 16 * ct) * 2;
                const u32x2_t a0 = lds_tr4(ap), a1 = lds_tr4(ap + 4 * VP); const u32x4 aw = {a0.x, a0.y, a1.x, a1.y};
                acc = ml::mfma16(__builtin_bit_cast(bf16x8, aw), wf[g & 1][ks], acc); }
            const int c0 = g * 64 + 16 * ct + 4 * qd;
            u32x2 o; o.x = pg8::cvt_pk_bf16(gelu_tanh(bfl(gw[ct].x)) * (acc[0] + bias), gelu_tanh(bfh(gw[ct].x)) * (acc[1] + bias)); o.y = pg8::cvt_pk_bf16(gelu_tanh(bfl(gw[ct].y)) * (acc[2] + bias), gelu_tanh(bfh(gw[ct].y)) * (acc[3] + bias));
            *(u32x2*)(mix + (size_t)(tok0 + t) * D + 768 + c0) = o; }
    }
}
}

__device__ __forceinline__ int xcd_major_id() { const int per = (int)gridDim.x >> 3; return ((int)gridDim.x & 7) ? (int)blockIdx.x : ((int)blockIdx.x & 7) * per + ((int)blockIdx.x >> 3); }
__device__ __forceinline__ void ph_mix1(float* lds, const Params& P, int l, bf16_t* z, const float* gates, bf16_t* mix, unsigned char* wsm, unsigned char* wss, const unsigned char* tb, int sub) {
    const int G = gridDim.x, bid = blockIdx.x;
    if (sub & 1) { ml::stage_convw((LAS unsigned char*)lds, P, l); for (int u = bid; u < ml::NU; u += G) ml::p1_unit((LAS unsigned char*)lds, z, gates, P, l, u, wsm); }
    __syncthreads();
    if (sub & 2) for (int u = bid; u < NTOK / 256; u += G) s5::p1_unit(z, tb, u, wss);
    __syncthreads();
    if (sub & 4) for (int u = xcd_major_id(); u < 1024; u += G) at::unit((LAS unsigned char*)lds, z, P.in[I_SINK] + l * 4, mix, u);
    __syncthreads();
    if (sub & 8) { sg::stage_ln((LAS unsigned char*)lds, P, l); for (int u = bid; u < NTOK / 128; u += G) sg::unit((LAS unsigned char*)lds, z, P, l, (const bf16_t*)(tb + s5::T_SGUW), mix, u); }
    __syncthreads();
}

__device__ __forceinline__ void ph_mix2(float* lds, const Params& P, int l, const bf16_t* z, const float* gates, bf16_t* mix, const unsigned char* wsm, const unsigned char* wss, const unsigned char* tb, int sub) {
    if (sub & 1) for (int u = blockIdx.x; u < NTOK / 256; u += gridDim.x) s5::p3_unit((LAS unsigned char*)lds, z, P, l, tb, u, wss, mix);
    __syncthreads();
    if (sub & 2) { ml::stage_convw((LAS unsigned char*)lds, P, l); for (int u = blockIdx.x; u < ml::NU; u += gridDim.x) ml::p3_unit((LAS unsigned char*)lds, z, gates, P, l, u, wsm, mix); }
    __syncthreads();
}

template <bool SRCF32>
__device__ __forceinline__ void ph_outproj(LAS unsigned char* ldsb, const bf16_t* mix, const bf16_t* wt, const float* xf, bf16_t* xb) {
    pg8::StaticOrder S; S.init(NTOK, D, D, D, gridDim.x, blockIdx.x, mix, wt);
    pg8::EpiResB<SRCF32> E{xf, xb};
    pg8::gemm_phase<pg8::EpiResB<SRCF32>, pg8::StaticOrder, false>(ldsb, D, D, S, E);
}

namespace rp {
using pg8::bf16x8; using pg8::f32x4; using pg8::u32x4;
constexpr size_t T_HI = 0, T_LO = (size_t)48 * D * 2, T_GHI = 2 * T_LO, T_GLO = T_GHI + (size_t)16 * D * 2, T_SIZE = T_GLO + (size_t)16 * D * 2;
static_assert(T_SIZE <= 256 * 1024, "row-pass tables fit their slot");
template <int NT, bool COMBINE> struct StepIn { float4 xa[2], xb[2]; u32x4 xr[2]; u32x4 y1[2], y2[2]; };
template <int NT> struct StepW { bf16x8 wh[NT], wl[NT]; };
__device__ __forceinline__ void build_base(LAS int* base, const unsigned* cnt) {
    __syncthreads();
    if (tid_opaque() == 0) { int b = 0; for (int e = 0; e < NEXP; ++e) { base[e] = b; b += (((int)cnt[e] + 255) >> 8) << 8; } }
    __syncthreads();
}
template <int NT, bool COMBINE, bool XBF>
__device__ __forceinline__ void run(LAS unsigned char* lds, const Params& P, int l, const float* x, bf16_t* xq, const bf16_t* YB, const unsigned* inv, const unsigned* cntprev,
                                    const bf16_t* WH, const bf16_t* WL, bf16_t* XN, float* RS, float* gates, unsigned* cnt, int2* lists, unsigned* invout) {
    const int tid = tid_opaque(), lane = tid & 63, wid = __builtin_amdgcn_readfirstlane(tid >> 6), r = lane & 15, qd = lane >> 4;
    LAS int* BASE = (LAS int*)(lds + 64 * 1024);
    LAS float* LG = (LAS float*)lds + wid * (32 * 49);
    if (COMBINE) build_base(BASE, cntprev);
    LAS unsigned* LCNT = (LAS unsigned*)(lds + 64 * 1024 + 256); LAS unsigned* GBASE = LCNT + 32;
    for (int rb0 = blockIdx.x * 8; rb0 < NTOK / 32; rb0 += gridDim.x * 8) {
        const int rb = rb0 + wid; const bool live = rb < NTOK / 32;
        const int row0 = (live ? rb : rb0) * 32;
        if (NT == 1 && !live) continue;
        size_t yr1[2] = {0, 0}, yr2[2] = {0, 0};
        if (COMBINE) {
#pragma unroll
            for (int mt = 0; mt < 2; ++mt) { const int row = row0 + 16 * mt + r; const unsigned i1 = inv[2 * row], i2 = inv[2 * row + 1];
                yr1[mt] = (size_t)(BASE[i1 >> 16] + (int)(i1 & 0xffffu)) * D; yr2[mt] = (size_t)(BASE[i2 >> 16] + (int)(i2 & 0xffffu)) * D; } }
        f32x4 acc[2][NT];
#pragma unroll
        for (int mt = 0; mt < 2; ++mt)
#pragma unroll
            for (int nt = 0; nt < NT; ++nt) acc[mt][nt] = (f32x4){0.f, 0.f, 0.f, 0.f};
        float ssq[2] = {0.f, 0.f};
        StepIn<NT, COMBINE> sb[4]; StepW<NT> sw[2];
        auto load = [&](StepIn<NT, COMBINE>& s, int ks) {
            const int k0 = 32 * ks + 8 * qd;
#pragma unroll
            for (int mt = 0; mt < 2; ++mt) {
                if (XBF) s.xr[mt] = *(const u32x4*)(xq + (size_t)(row0 + 16 * mt + r) * D + k0);
                else { const float* xp = x + (size_t)(row0 + 16 * mt + r) * D + k0; s.xa[mt] = *(const float4*)xp; s.xb[mt] = *(const float4*)(xp + 4); }
                if (COMBINE) { s.y1[mt] = *(const u32x4*)(YB + yr1[mt] + k0); s.y2[mt] = *(const u32x4*)(YB + yr2[mt] + k0); } }
        };
        auto loadw = [&](StepW<NT>& s, int ks) {
            const int k0 = 32 * ks + 8 * qd;
#pragma unroll
            for (int nt = 0; nt < NT; ++nt) { s.wh[nt] = *(const bf16x8*)(WH + (size_t)(16 * nt + r) * D + k0); s.wl[nt] = *(const bf16x8*)(WL + (size_t)(16 * nt + r) * D + k0); }
        };
        auto process = [&](const StepIn<NT, COMBINE>& s, const StepW<NT>& sw_, int ks) {
            const int k0 = 32 * ks + 8 * qd;
            bf16x8 xh[2], xl[2];
#pragma unroll
            for (int mt = 0; mt < 2; ++mt) { float4 a = s.xa[mt], b = s.xb[mt]; u32x4 h;
                if (XBF) { h = s.xr[mt]; a = make_float4(bfl(h.x), bfh(h.x), bfl(h.y), bfh(h.y)); b = make_float4(bfl(h.z), bfh(h.z), bfl(h.w), bfh(h.w)); }
                if (COMBINE) { const u32x4 p = s.y1[mt], q = s.y2[mt];
                    a.x += bfl(p.x) + bfl(q.x); a.y += bfh(p.x) + bfh(q.x); a.z += bfl(p.y) + bfl(q.y); a.w += bfh(p.y) + bfh(q.y);
                    b.x += bfl(p.z) + bfl(q.z); b.y += bfh(p.z) + bfh(q.z); b.z += bfl(p.w) + bfl(q.w); b.w += bfh(p.w) + bfh(q.w);
                    h.x = pg8::cvt_pk_bf16(a.x, a.y); h.y = pg8::cvt_pk_bf16(a.z, a.w); h.z = pg8::cvt_pk_bf16(b.x, b.y); h.w = pg8::cvt_pk_bf16(b.z, b.w);
                    *(u32x4*)(xq + (size_t)(row0 + 16 * mt + r) * D + k0) = h;
                    a = make_float4(bfl(h.x), bfh(h.x), bfl(h.y), bfh(h.y)); b = make_float4(bfl(h.z), bfh(h.z), bfl(h.w), bfh(h.w)); }
                ssq[mt] += a.x * a.x + a.y * a.y + a.z * a.z + a.w * a.w + b.x * b.x + b.y * b.y + b.z * b.z + b.w * b.w;
                if (!XBF) {
                    const float v[8] = {a.x, a.y, a.z, a.w, b.x, b.y, b.z, b.w};
                    h.x = pg8::cvt_pk_bf16(v[0], v[1]); h.y = pg8::cvt_pk_bf16(v[2], v[3]); h.z = pg8::cvt_pk_bf16(v[4], v[5]); h.w = pg8::cvt_pk_bf16(v[6], v[7]);
                    *(u32x4*)(XN + (size_t)(row0 + 16 * mt + r) * D + k0) = h;
                    u32x4 lo; lo.x = pg8::cvt_pk_bf16(v[0] - bfl(h.x), v[1] - bfh(h.x)); lo.y = pg8::cvt_pk_bf16(v[2] - bfl(h.y), v[3] - bfh(h.y)); lo.z = pg8::cvt_pk_bf16(v[4] - bfl(h.z), v[5] - bfh(h.z)); lo.w = pg8::cvt_pk_bf16(v[6] - bfl(h.w), v[7] - bfh(h.w));
                    xl[mt] = __builtin_bit_cast(bf16x8, lo); }
                xh[mt] = __builtin_bit_cast(bf16x8, h); }
#pragma unroll
            for (int nt = 0; nt < NT; ++nt)
#pragma unroll
                for (int mt = 0; mt < 2; ++mt) { acc[mt][nt] = ml::mfma16(sw_.wh[nt], xh[mt], acc[mt][nt]); acc[mt][nt] = ml::mfma16(sw_.wl[nt], xh[mt], acc[mt][nt]);
                    if (!XBF) acc[mt][nt] = ml::mfma16(sw_.wh[nt], xl[mt], acc[mt][nt]); }
        };
        if (NT > 1 && !COMBINE) {
            load(sb[0], 0); load(sb[1], 1); load(sb[2], 2); loadw(sw[0], 0);
#define RP_STEP4(i, xs, ws) do { if ((i) + 3 < 32) load(sb[((xs) + 3) % 4], (i) + 3); if ((i) + 1 < 32) loadw(sw[((ws) + 1) % 2], (i) + 1); process(sb[xs], sw[ws], (i)); } while (0)
#pragma unroll 1
            for (int ks = 0; ks < 28; ks += 4) { RP_STEP4(ks, 0, 0); RP_STEP4(ks + 1, 1, 1); RP_STEP4(ks + 2, 2, 0); RP_STEP4(ks + 3, 3, 1); }
            RP_STEP4(28, 0, 0); RP_STEP4(29, 1, 1); RP_STEP4(30, 2, 0); RP_STEP4(31, 3, 1);
#undef RP_STEP4
        } else if (COMBINE) {
            load(sb[0], 0); loadw(sw[0], 0);
#pragma unroll 1
            for (int ks = 0; ks < 32; ks += 2) {
                load(sb[1], ks + 1); loadw(sw[1], ks + 1);
                process(sb[0], sw[0], ks);
                if (ks + 2 < 32) { load(sb[0], ks + 2); loadw(sw[0], ks + 2); }
                process(sb[1], sw[1], ks + 1);
            }
        } else {
            load(sb[0], 0); load(sb[1], 1); loadw(sw[0], 0);
#define RP_STEP(i, xs, ws) do { if ((i) + 2 < 32) load(sb[((xs) + 2) % 3], (i) + 2); if ((i) + 1 < 32) loadw(sw[((ws) + 1) % 2], (i) + 1); process(sb[xs], sw[ws], (i)); } while (0)
#pragma unroll 1
            for (int ks = 0; ks < 30; ks += 6) { RP_STEP(ks, 0, 0); RP_STEP(ks + 1, 1, 1); RP_STEP(ks + 2, 2, 0); RP_STEP(ks + 3, 0, 1); RP_STEP(ks + 4, 1, 0); RP_STEP(ks + 5, 2, 1); }
            RP_STEP(30, 0, 0); RP_STEP(31, 1, 1);
#undef RP_STEP
        }
        float rsv[2];
#pragma unroll
        for (int mt = 0; mt < 2; ++mt) { float s = ssq[mt]; s += __shfl_xor(s, 16); s += __shfl_xor(s, 32); rsv[mt] = rsqrtf(s * (1.f / D) + EPS);
            if (qd == 0) RS[row0 + 16 * mt + r] = rsv[mt]; }
        if (NT == 1) {
#pragma unroll
            for (int mt = 0; mt < 2; ++mt) if (qd < 2) { const f32x4 gv = acc[mt][0] * rsv[mt]; *(f32x4*)(gates + (size_t)(row0 + 16 * mt + r) * 8 + 4 * qd) = gv; }
        } else {
            const float* bg = P.in[I_RGB] + l * 4; const float* be = P.in[I_REB] + l * 32;
#pragma unroll
            for (int mt = 0; mt < 2; ++mt)
#pragma unroll
                for (int nt = 0; nt < NT; ++nt)
#pragma unroll
                    for (int j = 0; j < 4; ++j) LG[(16 * mt + r) * 49 + 16 * nt + 4 * qd + j] = acc[mt][nt][j] * rsv[mt];
            wave_lds_fence();
            if (tid < 32) LCNT[tid] = 0u;
            __syncthreads();
            int ex1 = 0, ex2 = 0; float w1 = 0.f, w2 = 0.f; unsigned lp1 = 0u, lp2 = 0u;
            if (lane < 32 && live) {
                const LAS float* lg = LG + lane * 49;
                float gl[4];
#pragma unroll
                for (int j = 0; j < 4; ++j) gl[j] = lg[j] + bg[j];
                int sel = 0; float gm = gl[0];
#pragma unroll
                for (int j = 1; j < 4; ++j) if (gl[j] > gm) { gm = gl[j]; sel = j; }
                float gs = 0.f;
#pragma unroll
                for (int j = 0; j < 4; ++j) gs += expf(gl[j] - gm);
                const float pg = 1.f / gs;
                float ein[8];
#pragma unroll
                for (int j = 0; j < 8; ++j) ein[j] = lg[4 + sel * 8 + j] + be[sel * 8 + j];
                int i1 = 0; float v1 = ein[0];
#pragma unroll
                for (int j = 1; j < 8; ++j) if (ein[j] > v1) { v1 = ein[j]; i1 = j; }
                int i2 = -1; float v2 = -3.0e38f;
#pragma unroll
                for (int j = 0; j < 8; ++j) if (j != i1 && ein[j] > v2) { v2 = ein[j]; i2 = j; }
                const float e2 = expf(v2 - v1), den = 1.f / (1.f + e2);
                w1 = den * pg; w2 = e2 * den * pg;
                ex1 = sel * 8 + i1; ex2 = sel * 8 + i2;
                lp1 = atomicAdd((unsigned*)&LCNT[ex1], 1u); lp2 = atomicAdd((unsigned*)&LCNT[ex2], 1u);
            }
            __syncthreads();
            if (tid < 32) { const unsigned c = LCNT[tid]; GBASE[tid] = c ? atomicAdd(&cnt[tid], c) : 0u; }
            __syncthreads();
            if (lane < 32 && live) { const int row = row0 + lane; const unsigned p1 = GBASE[ex1] + lp1, p2 = GBASE[ex2] + lp2;
                lists[(size_t)ex1 * NTOK + p1] = make_int2(row, __float_as_int(w1));
                lists[(size_t)ex2 * NTOK + p2] = make_int2(row, __float_as_int(w2));
                const float rsl = (lane >> 4) ? rsv[1] : rsv[0];
                gates[(size_t)ex1 * NTOK + p1] = rsl; gates[(size_t)ex2 * NTOK + p2] = rsl;
                invout[2 * row] = ((unsigned)ex1 << 16) | p1; invout[2 * row + 1] = ((unsigned)ex2 << 16) | p2; }
        }
    }
}
__device__ __forceinline__ void final_norm(LAS unsigned char* lds, const bf16_t* xb, float* out, const bf16_t* YB, const unsigned* inv, const unsigned* cntprev, const float* g) {
    const int tid = tid_opaque(), wave = tid >> 6, lane = tid & 63;
    LAS int* BASE = (LAS int*)(lds + 64 * 1024);
    build_base(BASE, cntprev);
    f32x4 gg[2][2];
#pragma unroll
    for (int i = 0; i < 2; ++i) { gg[i][0] = *(const f32x4*)(g + 512 * i + 8 * lane); gg[i][1] = *(const f32x4*)(g + 512 * i + 8 * lane + 4); }
    const int rstep = gridDim.x * 8, r0 = blockIdx.x * 8 + wave;
    constexpr int RB = 4;
    unsigned iv[RB][2];
#pragma unroll
    for (int j = 0; j < RB; ++j) { const int r = r0 + j * rstep; const bool ok = r < NTOK; iv[j][0] = ok ? inv[2 * r] : 0u; iv[j][1] = ok ? inv[2 * r + 1] : 0u; }
    for (int rb = r0; rb < NTOK; rb += RB * rstep) {
        u32x4 xw[RB][2], ya[RB][2], yb[RB][2];
#pragma unroll
        for (int j = 0; j < RB; ++j) { const int r = rb + j * rstep; const int rc = r < NTOK ? r : rb;
            const bf16_t* y1 = YB + (size_t)(BASE[iv[j][0] >> 16] + (int)(iv[j][0] & 0xffffu)) * D; const bf16_t* y2 = YB + (size_t)(BASE[iv[j][1] >> 16] + (int)(iv[j][1] & 0xffffu)) * D;
            const bf16_t* xp = xb + (size_t)rc * D;
#pragma unroll
            for (int i = 0; i < 2; ++i) { xw[j][i] = *(const u32x4*)(xp + 512 * i + 8 * lane); ya[j][i] = *(const u32x4*)(y1 + 512 * i + 8 * lane); yb[j][i] = *(const u32x4*)(y2 + 512 * i + 8 * lane); } }
#pragma unroll
        for (int j = 0; j < RB; ++j) { const int r = rb + (RB + j) * rstep; const bool ok = r < NTOK; iv[j][0] = ok ? inv[2 * r] : 0u; iv[j][1] = ok ? inv[2 * r + 1] : 0u; }
        __builtin_amdgcn_sched_barrier(0);
#pragma unroll
        for (int j = 0; j < RB; ++j) { const int r = rb + j * rstep;
            float v[2][8]; float ss = 0.f;
#pragma unroll
            for (int i = 0; i < 2; ++i) { const unsigned xx[4] = {xw[j][i].x, xw[j][i].y, xw[j][i].z, xw[j][i].w}, aa[4] = {ya[j][i].x, ya[j][i].y, ya[j][i].z, ya[j][i].w}, bb[4] = {yb[j][i].x, yb[j][i].y, yb[j][i].z, yb[j][i].w};
#pragma unroll
                for (int e = 0; e < 4; ++e) { v[i][2 * e] = bfl(xx[e]) + bfl(aa[e]) + bfl(bb[e]); v[i][2 * e + 1] = bfh(xx[e]) + bfh(aa[e]) + bfh(bb[e]); ss += v[i][2 * e] * v[i][2 * e] + v[i][2 * e + 1] * v[i][2 * e + 1]; } }
            ss = wave_sum(ss);
            const float rs = rsqrtf(ss * (1.f / D) + EPS);
            if (r < NTOK) {
#pragma unroll
                for (int i = 0; i < 2; ++i) { float* p = out + (size_t)r * D + 512 * i + 8 * lane;
                    *(f32x4*)p = (f32x4){v[i][0] * rs * gg[i][0].x, v[i][1] * rs * gg[i][0].y, v[i][2] * rs * gg[i][0].z, v[i][3] * rs * gg[i][0].w};
                    *(f32x4*)(p + 4) = (f32x4){v[i][4] * rs * gg[i][1].x, v[i][5] * rs * gg[i][1].y, v[i][6] * rs * gg[i][1].z, v[i][7] * rs * gg[i][1].w}; } }
        }
    }
}
}

__device__ __forceinline__ int moe_build_tab(LAS unsigned char* ldsb, const unsigned* cnt) {
    LAS pg8::i32x4* tab = (LAS pg8::i32x4*)(ldsb + TAB_OFF);
    __syncthreads();
    int base = 0;
#pragma unroll 1
    for (int e = 0; e < NEXP; ++e) { const int c = __builtin_amdgcn_readfirstlane((int)cnt[e]), nt = (c + 255) >> 8;
        if ((int)tid_opaque() < nt) tab[base + tid_opaque()] = (pg8::i32x4){e, (int)tid_opaque() * 256, c, 0};
        base += nt; }
    __syncthreads();
    return base;
}
__device__ __forceinline__ void moe_tail(float* lds, const Params& P, int l, unsigned* done, bool drain) {
    if (l + 1 >= NLAYER) return;
    __syncthreads();
    if (tid_opaque() == 0) atomicAdd(done, 1u);
    ph_prologue(lds, P, l + 1, drain ? nullptr : done);
}
__device__ __forceinline__ void ph_moe1(float* lds, LAS unsigned char* ldsb, const Params& P, int l, const bf16_t* H, const unsigned* cnt, const int2* lists, bf16_t* act) {
    const int ntiles = moe_build_tab(ldsb, cnt);
    pg8::MoeOrder S; S.tab = (const LAS pg8::i32x4*)(ldsb + TAB_OFF); S.ntiles = ntiles; S.npn = 4; S.G = gridDim.x; S.c = xcd_major_id();
    S.A = (const char*)H; S.atile = 0; S.Bt = (const char*)(P.ws + WS_WGU) + (size_t)l * NEXP * 1024 * D * 2; S.bexp = (size_t)1024 * D * 2; S.btile = (size_t)256 * D * 2; S.lists = lists;
    pg8::EpiAct E{act, (const float*)(P.ws + WS_RSL)};
    pg8::gemm_phase<pg8::EpiAct, pg8::MoeOrder, true>(ldsb, D, D, S, E);
    moe_tail(lds, P, l, (unsigned*)(P.ws + WS_CTL) + CW_DONE + 2 * l, false);
}
__device__ __forceinline__ void ph_moe2(float* lds, LAS unsigned char* ldsb, const Params& P, int l, const bf16_t* act, const unsigned* cnt, const int2* lists, bf16_t* yb) {
    const int ntiles = moe_build_tab(ldsb, cnt);
    pg8::MoeOrder S; S.tab = (const LAS pg8::i32x4*)(ldsb + TAB_OFF); S.ntiles = ntiles; S.npn = 4; S.G = gridDim.x; S.c = xcd_major_id();
    S.A = (const char*)act; S.atile = (size_t)256 * DE * 2; S.Bt = (const char*)(P.ws + WS_WD) + (size_t)l * NEXP * D * DE * 2; S.bexp = (size_t)D * DE * 2; S.btile = (size_t)256 * DE * 2; S.lists = lists;
    pg8::EpiY E{yb, lists};
    pg8::gemm_phase<pg8::EpiY, pg8::MoeOrder, false>(ldsb, DE, DE, S, E);
    moe_tail(lds, P, l, (unsigned*)(P.ws + WS_CTL) + CW_DONE + 2 * l + 1, true);
}

#ifndef PROBE_PH
#define PROBE_PH -1
#endif
#ifndef PROBE_SUB
#define PROBE_SUB 15
#endif
#ifndef PROBE_REPS
#define PROBE_REPS 4
#endif
__global__ void __launch_bounds__(NTHREADS, 2) fwd_kernel(Params P) {
    extern __shared__ __attribute__((aligned(16))) unsigned char lds_raw[];
    float* lds = (float*)lds_raw;
    volatile LAS unsigned* xbw = (volatile LAS unsigned*)(lds_raw + LDS_BYTES - 16);
    if (threadIdx.x == 0) { xbw[0] = 0u; xbw[1] = 0u; }
    __syncthreads();
    unsigned char* const ws = P.ws;
    unsigned* ctl = (unsigned*)(ws + WS_CTL);
    const bool multi = (P.ph_hi - P.ph_lo) > 1;
    XcdBarrier bar; bar.bar = ctl; bar.x = 0; bar.st = xbw;
    if (multi) bar = xcd_barrier_post(ctl, xbw);
    bf16_t* z = (bf16_t*)(ws + WS_Z); float* gates = (float*)(ws + WS_GATES); unsigned char* wss = ws + WS_S5; bf16_t* mix = (bf16_t*)(ws + WS_MIX); unsigned char* wsm = ws + WS_HRAW;
    bf16_t* act = (bf16_t*)(ws + WS_ACT); bf16_t* yb = (bf16_t*)(ws + WS_YB); bf16_t* xbuf = (bf16_t*)(ws + WS_XB); float* rsb = (float*)(ws + WS_RS);
    int2* lists = (int2*)(ws + WS_LIST);
    LAS unsigned char* ldsb = (LAS unsigned char*)lds_raw;
    const int lo = P.ph_lo, hi = P.ph_hi;
#define IN(k) (lo <= (k) && (k) < hi)
#define SEAM(k) do { if (IN(k) && IN((k) + 1)) xcd_barrier(bar); } while (0)
#if PROBE_PH >= 0
#define RUNPH(k, ...) do { if (IN(k)) { const int nrep = ((k) == PROBE_PH) ? 1 + PROBE_REPS : 1; for (int rep = 0; rep < nrep; ++rep) { __VA_ARGS__; if (rep + 1 < nrep) xcd_barrier(bar); } } SEAM(k); } while (0)
#else
#define RUNPH(k, ...) do { if (IN(k)) { constexpr int rep = 0; (void)rep; __VA_ARGS__; } SEAM(k); } while (0)
#endif
    RUNPH(0, ph_prologue(lds, PF, 0, nullptr));
    for (int l = 0; l < NLAYER; ++l) {
        const int pb = 1 + l * PH_PER_LAYER;
        unsigned* cnt = ctl + CW_CNT + l * 64;
        const unsigned char* tb = ws + WS_TB + (size_t)l * 4 * MiB;
        const unsigned char* rtb = ws + WS_RT + (size_t)l * 256 * 1024;
        unsigned* inv = (unsigned*)(ws + WS_INV) + (size_t)l * NTOK * 2;
        RUNPH(pb + 0, { const Params& Q = PF;
            if (l == 0) rp::run<1, false, false>(ldsb, Q, l, Q.in[I_X], nullptr, nullptr, nullptr, nullptr, (const bf16_t*)(rtb + rp::T_GHI), (const bf16_t*)(rtb + rp::T_GLO), xbuf, rsb, gates, nullptr, nullptr, nullptr);
            else        rp::run<1, true, true>(ldsb, Q, l, nullptr, xbuf, yb, inv - (size_t)NTOK * 2, cnt - 64, (const bf16_t*)(rtb + rp::T_GHI), (const bf16_t*)(rtb + rp::T_GLO), nullptr, rsb, gates, nullptr, nullptr, nullptr); });
        RUNPH(pb + 1, ph_inproj(ldsb, xbuf, (const bf16_t*)(ws + WS_WIN) + (size_t)l * NMAIN * D, z, rsb, (rep > 0 && PROBE_SUB <= 3) ? PROBE_SUB : 0));
        RUNPH(pb + 2, ph_mix1(lds, PF, l, z, gates, mix, wsm, wss, tb, rep == 0 ? 15 : PROBE_SUB));
        RUNPH(pb + 3, { s5::p2_scan(ldsb, tb, wss); ml::p2_scan(wsm); });
        RUNPH(pb + 4, ph_mix2(lds, PF, l, z, gates, mix, wsm, wss, tb, rep == 0 ? 15 : PROBE_SUB));
        RUNPH(pb + 5, ph_outproj<false>(ldsb, mix, (const bf16_t*)(ws + WS_WOUT) + (size_t)l * D * D, nullptr, xbuf));
        RUNPH(pb + 6, { if (rep > 0) { if (blockIdx.x == 0 && threadIdx.x < 64) cnt[threadIdx.x] = 0u; xcd_barrier(bar); }
                        const Params& Q = PF; rp::run<3, false, true>(ldsb, Q, l, nullptr, xbuf, nullptr, nullptr, nullptr, (const bf16_t*)(rtb + rp::T_HI), (const bf16_t*)(rtb + rp::T_LO), nullptr, rsb, (float*)(ws + WS_RSL), cnt, lists, inv); });
        RUNPH(pb + 7, ph_moe1(lds, ldsb, PF, l, xbuf, cnt, lists, act));
        RUNPH(pb + 8, ph_moe2(lds, ldsb, PF, l, act, cnt, lists, yb));
    }
    RUNPH(1 + NLAYER * PH_PER_LAYER, { const Params& Q = PF; rp::final_norm(ldsb, xbuf, Q.out, yb, (const unsigned*)(ws + WS_INV) + (size_t)(NLAYER - 1) * NTOK * 2, ctl + CW_CNT + (NLAYER - 1) * 64, Q.in[I_NFIN]); });
#undef RUNPH
#undef IN
#undef SEAM
}

#ifndef N_LAUNCH_MODE
#define N_LAUNCH_MODE 1
#endif
extern "C" void kernel_launch(void* const* d_in, const int* in_sizes, int n_in, void* d_out, int out_size, void* d_ws, size_t ws_size, hipStream_t stream) {
    static int grid = 0;
    if (grid == 0) {
        if (n_in != 31 || out_size != NTOK * D || ws_size < WS_END) { fprintf(stderr, "kernel_launch: unexpected shapes n_in %d out %d ws %zu (need %zu)\n", n_in, out_size, ws_size, (size_t)WS_END); grid = -1; return; }
        int dev = 0, cus = 0, per_cu = 0;
        if (hipGetDevice(&dev) != hipSuccess || hipDeviceGetAttribute(&cus, hipDeviceAttributeMultiprocessorCount, dev) != hipSuccess) { grid = -1; return; }
        if (hipFuncSetAttribute((const void*)fwd_kernel, hipFuncAttributeMaxDynamicSharedMemorySize, LDS_BYTES) != hipSuccess) { fprintf(stderr, "kernel_launch: hipFuncSetAttribute failed\n"); grid = -1; return; }
        if (hipOccupancyMaxActiveBlocksPerMultiprocessor(&per_cu, (const void*)fwd_kernel, NTHREADS, LDS_BYTES) != hipSuccess || per_cu < 1) { fprintf(stderr, "kernel_launch: occupancy query says %d\n", per_cu); }
        (void)hipGetLastError();
        grid = cus;
    }
    if (grid < 0) return;
    (void)hipMemsetAsync((char*)d_ws + WS_CTL, 0, CTL_BYTES, stream);
    Params p{};
    for (int i = 0; i < 31; ++i) p.in[i] = (const float*)d_in[i];
    p.out = (float*)d_out; p.ws = (unsigned char*)d_ws;
#if N_LAUNCH_MODE == 1
    p.ph_lo = 0; p.ph_hi = N_PHASES;
    hipLaunchKernelGGL(fwd_kernel, dim3(grid), dim3(NTHREADS), LDS_BYTES, stream, p);
#else
    for (int ph = 0; ph < N_PHASES; ++ph) { p.ph_lo = ph; p.ph_hi = ph + 1; hipLaunchKernelGGL(fwd_kernel, dim3(grid), dim3(NTHREADS), LDS_BYTES, stream, p); }
#endif
}
```
